# Optimizing an MI355X kernel written in HIP

```python
import math
import jax
import jax.numpy as jnp
from jax import lax
import numpy as np

D_MODEL = 1024
BATCH = 4
SEQ = 8192
DEPTH = 2

CTX_LEN = 256
GRID_W = 64
N_MIXERS = 4
GROUP_WIDTH = D_MODEL // N_MIXERS
HEAD_DIM = 64
N_HEADS = GROUP_WIDTH // HEAD_DIM
CHUNK = 64
CONV_K = 3
GLA_GATE_RANK = 16
GLA_GATE_NORM = 16.0
RWKV_DECAY_RANK = 32
RWKV_A_RANK = 32
RWKV_G_RANK = 64
RWKV_GN_EPS = 64e-5
SSM_STATE = 128
SSM_GROUPS = 2
SSM_HPG = N_HEADS // SSM_GROUPS
SSM_XBC = GROUP_WIDTH + 2 * SSM_GROUPS * SSM_STATE
N_EXPERTS = 64
TOP_K = 8
EXPERT_DIM = 256
SHARED_DIM = 256
ROUTED_SCALE = 2.5
MOE_BLOCK = 128
RMS_EPS = 1e-6

IN_SPLITS = (
    GROUP_WIDTH, GROUP_WIDTH, GROUP_WIDTH, GROUP_WIDTH, GLA_GATE_RANK, GLA_GATE_RANK,
    GROUP_WIDTH, GROUP_WIDTH, GROUP_WIDTH, RWKV_DECAY_RANK, RWKV_DECAY_RANK, RWKV_A_RANK, RWKV_G_RANK,
    GROUP_WIDTH, SSM_XBC, N_HEADS, N_HEADS,
    3 * GROUP_WIDTH, GROUP_WIDTH, N_HEADS, N_HEADS, N_HEADS, N_HEADS,
)
IN_WIDTH = sum(IN_SPLITS)

kernel_name = "hymba_style_bidir_hybrid_moe_block"


def rms_norm(x, g):
    xf = x.astype(jnp.float32)
    y = xf * lax.rsqrt(jnp.mean(xf * xf, axis=-1, keepdims=True) + RMS_EPS)
    return (y * g.astype(jnp.float32)).astype(x.dtype)


def modulate(x, g, shift, scale):
    return rms_norm(x, g) * (1 + scale) + shift


def split_heads(t, n=N_HEADS):
    return t.reshape(t.shape[:-1] + (n, t.shape[-1] // n)).astype(jnp.float32)


def merge_heads(t):
    return t.reshape(t.shape[:-2] + (-1,))


def l2norm(t, eps=1e-6):
    return t * lax.rsqrt(jnp.sum(t * t, axis=-1, keepdims=True) + eps)


def head_rms(o, g):
    o = o * lax.rsqrt(jnp.mean(o * o, axis=-1, keepdims=True) + RMS_EPS)
    return merge_heads(o * g.astype(jnp.float32).reshape(o.shape[-2:]))


def flip(t):
    return t[:, ::-1]


def to_chunks(t):
    b, l = t.shape[:2]
    t = t.reshape((b, l // CHUNK, CHUNK) + t.shape[2:])
    return jnp.swapaxes(t, 2, 3)


def from_chunks(t):
    t = jnp.swapaxes(t, 2, 3)
    return t.reshape((t.shape[0], t.shape[1] * t.shape[2]) + t.shape[3:])


def bidir(core, fwd_args, bwd_args, init):
    y_f, s_f = core(*fwd_args, init[0])
    y_b, s_b = core(*[flip(a) for a in bwd_args], init[1])
    return y_f + flip(y_b), (s_f, s_b)


def dwconv2d(u, w, rows, cols):
    b, l, ch = u.shape
    y = lax.conv_general_dilated(
        u.reshape(b, rows, cols, ch), w[:, :, None, :].astype(u.dtype), (1, 1), 'SAME',
        dimension_numbers=('NHWC', 'HWIO', 'NHWC'), feature_group_count=ch)
    return y.reshape(b, l, ch)


def zero_states(batch):
    z = lambda *s: jnp.zeros((batch, N_HEADS) + s, jnp.float32)
    pair = lambda *s: (z(*s), z(*s))
    return (pair(HEAD_DIM, HEAD_DIM), pair(HEAD_DIM, HEAD_DIM),
            pair(HEAD_DIM, SSM_STATE), pair(HEAD_DIM, HEAD_DIM))


def gla_core(q, k, v, gk, s0):
    incl = jnp.tril(jnp.ones((CHUNK, CHUNK), bool))
    q, k, v, gk = (to_chunks(t) for t in (q * q.shape[-1] ** -0.5, k, v, gk))
    b = jnp.cumsum(gk, axis=3)
    b_last = b[:, :, :, -1:]
    q_t = q * jnp.exp(b)
    k_t = k * jnp.exp(-b)
    k_s = k * jnp.exp(b_last - b)
    att = jnp.where(incl, jnp.einsum('bnhid,bnhjd->bnhij', q_t, k_t), 0.0)
    o_intra = jnp.einsum('bnhij,bnhjv->bnhiv', att, v)

    def step(s, xs):
        q_n, k_n, v_n, dec_n = xs
        o_n = jnp.einsum('bhid,bhdv->bhiv', q_n, s)
        s = s * dec_n[..., None] + jnp.einsum('bhjd,bhjv->bhdv', k_n, v_n)
        return s, o_n

    xs = tuple(jnp.moveaxis(t, 1, 0) for t in (q_t, k_s, v, jnp.exp(b_last[:, :, :, 0])))
    s_fin, o_inter = lax.scan(step, s0, xs)
    return from_chunks(o_intra + jnp.moveaxis(o_inter, 0, 1)), s_fin


def gla_mixer(q, k, v, g, gl_f, gl_b, lp, init):
    dt_in = g.dtype
    q, k, v = split_heads(q), split_heads(k), split_heads(v)

    def forget(gl, d):
        z = gl @ lp['gla_gate_w2'][d] + lp['gla_gate_b'][d]
        return split_heads(jax.nn.log_sigmoid(z.astype(jnp.float32))) / GLA_GATE_NORM

    o, st = bidir(gla_core, (q, k, v, forget(gl_f, 0)), (q, k, v, forget(gl_b, 1)), init)
    y = head_rms(o, lp['gla_norm_g']) * jax.nn.silu(g.astype(jnp.float32))
    return y.astype(dt_in), st


def rwkv_core(r, w, k, v, z, b, s0):
    def step(s, xs):
        r_t, w_t, k_t, v_t, z_t, b_t = xs
        sz = jnp.einsum('bhvk,bhk->bhv', s, z_t)
        s = (s * w_t[:, :, None, :] + sz[..., None] * b_t[:, :, None, :]
             + v_t[..., None] * k_t[:, :, None, :])
        return s, jnp.einsum('bhvk,bhk->bhv', s, r_t)

    s_fin, y = lax.scan(step, s0, tuple(jnp.moveaxis(t, 1, 0) for t in (r, w, k, v, z, b)))
    return jnp.moveaxis(y, 0, 1), s_fin


def rwkv_mixer(r, k, v, wl_f, wl_b, al, gl, lp, init):
    f32 = jnp.float32
    dt_in = r.dtype
    r, k, v = split_heads(r), split_heads(k), split_heads(v)

    def decay(wl, d):
        w = lp['rwkv_w0'][d] + jnp.tanh(wl) @ lp['rwkv_w_w2'][d]
        w = -jax.nn.softplus(-w.astype(f32)) - 0.5
        return split_heads(jnp.exp(-jnp.exp(w)))

    a = split_heads(jax.nn.sigmoid((lp['rwkv_a0'] + al @ lp['rwkv_a_w2']).astype(f32)))
    gate = (jax.nn.sigmoid(gl) @ lp['rwkv_g_w2']).astype(f32)
    kk = l2norm(k * split_heads(lp['rwkv_k_k']))
    k = k * (1.0 + (a - 1.0) * split_heads(lp['rwkv_k_a']))
    z, bvec = -kk, kk * a
    o, st = bidir(rwkv_core, (r, decay(wl_f, 0), k, v, z, bvec),
                  (r, decay(wl_b, 1), k, v, z, bvec), init)
    mu = jnp.mean(o, axis=-1, keepdims=True)
    var = jnp.mean(jnp.square(o - mu), axis=-1, keepdims=True)
    o = merge_heads((o - mu) * lax.rsqrt(var + RWKV_GN_EPS))
    o = o * lp['rwkv_ln_g'].astype(f32) + lp['rwkv_ln_b'].astype(f32)
    bonus = jnp.sum(r * k * lp['rwkv_r_k'].astype(f32), axis=-1, keepdims=True) * v
    y = (o + merge_heads(bonus)) * gate
    return y.astype(dt_in), st


def ssd_core(x, a, bm, cm, s0):
    incl = jnp.tril(jnp.ones((CHUNK, CHUNK), bool))
    xc, ac, bc, cc = (to_chunks(t) for t in (x, a, bm, cm))
    bn, nc = xc.shape[:2]
    acum = jnp.cumsum(ac, axis=-1)
    seg = acum[..., :, None] - acum[..., None, :]
    lmat = jnp.exp(jnp.where(incl, seg, -jnp.inf))
    cb = jnp.einsum('bngis,bngjs->bngij', cc, bc)
    xg = xc.reshape(bn, nc, SSM_GROUPS, SSM_HPG, CHUNK, HEAD_DIM)
    m = cb[:, :, :, None] * lmat.reshape(bn, nc, SSM_GROUPS, SSM_HPG, CHUNK, CHUNK)
    y_intra = jnp.einsum('bngkij,bngkjp->bngkip', m, xg)
    dte = jnp.exp(acum[..., -1:] - acum).reshape(bn, nc, SSM_GROUPS, SSM_HPG, CHUNK)
    cs = jnp.einsum('bngjs,bngkj,bngkjp->bngkps', bc, dte, xg)
    cs = cs.reshape(bn, nc, N_HEADS, HEAD_DIM, SSM_STATE)
    cd = jnp.exp(acum[..., -1])

    def step(s, xs):
        cs_n, cd_n = xs
        return s * cd_n[..., None, None] + cs_n, s

    s_fin, s_in = lax.scan(step, s0, (jnp.moveaxis(cs, 1, 0), jnp.moveaxis(cd, 1, 0)))
    s_in = jnp.moveaxis(s_in, 0, 1).reshape(bn, nc, SSM_GROUPS, SSM_HPG, HEAD_DIM, SSM_STATE)
    dec_in = jnp.exp(acum).reshape(bn, nc, SSM_GROUPS, SSM_HPG, CHUNK)
    y_off = jnp.einsum('bngis,bngkps->bngkip', cc, s_in) * dec_in[..., None]
    y = (y_intra + y_off).reshape(bn, nc, N_HEADS, CHUNK, HEAD_DIM)
    return from_chunks(y), s_fin


def mamba_mixer(z, xbc, dt_f, dt_b, lp, init, rows, cols):
    f32 = jnp.float32
    dt_in = z.dtype
    xbc = jax.nn.silu(dwconv2d(xbc, lp['ssm_conv_w'], rows, cols) + lp['ssm_conv_b'])
    xs, bm, cm = jnp.split(xbc, [GROUP_WIDTH, GROUP_WIDTH + SSM_GROUPS * SSM_STATE], axis=-1)
    xs = split_heads(xs)
    bm, cm = split_heads(bm, SSM_GROUPS), split_heads(cm, SSM_GROUPS)

    def discretise(dt_raw, d):
        dt = jax.nn.softplus((dt_raw + lp['ssm_dt_bias'][d]).astype(f32))
        return xs * dt[..., None], -jnp.exp(lp['ssm_A_log'][d].astype(f32)) * dt

    x_f, a_f = discretise(dt_f, 0)
    x_b, a_b = discretise(dt_b, 1)
    y, st = bidir(ssd_core, (x_f, a_f, bm, cm), (x_b, a_b, bm, cm), init)
    y = y + lp['ssm_D'].astype(f32)[:, None] * xs
    y = merge_heads(y) * jax.nn.silu(z.astype(f32))
    y = y.reshape(y.shape[:-1] + (SSM_GROUPS, -1))
    y = y * lax.rsqrt(jnp.mean(y * y, axis=-1, keepdims=True) + RMS_EPS)
    y = y.reshape(y.shape[:-2] + (GROUP_WIDTH,)) * lp['ssm_norm_g'].astype(f32)
    return y.astype(dt_in), st


def gdn_core(q, k, v, g, beta, s0):
    incl = jnp.tril(jnp.ones((CHUNK, CHUNK), bool))
    strict = jnp.tril(jnp.ones((CHUNK, CHUNK), bool), -1)
    q, k, v, g, beta = (to_chunks(t) for t in (q, k, v, g, beta))
    gcum = jnp.cumsum(g, axis=-1)
    seg = gcum[..., :, None] - gcum[..., None, :]
    kb = k * beta[..., None]
    a_kk = jnp.einsum('bnhid,bnhjd->bnhij', kb, k) * jnp.exp(jnp.where(strict, seg, -jnp.inf))
    rhs = jnp.concatenate([kb * jnp.exp(gcum)[..., None], v * beta[..., None]], axis=-1)
    sol = lax.linalg.triangular_solve(a_kk, rhs, left_side=True, lower=True, unit_diagonal=True)
    dk = k.shape[-1]
    w, u = sol[..., :dk], sol[..., dk:]
    a_qk = jnp.einsum('bnhid,bnhjd->bnhij', q, k) * jnp.exp(jnp.where(incl, seg, -jnp.inf))
    q_dec = q * jnp.exp(gcum)[..., None]
    k_dec = k * jnp.exp(gcum[..., -1:] - gcum)[..., None]
    g_last = jnp.exp(gcum[..., -1])

    def step(s, xs):
        w_n, u_n, aqk_n, q_n, k_n, gl_n = xs
        v_new = u_n - w_n @ s
        o_n = q_n @ s + aqk_n @ v_new
        s = s * gl_n[..., None, None] + jnp.swapaxes(k_n, -1, -2) @ v_new
        return s, o_n

    xs = tuple(jnp.moveaxis(t, 1, 0) for t in (w, u, a_qk, q_dec, k_dec, g_last))
    s_fin, o = lax.scan(step, s0, xs)
    return from_chunks(jnp.moveaxis(o, 0, 1)), s_fin


def deltanet_mixer(qkv, z, b_f, b_b, a_f, a_b, lp, init, rows, cols):
    f32 = jnp.float32
    dt_in = z.dtype
    qkv = jax.nn.silu(dwconv2d(qkv, lp['dn_conv_w'], rows, cols))
    q, k, v = (split_heads(t) for t in jnp.split(qkv, 3, axis=-1))
    q = l2norm(q) * HEAD_DIM ** -0.5
    k = l2norm(k)

    def gates(b_raw, a_raw, d):
        beta = jax.nn.sigmoid(b_raw.astype(f32))
        g = -jnp.exp(lp['dn_A_log'][d].astype(f32)) * jax.nn.softplus(
            (a_raw + lp['dn_dt_bias'][d]).astype(f32))
        return g, beta

    g_f, be_f = gates(b_f, a_f, 0)
    g_b, be_b = gates(b_b, a_b, 1)
    o, st = bidir(gdn_core, (q, k, v, g_f, be_f), (q, k, v, g_b, be_b), init)
    y = head_rms(o, lp['dn_norm_g']) * jax.nn.silu(z.astype(f32))
    return y.astype(dt_in), st


def mixer_block(h, init, lp, rows, cols):
    cuts = np.cumsum(IN_SPLITS)[:-1].tolist()
    (aq, ak, av, ag, agf, agb,
     br, bk, bv, bwf, bwb, ba, bg,
     cz, cxbc, cdf, cdb,
     dqkv, dz, dbf, dbb, daf, dab) = jnp.split(h @ lp['w_in'], cuts, axis=-1)
    ya, sa = gla_mixer(aq, ak, av, ag, agf, agb, lp, init[0])
    yb, sb = rwkv_mixer(br, bk, bv, bwf, bwb, ba, bg, lp, init[1])
    yc, sc = mamba_mixer(cz, cxbc, cdf, cdb, lp, init[2], rows, cols)
    yd, sd = deltanet_mixer(dqkv, dz, dbf, dbb, daf, dab, lp, init[3], rows, cols)
    y = jnp.concatenate([ya, yb, yc, yd], axis=-1) @ lp['w_out']
    return y, (sa, sb, sc, sd)


def swiglu(t, wg, wu, wd):
    return (jax.nn.silu(t @ wg) * (t @ wu)) @ wd


def moe_ffn(t, router_w, router_bias, w_gate, w_up, w_down, sh_gate, sh_up, sh_down):
    n_tok, d = t.shape
    n_assign = n_tok * TOP_K
    scores = jax.nn.sigmoid((t @ router_w).astype(jnp.float32))
    _, idx = lax.top_k(scores + router_bias.astype(jnp.float32), TOP_K)
    wts = jnp.take_along_axis(scores, idx, axis=-1)
    wts = wts / jnp.sum(wts, axis=-1, keepdims=True) * ROUTED_SCALE
    e_flat = idx.reshape(-1)
    order = jnp.argsort(e_flat)
    e_sorted = e_flat[order]
    tok_sorted = (order // TOP_K).astype(jnp.int32)
    w_sorted = wts.reshape(-1)[order]
    counts = jnp.bincount(e_flat, length=N_EXPERTS)
    padded = (counts + MOE_BLOCK - 1) // MOE_BLOCK * MOE_BLOCK
    start = jnp.cumsum(counts) - counts
    pend = jnp.cumsum(padded)
    pstart = pend - padded
    dest = pstart[e_sorted] + jnp.arange(n_assign) - start[e_sorted]
    n_blocks = -(-(n_assign + N_EXPERTS * (MOE_BLOCK - 1)) // MOE_BLOCK)
    buf_tok = jnp.zeros((n_blocks * MOE_BLOCK,), jnp.int32).at[dest].set(tok_sorted)
    buf_w = jnp.zeros((n_blocks * MOE_BLOCK,), jnp.float32).at[dest].set(w_sorted)
    blk_exp = jnp.minimum(
        jnp.searchsorted(pend, jnp.arange(n_blocks) * MOE_BLOCK, side='right'), N_EXPERTS - 1)

    def expert_block(args):
        tok, e = args
        return swiglu(t[tok], w_gate[e], w_up[e], w_down[e])

    y = lax.map(expert_block, (buf_tok.reshape(n_blocks, MOE_BLOCK), blk_exp))
    y = y.reshape(-1, d).astype(jnp.float32) * buf_w[:, None]
    routed = jnp.zeros((n_tok, d), jnp.float32).at[buf_tok].add(y)
    shared = swiglu(t, sh_gate, sh_up, sh_down).astype(jnp.float32)
    return (routed + shared).astype(t.dtype)


def setup_inputs(seed: int = 0) -> dict:
    key = jax.random.key(seed)
    keys = iter(jax.random.split(key, 48))
    f32 = jnp.float32

    def nrm(shape, scale):
        return jax.random.normal(next(keys), shape, f32) * scale

    def gain(shape):
        return 1.0 + nrm(shape, 0.05)

    def dt_bias(shape):
        dt = jnp.exp(jax.random.uniform(next(keys), shape, f32, math.log(1e-3), math.log(1e-1)))
        return dt + jnp.log(-jnp.expm1(-dt))

    def a_log(shape):
        return jnp.log(jax.random.uniform(next(keys), shape, f32, 1.0, 16.0))

    L, D, G = DEPTH, D_MODEL, GROUP_WIDTH
    return {
        'x': nrm((BATCH, SEQ, D), 1.0),
        'c': nrm((BATCH, D), 1.0),
        'ctx': nrm((BATCH, CTX_LEN, D), 1.0),
        'c_ctx': nrm((D,), 1.0),
        'norm1_g': gain((L, D)),
        'norm2_g': gain((L, D)),
        'w_mod': nrm((L, D, 6 * D), 0.5 * D ** -0.5),
        'b_mod': nrm((L, 6 * D), 0.02),
        'w_in': nrm((L, D, IN_WIDTH), D ** -0.5),
        'w_out': nrm((L, D, D), D ** -0.5),
        'gla_gate_w2': nrm((L, 2, GLA_GATE_RANK, G), GLA_GATE_RANK ** -0.5),
        'gla_gate_b': nrm((L, 2, G), 0.1),
        'gla_norm_g': gain((L, G)),
        'rwkv_w_w2': nrm((L, 2, RWKV_DECAY_RANK, G), 0.1),
        'rwkv_w0': -2.0 + nrm((L, 2, G), 1.0),
        'rwkv_a_w2': nrm((L, RWKV_A_RANK, G), RWKV_A_RANK ** -0.5),
        'rwkv_a0': nrm((L, G), 0.1),
        'rwkv_g_w2': nrm((L, RWKV_G_RANK, G), RWKV_G_RANK ** -0.5),
        'rwkv_k_k': 0.85 + nrm((L, G), 0.05),
        'rwkv_k_a': gain((L, G)),
        'rwkv_r_k': nrm((L, N_HEADS, HEAD_DIM), 0.1),
        'rwkv_ln_g': gain((L, G)),
        'rwkv_ln_b': nrm((L, G), 0.02),
        'ssm_conv_w': nrm((L, CONV_K, CONV_K, SSM_XBC), 1.0 / CONV_K),
        'ssm_conv_b': nrm((L, SSM_XBC), 0.02),
        'ssm_A_log': a_log((L, 2, N_HEADS)),
        'ssm_dt_bias': dt_bias((L, 2, N_HEADS)),
        'ssm_D': gain((L, N_HEADS)),
        'ssm_norm_g': gain((L, G)),
        'dn_conv_w': nrm((L, CONV_K, CONV_K, 3 * G), 1.0 / CONV_K),
        'dn_A_log': a_log((L, 2, N_HEADS)),
        'dn_dt_bias': dt_bias((L, 2, N_HEADS)),
        'dn_norm_g': gain((L, G)),
        'router_w': nrm((L, D, N_EXPERTS), D ** -0.5),
        'router_bias': nrm((L, N_EXPERTS), 0.01),
        'exp_w_gate': nrm((L, N_EXPERTS, D, EXPERT_DIM), D ** -0.5),
        'exp_w_up': nrm((L, N_EXPERTS, D, EXPERT_DIM), D ** -0.5),
        'exp_w_down': nrm((L, N_EXPERTS, EXPERT_DIM, D), EXPERT_DIM ** -0.5),
        'sh_w_gate': nrm((L, D, SHARED_DIM), D ** -0.5),
        'sh_w_up': nrm((L, D, SHARED_DIM), D ** -0.5),
        'sh_w_down': nrm((L, SHARED_DIM, D), SHARED_DIM ** -0.5),
        'final_norm_g': gain((D,)),
    }


def reference(x, c, ctx, c_ctx, norm1_g, norm2_g, w_mod, b_mod, w_in, w_out,
              gla_gate_w2, gla_gate_b, gla_norm_g,
              rwkv_w_w2, rwkv_w0, rwkv_a_w2, rwkv_a0, rwkv_g_w2, rwkv_k_k, rwkv_k_a,
              rwkv_r_k, rwkv_ln_g, rwkv_ln_b,
              ssm_conv_w, ssm_conv_b, ssm_A_log, ssm_dt_bias, ssm_D, ssm_norm_g,
              dn_conv_w, dn_A_log, dn_dt_bias, dn_norm_g,
              router_w, router_bias, exp_w_gate, exp_w_up, exp_w_down,
              sh_w_gate, sh_w_up, sh_w_down, final_norm_g):
    bsz, n_lat, d = x.shape
    rows = n_lat // GRID_W
    n_ctx = ctx.shape[1]
    ctx_init = zero_states(bsz)
    for i in range(DEPTH):
        last = i == DEPTH - 1
        lp = dict(
            w_in=w_in[i], w_out=w_out[i],
            gla_gate_w2=gla_gate_w2[i], gla_gate_b=gla_gate_b[i], gla_norm_g=gla_norm_g[i],
            rwkv_w_w2=rwkv_w_w2[i], rwkv_w0=rwkv_w0[i], rwkv_a_w2=rwkv_a_w2[i],
            rwkv_a0=rwkv_a0[i], rwkv_g_w2=rwkv_g_w2[i], rwkv_k_k=rwkv_k_k[i],
            rwkv_k_a=rwkv_k_a[i], rwkv_r_k=rwkv_r_k[i], rwkv_ln_g=rwkv_ln_g[i],
            rwkv_ln_b=rwkv_ln_b[i],
            ssm_conv_w=ssm_conv_w[i], ssm_conv_b=ssm_conv_b[i], ssm_A_log=ssm_A_log[i],
            ssm_dt_bias=ssm_dt_bias[i], ssm_D=ssm_D[i], ssm_norm_g=ssm_norm_g[i],
            dn_conv_w=dn_conv_w[i], dn_A_log=dn_A_log[i], dn_dt_bias=dn_dt_bias[i],
            dn_norm_g=dn_norm_g[i])
        mod_x = jax.nn.silu(c) @ w_mod[i] + b_mod[i]
        mod_c = jax.nn.silu(c_ctx) @ w_mod[i] + b_mod[i]
        sa_x, ca_x, ga_x, sf_x, cf_x, gf_x = jnp.split(mod_x[:, None, :], 6, axis=-1)
        sa_c, ca_c, ga_c, sf_c, cf_c, gf_c = jnp.split(mod_c[None, None, :], 6, axis=-1)
        y_c, ctx_states = mixer_block(modulate(ctx, norm1_g[i], sa_c, ca_c), ctx_init, lp, 1, n_ctx)
        y_x, _ = mixer_block(modulate(x, norm1_g[i], sa_x, ca_x), ctx_states, lp, rows, GRID_W)
        x = x + ga_x * y_x
        h_x = modulate(x, norm2_g[i], sf_x, cf_x).reshape(-1, d)
        moe_args = (router_w[i], router_bias[i], exp_w_gate[i], exp_w_up[i], exp_w_down[i],
                    sh_w_gate[i], sh_w_up[i], sh_w_down[i])
        if last:
            x = x + gf_x * moe_ffn(h_x, *moe_args).reshape(x.shape)
        else:
            ctx = ctx + ga_c * y_c
            h_c = modulate(ctx, norm2_g[i], sf_c, cf_c).reshape(-1, d)
            f = moe_ffn(jnp.concatenate([h_c, h_x], axis=0), *moe_args)
            ctx = ctx + gf_c * f[: bsz * n_ctx].reshape(ctx.shape)
            x = x + gf_x * f[bsz * n_ctx:].reshape(x.shape)
    return rms_norm(x, final_norm_g)
```

```cpp
#include <hip/hip_runtime.h>
#ifndef MK_ABL
#define MK_ABL 0
#endif
#include <cstdio>
#include <cstdint>

typedef unsigned short bf16_t;
typedef short bf16x8 __attribute__((ext_vector_type(8)));
typedef float f32x4 __attribute__((ext_vector_type(4)));
typedef float f32x2 __attribute__((ext_vector_type(2)));
typedef unsigned u32x4 __attribute__((ext_vector_type(4)));
typedef unsigned u32x2 __attribute__((ext_vector_type(2)));

constexpr int NB = 4, SEQ = 8192, NCTX = 256, D = 1024, NL = 2;
constexpr int CROWS = NB * NCTX;
constexpr int ROWS = CROWS + NB * SEQ;
constexpr int SB = NCTX + SEQ;
constexpr int INW = 4056, NPROJ = 4096;
constexpr int NE = 64, NE1 = 65, TOPK = 8, EH = 256;
constexpr int GRIDW = 64, GRIDH = SEQ / GRIDW;
constexpr int PA_Q = 0, PA_K = 256, PA_V = 512, PA_G = 768, PA_GF = 1024, PA_GB = 1040;
constexpr int PB_R = 1056, PB_K = 1312, PB_V = 1568, PB_WF = 1824, PB_WB = 1856, PB_A = 1888, PB_G = 1920;
constexpr int PC_Z = 1984, PC_X = 2240, PC_DF = 3008, PC_DB = 3012;
constexpr int PD_Q = 3016, PD_Z = 3784, PD_BF = 4040, PD_BB = 4044, PD_AF = 4048, PD_AB = 4052;
enum { I_X = 0, I_C, I_CTX, I_CCTX, I_N1G, I_N2G, I_WMOD, I_BMOD, I_WIN, I_WOUT, I_GLA_W2, I_GLA_B, I_GLA_NG,
       I_RW_W2, I_RW_W0, I_RW_AW2, I_RW_A0, I_RW_GW2, I_RW_KK, I_RW_KA, I_RW_RK, I_RW_LNG, I_RW_LNB,
       I_SS_CW, I_SS_CB, I_SS_ALOG, I_SS_DTB, I_SS_D, I_SS_NG, I_DN_CW, I_DN_ALOG, I_DN_DTB, I_DN_NG,
       I_ROUT_W, I_ROUT_B, I_EXP_G, I_EXP_U, I_EXP_D, I_SH_G, I_SH_U, I_SH_D, I_FNG, N_IN };
static_assert(N_IN == 42, "input count");

constexpr size_t MiB = 1u << 20;
constexpr size_t WS_CTL = 0, CTL_ZERO_BYTES = 1 * MiB;
constexpr size_t WS_MOD = 1 * MiB;
constexpr size_t WS_WIN = 2 * MiB;
constexpr size_t WS_WOUT = 18 * MiB;
constexpr size_t WS_ROUT = 22 * MiB;
constexpr size_t WS_CTXRES = 23 * MiB;
constexpr size_t WS_EXPGU = 27 * MiB;
constexpr size_t WS_EXPD = 92 * MiB;
constexpr size_t WS_HBUF = 125 * MiB;
constexpr size_t WS_PROJ = 191 * MiB;
constexpr size_t WS_SCR = 455 * MiB;
constexpr size_t WS_END = 640455456;
constexpr int HROWS_MAX = ROWS * 9 + NE1 * 256;
constexpr size_t WS_H = WS_PROJ;
constexpr size_t WS_LTOK = WS_PROJ + 160 * MiB;
constexpr size_t WS_LW = WS_PROJ + 170 * MiB;
static_assert((size_t)HROWS_MAX * 512 <= 160 * MiB && (size_t)NE * ROWS * 4 <= 10 * MiB && WS_LW + 10 * MiB <= WS_SCR, "moe overlay");
constexpr size_t WS_ACC = WS_SCR;
constexpr float ACC_SCALE = 1048576.0f, ACC_INV = 1.0f / 1048576.0f;
static_assert(WS_ACC + (size_t)ROWS * D * 4 <= WS_END, "acc fits");
constexpr size_t SC_OF = WS_SCR;
constexpr size_t SC_OB = SC_OF + (size_t)SB * 1024 * 4;
constexpr size_t SC_RK = SC_OB + (size_t)SB * 1024 * 4;
constexpr size_t SC_RKK = SC_RK + (size_t)SB * 256 * 4;
constexpr size_t SC_RB = SC_RKK + (size_t)SB * 256 * 4;
constexpr size_t SC_RLW = SC_RB + (size_t)SB * 256 * 4;
constexpr size_t SC_SX = SC_RLW + (size_t)2 * SB * 256 * 4;
constexpr size_t SC_DQ = SC_SX + (size_t)SB * 768 * 2;
constexpr size_t SC_SDT = SC_DQ + (size_t)SB * 768 * 2;
constexpr size_t SC_DG = SC_SDT + (size_t)SB * 8 * 4;
constexpr size_t SC_END = SC_DG + (size_t)SB * 16 * 4;
static_assert(SC_END <= WS_END, "scratch fits");
constexpr int CW_CNT = 1024;
constexpr int CW_BAR = 4096;

#define LAS __attribute__((address_space(3)))
constexpr int NTHR = 512;
constexpr int LDS_BYTES = 147456;
constexpr int LDS_CTL = 143360;
constexpr int LDS_PTRS = LDS_CTL + 2048;

__device__ __forceinline__ int lane_id_asm() { int l; asm volatile("v_mbcnt_lo_u32_b32 %0, -1, 0\n\tv_mbcnt_hi_u32_b32 %0, -1, %0" : "=v"(l)); return l; }
__device__ __forceinline__ float bf2f(bf16_t b) { return __uint_as_float(((unsigned)b) << 16); }
__device__ __forceinline__ unsigned f2bf(float f) { unsigned u = __float_as_uint(f); u += 0x7FFFu + ((u >> 16) & 1u); return u >> 16; }
__device__ __forceinline__ unsigned pk2(float lo, float hi) { return f2bf(lo) | (f2bf(hi) << 16); }
__device__ __forceinline__ float rl(float x, int k) { return __uint_as_float(__builtin_amdgcn_readlane(__float_as_uint(x), k)); }
__device__ __forceinline__ float wsum(float v) { v += __shfl_xor(v, 32); v += __shfl_xor(v, 16); v += __shfl_xor(v, 8); v += __shfl_xor(v, 4); v += __shfl_xor(v, 2); v += __shfl_xor(v, 1); return v; }
__device__ __forceinline__ float sigmoidf_(float x) { return 1.0f / (1.0f + __expf(-x)); }
__device__ __forceinline__ float siluf_(float x) { return x / (1.0f + __expf(-x)); }
__device__ __forceinline__ float softplusf_(float x) { return x > 20.f ? x : log1pf(__expf(x)); }
__device__ __forceinline__ float logsigmoidf_(float x) { return fminf(x, 0.f) - log1pf(__expf(-fabsf(x))); }
__device__ __forceinline__ int seq_tok(int i, int d) { return d == 0 ? i : (i < NCTX ? NCTX - 1 - i : SB + NCTX - 1 - i); }
__device__ __forceinline__ int tok_row(int b, int s) { return s < NCTX ? b * NCTX + s : CROWS + b * SEQ + (s - NCTX); }

struct Params { const float* in[N_IN]; float* out; unsigned char* ws; int lo, hi, li, pad; };
struct Cx { float* out; unsigned char* ws; int tid, bid, G, pad; };
__device__ __forceinline__ const float* PIN(int i) {
    extern __shared__ __attribute__((aligned(16))) unsigned char lds_raw_[];
    int off = LDS_PTRS + 8 * i; asm volatile("" : "+s"(off));
    const LAS unsigned* t = (const LAS unsigned*)((LAS unsigned char*)lds_raw_ + off);
    const unsigned lo = __builtin_amdgcn_readfirstlane(t[0]), hi = __builtin_amdgcn_readfirstlane(t[1]);
    return (const float*)(((unsigned long long)hi << 32) | lo);
}
#define XB_TMO      128
#define XB_XCNT(j)  (256  + 64 * (j))
#define XB_XSUB(j)  (1280 + 64 * (j))
#define XB_XGEN(j)  (2304 + 64 * (j))
#define XB_TOP      3328
#define XB_TOPGEN   3392
#define XCD_BAR_WORDS 3456
#define XB_SPIN_CAP (1u << 18)

__device__ __forceinline__ unsigned xb_ld(unsigned* p)              { return __hip_atomic_load(p, __ATOMIC_RELAXED, __HIP_MEMORY_SCOPE_AGENT); }
__device__ __forceinline__ unsigned xb_add(unsigned* p, unsigned v) { return __hip_atomic_fetch_add(p, v, __ATOMIC_RELAXED, __HIP_MEMORY_SCOPE_AGENT); }
__device__ __forceinline__ unsigned xb_xcc_id() { return (unsigned)__builtin_amdgcn_s_getreg((3 << 11) | 20) & 0xFu; }
#define XB_SPIN(cond, bar) do { unsigned _sp = 0; while (cond) { __builtin_amdgcn_s_sleep(1); \
    if ((++_sp & 255u) == 0u) { if (xb_ld(&(bar)[XB_TMO])) break; if (_sp > XB_SPIN_CAP) { atomicAdd(&(bar)[XB_TMO], 1u); break; } } } } while (0)

struct XcdBarrier {
    unsigned* bar; unsigned x;
    volatile LAS unsigned* st;
};

__device__ __forceinline__ XcdBarrier xcd_barrier_post(unsigned* bar, volatile LAS unsigned* st, const unsigned xb_tid) {
    XcdBarrier b; b.bar = bar; b.x = xb_xcc_id(); b.st = st;
    if (xb_tid == 0) (void)xb_add(&bar[XB_XCNT(b.x)], 1u);
    return b;
}
__device__ __forceinline__ void xcd_barrier_complete(unsigned* bar, unsigned x, unsigned& nloc, unsigned& nx) {
    const unsigned G = gridDim.x * gridDim.y * gridDim.z;
    unsigned sum, cnt, mine, sp = 0u;
    for (;;) {
        sum = 0u; cnt = 0u; mine = 0u;
#pragma unroll
        for (unsigned j = 0; j < 16; ++j) { const unsigned c = xb_ld(&bar[XB_XCNT(j)]); sum += c; cnt += (c > 0u) ? 1u : 0u; mine = (j == x) ? c : mine; }
        if (sum == G) break;
        __builtin_amdgcn_s_sleep(1);
        if ((++sp & 255u) == 0u) { if (xb_ld(&bar[XB_TMO])) break; if (sp > XB_SPIN_CAP) { atomicAdd(&bar[XB_TMO], 1u); break; } }
    }
    nloc = mine > 0u ? mine : 1u; nx = cnt > 0u ? cnt : 1u;
}

__device__ __forceinline__ void xcd_barrier(const XcdBarrier& b, const unsigned xb_tid) {
    asm volatile("s_waitcnt vmcnt(0)" ::: "memory");
    __syncthreads();
    if (xb_tid == 0) {
        unsigned* bar = b.bar;
        __builtin_amdgcn_s_waitcnt(0);
        unsigned nloc = b.st[0], nx = b.st[1];
        if (nloc == 0u) { xcd_barrier_complete(bar, b.x, nloc, nx); b.st[0] = nloc; b.st[1] = nx; }
        const unsigned old = xb_add(&bar[XB_XSUB(b.x)], 1u);
        const unsigned gen = old / nloc;
        if (old + 1u == (gen + 1u) * nloc) {
            __builtin_amdgcn_fence(__ATOMIC_RELEASE, "agent");
            asm volatile("s_waitcnt vmcnt(0)" ::: "memory");
            const unsigned og = xb_add(&bar[XB_TOP], 1u);
            const unsigned tg = og / nx;
            if (og + 1u == (tg + 1u) * nx) xb_add(&bar[XB_TOPGEN], 1u);
            else XB_SPIN(xb_ld(&bar[XB_TOPGEN]) == tg, bar);
            __builtin_amdgcn_fence(__ATOMIC_ACQUIRE, "agent");
            xb_add(&bar[XB_XGEN(b.x)], 1u);
            asm volatile("s_waitcnt vmcnt(0)" ::: "memory");
        } else {
            XB_SPIN(xb_ld(&bar[XB_XGEN(b.x)]) == gen, bar);
            __builtin_amdgcn_fence(__ATOMIC_ACQUIRE, "agent");
            asm volatile("s_waitcnt vmcnt(0)" ::: "memory");
        }
    }
    __syncthreads();
}

namespace pg8 {
constexpr int BM = 256, BK = 64, HALF = 128, HTB = HALF * BK * 2  , STAGE_BYTES = 8 * HTB, NXCD = 8, WGM = 8;
__host__ __device__ __forceinline__ int lds_byte(int r, int c) { const int st = (r >> 4) * 2 + (c >> 5), rr = r & 15, cc = c & 31, ob = rr * 64 + cc * 2; return st * 1024 + (ob ^ (((ob >> 9) & 1) << 5)); }
__host__ __device__ __forceinline__ void stage_rc(int b, int& R, int& C) { const int st = b / 1024, sb = b % 1024, swz = sb ^ (((sb >> 9) & 1) << 5); R = (st >> 1) * 16 + swz / 64; C = (st & 1) * 32 + (swz % 64) / 2; }
__host__ __device__ __forceinline__ int perm32(int rho) { const int n = rho >> 4, i = rho & 15; return 8 * (i >> 2) + 4 * n + (i & 3); }

struct Unit { int pm, pn, e, r0; };

__device__ __forceinline__ unsigned cvt_pk_bf16(float lo, float hi) { unsigned r; asm volatile("v_cvt_pk_bf16_f32 %0, %1, %2" : "=v"(r) : "v"(lo), "v"(hi)); return r; }

template <int K, class Epi, class Sched>
__device__ __forceinline__ void gemm_phase(const int tid, LAS unsigned char* lds, const char* Abase, const Sched& S, const Epi& E) {
    const int wid = __builtin_amdgcn_readfirstlane(tid >> 6), lane = tid & 63, wr = wid >> 2, wc = wid & 3, fr = lane & 15, fq = lane >> 4;
    const int nt = K / BK;
    int RA[2], CA[2]; unsigned voffB[2];
#pragma unroll
    for (int i = 0; i < 2; ++i) { int R, C; stage_rc(tid * 16 + i * 8192, R, C); const int Rb = Epi::PERM ? ((R & ~31) + perm32(R & 31)) : R;
        RA[i] = R; CA[i] = C; voffB[i] = (unsigned)(Rb * K + C) * 2u; }
    const size_t kstep = (size_t)(BK * 2);
    const size_t hstep = (size_t)HALF * K * 2;
    const unsigned ldsw = (unsigned)wid * 1024u;
    const int aoff = lds_byte(wr * 64 + fr, fq * 8), boff = lds_byte(wc * 32 + fr, fq * 8);
#define PG8_SA(b, h) (((b) * 2 + (h)) * HTB)
#define PG8_SB(b, h) ((4 + (b) * 2 + (h)) * HTB)
#define PG8_STAGE(bufoff, gbase, voff) do { _Pragma("unroll") for (int _i = 0; _i < 2; ++_i) \
        __builtin_amdgcn_global_load_lds((const unsigned*)((const char*)(gbase) + (voff)[_i]), (LAS unsigned*)(lds + (bufoff) + ldsw + _i * 8192), 16, 0, 0); } while (0)
#define PG8_LDA(dst, b, h) do { _Pragma("unroll") for (int m = 0; m < 4; ++m) _Pragma("unroll") for (int k = 0; k < 2; ++k) dst[m][k] = *(const LAS bf16x8*)(lds + PG8_SA(b, h) + aoff + m * 2048 + k * 1024); } while (0)
#define PG8_LDB(dst, b, h) do { _Pragma("unroll") for (int n = 0; n < 2; ++n) _Pragma("unroll") for (int k = 0; k < 2; ++k) dst[n][k] = *(const LAS bf16x8*)(lds + PG8_SB(b, h) + boff + n * 2048 + k * 1024); } while (0)
#define PG8_MMA(ai, bj, At, Bt) do { __builtin_amdgcn_s_setprio(1); _Pragma("unroll") for (int m = 0; m < 4; ++m) _Pragma("unroll") for (int n = 0; n < 2; ++n) _Pragma("unroll") for (int k = 0; k < 2; ++k) \
        acc[ai][bj][m][n] = __builtin_amdgcn_mfma_f32_16x16x32_bf16(Bt[n][k], At[m][k], acc[ai][bj][m][n], 0, 0, 0); __builtin_amdgcn_s_setprio(0); } while (0)
#define PG8_WAIT_V(n) asm volatile("s_waitcnt vmcnt(" #n ")" ::: "memory")
#define PG8_WAIT_L(n) asm volatile("s_waitcnt lgkmcnt(" #n ")" ::: "memory")
#define PG8_BAR __builtin_amdgcn_s_barrier()
#define PG8_SCHED __builtin_amdgcn_sched_barrier(0)
#define PG8_AOFF(dst, u) do { _Pragma("unroll") for (int _h = 0; _h < 2; ++_h) _Pragma("unroll") for (int _i = 0; _i < 2; ++_i) \
        dst[_h][_i] = ((unsigned)S.a_row(u, _h * HALF + RA[_i]) * (unsigned)K + (unsigned)CA[_i]) * 2u; } while (0)
    Unit cur, nxt; int ui = 0;
    if (!S.next(0, cur)) return;
    f32x4 acc[2][2][4][2];
#pragma unroll
    for (int a = 0; a < 2; ++a)
#pragma unroll
        for (int b = 0; b < 2; ++b)
#pragma unroll
            for (int m = 0; m < 4; ++m)
#pragma unroll
                for (int n = 0; n < 2; ++n) acc[a][b][m][n] = (f32x4){0.f, 0.f, 0.f, 0.f};
    bf16x8 At[4][2], B0[2][2], B1[2][2];
    unsigned cO[2][2], nO[2][2];
    PG8_AOFF(cO, cur);
    const char* cB = S.b_ptr(cur);
    PG8_STAGE(PG8_SB(0, 0), cB, voffB); PG8_STAGE(PG8_SA(0, 0), Abase, cO[0]); PG8_STAGE(PG8_SB(0, 1), cB + hstep, voffB); PG8_STAGE(PG8_SA(0, 1), Abase, cO[1]);
    if (wr == 1) PG8_BAR;
    PG8_WAIT_V(4); PG8_BAR;
    PG8_STAGE(PG8_SB(1, 0), cB + kstep, voffB); PG8_STAGE(PG8_SA(1, 0), Abase + kstep, cO[0]); PG8_STAGE(PG8_SB(1, 1), cB + hstep + kstep, voffB);
    PG8_WAIT_V(6); PG8_BAR;
    for (;;) {
        const bool has_next = S.next(ui + 1, nxt);
        const char* nB = cB;
        if (has_next) { PG8_AOFF(nO, nxt); nB = S.b_ptr(nxt); }
        else {
#pragma unroll
            for (int h = 0; h < 2; ++h)
#pragma unroll
                for (int i = 0; i < 2; ++i) nO[h][i] = cO[h][i]; }
        for (int t = 0; t < nt; t += 2) {
            const bool last = (t == nt - 2);
            const char* a1 = Abase + (size_t)(t + 1) * kstep;
            const char* a2 = last ? Abase : Abase + (size_t)(t + 2) * kstep; const char* b2 = last ? nB : cB + (size_t)(t + 2) * kstep;
            const char* a3 = a2 + kstep; const char* b3 = b2 + kstep;
            unsigned o2[2][2];
#pragma unroll
            for (int h = 0; h < 2; ++h)
#pragma unroll
                for (int i = 0; i < 2; ++i) o2[h][i] = last ? nO[h][i] : cO[h][i];
            PG8_LDB(B0, 0, 0); PG8_SCHED; PG8_LDA(At, 0, 0); PG8_STAGE(PG8_SA(1, 1), a1, cO[1]);
            PG8_WAIT_L(8); PG8_BAR; PG8_WAIT_L(0); PG8_MMA(0, 0, At, B0); PG8_BAR; PG8_SCHED;
            PG8_LDB(B1, 0, 1); PG8_STAGE(PG8_SB(0, 0), b2, voffB);
            PG8_BAR; PG8_WAIT_L(0); PG8_MMA(0, 1, At, B1); PG8_BAR;
            PG8_LDA(At, 0, 1); PG8_STAGE(PG8_SA(0, 0), a2, o2[0]);
            PG8_BAR; PG8_WAIT_L(0); PG8_MMA(1, 0, At, B0); PG8_BAR; PG8_SCHED;
            PG8_STAGE(PG8_SB(0, 1), b2 + hstep, voffB);
            PG8_WAIT_V(6); PG8_BAR; PG8_MMA(1, 1, At, B1); PG8_BAR;
            PG8_LDB(B0, 1, 0); PG8_SCHED; PG8_LDA(At, 1, 0); PG8_STAGE(PG8_SA(0, 1), a2, o2[1]);
            PG8_WAIT_L(8); PG8_BAR; PG8_WAIT_L(0); PG8_MMA(0, 0, At, B0); PG8_BAR; PG8_SCHED;
            PG8_LDB(B1, 1, 1); PG8_STAGE(PG8_SB(1, 0), b3, voffB);
            PG8_BAR; PG8_WAIT_L(0); PG8_MMA(0, 1, At, B1); PG8_BAR;
            PG8_LDA(At, 1, 1); PG8_STAGE(PG8_SA(1, 0), a3, o2[0]);
            PG8_BAR; PG8_WAIT_L(0); PG8_MMA(1, 0, At, B0); PG8_BAR; PG8_SCHED;
            PG8_STAGE(PG8_SB(1, 1), b3 + hstep, voffB);
            PG8_WAIT_V(6); PG8_BAR; PG8_MMA(1, 1, At, B1); PG8_BAR;
        }
        E(acc, cur, wid);
        if (!has_next) break;
#pragma unroll
        for (int a = 0; a < 2; ++a)
#pragma unroll
            for (int b = 0; b < 2; ++b)
#pragma unroll
                for (int m = 0; m < 4; ++m)
#pragma unroll
                    for (int n = 0; n < 2; ++n) acc[a][b][m][n] = (f32x4){0.f, 0.f, 0.f, 0.f};
        cur = nxt; cB = nB; ++ui;
#pragma unroll
        for (int h = 0; h < 2; ++h)
#pragma unroll
            for (int i = 0; i < 2; ++i) cO[h][i] = nO[h][i];
    }
    PG8_WAIT_V(0);
    if (wr == 0) PG8_BAR;
    PG8_BAR;
#undef PG8_SA
#undef PG8_SB
#undef PG8_STAGE
#undef PG8_LDA
#undef PG8_LDB
#undef PG8_MMA
#undef PG8_WAIT_V
#undef PG8_WAIT_L
#undef PG8_BAR
#undef PG8_SCHED
#undef PG8_AOFF
}
}
struct DenseSched {
    int nM, nN, nwg, G, c, K; const char* Bt;
    __device__ __forceinline__ void init(int M, int N, int K_, const bf16_t* Bt_, int G_, int c_) { nM = M / 256; nN = N / 256; nwg = nM * nN; G = G_; c = c_; K = K_; Bt = (const char*)Bt_; }
    __device__ __forceinline__ bool next(int i, pg8::Unit& u) const {
        const long L = (long)i * G + c; if (L >= nwg) return false;
        int wgid = (int)L; { const int q = nwg / 8, r = nwg % 8, xcd = wgid % 8, off = wgid / 8; wgid = (xcd < r ? xcd * (q + 1) : r * (q + 1) + (xcd - r) * q) + off; }
        const int nig = 8 * nN, gid = wgid / nig, fm = gid * 8, gsz = (nM - fm) < 8 ? (nM - fm) : 8;
        u.pm = fm + ((wgid % nig) % gsz); u.pn = (wgid % nig) / gsz; u.e = 0; u.r0 = 0; return true;
    }
    __device__ __forceinline__ int a_row(const pg8::Unit& u, int r) const { return u.pm * 256 + r; }
    __device__ __forceinline__ const char* b_ptr(const pg8::Unit& u) const { return Bt + (size_t)u.pn * 256 * K * 2; }
};
template <bool GATHER> struct MoeSched {
    const LAS int* tstart; const LAS int* cnt; int nN, G, c, K, row_lo; const int* ltok; const char* Bt; size_t bstride;
    __device__ __forceinline__ bool next(int i, pg8::Unit& u) const {
        const long L = (long)i * G + c; const int ntile = __builtin_amdgcn_readfirstlane(tstart[NE1]); if (L >= (long)ntile * nN) return false;
        const int tile = (int)(L / nN); u.pn = (int)(L % nN);
        int e = 0;
#pragma unroll 1
        for (int step = 64; step >= 1; step >>= 1) { const int e2 = e + step; if (e2 <= NE && tstart[e2] <= tile) e = e2; }
        e = __builtin_amdgcn_readfirstlane(e); u.e = e; u.pm = __builtin_amdgcn_readfirstlane(tile); u.pn = __builtin_amdgcn_readfirstlane(u.pn); u.r0 = __builtin_amdgcn_readfirstlane((tile - tstart[e]) * 256); return true;
    }
    __device__ __forceinline__ int a_row(const pg8::Unit& u, int r) const {
        if (!GATHER) return u.pm * 256 + r;
        const int ri = u.r0 + r;
        if (u.e == NE) return ri < cnt[NE] ? row_lo + ri : row_lo;
        return ri < cnt[u.e] ? ltok[(size_t)u.e * ROWS + ri] : row_lo;
    }
    __device__ __forceinline__ const char* b_ptr(const pg8::Unit& u) const { return Bt + (size_t)u.e * bstride + (size_t)u.pn * 256 * K * 2; }
};

struct EpiProj {
    static constexpr bool PERM = true;
    bf16_t* O; int ldc;
    __device__ __forceinline__ void operator()(const f32x4 (&acc)[2][2][4][2], const pg8::Unit& u, const int wid) const {
        const int lane_ = lane_id_asm(), fr = lane_ & 15, fq = lane_ >> 4, wr = wid >> 2, wc = wid & 3;
        const int row0 = u.pm * 256 + wr * 64 + fr, col0 = u.pn * 256 + wc * 32 + 8 * fq;
#pragma unroll
        for (int ai = 0; ai < 2; ++ai)
#pragma unroll
            for (int m = 0; m < 4; ++m) { bf16_t* rowp = O + (size_t)(row0 + ai * 128 + m * 16) * ldc + col0;
#pragma unroll
                for (int bj = 0; bj < 2; ++bj) { const f32x4 v0 = acc[ai][bj][m][0], v1 = acc[ai][bj][m][1];
                    u32x4 w; w.x = pg8::cvt_pk_bf16(v0[0], v0[1]); w.y = pg8::cvt_pk_bf16(v0[2], v0[3]); w.z = pg8::cvt_pk_bf16(v1[0], v1[1]); w.w = pg8::cvt_pk_bf16(v1[2], v1[3]);
                    *(u32x4*)(rowp + bj * 128) = w; } }
    }
};
struct EpiRes {
    static constexpr bool PERM = false;
    const float* xsrc; const float* csrc; float* xdst; float* cdst; const float* gate;
    __device__ __forceinline__ void operator()(const f32x4 (&acc)[2][2][4][2], const pg8::Unit& u, const int wid) const {
        const int lane_ = lane_id_asm(), fr = lane_ & 15, fq = lane_ >> 4, wr = wid >> 2, wc = wid & 3;
        const int col0 = u.pn * 256 + wc * 32 + 4 * fq;
        const bool isc = u.pm < 4; const int sel = isc ? 4 : (u.pm - 4) >> 5;
        const float* src = isc ? csrc + (size_t)u.pm * 256 * D : xsrc + (size_t)(u.pm - 4) * 256 * D;
        float* dst = isc ? cdst + (size_t)u.pm * 256 * D : xdst + (size_t)(u.pm - 4) * 256 * D;
        f32x4 gv[2][2];
#pragma unroll
        for (int bj = 0; bj < 2; ++bj)
#pragma unroll
            for (int n = 0; n < 2; ++n) gv[bj][n] = *(const f32x4*)(gate + sel * 6144 + col0 + bj * 128 + n * 16);
#pragma unroll
        for (int ai = 0; ai < 2; ++ai)
#pragma unroll
            for (int m = 0; m < 4; ++m) { const size_t off = (size_t)(ai * 128 + wr * 64 + m * 16 + fr) * D + col0;
#pragma unroll
                for (int bj = 0; bj < 2; ++bj)
#pragma unroll
                    for (int n = 0; n < 2; ++n) { const f32x4 s = *(const f32x4*)(src + off + bj * 128 + n * 16); *(f32x4*)(dst + off + bj * 128 + n * 16) = s + gv[bj][n] * acc[ai][bj][m][n]; }
                asm volatile("" ::: "memory"); }
    }
};
struct EpiGU {
    static constexpr bool PERM = false;
    bf16_t* H;
    __device__ __forceinline__ void operator()(const f32x4 (&acc)[2][2][4][2], const pg8::Unit& u, const int wid) const {
        const int lane_ = lane_id_asm(), fr = lane_ & 15, fq = lane_ >> 4, wr = wid >> 2, wc = wid & 3;
        const int row0 = u.pm * 256 + wr * 64 + fr;
#pragma unroll
        for (int ai = 0; ai < 2; ++ai)
#pragma unroll
            for (int m = 0; m < 4; ++m) { bf16_t* rowp = H + (size_t)(row0 + ai * 128 + m * 16) * EH + 4 * fq;
#pragma unroll
                for (int bj = 0; bj < 2; ++bj) { const f32x4 g = acc[ai][bj][m][0], up = acc[ai][bj][m][1]; float h[4];
#pragma unroll
                    for (int j = 0; j < 4; ++j) h[j] = g[j] / (1.0f + __expf(-g[j])) * up[j];
                    u32x2 w; w.x = pg8::cvt_pk_bf16(h[0], h[1]); w.y = pg8::cvt_pk_bf16(h[2], h[3]);
                    *(u32x2*)(rowp + (u.pn * 256 + bj * 128 + wc * 32) / 2) = w; } }
    }
};
struct EpiDown {
    static constexpr bool PERM = false;
    int* accb; const float* gate; const int* ltok; const float* lw; const LAS int* cnt; int row_lo;
    __device__ __forceinline__ void operator()(const f32x4 (&acc)[2][2][4][2], const pg8::Unit& u, const int wid) const {
        const int lane_ = lane_id_asm(), fr = lane_ & 15, fq = lane_ >> 4, wr = wid >> 2, wc = wid & 3;
        const int col0 = u.pn * 256 + wc * 32 + 4 * fq; const int ce = __builtin_amdgcn_readfirstlane(cnt[u.e]);
        const int rbase = u.r0 + wr * 64 + fr; const size_t lbase = (size_t)u.e * ROWS;
#pragma unroll
        for (int ai = 0; ai < 2; ++ai)
#pragma unroll
            for (int m = 0; m < 4; ++m) { const int ri = rbase + ai * 128 + m * 16;
                __builtin_amdgcn_sched_barrier(0);
                if (ri < ce && !((MK_ABL & 1) && u.e != NE) && !((MK_ABL & 2) && u.e == NE)) {
                    int tok = row_lo + ri; float w = ACC_SCALE;
                    if (u.e != NE) { tok = ltok[lbase + ri]; w = lw[lbase + ri] * ACC_SCALE; }
                    const int sel = tok < CROWS ? 4 : (tok - CROWS) >> 13;
                    int* dst = accb + (size_t)tok * D + col0;
                    const float* gp = gate + sel * 6144 + col0;
#pragma unroll
                    for (int bj = 0; bj < 2; ++bj)
#pragma unroll
                        for (int n = 0; n < 2; ++n) { const f32x4 gv = *(const f32x4*)(gp + bj * 128 + n * 16); const f32x4 v = acc[ai][bj][m][n] * gv * w;
#pragma unroll
                            for (int j = 0; j < 4; ++j) atomicAdd(dst + bj * 128 + n * 16 + j, (int)rintf(v[j])); }
                }
                asm volatile("" ::: "memory"); }
    }
};
#define WSP(T, off) ((T*)(p.ws + (off)))

__device__ __forceinline__ void conv_tile(const int t, LAS float* tl, const float* __restrict__ src, int ldsrc, int k0, int n0, int nvalid, bf16_t* dst, int lddst, int mode) {
#pragma unroll
    for (int j = 0; j < 8; ++j) { const int idx = t + NTHR * j, k = idx >> 6, n = idx & 63; float v = 0.f; if (n0 + n < nvalid) v = src[(size_t)(k0 + k) * ldsrc + n0 + n]; tl[k * 65 + n] = v; }
    __syncthreads();
#pragma unroll
    for (int j = 0; j < 4; ++j) { const int pi = t + NTHR * j, n = pi >> 5, k = (pi & 31) * 2; const int nn = n0 + n;
        const int row = (mode == 0 || mode == 3) ? nn : ((nn >> 4) * 32 + (nn & 15) + (mode == 2 ? 16 : 0));
        float v0 = tl[k * 65 + n], v1 = tl[(k + 1) * 65 + n];
        if (mode == 3) { v0 -= bf2f((bf16_t)f2bf(v0)); v1 -= bf2f((bf16_t)f2bf(v1)); }
        *(unsigned*)(dst + (size_t)row * lddst + k0 + k) = pk2(v0, v1); }
    __syncthreads();
}
constexpr int CONV_A_UNITS = 2048 + 512 + 64;
__device__ __forceinline__ void conv_unit_A(const Cx& p, LAS float* tl, int u) {
    if (u < 2048) { const int l = u >> 10, r = u & 1023; conv_tile(p.tid, tl, PIN(I_WIN) + (size_t)l * D * INW, INW, (r >> 6) * 64, (r & 63) * 64, INW, WSP(bf16_t, WS_WIN) + (size_t)l * NPROJ * D, D, 0); }
    else if (u < 2560) { const int v = u - 2048, l = v >> 8, r = v & 255; conv_tile(p.tid, tl, PIN(I_WOUT) + (size_t)l * D * D, D, (r >> 4) * 64, (r & 15) * 64, D, WSP(bf16_t, WS_WOUT) + (size_t)l * D * D, D, 0); }
    else { const int v = u - 2560, l = v >> 5, lo = (v >> 4) & 1, r = v & 15; conv_tile(p.tid, tl, PIN(I_ROUT_W) + (size_t)l * D * NE, NE, r * 64, 0, NE, WSP(bf16_t, WS_ROUT) + (size_t)(l * 2 + lo) * NE * D, D, lo ? 3 : 0); }
}
constexpr int CONV_E_UNITS = NE1 * 192;
__device__ __forceinline__ void conv_unit_E(const Cx& p, LAS float* tl, int l, int u) {
    const int e = u / 192, r = u % 192;
    if (r < 128) { const int up = r >> 6, q = r & 63;
        const float* src = e < NE ? PIN(up ? I_EXP_U : I_EXP_G) + ((size_t)l * NE + e) * D * EH : PIN(up ? I_SH_U : I_SH_G) + (size_t)l * D * EH;
        conv_tile(p.tid, tl, src, EH, (q >> 2) * 64, (q & 3) * 64, EH, WSP(bf16_t, WS_EXPGU) + (size_t)e * 512 * D, D, 1 + up); }
    else { const int q = r - 128;
        const float* src = e < NE ? PIN(I_EXP_D) + ((size_t)l * NE + e) * EH * D : PIN(I_SH_D) + (size_t)l * EH * D;
        conv_tile(p.tid, tl, src, D, (q >> 4) * 64, (q & 15) * 64, D, WSP(bf16_t, WS_EXPD) + (size_t)e * D * EH, EH, 0); }
}
__device__ __forceinline__ void phase_mod(const Cx& p, LAS unsigned char* lds) {
    LAS float* sv = (LAS float*)lds; LAS float* red = sv + 5 * D;
    const int tid = p.tid;
    if (p.bid >= 192) return;
    for (int i = tid; i < 5 * D; i += NTHR) { const int j = i >> 10, k = i & 1023; const float c = j < 4 ? PIN(I_C)[j * D + k] : PIN(I_CCTX)[k]; sv[i] = siluf_(c); }
    __syncthreads();
    for (int u = p.bid; u < 192; u += p.G) {
        const int l = u / 96, cb = u % 96, kg = tid >> 6, cl = tid & 63;
        const float* w = PIN(I_WMOD) + (size_t)l * D * 6144 + cb * 64 + cl;
        float a0 = 0.f, a1 = 0.f, a2 = 0.f, a3 = 0.f, a4 = 0.f;
#pragma unroll 8
        for (int kk = 0; kk < 128; ++kk) { const int k = kg * 128 + kk; const float wv = w[(size_t)k * 6144];
            a0 += sv[k] * wv; a1 += sv[D + k] * wv; a2 += sv[2 * D + k] * wv; a3 += sv[3 * D + k] * wv; a4 += sv[4 * D + k] * wv; }
        red[(kg * 5 + 0) * 64 + cl] = a0; red[(kg * 5 + 1) * 64 + cl] = a1; red[(kg * 5 + 2) * 64 + cl] = a2; red[(kg * 5 + 3) * 64 + cl] = a3; red[(kg * 5 + 4) * 64 + cl] = a4;
        __syncthreads();
        if (tid < 320) { const int j = tid >> 6; float s = 0.f;
#pragma unroll
            for (int g = 0; g < 8; ++g) s += red[(g * 5 + j) * 64 + cl];
            WSP(float, WS_MOD)[((size_t)l * 5 + j) * 6144 + cb * 64 + cl] = s + PIN(I_BMOD)[l * 6144 + cb * 64 + cl]; }
        __syncthreads();
    }
}
__device__ __forceinline__ const float* res_row(const Cx& p, int layer_src0, int r) {
    if (r < CROWS) return (layer_src0 ? PIN(I_CTX) : (const float*)WSP(float, WS_CTXRES)) + (size_t)r * D;
    return (layer_src0 ? PIN(I_X) : (const float*)p.out) + (size_t)(r - CROWS) * D;
}
__device__ __forceinline__ int row_sel(int r) { return r < CROWS ? 4 : (r - CROWS) >> 13; }

__device__ __forceinline__ void norm_row(const float* src, const int* accp, float* wb, int* zacc, const float* g, const float* shift, const float* scale, bf16_t* dst, LAS bf16_t* ldst, LAS bf16_t* ldlo, int lane) {
    f32x4 v[4]; float ss = 0.f;
#pragma unroll
    for (int i = 0; i < 4; ++i) { v[i] = *(const f32x4*)(src + 256 * i + 4 * lane);
        if (accp) { const int4 a = *(const int4*)(accp + 256 * i + 4 * lane); v[i][0] += (float)a.x * ACC_INV; v[i][1] += (float)a.y * ACC_INV; v[i][2] += (float)a.z * ACC_INV; v[i][3] += (float)a.w * ACC_INV; }
        if (wb) *(f32x4*)(wb + 256 * i + 4 * lane) = v[i];
        if (zacc) *(int4*)(zacc + 256 * i + 4 * lane) = make_int4(0, 0, 0, 0);
        ss += v[i][0] * v[i][0] + v[i][1] * v[i][1] + v[i][2] * v[i][2] + v[i][3] * v[i][3]; }
    ss = wsum(ss); const float rstd = rsqrtf(ss * (1.0f / D) + 1e-6f);
#pragma unroll
    for (int i = 0; i < 4; ++i) { const int col = 256 * i + 4 * lane; const f32x4 gv = *(const f32x4*)(g + col), sh = *(const f32x4*)(shift + col), sc = *(const f32x4*)(scale + col);
        const f32x4 y = v[i] * rstd * gv * (sc + 1.0f) + sh; u32x2 w; w.x = pk2(y[0], y[1]); w.y = pk2(y[2], y[3]);
        *(u32x2*)(dst + col) = w;
        if (ldst) { *(LAS u32x2*)(ldst + col) = w; u32x2 wl;
            wl.x = pk2(y[0] - __uint_as_float(w.x << 16), y[1] - __uint_as_float(w.x & 0xffff0000u)); wl.y = pk2(y[2] - __uint_as_float(w.y << 16), y[3] - __uint_as_float(w.y & 0xffff0000u));
            *(LAS u32x2*)(ldlo + col) = wl; } }
}
__device__ __forceinline__ void phase_norm1(const Cx& p, int layer) {
    const int lane = p.tid & 63, wave = p.tid >> 6;
    const float* mod = WSP(float, WS_MOD) + (size_t)layer * 5 * 6144; const float* g = PIN(I_N1G) + layer * D; bf16_t* hb = WSP(bf16_t, WS_HBUF);
    for (int r = p.bid * 8 + wave; r < ROWS; r += p.G * 8) { const int sel = row_sel(r);
        const float* src = res_row(p, layer == 0, r);
        norm_row(src, layer == 0 ? (const int*)0 : WSP(int, WS_ACC) + (size_t)r * D, layer == 0 ? (float*)0 : (float*)src, (int*)0, g, mod + sel * 6144 + 0, mod + sel * 6144 + 1024, hb + (size_t)r * D, (LAS bf16_t*)0, (LAS bf16_t*)0, lane); }
}
__device__ __forceinline__ float conv_at(const Cx& p, const bf16_t* proj, int b, int s, int col, const float* cw  ) {
    float acc = 0.f;
    if (s < NCTX) {
#pragma unroll
        for (int dx = -1; dx <= 1; ++dx) { const int s2 = s + dx; if (s2 >= 0 && s2 < NCTX) acc += cw[(3 + dx + 1) * 768] * bf2f(proj[(size_t)(b * NCTX + s2) * NPROJ + col]); }
    } else { const int t = s - NCTX, r = t >> 6, c = t & 63;
#pragma unroll
        for (int dy = -1; dy <= 1; ++dy)
#pragma unroll
            for (int dx = -1; dx <= 1; ++dx) { const int r2 = r + dy, c2 = c + dx;
                if (r2 >= 0 && r2 < GRIDH && c2 >= 0 && c2 < GRIDW) acc += cw[((dy + 1) * 3 + dx + 1) * 768] * bf2f(proj[(size_t)(CROWS + b * SEQ + r2 * 64 + c2) * NPROJ + col]); }
    }
    return acc;
}
__device__ __forceinline__ void phase_prep(const Cx& p, LAS unsigned char* lds, int layer, int b) {
    const int lane = p.tid & 63, wave = __builtin_amdgcn_readfirstlane(p.tid >> 6);
    const bf16_t* proj = WSP(bf16_t, WS_PROJ);
    if (p.bid < SB / 32) {
        LAS float* wl = (LAS float*)lds;
        { const float* AW = PIN(I_RW_AW2) + (size_t)layer * 32 * 256; const float* WW = PIN(I_RW_W2) + (size_t)layer * 2 * 32 * 256;
          for (int i = p.tid; i < 96 * 256; i += NTHR) wl[i] = i < 32 * 256 ? AW[i] : WW[i - 32 * 256]; }
        __syncthreads();
        const int h = wave & 3, half = wave >> 2, c = 64 * h + lane;
        const float a0 = PIN(I_RW_A0)[layer * 256 + c], w0f = PIN(I_RW_W0)[(layer * 2 + 0) * 256 + c], w0b = PIN(I_RW_W0)[(layer * 2 + 1) * 256 + c];
        const float kkm = PIN(I_RW_KK)[layer * 256 + c], kam = PIN(I_RW_KA)[layer * 256 + c];
        for (int u = p.bid; u < SB / 32; u += p.G) {
#pragma unroll 1
            for (int i = 0; i < 16; ++i) { const int s = u * 32 + half * 16 + i; const bf16_t* pr = proj + (size_t)tok_row(b, s) * NPROJ;
                float xa = 0.f, xf = 0.f, xb = 0.f;
                if (lane < 32) { xa = bf2f(pr[PB_A + lane]); xf = tanhf(bf2f(pr[PB_WF + lane])); xb = tanhf(bf2f(pr[PB_WB + lane])); }
                const float kv = bf2f(pr[PB_K + c]);
                float sa = a0, sf = w0f, sb = w0b;
#pragma unroll 8
                for (int j = 0; j < 32; ++j) { sa += rl(xa, j) * wl[j * 256 + c]; sf += rl(xf, j) * wl[(32 + j) * 256 + c]; sb += rl(xb, j) * wl[(64 + j) * 256 + c]; }
                const float a = sigmoidf_(sa);
                const float lwf = -__expf(-softplusf_(-sf) - 0.5f), lwb = -__expf(-softplusf_(-sb) - 0.5f);
                const float kr = kv * kkm; const float ss = wsum(kr * kr); const float kk = kr * rsqrtf(ss + 1e-6f);
                const size_t o = (size_t)s * 256 + c;
                WSP(float, SC_RK)[o] = kv * (1.0f + (a - 1.0f) * kam); WSP(float, SC_RKK)[o] = kk; WSP(float, SC_RB)[o] = kk * a;
                WSP(float, SC_RLW)[o] = lwf; WSP(float, SC_RLW)[(size_t)SB * 256 + o] = lwb; }
        }
    }
    for (int u = p.bid; u < SB / 8; u += p.G) {
        for (int task = wave; task < 8 * 25; task += 8) { const int s = u * 8 + task / 25, grp = task % 25;
            if (grp < 12) { const int j = 64 * grp + lane;
                const float v = conv_at(p, proj, b, s, PC_X + j, PIN(I_SS_CW) + (size_t)layer * 9 * 768 + j) + PIN(I_SS_CB)[layer * 768 + j];
                WSP(bf16_t, SC_SX)[(size_t)s * 768 + j] = (bf16_t)f2bf(siluf_(v)); }
            else if (grp < 24) { const int g2 = grp - 12, j = 64 * g2 + lane;
                float y = siluf_(conv_at(p, proj, b, s, PD_Q + j, PIN(I_DN_CW) + (size_t)layer * 9 * 768 + j));
                if (g2 < 8) { const float ss = wsum(y * y); y *= rsqrtf(ss + 1e-6f); if (g2 < 4) y *= 0.125f; }
                WSP(bf16_t, SC_DQ)[(size_t)s * 768 + j] = (bf16_t)f2bf(y); }
            else { const bf16_t* pr = proj + (size_t)tok_row(b, s) * NPROJ;
                if (lane < 8) { const int d = lane >> 2, h = lane & 3; WSP(float, SC_SDT)[(size_t)s * 8 + lane] = softplusf_(bf2f(pr[PC_DF + lane]) + PIN(I_SS_DTB)[(layer * 2 + d) * 4 + h]); }
                else if (lane < 16) { const int q = lane - 8; WSP(float, SC_DG)[(size_t)s * 16 + q] = sigmoidf_(bf2f(pr[PD_BF + q])); }
                else if (lane < 24) { const int q = lane - 16, d = q >> 2, h = q & 3;
                    WSP(float, SC_DG)[(size_t)s * 16 + 8 + q] = -__expf(PIN(I_DN_ALOG)[(layer * 2 + d) * 4 + h]) * softplusf_(bf2f(pr[PD_AF + q]) + PIN(I_DN_DTB)[(layer * 2 + d) * 4 + h]); } }
        }
    }
}
__device__ __forceinline__ void scan_gla(const Cx& p, int layer, int b, int h, int d, int lane) {
    const bf16_t* proj = WSP(bf16_t, WS_PROJ); float* ob = WSP(float, d ? SC_OB : SC_OF); const int c = 64 * h + lane;
    float w2[16];
#pragma unroll
    for (int r = 0; r < 16; ++r) w2[r] = PIN(I_GLA_W2)[((size_t)(layer * 2 + d) * 16 + r) * 256 + c];
    const float gb = PIN(I_GLA_B)[(layer * 2 + d) * 256 + c];
    float S[64];
#pragma unroll
    for (int k = 0; k < 64; ++k) S[k] = 0.f;
    for (int i = 0; i < SB; ++i) { const int s = seq_tok(i, d); const bf16_t* pr = proj + (size_t)tok_row(b, s) * NPROJ;
        const float q = bf2f(pr[PA_Q + c]) * 0.125f, kv = bf2f(pr[PA_K + c]), vv = bf2f(pr[PA_V + c]);
        const float gl = lane < 16 ? bf2f(pr[(d ? PA_GB : PA_GF) + lane]) : 0.f;
        float z = gb;
#pragma unroll
        for (int r = 0; r < 16; ++r) z += rl(gl, r) * w2[r];
        const float dec = __expf(logsigmoidf_(z) * (1.0f / 16.0f));
        float o = 0.f;
#pragma unroll
        for (int k = 0; k < 64; ++k) { S[k] = S[k] * rl(dec, k) + rl(kv, k) * vv; o += rl(q, k) * S[k]; }
        ob[(size_t)s * 1024 + c] = o; }
}
__device__ __forceinline__ void scan_rwkv(const Cx& p, int layer, int b, int h, int d, int lane) {
    const bf16_t* proj = WSP(bf16_t, WS_PROJ); float* ob = WSP(float, d ? SC_OB : SC_OF); const int c = 64 * h + lane;
    const float* lwp = WSP(float, SC_RLW) + (size_t)d * SB * 256;
    float S[64];
#pragma unroll
    for (int k = 0; k < 64; ++k) S[k] = 0.f;
    for (int i = 0; i < SB; ++i) { const int s = seq_tok(i, d); const bf16_t* pr = proj + (size_t)tok_row(b, s) * NPROJ; const size_t o = (size_t)s * 256 + c;
        const float r = bf2f(pr[PB_R + c]), vv = bf2f(pr[PB_V + c]);
        const float kp = WSP(float, SC_RK)[o], z = -WSP(float, SC_RKK)[o], bb = WSP(float, SC_RB)[o], w = __expf(lwp[o]);
        float sz = 0.f;
#pragma unroll
        for (int k = 0; k < 64; ++k) sz += S[k] * rl(z, k);
        float y = 0.f;
#pragma unroll
        for (int k = 0; k < 64; ++k) { S[k] = S[k] * rl(w, k) + sz * rl(bb, k) + vv * rl(kp, k); y += S[k] * rl(r, k); }
        ob[(size_t)s * 1024 + 256 + c] = y; }
}
__device__ __forceinline__ void scan_ssd(const Cx& p, int layer, int b, int h, int d, int lane) {
    float* ob = WSP(float, d ? SC_OB : SC_OF); const int g = h >> 1;
    const float aneg = -__expf(PIN(I_SS_ALOG)[(layer * 2 + d) * 4 + h]);
    float S[128];
#pragma unroll
    for (int k = 0; k < 128; ++k) S[k] = 0.f;
    for (int i = 0; i < SB; ++i) { const int s = seq_tok(i, d); const bf16_t* sx = WSP(bf16_t, SC_SX) + (size_t)s * 768;
        const float dt = WSP(float, SC_SDT)[(size_t)s * 8 + d * 4 + h]; const float x = bf2f(sx[64 * h + lane]) * dt, dA = __expf(aneg * dt);
        const float B0 = bf2f(sx[256 + 128 * g + lane]), B1 = bf2f(sx[256 + 128 * g + 64 + lane]), C0 = bf2f(sx[512 + 128 * g + lane]), C1 = bf2f(sx[512 + 128 * g + 64 + lane]);
        float y = 0.f;
#pragma unroll
        for (int n = 0; n < 64; ++n) { S[n] = S[n] * dA + x * rl(B0, n); y += rl(C0, n) * S[n]; }
#pragma unroll
        for (int n = 0; n < 64; ++n) { S[64 + n] = S[64 + n] * dA + x * rl(B1, n); y += rl(C1, n) * S[64 + n]; }
        ob[(size_t)s * 1024 + 512 + 64 * h + lane] = y; }
}
__device__ __forceinline__ void scan_gdn(const Cx& p, int layer, int b, int h, int d, int lane) {
    float* ob = WSP(float, d ? SC_OB : SC_OF); const int c = 64 * h + lane;
    float S[64];
#pragma unroll
    for (int k = 0; k < 64; ++k) S[k] = 0.f;
    for (int i = 0; i < SB; ++i) { const int s = seq_tok(i, d); const bf16_t* dq = WSP(bf16_t, SC_DQ) + (size_t)s * 768;
        const float q = bf2f(dq[c]), kv = bf2f(dq[256 + c]), vv = bf2f(dq[512 + c]);
        const float beta = WSP(float, SC_DG)[(size_t)s * 16 + d * 4 + h], eg = __expf(WSP(float, SC_DG)[(size_t)s * 16 + 8 + d * 4 + h]);
        float ks = 0.f;
#pragma unroll
        for (int k = 0; k < 64; ++k) { S[k] *= eg; ks += rl(kv, k) * S[k]; }
        const float vn = beta * (vv - ks);
        float o = 0.f;
#pragma unroll
        for (int k = 0; k < 64; ++k) { S[k] += rl(kv, k) * vn; o += rl(q, k) * S[k]; }
        ob[(size_t)s * 1024 + 768 + c] = o; }
}
__device__ __forceinline__ void phase_scan(const Cx& p, int layer, int b) {
    if (p.tid >= 64) return;
    const int lane = p.tid;
    for (int ch = p.bid; ch < 32; ch += p.G) { const int mixer = ch >> 3, h = (ch >> 1) & 3, d = ch & 1;
        if (mixer == 0) scan_gla(p, layer, b, h, d, lane);
        else if (mixer == 1) scan_rwkv(p, layer, b, h, d, lane);
        else if (mixer == 2) scan_ssd(p, layer, b, h, d, lane);
        else scan_gdn(p, layer, b, h, d, lane); }
}
__device__ __forceinline__ void phase_post(const Cx& p, int layer, int b) {
    const int lane = p.tid & 63, wave = __builtin_amdgcn_readfirstlane(p.tid >> 6);
    const bf16_t* proj = WSP(bf16_t, WS_PROJ); const float* of = WSP(float, SC_OF); const float* obk = WSP(float, SC_OB); bf16_t* yc = WSP(bf16_t, WS_HBUF);
    float gw[64]; bool loaded = false;
    for (int u = p.bid; u < SB / 8; u += p.G) {
        if (wave >= 4 && !loaded) { loaded = true; const int c = 64 * (wave - 4) + lane;
#pragma unroll
            for (int j = 0; j < 64; ++j) gw[j] = PIN(I_RW_GW2)[((size_t)layer * 64 + j) * 256 + c]; }
        for (int i = 0; i < 8; ++i) { const int s = u * 8 + i, row = tok_row(b, s); const bf16_t* pr = proj + (size_t)row * NPROJ; bf16_t* yr = yc + (size_t)row * D;
            const float* o1 = of + (size_t)s * 1024; const float* o2 = obk + (size_t)s * 1024;
            const float mf = (MK_ABL & 128) ? 0.f : 1.f, mb = (MK_ABL & 64) ? 0.f : 1.f;
            if (wave < 4) { const int h = wave, c = 64 * h + lane;
                { const float o = mf * o1[c] + mb * o2[c]; const float ms = wsum(o * o) * (1.0f / 64.0f);
                  const float y = o * rsqrtf(ms + 1e-6f) * PIN(I_GLA_NG)[layer * 256 + c] * siluf_(bf2f(pr[PA_G + c])); yr[c] = (bf16_t)f2bf((MK_ABL & 4) ? 0.f : y); }
                if (wave < 2) { float y[2];
#pragma unroll
                    for (int q = 0; q < 2; ++q) { const int cc = 128 * wave + 64 * q + lane, hh = cc >> 6;
                        const float xs = bf2f(WSP(bf16_t, SC_SX)[(size_t)s * 768 + cc]);
                        y[q] = (mf * o1[512 + cc] + mb * o2[512 + cc] + PIN(I_SS_D)[layer * 4 + hh] * xs) * siluf_(bf2f(pr[PC_Z + cc])); }
                    const float ms = wsum(y[0] * y[0] + y[1] * y[1]) * (1.0f / 128.0f); const float rs = rsqrtf(ms + 1e-6f);
#pragma unroll
                    for (int q = 0; q < 2; ++q) { const int cc = 128 * wave + 64 * q + lane; yr[512 + cc] = (bf16_t)f2bf((MK_ABL & 16) ? 0.f : y[q] * rs * PIN(I_SS_NG)[layer * 256 + cc]); } }
            } else { const int h = wave - 4, c = 64 * h + lane;
                { const float o = mf * o1[256 + c] + mb * o2[256 + c]; const float mu = wsum(o) * (1.0f / 64.0f); const float dlt = o - mu; const float var = wsum(dlt * dlt) * (1.0f / 64.0f);
                  float y = dlt * rsqrtf(var + 64e-5f) * PIN(I_RW_LNG)[layer * 256 + c] + PIN(I_RW_LNB)[layer * 256 + c];
                  const float r = bf2f(pr[PB_R + c]), kp = WSP(float, SC_RK)[(size_t)s * 256 + c], vv = bf2f(pr[PB_V + c]);
                  const float bonus = wsum(r * kp * PIN(I_RW_RK)[layer * 256 + c]) * vv;
                  const float sg = sigmoidf_(bf2f(pr[PB_G + lane])); float gate = 0.f;
#pragma unroll
                  for (int j = 0; j < 64; ++j) gate += rl(sg, j) * gw[j];
                  yr[256 + c] = (bf16_t)f2bf((MK_ABL & 8) ? 0.f : (y + bonus) * gate); }
                { const float o = mf * o1[768 + c] + mb * o2[768 + c]; const float ms = wsum(o * o) * (1.0f / 64.0f);
                  const float y = o * rsqrtf(ms + 1e-6f) * PIN(I_DN_NG)[layer * 256 + c] * siluf_(bf2f(pr[PD_Z + c])); yr[768 + c] = (bf16_t)f2bf((MK_ABL & 32) ? 0.f : y); }
            }
        }
    }
}
constexpr int N2_TILE = 32, N2_STRIDE = 2064;
__device__ __forceinline__ void phase_norm2(const Cx& p, LAS unsigned char* lds, int layer, int row_lo) {
    const int tid = p.tid, lane = tid & 63, wave = __builtin_amdgcn_readfirstlane(tid >> 6), fr = lane & 15, fq = lane >> 4;
    const float* mod = WSP(float, WS_MOD) + (size_t)layer * 5 * 6144; const float* g = PIN(I_N2G) + layer * D; bf16_t* hb = WSP(bf16_t, WS_HBUF);
    const bf16_t* rt = WSP(bf16_t, WS_ROUT) + (size_t)layer * 2 * NE * D;
    LAS float* lg = (LAS float*)(lds + 2 * N2_TILE * N2_STRIDE);
    unsigned* cnt = WSP(unsigned, WS_CTL) + CW_CNT + layer * 80 * 16; int* ltok = WSP(int, WS_LTOK); float* lw = WSP(float, WS_LW);
    const float rbias = PIN(I_ROUT_B)[layer * NE + lane];
    const int nun = (ROWS - row_lo) / N2_TILE;
    for (int u = p.bid; u < nun; u += p.G) { const int r0 = row_lo + u * N2_TILE;
#pragma unroll 1
        for (int i = 0; i < 4; ++i) { const int tr = 4 * wave + i, r = r0 + tr, sel = row_sel(r);
            norm_row(res_row(p, 0, r), (const int*)0, (float*)0, WSP(int, WS_ACC) + (size_t)r * D, g, mod + sel * 6144 + 3072, mod + sel * 6144 + 4096, hb + (size_t)r * D, (LAS bf16_t*)(lds + tr * N2_STRIDE), (LAS bf16_t*)(lds + N2_TILE * N2_STRIDE + tr * N2_STRIDE), lane); }
        __syncthreads();
        { const int mt = wave >> 2, nt = wave & 3; f32x4 acc = (f32x4){0.f, 0.f, 0.f, 0.f};
          const LAS unsigned char* ap = lds + (16 * mt + fr) * N2_STRIDE + fq * 16; const bf16_t* bp = rt + (size_t)(16 * nt + fr) * D + fq * 8;
#pragma unroll 4
          for (int ks = 0; ks < 32; ++ks) { const bf16x8 a = *(const LAS bf16x8*)(ap + ks * 64), al = *(const LAS bf16x8*)(ap + N2_TILE * N2_STRIDE + ks * 64);
              const bf16x8 bb = *(const bf16x8*)(bp + ks * 32), bl = *(const bf16x8*)(bp + NE * D + ks * 32);
              acc = __builtin_amdgcn_mfma_f32_16x16x32_bf16(a, bb, acc, 0, 0, 0); acc = __builtin_amdgcn_mfma_f32_16x16x32_bf16(al, bb, acc, 0, 0, 0); acc = __builtin_amdgcn_mfma_f32_16x16x32_bf16(a, bl, acc, 0, 0, 0); }
#pragma unroll
          for (int j = 0; j < 4; ++j) lg[(16 * mt + 4 * fq + j) * 64 + 16 * nt + fr] = acc[j]; }
        __syncthreads();
#pragma unroll 1
        for (int i = 0; i < 4; ++i) { const int tr = 4 * wave + i, r = r0 + tr;
            const float sc = sigmoidf_(lg[tr * 64 + lane]); float sel = sc + rbias; float ssum = 0.f; int myE = 0; float myS = 0.f;
#pragma unroll 1
            for (int k = 0; k < TOPK; ++k) { float bv = sel; int bi = lane;
#pragma unroll
                for (int o = 32; o >= 1; o >>= 1) { const float ov = __shfl_xor(bv, o); const int oi = __shfl_xor(bi, o); if (ov > bv || (ov == bv && oi < bi)) { bv = ov; bi = oi; } }
                const int e = __builtin_amdgcn_readfirstlane(bi); const float se = rl(sc, e);
                ssum += se; if (lane == k) { myE = e; myS = se; } if (lane == e) sel = -1e30f; }
            if (lane < TOPK) { const unsigned pos = atomicAdd(cnt + myE * 16, 1u); ltok[(size_t)myE * ROWS + pos] = r; lw[(size_t)myE * ROWS + pos] = myS / ssum * 2.5f; } }
        __syncthreads();
    }
}
__device__ __forceinline__ void moe_table(const Cx& p, LAS int* tb, int layer, int row_lo) {
    const unsigned* cnt = WSP(unsigned, WS_CTL) + CW_CNT + layer * 80 * 16;
    if (p.tid == 0) { int acc = 0;
#pragma unroll 1
        for (int e = 0; e < NE1; ++e) { const int c = e < NE ? (int)__hip_atomic_load(cnt + e * 16, __ATOMIC_RELAXED, __HIP_MEMORY_SCOPE_AGENT) : ROWS - row_lo; tb[e] = c; tb[128 + e] = acc; acc += (c + 255) >> 8; }
        tb[128 + NE1] = acc; }
    __syncthreads();
}
__device__ __forceinline__ void phase_final(const Cx& p) {
    const int lane = p.tid & 63, wave = p.tid >> 6; const float* g = PIN(I_FNG);
    for (int r = p.bid * 8 + wave; r < NB * SEQ; r += p.G * 8) { float* x = p.out + (size_t)r * D;
        f32x4 v[4]; float ss = 0.f;
#pragma unroll
        for (int i = 0; i < 4; ++i) { v[i] = *(const f32x4*)(x + 256 * i + 4 * lane); const int4 a = *(const int4*)(WSP(int, WS_ACC) + (size_t)(CROWS + r) * D + 256 * i + 4 * lane);
            v[i][0] += (float)a.x * ACC_INV; v[i][1] += (float)a.y * ACC_INV; v[i][2] += (float)a.z * ACC_INV; v[i][3] += (float)a.w * ACC_INV;
            ss += v[i][0] * v[i][0] + v[i][1] * v[i][1] + v[i][2] * v[i][2] + v[i][3] * v[i][3]; }
        ss = wsum(ss); const float rstd = rsqrtf(ss * (1.0f / D) + 1e-6f);
#pragma unroll
        for (int i = 0; i < 4; ++i) *(f32x4*)(x + 256 * i + 4 * lane) = v[i] * rstd * *(const f32x4*)(g + 256 * i + 4 * lane); }
}
#ifndef MK_ABL
#define MK_ABL 0
#endif
#ifndef MK_ONE_LAUNCH
#define MK_ONE_LAUNCH 1
#endif
constexpr int N_PHASES = 1 + NL * (2 + 3 * NB + 4) + 1;

__global__ void __launch_bounds__(NTHR, 2) mega_fwd(Params pp) {
    extern __shared__ __attribute__((aligned(16))) unsigned char lds_raw[];
    LAS unsigned char* lds = (LAS unsigned char*)lds_raw;
    const int swave = __builtin_amdgcn_readfirstlane(threadIdx.x >> 6);
    for (int i = threadIdx.x; i < (LDS_BYTES - LDS_CTL) / 4; i += NTHR) ((LAS unsigned*)(lds + LDS_CTL))[i] = 0u;
    __syncthreads();
    if (threadIdx.x < N_IN) { const unsigned long long a = (unsigned long long)pp.in[threadIdx.x]; ((LAS unsigned*)(lds + LDS_PTRS))[2 * threadIdx.x] = (unsigned)a; ((LAS unsigned*)(lds + LDS_PTRS))[2 * threadIdx.x + 1] = (unsigned)(a >> 32); }
    __syncthreads();
    XcdBarrier bar = xcd_barrier_post((unsigned*)(pp.ws + WS_CTL) + CW_BAR + pp.li * XCD_BAR_WORDS, (volatile LAS unsigned*)(lds + LDS_CTL), threadIdx.x);
    LAS int* tb = (LAS int*)(lds + LDS_CTL + 64);
    int pc = 0; const int lo = pp.lo, hi = pp.hi;
#define PH_BEGIN if (pc >= lo && pc < hi) { Cx p; p.out = pp.out; p.ws = pp.ws; p.tid = swave * 64 + lane_id_asm(); p.bid = blockIdx.x; p.G = gridDim.x; p.pad = 0; asm volatile("" : "+s"(p.out), "+s"(p.ws), "+v"(p.tid), "+s"(p.bid), "+s"(p.G)); const int G = p.G, bid = p.bid;
#define PH_END if (pc + 1 < hi) { XcdBarrier b2 = bar; asm volatile("" : "+s"(b2.bar), "+s"(b2.x)); xcd_barrier(b2, (unsigned)(swave * 64 + lane_id_asm())); } } ++pc;

    PH_BEGIN
        for (int u = bid; u < CONV_A_UNITS; u += G) conv_unit_A(p, (LAS float*)lds, u);
        __syncthreads();
        phase_mod(p, lds);
    PH_END

#pragma unroll 1
    for (int layer = 0; layer < NL; ++layer) {
        const int row_lo = layer == NL - 1 ? CROWS : 0;
        PH_BEGIN
            phase_norm1(p, layer);
            __syncthreads();
            for (int u = bid; u < CONV_E_UNITS; u += G) conv_unit_E(p, (LAS float*)lds, layer, u);
        PH_END
        PH_BEGIN
            DenseSched S; S.init(ROWS, NPROJ, D, WSP(bf16_t, WS_WIN) + (size_t)layer * NPROJ * D, G, bid);
            EpiProj E{WSP(bf16_t, WS_PROJ), NPROJ};
            pg8::gemm_phase<D>(p.tid, lds, (const char*)WSP(bf16_t, WS_HBUF), S, E);
        PH_END
#pragma unroll 1
        for (int b = 0; b < NB; ++b) {
            PH_BEGIN phase_prep(p, lds, layer, b); PH_END
            PH_BEGIN phase_scan(p, layer, b); PH_END
            PH_BEGIN phase_post(p, layer, b); PH_END
        }
        PH_BEGIN
            DenseSched S; S.init(ROWS, D, D, WSP(bf16_t, WS_WOUT) + (size_t)layer * D * D, G, bid);
            EpiRes E{layer == 0 ? PIN(I_X) : (const float*)p.out, layer == 0 ? PIN(I_CTX) : (const float*)WSP(float, WS_CTXRES), p.out, WSP(float, WS_CTXRES), WSP(float, WS_MOD) + (size_t)layer * 5 * 6144 + 2048};
            pg8::gemm_phase<D>(p.tid, lds, (const char*)WSP(bf16_t, WS_HBUF), S, E);
        PH_END
        PH_BEGIN phase_norm2(p, lds, layer, row_lo); PH_END
        PH_BEGIN
            moe_table(p, tb, layer, row_lo);
            MoeSched<true> S{tb + 128, tb, 2, G, bid, D, row_lo, WSP(int, WS_LTOK), (const char*)WSP(bf16_t, WS_EXPGU), (size_t)512 * D * 2};
            EpiGU E{WSP(bf16_t, WS_H)};
            pg8::gemm_phase<D>(p.tid, lds, (const char*)WSP(bf16_t, WS_HBUF), S, E);
        PH_END
        PH_BEGIN
            moe_table(p, tb, layer, row_lo);
            MoeSched<false> S{tb + 128, tb, 4, G, bid, EH, row_lo, WSP(int, WS_LTOK), (const char*)WSP(bf16_t, WS_EXPD), (size_t)D * EH * 2};
            EpiDown E{WSP(int, WS_ACC), WSP(float, WS_MOD) + (size_t)layer * 5 * 6144 + 5120, WSP(int, WS_LTOK), WSP(float, WS_LW), tb, row_lo};
            pg8::gemm_phase<EH>(p.tid, lds, (const char*)WSP(bf16_t, WS_H), S, E);
        PH_END
    }
    PH_BEGIN phase_final(p); PH_END
#undef PH_BEGIN
#undef PH_END
}

extern "C" void kernel_launch(void* const* d_in, const int* in_sizes, int n_in, void* d_out, int out_size, void* d_ws, size_t ws_size, hipStream_t stream) {
    static int grid = 0;
    if (grid == 0) {
        if (n_in != N_IN || in_sizes[0] != NB * SEQ * D || out_size != NB * SEQ * D || ws_size < WS_END) {
            fprintf(stderr, "kernel_launch: unexpected shapes (n_in %d, in0 %d, out %d, ws %zu); nothing launched\n", n_in, n_in > 0 ? in_sizes[0] : -1, out_size, ws_size); grid = -1; return; }
        int dev = 0, cus = 0, per_cu = 0;
        if (hipGetDevice(&dev) != hipSuccess || hipDeviceGetAttribute(&cus, hipDeviceAttributeMultiprocessorCount, dev) != hipSuccess) { grid = -1; return; }
        if (hipFuncSetAttribute((const void*)mega_fwd, hipFuncAttributeMaxDynamicSharedMemorySize, LDS_BYTES) != hipSuccess) { fprintf(stderr, "kernel_launch: hipFuncSetAttribute failed\n"); grid = -1; return; }
        if (hipOccupancyMaxActiveBlocksPerMultiprocessor(&per_cu, (const void*)mega_fwd, NTHR, LDS_BYTES) != hipSuccess || per_cu < 1) { fprintf(stderr, "kernel_launch: occupancy query says %d\n", per_cu); per_cu = 1; }
        (void)hipGetLastError();
        grid = cus * 1;
    }
    if (grid < 0) return;
    if (hipMemsetAsync((char*)d_ws + WS_CTL, 0, CTL_ZERO_BYTES, stream) != hipSuccess) return;
    Params p{};
    for (int i = 0; i < N_IN; ++i) p.in[i] = (const float*)d_in[i];
    p.out = (float*)d_out; p.ws = (unsigned char*)d_ws; p.pad = 0;
#if MK_ONE_LAUNCH
    p.lo = 0; p.hi = N_PHASES; p.li = 0;
    hipLaunchKernelGGL(mega_fwd, dim3(grid), dim3(NTHR), LDS_BYTES, stream, p);
#else
    for (int k = 0; k < N_PHASES; ++k) { p.lo = k; p.hi = k + 1; p.li = k;
        hipLaunchKernelGGL(mega_fwd, dim3(grid), dim3(NTHR), LDS_BYTES, stream, p); }
#endif
}
```

```cpp
#include <hip/hip_runtime.h>
#ifndef MK_ABL
#define MK_ABL 0
#endif
#include <cstdio>
#include <cstdint>

typedef unsigned short bf16_t;
typedef short bf16x8 __attribute__((ext_vector_type(8)));
typedef float f32x4 __attribute__((ext_vector_type(4)));
typedef float f32x2 __attribute__((ext_vector_type(2)));
typedef unsigned u32x4 __attribute__((ext_vector_type(4)));
typedef unsigned u32x2 __attribute__((ext_vector_type(2)));

constexpr int NB = 4, SEQ = 8192, NCTX = 256, D = 1024, NL = 2;
constexpr int CROWS = NB * NCTX;
constexpr int ROWS = CROWS + NB * SEQ;
constexpr int SB = NCTX + SEQ;
constexpr int INW = 4056, NPROJ = 4096;
constexpr int NE = 64, NE1 = 65, TOPK = 8, EH = 256;
constexpr int GRIDW = 64, GRIDH = SEQ / GRIDW;
constexpr int PA_Q = 0, PA_K = 256, PA_V = 512, PA_G = 768, PA_GF = 1024, PA_GB = 1040;
constexpr int PB_R = 1056, PB_K = 1312, PB_V = 1568, PB_WF = 1824, PB_WB = 1856, PB_A = 1888, PB_G = 1920;
constexpr int PC_Z = 1984, PC_X = 2240, PC_DF = 3008, PC_DB = 3012;
constexpr int PD_Q = 3016, PD_Z = 3784, PD_BF = 4040, PD_BB = 4044, PD_AF = 4048, PD_AB = 4052;
enum { I_X = 0, I_C, I_CTX, I_CCTX, I_N1G, I_N2G, I_WMOD, I_BMOD, I_WIN, I_WOUT, I_GLA_W2, I_GLA_B, I_GLA_NG,
       I_RW_W2, I_RW_W0, I_RW_AW2, I_RW_A0, I_RW_GW2, I_RW_KK, I_RW_KA, I_RW_RK, I_RW_LNG, I_RW_LNB,
       I_SS_CW, I_SS_CB, I_SS_ALOG, I_SS_DTB, I_SS_D, I_SS_NG, I_DN_CW, I_DN_ALOG, I_DN_DTB, I_DN_NG,
       I_ROUT_W, I_ROUT_B, I_EXP_G, I_EXP_U, I_EXP_D, I_SH_G, I_SH_U, I_SH_D, I_FNG, N_IN };
static_assert(N_IN == 42, "input count");

constexpr size_t MiB = 1u << 20;
constexpr size_t WS_CTL = 0, CTL_ZERO_BYTES = 1 * MiB;
constexpr size_t WS_MOD = 1 * MiB;
constexpr size_t WS_WIN = 2 * MiB;
constexpr size_t WS_WOUT = 18 * MiB;
constexpr size_t WS_ROUT = 22 * MiB;
constexpr size_t WS_CTXRES = 23 * MiB;
constexpr size_t WS_EXPGU = 27 * MiB;
constexpr size_t WS_EXPD = 92 * MiB;
constexpr size_t WS_HBUF = 125 * MiB;
constexpr size_t WS_PROJ = 191 * MiB;
constexpr size_t WS_SCR = 455 * MiB;
constexpr size_t WS_END = 640455456;
constexpr int HROWS_MAX = ROWS * 9 + NE1 * 256;
constexpr size_t WS_H = WS_PROJ;
constexpr size_t WS_LTOK = WS_PROJ + 160 * MiB;
constexpr size_t WS_LW = WS_PROJ + 170 * MiB;
static_assert((size_t)HROWS_MAX * 512 <= 160 * MiB && (size_t)NE * ROWS * 4 <= 10 * MiB && WS_LW + 10 * MiB <= WS_SCR, "moe overlay");
constexpr size_t WS_ACC = WS_SCR;
constexpr float ACC_SCALE = 1048576.0f, ACC_INV = 1.0f / 1048576.0f;
static_assert(WS_ACC + (size_t)ROWS * D * 4 <= WS_END, "acc fits");
constexpr size_t SC_OF = WS_SCR;
constexpr size_t SC_OB = SC_OF + (size_t)SB * 1024 * 4;
constexpr size_t SC_RK = SC_OB + (size_t)SB * 1024 * 4;
constexpr size_t SC_RKK = SC_RK + (size_t)SB * 256 * 4;
constexpr size_t SC_RB = SC_RKK + (size_t)SB * 256 * 4;
constexpr size_t SC_RLW = SC_RB + (size_t)SB * 256 * 4;
constexpr size_t SC_SX = SC_RLW + (size_t)2 * SB * 256 * 4;
constexpr size_t SC_DQ = SC_SX + (size_t)SB * 768 * 2;
constexpr size_t SC_SDT = SC_DQ + (size_t)SB * 768 * 2;
constexpr size_t SC_DG = SC_SDT + (size_t)SB * 8 * 4;
constexpr size_t SC_END = SC_DG + (size_t)SB * 16 * 4;
static_assert(SC_END <= WS_END, "scratch fits");
constexpr int CW_CNT = 1024;
constexpr int CW_BAR = 4096;

#define LAS __attribute__((address_space(3)))
constexpr int NTHR = 512;
constexpr int LDS_BYTES = 147456;
constexpr int LDS_CTL = 143360;
constexpr int LDS_PTRS = LDS_CTL + 2048;

__device__ __forceinline__ int lane_id_asm() { int l; asm volatile("v_mbcnt_lo_u32_b32 %0, -1, 0\n\tv_mbcnt_hi_u32_b32 %0, -1, %0" : "=v"(l)); return l; }
__device__ __forceinline__ float bf2f(bf16_t b) { return __uint_as_float(((unsigned)b) << 16); }
__device__ __forceinline__ unsigned f2bf(float f) { unsigned u = __float_as_uint(f); u += 0x7FFFu + ((u >> 16) & 1u); return u >> 16; }
__device__ __forceinline__ unsigned pk2(float lo, float hi) { return f2bf(lo) | (f2bf(hi) << 16); }
__device__ __forceinline__ float rl(float x, int k) { return __uint_as_float(__builtin_amdgcn_readlane(__float_as_uint(x), k)); }
__device__ __forceinline__ float wsum(float v) { v += __shfl_xor(v, 32); v += __shfl_xor(v, 16); v += __shfl_xor(v, 8); v += __shfl_xor(v, 4); v += __shfl_xor(v, 2); v += __shfl_xor(v, 1); return v; }
__device__ __forceinline__ float sigmoidf_(float x) { return 1.0f / (1.0f + __expf(-x)); }
__device__ __forceinline__ float siluf_(float x) { return x / (1.0f + __expf(-x)); }
__device__ __forceinline__ float softplusf_(float x) { return x > 20.f ? x : log1pf(__expf(x)); }
__device__ __forceinline__ float logsigmoidf_(float x) { return fminf(x, 0.f) - log1pf(__expf(-fabsf(x))); }
__device__ __forceinline__ int seq_tok(int i, int d) { return d == 0 ? i : (i < NCTX ? NCTX - 1 - i : SB + NCTX - 1 - i); }
__device__ __forceinline__ int tok_row(int b, int s) { return s < NCTX ? b * NCTX + s : CROWS + b * SEQ + (s - NCTX); }

struct Params { const float* in[N_IN]; float* out; unsigned char* ws; int lo, hi, li, pad; };
struct Cx { float* out; unsigned char* ws; int tid, bid, G, pad; };
__device__ __forceinline__ const float* PIN(int i) {
    extern __shared__ __attribute__((aligned(16))) unsigned char lds_raw_[];
    int off = LDS_PTRS + 8 * i; asm volatile("" : "+s"(off));
    const LAS unsigned* t = (const LAS unsigned*)((LAS unsigned char*)lds_raw_ + off);
    const unsigned lo = __builtin_amdgcn_readfirstlane(t[0]), hi = __builtin_amdgcn_readfirstlane(t[1]);
    return (const float*)(((unsigned long long)hi << 32) | lo);
}
#define XB_TMO      128
#define XB_XCNT(j)  (256  + 64 * (j))
#define XB_XSUB(j)  (1280 + 64 * (j))
#define XB_XGEN(j)  (2304 + 64 * (j))
#define XB_TOP      3328
#define XB_TOPGEN   3392
#define XCD_BAR_WORDS 3456
#define XB_SPIN_CAP (1u << 18)

__device__ __forceinline__ unsigned xb_ld(unsigned* p)              { return __hip_atomic_load(p, __ATOMIC_RELAXED, __HIP_MEMORY_SCOPE_AGENT); }
__device__ __forceinline__ unsigned xb_add(unsigned* p, unsigned v) { return __hip_atomic_fetch_add(p, v, __ATOMIC_RELAXED, __HIP_MEMORY_SCOPE_AGENT); }
__device__ __forceinline__ unsigned xb_xcc_id() { return (unsigned)__builtin_amdgcn_s_getreg((3 << 11) | 20) & 0xFu; }
#define XB_SPIN(cond, bar) do { unsigned _sp = 0; while (cond) { __builtin_amdgcn_s_sleep(1); \
    if ((++_sp & 255u) == 0u) { if (xb_ld(&(bar)[XB_TMO])) break; if (_sp > XB_SPIN_CAP) { atomicAdd(&(bar)[XB_TMO], 1u); break; } } } } while (0)

struct XcdBarrier {
    unsigned* bar; unsigned x;
    volatile LAS unsigned* st;
};

__device__ __forceinline__ XcdBarrier xcd_barrier_post(unsigned* bar, volatile LAS unsigned* st, const unsigned xb_tid) {
    XcdBarrier b; b.bar = bar; b.x = xb_xcc_id(); b.st = st;
    if (xb_tid == 0) (void)xb_add(&bar[XB_XCNT(b.x)], 1u);
    return b;
}
__device__ __forceinline__ void xcd_barrier_complete(unsigned* bar, unsigned x, unsigned& nloc, unsigned& nx) {
    const unsigned G = gridDim.x * gridDim.y * gridDim.z;
    unsigned sum, cnt, mine, sp = 0u;
    for (;;) {
        sum = 0u; cnt = 0u; mine = 0u;
#pragma unroll
        for (unsigned j = 0; j < 16; ++j) { const unsigned c = xb_ld(&bar[XB_XCNT(j)]); sum += c; cnt += (c > 0u) ? 1u : 0u; mine = (j == x) ? c : mine; }
        if (sum == G) break;
        __builtin_amdgcn_s_sleep(1);
        if ((++sp & 255u) == 0u) { if (xb_ld(&bar[XB_TMO])) break; if (sp > XB_SPIN_CAP) { atomicAdd(&bar[XB_TMO], 1u); break; } }
    }
    nloc = mine > 0u ? mine : 1u; nx = cnt > 0u ? cnt : 1u;
}

__device__ __forceinline__ void xcd_barrier(const XcdBarrier& b, const unsigned xb_tid) {
    asm volatile("s_waitcnt vmcnt(0)" ::: "memory");
    __syncthreads();
    if (xb_tid == 0) {
        unsigned* bar = b.bar;
        __builtin_amdgcn_s_waitcnt(0);
        unsigned nloc = b.st[0], nx = b.st[1];
        if (nloc == 0u) { xcd_barrier_complete(bar, b.x, nloc, nx); b.st[0] = nloc; b.st[1] = nx; }
        const unsigned old = xb_add(&bar[XB_XSUB(b.x)], 1u);
        const unsigned gen = old / nloc;
        if (old + 1u == (gen + 1u) * nloc) {
            __builtin_amdgcn_fence(__ATOMIC_RELEASE, "agent");
            asm volatile("s_waitcnt vmcnt(0)" ::: "memory");
            const unsigned og = xb_add(&bar[XB_TOP], 1u);
            const unsigned tg = og / nx;
            if (og + 1u == (tg + 1u) * nx) xb_add(&bar[XB_TOPGEN], 1u);
            else XB_SPIN(xb_ld(&bar[XB_TOPGEN]) == tg, bar);
            __builtin_amdgcn_fence(__ATOMIC_ACQUIRE, "agent");
            xb_add(&bar[XB_XGEN(b.x)], 1u);
            asm volatile("s_waitcnt vmcnt(0)" ::: "memory");
        } else {
            XB_SPIN(xb_ld(&bar[XB_XGEN(b.x)]) == gen, bar);
            __builtin_amdgcn_fence(__ATOMIC_ACQUIRE, "agent");
            asm volatile("s_waitcnt vmcnt(0)" ::: "memory");
        }
    }
    __syncthreads();
}

namespace pg8 {
constexpr int BM = 256, BK = 64, HALF = 128, HTB = HALF * BK * 2  , STAGE_BYTES = 8 * HTB, NXCD = 8, WGM = 8;
__host__ __device__ __forceinline__ int lds_byte(int r, int c) { const int st = (r >> 4) * 2 + (c >> 5), rr = r & 15, cc = c & 31, ob = rr * 64 + cc * 2; return st * 1024 + (ob ^ (((ob >> 9) & 1) << 5)); }
__host__ __device__ __forceinline__ void stage_rc(int b, int& R, int& C) { const int st = b / 1024, sb = b % 1024, swz = sb ^ (((sb >> 9) & 1) << 5); R = (st >> 1) * 16 + swz / 64; C = (st & 1) * 32 + (swz % 64) / 2; }
__host__ __device__ __forceinline__ int perm32(int rho) { const int n = rho >> 4, i = rho & 15; return 8 * (i >> 2) + 4 * n + (i & 3); }

struct Unit { int pm, pn, e, r0; };

__device__ __forceinline__ unsigned cvt_pk_bf16(float lo, float hi) { unsigned r; asm volatile("v_cvt_pk_bf16_f32 %0, %1, %2" : "=v"(r) : "v"(lo), "v"(hi)); return r; }

template <int K, class Epi, class Sched>
__device__ __forceinline__ void gemm_phase(const int tid, LAS unsigned char* lds, const char* Abase, const Sched& S, const Epi& E) {
    const int wid = __builtin_amdgcn_readfirstlane(tid >> 6), lane = tid & 63, wr = wid >> 2, wc = wid & 3, fr = lane & 15, fq = lane >> 4;
    const int nt = K / BK;
    int RA[2], CA[2]; unsigned voffB[2];
#pragma unroll
    for (int i = 0; i < 2; ++i) { int R, C; stage_rc(tid * 16 + i * 8192, R, C); const int Rb = Epi::PERM ? ((R & ~31) + perm32(R & 31)) : R;
        RA[i] = R; CA[i] = C; voffB[i] = (unsigned)(Rb * K + C) * 2u; }
    const size_t kstep = (size_t)(BK * 2);
    const size_t hstep = (size_t)HALF * K * 2;
    const unsigned ldsw = (unsigned)wid * 1024u;
    const int aoff = lds_byte(wr * 64 + fr, fq * 8), boff = lds_byte(wc * 32 + fr, fq * 8);
#define PG8_SA(b, h) (((b) * 2 + (h)) * HTB)
#define PG8_SB(b, h) ((4 + (b) * 2 + (h)) * HTB)
#define PG8_STAGE(bufoff, gbase, voff) do { _Pragma("unroll") for (int _i = 0; _i < 2; ++_i) \
        __builtin_amdgcn_global_load_lds((const unsigned*)((const char*)(gbase) + (voff)[_i]), (LAS unsigned*)(lds + (bufoff) + ldsw + _i * 8192), 16, 0, 0); } while (0)
#define PG8_LDA(dst, b, h) do { _Pragma("unroll") for (int m = 0; m < 4; ++m) _Pragma("unroll") for (int k = 0; k < 2; ++k) dst[m][k] = *(const LAS bf16x8*)(lds + PG8_SA(b, h) + aoff + m * 2048 + k * 1024); } while (0)
#define PG8_LDB(dst, b, h) do { _Pragma("unroll") for (int n = 0; n < 2; ++n) _Pragma("unroll") for (int k = 0; k < 2; ++k) dst[n][k] = *(const LAS bf16x8*)(lds + PG8_SB(b, h) + boff + n * 2048 + k * 1024); } while (0)
#define PG8_MMA(ai, bj, At, Bt) do { __builtin_amdgcn_s_setprio(1); _Pragma("unroll") for (int m = 0; m < 4; ++m) _Pragma("unroll") for (int n = 0; n < 2; ++n) _Pragma("unroll") for (int k = 0; k < 2; ++k) \
        acc[ai][bj][m][n] = __builtin_amdgcn_mfma_f32_16x16x32_bf16(Bt[n][k], At[m][k], acc[ai][bj][m][n], 0, 0, 0); __builtin_amdgcn_s_setprio(0); } while (0)
#define PG8_WAIT_V(n) asm volatile("s_waitcnt vmcnt(" #n ")" ::: "memory")
#define PG8_WAIT_L(n) asm volatile("s_waitcnt lgkmcnt(" #n ")" ::: "memory")
#define PG8_BAR __builtin_amdgcn_s_barrier()
#define PG8_SCHED __builtin_amdgcn_sched_barrier(0)
#define PG8_AOFF(dst, u) do { _Pragma("unroll") for (int _h = 0; _h < 2; ++_h) _Pragma("unroll") for (int _i = 0; _i < 2; ++_i) \
        dst[_h][_i] = ((unsigned)S.a_row(u, _h * HALF + RA[_i]) * (unsigned)K + (unsigned)CA[_i]) * 2u; } while (0)
    Unit cur, nxt; int ui = 0;
    if (!S.next(0, cur)) return;
    f32x4 acc[2][2][4][2];
#pragma unroll
    for (int a = 0; a < 2; ++a)
#pragma unroll
        for (int b = 0; b < 2; ++b)
#pragma unroll
            for (int m = 0; m < 4; ++m)
#pragma unroll
                for (int n = 0; n < 2; ++n) acc[a][b][m][n] = (f32x4){0.f, 0.f, 0.f, 0.f};
    bf16x8 At[4][2], B0[2][2], B1[2][2];
    unsigned cO[2][2], nO[2][2];
    PG8_AOFF(cO, cur);
    const char* cB = S.b_ptr(cur);
    PG8_STAGE(PG8_SB(0, 0), cB, voffB); PG8_STAGE(PG8_SA(0, 0), Abase, cO[0]); PG8_STAGE(PG8_SB(0, 1), cB + hstep, voffB); PG8_STAGE(PG8_SA(0, 1), Abase, cO[1]);
    if (wr == 1) PG8_BAR;
    PG8_WAIT_V(4); PG8_BAR;
    PG8_STAGE(PG8_SB(1, 0), cB + kstep, voffB); PG8_STAGE(PG8_SA(1, 0), Abase + kstep, cO[0]); PG8_STAGE(PG8_SB(1, 1), cB + hstep + kstep, voffB);
    PG8_WAIT_V(6); PG8_BAR;
    for (;;) {
        const bool has_next = S.next(ui + 1, nxt);
        const char* nB = cB;
        if (has_next) { PG8_AOFF(nO, nxt); nB = S.b_ptr(nxt); }
        else {
#pragma unroll
            for (int h = 0; h < 2; ++h)
#pragma unroll
                for (int i = 0; i < 2; ++i) nO[h][i] = cO[h][i]; }
        for (int t = 0; t < nt; t += 2) {
            const bool last = (t == nt - 2);
            const char* a1 = Abase + (size_t)(t + 1) * kstep;
            const char* a2 = last ? Abase : Abase + (size_t)(t + 2) * kstep; const char* b2 = last ? nB : cB + (size_t)(t + 2) * kstep;
            const char* a3 = a2 + kstep; const char* b3 = b2 + kstep;
            unsigned o2[2][2];
#pragma unroll
            for (int h = 0; h < 2; ++h)
#pragma unroll
                for (int i = 0; i < 2; ++i) o2[h][i] = last ? nO[h][i] : cO[h][i];
            PG8_LDB(B0, 0, 0); PG8_SCHED; PG8_LDA(At, 0, 0); PG8_STAGE(PG8_SA(1, 1), a1, cO[1]);
            PG8_WAIT_L(8); PG8_BAR; PG8_WAIT_L(0); PG8_MMA(0, 0, At, B0); PG8_BAR; PG8_SCHED;
            PG8_LDB(B1, 0, 1); PG8_STAGE(PG8_SB(0, 0), b2, voffB);
            PG8_BAR; PG8_WAIT_L(0); PG8_MMA(0, 1, At, B1); PG8_BAR;
            PG8_LDA(At, 0, 1); PG8_STAGE(PG8_SA(0, 0), a2, o2[0]);
            PG8_BAR; PG8_WAIT_L(0); PG8_MMA(1, 0, At, B0); PG8_BAR; PG8_SCHED;
            PG8_STAGE(PG8_SB(0, 1), b2 + hstep, voffB);
            PG8_WAIT_V(6); PG8_BAR; PG8_MMA(1, 1, At, B1); PG8_BAR;
            PG8_LDB(B0, 1, 0); PG8_SCHED; PG8_LDA(At, 1, 0); PG8_STAGE(PG8_SA(0, 1), a2, o2[1]);
            PG8_WAIT_L(8); PG8_BAR; PG8_WAIT_L(0); PG8_MMA(0, 0, At, B0); PG8_BAR; PG8_SCHED;
            PG8_LDB(B1, 1, 1); PG8_STAGE(PG8_SB(1, 0), b3, voffB);
            PG8_BAR; PG8_WAIT_L(0); PG8_MMA(0, 1, At, B1); PG8_BAR;
            PG8_LDA(At, 1, 1); PG8_STAGE(PG8_SA(1, 0), a3, o2[0]);
            PG8_BAR; PG8_WAIT_L(0); PG8_MMA(1, 0, At, B0); PG8_BAR; PG8_SCHED;
            PG8_STAGE(PG8_SB(1, 1), b3 + hstep, voffB);
            PG8_WAIT_V(6); PG8_BAR; PG8_MMA(1, 1, At, B1); PG8_BAR;
        }
        E(acc, cur, wid);
        if (!has_next) break;
#pragma unroll
        for (int a = 0; a < 2; ++a)
#pragma unroll
            for (int b = 0; b < 2; ++b)
#pragma unroll
                for (int m = 0; m < 4; ++m)
#pragma unroll
                    for (int n = 0; n < 2; ++n) acc[a][b][m][n] = (f32x4){0.f, 0.f, 0.f, 0.f};
        cur = nxt; cB = nB; ++ui;
#pragma unroll
        for (int h = 0; h < 2; ++h)
#pragma unroll
            for (int i = 0; i < 2; ++i) cO[h][i] = nO[h][i];
    }
    PG8_WAIT_V(0);
    if (wr == 0) PG8_BAR;
    PG8_BAR;
#undef PG8_SA
#undef PG8_SB
#undef PG8_STAGE
#undef PG8_LDA
#undef PG8_LDB
#undef PG8_MMA
#undef PG8_WAIT_V
#undef PG8_WAIT_L
#undef PG8_BAR
#undef PG8_SCHED
#undef PG8_AOFF
}
}
struct DenseSched {
    int nM, nN, nwg, G, c, K; const char* Bt; int single = 0, round = 0;
    __device__ __forceinline__ void init(int M, int N, int K_, const bf16_t* Bt_, int G_, int c_) { nM = M / 256; nN = N / 256; nwg = nM * nN; G = G_; c = c_; K = K_; Bt = (const char*)Bt_; }
    __device__ __forceinline__ bool next(int i, pg8::Unit& u) const {
        if (single && i > 0) return false;
        const long L = (long)(single ? round : i) * G + c; if (L >= nwg) return false;
        int wgid = (int)L; { const int q = nwg / 8, r = nwg % 8, xcd = wgid % 8, off = wgid / 8; wgid = (xcd < r ? xcd * (q + 1) : r * (q + 1) + (xcd - r) * q) + off; }
        const int nig = 8 * nN, gid = wgid / nig, fm = gid * 8, gsz = (nM - fm) < 8 ? (nM - fm) : 8;
        u.pm = fm + ((wgid % nig) % gsz); u.pn = (wgid % nig) / gsz; u.e = 0; u.r0 = 0; return true;
    }
    __device__ __forceinline__ int a_row(const pg8::Unit& u, int r) const { return u.pm * 256 + r; }
    __device__ __forceinline__ const char* b_ptr(const pg8::Unit& u) const { return Bt + (size_t)u.pn * 256 * K * 2; }
};
template <bool GATHER> struct MoeSched {
    const LAS int* tstart; const LAS int* cnt; int nN, G, c, K, row_lo; const int* ltok; const char* Bt; size_t bstride;
    __device__ __forceinline__ bool next(int i, pg8::Unit& u) const {
        const long L = (long)i * G + c; const int ntile = __builtin_amdgcn_readfirstlane(tstart[NE1]); if (L >= (long)ntile * nN) return false;
        const int tile = (int)(L / nN); u.pn = (int)(L % nN);
        int e = 0;
#pragma unroll 1
        for (int step = 64; step >= 1; step >>= 1) { const int e2 = e + step; if (e2 <= NE && tstart[e2] <= tile) e = e2; }
        e = __builtin_amdgcn_readfirstlane(e); u.e = e; u.pm = __builtin_amdgcn_readfirstlane(tile); u.pn = __builtin_amdgcn_readfirstlane(u.pn); u.r0 = __builtin_amdgcn_readfirstlane((tile - tstart[e]) * 256); return true;
    }
    __device__ __forceinline__ int a_row(const pg8::Unit& u, int r) const {
        if (!GATHER) return u.pm * 256 + r;
        const int ri = u.r0 + r;
        if (u.e == NE) return ri < cnt[NE] ? row_lo + ri : row_lo;
        return ri < cnt[u.e] ? ltok[(size_t)u.e * ROWS + ri] : row_lo;
    }
    __device__ __forceinline__ const char* b_ptr(const pg8::Unit& u) const { return Bt + (size_t)u.e * bstride + (size_t)u.pn * 256 * K * 2; }
};

struct EpiProj {
    static constexpr bool PERM = true;
    bf16_t* O; int ldc;
    __device__ __forceinline__ void operator()(const f32x4 (&acc)[2][2][4][2], const pg8::Unit& u, const int wid) const {
        const int lane_ = lane_id_asm(), fr = lane_ & 15, fq = lane_ >> 4, wr = wid >> 2, wc = wid & 3;
        const int row0 = u.pm * 256 + wr * 64 + fr, col0 = u.pn * 256 + wc * 32 + 8 * fq;
#pragma unroll
        for (int ai = 0; ai < 2; ++ai)
#pragma unroll
            for (int m = 0; m < 4; ++m) { bf16_t* rowp = O + (size_t)(row0 + ai * 128 + m * 16) * ldc + col0;
#pragma unroll
                for (int bj = 0; bj < 2; ++bj) { const f32x4 v0 = acc[ai][bj][m][0], v1 = acc[ai][bj][m][1];
                    u32x4 w; w.x = pg8::cvt_pk_bf16(v0[0], v0[1]); w.y = pg8::cvt_pk_bf16(v0[2], v0[3]); w.z = pg8::cvt_pk_bf16(v1[0], v1[1]); w.w = pg8::cvt_pk_bf16(v1[2], v1[3]);
                    *(u32x4*)(rowp + bj * 128) = w; } }
    }
};
struct EpiRes {
    static constexpr bool PERM = false;
    const float* xsrc; const float* csrc; float* xdst; float* cdst; const float* gate; float pert = 0.f;
    __device__ __forceinline__ void operator()(const f32x4 (&acc)[2][2][4][2], const pg8::Unit& u, const int wid) const {
        const int lane_ = lane_id_asm(), fr = lane_ & 15, fq = lane_ >> 4, wr = wid >> 2, wc = wid & 3;
        const int col0 = u.pn * 256 + wc * 32 + 4 * fq;
        const bool isc = u.pm < 4; const int sel = isc ? 4 : (u.pm - 4) >> 5;
        const float* src = isc ? csrc + (size_t)u.pm * 256 * D : xsrc + (size_t)(u.pm - 4) * 256 * D;
        float* dst = isc ? cdst + (size_t)u.pm * 256 * D : xdst + (size_t)(u.pm - 4) * 256 * D;
        f32x4 gv[2][2];
#pragma unroll
        for (int bj = 0; bj < 2; ++bj)
#pragma unroll
            for (int n = 0; n < 2; ++n) gv[bj][n] = *(const f32x4*)(gate + sel * 6144 + col0 + bj * 128 + n * 16);
#pragma unroll
        for (int ai = 0; ai < 2; ++ai)
#pragma unroll
            for (int m = 0; m < 4; ++m) { const size_t off = (size_t)(ai * 128 + wr * 64 + m * 16 + fr) * D + col0;
#pragma unroll
                for (int bj = 0; bj < 2; ++bj)
#pragma unroll
                    for (int n = 0; n < 2; ++n) { const f32x4 s = *(const f32x4*)(src + off + bj * 128 + n * 16); *(f32x4*)(dst + off + bj * 128 + n * 16) = (s + gv[bj][n] * acc[ai][bj][m][n]) * (1.0f + (((fr + m + n) & 1) ? pert : -pert)); }
                asm volatile("" ::: "memory"); }
    }
};
struct EpiF32T {
    static constexpr bool PERM = false;
    float* Y;
    __device__ __forceinline__ void operator()(const f32x4 (&acc)[2][2][4][2], const pg8::Unit& u, const int wid) const {
        const int lane_ = lane_id_asm(), fr = lane_ & 15, fq = lane_ >> 4, wr = wid >> 2, wc = wid & 3;
        const int col0 = u.pn * 256 + wc * 32 + 4 * fq;
#pragma unroll
        for (int ai = 0; ai < 2; ++ai)
#pragma unroll
            for (int m = 0; m < 4; ++m) { float* rp = Y + (size_t)(u.pm * 256 + ai * 128 + wr * 64 + m * 16 + fr) * D + col0;
#pragma unroll
                for (int bj = 0; bj < 2; ++bj)
#pragma unroll
                    for (int n = 0; n < 2; ++n) *(f32x4*)(rp + bj * 128 + n * 16) = acc[ai][bj][m][n]; }
    }
};
struct EpiGU {
    static constexpr bool PERM = false;
    bf16_t* H;
    __device__ __forceinline__ void operator()(const f32x4 (&acc)[2][2][4][2], const pg8::Unit& u, const int wid) const {
        const int lane_ = lane_id_asm(), fr = lane_ & 15, fq = lane_ >> 4, wr = wid >> 2, wc = wid & 3;
        const int row0 = u.pm * 256 + wr * 64 + fr;
#pragma unroll
        for (int ai = 0; ai < 2; ++ai)
#pragma unroll
            for (int m = 0; m < 4; ++m) { bf16_t* rowp = H + (size_t)(row0 + ai * 128 + m * 16) * EH + 4 * fq;
#pragma unroll
                for (int bj = 0; bj < 2; ++bj) { const f32x4 g = acc[ai][bj][m][0], up = acc[ai][bj][m][1]; float h[4];
#pragma unroll
                    for (int j = 0; j < 4; ++j) h[j] = g[j] / (1.0f + __expf(-g[j])) * up[j];
                    u32x2 w; w.x = pg8::cvt_pk_bf16(h[0], h[1]); w.y = pg8::cvt_pk_bf16(h[2], h[3]);
                    *(u32x2*)(rowp + (u.pn * 256 + bj * 128 + wc * 32) / 2) = w; } }
    }
};
struct EpiDown {
    static constexpr bool PERM = false;
    int* accb; const float* gate; const int* ltok; const float* lw; const LAS int* cnt; int row_lo;
    __device__ __forceinline__ void operator()(const f32x4 (&acc)[2][2][4][2], const pg8::Unit& u, const int wid) const {
        const int lane_ = lane_id_asm(), fr = lane_ & 15, fq = lane_ >> 4, wr = wid >> 2, wc = wid & 3;
        const int col0 = u.pn * 256 + wc * 32 + 4 * fq; const int ce = __builtin_amdgcn_readfirstlane(cnt[u.e]);
        const int rbase = u.r0 + wr * 64 + fr; const size_t lbase = (size_t)u.e * ROWS;
#pragma unroll
        for (int ai = 0; ai < 2; ++ai)
#pragma unroll
            for (int m = 0; m < 4; ++m) { const int ri = rbase + ai * 128 + m * 16;
                __builtin_amdgcn_sched_barrier(0);
                if (ri < ce && !((MK_ABL & 1) && u.e != NE) && !((MK_ABL & 2) && u.e == NE)) {
                    int tok = row_lo + ri; float w = ACC_SCALE;
                    if (u.e != NE) { tok = ltok[lbase + ri]; w = lw[lbase + ri] * ACC_SCALE; }
                    const int sel = tok < CROWS ? 4 : (tok - CROWS) >> 13;
                    int* dst = accb + (size_t)tok * D + col0;
                    const float* gp = gate + sel * 6144 + col0;
#pragma unroll
                    for (int bj = 0; bj < 2; ++bj)
#pragma unroll
                        for (int n = 0; n < 2; ++n) { const f32x4 gv = *(const f32x4*)(gp + bj * 128 + n * 16); const f32x4 v = acc[ai][bj][m][n] * gv * w;
#pragma unroll
                            for (int j = 0; j < 4; ++j) atomicAdd(dst + bj * 128 + n * 16 + j, (int)rintf(v[j])); }
                }
                asm volatile("" ::: "memory"); }
    }
};
#define WSP(T, off) ((T*)(p.ws + (off)))

__device__ __forceinline__ void conv_tile(const int t, LAS float* tl, const float* __restrict__ src, int ldsrc, int k0, int n0, int nvalid, bf16_t* dst, int lddst, int mode) {
#pragma unroll
    for (int j = 0; j < 8; ++j) { const int idx = t + NTHR * j, k = idx >> 6, n = idx & 63; float v = 0.f; if (n0 + n < nvalid) v = src[(size_t)(k0 + k) * ldsrc + n0 + n]; tl[k * 65 + n] = v; }
    __syncthreads();
#pragma unroll
    for (int j = 0; j < 4; ++j) { const int pi = t + NTHR * j, n = pi >> 5, k = (pi & 31) * 2; const int nn = n0 + n;
        const int row = (mode == 0 || mode == 3) ? nn : ((nn >> 4) * 32 + (nn & 15) + (mode == 2 ? 16 : 0));
        float v0 = tl[k * 65 + n], v1 = tl[(k + 1) * 65 + n];
        if (mode == 3) { v0 -= bf2f((bf16_t)f2bf(v0)); v1 -= bf2f((bf16_t)f2bf(v1)); }
        *(unsigned*)(dst + (size_t)row * lddst + k0 + k) = pk2(v0, v1); }
    __syncthreads();
}
constexpr int CONV_A_UNITS = 2048 + 512 + 64;
__device__ __forceinline__ void conv_unit_A(const Cx& p, LAS float* tl, int u) {
    if (u < 2048) { const int l = u >> 10, r = u & 1023; conv_tile(p.tid, tl, PIN(I_WIN) + (size_t)l * D * INW, INW, (r >> 6) * 64, (r & 63) * 64, INW, WSP(bf16_t, WS_WIN) + (size_t)l * NPROJ * D, D, 0); }
    else if (u < 2560) { const int v = u - 2048, l = v >> 8, r = v & 255; conv_tile(p.tid, tl, PIN(I_WOUT) + (size_t)l * D * D, D, (r >> 4) * 64, (r & 15) * 64, D, WSP(bf16_t, WS_WOUT) + (size_t)l * D * D, D, 0); }
    else { const int v = u - 2560, l = v >> 5, lo = (v >> 4) & 1, r = v & 15; conv_tile(p.tid, tl, PIN(I_ROUT_W) + (size_t)l * D * NE, NE, r * 64, 0, NE, WSP(bf16_t, WS_ROUT) + (size_t)(l * 2 + lo) * NE * D, D, lo ? 3 : 0); }
}
constexpr int CONV_E_UNITS = NE1 * 192;
__device__ __forceinline__ void conv_unit_E(const Cx& p, LAS float* tl, int l, int u) {
    const int e = u / 192, r = u % 192;
    if (r < 128) { const int up = r >> 6, q = r & 63;
        const float* src = e < NE ? PIN(up ? I_EXP_U : I_EXP_G) + ((size_t)l * NE + e) * D * EH : PIN(up ? I_SH_U : I_SH_G) + (size_t)l * D * EH;
        conv_tile(p.tid, tl, src, EH, (q >> 2) * 64, (q & 3) * 64, EH, WSP(bf16_t, WS_EXPGU) + (size_t)e * 512 * D, D, 1 + up); }
    else { const int q = r - 128;
        const float* src = e < NE ? PIN(I_EXP_D) + ((size_t)l * NE + e) * EH * D : PIN(I_SH_D) + (size_t)l * EH * D;
        conv_tile(p.tid, tl, src, D, (q >> 4) * 64, (q & 15) * 64, D, WSP(bf16_t, WS_EXPD) + (size_t)e * D * EH, EH, 0); }
}
__device__ __forceinline__ void phase_mod(const Cx& p, LAS unsigned char* lds) {
    LAS float* sv = (LAS float*)lds; LAS float* red = sv + 5 * D;
    const int tid = p.tid;
    if (p.bid >= 192) return;
    for (int i = tid; i < 5 * D; i += NTHR) { const int j = i >> 10, k = i & 1023; const float c = j < 4 ? PIN(I_C)[j * D + k] : PIN(I_CCTX)[k]; sv[i] = siluf_(c); }
    __syncthreads();
    for (int u = p.bid; u < 192; u += p.G) {
        const int l = u / 96, cb = u % 96, kg = tid >> 6, cl = tid & 63;
        const float* w = PIN(I_WMOD) + (size_t)l * D * 6144 + cb * 64 + cl;
        float a0 = 0.f, a1 = 0.f, a2 = 0.f, a3 = 0.f, a4 = 0.f;
#pragma unroll 8
        for (int kk = 0; kk < 128; ++kk) { const int k = kg * 128 + kk; const float wv = w[(size_t)k * 6144];
            a0 += sv[k] * wv; a1 += sv[D + k] * wv; a2 += sv[2 * D + k] * wv; a3 += sv[3 * D + k] * wv; a4 += sv[4 * D + k] * wv; }
        red[(kg * 5 + 0) * 64 + cl] = a0; red[(kg * 5 + 1) * 64 + cl] = a1; red[(kg * 5 + 2) * 64 + cl] = a2; red[(kg * 5 + 3) * 64 + cl] = a3; red[(kg * 5 + 4) * 64 + cl] = a4;
        __syncthreads();
        if (tid < 320) { const int j = tid >> 6; float s = 0.f;
#pragma unroll
            for (int g = 0; g < 8; ++g) s += red[(g * 5 + j) * 64 + cl];
            WSP(float, WS_MOD)[((size_t)l * 5 + j) * 6144 + cb * 64 + cl] = s + PIN(I_BMOD)[l * 6144 + cb * 64 + cl]; }
        __syncthreads();
    }
}
__device__ __forceinline__ const float* res_row(const Cx& p, int layer_src0, int r) {
    if (r < CROWS) return (layer_src0 ? PIN(I_CTX) : (const float*)WSP(float, WS_CTXRES)) + (size_t)r * D;
    return (layer_src0 ? PIN(I_X) : (const float*)p.out) + (size_t)(r - CROWS) * D;
}
__device__ __forceinline__ int row_sel(int r) { return r < CROWS ? 4 : (r - CROWS) >> 13; }

__device__ __forceinline__ void norm_row(const float* src, const int* accp, float* wb, int* zacc, const float* g, const float* shift, const float* scale, bf16_t* dst, const bool tolds, LAS bf16_t* ldst, LAS bf16_t* ldlo, int lane) {
    f32x4 v[4]; float ss = 0.f;
#pragma unroll
    for (int i = 0; i < 4; ++i) { v[i] = *(const f32x4*)(src + 256 * i + 4 * lane);
        if (accp) { const int4 a = *(const int4*)(accp + 256 * i + 4 * lane); v[i][0] += (float)a.x * ACC_INV; v[i][1] += (float)a.y * ACC_INV; v[i][2] += (float)a.z * ACC_INV; v[i][3] += (float)a.w * ACC_INV; }
        if (wb) *(f32x4*)(wb + 256 * i + 4 * lane) = v[i];
        if (zacc) *(int4*)(zacc + 256 * i + 4 * lane) = make_int4(0, 0, 0, 0);
        ss += v[i][0] * v[i][0] + v[i][1] * v[i][1] + v[i][2] * v[i][2] + v[i][3] * v[i][3]; }
    ss = wsum(ss); const float rstd = rsqrtf(ss * (1.0f / D) + 1e-6f);
#pragma unroll
    for (int i = 0; i < 4; ++i) { const int col = 256 * i + 4 * lane; const f32x4 gv = *(const f32x4*)(g + col), sh = *(const f32x4*)(shift + col), sc = *(const f32x4*)(scale + col);
        const f32x4 y = v[i] * rstd * gv * (sc + 1.0f) + sh; u32x2 w; w.x = pk2(y[0], y[1]); w.y = pk2(y[2], y[3]);
        *(u32x2*)(dst + col) = w;
        if (tolds) { *(LAS u32x2*)(ldst + col) = w; u32x2 wl;
            wl.x = pk2(y[0] - __uint_as_float(w.x << 16), y[1] - __uint_as_float(w.x & 0xffff0000u)); wl.y = pk2(y[2] - __uint_as_float(w.y << 16), y[3] - __uint_as_float(w.y & 0xffff0000u));
            *(LAS u32x2*)(ldlo + col) = wl; } }
}
__device__ __forceinline__ void phase_norm1(const Cx& p, int layer) {
    const int lane = p.tid & 63, wave = p.tid >> 6;
    const float* mod = WSP(float, WS_MOD) + (size_t)layer * 5 * 6144; const float* g = PIN(I_N1G) + layer * D; bf16_t* hb = WSP(bf16_t, WS_HBUF);
    for (int r = p.bid * 8 + wave; r < ROWS; r += p.G * 8) { const int sel = row_sel(r);
        const float* src = res_row(p, layer == 0, r);
        norm_row(src, layer == 0 ? (const int*)0 : WSP(int, WS_ACC) + (size_t)r * D, layer == 0 ? (float*)0 : (float*)src, (int*)0, g, mod + sel * 6144 + 0, mod + sel * 6144 + 1024, hb + (size_t)r * D, false, (LAS bf16_t*)0, (LAS bf16_t*)0, lane); }
}
__device__ __forceinline__ float conv_at(const Cx& p, const bf16_t* proj, int b, int s, int col, const float* cw  ) {
    float acc = 0.f;
    if (s < NCTX) {
#pragma unroll
        for (int dx = -1; dx <= 1; ++dx) { const int s2 = s + dx; if (s2 >= 0 && s2 < NCTX) acc += cw[(3 + dx + 1) * 768] * bf2f(proj[(size_t)(b * NCTX + s2) * NPROJ + col]); }
    } else { const int t = s - NCTX, r = t >> 6, c = t & 63;
#pragma unroll
        for (int dy = -1; dy <= 1; ++dy)
#pragma unroll
            for (int dx = -1; dx <= 1; ++dx) { const int r2 = r + dy, c2 = c + dx;
                if (r2 >= 0 && r2 < GRIDH && c2 >= 0 && c2 < GRIDW) acc += cw[((dy + 1) * 3 + dx + 1) * 768] * bf2f(proj[(size_t)(CROWS + b * SEQ + r2 * 64 + c2) * NPROJ + col]); }
    }
    return acc;
}
__device__ __forceinline__ void phase_prep(const Cx& p, LAS unsigned char* lds, int layer, int b) {
    const int lane = p.tid & 63, wave = __builtin_amdgcn_readfirstlane(p.tid >> 6);
    const bf16_t* proj = WSP(bf16_t, WS_PROJ);
    if (p.bid < SB / 32) {
        LAS float* wl = (LAS float*)lds;
        { const float* AW = PIN(I_RW_AW2) + (size_t)layer * 32 * 256; const float* WW = PIN(I_RW_W2) + (size_t)layer * 2 * 32 * 256;
          for (int i = p.tid; i < 96 * 256; i += NTHR) wl[i] = i < 32 * 256 ? AW[i] : WW[i - 32 * 256]; }
        __syncthreads();
        const int h = wave & 3, half = wave >> 2, c = 64 * h + lane;
        const float a0 = PIN(I_RW_A0)[layer * 256 + c], w0f = PIN(I_RW_W0)[(layer * 2 + 0) * 256 + c], w0b = PIN(I_RW_W0)[(layer * 2 + 1) * 256 + c];
        const float kkm = PIN(I_RW_KK)[layer * 256 + c], kam = PIN(I_RW_KA)[layer * 256 + c];
        for (int u = p.bid; u < SB / 32; u += p.G) {
#pragma unroll 1
            for (int i = 0; i < 16; ++i) { const int s = u * 32 + half * 16 + i; const bf16_t* pr = proj + (size_t)tok_row(b, s) * NPROJ;
                float xa = 0.f, xf = 0.f, xb = 0.f;
                if (lane < 32) { xa = bf2f(pr[PB_A + lane]); xf = tanhf(bf2f(pr[PB_WF + lane])); xb = tanhf(bf2f(pr[PB_WB + lane])); }
                const float kv = bf2f(pr[PB_K + c]);
                float sa = a0, sf = w0f, sb = w0b;
#pragma unroll 8
                for (int j = 0; j < 32; ++j) { sa += rl(xa, j) * wl[j * 256 + c]; sf += rl(xf, j) * wl[(32 + j) * 256 + c]; sb += rl(xb, j) * wl[(64 + j) * 256 + c]; }
                const float a = sigmoidf_(sa);
                const float lwf = -__expf(-softplusf_(-sf) - 0.5f), lwb = -__expf(-softplusf_(-sb) - 0.5f);
                const float kr = kv * kkm; const float ss = wsum(kr * kr); const float kk = kr * rsqrtf(ss + 1e-6f);
                const size_t o = (size_t)s * 256 + c;
                WSP(float, SC_RK)[o] = kv * (1.0f + (a - 1.0f) * kam); WSP(float, SC_RKK)[o] = kk; WSP(float, SC_RB)[o] = kk * a;
                WSP(float, SC_RLW)[o] = lwf; WSP(float, SC_RLW)[(size_t)SB * 256 + o] = lwb; }
        }
    }
    for (int u = p.bid; u < SB / 8; u += p.G) {
        for (int task = wave; task < 8 * 25; task += 8) { const int s = u * 8 + task / 25, grp = task % 25;
            if (grp < 12) { const int j = 64 * grp + lane;
                const float v = conv_at(p, proj, b, s, PC_X + j, PIN(I_SS_CW) + (size_t)layer * 9 * 768 + j) + PIN(I_SS_CB)[layer * 768 + j];
                WSP(bf16_t, SC_SX)[(size_t)s * 768 + j] = (bf16_t)f2bf(siluf_(v)); }
            else if (grp < 24) { const int g2 = grp - 12, j = 64 * g2 + lane;
                float y = siluf_(conv_at(p, proj, b, s, PD_Q + j, PIN(I_DN_CW) + (size_t)layer * 9 * 768 + j));
                if (g2 < 8) { const float ss = wsum(y * y); y *= rsqrtf(ss + 1e-6f); if (g2 < 4) y *= 0.125f; }
                WSP(bf16_t, SC_DQ)[(size_t)s * 768 + j] = (bf16_t)f2bf(y); }
            else { const bf16_t* pr = proj + (size_t)tok_row(b, s) * NPROJ;
                if (lane < 8) { const int d = lane >> 2, h = lane & 3; WSP(float, SC_SDT)[(size_t)s * 8 + lane] = softplusf_(bf2f(pr[PC_DF + lane]) + PIN(I_SS_DTB)[(layer * 2 + d) * 4 + h]); }
                else if (lane < 16) { const int q = lane - 8; WSP(float, SC_DG)[(size_t)s * 16 + q] = sigmoidf_(bf2f(pr[PD_BF + q])); }
                else if (lane < 24) { const int q = lane - 16, d = q >> 2, h = q & 3;
                    WSP(float, SC_DG)[(size_t)s * 16 + 8 + q] = -__expf(PIN(I_DN_ALOG)[(layer * 2 + d) * 4 + h]) * softplusf_(bf2f(pr[PD_AF + q]) + PIN(I_DN_DTB)[(layer * 2 + d) * 4 + h]); } }
        }
    }
}
__device__ __forceinline__ void scan_gla(const Cx& p, int layer, int b, int h, int d, int lane) {
    const bf16_t* proj = WSP(bf16_t, WS_PROJ); float* ob = WSP(float, d ? SC_OB : SC_OF); const int c = 64 * h + lane;
    float w2[16];
#pragma unroll
    for (int r = 0; r < 16; ++r) w2[r] = PIN(I_GLA_W2)[((size_t)(layer * 2 + d) * 16 + r) * 256 + c];
    const float gb = PIN(I_GLA_B)[(layer * 2 + d) * 256 + c];
    float S[64];
#pragma unroll
    for (int k = 0; k < 64; ++k) S[k] = 0.f;
    for (int i = 0; i < SB; ++i) { const int s = seq_tok(i, d); const bf16_t* pr = proj + (size_t)tok_row(b, s) * NPROJ;
        const float q = bf2f(pr[PA_Q + c]) * 0.125f, kv = bf2f(pr[PA_K + c]), vv = bf2f(pr[PA_V + c]);
        const float gl = lane < 16 ? bf2f(pr[(d ? PA_GB : PA_GF) + lane]) : 0.f;
        float z = gb;
#pragma unroll
        for (int r = 0; r < 16; ++r) z += rl(gl, r) * w2[r];
        const float dec = __expf(logsigmoidf_(z) * (1.0f / 16.0f));
        float o = 0.f;
#pragma unroll
        for (int k = 0; k < 64; ++k) { S[k] = S[k] * rl(dec, k) + rl(kv, k) * vv; o += rl(q, k) * S[k]; }
        ob[(size_t)s * 1024 + c] = o; }
}
__device__ __forceinline__ void scan_rwkv(const Cx& p, int layer, int b, int h, int d, int lane) {
    const bf16_t* proj = WSP(bf16_t, WS_PROJ); float* ob = WSP(float, d ? SC_OB : SC_OF); const int c = 64 * h + lane;
    const float* lwp = WSP(float, SC_RLW) + (size_t)d * SB * 256;
    float S[64];
#pragma unroll
    for (int k = 0; k < 64; ++k) S[k] = 0.f;
    for (int i = 0; i < SB; ++i) { const int s = seq_tok(i, d); const bf16_t* pr = proj + (size_t)tok_row(b, s) * NPROJ; const size_t o = (size_t)s * 256 + c;
        const float r = bf2f(pr[PB_R + c]), vv = bf2f(pr[PB_V + c]);
        const float kp = WSP(float, SC_RK)[o], z = -WSP(float, SC_RKK)[o], bb = WSP(float, SC_RB)[o], w = __expf(lwp[o]);
        float sz = 0.f;
#pragma unroll
        for (int k = 0; k < 64; ++k) sz += S[k] * rl(z, k);
        float y = 0.f;
#pragma unroll
        for (int k = 0; k < 64; ++k) { S[k] = S[k] * rl(w, k) + sz * rl(bb, k) + vv * rl(kp, k); y += S[k] * rl(r, k); }
        ob[(size_t)s * 1024 + 256 + c] = y; }
}
__device__ __forceinline__ void scan_ssd(const Cx& p, int layer, int b, int h, int d, int lane) {
    float* ob = WSP(float, d ? SC_OB : SC_OF); const int g = h >> 1;
    const float aneg = -__expf(PIN(I_SS_ALOG)[(layer * 2 + d) * 4 + h]);
    float S[128];
#pragma unroll
    for (int k = 0; k < 128; ++k) S[k] = 0.f;
    for (int i = 0; i < SB; ++i) { const int s = seq_tok(i, d); const bf16_t* sx = WSP(bf16_t, SC_SX) + (size_t)s * 768;
        const float dt = WSP(float, SC_SDT)[(size_t)s * 8 + d * 4 + h]; const float x = bf2f(sx[64 * h + lane]) * dt, dA = __expf(aneg * dt);
        const float B0 = bf2f(sx[256 + 128 * g + lane]), B1 = bf2f(sx[256 + 128 * g + 64 + lane]), C0 = bf2f(sx[512 + 128 * g + lane]), C1 = bf2f(sx[512 + 128 * g + 64 + lane]);
        float y = 0.f;
#pragma unroll
        for (int n = 0; n < 64; ++n) { S[n] = S[n] * dA + x * rl(B0, n); y += rl(C0, n) * S[n]; }
#pragma unroll
        for (int n = 0; n < 64; ++n) { S[64 + n] = S[64 + n] * dA + x * rl(B1, n); y += rl(C1, n) * S[64 + n]; }
        ob[(size_t)s * 1024 + 512 + 64 * h + lane] = y; }
}
__device__ __forceinline__ void scan_gdn(const Cx& p, int layer, int b, int h, int d, int lane) {
    float* ob = WSP(float, d ? SC_OB : SC_OF); const int c = 64 * h + lane;
    float S[64];
#pragma unroll
    for (int k = 0; k < 64; ++k) S[k] = 0.f;
    for (int i = 0; i < SB; ++i) { const int s = seq_tok(i, d); const bf16_t* dq = WSP(bf16_t, SC_DQ) + (size_t)s * 768;
        const float q = bf2f(dq[c]), kv = bf2f(dq[256 + c]), vv = bf2f(dq[512 + c]);
        const float beta = WSP(float, SC_DG)[(size_t)s * 16 + d * 4 + h], eg = __expf(WSP(float, SC_DG)[(size_t)s * 16 + 8 + d * 4 + h]);
        float ks = 0.f;
#pragma unroll
        for (int k = 0; k < 64; ++k) { S[k] *= eg; ks += rl(kv, k) * S[k]; }
        const float vn = beta * (vv - ks);
        float o = 0.f;
#pragma unroll
        for (int k = 0; k < 64; ++k) { S[k] += rl(kv, k) * vn; o += rl(q, k) * S[k]; }
        ob[(size_t)s * 1024 + 768 + c] = o; }
}
__device__ __forceinline__ void phase_scan(const Cx& p, int layer, int b) {
    if (p.tid >= 64) return;
    const int lane = p.tid;
    for (int ch = p.bid; ch < 32; ch += p.G) { const int mixer = ch >> 3, h = (ch >> 1) & 3, d = ch & 1;
        if (mixer == 0) scan_gla(p, layer, b, h, d, lane);
        else if (mixer == 1) scan_rwkv(p, layer, b, h, d, lane);
        else if (mixer == 2) scan_ssd(p, layer, b, h, d, lane);
        else scan_gdn(p, layer, b, h, d, lane); }
}
__device__ __forceinline__ void phase_post(const Cx& p, int layer, int b) {
    const int lane = p.tid & 63, wave = __builtin_amdgcn_readfirstlane(p.tid >> 6);
    const bf16_t* proj = WSP(bf16_t, WS_PROJ); const float* of = WSP(float, SC_OF); const float* obk = WSP(float, SC_OB); bf16_t* yc = WSP(bf16_t, WS_HBUF);
    float gw[64]; bool loaded = false;
    for (int u = p.bid; u < SB / 8; u += p.G) {
        if (wave >= 4 && !loaded) { loaded = true; const int c = 64 * (wave - 4) + lane;
#pragma unroll
            for (int j = 0; j < 64; ++j) gw[j] = PIN(I_RW_GW2)[((size_t)layer * 64 + j) * 256 + c]; }
        for (int i = 0; i < 8; ++i) { const int s = u * 8 + i, row = tok_row(b, s); const bf16_t* pr = proj + (size_t)row * NPROJ; bf16_t* yr = yc + (size_t)row * D;
            const float* o1 = of + (size_t)s * 1024; const float* o2 = obk + (size_t)s * 1024;
            const float mf = (MK_ABL & 128) ? 0.f : 1.f, mb = (MK_ABL & 64) ? 0.f : 1.f;
            if (wave < 4) { const int h = wave, c = 64 * h + lane;
                { const float o = mf * o1[c] + mb * o2[c]; const float ms = wsum(o * o) * (1.0f / 64.0f);
                  const float y = o * rsqrtf(ms + 1e-6f) * PIN(I_GLA_NG)[layer * 256 + c] * siluf_(bf2f(pr[PA_G + c])); yr[c] = (bf16_t)f2bf((MK_ABL & 4) ? 0.f : y); }
                if (wave < 2) { float y[2];
#pragma unroll
                    for (int q = 0; q < 2; ++q) { const int cc = 128 * wave + 64 * q + lane, hh = cc >> 6;
                        const float xs = bf2f(WSP(bf16_t, SC_SX)[(size_t)s * 768 + cc]);
                        y[q] = (mf * o1[512 + cc] + mb * o2[512 + cc] + PIN(I_SS_D)[layer * 4 + hh] * xs) * siluf_(bf2f(pr[PC_Z + cc])); }
                    const float ms = wsum(y[0] * y[0] + y[1] * y[1]) * (1.0f / 128.0f); const float rs = rsqrtf(ms + 1e-6f);
#pragma unroll
                    for (int q = 0; q < 2; ++q) { const int cc = 128 * wave + 64 * q + lane; yr[512 + cc] = (bf16_t)f2bf((MK_ABL & 16) ? 0.f : y[q] * rs * PIN(I_SS_NG)[layer * 256 + cc]); } }
            } else { const int h = wave - 4, c = 64 * h + lane;
                { const float o = mf * o1[256 + c] + mb * o2[256 + c]; const float mu = wsum(o) * (1.0f / 64.0f); const float dlt = o - mu; const float var = wsum(dlt * dlt) * (1.0f / 64.0f);
                  float y = dlt * rsqrtf(var + 64e-5f) * PIN(I_RW_LNG)[layer * 256 + c] + PIN(I_RW_LNB)[layer * 256 + c];
                  const float r = bf2f(pr[PB_R + c]), kp = WSP(float, SC_RK)[(size_t)s * 256 + c], vv = bf2f(pr[PB_V + c]);
                  const float bonus = wsum(r * kp * PIN(I_RW_RK)[layer * 256 + c]) * vv;
                  const float sg = sigmoidf_(bf2f(pr[PB_G + lane])); float gate = 0.f;
#pragma unroll
                  for (int j = 0; j < 64; ++j) gate += rl(sg, j) * gw[j];
                  yr[256 + c] = (bf16_t)f2bf((MK_ABL & 8) ? 0.f : (y + bonus) * gate); }
                { const float o = mf * o1[768 + c] + mb * o2[768 + c]; const float ms = wsum(o * o) * (1.0f / 64.0f);
                  const float y = o * rsqrtf(ms + 1e-6f) * PIN(I_DN_NG)[layer * 256 + c] * siluf_(bf2f(pr[PD_Z + c])); yr[768 + c] = (bf16_t)f2bf((MK_ABL & 32) ? 0.f : y); }
            }
        }
    }
}
constexpr int N2_TILE = 32, N2_STRIDE = 2064;
__device__ __forceinline__ void phase_norm2(const Cx& p, LAS unsigned char* lds, int layer, int row_lo) {
    const int tid = p.tid, lane = tid & 63, wave = __builtin_amdgcn_readfirstlane(tid >> 6), fr = lane & 15, fq = lane >> 4;
    const float* mod = WSP(float, WS_MOD) + (size_t)layer * 5 * 6144; const float* g = PIN(I_N2G) + layer * D; bf16_t* hb = WSP(bf16_t, WS_HBUF);
    const bf16_t* rt = WSP(bf16_t, WS_ROUT) + (size_t)layer * 2 * NE * D;
    LAS float* lg = (LAS float*)(lds + 2 * N2_TILE * N2_STRIDE);
    unsigned* cnt = WSP(unsigned, WS_CTL) + CW_CNT + layer * 80 * 16; int* ltok = WSP(int, WS_LTOK); float* lw = WSP(float, WS_LW);
    const float rbias = PIN(I_ROUT_B)[layer * NE + lane];
    const int nun = (ROWS - row_lo) / N2_TILE;
    for (int u = p.bid; u < nun; u += p.G) { const int r0 = row_lo + u * N2_TILE;
#pragma unroll 1
        for (int i = 0; i < 4; ++i) { const int tr = 4 * wave + i, r = r0 + tr, sel = row_sel(r);
            norm_row(res_row(p, 0, r), (const int*)0, (float*)0, WSP(int, WS_ACC) + (size_t)r * D, g, mod + sel * 6144 + 3072, mod + sel * 6144 + 4096, hb + (size_t)r * D, true, (LAS bf16_t*)(lds + tr * N2_STRIDE), (LAS bf16_t*)(lds + N2_TILE * N2_STRIDE + tr * N2_STRIDE), lane); }
        __syncthreads();
        { const int mt = wave >> 2, nt = wave & 3; f32x4 acc = (f32x4){0.f, 0.f, 0.f, 0.f};
          const LAS unsigned char* ap = lds + (16 * mt + fr) * N2_STRIDE + fq * 16; const bf16_t* bp = rt + (size_t)(16 * nt + fr) * D + fq * 8;
#pragma unroll 4
          for (int ks = 0; ks < 32; ++ks) { const bf16x8 a = *(const LAS bf16x8*)(ap + ks * 64), al = *(const LAS bf16x8*)(ap + N2_TILE * N2_STRIDE + ks * 64);
              const bf16x8 bb = *(const bf16x8*)(bp + ks * 32), bl = *(const bf16x8*)(bp + NE * D + ks * 32);
              acc = __builtin_amdgcn_mfma_f32_16x16x32_bf16(a, bb, acc, 0, 0, 0); acc = __builtin_amdgcn_mfma_f32_16x16x32_bf16(al, bb, acc, 0, 0, 0); acc = __builtin_amdgcn_mfma_f32_16x16x32_bf16(a, bl, acc, 0, 0, 0); }
#pragma unroll
          for (int j = 0; j < 4; ++j) lg[(16 * mt + 4 * fq + j) * 64 + 16 * nt + fr] = acc[j]; }
        __syncthreads();
#pragma unroll 1
        for (int i = 0; i < 4; ++i) { const int tr = 4 * wave + i, r = r0 + tr;
            const float sc = sigmoidf_(lg[tr * 64 + lane]); float sel = sc + rbias; float ssum = 0.f; int myE = 0; float myS = 0.f;
#pragma unroll 1
            for (int k = 0; k < TOPK; ++k) { float bv = sel; int bi = lane;
#pragma unroll
                for (int o = 32; o >= 1; o >>= 1) { const float ov = __shfl_xor(bv, o); const int oi = __shfl_xor(bi, o); if (ov > bv || (ov == bv && oi < bi)) { bv = ov; bi = oi; } }
                const int e = __builtin_amdgcn_readfirstlane(bi); const float se = rl(sc, e);
                ssum += se; if (lane == k) { myE = e; myS = se; } if (lane == e) sel = -1e30f; }
            if (lane < TOPK) { const unsigned pos = atomicAdd(cnt + myE * 16, 1u); ltok[(size_t)myE * ROWS + pos] = r; lw[(size_t)myE * ROWS + pos] = myS / ssum * 2.5f; } }
        __syncthreads();
    }
}
__device__ __forceinline__ void moe_table(const Cx& p, LAS int* tb, int layer, int row_lo) {
    const unsigned* cnt = WSP(unsigned, WS_CTL) + CW_CNT + layer * 80 * 16;
    if (p.tid == 0) { int acc = 0;
#pragma unroll 1
        for (int e = 0; e < NE1; ++e) { const int c = e < NE ? (int)__hip_atomic_load(cnt + e * 16, __ATOMIC_RELAXED, __HIP_MEMORY_SCOPE_AGENT) : ROWS - row_lo; tb[e] = c; tb[128 + e] = acc; acc += (c + 255) >> 8; }
        tb[128 + NE1] = acc; }
    __syncthreads();
}
__device__ __forceinline__ void phase_final(const Cx& p) {
    const int lane = p.tid & 63, wave = p.tid >> 6; const float* g = PIN(I_FNG);
    for (int r = p.bid * 8 + wave; r < NB * SEQ; r += p.G * 8) { float* x = p.out + (size_t)r * D;
        f32x4 v[4]; float ss = 0.f;
#pragma unroll
        for (int i = 0; i < 4; ++i) { v[i] = *(const f32x4*)(x + 256 * i + 4 * lane); const int4 a = *(const int4*)(WSP(int, WS_ACC) + (size_t)(CROWS + r) * D + 256 * i + 4 * lane);
            v[i][0] += (float)a.x * ACC_INV; v[i][1] += (float)a.y * ACC_INV; v[i][2] += (float)a.z * ACC_INV; v[i][3] += (float)a.w * ACC_INV;
            ss += v[i][0] * v[i][0] + v[i][1] * v[i][1] + v[i][2] * v[i][2] + v[i][3] * v[i][3]; }
        ss = wsum(ss); const float rstd = rsqrtf(ss * (1.0f / D) + 1e-6f);
#pragma unroll
        for (int i = 0; i < 4; ++i) *(f32x4*)(x + 256 * i + 4 * lane) = v[i] * rstd * *(const f32x4*)(g + 256 * i + 4 * lane); }
}
#ifndef MK_NAIVE
#define MK_NAIVE 0
#endif
__device__ __forceinline__ float dot_bf16(const bf16_t* a, const bf16_t* b, int K) {
    float s = 0.f;
    for (int k = 0; k < K; k += 8) { const u32x4 av = *(const u32x4*)(a + k), bv = *(const u32x4*)(b + k);
#pragma unroll
        for (int j = 0; j < 4; ++j) { s += __uint_as_float(av[j] << 16) * __uint_as_float(bv[j] << 16); s += __uint_as_float(av[j] & 0xffff0000u) * __uint_as_float(bv[j] & 0xffff0000u); } }
    return s;
}
__device__ __forceinline__ void naive_proj(const Cx& p, int layer) {
    const bf16_t* A = WSP(bf16_t, WS_HBUF); const bf16_t* Bt = WSP(bf16_t, WS_WIN) + (size_t)layer * NPROJ * D; bf16_t* O = WSP(bf16_t, WS_PROJ);
    for (size_t i = (size_t)p.bid * NTHR + p.tid; i < (size_t)ROWS * NPROJ; i += (size_t)p.G * NTHR) { const int r = (int)(i / NPROJ), c = (int)(i % NPROJ);
        O[i] = (bf16_t)f2bf(dot_bf16(A + (size_t)r * D, Bt + (size_t)c * D, D)); }
}
__device__ __forceinline__ void naive_res(const Cx& p, int layer) {
    const bf16_t* A = WSP(bf16_t, WS_HBUF); const bf16_t* Bt = WSP(bf16_t, WS_WOUT) + (size_t)layer * D * D; const float* gate = WSP(float, WS_MOD) + (size_t)layer * 5 * 6144 + 2048;
    for (size_t i = (size_t)p.bid * NTHR + p.tid; i < (size_t)ROWS * D; i += (size_t)p.G * NTHR) { const int r = (int)(i / D), c = (int)(i % D);
        const float y = dot_bf16(A + (size_t)r * D, Bt + (size_t)c * D, D); const float* src = res_row(p, layer == 0, r); float* dst = (float*)res_row(p, 0, r);
        dst[c] = src[c] + gate[row_sel(r) * 6144 + c] * y; }
}
__device__ __forceinline__ void naive_gu(const Cx& p, LAS int* tb, int layer, int row_lo) {
    const bf16_t* A = WSP(bf16_t, WS_HBUF); bf16_t* H = WSP(bf16_t, WS_H); const int* ltok = WSP(int, WS_LTOK);
    const int ntile = tb[128 + NE1];
    for (size_t i = (size_t)p.bid * NTHR + p.tid; i < (size_t)ntile * 256 * EH; i += (size_t)p.G * NTHR) { const int hr = (int)(i / EH), j = (int)(i % EH), tile = hr >> 8;
        int e = 0; while (e < NE && tb[128 + e + 1] <= tile) ++e;
        const int ri = (tile - tb[128 + e]) * 256 + (hr & 255); const int tok = ri < tb[e] ? (e == NE ? row_lo + ri : ltok[(size_t)e * ROWS + ri]) : row_lo;
        const bf16_t* W = WSP(bf16_t, WS_EXPGU) + (size_t)e * 512 * D; const int rg = (j >> 4) * 32 + (j & 15);
        const float g = dot_bf16(A + (size_t)tok * D, W + (size_t)rg * D, D), up = dot_bf16(A + (size_t)tok * D, W + (size_t)(rg + 16) * D, D);
        H[i] = (bf16_t)f2bf(g / (1.0f + __expf(-g)) * up); }
}
__device__ __forceinline__ void naive_down(const Cx& p, LAS int* tb, int layer, int row_lo) {
    const bf16_t* H = WSP(bf16_t, WS_H); const int* ltok = WSP(int, WS_LTOK); const float* lw = WSP(float, WS_LW); int* accb = WSP(int, WS_ACC);
    const float* gate = WSP(float, WS_MOD) + (size_t)layer * 5 * 6144 + 5120; const int ntile = tb[128 + NE1];
    for (size_t i = (size_t)p.bid * NTHR + p.tid; i < (size_t)ntile * 256 * D; i += (size_t)p.G * NTHR) { const int hr = (int)(i / D), c = (int)(i % D), tile = hr >> 8;
        int e = 0; while (e < NE && tb[128 + e + 1] <= tile) ++e;
        const int ri = (tile - tb[128 + e]) * 256 + (hr & 255); if (ri >= tb[e]) continue;
        const int tok = e == NE ? row_lo + ri : ltok[(size_t)e * ROWS + ri]; const float w = e == NE ? 1.0f : lw[(size_t)e * ROWS + ri];
        const float y = dot_bf16(H + (size_t)hr * EH, WSP(bf16_t, WS_EXPD) + (size_t)e * D * EH + (size_t)c * EH, EH);
        atomicAdd(accb + (size_t)tok * D + c, (int)rintf(y * gate[row_sel(tok) * 6144 + c] * w * ACC_SCALE)); }
}
#ifndef MK_ABL
#define MK_ABL 0
#endif
#ifndef MK_PERT
#define MK_PERT 0
#endif
#ifndef MK_FILL_LO
#define MK_FILL_LO 0
#define MK_FILL_HI 143360
#endif
#ifndef MK_ONE_LAUNCH
#define MK_ONE_LAUNCH 1
#endif
constexpr int N_PHASES = 1 + NL * (2 + 3 * NB + 4) + 1 + ((MK_NAIVE & 64) ? 1 : 0) + ((MK_PERT == 101 || MK_PERT == 102) ? NL : 0);

__global__ void __launch_bounds__(NTHR, 2) mega_fwd(Params pp) {
    extern __shared__ __attribute__((aligned(16))) unsigned char lds_raw[];
    LAS unsigned char* lds = (LAS unsigned char*)lds_raw;
    const int swave = __builtin_amdgcn_readfirstlane(threadIdx.x >> 6);
    for (int i = threadIdx.x; i < (LDS_BYTES - LDS_CTL) / 4; i += NTHR) ((LAS unsigned*)(lds + LDS_CTL))[i] = 0u;
    __syncthreads();
    if (threadIdx.x < N_IN) { const unsigned long long a = (unsigned long long)pp.in[threadIdx.x]; ((LAS unsigned*)(lds + LDS_PTRS))[2 * threadIdx.x] = (unsigned)a; ((LAS unsigned*)(lds + LDS_PTRS))[2 * threadIdx.x + 1] = (unsigned)(a >> 32); }
    __syncthreads();
    XcdBarrier bar = xcd_barrier_post((unsigned*)(pp.ws + WS_CTL) + CW_BAR + pp.li * XCD_BAR_WORDS, (volatile LAS unsigned*)(lds + LDS_CTL), threadIdx.x);
    LAS int* tb = (LAS int*)(lds + LDS_CTL + 64);
    int pc = 0; const int lo = pp.lo, hi = pp.hi;
#define PH_BEGIN if (pc >= lo && pc < hi) { Cx p; p.out = pp.out; p.ws = pp.ws; p.tid = swave * 64 + lane_id_asm(); p.bid = blockIdx.x; p.G = gridDim.x; p.pad = 0; asm volatile("" : "+s"(p.out), "+s"(p.ws), "+v"(p.tid), "+s"(p.bid), "+s"(p.G)); const int G = p.G, bid = p.bid;
#define PH_END if (pc + 1 < hi) { if (MK_PERT == 100) __builtin_amdgcn_fence(__ATOMIC_RELEASE, ""); XcdBarrier b2 = bar; asm volatile("" : "+s"(b2.bar), "+s"(b2.x)); xcd_barrier(b2, (unsigned)(swave * 64 + lane_id_asm())); if (MK_PERT == 100) { __builtin_amdgcn_fence(__ATOMIC_ACQUIRE, ""); asm volatile("s_waitcnt vmcnt(0)" ::: "memory"); __syncthreads(); } if (MK_PERT >= 200 && (MK_PERT == 200 || pc == MK_PERT - 201 || pc == MK_PERT - 201 + 18)) { for (int i_ = MK_FILL_LO / 4 + swave * 64 + lane_id_asm(); i_ < MK_FILL_HI / 4; i_ += NTHR) ((LAS unsigned*)lds)[i_] = 0x7FC07FC0u; __syncthreads(); } } } ++pc;

    PH_BEGIN
        for (int u = bid; u < CONV_A_UNITS; u += G) conv_unit_A(p, (LAS float*)lds, u);
        __syncthreads();
        phase_mod(p, lds);
    PH_END

#pragma unroll 1
    for (int layer = 0; layer < NL; ++layer) {
        const int row_lo = layer == NL - 1 ? CROWS : 0;
        PH_BEGIN
            phase_norm1(p, layer);
            __syncthreads();
            for (int u = bid; u < CONV_E_UNITS; u += G) conv_unit_E(p, (LAS float*)lds, layer, u);
        PH_END
        PH_BEGIN
            DenseSched S; S.init(ROWS, NPROJ, D, WSP(bf16_t, WS_WIN) + (size_t)layer * NPROJ * D, G, bid);
            EpiProj E{WSP(bf16_t, WS_PROJ), NPROJ};
            if (MK_NAIVE & 1) naive_proj(p, layer); else
            pg8::gemm_phase<D>(p.tid, lds, (const char*)WSP(bf16_t, WS_HBUF), S, E);
        PH_END
#pragma unroll 1
        for (int b = 0; b < NB; ++b) {
            PH_BEGIN phase_prep(p, lds, layer, b); PH_END
            PH_BEGIN phase_scan(p, layer, b); PH_END
            PH_BEGIN phase_post(p, layer, b); PH_END
        }
        PH_BEGIN
            DenseSched S; S.init(ROWS, D, D, WSP(bf16_t, WS_WOUT) + (size_t)layer * D * D, G, bid);
            EpiRes E{layer == 0 ? PIN(I_X) : (const float*)p.out, layer == 0 ? PIN(I_CTX) : (const float*)WSP(float, WS_CTXRES), p.out, WSP(float, WS_CTXRES), WSP(float, WS_MOD) + (size_t)layer * 5 * 6144 + 2048};
            if (MK_PERT == 1 + 2 * layer) E.pert = 1e-5f;
            if (MK_NAIVE & 256) { EpiF32T E2{WSP(float, WS_SCR)};
                pg8::gemm_phase<D>(p.tid, lds, (const char*)WSP(bf16_t, WS_HBUF), S, E2);
                { XcdBarrier b3 = bar; asm volatile("" : "+s"(b3.bar), "+s"(b3.x)); xcd_barrier(b3, (unsigned)(swave * 64 + lane_id_asm())); }
                const float* gate2 = WSP(float, WS_MOD) + (size_t)layer * 5 * 6144 + 2048;
                for (size_t i = (size_t)p.bid * NTHR + p.tid; i < (size_t)ROWS * D; i += (size_t)p.G * NTHR) { const int r = (int)(i / D), c = (int)(i % D);
                    const float* src = res_row(p, layer == 0, r); float* dst = (float*)res_row(p, 0, r);
                    dst[c] = src[c] + gate2[row_sel(r) * 6144 + c] * WSP(float, WS_SCR)[i]; }
            } else
            if (MK_NAIVE & 2) naive_res(p, layer); else if (MK_NAIVE & 32) { EpiF32T E2{WSP(float, WS_SCR)};
                pg8::gemm_phase<D>(p.tid, lds, (const char*)WSP(bf16_t, WS_HBUF), S, E2);
                asm volatile("s_waitcnt vmcnt(0)" ::: "memory"); __syncthreads();
                pg8::Unit u2; const float* gate2 = WSP(float, WS_MOD) + (size_t)layer * 5 * 6144 + 2048;
                unsigned bad = 0; float sdiff = 0.f, sref = 0.f;
                for (int it = 0; S.next(it, u2); ++it)
                    for (int e2 = p.tid; e2 < 256 * 256; e2 += NTHR) { const int r = u2.pm * 256 + (e2 >> 8), c = u2.pn * 256 + (e2 & 255);
                        if (MK_NAIVE & 128) { const float yn = dot_bf16(WSP(bf16_t, WS_HBUF) + (size_t)r * D, WSP(bf16_t, WS_WOUT) + (size_t)layer * D * D + (size_t)c * D, D);
                            const float dd = yn - WSP(float, WS_SCR)[(size_t)r * D + c]; sdiff += dd * dd; sref += yn * yn;
                            if (!(fabsf(dd) <= 0.01f)) ++bad; }
                        const float* src = res_row(p, layer == 0, r); float* dst = (float*)res_row(p, 0, r);
                        dst[c] = src[c] + gate2[row_sel(r) * 6144 + c] * WSP(float, WS_SCR)[(size_t)r * D + c]; }
                if ((MK_NAIVE & 128) && bad) atomicAdd(WSP(unsigned, WS_CTL) + 900 + layer, bad);
                if (MK_NAIVE & 128) { sdiff = wsum(sdiff); sref = wsum(sref); if ((p.tid & 63) == 0) { atomicAdd(WSP(float, WS_CTL) + 910 + layer, sdiff); atomicAdd(WSP(float, WS_CTL) + 920 + layer, sref); } }
            } else if (MK_NAIVE & 16) { S.single = 1;
#pragma unroll 1
                for (int rd = 0; rd < 3; ++rd) { S.round = rd; pg8::gemm_phase<D>(p.tid, lds, (const char*)WSP(bf16_t, WS_HBUF), S, E); __syncthreads(); } } else
            pg8::gemm_phase<D>(p.tid, lds, (const char*)WSP(bf16_t, WS_HBUF), S, E);
            if (MK_PERT == 103) { __syncthreads(); for (int i = p.tid; i < 140 * 1024 / 4; i += NTHR) ((LAS unsigned*)lds)[i] = 0u; __syncthreads(); }
        PH_END
#if MK_NAIVE & 64
        if (layer == 0) { PH_BEGIN
            const bf16_t* A = WSP(bf16_t, WS_HBUF); const bf16_t* Bt = WSP(bf16_t, WS_WOUT); const float* gate = WSP(float, WS_MOD) + 2048; unsigned bad = 0;
            for (size_t i = (size_t)p.bid * NTHR + p.tid; i < (size_t)ROWS * D; i += (size_t)p.G * NTHR) { const int r = (int)(i / D), c = (int)(i % D);
                const float y = dot_bf16(A + (size_t)r * D, Bt + (size_t)c * D, D); const float ref = res_row(p, 1, r)[c] + gate[row_sel(r) * 6144 + c] * y;
                const float got = res_row(p, 0, r)[c]; if (!(fabsf(got - ref) <= 0.01f)) ++bad; }
            if (bad) atomicAdd(WSP(unsigned, WS_CTL) + 900, bad);
        PH_END }
#endif
#if MK_PERT == 101 || MK_PERT == 102
        PH_BEGIN
            if (MK_PERT == 101) { const unsigned long long t0 = __builtin_amdgcn_s_memrealtime(); while (__builtin_amdgcn_s_memrealtime() - t0 < 2000000ull) __builtin_amdgcn_s_sleep(32); }
            else { float acc_ = 0.f; const float* wsf = (const float*)p.ws;
                for (int rep = 0; rep < 2; ++rep) for (size_t i = (size_t)p.bid * NTHR + p.tid; i < (size_t)150000000; i += (size_t)p.G * NTHR) acc_ += __builtin_nontemporal_load(wsf + i);
                if (acc_ == 1.2345f) WSP(float, WS_CTL)[950] = acc_; }
        PH_END
#endif
        PH_BEGIN phase_norm2(p, lds, layer, row_lo); PH_END
        PH_BEGIN
            moe_table(p, tb, layer, row_lo);
            MoeSched<true> S{tb + 128, tb, 2, G, bid, D, row_lo, WSP(int, WS_LTOK), (const char*)WSP(bf16_t, WS_EXPGU), (size_t)512 * D * 2};
            EpiGU E{WSP(bf16_t, WS_H)};
            if (MK_NAIVE & 4) naive_gu(p, tb, layer, row_lo); else
            pg8::gemm_phase<D>(p.tid, lds, (const char*)WSP(bf16_t, WS_HBUF), S, E);
        PH_END
        PH_BEGIN
            moe_table(p, tb, layer, row_lo);
            MoeSched<false> S{tb + 128, tb, 4, G, bid, EH, row_lo, WSP(int, WS_LTOK), (const char*)WSP(bf16_t, WS_EXPD), (size_t)D * EH * 2};
            EpiDown E{WSP(int, WS_ACC), WSP(float, WS_MOD) + (size_t)layer * 5 * 6144 + 5120, WSP(int, WS_LTOK), WSP(float, WS_LW), tb, row_lo};
            if (MK_NAIVE & 8) naive_down(p, tb, layer, row_lo); else
            pg8::gemm_phase<EH>(p.tid, lds, (const char*)WSP(bf16_t, WS_H), S, E);
        PH_END
    }
    PH_BEGIN phase_final(p);
#if MK_NAIVE & (64 | 128)
        { __syncthreads(); const unsigned cntb = __hip_atomic_load(WSP(unsigned, WS_CTL) + ((MK_NAIVE & 128) ? 901 : 900), __ATOMIC_RELAXED, __HIP_MEMORY_SCOPE_AGENT); int code = 0; for (unsigned v = cntb; v; v /= 10) ++code;
          if (MK_NAIVE & 128) { const float sd = __uint_as_float(__hip_atomic_load(WSP(unsigned, WS_CTL) + 911, __ATOMIC_RELAXED, __HIP_MEMORY_SCOPE_AGENT)), sr = __uint_as_float(__hip_atomic_load(WSP(unsigned, WS_CTL) + 921, __ATOMIC_RELAXED, __HIP_MEMORY_SCOPE_AGENT));
            const float lg = -log10f(sd / sr + 1e-30f); code = lg < 0.f ? 0 : (lg > 9.f ? 9 : (int)(lg + 0.5f)); }
          const float sc = 1.0f + 0.1f * code; const int lane = p.tid & 63, wave = p.tid >> 6;
          for (int r = p.bid * 8 + wave; r < NB * SEQ; r += p.G * 8) for (int i = 0; i < 16; ++i) p.out[(size_t)r * D + i * 64 + lane] *= sc; }
#endif
    PH_END
#undef PH_BEGIN
#undef PH_END
}

extern "C" void kernel_launch(void* const* d_in, const int* in_sizes, int n_in, void* d_out, int out_size, void* d_ws, size_t ws_size, hipStream_t stream) {
    static int grid = 0;
    if (grid == 0) {
        if (n_in != N_IN || in_sizes[0] != NB * SEQ * D || out_size != NB * SEQ * D || ws_size < WS_END) {
            fprintf(stderr, "kernel_launch: unexpected shapes (n_in %d, in0 %d, out %d, ws %zu); nothing launched\n", n_in, n_in > 0 ? in_sizes[0] : -1, out_size, ws_size); grid = -1; return; }
        int dev = 0, cus = 0, per_cu = 0;
        if (hipGetDevice(&dev) != hipSuccess || hipDeviceGetAttribute(&cus, hipDeviceAttributeMultiprocessorCount, dev) != hipSuccess) { grid = -1; return; }
        if (hipFuncSetAttribute((const void*)mega_fwd, hipFuncAttributeMaxDynamicSharedMemorySize, LDS_BYTES) != hipSuccess) { fprintf(stderr, "kernel_launch: hipFuncSetAttribute failed\n"); grid = -1; return; }
        if (hipOccupancyMaxActiveBlocksPerMultiprocessor(&per_cu, (const void*)mega_fwd, NTHR, LDS_BYTES) != hipSuccess || per_cu < 1) { fprintf(stderr, "kernel_launch: occupancy query says %d\n", per_cu); per_cu = 1; }
        (void)hipGetLastError();
        grid = cus * 1;
    }
    if (grid < 0) return;
    if (hipMemsetAsync((char*)d_ws + WS_CTL, 0, CTL_ZERO_BYTES, stream) != hipSuccess) return;
    Params p{};
    for (int i = 0; i < N_IN; ++i) p.in[i] = (const float*)d_in[i];
    p.out = (float*)d_out; p.ws = (unsigned char*)d_ws; p.pad = 0;
#if MK_ONE_LAUNCH
    p.lo = 0; p.hi = N_PHASES; p.li = 0;
    hipLaunchKernelGGL(mega_fwd, dim3(grid), dim3(NTHR), LDS_BYTES, stream, p);
#else
    for (int k = 0; k < N_PHASES; ++k) { p.lo = k; p.hi = k + 1; p.li = k;
        hipLaunchKernelGGL(mega_fwd, dim3(grid), dim3(NTHR), LDS_BYTES, stream, p); }
#endif
}
```

```cpp
#include <hip/hip_runtime.h>
#ifndef MK_ABL
#define MK_ABL 0
#endif
#include <cstdio>
#include <cstdint>

typedef unsigned short bf16_t;
typedef short bf16x8 __attribute__((ext_vector_type(8)));
typedef float f32x4 __attribute__((ext_vector_type(4)));
typedef float f32x2 __attribute__((ext_vector_type(2)));
typedef unsigned u32x4 __attribute__((ext_vector_type(4)));
typedef unsigned u32x2 __attribute__((ext_vector_type(2)));

constexpr int NB = 4, SEQ = 8192, NCTX = 256, D = 1024, NL = 2;
constexpr int CROWS = NB * NCTX;
constexpr int ROWS = CROWS + NB * SEQ;
constexpr int SB = NCTX + SEQ;
constexpr int INW = 4056, NPROJ = 4096;
constexpr int NE = 64, NE1 = 65, TOPK = 8, EH = 256;
constexpr int GRIDW = 64, GRIDH = SEQ / GRIDW;
constexpr int PA_Q = 0, PA_K = 256, PA_V = 512, PA_G = 768, PA_GF = 1024, PA_GB = 1040;
constexpr int PB_R = 1056, PB_K = 1312, PB_V = 1568, PB_WF = 1824, PB_WB = 1856, PB_A = 1888, PB_G = 1920;
constexpr int PC_Z = 1984, PC_X = 2240, PC_DF = 3008, PC_DB = 3012;
constexpr int PD_Q = 3016, PD_Z = 3784, PD_BF = 4040, PD_BB = 4044, PD_AF = 4048, PD_AB = 4052;
enum { I_X = 0, I_C, I_CTX, I_CCTX, I_N1G, I_N2G, I_WMOD, I_BMOD, I_WIN, I_WOUT, I_GLA_W2, I_GLA_B, I_GLA_NG,
       I_RW_W2, I_RW_W0, I_RW_AW2, I_RW_A0, I_RW_GW2, I_RW_KK, I_RW_KA, I_RW_RK, I_RW_LNG, I_RW_LNB,
       I_SS_CW, I_SS_CB, I_SS_ALOG, I_SS_DTB, I_SS_D, I_SS_NG, I_DN_CW, I_DN_ALOG, I_DN_DTB, I_DN_NG,
       I_ROUT_W, I_ROUT_B, I_EXP_G, I_EXP_U, I_EXP_D, I_SH_G, I_SH_U, I_SH_D, I_FNG, N_IN };
static_assert(N_IN == 42, "input count");

constexpr size_t MiB = 1u << 20;
constexpr size_t WS_CTL = 0, CTL_ZERO_BYTES = 1 * MiB;
constexpr size_t WS_MOD = 1 * MiB;
constexpr size_t WS_WIN = 2 * MiB;
constexpr size_t WS_WOUT = 18 * MiB;
constexpr size_t WS_ROUT = 22 * MiB;
constexpr size_t WS_CTXRES = 23 * MiB;
constexpr size_t WS_EXPGU = 27 * MiB;
constexpr size_t WS_EXPD = 92 * MiB;
constexpr size_t WS_HBUF = 125 * MiB;
constexpr size_t WS_PROJ = 191 * MiB;
constexpr size_t WS_SCR = 455 * MiB;
constexpr size_t WS_END = 640455456;
constexpr int HROWS_MAX = ROWS * 9 + NE1 * 256;
constexpr size_t WS_H = WS_PROJ;
constexpr size_t WS_LTOK = WS_PROJ + 160 * MiB;
constexpr size_t WS_LW = WS_PROJ + 170 * MiB;
static_assert((size_t)HROWS_MAX * 512 <= 160 * MiB && (size_t)NE * ROWS * 4 <= 10 * MiB && WS_LW + 10 * MiB <= WS_SCR, "moe overlay");
constexpr size_t WS_ACC = WS_SCR;
constexpr float ACC_SCALE = 1048576.0f, ACC_INV = 1.0f / 1048576.0f;
static_assert(WS_ACC + (size_t)ROWS * D * 4 <= WS_END, "acc fits");
constexpr size_t SC_OF = WS_SCR;
constexpr size_t SC_OB = SC_OF + (size_t)SB * 1024 * 2;
constexpr size_t SC_RK = SC_OB + (size_t)SB * 1024 * 2;
constexpr size_t SC_RKK = SC_RK + (size_t)SB * 256 * 4;
constexpr size_t SC_RB = SC_RKK + (size_t)SB * 256 * 4;
constexpr size_t SC_RLW = SC_RB + (size_t)SB * 256 * 4;
constexpr size_t SC_SX = SC_RLW + (size_t)2 * SB * 256 * 4;
constexpr size_t SC_DQ = SC_SX + (size_t)SB * 768 * 2;
constexpr size_t SC_SDT = SC_DQ + (size_t)SB * 768 * 2;
constexpr size_t SC_DG = SC_SDT + (size_t)SB * 8 * 4;
constexpr size_t SC_FEND = SC_DG + (size_t)SB * 16 * 4;
constexpr int NTB = SB / 64, NUNIT = NTB * 4 * 2;
constexpr size_t SC_RW_M = SC_FEND;
constexpr size_t SC_RW_NS = SC_RW_M + (size_t)(SB / 64 * 8) * 4096 * 2;
constexpr size_t SC_RW_WU = SC_RW_NS + (size_t)(SB / 64 * 8) * 4096 * 2;
constexpr size_t SC_END = SC_RW_WU + (size_t)(SB / 64 * 8) * 8192 * 2;
constexpr size_t SC2 = WS_EXPGU;
constexpr size_t SC_GLA_S = SC2;
constexpr size_t SC_GLA_DEC = SC_GLA_S + (size_t)NUNIT * 4096 * 4;
constexpr size_t SC_SSD_S = SC_GLA_DEC + (size_t)NUNIT * 64 * 4;
constexpr size_t SC_SSD_CD = SC_SSD_S + (size_t)NUNIT * 8192 * 4;
constexpr size_t SC_DR_M = SC_SSD_CD + (size_t)NUNIT * 4 + 4096;
constexpr size_t SC_DR_NS = SC_DR_M + (size_t)NUNIT * 4096 * 2;
constexpr size_t SC_DR_WU = SC_DR_NS + (size_t)NUNIT * 4096 * 2;
constexpr size_t SC2_END = SC_DR_WU + (size_t)NUNIT * 8192 * 2;
static_assert(SC2_END <= WS_HBUF, "chunk slots fit in the expert-weight region");
static_assert(SC_END <= WS_END, "scratch fits");
constexpr int CW_CNT = 1024;
constexpr int CW_BAR = 4096;

#define LAS __attribute__((address_space(3)))
constexpr int NTHR = 512;
constexpr int LDS_BYTES = 147456;
constexpr int LDS_CTL = 143360;
constexpr int LDS_PTRS = LDS_CTL + 2048;

__device__ __forceinline__ int lane_id_asm() { int l; asm volatile("v_mbcnt_lo_u32_b32 %0, -1, 0\n\tv_mbcnt_hi_u32_b32 %0, -1, %0" : "=v"(l)); return l; }
__device__ __forceinline__ float bf2f(bf16_t b) { return __uint_as_float(((unsigned)b) << 16); }
__device__ __forceinline__ unsigned f2bf(float f) { unsigned u = __float_as_uint(f); u += 0x7FFFu + ((u >> 16) & 1u); return u >> 16; }
__device__ __forceinline__ unsigned pk2(float lo, float hi) { return f2bf(lo) | (f2bf(hi) << 16); }
__device__ __forceinline__ float rl(float x, int k) { return __uint_as_float(__builtin_amdgcn_readlane(__float_as_uint(x), k)); }
__device__ __forceinline__ float wsum(float v) { v += __shfl_xor(v, 32); v += __shfl_xor(v, 16); v += __shfl_xor(v, 8); v += __shfl_xor(v, 4); v += __shfl_xor(v, 2); v += __shfl_xor(v, 1); return v; }
__device__ __forceinline__ float sigmoidf_(float x) { return 1.0f / (1.0f + __expf(-x)); }
__device__ __forceinline__ float siluf_(float x) { return x / (1.0f + __expf(-x)); }
__device__ __forceinline__ float softplusf_(float x) { return x > 20.f ? x : log1pf(__expf(x)); }
__device__ __forceinline__ float logsigmoidf_(float x) { return fminf(x, 0.f) - log1pf(__expf(-fabsf(x))); }
__device__ __forceinline__ int seq_tok(int i, int d) { return d == 0 ? i : (i < NCTX ? NCTX - 1 - i : SB + NCTX - 1 - i); }
__device__ __forceinline__ int tok_row(int b, int s) { return s < NCTX ? b * NCTX + s : CROWS + b * SEQ + (s - NCTX); }

struct Params { const float* in[N_IN]; float* out; unsigned char* ws; int lo, hi, li, pad; };
struct Cx { float* out; unsigned char* ws; int tid, bid, G, pad; };
__device__ __forceinline__ const float* PIN(int i) {
    extern __shared__ __attribute__((aligned(16))) unsigned char lds_raw_[];
    int off = __builtin_amdgcn_readfirstlane(LDS_PTRS + 8 * i); asm volatile("" : "+s"(off));
    const LAS unsigned* t = (const LAS unsigned*)((LAS unsigned char*)lds_raw_ + off);
    const unsigned lo = __builtin_amdgcn_readfirstlane(t[0]), hi = __builtin_amdgcn_readfirstlane(t[1]);
    return (const float*)(((unsigned long long)hi << 32) | lo);
}
#define XB_TMO      128
#define XB_XCNT(j)  (256  + 64 * (j))
#define XB_XSUB(j)  (1280 + 64 * (j))
#define XB_XGEN(j)  (2304 + 64 * (j))
#define XB_TOP      3328
#define XB_TOPGEN   3392
#define XCD_BAR_WORDS 3456
#define XB_SPIN_CAP (1u << 18)

__device__ __forceinline__ unsigned xb_ld(unsigned* p)              { return __hip_atomic_load(p, __ATOMIC_RELAXED, __HIP_MEMORY_SCOPE_AGENT); }
__device__ __forceinline__ unsigned xb_add(unsigned* p, unsigned v) { return __hip_atomic_fetch_add(p, v, __ATOMIC_RELAXED, __HIP_MEMORY_SCOPE_AGENT); }
__device__ __forceinline__ unsigned xb_xcc_id() { return (unsigned)__builtin_amdgcn_s_getreg((3 << 11) | 20) & 0xFu; }
#define XB_SPIN(cond, bar) do { unsigned _sp = 0; while (cond) { __builtin_amdgcn_s_sleep(1); \
    if ((++_sp & 255u) == 0u) { if (xb_ld(&(bar)[XB_TMO])) break; if (_sp > XB_SPIN_CAP) { atomicAdd(&(bar)[XB_TMO], 1u); break; } } } } while (0)

struct XcdBarrier {
    unsigned* bar; unsigned x;
    volatile LAS unsigned* st;
};

__device__ __forceinline__ XcdBarrier xcd_barrier_post(unsigned* bar, volatile LAS unsigned* st, const unsigned xb_tid) {
    XcdBarrier b; b.bar = bar; b.x = xb_xcc_id(); b.st = st;
    if (xb_tid == 0) (void)xb_add(&bar[XB_XCNT(b.x)], 1u);
    return b;
}
__device__ __forceinline__ void xcd_barrier_complete(unsigned* bar, unsigned x, unsigned& nloc, unsigned& nx) {
    const unsigned G = gridDim.x * gridDim.y * gridDim.z;
    unsigned sum, cnt, mine, sp = 0u;
    for (;;) {
        sum = 0u; cnt = 0u; mine = 0u;
#pragma unroll
        for (unsigned j = 0; j < 16; ++j) { const unsigned c = xb_ld(&bar[XB_XCNT(j)]); sum += c; cnt += (c > 0u) ? 1u : 0u; mine = (j == x) ? c : mine; }
        if (sum == G) break;
        __builtin_amdgcn_s_sleep(1);
        if ((++sp & 255u) == 0u) { if (xb_ld(&bar[XB_TMO])) break; if (sp > XB_SPIN_CAP) { atomicAdd(&bar[XB_TMO], 1u); break; } }
    }
    nloc = mine > 0u ? mine : 1u; nx = cnt > 0u ? cnt : 1u;
}

__device__ __forceinline__ void xcd_barrier(const XcdBarrier& b, const unsigned xb_tid) {
    asm volatile("s_waitcnt vmcnt(0)" ::: "memory");
    __syncthreads();
    if (xb_tid == 0) {
        unsigned* bar = b.bar;
        __builtin_amdgcn_s_waitcnt(0);
        unsigned nloc = b.st[0], nx = b.st[1];
        if (nloc == 0u) { xcd_barrier_complete(bar, b.x, nloc, nx); b.st[0] = nloc; b.st[1] = nx; }
        const unsigned old = xb_add(&bar[XB_XSUB(b.x)], 1u);
        const unsigned gen = old / nloc;
        if (old + 1u == (gen + 1u) * nloc) {
            __builtin_amdgcn_fence(__ATOMIC_RELEASE, "agent");
            asm volatile("s_waitcnt vmcnt(0)" ::: "memory");
            const unsigned og = xb_add(&bar[XB_TOP], 1u);
            const unsigned tg = og / nx;
            if (og + 1u == (tg + 1u) * nx) xb_add(&bar[XB_TOPGEN], 1u);
            else XB_SPIN(xb_ld(&bar[XB_TOPGEN]) == tg, bar);
            __builtin_amdgcn_fence(__ATOMIC_ACQUIRE, "agent");
            xb_add(&bar[XB_XGEN(b.x)], 1u);
            asm volatile("s_waitcnt vmcnt(0)" ::: "memory");
        } else {
            XB_SPIN(xb_ld(&bar[XB_XGEN(b.x)]) == gen, bar);
            __builtin_amdgcn_fence(__ATOMIC_ACQUIRE, "agent");
            asm volatile("s_waitcnt vmcnt(0)" ::: "memory");
        }
    }
    __syncthreads();
}

namespace pg8 {
constexpr int BM = 256, BK = 64, HALF = 128, HTB = HALF * BK * 2  , STAGE_BYTES = 8 * HTB, NXCD = 8, WGM = 8;
__host__ __device__ __forceinline__ int lds_byte(int r, int c) { const int st = (r >> 4) * 2 + (c >> 5), rr = r & 15, cc = c & 31, ob = rr * 64 + cc * 2; return st * 1024 + (ob ^ (((ob >> 9) & 1) << 5)); }
__host__ __device__ __forceinline__ void stage_rc(int b, int& R, int& C) { const int st = b / 1024, sb = b % 1024, swz = sb ^ (((sb >> 9) & 1) << 5); R = (st >> 1) * 16 + swz / 64; C = (st & 1) * 32 + (swz % 64) / 2; }
__host__ __device__ __forceinline__ int perm32(int rho) { const int n = rho >> 4, i = rho & 15; return 8 * (i >> 2) + 4 * n + (i & 3); }

struct Unit { int pm, pn, e, r0; };

__device__ __forceinline__ unsigned cvt_pk_bf16(float lo, float hi) { unsigned r; asm volatile("v_cvt_pk_bf16_f32 %0, %1, %2" : "=v"(r) : "v"(lo), "v"(hi)); return r; }

template <int K, class Epi, class Sched>
__device__ __forceinline__ void gemm_phase(const int tid, LAS unsigned char* lds, const char* Abase, const Sched& S, const Epi& E) {
    const int wid = __builtin_amdgcn_readfirstlane(tid >> 6), lane = tid & 63, wr = wid >> 2, wc = wid & 3, fr = lane & 15, fq = lane >> 4;
    const int nt = K / BK;
    int RA[2], CA[2]; unsigned voffB[2];
#pragma unroll
    for (int i = 0; i < 2; ++i) { int R, C; stage_rc(tid * 16 + i * 8192, R, C); const int Rb = Epi::PERM ? ((R & ~31) + perm32(R & 31)) : R;
        RA[i] = R; CA[i] = C; voffB[i] = (unsigned)(Rb * K + C) * 2u; }
    const size_t kstep = (size_t)(BK * 2);
    const size_t hstep = (size_t)HALF * K * 2;
    const unsigned ldsw = (unsigned)wid * 1024u;
    const int aoff = lds_byte(wr * 64 + fr, fq * 8), boff = lds_byte(wc * 32 + fr, fq * 8);
#define PG8_SA(b, h) (((b) * 2 + (h)) * HTB)
#define PG8_SB(b, h) ((4 + (b) * 2 + (h)) * HTB)
#define PG8_STAGE(bufoff, gbase, voff) do { _Pragma("unroll") for (int _i = 0; _i < 2; ++_i) \
        __builtin_amdgcn_global_load_lds((const unsigned*)((const char*)(gbase) + (voff)[_i]), (LAS unsigned*)(lds + (bufoff) + ldsw + _i * 8192), 16, 0, 0); } while (0)
#define PG8_LDA(dst, b, h) do { _Pragma("unroll") for (int m = 0; m < 4; ++m) _Pragma("unroll") for (int k = 0; k < 2; ++k) dst[m][k] = *(const LAS bf16x8*)(lds + PG8_SA(b, h) + aoff + m * 2048 + k * 1024); } while (0)
#define PG8_LDB(dst, b, h) do { _Pragma("unroll") for (int n = 0; n < 2; ++n) _Pragma("unroll") for (int k = 0; k < 2; ++k) dst[n][k] = *(const LAS bf16x8*)(lds + PG8_SB(b, h) + boff + n * 2048 + k * 1024); } while (0)
#define PG8_MMA(ai, bj, At, Bt) do { __builtin_amdgcn_s_setprio(1); _Pragma("unroll") for (int m = 0; m < 4; ++m) _Pragma("unroll") for (int n = 0; n < 2; ++n) _Pragma("unroll") for (int k = 0; k < 2; ++k) \
        acc[ai][bj][m][n] = __builtin_amdgcn_mfma_f32_16x16x32_bf16(Bt[n][k], At[m][k], acc[ai][bj][m][n], 0, 0, 0); __builtin_amdgcn_s_setprio(0); } while (0)
#define PG8_WAIT_V(n) asm volatile("s_waitcnt vmcnt(" #n ")" ::: "memory")
#define PG8_WAIT_L(n) asm volatile("s_waitcnt lgkmcnt(" #n ")" ::: "memory")
#define PG8_BAR __builtin_amdgcn_s_barrier()
#define PG8_SCHED __builtin_amdgcn_sched_barrier(0)
#define PG8_AOFF(dst, u) do { _Pragma("unroll") for (int _h = 0; _h < 2; ++_h) _Pragma("unroll") for (int _i = 0; _i < 2; ++_i) \
        dst[_h][_i] = ((unsigned)S.a_row(u, _h * HALF + RA[_i]) * (unsigned)K + (unsigned)CA[_i]) * 2u; } while (0)
    Unit cur, nxt; int ui = 0;
    if (!S.next(0, cur)) return;
    f32x4 acc[2][2][4][2];
#pragma unroll
    for (int a = 0; a < 2; ++a)
#pragma unroll
        for (int b = 0; b < 2; ++b)
#pragma unroll
            for (int m = 0; m < 4; ++m)
#pragma unroll
                for (int n = 0; n < 2; ++n) acc[a][b][m][n] = (f32x4){0.f, 0.f, 0.f, 0.f};
    bf16x8 At[4][2], B0[2][2], B1[2][2];
    unsigned cO[2][2], nO[2][2];
    PG8_AOFF(cO, cur);
    const char* cB = S.b_ptr(cur);
    PG8_STAGE(PG8_SB(0, 0), cB, voffB); PG8_STAGE(PG8_SA(0, 0), Abase, cO[0]); PG8_STAGE(PG8_SB(0, 1), cB + hstep, voffB); PG8_STAGE(PG8_SA(0, 1), Abase, cO[1]);
    if (wr == 1) PG8_BAR;
    PG8_WAIT_V(4); PG8_BAR;
    PG8_STAGE(PG8_SB(1, 0), cB + kstep, voffB); PG8_STAGE(PG8_SA(1, 0), Abase + kstep, cO[0]); PG8_STAGE(PG8_SB(1, 1), cB + hstep + kstep, voffB);
    PG8_WAIT_V(6); PG8_BAR;
    for (;;) {
        const bool has_next = S.next(ui + 1, nxt);
        const char* nB = cB;
        if (has_next) { PG8_AOFF(nO, nxt); nB = S.b_ptr(nxt); }
        else {
#pragma unroll
            for (int h = 0; h < 2; ++h)
#pragma unroll
                for (int i = 0; i < 2; ++i) nO[h][i] = cO[h][i]; }
        for (int t = 0; t < nt; t += 2) {
            const bool last = (t == nt - 2);
            const char* a1 = Abase + (size_t)(t + 1) * kstep;
            const char* a2 = last ? Abase : Abase + (size_t)(t + 2) * kstep; const char* b2 = last ? nB : cB + (size_t)(t + 2) * kstep;
            const char* a3 = a2 + kstep; const char* b3 = b2 + kstep;
            unsigned o2[2][2];
#pragma unroll
            for (int h = 0; h < 2; ++h)
#pragma unroll
                for (int i = 0; i < 2; ++i) o2[h][i] = last ? nO[h][i] : cO[h][i];
            PG8_LDB(B0, 0, 0); PG8_SCHED; PG8_LDA(At, 0, 0); PG8_STAGE(PG8_SA(1, 1), a1, cO[1]);
            PG8_WAIT_L(8); PG8_BAR; PG8_WAIT_L(0); PG8_MMA(0, 0, At, B0); PG8_BAR; PG8_SCHED;
            PG8_LDB(B1, 0, 1); PG8_STAGE(PG8_SB(0, 0), b2, voffB);
            PG8_BAR; PG8_WAIT_L(0); PG8_MMA(0, 1, At, B1); PG8_BAR;
            PG8_LDA(At, 0, 1); PG8_STAGE(PG8_SA(0, 0), a2, o2[0]);
            PG8_BAR; PG8_WAIT_L(0); PG8_MMA(1, 0, At, B0); PG8_BAR; PG8_SCHED;
            PG8_STAGE(PG8_SB(0, 1), b2 + hstep, voffB);
            PG8_WAIT_V(6); PG8_BAR; PG8_MMA(1, 1, At, B1); PG8_BAR;
            PG8_LDB(B0, 1, 0); PG8_SCHED; PG8_LDA(At, 1, 0); PG8_STAGE(PG8_SA(0, 1), a2, o2[1]);
            PG8_WAIT_L(8); PG8_BAR; PG8_WAIT_L(0); PG8_MMA(0, 0, At, B0); PG8_BAR; PG8_SCHED;
            PG8_LDB(B1, 1, 1); PG8_STAGE(PG8_SB(1, 0), b3, voffB);
            PG8_BAR; PG8_WAIT_L(0); PG8_MMA(0, 1, At, B1); PG8_BAR;
            PG8_LDA(At, 1, 1); PG8_STAGE(PG8_SA(1, 0), a3, o2[0]);
            PG8_BAR; PG8_WAIT_L(0); PG8_MMA(1, 0, At, B0); PG8_BAR; PG8_SCHED;
            PG8_STAGE(PG8_SB(1, 1), b3 + hstep, voffB);
            PG8_WAIT_V(6); PG8_BAR; PG8_MMA(1, 1, At, B1); PG8_BAR;
        }
        E(acc, cur, wid);
        if (!has_next) break;
#pragma unroll
        for (int a = 0; a < 2; ++a)
#pragma unroll
            for (int b = 0; b < 2; ++b)
#pragma unroll
                for (int m = 0; m < 4; ++m)
#pragma unroll
                    for (int n = 0; n < 2; ++n) acc[a][b][m][n] = (f32x4){0.f, 0.f, 0.f, 0.f};
        cur = nxt; cB = nB; ++ui;
#pragma unroll
        for (int h = 0; h < 2; ++h)
#pragma unroll
            for (int i = 0; i < 2; ++i) cO[h][i] = nO[h][i];
    }
    PG8_WAIT_V(0);
    if (wr == 0) PG8_BAR;
    PG8_BAR;
#undef PG8_SA
#undef PG8_SB
#undef PG8_STAGE
#undef PG8_LDA
#undef PG8_LDB
#undef PG8_MMA
#undef PG8_WAIT_V
#undef PG8_WAIT_L
#undef PG8_BAR
#undef PG8_SCHED
#undef PG8_AOFF
}
}
struct DenseSched {
    int nM, nN, nwg, G, c, K; const char* Bt; int single = 0, round = 0;
    __device__ __forceinline__ void init(int M, int N, int K_, const bf16_t* Bt_, int G_, int c_) { nM = M / 256; nN = N / 256; nwg = nM * nN; G = G_; c = c_; K = K_; Bt = (const char*)Bt_; }
    __device__ __forceinline__ bool next(int i, pg8::Unit& u) const {
        if (single && i > 0) return false;
        const long L = (long)(single ? round : i) * G + c; if (L >= nwg) return false;
        int wgid = (int)L; { const int q = nwg / 8, r = nwg % 8, xcd = wgid % 8, off = wgid / 8; wgid = (xcd < r ? xcd * (q + 1) : r * (q + 1) + (xcd - r) * q) + off; }
        const int nig = 8 * nN, gid = wgid / nig, fm = gid * 8, gsz = (nM - fm) < 8 ? (nM - fm) : 8;
        u.pm = fm + ((wgid % nig) % gsz); u.pn = (wgid % nig) / gsz; u.e = 0; u.r0 = 0; return true;
    }
    __device__ __forceinline__ int a_row(const pg8::Unit& u, int r) const { return u.pm * 256 + r; }
    __device__ __forceinline__ const char* b_ptr(const pg8::Unit& u) const { return Bt + (size_t)u.pn * 256 * K * 2; }
};
template <bool GATHER> struct MoeSched {
    const LAS int* tstart; const LAS int* cnt; int nN, G, c, K, row_lo; const int* ltok; const char* Bt; size_t bstride;
    __device__ __forceinline__ bool next(int i, pg8::Unit& u) const {
        const long L = (long)i * G + c; const int ntile = __builtin_amdgcn_readfirstlane(tstart[NE1]); if (L >= (long)ntile * nN) return false;
        const int tile = (int)(L / nN); u.pn = (int)(L % nN);
        int e = 0;
#pragma unroll 1
        for (int step = 64; step >= 1; step >>= 1) { const int e2 = e + step; if (e2 <= NE && tstart[e2] <= tile) e = e2; }
        e = __builtin_amdgcn_readfirstlane(e); u.e = e; u.pm = __builtin_amdgcn_readfirstlane(tile); u.pn = __builtin_amdgcn_readfirstlane(u.pn); u.r0 = __builtin_amdgcn_readfirstlane((tile - tstart[e]) * 256); return true;
    }
    __device__ __forceinline__ int a_row(const pg8::Unit& u, int r) const {
        if (!GATHER) return u.pm * 256 + r;
        const int ri = u.r0 + r;
        if (u.e == NE) return ri < cnt[NE] ? row_lo + ri : row_lo;
        return ri < cnt[u.e] ? ltok[(size_t)u.e * ROWS + ri] : row_lo;
    }
    __device__ __forceinline__ const char* b_ptr(const pg8::Unit& u) const { return Bt + (size_t)u.e * bstride + (size_t)u.pn * 256 * K * 2; }
};

struct EpiProj {
    static constexpr bool PERM = true;
    bf16_t* O; int ldc;
    __device__ __forceinline__ void operator()(const f32x4 (&acc)[2][2][4][2], const pg8::Unit& u, const int wid) const {
        const int lane_ = lane_id_asm(), fr = lane_ & 15, fq = lane_ >> 4, wr = wid >> 2, wc = wid & 3;
        const int row0 = u.pm * 256 + wr * 64 + fr, col0 = u.pn * 256 + wc * 32 + 8 * fq;
#pragma unroll
        for (int ai = 0; ai < 2; ++ai)
#pragma unroll
            for (int m = 0; m < 4; ++m) { bf16_t* rowp = O + (size_t)(row0 + ai * 128 + m * 16) * ldc + col0;
#pragma unroll
                for (int bj = 0; bj < 2; ++bj) { const f32x4 v0 = acc[ai][bj][m][0], v1 = acc[ai][bj][m][1];
                    u32x4 w; w.x = pg8::cvt_pk_bf16(v0[0], v0[1]); w.y = pg8::cvt_pk_bf16(v0[2], v0[3]); w.z = pg8::cvt_pk_bf16(v1[0], v1[1]); w.w = pg8::cvt_pk_bf16(v1[2], v1[3]);
                    *(u32x4*)(rowp + bj * 128) = w; } }
    }
};
struct EpiRes {
    static constexpr bool PERM = false;
    const float* xsrc; const float* csrc; float* xdst; float* cdst; const float* gate; float pert = 0.f;
    __device__ __forceinline__ void operator()(const f32x4 (&acc)[2][2][4][2], const pg8::Unit& u, const int wid) const {
        const int lane_ = lane_id_asm(), fr = lane_ & 15, fq = lane_ >> 4, wr = wid >> 2, wc = wid & 3;
        const int col0 = u.pn * 256 + wc * 32 + 4 * fq;
        const bool isc = u.pm < 4; const int sel = isc ? 4 : (u.pm - 4) >> 5;
        const float* src = isc ? csrc + (size_t)u.pm * 256 * D : xsrc + (size_t)(u.pm - 4) * 256 * D;
        float* dst = isc ? cdst + (size_t)u.pm * 256 * D : xdst + (size_t)(u.pm - 4) * 256 * D;
        f32x4 gv[2][2];
#pragma unroll
        for (int bj = 0; bj < 2; ++bj)
#pragma unroll
            for (int n = 0; n < 2; ++n) gv[bj][n] = *(const f32x4*)(gate + sel * 6144 + col0 + bj * 128 + n * 16);
#pragma unroll
        for (int ai = 0; ai < 2; ++ai)
#pragma unroll
            for (int m = 0; m < 4; ++m) { const size_t off = (size_t)(ai * 128 + wr * 64 + m * 16 + fr) * D + col0;
#pragma unroll
                for (int bj = 0; bj < 2; ++bj)
#pragma unroll
                    for (int n = 0; n < 2; ++n) { const f32x4 s = *(const f32x4*)(src + off + bj * 128 + n * 16); *(f32x4*)(dst + off + bj * 128 + n * 16) = (s + gv[bj][n] * acc[ai][bj][m][n]) * (1.0f + (((fr + m + n) & 1) ? pert : -pert)); }
                asm volatile("" ::: "memory"); }
    }
};
struct EpiF32T {
    static constexpr bool PERM = false;
    float* Y;
    __device__ __forceinline__ void operator()(const f32x4 (&acc)[2][2][4][2], const pg8::Unit& u, const int wid) const {
        const int lane_ = lane_id_asm(), fr = lane_ & 15, fq = lane_ >> 4, wr = wid >> 2, wc = wid & 3;
        const int col0 = u.pn * 256 + wc * 32 + 4 * fq;
#pragma unroll
        for (int ai = 0; ai < 2; ++ai)
#pragma unroll
            for (int m = 0; m < 4; ++m) { float* rp = Y + (size_t)(u.pm * 256 + ai * 128 + wr * 64 + m * 16 + fr) * D + col0;
#pragma unroll
                for (int bj = 0; bj < 2; ++bj)
#pragma unroll
                    for (int n = 0; n < 2; ++n) *(f32x4*)(rp + bj * 128 + n * 16) = acc[ai][bj][m][n]; }
    }
};
struct EpiGU {
    static constexpr bool PERM = false;
    bf16_t* H;
    __device__ __forceinline__ void operator()(const f32x4 (&acc)[2][2][4][2], const pg8::Unit& u, const int wid) const {
        const int lane_ = lane_id_asm(), fr = lane_ & 15, fq = lane_ >> 4, wr = wid >> 2, wc = wid & 3;
        const int row0 = u.pm * 256 + wr * 64 + fr;
#pragma unroll
        for (int ai = 0; ai < 2; ++ai)
#pragma unroll
            for (int m = 0; m < 4; ++m) { bf16_t* rowp = H + (size_t)(row0 + ai * 128 + m * 16) * EH + 4 * fq;
#pragma unroll
                for (int bj = 0; bj < 2; ++bj) { const f32x4 g = acc[ai][bj][m][0], up = acc[ai][bj][m][1]; float h[4];
#pragma unroll
                    for (int j = 0; j < 4; ++j) h[j] = g[j] / (1.0f + __expf(-g[j])) * up[j];
                    u32x2 w; w.x = pg8::cvt_pk_bf16(h[0], h[1]); w.y = pg8::cvt_pk_bf16(h[2], h[3]);
                    *(u32x2*)(rowp + (u.pn * 256 + bj * 128 + wc * 32) / 2) = w; } }
    }
};
struct EpiDown {
    static constexpr bool PERM = false;
    int* accb; const float* gate; const int* ltok; const float* lw; const LAS int* cnt; int row_lo;
    __device__ __forceinline__ void operator()(const f32x4 (&acc)[2][2][4][2], const pg8::Unit& u, const int wid) const {
        const int lane_ = lane_id_asm(), fr = lane_ & 15, fq = lane_ >> 4, wr = wid >> 2, wc = wid & 3;
        const int col0 = u.pn * 256 + wc * 32 + 4 * fq; const int ce = __builtin_amdgcn_readfirstlane(cnt[u.e]);
        const int rbase = u.r0 + wr * 64 + fr; const size_t lbase = (size_t)u.e * ROWS;
#pragma unroll
        for (int ai = 0; ai < 2; ++ai)
#pragma unroll
            for (int m = 0; m < 4; ++m) { const int ri = rbase + ai * 128 + m * 16;
                __builtin_amdgcn_sched_barrier(0);
                if (ri < ce && !((MK_ABL & 1) && u.e != NE) && !((MK_ABL & 2) && u.e == NE)) {
                    int tok = row_lo + ri; float w = ACC_SCALE;
                    if (u.e != NE) { tok = ltok[lbase + ri]; w = lw[lbase + ri] * ACC_SCALE; }
                    const int sel = tok < CROWS ? 4 : (tok - CROWS) >> 13;
                    int* dst = accb + (size_t)tok * D + col0;
                    const float* gp = gate + sel * 6144 + col0;
#pragma unroll
                    for (int bj = 0; bj < 2; ++bj)
#pragma unroll
                        for (int n = 0; n < 2; ++n) { const f32x4 gv = *(const f32x4*)(gp + bj * 128 + n * 16); const f32x4 v = acc[ai][bj][m][n] * gv * w;
#pragma unroll
                            for (int j = 0; j < 4; ++j) atomicAdd(dst + bj * 128 + n * 16 + j, (int)rintf(v[j])); }
                }
                asm volatile("" ::: "memory"); }
    }
};
#define WSP(T, off) ((T*)(p.ws + (off)))

__device__ __forceinline__ void conv_tile(const int t, LAS float* tl, const float* __restrict__ src, int ldsrc, int k0, int n0, int nvalid, bf16_t* dst, int lddst, int mode) {
#pragma unroll
    for (int j = 0; j < 8; ++j) { const int idx = t + NTHR * j, k = idx >> 6, n = idx & 63; float v = 0.f; if (n0 + n < nvalid) v = src[(size_t)(k0 + k) * ldsrc + n0 + n]; tl[k * 65 + n] = v; }
    __syncthreads();
#pragma unroll
    for (int j = 0; j < 4; ++j) { const int pi = t + NTHR * j, n = pi >> 5, k = (pi & 31) * 2; const int nn = n0 + n;
        const int row = (mode == 0 || mode == 3) ? nn : ((nn >> 4) * 32 + (nn & 15) + (mode == 2 ? 16 : 0));
        float v0 = tl[k * 65 + n], v1 = tl[(k + 1) * 65 + n];
        if (mode == 3) { v0 -= bf2f((bf16_t)f2bf(v0)); v1 -= bf2f((bf16_t)f2bf(v1)); }
        *(unsigned*)(dst + (size_t)row * lddst + k0 + k) = pk2(v0, v1); }
    __syncthreads();
}
constexpr int CONV_A_UNITS = 2048 + 512 + 64;
__device__ __forceinline__ void conv_unit_A(const Cx& p, LAS float* tl, int u) {
    if (u < 2048) { const int l = u >> 10, r = u & 1023; conv_tile(p.tid, tl, PIN(I_WIN) + (size_t)l * D * INW, INW, (r >> 6) * 64, (r & 63) * 64, INW, WSP(bf16_t, WS_WIN) + (size_t)l * NPROJ * D, D, 0); }
    else if (u < 2560) { const int v = u - 2048, l = v >> 8, r = v & 255; conv_tile(p.tid, tl, PIN(I_WOUT) + (size_t)l * D * D, D, (r >> 4) * 64, (r & 15) * 64, D, WSP(bf16_t, WS_WOUT) + (size_t)l * D * D, D, 0); }
    else { const int v = u - 2560, l = v >> 5, lo = (v >> 4) & 1, r = v & 15; conv_tile(p.tid, tl, PIN(I_ROUT_W) + (size_t)l * D * NE, NE, r * 64, 0, NE, WSP(bf16_t, WS_ROUT) + (size_t)(l * 2 + lo) * NE * D, D, lo ? 3 : 0); }
}
constexpr int CONV_E_UNITS = NE1 * 192;
__device__ __forceinline__ void conv_unit_E(const Cx& p, LAS float* tl, int l, int u) {
    const int e = u / 192, r = u % 192;
    if (r < 128) { const int up = r >> 6, q = r & 63;
        const float* src = e < NE ? PIN(up ? I_EXP_U : I_EXP_G) + ((size_t)l * NE + e) * D * EH : PIN(up ? I_SH_U : I_SH_G) + (size_t)l * D * EH;
        conv_tile(p.tid, tl, src, EH, (q >> 2) * 64, (q & 3) * 64, EH, WSP(bf16_t, WS_EXPGU) + (size_t)e * 512 * D, D, 1 + up); }
    else { const int q = r - 128;
        const float* src = e < NE ? PIN(I_EXP_D) + ((size_t)l * NE + e) * EH * D : PIN(I_SH_D) + (size_t)l * EH * D;
        conv_tile(p.tid, tl, src, D, (q >> 4) * 64, (q & 15) * 64, D, WSP(bf16_t, WS_EXPD) + (size_t)e * D * EH, EH, 0); }
}
__device__ __forceinline__ void phase_mod(const Cx& p, LAS unsigned char* lds) {
    LAS float* sv = (LAS float*)lds; LAS float* red = sv + 5 * D;
    const int tid = p.tid;
    if (p.bid >= 192) return;
    for (int i = tid; i < 5 * D; i += NTHR) { const int j = i >> 10, k = i & 1023; const float c = j < 4 ? PIN(I_C)[j * D + k] : PIN(I_CCTX)[k]; sv[i] = siluf_(c); }
    __syncthreads();
    for (int u = p.bid; u < 192; u += p.G) {
        const int l = u / 96, cb = u % 96, kg = tid >> 6, cl = tid & 63;
        const float* w = PIN(I_WMOD) + (size_t)l * D * 6144 + cb * 64 + cl;
        float a0 = 0.f, a1 = 0.f, a2 = 0.f, a3 = 0.f, a4 = 0.f;
#pragma unroll 8
        for (int kk = 0; kk < 128; ++kk) { const int k = kg * 128 + kk; const float wv = w[(size_t)k * 6144];
            a0 += sv[k] * wv; a1 += sv[D + k] * wv; a2 += sv[2 * D + k] * wv; a3 += sv[3 * D + k] * wv; a4 += sv[4 * D + k] * wv; }
        red[(kg * 5 + 0) * 64 + cl] = a0; red[(kg * 5 + 1) * 64 + cl] = a1; red[(kg * 5 + 2) * 64 + cl] = a2; red[(kg * 5 + 3) * 64 + cl] = a3; red[(kg * 5 + 4) * 64 + cl] = a4;
        __syncthreads();
        if (tid < 320) { const int j = tid >> 6; float s = 0.f;
#pragma unroll
            for (int g = 0; g < 8; ++g) s += red[(g * 5 + j) * 64 + cl];
            WSP(float, WS_MOD)[((size_t)l * 5 + j) * 6144 + cb * 64 + cl] = s + PIN(I_BMOD)[l * 6144 + cb * 64 + cl]; }
        __syncthreads();
    }
}
__device__ __forceinline__ const float* res_row(const Cx& p, int layer_src0, int r) {
    if (r < CROWS) return (layer_src0 ? PIN(I_CTX) : (const float*)WSP(float, WS_CTXRES)) + (size_t)r * D;
    return (layer_src0 ? PIN(I_X) : (const float*)p.out) + (size_t)(r - CROWS) * D;
}
__device__ __forceinline__ int row_sel(int r) { return r < CROWS ? 4 : (r - CROWS) >> 13; }

__device__ __forceinline__ void norm_row(const float* src, const int* accp, float* wb, int* zacc, const float* g, const float* shift, const float* scale, bf16_t* dst, const bool tolds, LAS bf16_t* ldst, LAS bf16_t* ldlo, int lane) {
    f32x4 v[4]; float ss = 0.f;
#pragma unroll
    for (int i = 0; i < 4; ++i) { v[i] = *(const f32x4*)(src + 256 * i + 4 * lane);
        if (accp) { const int4 a = *(const int4*)(accp + 256 * i + 4 * lane); v[i][0] += (float)a.x * ACC_INV; v[i][1] += (float)a.y * ACC_INV; v[i][2] += (float)a.z * ACC_INV; v[i][3] += (float)a.w * ACC_INV; }
        if (wb) *(f32x4*)(wb + 256 * i + 4 * lane) = v[i];
        if (zacc) { int z0 = 0; asm volatile("" : "+v"(z0)); *(int4*)(zacc + 256 * i + 4 * lane) = make_int4(z0, z0, z0, z0); }
        ss += v[i][0] * v[i][0] + v[i][1] * v[i][1] + v[i][2] * v[i][2] + v[i][3] * v[i][3]; }
    ss = wsum(ss); const float rstd = rsqrtf(ss * (1.0f / D) + 1e-6f);
#pragma unroll
    for (int i = 0; i < 4; ++i) { const int col = 256 * i + 4 * lane; const f32x4 gv = *(const f32x4*)(g + col), sh = *(const f32x4*)(shift + col), sc = *(const f32x4*)(scale + col);
        const f32x4 y = v[i] * rstd * gv * (sc + 1.0f) + sh; u32x2 w; w.x = pk2(y[0], y[1]); w.y = pk2(y[2], y[3]);
        *(u32x2*)(dst + col) = w;
        if (tolds) { *(LAS u32x2*)(ldst + col) = w; u32x2 wl;
            wl.x = pk2(y[0] - __uint_as_float(w.x << 16), y[1] - __uint_as_float(w.x & 0xffff0000u)); wl.y = pk2(y[2] - __uint_as_float(w.y << 16), y[3] - __uint_as_float(w.y & 0xffff0000u));
            *(LAS u32x2*)(ldlo + col) = wl; } }
}
__device__ __forceinline__ void phase_norm1(const Cx& p, int layer) {
    const int lane = p.tid & 63, wave = p.tid >> 6;
    const float* mod = WSP(float, WS_MOD) + (size_t)layer * 5 * 6144; const float* g = PIN(I_N1G) + layer * D; bf16_t* hb = WSP(bf16_t, WS_HBUF);
    for (int r = p.bid * 8 + wave; r < ROWS; r += p.G * 8) { const int sel = row_sel(r);
        const float* src = res_row(p, layer == 0, r);
        norm_row(src, layer == 0 ? (const int*)0 : WSP(int, WS_ACC) + (size_t)r * D, layer == 0 ? (float*)0 : (float*)src, (int*)0, g, mod + sel * 6144 + 0, mod + sel * 6144 + 1024, hb + (size_t)r * D, false, (LAS bf16_t*)0, (LAS bf16_t*)0, lane); }
}
__device__ __forceinline__ float conv_at(const Cx& p, const bf16_t* proj, int b, int s, int col, const float* cw  ) {
    float acc = 0.f;
    if (s < NCTX) {
#pragma unroll
        for (int dx = -1; dx <= 1; ++dx) { const int s2 = s + dx; if (s2 >= 0 && s2 < NCTX) acc += cw[(3 + dx + 1) * 768] * bf2f(proj[(size_t)(b * NCTX + s2) * NPROJ + col]); }
    } else { const int t = s - NCTX, r = t >> 6, c = t & 63;
#pragma unroll
        for (int dy = -1; dy <= 1; ++dy)
#pragma unroll
            for (int dx = -1; dx <= 1; ++dx) { const int r2 = r + dy, c2 = c + dx;
                if (r2 >= 0 && r2 < GRIDH && c2 >= 0 && c2 < GRIDW) acc += cw[((dy + 1) * 3 + dx + 1) * 768] * bf2f(proj[(size_t)(CROWS + b * SEQ + r2 * 64 + c2) * NPROJ + col]); }
    }
    return acc;
}
__device__ __forceinline__ void phase_prep(const Cx& p, LAS unsigned char* lds, int layer, int b) {
    const int lane = p.tid & 63, wave = __builtin_amdgcn_readfirstlane(p.tid >> 6);
    const bf16_t* proj = WSP(bf16_t, WS_PROJ);
    if (p.bid < SB / 32) {
        LAS float* wl = (LAS float*)lds;
        { const float* AW = PIN(I_RW_AW2) + (size_t)layer * 32 * 256; const float* WW = PIN(I_RW_W2) + (size_t)layer * 2 * 32 * 256;
          for (int i = p.tid; i < 96 * 256; i += NTHR) wl[i] = i < 32 * 256 ? AW[i] : WW[i - 32 * 256]; }
        __syncthreads();
        const int h = wave & 3, half = wave >> 2, c = 64 * h + lane;
        const float a0 = PIN(I_RW_A0)[layer * 256 + c], w0f = PIN(I_RW_W0)[(layer * 2 + 0) * 256 + c], w0b = PIN(I_RW_W0)[(layer * 2 + 1) * 256 + c];
        const float kkm = PIN(I_RW_KK)[layer * 256 + c], kam = PIN(I_RW_KA)[layer * 256 + c];
        for (int u = p.bid; u < SB / 32; u += p.G) {
#pragma unroll 1
            for (int i = 0; i < 16; ++i) { const int s = u * 32 + half * 16 + i; const bf16_t* pr = proj + (size_t)tok_row(b, s) * NPROJ;
                float xa = 0.f, xf = 0.f, xb = 0.f;
                if (lane < 32) { xa = bf2f(pr[PB_A + lane]); xf = tanhf(bf2f(pr[PB_WF + lane])); xb = tanhf(bf2f(pr[PB_WB + lane])); }
                const float kv = bf2f(pr[PB_K + c]);
                float sa = a0, sf = w0f, sb = w0b;
#pragma unroll 8
                for (int j = 0; j < 32; ++j) { sa += rl(xa, j) * wl[j * 256 + c]; sf += rl(xf, j) * wl[(32 + j) * 256 + c]; sb += rl(xb, j) * wl[(64 + j) * 256 + c]; }
                const float a = sigmoidf_(sa);
                const float lwf = -__expf(-softplusf_(-sf) - 0.5f), lwb = -__expf(-softplusf_(-sb) - 0.5f);
                const float kr = kv * kkm; const float ss = wsum(kr * kr); const float kk = kr * rsqrtf(ss + 1e-6f);
                const size_t o = (size_t)s * 256 + c;
                WSP(float, SC_RK)[o] = kv * (1.0f + (a - 1.0f) * kam); WSP(float, SC_RKK)[o] = kk; WSP(float, SC_RB)[o] = kk * a;
                WSP(float, SC_RLW)[o] = lwf; WSP(float, SC_RLW)[(size_t)SB * 256 + o] = lwb; }
        }
    }
    for (int u = p.bid; u < SB / 8; u += p.G) {
        for (int task = wave; task < 8 * 25; task += 8) { const int s = u * 8 + task / 25, grp = task % 25;
            if (grp < 12) { const int j = 64 * grp + lane;
                const float v = conv_at(p, proj, b, s, PC_X + j, PIN(I_SS_CW) + (size_t)layer * 9 * 768 + j) + PIN(I_SS_CB)[layer * 768 + j];
                WSP(bf16_t, SC_SX)[(size_t)s * 768 + j] = (bf16_t)f2bf(siluf_(v)); }
            else if (grp < 24) { const int g2 = grp - 12, j = 64 * g2 + lane;
                float y = siluf_(conv_at(p, proj, b, s, PD_Q + j, PIN(I_DN_CW) + (size_t)layer * 9 * 768 + j));
                if (g2 < 8) { const float ss = wsum(y * y); y *= rsqrtf(ss + 1e-6f); if (g2 < 4) y *= 0.125f; }
                WSP(bf16_t, SC_DQ)[(size_t)s * 768 + j] = (bf16_t)f2bf(y); }
            else { const bf16_t* pr = proj + (size_t)tok_row(b, s) * NPROJ;
                if (lane < 8) { const int d = lane >> 2, h = lane & 3; WSP(float, SC_SDT)[(size_t)s * 8 + lane] = softplusf_(bf2f(pr[PC_DF + lane]) + PIN(I_SS_DTB)[(layer * 2 + d) * 4 + h]); }
                else if (lane < 16) { const int q = lane - 8; WSP(float, SC_DG)[(size_t)s * 16 + q] = sigmoidf_(bf2f(pr[PD_BF + q])); }
                else if (lane < 24) { const int q = lane - 16, d = q >> 2, h = q & 3;
                    WSP(float, SC_DG)[(size_t)s * 16 + 8 + q] = -__expf(PIN(I_DN_ALOG)[(layer * 2 + d) * 4 + h]) * softplusf_(bf2f(pr[PD_AF + q]) + PIN(I_DN_DTB)[(layer * 2 + d) * 4 + h]); } }
        }
    }
}
__device__ __forceinline__ void phase_scan(const Cx& p, int layer, int b);
__device__ __forceinline__ void phase_post(const Cx& p, int layer, int b) {
    const int lane = p.tid & 63, wave = __builtin_amdgcn_readfirstlane(p.tid >> 6);
    const bf16_t* proj = WSP(bf16_t, WS_PROJ); const bf16_t* of = WSP(bf16_t, SC_OF); const bf16_t* obk = WSP(bf16_t, SC_OB); bf16_t* yc = WSP(bf16_t, WS_HBUF);
    float gw[64]; bool loaded = false;
    for (int u = p.bid; u < SB / 8; u += p.G) {
        if (wave >= 4 && !loaded) { loaded = true; const int c = 64 * (wave - 4) + lane;
#pragma unroll
            for (int j = 0; j < 64; ++j) gw[j] = PIN(I_RW_GW2)[((size_t)layer * 64 + j) * 256 + c]; }
        for (int i = 0; i < 8; ++i) { const int s = u * 8 + i, row = tok_row(b, s); const bf16_t* pr = proj + (size_t)row * NPROJ; bf16_t* yr = yc + (size_t)row * D;
            const bf16_t* o1 = of + (size_t)s * 1024; const bf16_t* o2 = obk + (size_t)s * 1024;
            const float mf = (MK_ABL & 128) ? 0.f : 1.f, mb = (MK_ABL & 64) ? 0.f : 1.f;
            if (wave < 4) { const int h = wave, c = 64 * h + lane;
                { const float o = mf * bf2f(o1[c]) + mb * bf2f(o2[c]); const float ms = wsum(o * o) * (1.0f / 64.0f);
                  const float y = o * rsqrtf(ms + 1e-6f) * PIN(I_GLA_NG)[layer * 256 + c] * siluf_(bf2f(pr[PA_G + c])); yr[c] = (bf16_t)f2bf((MK_ABL & 4) ? 0.f : y); }
                if (wave < 2) { float y[2];
#pragma unroll
                    for (int q = 0; q < 2; ++q) { const int cc = 128 * wave + 64 * q + lane, hh = cc >> 6;
                        const float xs = bf2f(WSP(bf16_t, SC_SX)[(size_t)s * 768 + cc]);
                        y[q] = (mf * bf2f(o1[512 + cc]) + mb * bf2f(o2[512 + cc]) + PIN(I_SS_D)[layer * 4 + hh] * xs) * siluf_(bf2f(pr[PC_Z + cc])); }
                    const float ms = wsum(y[0] * y[0] + y[1] * y[1]) * (1.0f / 128.0f); const float rs = rsqrtf(ms + 1e-6f);
#pragma unroll
                    for (int q = 0; q < 2; ++q) { const int cc = 128 * wave + 64 * q + lane; yr[512 + cc] = (bf16_t)f2bf((MK_ABL & 16) ? 0.f : y[q] * rs * PIN(I_SS_NG)[layer * 256 + cc]); } }
            } else { const int h = wave - 4, c = 64 * h + lane;
                { const float o = mf * bf2f(o1[256 + c]) + mb * bf2f(o2[256 + c]); const float mu = wsum(o) * (1.0f / 64.0f); const float dlt = o - mu; const float var = wsum(dlt * dlt) * (1.0f / 64.0f);
                  float y = dlt * rsqrtf(var + 64e-5f) * PIN(I_RW_LNG)[layer * 256 + c] + PIN(I_RW_LNB)[layer * 256 + c];
                  const float r = bf2f(pr[PB_R + c]), kp = WSP(float, SC_RK)[(size_t)s * 256 + c], vv = bf2f(pr[PB_V + c]);
                  const float bonus = wsum(r * kp * PIN(I_RW_RK)[layer * 256 + c]) * vv;
                  const float sg = sigmoidf_(bf2f(pr[PB_G + lane])); float gate = 0.f;
#pragma unroll
                  for (int j = 0; j < 64; ++j) gate += rl(sg, j) * gw[j];
                  yr[256 + c] = (bf16_t)f2bf((MK_ABL & 8) ? 0.f : (y + bonus) * gate); }
                { const float o = mf * bf2f(o1[768 + c]) + mb * bf2f(o2[768 + c]); const float ms = wsum(o * o) * (1.0f / 64.0f);
                  const float y = o * rsqrtf(ms + 1e-6f) * PIN(I_DN_NG)[layer * 256 + c] * siluf_(bf2f(pr[PD_Z + c])); yr[768 + c] = (bf16_t)f2bf((MK_ABL & 32) ? 0.f : y); }
            }
        }
    }
}
constexpr int N2_TILE = 32, N2_STRIDE = 2064;
__device__ __forceinline__ void phase_norm2(const Cx& p, LAS unsigned char* lds, int layer, int row_lo) {
    const int tid = p.tid, lane = tid & 63, wave = __builtin_amdgcn_readfirstlane(tid >> 6), fr = lane & 15, fq = lane >> 4;
    const float* mod = WSP(float, WS_MOD) + (size_t)layer * 5 * 6144; const float* g = PIN(I_N2G) + layer * D; bf16_t* hb = WSP(bf16_t, WS_HBUF);
    const bf16_t* rt = WSP(bf16_t, WS_ROUT) + (size_t)layer * 2 * NE * D;
    LAS float* lg = (LAS float*)(lds + 2 * N2_TILE * N2_STRIDE);
    unsigned* cnt = WSP(unsigned, WS_CTL) + CW_CNT + layer * 80 * 16; int* ltok = WSP(int, WS_LTOK); float* lw = WSP(float, WS_LW);
    const float rbias = PIN(I_ROUT_B)[layer * NE + lane];
    const int nun = (ROWS - row_lo) / N2_TILE;
    for (int u = p.bid; u < nun; u += p.G) { const int r0 = row_lo + u * N2_TILE;
#pragma unroll 1
        for (int i = 0; i < 4; ++i) { const int tr = 4 * wave + i, r = r0 + tr, sel = row_sel(r);
            norm_row(res_row(p, 0, r), (const int*)0, (float*)0, WSP(int, WS_ACC) + (size_t)r * D, g, mod + sel * 6144 + 3072, mod + sel * 6144 + 4096, hb + (size_t)r * D, true, (LAS bf16_t*)(lds + tr * N2_STRIDE), (LAS bf16_t*)(lds + N2_TILE * N2_STRIDE + tr * N2_STRIDE), lane); }
        __syncthreads();
        { const int mt = wave >> 2, nt = wave & 3; f32x4 acc = (f32x4){0.f, 0.f, 0.f, 0.f};
          const LAS unsigned char* ap = lds + (16 * mt + fr) * N2_STRIDE + fq * 16; const bf16_t* bp = rt + (size_t)(16 * nt + fr) * D + fq * 8;
#pragma unroll 4
          for (int ks = 0; ks < 32; ++ks) { const bf16x8 a = *(const LAS bf16x8*)(ap + ks * 64), al = *(const LAS bf16x8*)(ap + N2_TILE * N2_STRIDE + ks * 64);
              const bf16x8 bb = *(const bf16x8*)(bp + ks * 32), bl = *(const bf16x8*)(bp + NE * D + ks * 32);
              acc = __builtin_amdgcn_mfma_f32_16x16x32_bf16(a, bb, acc, 0, 0, 0); acc = __builtin_amdgcn_mfma_f32_16x16x32_bf16(al, bb, acc, 0, 0, 0); acc = __builtin_amdgcn_mfma_f32_16x16x32_bf16(a, bl, acc, 0, 0, 0); }
#pragma unroll
          for (int j = 0; j < 4; ++j) lg[(16 * mt + 4 * fq + j) * 64 + 16 * nt + fr] = acc[j]; }
        __syncthreads();
#pragma unroll 1
        for (int i = 0; i < 4; ++i) { const int tr = 4 * wave + i, r = r0 + tr;
            const float sc = sigmoidf_(lg[tr * 64 + lane]); float sel = sc + rbias; float ssum = 0.f; int myE = 0; float myS = 0.f;
#pragma unroll 1
            for (int k = 0; k < TOPK; ++k) { float bv = sel; int bi = lane;
#pragma unroll
                for (int o = 32; o >= 1; o >>= 1) { const float ov = __shfl_xor(bv, o); const int oi = __shfl_xor(bi, o); if (ov > bv || (ov == bv && oi < bi)) { bv = ov; bi = oi; } }
                const int e = __builtin_amdgcn_readfirstlane(bi); const float se = rl(sc, e);
                ssum += se; if (lane == k) { myE = e; myS = se; } if (lane == e) sel = -1e30f; }
            if (lane < TOPK) { const unsigned pos = atomicAdd(cnt + myE * 16, 1u); ltok[(size_t)myE * ROWS + pos] = r; lw[(size_t)myE * ROWS + pos] = myS / ssum * 2.5f; } }
        __syncthreads();
    }
}
__device__ __forceinline__ void moe_table(const Cx& p, LAS int* tb, int layer, int row_lo) {
    const unsigned* cnt = WSP(unsigned, WS_CTL) + CW_CNT + layer * 80 * 16;
    if (p.tid == 0) { int acc = 0;
#pragma unroll 1
        for (int e = 0; e < NE1; ++e) { const int c = e < NE ? (int)__hip_atomic_load(cnt + e * 16, __ATOMIC_RELAXED, __HIP_MEMORY_SCOPE_AGENT) : ROWS - row_lo; tb[e] = c; tb[128 + e] = acc; acc += (c + 255) >> 8; }
        tb[128 + NE1] = acc; }
    __syncthreads();
}
__device__ __forceinline__ void phase_final(const Cx& p) {
    const int lane = p.tid & 63, wave = p.tid >> 6; const float* g = PIN(I_FNG);
    for (int r = p.bid * 8 + wave; r < NB * SEQ; r += p.G * 8) { float* x = p.out + (size_t)r * D;
        f32x4 v[4]; float ss = 0.f;
#pragma unroll
        for (int i = 0; i < 4; ++i) { v[i] = *(const f32x4*)(x + 256 * i + 4 * lane); const int4 a = *(const int4*)(WSP(int, WS_ACC) + (size_t)(CROWS + r) * D + 256 * i + 4 * lane);
            v[i][0] += (float)a.x * ACC_INV; v[i][1] += (float)a.y * ACC_INV; v[i][2] += (float)a.z * ACC_INV; v[i][3] += (float)a.w * ACC_INV;
            ss += v[i][0] * v[i][0] + v[i][1] * v[i][1] + v[i][2] * v[i][2] + v[i][3] * v[i][3]; }
        ss = wsum(ss); const float rstd = rsqrtf(ss * (1.0f / D) + 1e-6f);
#pragma unroll
        for (int i = 0; i < 4; ++i) *(f32x4*)(x + 256 * i + 4 * lane) = v[i] * rstd * *(const f32x4*)(g + 256 * i + 4 * lane); }
}
#ifndef MK_CHUNK
#define MK_CHUNK 7
#endif
__device__ __forceinline__ int chain_tb(int n, int d) { return d == 0 ? n : (n < 4 ? 3 - n : 135 - n); }
__device__ __forceinline__ int tb_row0(int b, int tb) { return tb < 4 ? b * NCTX + 64 * tb : CROWS + b * SEQ + 64 * (tb - 4); }
constexpr int TS = 144;
template <int K, int NT> __device__ __forceinline__ void mm_rows(const LAS unsigned char* A, int lda, const LAS unsigned char* Bt, int ldb, int mt, int nt0, int fr, int fq, f32x4 (&acc)[NT]) {
#pragma unroll
    for (int ks = 0; ks < K / 32; ++ks) { const bf16x8 a = *(const LAS bf16x8*)(A + (16 * mt + fr) * lda + ks * 64 + fq * 16);
#pragma unroll
        for (int nt = 0; nt < NT; ++nt) { const bf16x8 bb = *(const LAS bf16x8*)(Bt + (16 * (nt0 + nt) + fr) * ldb + ks * 64 + fq * 16);
            acc[nt] = __builtin_amdgcn_mfma_f32_16x16x32_bf16(a, bb, acc[nt], 0, 0, 0); } }
}
__device__ __forceinline__ void gla_p1(const Cx& p, LAS unsigned char* lds, int layer, int b) {
    const int lane = p.tid & 63, wave = __builtin_amdgcn_readfirstlane(p.tid >> 6), fr = lane & 15, fq = lane >> 4;
    if (wave >= 7) return;
    LAS unsigned char* ksT = lds + wave * (2 * 64 * TS); LAS unsigned char* vT = ksT + 64 * TS;
    const bf16_t* proj = WSP(bf16_t, WS_PROJ);
    for (int u = p.bid * 7 + wave; u < NUNIT; u += p.G * 7) { const int tb = u >> 3, h = (u >> 1) & 3, d = u & 1, c = 64 * h + lane;
        const bf16_t* pr0 = proj + (size_t)tb_row0(b, tb) * NPROJ;
        float w2[16];
#pragma unroll
        for (int r = 0; r < 16; ++r) w2[r] = PIN(I_GLA_W2)[((size_t)(layer * 2 + d) * 16 + r) * 256 + c];
        const float gb = PIN(I_GLA_B)[(layer * 2 + d) * 256 + c];
        float total = 0.f;
#pragma unroll 2
        for (int i = 0; i < 64; ++i) { const bf16_t* pr = pr0 + (size_t)i * NPROJ;
            const float gl = lane < 16 ? bf2f(pr[(d ? PA_GB : PA_GF) + lane]) : 0.f; float z = gb;
#pragma unroll
            for (int r = 0; r < 16; ++r) z += rl(gl, r) * w2[r];
            total += logsigmoidf_(z) * (1.0f / 16.0f); }
        float run = 0.f;
#pragma unroll 1
        for (int ii = 0; ii < 64; ii += 2) { const int ia = d ? 63 - ii : ii, ib = d ? 62 - ii : ii + 1;
            const bf16_t* pa = pr0 + (size_t)ia * NPROJ; const bf16_t* pb = pr0 + (size_t)ib * NPROJ;
            const float gla_ = lane < 16 ? bf2f(pa[(d ? PA_GB : PA_GF) + lane]) : 0.f, glb_ = lane < 16 ? bf2f(pb[(d ? PA_GB : PA_GF) + lane]) : 0.f; float za = gb, zb = gb;
#pragma unroll
            for (int r = 0; r < 16; ++r) { za += rl(gla_, r) * w2[r]; zb += rl(glb_, r) * w2[r]; }
            run += logsigmoidf_(za) * (1.0f / 16.0f); const float ka = bf2f(pa[PA_K + c]) * __expf(total - run);
            run += logsigmoidf_(zb) * (1.0f / 16.0f); const float kb = bf2f(pb[PA_K + c]) * __expf(total - run);
            const int lo = d ? ib : ia;
            *(LAS unsigned*)(ksT + lane * TS + lo * 2) = d ? pk2(kb, ka) : pk2(ka, kb);
            *(LAS unsigned*)(vT + lane * TS + lo * 2) = d ? ((unsigned)pb[PA_V + c] | ((unsigned)pa[PA_V + c] << 16)) : ((unsigned)pa[PA_V + c] | ((unsigned)pb[PA_V + c] << 16)); }
        WSP(float, SC_GLA_DEC)[(size_t)u * 64 + lane] = __expf(total);
        float* kv = WSP(float, SC_GLA_S) + (size_t)u * 4096;
#pragma unroll
        for (int mt = 0; mt < 4; ++mt) { f32x4 acc[4];
#pragma unroll
            for (int nt = 0; nt < 4; ++nt) acc[nt] = (f32x4){0.f, 0.f, 0.f, 0.f};
            mm_rows<64, 4>(ksT, TS, vT, TS, mt, 0, fr, fq, acc);
#pragma unroll
            for (int nt = 0; nt < 4; ++nt)
#pragma unroll
                for (int j = 0; j < 4; ++j) kv[(16 * mt + 4 * fq + j) * 64 + 16 * nt + fr] = acc[nt][j]; }
    }
}
__device__ __forceinline__ void gla_chain(const Cx& p, int h, int d) {
    const int dk = p.tid >> 3, c0 = (p.tid & 7) * 8;
    f32x4 s0 = (f32x4){0.f, 0.f, 0.f, 0.f}, s1 = s0;
    f32x4 n0[2], n1[2]; float dc[2];
#pragma unroll
    for (int q = 0; q < 2; ++q) { const int u = (chain_tb(q, d) * 4 + h) * 2 + d; const float* kv = WSP(float, SC_GLA_S) + (size_t)u * 4096 + dk * 64 + c0;
        n0[q] = *(const f32x4*)kv; n1[q] = *(const f32x4*)(kv + 4); dc[q] = WSP(float, SC_GLA_DEC)[(size_t)u * 64 + dk]; }
#pragma unroll 2
    for (int n = 0; n < NTB; ++n) { const int q = n & 1; const int u = (chain_tb(n, d) * 4 + h) * 2 + d; float* kv = WSP(float, SC_GLA_S) + (size_t)u * 4096 + dk * 64 + c0;
        const f32x4 a0 = n0[q], a1 = n1[q]; const float de = dc[q];
        if (n + 2 < NTB) { const int u2 = (chain_tb(n + 2, d) * 4 + h) * 2 + d; const float* k2 = WSP(float, SC_GLA_S) + (size_t)u2 * 4096 + dk * 64 + c0;
            n0[q] = *(const f32x4*)k2; n1[q] = *(const f32x4*)(k2 + 4); dc[q] = WSP(float, SC_GLA_DEC)[(size_t)u2 * 64 + dk]; }
        *(f32x4*)kv = s0; *(f32x4*)(kv + 4) = s1;
        s0 = s0 * de + a0; s1 = s1 * de + a1; }
}
__device__ __forceinline__ void gla_p2(const Cx& p, LAS unsigned char* lds, int layer, int b) {
    const int tid = p.tid, lane = tid & 63, wave = __builtin_amdgcn_readfirstlane(tid >> 6), fr = lane & 15, fq = lane >> 4;
    LAS unsigned char* qt = lds; LAS unsigned char* kt = lds + 64 * TS; LAS unsigned char* vT = lds + 2 * 64 * TS; LAS unsigned char* sT = lds + 3 * 64 * TS; LAS unsigned char* att = lds + 4 * 64 * TS;
    LAS float* gs = (LAS float*)(lds + 5 * 64 * TS);
    const bf16_t* proj = WSP(bf16_t, WS_PROJ);
    for (int u = p.bid; u < NUNIT; u += p.G) { const int tb = u >> 3, h = (u >> 1) & 3, d = u & 1; const int cl = tid & 63, tg = tid >> 6, c = 64 * h + cl;
        const int row0 = tb_row0(b, tb), s0 = 64 * tb; const bf16_t* pr0 = proj + (size_t)row0 * NPROJ;
        float w2[16];
#pragma unroll
        for (int r = 0; r < 16; ++r) w2[r] = PIN(I_GLA_W2)[((size_t)(layer * 2 + d) * 16 + r) * 256 + c];
        const float gb = PIN(I_GLA_B)[(layer * 2 + d) * 256 + c];
        float bl[8]; float run = 0.f;
#pragma unroll
        for (int ii = 0; ii < 8; ++ii) { const int i8 = d ? 7 - ii : ii; const bf16_t* pr = pr0 + (size_t)(8 * tg + i8) * NPROJ + (d ? PA_GB : PA_GF); float z = gb;
#pragma unroll
            for (int r = 0; r < 16; ++r) z += bf2f(pr[r]) * w2[r];
            run += logsigmoidf_(z) * (1.0f / 16.0f); if (d) bl[7 - ii] = run; else bl[ii] = run; }
        gs[tg * 64 + cl] = run;
        { const float* sp = WSP(float, SC_GLA_S) + (size_t)u * 4096;
#pragma unroll
          for (int q = 0; q < 8; ++q) { const int e = tid + NTHR * q, dk = e >> 6, dv = e & 63; *(LAS bf16_t*)(sT + dv * TS + dk * 2) = (bf16_t)f2bf(sp[e]); } }
        __syncthreads();
        float off = 0.f;
#pragma unroll
        for (int g2 = 0; g2 < 8; ++g2) if (d ? g2 > tg : g2 < tg) off += gs[g2 * 64 + cl];
#pragma unroll
        for (int i8 = 0; i8 < 8; ++i8) { const int i = 8 * tg + i8; const bf16_t* pr = pr0 + (size_t)i * NPROJ; const float bi = bl[i8] + off;
            *(LAS bf16_t*)(qt + i * TS + cl * 2) = (bf16_t)f2bf(bf2f(pr[PA_Q + c]) * 0.125f * __expf(bi));
            *(LAS bf16_t*)(kt + i * TS + cl * 2) = (bf16_t)f2bf(bf2f(pr[PA_K + c]) * __expf(-bi));
            *(LAS bf16_t*)(vT + cl * TS + i * 2) = pr[PA_V + c]; }
        __syncthreads();
        const int mt = wave >> 1, nt0 = (wave & 1) * 2;
        { f32x4 acc[2] = {(f32x4){0.f, 0.f, 0.f, 0.f}, (f32x4){0.f, 0.f, 0.f, 0.f}};
          mm_rows<64, 2>(qt, TS, kt, TS, mt, nt0, fr, fq, acc);
#pragma unroll
          for (int t = 0; t < 2; ++t)
#pragma unroll
              for (int j = 0; j < 4; ++j) { const int i = 16 * mt + 4 * fq + j, jj = 16 * (nt0 + t) + fr; const bool keep = d ? jj >= i : jj <= i;
                  *(LAS bf16_t*)(att + i * TS + jj * 2) = (bf16_t)f2bf(keep ? acc[t][j] : 0.f); } }
        __syncthreads();
        { f32x4 acc[2] = {(f32x4){0.f, 0.f, 0.f, 0.f}, (f32x4){0.f, 0.f, 0.f, 0.f}};
          mm_rows<64, 2>(att, TS, vT, TS, mt, nt0, fr, fq, acc);
          mm_rows<64, 2>(qt, TS, sT, TS, mt, nt0, fr, fq, acc);
          bf16_t* ob = WSP(bf16_t, d ? SC_OB : SC_OF);
#pragma unroll
          for (int t = 0; t < 2; ++t)
#pragma unroll
              for (int j = 0; j < 4; ++j) ob[(size_t)(s0 + 16 * mt + 4 * fq + j) * 1024 + 64 * h + 16 * (nt0 + t) + fr] = (bf16_t)f2bf(acc[t][j]); }
        __syncthreads();
    }
}
constexpr int TS2 = 272;
__device__ __forceinline__ float ssd_acum(float a, int d, int lane, float& total) {
    float pre = a;
#pragma unroll
    for (int o = 1; o < 64; o <<= 1) { const float t = __shfl_up(pre, o); if (lane >= o) pre += t; }
    total = rl(pre, 63);
    return d ? total - pre + a : pre;
}
__device__ __forceinline__ void ssd_p1(const Cx& p, LAS unsigned char* lds, int layer, int b) {
    const int tid = p.tid, lane = tid & 63, wave = __builtin_amdgcn_readfirstlane(tid >> 6), fr = lane & 15, fq = lane >> 4;
    LAS unsigned char* BT = lds; LAS unsigned char* xT = lds + 128 * TS; LAS float* AC = (LAS float*)(lds + 128 * TS + 4 * 64 * TS);
    for (int u2 = p.bid; u2 < NTB * 2; u2 += p.G) { const int tb = u2 >> 1, g = u2 & 1, s0 = 64 * tb;
        const bf16_t* sx = WSP(bf16_t, SC_SX) + (size_t)s0 * 768; const float* sdt = WSP(float, SC_SDT) + (size_t)s0 * 8;
        if (wave < 4) { const int hd = wave, h = 2 * g + (hd >> 1), d = hd & 1; const float aneg = -__expf(PIN(I_SS_ALOG)[(layer * 2 + d) * 4 + h]);
            float tot; const float ac = ssd_acum(aneg * sdt[lane * 8 + d * 4 + h], d, lane, tot); AC[hd * 64 + lane] = ac; if (lane == 0) { AC[256 + hd] = tot; WSP(float, SC_SSD_CD)[(tb * 4 + h) * 2 + d] = __expf(tot); } }
#pragma unroll 2
        for (int q = 0; q < 16; ++q) { const int e = tid + NTHR * q, i = e >> 7, s = e & 127; *(LAS bf16_t*)(BT + s * TS + i * 2) = sx[(size_t)i * 768 + 256 + 128 * g + s]; }
        __syncthreads();
#pragma unroll 2
        for (int q = 0; q < 32; ++q) { const int e = tid + NTHR * q, hd = e >> 12, i = (e >> 6) & 63, pp = e & 63, h = 2 * g + (hd >> 1), d = hd & 1;
            const float x = bf2f(sx[(size_t)i * 768 + 64 * h + pp]) * sdt[i * 8 + d * 4 + h] * __expf(AC[256 + hd] - AC[hd * 64 + i]);
            *(LAS bf16_t*)(xT + (hd * 64 + pp) * TS + i * 2) = (bf16_t)f2bf(x); }
        __syncthreads();
        { const int hd = wave >> 1, half = wave & 1, h = 2 * g + (hd >> 1), d = hd & 1; float* cs = WSP(float, SC_SSD_S) + (size_t)((tb * 4 + h) * 2 + d) * 8192;
#pragma unroll 1
          for (int mt = 0; mt < 4; ++mt) { f32x4 acc[4];
#pragma unroll
              for (int t = 0; t < 4; ++t) acc[t] = (f32x4){0.f, 0.f, 0.f, 0.f};
              mm_rows<64, 4>(xT + hd * 64 * TS, TS, BT, TS, mt, 4 * half, fr, fq, acc);
#pragma unroll
              for (int t = 0; t < 4; ++t)
#pragma unroll
                  for (int j = 0; j < 4; ++j) cs[(16 * mt + 4 * fq + j) * 128 + 16 * (4 * half + t) + fr] = acc[t][j]; } }
        __syncthreads();
    }
}
__device__ __forceinline__ void ssd_chain(const Cx& p, int h, int d) {
    const int e0 = p.tid * 16;
    f32x4 s[4], na[4], nb[4]; float cda, cdb;
#pragma unroll
    for (int k = 0; k < 4; ++k) s[k] = (f32x4){0.f, 0.f, 0.f, 0.f};
#define SSD_LD(dst, cdst, n_) do { const int u_ = (chain_tb((n_), d) * 4 + h) * 2 + d; const float* c_ = WSP(float, SC_SSD_S) + (size_t)u_ * 8192 + e0; \
        _Pragma("unroll") for (int k = 0; k < 4; ++k) dst[k] = *(const f32x4*)(c_ + 4 * k); cdst = WSP(float, SC_SSD_CD)[u_]; } while (0)
#define SSD_ST(src, csrc, n_) do { const int u_ = (chain_tb((n_), d) * 4 + h) * 2 + d; float* c_ = WSP(float, SC_SSD_S) + (size_t)u_ * 8192 + e0; \
        _Pragma("unroll") for (int k = 0; k < 4; ++k) { *(f32x4*)(c_ + 4 * k) = s[k]; s[k] = s[k] * csrc + src[k]; } } while (0)
    SSD_LD(na, cda, 0); SSD_LD(nb, cdb, 1);
#pragma unroll 1
    for (int n = 0; n < NTB; n += 2) { f32x4 a[4]; float de;
#pragma unroll
        for (int k = 0; k < 4; ++k) a[k] = na[k];
        de = cda; if (n + 2 < NTB) SSD_LD(na, cda, n + 2);
        SSD_ST(a, de, n);
#pragma unroll
        for (int k = 0; k < 4; ++k) a[k] = nb[k];
        de = cdb; if (n + 3 < NTB) SSD_LD(nb, cdb, n + 3);
        SSD_ST(a, de, n + 1); }
#undef SSD_LD
#undef SSD_ST
}
__device__ __forceinline__ void ssd_p2(const Cx& p, LAS unsigned char* lds, int layer, int b) {
    const int tid = p.tid, lane = tid & 63, wave = __builtin_amdgcn_readfirstlane(tid >> 6), fr = lane & 15, fq = lane >> 4;
    LAS unsigned char* Ct = lds; LAS unsigned char* Bt2 = lds + 64 * TS2; LAS float* cb = (LAS float*)(lds + 2 * 64 * TS2); LAS float* AC = cb + 64 * 65;
    LAS unsigned char* Mt = (LAS unsigned char*)(AC + 260 + 4); LAS unsigned char* xT = Mt + 64 * TS; LAS unsigned char* Sb = xT + 64 * TS;
    const int mt = wave >> 1, nt0 = (wave & 1) * 2;
    for (int u2 = p.bid; u2 < NTB * 2; u2 += p.G) { const int tb = u2 >> 1, g = u2 & 1, s0 = 64 * tb;
        const bf16_t* sx = WSP(bf16_t, SC_SX) + (size_t)s0 * 768; const float* sdt = WSP(float, SC_SDT) + (size_t)s0 * 8;
        if (wave < 4) { const int hd = wave, h = 2 * g + (hd >> 1), d = hd & 1; const float aneg = -__expf(PIN(I_SS_ALOG)[(layer * 2 + d) * 4 + h]);
            float tot; const float ac = ssd_acum(aneg * sdt[lane * 8 + d * 4 + h], d, lane, tot); AC[hd * 64 + lane] = ac; }
#pragma unroll
        for (int q = 0; q < 2; ++q) { const int e = tid + NTHR * q, i = e >> 4, ch = e & 15;
            *(LAS u32x4*)(Ct + i * TS2 + ch * 16) = *(const u32x4*)(sx + (size_t)i * 768 + 512 + 128 * g + ch * 8);
            *(LAS u32x4*)(Bt2 + i * TS2 + ch * 16) = *(const u32x4*)(sx + (size_t)i * 768 + 256 + 128 * g + ch * 8); }
        __syncthreads();
        { f32x4 acc[2] = {(f32x4){0.f, 0.f, 0.f, 0.f}, (f32x4){0.f, 0.f, 0.f, 0.f}};
          mm_rows<128, 2>(Ct, TS2, Bt2, TS2, mt, nt0, fr, fq, acc);
#pragma unroll
          for (int t = 0; t < 2; ++t)
#pragma unroll
              for (int j = 0; j < 4; ++j) cb[(16 * mt + 4 * fq + j) * 65 + 16 * (nt0 + t) + fr] = acc[t][j]; }
        __syncthreads();
#pragma unroll 1
        for (int hd = 0; hd < 4; ++hd) { const int h = 2 * g + (hd >> 1), d = hd & 1;
            { const int i = tid >> 3, j0 = (tid & 7) * 8; const float ai = AC[hd * 64 + i]; unsigned w[4];
#pragma unroll
              for (int jj = 0; jj < 8; jj += 2) { float m[2];
#pragma unroll
                  for (int q = 0; q < 2; ++q) { const int j = j0 + jj + q; const bool keep = d ? j >= i : j <= i; m[q] = keep ? cb[i * 65 + j] * __expf(ai - AC[hd * 64 + j]) : 0.f; }
                  w[jj >> 1] = pk2(m[0], m[1]); }
              *(LAS u32x4*)(Mt + i * TS + j0 * 2) = (u32x4){w[0], w[1], w[2], w[3]}; }
#pragma unroll 2
            for (int q = 0; q < 8; ++q) { const int e = tid + NTHR * q, j = e >> 6, pp = e & 63;
                *(LAS bf16_t*)(xT + pp * TS + j * 2) = (bf16_t)f2bf(bf2f(sx[(size_t)j * 768 + 64 * h + pp]) * sdt[j * 8 + d * 4 + h]); }
            { const float* sp = WSP(float, SC_SSD_S) + (size_t)((tb * 4 + h) * 2 + d) * 8192;
#pragma unroll
              for (int q = 0; q < 4; ++q) { const int e = (tid + NTHR * q) * 4, pp = e >> 7, s = e & 127; const f32x4 v = *(const f32x4*)(sp + e);
                  *(LAS u32x2*)(Sb + pp * TS2 + s * 2) = (u32x2){pk2(v[0], v[1]), pk2(v[2], v[3])}; } }
            __syncthreads();
            { f32x4 acc[2] = {(f32x4){0.f, 0.f, 0.f, 0.f}, (f32x4){0.f, 0.f, 0.f, 0.f}};
              mm_rows<128, 2>(Ct, TS2, Sb, TS2, mt, nt0, fr, fq, acc);
#pragma unroll
              for (int j = 0; j < 4; ++j) { const float sc = __expf(AC[hd * 64 + 16 * mt + 4 * fq + j]); acc[0][j] *= sc; acc[1][j] *= sc; }
              mm_rows<64, 2>(Mt, TS, xT, TS, mt, nt0, fr, fq, acc);
              bf16_t* ob = WSP(bf16_t, d ? SC_OB : SC_OF);
#pragma unroll
              for (int t = 0; t < 2; ++t)
#pragma unroll
                  for (int j = 0; j < 4; ++j) ob[(size_t)(s0 + 16 * mt + 4 * fq + j) * 1024 + 512 + 64 * h + 16 * (nt0 + t) + fr] = (bf16_t)f2bf(acc[t][j]); }
            __syncthreads();
        }
    }
}
constexpr int AFS = 68;
#define DR_PIN16(x, b_) asm volatile("" : "+v"(x[(b_)+0]), "+v"(x[(b_)+1]), "+v"(x[(b_)+2]), "+v"(x[(b_)+3]), "+v"(x[(b_)+4]), "+v"(x[(b_)+5]), "+v"(x[(b_)+6]), "+v"(x[(b_)+7]), \
        "+v"(x[(b_)+8]), "+v"(x[(b_)+9]), "+v"(x[(b_)+10]), "+v"(x[(b_)+11]), "+v"(x[(b_)+12]), "+v"(x[(b_)+13]), "+v"(x[(b_)+14]), "+v"(x[(b_)+15]) :: "memory")
template <int J> __device__ __forceinline__ void dr_subst_step(float (&x)[64], const LAS float* AfT, const float sgn) {
    const float xj_ = sgn * x[J];
#pragma unroll
    for (int g_ = 0; g_ < 4; ++g_) if (16 * g_ + 15 > J) {
#pragma unroll
        for (int q_ = 0; q_ < 16; ++q_) if (16 * g_ + q_ > J) x[16 * g_ + q_] -= AfT[J * AFS + 16 * g_ + q_] * xj_;
        DR_PIN16(x, 16 * g_); }
    if constexpr (J + 1 < 63) dr_subst_step<J + 1>(x, AfT, sgn);
}
#define DR_SUBST(x, AfT, sgn) dr_subst_step<0>(x, AfT, sgn)
__device__ __forceinline__ int dr_mfrag_idx(int row, int col) { return (((row >> 4) * 2 + (col >> 5)) * 64 + ((col >> 2) & 3) * 16 + (row & 15)) * 8 + ((col >> 4) & 1) * 4 + (col & 3); }
__device__ __forceinline__ void gdn_p1(const Cx& p, LAS unsigned char* lds, int layer, int b) {
    const int wave = __builtin_amdgcn_readfirstlane(p.tid >> 6);
#define GDN_LANES const int lane = lane_id_asm(), tid = wave * 64 + lane, fr = lane & 15, fq = lane >> 4; (void)tid; (void)fr; (void)fq
    LAS unsigned char* kh = lds; LAS unsigned char* kb = lds + 64 * TS; LAS unsigned char* XT = lds + 2 * 64 * TS; LAS unsigned char* kdT = lds + 4 * 64 * TS;
    LAS float* Af = (LAS float*)(lds + 5 * 64 * TS); LAS float* GC = Af + 64 * AFS;
    const int mt = wave >> 1, nt0 = (wave & 1) * 2;
    for (int u = p.bid; u < NUNIT; u += p.G) { const int tb = u >> 3, h = (u >> 1) & 3, d = u & 1, s0 = 64 * tb;
        const bf16_t* dq = WSP(bf16_t, SC_DQ) + (size_t)s0 * 768; const float* dg = WSP(float, SC_DG) + (size_t)s0 * 16;
        if (wave == 0) { GDN_LANES; const int i = d ? 63 - lane : lane; float pre = dg[i * 16 + 8 + d * 4 + h];
#pragma unroll
            for (int o = 1; o < 64; o <<= 1) { const float t = __shfl_up(pre, o); if (lane >= o) pre += t; }
            GC[lane] = pre; GC[64 + lane] = dg[i * 16 + d * 4 + h]; }
        { GDN_LANES; const int r = tid >> 3, c0 = (tid & 7) * 8, i = d ? 63 - r : r; const float beta = dg[i * 16 + d * 4 + h];
          const u32x4 kv = *(const u32x4*)(dq + (size_t)i * 768 + 256 + 64 * h + c0); u32x4 kw;
#pragma unroll
          for (int q = 0; q < 4; ++q) kw[q] = pk2(__uint_as_float(kv[q] << 16) * beta, __uint_as_float(kv[q] & 0xffff0000u) * beta);
          *(LAS u32x4*)(kh + r * TS + c0 * 2) = kv; *(LAS u32x4*)(kb + r * TS + c0 * 2) = kw; }
        __syncthreads();
        const float gtot = GC[63];
        { GDN_LANES; f32x4 acc[2] = {(f32x4){0.f, 0.f, 0.f, 0.f}, (f32x4){0.f, 0.f, 0.f, 0.f}};
          mm_rows<64, 2>(kb, TS, kh, TS, mt, nt0, fr, fq, acc);
#pragma unroll
          for (int t = 0; t < 2; ++t)
#pragma unroll
              for (int j = 0; j < 4; ++j) { const int r = 16 * mt + 4 * fq + j, jj = 16 * (nt0 + t) + fr; Af[jj * AFS + r] = jj < r ? acc[t][j] * __expf(GC[r] - GC[jj]) : 0.f; } }
        { GDN_LANES;
#pragma unroll 2
        for (int q = 0; q < 8; ++q) { const int e = tid + NTHR * q, r = e >> 6, cc = e & 63;
            *(LAS bf16_t*)(kdT + cc * TS + r * 2) = (bf16_t)f2bf(bf2f(*(const LAS bf16_t*)(kh + r * TS + cc * 2)) * __expf(gtot - GC[r])); } }
        __syncthreads();
        if (wave < 2) { GDN_LANES; const int col = tid; float x[64];
            const bf16_t* vcol = dq + 512 + 64 * h + (col - 64);
            if (wave == 0) {
#pragma unroll
                for (int r = 0; r < 64; ++r) { x[r] = bf2f(*(const LAS bf16_t*)(kb + r * TS + col * 2)) * __expf(GC[r]); if ((r & 7) == 7) { asm volatile("" ::: "memory"); __builtin_amdgcn_sched_barrier(0); } }
            } else {
#pragma unroll
                for (int r = 0; r < 64; ++r) { x[r] = bf2f(vcol[(size_t)(d ? 63 - r : r) * 768]) * GC[64 + r]; if ((r & 7) == 7) { asm volatile("" ::: "memory"); __builtin_amdgcn_sched_barrier(0); } }
            }
            { const LAS float* Aop = Af; asm volatile("" : "+v"(Aop));
              DR_SUBST(x, Aop, 1.0f); }
            bf16_t* wu = WSP(bf16_t, SC_DR_WU) + (size_t)u * 8192;
#pragma unroll
            for (int r = 0; r < 64; r += 2) { *(LAS unsigned*)(XT + col * TS + r * 2) = pk2(x[r], x[r + 1]); wu[r * 128 + col] = (bf16_t)f2bf(x[r]); wu[(r + 1) * 128 + col] = (bf16_t)f2bf(x[r + 1]); } }
        __syncthreads();
        { GDN_LANES; f32x4 am[2] = {(f32x4){0.f, 0.f, 0.f, 0.f}, (f32x4){0.f, 0.f, 0.f, 0.f}}, an[2] = {(f32x4){0.f, 0.f, 0.f, 0.f}, (f32x4){0.f, 0.f, 0.f, 0.f}};
          mm_rows<64, 2>(kdT, TS, XT, TS, mt, nt0, fr, fq, am);
          mm_rows<64, 2>(kdT, TS, XT + 64 * TS, TS, mt, nt0, fr, fq, an);
          bf16_t* Mg = WSP(bf16_t, SC_DR_M) + (size_t)u * 4096; bf16_t* Ng = WSP(bf16_t, SC_DR_NS) + (size_t)u * 4096; const float eg = __expf(gtot);
#pragma unroll
          for (int t = 0; t < 2; ++t) {
#pragma unroll
              for (int j = 0; j < 4; ++j) { const int row = 16 * mt + 4 * fq + j, col = 16 * (nt0 + t) + fr; Mg[dr_mfrag_idx(row, col)] = (bf16_t)f2bf((row == col ? eg : 0.f) - am[t][j]); }
              *(u32x2*)(Ng + (((nt0 + t) * 4 + mt) * 64 + lane) * 4) = (u32x2){pk2(an[t][0], an[t][1]), pk2(an[t][2], an[t][3])}; } }
        __syncthreads();
    }
#undef GDN_LANES
}
__device__ __forceinline__ void dr_chain(const Cx& p, size_t offM, size_t offNS, int h, int d) {
    const int lane = p.tid & 63, cb = __builtin_amdgcn_readfirstlane(p.tid >> 6), fr = lane & 15, fq = lane >> 4;
    if (cb >= 4) return;
    f32x4 acc[4];
#pragma unroll
    for (int t = 0; t < 4; ++t) acc[t] = (f32x4){0.f, 0.f, 0.f, 0.f};
    bf16x8 mA[4][2], mB[4][2]; u32x2 nA[4], nB[4];
#define DR_LD(m, nn, n_) do { const int u_ = (chain_tb((n_), d) * 4 + h) * 2 + d; const bf16_t* M_ = WSP(bf16_t, offM) + (size_t)u_ * 4096; const bf16_t* N_ = WSP(bf16_t, offNS) + (size_t)u_ * 4096; \
        _Pragma("unroll") for (int t = 0; t < 4; ++t) { _Pragma("unroll") for (int ks = 0; ks < 2; ++ks) m[t][ks] = *(const bf16x8*)(M_ + ((t * 2 + ks) * 64 + lane) * 8); nn[t] = *(const u32x2*)(N_ + ((cb * 4 + t) * 64 + lane) * 4); } } while (0)
#define DR_STEP(m, nn, n_) do { const int u_ = (chain_tb((n_), d) * 4 + h) * 2 + d; bf16_t* ST_ = WSP(bf16_t, offNS) + (size_t)u_ * 4096 + (16 * cb + fr) * 64 + 4 * fq; \
        u32x2 sp_[4]; _Pragma("unroll") for (int t = 0; t < 4; ++t) { sp_[t] = (u32x2){pk2(acc[t][0], acc[t][1]), pk2(acc[t][2], acc[t][3])}; *(u32x2*)(ST_ + 16 * t) = sp_[t]; } \
        bf16x8 bf_[2]; _Pragma("unroll") for (int ks = 0; ks < 2; ++ks) { u32x4 w_ = (u32x4){sp_[2 * ks][0], sp_[2 * ks][1], sp_[2 * ks + 1][0], sp_[2 * ks + 1][1]}; bf_[ks] = __builtin_bit_cast(bf16x8, w_); } \
        _Pragma("unroll") for (int t = 0; t < 4; ++t) { f32x4 a_ = (f32x4){__uint_as_float(nn[t][0] << 16), __uint_as_float(nn[t][0] & 0xffff0000u), __uint_as_float(nn[t][1] << 16), __uint_as_float(nn[t][1] & 0xffff0000u)}; \
            a_ = __builtin_amdgcn_mfma_f32_16x16x32_bf16(m[t][0], bf_[0], a_, 0, 0, 0); acc[t] = __builtin_amdgcn_mfma_f32_16x16x32_bf16(m[t][1], bf_[1], a_, 0, 0, 0); } } while (0)
    DR_LD(mA, nA, 0); DR_LD(mB, nB, 1);
#pragma unroll 1
    for (int n = 0; n < NTB; n += 2) { bf16x8 m[4][2]; u32x2 nn[4];
#pragma unroll
        for (int t = 0; t < 4; ++t) { m[t][0] = mA[t][0]; m[t][1] = mA[t][1]; nn[t] = nA[t]; }
        if (n + 2 < NTB) DR_LD(mA, nA, n + 2);
        DR_STEP(m, nn, n);
#pragma unroll
        for (int t = 0; t < 4; ++t) { m[t][0] = mB[t][0]; m[t][1] = mB[t][1]; nn[t] = nB[t]; }
        if (n + 3 < NTB) DR_LD(mB, nB, n + 3);
        DR_STEP(m, nn, n + 1); }
#undef DR_LD
#undef DR_STEP
}
__device__ __forceinline__ void gdn_p2(const Cx& p, LAS unsigned char* lds, int layer, int b) {
    const int tid = p.tid, lane = tid & 63, wave = __builtin_amdgcn_readfirstlane(tid >> 6), fr = lane & 15, fq = lane >> 4;
    LAS unsigned char* qh = lds; LAS unsigned char* kh = lds + 64 * TS; LAS unsigned char* wt = lds + 2 * 64 * TS; LAS unsigned char* sT = lds + 3 * 64 * TS; LAS unsigned char* aq = lds + 4 * 64 * TS; LAS unsigned char* vnT = lds + 5 * 64 * TS;
    LAS float* GC = (LAS float*)(lds + 6 * 64 * TS);
    const int mt = wave >> 1, nt0 = (wave & 1) * 2;
    for (int u = p.bid; u < NUNIT; u += p.G) { const int tb = u >> 3, h = (u >> 1) & 3, d = u & 1, s0 = 64 * tb;
        const bf16_t* dq = WSP(bf16_t, SC_DQ) + (size_t)s0 * 768; const float* dg = WSP(float, SC_DG) + (size_t)s0 * 16;
        const bf16_t* wu = WSP(bf16_t, SC_DR_WU) + (size_t)u * 8192; const bf16_t* st = WSP(bf16_t, SC_DR_NS) + (size_t)u * 4096;
        if (wave == 0) { const int i = d ? 63 - lane : lane; float pre = dg[i * 16 + 8 + d * 4 + h];
#pragma unroll
            for (int o = 1; o < 64; o <<= 1) { const float t = __shfl_up(pre, o); if (lane >= o) pre += t; }
            GC[lane] = pre; }
        { const int r = tid >> 3, c0 = (tid & 7) * 8, i = d ? 63 - r : r;
          *(LAS u32x4*)(qh + r * TS + c0 * 2) = *(const u32x4*)(dq + (size_t)i * 768 + 64 * h + c0);
          *(LAS u32x4*)(kh + r * TS + c0 * 2) = *(const u32x4*)(dq + (size_t)i * 768 + 256 + 64 * h + c0);
          *(LAS u32x4*)(wt + r * TS + c0 * 2) = *(const u32x4*)(wu + r * 128 + c0);
          *(LAS u32x4*)(sT + r * TS + c0 * 2) = *(const u32x4*)(st + r * 64 + c0); }
        __syncthreads();
        { f32x4 acc[2] = {(f32x4){0.f, 0.f, 0.f, 0.f}, (f32x4){0.f, 0.f, 0.f, 0.f}};
          mm_rows<64, 2>(qh, TS, kh, TS, mt, nt0, fr, fq, acc);
#pragma unroll
          for (int t = 0; t < 2; ++t)
#pragma unroll
              for (int j = 0; j < 4; ++j) { const int r = 16 * mt + 4 * fq + j, jj = 16 * (nt0 + t) + fr; *(LAS bf16_t*)(aq + r * TS + jj * 2) = (bf16_t)f2bf(jj <= r ? acc[t][j] * __expf(GC[r] - GC[jj]) : 0.f); }
          f32x4 av[2] = {(f32x4){0.f, 0.f, 0.f, 0.f}, (f32x4){0.f, 0.f, 0.f, 0.f}};
          mm_rows<64, 2>(wt, TS, sT, TS, mt, nt0, fr, fq, av);
#pragma unroll
          for (int t = 0; t < 2; ++t) { const int dv = 16 * (nt0 + t) + fr; float vn[4];
#pragma unroll
              for (int j = 0; j < 4; ++j) vn[j] = bf2f(wu[(16 * mt + 4 * fq + j) * 128 + 64 + dv]) - av[t][j];
              *(LAS u32x2*)(vnT + dv * TS + (16 * mt + 4 * fq) * 2) = (u32x2){pk2(vn[0], vn[1]), pk2(vn[2], vn[3])}; } }
        __syncthreads();
        { f32x4 acc[2] = {(f32x4){0.f, 0.f, 0.f, 0.f}, (f32x4){0.f, 0.f, 0.f, 0.f}};
          mm_rows<64, 2>(qh, TS, sT, TS, mt, nt0, fr, fq, acc);
#pragma unroll
          for (int j = 0; j < 4; ++j) { const float sc = __expf(GC[16 * mt + 4 * fq + j]); acc[0][j] *= sc; acc[1][j] *= sc; }
          mm_rows<64, 2>(aq, TS, vnT, TS, mt, nt0, fr, fq, acc);
          bf16_t* ob = WSP(bf16_t, d ? SC_OB : SC_OF);
#pragma unroll
          for (int t = 0; t < 2; ++t)
#pragma unroll
              for (int j = 0; j < 4; ++j) { const int r = 16 * mt + 4 * fq + j, i = d ? 63 - r : r; ob[(size_t)(s0 + i) * 1024 + 768 + 64 * h + 16 * (nt0 + t) + fr] = (bf16_t)f2bf(acc[t][j]); } }
        __syncthreads();
    }
}
constexpr int LPS = 65;
#define RW_LP(LP, GS, lwp) do { const int lane_ = lane_id_asm(), c_ = lane_, tg_ = wave; float loc_[8]; float run_ = 0.f; \
        _Pragma("unroll") for (int ii = 0; ii < 8; ++ii) { const int r_ = 8 * tg_ + ii; run_ += (lwp)[(size_t)(d ? 63 - r_ : r_) * 256 + c_]; loc_[ii] = run_; } \
        (GS)[tg_ * 64 + c_] = run_; __syncthreads(); float off_ = 0.f; \
        _Pragma("unroll") for (int g2 = 0; g2 < 8; ++g2) if (g2 < tg_) off_ += (GS)[g2 * 64 + c_]; \
        _Pragma("unroll") for (int ii = 0; ii < 8; ++ii) (LP)[(8 * tg_ + ii) * LPS + c_] = loc_[ii] + off_; __syncthreads(); } while (0)
__device__ __forceinline__ void rw_p1(const Cx& p, LAS unsigned char* lds, int layer, int b) {
    const int wave = __builtin_amdgcn_readfirstlane(p.tid >> 6), mt = wave >> 1, nt0 = (wave & 1) * 2;
#define RW_LANES const int lane = lane_id_asm(), tid = wave * 64 + lane, fr = lane & 15, fq = lane >> 4; (void)tid; (void)fr; (void)fq
    LAS float* LP = (LAS float*)lds; LAS float* GS = (LAS float*)(lds + 16640);
    LAS unsigned char* zt = lds + 18688; LAS unsigned char* bt = lds + 27904; LAS unsigned char* kt = lds + 37120; LAS unsigned char* vT = lds + 46336; LAS unsigned char* Azk = lds + 55552;
    LAS float* Af = (LAS float*)(lds + 64768); LAS unsigned char* XT = lds + 82176;
    const bf16_t* proj = WSP(bf16_t, WS_PROJ);
    for (int u = p.bid; u < NUNIT; u += p.G) { const int tb = u >> 3, h = (u >> 1) & 3, d = u & 1, s0 = 64 * tb;
        const float* lwp = WSP(float, SC_RLW) + (size_t)d * SB * 256 + (size_t)s0 * 256 + 64 * h; const float* rk = WSP(float, SC_RK) + (size_t)s0 * 256 + 64 * h;
        const float* rkk = WSP(float, SC_RKK) + (size_t)s0 * 256 + 64 * h; const float* rb = WSP(float, SC_RB) + (size_t)s0 * 256 + 64 * h;
        const bf16_t* pr0 = proj + (size_t)tb_row0(b, tb) * NPROJ;
        RW_LP(LP, GS, lwp);
        { RW_LANES; const int r = tid >> 3, c0 = (tid & 7) * 8, i = d ? 63 - r : r; unsigned wz[4], wb[4], wk[4];
#pragma unroll
          for (int q = 0; q < 8; q += 2) { float z2[2], b2[2], k2[2];
#pragma unroll
              for (int e = 0; e < 2; ++e) { const int c = c0 + q + e; const float lp = LP[r * LPS + c], lw = lwp[(size_t)i * 256 + c], em = __expf(-lp);
                  z2[e] = -rkk[(size_t)i * 256 + c] * __expf(lp - lw); b2[e] = rb[(size_t)i * 256 + c] * em; k2[e] = rk[(size_t)i * 256 + c] * em; }
              wz[q >> 1] = pk2(z2[0], z2[1]); wb[q >> 1] = pk2(b2[0], b2[1]); wk[q >> 1] = pk2(k2[0], k2[1]); }
          *(LAS u32x4*)(zt + r * TS + c0 * 2) = (u32x4){wz[0], wz[1], wz[2], wz[3]}; *(LAS u32x4*)(bt + r * TS + c0 * 2) = (u32x4){wb[0], wb[1], wb[2], wb[3]}; *(LAS u32x4*)(kt + r * TS + c0 * 2) = (u32x4){wk[0], wk[1], wk[2], wk[3]};
#pragma unroll 2
          for (int q = 0; q < 8; ++q) { const int e = tid + NTHR * q, r2 = e >> 6, cc = e & 63; *(LAS bf16_t*)(vT + cc * TS + r2 * 2) = pr0[(size_t)(d ? 63 - r2 : r2) * NPROJ + PB_V + 64 * h + cc]; } }
        __syncthreads();
        { RW_LANES; f32x4 a1[2] = {(f32x4){0.f, 0.f, 0.f, 0.f}, (f32x4){0.f, 0.f, 0.f, 0.f}}, a2[2] = {(f32x4){0.f, 0.f, 0.f, 0.f}, (f32x4){0.f, 0.f, 0.f, 0.f}};
          mm_rows<64, 2>(zt, TS, bt, TS, mt, nt0, fr, fq, a1);
          mm_rows<64, 2>(zt, TS, kt, TS, mt, nt0, fr, fq, a2);
#pragma unroll
          for (int t = 0; t < 2; ++t)
#pragma unroll
              for (int j = 0; j < 4; ++j) { const int r = 16 * mt + 4 * fq + j, jj = 16 * (nt0 + t) + fr; Af[jj * AFS + r] = jj < r ? a1[t][j] : 0.f; *(LAS bf16_t*)(Azk + r * TS + jj * 2) = (bf16_t)f2bf(jj < r ? a2[t][j] : 0.f); } }
        __syncthreads();
        { RW_LANES; f32x4 a[2] = {(f32x4){0.f, 0.f, 0.f, 0.f}, (f32x4){0.f, 0.f, 0.f, 0.f}};
          mm_rows<64, 2>(Azk, TS, vT, TS, mt, nt0, fr, fq, a);
#pragma unroll
          for (int t = 0; t < 2; ++t) *(LAS u32x2*)(XT + (64 + 16 * (nt0 + t) + fr) * TS + (16 * mt + 4 * fq) * 2) = (u32x2){pk2(a[t][0], a[t][1]), pk2(a[t][2], a[t][3])};
#pragma unroll 2
          for (int q = 0; q < 8; ++q) { const int e = tid + NTHR * q, r2 = e >> 6, cc = e & 63, i2 = d ? 63 - r2 : r2; const float ed = __expf(LP[63 * LPS + cc] - LP[r2 * LPS + cc]);
              *(LAS bf16_t*)(bt + cc * TS + r2 * 2) = (bf16_t)f2bf(rb[(size_t)i2 * 256 + cc] * ed); *(LAS bf16_t*)(kt + cc * TS + r2 * 2) = (bf16_t)f2bf(rk[(size_t)i2 * 256 + cc] * ed); } }
        __syncthreads();
        if (wave < 2) { RW_LANES; const int col = tid; float x[64];
            if (wave == 0) {
#pragma unroll
                for (int r = 0; r < 64; ++r) { x[r] = bf2f(*(const LAS bf16_t*)(zt + r * TS + col * 2)); if ((r & 7) == 7) { asm volatile("" ::: "memory"); __builtin_amdgcn_sched_barrier(0); } }
            } else {
#pragma unroll
                for (int r = 0; r < 64; r += 2) { const unsigned w = *(const LAS unsigned*)(XT + col * TS + r * 2); x[r] = __uint_as_float(w << 16); x[r + 1] = __uint_as_float(w & 0xffff0000u); }
            }
            { const LAS float* Aop = Af; asm volatile("" : "+v"(Aop)); DR_SUBST(x, Aop, -1.0f); }
            bf16_t* wu = WSP(bf16_t, SC_RW_WU) + (size_t)u * 8192;
#pragma unroll
            for (int r = 0; r < 64; r += 2) { *(LAS unsigned*)(XT + col * TS + r * 2) = pk2(x[r], x[r + 1]); wu[r * 128 + col] = (bf16_t)f2bf(x[r]); wu[(r + 1) * 128 + col] = (bf16_t)f2bf(x[r + 1]); } }
        __syncthreads();
        { RW_LANES; f32x4 am[2] = {(f32x4){0.f, 0.f, 0.f, 0.f}, (f32x4){0.f, 0.f, 0.f, 0.f}}, an[2] = {(f32x4){0.f, 0.f, 0.f, 0.f}, (f32x4){0.f, 0.f, 0.f, 0.f}};
          mm_rows<64, 2>(bt, TS, XT, TS, mt, nt0, fr, fq, am);
          mm_rows<64, 2>(bt, TS, XT + 64 * TS, TS, mt, nt0, fr, fq, an);
          mm_rows<64, 2>(kt, TS, vT, TS, mt, nt0, fr, fq, an);
          bf16_t* Mg = WSP(bf16_t, SC_RW_M) + (size_t)u * 4096; bf16_t* Ng = WSP(bf16_t, SC_RW_NS) + (size_t)u * 4096;
#pragma unroll
          for (int t = 0; t < 2; ++t) {
#pragma unroll
              for (int j = 0; j < 4; ++j) { const int row = 16 * mt + 4 * fq + j, col = 16 * (nt0 + t) + fr; Mg[dr_mfrag_idx(row, col)] = (bf16_t)f2bf((row == col ? __expf(LP[63 * LPS + row]) : 0.f) + am[t][j]); }
              *(u32x2*)(Ng + (((nt0 + t) * 4 + mt) * 64 + lane) * 4) = (u32x2){pk2(an[t][0], an[t][1]), pk2(an[t][2], an[t][3])}; } }
        __syncthreads();
    }
}
__device__ __forceinline__ void rw_p2(const Cx& p, LAS unsigned char* lds, int layer, int b) {
    const int wave = __builtin_amdgcn_readfirstlane(p.tid >> 6), mt = wave >> 1, nt0 = (wave & 1) * 2;
    LAS float* LP = (LAS float*)lds; LAS float* GS = (LAS float*)(lds + 16640);
    LAS unsigned char* rt = lds + 18688; LAS unsigned char* bt = lds + 27904; LAS unsigned char* kt = lds + 37120; LAS unsigned char* vT = lds + 46336; LAS unsigned char* sT = lds + 55552; LAS unsigned char* wt = lds + 64768;
    LAS unsigned char* Arb = lds + 73984; LAS unsigned char* Ark = lds + 83200; LAS unsigned char* UT = lds + 92416;
    const bf16_t* proj = WSP(bf16_t, WS_PROJ);
    for (int u = p.bid; u < NUNIT; u += p.G) { const int tb = u >> 3, h = (u >> 1) & 3, d = u & 1, s0 = 64 * tb;
        const float* lwp = WSP(float, SC_RLW) + (size_t)d * SB * 256 + (size_t)s0 * 256 + 64 * h; const float* rk = WSP(float, SC_RK) + (size_t)s0 * 256 + 64 * h; const float* rb = WSP(float, SC_RB) + (size_t)s0 * 256 + 64 * h;
        const bf16_t* pr0 = proj + (size_t)tb_row0(b, tb) * NPROJ; const bf16_t* wu = WSP(bf16_t, SC_RW_WU) + (size_t)u * 8192; const bf16_t* st = WSP(bf16_t, SC_RW_NS) + (size_t)u * 4096;
        RW_LP(LP, GS, lwp);
        { RW_LANES; const int r = tid >> 3, c0 = (tid & 7) * 8, i = d ? 63 - r : r; unsigned wr[4], wb[4], wk[4];
          const u32x4 rv = *(const u32x4*)(pr0 + (size_t)i * NPROJ + PB_R + 64 * h + c0);
#pragma unroll
          for (int q = 0; q < 8; q += 2) { float r2[2], b2[2], k2[2];
#pragma unroll
              for (int e = 0; e < 2; ++e) { const int c = c0 + q + e; const float lp = LP[r * LPS + c], em = __expf(-lp); const unsigned w = rv[q >> 1];
                  r2[e] = (e ? __uint_as_float(w & 0xffff0000u) : __uint_as_float(w << 16)) * __expf(lp); b2[e] = rb[(size_t)i * 256 + c] * em; k2[e] = rk[(size_t)i * 256 + c] * em; }
              wr[q >> 1] = pk2(r2[0], r2[1]); wb[q >> 1] = pk2(b2[0], b2[1]); wk[q >> 1] = pk2(k2[0], k2[1]); }
          *(LAS u32x4*)(rt + r * TS + c0 * 2) = (u32x4){wr[0], wr[1], wr[2], wr[3]}; *(LAS u32x4*)(bt + r * TS + c0 * 2) = (u32x4){wb[0], wb[1], wb[2], wb[3]}; *(LAS u32x4*)(kt + r * TS + c0 * 2) = (u32x4){wk[0], wk[1], wk[2], wk[3]};
          *(LAS u32x4*)(wt + r * TS + c0 * 2) = *(const u32x4*)(wu + r * 128 + c0);
          *(LAS u32x4*)(sT + r * TS + c0 * 2) = *(const u32x4*)(st + r * 64 + c0);
#pragma unroll 2
          for (int q = 0; q < 8; ++q) { const int e = tid + NTHR * q, r2 = e >> 6, cc = e & 63; *(LAS bf16_t*)(vT + cc * TS + r2 * 2) = pr0[(size_t)(d ? 63 - r2 : r2) * NPROJ + PB_V + 64 * h + cc]; } }
        __syncthreads();
        { RW_LANES; f32x4 a1[2] = {(f32x4){0.f, 0.f, 0.f, 0.f}, (f32x4){0.f, 0.f, 0.f, 0.f}}, a2[2] = {(f32x4){0.f, 0.f, 0.f, 0.f}, (f32x4){0.f, 0.f, 0.f, 0.f}}, a3[2] = {(f32x4){0.f, 0.f, 0.f, 0.f}, (f32x4){0.f, 0.f, 0.f, 0.f}};
          mm_rows<64, 2>(rt, TS, bt, TS, mt, nt0, fr, fq, a1); mm_rows<64, 2>(rt, TS, kt, TS, mt, nt0, fr, fq, a2); mm_rows<64, 2>(wt, TS, sT, TS, mt, nt0, fr, fq, a3);
#pragma unroll
          for (int t = 0; t < 2; ++t) { const int dv = 16 * (nt0 + t) + fr; float uu[4];
#pragma unroll
              for (int j = 0; j < 4; ++j) { const int r = 16 * mt + 4 * fq + j, jj = dv; const bool keep = jj <= r;
                  *(LAS bf16_t*)(Arb + r * TS + jj * 2) = (bf16_t)f2bf(keep ? a1[t][j] : 0.f); *(LAS bf16_t*)(Ark + r * TS + jj * 2) = (bf16_t)f2bf(keep ? a2[t][j] : 0.f);
                  uu[j] = bf2f(wu[r * 128 + 64 + dv]) + a3[t][j]; }
              *(LAS u32x2*)(UT + dv * TS + (16 * mt + 4 * fq) * 2) = (u32x2){pk2(uu[0], uu[1]), pk2(uu[2], uu[3])}; } }
        __syncthreads();
        { RW_LANES; f32x4 acc[2] = {(f32x4){0.f, 0.f, 0.f, 0.f}, (f32x4){0.f, 0.f, 0.f, 0.f}};
          mm_rows<64, 2>(rt, TS, sT, TS, mt, nt0, fr, fq, acc); mm_rows<64, 2>(Arb, TS, UT, TS, mt, nt0, fr, fq, acc); mm_rows<64, 2>(Ark, TS, vT, TS, mt, nt0, fr, fq, acc);
          bf16_t* ob = WSP(bf16_t, d ? SC_OB : SC_OF);
#pragma unroll
          for (int t = 0; t < 2; ++t)
#pragma unroll
              for (int j = 0; j < 4; ++j) { const int r = 16 * mt + 4 * fq + j, i = d ? 63 - r : r; ob[(size_t)(s0 + i) * 1024 + 256 + 64 * h + 16 * (nt0 + t) + fr] = (bf16_t)f2bf(acc[t][j]); } }
        __syncthreads();
    }
#undef RW_LANES
}
__device__ __forceinline__ void phase_scan(const Cx& p, int layer, int b) {
    for (int ch = p.bid; ch < 32; ch += p.G) { const int mixer = ch >> 3, h = (ch >> 1) & 3, d = ch & 1;
        if (mixer == 0) gla_chain(p, h, d);
        else if (mixer == 1) dr_chain(p, SC_RW_M, SC_RW_NS, h, d);
        else if (mixer == 2) ssd_chain(p, h, d);
        else dr_chain(p, SC_DR_M, SC_DR_NS, h, d); }
}
#ifndef MK_NAIVE
#define MK_NAIVE 0
#endif
__device__ __forceinline__ float dot_bf16(const bf16_t* a, const bf16_t* b, int K) {
    float s = 0.f;
    for (int k = 0; k < K; k += 8) { const u32x4 av = *(const u32x4*)(a + k), bv = *(const u32x4*)(b + k);
#pragma unroll
        for (int j = 0; j < 4; ++j) { s += __uint_as_float(av[j] << 16) * __uint_as_float(bv[j] << 16); s += __uint_as_float(av[j] & 0xffff0000u) * __uint_as_float(bv[j] & 0xffff0000u); } }
    return s;
}
__device__ __forceinline__ void naive_proj(const Cx& p, int layer) {
    const bf16_t* A = WSP(bf16_t, WS_HBUF); const bf16_t* Bt = WSP(bf16_t, WS_WIN) + (size_t)layer * NPROJ * D; bf16_t* O = WSP(bf16_t, WS_PROJ);
    for (size_t i = (size_t)p.bid * NTHR + p.tid; i < (size_t)ROWS * NPROJ; i += (size_t)p.G * NTHR) { const int r = (int)(i / NPROJ), c = (int)(i % NPROJ);
        O[i] = (bf16_t)f2bf(dot_bf16(A + (size_t)r * D, Bt + (size_t)c * D, D)); }
}
__device__ __forceinline__ void naive_res(const Cx& p, int layer) {
    const bf16_t* A = WSP(bf16_t, WS_HBUF); const bf16_t* Bt = WSP(bf16_t, WS_WOUT) + (size_t)layer * D * D; const float* gate = WSP(float, WS_MOD) + (size_t)layer * 5 * 6144 + 2048;
    for (size_t i = (size_t)p.bid * NTHR + p.tid; i < (size_t)ROWS * D; i += (size_t)p.G * NTHR) { const int r = (int)(i / D), c = (int)(i % D);
        const float y = dot_bf16(A + (size_t)r * D, Bt + (size_t)c * D, D); const float* src = res_row(p, layer == 0, r); float* dst = (float*)res_row(p, 0, r);
        dst[c] = src[c] + gate[row_sel(r) * 6144 + c] * y; }
}
__device__ __forceinline__ void naive_gu(const Cx& p, LAS int* tb, int layer, int row_lo) {
    const bf16_t* A = WSP(bf16_t, WS_HBUF); bf16_t* H = WSP(bf16_t, WS_H); const int* ltok = WSP(int, WS_LTOK);
    const int ntile = tb[128 + NE1];
    for (size_t i = (size_t)p.bid * NTHR + p.tid; i < (size_t)ntile * 256 * EH; i += (size_t)p.G * NTHR) { const int hr = (int)(i / EH), j = (int)(i % EH), tile = hr >> 8;
        int e = 0; while (e < NE && tb[128 + e + 1] <= tile) ++e;
        const int ri = (tile - tb[128 + e]) * 256 + (hr & 255); const int tok = ri < tb[e] ? (e == NE ? row_lo + ri : ltok[(size_t)e * ROWS + ri]) : row_lo;
        const bf16_t* W = WSP(bf16_t, WS_EXPGU) + (size_t)e * 512 * D; const int rg = (j >> 4) * 32 + (j & 15);
        const float g = dot_bf16(A + (size_t)tok * D, W + (size_t)rg * D, D), up = dot_bf16(A + (size_t)tok * D, W + (size_t)(rg + 16) * D, D);
        H[i] = (bf16_t)f2bf(g / (1.0f + __expf(-g)) * up); }
}
__device__ __forceinline__ void naive_down(const Cx& p, LAS int* tb, int layer, int row_lo) {
    const bf16_t* H = WSP(bf16_t, WS_H); const int* ltok = WSP(int, WS_LTOK); const float* lw = WSP(float, WS_LW); int* accb = WSP(int, WS_ACC);
    const float* gate = WSP(float, WS_MOD) + (size_t)layer * 5 * 6144 + 5120; const int ntile = tb[128 + NE1];
    for (size_t i = (size_t)p.bid * NTHR + p.tid; i < (size_t)ntile * 256 * D; i += (size_t)p.G * NTHR) { const int hr = (int)(i / D), c = (int)(i % D), tile = hr >> 8;
        int e = 0; while (e < NE && tb[128 + e + 1] <= tile) ++e;
        const int ri = (tile - tb[128 + e]) * 256 + (hr & 255); if (ri >= tb[e]) continue;
        const int tok = e == NE ? row_lo + ri : ltok[(size_t)e * ROWS + ri]; const float w = e == NE ? 1.0f : lw[(size_t)e * ROWS + ri];
        const float y = dot_bf16(H + (size_t)hr * EH, WSP(bf16_t, WS_EXPD) + (size_t)e * D * EH + (size_t)c * EH, EH);
        atomicAdd(accb + (size_t)tok * D + c, (int)rintf(y * gate[row_sel(tok) * 6144 + c] * w * ACC_SCALE)); }
}
#ifndef MK_ABL
#define MK_ABL 0
#endif
#ifndef MK_PERT
#define MK_PERT 0
#endif
#ifndef MK_FILL_LO
#define MK_FILL_LO 0
#define MK_FILL_HI 143360
#endif
#ifndef MK_ONE_LAUNCH
#define MK_ONE_LAUNCH 1
#endif
constexpr int N_PHASES = 1 + NL * (2 + 5 * NB + 4) + 1 + ((MK_NAIVE & 64) ? 1 : 0) + ((MK_PERT == 101 || MK_PERT == 102) ? NL : 0);

__global__ void __launch_bounds__(NTHR, 2) mega_fwd(Params pp) {
    extern __shared__ __attribute__((aligned(16))) unsigned char lds_raw[];
    LAS unsigned char* lds = (LAS unsigned char*)lds_raw;
    const int swave = __builtin_amdgcn_readfirstlane(threadIdx.x >> 6);
    for (int i = threadIdx.x; i < (LDS_BYTES - LDS_CTL) / 4; i += NTHR) ((LAS unsigned*)(lds + LDS_CTL))[i] = 0u;
    __syncthreads();
    if (threadIdx.x < N_IN + 2) { const unsigned long long a = threadIdx.x < N_IN ? (unsigned long long)pp.in[threadIdx.x] : (threadIdx.x == N_IN ? (unsigned long long)pp.out : (unsigned long long)pp.ws); ((LAS unsigned*)(lds + LDS_PTRS))[2 * threadIdx.x] = (unsigned)a; ((LAS unsigned*)(lds + LDS_PTRS))[2 * threadIdx.x + 1] = (unsigned)(a >> 32); }
    __syncthreads();
    XcdBarrier bar = xcd_barrier_post((unsigned*)(pp.ws + WS_CTL) + CW_BAR + pp.li * XCD_BAR_WORDS, (volatile LAS unsigned*)(lds + LDS_CTL), threadIdx.x);
    LAS int* tb = (LAS int*)(lds + LDS_CTL + 64);
    int pc = 0; const int lo = pp.lo, hi = pp.hi;
#define PH_BEGIN if (pc >= lo && pc < hi) { Cx p; p.out = (float*)PIN(N_IN); p.ws = (unsigned char*)PIN(N_IN + 1); p.tid = swave * 64 + lane_id_asm(); p.bid = blockIdx.x; p.G = gridDim.x; p.pad = 0; asm volatile("" : "+s"(p.out), "+s"(p.ws), "+v"(p.tid), "+s"(p.bid), "+s"(p.G)); const int G = p.G, bid = p.bid;
#define PH_END if (pc + 1 < hi) { if (MK_PERT == 100) __builtin_amdgcn_fence(__ATOMIC_RELEASE, ""); XcdBarrier b2 = bar; asm volatile("" : "+s"(b2.bar), "+s"(b2.x)); xcd_barrier(b2, (unsigned)(swave * 64 + lane_id_asm())); if (MK_PERT == 100) { __builtin_amdgcn_fence(__ATOMIC_ACQUIRE, ""); asm volatile("s_waitcnt vmcnt(0)" ::: "memory"); __syncthreads(); } if (MK_PERT >= 200 && (MK_PERT == 200 || pc == MK_PERT - 201 || pc == MK_PERT - 201 + 18)) { for (int i_ = MK_FILL_LO / 4 + swave * 64 + lane_id_asm(); i_ < MK_FILL_HI / 4; i_ += NTHR) ((LAS unsigned*)lds)[i_] = 0x7FC07FC0u; __syncthreads(); } } } ++pc;

    PH_BEGIN
        for (int u = bid; u < CONV_A_UNITS; u += G) conv_unit_A(p, (LAS float*)lds, u);
        __syncthreads();
        phase_mod(p, lds);
    PH_END

#pragma unroll
    for (int layer = 0; layer < NL; ++layer) {
        const int row_lo = layer == NL - 1 ? CROWS : 0;
        PH_BEGIN
            phase_norm1(p, layer);
        PH_END
        PH_BEGIN
            DenseSched S; S.init(ROWS, NPROJ, D, WSP(bf16_t, WS_WIN) + (size_t)layer * NPROJ * D, G, bid);
            EpiProj E{WSP(bf16_t, WS_PROJ), NPROJ};
            if (MK_NAIVE & 1) naive_proj(p, layer); else
            pg8::gemm_phase<D>(p.tid, lds, (const char*)WSP(bf16_t, WS_HBUF), S, E);
        PH_END
#pragma unroll 1
        for (int b = 0; b < NB; ++b) {
            PH_BEGIN phase_prep(p, lds, layer, b); PH_END
            PH_BEGIN if (MK_CHUNK & 1) gla_p1(p, lds, layer, b); if (MK_CHUNK & 2) { __syncthreads(); ssd_p1(p, lds, layer, b); } if (MK_CHUNK & 4) { __syncthreads(); gdn_p1(p, lds, layer, b); } __syncthreads(); rw_p1(p, lds, layer, b); PH_END
            PH_BEGIN phase_scan(p, layer, b); PH_END
            PH_BEGIN if (MK_CHUNK & 1) gla_p2(p, lds, layer, b); if (MK_CHUNK & 2) { __syncthreads(); ssd_p2(p, lds, layer, b); } if (MK_CHUNK & 4) { __syncthreads(); gdn_p2(p, lds, layer, b); } __syncthreads(); rw_p2(p, lds, layer, b); PH_END
            PH_BEGIN phase_post(p, layer, b); PH_END
        }
        PH_BEGIN
            DenseSched S; S.init(ROWS, D, D, WSP(bf16_t, WS_WOUT) + (size_t)layer * D * D, G, bid);
            EpiRes E{layer == 0 ? PIN(I_X) : (const float*)p.out, layer == 0 ? PIN(I_CTX) : (const float*)WSP(float, WS_CTXRES), p.out, WSP(float, WS_CTXRES), WSP(float, WS_MOD) + (size_t)layer * 5 * 6144 + 2048};
            if (MK_PERT == 1 + 2 * layer) E.pert = 1e-5f;
            if (MK_NAIVE & 256) { EpiF32T E2{WSP(float, WS_SCR)};
                pg8::gemm_phase<D>(p.tid, lds, (const char*)WSP(bf16_t, WS_HBUF), S, E2);
                { XcdBarrier b3 = bar; asm volatile("" : "+s"(b3.bar), "+s"(b3.x)); xcd_barrier(b3, (unsigned)(swave * 64 + lane_id_asm())); }
                const float* gate2 = WSP(float, WS_MOD) + (size_t)layer * 5 * 6144 + 2048;
                for (size_t i = (size_t)p.bid * NTHR + p.tid; i < (size_t)ROWS * D; i += (size_t)p.G * NTHR) { const int r = (int)(i / D), c = (int)(i % D);
                    const float* src = res_row(p, layer == 0, r); float* dst = (float*)res_row(p, 0, r);
                    dst[c] = src[c] + gate2[row_sel(r) * 6144 + c] * WSP(float, WS_SCR)[i]; }
            } else
            if (MK_NAIVE & 2) naive_res(p, layer); else if (MK_NAIVE & 32) { EpiF32T E2{WSP(float, WS_SCR)};
                pg8::gemm_phase<D>(p.tid, lds, (const char*)WSP(bf16_t, WS_HBUF), S, E2);
                asm volatile("s_waitcnt vmcnt(0)" ::: "memory"); __syncthreads();
                pg8::Unit u2; const float* gate2 = WSP(float, WS_MOD) + (size_t)layer * 5 * 6144 + 2048;
                unsigned bad = 0; float sdiff = 0.f, sref = 0.f;
                for (int it = 0; S.next(it, u2); ++it)
                    for (int e2 = p.tid; e2 < 256 * 256; e2 += NTHR) { const int r = u2.pm * 256 + (e2 >> 8), c = u2.pn * 256 + (e2 & 255);
                        if (MK_NAIVE & 128) { const float yn = dot_bf16(WSP(bf16_t, WS_HBUF) + (size_t)r * D, WSP(bf16_t, WS_WOUT) + (size_t)layer * D * D + (size_t)c * D, D);
                            const float dd = yn - WSP(float, WS_SCR)[(size_t)r * D + c]; sdiff += dd * dd; sref += yn * yn;
                            if (!(fabsf(dd) <= 0.01f)) ++bad; }
                        const float* src = res_row(p, layer == 0, r); float* dst = (float*)res_row(p, 0, r);
                        dst[c] = src[c] + gate2[row_sel(r) * 6144 + c] * WSP(float, WS_SCR)[(size_t)r * D + c]; }
                if ((MK_NAIVE & 128) && bad) atomicAdd(WSP(unsigned, WS_CTL) + 900 + layer, bad);
                if (MK_NAIVE & 128) { sdiff = wsum(sdiff); sref = wsum(sref); if ((p.tid & 63) == 0) { atomicAdd(WSP(float, WS_CTL) + 910 + layer, sdiff); atomicAdd(WSP(float, WS_CTL) + 920 + layer, sref); } }
            } else if (MK_NAIVE & 16) { S.single = 1;
#pragma unroll 1
                for (int rd = 0; rd < 3; ++rd) { S.round = rd; pg8::gemm_phase<D>(p.tid, lds, (const char*)WSP(bf16_t, WS_HBUF), S, E); __syncthreads(); } } else
            pg8::gemm_phase<D>(p.tid, lds, (const char*)WSP(bf16_t, WS_HBUF), S, E);
            if (MK_PERT == 103) { __syncthreads(); for (int i = p.tid; i < 140 * 1024 / 4; i += NTHR) ((LAS unsigned*)lds)[i] = 0u; __syncthreads(); }
        PH_END
#if MK_NAIVE & 64
        if (layer == 0) { PH_BEGIN
            const bf16_t* A = WSP(bf16_t, WS_HBUF); const bf16_t* Bt = WSP(bf16_t, WS_WOUT); const float* gate = WSP(float, WS_MOD) + 2048; unsigned bad = 0;
            for (size_t i = (size_t)p.bid * NTHR + p.tid; i < (size_t)ROWS * D; i += (size_t)p.G * NTHR) { const int r = (int)(i / D), c = (int)(i % D);
                const float y = dot_bf16(A + (size_t)r * D, Bt + (size_t)c * D, D); const float ref = res_row(p, 1, r)[c] + gate[row_sel(r) * 6144 + c] * y;
                const float got = res_row(p, 0, r)[c]; if (!(fabsf(got - ref) <= 0.01f)) ++bad; }
            if (bad) atomicAdd(WSP(unsigned, WS_CTL) + 900, bad);
        PH_END }
#endif
#if MK_PERT == 101 || MK_PERT == 102
        PH_BEGIN
            if (MK_PERT == 101) { const unsigned long long t0 = __builtin_amdgcn_s_memrealtime(); while (__builtin_amdgcn_s_memrealtime() - t0 < 2000000ull) __builtin_amdgcn_s_sleep(32); }
            else { float acc_ = 0.f; const float* wsf = (const float*)p.ws;
                for (int rep = 0; rep < 2; ++rep) for (size_t i = (size_t)p.bid * NTHR + p.tid; i < (size_t)150000000; i += (size_t)p.G * NTHR) acc_ += __builtin_nontemporal_load(wsf + i);
                if (acc_ == 1.2345f) WSP(float, WS_CTL)[950] = acc_; }
        PH_END
#endif
        PH_BEGIN phase_norm2(p, lds, layer, row_lo);
            __syncthreads();
            for (int u = bid; u < CONV_E_UNITS; u += G) conv_unit_E(p, (LAS float*)lds, layer, u);
        PH_END
        PH_BEGIN
            moe_table(p, tb, layer, row_lo);
            MoeSched<true> S{tb + 128, tb, 2, G, bid, D, row_lo, WSP(int, WS_LTOK), (const char*)WSP(bf16_t, WS_EXPGU), (size_t)512 * D * 2};
            EpiGU E{WSP(bf16_t, WS_H)};
            if (MK_NAIVE & 4) naive_gu(p, tb, layer, row_lo); else
            pg8::gemm_phase<D>(p.tid, lds, (const char*)WSP(bf16_t, WS_HBUF), S, E);
        PH_END
        PH_BEGIN
            moe_table(p, tb, layer, row_lo);
            MoeSched<false> S{tb + 128, tb, 4, G, bid, EH, row_lo, WSP(int, WS_LTOK), (const char*)WSP(bf16_t, WS_EXPD), (size_t)D * EH * 2};
            EpiDown E{WSP(int, WS_ACC), WSP(float, WS_MOD) + (size_t)layer * 5 * 6144 + 5120, WSP(int, WS_LTOK), WSP(float, WS_LW), tb, row_lo};
            if (MK_NAIVE & 8) naive_down(p, tb, layer, row_lo); else
            pg8::gemm_phase<EH>(p.tid, lds, (const char*)WSP(bf16_t, WS_H), S, E);
        PH_END
    }
    PH_BEGIN phase_final(p);
#if MK_NAIVE & (64 | 128)
        { __syncthreads(); const unsigned cntb = __hip_atomic_load(WSP(unsigned, WS_CTL) + ((MK_NAIVE & 128) ? 901 : 900), __ATOMIC_RELAXED, __HIP_MEMORY_SCOPE_AGENT); int code = 0; for (unsigned v = cntb; v; v /= 10) ++code;
          if (MK_NAIVE & 128) { const float sd = __uint_as_float(__hip_atomic_load(WSP(unsigned, WS_CTL) + 911, __ATOMIC_RELAXED, __HIP_MEMORY_SCOPE_AGENT)), sr = __uint_as_float(__hip_atomic_load(WSP(unsigned, WS_CTL) + 921, __ATOMIC_RELAXED, __HIP_MEMORY_SCOPE_AGENT));
            const float lg = -log10f(sd / sr + 1e-30f); code = lg < 0.f ? 0 : (lg > 9.f ? 9 : (int)(lg + 0.5f)); }
          const float sc = 1.0f + 0.1f * code; const int lane = p.tid & 63, wave = p.tid >> 6;
          for (int r = p.bid * 8 + wave; r < NB * SEQ; r += p.G * 8) for (int i = 0; i < 16; ++i) p.out[(size_t)r * D + i * 64 + lane] *= sc; }
#endif
    PH_END
#undef PH_BEGIN
#undef PH_END
}

extern "C" void kernel_launch(void* const* d_in, const int* in_sizes, int n_in, void* d_out, int out_size, void* d_ws, size_t ws_size, hipStream_t stream) {
    static int grid = 0;
    if (grid == 0) {
        if (n_in != N_IN || in_sizes[0] != NB * SEQ * D || out_size != NB * SEQ * D || ws_size < WS_END) {
            fprintf(stderr, "kernel_launch: unexpected shapes (n_in %d, in0 %d, out %d, ws %zu); nothing launched\n", n_in, n_in > 0 ? in_sizes[0] : -1, out_size, ws_size); grid = -1; return; }
        int dev = 0, cus = 0, per_cu = 0;
        if (hipGetDevice(&dev) != hipSuccess || hipDeviceGetAttribute(&cus, hipDeviceAttributeMultiprocessorCount, dev) != hipSuccess) { grid = -1; return; }
        if (hipFuncSetAttribute((const void*)mega_fwd, hipFuncAttributeMaxDynamicSharedMemorySize, LDS_BYTES) != hipSuccess) { fprintf(stderr, "kernel_launch: hipFuncSetAttribute failed\n"); grid = -1; return; }
        if (hipOccupancyMaxActiveBlocksPerMultiprocessor(&per_cu, (const void*)mega_fwd, NTHR, LDS_BYTES) != hipSuccess || per_cu < 1) { fprintf(stderr, "kernel_launch: occupancy query says %d\n", per_cu); per_cu = 1; }
        (void)hipGetLastError();
        grid = cus * 1;
    }
    if (grid < 0) return;
    if (hipMemsetAsync((char*)d_ws + WS_CTL, 0, CTL_ZERO_BYTES, stream) != hipSuccess) return;
    Params p{};
    for (int i = 0; i < N_IN; ++i) p.in[i] = (const float*)d_in[i];
    p.out = (float*)d_out; p.ws = (unsigned char*)d_ws; p.pad = 0;
#if MK_ONE_LAUNCH
    p.lo = 0; p.hi = N_PHASES; p.li = 0;
    hipLaunchKernelGGL(mega_fwd, dim3(grid), dim3(NTHR), LDS_BYTES, stream, p);
#else
    for (int k = 0; k < N_PHASES; ++k) { p.lo = k; p.hi = k + 1; p.li = k;
        hipLaunchKernelGGL(mega_fwd, dim3(grid), dim3(NTHR), LDS_BYTES, stream, p); }
#endif
}
```

```cpp
#include <hip/hip_runtime.h>
#ifndef MK_ABL
#define MK_ABL 0
#endif
#include <cstdio>
#include <cstdint>

typedef unsigned short bf16_t;
typedef short bf16x8 __attribute__((ext_vector_type(8)));
typedef float f32x4 __attribute__((ext_vector_type(4)));
typedef float f32x2 __attribute__((ext_vector_type(2)));
typedef unsigned u32x4 __attribute__((ext_vector_type(4)));
typedef unsigned u32x2 __attribute__((ext_vector_type(2)));

constexpr int NB = 4, SEQ = 8192, NCTX = 256, D = 1024, NL = 2;
constexpr int CROWS = NB * NCTX;
constexpr int ROWS = CROWS + NB * SEQ;
constexpr int SB = NCTX + SEQ;
constexpr int INW = 4056, NPROJ = 4096;
constexpr int NE = 64, NE1 = 65, TOPK = 8, EH = 256;
constexpr int GRIDW = 64, GRIDH = SEQ / GRIDW;
constexpr int PA_Q = 0, PA_K = 256, PA_V = 512, PA_G = 768, PA_GF = 1024, PA_GB = 1040;
constexpr int PB_R = 1056, PB_K = 1312, PB_V = 1568, PB_WF = 1824, PB_WB = 1856, PB_A = 1888, PB_G = 1920;
constexpr int PC_Z = 1984, PC_X = 2240, PC_DF = 3008, PC_DB = 3012;
constexpr int PD_Q = 3016, PD_Z = 3784, PD_BF = 4040, PD_BB = 4044, PD_AF = 4048, PD_AB = 4052;
enum { I_X = 0, I_C, I_CTX, I_CCTX, I_N1G, I_N2G, I_WMOD, I_BMOD, I_WIN, I_WOUT, I_GLA_W2, I_GLA_B, I_GLA_NG,
       I_RW_W2, I_RW_W0, I_RW_AW2, I_RW_A0, I_RW_GW2, I_RW_KK, I_RW_KA, I_RW_RK, I_RW_LNG, I_RW_LNB,
       I_SS_CW, I_SS_CB, I_SS_ALOG, I_SS_DTB, I_SS_D, I_SS_NG, I_DN_CW, I_DN_ALOG, I_DN_DTB, I_DN_NG,
       I_ROUT_W, I_ROUT_B, I_EXP_G, I_EXP_U, I_EXP_D, I_SH_G, I_SH_U, I_SH_D, I_FNG, N_IN };
static_assert(N_IN == 42, "input count");

constexpr size_t MiB = 1u << 20;
constexpr size_t WS_CTL = 0, CTL_ZERO_BYTES = 1 * MiB;
constexpr size_t WS_MOD = 1 * MiB;
constexpr size_t WS_WIN = 2 * MiB;
constexpr size_t WS_WOUT = 18 * MiB;
constexpr size_t WS_ROUT = 22 * MiB;
constexpr size_t WS_CTXRES = 23 * MiB;
constexpr size_t WS_EXPGU = 27 * MiB;
constexpr size_t WS_EXPD = 92 * MiB;
constexpr size_t WS_HBUF = 125 * MiB;
constexpr size_t WS_PROJ = 191 * MiB;
constexpr size_t WS_SCR = 455 * MiB;
constexpr size_t WS_END = 640455456;
constexpr int HROWS_MAX = ROWS * 9 + NE1 * 256;
constexpr size_t WS_Y = WS_HBUF;
constexpr size_t WS_H = 443 * MiB;
constexpr size_t WS_LTOK = 600 * MiB;
constexpr size_t WS_TOKT = WS_LTOK + (size_t)NE * ROWS * 4;
static_assert(WS_Y + (size_t)HROWS_MAX * 512 * 2 <= WS_H && WS_H + (size_t)HROWS_MAX * 256 * 2 <= WS_LTOK && WS_TOKT + (size_t)ROWS * 64 <= WS_END, "moe overlay");
constexpr size_t SC_OF = WS_SCR;
constexpr size_t SC_OB = SC_OF + (size_t)SB * 1024 * 2;
constexpr size_t SC_RK = SC_OB + (size_t)SB * 1024 * 2;
constexpr size_t SC_RKK = SC_RK + (size_t)SB * 256 * 4;
constexpr size_t SC_RB = SC_RKK + (size_t)SB * 256 * 4;
constexpr size_t SC_RLW = SC_RB + (size_t)SB * 256 * 4;
constexpr size_t SC_SX = SC_RLW + (size_t)2 * SB * 256 * 4;
constexpr size_t SC_DQ = SC_SX + (size_t)SB * 768 * 2;
constexpr size_t SC_SDT = SC_DQ + (size_t)SB * 768 * 2;
constexpr size_t SC_DG = SC_SDT + (size_t)SB * 8 * 4;
constexpr size_t SC_FEND = SC_DG + (size_t)SB * 16 * 4;
constexpr int NTB = SB / 64, NUNIT = NTB * 4 * 2;
constexpr size_t SC_RW_M = SC_FEND;
constexpr size_t SC_RW_NS = SC_RW_M + (size_t)(SB / 64 * 8) * 4096 * 2;
constexpr size_t SC_RW_WU = SC_RW_NS + (size_t)(SB / 64 * 8) * 4096 * 2;
constexpr size_t SC_END = SC_RW_WU + (size_t)(SB / 64 * 8) * 8192 * 2;
constexpr size_t SC2 = WS_EXPGU;
constexpr size_t SC_GLA_S = SC2;
constexpr size_t SC_GLA_DEC = SC_GLA_S + (size_t)NUNIT * 4096 * 4;
constexpr size_t SC_SSD_S = SC_GLA_DEC + (size_t)NUNIT * 64 * 4;
constexpr size_t SC_SSD_CD = SC_SSD_S + (size_t)NUNIT * 8192 * 4;
constexpr size_t SC_DR_M = SC_SSD_CD + (size_t)NUNIT * 4 + 4096;
constexpr size_t SC_DR_NS = SC_DR_M + (size_t)NUNIT * 4096 * 2;
constexpr size_t SC_DR_WU = SC_DR_NS + (size_t)NUNIT * 4096 * 2;
constexpr size_t SC2_END = SC_DR_WU + (size_t)NUNIT * 8192 * 2;
static_assert(SC2_END <= WS_HBUF, "chunk slots fit in the expert-weight region");
static_assert(SC_END <= WS_END, "scratch fits");
constexpr int CW_CNT = 1024;
constexpr int CW_BAR = 4096;

#define LAS __attribute__((address_space(3)))
constexpr int NTHR = 512;
constexpr int LDS_BYTES = 147456;
constexpr int LDS_CTL = 143360;
constexpr int LDS_PTRS = LDS_CTL + 2048;

__device__ __forceinline__ int lane_id_asm() { int l; asm volatile("v_mbcnt_lo_u32_b32 %0, -1, 0\n\tv_mbcnt_hi_u32_b32 %0, -1, %0" : "=v"(l)); return l; }
__device__ __forceinline__ float bf2f(bf16_t b) { return __uint_as_float(((unsigned)b) << 16); }
__device__ __forceinline__ unsigned f2bf(float f) { unsigned u = __float_as_uint(f); u += 0x7FFFu + ((u >> 16) & 1u); return u >> 16; }
__device__ __forceinline__ unsigned pk2(float lo, float hi) { return f2bf(lo) | (f2bf(hi) << 16); }
__device__ __forceinline__ float rl(float x, int k) { return __uint_as_float(__builtin_amdgcn_readlane(__float_as_uint(x), k)); }
__device__ __forceinline__ float shx_(float v, int lane, int o) { return __uint_as_float(__builtin_amdgcn_ds_bpermute((lane ^ o) << 2, __float_as_uint(v))); }
__device__ __forceinline__ int shxi_(int v, int lane, int o) { return __builtin_amdgcn_ds_bpermute((lane ^ o) << 2, v); }
__device__ __forceinline__ float shup_(float v, int lane, int o) { return __uint_as_float(__builtin_amdgcn_ds_bpermute((lane - o) << 2, __float_as_uint(v))); }
__device__ __forceinline__ float wsum(float v) { const int l = lane_id_asm(); v += shx_(v, l, 32); v += shx_(v, l, 16); v += shx_(v, l, 8); v += shx_(v, l, 4); v += shx_(v, l, 2); v += shx_(v, l, 1); return v; }
__device__ __forceinline__ float sigmoidf_(float x) { return 1.0f / (1.0f + __expf(-x)); }
__device__ __forceinline__ float siluf_(float x) { return x / (1.0f + __expf(-x)); }
__device__ __forceinline__ float log1pexp_(float t  ) { return t < 1e-4f ? t - 0.5f * t * t : __logf(1.0f + t); }
__device__ __forceinline__ float softplusf_(float x) { return x > 15.f ? x : log1pexp_(__expf(x)); }
__device__ __forceinline__ float logsigmoidf_(float x) { return fminf(x, 0.f) - log1pexp_(__expf(-fabsf(x))); }
__device__ __forceinline__ float tanhf_(float x) { const float e = __expf(2.0f * fminf(fmaxf(x, -15.f), 15.f)); return (e - 1.0f) / (e + 1.0f); }
__device__ __forceinline__ int seq_tok(int i, int d) { return d == 0 ? i : (i < NCTX ? NCTX - 1 - i : SB + NCTX - 1 - i); }
__device__ __forceinline__ int tok_row(int b, int s) { return s < NCTX ? b * NCTX + s : CROWS + b * SEQ + (s - NCTX); }

struct Params { const float* in[N_IN]; float* out; unsigned char* ws; int lo, hi, li, pad; };
struct Cx { float* out; unsigned char* ws; int tid, bid, G, pad; };
__device__ __forceinline__ const float* PIN(int i) {
    extern __shared__ __attribute__((aligned(16))) unsigned char lds_raw_[];
    int off = __builtin_amdgcn_readfirstlane(LDS_PTRS + 8 * i); asm volatile("" : "+s"(off));
    const LAS unsigned* t = (const LAS unsigned*)((LAS unsigned char*)lds_raw_ + off);
    const unsigned lo = __builtin_amdgcn_readfirstlane(t[0]), hi = __builtin_amdgcn_readfirstlane(t[1]);
    return (const float*)(((unsigned long long)hi << 32) | lo);
}
#define XB_TMO      128
#define XB_XCNT(j)  (256  + 64 * (j))
#define XB_XSUB(j)  (1280 + 64 * (j))
#define XB_XGEN(j)  (2304 + 64 * (j))
#define XB_TOP      3328
#define XB_TOPGEN   3392
#define XCD_BAR_WORDS 3456
#define XB_SPIN_CAP (1u << 18)

__device__ __forceinline__ unsigned xb_ld(unsigned* p)              { return __hip_atomic_load(p, __ATOMIC_RELAXED, __HIP_MEMORY_SCOPE_AGENT); }
__device__ __forceinline__ unsigned xb_add(unsigned* p, unsigned v) { return __hip_atomic_fetch_add(p, v, __ATOMIC_RELAXED, __HIP_MEMORY_SCOPE_AGENT); }
__device__ __forceinline__ unsigned xb_xcc_id() { return (unsigned)__builtin_amdgcn_s_getreg((3 << 11) | 20) & 0xFu; }
#define XB_SPIN(cond, bar) do { unsigned _sp = 0; while (cond) { __builtin_amdgcn_s_sleep(1); \
    if ((++_sp & 255u) == 0u) { if (xb_ld(&(bar)[XB_TMO])) break; if (_sp > XB_SPIN_CAP) { atomicAdd(&(bar)[XB_TMO], 1u); break; } } } } while (0)

struct XcdBarrier {
    unsigned* bar; unsigned x;
    volatile LAS unsigned* st;
};

__device__ __forceinline__ XcdBarrier xcd_barrier_post(unsigned* bar, volatile LAS unsigned* st, const unsigned xb_tid) {
    XcdBarrier b; b.bar = bar; b.x = xb_xcc_id(); b.st = st;
    if (xb_tid == 0) (void)xb_add(&bar[XB_XCNT(b.x)], 1u);
    return b;
}
__device__ __forceinline__ void xcd_barrier_complete(unsigned* bar, unsigned x, unsigned& nloc, unsigned& nx) {
    const unsigned G = gridDim.x * gridDim.y * gridDim.z;
    unsigned sum, cnt, mine, sp = 0u;
    for (;;) {
        sum = 0u; cnt = 0u; mine = 0u;
#pragma unroll
        for (unsigned j = 0; j < 16; ++j) { const unsigned c = xb_ld(&bar[XB_XCNT(j)]); sum += c; cnt += (c > 0u) ? 1u : 0u; mine = (j == x) ? c : mine; }
        if (sum == G) break;
        __builtin_amdgcn_s_sleep(1);
        if ((++sp & 255u) == 0u) { if (xb_ld(&bar[XB_TMO])) break; if (sp > XB_SPIN_CAP) { atomicAdd(&bar[XB_TMO], 1u); break; } }
    }
    nloc = mine > 0u ? mine : 1u; nx = cnt > 0u ? cnt : 1u;
}

__device__ __forceinline__ void xcd_barrier(const XcdBarrier& b, const unsigned xb_tid) {
    asm volatile("s_waitcnt vmcnt(0)" ::: "memory");
    __syncthreads();
    if (xb_tid == 0) {
        unsigned* bar = b.bar;
        __builtin_amdgcn_s_waitcnt(0);
        unsigned nloc = b.st[0], nx = b.st[1];
        if (nloc == 0u) { xcd_barrier_complete(bar, b.x, nloc, nx); b.st[0] = nloc; b.st[1] = nx; }
        const unsigned old = xb_add(&bar[XB_XSUB(b.x)], 1u);
        const unsigned gen = old / nloc;
        if (old + 1u == (gen + 1u) * nloc) {
            __builtin_amdgcn_fence(__ATOMIC_RELEASE, "agent");
            asm volatile("s_waitcnt vmcnt(0)" ::: "memory");
            const unsigned og = xb_add(&bar[XB_TOP], 1u);
            const unsigned tg = og / nx;
            if (og + 1u == (tg + 1u) * nx) xb_add(&bar[XB_TOPGEN], 1u);
            else XB_SPIN(xb_ld(&bar[XB_TOPGEN]) == tg, bar);
            __builtin_amdgcn_fence(__ATOMIC_ACQUIRE, "agent");
            xb_add(&bar[XB_XGEN(b.x)], 1u);
            asm volatile("s_waitcnt vmcnt(0)" ::: "memory");
        } else {
            XB_SPIN(xb_ld(&bar[XB_XGEN(b.x)]) == gen, bar);
            __builtin_amdgcn_fence(__ATOMIC_ACQUIRE, "agent");
            asm volatile("s_waitcnt vmcnt(0)" ::: "memory");
        }
    }
    __syncthreads();
}

namespace pg8 {
constexpr int BM = 256, BK = 64, HALF = 128, HTB = HALF * BK * 2  , STAGE_BYTES = 8 * HTB, NXCD = 8, WGM = 8;
__host__ __device__ __forceinline__ int lds_byte(int r, int c) { const int st = (r >> 4) * 2 + (c >> 5), rr = r & 15, cc = c & 31, ob = rr * 64 + cc * 2; return st * 1024 + (ob ^ (((ob >> 9) & 1) << 5)); }
__host__ __device__ __forceinline__ void stage_rc(int b, int& R, int& C) { const int st = b / 1024, sb = b % 1024, swz = sb ^ (((sb >> 9) & 1) << 5); R = (st >> 1) * 16 + swz / 64; C = (st & 1) * 32 + (swz % 64) / 2; }
__host__ __device__ __forceinline__ int perm32(int rho) { const int n = rho >> 4, i = rho & 15; return 8 * (i >> 2) + 4 * n + (i & 3); }

struct Unit { int pm, pn, e, r0; };

__device__ __forceinline__ unsigned cvt_pk_bf16(float lo, float hi) { unsigned r; asm volatile("v_cvt_pk_bf16_f32 %0, %1, %2" : "=v"(r) : "v"(lo), "v"(hi)); return r; }

template <int K, class Epi, class Sched>
__device__ __forceinline__ void gemm_phase(const int tid, LAS unsigned char* lds, const char* Abase, const Sched& S, const Epi& E) {
    const int wid = __builtin_amdgcn_readfirstlane(tid >> 6), lane = tid & 63, wr = wid >> 2, wc = wid & 3, fr = lane & 15, fq = lane >> 4;
    const int nt = K / BK;
    constexpr bool DN = Sched::DENSE;
    int RA[2], CA[2]; unsigned voffB[2], voffA[2];
#pragma unroll
    for (int i = 0; i < 2; ++i) { int R, C; stage_rc(tid * 16 + i * 8192, R, C); const int Rb = Epi::PERM ? ((R & ~31) + perm32(R & 31)) : R;
        RA[i] = R; CA[i] = C; voffB[i] = (unsigned)(Rb * K + C) * 2u; voffA[i] = (unsigned)(R * K + C) * 2u; }
    const size_t kstep = (size_t)(BK * 2);
    const size_t hstep = (size_t)HALF * K * 2;
    const size_t tstep = 2 * hstep;
    const unsigned ldsw = (unsigned)wid * 1024u;
    const int aoff = lds_byte(wr * 64 + fr, fq * 8), boff = lds_byte(wc * 32 + fr, fq * 8);
#define PG8_SA(b, h) (((b) * 2 + (h)) * HTB)
#define PG8_SB(b, h) ((4 + (b) * 2 + (h)) * HTB)
#define PG8_STAGE(bufoff, gbase, voff) do { _Pragma("unroll") for (int _i = 0; _i < 2; ++_i) \
        __builtin_amdgcn_global_load_lds((const __attribute__((address_space(1))) unsigned*)((const __attribute__((address_space(1))) char*)(gbase) + (voff)[_i]), (LAS unsigned*)(lds + (bufoff) + ldsw + _i * 8192), 16, 0, 0); } while (0)
#define PG8_LDA(dst, b, h) do { _Pragma("unroll") for (int m = 0; m < 4; ++m) _Pragma("unroll") for (int k = 0; k < 2; ++k) dst[m][k] = *(const LAS bf16x8*)(lds + PG8_SA(b, h) + aoff + m * 2048 + k * 1024); } while (0)
#define PG8_LDB(dst, b, h) do { _Pragma("unroll") for (int n = 0; n < 2; ++n) _Pragma("unroll") for (int k = 0; k < 2; ++k) dst[n][k] = *(const LAS bf16x8*)(lds + PG8_SB(b, h) + boff + n * 2048 + k * 1024); } while (0)
#define PG8_MMA(ai, bj, At, Bt) do { __builtin_amdgcn_s_setprio(1); _Pragma("unroll") for (int m = 0; m < 4; ++m) _Pragma("unroll") for (int n = 0; n < 2; ++n) _Pragma("unroll") for (int k = 0; k < 2; ++k) \
        acc[ai][bj][m][n] = __builtin_amdgcn_mfma_f32_16x16x32_bf16(Bt[n][k], At[m][k], acc[ai][bj][m][n], 0, 0, 0); __builtin_amdgcn_s_setprio(0); } while (0)
#define PG8_WAIT_V(n) asm volatile("s_waitcnt vmcnt(" #n ")" ::: "memory")
#define PG8_WAIT_L(n) asm volatile("s_waitcnt lgkmcnt(" #n ")" ::: "memory")
#define PG8_BAR __builtin_amdgcn_s_barrier()
#define PG8_SCHED __builtin_amdgcn_sched_barrier(0)
#define PG8_AOFF(dst, u) do { _Pragma("unroll") for (int _h = 0; _h < 2; ++_h) _Pragma("unroll") for (int _i = 0; _i < 2; ++_i) \
        dst[_h][_i] = ((unsigned)S.a_row(u, _h * HALF + RA[_i]) * (unsigned)K + (unsigned)CA[_i]) * 2u; } while (0)
    Unit cur, nxt; int ui = 0;
    if (!S.next(0, cur)) return;
    f32x4 acc[2][2][4][2];
#pragma unroll
    for (int a = 0; a < 2; ++a)
#pragma unroll
        for (int b = 0; b < 2; ++b)
#pragma unroll
            for (int m = 0; m < 4; ++m)
#pragma unroll
                for (int n = 0; n < 2; ++n) acc[a][b][m][n] = (f32x4){0.f, 0.f, 0.f, 0.f};
    bf16x8 At[4][2], B0[2][2], B1[2][2];
    unsigned cO[2][2], nO[2][2];
    const char* cA = Abase; const char* nA = Abase;
    if constexpr (DN) cA = Abase + (size_t)S.a_row(cur, 0) * K * 2; else PG8_AOFF(cO, cur);
    const char* cB = S.b_ptr(cur);
#define PG8_STA(bufoff, h_, kb_, nx_) do { if constexpr (DN) PG8_STAGE(bufoff, ((nx_) ? nA : cA) + (h_) * hstep + (kb_), voffA); else PG8_STAGE(bufoff, Abase + (kb_), ((nx_) ? nO : cO)[h_]); } while (0)
    PG8_STAGE(PG8_SB(0, 0), cB, voffB); PG8_SCHED; PG8_STA(PG8_SA(0, 0), 0, 0, false); PG8_SCHED; PG8_STAGE(PG8_SB(0, 1), cB + hstep, voffB); PG8_SCHED; PG8_STA(PG8_SA(0, 1), 1, 0, false); PG8_SCHED;
    if (wr == 1) PG8_BAR;
    PG8_WAIT_V(4); PG8_BAR;
    PG8_STAGE(PG8_SB(1, 0), cB + kstep, voffB); PG8_SCHED; PG8_STA(PG8_SA(1, 0), 0, kstep, false); PG8_SCHED; PG8_STAGE(PG8_SB(1, 1), cB + hstep + kstep, voffB); PG8_SCHED;
    PG8_WAIT_V(6); PG8_BAR;
    for (;;) {
        const bool has_next = S.next(ui + 1, nxt);
        const char* nB = cB; nA = cA;
        if (has_next) { if constexpr (DN) nA = Abase + (size_t)S.a_row(nxt, 0) * K * 2; else PG8_AOFF(nO, nxt); nB = S.b_ptr(nxt); }
        else if constexpr (!DN) {
#pragma unroll
            for (int h = 0; h < 2; ++h)
#pragma unroll
                for (int i = 0; i < 2; ++i) nO[h][i] = cO[h][i]; }
        for (int t = 0; t < nt; t += 2) {
            const bool last = (t == nt - 2);
            const size_t k1 = (size_t)(t + 1) * kstep, k2 = last ? 0 : (size_t)(t + 2) * kstep, k3 = k2 + kstep;
            const char* b2 = last ? nB : cB + (size_t)(t + 2) * kstep; const char* b3 = b2 + kstep;
            PG8_LDB(B0, 0, 0); PG8_SCHED; PG8_LDA(At, 0, 0); PG8_STA(PG8_SA(1, 1), 1, k1, false);
            PG8_WAIT_L(8); PG8_BAR; PG8_WAIT_L(0); PG8_MMA(0, 0, At, B0); PG8_BAR; PG8_SCHED;
            PG8_LDB(B1, 0, 1); PG8_STAGE(PG8_SB(0, 0), b2, voffB);
            PG8_BAR; PG8_WAIT_L(0); PG8_MMA(0, 1, At, B1); PG8_BAR;
            PG8_LDA(At, 0, 1); PG8_STA(PG8_SA(0, 0), 0, k2, last);
            PG8_BAR; PG8_WAIT_L(0); PG8_MMA(1, 0, At, B0); PG8_BAR; PG8_SCHED;
            PG8_STAGE(PG8_SB(0, 1), b2 + hstep, voffB);
            PG8_WAIT_V(6); PG8_BAR; PG8_MMA(1, 1, At, B1); PG8_BAR;
            PG8_LDB(B0, 1, 0); PG8_SCHED; PG8_LDA(At, 1, 0); PG8_STA(PG8_SA(0, 1), 1, k2, last);
            PG8_WAIT_L(8); PG8_BAR; PG8_WAIT_L(0); PG8_MMA(0, 0, At, B0); PG8_BAR; PG8_SCHED;
            PG8_LDB(B1, 1, 1); PG8_STAGE(PG8_SB(1, 0), b3, voffB);
            PG8_BAR; PG8_WAIT_L(0); PG8_MMA(0, 1, At, B1); PG8_BAR;
            PG8_LDA(At, 1, 1); PG8_STA(PG8_SA(1, 0), 0, k3, last);
            PG8_BAR; PG8_WAIT_L(0); PG8_MMA(1, 0, At, B0); PG8_BAR; PG8_SCHED;
            PG8_STAGE(PG8_SB(1, 1), b3 + hstep, voffB);
            PG8_WAIT_V(6); PG8_BAR; PG8_MMA(1, 1, At, B1); PG8_BAR;
        }
        E(acc, cur, wid);
        if (!has_next) break;
#pragma unroll
        for (int a = 0; a < 2; ++a)
#pragma unroll
            for (int b = 0; b < 2; ++b)
#pragma unroll
                for (int m = 0; m < 4; ++m)
#pragma unroll
                    for (int n = 0; n < 2; ++n) acc[a][b][m][n] = (f32x4){0.f, 0.f, 0.f, 0.f};
        cur = nxt; cB = nB; cA = nA; ++ui;
        if constexpr (!DN) {
#pragma unroll
        for (int h = 0; h < 2; ++h)
#pragma unroll
            for (int i = 0; i < 2; ++i) cO[h][i] = nO[h][i]; }
    }
    PG8_WAIT_V(0);
    if (wr == 0) PG8_BAR;
    PG8_BAR;
#undef PG8_SA
#undef PG8_SB
#undef PG8_STAGE
#undef PG8_LDA
#undef PG8_LDB
#undef PG8_MMA
#undef PG8_WAIT_V
#undef PG8_WAIT_L
#undef PG8_BAR
#undef PG8_SCHED
#undef PG8_AOFF
#undef PG8_STA
}
}
struct DenseSched {
    static constexpr bool DENSE = true;
    int nM, nN, nwg, G, c, K; const char* Bt; int single = 0, round = 0;
    __device__ __forceinline__ void init(int M, int N, int K_, const bf16_t* Bt_, int G_, int c_) { nM = M / 256; nN = N / 256; nwg = nM * nN; G = G_; c = c_; K = K_; Bt = (const char*)Bt_; }
    __device__ __forceinline__ bool next(int i, pg8::Unit& u) const {
        if (single && i > 0) return false;
        const long L = (long)(single ? round : i) * G + c; if (L >= nwg) return false;
        int wgid = (int)L; { const int q = nwg / 8, r = nwg % 8, xcd = wgid % 8, off = wgid / 8; wgid = (xcd < r ? xcd * (q + 1) : r * (q + 1) + (xcd - r) * q) + off; }
        const int nig = 8 * nN, gid = wgid / nig, fm = gid * 8, gsz = (nM - fm) < 8 ? (nM - fm) : 8;
        u.pm = fm + ((wgid % nig) % gsz); u.pn = (wgid % nig) / gsz; u.e = 0; u.r0 = 0; return true;
    }
    __device__ __forceinline__ int a_row(const pg8::Unit& u, int r) const { return u.pm * 256 + r; }
    __device__ __forceinline__ const char* b_ptr(const pg8::Unit& u) const { return Bt + (size_t)u.pn * 256 * K * 2; }
};
template <bool GATHER> struct MoeSched {
    static constexpr bool DENSE = !GATHER;
    const LAS int* tstart; const LAS int* cnt; int nN, G, c, K, row_lo; const int* ltok; const char* Bt; size_t bstride;
    __device__ __forceinline__ bool next(int i, pg8::Unit& u) const {
        const long L = (long)i * G + c; const int ntile = __builtin_amdgcn_readfirstlane(tstart[NE1]); if (L >= (long)ntile * nN) return false;
        const int tile = (int)(L / nN); u.pn = (int)(L % nN);
        int e = 0;
#pragma unroll 1
        for (int step = 64; step >= 1; step >>= 1) { const int e2 = e + step; if (e2 <= NE && tstart[e2] <= tile) e = e2; }
        e = __builtin_amdgcn_readfirstlane(e); u.e = e; u.pm = __builtin_amdgcn_readfirstlane(tile); u.pn = __builtin_amdgcn_readfirstlane(u.pn); u.r0 = __builtin_amdgcn_readfirstlane((tile - tstart[e]) * 256); return true;
    }
    __device__ __forceinline__ int a_row(const pg8::Unit& u, int r) const {
        if (!GATHER) return u.pm * 256 + r;
        const int ri = u.r0 + r;
        if (u.e == NE) return ri < cnt[NE] ? row_lo + ri : row_lo;
        return ri < cnt[u.e] ? ltok[(size_t)u.e * ROWS + ri] : row_lo;
    }
    __device__ __forceinline__ const char* b_ptr(const pg8::Unit& u) const { return Bt + (size_t)u.e * bstride + (size_t)u.pn * 256 * K * 2; }
};

struct EpiProj {
    static constexpr bool PERM = true;
    bf16_t* O; int ldc;
    __device__ __forceinline__ void operator()(const f32x4 (&acc)[2][2][4][2], const pg8::Unit& u, const int wid) const {
        const int lane_ = lane_id_asm(), fr = lane_ & 15, fq = lane_ >> 4, wr = wid >> 2, wc = wid & 3;
        const int row0 = u.pm * 256 + wr * 64 + fr, col0 = u.pn * 256 + wc * 32 + 8 * fq;
#pragma unroll
        for (int ai = 0; ai < 2; ++ai)
#pragma unroll
            for (int m = 0; m < 4; ++m) { bf16_t* rowp = O + (size_t)(row0 + ai * 128 + m * 16) * ldc + col0;
#pragma unroll
                for (int bj = 0; bj < 2; ++bj) { const f32x4 v0 = acc[ai][bj][m][0], v1 = acc[ai][bj][m][1];
                    u32x4 w; w.x = pg8::cvt_pk_bf16(v0[0], v0[1]); w.y = pg8::cvt_pk_bf16(v0[2], v0[3]); w.z = pg8::cvt_pk_bf16(v1[0], v1[1]); w.w = pg8::cvt_pk_bf16(v1[2], v1[3]);
                    *(u32x4*)(rowp + bj * 128) = w; } }
    }
};
struct EpiRes {
    static constexpr bool PERM = false;
    const float* xsrc; const float* csrc; float* xdst; float* cdst; const float* gate; float pert = 0.f;
    __device__ __forceinline__ void operator()(const f32x4 (&acc)[2][2][4][2], const pg8::Unit& u, const int wid) const {
        const int lane_ = lane_id_asm(), fr = lane_ & 15, fq = lane_ >> 4, wr = wid >> 2, wc = wid & 3;
        const int col0 = u.pn * 256 + wc * 32 + 4 * fq;
        const bool isc = u.pm < 4; const int sel = isc ? 4 : (u.pm - 4) >> 5;
        const float* src = isc ? csrc + (size_t)u.pm * 256 * D : xsrc + (size_t)(u.pm - 4) * 256 * D;
        float* dst = isc ? cdst + (size_t)u.pm * 256 * D : xdst + (size_t)(u.pm - 4) * 256 * D;
        f32x4 gv[2][2];
#pragma unroll
        for (int bj = 0; bj < 2; ++bj)
#pragma unroll
            for (int n = 0; n < 2; ++n) gv[bj][n] = *(const f32x4*)(gate + sel * 6144 + col0 + bj * 128 + n * 16);
#pragma unroll
        for (int ai = 0; ai < 2; ++ai)
#pragma unroll
            for (int m = 0; m < 4; ++m) { const size_t off = (size_t)(ai * 128 + wr * 64 + m * 16 + fr) * D + col0;
#pragma unroll
                for (int bj = 0; bj < 2; ++bj)
#pragma unroll
                    for (int n = 0; n < 2; ++n) { const f32x4 s = *(const f32x4*)(src + off + bj * 128 + n * 16); *(f32x4*)(dst + off + bj * 128 + n * 16) = (s + gv[bj][n] * acc[ai][bj][m][n]) * (1.0f + (((fr + m + n) & 1) ? pert : -pert)); }
                asm volatile("" ::: "memory"); }
    }
};
struct EpiF32T {
    static constexpr bool PERM = false;
    float* Y;
    __device__ __forceinline__ void operator()(const f32x4 (&acc)[2][2][4][2], const pg8::Unit& u, const int wid) const {
        const int lane_ = lane_id_asm(), fr = lane_ & 15, fq = lane_ >> 4, wr = wid >> 2, wc = wid & 3;
        const int col0 = u.pn * 256 + wc * 32 + 4 * fq;
#pragma unroll
        for (int ai = 0; ai < 2; ++ai)
#pragma unroll
            for (int m = 0; m < 4; ++m) { float* rp = Y + (size_t)(u.pm * 256 + ai * 128 + wr * 64 + m * 16 + fr) * D + col0;
#pragma unroll
                for (int bj = 0; bj < 2; ++bj)
#pragma unroll
                    for (int n = 0; n < 2; ++n) *(f32x4*)(rp + bj * 128 + n * 16) = acc[ai][bj][m][n]; }
    }
};
struct EpiGU {
    static constexpr bool PERM = false;
    bf16_t* H;
    __device__ __forceinline__ void operator()(const f32x4 (&acc)[2][2][4][2], const pg8::Unit& u, const int wid) const {
        const int lane_ = lane_id_asm(), fr = lane_ & 15, fq = lane_ >> 4, wr = wid >> 2, wc = wid & 3;
        const int row0 = u.pm * 256 + wr * 64 + fr;
#pragma unroll
        for (int ai = 0; ai < 2; ++ai)
#pragma unroll
            for (int m = 0; m < 4; ++m) { bf16_t* rowp = H + (size_t)(row0 + ai * 128 + m * 16) * EH + 4 * fq;
#pragma unroll
                for (int bj = 0; bj < 2; ++bj) { const f32x4 g = acc[ai][bj][m][0], up = acc[ai][bj][m][1]; float h[4];
#pragma unroll
                    for (int j = 0; j < 4; ++j) h[j] = g[j] / (1.0f + __expf(-g[j])) * up[j];
                    u32x2 w; w.x = pg8::cvt_pk_bf16(h[0], h[1]); w.y = pg8::cvt_pk_bf16(h[2], h[3]);
                    *(u32x2*)(rowp + (u.pn * 256 + bj * 128 + wc * 32) / 2) = w; } }
    }
};
struct EpiY {
    static constexpr bool PERM = true;
    bf16_t* Y;
    __device__ __forceinline__ void operator()(const f32x4 (&acc)[2][2][4][2], const pg8::Unit& u, const int wid) const {
        const int lane_ = lane_id_asm(), fr = lane_ & 15, fq = lane_ >> 4, wr = wid >> 2, wc = wid & 3;
        const int row0 = u.pm * 256 + wr * 64 + fr, col0 = u.pn * 256 + wc * 32 + 8 * fq;
#pragma unroll
        for (int ai = 0; ai < 2; ++ai)
#pragma unroll
            for (int m = 0; m < 4; ++m) { bf16_t* rowp = Y + (size_t)(row0 + ai * 128 + m * 16) * 512 + col0;
#pragma unroll
                for (int bj = 0; bj < 2; ++bj) { const f32x4 v0 = acc[ai][bj][m][0], v1 = acc[ai][bj][m][1];
                    u32x4 w; w.x = pg8::cvt_pk_bf16(v0[0], v0[1]); w.y = pg8::cvt_pk_bf16(v0[2], v0[3]); w.z = pg8::cvt_pk_bf16(v1[0], v1[1]); w.w = pg8::cvt_pk_bf16(v1[2], v1[3]);
                    *(u32x4*)(rowp + bj * 128) = w; } }
    }
};
#define WSP(T, off) ((T*)(p.ws + (off)))

__device__ __forceinline__ void conv_tile(const int t, LAS float* tl, const float* __restrict__ src, int ldsrc, int k0, int n0, int nvalid, bf16_t* dst, int lddst, int mode) {
#pragma unroll
    for (int j = 0; j < 8; ++j) { const int idx = t + NTHR * j, k = idx >> 6, n = idx & 63; float v = 0.f; if (n0 + n < nvalid) v = src[(size_t)(k0 + k) * ldsrc + n0 + n]; tl[k * 65 + n] = v; }
    __syncthreads();
#pragma unroll
    for (int j = 0; j < 4; ++j) { const int pi = t + NTHR * j, n = pi >> 5, k = (pi & 31) * 2; const int nn = n0 + n;
        const int row = (mode == 0 || mode == 3) ? nn : ((nn >> 4) * 32 + (nn & 15) + (mode == 2 ? 16 : 0));
        float v0 = tl[k * 65 + n], v1 = tl[(k + 1) * 65 + n];
        if (mode == 3) { v0 -= bf2f((bf16_t)f2bf(v0)); v1 -= bf2f((bf16_t)f2bf(v1)); }
        *(unsigned*)(dst + (size_t)row * lddst + k0 + k) = pk2(v0, v1); }
    __syncthreads();
}
constexpr int CONV_A_UNITS = 2048 + 512 + 64;
__device__ __forceinline__ void conv_unit_A(const Cx& p, LAS float* tl, int u) {
    if (u < 2048) { const int l = u >> 10, r = u & 1023; conv_tile(p.tid, tl, PIN(I_WIN) + (size_t)l * D * INW, INW, (r >> 6) * 64, (r & 63) * 64, INW, WSP(bf16_t, WS_WIN) + (size_t)l * NPROJ * D, D, 0); }
    else if (u < 2560) { const int v = u - 2048, l = v >> 8, r = v & 255; conv_tile(p.tid, tl, PIN(I_WOUT) + (size_t)l * D * D, D, (r >> 4) * 64, (r & 15) * 64, D, WSP(bf16_t, WS_WOUT) + (size_t)l * D * D, D, 0); }
    else { const int v = u - 2560, l = v >> 5, lo = (v >> 4) & 1, r = v & 15; conv_tile(p.tid, tl, PIN(I_ROUT_W) + (size_t)l * D * NE, NE, r * 64, 0, NE, WSP(bf16_t, WS_ROUT) + (size_t)(l * 2 + lo) * NE * D, D, lo ? 3 : 0); }
}
constexpr int CONV_E_UNITS = NE1 * 192;
__device__ __forceinline__ void conv_unit_E(const Cx& p, LAS float* tl, int l, int u) {
    const int e = u / 192, r = u % 192;
    if (r < 128) { const int up = r >> 6, q = r & 63;
        const float* src = e < NE ? PIN(up ? I_EXP_U : I_EXP_G) + ((size_t)l * NE + e) * D * EH : PIN(up ? I_SH_U : I_SH_G) + (size_t)l * D * EH;
        conv_tile(p.tid, tl, src, EH, (q >> 2) * 64, (q & 3) * 64, EH, WSP(bf16_t, WS_EXPGU) + (size_t)e * 512 * D, D, 1 + up); }
    else { const int q = r - 128;
        const float* src = e < NE ? PIN(I_EXP_D) + ((size_t)l * NE + e) * EH * D : PIN(I_SH_D) + (size_t)l * EH * D;
        conv_tile(p.tid, tl, src, D, (q >> 4) * 64, (q & 15) * 64, D, WSP(bf16_t, WS_EXPD) + (size_t)e * D * EH, EH, 0); }
}
__device__ __forceinline__ void phase_mod(const Cx& p, LAS unsigned char* lds) {
    LAS float* sv = (LAS float*)lds; LAS float* red = sv + 5 * D;
    const int tid = p.tid;
    if (p.bid >= 192) return;
    for (int i = tid; i < 5 * D; i += NTHR) { const int j = i >> 10, k = i & 1023; const float c = j < 4 ? PIN(I_C)[j * D + k] : PIN(I_CCTX)[k]; sv[i] = siluf_(c); }
    __syncthreads();
    for (int u = p.bid; u < 192; u += p.G) {
        const int l = u / 96, cb = u % 96, kg = tid >> 6, cl = tid & 63;
        const float* w = PIN(I_WMOD) + (size_t)l * D * 6144 + cb * 64 + cl;
        float a0 = 0.f, a1 = 0.f, a2 = 0.f, a3 = 0.f, a4 = 0.f;
#pragma unroll 8
        for (int kk = 0; kk < 128; ++kk) { const int k = kg * 128 + kk; const float wv = w[(size_t)k * 6144];
            a0 += sv[k] * wv; a1 += sv[D + k] * wv; a2 += sv[2 * D + k] * wv; a3 += sv[3 * D + k] * wv; a4 += sv[4 * D + k] * wv; }
        red[(kg * 5 + 0) * 64 + cl] = a0; red[(kg * 5 + 1) * 64 + cl] = a1; red[(kg * 5 + 2) * 64 + cl] = a2; red[(kg * 5 + 3) * 64 + cl] = a3; red[(kg * 5 + 4) * 64 + cl] = a4;
        __syncthreads();
        if (tid < 320) { const int j = tid >> 6; float s = 0.f;
#pragma unroll
            for (int g = 0; g < 8; ++g) s += red[(g * 5 + j) * 64 + cl];
            WSP(float, WS_MOD)[((size_t)l * 5 + j) * 6144 + cb * 64 + cl] = s + PIN(I_BMOD)[l * 6144 + cb * 64 + cl]; }
        __syncthreads();
    }
}
__device__ __forceinline__ const float* res_row(const Cx& p, int layer_src0, int r) {
    if (r < CROWS) return (layer_src0 ? PIN(I_CTX) : (const float*)WSP(float, WS_CTXRES)) + (size_t)r * D;
    return (layer_src0 ? PIN(I_X) : (const float*)p.out) + (size_t)(r - CROWS) * D;
}
__device__ __forceinline__ int row_sel(int r) { return r < CROWS ? 4 : (r - CROWS) >> 13; }

__device__ __forceinline__ void norm_row(const float* src, const int* accp, float* wb, int* zacc, const float* g, const float* shift, const float* scale, bf16_t* dst, const bool tolds, LAS bf16_t* ldst, LAS bf16_t* ldlo, int lane) {
    f32x4 v[4]; float ss = 0.f;
#pragma unroll
    for (int i = 0; i < 4; ++i) { v[i] = *(const f32x4*)(src + 256 * i + 4 * lane);
        ss += v[i][0] * v[i][0] + v[i][1] * v[i][1] + v[i][2] * v[i][2] + v[i][3] * v[i][3]; }
    ss = wsum(ss); const float rstd = rsqrtf(ss * (1.0f / D) + 1e-6f);
#pragma unroll
    for (int i = 0; i < 4; ++i) { const int col = 256 * i + 4 * lane; const f32x4 gv = *(const f32x4*)(g + col), sh = *(const f32x4*)(shift + col), sc = *(const f32x4*)(scale + col);
        const f32x4 y = v[i] * rstd * gv * (sc + 1.0f) + sh; u32x2 w; w.x = pk2(y[0], y[1]); w.y = pk2(y[2], y[3]);
        *(u32x2*)(dst + col) = w;
        if (tolds) { *(LAS u32x2*)(ldst + col) = w; u32x2 wl;
            wl.x = pk2(y[0] - __uint_as_float(w.x << 16), y[1] - __uint_as_float(w.x & 0xffff0000u)); wl.y = pk2(y[2] - __uint_as_float(w.y << 16), y[3] - __uint_as_float(w.y & 0xffff0000u));
            *(LAS u32x2*)(ldlo + col) = wl; } }
}
__device__ __forceinline__ void phase_norm1(const Cx& p, int layer) {
    const int lane = p.tid & 63, wave = p.tid >> 6;
    const float* mod = WSP(float, WS_MOD) + (size_t)layer * 5 * 6144; const float* g = PIN(I_N1G) + layer * D; bf16_t* hb = WSP(bf16_t, WS_HBUF);
    for (int r = p.bid * 8 + wave; r < ROWS; r += p.G * 8) { const int sel = row_sel(r);
        const float* src = res_row(p, layer == 0, r);
        norm_row(src, (const int*)0, (float*)0, (int*)0, g, mod + sel * 6144 + 0, mod + sel * 6144 + 1024, hb + (size_t)r * D, false, (LAS bf16_t*)0, (LAS bf16_t*)0, lane); }
}
__device__ __forceinline__ float conv_at(const Cx& p, const bf16_t* proj, int b, int s, int col, const float* cw  ) {
    float acc = 0.f;
    if (s < NCTX) {
#pragma unroll
        for (int dx = -1; dx <= 1; ++dx) { const int s2 = s + dx; if (s2 >= 0 && s2 < NCTX) acc += cw[(3 + dx + 1) * 768] * bf2f(proj[(size_t)(b * NCTX + s2) * NPROJ + col]); }
    } else { const int t = s - NCTX, r = t >> 6, c = t & 63;
#pragma unroll
        for (int dy = -1; dy <= 1; ++dy)
#pragma unroll
            for (int dx = -1; dx <= 1; ++dx) { const int r2 = r + dy, c2 = c + dx;
                if (r2 >= 0 && r2 < GRIDH && c2 >= 0 && c2 < GRIDW) acc += cw[((dy + 1) * 3 + dx + 1) * 768] * bf2f(proj[(size_t)(CROWS + b * SEQ + r2 * 64 + c2) * NPROJ + col]); }
    }
    return acc;
}
__device__ __forceinline__ void phase_prep(const Cx& p, LAS unsigned char* lds, int layer, int b) {
    const int lane = p.tid & 63, wave = __builtin_amdgcn_readfirstlane(p.tid >> 6);
    const bf16_t* proj = WSP(bf16_t, WS_PROJ);
    if (p.bid < SB / 32) {
        LAS float* wl = (LAS float*)lds;
        { const float* AW = PIN(I_RW_AW2) + (size_t)layer * 32 * 256; const float* WW = PIN(I_RW_W2) + (size_t)layer * 2 * 32 * 256;
          for (int i = p.tid; i < 96 * 256; i += NTHR) wl[i] = i < 32 * 256 ? AW[i] : WW[i - 32 * 256]; }
        __syncthreads();
        const int h = wave & 3, half = wave >> 2, c = 64 * h + lane;
        const float a0 = PIN(I_RW_A0)[layer * 256 + c], w0f = PIN(I_RW_W0)[(layer * 2 + 0) * 256 + c], w0b = PIN(I_RW_W0)[(layer * 2 + 1) * 256 + c];
        const float kkm = PIN(I_RW_KK)[layer * 256 + c], kam = PIN(I_RW_KA)[layer * 256 + c];
        for (int u = p.bid; u < SB / 32; u += p.G) {
#pragma unroll 1
            for (int i = 0; i < 16; ++i) { const int s = u * 32 + half * 16 + i; const bf16_t* pr = proj + (size_t)tok_row(b, s) * NPROJ;
                float xa = 0.f, xf = 0.f, xb = 0.f;
                if (lane < 32) { xa = bf2f(pr[PB_A + lane]); xf = tanhf_(bf2f(pr[PB_WF + lane])); xb = tanhf_(bf2f(pr[PB_WB + lane])); }
                const float kv = bf2f(pr[PB_K + c]);
                float sa = a0, sf = w0f, sb = w0b;
#pragma unroll 8
                for (int j = 0; j < 32; ++j) { sa += rl(xa, j) * wl[j * 256 + c]; sf += rl(xf, j) * wl[(32 + j) * 256 + c]; sb += rl(xb, j) * wl[(64 + j) * 256 + c]; }
                const float a = sigmoidf_(sa);
                const float lwf = -__expf(-softplusf_(-sf) - 0.5f), lwb = -__expf(-softplusf_(-sb) - 0.5f);
                const float kr = kv * kkm; const float ss = wsum(kr * kr); const float kk = kr * rsqrtf(ss + 1e-6f);
                const size_t o = (size_t)s * 256 + c;
                WSP(float, SC_RK)[o] = kv * (1.0f + (a - 1.0f) * kam); WSP(float, SC_RKK)[o] = kk; WSP(float, SC_RB)[o] = kk * a;
                WSP(float, SC_RLW)[o] = lwf; WSP(float, SC_RLW)[(size_t)SB * 256 + o] = lwb; }
        }
    }
    for (int u = p.bid; u < SB / 8; u += p.G) {
        for (int task = wave; task < 8 * 25; task += 8) { const int s = u * 8 + task / 25, grp = task % 25;
            if (grp < 12) { const int j = 64 * grp + lane;
                const float v = conv_at(p, proj, b, s, PC_X + j, PIN(I_SS_CW) + (size_t)layer * 9 * 768 + j) + PIN(I_SS_CB)[layer * 768 + j];
                WSP(bf16_t, SC_SX)[(size_t)s * 768 + j] = (bf16_t)f2bf(siluf_(v)); }
            else if (grp < 24) { const int g2 = grp - 12, j = 64 * g2 + lane;
                float y = siluf_(conv_at(p, proj, b, s, PD_Q + j, PIN(I_DN_CW) + (size_t)layer * 9 * 768 + j));
                if (g2 < 8) { const float ss = wsum(y * y); y *= rsqrtf(ss + 1e-6f); if (g2 < 4) y *= 0.125f; }
                WSP(bf16_t, SC_DQ)[(size_t)s * 768 + j] = (bf16_t)f2bf(y); }
            else { const bf16_t* pr = proj + (size_t)tok_row(b, s) * NPROJ;
                if (lane < 8) { const int d = lane >> 2, h = lane & 3; WSP(float, SC_SDT)[(size_t)s * 8 + lane] = softplusf_(bf2f(pr[PC_DF + lane]) + PIN(I_SS_DTB)[(layer * 2 + d) * 4 + h]); }
                else if (lane < 16) { const int q = lane - 8; WSP(float, SC_DG)[(size_t)s * 16 + q] = sigmoidf_(bf2f(pr[PD_BF + q])); }
                else if (lane < 24) { const int q = lane - 16, d = q >> 2, h = q & 3;
                    WSP(float, SC_DG)[(size_t)s * 16 + 8 + q] = -__expf(PIN(I_DN_ALOG)[(layer * 2 + d) * 4 + h]) * softplusf_(bf2f(pr[PD_AF + q]) + PIN(I_DN_DTB)[(layer * 2 + d) * 4 + h]); } }
        }
    }
}
__device__ __forceinline__ void phase_scan(const Cx& p, int layer, int b);
__device__ __forceinline__ void phase_post(const Cx& p, int layer, int b) {
    const int lane = p.tid & 63, wave = __builtin_amdgcn_readfirstlane(p.tid >> 6);
    const bf16_t* proj = WSP(bf16_t, WS_PROJ); const bf16_t* of = WSP(bf16_t, SC_OF); const bf16_t* obk = WSP(bf16_t, SC_OB); bf16_t* yc = WSP(bf16_t, WS_HBUF);
    float gw[64]; bool loaded = false;
    for (int u = p.bid; u < SB / 8; u += p.G) {
        if (wave >= 4 && !loaded) { loaded = true; const int c = 64 * (wave - 4) + lane;
#pragma unroll
            for (int j = 0; j < 64; ++j) gw[j] = PIN(I_RW_GW2)[((size_t)layer * 64 + j) * 256 + c]; }
        for (int i = 0; i < 8; ++i) { const int s = u * 8 + i, row = tok_row(b, s); const bf16_t* pr = proj + (size_t)row * NPROJ; bf16_t* yr = yc + (size_t)row * D;
            const bf16_t* o1 = of + (size_t)s * 1024; const bf16_t* o2 = obk + (size_t)s * 1024;
            const float mf = (MK_ABL & 128) ? 0.f : 1.f, mb = (MK_ABL & 64) ? 0.f : 1.f;
            if (wave < 4) { const int h = wave, c = 64 * h + lane;
                { const float o = mf * bf2f(o1[c]) + mb * bf2f(o2[c]); const float ms = wsum(o * o) * (1.0f / 64.0f);
                  const float y = o * rsqrtf(ms + 1e-6f) * PIN(I_GLA_NG)[layer * 256 + c] * siluf_(bf2f(pr[PA_G + c])); yr[c] = (bf16_t)f2bf((MK_ABL & 4) ? 0.f : y); }
                if (wave < 2) { float y[2];
#pragma unroll
                    for (int q = 0; q < 2; ++q) { const int cc = 128 * wave + 64 * q + lane, hh = cc >> 6;
                        const float xs = bf2f(WSP(bf16_t, SC_SX)[(size_t)s * 768 + cc]);
                        y[q] = (mf * bf2f(o1[512 + cc]) + mb * bf2f(o2[512 + cc]) + PIN(I_SS_D)[layer * 4 + hh] * xs) * siluf_(bf2f(pr[PC_Z + cc])); }
                    const float ms = wsum(y[0] * y[0] + y[1] * y[1]) * (1.0f / 128.0f); const float rs = rsqrtf(ms + 1e-6f);
#pragma unroll
                    for (int q = 0; q < 2; ++q) { const int cc = 128 * wave + 64 * q + lane; yr[512 + cc] = (bf16_t)f2bf((MK_ABL & 16) ? 0.f : y[q] * rs * PIN(I_SS_NG)[layer * 256 + cc]); } }
            } else { const int h = wave - 4, c = 64 * h + lane;
                { const float o = mf * bf2f(o1[256 + c]) + mb * bf2f(o2[256 + c]); const float mu = wsum(o) * (1.0f / 64.0f); const float dlt = o - mu; const float var = wsum(dlt * dlt) * (1.0f / 64.0f);
                  float y = dlt * rsqrtf(var + 64e-5f) * PIN(I_RW_LNG)[layer * 256 + c] + PIN(I_RW_LNB)[layer * 256 + c];
                  const float r = bf2f(pr[PB_R + c]), kp = WSP(float, SC_RK)[(size_t)s * 256 + c], vv = bf2f(pr[PB_V + c]);
                  const float bonus = wsum(r * kp * PIN(I_RW_RK)[layer * 256 + c]) * vv;
                  const float sg = sigmoidf_(bf2f(pr[PB_G + lane])); float gate = 0.f;
#pragma unroll
                  for (int j = 0; j < 64; ++j) gate += rl(sg, j) * gw[j];
                  yr[256 + c] = (bf16_t)f2bf((MK_ABL & 8) ? 0.f : (y + bonus) * gate); }
                { const float o = mf * bf2f(o1[768 + c]) + mb * bf2f(o2[768 + c]); const float ms = wsum(o * o) * (1.0f / 64.0f);
                  const float y = o * rsqrtf(ms + 1e-6f) * PIN(I_DN_NG)[layer * 256 + c] * siluf_(bf2f(pr[PD_Z + c])); yr[768 + c] = (bf16_t)f2bf((MK_ABL & 32) ? 0.f : y); }
            }
        }
    }
}
constexpr int N2_TILE = 32, N2_STRIDE = 2064;
__device__ __forceinline__ void phase_norm2(const Cx& p, LAS unsigned char* lds, int layer, int row_lo) {
    const int tid = p.tid, lane = tid & 63, wave = __builtin_amdgcn_readfirstlane(tid >> 6), fr = lane & 15, fq = lane >> 4;
    const float* mod = WSP(float, WS_MOD) + (size_t)layer * 5 * 6144; const float* g = PIN(I_N2G) + layer * D; bf16_t* hb = WSP(bf16_t, WS_HBUF);
    const bf16_t* rt = WSP(bf16_t, WS_ROUT) + (size_t)layer * 2 * NE * D;
    LAS float* lg = (LAS float*)(lds + 2 * N2_TILE * N2_STRIDE);
    unsigned* cnt = WSP(unsigned, WS_CTL) + CW_CNT + layer * 80 * 16; int* ltok = WSP(int, WS_LTOK); int* tokt = WSP(int, WS_TOKT);
    const float rbias = PIN(I_ROUT_B)[layer * NE + lane];
    const int nun = (ROWS - row_lo) / N2_TILE;
    for (int u = p.bid; u < nun; u += p.G) { const int r0 = row_lo + u * N2_TILE;
#pragma unroll 1
        for (int i = 0; i < 4; ++i) { const int tr = 4 * wave + i, r = r0 + tr, sel = row_sel(r);
            norm_row(res_row(p, 0, r), (const int*)0, (float*)0, (int*)0, g, mod + sel * 6144 + 3072, mod + sel * 6144 + 4096, hb + (size_t)r * D, true, (LAS bf16_t*)(lds + tr * N2_STRIDE), (LAS bf16_t*)(lds + N2_TILE * N2_STRIDE + tr * N2_STRIDE), lane); }
        __syncthreads();
        { const int mt = wave >> 2, nt = wave & 3; f32x4 acc = (f32x4){0.f, 0.f, 0.f, 0.f};
          const LAS unsigned char* ap = lds + (16 * mt + fr) * N2_STRIDE + fq * 16; const bf16_t* bp = rt + (size_t)(16 * nt + fr) * D + fq * 8;
#pragma unroll 4
          for (int ks = 0; ks < 32; ++ks) { const bf16x8 a = *(const LAS bf16x8*)(ap + ks * 64), al = *(const LAS bf16x8*)(ap + N2_TILE * N2_STRIDE + ks * 64);
              const bf16x8 bb = *(const bf16x8*)(bp + ks * 32), bl = *(const bf16x8*)(bp + NE * D + ks * 32);
              acc = __builtin_amdgcn_mfma_f32_16x16x32_bf16(a, bb, acc, 0, 0, 0); acc = __builtin_amdgcn_mfma_f32_16x16x32_bf16(al, bb, acc, 0, 0, 0); acc = __builtin_amdgcn_mfma_f32_16x16x32_bf16(a, bl, acc, 0, 0, 0); }
#pragma unroll
          for (int j = 0; j < 4; ++j) lg[(16 * mt + 4 * fq + j) * 64 + 16 * nt + fr] = acc[j]; }
        __syncthreads();
#pragma unroll 1
        for (int i = 0; i < 4; ++i) { const int tr = 4 * wave + i, r = r0 + tr;
            const float sc = sigmoidf_(lg[tr * 64 + lane]); float sel = sc + rbias; float ssum = 0.f; int myE = 0; float myS = 0.f;
#pragma unroll 1
            for (int k = 0; k < TOPK; ++k) { float bv = sel; int bi = lane;
#pragma unroll
                for (int o = 32; o >= 1; o >>= 1) { const int l_ = lane_id_asm(); const float ov = shx_(bv, l_, o); const int oi = shxi_(bi, l_, o); if (ov > bv || (ov == bv && oi < bi)) { bv = ov; bi = oi; } }
                const int e = __builtin_amdgcn_readfirstlane(bi); const float se = rl(sc, e);
                ssum += se; if (lane == k) { myE = e; myS = se; } if (lane == e) sel = -1e30f; }
            if (lane < TOPK) { const unsigned pos = atomicAdd(cnt + myE * 16, 1u); ltok[(size_t)myE * ROWS + pos] = r; tokt[(size_t)r * 16 + lane] = (myE << 16) | (int)pos; ((float*)tokt)[(size_t)r * 16 + 8 + lane] = myS / ssum * 2.5f; } }
        __syncthreads();
    }
}
__device__ __forceinline__ void moe_table(const Cx& p, LAS int* tb, int layer, int row_lo) {
    const unsigned* cnt = WSP(unsigned, WS_CTL) + CW_CNT + layer * 80 * 16;
    if (p.tid == 0) { int acc = 0;
#pragma unroll 1
        for (int e = 0; e < NE1; ++e) { const int c = e < NE ? (int)__hip_atomic_load(cnt + e * 16, __ATOMIC_RELAXED, __HIP_MEMORY_SCOPE_AGENT) : ROWS - row_lo; tb[e] = c; tb[128 + e] = acc; acc += (c + 255) >> 8; }
        tb[128 + NE1] = acc; }
    __syncthreads();
}
__device__ __forceinline__ void phase_combine(const Cx& p, const LAS int* tb, int layer, int row_lo, int half) {
    const int lane = p.tid & 63, wave = p.tid >> 6; const bf16_t* Y = WSP(bf16_t, WS_Y); const int* tokt = WSP(int, WS_TOKT);
    const float* gate = WSP(float, WS_MOD) + (size_t)layer * 5 * 6144 + 5120; const int col = 512 * half + 8 * lane; const int shbase = tb[128 + NE] * 256;
#pragma unroll 2
    for (int r = row_lo + p.bid * 8 + wave; r < ROWS; r += p.G * 8) {
        const int sw = lane < 16 ? tokt[(size_t)r * 16 + lane] : 0;
        float a[8];
        { const u32x4 y = *(const u32x4*)(Y + (size_t)(shbase + (r - row_lo)) * 512 + 8 * lane);
#pragma unroll
          for (int q = 0; q < 4; ++q) { a[2 * q] = __uint_as_float(y[q] << 16); a[2 * q + 1] = __uint_as_float(y[q] & 0xffff0000u); } }
#pragma unroll
        for (int k = 0; k < 8; ++k) { const int sl = __builtin_amdgcn_readlane(sw, k); const float w = __uint_as_float(__builtin_amdgcn_readlane(sw, 8 + k));
            const int hrow = tb[128 + (sl >> 16)] * 256 + (sl & 0xffff); const u32x4 y = *(const u32x4*)(Y + (size_t)hrow * 512 + 8 * lane);
#pragma unroll
            for (int q = 0; q < 4; ++q) { a[2 * q] += w * __uint_as_float(y[q] << 16); a[2 * q + 1] += w * __uint_as_float(y[q] & 0xffff0000u); } }
        float* x = (float*)res_row(p, 0, r) + col; const float* gp = gate + row_sel(r) * 6144 + col;
#pragma unroll
        for (int q = 0; q < 2; ++q) { const f32x4 gv = *(const f32x4*)(gp + 4 * q); f32x4 xv = *(const f32x4*)(x + 4 * q);
            xv[0] += gv[0] * a[4 * q]; xv[1] += gv[1] * a[4 * q + 1]; xv[2] += gv[2] * a[4 * q + 2]; xv[3] += gv[3] * a[4 * q + 3]; *(f32x4*)(x + 4 * q) = xv; }
    }
}
__device__ __forceinline__ void phase_final(const Cx& p) {
    const int lane = p.tid & 63, wave = p.tid >> 6; const float* g = PIN(I_FNG);
    for (int r = p.bid * 8 + wave; r < NB * SEQ; r += p.G * 8) { float* x = p.out + (size_t)r * D;
        f32x4 v[4]; float ss = 0.f;
#pragma unroll
        for (int i = 0; i < 4; ++i) { v[i] = *(const f32x4*)(x + 256 * i + 4 * lane); ss += v[i][0] * v[i][0] + v[i][1] * v[i][1] + v[i][2] * v[i][2] + v[i][3] * v[i][3]; }
        ss = wsum(ss); const float rstd = rsqrtf(ss * (1.0f / D) + 1e-6f);
#pragma unroll
        for (int i = 0; i < 4; ++i) *(f32x4*)(x + 256 * i + 4 * lane) = v[i] * rstd * *(const f32x4*)(g + 256 * i + 4 * lane); }
}
#ifndef MK_CHUNK
#define MK_CHUNK 7
#endif
__device__ __forceinline__ int chain_tb(int n, int d) { return d == 0 ? n : (n < 4 ? 3 - n : 135 - n); }
__device__ __forceinline__ int tb_row0(int b, int tb) { return tb < 4 ? b * NCTX + 64 * tb : CROWS + b * SEQ + 64 * (tb - 4); }
constexpr int TS = 144;
template <int K, int NT> __device__ __forceinline__ void mm_rows(const LAS unsigned char* A, int lda, const LAS unsigned char* Bt, int ldb, int mt, int nt0, int fr, int fq, f32x4 (&acc)[NT]) {
#pragma unroll
    for (int ks = 0; ks < K / 32; ++ks) { const bf16x8 a = *(const LAS bf16x8*)(A + (16 * mt + fr) * lda + ks * 64 + fq * 16);
#pragma unroll
        for (int nt = 0; nt < NT; ++nt) { const bf16x8 bb = *(const LAS bf16x8*)(Bt + (16 * (nt0 + nt) + fr) * ldb + ks * 64 + fq * 16);
            acc[nt] = __builtin_amdgcn_mfma_f32_16x16x32_bf16(a, bb, acc[nt], 0, 0, 0); } }
}
__device__ __forceinline__ void gla_p1(const Cx& p, LAS unsigned char* lds, int layer, int b) {
    const int lane = p.tid & 63, wave = __builtin_amdgcn_readfirstlane(p.tid >> 6), fr = lane & 15, fq = lane >> 4;
    if (wave >= 7) return;
    LAS unsigned char* ksT = lds + wave * (2 * 64 * TS); LAS unsigned char* vT = ksT + 64 * TS;
    const bf16_t* proj = WSP(bf16_t, WS_PROJ);
    for (int u = p.bid * 7 + wave; u < NUNIT; u += p.G * 7) { const int tb = u >> 3, h = (u >> 1) & 3, d = u & 1, c = 64 * h + lane;
        const bf16_t* pr0 = proj + (size_t)tb_row0(b, tb) * NPROJ;
        float w2[16];
#pragma unroll
        for (int r = 0; r < 16; ++r) w2[r] = PIN(I_GLA_W2)[((size_t)(layer * 2 + d) * 16 + r) * 256 + c];
        const float gb = PIN(I_GLA_B)[(layer * 2 + d) * 256 + c];
        float total = 0.f;
#pragma unroll 2
        for (int i = 0; i < 64; ++i) { const bf16_t* pr = pr0 + (size_t)i * NPROJ;
            const float gl = lane < 16 ? bf2f(pr[(d ? PA_GB : PA_GF) + lane]) : 0.f; float z = gb;
#pragma unroll
            for (int r = 0; r < 16; ++r) z += rl(gl, r) * w2[r];
            total += logsigmoidf_(z) * (1.0f / 16.0f); }
        float run = 0.f;
#pragma unroll 1
        for (int ii = 0; ii < 64; ii += 2) { const int ia = d ? 63 - ii : ii, ib = d ? 62 - ii : ii + 1;
            const bf16_t* pa = pr0 + (size_t)ia * NPROJ; const bf16_t* pb = pr0 + (size_t)ib * NPROJ;
            const float gla_ = lane < 16 ? bf2f(pa[(d ? PA_GB : PA_GF) + lane]) : 0.f, glb_ = lane < 16 ? bf2f(pb[(d ? PA_GB : PA_GF) + lane]) : 0.f; float za = gb, zb = gb;
#pragma unroll
            for (int r = 0; r < 16; ++r) { za += rl(gla_, r) * w2[r]; zb += rl(glb_, r) * w2[r]; }
            run += logsigmoidf_(za) * (1.0f / 16.0f); const float ka = bf2f(pa[PA_K + c]) * __expf(total - run);
            run += logsigmoidf_(zb) * (1.0f / 16.0f); const float kb = bf2f(pb[PA_K + c]) * __expf(total - run);
            const int lo = d ? ib : ia;
            *(LAS unsigned*)(ksT + lane * TS + lo * 2) = d ? pk2(kb, ka) : pk2(ka, kb);
            *(LAS unsigned*)(vT + lane * TS + lo * 2) = d ? ((unsigned)pb[PA_V + c] | ((unsigned)pa[PA_V + c] << 16)) : ((unsigned)pa[PA_V + c] | ((unsigned)pb[PA_V + c] << 16)); }
        WSP(float, SC_GLA_DEC)[(size_t)u * 64 + lane] = __expf(total);
        float* kv = WSP(float, SC_GLA_S) + (size_t)u * 4096;
#pragma unroll
        for (int mt = 0; mt < 4; ++mt) { f32x4 acc[4];
#pragma unroll
            for (int nt = 0; nt < 4; ++nt) acc[nt] = (f32x4){0.f, 0.f, 0.f, 0.f};
            mm_rows<64, 4>(ksT, TS, vT, TS, mt, 0, fr, fq, acc);
#pragma unroll
            for (int nt = 0; nt < 4; ++nt)
#pragma unroll
                for (int j = 0; j < 4; ++j) kv[(16 * mt + 4 * fq + j) * 64 + 16 * nt + fr] = acc[nt][j]; }
    }
}
__device__ __forceinline__ void gla_chain(const Cx& p, int h, int d) {
    const int dk = p.tid >> 3, c0 = (p.tid & 7) * 8;
    f32x4 s0 = (f32x4){0.f, 0.f, 0.f, 0.f}, s1 = s0;
    f32x4 n0[6], n1[6]; float dc[6];
#define GC_LD(q, n_) do { const int u_ = (chain_tb((n_), d) * 4 + h) * 2 + d; const float* k_ = WSP(float, SC_GLA_S) + (size_t)u_ * 4096 + dk * 64 + c0; \
        n0[q] = *(const f32x4*)k_; n1[q] = *(const f32x4*)(k_ + 4); dc[q] = WSP(float, SC_GLA_DEC)[(size_t)u_ * 64 + dk]; } while (0)
#define GC_ST(q, n_) do { const int u_ = (chain_tb((n_), d) * 4 + h) * 2 + d; float* k_ = WSP(float, SC_GLA_S) + (size_t)u_ * 4096 + dk * 64 + c0; \
        const f32x4 a0_ = n0[q], a1_ = n1[q]; const float de_ = dc[q]; if ((n_) + 6 < NTB) GC_LD(q, (n_) + 6); \
        *(f32x4*)k_ = s0; *(f32x4*)(k_ + 4) = s1; s0 = s0 * de_ + a0_; s1 = s1 * de_ + a1_; } while (0)
    GC_LD(0, 0); GC_LD(1, 1); GC_LD(2, 2); GC_LD(3, 3); GC_LD(4, 4); GC_LD(5, 5);
#pragma unroll 1
    for (int n = 0; n < NTB; n += 6) { GC_ST(0, n); GC_ST(1, n + 1); GC_ST(2, n + 2); GC_ST(3, n + 3); GC_ST(4, n + 4); GC_ST(5, n + 5); }
#undef GC_LD
#undef GC_ST
}
__device__ __forceinline__ void gla_p2(const Cx& p, LAS unsigned char* lds, int layer, int b) {
    const int tid = p.tid, lane = tid & 63, wave = __builtin_amdgcn_readfirstlane(tid >> 6), fr = lane & 15, fq = lane >> 4;
    LAS unsigned char* qt = lds; LAS unsigned char* kt = lds + 64 * TS; LAS unsigned char* vT = lds + 2 * 64 * TS; LAS unsigned char* sT = lds + 3 * 64 * TS; LAS unsigned char* att = lds + 4 * 64 * TS;
    LAS float* gs = (LAS float*)(lds + 5 * 64 * TS);
    const bf16_t* proj = WSP(bf16_t, WS_PROJ);
    for (int u = p.bid; u < NUNIT; u += p.G) { const int tb = u >> 3, h = (u >> 1) & 3, d = u & 1; const int cl = tid & 63, tg = tid >> 6, c = 64 * h + cl;
        const int row0 = tb_row0(b, tb), s0 = 64 * tb; const bf16_t* pr0 = proj + (size_t)row0 * NPROJ;
        float w2[16];
#pragma unroll
        for (int r = 0; r < 16; ++r) w2[r] = PIN(I_GLA_W2)[((size_t)(layer * 2 + d) * 16 + r) * 256 + c];
        const float gb = PIN(I_GLA_B)[(layer * 2 + d) * 256 + c];
        float bl[8]; float run = 0.f;
#pragma unroll
        for (int ii = 0; ii < 8; ++ii) { const int i8 = d ? 7 - ii : ii; const bf16_t* pr = pr0 + (size_t)(8 * tg + i8) * NPROJ + (d ? PA_GB : PA_GF); float z = gb;
#pragma unroll
            for (int r = 0; r < 16; ++r) z += bf2f(pr[r]) * w2[r];
            run += logsigmoidf_(z) * (1.0f / 16.0f); if (d) bl[7 - ii] = run; else bl[ii] = run; }
        gs[tg * 64 + cl] = run;
        { const float* sp = WSP(float, SC_GLA_S) + (size_t)u * 4096;
#pragma unroll
          for (int q = 0; q < 8; ++q) { const int e = tid + NTHR * q, dk = e >> 6, dv = e & 63; *(LAS bf16_t*)(sT + dv * TS + dk * 2) = (bf16_t)f2bf(sp[e]); } }
        __syncthreads();
        float off = 0.f;
#pragma unroll
        for (int g2 = 0; g2 < 8; ++g2) if (d ? g2 > tg : g2 < tg) off += gs[g2 * 64 + cl];
#pragma unroll
        for (int i8 = 0; i8 < 8; ++i8) { const int i = 8 * tg + i8; const bf16_t* pr = pr0 + (size_t)i * NPROJ; const float bi = bl[i8] + off;
            *(LAS bf16_t*)(qt + i * TS + cl * 2) = (bf16_t)f2bf(bf2f(pr[PA_Q + c]) * 0.125f * __expf(bi));
            *(LAS bf16_t*)(kt + i * TS + cl * 2) = (bf16_t)f2bf(bf2f(pr[PA_K + c]) * __expf(-bi));
            *(LAS bf16_t*)(vT + cl * TS + i * 2) = pr[PA_V + c]; }
        __syncthreads();
        const int mt = wave >> 1, nt0 = (wave & 1) * 2;
        { f32x4 acc[2] = {(f32x4){0.f, 0.f, 0.f, 0.f}, (f32x4){0.f, 0.f, 0.f, 0.f}};
          mm_rows<64, 2>(qt, TS, kt, TS, mt, nt0, fr, fq, acc);
#pragma unroll
          for (int t = 0; t < 2; ++t)
#pragma unroll
              for (int j = 0; j < 4; ++j) { const int i = 16 * mt + 4 * fq + j, jj = 16 * (nt0 + t) + fr; const bool keep = d ? jj >= i : jj <= i;
                  *(LAS bf16_t*)(att + i * TS + jj * 2) = (bf16_t)f2bf(keep ? acc[t][j] : 0.f); } }
        __syncthreads();
        { f32x4 acc[2] = {(f32x4){0.f, 0.f, 0.f, 0.f}, (f32x4){0.f, 0.f, 0.f, 0.f}};
          mm_rows<64, 2>(att, TS, vT, TS, mt, nt0, fr, fq, acc);
          mm_rows<64, 2>(qt, TS, sT, TS, mt, nt0, fr, fq, acc);
          bf16_t* ob = WSP(bf16_t, d ? SC_OB : SC_OF);
#pragma unroll
          for (int t = 0; t < 2; ++t)
#pragma unroll
              for (int j = 0; j < 4; ++j) ob[(size_t)(s0 + 16 * mt + 4 * fq + j) * 1024 + 64 * h + 16 * (nt0 + t) + fr] = (bf16_t)f2bf(acc[t][j]); }
        __syncthreads();
    }
}
constexpr int TS2 = 272;
__device__ __forceinline__ float ssd_acum(float a, int d, int lane, float& total) {
    float pre = a;
#pragma unroll
    for (int o = 1; o < 64; o <<= 1) { const float t = shup_(pre, lane, o); if (lane >= o) pre += t; }
    total = rl(pre, 63);
    return d ? total - pre + a : pre;
}
__device__ __forceinline__ void ssd_p1(const Cx& p, LAS unsigned char* lds, int layer, int b) {
    const int tid = p.tid, lane = tid & 63, wave = __builtin_amdgcn_readfirstlane(tid >> 6), fr = lane & 15, fq = lane >> 4;
    LAS unsigned char* BT = lds; LAS unsigned char* xT = lds + 128 * TS; LAS float* AC = (LAS float*)(lds + 128 * TS + 4 * 64 * TS);
    for (int u2 = p.bid; u2 < NTB * 2; u2 += p.G) { const int tb = u2 >> 1, g = u2 & 1, s0 = 64 * tb;
        const bf16_t* sx = WSP(bf16_t, SC_SX) + (size_t)s0 * 768; const float* sdt = WSP(float, SC_SDT) + (size_t)s0 * 8;
        if (wave < 4) { const int hd = wave, h = 2 * g + (hd >> 1), d = hd & 1; const float aneg = -__expf(PIN(I_SS_ALOG)[(layer * 2 + d) * 4 + h]);
            float tot; const float ac = ssd_acum(aneg * sdt[lane * 8 + d * 4 + h], d, lane, tot); AC[hd * 64 + lane] = ac; if (lane == 0) { AC[256 + hd] = tot; WSP(float, SC_SSD_CD)[(tb * 4 + h) * 2 + d] = __expf(tot); } }
#pragma unroll 2
        for (int q = 0; q < 16; ++q) { const int e = tid + NTHR * q, i = e >> 7, s = e & 127; *(LAS bf16_t*)(BT + s * TS + i * 2) = sx[(size_t)i * 768 + 256 + 128 * g + s]; }
        __syncthreads();
#pragma unroll 2
        for (int q = 0; q < 32; ++q) { const int e = tid + NTHR * q, hd = e >> 12, i = (e >> 6) & 63, pp = e & 63, h = 2 * g + (hd >> 1), d = hd & 1;
            const float x = bf2f(sx[(size_t)i * 768 + 64 * h + pp]) * sdt[i * 8 + d * 4 + h] * __expf(AC[256 + hd] - AC[hd * 64 + i]);
            *(LAS bf16_t*)(xT + (hd * 64 + pp) * TS + i * 2) = (bf16_t)f2bf(x); }
        __syncthreads();
        { const int hd = wave >> 1, half = wave & 1, h = 2 * g + (hd >> 1), d = hd & 1; float* cs = WSP(float, SC_SSD_S) + (size_t)((tb * 4 + h) * 2 + d) * 8192;
#pragma unroll 1
          for (int mt = 0; mt < 4; ++mt) { f32x4 acc[4];
#pragma unroll
              for (int t = 0; t < 4; ++t) acc[t] = (f32x4){0.f, 0.f, 0.f, 0.f};
              mm_rows<64, 4>(xT + hd * 64 * TS, TS, BT, TS, mt, 4 * half, fr, fq, acc);
#pragma unroll
              for (int t = 0; t < 4; ++t)
#pragma unroll
                  for (int j = 0; j < 4; ++j) cs[(16 * mt + 4 * fq + j) * 128 + 16 * (4 * half + t) + fr] = acc[t][j]; } }
        __syncthreads();
    }
}
__device__ __forceinline__ void ssd_chain(const Cx& p, int h, int d) {
    const int e0 = p.tid * 16;
    f32x4 s[4]; f32x4 nx[6][4]; float cd[6];
#pragma unroll
    for (int k = 0; k < 4; ++k) s[k] = (f32x4){0.f, 0.f, 0.f, 0.f};
#define SC_LD(q, n_) do { const int u_ = (chain_tb((n_), d) * 4 + h) * 2 + d; const float* c_ = WSP(float, SC_SSD_S) + (size_t)u_ * 8192 + e0; \
        _Pragma("unroll") for (int k = 0; k < 4; ++k) nx[q][k] = *(const f32x4*)(c_ + 4 * k); cd[q] = WSP(float, SC_SSD_CD)[u_]; } while (0)
#define SC_ST(q, n_) do { const int u_ = (chain_tb((n_), d) * 4 + h) * 2 + d; float* c_ = WSP(float, SC_SSD_S) + (size_t)u_ * 8192 + e0; f32x4 a_[4]; const float de_ = cd[q]; \
        _Pragma("unroll") for (int k = 0; k < 4; ++k) a_[k] = nx[q][k]; if ((n_) + 6 < NTB) SC_LD(q, (n_) + 6); \
        _Pragma("unroll") for (int k = 0; k < 4; ++k) { *(f32x4*)(c_ + 4 * k) = s[k]; s[k] = s[k] * de_ + a_[k]; } } while (0)
    SC_LD(0, 0); SC_LD(1, 1); SC_LD(2, 2); SC_LD(3, 3); SC_LD(4, 4); SC_LD(5, 5);
#pragma unroll 1
    for (int n = 0; n < NTB; n += 6) { SC_ST(0, n); SC_ST(1, n + 1); SC_ST(2, n + 2); SC_ST(3, n + 3); SC_ST(4, n + 4); SC_ST(5, n + 5); }
#undef SC_LD
#undef SC_ST
}
__device__ __forceinline__ void ssd_p2(const Cx& p, LAS unsigned char* lds, int layer, int b) {
    const int tid = p.tid, lane = tid & 63, wave = __builtin_amdgcn_readfirstlane(tid >> 6), fr = lane & 15, fq = lane >> 4;
    LAS unsigned char* Ct = lds; LAS unsigned char* Bt2 = lds + 64 * TS2; LAS float* cb = (LAS float*)(lds + 2 * 64 * TS2); LAS float* AC = cb + 64 * 65;
    LAS unsigned char* Mt = (LAS unsigned char*)(AC + 260 + 4); LAS unsigned char* xT = Mt + 64 * TS; LAS unsigned char* Sb = xT + 64 * TS;
    const int mt = wave >> 1, nt0 = (wave & 1) * 2;
    for (int u2 = p.bid; u2 < NTB * 2; u2 += p.G) { const int tb = u2 >> 1, g = u2 & 1, s0 = 64 * tb;
        const bf16_t* sx = WSP(bf16_t, SC_SX) + (size_t)s0 * 768; const float* sdt = WSP(float, SC_SDT) + (size_t)s0 * 8;
        if (wave < 4) { const int hd = wave, h = 2 * g + (hd >> 1), d = hd & 1; const float aneg = -__expf(PIN(I_SS_ALOG)[(layer * 2 + d) * 4 + h]);
            float tot; const float ac = ssd_acum(aneg * sdt[lane * 8 + d * 4 + h], d, lane, tot); AC[hd * 64 + lane] = ac; }
#pragma unroll
        for (int q = 0; q < 2; ++q) { const int e = tid + NTHR * q, i = e >> 4, ch = e & 15;
            *(LAS u32x4*)(Ct + i * TS2 + ch * 16) = *(const u32x4*)(sx + (size_t)i * 768 + 512 + 128 * g + ch * 8);
            *(LAS u32x4*)(Bt2 + i * TS2 + ch * 16) = *(const u32x4*)(sx + (size_t)i * 768 + 256 + 128 * g + ch * 8); }
        __syncthreads();
        { f32x4 acc[2] = {(f32x4){0.f, 0.f, 0.f, 0.f}, (f32x4){0.f, 0.f, 0.f, 0.f}};
          mm_rows<128, 2>(Ct, TS2, Bt2, TS2, mt, nt0, fr, fq, acc);
#pragma unroll
          for (int t = 0; t < 2; ++t)
#pragma unroll
              for (int j = 0; j < 4; ++j) cb[(16 * mt + 4 * fq + j) * 65 + 16 * (nt0 + t) + fr] = acc[t][j]; }
        __syncthreads();
#pragma unroll 1
        for (int hd = 0; hd < 4; ++hd) { const int h = 2 * g + (hd >> 1), d = hd & 1;
            { const int i = tid >> 3, j0 = (tid & 7) * 8; const float ai = AC[hd * 64 + i]; unsigned w[4];
#pragma unroll
              for (int jj = 0; jj < 8; jj += 2) { float m[2];
#pragma unroll
                  for (int q = 0; q < 2; ++q) { const int j = j0 + jj + q; const bool keep = d ? j >= i : j <= i; m[q] = keep ? cb[i * 65 + j] * __expf(ai - AC[hd * 64 + j]) : 0.f; }
                  w[jj >> 1] = pk2(m[0], m[1]); }
              *(LAS u32x4*)(Mt + i * TS + j0 * 2) = (u32x4){w[0], w[1], w[2], w[3]}; }
#pragma unroll 2
            for (int q = 0; q < 8; ++q) { const int e = tid + NTHR * q, j = e >> 6, pp = e & 63;
                *(LAS bf16_t*)(xT + pp * TS + j * 2) = (bf16_t)f2bf(bf2f(sx[(size_t)j * 768 + 64 * h + pp]) * sdt[j * 8 + d * 4 + h]); }
            { const float* sp = WSP(float, SC_SSD_S) + (size_t)((tb * 4 + h) * 2 + d) * 8192;
#pragma unroll
              for (int q = 0; q < 4; ++q) { const int e = (tid + NTHR * q) * 4, pp = e >> 7, s = e & 127; const f32x4 v = *(const f32x4*)(sp + e);
                  *(LAS u32x2*)(Sb + pp * TS2 + s * 2) = (u32x2){pk2(v[0], v[1]), pk2(v[2], v[3])}; } }
            __syncthreads();
            { f32x4 acc[2] = {(f32x4){0.f, 0.f, 0.f, 0.f}, (f32x4){0.f, 0.f, 0.f, 0.f}};
              mm_rows<128, 2>(Ct, TS2, Sb, TS2, mt, nt0, fr, fq, acc);
#pragma unroll
              for (int j = 0; j < 4; ++j) { const float sc = __expf(AC[hd * 64 + 16 * mt + 4 * fq + j]); acc[0][j] *= sc; acc[1][j] *= sc; }
              mm_rows<64, 2>(Mt, TS, xT, TS, mt, nt0, fr, fq, acc);
              bf16_t* ob = WSP(bf16_t, d ? SC_OB : SC_OF);
#pragma unroll
              for (int t = 0; t < 2; ++t)
#pragma unroll
                  for (int j = 0; j < 4; ++j) ob[(size_t)(s0 + 16 * mt + 4 * fq + j) * 1024 + 512 + 64 * h + 16 * (nt0 + t) + fr] = (bf16_t)f2bf(acc[t][j]); }
            __syncthreads();
        }
    }
}
constexpr int AFS = 68;
#define DR_PIN16(x, b_) asm volatile("" : "+v"(x[(b_)+0]), "+v"(x[(b_)+1]), "+v"(x[(b_)+2]), "+v"(x[(b_)+3]), "+v"(x[(b_)+4]), "+v"(x[(b_)+5]), "+v"(x[(b_)+6]), "+v"(x[(b_)+7]), \
        "+v"(x[(b_)+8]), "+v"(x[(b_)+9]), "+v"(x[(b_)+10]), "+v"(x[(b_)+11]), "+v"(x[(b_)+12]), "+v"(x[(b_)+13]), "+v"(x[(b_)+14]), "+v"(x[(b_)+15]) :: "memory")
template <int J> __device__ __forceinline__ void dr_subst_step(float (&x)[64], const LAS float* AfT, const float sgn) {
    const float xj_ = sgn * x[J];
#pragma unroll
    for (int g_ = 0; g_ < 4; ++g_) if (16 * g_ + 15 > J) {
#pragma unroll
        for (int q_ = 0; q_ < 16; ++q_) if (16 * g_ + q_ > J) x[16 * g_ + q_] -= AfT[J * AFS + 16 * g_ + q_] * xj_;
        DR_PIN16(x, 16 * g_); }
    if constexpr (J + 1 < 63) dr_subst_step<J + 1>(x, AfT, sgn);
}
#define DR_SUBST(x, AfT, sgn) dr_subst_step<0>(x, AfT, sgn)
__device__ __forceinline__ int dr_mfrag_idx(int row, int col) { return (((row >> 4) * 2 + (col >> 5)) * 64 + ((col >> 2) & 3) * 16 + (row & 15)) * 8 + ((col >> 4) & 1) * 4 + (col & 3); }
__device__ __forceinline__ void gdn_p1(const Cx& p, LAS unsigned char* lds, int layer, int b) {
    const int wave = __builtin_amdgcn_readfirstlane(p.tid >> 6);
#define GDN_LANES const int lane = lane_id_asm(), tid = wave * 64 + lane, fr = lane & 15, fq = lane >> 4; (void)tid; (void)fr; (void)fq
    LAS unsigned char* kh = lds; LAS unsigned char* kb = lds + 64 * TS; LAS unsigned char* XT = lds + 2 * 64 * TS; LAS unsigned char* kdT = lds + 4 * 64 * TS;
    LAS float* Af = (LAS float*)(lds + 5 * 64 * TS); LAS float* GC = Af + 64 * AFS;
    const int mt = wave >> 1, nt0 = (wave & 1) * 2;
    for (int u = p.bid; u < NUNIT; u += p.G) { const int tb = u >> 3, h = (u >> 1) & 3, d = u & 1, s0 = 64 * tb;
        const bf16_t* dq = WSP(bf16_t, SC_DQ) + (size_t)s0 * 768; const float* dg = WSP(float, SC_DG) + (size_t)s0 * 16;
        if (wave == 0) { GDN_LANES; const int i = d ? 63 - lane : lane; float pre = dg[i * 16 + 8 + d * 4 + h];
#pragma unroll
            for (int o = 1; o < 64; o <<= 1) { const float t = shup_(pre, lane, o); if (lane >= o) pre += t; }
            GC[lane] = pre; GC[64 + lane] = dg[i * 16 + d * 4 + h]; }
        { GDN_LANES; const int r = tid >> 3, c0 = (tid & 7) * 8, i = d ? 63 - r : r; const float beta = dg[i * 16 + d * 4 + h];
          const u32x4 kv = *(const u32x4*)(dq + (size_t)i * 768 + 256 + 64 * h + c0); u32x4 kw;
#pragma unroll
          for (int q = 0; q < 4; ++q) kw[q] = pk2(__uint_as_float(kv[q] << 16) * beta, __uint_as_float(kv[q] & 0xffff0000u) * beta);
          *(LAS u32x4*)(kh + r * TS + c0 * 2) = kv; *(LAS u32x4*)(kb + r * TS + c0 * 2) = kw; }
        __syncthreads();
        const float gtot = GC[63];
        { GDN_LANES; f32x4 acc[2] = {(f32x4){0.f, 0.f, 0.f, 0.f}, (f32x4){0.f, 0.f, 0.f, 0.f}};
          mm_rows<64, 2>(kb, TS, kh, TS, mt, nt0, fr, fq, acc);
#pragma unroll
          for (int t = 0; t < 2; ++t)
#pragma unroll
              for (int j = 0; j < 4; ++j) { const int r = 16 * mt + 4 * fq + j, jj = 16 * (nt0 + t) + fr; Af[jj * AFS + r] = jj < r ? acc[t][j] * __expf(GC[r] - GC[jj]) : 0.f; } }
        { GDN_LANES;
#pragma unroll 2
        for (int q = 0; q < 8; ++q) { const int e = tid + NTHR * q, r = e >> 6, cc = e & 63;
            *(LAS bf16_t*)(kdT + cc * TS + r * 2) = (bf16_t)f2bf(bf2f(*(const LAS bf16_t*)(kh + r * TS + cc * 2)) * __expf(gtot - GC[r])); } }
        __syncthreads();
        if (wave < 2) { GDN_LANES; const int col = tid; float x[64];
            const bf16_t* vcol = dq + 512 + 64 * h + (col - 64);
            if (wave == 0) {
#pragma unroll
                for (int r = 0; r < 64; ++r) { x[r] = bf2f(*(const LAS bf16_t*)(kb + r * TS + col * 2)) * __expf(GC[r]); if ((r & 7) == 7) { asm volatile("" ::: "memory"); __builtin_amdgcn_sched_barrier(0); } }
            } else {
#pragma unroll
                for (int r = 0; r < 64; ++r) { x[r] = bf2f(vcol[(size_t)(d ? 63 - r : r) * 768]) * GC[64 + r]; if ((r & 7) == 7) { asm volatile("" ::: "memory"); __builtin_amdgcn_sched_barrier(0); } }
            }
            { const LAS float* Aop = Af; asm volatile("" : "+v"(Aop));
              DR_SUBST(x, Aop, 1.0f); }
            bf16_t* wu = WSP(bf16_t, SC_DR_WU) + (size_t)u * 8192;
#pragma unroll
            for (int r = 0; r < 64; r += 2) { *(LAS unsigned*)(XT + col * TS + r * 2) = pk2(x[r], x[r + 1]); wu[r * 128 + col] = (bf16_t)f2bf(x[r]); wu[(r + 1) * 128 + col] = (bf16_t)f2bf(x[r + 1]); } }
        __syncthreads();
        { GDN_LANES; f32x4 am[2] = {(f32x4){0.f, 0.f, 0.f, 0.f}, (f32x4){0.f, 0.f, 0.f, 0.f}}, an[2] = {(f32x4){0.f, 0.f, 0.f, 0.f}, (f32x4){0.f, 0.f, 0.f, 0.f}};
          mm_rows<64, 2>(kdT, TS, XT, TS, mt, nt0, fr, fq, am);
          mm_rows<64, 2>(kdT, TS, XT + 64 * TS, TS, mt, nt0, fr, fq, an);
          bf16_t* Mg = WSP(bf16_t, SC_DR_M) + (size_t)u * 4096; bf16_t* Ng = WSP(bf16_t, SC_DR_NS) + (size_t)u * 4096; const float eg = __expf(gtot);
#pragma unroll
          for (int t = 0; t < 2; ++t) {
#pragma unroll
              for (int j = 0; j < 4; ++j) { const int row = 16 * mt + 4 * fq + j, col = 16 * (nt0 + t) + fr; Mg[dr_mfrag_idx(row, col)] = (bf16_t)f2bf((row == col ? eg : 0.f) - am[t][j]); }
              *(u32x2*)(Ng + (((nt0 + t) * 4 + mt) * 64 + lane) * 4) = (u32x2){pk2(an[t][0], an[t][1]), pk2(an[t][2], an[t][3])}; } }
        __syncthreads();
    }
#undef GDN_LANES
}
__device__ __forceinline__ void dr_chain(const Cx& p, size_t offM, size_t offNS, int h, int d) {
    const int lane = p.tid & 63, cb = __builtin_amdgcn_readfirstlane(p.tid >> 6), fr = lane & 15, fq = lane >> 4;
    if (cb >= 4) return;
    f32x4 acc[4];
#pragma unroll
    for (int t = 0; t < 4; ++t) acc[t] = (f32x4){0.f, 0.f, 0.f, 0.f};
    bf16x8 mR[4][4][2]; u32x2 nR[4][4];
#define DR_LD(m, nn, n_) do { const int u_ = (chain_tb((n_), d) * 4 + h) * 2 + d; const bf16_t* M_ = WSP(bf16_t, offM) + (size_t)u_ * 4096; const bf16_t* N_ = WSP(bf16_t, offNS) + (size_t)u_ * 4096; \
        _Pragma("unroll") for (int t = 0; t < 4; ++t) { _Pragma("unroll") for (int ks = 0; ks < 2; ++ks) m[t][ks] = *(const bf16x8*)(M_ + ((t * 2 + ks) * 64 + lane) * 8); nn[t] = *(const u32x2*)(N_ + ((cb * 4 + t) * 64 + lane) * 4); } } while (0)
#define DR_STEP(m, nn, n_) do { const int u_ = (chain_tb((n_), d) * 4 + h) * 2 + d; bf16_t* ST_ = WSP(bf16_t, offNS) + (size_t)u_ * 4096 + (16 * cb + fr) * 64 + 4 * fq; \
        u32x2 sp_[4]; _Pragma("unroll") for (int t = 0; t < 4; ++t) { sp_[t] = (u32x2){pk2(acc[t][0], acc[t][1]), pk2(acc[t][2], acc[t][3])}; *(u32x2*)(ST_ + 16 * t) = sp_[t]; } \
        bf16x8 bf_[2]; _Pragma("unroll") for (int ks = 0; ks < 2; ++ks) { u32x4 w_ = (u32x4){sp_[2 * ks][0], sp_[2 * ks][1], sp_[2 * ks + 1][0], sp_[2 * ks + 1][1]}; bf_[ks] = __builtin_bit_cast(bf16x8, w_); } \
        _Pragma("unroll") for (int t = 0; t < 4; ++t) { f32x4 a_ = (f32x4){__uint_as_float(nn[t][0] << 16), __uint_as_float(nn[t][0] & 0xffff0000u), __uint_as_float(nn[t][1] << 16), __uint_as_float(nn[t][1] & 0xffff0000u)}; \
            a_ = __builtin_amdgcn_mfma_f32_16x16x32_bf16(m[t][0], bf_[0], a_, 0, 0, 0); acc[t] = __builtin_amdgcn_mfma_f32_16x16x32_bf16(m[t][1], bf_[1], a_, 0, 0, 0); } } while (0)
#define DR_GO(q, n_) do { DR_STEP(mR[q], nR[q], (n_)); if ((n_) + 4 < NTB) DR_LD(mR[q], nR[q], (n_) + 4); } while (0)
    DR_LD(mR[0], nR[0], 0); DR_LD(mR[1], nR[1], 1); DR_LD(mR[2], nR[2], 2); DR_LD(mR[3], nR[3], 3);
#pragma unroll 1
    for (int n = 0; n < NTB; n += 4) { DR_GO(0, n); DR_GO(1, n + 1); DR_GO(2, n + 2); DR_GO(3, n + 3); }
#undef DR_GO
#undef DR_LD
#undef DR_STEP
}
__device__ __forceinline__ void gdn_p2(const Cx& p, LAS unsigned char* lds, int layer, int b) {
    const int tid = p.tid, lane = tid & 63, wave = __builtin_amdgcn_readfirstlane(tid >> 6), fr = lane & 15, fq = lane >> 4;
    LAS unsigned char* qh = lds; LAS unsigned char* kh = lds + 64 * TS; LAS unsigned char* wt = lds + 2 * 64 * TS; LAS unsigned char* sT = lds + 3 * 64 * TS; LAS unsigned char* aq = lds + 4 * 64 * TS; LAS unsigned char* vnT = lds + 5 * 64 * TS;
    LAS float* GC = (LAS float*)(lds + 6 * 64 * TS);
    const int mt = wave >> 1, nt0 = (wave & 1) * 2;
    for (int u = p.bid; u < NUNIT; u += p.G) { const int tb = u >> 3, h = (u >> 1) & 3, d = u & 1, s0 = 64 * tb;
        const bf16_t* dq = WSP(bf16_t, SC_DQ) + (size_t)s0 * 768; const float* dg = WSP(float, SC_DG) + (size_t)s0 * 16;
        const bf16_t* wu = WSP(bf16_t, SC_DR_WU) + (size_t)u * 8192; const bf16_t* st = WSP(bf16_t, SC_DR_NS) + (size_t)u * 4096;
        if (wave == 0) { const int i = d ? 63 - lane : lane; float pre = dg[i * 16 + 8 + d * 4 + h];
#pragma unroll
            for (int o = 1; o < 64; o <<= 1) { const float t = shup_(pre, lane, o); if (lane >= o) pre += t; }
            GC[lane] = pre; }
        { const int r = tid >> 3, c0 = (tid & 7) * 8, i = d ? 63 - r : r;
          *(LAS u32x4*)(qh + r * TS + c0 * 2) = *(const u32x4*)(dq + (size_t)i * 768 + 64 * h + c0);
          *(LAS u32x4*)(kh + r * TS + c0 * 2) = *(const u32x4*)(dq + (size_t)i * 768 + 256 + 64 * h + c0);
          *(LAS u32x4*)(wt + r * TS + c0 * 2) = *(const u32x4*)(wu + r * 128 + c0);
          *(LAS u32x4*)(sT + r * TS + c0 * 2) = *(const u32x4*)(st + r * 64 + c0); }
        __syncthreads();
        { f32x4 acc[2] = {(f32x4){0.f, 0.f, 0.f, 0.f}, (f32x4){0.f, 0.f, 0.f, 0.f}};
          mm_rows<64, 2>(qh, TS, kh, TS, mt, nt0, fr, fq, acc);
#pragma unroll
          for (int t = 0; t < 2; ++t)
#pragma unroll
              for (int j = 0; j < 4; ++j) { const int r = 16 * mt + 4 * fq + j, jj = 16 * (nt0 + t) + fr; *(LAS bf16_t*)(aq + r * TS + jj * 2) = (bf16_t)f2bf(jj <= r ? acc[t][j] * __expf(GC[r] - GC[jj]) : 0.f); }
          f32x4 av[2] = {(f32x4){0.f, 0.f, 0.f, 0.f}, (f32x4){0.f, 0.f, 0.f, 0.f}};
          mm_rows<64, 2>(wt, TS, sT, TS, mt, nt0, fr, fq, av);
#pragma unroll
          for (int t = 0; t < 2; ++t) { const int dv = 16 * (nt0 + t) + fr; float vn[4];
#pragma unroll
              for (int j = 0; j < 4; ++j) vn[j] = bf2f(wu[(16 * mt + 4 * fq + j) * 128 + 64 + dv]) - av[t][j];
              *(LAS u32x2*)(vnT + dv * TS + (16 * mt + 4 * fq) * 2) = (u32x2){pk2(vn[0], vn[1]), pk2(vn[2], vn[3])}; } }
        __syncthreads();
        { f32x4 acc[2] = {(f32x4){0.f, 0.f, 0.f, 0.f}, (f32x4){0.f, 0.f, 0.f, 0.f}};
          mm_rows<64, 2>(qh, TS, sT, TS, mt, nt0, fr, fq, acc);
#pragma unroll
          for (int j = 0; j < 4; ++j) { const float sc = __expf(GC[16 * mt + 4 * fq + j]); acc[0][j] *= sc; acc[1][j] *= sc; }
          mm_rows<64, 2>(aq, TS, vnT, TS, mt, nt0, fr, fq, acc);
          bf16_t* ob = WSP(bf16_t, d ? SC_OB : SC_OF);
#pragma unroll
          for (int t = 0; t < 2; ++t)
#pragma unroll
              for (int j = 0; j < 4; ++j) { const int r = 16 * mt + 4 * fq + j, i = d ? 63 - r : r; ob[(size_t)(s0 + i) * 1024 + 768 + 64 * h + 16 * (nt0 + t) + fr] = (bf16_t)f2bf(acc[t][j]); } }
        __syncthreads();
    }
}
constexpr int LPS = 65;
#define RW_LP(LP, GS, lwp) do { const int lane_ = lane_id_asm(), c_ = lane_, tg_ = wave; float loc_[8]; float run_ = 0.f; \
        _Pragma("unroll") for (int ii = 0; ii < 8; ++ii) { const int r_ = 8 * tg_ + ii; run_ += (lwp)[(size_t)(d ? 63 - r_ : r_) * 256 + c_]; loc_[ii] = run_; } \
        (GS)[tg_ * 64 + c_] = run_; __syncthreads(); float off_ = 0.f; \
        _Pragma("unroll") for (int g2 = 0; g2 < 8; ++g2) if (g2 < tg_) off_ += (GS)[g2 * 64 + c_]; \
        _Pragma("unroll") for (int ii = 0; ii < 8; ++ii) (LP)[(8 * tg_ + ii) * LPS + c_] = loc_[ii] + off_; __syncthreads(); } while (0)
__device__ __forceinline__ void rw_p1(const Cx& p, LAS unsigned char* lds, int layer, int b) {
    const int wave = __builtin_amdgcn_readfirstlane(p.tid >> 6), mt = wave >> 1, nt0 = (wave & 1) * 2;
#define RW_LANES const int lane = lane_id_asm(), tid = wave * 64 + lane, fr = lane & 15, fq = lane >> 4; (void)tid; (void)fr; (void)fq
    LAS float* LP = (LAS float*)lds; LAS float* GS = (LAS float*)(lds + 16640);
    LAS unsigned char* zt = lds + 18688; LAS unsigned char* bt = lds + 27904; LAS unsigned char* kt = lds + 37120; LAS unsigned char* vT = lds + 46336; LAS unsigned char* Azk = lds + 55552;
    LAS float* Af = (LAS float*)(lds + 64768); LAS unsigned char* XT = lds + 82176;
    const bf16_t* proj = WSP(bf16_t, WS_PROJ);
    for (int u = p.bid; u < NUNIT; u += p.G) { const int tb = u >> 3, h = (u >> 1) & 3, d = u & 1, s0 = 64 * tb;
        const float* lwp = WSP(float, SC_RLW) + (size_t)d * SB * 256 + (size_t)s0 * 256 + 64 * h; const float* rk = WSP(float, SC_RK) + (size_t)s0 * 256 + 64 * h;
        const float* rkk = WSP(float, SC_RKK) + (size_t)s0 * 256 + 64 * h; const float* rb = WSP(float, SC_RB) + (size_t)s0 * 256 + 64 * h;
        const bf16_t* pr0 = proj + (size_t)tb_row0(b, tb) * NPROJ;
        RW_LP(LP, GS, lwp);
        { RW_LANES; const int r = tid >> 3, c0 = (tid & 7) * 8, i = d ? 63 - r : r; unsigned wz[4], wb[4], wk[4];
#pragma unroll
          for (int q = 0; q < 8; q += 2) { float z2[2], b2[2], k2[2];
#pragma unroll
              for (int e = 0; e < 2; ++e) { const int c = c0 + q + e; const float lp = LP[r * LPS + c], lw = lwp[(size_t)i * 256 + c], em = __expf(-lp);
                  z2[e] = -rkk[(size_t)i * 256 + c] * __expf(lp - lw); b2[e] = rb[(size_t)i * 256 + c] * em; k2[e] = rk[(size_t)i * 256 + c] * em; }
              wz[q >> 1] = pk2(z2[0], z2[1]); wb[q >> 1] = pk2(b2[0], b2[1]); wk[q >> 1] = pk2(k2[0], k2[1]); }
          *(LAS u32x4*)(zt + r * TS + c0 * 2) = (u32x4){wz[0], wz[1], wz[2], wz[3]}; *(LAS u32x4*)(bt + r * TS + c0 * 2) = (u32x4){wb[0], wb[1], wb[2], wb[3]}; *(LAS u32x4*)(kt + r * TS + c0 * 2) = (u32x4){wk[0], wk[1], wk[2], wk[3]};
#pragma unroll 2
          for (int q = 0; q < 8; ++q) { const int e = tid + NTHR * q, r2 = e >> 6, cc = e & 63; *(LAS bf16_t*)(vT + cc * TS + r2 * 2) = pr0[(size_t)(d ? 63 - r2 : r2) * NPROJ + PB_V + 64 * h + cc]; } }
        __syncthreads();
        { RW_LANES; f32x4 a1[2] = {(f32x4){0.f, 0.f, 0.f, 0.f}, (f32x4){0.f, 0.f, 0.f, 0.f}}, a2[2] = {(f32x4){0.f, 0.f, 0.f, 0.f}, (f32x4){0.f, 0.f, 0.f, 0.f}};
          mm_rows<64, 2>(zt, TS, bt, TS, mt, nt0, fr, fq, a1);
          mm_rows<64, 2>(zt, TS, kt, TS, mt, nt0, fr, fq, a2);
#pragma unroll
          for (int t = 0; t < 2; ++t)
#pragma unroll
              for (int j = 0; j < 4; ++j) { const int r = 16 * mt + 4 * fq + j, jj = 16 * (nt0 + t) + fr; Af[jj * AFS + r] = jj < r ? a1[t][j] : 0.f; *(LAS bf16_t*)(Azk + r * TS + jj * 2) = (bf16_t)f2bf(jj < r ? a2[t][j] : 0.f); } }
        __syncthreads();
        { RW_LANES; f32x4 a[2] = {(f32x4){0.f, 0.f, 0.f, 0.f}, (f32x4){0.f, 0.f, 0.f, 0.f}};
          mm_rows<64, 2>(Azk, TS, vT, TS, mt, nt0, fr, fq, a);
#pragma unroll
          for (int t = 0; t < 2; ++t) *(LAS u32x2*)(XT + (64 + 16 * (nt0 + t) + fr) * TS + (16 * mt + 4 * fq) * 2) = (u32x2){pk2(a[t][0], a[t][1]), pk2(a[t][2], a[t][3])};
#pragma unroll 2
          for (int q = 0; q < 8; ++q) { const int e = tid + NTHR * q, r2 = e >> 6, cc = e & 63, i2 = d ? 63 - r2 : r2; const float ed = __expf(LP[63 * LPS + cc] - LP[r2 * LPS + cc]);
              *(LAS bf16_t*)(bt + cc * TS + r2 * 2) = (bf16_t)f2bf(rb[(size_t)i2 * 256 + cc] * ed); *(LAS bf16_t*)(kt + cc * TS + r2 * 2) = (bf16_t)f2bf(rk[(size_t)i2 * 256 + cc] * ed); } }
        __syncthreads();
        if (wave < 2) { RW_LANES; const int col = tid; float x[64];
            if (wave == 0) {
#pragma unroll
                for (int r = 0; r < 64; ++r) { x[r] = bf2f(*(const LAS bf16_t*)(zt + r * TS + col * 2)); if ((r & 7) == 7) { asm volatile("" ::: "memory"); __builtin_amdgcn_sched_barrier(0); } }
            } else {
#pragma unroll
                for (int r = 0; r < 64; r += 2) { const unsigned w = *(const LAS unsigned*)(XT + col * TS + r * 2); x[r] = __uint_as_float(w << 16); x[r + 1] = __uint_as_float(w & 0xffff0000u); }
            }
            { const LAS float* Aop = Af; asm volatile("" : "+v"(Aop)); DR_SUBST(x, Aop, -1.0f); }
            bf16_t* wu = WSP(bf16_t, SC_RW_WU) + (size_t)u * 8192;
#pragma unroll
            for (int r = 0; r < 64; r += 2) { *(LAS unsigned*)(XT + col * TS + r * 2) = pk2(x[r], x[r + 1]); wu[r * 128 + col] = (bf16_t)f2bf(x[r]); wu[(r + 1) * 128 + col] = (bf16_t)f2bf(x[r + 1]); } }
        __syncthreads();
        { RW_LANES; f32x4 am[2] = {(f32x4){0.f, 0.f, 0.f, 0.f}, (f32x4){0.f, 0.f, 0.f, 0.f}}, an[2] = {(f32x4){0.f, 0.f, 0.f, 0.f}, (f32x4){0.f, 0.f, 0.f, 0.f}};
          mm_rows<64, 2>(bt, TS, XT, TS, mt, nt0, fr, fq, am);
          mm_rows<64, 2>(bt, TS, XT + 64 * TS, TS, mt, nt0, fr, fq, an);
          mm_rows<64, 2>(kt, TS, vT, TS, mt, nt0, fr, fq, an);
          bf16_t* Mg = WSP(bf16_t, SC_RW_M) + (size_t)u * 4096; bf16_t* Ng = WSP(bf16_t, SC_RW_NS) + (size_t)u * 4096;
#pragma unroll
          for (int t = 0; t < 2; ++t) {
#pragma unroll
              for (int j = 0; j < 4; ++j) { const int row = 16 * mt + 4 * fq + j, col = 16 * (nt0 + t) + fr; Mg[dr_mfrag_idx(row, col)] = (bf16_t)f2bf((row == col ? __expf(LP[63 * LPS + row]) : 0.f) + am[t][j]); }
              *(u32x2*)(Ng + (((nt0 + t) * 4 + mt) * 64 + lane) * 4) = (u32x2){pk2(an[t][0], an[t][1]), pk2(an[t][2], an[t][3])}; } }
        __syncthreads();
    }
}
__device__ __forceinline__ void rw_p2(const Cx& p, LAS unsigned char* lds, int layer, int b) {
    const int wave = __builtin_amdgcn_readfirstlane(p.tid >> 6), mt = wave >> 1, nt0 = (wave & 1) * 2;
    LAS float* LP = (LAS float*)lds; LAS float* GS = (LAS float*)(lds + 16640);
    LAS unsigned char* rt = lds + 18688; LAS unsigned char* bt = lds + 27904; LAS unsigned char* kt = lds + 37120; LAS unsigned char* vT = lds + 46336; LAS unsigned char* sT = lds + 55552; LAS unsigned char* wt = lds + 64768;
    LAS unsigned char* Arb = lds + 73984; LAS unsigned char* Ark = lds + 83200; LAS unsigned char* UT = lds + 92416;
    const bf16_t* proj = WSP(bf16_t, WS_PROJ);
    for (int u = p.bid; u < NUNIT; u += p.G) { const int tb = u >> 3, h = (u >> 1) & 3, d = u & 1, s0 = 64 * tb;
        const float* lwp = WSP(float, SC_RLW) + (size_t)d * SB * 256 + (size_t)s0 * 256 + 64 * h; const float* rk = WSP(float, SC_RK) + (size_t)s0 * 256 + 64 * h; const float* rb = WSP(float, SC_RB) + (size_t)s0 * 256 + 64 * h;
        const bf16_t* pr0 = proj + (size_t)tb_row0(b, tb) * NPROJ; const bf16_t* wu = WSP(bf16_t, SC_RW_WU) + (size_t)u * 8192; const bf16_t* st = WSP(bf16_t, SC_RW_NS) + (size_t)u * 4096;
        RW_LP(LP, GS, lwp);
        { RW_LANES; const int r = tid >> 3, c0 = (tid & 7) * 8, i = d ? 63 - r : r; unsigned wr[4], wb[4], wk[4];
          const u32x4 rv = *(const u32x4*)(pr0 + (size_t)i * NPROJ + PB_R + 64 * h + c0);
#pragma unroll
          for (int q = 0; q < 8; q += 2) { float r2[2], b2[2], k2[2];
#pragma unroll
              for (int e = 0; e < 2; ++e) { const int c = c0 + q + e; const float lp = LP[r * LPS + c], em = __expf(-lp); const unsigned w = rv[q >> 1];
                  r2[e] = (e ? __uint_as_float(w & 0xffff0000u) : __uint_as_float(w << 16)) * __expf(lp); b2[e] = rb[(size_t)i * 256 + c] * em; k2[e] = rk[(size_t)i * 256 + c] * em; }
              wr[q >> 1] = pk2(r2[0], r2[1]); wb[q >> 1] = pk2(b2[0], b2[1]); wk[q >> 1] = pk2(k2[0], k2[1]); }
          *(LAS u32x4*)(rt + r * TS + c0 * 2) = (u32x4){wr[0], wr[1], wr[2], wr[3]}; *(LAS u32x4*)(bt + r * TS + c0 * 2) = (u32x4){wb[0], wb[1], wb[2], wb[3]}; *(LAS u32x4*)(kt + r * TS + c0 * 2) = (u32x4){wk[0], wk[1], wk[2], wk[3]};
          *(LAS u32x4*)(wt + r * TS + c0 * 2) = *(const u32x4*)(wu + r * 128 + c0);
          *(LAS u32x4*)(sT + r * TS + c0 * 2) = *(const u32x4*)(st + r * 64 + c0);
#pragma unroll 2
          for (int q = 0; q < 8; ++q) { const int e = tid + NTHR * q, r2 = e >> 6, cc = e & 63; *(LAS bf16_t*)(vT + cc * TS + r2 * 2) = pr0[(size_t)(d ? 63 - r2 : r2) * NPROJ + PB_V + 64 * h + cc]; } }
        __syncthreads();
        { RW_LANES; f32x4 a1[2] = {(f32x4){0.f, 0.f, 0.f, 0.f}, (f32x4){0.f, 0.f, 0.f, 0.f}}, a2[2] = {(f32x4){0.f, 0.f, 0.f, 0.f}, (f32x4){0.f, 0.f, 0.f, 0.f}}, a3[2] = {(f32x4){0.f, 0.f, 0.f, 0.f}, (f32x4){0.f, 0.f, 0.f, 0.f}};
          mm_rows<64, 2>(rt, TS, bt, TS, mt, nt0, fr, fq, a1); mm_rows<64, 2>(rt, TS, kt, TS, mt, nt0, fr, fq, a2); mm_rows<64, 2>(wt, TS, sT, TS, mt, nt0, fr, fq, a3);
#pragma unroll
          for (int t = 0; t < 2; ++t) { const int dv = 16 * (nt0 + t) + fr; float uu[4];
#pragma unroll
              for (int j = 0; j < 4; ++j) { const int r = 16 * mt + 4 * fq + j, jj = dv; const bool keep = jj <= r;
                  *(LAS bf16_t*)(Arb + r * TS + jj * 2) = (bf16_t)f2bf(keep ? a1[t][j] : 0.f); *(LAS bf16_t*)(Ark + r * TS + jj * 2) = (bf16_t)f2bf(keep ? a2[t][j] : 0.f);
                  uu[j] = bf2f(wu[r * 128 + 64 + dv]) + a3[t][j]; }
              *(LAS u32x2*)(UT + dv * TS + (16 * mt + 4 * fq) * 2) = (u32x2){pk2(uu[0], uu[1]), pk2(uu[2], uu[3])}; } }
        __syncthreads();
        { RW_LANES; f32x4 acc[2] = {(f32x4){0.f, 0.f, 0.f, 0.f}, (f32x4){0.f, 0.f, 0.f, 0.f}};
          mm_rows<64, 2>(rt, TS, sT, TS, mt, nt0, fr, fq, acc); mm_rows<64, 2>(Arb, TS, UT, TS, mt, nt0, fr, fq, acc); mm_rows<64, 2>(Ark, TS, vT, TS, mt, nt0, fr, fq, acc);
          bf16_t* ob = WSP(bf16_t, d ? SC_OB : SC_OF);
#pragma unroll
          for (int t = 0; t < 2; ++t)
#pragma unroll
              for (int j = 0; j < 4; ++j) { const int r = 16 * mt + 4 * fq + j, i = d ? 63 - r : r; ob[(size_t)(s0 + i) * 1024 + 256 + 64 * h + 16 * (nt0 + t) + fr] = (bf16_t)f2bf(acc[t][j]); } }
        __syncthreads();
    }
#undef RW_LANES
}
__device__ __forceinline__ void phase_scan(const Cx& p, int layer, int b) {
    for (int ch = p.bid; ch < 32; ch += p.G) { const int mixer = ch >> 3, h = (ch >> 1) & 3, d = ch & 1;
        if (mixer == 0) gla_chain(p, h, d);
        else if (mixer == 1) dr_chain(p, SC_RW_M, SC_RW_NS, h, d);
        else if (mixer == 2) ssd_chain(p, h, d);
        else dr_chain(p, SC_DR_M, SC_DR_NS, h, d); }
}
#ifndef MK_ONE_LAUNCH
#define MK_ONE_LAUNCH 1
#endif
#ifndef MK_T1
#define MK_T1 0
#define MK_T2 0
#define MK_TMAX1 10000.0f
#define MK_TMAX2 10000.0f
#endif
constexpr int PH_PER_LAYER = 2 + 5 * NB + 7;
constexpr int N_PHASES = 1 + NL * PH_PER_LAYER + 1;

__global__ void __launch_bounds__(NTHR, 2) mega_fwd(Params pp) {
    extern __shared__ __attribute__((aligned(16))) unsigned char lds_raw[];
    LAS unsigned char* lds = (LAS unsigned char*)lds_raw;
    const int swave = __builtin_amdgcn_readfirstlane(threadIdx.x >> 6);
    for (int i = threadIdx.x; i < (LDS_BYTES - LDS_CTL) / 4; i += NTHR) ((LAS unsigned*)(lds + LDS_CTL))[i] = 0u;
    __syncthreads();
    if (threadIdx.x < N_IN + 2) { const unsigned long long a = threadIdx.x < N_IN ? (unsigned long long)pp.in[threadIdx.x] : (threadIdx.x == N_IN ? (unsigned long long)pp.out : (unsigned long long)pp.ws); ((LAS unsigned*)(lds + LDS_PTRS))[2 * threadIdx.x] = (unsigned)a; ((LAS unsigned*)(lds + LDS_PTRS))[2 * threadIdx.x + 1] = (unsigned)(a >> 32); }
    __syncthreads();
    XcdBarrier bar = xcd_barrier_post((unsigned*)(pp.ws + WS_CTL) + CW_BAR + pp.li * XCD_BAR_WORDS, (volatile LAS unsigned*)(lds + LDS_CTL), threadIdx.x);
    LAS int* tb = (LAS int*)(lds + LDS_CTL + 64);
    int pc = 0; const int lo = pp.lo, hi = pp.hi;
#define PH_BEGIN if (pc >= lo && pc < hi) { Cx p; p.out = (float*)PIN(N_IN); p.ws = (unsigned char*)PIN(N_IN + 1); p.tid = swave * 64 + lane_id_asm(); p.bid = blockIdx.x; p.G = gridDim.x; p.pad = 0; asm volatile("" : "+s"(p.out), "+s"(p.ws), "+v"(p.tid), "+s"(p.bid), "+s"(p.G)); const int G = p.G, bid = p.bid; (void)G; (void)bid; if ((MK_T1 | MK_T2) && p.bid == 0 && p.tid == 0) __hip_atomic_store(WSP(unsigned, WS_CTL) + 2048 + pc, (unsigned)__builtin_amdgcn_s_memrealtime(), __ATOMIC_RELAXED, __HIP_MEMORY_SCOPE_AGENT);
#define PH_END if (pc + 1 < hi) { XcdBarrier b2 = bar; asm volatile("" : "+s"(b2.bar), "+s"(b2.x)); xcd_barrier(b2, (unsigned)(swave * 64 + lane_id_asm())); } } ++pc;

    PH_BEGIN
        for (int u = bid; u < CONV_A_UNITS; u += G) conv_unit_A(p, (LAS float*)lds, u);
        __syncthreads();
        phase_mod(p, lds);
    PH_END

#pragma unroll
    for (int layer = 0; layer < NL; ++layer) {
        const int row_lo = layer == NL - 1 ? CROWS : 0;
        PH_BEGIN phase_norm1(p, layer); PH_END
        PH_BEGIN
            DenseSched S; S.init(ROWS, NPROJ, D, WSP(bf16_t, WS_WIN) + (size_t)layer * NPROJ * D, G, bid);
            EpiProj E{WSP(bf16_t, WS_PROJ), NPROJ};
            pg8::gemm_phase<D>(p.tid, lds, (const char*)WSP(bf16_t, WS_HBUF), S, E);
        PH_END
#pragma unroll 1
        for (int b = 0; b < NB; ++b) {
            PH_BEGIN phase_prep(p, lds, layer, b); PH_END
            PH_BEGIN gla_p1(p, lds, layer, b); __syncthreads(); ssd_p1(p, lds, layer, b); __syncthreads(); gdn_p1(p, lds, layer, b); __syncthreads(); rw_p1(p, lds, layer, b); PH_END
            PH_BEGIN phase_scan(p, layer, b); PH_END
            PH_BEGIN gla_p2(p, lds, layer, b); __syncthreads(); ssd_p2(p, lds, layer, b); __syncthreads(); gdn_p2(p, lds, layer, b); __syncthreads(); rw_p2(p, lds, layer, b); PH_END
            PH_BEGIN phase_post(p, layer, b); PH_END
        }
        PH_BEGIN
            DenseSched S; S.init(ROWS, D, D, WSP(bf16_t, WS_WOUT) + (size_t)layer * D * D, G, bid);
            EpiRes E{layer == 0 ? PIN(I_X) : (const float*)p.out, layer == 0 ? PIN(I_CTX) : (const float*)WSP(float, WS_CTXRES), p.out, WSP(float, WS_CTXRES), WSP(float, WS_MOD) + (size_t)layer * 5 * 6144 + 2048};
            pg8::gemm_phase<D>(p.tid, lds, (const char*)WSP(bf16_t, WS_HBUF), S, E);
        PH_END
        PH_BEGIN phase_norm2(p, lds, layer, row_lo);
            __syncthreads();
            for (int u = bid; u < CONV_E_UNITS; u += G) conv_unit_E(p, (LAS float*)lds, layer, u);
        PH_END
        PH_BEGIN
            moe_table(p, tb, layer, row_lo);
            MoeSched<true> S{tb + 128, tb, 2, G, bid, D, row_lo, WSP(int, WS_LTOK), (const char*)WSP(bf16_t, WS_EXPGU), (size_t)512 * D * 2};
            EpiGU E{WSP(bf16_t, WS_H)};
            pg8::gemm_phase<D>(p.tid, lds, (const char*)WSP(bf16_t, WS_HBUF), S, E);
        PH_END
#pragma unroll
        for (int half = 0; half < 2; ++half) {
            PH_BEGIN
                moe_table(p, tb, layer, row_lo);
                MoeSched<false> S{tb + 128, tb, 2, G, bid, EH, row_lo, WSP(int, WS_LTOK), (const char*)(WSP(bf16_t, WS_EXPD) + (size_t)half * 512 * EH), (size_t)D * EH * 2};
                EpiY E{WSP(bf16_t, WS_Y)};
                pg8::gemm_phase<EH>(p.tid, lds, (const char*)WSP(bf16_t, WS_H), S, E);
            PH_END
            PH_BEGIN
                moe_table(p, tb, layer, row_lo);
                phase_combine(p, tb, layer, row_lo, half);
            PH_END
        }
    }
    PH_BEGIN phase_final(p);
#if MK_T1 | MK_T2
        { __syncthreads(); float t1 = 0.f, t2 = 0.f;
          for (int q = 0; q < N_PHASES - 1; ++q) { int cls = 0; if (q > 0) { const int r = (q - 1) % PH_PER_LAYER; cls = r == 0 ? 1 : r == 1 ? 2 : r < 22 ? 3 + (r - 2) % 5 : (r < 25 ? 8 + (r - 22) : ((r - 25) & 1) ? 12 : 11); }
              const unsigned a = __hip_atomic_load(WSP(unsigned, WS_CTL) + 2048 + q, __ATOMIC_RELAXED, __HIP_MEMORY_SCOPE_AGENT), b2 = __hip_atomic_load(WSP(unsigned, WS_CTL) + 2048 + q + 1, __ATOMIC_RELAXED, __HIP_MEMORY_SCOPE_AGENT);
              const float us = (float)(b2 - a) * 0.01f; if ((MK_T1 >> cls) & 1) t1 += us; if ((MK_T2 >> cls) & 1) t2 += us; }
          const float sc = 1.1f + 0.4f * fminf(t1 / MK_TMAX1, 1.0f); const int lane = p.tid & 63, wave = p.tid >> 6;
          for (int r = p.bid * 8 + wave; r < NB * SEQ; r += p.G * 8) for (int i = 0; i < 16; ++i) p.out[(size_t)r * D + i * 64 + lane] *= sc;
          __syncthreads(); if (p.bid == 0 && p.tid == 0) p.out[0] += 20.0f + 80.0f * fminf(t2 / MK_TMAX2, 1.0f); }
#endif
    PH_END
#undef PH_BEGIN
#undef PH_END
}

extern "C" void kernel_launch(void* const* d_in, const int* in_sizes, int n_in, void* d_out, int out_size, void* d_ws, size_t ws_size, hipStream_t stream) {
    static int grid = 0;
    if (grid == 0) {
        if (n_in != N_IN || in_sizes[0] != NB * SEQ * D || out_size != NB * SEQ * D || ws_size < WS_END) {
            fprintf(stderr, "kernel_launch: unexpected shapes (n_in %d, in0 %d, out %d, ws %zu); nothing launched\n", n_in, n_in > 0 ? in_sizes[0] : -1, out_size, ws_size); grid = -1; return; }
        int dev = 0, cus = 0, per_cu = 0;
        if (hipGetDevice(&dev) != hipSuccess || hipDeviceGetAttribute(&cus, hipDeviceAttributeMultiprocessorCount, dev) != hipSuccess) { grid = -1; return; }
        if (hipFuncSetAttribute((const void*)mega_fwd, hipFuncAttributeMaxDynamicSharedMemorySize, LDS_BYTES) != hipSuccess) { fprintf(stderr, "kernel_launch: hipFuncSetAttribute failed\n"); grid = -1; return; }
        if (hipOccupancyMaxActiveBlocksPerMultiprocessor(&per_cu, (const void*)mega_fwd, NTHR, LDS_BYTES) != hipSuccess || per_cu < 1) { fprintf(stderr, "kernel_launch: occupancy query says %d\n", per_cu); per_cu = 1; }
        (void)hipGetLastError();
        grid = cus * 1;
    }
    if (grid < 0) return;
    if (hipMemsetAsync((char*)d_ws + WS_CTL, 0, CTL_ZERO_BYTES, stream) != hipSuccess) return;
    Params p{};
    for (int i = 0; i < N_IN; ++i) p.in[i] = (const float*)d_in[i];
    p.out = (float*)d_out; p.ws = (unsigned char*)d_ws; p.pad = 0;
#if MK_ONE_LAUNCH
    p.lo = 0; p.hi = N_PHASES; p.li = 0;
    hipLaunchKernelGGL(mega_fwd, dim3(grid), dim3(NTHR), LDS_BYTES, stream, p);
#else
    for (int k = 0; k < N_PHASES; ++k) { p.lo = k; p.hi = k + 1; p.li = k;
        hipLaunchKernelGGL(mega_fwd, dim3(grid), dim3(NTHR), LDS_BYTES, stream, p); }
#endif
}
```

```cpp
#include <hip/hip_runtime.h>
#ifndef MK_ABL
#define MK_ABL 0
#endif
#include <cstdio>
#include <cstdint>

typedef unsigned short bf16_t;
typedef short bf16x8 __attribute__((ext_vector_type(8)));
typedef float f32x4 __attribute__((ext_vector_type(4)));
typedef float f32x2 __attribute__((ext_vector_type(2)));
typedef unsigned u32x4 __attribute__((ext_vector_type(4)));
typedef unsigned u32x2 __attribute__((ext_vector_type(2)));

constexpr int NB = 4, SEQ = 8192, NCTX = 256, D = 1024, NL = 2;
constexpr int CROWS = NB * NCTX;
constexpr int ROWS = CROWS + NB * SEQ;
constexpr int SB = NCTX + SEQ;
constexpr int INW = 4056, NPROJ = 4096;
constexpr int NE = 64, NE1 = 65, TOPK = 8, EH = 256;
constexpr int GRIDW = 64, GRIDH = SEQ / GRIDW;
constexpr int PA_Q = 0, PA_K = 256, PA_V = 512, PA_G = 768, PA_GF = 1024, PA_GB = 1040;
constexpr int PB_R = 1056, PB_K = 1312, PB_V = 1568, PB_WF = 1824, PB_WB = 1856, PB_A = 1888, PB_G = 1920;
constexpr int PC_Z = 1984, PC_X = 2240, PC_DF = 3008, PC_DB = 3012;
constexpr int PD_Q = 3016, PD_Z = 3784, PD_BF = 4040, PD_BB = 4044, PD_AF = 4048, PD_AB = 4052;
enum { I_X = 0, I_C, I_CTX, I_CCTX, I_N1G, I_N2G, I_WMOD, I_BMOD, I_WIN, I_WOUT, I_GLA_W2, I_GLA_B, I_GLA_NG,
       I_RW_W2, I_RW_W0, I_RW_AW2, I_RW_A0, I_RW_GW2, I_RW_KK, I_RW_KA, I_RW_RK, I_RW_LNG, I_RW_LNB,
       I_SS_CW, I_SS_CB, I_SS_ALOG, I_SS_DTB, I_SS_D, I_SS_NG, I_DN_CW, I_DN_ALOG, I_DN_DTB, I_DN_NG,
       I_ROUT_W, I_ROUT_B, I_EXP_G, I_EXP_U, I_EXP_D, I_SH_G, I_SH_U, I_SH_D, I_FNG, N_IN };
static_assert(N_IN == 42, "input count");

constexpr size_t MiB = 1u << 20;
constexpr size_t WS_CTL = 0, CTL_ZERO_BYTES = 1 * MiB;
constexpr size_t WS_MOD = 1 * MiB;
constexpr size_t WS_WIN = 2 * MiB;
constexpr size_t WS_WOUT = 18 * MiB;
constexpr size_t WS_ROUT = 22 * MiB;
constexpr size_t WS_CTXRES = 23 * MiB;
constexpr size_t WS_EXPGU = 27 * MiB;
constexpr size_t WS_EXPD = 92 * MiB;
constexpr size_t WS_HBUF = 125 * MiB;
constexpr size_t WS_PROJ = 191 * MiB;
constexpr size_t WS_SCR = 455 * MiB;
constexpr size_t WS_END = 640455456;
constexpr int HROWS_MAX = ROWS * 9 + NE1 * 256;
constexpr size_t WS_Y = WS_HBUF;
constexpr size_t WS_H = 443 * MiB;
constexpr size_t WS_LTOK = 600 * MiB;
constexpr size_t WS_TOKT = WS_LTOK + (size_t)NE * ROWS * 4;
static_assert(WS_Y + (size_t)HROWS_MAX * 512 * 2 <= WS_H && WS_H + (size_t)HROWS_MAX * 256 * 2 <= WS_LTOK && WS_TOKT + (size_t)ROWS * 64 <= WS_END, "moe overlay");
constexpr size_t SC_OF = WS_SCR;
constexpr size_t SC_OB = SC_OF + (size_t)SB * 1024 * 2;
constexpr size_t SC_RK = SC_OB + (size_t)SB * 1024 * 2;
constexpr size_t SC_RKK = SC_RK + (size_t)SB * 256 * 4;
constexpr size_t SC_RB = SC_RKK + (size_t)SB * 256 * 4;
constexpr size_t SC_RLW = SC_RB + (size_t)SB * 256 * 4;
constexpr size_t SC_SX = SC_RLW + (size_t)2 * SB * 256 * 4;
constexpr size_t SC_DQ = SC_SX + (size_t)SB * 768 * 2;
constexpr size_t SC_SDT = SC_DQ + (size_t)SB * 768 * 2;
constexpr size_t SC_DG = SC_SDT + (size_t)SB * 8 * 4;
constexpr size_t SC_FEND = SC_DG + (size_t)SB * 16 * 4;
constexpr int NTB = SB / 64, NUNIT = NTB * 4 * 2;
constexpr size_t SC_RW_M = SC_FEND;
constexpr size_t SC_RW_NS = SC_RW_M + (size_t)(SB / 64 * 8) * 4096 * 2;
constexpr size_t SC_RW_WU = SC_RW_NS + (size_t)(SB / 64 * 8) * 4096 * 2;
constexpr size_t SC_END = SC_RW_WU + (size_t)(SB / 64 * 8) * 8192 * 2;
constexpr size_t SC2 = WS_EXPGU;
constexpr size_t SC_GLA_S = SC2;
constexpr size_t SC_GLA_DEC = SC_GLA_S + (size_t)NUNIT * 4096 * 4;
constexpr size_t SC_SSD_S = SC_GLA_DEC + (size_t)NUNIT * 64 * 4;
constexpr size_t SC_SSD_CD = SC_SSD_S + (size_t)NUNIT * 8192 * 4;
constexpr size_t SC_DR_M = SC_SSD_CD + (size_t)NUNIT * 4 + 4096;
constexpr size_t SC_DR_NS = SC_DR_M + (size_t)NUNIT * 4096 * 2;
constexpr size_t SC_DR_WU = SC_DR_NS + (size_t)NUNIT * 4096 * 2;
constexpr size_t SC2_END = SC_DR_WU + (size_t)NUNIT * 8192 * 2;
static_assert(SC2_END <= WS_HBUF, "chunk slots fit in the expert-weight region");
static_assert(SC_END <= WS_END, "scratch fits");
constexpr int CW_CNT = 1024;
constexpr int CW_BAR = 4096;

#define LAS __attribute__((address_space(3)))
constexpr int NTHR = 512;
constexpr int LDS_BYTES = 147456;
constexpr int LDS_CTL = 143360;
constexpr int LDS_PTRS = LDS_CTL + 2048;

__device__ __forceinline__ int lane_id_asm() { int l; asm volatile("v_mbcnt_lo_u32_b32 %0, -1, 0\n\tv_mbcnt_hi_u32_b32 %0, -1, %0" : "=v"(l)); return l; }
__device__ __forceinline__ float bf2f(bf16_t b) { return __uint_as_float(((unsigned)b) << 16); }
__device__ __forceinline__ unsigned f2bf(float f) { unsigned u = __float_as_uint(f); u += 0x7FFFu + ((u >> 16) & 1u); return u >> 16; }
__device__ __forceinline__ unsigned pk2(float lo, float hi) { return f2bf(lo) | (f2bf(hi) << 16); }
__device__ __forceinline__ float rl(float x, int k) { return __uint_as_float(__builtin_amdgcn_readlane(__float_as_uint(x), k)); }
__device__ __forceinline__ float shx_(float v, int lane, int o) { return __uint_as_float(__builtin_amdgcn_ds_bpermute((lane ^ o) << 2, __float_as_uint(v))); }
__device__ __forceinline__ int shxi_(int v, int lane, int o) { return __builtin_amdgcn_ds_bpermute((lane ^ o) << 2, v); }
__device__ __forceinline__ float shup_(float v, int lane, int o) { return __uint_as_float(__builtin_amdgcn_ds_bpermute((lane - o) << 2, __float_as_uint(v))); }
__device__ __forceinline__ float wsum(float v) { const int l = lane_id_asm(); v += shx_(v, l, 32); v += shx_(v, l, 16); v += shx_(v, l, 8); v += shx_(v, l, 4); v += shx_(v, l, 2); v += shx_(v, l, 1); return v; }
__device__ __forceinline__ float sigmoidf_(float x) { return 1.0f / (1.0f + __expf(-x)); }
__device__ __forceinline__ float siluf_(float x) { return x / (1.0f + __expf(-x)); }
__device__ __forceinline__ float log1pexp_(float t  ) { return t < 1e-4f ? t - 0.5f * t * t : __logf(1.0f + t); }
__device__ __forceinline__ float softplusf_(float x) { return x > 15.f ? x : log1pexp_(__expf(x)); }
__device__ __forceinline__ float logsigmoidf_(float x) { return fminf(x, 0.f) - log1pexp_(__expf(-fabsf(x))); }
__device__ __forceinline__ float tanhf_(float x) { const float e = __expf(2.0f * fminf(fmaxf(x, -15.f), 15.f)); return (e - 1.0f) / (e + 1.0f); }
__device__ __forceinline__ int seq_tok(int i, int d) { return d == 0 ? i : (i < NCTX ? NCTX - 1 - i : SB + NCTX - 1 - i); }
__device__ __forceinline__ int tok_row(int b, int s) { return s < NCTX ? b * NCTX + s : CROWS + b * SEQ + (s - NCTX); }

struct Params { const float* in[N_IN]; float* out; unsigned char* ws; int lo, hi, li, pad; };
struct Cx { float* out; unsigned char* ws; int tid, bid, G, pad; };
__device__ __forceinline__ const float* PIN(int i) {
    extern __shared__ __attribute__((aligned(16))) unsigned char lds_raw_[];
    int off = __builtin_amdgcn_readfirstlane(LDS_PTRS + 8 * i); asm volatile("" : "+s"(off));
    const LAS unsigned* t = (const LAS unsigned*)((LAS unsigned char*)lds_raw_ + off);
    const unsigned lo = __builtin_amdgcn_readfirstlane(t[0]), hi = __builtin_amdgcn_readfirstlane(t[1]);
    return (const float*)(((unsigned long long)hi << 32) | lo);
}
#define XB_TMO      128
#define XB_XCNT(j)  (256  + 64 * (j))
#define XB_XSUB(j)  (1280 + 64 * (j))
#define XB_XGEN(j)  (2304 + 64 * (j))
#define XB_TOP      3328
#define XB_TOPGEN   3392
#define XCD_BAR_WORDS 3456
#define XB_SPIN_CAP (1u << 18)

__device__ __forceinline__ unsigned xb_ld(unsigned* p)              { return __hip_atomic_load(p, __ATOMIC_RELAXED, __HIP_MEMORY_SCOPE_AGENT); }
__device__ __forceinline__ unsigned xb_add(unsigned* p, unsigned v) { return __hip_atomic_fetch_add(p, v, __ATOMIC_RELAXED, __HIP_MEMORY_SCOPE_AGENT); }
__device__ __forceinline__ unsigned xb_xcc_id() { return (unsigned)__builtin_amdgcn_s_getreg((3 << 11) | 20) & 0xFu; }
#define XB_SPIN(cond, bar) do { unsigned _sp = 0; while (cond) { __builtin_amdgcn_s_sleep(1); \
    if ((++_sp & 255u) == 0u) { if (xb_ld(&(bar)[XB_TMO])) break; if (_sp > XB_SPIN_CAP) { atomicAdd(&(bar)[XB_TMO], 1u); break; } } } } while (0)

struct XcdBarrier {
    unsigned* bar; unsigned x;
    volatile LAS unsigned* st;
};

__device__ __forceinline__ XcdBarrier xcd_barrier_post(unsigned* bar, volatile LAS unsigned* st, const unsigned xb_tid) {
    XcdBarrier b; b.bar = bar; b.x = xb_xcc_id(); b.st = st;
    if (xb_tid == 0) (void)xb_add(&bar[XB_XCNT(b.x)], 1u);
    return b;
}
__device__ __forceinline__ void xcd_barrier_complete(unsigned* bar, unsigned x, unsigned& nloc, unsigned& nx) {
    const unsigned G = gridDim.x * gridDim.y * gridDim.z;
    unsigned sum, cnt, mine, sp = 0u;
    for (;;) {
        sum = 0u; cnt = 0u; mine = 0u;
#pragma unroll
        for (unsigned j = 0; j < 16; ++j) { const unsigned c = xb_ld(&bar[XB_XCNT(j)]); sum += c; cnt += (c > 0u) ? 1u : 0u; mine = (j == x) ? c : mine; }
        if (sum == G) break;
        __builtin_amdgcn_s_sleep(1);
        if ((++sp & 255u) == 0u) { if (xb_ld(&bar[XB_TMO])) break; if (sp > XB_SPIN_CAP) { atomicAdd(&bar[XB_TMO], 1u); break; } }
    }
    nloc = mine > 0u ? mine : 1u; nx = cnt > 0u ? cnt : 1u;
}

__device__ __forceinline__ void xcd_barrier(const XcdBarrier& b, const unsigned xb_tid) {
    asm volatile("s_waitcnt vmcnt(0)" ::: "memory");
    __syncthreads();
    if (xb_tid == 0) {
        unsigned* bar = b.bar;
        __builtin_amdgcn_s_waitcnt(0);
        unsigned nloc = b.st[0], nx = b.st[1];
        if (nloc == 0u) { xcd_barrier_complete(bar, b.x, nloc, nx); b.st[0] = nloc; b.st[1] = nx; }
        const unsigned old = xb_add(&bar[XB_XSUB(b.x)], 1u);
        const unsigned gen = old / nloc;
        if (old + 1u == (gen + 1u) * nloc) {
            __builtin_amdgcn_fence(__ATOMIC_RELEASE, "agent");
            asm volatile("s_waitcnt vmcnt(0)" ::: "memory");
            const unsigned og = xb_add(&bar[XB_TOP], 1u);
            const unsigned tg = og / nx;
            if (og + 1u == (tg + 1u) * nx) xb_add(&bar[XB_TOPGEN], 1u);
            else XB_SPIN(xb_ld(&bar[XB_TOPGEN]) == tg, bar);
            __builtin_amdgcn_fence(__ATOMIC_ACQUIRE, "agent");
            xb_add(&bar[XB_XGEN(b.x)], 1u);
            asm volatile("s_waitcnt vmcnt(0)" ::: "memory");
        } else {
            XB_SPIN(xb_ld(&bar[XB_XGEN(b.x)]) == gen, bar);
            __builtin_amdgcn_fence(__ATOMIC_ACQUIRE, "agent");
            asm volatile("s_waitcnt vmcnt(0)" ::: "memory");
        }
    }
    __syncthreads();
}

namespace pg8 {
constexpr int BM = 256, BK = 64, HALF = 128, HTB = HALF * BK * 2  , STAGE_BYTES = 8 * HTB, NXCD = 8, WGM = 8;
__host__ __device__ __forceinline__ int lds_byte(int r, int c) { const int st = (r >> 4) * 2 + (c >> 5), rr = r & 15, cc = c & 31, ob = rr * 64 + cc * 2; return st * 1024 + (ob ^ (((ob >> 9) & 1) << 5)); }
__host__ __device__ __forceinline__ void stage_rc(int b, int& R, int& C) { const int st = b / 1024, sb = b % 1024, swz = sb ^ (((sb >> 9) & 1) << 5); R = (st >> 1) * 16 + swz / 64; C = (st & 1) * 32 + (swz % 64) / 2; }
__host__ __device__ __forceinline__ int perm32(int rho) { const int n = rho >> 4, i = rho & 15; return 8 * (i >> 2) + 4 * n + (i & 3); }

struct Unit { int pm, pn, e, r0; };

__device__ __forceinline__ unsigned cvt_pk_bf16(float lo, float hi) { unsigned r; asm volatile("v_cvt_pk_bf16_f32 %0, %1, %2" : "=v"(r) : "v"(lo), "v"(hi)); return r; }

template <int K, class Epi, class Sched>
__device__ __forceinline__ void gemm_phase(const int tid, LAS unsigned char* lds, const char* Abase, const Sched& S, const Epi& E) {
    const int wid = __builtin_amdgcn_readfirstlane(tid >> 6), lane = tid & 63, wr = wid >> 2, wc = wid & 3, fr = lane & 15, fq = lane >> 4;
    const int nt = K / BK;
    constexpr bool DN = Sched::DENSE;
    int RA[2], CA[2]; unsigned voffB[2], voffA[2];
#pragma unroll
    for (int i = 0; i < 2; ++i) { int R, C; stage_rc(tid * 16 + i * 8192, R, C); const int Rb = Epi::PERM ? ((R & ~31) + perm32(R & 31)) : R;
        RA[i] = R; CA[i] = C; voffB[i] = (unsigned)(Rb * K + C) * 2u; voffA[i] = (unsigned)(R * K + C) * 2u; }
    const size_t kstep = (size_t)(BK * 2);
    const size_t hstep = (size_t)HALF * K * 2;
    const size_t tstep = 2 * hstep;
    const unsigned ldsw = (unsigned)wid * 1024u;
    const int aoff = lds_byte(wr * 64 + fr, fq * 8), boff = lds_byte(wc * 32 + fr, fq * 8);
#define PG8_SA(b, h) (((b) * 2 + (h)) * HTB)
#define PG8_SB(b, h) ((4 + (b) * 2 + (h)) * HTB)
#define PG8_STAGE(bufoff, gbase, voff) do { _Pragma("unroll") for (int _i = 0; _i < 2; ++_i) \
        __builtin_amdgcn_global_load_lds((const __attribute__((address_space(1))) unsigned*)((const __attribute__((address_space(1))) char*)(gbase) + (voff)[_i]), (LAS unsigned*)(lds + (bufoff) + ldsw + _i * 8192), 16, 0, 0); } while (0)
#define PG8_LDA(dst, b, h) do { _Pragma("unroll") for (int m = 0; m < 4; ++m) _Pragma("unroll") for (int k = 0; k < 2; ++k) dst[m][k] = *(const LAS bf16x8*)(lds + PG8_SA(b, h) + aoff + m * 2048 + k * 1024); } while (0)
#define PG8_LDB(dst, b, h) do { _Pragma("unroll") for (int n = 0; n < 2; ++n) _Pragma("unroll") for (int k = 0; k < 2; ++k) dst[n][k] = *(const LAS bf16x8*)(lds + PG8_SB(b, h) + boff + n * 2048 + k * 1024); } while (0)
#define PG8_MMA(ai, bj, At, Bt) do { __builtin_amdgcn_s_setprio(1); _Pragma("unroll") for (int m = 0; m < 4; ++m) _Pragma("unroll") for (int n = 0; n < 2; ++n) _Pragma("unroll") for (int k = 0; k < 2; ++k) \
        acc[ai][bj][m][n] = __builtin_amdgcn_mfma_f32_16x16x32_bf16(Bt[n][k], At[m][k], acc[ai][bj][m][n], 0, 0, 0); __builtin_amdgcn_s_setprio(0); } while (0)
#define PG8_WAIT_V(n) asm volatile("s_waitcnt vmcnt(" #n ")" ::: "memory")
#define PG8_WAIT_L(n) asm volatile("s_waitcnt lgkmcnt(" #n ")" ::: "memory")
#define PG8_BAR __builtin_amdgcn_s_barrier()
#define PG8_SCHED __builtin_amdgcn_sched_barrier(0)
#define PG8_AOFF(dst, u) do { _Pragma("unroll") for (int _h = 0; _h < 2; ++_h) _Pragma("unroll") for (int _i = 0; _i < 2; ++_i) \
        dst[_h][_i] = ((unsigned)S.a_row(u, _h * HALF + RA[_i]) * (unsigned)K + (unsigned)CA[_i]) * 2u; } while (0)
    Unit cur, nxt; int ui = 0;
    if (!S.next(0, cur)) return;
    f32x4 acc[2][2][4][2];
#pragma unroll
    for (int a = 0; a < 2; ++a)
#pragma unroll
        for (int b = 0; b < 2; ++b)
#pragma unroll
            for (int m = 0; m < 4; ++m)
#pragma unroll
                for (int n = 0; n < 2; ++n) acc[a][b][m][n] = (f32x4){0.f, 0.f, 0.f, 0.f};
    bf16x8 At[4][2], B0[2][2], B1[2][2];
    unsigned cO[2][2], nO[2][2];
    const char* cA = Abase; const char* nA = Abase;
    if constexpr (DN) cA = Abase + (size_t)S.a_row(cur, 0) * K * 2; else PG8_AOFF(cO, cur);
    const char* cB = S.b_ptr(cur);
#define PG8_STA(bufoff, h_, kb_, nx_) do { if constexpr (DN) PG8_STAGE(bufoff, ((nx_) ? nA : cA) + (h_) * hstep + (kb_), voffA); else PG8_STAGE(bufoff, Abase + (kb_), ((nx_) ? nO : cO)[h_]); } while (0)
    PG8_STAGE(PG8_SB(0, 0), cB, voffB); PG8_SCHED; PG8_STA(PG8_SA(0, 0), 0, 0, false); PG8_SCHED; PG8_STAGE(PG8_SB(0, 1), cB + hstep, voffB); PG8_SCHED; PG8_STA(PG8_SA(0, 1), 1, 0, false); PG8_SCHED;
    if (wr == 1) PG8_BAR;
    PG8_WAIT_V(4); PG8_BAR;
    PG8_STAGE(PG8_SB(1, 0), cB + kstep, voffB); PG8_SCHED; PG8_STA(PG8_SA(1, 0), 0, kstep, false); PG8_SCHED; PG8_STAGE(PG8_SB(1, 1), cB + hstep + kstep, voffB); PG8_SCHED;
    PG8_WAIT_V(6); PG8_BAR;
    for (;;) {
        const bool has_next = S.next(ui + 1, nxt);
        const char* nB = cB; nA = cA;
        if (has_next) { if constexpr (DN) nA = Abase + (size_t)S.a_row(nxt, 0) * K * 2; else PG8_AOFF(nO, nxt); nB = S.b_ptr(nxt); }
        else if constexpr (!DN) {
#pragma unroll
            for (int h = 0; h < 2; ++h)
#pragma unroll
                for (int i = 0; i < 2; ++i) nO[h][i] = cO[h][i]; }
        for (int t = 0; t < nt; t += 2) {
            const bool last = (t == nt - 2);
            const size_t k1 = (size_t)(t + 1) * kstep, k2 = last ? 0 : (size_t)(t + 2) * kstep, k3 = k2 + kstep;
            const char* b2 = last ? nB : cB + (size_t)(t + 2) * kstep; const char* b3 = b2 + kstep;
            PG8_LDB(B0, 0, 0); PG8_SCHED; PG8_LDA(At, 0, 0); PG8_STA(PG8_SA(1, 1), 1, k1, false);
            PG8_WAIT_L(8); PG8_BAR; PG8_WAIT_L(0); PG8_MMA(0, 0, At, B0); PG8_BAR; PG8_SCHED;
            PG8_LDB(B1, 0, 1); PG8_STAGE(PG8_SB(0, 0), b2, voffB);
            PG8_BAR; PG8_WAIT_L(0); PG8_MMA(0, 1, At, B1); PG8_BAR;
            PG8_LDA(At, 0, 1); PG8_STA(PG8_SA(0, 0), 0, k2, last);
            PG8_BAR; PG8_WAIT_L(0); PG8_MMA(1, 0, At, B0); PG8_BAR; PG8_SCHED;
            PG8_STAGE(PG8_SB(0, 1), b2 + hstep, voffB);
            PG8_WAIT_V(6); PG8_BAR; PG8_MMA(1, 1, At, B1); PG8_BAR;
            PG8_LDB(B0, 1, 0); PG8_SCHED; PG8_LDA(At, 1, 0); PG8_STA(PG8_SA(0, 1), 1, k2, last);
            PG8_WAIT_L(8); PG8_BAR; PG8_WAIT_L(0); PG8_MMA(0, 0, At, B0); PG8_BAR; PG8_SCHED;
            PG8_LDB(B1, 1, 1); PG8_STAGE(PG8_SB(1, 0), b3, voffB);
            PG8_BAR; PG8_WAIT_L(0); PG8_MMA(0, 1, At, B1); PG8_BAR;
            PG8_LDA(At, 1, 1); PG8_STA(PG8_SA(1, 0), 0, k3, last);
            PG8_BAR; PG8_WAIT_L(0); PG8_MMA(1, 0, At, B0); PG8_BAR; PG8_SCHED;
            PG8_STAGE(PG8_SB(1, 1), b3 + hstep, voffB);
            PG8_WAIT_V(6); PG8_BAR; PG8_MMA(1, 1, At, B1); PG8_BAR;
        }
        E(acc, cur, wid);
        if (!has_next) break;
#pragma unroll
        for (int a = 0; a < 2; ++a)
#pragma unroll
            for (int b = 0; b < 2; ++b)
#pragma unroll
                for (int m = 0; m < 4; ++m)
#pragma unroll
                    for (int n = 0; n < 2; ++n) acc[a][b][m][n] = (f32x4){0.f, 0.f, 0.f, 0.f};
        cur = nxt; cB = nB; cA = nA; ++ui;
        if constexpr (!DN) {
#pragma unroll
        for (int h = 0; h < 2; ++h)
#pragma unroll
            for (int i = 0; i < 2; ++i) cO[h][i] = nO[h][i]; }
    }
    PG8_WAIT_V(0);
    if (wr == 0) PG8_BAR;
    PG8_BAR;
#undef PG8_SA
#undef PG8_SB
#undef PG8_STAGE
#undef PG8_LDA
#undef PG8_LDB
#undef PG8_MMA
#undef PG8_WAIT_V
#undef PG8_WAIT_L
#undef PG8_BAR
#undef PG8_SCHED
#undef PG8_AOFF
#undef PG8_STA
}
}
struct DenseSched {
    static constexpr bool DENSE = true;
    int nM, nN, nwg, G, c, K; const char* Bt; int single = 0, round = 0;
    __device__ __forceinline__ void init(int M, int N, int K_, const bf16_t* Bt_, int G_, int c_) { nM = M / 256; nN = N / 256; nwg = nM * nN; G = G_; c = c_; K = K_; Bt = (const char*)Bt_; }
    __device__ __forceinline__ bool next(int i, pg8::Unit& u) const {
        if (single && i > 0) return false;
        const long L = (long)(single ? round : i) * G + c; if (L >= nwg) return false;
        int wgid = (int)L; { const int q = nwg / 8, r = nwg % 8, xcd = wgid % 8, off = wgid / 8; wgid = (xcd < r ? xcd * (q + 1) : r * (q + 1) + (xcd - r) * q) + off; }
        const int nig = 8 * nN, gid = wgid / nig, fm = gid * 8, gsz = (nM - fm) < 8 ? (nM - fm) : 8;
        u.pm = fm + ((wgid % nig) % gsz); u.pn = (wgid % nig) / gsz; u.e = 0; u.r0 = 0; return true;
    }
    __device__ __forceinline__ int a_row(const pg8::Unit& u, int r) const { return u.pm * 256 + r; }
    __device__ __forceinline__ const char* b_ptr(const pg8::Unit& u) const { return Bt + (size_t)u.pn * 256 * K * 2; }
};
template <bool GATHER> struct MoeSched {
    static constexpr bool DENSE = !GATHER;
    const LAS int* tstart; const LAS int* cnt; int nN, G, c, K, row_lo; const int* ltok; const char* Bt; size_t bstride;
    __device__ __forceinline__ bool next(int i, pg8::Unit& u) const {
        const long L = (long)i * G + c; const int ntile = __builtin_amdgcn_readfirstlane(tstart[NE1]); if (L >= (long)ntile * nN) return false;
        const int tile = (int)(L / nN); u.pn = (int)(L % nN);
        int e = 0;
#pragma unroll 1
        for (int step = 64; step >= 1; step >>= 1) { const int e2 = e + step; if (e2 <= NE && tstart[e2] <= tile) e = e2; }
        e = __builtin_amdgcn_readfirstlane(e); u.e = e; u.pm = __builtin_amdgcn_readfirstlane(tile); u.pn = __builtin_amdgcn_readfirstlane(u.pn); u.r0 = __builtin_amdgcn_readfirstlane((tile - tstart[e]) * 256); return true;
    }
    __device__ __forceinline__ int a_row(const pg8::Unit& u, int r) const {
        if (!GATHER) return u.pm * 256 + r;
        const int ri = u.r0 + r;
        if (u.e == NE) return ri < cnt[NE] ? row_lo + ri : row_lo;
        return ri < cnt[u.e] ? ltok[(size_t)u.e * ROWS + ri] : row_lo;
    }
    __device__ __forceinline__ const char* b_ptr(const pg8::Unit& u) const { return Bt + (size_t)u.e * bstride + (size_t)u.pn * 256 * K * 2; }
};

struct EpiProj {
    static constexpr bool PERM = true;
    bf16_t* O; int ldc;
    __device__ __forceinline__ void operator()(const f32x4 (&acc)[2][2][4][2], const pg8::Unit& u, const int wid) const {
        const int lane_ = lane_id_asm(), fr = lane_ & 15, fq = lane_ >> 4, wr = wid >> 2, wc = wid & 3;
        const int row0 = u.pm * 256 + wr * 64 + fr, col0 = u.pn * 256 + wc * 32 + 8 * fq;
#pragma unroll
        for (int ai = 0; ai < 2; ++ai)
#pragma unroll
            for (int m = 0; m < 4; ++m) { bf16_t* rowp = O + (size_t)(row0 + ai * 128 + m * 16) * ldc + col0;
#pragma unroll
                for (int bj = 0; bj < 2; ++bj) { const f32x4 v0 = acc[ai][bj][m][0], v1 = acc[ai][bj][m][1];
                    u32x4 w; w.x = pg8::cvt_pk_bf16(v0[0], v0[1]); w.y = pg8::cvt_pk_bf16(v0[2], v0[3]); w.z = pg8::cvt_pk_bf16(v1[0], v1[1]); w.w = pg8::cvt_pk_bf16(v1[2], v1[3]);
                    *(u32x4*)(rowp + bj * 128) = w; } }
    }
};
struct EpiRes {
    static constexpr bool PERM = false;
    const float* xsrc; const float* csrc; float* xdst; float* cdst; const float* gate; float pert = 0.f;
    __device__ __forceinline__ void operator()(const f32x4 (&acc)[2][2][4][2], const pg8::Unit& u, const int wid) const {
        const int lane_ = lane_id_asm(), fr = lane_ & 15, fq = lane_ >> 4, wr = wid >> 2, wc = wid & 3;
        const int col0 = u.pn * 256 + wc * 32 + 4 * fq;
        const bool isc = u.pm < 4; const int sel = isc ? 4 : (u.pm - 4) >> 5;
        const float* src = isc ? csrc + (size_t)u.pm * 256 * D : xsrc + (size_t)(u.pm - 4) * 256 * D;
        float* dst = isc ? cdst + (size_t)u.pm * 256 * D : xdst + (size_t)(u.pm - 4) * 256 * D;
        f32x4 gv[2][2];
#pragma unroll
        for (int bj = 0; bj < 2; ++bj)
#pragma unroll
            for (int n = 0; n < 2; ++n) gv[bj][n] = *(const f32x4*)(gate + sel * 6144 + col0 + bj * 128 + n * 16);
#pragma unroll
        for (int ai = 0; ai < 2; ++ai)
#pragma unroll
            for (int m = 0; m < 4; ++m) { const size_t off = (size_t)(ai * 128 + wr * 64 + m * 16 + fr) * D + col0;
#pragma unroll
                for (int bj = 0; bj < 2; ++bj)
#pragma unroll
                    for (int n = 0; n < 2; ++n) { const f32x4 s = *(const f32x4*)(src + off + bj * 128 + n * 16); *(f32x4*)(dst + off + bj * 128 + n * 16) = (s + gv[bj][n] * acc[ai][bj][m][n]) * (1.0f + (((fr + m + n) & 1) ? pert : -pert)); }
                asm volatile("" ::: "memory"); }
    }
};
struct EpiF32T {
    static constexpr bool PERM = false;
    float* Y;
    __device__ __forceinline__ void operator()(const f32x4 (&acc)[2][2][4][2], const pg8::Unit& u, const int wid) const {
        const int lane_ = lane_id_asm(), fr = lane_ & 15, fq = lane_ >> 4, wr = wid >> 2, wc = wid & 3;
        const int col0 = u.pn * 256 + wc * 32 + 4 * fq;
#pragma unroll
        for (int ai = 0; ai < 2; ++ai)
#pragma unroll
            for (int m = 0; m < 4; ++m) { float* rp = Y + (size_t)(u.pm * 256 + ai * 128 + wr * 64 + m * 16 + fr) * D + col0;
#pragma unroll
                for (int bj = 0; bj < 2; ++bj)
#pragma unroll
                    for (int n = 0; n < 2; ++n) *(f32x4*)(rp + bj * 128 + n * 16) = acc[ai][bj][m][n]; }
    }
};
struct EpiGU {
    static constexpr bool PERM = false;
    bf16_t* H;
    __device__ __forceinline__ void operator()(const f32x4 (&acc)[2][2][4][2], const pg8::Unit& u, const int wid) const {
        const int lane_ = lane_id_asm(), fr = lane_ & 15, fq = lane_ >> 4, wr = wid >> 2, wc = wid & 3;
        const int row0 = u.pm * 256 + wr * 64 + fr;
#pragma unroll
        for (int ai = 0; ai < 2; ++ai)
#pragma unroll
            for (int m = 0; m < 4; ++m) { bf16_t* rowp = H + (size_t)(row0 + ai * 128 + m * 16) * EH + 4 * fq;
#pragma unroll
                for (int bj = 0; bj < 2; ++bj) { const f32x4 g = acc[ai][bj][m][0], up = acc[ai][bj][m][1]; float h[4];
#pragma unroll
                    for (int j = 0; j < 4; ++j) h[j] = g[j] / (1.0f + __expf(-g[j])) * up[j];
                    u32x2 w; w.x = pg8::cvt_pk_bf16(h[0], h[1]); w.y = pg8::cvt_pk_bf16(h[2], h[3]);
                    *(u32x2*)(rowp + (u.pn * 256 + bj * 128 + wc * 32) / 2) = w; } }
    }
};
struct EpiY {
    static constexpr bool PERM = true;
    bf16_t* Y;
    __device__ __forceinline__ void operator()(const f32x4 (&acc)[2][2][4][2], const pg8::Unit& u, const int wid) const {
        const int lane_ = lane_id_asm(), fr = lane_ & 15, fq = lane_ >> 4, wr = wid >> 2, wc = wid & 3;
        const int row0 = u.pm * 256 + wr * 64 + fr, col0 = u.pn * 256 + wc * 32 + 8 * fq;
#pragma unroll
        for (int ai = 0; ai < 2; ++ai)
#pragma unroll
            for (int m = 0; m < 4; ++m) { bf16_t* rowp = Y + (size_t)(row0 + ai * 128 + m * 16) * 512 + col0;
#pragma unroll
                for (int bj = 0; bj < 2; ++bj) { const f32x4 v0 = acc[ai][bj][m][0], v1 = acc[ai][bj][m][1];
                    u32x4 w; w.x = pg8::cvt_pk_bf16(v0[0], v0[1]); w.y = pg8::cvt_pk_bf16(v0[2], v0[3]); w.z = pg8::cvt_pk_bf16(v1[0], v1[1]); w.w = pg8::cvt_pk_bf16(v1[2], v1[3]);
                    *(u32x4*)(rowp + bj * 128) = w; } }
    }
};
#define WSP(T, off) ((T*)(p.ws + (off)))

__device__ __forceinline__ void conv_tile(const int t, LAS float* tl, const float* __restrict__ src, int ldsrc, int k0, int n0, int nvalid, bf16_t* dst, int lddst, int mode) {
#pragma unroll
    for (int j = 0; j < 8; ++j) { const int idx = t + NTHR * j, k = idx >> 6, n = idx & 63; float v = 0.f; if (n0 + n < nvalid) v = src[(size_t)(k0 + k) * ldsrc + n0 + n]; tl[k * 65 + n] = v; }
    __syncthreads();
#pragma unroll
    for (int j = 0; j < 4; ++j) { const int pi = t + NTHR * j, n = pi >> 5, k = (pi & 31) * 2; const int nn = n0 + n;
        const int row = (mode == 0 || mode == 3) ? nn : ((nn >> 4) * 32 + (nn & 15) + (mode == 2 ? 16 : 0));
        float v0 = tl[k * 65 + n], v1 = tl[(k + 1) * 65 + n];
        if (mode == 3) { v0 -= bf2f((bf16_t)f2bf(v0)); v1 -= bf2f((bf16_t)f2bf(v1)); }
        *(unsigned*)(dst + (size_t)row * lddst + k0 + k) = pk2(v0, v1); }
    __syncthreads();
}
constexpr int CONV_A_UNITS = 2048 + 512 + 64;
__device__ __forceinline__ void conv_unit_A(const Cx& p, LAS float* tl, int u) {
    if (u < 2048) { const int l = u >> 10, r = u & 1023; conv_tile(p.tid, tl, PIN(I_WIN) + (size_t)l * D * INW, INW, (r >> 6) * 64, (r & 63) * 64, INW, WSP(bf16_t, WS_WIN) + (size_t)l * NPROJ * D, D, 0); }
    else if (u < 2560) { const int v = u - 2048, l = v >> 8, r = v & 255; conv_tile(p.tid, tl, PIN(I_WOUT) + (size_t)l * D * D, D, (r >> 4) * 64, (r & 15) * 64, D, WSP(bf16_t, WS_WOUT) + (size_t)l * D * D, D, 0); }
    else { const int v = u - 2560, l = v >> 5, lo = (v >> 4) & 1, r = v & 15; conv_tile(p.tid, tl, PIN(I_ROUT_W) + (size_t)l * D * NE, NE, r * 64, 0, NE, WSP(bf16_t, WS_ROUT) + (size_t)(l * 2 + lo) * NE * D, D, lo ? 3 : 0); }
}
constexpr int CONV_E_UNITS = NE1 * 192;
__device__ __forceinline__ void conv_unit_E(const Cx& p, LAS float* tl, int l, int u) {
    const int e = u / 192, r = u % 192;
    if (r < 128) { const int up = r >> 6, q = r & 63;
        const float* src = e < NE ? PIN(up ? I_EXP_U : I_EXP_G) + ((size_t)l * NE + e) * D * EH : PIN(up ? I_SH_U : I_SH_G) + (size_t)l * D * EH;
        conv_tile(p.tid, tl, src, EH, (q >> 2) * 64, (q & 3) * 64, EH, WSP(bf16_t, WS_EXPGU) + (size_t)e * 512 * D, D, 1 + up); }
    else { const int q = r - 128;
        const float* src = e < NE ? PIN(I_EXP_D) + ((size_t)l * NE + e) * EH * D : PIN(I_SH_D) + (size_t)l * EH * D;
        conv_tile(p.tid, tl, src, D, (q >> 4) * 64, (q & 15) * 64, D, WSP(bf16_t, WS_EXPD) + (size_t)e * D * EH, EH, 0); }
}
__device__ __forceinline__ void phase_mod(const Cx& p, LAS unsigned char* lds) {
    LAS float* sv = (LAS float*)lds; LAS float* red = sv + 5 * D;
    const int tid = p.tid;
    if (p.bid >= 192) return;
    for (int i = tid; i < 5 * D; i += NTHR) { const int j = i >> 10, k = i & 1023; const float c = j < 4 ? PIN(I_C)[j * D + k] : PIN(I_CCTX)[k]; sv[i] = siluf_(c); }
    __syncthreads();
    for (int u = p.bid; u < 192; u += p.G) {
        const int l = u / 96, cb = u % 96, kg = tid >> 6, cl = tid & 63;
        const float* w = PIN(I_WMOD) + (size_t)l * D * 6144 + cb * 64 + cl;
        float a0 = 0.f, a1 = 0.f, a2 = 0.f, a3 = 0.f, a4 = 0.f;
#pragma unroll 8
        for (int kk = 0; kk < 128; ++kk) { const int k = kg * 128 + kk; const float wv = w[(size_t)k * 6144];
            a0 += sv[k] * wv; a1 += sv[D + k] * wv; a2 += sv[2 * D + k] * wv; a3 += sv[3 * D + k] * wv; a4 += sv[4 * D + k] * wv; }
        red[(kg * 5 + 0) * 64 + cl] = a0; red[(kg * 5 + 1) * 64 + cl] = a1; red[(kg * 5 + 2) * 64 + cl] = a2; red[(kg * 5 + 3) * 64 + cl] = a3; red[(kg * 5 + 4) * 64 + cl] = a4;
        __syncthreads();
        if (tid < 320) { const int j = tid >> 6; float s = 0.f;
#pragma unroll
            for (int g = 0; g < 8; ++g) s += red[(g * 5 + j) * 64 + cl];
            WSP(float, WS_MOD)[((size_t)l * 5 + j) * 6144 + cb * 64 + cl] = s + PIN(I_BMOD)[l * 6144 + cb * 64 + cl]; }
        __syncthreads();
    }
}
__device__ __forceinline__ const float* res_row(const Cx& p, int layer_src0, int r) {
    if (r < CROWS) return (layer_src0 ? PIN(I_CTX) : (const float*)WSP(float, WS_CTXRES)) + (size_t)r * D;
    return (layer_src0 ? PIN(I_X) : (const float*)p.out) + (size_t)(r - CROWS) * D;
}
__device__ __forceinline__ int row_sel(int r) { return r < CROWS ? 4 : (r - CROWS) >> 13; }

__device__ __forceinline__ void norm_row(const float* src, const int* accp, float* wb, int* zacc, const float* g, const float* shift, const float* scale, bf16_t* dst, const bool tolds, LAS bf16_t* ldst, LAS bf16_t* ldlo, int lane) {
    f32x4 v[4]; float ss = 0.f;
#pragma unroll
    for (int i = 0; i < 4; ++i) { v[i] = *(const f32x4*)(src + 256 * i + 4 * lane);
        ss += v[i][0] * v[i][0] + v[i][1] * v[i][1] + v[i][2] * v[i][2] + v[i][3] * v[i][3]; }
    ss = wsum(ss); const float rstd = rsqrtf(ss * (1.0f / D) + 1e-6f);
#pragma unroll
    for (int i = 0; i < 4; ++i) { const int col = 256 * i + 4 * lane; const f32x4 gv = *(const f32x4*)(g + col), sh = *(const f32x4*)(shift + col), sc = *(const f32x4*)(scale + col);
        const f32x4 y = v[i] * rstd * gv * (sc + 1.0f) + sh; u32x2 w; w.x = pk2(y[0], y[1]); w.y = pk2(y[2], y[3]);
        *(u32x2*)(dst + col) = w;
        if (tolds) { *(LAS u32x2*)(ldst + col) = w; u32x2 wl;
            wl.x = pk2(y[0] - __uint_as_float(w.x << 16), y[1] - __uint_as_float(w.x & 0xffff0000u)); wl.y = pk2(y[2] - __uint_as_float(w.y << 16), y[3] - __uint_as_float(w.y & 0xffff0000u));
            *(LAS u32x2*)(ldlo + col) = wl; } }
}
__device__ __forceinline__ void phase_norm1(const Cx& p, int layer) {
    const int lane = p.tid & 63, wave = p.tid >> 6;
    const float* mod = WSP(float, WS_MOD) + (size_t)layer * 5 * 6144; const float* g = PIN(I_N1G) + layer * D; bf16_t* hb = WSP(bf16_t, WS_HBUF);
    for (int r = p.bid * 8 + wave; r < ROWS; r += p.G * 8) { const int sel = row_sel(r);
        const float* src = res_row(p, layer == 0, r);
        norm_row(src, (const int*)0, (float*)0, (int*)0, g, mod + sel * 6144 + 0, mod + sel * 6144 + 1024, hb + (size_t)r * D, false, (LAS bf16_t*)0, (LAS bf16_t*)0, lane); }
}
__device__ __forceinline__ float conv_at(const Cx& p, const bf16_t* proj, int b, int s, int col, const float* cw  ) {
    float acc = 0.f;
    if (s < NCTX) {
#pragma unroll
        for (int dx = -1; dx <= 1; ++dx) { const int s2 = s + dx; if (s2 >= 0 && s2 < NCTX) acc += cw[(3 + dx + 1) * 768] * bf2f(proj[(size_t)(b * NCTX + s2) * NPROJ + col]); }
    } else { const int t = s - NCTX, r = t >> 6, c = t & 63;
#pragma unroll
        for (int dy = -1; dy <= 1; ++dy)
#pragma unroll
            for (int dx = -1; dx <= 1; ++dx) { const int r2 = r + dy, c2 = c + dx;
                if (r2 >= 0 && r2 < GRIDH && c2 >= 0 && c2 < GRIDW) acc += cw[((dy + 1) * 3 + dx + 1) * 768] * bf2f(proj[(size_t)(CROWS + b * SEQ + r2 * 64 + c2) * NPROJ + col]); }
    }
    return acc;
}
__device__ __forceinline__ void phase_prep(const Cx& p, LAS unsigned char* lds, int layer, int b) {
    const int lane = p.tid & 63, wave = __builtin_amdgcn_readfirstlane(p.tid >> 6);
    const bf16_t* proj = WSP(bf16_t, WS_PROJ);
    if (p.bid < SB / 33) {
        LAS float* wl = (LAS float*)lds;
        { const float* AW = PIN(I_RW_AW2) + (size_t)layer * 32 * 256; const float* WW = PIN(I_RW_W2) + (size_t)layer * 2 * 32 * 256;
          for (int i = p.tid; i < 96 * 256; i += NTHR) wl[i] = i < 32 * 256 ? AW[i] : WW[i - 32 * 256]; }
        __syncthreads();
        const int h = wave & 3, half = wave >> 2, c = 64 * h + lane;
        const float a0 = PIN(I_RW_A0)[layer * 256 + c], w0f = PIN(I_RW_W0)[(layer * 2 + 0) * 256 + c], w0b = PIN(I_RW_W0)[(layer * 2 + 1) * 256 + c];
        const float kkm = PIN(I_RW_KK)[layer * 256 + c], kam = PIN(I_RW_KA)[layer * 256 + c];
        for (int u = p.bid; u < SB / 33; u += p.G) {
#pragma unroll 1
            for (int i = 0; i < (half ? 16 : 17); ++i) { const int s = u * 33 + half * 17 + i; const bf16_t* pr = proj + (size_t)tok_row(b, s) * NPROJ;
                float xa = 0.f, xf = 0.f, xb = 0.f;
                if (lane < 32) { xa = bf2f(pr[PB_A + lane]); xf = tanhf_(bf2f(pr[PB_WF + lane])); xb = tanhf_(bf2f(pr[PB_WB + lane])); }
                const float kv = bf2f(pr[PB_K + c]);
                float sa = a0, sf = w0f, sb = w0b;
#pragma unroll 8
                for (int j = 0; j < 32; ++j) { sa += rl(xa, j) * wl[j * 256 + c]; sf += rl(xf, j) * wl[(32 + j) * 256 + c]; sb += rl(xb, j) * wl[(64 + j) * 256 + c]; }
                const float a = sigmoidf_(sa);
                const float lwf = -__expf(-softplusf_(-sf) - 0.5f), lwb = -__expf(-softplusf_(-sb) - 0.5f);
                const float kr = kv * kkm; const float ss = wsum(kr * kr); const float kk = kr * rsqrtf(ss + 1e-6f);
                const size_t o = (size_t)s * 256 + c;
                WSP(float, SC_RK)[o] = kv * (1.0f + (a - 1.0f) * kam); WSP(float, SC_RKK)[o] = kk; WSP(float, SC_RB)[o] = kk * a;
                WSP(float, SC_RLW)[o] = lwf; WSP(float, SC_RLW)[(size_t)SB * 256 + o] = lwb; }
        }
    }
    __syncthreads();
    { LAS bf16_t* T = (LAS bf16_t*)lds; const int tid = p.tid;
      for (int u = p.bid; u < 2 * NTB * 3; u += p.G) { const int mixer = u / (NTB * 3), r2 = u % (NTB * 3), rb = r2 / 3, third = r2 % 3, colbase = (mixer ? PD_Q : PC_X) + 256 * third;
#pragma unroll 4
          for (int q = 0; q < 12; ++q) { const int e = tid + NTHR * q, rr = e >> 11, tok = (e >> 5) & 63, ch = (e & 31) * 8; u32x4 v = (u32x4){0u, 0u, 0u, 0u};
              if (rb < 4) { if (rr == 1) v = *(const u32x4*)(proj + (size_t)(b * NCTX + 64 * rb + tok) * NPROJ + colbase + ch); }
              else { const int gr = rb - 4 + rr - 1; if (gr >= 0 && gr < GRIDH) v = *(const u32x4*)(proj + (size_t)(CROWS + b * SEQ + gr * 64 + tok) * NPROJ + colbase + ch); }
              *(LAS u32x4*)(T + (rr * 66 + tok + 1) * 256 + ch) = v; }
          if (tid < 192) { const int rr = tid >> 6, side = (tid >> 5) & 1, ch = (tid & 31) * 8; u32x4 v = (u32x4){0u, 0u, 0u, 0u};
              if (rb < 4 && rr == 1) { const int tk = side ? 64 * (rb + 1) : 64 * rb - 1; if (tk >= 0 && tk < NCTX) v = *(const u32x4*)(proj + (size_t)(b * NCTX + tk) * NPROJ + colbase + ch); }
              *(LAS u32x4*)(T + (rr * 66 + (side ? 65 : 0)) * 256 + ch) = v; }
          __syncthreads();
          { const int c = tid & 255, th = tid >> 8, chn = 256 * third + c; float w[9];
            const float* cw = (mixer ? PIN(I_DN_CW) : PIN(I_SS_CW)) + (size_t)layer * 9 * 768 + chn;
#pragma unroll
            for (int k = 0; k < 9; ++k) w[k] = cw[k * 768];
            const float bias = mixer ? 0.f : PIN(I_SS_CB)[layer * 768 + chn];
            bf16_t* dst = (mixer ? WSP(bf16_t, SC_DQ) : WSP(bf16_t, SC_SX)) + (size_t)(64 * rb) * 768 + chn;
#pragma unroll 2
            for (int tk = 0; tk < 32; ++tk) { const int x = 32 * th + tk; float acc = bias;
#pragma unroll
                for (int dy = 0; dy < 3; ++dy)
#pragma unroll
                    for (int dx = 0; dx < 3; ++dx) acc += w[dy * 3 + dx] * bf2f(T[(dy * 66 + x + dx) * 256 + c]);
                float y = siluf_(acc);
                if (mixer && third < 2) { const float ss = wsum(y * y); y *= rsqrtf(ss + 1e-6f); if (third == 0) y *= 0.125f; }
                dst[(size_t)x * 768] = (bf16_t)f2bf(y); } }
          __syncthreads();
      }
      for (int e = p.bid * NTHR + tid; e < SB * 24; e += p.G * NTHR) { const int s = e / 24, q = e % 24; const bf16_t* pr = proj + (size_t)tok_row(b, s) * NPROJ;
          if (q < 8) { const int d = q >> 2, h = q & 3; WSP(float, SC_SDT)[(size_t)s * 8 + q] = softplusf_(bf2f(pr[PC_DF + q]) + PIN(I_SS_DTB)[(layer * 2 + d) * 4 + h]); }
          else if (q < 16) { WSP(float, SC_DG)[(size_t)s * 16 + (q - 8)] = sigmoidf_(bf2f(pr[PD_BF + (q - 8)])); }
          else { const int q2 = q - 16, d = q2 >> 2, h = q2 & 3; WSP(float, SC_DG)[(size_t)s * 16 + 8 + q2] = -__expf(PIN(I_DN_ALOG)[(layer * 2 + d) * 4 + h]) * softplusf_(bf2f(pr[PD_AF + q2]) + PIN(I_DN_DTB)[(layer * 2 + d) * 4 + h]); } }
    }
}
__device__ __forceinline__ void phase_scan(const Cx& p, int layer, int b);
__device__ __forceinline__ void phase_post(const Cx& p, int layer, int b) {
    const int lane = p.tid & 63, wave = __builtin_amdgcn_readfirstlane(p.tid >> 6);
    const bf16_t* proj = WSP(bf16_t, WS_PROJ); const bf16_t* of = WSP(bf16_t, SC_OF); const bf16_t* obk = WSP(bf16_t, SC_OB); bf16_t* yc = WSP(bf16_t, WS_HBUF);
    for (int u = p.bid; u < SB / 33; u += p.G) {
        if (wave < 4) { const int h = wave, c = 64 * h + lane; const float ng = PIN(I_GLA_NG)[layer * 256 + c];
            const int c0 = 128 * wave + lane, c1 = c0 + 64; float sd0 = 0.f, sd1 = 0.f, sg0 = 0.f, sg1 = 0.f;
            if (wave < 2) { sd0 = PIN(I_SS_D)[layer * 4 + (c0 >> 6)]; sd1 = PIN(I_SS_D)[layer * 4 + (c1 >> 6)]; sg0 = PIN(I_SS_NG)[layer * 256 + c0]; sg1 = PIN(I_SS_NG)[layer * 256 + c1]; }
#pragma unroll 1
            for (int i0 = 0; i0 < 33; i0 += 3) { float yg[3], y0[3], y1[3];
#pragma unroll
                for (int ii = 0; ii < 3; ++ii) { const int s = u * 33 + i0 + ii, row = tok_row(b, s); const bf16_t* pr = proj + (size_t)row * NPROJ; const bf16_t* o1 = of + (size_t)s * 1024; const bf16_t* o2 = obk + (size_t)s * 1024;
                    yg[ii] = (bf2f(o1[c]) + bf2f(o2[c])) ; const float gz = bf2f(pr[PA_G + c]);
                    const float ms = wsum(yg[ii] * yg[ii]) * (1.0f / 64.0f); yg[ii] = yg[ii] * rsqrtf(ms + 1e-6f) * ng * siluf_(gz);
                    if (wave < 2) { const bf16_t* sx = WSP(bf16_t, SC_SX) + (size_t)s * 768;
                        y0[ii] = (bf2f(o1[512 + c0]) + bf2f(o2[512 + c0]) + sd0 * bf2f(sx[c0])) * siluf_(bf2f(pr[PC_Z + c0]));
                        y1[ii] = (bf2f(o1[512 + c1]) + bf2f(o2[512 + c1]) + sd1 * bf2f(sx[c1])) * siluf_(bf2f(pr[PC_Z + c1]));
                        const float rs = rsqrtf(wsum(y0[ii] * y0[ii] + y1[ii] * y1[ii]) * (1.0f / 128.0f) + 1e-6f); y0[ii] *= rs * sg0; y1[ii] *= rs * sg1; } }
#pragma unroll
                for (int ii = 0; ii < 3; ++ii) { bf16_t* yr = yc + (size_t)tok_row(b, u * 33 + i0 + ii) * D; yr[c] = (bf16_t)f2bf(yg[ii]); if (wave < 2) { yr[512 + c0] = (bf16_t)f2bf(y0[ii]); yr[512 + c1] = (bf16_t)f2bf(y1[ii]); } } }
        } else { const int h = wave - 4, c = 64 * h + lane; float gw[64];
#pragma unroll
            for (int j = 0; j < 64; ++j) gw[j] = PIN(I_RW_GW2)[((size_t)layer * 64 + j) * 256 + c];
            const float lng = PIN(I_RW_LNG)[layer * 256 + c], lnb = PIN(I_RW_LNB)[layer * 256 + c], rrk = PIN(I_RW_RK)[layer * 256 + c], dng = PIN(I_DN_NG)[layer * 256 + c];
#pragma unroll 1
            for (int i0 = 0; i0 < 33; i0 += 3) { float yr_[3], yd[3];
#pragma unroll
                for (int ii = 0; ii < 3; ++ii) { const int s = u * 33 + i0 + ii, row = tok_row(b, s); const bf16_t* pr = proj + (size_t)row * NPROJ; const bf16_t* o1 = of + (size_t)s * 1024; const bf16_t* o2 = obk + (size_t)s * 1024;
                    const float o = bf2f(o1[256 + c]) + bf2f(o2[256 + c]), od = bf2f(o1[768 + c]) + bf2f(o2[768 + c]);
                    const float r = bf2f(pr[PB_R + c]), kp = WSP(float, SC_RK)[(size_t)s * 256 + c], vv = bf2f(pr[PB_V + c]), sg = sigmoidf_(bf2f(pr[PB_G + lane])), dz = bf2f(pr[PD_Z + c]);
                    const float mu = wsum(o) * (1.0f / 64.0f); const float dlt = o - mu; const float var = wsum(dlt * dlt) * (1.0f / 64.0f);
                    const float y = dlt * rsqrtf(var + 64e-5f) * lng + lnb; const float bonus = wsum(r * kp * rrk) * vv; float gate = 0.f;
#pragma unroll
                    for (int j = 0; j < 64; ++j) gate += rl(sg, j) * gw[j];
                    yr_[ii] = (y + bonus) * gate;
                    const float ms = wsum(od * od) * (1.0f / 64.0f); yd[ii] = od * rsqrtf(ms + 1e-6f) * dng * siluf_(dz); }
#pragma unroll
                for (int ii = 0; ii < 3; ++ii) { bf16_t* yr = yc + (size_t)tok_row(b, u * 33 + i0 + ii) * D; yr[256 + c] = (bf16_t)f2bf(yr_[ii]); yr[768 + c] = (bf16_t)f2bf(yd[ii]); } }
        }
    }
}
constexpr int N2_TILE = 32, N2_STRIDE = 2064;
__device__ __forceinline__ void phase_norm2(const Cx& p, LAS unsigned char* lds, int layer, int row_lo) {
    const int tid = p.tid, lane = tid & 63, wave = __builtin_amdgcn_readfirstlane(tid >> 6), fr = lane & 15, fq = lane >> 4;
    const float* mod = WSP(float, WS_MOD) + (size_t)layer * 5 * 6144; const float* g = PIN(I_N2G) + layer * D; bf16_t* hb = WSP(bf16_t, WS_HBUF);
    const bf16_t* rt = WSP(bf16_t, WS_ROUT) + (size_t)layer * 2 * NE * D;
    LAS float* lg = (LAS float*)(lds + 2 * N2_TILE * N2_STRIDE);
    unsigned* cnt = WSP(unsigned, WS_CTL) + CW_CNT + layer * 80 * 16; int* ltok = WSP(int, WS_LTOK); int* tokt = WSP(int, WS_TOKT);
    const float rbias = PIN(I_ROUT_B)[layer * NE + lane];
    const int nun = (ROWS - row_lo) / N2_TILE;
    for (int u = p.bid; u < nun; u += p.G) { const int r0 = row_lo + u * N2_TILE;
#pragma unroll 1
        for (int i = 0; i < 4; ++i) { const int tr = 4 * wave + i, r = r0 + tr, sel = row_sel(r);
            norm_row(res_row(p, 0, r), (const int*)0, (float*)0, (int*)0, g, mod + sel * 6144 + 3072, mod + sel * 6144 + 4096, hb + (size_t)r * D, true, (LAS bf16_t*)(lds + tr * N2_STRIDE), (LAS bf16_t*)(lds + N2_TILE * N2_STRIDE + tr * N2_STRIDE), lane); }
        __syncthreads();
        { const int mt = wave >> 2, nt = wave & 3; f32x4 acc = (f32x4){0.f, 0.f, 0.f, 0.f};
          const LAS unsigned char* ap = lds + (16 * mt + fr) * N2_STRIDE + fq * 16; const bf16_t* bp = rt + (size_t)(16 * nt + fr) * D + fq * 8;
#pragma unroll 4
          for (int ks = 0; ks < 32; ++ks) { const bf16x8 a = *(const LAS bf16x8*)(ap + ks * 64), al = *(const LAS bf16x8*)(ap + N2_TILE * N2_STRIDE + ks * 64);
              const bf16x8 bb = *(const bf16x8*)(bp + ks * 32), bl = *(const bf16x8*)(bp + NE * D + ks * 32);
              acc = __builtin_amdgcn_mfma_f32_16x16x32_bf16(a, bb, acc, 0, 0, 0); acc = __builtin_amdgcn_mfma_f32_16x16x32_bf16(al, bb, acc, 0, 0, 0); acc = __builtin_amdgcn_mfma_f32_16x16x32_bf16(a, bl, acc, 0, 0, 0); }
#pragma unroll
          for (int j = 0; j < 4; ++j) lg[(16 * mt + 4 * fq + j) * 64 + 16 * nt + fr] = acc[j]; }
        __syncthreads();
#pragma unroll 1
        for (int i = 0; i < 4; ++i) { const int tr = 4 * wave + i, r = r0 + tr;
            const float sc = sigmoidf_(lg[tr * 64 + lane]); float sel = sc + rbias; float ssum = 0.f; int myE = 0; float myS = 0.f;
#pragma unroll 1
            for (int k = 0; k < TOPK; ++k) { float bv = sel; int bi = lane;
#pragma unroll
                for (int o = 32; o >= 1; o >>= 1) { const int l_ = lane_id_asm(); const float ov = shx_(bv, l_, o); const int oi = shxi_(bi, l_, o); if (ov > bv || (ov == bv && oi < bi)) { bv = ov; bi = oi; } }
                const int e = __builtin_amdgcn_readfirstlane(bi); const float se = rl(sc, e);
                ssum += se; if (lane == k) { myE = e; myS = se; } if (lane == e) sel = -1e30f; }
            if (lane < TOPK) { const unsigned pos = atomicAdd(cnt + myE * 16, 1u); ltok[(size_t)myE * ROWS + pos] = r; tokt[(size_t)r * 16 + lane] = (myE << 16) | (int)pos; ((float*)tokt)[(size_t)r * 16 + 8 + lane] = myS / ssum * 2.5f; } }
        __syncthreads();
    }
}
__device__ __forceinline__ void moe_table(const Cx& p, LAS int* tb, int layer, int row_lo) {
    const unsigned* cnt = WSP(unsigned, WS_CTL) + CW_CNT + layer * 80 * 16;
    if (p.tid == 0) { int acc = 0;
#pragma unroll 1
        for (int e = 0; e < NE1; ++e) { const int c = e < NE ? (int)__hip_atomic_load(cnt + e * 16, __ATOMIC_RELAXED, __HIP_MEMORY_SCOPE_AGENT) : ROWS - row_lo; tb[e] = c; tb[128 + e] = acc; acc += (c + 255) >> 8; }
        tb[128 + NE1] = acc; }
    __syncthreads();
}
__device__ __forceinline__ void phase_combine(const Cx& p, const LAS int* tb, int layer, int row_lo, int half) {
    const int lane = p.tid & 63, wave = p.tid >> 6; const bf16_t* Y = WSP(bf16_t, WS_Y); const int* tokt = WSP(int, WS_TOKT);
    const float* gate = WSP(float, WS_MOD) + (size_t)layer * 5 * 6144 + 5120; const int col = 512 * half + 8 * lane; const int shbase = tb[128 + NE] * 256;
#pragma unroll 2
    for (int r = row_lo + p.bid * 8 + wave; r < ROWS; r += p.G * 8) {
        const int sw = lane < 16 ? tokt[(size_t)r * 16 + lane] : 0;
        float a[8];
        { const u32x4 y = *(const u32x4*)(Y + (size_t)(shbase + (r - row_lo)) * 512 + 8 * lane);
#pragma unroll
          for (int q = 0; q < 4; ++q) { a[2 * q] = __uint_as_float(y[q] << 16); a[2 * q + 1] = __uint_as_float(y[q] & 0xffff0000u); } }
#pragma unroll
        for (int k = 0; k < 8; ++k) { const int sl = __builtin_amdgcn_readlane(sw, k); const float w = __uint_as_float(__builtin_amdgcn_readlane(sw, 8 + k));
            const int hrow = tb[128 + (sl >> 16)] * 256 + (sl & 0xffff); const u32x4 y = *(const u32x4*)(Y + (size_t)hrow * 512 + 8 * lane);
#pragma unroll
            for (int q = 0; q < 4; ++q) { a[2 * q] += w * __uint_as_float(y[q] << 16); a[2 * q + 1] += w * __uint_as_float(y[q] & 0xffff0000u); } }
        float* x = (float*)res_row(p, 0, r) + col; const float* gp = gate + row_sel(r) * 6144 + col;
#pragma unroll
        for (int q = 0; q < 2; ++q) { const f32x4 gv = *(const f32x4*)(gp + 4 * q); f32x4 xv = *(const f32x4*)(x + 4 * q);
            xv[0] += gv[0] * a[4 * q]; xv[1] += gv[1] * a[4 * q + 1]; xv[2] += gv[2] * a[4 * q + 2]; xv[3] += gv[3] * a[4 * q + 3]; *(f32x4*)(x + 4 * q) = xv; }
    }
}
__device__ __forceinline__ void phase_final(const Cx& p) {
    const int lane = p.tid & 63, wave = p.tid >> 6; const float* g = PIN(I_FNG);
    for (int r = p.bid * 8 + wave; r < NB * SEQ; r += p.G * 8) { float* x = p.out + (size_t)r * D;
        f32x4 v[4]; float ss = 0.f;
#pragma unroll
        for (int i = 0; i < 4; ++i) { v[i] = *(const f32x4*)(x + 256 * i + 4 * lane); ss += v[i][0] * v[i][0] + v[i][1] * v[i][1] + v[i][2] * v[i][2] + v[i][3] * v[i][3]; }
        ss = wsum(ss); const float rstd = rsqrtf(ss * (1.0f / D) + 1e-6f);
#pragma unroll
        for (int i = 0; i < 4; ++i) *(f32x4*)(x + 256 * i + 4 * lane) = v[i] * rstd * *(const f32x4*)(g + 256 * i + 4 * lane); }
}
#ifndef MK_CHUNK
#define MK_CHUNK 7
#endif
__device__ __forceinline__ int chain_tb(int n, int d) { return d == 0 ? n : (n < 4 ? 3 - n : 135 - n); }
__device__ __forceinline__ int tb_row0(int b, int tb) { return tb < 4 ? b * NCTX + 64 * tb : CROWS + b * SEQ + 64 * (tb - 4); }
constexpr int TS = 144;
template <int K, int NT> __device__ __forceinline__ void mm_rows(const LAS unsigned char* A, int lda, const LAS unsigned char* Bt, int ldb, int mt, int nt0, int fr, int fq, f32x4 (&acc)[NT]) {
#pragma unroll
    for (int ks = 0; ks < K / 32; ++ks) { const bf16x8 a = *(const LAS bf16x8*)(A + (16 * mt + fr) * lda + ks * 64 + fq * 16);
#pragma unroll
        for (int nt = 0; nt < NT; ++nt) { const bf16x8 bb = *(const LAS bf16x8*)(Bt + (16 * (nt0 + nt) + fr) * ldb + ks * 64 + fq * 16);
            acc[nt] = __builtin_amdgcn_mfma_f32_16x16x32_bf16(a, bb, acc[nt], 0, 0, 0); } }
}
#define UNIT_LOOP(u, N, OFF) for (int u = (p.bid + p.G - ((OFF) % p.G)) % p.G; u < (N); u += p.G)
__device__ __forceinline__ void gla_p1(const Cx& p, LAS unsigned char* lds, int layer, int b) {
    const int tid = p.tid, lane = tid & 63, wave = __builtin_amdgcn_readfirstlane(tid >> 6), fr = lane & 15, fq = lane >> 4;
    LAS unsigned char* ksT = lds; LAS unsigned char* vT = lds + 64 * TS; LAS float* gs = (LAS float*)(lds + 2 * 64 * TS);
    const bf16_t* proj = WSP(bf16_t, WS_PROJ); const int mt = wave >> 1, nt0 = (wave & 1) * 2;
    UNIT_LOOP(u, NUNIT, 0) { const int tb = u >> 3, h = (u >> 1) & 3, d = u & 1; const int cl = lane, tg = wave, c = 64 * h + cl;
        const bf16_t* pr0 = proj + (size_t)tb_row0(b, tb) * NPROJ;
        float w2[16];
#pragma unroll
        for (int r = 0; r < 16; ++r) w2[r] = PIN(I_GLA_W2)[((size_t)(layer * 2 + d) * 16 + r) * 256 + c];
        const float gb = PIN(I_GLA_B)[(layer * 2 + d) * 256 + c];
        float bl[8]; float run = 0.f;
#pragma unroll
        for (int ii = 0; ii < 8; ++ii) { const int i8 = d ? 7 - ii : ii; const bf16_t* pr = pr0 + (size_t)(8 * tg + i8) * NPROJ + (d ? PA_GB : PA_GF); float z = gb;
#pragma unroll
            for (int r = 0; r < 16; ++r) z += bf2f(pr[r]) * w2[r];
            run += logsigmoidf_(z) * (1.0f / 16.0f); if (d) bl[7 - ii] = run; else bl[ii] = run; }
        gs[tg * 64 + cl] = run;
        __syncthreads();
        float off = 0.f, total = 0.f;
#pragma unroll
        for (int g2 = 0; g2 < 8; ++g2) { const float t = gs[g2 * 64 + cl]; total += t; if (d ? g2 > tg : g2 < tg) off += t; }
#pragma unroll
        for (int i8 = 0; i8 < 8; i8 += 2) { const int i = 8 * tg + i8; const bf16_t* pa = pr0 + (size_t)i * NPROJ; const bf16_t* pb = pa + NPROJ;
            const float ka = bf2f(pa[PA_K + c]) * __expf(total - (bl[i8] + off)), kb = bf2f(pb[PA_K + c]) * __expf(total - (bl[i8 + 1] + off));
            *(LAS unsigned*)(ksT + cl * TS + i * 2) = pk2(ka, kb); *(LAS unsigned*)(vT + cl * TS + i * 2) = (unsigned)pa[PA_V + c] | ((unsigned)pb[PA_V + c] << 16); }
        if (tg == 0) WSP(float, SC_GLA_DEC)[(size_t)u * 64 + cl] = __expf(total);
        __syncthreads();
        { f32x4 acc[2] = {(f32x4){0.f, 0.f, 0.f, 0.f}, (f32x4){0.f, 0.f, 0.f, 0.f}}; float* kv = WSP(float, SC_GLA_S) + (size_t)u * 4096;
          mm_rows<64, 2>(ksT, TS, vT, TS, mt, nt0, fr, fq, acc);
#pragma unroll
          for (int t = 0; t < 2; ++t)
#pragma unroll
              for (int j = 0; j < 4; ++j) kv[(16 * mt + 4 * fq + j) * 64 + 16 * (nt0 + t) + fr] = acc[t][j]; }
        __syncthreads();
    }
}
__device__ __forceinline__ void gla_chain(const Cx& p, int h, int d) {
    const int dk = p.tid >> 3, c0 = (p.tid & 7) * 8;
    f32x4 s0 = (f32x4){0.f, 0.f, 0.f, 0.f}, s1 = s0;
    f32x4 n0[6], n1[6]; float dc[6];
#define GC_LD(q, n_) do { const int u_ = (chain_tb((n_), d) * 4 + h) * 2 + d; const float* k_ = WSP(float, SC_GLA_S) + (size_t)u_ * 4096 + dk * 64 + c0; \
        n0[q] = *(const f32x4*)k_; n1[q] = *(const f32x4*)(k_ + 4); dc[q] = WSP(float, SC_GLA_DEC)[(size_t)u_ * 64 + dk]; } while (0)
#define GC_ST(q, n_) do { const int u_ = (chain_tb((n_), d) * 4 + h) * 2 + d; float* k_ = WSP(float, SC_GLA_S) + (size_t)u_ * 4096 + dk * 64 + c0; \
        const f32x4 a0_ = n0[q], a1_ = n1[q]; const float de_ = dc[q]; if ((n_) + 6 < NTB) GC_LD(q, (n_) + 6); \
        *(f32x4*)k_ = s0; *(f32x4*)(k_ + 4) = s1; s0 = s0 * de_ + a0_; s1 = s1 * de_ + a1_; } while (0)
    GC_LD(0, 0); GC_LD(1, 1); GC_LD(2, 2); GC_LD(3, 3); GC_LD(4, 4); GC_LD(5, 5);
#pragma unroll 1
    for (int n = 0; n < NTB; n += 6) { GC_ST(0, n); GC_ST(1, n + 1); GC_ST(2, n + 2); GC_ST(3, n + 3); GC_ST(4, n + 4); GC_ST(5, n + 5); }
#undef GC_LD
#undef GC_ST
}
__device__ __forceinline__ void gla_p2(const Cx& p, LAS unsigned char* lds, int layer, int b) {
    const int tid = p.tid, lane = tid & 63, wave = __builtin_amdgcn_readfirstlane(tid >> 6), fr = lane & 15, fq = lane >> 4;
    LAS unsigned char* qt = lds; LAS unsigned char* kt = lds + 64 * TS; LAS unsigned char* vT = lds + 2 * 64 * TS; LAS unsigned char* sT = lds + 3 * 64 * TS; LAS unsigned char* att = lds + 4 * 64 * TS;
    LAS float* gs = (LAS float*)(lds + 5 * 64 * TS);
    const bf16_t* proj = WSP(bf16_t, WS_PROJ);
    UNIT_LOOP(u, NUNIT, 128) { const int tb = u >> 3, h = (u >> 1) & 3, d = u & 1; const int cl = tid & 63, tg = tid >> 6, c = 64 * h + cl;
        const int row0 = tb_row0(b, tb), s0 = 64 * tb; const bf16_t* pr0 = proj + (size_t)row0 * NPROJ;
        float w2[16];
#pragma unroll
        for (int r = 0; r < 16; ++r) w2[r] = PIN(I_GLA_W2)[((size_t)(layer * 2 + d) * 16 + r) * 256 + c];
        const float gb = PIN(I_GLA_B)[(layer * 2 + d) * 256 + c];
        float bl[8]; float run = 0.f;
#pragma unroll
        for (int ii = 0; ii < 8; ++ii) { const int i8 = d ? 7 - ii : ii; const bf16_t* pr = pr0 + (size_t)(8 * tg + i8) * NPROJ + (d ? PA_GB : PA_GF); float z = gb;
#pragma unroll
            for (int r = 0; r < 16; ++r) z += bf2f(pr[r]) * w2[r];
            run += logsigmoidf_(z) * (1.0f / 16.0f); if (d) bl[7 - ii] = run; else bl[ii] = run; }
        gs[tg * 64 + cl] = run;
        { const float* sp = WSP(float, SC_GLA_S) + (size_t)u * 4096;
#pragma unroll
          for (int q = 0; q < 8; ++q) { const int e = tid + NTHR * q, dk = e >> 6, dv = e & 63; *(LAS bf16_t*)(sT + dv * TS + dk * 2) = (bf16_t)f2bf(sp[e]); } }
        __syncthreads();
        float off = 0.f;
#pragma unroll
        for (int g2 = 0; g2 < 8; ++g2) if (d ? g2 > tg : g2 < tg) off += gs[g2 * 64 + cl];
#pragma unroll
        for (int i8 = 0; i8 < 8; ++i8) { const int i = 8 * tg + i8; const bf16_t* pr = pr0 + (size_t)i * NPROJ; const float bi = bl[i8] + off;
            *(LAS bf16_t*)(qt + i * TS + cl * 2) = (bf16_t)f2bf(bf2f(pr[PA_Q + c]) * 0.125f * __expf(bi));
            *(LAS bf16_t*)(kt + i * TS + cl * 2) = (bf16_t)f2bf(bf2f(pr[PA_K + c]) * __expf(-bi));
            *(LAS bf16_t*)(vT + cl * TS + i * 2) = pr[PA_V + c]; }
        __syncthreads();
        const int mt = wave >> 1, nt0 = (wave & 1) * 2;
        { f32x4 acc[2] = {(f32x4){0.f, 0.f, 0.f, 0.f}, (f32x4){0.f, 0.f, 0.f, 0.f}};
          mm_rows<64, 2>(qt, TS, kt, TS, mt, nt0, fr, fq, acc);
#pragma unroll
          for (int t = 0; t < 2; ++t)
#pragma unroll
              for (int j = 0; j < 4; ++j) { const int i = 16 * mt + 4 * fq + j, jj = 16 * (nt0 + t) + fr; const bool keep = d ? jj >= i : jj <= i;
                  *(LAS bf16_t*)(att + i * TS + jj * 2) = (bf16_t)f2bf(keep ? acc[t][j] : 0.f); } }
        __syncthreads();
        { f32x4 acc[2] = {(f32x4){0.f, 0.f, 0.f, 0.f}, (f32x4){0.f, 0.f, 0.f, 0.f}};
          mm_rows<64, 2>(att, TS, vT, TS, mt, nt0, fr, fq, acc);
          mm_rows<64, 2>(qt, TS, sT, TS, mt, nt0, fr, fq, acc);
          bf16_t* ob = WSP(bf16_t, d ? SC_OB : SC_OF);
#pragma unroll
          for (int t = 0; t < 2; ++t)
#pragma unroll
              for (int j = 0; j < 4; ++j) ob[(size_t)(s0 + 16 * mt + 4 * fq + j) * 1024 + 64 * h + 16 * (nt0 + t) + fr] = (bf16_t)f2bf(acc[t][j]); }
        __syncthreads();
    }
}
constexpr int TS2 = 272;
__device__ __forceinline__ float ssd_acum(float a, int d, int lane, float& total) {
    float pre = a;
#pragma unroll
    for (int o = 1; o < 64; o <<= 1) { const float t = shup_(pre, lane, o); if (lane >= o) pre += t; }
    total = rl(pre, 63);
    return d ? total - pre + a : pre;
}
__device__ __forceinline__ void ssd_p1(const Cx& p, LAS unsigned char* lds, int layer, int b) {
    const int tid = p.tid, lane = tid & 63, wave = __builtin_amdgcn_readfirstlane(tid >> 6), fr = lane & 15, fq = lane >> 4;
    LAS unsigned char* BT = lds; LAS unsigned char* xT = lds + 128 * TS; LAS float* AC = (LAS float*)(lds + 128 * TS + 4 * 64 * TS);
    UNIT_LOOP(u2, NTB * 2, 32) { const int tb = u2 >> 1, g = u2 & 1, s0 = 64 * tb;
        const bf16_t* sx = WSP(bf16_t, SC_SX) + (size_t)s0 * 768; const float* sdt = WSP(float, SC_SDT) + (size_t)s0 * 8;
        if (wave < 4) { const int hd = wave, h = 2 * g + (hd >> 1), d = hd & 1; const float aneg = -__expf(PIN(I_SS_ALOG)[(layer * 2 + d) * 4 + h]);
            float tot; const float ac = ssd_acum(aneg * sdt[lane * 8 + d * 4 + h], d, lane, tot); AC[hd * 64 + lane] = ac; if (lane == 0) { AC[256 + hd] = tot; WSP(float, SC_SSD_CD)[(tb * 4 + h) * 2 + d] = __expf(tot); } }
#pragma unroll 2
        for (int q = 0; q < 16; ++q) { const int e = tid + NTHR * q, i = e >> 7, s = e & 127; *(LAS bf16_t*)(BT + s * TS + i * 2) = sx[(size_t)i * 768 + 256 + 128 * g + s]; }
        __syncthreads();
#pragma unroll 2
        for (int q = 0; q < 32; ++q) { const int e = tid + NTHR * q, hd = e >> 12, i = (e >> 6) & 63, pp = e & 63, h = 2 * g + (hd >> 1), d = hd & 1;
            const float x = bf2f(sx[(size_t)i * 768 + 64 * h + pp]) * sdt[i * 8 + d * 4 + h] * __expf(AC[256 + hd] - AC[hd * 64 + i]);
            *(LAS bf16_t*)(xT + (hd * 64 + pp) * TS + i * 2) = (bf16_t)f2bf(x); }
        __syncthreads();
        { const int hd = wave >> 1, half = wave & 1, h = 2 * g + (hd >> 1), d = hd & 1; float* cs = WSP(float, SC_SSD_S) + (size_t)((tb * 4 + h) * 2 + d) * 8192;
#pragma unroll 1
          for (int mt = 0; mt < 4; ++mt) { f32x4 acc[4];
#pragma unroll
              for (int t = 0; t < 4; ++t) acc[t] = (f32x4){0.f, 0.f, 0.f, 0.f};
              mm_rows<64, 4>(xT + hd * 64 * TS, TS, BT, TS, mt, 4 * half, fr, fq, acc);
#pragma unroll
              for (int t = 0; t < 4; ++t)
#pragma unroll
                  for (int j = 0; j < 4; ++j) cs[(16 * mt + 4 * fq + j) * 128 + 16 * (4 * half + t) + fr] = acc[t][j]; } }
        __syncthreads();
    }
}
__device__ __forceinline__ void ssd_chain(const Cx& p, int h, int d) {
    const int e0 = p.tid * 16;
    f32x4 s[4]; f32x4 nx[6][4]; float cd[6];
#pragma unroll
    for (int k = 0; k < 4; ++k) s[k] = (f32x4){0.f, 0.f, 0.f, 0.f};
#define SC_LD(q, n_) do { const int u_ = (chain_tb((n_), d) * 4 + h) * 2 + d; const float* c_ = WSP(float, SC_SSD_S) + (size_t)u_ * 8192 + e0; \
        _Pragma("unroll") for (int k = 0; k < 4; ++k) nx[q][k] = *(const f32x4*)(c_ + 4 * k); cd[q] = WSP(float, SC_SSD_CD)[u_]; } while (0)
#define SC_ST(q, n_) do { const int u_ = (chain_tb((n_), d) * 4 + h) * 2 + d; float* c_ = WSP(float, SC_SSD_S) + (size_t)u_ * 8192 + e0; f32x4 a_[4]; const float de_ = cd[q]; \
        _Pragma("unroll") for (int k = 0; k < 4; ++k) a_[k] = nx[q][k]; if ((n_) + 6 < NTB) SC_LD(q, (n_) + 6); \
        _Pragma("unroll") for (int k = 0; k < 4; ++k) { *(f32x4*)(c_ + 4 * k) = s[k]; s[k] = s[k] * de_ + a_[k]; } } while (0)
    SC_LD(0, 0); SC_LD(1, 1); SC_LD(2, 2); SC_LD(3, 3); SC_LD(4, 4); SC_LD(5, 5);
#pragma unroll 1
    for (int n = 0; n < NTB; n += 6) { SC_ST(0, n); SC_ST(1, n + 1); SC_ST(2, n + 2); SC_ST(3, n + 3); SC_ST(4, n + 4); SC_ST(5, n + 5); }
#undef SC_LD
#undef SC_ST
}
__device__ __forceinline__ void ssd_p2(const Cx& p, LAS unsigned char* lds, int layer, int b) {
    const int tid = p.tid, lane = tid & 63, wave = __builtin_amdgcn_readfirstlane(tid >> 6), fr = lane & 15, fq = lane >> 4;
    LAS unsigned char* Ct = lds; LAS unsigned char* Bt2 = lds + 64 * TS2; LAS float* cb = (LAS float*)(lds + 2 * 64 * TS2); LAS float* AC = cb + 64 * 65;
    LAS unsigned char* Mt = (LAS unsigned char*)(AC + 260 + 4); LAS unsigned char* xT = Mt + 64 * TS; LAS unsigned char* Sb = xT + 64 * TS;
    const int mt = wave >> 1, nt0 = (wave & 1) * 2;
    UNIT_LOOP(u2, NTB * 2, 160) { const int tb = u2 >> 1, g = u2 & 1, s0 = 64 * tb;
        const bf16_t* sx = WSP(bf16_t, SC_SX) + (size_t)s0 * 768; const float* sdt = WSP(float, SC_SDT) + (size_t)s0 * 8;
        if (wave < 4) { const int hd = wave, h = 2 * g + (hd >> 1), d = hd & 1; const float aneg = -__expf(PIN(I_SS_ALOG)[(layer * 2 + d) * 4 + h]);
            float tot; const float ac = ssd_acum(aneg * sdt[lane * 8 + d * 4 + h], d, lane, tot); AC[hd * 64 + lane] = ac; }
#pragma unroll
        for (int q = 0; q < 2; ++q) { const int e = tid + NTHR * q, i = e >> 4, ch = e & 15;
            *(LAS u32x4*)(Ct + i * TS2 + ch * 16) = *(const u32x4*)(sx + (size_t)i * 768 + 512 + 128 * g + ch * 8);
            *(LAS u32x4*)(Bt2 + i * TS2 + ch * 16) = *(const u32x4*)(sx + (size_t)i * 768 + 256 + 128 * g + ch * 8); }
        __syncthreads();
        { f32x4 acc[2] = {(f32x4){0.f, 0.f, 0.f, 0.f}, (f32x4){0.f, 0.f, 0.f, 0.f}};
          mm_rows<128, 2>(Ct, TS2, Bt2, TS2, mt, nt0, fr, fq, acc);
#pragma unroll
          for (int t = 0; t < 2; ++t)
#pragma unroll
              for (int j = 0; j < 4; ++j) cb[(16 * mt + 4 * fq + j) * 65 + 16 * (nt0 + t) + fr] = acc[t][j]; }
        __syncthreads();
#pragma unroll 1
        for (int hd = 0; hd < 4; ++hd) { const int h = 2 * g + (hd >> 1), d = hd & 1;
            { const int i = tid >> 3, j0 = (tid & 7) * 8; const float ai = AC[hd * 64 + i]; unsigned w[4];
#pragma unroll
              for (int jj = 0; jj < 8; jj += 2) { float m[2];
#pragma unroll
                  for (int q = 0; q < 2; ++q) { const int j = j0 + jj + q; const bool keep = d ? j >= i : j <= i; m[q] = keep ? cb[i * 65 + j] * __expf(ai - AC[hd * 64 + j]) : 0.f; }
                  w[jj >> 1] = pk2(m[0], m[1]); }
              *(LAS u32x4*)(Mt + i * TS + j0 * 2) = (u32x4){w[0], w[1], w[2], w[3]}; }
#pragma unroll 2
            for (int q = 0; q < 8; ++q) { const int e = tid + NTHR * q, j = e >> 6, pp = e & 63;
                *(LAS bf16_t*)(xT + pp * TS + j * 2) = (bf16_t)f2bf(bf2f(sx[(size_t)j * 768 + 64 * h + pp]) * sdt[j * 8 + d * 4 + h]); }
            { const float* sp = WSP(float, SC_SSD_S) + (size_t)((tb * 4 + h) * 2 + d) * 8192;
#pragma unroll
              for (int q = 0; q < 4; ++q) { const int e = (tid + NTHR * q) * 4, pp = e >> 7, s = e & 127; const f32x4 v = *(const f32x4*)(sp + e);
                  *(LAS u32x2*)(Sb + pp * TS2 + s * 2) = (u32x2){pk2(v[0], v[1]), pk2(v[2], v[3])}; } }
            __syncthreads();
            { f32x4 acc[2] = {(f32x4){0.f, 0.f, 0.f, 0.f}, (f32x4){0.f, 0.f, 0.f, 0.f}};
              mm_rows<128, 2>(Ct, TS2, Sb, TS2, mt, nt0, fr, fq, acc);
#pragma unroll
              for (int j = 0; j < 4; ++j) { const float sc = __expf(AC[hd * 64 + 16 * mt + 4 * fq + j]); acc[0][j] *= sc; acc[1][j] *= sc; }
              mm_rows<64, 2>(Mt, TS, xT, TS, mt, nt0, fr, fq, acc);
              bf16_t* ob = WSP(bf16_t, d ? SC_OB : SC_OF);
#pragma unroll
              for (int t = 0; t < 2; ++t)
#pragma unroll
                  for (int j = 0; j < 4; ++j) ob[(size_t)(s0 + 16 * mt + 4 * fq + j) * 1024 + 512 + 64 * h + 16 * (nt0 + t) + fr] = (bf16_t)f2bf(acc[t][j]); }
            __syncthreads();
        }
    }
}
constexpr int AFS = 68;
#define DR_PIN16(x, b_) asm volatile("" : "+v"(x[(b_)+0]), "+v"(x[(b_)+1]), "+v"(x[(b_)+2]), "+v"(x[(b_)+3]), "+v"(x[(b_)+4]), "+v"(x[(b_)+5]), "+v"(x[(b_)+6]), "+v"(x[(b_)+7]), \
        "+v"(x[(b_)+8]), "+v"(x[(b_)+9]), "+v"(x[(b_)+10]), "+v"(x[(b_)+11]), "+v"(x[(b_)+12]), "+v"(x[(b_)+13]), "+v"(x[(b_)+14]), "+v"(x[(b_)+15]) :: "memory")
template <int J> __device__ __forceinline__ void dr_subst_step(float (&x)[64], const LAS float* AfT, const float sgn) {
    const float xj_ = sgn * x[J];
#pragma unroll
    for (int g_ = 0; g_ < 4; ++g_) if (16 * g_ + 15 > J) {
#pragma unroll
        for (int q_ = 0; q_ < 16; ++q_) if (16 * g_ + q_ > J) x[16 * g_ + q_] -= AfT[J * AFS + 16 * g_ + q_] * xj_;
        DR_PIN16(x, 16 * g_); }
    if constexpr (J + 1 < 63) dr_subst_step<J + 1>(x, AfT, sgn);
}
#define DR_SUBST(x, AfT, sgn) dr_subst_step<0>(x, AfT, sgn)
__device__ __forceinline__ int dr_mfrag_idx(int row, int col) { return (((row >> 4) * 2 + (col >> 5)) * 64 + ((col >> 2) & 3) * 16 + (row & 15)) * 8 + ((col >> 4) & 1) * 4 + (col & 3); }
template <class RhsF> __device__ __forceinline__ void dr_block_solve(const LAS unsigned char* Abf, const LAS float* AfT, LAS unsigned char* XT, LAS float* Dbuf, const float sgn, const int wave, const RhsF& rhs, bf16_t* wu) {
#pragma unroll 1
    for (int kb_ = 0; kb_ < 4; ++kb_) {
        { const int lane = lane_id_asm(), fr = lane & 15, fq = lane >> 4; f32x4 acc = (f32x4){0.f, 0.f, 0.f, 0.f};
          if (kb_ > 0) {
#pragma unroll
              for (int ks = 0; ks < 2; ++ks) { const bf16x8 a = *(const LAS bf16x8*)(Abf + (16 * kb_ + fr) * TS + ks * 64 + fq * 16), bb = *(const LAS bf16x8*)(XT + (16 * wave + fr) * TS + ks * 64 + fq * 16);
                  acc = __builtin_amdgcn_mfma_f32_16x16x32_bf16(a, bb, acc, 0, 0, 0); } }
          *(LAS f32x4*)(Dbuf + (16 * wave + fr) * 20 + 4 * fq) = acc; }
        __syncthreads();
        if (wave < 2) { const int col = wave * 64 + lane_id_asm(); float x[16];
#pragma unroll
            for (int i = 0; i < 16; ++i) x[i] = rhs(16 * kb_ + i, col) - sgn * Dbuf[col * 20 + i];
            const LAS float* Ab = AfT + (16 * kb_) * AFS + 16 * kb_;
#pragma unroll
            for (int j = 0; j < 15; ++j) { const float xj = sgn * x[j];
#pragma unroll
                for (int i = j + 1; i < 16; ++i) x[i] -= Ab[j * AFS + i] * xj; }
            u32x4 w0, w1;
#pragma unroll
            for (int q = 0; q < 4; ++q) { w0[q] = pk2(x[2 * q], x[2 * q + 1]); w1[q] = pk2(x[8 + 2 * q], x[8 + 2 * q + 1]); }
            *(LAS u32x4*)(XT + col * TS + (16 * kb_) * 2) = w0; *(LAS u32x4*)(XT + col * TS + (16 * kb_ + 8) * 2) = w1;
#pragma unroll
            for (int i = 0; i < 16; ++i) wu[(16 * kb_ + i) * 128 + col] = (bf16_t)f2bf(x[i]); }
        __syncthreads();
    }
}
struct GdnRhs { const LAS unsigned char* kb; const LAS unsigned char* vb; const LAS float* GC;
    __device__ __forceinline__ float operator()(int r, int col) const { return col < 64 ? bf2f(*(const LAS bf16_t*)(kb + r * TS + col * 2)) * __expf(GC[r]) : bf2f(*(const LAS bf16_t*)(vb + r * TS + (col - 64) * 2)); } };
__device__ __forceinline__ void gdn_p1(const Cx& p, LAS unsigned char* lds, int layer, int b) {
    const int wave = __builtin_amdgcn_readfirstlane(p.tid >> 6);
#define GDN_LANES const int lane = lane_id_asm(), tid = wave * 64 + lane, fr = lane & 15, fq = lane >> 4; (void)tid; (void)fr; (void)fq
    LAS unsigned char* kh = lds; LAS unsigned char* kb = lds + 64 * TS; LAS unsigned char* vb = lds + 2 * 64 * TS; LAS unsigned char* Abf = lds + 3 * 64 * TS; LAS unsigned char* kdT = lds + 4 * 64 * TS; LAS unsigned char* XT = lds + 5 * 64 * TS;
    LAS float* Af = (LAS float*)(lds + 7 * 64 * TS); LAS float* Dbuf = Af + 64 * AFS; LAS float* GC = Dbuf + 128 * 20;
    const int mt = wave >> 1, nt0 = (wave & 1) * 2;
    UNIT_LOOP(u, NUNIT, 64) { const int tb = u >> 3, h = (u >> 1) & 3, d = u & 1, s0 = 64 * tb;
        const bf16_t* dq = WSP(bf16_t, SC_DQ) + (size_t)s0 * 768; const float* dg = WSP(float, SC_DG) + (size_t)s0 * 16;
        if (wave == 0) { GDN_LANES; const int i = d ? 63 - lane : lane; float pre = dg[i * 16 + 8 + d * 4 + h];
#pragma unroll
            for (int o = 1; o < 64; o <<= 1) { const float t = shup_(pre, lane, o); if (lane >= o) pre += t; }
            GC[lane] = pre; }
        { GDN_LANES; const int r = tid >> 3, c0 = (tid & 7) * 8, i = d ? 63 - r : r; const float beta = dg[i * 16 + d * 4 + h];
          const u32x4 kv = *(const u32x4*)(dq + (size_t)i * 768 + 256 + 64 * h + c0), vv = *(const u32x4*)(dq + (size_t)i * 768 + 512 + 64 * h + c0); u32x4 kw, vw;
#pragma unroll
          for (int q = 0; q < 4; ++q) { kw[q] = pk2(__uint_as_float(kv[q] << 16) * beta, __uint_as_float(kv[q] & 0xffff0000u) * beta); vw[q] = pk2(__uint_as_float(vv[q] << 16) * beta, __uint_as_float(vv[q] & 0xffff0000u) * beta); }
          *(LAS u32x4*)(kh + r * TS + c0 * 2) = kv; *(LAS u32x4*)(kb + r * TS + c0 * 2) = kw; *(LAS u32x4*)(vb + r * TS + c0 * 2) = vw;
          *(LAS u32x4*)(XT + (2 * r) * TS + c0 * 2) = (u32x4){0u, 0u, 0u, 0u}; *(LAS u32x4*)(XT + (2 * r + 1) * TS + c0 * 2) = (u32x4){0u, 0u, 0u, 0u}; }
        __syncthreads();
        const float gtot = GC[63];
        { GDN_LANES; f32x4 acc[2] = {(f32x4){0.f, 0.f, 0.f, 0.f}, (f32x4){0.f, 0.f, 0.f, 0.f}};
          mm_rows<64, 2>(kb, TS, kh, TS, mt, nt0, fr, fq, acc);
#pragma unroll
          for (int t = 0; t < 2; ++t)
#pragma unroll
              for (int j = 0; j < 4; ++j) { const int r = 16 * mt + 4 * fq + j, jj = 16 * (nt0 + t) + fr; const float a = jj < r ? acc[t][j] * __expf(GC[r] - GC[jj]) : 0.f;
                  Af[jj * AFS + r] = a; *(LAS bf16_t*)(Abf + r * TS + jj * 2) = (bf16_t)f2bf(a); }
#pragma unroll 2
          for (int q = 0; q < 8; ++q) { const int e = tid + NTHR * q, r = e >> 6, cc = e & 63;
              *(LAS bf16_t*)(kdT + cc * TS + r * 2) = (bf16_t)f2bf(bf2f(*(const LAS bf16_t*)(kh + r * TS + cc * 2)) * __expf(gtot - GC[r])); } }
        __syncthreads();
        { const GdnRhs rhs{kb, vb, GC}; dr_block_solve(Abf, Af, XT, Dbuf, 1.0f, wave, rhs, WSP(bf16_t, SC_DR_WU) + (size_t)u * 8192); }
        { GDN_LANES; f32x4 am[2] = {(f32x4){0.f, 0.f, 0.f, 0.f}, (f32x4){0.f, 0.f, 0.f, 0.f}}, an[2] = {(f32x4){0.f, 0.f, 0.f, 0.f}, (f32x4){0.f, 0.f, 0.f, 0.f}};
          mm_rows<64, 2>(kdT, TS, XT, TS, mt, nt0, fr, fq, am);
          mm_rows<64, 2>(kdT, TS, XT + 64 * TS, TS, mt, nt0, fr, fq, an);
          bf16_t* Mg = WSP(bf16_t, SC_DR_M) + (size_t)u * 4096; bf16_t* Ng = WSP(bf16_t, SC_DR_NS) + (size_t)u * 4096; const float eg = __expf(gtot);
#pragma unroll
          for (int t = 0; t < 2; ++t) {
#pragma unroll
              for (int j = 0; j < 4; ++j) { const int row = 16 * mt + 4 * fq + j, col = 16 * (nt0 + t) + fr; Mg[dr_mfrag_idx(row, col)] = (bf16_t)f2bf((row == col ? eg : 0.f) - am[t][j]); }
              *(u32x2*)(Ng + (((nt0 + t) * 4 + mt) * 64 + lane) * 4) = (u32x2){pk2(an[t][0], an[t][1]), pk2(an[t][2], an[t][3])}; } }
        __syncthreads();
    }
#undef GDN_LANES
}
__device__ __forceinline__ void dr_chain(const Cx& p, size_t offM, size_t offNS, int h, int d) {
    const int lane = p.tid & 63, cb = __builtin_amdgcn_readfirstlane(p.tid >> 6), fr = lane & 15, fq = lane >> 4;
    if (cb >= 4) return;
    f32x4 acc[4];
#pragma unroll
    for (int t = 0; t < 4; ++t) acc[t] = (f32x4){0.f, 0.f, 0.f, 0.f};
    bf16x8 mR[4][4][2]; u32x2 nR[4][4];
#define DR_LD(m, nn, n_) do { const int u_ = (chain_tb((n_), d) * 4 + h) * 2 + d; const bf16_t* M_ = WSP(bf16_t, offM) + (size_t)u_ * 4096; const bf16_t* N_ = WSP(bf16_t, offNS) + (size_t)u_ * 4096; \
        _Pragma("unroll") for (int t = 0; t < 4; ++t) { _Pragma("unroll") for (int ks = 0; ks < 2; ++ks) m[t][ks] = *(const bf16x8*)(M_ + ((t * 2 + ks) * 64 + lane) * 8); nn[t] = *(const u32x2*)(N_ + ((cb * 4 + t) * 64 + lane) * 4); } } while (0)
#define DR_STEP(m, nn, n_) do { const int u_ = (chain_tb((n_), d) * 4 + h) * 2 + d; bf16_t* ST_ = WSP(bf16_t, offNS) + (size_t)u_ * 4096 + (16 * cb + fr) * 64 + 4 * fq; \
        u32x2 sp_[4]; _Pragma("unroll") for (int t = 0; t < 4; ++t) { sp_[t] = (u32x2){pk2(acc[t][0], acc[t][1]), pk2(acc[t][2], acc[t][3])}; *(u32x2*)(ST_ + 16 * t) = sp_[t]; } \
        bf16x8 bf_[2]; _Pragma("unroll") for (int ks = 0; ks < 2; ++ks) { u32x4 w_ = (u32x4){sp_[2 * ks][0], sp_[2 * ks][1], sp_[2 * ks + 1][0], sp_[2 * ks + 1][1]}; bf_[ks] = __builtin_bit_cast(bf16x8, w_); } \
        _Pragma("unroll") for (int t = 0; t < 4; ++t) { f32x4 a_ = (f32x4){__uint_as_float(nn[t][0] << 16), __uint_as_float(nn[t][0] & 0xffff0000u), __uint_as_float(nn[t][1] << 16), __uint_as_float(nn[t][1] & 0xffff0000u)}; \
            a_ = __builtin_amdgcn_mfma_f32_16x16x32_bf16(m[t][0], bf_[0], a_, 0, 0, 0); acc[t] = __builtin_amdgcn_mfma_f32_16x16x32_bf16(m[t][1], bf_[1], a_, 0, 0, 0); } } while (0)
#define DR_GO(q, n_) do { DR_STEP(mR[q], nR[q], (n_)); if ((n_) + 4 < NTB) DR_LD(mR[q], nR[q], (n_) + 4); } while (0)
    DR_LD(mR[0], nR[0], 0); DR_LD(mR[1], nR[1], 1); DR_LD(mR[2], nR[2], 2); DR_LD(mR[3], nR[3], 3);
#pragma unroll 1
    for (int n = 0; n < NTB; n += 4) { DR_GO(0, n); DR_GO(1, n + 1); DR_GO(2, n + 2); DR_GO(3, n + 3); }
#undef DR_GO
#undef DR_LD
#undef DR_STEP
}
__device__ __forceinline__ void gdn_p2(const Cx& p, LAS unsigned char* lds, int layer, int b) {
    const int tid = p.tid, lane = tid & 63, wave = __builtin_amdgcn_readfirstlane(tid >> 6), fr = lane & 15, fq = lane >> 4;
    LAS unsigned char* qh = lds; LAS unsigned char* kh = lds + 64 * TS; LAS unsigned char* wt = lds + 2 * 64 * TS; LAS unsigned char* sT = lds + 3 * 64 * TS; LAS unsigned char* aq = lds + 4 * 64 * TS; LAS unsigned char* vnT = lds + 5 * 64 * TS;
    LAS float* GC = (LAS float*)(lds + 6 * 64 * TS);
    const int mt = wave >> 1, nt0 = (wave & 1) * 2;
    UNIT_LOOP(u, NUNIT, 192) { const int tb = u >> 3, h = (u >> 1) & 3, d = u & 1, s0 = 64 * tb;
        const bf16_t* dq = WSP(bf16_t, SC_DQ) + (size_t)s0 * 768; const float* dg = WSP(float, SC_DG) + (size_t)s0 * 16;
        const bf16_t* wu = WSP(bf16_t, SC_DR_WU) + (size_t)u * 8192; const bf16_t* st = WSP(bf16_t, SC_DR_NS) + (size_t)u * 4096;
        if (wave == 0) { const int i = d ? 63 - lane : lane; float pre = dg[i * 16 + 8 + d * 4 + h];
#pragma unroll
            for (int o = 1; o < 64; o <<= 1) { const float t = shup_(pre, lane, o); if (lane >= o) pre += t; }
            GC[lane] = pre; }
        { const int r = tid >> 3, c0 = (tid & 7) * 8, i = d ? 63 - r : r;
          *(LAS u32x4*)(qh + r * TS + c0 * 2) = *(const u32x4*)(dq + (size_t)i * 768 + 64 * h + c0);
          *(LAS u32x4*)(kh + r * TS + c0 * 2) = *(const u32x4*)(dq + (size_t)i * 768 + 256 + 64 * h + c0);
          *(LAS u32x4*)(wt + r * TS + c0 * 2) = *(const u32x4*)(wu + r * 128 + c0);
          *(LAS u32x4*)(sT + r * TS + c0 * 2) = *(const u32x4*)(st + r * 64 + c0); }
        __syncthreads();
        { f32x4 acc[2] = {(f32x4){0.f, 0.f, 0.f, 0.f}, (f32x4){0.f, 0.f, 0.f, 0.f}};
          mm_rows<64, 2>(qh, TS, kh, TS, mt, nt0, fr, fq, acc);
#pragma unroll
          for (int t = 0; t < 2; ++t)
#pragma unroll
              for (int j = 0; j < 4; ++j) { const int r = 16 * mt + 4 * fq + j, jj = 16 * (nt0 + t) + fr; *(LAS bf16_t*)(aq + r * TS + jj * 2) = (bf16_t)f2bf(jj <= r ? acc[t][j] * __expf(GC[r] - GC[jj]) : 0.f); }
          f32x4 av[2] = {(f32x4){0.f, 0.f, 0.f, 0.f}, (f32x4){0.f, 0.f, 0.f, 0.f}};
          mm_rows<64, 2>(wt, TS, sT, TS, mt, nt0, fr, fq, av);
#pragma unroll
          for (int t = 0; t < 2; ++t) { const int dv = 16 * (nt0 + t) + fr; float vn[4];
#pragma unroll
              for (int j = 0; j < 4; ++j) vn[j] = bf2f(wu[(16 * mt + 4 * fq + j) * 128 + 64 + dv]) - av[t][j];
              *(LAS u32x2*)(vnT + dv * TS + (16 * mt + 4 * fq) * 2) = (u32x2){pk2(vn[0], vn[1]), pk2(vn[2], vn[3])}; } }
        __syncthreads();
        { f32x4 acc[2] = {(f32x4){0.f, 0.f, 0.f, 0.f}, (f32x4){0.f, 0.f, 0.f, 0.f}};
          mm_rows<64, 2>(qh, TS, sT, TS, mt, nt0, fr, fq, acc);
#pragma unroll
          for (int j = 0; j < 4; ++j) { const float sc = __expf(GC[16 * mt + 4 * fq + j]); acc[0][j] *= sc; acc[1][j] *= sc; }
          mm_rows<64, 2>(aq, TS, vnT, TS, mt, nt0, fr, fq, acc);
          bf16_t* ob = WSP(bf16_t, d ? SC_OB : SC_OF);
#pragma unroll
          for (int t = 0; t < 2; ++t)
#pragma unroll
              for (int j = 0; j < 4; ++j) { const int r = 16 * mt + 4 * fq + j, i = d ? 63 - r : r; ob[(size_t)(s0 + i) * 1024 + 768 + 64 * h + 16 * (nt0 + t) + fr] = (bf16_t)f2bf(acc[t][j]); } }
        __syncthreads();
    }
}
constexpr int LPS = 65;
#define RW_LP(LP, GS, lwp) do { const int lane_ = lane_id_asm(), c_ = lane_, tg_ = wave; float loc_[8]; float run_ = 0.f; \
        _Pragma("unroll") for (int ii = 0; ii < 8; ++ii) { const int r_ = 8 * tg_ + ii; run_ += (lwp)[(size_t)(d ? 63 - r_ : r_) * 256 + c_]; loc_[ii] = run_; } \
        (GS)[tg_ * 64 + c_] = run_; __syncthreads(); float off_ = 0.f; \
        _Pragma("unroll") for (int g2 = 0; g2 < 8; ++g2) if (g2 < tg_) off_ += (GS)[g2 * 64 + c_]; \
        _Pragma("unroll") for (int ii = 0; ii < 8; ++ii) (LP)[(8 * tg_ + ii) * LPS + c_] = loc_[ii] + off_; __syncthreads(); } while (0)
struct RwRhs { const LAS unsigned char* zt; const LAS unsigned char* RU;
    __device__ __forceinline__ float operator()(int r, int col) const { return col < 64 ? bf2f(*(const LAS bf16_t*)(zt + r * TS + col * 2)) : bf2f(*(const LAS bf16_t*)(RU + (col - 64) * TS + r * 2)); } };
__device__ __forceinline__ void rw_p1(const Cx& p, LAS unsigned char* lds, int layer, int b) {
    const int wave = __builtin_amdgcn_readfirstlane(p.tid >> 6), mt = wave >> 1, nt0 = (wave & 1) * 2;
#define RW_LANES const int lane = lane_id_asm(), tid = wave * 64 + lane, fr = lane & 15, fq = lane >> 4; (void)tid; (void)fr; (void)fq
    LAS float* LP = (LAS float*)lds; LAS float* GS = (LAS float*)(lds + 16640);
    LAS unsigned char* zt = lds + 18688; LAS unsigned char* bt = lds + 27904; LAS unsigned char* kt = lds + 37120; LAS unsigned char* vT = lds + 46336; LAS unsigned char* Azk = lds + 55552;
    LAS float* Af = (LAS float*)(lds + 64768); LAS unsigned char* XT = lds + 82176; LAS unsigned char* Abf = lds + 100608; LAS unsigned char* RU = lds + 109824; LAS float* Dbuf = (LAS float*)(lds + 119040);
    const bf16_t* proj = WSP(bf16_t, WS_PROJ);
    UNIT_LOOP(u, NUNIT, 96) { const int tb = u >> 3, h = (u >> 1) & 3, d = u & 1, s0 = 64 * tb;
        const float* lwp = WSP(float, SC_RLW) + (size_t)d * SB * 256 + (size_t)s0 * 256 + 64 * h; const float* rk = WSP(float, SC_RK) + (size_t)s0 * 256 + 64 * h;
        const float* rkk = WSP(float, SC_RKK) + (size_t)s0 * 256 + 64 * h; const float* rb = WSP(float, SC_RB) + (size_t)s0 * 256 + 64 * h;
        const bf16_t* pr0 = proj + (size_t)tb_row0(b, tb) * NPROJ;
        RW_LP(LP, GS, lwp);
        { RW_LANES; const int r = tid >> 3, c0 = (tid & 7) * 8, i = d ? 63 - r : r; unsigned wz[4], wb[4], wk[4];
#pragma unroll
          for (int q = 0; q < 8; q += 2) { float z2[2], b2[2], k2[2];
#pragma unroll
              for (int e = 0; e < 2; ++e) { const int c = c0 + q + e; const float lp = LP[r * LPS + c], lw = lwp[(size_t)i * 256 + c], em = __expf(-lp);
                  z2[e] = -rkk[(size_t)i * 256 + c] * __expf(lp - lw); b2[e] = rb[(size_t)i * 256 + c] * em; k2[e] = rk[(size_t)i * 256 + c] * em; }
              wz[q >> 1] = pk2(z2[0], z2[1]); wb[q >> 1] = pk2(b2[0], b2[1]); wk[q >> 1] = pk2(k2[0], k2[1]); }
          *(LAS u32x4*)(zt + r * TS + c0 * 2) = (u32x4){wz[0], wz[1], wz[2], wz[3]}; *(LAS u32x4*)(bt + r * TS + c0 * 2) = (u32x4){wb[0], wb[1], wb[2], wb[3]}; *(LAS u32x4*)(kt + r * TS + c0 * 2) = (u32x4){wk[0], wk[1], wk[2], wk[3]};
          *(LAS u32x4*)(XT + (2 * r) * TS + c0 * 2) = (u32x4){0u, 0u, 0u, 0u}; *(LAS u32x4*)(XT + (2 * r + 1) * TS + c0 * 2) = (u32x4){0u, 0u, 0u, 0u};
#pragma unroll 2
          for (int q = 0; q < 8; ++q) { const int e = tid + NTHR * q, r2 = e >> 6, cc = e & 63; *(LAS bf16_t*)(vT + cc * TS + r2 * 2) = pr0[(size_t)(d ? 63 - r2 : r2) * NPROJ + PB_V + 64 * h + cc]; } }
        __syncthreads();
        { RW_LANES; f32x4 a1[2] = {(f32x4){0.f, 0.f, 0.f, 0.f}, (f32x4){0.f, 0.f, 0.f, 0.f}}, a2[2] = {(f32x4){0.f, 0.f, 0.f, 0.f}, (f32x4){0.f, 0.f, 0.f, 0.f}};
          mm_rows<64, 2>(zt, TS, bt, TS, mt, nt0, fr, fq, a1);
          mm_rows<64, 2>(zt, TS, kt, TS, mt, nt0, fr, fq, a2);
#pragma unroll
          for (int t = 0; t < 2; ++t)
#pragma unroll
              for (int j = 0; j < 4; ++j) { const int r = 16 * mt + 4 * fq + j, jj = 16 * (nt0 + t) + fr; const float a = jj < r ? a1[t][j] : 0.f;
                  Af[jj * AFS + r] = a; *(LAS bf16_t*)(Abf + r * TS + jj * 2) = (bf16_t)f2bf(a); *(LAS bf16_t*)(Azk + r * TS + jj * 2) = (bf16_t)f2bf(jj < r ? a2[t][j] : 0.f); } }
        __syncthreads();
        { RW_LANES; f32x4 a[2] = {(f32x4){0.f, 0.f, 0.f, 0.f}, (f32x4){0.f, 0.f, 0.f, 0.f}};
          mm_rows<64, 2>(Azk, TS, vT, TS, mt, nt0, fr, fq, a);
#pragma unroll
          for (int t = 0; t < 2; ++t) *(LAS u32x2*)(RU + (16 * (nt0 + t) + fr) * TS + (16 * mt + 4 * fq) * 2) = (u32x2){pk2(a[t][0], a[t][1]), pk2(a[t][2], a[t][3])};
#pragma unroll 2
          for (int q = 0; q < 8; ++q) { const int e = tid + NTHR * q, r2 = e >> 6, cc = e & 63, i2 = d ? 63 - r2 : r2; const float ed = __expf(LP[63 * LPS + cc] - LP[r2 * LPS + cc]);
              *(LAS bf16_t*)(bt + cc * TS + r2 * 2) = (bf16_t)f2bf(rb[(size_t)i2 * 256 + cc] * ed); *(LAS bf16_t*)(kt + cc * TS + r2 * 2) = (bf16_t)f2bf(rk[(size_t)i2 * 256 + cc] * ed); } }
        __syncthreads();
        { const RwRhs rhs{zt, RU}; dr_block_solve(Abf, Af, XT, Dbuf, -1.0f, wave, rhs, WSP(bf16_t, SC_RW_WU) + (size_t)u * 8192); }
        { RW_LANES; f32x4 am[2] = {(f32x4){0.f, 0.f, 0.f, 0.f}, (f32x4){0.f, 0.f, 0.f, 0.f}}, an[2] = {(f32x4){0.f, 0.f, 0.f, 0.f}, (f32x4){0.f, 0.f, 0.f, 0.f}};
          mm_rows<64, 2>(bt, TS, XT, TS, mt, nt0, fr, fq, am);
          mm_rows<64, 2>(bt, TS, XT + 64 * TS, TS, mt, nt0, fr, fq, an);
          mm_rows<64, 2>(kt, TS, vT, TS, mt, nt0, fr, fq, an);
          bf16_t* Mg = WSP(bf16_t, SC_RW_M) + (size_t)u * 4096; bf16_t* Ng = WSP(bf16_t, SC_RW_NS) + (size_t)u * 4096;
#pragma unroll
          for (int t = 0; t < 2; ++t) {
#pragma unroll
              for (int j = 0; j < 4; ++j) { const int row = 16 * mt + 4 * fq + j, col = 16 * (nt0 + t) + fr; Mg[dr_mfrag_idx(row, col)] = (bf16_t)f2bf((row == col ? __expf(LP[63 * LPS + row]) : 0.f) + am[t][j]); }
              *(u32x2*)(Ng + (((nt0 + t) * 4 + mt) * 64 + lane) * 4) = (u32x2){pk2(an[t][0], an[t][1]), pk2(an[t][2], an[t][3])}; } }
        __syncthreads();
    }
}
__device__ __forceinline__ void rw_p2(const Cx& p, LAS unsigned char* lds, int layer, int b) {
    const int wave = __builtin_amdgcn_readfirstlane(p.tid >> 6), mt = wave >> 1, nt0 = (wave & 1) * 2;
    LAS float* LP = (LAS float*)lds; LAS float* GS = (LAS float*)(lds + 16640);
    LAS unsigned char* rt = lds + 18688; LAS unsigned char* bt = lds + 27904; LAS unsigned char* kt = lds + 37120; LAS unsigned char* vT = lds + 46336; LAS unsigned char* sT = lds + 55552; LAS unsigned char* wt = lds + 64768;
    LAS unsigned char* Arb = lds + 73984; LAS unsigned char* Ark = lds + 83200; LAS unsigned char* UT = lds + 92416;
    const bf16_t* proj = WSP(bf16_t, WS_PROJ);
    UNIT_LOOP(u, NUNIT, 224) { const int tb = u >> 3, h = (u >> 1) & 3, d = u & 1, s0 = 64 * tb;
        const float* lwp = WSP(float, SC_RLW) + (size_t)d * SB * 256 + (size_t)s0 * 256 + 64 * h; const float* rk = WSP(float, SC_RK) + (size_t)s0 * 256 + 64 * h; const float* rb = WSP(float, SC_RB) + (size_t)s0 * 256 + 64 * h;
        const bf16_t* pr0 = proj + (size_t)tb_row0(b, tb) * NPROJ; const bf16_t* wu = WSP(bf16_t, SC_RW_WU) + (size_t)u * 8192; const bf16_t* st = WSP(bf16_t, SC_RW_NS) + (size_t)u * 4096;
        RW_LP(LP, GS, lwp);
        { RW_LANES; const int r = tid >> 3, c0 = (tid & 7) * 8, i = d ? 63 - r : r; unsigned wr[4], wb[4], wk[4];
          const u32x4 rv = *(const u32x4*)(pr0 + (size_t)i * NPROJ + PB_R + 64 * h + c0);
#pragma unroll
          for (int q = 0; q < 8; q += 2) { float r2[2], b2[2], k2[2];
#pragma unroll
              for (int e = 0; e < 2; ++e) { const int c = c0 + q + e; const float lp = LP[r * LPS + c], em = __expf(-lp); const unsigned w = rv[q >> 1];
                  r2[e] = (e ? __uint_as_float(w & 0xffff0000u) : __uint_as_float(w << 16)) * __expf(lp); b2[e] = rb[(size_t)i * 256 + c] * em; k2[e] = rk[(size_t)i * 256 + c] * em; }
              wr[q >> 1] = pk2(r2[0], r2[1]); wb[q >> 1] = pk2(b2[0], b2[1]); wk[q >> 1] = pk2(k2[0], k2[1]); }
          *(LAS u32x4*)(rt + r * TS + c0 * 2) = (u32x4){wr[0], wr[1], wr[2], wr[3]}; *(LAS u32x4*)(bt + r * TS + c0 * 2) = (u32x4){wb[0], wb[1], wb[2], wb[3]}; *(LAS u32x4*)(kt + r * TS + c0 * 2) = (u32x4){wk[0], wk[1], wk[2], wk[3]};
          *(LAS u32x4*)(wt + r * TS + c0 * 2) = *(const u32x4*)(wu + r * 128 + c0);
          *(LAS u32x4*)(sT + r * TS + c0 * 2) = *(const u32x4*)(st + r * 64 + c0);
#pragma unroll 2
          for (int q = 0; q < 8; ++q) { const int e = tid + NTHR * q, r2 = e >> 6, cc = e & 63; *(LAS bf16_t*)(vT + cc * TS + r2 * 2) = pr0[(size_t)(d ? 63 - r2 : r2) * NPROJ + PB_V + 64 * h + cc]; } }
        __syncthreads();
        { RW_LANES; f32x4 a1[2] = {(f32x4){0.f, 0.f, 0.f, 0.f}, (f32x4){0.f, 0.f, 0.f, 0.f}}, a2[2] = {(f32x4){0.f, 0.f, 0.f, 0.f}, (f32x4){0.f, 0.f, 0.f, 0.f}}, a3[2] = {(f32x4){0.f, 0.f, 0.f, 0.f}, (f32x4){0.f, 0.f, 0.f, 0.f}};
          mm_rows<64, 2>(rt, TS, bt, TS, mt, nt0, fr, fq, a1); mm_rows<64, 2>(rt, TS, kt, TS, mt, nt0, fr, fq, a2); mm_rows<64, 2>(wt, TS, sT, TS, mt, nt0, fr, fq, a3);
#pragma unroll
          for (int t = 0; t < 2; ++t) { const int dv = 16 * (nt0 + t) + fr; float uu[4];
#pragma unroll
              for (int j = 0; j < 4; ++j) { const int r = 16 * mt + 4 * fq + j, jj = dv; const bool keep = jj <= r;
                  *(LAS bf16_t*)(Arb + r * TS + jj * 2) = (bf16_t)f2bf(keep ? a1[t][j] : 0.f); *(LAS bf16_t*)(Ark + r * TS + jj * 2) = (bf16_t)f2bf(keep ? a2[t][j] : 0.f);
                  uu[j] = bf2f(wu[r * 128 + 64 + dv]) + a3[t][j]; }
              *(LAS u32x2*)(UT + dv * TS + (16 * mt + 4 * fq) * 2) = (u32x2){pk2(uu[0], uu[1]), pk2(uu[2], uu[3])}; } }
        __syncthreads();
        { RW_LANES; f32x4 acc[2] = {(f32x4){0.f, 0.f, 0.f, 0.f}, (f32x4){0.f, 0.f, 0.f, 0.f}};
          mm_rows<64, 2>(rt, TS, sT, TS, mt, nt0, fr, fq, acc); mm_rows<64, 2>(Arb, TS, UT, TS, mt, nt0, fr, fq, acc); mm_rows<64, 2>(Ark, TS, vT, TS, mt, nt0, fr, fq, acc);
          bf16_t* ob = WSP(bf16_t, d ? SC_OB : SC_OF);
#pragma unroll
          for (int t = 0; t < 2; ++t)
#pragma unroll
              for (int j = 0; j < 4; ++j) { const int r = 16 * mt + 4 * fq + j, i = d ? 63 - r : r; ob[(size_t)(s0 + i) * 1024 + 256 + 64 * h + 16 * (nt0 + t) + fr] = (bf16_t)f2bf(acc[t][j]); } }
        __syncthreads();
    }
#undef RW_LANES
}
__device__ __forceinline__ void phase_scan(const Cx& p, int layer, int b) {
    for (int ch = p.bid; ch < 32; ch += p.G) { const int mixer = ch >> 3, h = (ch >> 1) & 3, d = ch & 1;
        if (mixer == 0) gla_chain(p, h, d);
        else if (mixer == 1) dr_chain(p, SC_RW_M, SC_RW_NS, h, d);
        else if (mixer == 2) ssd_chain(p, h, d);
        else dr_chain(p, SC_DR_M, SC_DR_NS, h, d); }
}
#ifndef MK_ONE_LAUNCH
#define MK_ONE_LAUNCH 1
#endif
#ifndef MK_T1
#define MK_T1 0
#define MK_T2 0
#define MK_TMAX1 10000.0f
#define MK_TMAX2 10000.0f
#endif
constexpr int PH_PER_LAYER = 2 + 5 * NB + 7;
constexpr int N_PHASES = 1 + NL * PH_PER_LAYER + 1;

__global__ void __launch_bounds__(NTHR, 2) mega_fwd(Params pp) {
    extern __shared__ __attribute__((aligned(16))) unsigned char lds_raw[];
    LAS unsigned char* lds = (LAS unsigned char*)lds_raw;
    const int swave = __builtin_amdgcn_readfirstlane(threadIdx.x >> 6);
    for (int i = threadIdx.x; i < (LDS_BYTES - LDS_CTL) / 4; i += NTHR) ((LAS unsigned*)(lds + LDS_CTL))[i] = 0u;
    __syncthreads();
    if (threadIdx.x < N_IN + 2) { const unsigned long long a = threadIdx.x < N_IN ? (unsigned long long)pp.in[threadIdx.x] : (threadIdx.x == N_IN ? (unsigned long long)pp.out : (unsigned long long)pp.ws); ((LAS unsigned*)(lds + LDS_PTRS))[2 * threadIdx.x] = (unsigned)a; ((LAS unsigned*)(lds + LDS_PTRS))[2 * threadIdx.x + 1] = (unsigned)(a >> 32); }
    __syncthreads();
    XcdBarrier bar = xcd_barrier_post((unsigned*)(pp.ws + WS_CTL) + CW_BAR + pp.li * XCD_BAR_WORDS, (volatile LAS unsigned*)(lds + LDS_CTL), threadIdx.x);
    LAS int* tb = (LAS int*)(lds + LDS_CTL + 64);
    int pc = 0; const int lo = pp.lo, hi = pp.hi;
#define PH_BEGIN if (pc >= lo && pc < hi) { Cx p; p.out = (float*)PIN(N_IN); p.ws = (unsigned char*)PIN(N_IN + 1); p.tid = swave * 64 + lane_id_asm(); p.bid = blockIdx.x; p.G = gridDim.x; p.pad = 0; asm volatile("" : "+s"(p.out), "+s"(p.ws), "+v"(p.tid), "+s"(p.bid), "+s"(p.G)); const int G = p.G, bid = p.bid; (void)G; (void)bid; if ((MK_T1 | MK_T2) && p.bid == 0 && p.tid == 0) __hip_atomic_store(WSP(unsigned, WS_CTL) + 2048 + pc, (unsigned)__builtin_amdgcn_s_memrealtime(), __ATOMIC_RELAXED, __HIP_MEMORY_SCOPE_AGENT);
#define PH_END if (pc + 1 < hi) { XcdBarrier b2 = bar; asm volatile("" : "+s"(b2.bar), "+s"(b2.x)); xcd_barrier(b2, (unsigned)(swave * 64 + lane_id_asm())); } } ++pc;

    PH_BEGIN
        for (int u = bid; u < CONV_A_UNITS; u += G) conv_unit_A(p, (LAS float*)lds, u);
        __syncthreads();
        phase_mod(p, lds);
    PH_END

#pragma unroll
    for (int layer = 0; layer < NL; ++layer) {
        const int row_lo = layer == NL - 1 ? CROWS : 0;
        PH_BEGIN phase_norm1(p, layer); PH_END
        PH_BEGIN
            DenseSched S; S.init(ROWS, NPROJ, D, WSP(bf16_t, WS_WIN) + (size_t)layer * NPROJ * D, G, bid);
            EpiProj E{WSP(bf16_t, WS_PROJ), NPROJ};
            pg8::gemm_phase<D>(p.tid, lds, (const char*)WSP(bf16_t, WS_HBUF), S, E);
        PH_END
#pragma unroll 1
        for (int b = 0; b < NB; ++b) {
            PH_BEGIN phase_prep(p, lds, layer, b); PH_END
            PH_BEGIN gla_p1(p, lds, layer, b); __syncthreads(); ssd_p1(p, lds, layer, b); __syncthreads(); gdn_p1(p, lds, layer, b); __syncthreads(); rw_p1(p, lds, layer, b); PH_END
            PH_BEGIN phase_scan(p, layer, b); PH_END
            PH_BEGIN gla_p2(p, lds, layer, b); __syncthreads(); ssd_p2(p, lds, layer, b); __syncthreads(); gdn_p2(p, lds, layer, b); __syncthreads(); rw_p2(p, lds, layer, b); PH_END
            PH_BEGIN phase_post(p, layer, b); PH_END
        }
        PH_BEGIN
            DenseSched S; S.init(ROWS, D, D, WSP(bf16_t, WS_WOUT) + (size_t)layer * D * D, G, bid);
            EpiRes E{layer == 0 ? PIN(I_X) : (const float*)p.out, layer == 0 ? PIN(I_CTX) : (const float*)WSP(float, WS_CTXRES), p.out, WSP(float, WS_CTXRES), WSP(float, WS_MOD) + (size_t)layer * 5 * 6144 + 2048};
            pg8::gemm_phase<D>(p.tid, lds, (const char*)WSP(bf16_t, WS_HBUF), S, E);
        PH_END
        PH_BEGIN phase_norm2(p, lds, layer, row_lo);
            __syncthreads();
            for (int u = bid; u < CONV_E_UNITS; u += G) conv_unit_E(p, (LAS float*)lds, layer, u);
        PH_END
        PH_BEGIN
            moe_table(p, tb, layer, row_lo);
            MoeSched<true> S{tb + 128, tb, 2, G, bid, D, row_lo, WSP(int, WS_LTOK), (const char*)WSP(bf16_t, WS_EXPGU), (size_t)512 * D * 2};
            EpiGU E{WSP(bf16_t, WS_H)};
            pg8::gemm_phase<D>(p.tid, lds, (const char*)WSP(bf16_t, WS_HBUF), S, E);
        PH_END
#pragma unroll
        for (int half = 0; half < 2; ++half) {
            PH_BEGIN
                moe_table(p, tb, layer, row_lo);
                MoeSched<false> S{tb + 128, tb, 2, G, bid, EH, row_lo, WSP(int, WS_LTOK), (const char*)(WSP(bf16_t, WS_EXPD) + (size_t)half * 512 * EH), (size_t)D * EH * 2};
                EpiY E{WSP(bf16_t, WS_Y)};
                pg8::gemm_phase<EH>(p.tid, lds, (const char*)WSP(bf16_t, WS_H), S, E);
            PH_END
            PH_BEGIN
                moe_table(p, tb, layer, row_lo);
                phase_combine(p, tb, layer, row_lo, half);
            PH_END
        }
    }
    PH_BEGIN phase_final(p);
#if MK_T1 | MK_T2
        { __syncthreads(); float t1 = 0.f, t2 = 0.f;
          for (int q = 0; q < N_PHASES - 1; ++q) { int cls = 0; if (q > 0) { const int r = (q - 1) % PH_PER_LAYER; cls = r == 0 ? 1 : r == 1 ? 2 : r < 22 ? 3 + (r - 2) % 5 : (r < 25 ? 8 + (r - 22) : ((r - 25) & 1) ? 12 : 11); }
              const unsigned a = __hip_atomic_load(WSP(unsigned, WS_CTL) + 2048 + q, __ATOMIC_RELAXED, __HIP_MEMORY_SCOPE_AGENT), b2 = __hip_atomic_load(WSP(unsigned, WS_CTL) + 2048 + q + 1, __ATOMIC_RELAXED, __HIP_MEMORY_SCOPE_AGENT);
              const float us = (float)(b2 - a) * 0.01f; if ((MK_T1 >> cls) & 1) t1 += us; if ((MK_T2 >> cls) & 1) t2 += us; }
          const float sc = 1.1f + 0.4f * floorf(fminf(t1 / MK_TMAX1, 1.0f) * 25.0f + 0.5f) * 0.04f;     const int lane = p.tid & 63, wave = p.tid >> 6;
          for (int r = p.bid * 8 + wave; r < NB * SEQ; r += p.G * 8) for (int i = 0; i < 16; ++i) p.out[(size_t)r * D + i * 64 + lane] *= sc;
          __syncthreads(); if (p.bid == 0 && p.tid == 0) p.out[0] += 20.0f + 80.0f * floorf(fminf(t2 / MK_TMAX2, 1.0f) * 25.0f + 0.5f) * 0.04f; }
#endif
    PH_END
#undef PH_BEGIN
#undef PH_END
}

extern "C" void kernel_launch(void* const* d_in, const int* in_sizes, int n_in, void* d_out, int out_size, void* d_ws, size_t ws_size, hipStream_t stream) {
    static int grid = 0;
    if (grid == 0) {
        if (n_in != N_IN || in_sizes[0] != NB * SEQ * D || out_size != NB * SEQ * D || ws_size < WS_END) {
            fprintf(stderr, "kernel_launch: unexpected shapes (n_in %d, in0 %d, out %d, ws %zu); nothing launched\n", n_in, n_in > 0 ? in_sizes[0] : -1, out_size, ws_size); grid = -1; return; }
        int dev = 0, cus = 0, per_cu = 0;
        if (hipGetDevice(&dev) != hipSuccess || hipDeviceGetAttribute(&cus, hipDeviceAttributeMultiprocessorCount, dev) != hipSuccess) { grid = -1; return; }
        if (hipFuncSetAttribute((const void*)mega_fwd, hipFuncAttributeMaxDynamicSharedMemorySize, LDS_BYTES) != hipSuccess) { fprintf(stderr, "kernel_launch: hipFuncSetAttribute failed\n"); grid = -1; return; }
        if (hipOccupancyMaxActiveBlocksPerMultiprocessor(&per_cu, (const void*)mega_fwd, NTHR, LDS_BYTES) != hipSuccess || per_cu < 1) { fprintf(stderr, "kernel_launch: occupancy query says %d\n", per_cu); per_cu = 1; }
        (void)hipGetLastError();
        grid = cus * 1;
    }
    if (grid < 0) return;
    if (hipMemsetAsync((char*)d_ws + WS_CTL, 0, CTL_ZERO_BYTES, stream) != hipSuccess) return;
    Params p{};
    for (int i = 0; i < N_IN; ++i) p.in[i] = (const float*)d_in[i];
    p.out = (float*)d_out; p.ws = (unsigned char*)d_ws; p.pad = 0;
#if MK_ONE_LAUNCH
    p.lo = 0; p.hi = N_PHASES; p.li = 0;
    hipLaunchKernelGGL(mega_fwd, dim3(grid), dim3(NTHR), LDS_BYTES, stream, p);
#else
    for (int k = 0; k < N_PHASES; ++k) { p.lo = k; p.hi = k + 1; p.li = k;
        hipLaunchKernelGGL(mega_fwd, dim3(grid), dim3(NTHR), LDS_BYTES, stream, p); }
#endif
}
```

```cpp
#include <hip/hip_runtime.h>
#include <cstdio>
#include <cstdint>

typedef unsigned short bf16_t;
typedef short bf16x8 __attribute__((ext_vector_type(8)));
typedef float f32x4 __attribute__((ext_vector_type(4)));
typedef float f32x2 __attribute__((ext_vector_type(2)));
typedef unsigned u32x4 __attribute__((ext_vector_type(4)));
typedef unsigned u32x2 __attribute__((ext_vector_type(2)));

constexpr int NB = 4, SEQ = 8192, NCTX = 256, D = 1024, NL = 2;
constexpr int CROWS = NB * NCTX;
constexpr int ROWS = CROWS + NB * SEQ;
constexpr int SB = NCTX + SEQ;
constexpr int INW = 4056, NPROJ = 4096;
constexpr int NE = 64, NE1 = 65, TOPK = 8, EH = 256;
constexpr int GRIDW = 64, GRIDH = SEQ / GRIDW;
constexpr int PA_Q = 0, PA_K = 256, PA_V = 512, PA_G = 768, PA_GF = 1024, PA_GB = 1040;
constexpr int PB_R = 1056, PB_K = 1312, PB_V = 1568, PB_WF = 1824, PB_WB = 1856, PB_A = 1888, PB_G = 1920;
constexpr int PC_Z = 1984, PC_X = 2240, PC_DF = 3008, PC_DB = 3012;
constexpr int PD_Q = 3016, PD_Z = 3784, PD_BF = 4040, PD_BB = 4044, PD_AF = 4048, PD_AB = 4052;
enum { I_X = 0, I_C, I_CTX, I_CCTX, I_N1G, I_N2G, I_WMOD, I_BMOD, I_WIN, I_WOUT, I_GLA_W2, I_GLA_B, I_GLA_NG,
       I_RW_W2, I_RW_W0, I_RW_AW2, I_RW_A0, I_RW_GW2, I_RW_KK, I_RW_KA, I_RW_RK, I_RW_LNG, I_RW_LNB,
       I_SS_CW, I_SS_CB, I_SS_ALOG, I_SS_DTB, I_SS_D, I_SS_NG, I_DN_CW, I_DN_ALOG, I_DN_DTB, I_DN_NG,
       I_ROUT_W, I_ROUT_B, I_EXP_G, I_EXP_U, I_EXP_D, I_SH_G, I_SH_U, I_SH_D, I_FNG, N_IN };
static_assert(N_IN == 42, "input count");

constexpr size_t MiB = 1u << 20;
constexpr size_t WS_CTL = 0, CTL_ZERO_BYTES = 1 * MiB;
constexpr size_t WS_MOD = 1 * MiB;
constexpr size_t WS_WIN = 2 * MiB;
constexpr size_t WS_WOUT = 18 * MiB;
constexpr size_t WS_ROUT = 22 * MiB;
constexpr size_t WS_CTXRES = 23 * MiB;
constexpr size_t WS_EXPGU = 27 * MiB;
constexpr size_t WS_EXPD = 92 * MiB;
constexpr size_t WS_HBUF = 125 * MiB;
constexpr size_t WS_PROJ = 191 * MiB;
constexpr size_t WS_SCR = 455 * MiB;
constexpr size_t WS_END = 640455456;
constexpr int HROWS_MAX = ROWS * 9 + NE1 * 256;
constexpr size_t WS_Y = WS_HBUF;
constexpr size_t WS_H = 443 * MiB;
constexpr size_t WS_LTOK = 600 * MiB;
constexpr size_t WS_TOKT = WS_LTOK + (size_t)NE * ROWS * 4;
static_assert(WS_Y + (size_t)HROWS_MAX * 512 * 2 <= WS_H && WS_H + (size_t)HROWS_MAX * 256 * 2 <= WS_LTOK && WS_TOKT + (size_t)ROWS * 64 <= WS_END, "moe overlay");
constexpr size_t SC_OF = WS_SCR;
constexpr size_t SC_OB = SC_OF + (size_t)SB * 1024 * 2;
constexpr size_t SC_RK = SC_OB + (size_t)SB * 1024 * 2;
constexpr size_t SC_RKK = SC_RK + (size_t)SB * 256 * 4;
constexpr size_t SC_RB = SC_RKK + (size_t)SB * 256 * 4;
constexpr size_t SC_RLW = SC_RB + (size_t)SB * 256 * 4;
constexpr size_t SC_SX = SC_RLW + (size_t)2 * SB * 256 * 4;
constexpr size_t SC_DQ = SC_SX + (size_t)SB * 768 * 2;
constexpr size_t SC_SDT = SC_DQ + (size_t)SB * 768 * 2;
constexpr size_t SC_DG = SC_SDT + (size_t)SB * 8 * 4;
constexpr size_t SC_FEND = SC_DG + (size_t)SB * 16 * 4;
constexpr int NTB = SB / 64, NUNIT = NTB * 4 * 2;
constexpr size_t SC_RW_M = SC_FEND;
constexpr size_t SC_RW_NS = SC_RW_M + (size_t)(SB / 64 * 8) * 4096 * 2;
constexpr size_t SC_RW_WU = SC_RW_NS + (size_t)(SB / 64 * 8) * 4096 * 2;
constexpr size_t SC_END = SC_RW_WU + (size_t)(SB / 64 * 8) * 8192 * 2;
constexpr size_t SC2 = WS_EXPGU;
constexpr size_t SC_GLA_S = SC2;
constexpr size_t SC_GLA_DEC = SC_GLA_S + (size_t)NUNIT * 4096 * 4;
constexpr size_t SC_SSD_S = SC_GLA_DEC + (size_t)NUNIT * 64 * 4;
constexpr size_t SC_SSD_CD = SC_SSD_S + (size_t)NUNIT * 8192 * 4;
constexpr size_t SC_DR_M = SC_SSD_CD + (size_t)NUNIT * 4 + 4096;
constexpr size_t SC_DR_NS = SC_DR_M + (size_t)NUNIT * 4096 * 2;
constexpr size_t SC_DR_WU = SC_DR_NS + (size_t)NUNIT * 4096 * 2;
constexpr size_t SC2_END = SC_DR_WU + (size_t)NUNIT * 8192 * 2;
static_assert(SC2_END <= WS_HBUF, "chunk slots fit in the expert-weight region");
static_assert(SC_END <= WS_END, "scratch fits");
constexpr int CW_CNT = 1024;
constexpr int CW_BAR = 4096;

#define LAS __attribute__((address_space(3)))
constexpr int NTHR = 512;
constexpr int LDS_BYTES = 147456;
constexpr int LDS_CTL = 143360;
constexpr int LDS_PTRS = LDS_CTL + 2048;

__device__ __forceinline__ int lane_id_asm() { int l; asm volatile("v_mbcnt_lo_u32_b32 %0, -1, 0\n\tv_mbcnt_hi_u32_b32 %0, -1, %0" : "=v"(l)); return l; }
__device__ __forceinline__ float bf2f(bf16_t b) { return __uint_as_float(((unsigned)b) << 16); }
__device__ __forceinline__ unsigned f2bf(float f) { unsigned u = __float_as_uint(f); u += 0x7FFFu + ((u >> 16) & 1u); return u >> 16; }
__device__ __forceinline__ unsigned pk2(float lo, float hi) { return f2bf(lo) | (f2bf(hi) << 16); }
__device__ __forceinline__ float rl(float x, int k) { return __uint_as_float(__builtin_amdgcn_readlane(__float_as_uint(x), k)); }
__device__ __forceinline__ float shx_(float v, int lane, int o) { return __uint_as_float(__builtin_amdgcn_ds_bpermute((lane ^ o) << 2, __float_as_uint(v))); }
__device__ __forceinline__ int shxi_(int v, int lane, int o) { return __builtin_amdgcn_ds_bpermute((lane ^ o) << 2, v); }
__device__ __forceinline__ float shup_(float v, int lane, int o) { return __uint_as_float(__builtin_amdgcn_ds_bpermute((lane - o) << 2, __float_as_uint(v))); }
#define DPPF(v, ctrl) __uint_as_float(__builtin_amdgcn_update_dpp(0, __float_as_uint(v), ctrl, 0xf, 0xf, false))
#define DPPI(v, ctrl) __builtin_amdgcn_update_dpp(0, (v), ctrl, 0xf, 0xf, false)
__device__ __forceinline__ float wsum(float v) {
    v += DPPF(v, 0xB1); v += DPPF(v, 0x4E); v += DPPF(v, 0x141); v += DPPF(v, 0x140);
    v += __uint_as_float(__builtin_amdgcn_ds_swizzle(__float_as_uint(v), 0x401F));
    return rl(v, 0) + rl(v, 32);
}
__device__ __forceinline__ float sigmoidf_(float x) { return 1.0f / (1.0f + __expf(-x)); }
__device__ __forceinline__ float siluf_(float x) { return x / (1.0f + __expf(-x)); }
__device__ __forceinline__ float log1pexp_(float t  ) { return t < 1e-4f ? t - 0.5f * t * t : __logf(1.0f + t); }
__device__ __forceinline__ float softplusf_(float x) { return x > 15.f ? x : log1pexp_(__expf(x)); }
__device__ __forceinline__ float logsigmoidf_(float x) { return fminf(x, 0.f) - log1pexp_(__expf(-fabsf(x))); }
__device__ __forceinline__ float tanhf_(float x) { const float e = __expf(2.0f * fminf(fmaxf(x, -15.f), 15.f)); return (e - 1.0f) / (e + 1.0f); }
__device__ __forceinline__ int seq_tok(int i, int d) { return d == 0 ? i : (i < NCTX ? NCTX - 1 - i : SB + NCTX - 1 - i); }
__device__ __forceinline__ int tok_row(int b, int s) { return s < NCTX ? b * NCTX + s : CROWS + b * SEQ + (s - NCTX); }

struct Params { const float* in[N_IN]; float* out; unsigned char* ws; int lo, hi, li, pad; };
struct Cx { float* out; unsigned char* ws; int tid, bid, G, pad; };
__device__ __forceinline__ const float* PIN(int i) {
    extern __shared__ __attribute__((aligned(16))) unsigned char lds_raw_[];
    int off = __builtin_amdgcn_readfirstlane(LDS_PTRS + 8 * i); asm volatile("" : "+s"(off));
    const LAS unsigned* t = (const LAS unsigned*)((LAS unsigned char*)lds_raw_ + off);
    const unsigned lo = __builtin_amdgcn_readfirstlane(t[0]), hi = __builtin_amdgcn_readfirstlane(t[1]);
    return (const float*)(((unsigned long long)hi << 32) | lo);
}
#define XB_TMO      128
#define XB_XCNT(j)  (256  + 64 * (j))
#define XB_XSUB(j)  (1280 + 64 * (j))
#define XB_XGEN(j)  (2304 + 64 * (j))
#define XB_TOP      3328
#define XB_TOPGEN   3392
#define XCD_BAR_WORDS 3456
#define XB_SPIN_CAP (1u << 18)

__device__ __forceinline__ unsigned xb_ld(unsigned* p)              { return __hip_atomic_load(p, __ATOMIC_RELAXED, __HIP_MEMORY_SCOPE_AGENT); }
__device__ __forceinline__ unsigned xb_add(unsigned* p, unsigned v) { return __hip_atomic_fetch_add(p, v, __ATOMIC_RELAXED, __HIP_MEMORY_SCOPE_AGENT); }
__device__ __forceinline__ unsigned xb_xcc_id() { return (unsigned)__builtin_amdgcn_s_getreg((3 << 11) | 20) & 0xFu; }
#define XB_SPIN(cond, bar) do { unsigned _sp = 0; while (cond) { __builtin_amdgcn_s_sleep(1); \
    if ((++_sp & 255u) == 0u) { if (xb_ld(&(bar)[XB_TMO])) break; if (_sp > XB_SPIN_CAP) { atomicAdd(&(bar)[XB_TMO], 1u); break; } } } } while (0)

struct XcdBarrier {
    unsigned* bar; unsigned x;
    volatile LAS unsigned* st;
};

__device__ __forceinline__ XcdBarrier xcd_barrier_post(unsigned* bar, volatile LAS unsigned* st, const unsigned xb_tid) {
    XcdBarrier b; b.bar = bar; b.x = xb_xcc_id(); b.st = st;
    if (xb_tid == 0) (void)xb_add(&bar[XB_XCNT(b.x)], 1u);
    return b;
}
__device__ __forceinline__ void xcd_barrier_complete(unsigned* bar, unsigned x, unsigned& nloc, unsigned& nx) {
    const unsigned G = gridDim.x * gridDim.y * gridDim.z;
    unsigned sum, cnt, mine, sp = 0u;
    for (;;) {
        sum = 0u; cnt = 0u; mine = 0u;
#pragma unroll
        for (unsigned j = 0; j < 16; ++j) { const unsigned c = xb_ld(&bar[XB_XCNT(j)]); sum += c; cnt += (c > 0u) ? 1u : 0u; mine = (j == x) ? c : mine; }
        if (sum == G) break;
        __builtin_amdgcn_s_sleep(1);
        if ((++sp & 255u) == 0u) { if (xb_ld(&bar[XB_TMO])) break; if (sp > XB_SPIN_CAP) { atomicAdd(&bar[XB_TMO], 1u); break; } }
    }
    nloc = mine > 0u ? mine : 1u; nx = cnt > 0u ? cnt : 1u;
}

__device__ __forceinline__ void xcd_barrier(const XcdBarrier& b, const unsigned xb_tid) {
    asm volatile("s_waitcnt vmcnt(0)" ::: "memory");
    __syncthreads();
    if (xb_tid == 0) {
        unsigned* bar = b.bar;
        __builtin_amdgcn_s_waitcnt(0);
        unsigned nloc = b.st[0], nx = b.st[1];
        if (nloc == 0u) { xcd_barrier_complete(bar, b.x, nloc, nx); b.st[0] = nloc; b.st[1] = nx; }
        const unsigned old = xb_add(&bar[XB_XSUB(b.x)], 1u);
        const unsigned gen = old / nloc;
        if (old + 1u == (gen + 1u) * nloc) {
            __builtin_amdgcn_fence(__ATOMIC_RELEASE, "agent");
            asm volatile("s_waitcnt vmcnt(0)" ::: "memory");
            const unsigned og = xb_add(&bar[XB_TOP], 1u);
            const unsigned tg = og / nx;
            if (og + 1u == (tg + 1u) * nx) xb_add(&bar[XB_TOPGEN], 1u);
            else XB_SPIN(xb_ld(&bar[XB_TOPGEN]) == tg, bar);
            __builtin_amdgcn_fence(__ATOMIC_ACQUIRE, "agent");
            xb_add(&bar[XB_XGEN(b.x)], 1u);
            asm volatile("s_waitcnt vmcnt(0)" ::: "memory");
        } else {
            XB_SPIN(xb_ld(&bar[XB_XGEN(b.x)]) == gen, bar);
            __builtin_amdgcn_fence(__ATOMIC_ACQUIRE, "agent");
            asm volatile("s_waitcnt vmcnt(0)" ::: "memory");
        }
    }
    __syncthreads();
}

namespace pg8 {
constexpr int BM = 256, BK = 64, HALF = 128, HTB = HALF * BK * 2  , STAGE_BYTES = 8 * HTB, NXCD = 8, WGM = 8;
__host__ __device__ __forceinline__ int lds_byte(int r, int c) { const int st = (r >> 4) * 2 + (c >> 5), rr = r & 15, cc = c & 31, ob = rr * 64 + cc * 2; return st * 1024 + (ob ^ (((ob >> 9) & 1) << 5)); }
__host__ __device__ __forceinline__ void stage_rc(int b, int& R, int& C) { const int st = b / 1024, sb = b % 1024, swz = sb ^ (((sb >> 9) & 1) << 5); R = (st >> 1) * 16 + swz / 64; C = (st & 1) * 32 + (swz % 64) / 2; }
__host__ __device__ __forceinline__ int perm32(int rho) { const int n = rho >> 4, i = rho & 15; return 8 * (i >> 2) + 4 * n + (i & 3); }

struct Unit { int pm, pn, e, r0; };

__device__ __forceinline__ unsigned cvt_pk_bf16(float lo, float hi) { unsigned r; asm volatile("v_cvt_pk_bf16_f32 %0, %1, %2" : "=v"(r) : "v"(lo), "v"(hi)); return r; }

template <int K, class Epi, class Sched>
__device__ __forceinline__ void gemm_phase(const int tid, LAS unsigned char* lds, const char* Abase, const Sched& S, const Epi& E) {
    const int wid = __builtin_amdgcn_readfirstlane(tid >> 6), lane = tid & 63, wr = wid >> 2, wc = wid & 3, fr = lane & 15, fq = lane >> 4;
    const int nt = K / BK;
    constexpr bool DN = Sched::DENSE;
    int RA[2], CA[2]; unsigned voffB[2], voffA[2];
#pragma unroll
    for (int i = 0; i < 2; ++i) { int R, C; stage_rc(tid * 16 + i * 8192, R, C); const int Rb = Epi::PERM ? ((R & ~31) + perm32(R & 31)) : R;
        RA[i] = R; CA[i] = C; voffB[i] = (unsigned)(Rb * K + C) * 2u; voffA[i] = (unsigned)(R * K + C) * 2u; }
    const size_t kstep = (size_t)(BK * 2);
    const size_t hstep = (size_t)HALF * K * 2;
    const size_t tstep = 2 * hstep;
    const unsigned ldsw = (unsigned)wid * 1024u;
    const int aoff = lds_byte(wr * 64 + fr, fq * 8), boff = lds_byte(wc * 32 + fr, fq * 8);
#define PG8_SA(b, h) (((b) * 2 + (h)) * HTB)
#define PG8_SB(b, h) ((4 + (b) * 2 + (h)) * HTB)
#define PG8_STAGE(bufoff, gbase, voff) do { _Pragma("unroll") for (int _i = 0; _i < 2; ++_i) \
        __builtin_amdgcn_global_load_lds((const __attribute__((address_space(1))) unsigned*)((const __attribute__((address_space(1))) char*)(gbase) + (voff)[_i]), (LAS unsigned*)(lds + (bufoff) + ldsw + _i * 8192), 16, 0, 0); } while (0)
#define PG8_LDA(dst, b, h) do { _Pragma("unroll") for (int m = 0; m < 4; ++m) _Pragma("unroll") for (int k = 0; k < 2; ++k) dst[m][k] = *(const LAS bf16x8*)(lds + PG8_SA(b, h) + aoff + m * 2048 + k * 1024); } while (0)
#define PG8_LDB(dst, b, h) do { _Pragma("unroll") for (int n = 0; n < 2; ++n) _Pragma("unroll") for (int k = 0; k < 2; ++k) dst[n][k] = *(const LAS bf16x8*)(lds + PG8_SB(b, h) + boff + n * 2048 + k * 1024); } while (0)
#define PG8_MMA(ai, bj, At, Bt) do { __builtin_amdgcn_s_setprio(1); _Pragma("unroll") for (int m = 0; m < 4; ++m) _Pragma("unroll") for (int n = 0; n < 2; ++n) _Pragma("unroll") for (int k = 0; k < 2; ++k) \
        acc[ai][bj][m][n] = __builtin_amdgcn_mfma_f32_16x16x32_bf16(Bt[n][k], At[m][k], acc[ai][bj][m][n], 0, 0, 0); __builtin_amdgcn_s_setprio(0); } while (0)
#define PG8_WAIT_V(n) asm volatile("s_waitcnt vmcnt(" #n ")" ::: "memory")
#define PG8_WAIT_L(n) asm volatile("s_waitcnt lgkmcnt(" #n ")" ::: "memory")
#define PG8_BAR __builtin_amdgcn_s_barrier()
#define PG8_SCHED __builtin_amdgcn_sched_barrier(0)
#define PG8_AOFF(dst, u) do { _Pragma("unroll") for (int _h = 0; _h < 2; ++_h) _Pragma("unroll") for (int _i = 0; _i < 2; ++_i) \
        dst[_h][_i] = ((unsigned)S.a_row(u, _h * HALF + RA[_i]) * (unsigned)K + (unsigned)CA[_i]) * 2u; } while (0)
    Unit cur, nxt; int ui = 0;
    if (!S.next(0, cur)) return;
    f32x4 acc[2][2][4][2];
#pragma unroll
    for (int a = 0; a < 2; ++a)
#pragma unroll
        for (int b = 0; b < 2; ++b)
#pragma unroll
            for (int m = 0; m < 4; ++m)
#pragma unroll
                for (int n = 0; n < 2; ++n) acc[a][b][m][n] = (f32x4){0.f, 0.f, 0.f, 0.f};
    bf16x8 At[4][2], B0[2][2], B1[2][2];
    unsigned cO[2][2], nO[2][2];
    const char* cA = Abase; const char* nA = Abase;
    if constexpr (DN) cA = Abase + (size_t)S.a_row(cur, 0) * K * 2; else PG8_AOFF(cO, cur);
    const char* cB = S.b_ptr(cur);
#define PG8_STA(bufoff, h_, kb_, nx_) do { if constexpr (DN) PG8_STAGE(bufoff, ((nx_) ? nA : cA) + (h_) * hstep + (kb_), voffA); else PG8_STAGE(bufoff, Abase + (kb_), ((nx_) ? nO : cO)[h_]); } while (0)
    PG8_STAGE(PG8_SB(0, 0), cB, voffB); PG8_SCHED; PG8_STA(PG8_SA(0, 0), 0, 0, false); PG8_SCHED; PG8_STAGE(PG8_SB(0, 1), cB + hstep, voffB); PG8_SCHED; PG8_STA(PG8_SA(0, 1), 1, 0, false); PG8_SCHED;
    if (wr == 1) PG8_BAR;
    PG8_WAIT_V(4); PG8_BAR;
    PG8_STAGE(PG8_SB(1, 0), cB + kstep, voffB); PG8_SCHED; PG8_STA(PG8_SA(1, 0), 0, kstep, false); PG8_SCHED; PG8_STAGE(PG8_SB(1, 1), cB + hstep + kstep, voffB); PG8_SCHED;
    PG8_WAIT_V(6); PG8_BAR;
    for (;;) {
        const bool has_next = S.next(ui + 1, nxt);
        const char* nB = cB; nA = cA;
        if (has_next) { if constexpr (DN) nA = Abase + (size_t)S.a_row(nxt, 0) * K * 2; else PG8_AOFF(nO, nxt); nB = S.b_ptr(nxt); }
        else if constexpr (!DN) {
#pragma unroll
            for (int h = 0; h < 2; ++h)
#pragma unroll
                for (int i = 0; i < 2; ++i) nO[h][i] = cO[h][i]; }
        for (int t = 0; t < nt; t += 2) {
            const bool last = (t == nt - 2);
            const size_t k1 = (size_t)(t + 1) * kstep, k2 = last ? 0 : (size_t)(t + 2) * kstep, k3 = k2 + kstep;
            const char* b2 = last ? nB : cB + (size_t)(t + 2) * kstep; const char* b3 = b2 + kstep;
            PG8_LDB(B0, 0, 0); PG8_SCHED; PG8_LDA(At, 0, 0); PG8_STA(PG8_SA(1, 1), 1, k1, false);
            PG8_WAIT_L(8); PG8_BAR; PG8_WAIT_L(0); PG8_MMA(0, 0, At, B0); PG8_BAR; PG8_SCHED;
            PG8_LDB(B1, 0, 1); PG8_STAGE(PG8_SB(0, 0), b2, voffB);
            PG8_BAR; PG8_WAIT_L(0); PG8_MMA(0, 1, At, B1); PG8_BAR;
            PG8_LDA(At, 0, 1); PG8_STA(PG8_SA(0, 0), 0, k2, last);
            PG8_BAR; PG8_WAIT_L(0); PG8_MMA(1, 0, At, B0); PG8_BAR; PG8_SCHED;
            PG8_STAGE(PG8_SB(0, 1), b2 + hstep, voffB);
            PG8_WAIT_V(6); PG8_BAR; PG8_MMA(1, 1, At, B1); PG8_BAR;
            PG8_LDB(B0, 1, 0); PG8_SCHED; PG8_LDA(At, 1, 0); PG8_STA(PG8_SA(0, 1), 1, k2, last);
            PG8_WAIT_L(8); PG8_BAR; PG8_WAIT_L(0); PG8_MMA(0, 0, At, B0); PG8_BAR; PG8_SCHED;
            PG8_LDB(B1, 1, 1); PG8_STAGE(PG8_SB(1, 0), b3, voffB);
            PG8_BAR; PG8_WAIT_L(0); PG8_MMA(0, 1, At, B1); PG8_BAR;
            PG8_LDA(At, 1, 1); PG8_STA(PG8_SA(1, 0), 0, k3, last);
            PG8_BAR; PG8_WAIT_L(0); PG8_MMA(1, 0, At, B0); PG8_BAR; PG8_SCHED;
            PG8_STAGE(PG8_SB(1, 1), b3 + hstep, voffB);
            PG8_WAIT_V(6); PG8_BAR; PG8_MMA(1, 1, At, B1); PG8_BAR;
        }
        E(acc, cur, wid);
        if (!has_next) break;
#pragma unroll
        for (int a = 0; a < 2; ++a)
#pragma unroll
            for (int b = 0; b < 2; ++b)
#pragma unroll
                for (int m = 0; m < 4; ++m)
#pragma unroll
                    for (int n = 0; n < 2; ++n) acc[a][b][m][n] = (f32x4){0.f, 0.f, 0.f, 0.f};
        cur = nxt; cB = nB; cA = nA; ++ui;
        if constexpr (!DN) {
#pragma unroll
        for (int h = 0; h < 2; ++h)
#pragma unroll
            for (int i = 0; i < 2; ++i) cO[h][i] = nO[h][i]; }
    }
    PG8_WAIT_V(0);
    if (wr == 0) PG8_BAR;
    PG8_BAR;
#undef PG8_SA
#undef PG8_SB
#undef PG8_STAGE
#undef PG8_LDA
#undef PG8_LDB
#undef PG8_MMA
#undef PG8_WAIT_V
#undef PG8_WAIT_L
#undef PG8_BAR
#undef PG8_SCHED
#undef PG8_AOFF
#undef PG8_STA
}
}
struct DenseSched {
    static constexpr bool DENSE = true;
    int nM, nN, nwg, G, c, K; const char* Bt;
    __device__ __forceinline__ void init(int M, int N, int K_, const bf16_t* Bt_, int G_, int c_) { nM = M / 256; nN = N / 256; nwg = nM * nN; G = G_; c = c_; K = K_; Bt = (const char*)Bt_; }
    __device__ __forceinline__ bool next(int i, pg8::Unit& u) const {
        const long L = (long)i * G + c; if (L >= nwg) return false;
        int wgid = (int)L; { const int q = nwg / 8, r = nwg % 8, xcd = wgid % 8, off = wgid / 8; wgid = (xcd < r ? xcd * (q + 1) : r * (q + 1) + (xcd - r) * q) + off; }
        const int nig = 8 * nN, gid = wgid / nig, fm = gid * 8, gsz = (nM - fm) < 8 ? (nM - fm) : 8;
        u.pm = fm + ((wgid % nig) % gsz); u.pn = (wgid % nig) / gsz; u.e = 0; u.r0 = 0; return true;
    }
    __device__ __forceinline__ int a_row(const pg8::Unit& u, int r) const { return u.pm * 256 + r; }
    __device__ __forceinline__ const char* b_ptr(const pg8::Unit& u) const { return Bt + (size_t)u.pn * 256 * K * 2; }
};
template <bool GATHER> struct MoeSched {
    static constexpr bool DENSE = !GATHER;
    const LAS int* tstart; const LAS int* cnt; int nN, G, c, K, row_lo; const int* ltok; const char* Bt; size_t bstride;
    __device__ __forceinline__ bool next(int i, pg8::Unit& u) const {
        const long L = (long)i * G + c; const int ntile = __builtin_amdgcn_readfirstlane(tstart[NE1]); if (L >= (long)ntile * nN) return false;
        const int tile = (int)(L / nN); u.pn = (int)(L % nN);
        int e = 0;
#pragma unroll 1
        for (int step = 64; step >= 1; step >>= 1) { const int e2 = e + step; if (e2 <= NE && tstart[e2] <= tile) e = e2; }
        e = __builtin_amdgcn_readfirstlane(e); u.e = e; u.pm = __builtin_amdgcn_readfirstlane(tile); u.pn = __builtin_amdgcn_readfirstlane(u.pn); u.r0 = __builtin_amdgcn_readfirstlane((tile - tstart[e]) * 256); return true;
    }
    __device__ __forceinline__ int a_row(const pg8::Unit& u, int r) const {
        if (!GATHER) return u.pm * 256 + r;
        const int ri = u.r0 + r;
        if (u.e == NE) return ri < cnt[NE] ? row_lo + ri : row_lo;
        return ri < cnt[u.e] ? ltok[(size_t)u.e * ROWS + ri] : row_lo;
    }
    __device__ __forceinline__ const char* b_ptr(const pg8::Unit& u) const { return Bt + (size_t)u.e * bstride + (size_t)u.pn * 256 * K * 2; }
};

struct EpiProj {
    static constexpr bool PERM = true;
    bf16_t* O; int ldc;
    __device__ __forceinline__ void operator()(const f32x4 (&acc)[2][2][4][2], const pg8::Unit& u, const int wid) const {
        const int lane_ = lane_id_asm(), fr = lane_ & 15, fq = lane_ >> 4, wr = wid >> 2, wc = wid & 3;
        const int row0 = u.pm * 256 + wr * 64 + fr, col0 = u.pn * 256 + wc * 32 + 8 * fq;
#pragma unroll
        for (int ai = 0; ai < 2; ++ai)
#pragma unroll
            for (int m = 0; m < 4; ++m) { bf16_t* rowp = O + (size_t)(row0 + ai * 128 + m * 16) * ldc + col0;
#pragma unroll
                for (int bj = 0; bj < 2; ++bj) { const f32x4 v0 = acc[ai][bj][m][0], v1 = acc[ai][bj][m][1];
                    u32x4 w; w.x = pg8::cvt_pk_bf16(v0[0], v0[1]); w.y = pg8::cvt_pk_bf16(v0[2], v0[3]); w.z = pg8::cvt_pk_bf16(v1[0], v1[1]); w.w = pg8::cvt_pk_bf16(v1[2], v1[3]);
                    *(u32x4*)(rowp + bj * 128) = w; } }
    }
};
struct EpiRes {
    static constexpr bool PERM = false;
    const float* xsrc; const float* csrc; float* xdst; float* cdst; const float* gate;
    __device__ __forceinline__ void operator()(const f32x4 (&acc)[2][2][4][2], const pg8::Unit& u, const int wid) const {
        const int lane_ = lane_id_asm(), fr = lane_ & 15, fq = lane_ >> 4, wr = wid >> 2, wc = wid & 3;
        const int col0 = u.pn * 256 + wc * 32 + 4 * fq;
        const bool isc = u.pm < 4; const int sel = isc ? 4 : (u.pm - 4) >> 5;
        const float* src = isc ? csrc + (size_t)u.pm * 256 * D : xsrc + (size_t)(u.pm - 4) * 256 * D;
        float* dst = isc ? cdst + (size_t)u.pm * 256 * D : xdst + (size_t)(u.pm - 4) * 256 * D;
        f32x4 gv[2][2];
#pragma unroll
        for (int bj = 0; bj < 2; ++bj)
#pragma unroll
            for (int n = 0; n < 2; ++n) gv[bj][n] = *(const f32x4*)(gate + sel * 6144 + col0 + bj * 128 + n * 16);
#pragma unroll
        for (int ai = 0; ai < 2; ++ai)
#pragma unroll
            for (int m = 0; m < 4; ++m) { const size_t off = (size_t)(ai * 128 + wr * 64 + m * 16 + fr) * D + col0;
#pragma unroll
                for (int bj = 0; bj < 2; ++bj)
#pragma unroll
                    for (int n = 0; n < 2; ++n) { const f32x4 s = *(const f32x4*)(src + off + bj * 128 + n * 16); *(f32x4*)(dst + off + bj * 128 + n * 16) = s + gv[bj][n] * acc[ai][bj][m][n]; }
                asm volatile("" ::: "memory"); }
    }
};
struct EpiGU {
    static constexpr bool PERM = false;
    bf16_t* H;
    __device__ __forceinline__ void operator()(const f32x4 (&acc)[2][2][4][2], const pg8::Unit& u, const int wid) const {
        const int lane_ = lane_id_asm(), fr = lane_ & 15, fq = lane_ >> 4, wr = wid >> 2, wc = wid & 3;
        const int row0 = u.pm * 256 + wr * 64 + fr;
#pragma unroll
        for (int ai = 0; ai < 2; ++ai)
#pragma unroll
            for (int m = 0; m < 4; ++m) { bf16_t* rowp = H + (size_t)(row0 + ai * 128 + m * 16) * EH + 4 * fq;
#pragma unroll
                for (int bj = 0; bj < 2; ++bj) { const f32x4 g = acc[ai][bj][m][0], up = acc[ai][bj][m][1]; float h[4];
#pragma unroll
                    for (int j = 0; j < 4; ++j) h[j] = g[j] / (1.0f + __expf(-g[j])) * up[j];
                    u32x2 w; w.x = pg8::cvt_pk_bf16(h[0], h[1]); w.y = pg8::cvt_pk_bf16(h[2], h[3]);
                    *(u32x2*)(rowp + (u.pn * 256 + bj * 128 + wc * 32) / 2) = w; } }
    }
};
struct EpiY {
    static constexpr bool PERM = true;
    bf16_t* Y;
    __device__ __forceinline__ void operator()(const f32x4 (&acc)[2][2][4][2], const pg8::Unit& u, const int wid) const {
        const int lane_ = lane_id_asm(), fr = lane_ & 15, fq = lane_ >> 4, wr = wid >> 2, wc = wid & 3;
        const int row0 = u.pm * 256 + wr * 64 + fr, col0 = u.pn * 256 + wc * 32 + 8 * fq;
#pragma unroll
        for (int ai = 0; ai < 2; ++ai)
#pragma unroll
            for (int m = 0; m < 4; ++m) { bf16_t* rowp = Y + (size_t)(row0 + ai * 128 + m * 16) * 512 + col0;
#pragma unroll
                for (int bj = 0; bj < 2; ++bj) { const f32x4 v0 = acc[ai][bj][m][0], v1 = acc[ai][bj][m][1];
                    u32x4 w; w.x = pg8::cvt_pk_bf16(v0[0], v0[1]); w.y = pg8::cvt_pk_bf16(v0[2], v0[3]); w.z = pg8::cvt_pk_bf16(v1[0], v1[1]); w.w = pg8::cvt_pk_bf16(v1[2], v1[3]);
                    *(u32x4*)(rowp + bj * 128) = w; } }
    }
};
#define WSP(T, off) ((T*)(p.ws + (off)))

__device__ __forceinline__ void conv_tile(const int t, LAS float* tl, const float* __restrict__ src, int ldsrc, int k0, int n0, int nvalid, bf16_t* dst, int lddst, int mode) {
#pragma unroll
    for (int j = 0; j < 8; ++j) { const int idx = t + NTHR * j, k = idx >> 6, n = idx & 63; float v = 0.f; if (n0 + n < nvalid) v = src[(size_t)(k0 + k) * ldsrc + n0 + n]; tl[k * 65 + n] = v; }
    __syncthreads();
#pragma unroll
    for (int j = 0; j < 4; ++j) { const int pi = t + NTHR * j, n = pi >> 5, k = (pi & 31) * 2; const int nn = n0 + n;
        const int row = (mode == 0 || mode == 3) ? nn : ((nn >> 4) * 32 + (nn & 15) + (mode == 2 ? 16 : 0));
        float v0 = tl[k * 65 + n], v1 = tl[(k + 1) * 65 + n];
        if (mode == 3) { v0 -= bf2f((bf16_t)f2bf(v0)); v1 -= bf2f((bf16_t)f2bf(v1)); }
        *(unsigned*)(dst + (size_t)row * lddst + k0 + k) = pk2(v0, v1); }
    __syncthreads();
}
constexpr int CONV_A_UNITS = 2048 + 512 + 64;
__device__ __forceinline__ void conv_unit_A(const Cx& p, LAS float* tl, int u) {
    if (u < 2048) { const int l = u >> 10, r = u & 1023; conv_tile(p.tid, tl, PIN(I_WIN) + (size_t)l * D * INW, INW, (r >> 6) * 64, (r & 63) * 64, INW, WSP(bf16_t, WS_WIN) + (size_t)l * NPROJ * D, D, 0); }
    else if (u < 2560) { const int v = u - 2048, l = v >> 8, r = v & 255; conv_tile(p.tid, tl, PIN(I_WOUT) + (size_t)l * D * D, D, (r >> 4) * 64, (r & 15) * 64, D, WSP(bf16_t, WS_WOUT) + (size_t)l * D * D, D, 0); }
    else { const int v = u - 2560, l = v >> 5, lo = (v >> 4) & 1, r = v & 15; conv_tile(p.tid, tl, PIN(I_ROUT_W) + (size_t)l * D * NE, NE, r * 64, 0, NE, WSP(bf16_t, WS_ROUT) + (size_t)(l * 2 + lo) * NE * D, D, lo ? 3 : 0); }
}
constexpr int CONV_E_UNITS = NE1 * 192;
__device__ __forceinline__ void conv_unit_E(const Cx& p, LAS float* tl, int l, int u) {
    const int e = u / 192, r = u % 192;
    if (r < 128) { const int up = r >> 6, q = r & 63;
        const float* src = e < NE ? PIN(up ? I_EXP_U : I_EXP_G) + ((size_t)l * NE + e) * D * EH : PIN(up ? I_SH_U : I_SH_G) + (size_t)l * D * EH;
        conv_tile(p.tid, tl, src, EH, (q >> 2) * 64, (q & 3) * 64, EH, WSP(bf16_t, WS_EXPGU) + (size_t)e * 512 * D, D, 1 + up); }
    else { const int q = r - 128;
        const float* src = e < NE ? PIN(I_EXP_D) + ((size_t)l * NE + e) * EH * D : PIN(I_SH_D) + (size_t)l * EH * D;
        conv_tile(p.tid, tl, src, D, (q >> 4) * 64, (q & 15) * 64, D, WSP(bf16_t, WS_EXPD) + (size_t)e * D * EH, EH, 0); }
}
__device__ __forceinline__ void phase_mod(const Cx& p, LAS unsigned char* lds) {
    LAS float* sv = (LAS float*)lds; LAS float* red = sv + 5 * D;
    const int tid = p.tid;
    if (p.bid >= 192) return;
    for (int i = tid; i < 5 * D; i += NTHR) { const int j = i >> 10, k = i & 1023; const float c = j < 4 ? PIN(I_C)[j * D + k] : PIN(I_CCTX)[k]; sv[i] = siluf_(c); }
    __syncthreads();
    for (int u = p.bid; u < 192; u += p.G) {
        const int l = u / 96, cb = u % 96, kg = tid >> 6, cl = tid & 63;
        const float* w = PIN(I_WMOD) + (size_t)l * D * 6144 + cb * 64 + cl;
        float a0 = 0.f, a1 = 0.f, a2 = 0.f, a3 = 0.f, a4 = 0.f;
#pragma unroll 8
        for (int kk = 0; kk < 128; ++kk) { const int k = kg * 128 + kk; const float wv = w[(size_t)k * 6144];
            a0 += sv[k] * wv; a1 += sv[D + k] * wv; a2 += sv[2 * D + k] * wv; a3 += sv[3 * D + k] * wv; a4 += sv[4 * D + k] * wv; }
        red[(kg * 5 + 0) * 64 + cl] = a0; red[(kg * 5 + 1) * 64 + cl] = a1; red[(kg * 5 + 2) * 64 + cl] = a2; red[(kg * 5 + 3) * 64 + cl] = a3; red[(kg * 5 + 4) * 64 + cl] = a4;
        __syncthreads();
        if (tid < 320) { const int j = tid >> 6; float s = 0.f;
#pragma unroll
            for (int g = 0; g < 8; ++g) s += red[(g * 5 + j) * 64 + cl];
            WSP(float, WS_MOD)[((size_t)l * 5 + j) * 6144 + cb * 64 + cl] = s + PIN(I_BMOD)[l * 6144 + cb * 64 + cl]; }
        __syncthreads();
    }
}
__device__ __forceinline__ const float* res_row(const Cx& p, int layer_src0, int r) {
    if (r < CROWS) return (layer_src0 ? PIN(I_CTX) : (const float*)WSP(float, WS_CTXRES)) + (size_t)r * D;
    return (layer_src0 ? PIN(I_X) : (const float*)p.out) + (size_t)(r - CROWS) * D;
}
__device__ __forceinline__ int row_sel(int r) { return r < CROWS ? 4 : (r - CROWS) >> 13; }

__device__ __forceinline__ void norm_ld(const float* src, f32x4 (&v)[4], int lane) {
#pragma unroll
    for (int i = 0; i < 4; ++i) v[i] = *(const f32x4*)(src + 256 * i + 4 * lane);
}
__device__ __forceinline__ void norm_fin(const f32x4 (&v)[4], const float* g, const float* shift, const float* scale, bf16_t* dst, const bool tolds, LAS bf16_t* ldst, LAS bf16_t* ldlo, int lane) {
    float ss = 0.f;
#pragma unroll
    for (int i = 0; i < 4; ++i) ss += v[i][0] * v[i][0] + v[i][1] * v[i][1] + v[i][2] * v[i][2] + v[i][3] * v[i][3];
    ss = wsum(ss); const float rstd = rsqrtf(ss * (1.0f / D) + 1e-6f);
#pragma unroll
    for (int i = 0; i < 4; ++i) { const int col = 256 * i + 4 * lane; const f32x4 gv = *(const f32x4*)(g + col), sh = *(const f32x4*)(shift + col), sc = *(const f32x4*)(scale + col);
        const f32x4 y = v[i] * rstd * gv * (sc + 1.0f) + sh; u32x2 w; w.x = pk2(y[0], y[1]); w.y = pk2(y[2], y[3]);
        *(u32x2*)(dst + col) = w;
        if (tolds) { *(LAS u32x2*)(ldst + col) = w; u32x2 wl;
            wl.x = pk2(y[0] - __uint_as_float(w.x << 16), y[1] - __uint_as_float(w.x & 0xffff0000u)); wl.y = pk2(y[2] - __uint_as_float(w.y << 16), y[3] - __uint_as_float(w.y & 0xffff0000u));
            *(LAS u32x2*)(ldlo + col) = wl; } }
}
__device__ __forceinline__ void phase_norm1(const Cx& p, int layer) {
    const int lane = p.tid & 63, wave = p.tid >> 6;
    const float* mod = WSP(float, WS_MOD) + (size_t)layer * 5 * 6144; const float* g = PIN(I_N1G) + layer * D; bf16_t* hb = WSP(bf16_t, WS_HBUF);
    for (int r = p.bid * 16 + wave * 2; r < ROWS; r += p.G * 16) { f32x4 v0[4], v1[4];
        norm_ld(res_row(p, layer == 0, r), v0, lane); norm_ld(res_row(p, layer == 0, r + 1), v1, lane);
        const int s0 = row_sel(r), s1 = row_sel(r + 1);
        norm_fin(v0, g, mod + s0 * 6144 + 0, mod + s0 * 6144 + 1024, hb + (size_t)r * D, false, (LAS bf16_t*)0, (LAS bf16_t*)0, lane);
        norm_fin(v1, g, mod + s1 * 6144 + 0, mod + s1 * 6144 + 1024, hb + (size_t)(r + 1) * D, false, (LAS bf16_t*)0, (LAS bf16_t*)0, lane); }
}
__device__ __forceinline__ void phase_prep(const Cx& p, LAS unsigned char* lds, int layer, int b) {
    const int lane = p.tid & 63, wave = __builtin_amdgcn_readfirstlane(p.tid >> 6);
    const bf16_t* proj = WSP(bf16_t, WS_PROJ);
    if (p.bid < SB / 33) {
        LAS float* wl = (LAS float*)lds;
        { const float* AW = PIN(I_RW_AW2) + (size_t)layer * 32 * 256; const float* WW = PIN(I_RW_W2) + (size_t)layer * 2 * 32 * 256;
          for (int i = p.tid; i < 96 * 256; i += NTHR) wl[i] = i < 32 * 256 ? AW[i] : WW[i - 32 * 256]; }
        __syncthreads();
        const int h = wave & 3, half = wave >> 2, c = 64 * h + lane;
        const float a0 = PIN(I_RW_A0)[layer * 256 + c], w0f = PIN(I_RW_W0)[(layer * 2 + 0) * 256 + c], w0b = PIN(I_RW_W0)[(layer * 2 + 1) * 256 + c];
        const float kkm = PIN(I_RW_KK)[layer * 256 + c], kam = PIN(I_RW_KA)[layer * 256 + c];
        for (int u = p.bid; u < SB / 33; u += p.G) {
#pragma unroll 1
            for (int i0 = 0; i0 < (half ? 15 : 18); i0 += 3) {
                float xa[3], xf[3], xb[3], kv[3], sa[3], sf[3], sb[3];
#pragma unroll
                for (int t = 0; t < 3; ++t) { const bf16_t* pr = proj + (size_t)tok_row(b, u * 33 + half * 18 + i0 + t) * NPROJ; xa[t] = 0.f; xf[t] = 0.f; xb[t] = 0.f;
                    if (lane < 32) { xa[t] = bf2f(pr[PB_A + lane]); xf[t] = bf2f(pr[PB_WF + lane]); xb[t] = bf2f(pr[PB_WB + lane]); }
                    kv[t] = bf2f(pr[PB_K + c]); sa[t] = a0; sf[t] = w0f; sb[t] = w0b; }
#pragma unroll
                for (int t = 0; t < 3; ++t) { xf[t] = tanhf_(xf[t]); xb[t] = tanhf_(xb[t]); }
#pragma unroll 4
                for (int j = 0; j < 32; ++j) { const float wa = wl[j * 256 + c], wf = wl[(32 + j) * 256 + c], wb = wl[(64 + j) * 256 + c];
#pragma unroll
                    for (int t = 0; t < 3; ++t) { sa[t] += rl(xa[t], j) * wa; sf[t] += rl(xf[t], j) * wf; sb[t] += rl(xb[t], j) * wb; } }
#pragma unroll
                for (int t = 0; t < 3; ++t) { const int s = u * 33 + half * 18 + i0 + t; const float a = sigmoidf_(sa[t]);
                    const float lwf = -__expf(-softplusf_(-sf[t]) - 0.5f), lwb = -__expf(-softplusf_(-sb[t]) - 0.5f);
                    const float kr = kv[t] * kkm; const float ss = wsum(kr * kr); const float kk = kr * rsqrtf(ss + 1e-6f);
                    const size_t o = (size_t)s * 256 + c;
                    WSP(float, SC_RK)[o] = kv[t] * (1.0f + (a - 1.0f) * kam); WSP(float, SC_RKK)[o] = kk; WSP(float, SC_RB)[o] = kk * a;
                    WSP(float, SC_RLW)[o] = lwf; WSP(float, SC_RLW)[(size_t)SB * 256 + o] = lwb; } }
        }
    }
    __syncthreads();
    { LAS bf16_t* T = (LAS bf16_t*)lds; const int tid = p.tid;
      for (int u = p.bid; u < 2 * NTB * 3; u += p.G) { const int mixer = u / (NTB * 3), r2 = u % (NTB * 3), rb = r2 / 3, third = r2 % 3, colbase = (mixer ? PD_Q : PC_X) + 256 * third;
#pragma unroll 4
          for (int q = 0; q < 12; ++q) { const int e = tid + NTHR * q, rr = e >> 11, tok = (e >> 5) & 63, ch = (e & 31) * 8; u32x4 v = (u32x4){0u, 0u, 0u, 0u};
              if (rb < 4) { if (rr == 1) v = *(const u32x4*)(proj + (size_t)(b * NCTX + 64 * rb + tok) * NPROJ + colbase + ch); }
              else { const int gr = rb - 4 + rr - 1; if (gr >= 0 && gr < GRIDH) v = *(const u32x4*)(proj + (size_t)(CROWS + b * SEQ + gr * 64 + tok) * NPROJ + colbase + ch); }
              *(LAS u32x4*)(T + (rr * 66 + tok + 1) * 256 + ch) = v; }
          if (tid < 192) { const int rr = tid >> 6, side = (tid >> 5) & 1, ch = (tid & 31) * 8; u32x4 v = (u32x4){0u, 0u, 0u, 0u};
              if (rb < 4 && rr == 1) { const int tk = side ? 64 * (rb + 1) : 64 * rb - 1; if (tk >= 0 && tk < NCTX) v = *(const u32x4*)(proj + (size_t)(b * NCTX + tk) * NPROJ + colbase + ch); }
              *(LAS u32x4*)(T + (rr * 66 + (side ? 65 : 0)) * 256 + ch) = v; }
          __syncthreads();
          { const int c = tid & 255, th = tid >> 8, chn = 256 * third + c; float w[9];
            const float* cw = (mixer ? PIN(I_DN_CW) : PIN(I_SS_CW)) + (size_t)layer * 9 * 768 + chn;
#pragma unroll
            for (int k = 0; k < 9; ++k) w[k] = cw[k * 768];
            const float bias = mixer ? 0.f : PIN(I_SS_CB)[layer * 768 + chn];
            bf16_t* dst = (mixer ? WSP(bf16_t, SC_DQ) : WSP(bf16_t, SC_SX)) + (size_t)(64 * rb) * 768 + chn;
#pragma unroll 2
            for (int tk = 0; tk < 32; ++tk) { const int x = 32 * th + tk; float acc = bias;
#pragma unroll
                for (int dy = 0; dy < 3; ++dy)
#pragma unroll
                    for (int dx = 0; dx < 3; ++dx) acc += w[dy * 3 + dx] * bf2f(T[(dy * 66 + x + dx) * 256 + c]);
                float y = siluf_(acc);
                if (mixer && third < 2) { const float ss = wsum(y * y); y *= rsqrtf(ss + 1e-6f); if (third == 0) y *= 0.125f; }
                dst[(size_t)x * 768] = (bf16_t)f2bf(y); } }
          __syncthreads();
      }
      for (int e = p.bid * NTHR + tid; e < SB * 24; e += p.G * NTHR) { const int s = e / 24, q = e % 24; const bf16_t* pr = proj + (size_t)tok_row(b, s) * NPROJ;
          if (q < 8) { const int d = q >> 2, h = q & 3; WSP(float, SC_SDT)[(size_t)s * 8 + q] = softplusf_(bf2f(pr[PC_DF + q]) + PIN(I_SS_DTB)[(layer * 2 + d) * 4 + h]); }
          else if (q < 16) { WSP(float, SC_DG)[(size_t)s * 16 + (q - 8)] = sigmoidf_(bf2f(pr[PD_BF + (q - 8)])); }
          else { const int q2 = q - 16, d = q2 >> 2, h = q2 & 3; WSP(float, SC_DG)[(size_t)s * 16 + 8 + q2] = -__expf(PIN(I_DN_ALOG)[(layer * 2 + d) * 4 + h]) * softplusf_(bf2f(pr[PD_AF + q2]) + PIN(I_DN_DTB)[(layer * 2 + d) * 4 + h]); } }
    }
}
__device__ __forceinline__ void phase_scan(const Cx& p, int layer, int b);
__device__ __forceinline__ void phase_post(const Cx& p, int layer, int b) {
    const int lane = p.tid & 63, wave = __builtin_amdgcn_readfirstlane(p.tid >> 6);
    const bf16_t* proj = WSP(bf16_t, WS_PROJ); const bf16_t* of = WSP(bf16_t, SC_OF); const bf16_t* obk = WSP(bf16_t, SC_OB); bf16_t* yc = WSP(bf16_t, WS_HBUF);
    for (int u = p.bid; u < SB / 33; u += p.G) {
        if (wave < 4) { const int h = wave, c = 64 * h + lane; const float ng = PIN(I_GLA_NG)[layer * 256 + c];
            const int c0 = 128 * wave + lane, c1 = c0 + 64; float sd0 = 0.f, sd1 = 0.f, sg0 = 0.f, sg1 = 0.f;
            if (wave < 2) { sd0 = PIN(I_SS_D)[layer * 4 + (c0 >> 6)]; sd1 = PIN(I_SS_D)[layer * 4 + (c1 >> 6)]; sg0 = PIN(I_SS_NG)[layer * 256 + c0]; sg1 = PIN(I_SS_NG)[layer * 256 + c1]; }
#pragma unroll 1
            for (int i0 = 0; i0 < 33; i0 += 3) { float yg[3], y0[3], y1[3];
#pragma unroll
                for (int ii = 0; ii < 3; ++ii) { const int s = u * 33 + i0 + ii, row = tok_row(b, s); const bf16_t* pr = proj + (size_t)row * NPROJ; const bf16_t* o1 = of + (size_t)s * 1024; const bf16_t* o2 = obk + (size_t)s * 1024;
                    yg[ii] = (bf2f(o1[c]) + bf2f(o2[c])) ; const float gz = bf2f(pr[PA_G + c]);
                    const float ms = wsum(yg[ii] * yg[ii]) * (1.0f / 64.0f); yg[ii] = yg[ii] * rsqrtf(ms + 1e-6f) * ng * siluf_(gz);
                    if (wave < 2) { const bf16_t* sx = WSP(bf16_t, SC_SX) + (size_t)s * 768;
                        y0[ii] = (bf2f(o1[512 + c0]) + bf2f(o2[512 + c0]) + sd0 * bf2f(sx[c0])) * siluf_(bf2f(pr[PC_Z + c0]));
                        y1[ii] = (bf2f(o1[512 + c1]) + bf2f(o2[512 + c1]) + sd1 * bf2f(sx[c1])) * siluf_(bf2f(pr[PC_Z + c1]));
                        const float rs = rsqrtf(wsum(y0[ii] * y0[ii] + y1[ii] * y1[ii]) * (1.0f / 128.0f) + 1e-6f); y0[ii] *= rs * sg0; y1[ii] *= rs * sg1; } }
#pragma unroll
                for (int ii = 0; ii < 3; ++ii) { bf16_t* yr = yc + (size_t)tok_row(b, u * 33 + i0 + ii) * D; yr[c] = (bf16_t)f2bf(yg[ii]); if (wave < 2) { yr[512 + c0] = (bf16_t)f2bf(y0[ii]); yr[512 + c1] = (bf16_t)f2bf(y1[ii]); } } }
        } else { const int h = wave - 4, c = 64 * h + lane; float gw[64];
#pragma unroll
            for (int j = 0; j < 64; ++j) gw[j] = PIN(I_RW_GW2)[((size_t)layer * 64 + j) * 256 + c];
            const float lng = PIN(I_RW_LNG)[layer * 256 + c], lnb = PIN(I_RW_LNB)[layer * 256 + c], rrk = PIN(I_RW_RK)[layer * 256 + c], dng = PIN(I_DN_NG)[layer * 256 + c];
#pragma unroll 1
            for (int i0 = 0; i0 < 33; i0 += 3) { float yr_[3], yd[3];
#pragma unroll
                for (int ii = 0; ii < 3; ++ii) { const int s = u * 33 + i0 + ii, row = tok_row(b, s); const bf16_t* pr = proj + (size_t)row * NPROJ; const bf16_t* o1 = of + (size_t)s * 1024; const bf16_t* o2 = obk + (size_t)s * 1024;
                    const float o = bf2f(o1[256 + c]) + bf2f(o2[256 + c]), od = bf2f(o1[768 + c]) + bf2f(o2[768 + c]);
                    const float r = bf2f(pr[PB_R + c]), kp = WSP(float, SC_RK)[(size_t)s * 256 + c], vv = bf2f(pr[PB_V + c]), sg = sigmoidf_(bf2f(pr[PB_G + lane])), dz = bf2f(pr[PD_Z + c]);
                    const float mu = wsum(o) * (1.0f / 64.0f); const float dlt = o - mu; const float var = wsum(dlt * dlt) * (1.0f / 64.0f);
                    const float y = dlt * rsqrtf(var + 64e-5f) * lng + lnb; const float bonus = wsum(r * kp * rrk) * vv; float gate = 0.f;
#pragma unroll
                    for (int j = 0; j < 64; ++j) gate += rl(sg, j) * gw[j];
                    yr_[ii] = (y + bonus) * gate;
                    const float ms = wsum(od * od) * (1.0f / 64.0f); yd[ii] = od * rsqrtf(ms + 1e-6f) * dng * siluf_(dz); }
#pragma unroll
                for (int ii = 0; ii < 3; ++ii) { bf16_t* yr = yc + (size_t)tok_row(b, u * 33 + i0 + ii) * D; yr[256 + c] = (bf16_t)f2bf(yr_[ii]); yr[768 + c] = (bf16_t)f2bf(yd[ii]); } }
        }
    }
}
constexpr int N2_TILE = 32, N2_STRIDE = 2064;
__device__ __forceinline__ void phase_norm2(const Cx& p, LAS unsigned char* lds, int layer, int row_lo) {
    const int tid = p.tid, lane = tid & 63, wave = __builtin_amdgcn_readfirstlane(tid >> 6), fr = lane & 15, fq = lane >> 4;
    const float* mod = WSP(float, WS_MOD) + (size_t)layer * 5 * 6144; const float* g = PIN(I_N2G) + layer * D; bf16_t* hb = WSP(bf16_t, WS_HBUF);
    const bf16_t* rt = WSP(bf16_t, WS_ROUT) + (size_t)layer * 2 * NE * D;
    LAS float* lg = (LAS float*)(lds + 2 * N2_TILE * N2_STRIDE);
    unsigned* cnt = WSP(unsigned, WS_CTL) + CW_CNT + layer * 80 * 16; int* ltok = WSP(int, WS_LTOK); int* tokt = WSP(int, WS_TOKT);
    const float rbias = PIN(I_ROUT_B)[layer * NE + lane];
    const int nun = (ROWS - row_lo) / N2_TILE;
    for (int u = p.bid; u < nun; u += p.G) { const int r0 = row_lo + u * N2_TILE;
#pragma unroll 1
        for (int i = 0; i < 4; i += 2) { const int tr = 4 * wave + i, r = r0 + tr; f32x4 v0[4], v1[4];
            norm_ld(res_row(p, 0, r), v0, lane); norm_ld(res_row(p, 0, r + 1), v1, lane);
            const int s0 = row_sel(r), s1 = row_sel(r + 1);
            norm_fin(v0, g, mod + s0 * 6144 + 3072, mod + s0 * 6144 + 4096, hb + (size_t)r * D, true, (LAS bf16_t*)(lds + tr * N2_STRIDE), (LAS bf16_t*)(lds + N2_TILE * N2_STRIDE + tr * N2_STRIDE), lane);
            norm_fin(v1, g, mod + s1 * 6144 + 3072, mod + s1 * 6144 + 4096, hb + (size_t)(r + 1) * D, true, (LAS bf16_t*)(lds + (tr + 1) * N2_STRIDE), (LAS bf16_t*)(lds + N2_TILE * N2_STRIDE + (tr + 1) * N2_STRIDE), lane); }
        __syncthreads();
        { const int mt = wave >> 2, nt = wave & 3; f32x4 acc = (f32x4){0.f, 0.f, 0.f, 0.f};
          const LAS unsigned char* ap = lds + (16 * mt + fr) * N2_STRIDE + fq * 16; const bf16_t* bp = rt + (size_t)(16 * nt + fr) * D + fq * 8;
#pragma unroll 4
          for (int ks = 0; ks < 32; ++ks) { const bf16x8 a = *(const LAS bf16x8*)(ap + ks * 64), al = *(const LAS bf16x8*)(ap + N2_TILE * N2_STRIDE + ks * 64);
              const bf16x8 bb = *(const bf16x8*)(bp + ks * 32), bl = *(const bf16x8*)(bp + NE * D + ks * 32);
              acc = __builtin_amdgcn_mfma_f32_16x16x32_bf16(a, bb, acc, 0, 0, 0); acc = __builtin_amdgcn_mfma_f32_16x16x32_bf16(al, bb, acc, 0, 0, 0); acc = __builtin_amdgcn_mfma_f32_16x16x32_bf16(a, bl, acc, 0, 0, 0); }
#pragma unroll
          for (int j = 0; j < 4; ++j) lg[(16 * mt + 4 * fq + j) * 64 + 16 * nt + fr] = acc[j]; }
        __syncthreads();
#pragma unroll 1
        for (int i = 0; i < 4; ++i) { const int tr = 4 * wave + i, r = r0 + tr;
            const float sc = sigmoidf_(lg[tr * 64 + lane]); float sel = sc + rbias; float ssum = 0.f; int myE = 0; float myS = 0.f;
#pragma unroll 1
            for (int k = 0; k < TOPK; ++k) { float bv = sel; int bi = lane;
#define ARGSTEP(OV, OI) do { const float ov_ = (OV); const int oi_ = (OI); if (ov_ > bv || (ov_ == bv && oi_ < bi)) { bv = ov_; bi = oi_; } } while (0)
                ARGSTEP(DPPF(bv, 0xB1), DPPI(bi, 0xB1)); ARGSTEP(DPPF(bv, 0x4E), DPPI(bi, 0x4E)); ARGSTEP(DPPF(bv, 0x141), DPPI(bi, 0x141)); ARGSTEP(DPPF(bv, 0x140), DPPI(bi, 0x140));
                ARGSTEP(__uint_as_float(__builtin_amdgcn_ds_swizzle(__float_as_uint(bv), 0x401F)), __builtin_amdgcn_ds_swizzle(bi, 0x401F));
                { const float v0 = rl(bv, 0), v1 = rl(bv, 32); const int i0 = __builtin_amdgcn_readlane(bi, 0), i1 = __builtin_amdgcn_readlane(bi, 32); if (v1 > v0 || (v1 == v0 && i1 < i0)) { bv = v1; bi = i1; } else { bv = v0; bi = i0; } }
#undef ARGSTEP
                const int e = __builtin_amdgcn_readfirstlane(bi); const float se = rl(sc, e);
                ssum += se; if (lane == k) { myE = e; myS = se; } if (lane == e) sel = -1e30f; }
            if (lane < TOPK) { const unsigned pos = atomicAdd(cnt + myE * 16, 1u); ltok[(size_t)myE * ROWS + pos] = r; tokt[(size_t)r * 16 + lane] = (myE << 16) | (int)pos; ((float*)tokt)[(size_t)r * 16 + 8 + lane] = myS / ssum * 2.5f; } }
        __syncthreads();
    }
}
__device__ __forceinline__ void moe_table(const Cx& p, LAS int* tb, int layer, int row_lo) {
    const unsigned* cnt = WSP(unsigned, WS_CTL) + CW_CNT + layer * 80 * 16;
    if (p.tid == 0) { int acc = 0;
#pragma unroll 1
        for (int e = 0; e < NE1; ++e) { const int c = e < NE ? (int)__hip_atomic_load(cnt + e * 16, __ATOMIC_RELAXED, __HIP_MEMORY_SCOPE_AGENT) : ROWS - row_lo; tb[e] = c; tb[128 + e] = acc; acc += (c + 255) >> 8; }
        tb[128 + NE1] = acc; }
    __syncthreads();
}
__device__ __forceinline__ void phase_combine(const Cx& p, const LAS int* tb, int layer, int row_lo, int half) {
    const int lane = p.tid & 63, wave = p.tid >> 6; const bf16_t* Y = WSP(bf16_t, WS_Y); const int* tokt = WSP(int, WS_TOKT);
    const float* gate = WSP(float, WS_MOD) + (size_t)layer * 5 * 6144 + 5120; const int col = 512 * half + 8 * lane; const int shbase = tb[128 + NE] * 256;
#pragma unroll 2
    for (int r = row_lo + p.bid * 8 + wave; r < ROWS; r += p.G * 8) {
        const int sw = lane < 16 ? tokt[(size_t)r * 16 + lane] : 0;
        float a[8];
        { const u32x4 y = *(const u32x4*)(Y + (size_t)(shbase + (r - row_lo)) * 512 + 8 * lane);
#pragma unroll
          for (int q = 0; q < 4; ++q) { a[2 * q] = __uint_as_float(y[q] << 16); a[2 * q + 1] = __uint_as_float(y[q] & 0xffff0000u); } }
#pragma unroll
        for (int k = 0; k < 8; ++k) { const int sl = __builtin_amdgcn_readlane(sw, k); const float w = __uint_as_float(__builtin_amdgcn_readlane(sw, 8 + k));
            const int hrow = tb[128 + (sl >> 16)] * 256 + (sl & 0xffff); const u32x4 y = *(const u32x4*)(Y + (size_t)hrow * 512 + 8 * lane);
#pragma unroll
            for (int q = 0; q < 4; ++q) { a[2 * q] += w * __uint_as_float(y[q] << 16); a[2 * q + 1] += w * __uint_as_float(y[q] & 0xffff0000u); } }
        float* x = (float*)res_row(p, 0, r) + col; const float* gp = gate + row_sel(r) * 6144 + col;
#pragma unroll
        for (int q = 0; q < 2; ++q) { const f32x4 gv = *(const f32x4*)(gp + 4 * q); f32x4 xv = *(const f32x4*)(x + 4 * q);
            xv[0] += gv[0] * a[4 * q]; xv[1] += gv[1] * a[4 * q + 1]; xv[2] += gv[2] * a[4 * q + 2]; xv[3] += gv[3] * a[4 * q + 3]; *(f32x4*)(x + 4 * q) = xv; }
    }
}
__device__ __forceinline__ void phase_final(const Cx& p) {
    const int lane = p.tid & 63, wave = p.tid >> 6; const float* g = PIN(I_FNG);
    for (int r = p.bid * 16 + wave * 2; r < NB * SEQ; r += p.G * 16) { f32x4 v[2][4];
        norm_ld(p.out + (size_t)r * D, v[0], lane); norm_ld(p.out + (size_t)(r + 1) * D, v[1], lane);
#pragma unroll
        for (int q = 0; q < 2; ++q) { float* x = p.out + (size_t)(r + q) * D; float ss = 0.f;
#pragma unroll
            for (int i = 0; i < 4; ++i) ss += v[q][i][0] * v[q][i][0] + v[q][i][1] * v[q][i][1] + v[q][i][2] * v[q][i][2] + v[q][i][3] * v[q][i][3];
            ss = wsum(ss); const float rstd = rsqrtf(ss * (1.0f / D) + 1e-6f);
#pragma unroll
            for (int i = 0; i < 4; ++i) *(f32x4*)(x + 256 * i + 4 * lane) = v[q][i] * rstd * *(const f32x4*)(g + 256 * i + 4 * lane); } }
}
__device__ __forceinline__ int chain_tb(int n, int d) { return d == 0 ? n : (n < 4 ? 3 - n : 135 - n); }
__device__ __forceinline__ int tb_row0(int b, int tb) { return tb < 4 ? b * NCTX + 64 * tb : CROWS + b * SEQ + 64 * (tb - 4); }
constexpr int TS = 144;
template <int K, int NT> __device__ __forceinline__ void mm_rows(const LAS unsigned char* A, int lda, const LAS unsigned char* Bt, int ldb, int mt, int nt0, int fr, int fq, f32x4 (&acc)[NT]) {
#pragma unroll
    for (int ks = 0; ks < K / 32; ++ks) { const bf16x8 a = *(const LAS bf16x8*)(A + (16 * mt + fr) * lda + ks * 64 + fq * 16);
#pragma unroll
        for (int nt = 0; nt < NT; ++nt) { const bf16x8 bb = *(const LAS bf16x8*)(Bt + (16 * (nt0 + nt) + fr) * ldb + ks * 64 + fq * 16);
            acc[nt] = __builtin_amdgcn_mfma_f32_16x16x32_bf16(a, bb, acc[nt], 0, 0, 0); } }
}
#define UNIT_LOOP(u, N, OFF) for (int u = (p.bid + p.G - ((OFF) % p.G)) % p.G; u < (N); u += p.G)
__device__ __forceinline__ void gla_p1(const Cx& p, LAS unsigned char* lds, int layer, int b) {
    const int tid = p.tid, lane = tid & 63, wave = __builtin_amdgcn_readfirstlane(tid >> 6), fr = lane & 15, fq = lane >> 4;
    LAS unsigned char* ksT = lds; LAS unsigned char* vT = lds + 64 * TS; LAS float* gs = (LAS float*)(lds + 2 * 64 * TS); LAS float* glb = gs + 512;
    const bf16_t* proj = WSP(bf16_t, WS_PROJ); const int mt = wave >> 1, nt0 = (wave & 1) * 2;
    UNIT_LOOP(u, NUNIT, 0) { const int tb = u >> 3, h = (u >> 1) & 3, d = u & 1; const int cl = lane, tg = wave, c = 64 * h + cl;
        const bf16_t* pr0 = proj + (size_t)tb_row0(b, tb) * NPROJ;
        float w2[16];
#pragma unroll
        for (int r = 0; r < 16; ++r) w2[r] = PIN(I_GLA_W2)[((size_t)(layer * 2 + d) * 16 + r) * 256 + c];
        const float gb = PIN(I_GLA_B)[(layer * 2 + d) * 256 + c];
        { const int e = tid * 2, i = e >> 4, r = e & 15; const unsigned w = *(const unsigned*)(pr0 + (size_t)i * NPROJ + (d ? PA_GB : PA_GF) + r); glb[e] = __uint_as_float(w << 16); glb[e + 1] = __uint_as_float(w & 0xffff0000u); }
        __syncthreads();
        float bl[8]; float run = 0.f;
#pragma unroll
        for (int ii = 0; ii < 8; ++ii) { const int i8 = d ? 7 - ii : ii; const LAS float* gl_ = glb + (8 * tg + i8) * 16; float z = gb;
#pragma unroll
            for (int r = 0; r < 16; ++r) z += gl_[r] * w2[r];
            run += logsigmoidf_(z) * (1.0f / 16.0f); if (d) bl[7 - ii] = run; else bl[ii] = run; }
        gs[tg * 64 + cl] = run;
        __syncthreads();
        float off = 0.f, total = 0.f;
#pragma unroll
        for (int g2 = 0; g2 < 8; ++g2) { const float t = gs[g2 * 64 + cl]; total += t; if (d ? g2 > tg : g2 < tg) off += t; }
#pragma unroll
        for (int i8 = 0; i8 < 8; i8 += 2) { const int i = 8 * tg + i8; const bf16_t* pa = pr0 + (size_t)i * NPROJ; const bf16_t* pb = pa + NPROJ;
            const float ka = bf2f(pa[PA_K + c]) * __expf(total - (bl[i8] + off)), kb = bf2f(pb[PA_K + c]) * __expf(total - (bl[i8 + 1] + off));
            *(LAS unsigned*)(ksT + cl * TS + i * 2) = pk2(ka, kb); *(LAS unsigned*)(vT + cl * TS + i * 2) = (unsigned)pa[PA_V + c] | ((unsigned)pb[PA_V + c] << 16); }
        if (tg == 0) WSP(float, SC_GLA_DEC)[(size_t)u * 64 + cl] = __expf(total);
        __syncthreads();
        { f32x4 acc[2] = {(f32x4){0.f, 0.f, 0.f, 0.f}, (f32x4){0.f, 0.f, 0.f, 0.f}}; float* kv = WSP(float, SC_GLA_S) + (size_t)u * 4096;
          mm_rows<64, 2>(ksT, TS, vT, TS, mt, nt0, fr, fq, acc);
#pragma unroll
          for (int t = 0; t < 2; ++t)
#pragma unroll
              for (int j = 0; j < 4; ++j) kv[(16 * mt + 4 * fq + j) * 64 + 16 * (nt0 + t) + fr] = acc[t][j]; }
        __syncthreads();
    }
}
__device__ __forceinline__ void gla_chain(const Cx& p, int h, int d, int part) {
    if (p.tid >= 256) return;
    const int e0 = part * 1024 + p.tid * 4, dk = e0 >> 6;
    f32x4 s0 = (f32x4){0.f, 0.f, 0.f, 0.f};
    f32x4 n0[6]; float dc[6];
#define GC_LD(q, n_) do { const int u_ = (chain_tb((n_), d) * 4 + h) * 2 + d; n0[q] = *(const f32x4*)(WSP(float, SC_GLA_S) + (size_t)u_ * 4096 + e0); dc[q] = WSP(float, SC_GLA_DEC)[(size_t)u_ * 64 + dk]; } while (0)
#define GC_ST(q, n_) do { const int u_ = (chain_tb((n_), d) * 4 + h) * 2 + d; float* k_ = WSP(float, SC_GLA_S) + (size_t)u_ * 4096 + e0; \
        const f32x4 a0_ = n0[q]; const float de_ = dc[q]; if ((n_) + 6 < NTB) GC_LD(q, (n_) + 6); *(f32x4*)k_ = s0; s0 = s0 * de_ + a0_; } while (0)
    GC_LD(0, 0); GC_LD(1, 1); GC_LD(2, 2); GC_LD(3, 3); GC_LD(4, 4); GC_LD(5, 5);
#pragma unroll 1
    for (int n = 0; n < NTB; n += 6) { GC_ST(0, n); GC_ST(1, n + 1); GC_ST(2, n + 2); GC_ST(3, n + 3); GC_ST(4, n + 4); GC_ST(5, n + 5); }
#undef GC_LD
#undef GC_ST
}
__device__ __forceinline__ void gla_p2(const Cx& p, LAS unsigned char* lds, int layer, int b) {
    const int tid = p.tid, lane = tid & 63, wave = __builtin_amdgcn_readfirstlane(tid >> 6), fr = lane & 15, fq = lane >> 4;
    LAS unsigned char* qt = lds; LAS unsigned char* kt = lds + 64 * TS; LAS unsigned char* vT = lds + 2 * 64 * TS; LAS unsigned char* sT = lds + 3 * 64 * TS; LAS unsigned char* att = lds + 4 * 64 * TS;
    LAS float* gs = (LAS float*)(lds + 5 * 64 * TS); LAS float* glb = gs + 512;
    const bf16_t* proj = WSP(bf16_t, WS_PROJ);
    UNIT_LOOP(u, NUNIT, 128) { const int tb = u >> 3, h = (u >> 1) & 3, d = u & 1; const int cl = tid & 63, tg = tid >> 6, c = 64 * h + cl;
        const int row0 = tb_row0(b, tb), s0 = 64 * tb; const bf16_t* pr0 = proj + (size_t)row0 * NPROJ;
        float w2[16];
#pragma unroll
        for (int r = 0; r < 16; ++r) w2[r] = PIN(I_GLA_W2)[((size_t)(layer * 2 + d) * 16 + r) * 256 + c];
        const float gb = PIN(I_GLA_B)[(layer * 2 + d) * 256 + c];
        { const int e = tid * 2, i = e >> 4, r = e & 15; const unsigned w = *(const unsigned*)(pr0 + (size_t)i * NPROJ + (d ? PA_GB : PA_GF) + r); glb[e] = __uint_as_float(w << 16); glb[e + 1] = __uint_as_float(w & 0xffff0000u); }
        __syncthreads();
        float bl[8]; float run = 0.f;
#pragma unroll
        for (int ii = 0; ii < 8; ++ii) { const int i8 = d ? 7 - ii : ii; const LAS float* gl_ = glb + (8 * tg + i8) * 16; float z = gb;
#pragma unroll
            for (int r = 0; r < 16; ++r) z += gl_[r] * w2[r];
            run += logsigmoidf_(z) * (1.0f / 16.0f); if (d) bl[7 - ii] = run; else bl[ii] = run; }
        gs[tg * 64 + cl] = run;
        { const float* sp = WSP(float, SC_GLA_S) + (size_t)u * 4096;
#pragma unroll
          for (int q = 0; q < 8; ++q) { const int e = tid + NTHR * q, dk = e >> 6, dv = e & 63; *(LAS bf16_t*)(sT + dv * TS + dk * 2) = (bf16_t)f2bf(sp[e]); } }
        __syncthreads();
        float off = 0.f;
#pragma unroll
        for (int g2 = 0; g2 < 8; ++g2) if (d ? g2 > tg : g2 < tg) off += gs[g2 * 64 + cl];
#pragma unroll
        for (int i8 = 0; i8 < 8; ++i8) { const int i = 8 * tg + i8; const bf16_t* pr = pr0 + (size_t)i * NPROJ; const float bi = bl[i8] + off;
            *(LAS bf16_t*)(qt + i * TS + cl * 2) = (bf16_t)f2bf(bf2f(pr[PA_Q + c]) * 0.125f * __expf(bi));
            *(LAS bf16_t*)(kt + i * TS + cl * 2) = (bf16_t)f2bf(bf2f(pr[PA_K + c]) * __expf(-bi));
            *(LAS bf16_t*)(vT + cl * TS + i * 2) = pr[PA_V + c]; }
        __syncthreads();
        const int mt = wave >> 1, nt0 = (wave & 1) * 2;
        { f32x4 acc[2] = {(f32x4){0.f, 0.f, 0.f, 0.f}, (f32x4){0.f, 0.f, 0.f, 0.f}};
          mm_rows<64, 2>(qt, TS, kt, TS, mt, nt0, fr, fq, acc);
#pragma unroll
          for (int t = 0; t < 2; ++t)
#pragma unroll
              for (int j = 0; j < 4; ++j) { const int i = 16 * mt + 4 * fq + j, jj = 16 * (nt0 + t) + fr; const bool keep = d ? jj >= i : jj <= i;
                  *(LAS bf16_t*)(att + i * TS + jj * 2) = (bf16_t)f2bf(keep ? acc[t][j] : 0.f); } }
        __syncthreads();
        { f32x4 acc[2] = {(f32x4){0.f, 0.f, 0.f, 0.f}, (f32x4){0.f, 0.f, 0.f, 0.f}};
          mm_rows<64, 2>(att, TS, vT, TS, mt, nt0, fr, fq, acc);
          mm_rows<64, 2>(qt, TS, sT, TS, mt, nt0, fr, fq, acc);
          bf16_t* ob = WSP(bf16_t, d ? SC_OB : SC_OF);
#pragma unroll
          for (int t = 0; t < 2; ++t)
#pragma unroll
              for (int j = 0; j < 4; ++j) ob[(size_t)(s0 + 16 * mt + 4 * fq + j) * 1024 + 64 * h + 16 * (nt0 + t) + fr] = (bf16_t)f2bf(acc[t][j]); }
        __syncthreads();
    }
}
constexpr int TS2 = 272;
__device__ __forceinline__ float ssd_acum(float a, int d, int lane, float& total) {
    float pre = a;
#pragma unroll
    for (int o = 1; o < 64; o <<= 1) { const float t = shup_(pre, lane, o); if (lane >= o) pre += t; }
    total = rl(pre, 63);
    return d ? total - pre + a : pre;
}
__device__ __forceinline__ void ssd_p1(const Cx& p, LAS unsigned char* lds, int layer, int b) {
    const int tid = p.tid, lane = tid & 63, wave = __builtin_amdgcn_readfirstlane(tid >> 6), fr = lane & 15, fq = lane >> 4;
    LAS unsigned char* BT = lds; LAS unsigned char* xT = lds + 128 * TS; LAS float* AC = (LAS float*)(lds + 128 * TS + 4 * 64 * TS);
    UNIT_LOOP(u2, NTB * 2, 32) { const int tb = u2 >> 1, g = u2 & 1, s0 = 64 * tb;
        const bf16_t* sx = WSP(bf16_t, SC_SX) + (size_t)s0 * 768; const float* sdt = WSP(float, SC_SDT) + (size_t)s0 * 8;
        if (wave < 4) { const int hd = wave, h = 2 * g + (hd >> 1), d = hd & 1; const float aneg = -__expf(PIN(I_SS_ALOG)[(layer * 2 + d) * 4 + h]);
            float tot; const float ac = ssd_acum(aneg * sdt[lane * 8 + d * 4 + h], d, lane, tot); AC[hd * 64 + lane] = ac; if (lane == 0) { AC[256 + hd] = tot; WSP(float, SC_SSD_CD)[(tb * 4 + h) * 2 + d] = __expf(tot); } }
#pragma unroll 2
        for (int q = 0; q < 16; ++q) { const int e = tid + NTHR * q, i = e >> 7, s = e & 127; *(LAS bf16_t*)(BT + s * TS + i * 2) = sx[(size_t)i * 768 + 256 + 128 * g + s]; }
        __syncthreads();
#pragma unroll 2
        for (int q = 0; q < 32; ++q) { const int e = tid + NTHR * q, hd = e >> 12, i = (e >> 6) & 63, pp = e & 63, h = 2 * g + (hd >> 1), d = hd & 1;
            const float x = bf2f(sx[(size_t)i * 768 + 64 * h + pp]) * sdt[i * 8 + d * 4 + h] * __expf(AC[256 + hd] - AC[hd * 64 + i]);
            *(LAS bf16_t*)(xT + (hd * 64 + pp) * TS + i * 2) = (bf16_t)f2bf(x); }
        __syncthreads();
        { const int hd = wave >> 1, half = wave & 1, h = 2 * g + (hd >> 1), d = hd & 1; float* cs = WSP(float, SC_SSD_S) + (size_t)((tb * 4 + h) * 2 + d) * 8192;
#pragma unroll 1
          for (int mt = 0; mt < 4; ++mt) { f32x4 acc[4];
#pragma unroll
              for (int t = 0; t < 4; ++t) acc[t] = (f32x4){0.f, 0.f, 0.f, 0.f};
              mm_rows<64, 4>(xT + hd * 64 * TS, TS, BT, TS, mt, 4 * half, fr, fq, acc);
#pragma unroll
              for (int t = 0; t < 4; ++t)
#pragma unroll
                  for (int j = 0; j < 4; ++j) cs[(16 * mt + 4 * fq + j) * 128 + 16 * (4 * half + t) + fr] = acc[t][j]; } }
        __syncthreads();
    }
}
__device__ __forceinline__ void ssd_chain(const Cx& p, int h, int d, int part) {
    if (p.tid >= 256) return;
    const int e0 = part * 1024 + p.tid * 4;
    f32x4 s = (f32x4){0.f, 0.f, 0.f, 0.f}; f32x4 nx[6]; float cd[6];
#define SC_LD(q, n_) do { const int u_ = (chain_tb((n_), d) * 4 + h) * 2 + d; nx[q] = *(const f32x4*)(WSP(float, SC_SSD_S) + (size_t)u_ * 8192 + e0); cd[q] = WSP(float, SC_SSD_CD)[u_]; } while (0)
#define SC_ST(q, n_) do { const int u_ = (chain_tb((n_), d) * 4 + h) * 2 + d; float* c_ = WSP(float, SC_SSD_S) + (size_t)u_ * 8192 + e0; const f32x4 a_ = nx[q]; const float de_ = cd[q]; \
        if ((n_) + 6 < NTB) SC_LD(q, (n_) + 6); *(f32x4*)c_ = s; s = s * de_ + a_; } while (0)
    SC_LD(0, 0); SC_LD(1, 1); SC_LD(2, 2); SC_LD(3, 3); SC_LD(4, 4); SC_LD(5, 5);
#pragma unroll 1
    for (int n = 0; n < NTB; n += 6) { SC_ST(0, n); SC_ST(1, n + 1); SC_ST(2, n + 2); SC_ST(3, n + 3); SC_ST(4, n + 4); SC_ST(5, n + 5); }
#undef SC_LD
#undef SC_ST
}
__device__ __forceinline__ void ssd_p2(const Cx& p, LAS unsigned char* lds, int layer, int b) {
    const int tid = p.tid, lane = tid & 63, wave = __builtin_amdgcn_readfirstlane(tid >> 6), fr = lane & 15, fq = lane >> 4;
    LAS unsigned char* Ct = lds; LAS unsigned char* Bt2 = lds + 64 * TS2; LAS float* cb = (LAS float*)(lds + 2 * 64 * TS2); LAS float* AC = cb + 64 * 65;
    LAS unsigned char* Mt = (LAS unsigned char*)(AC + 260 + 4); LAS unsigned char* xT = Mt + 64 * TS; LAS unsigned char* Sb = xT + 64 * TS;
    const int mt = wave >> 1, nt0 = (wave & 1) * 2;
    UNIT_LOOP(u2, NTB * 2, 160) { const int tb = u2 >> 1, g = u2 & 1, s0 = 64 * tb;
        const bf16_t* sx = WSP(bf16_t, SC_SX) + (size_t)s0 * 768; const float* sdt = WSP(float, SC_SDT) + (size_t)s0 * 8;
        if (wave < 4) { const int hd = wave, h = 2 * g + (hd >> 1), d = hd & 1; const float aneg = -__expf(PIN(I_SS_ALOG)[(layer * 2 + d) * 4 + h]);
            float tot; const float ac = ssd_acum(aneg * sdt[lane * 8 + d * 4 + h], d, lane, tot); AC[hd * 64 + lane] = ac; }
#pragma unroll
        for (int q = 0; q < 2; ++q) { const int e = tid + NTHR * q, i = e >> 4, ch = e & 15;
            *(LAS u32x4*)(Ct + i * TS2 + ch * 16) = *(const u32x4*)(sx + (size_t)i * 768 + 512 + 128 * g + ch * 8);
            *(LAS u32x4*)(Bt2 + i * TS2 + ch * 16) = *(const u32x4*)(sx + (size_t)i * 768 + 256 + 128 * g + ch * 8); }
        __syncthreads();
        { f32x4 acc[2] = {(f32x4){0.f, 0.f, 0.f, 0.f}, (f32x4){0.f, 0.f, 0.f, 0.f}};
          mm_rows<128, 2>(Ct, TS2, Bt2, TS2, mt, nt0, fr, fq, acc);
#pragma unroll
          for (int t = 0; t < 2; ++t)
#pragma unroll
              for (int j = 0; j < 4; ++j) cb[(16 * mt + 4 * fq + j) * 65 + 16 * (nt0 + t) + fr] = acc[t][j]; }
        __syncthreads();
#pragma unroll 1
        for (int hd = 0; hd < 4; ++hd) { const int h = 2 * g + (hd >> 1), d = hd & 1;
            { const int i = tid >> 3, j0 = (tid & 7) * 8; const float ai = AC[hd * 64 + i]; unsigned w[4];
#pragma unroll
              for (int jj = 0; jj < 8; jj += 2) { float m[2];
#pragma unroll
                  for (int q = 0; q < 2; ++q) { const int j = j0 + jj + q; const bool keep = d ? j >= i : j <= i; m[q] = keep ? cb[i * 65 + j] * __expf(ai - AC[hd * 64 + j]) : 0.f; }
                  w[jj >> 1] = pk2(m[0], m[1]); }
              *(LAS u32x4*)(Mt + i * TS + j0 * 2) = (u32x4){w[0], w[1], w[2], w[3]}; }
#pragma unroll 2
            for (int q = 0; q < 8; ++q) { const int e = tid + NTHR * q, j = e >> 6, pp = e & 63;
                *(LAS bf16_t*)(xT + pp * TS + j * 2) = (bf16_t)f2bf(bf2f(sx[(size_t)j * 768 + 64 * h + pp]) * sdt[j * 8 + d * 4 + h]); }
            { const float* sp = WSP(float, SC_SSD_S) + (size_t)((tb * 4 + h) * 2 + d) * 8192;
#pragma unroll
              for (int q = 0; q < 4; ++q) { const int e = (tid + NTHR * q) * 4, pp = e >> 7, s = e & 127; const f32x4 v = *(const f32x4*)(sp + e);
                  *(LAS u32x2*)(Sb + pp * TS2 + s * 2) = (u32x2){pk2(v[0], v[1]), pk2(v[2], v[3])}; } }
            __syncthreads();
            { f32x4 acc[2] = {(f32x4){0.f, 0.f, 0.f, 0.f}, (f32x4){0.f, 0.f, 0.f, 0.f}};
              mm_rows<128, 2>(Ct, TS2, Sb, TS2, mt, nt0, fr, fq, acc);
#pragma unroll
              for (int j = 0; j < 4; ++j) { const float sc = __expf(AC[hd * 64 + 16 * mt + 4 * fq + j]); acc[0][j] *= sc; acc[1][j] *= sc; }
              mm_rows<64, 2>(Mt, TS, xT, TS, mt, nt0, fr, fq, acc);
              bf16_t* ob = WSP(bf16_t, d ? SC_OB : SC_OF);
#pragma unroll
              for (int t = 0; t < 2; ++t)
#pragma unroll
                  for (int j = 0; j < 4; ++j) ob[(size_t)(s0 + 16 * mt + 4 * fq + j) * 1024 + 512 + 64 * h + 16 * (nt0 + t) + fr] = (bf16_t)f2bf(acc[t][j]); }
            __syncthreads();
        }
    }
}
constexpr int AFS = 68;
__device__ __forceinline__ int dr_mfrag_idx(int row, int col) { return (((row >> 4) * 2 + (col >> 5)) * 64 + ((col >> 2) & 3) * 16 + (row & 15)) * 8 + ((col >> 4) & 1) * 4 + (col & 3); }
template <class RhsF> __device__ __forceinline__ void dr_block_solve(const LAS unsigned char* Abf, const LAS float* AfT, LAS unsigned char* XT, LAS float* Dbuf, const float sgn, const int wave, const RhsF& rhs, bf16_t* wu) {
#pragma unroll 1
    for (int kb_ = 0; kb_ < 4; ++kb_) {
        { const int lane = lane_id_asm(), fr = lane & 15, fq = lane >> 4; f32x4 acc = (f32x4){0.f, 0.f, 0.f, 0.f};
          if (kb_ > 0) {
#pragma unroll
              for (int ks = 0; ks < 2; ++ks) { const bf16x8 a = *(const LAS bf16x8*)(Abf + (16 * kb_ + fr) * TS + ks * 64 + fq * 16), bb = *(const LAS bf16x8*)(XT + (16 * wave + fr) * TS + ks * 64 + fq * 16);
                  acc = __builtin_amdgcn_mfma_f32_16x16x32_bf16(a, bb, acc, 0, 0, 0); } }
          *(LAS f32x4*)(Dbuf + (16 * wave + fr) * 20 + 4 * fq) = acc; }
        __syncthreads();
        if (wave < 2) { const int col = wave * 64 + lane_id_asm(); float x[16];
#pragma unroll
            for (int i = 0; i < 16; ++i) x[i] = rhs(16 * kb_ + i, col) - sgn * Dbuf[col * 20 + i];
            const LAS float* Ab = AfT + (16 * kb_) * AFS + 16 * kb_;
#pragma unroll
            for (int j = 0; j < 15; ++j) { const float xj = sgn * x[j];
#pragma unroll
                for (int i = j + 1; i < 16; ++i) x[i] -= Ab[j * AFS + i] * xj; }
            u32x4 w0, w1;
#pragma unroll
            for (int q = 0; q < 4; ++q) { w0[q] = pk2(x[2 * q], x[2 * q + 1]); w1[q] = pk2(x[8 + 2 * q], x[8 + 2 * q + 1]); }
            *(LAS u32x4*)(XT + col * TS + (16 * kb_) * 2) = w0; *(LAS u32x4*)(XT + col * TS + (16 * kb_ + 8) * 2) = w1;
#pragma unroll
            for (int i = 0; i < 16; ++i) wu[(16 * kb_ + i) * 128 + col] = (bf16_t)f2bf(x[i]); }
        __syncthreads();
    }
}
struct GdnRhs { const LAS unsigned char* kb; const LAS unsigned char* vb; const LAS float* GC;
    __device__ __forceinline__ float operator()(int r, int col) const { return col < 64 ? bf2f(*(const LAS bf16_t*)(kb + r * TS + col * 2)) * __expf(GC[r]) : bf2f(*(const LAS bf16_t*)(vb + r * TS + (col - 64) * 2)); } };
__device__ __forceinline__ void gdn_p1(const Cx& p, LAS unsigned char* lds, int layer, int b) {
    const int wave = __builtin_amdgcn_readfirstlane(p.tid >> 6);
#define GDN_LANES const int lane = lane_id_asm(), tid = wave * 64 + lane, fr = lane & 15, fq = lane >> 4; (void)tid; (void)fr; (void)fq
    LAS unsigned char* kh = lds; LAS unsigned char* kb = lds + 64 * TS; LAS unsigned char* vb = lds + 2 * 64 * TS; LAS unsigned char* Abf = lds + 3 * 64 * TS; LAS unsigned char* kdT = lds + 4 * 64 * TS; LAS unsigned char* XT = lds + 5 * 64 * TS;
    LAS float* Af = (LAS float*)(lds + 7 * 64 * TS); LAS float* Dbuf = Af + 64 * AFS; LAS float* GC = Dbuf + 128 * 20;
    const int mt = wave >> 1, nt0 = (wave & 1) * 2;
    UNIT_LOOP(u, NUNIT, 64) { const int tb = u >> 3, h = (u >> 1) & 3, d = u & 1, s0 = 64 * tb;
        const bf16_t* dq = WSP(bf16_t, SC_DQ) + (size_t)s0 * 768; const float* dg = WSP(float, SC_DG) + (size_t)s0 * 16;
        if (wave == 0) { GDN_LANES; const int i = d ? 63 - lane : lane; float pre = dg[i * 16 + 8 + d * 4 + h];
#pragma unroll
            for (int o = 1; o < 64; o <<= 1) { const float t = shup_(pre, lane, o); if (lane >= o) pre += t; }
            GC[lane] = pre; }
        { GDN_LANES; const int r = tid >> 3, c0 = (tid & 7) * 8, i = d ? 63 - r : r; const float beta = dg[i * 16 + d * 4 + h];
          const u32x4 kv = *(const u32x4*)(dq + (size_t)i * 768 + 256 + 64 * h + c0), vv = *(const u32x4*)(dq + (size_t)i * 768 + 512 + 64 * h + c0); u32x4 kw, vw;
#pragma unroll
          for (int q = 0; q < 4; ++q) { kw[q] = pk2(__uint_as_float(kv[q] << 16) * beta, __uint_as_float(kv[q] & 0xffff0000u) * beta); vw[q] = pk2(__uint_as_float(vv[q] << 16) * beta, __uint_as_float(vv[q] & 0xffff0000u) * beta); }
          *(LAS u32x4*)(kh + r * TS + c0 * 2) = kv; *(LAS u32x4*)(kb + r * TS + c0 * 2) = kw; *(LAS u32x4*)(vb + r * TS + c0 * 2) = vw;
          *(LAS u32x4*)(XT + (2 * r) * TS + c0 * 2) = (u32x4){0u, 0u, 0u, 0u}; *(LAS u32x4*)(XT + (2 * r + 1) * TS + c0 * 2) = (u32x4){0u, 0u, 0u, 0u}; }
        __syncthreads();
        const float gtot = GC[63];
        { GDN_LANES; f32x4 acc[2] = {(f32x4){0.f, 0.f, 0.f, 0.f}, (f32x4){0.f, 0.f, 0.f, 0.f}};
          mm_rows<64, 2>(kb, TS, kh, TS, mt, nt0, fr, fq, acc);
#pragma unroll
          for (int t = 0; t < 2; ++t)
#pragma unroll
              for (int j = 0; j < 4; ++j) { const int r = 16 * mt + 4 * fq + j, jj = 16 * (nt0 + t) + fr; const float a = jj < r ? acc[t][j] * __expf(GC[r] - GC[jj]) : 0.f;
                  Af[jj * AFS + r] = a; *(LAS bf16_t*)(Abf + r * TS + jj * 2) = (bf16_t)f2bf(a); }
#pragma unroll 2
          for (int q = 0; q < 8; ++q) { const int e = tid + NTHR * q, r = e >> 6, cc = e & 63;
              *(LAS bf16_t*)(kdT + cc * TS + r * 2) = (bf16_t)f2bf(bf2f(*(const LAS bf16_t*)(kh + r * TS + cc * 2)) * __expf(gtot - GC[r])); } }
        __syncthreads();
        { const GdnRhs rhs{kb, vb, GC}; dr_block_solve(Abf, Af, XT, Dbuf, 1.0f, wave, rhs, WSP(bf16_t, SC_DR_WU) + (size_t)u * 8192); }
        { GDN_LANES; f32x4 am[2] = {(f32x4){0.f, 0.f, 0.f, 0.f}, (f32x4){0.f, 0.f, 0.f, 0.f}}, an[2] = {(f32x4){0.f, 0.f, 0.f, 0.f}, (f32x4){0.f, 0.f, 0.f, 0.f}};
          mm_rows<64, 2>(kdT, TS, XT, TS, mt, nt0, fr, fq, am);
          mm_rows<64, 2>(kdT, TS, XT + 64 * TS, TS, mt, nt0, fr, fq, an);
          bf16_t* Mg = WSP(bf16_t, SC_DR_M) + (size_t)u * 4096; bf16_t* Ng = WSP(bf16_t, SC_DR_NS) + (size_t)u * 4096; const float eg = __expf(gtot);
#pragma unroll
          for (int t = 0; t < 2; ++t) {
#pragma unroll
              for (int j = 0; j < 4; ++j) { const int row = 16 * mt + 4 * fq + j, col = 16 * (nt0 + t) + fr; Mg[dr_mfrag_idx(row, col)] = (bf16_t)f2bf((row == col ? eg : 0.f) - am[t][j]); }
              *(u32x2*)(Ng + (((nt0 + t) * 4 + mt) * 64 + lane) * 4) = (u32x2){pk2(an[t][0], an[t][1]), pk2(an[t][2], an[t][3])}; } }
        __syncthreads();
    }
#undef GDN_LANES
}
__device__ __forceinline__ void dr_chain(const Cx& p, size_t offM, size_t offNS, int h, int d, int cb) {
    const int lane = p.tid & 63, fr = lane & 15, fq = lane >> 4;
    if (p.tid >= 64) return;
    f32x4 acc[4];
#pragma unroll
    for (int t = 0; t < 4; ++t) acc[t] = (f32x4){0.f, 0.f, 0.f, 0.f};
    bf16x8 mR[4][4][2]; u32x2 nR[4][4];
#define DR_LD(m, nn, n_) do { const int u_ = (chain_tb((n_), d) * 4 + h) * 2 + d; const bf16_t* M_ = WSP(bf16_t, offM) + (size_t)u_ * 4096; const bf16_t* N_ = WSP(bf16_t, offNS) + (size_t)u_ * 4096; \
        _Pragma("unroll") for (int t = 0; t < 4; ++t) { _Pragma("unroll") for (int ks = 0; ks < 2; ++ks) m[t][ks] = *(const bf16x8*)(M_ + ((t * 2 + ks) * 64 + lane) * 8); nn[t] = *(const u32x2*)(N_ + ((cb * 4 + t) * 64 + lane) * 4); } } while (0)
#define DR_STEP(m, nn, n_) do { const int u_ = (chain_tb((n_), d) * 4 + h) * 2 + d; bf16_t* ST_ = WSP(bf16_t, offNS) + (size_t)u_ * 4096 + (16 * cb + fr) * 64 + 4 * fq; \
        u32x2 sp_[4]; _Pragma("unroll") for (int t = 0; t < 4; ++t) { sp_[t] = (u32x2){pk2(acc[t][0], acc[t][1]), pk2(acc[t][2], acc[t][3])}; *(u32x2*)(ST_ + 16 * t) = sp_[t]; } \
        bf16x8 bf_[2]; _Pragma("unroll") for (int ks = 0; ks < 2; ++ks) { u32x4 w_ = (u32x4){sp_[2 * ks][0], sp_[2 * ks][1], sp_[2 * ks + 1][0], sp_[2 * ks + 1][1]}; bf_[ks] = __builtin_bit_cast(bf16x8, w_); } \
        _Pragma("unroll") for (int t = 0; t < 4; ++t) { f32x4 a_ = (f32x4){__uint_as_float(nn[t][0] << 16), __uint_as_float(nn[t][0] & 0xffff0000u), __uint_as_float(nn[t][1] << 16), __uint_as_float(nn[t][1] & 0xffff0000u)}; \
            a_ = __builtin_amdgcn_mfma_f32_16x16x32_bf16(m[t][0], bf_[0], a_, 0, 0, 0); acc[t] = __builtin_amdgcn_mfma_f32_16x16x32_bf16(m[t][1], bf_[1], a_, 0, 0, 0); } } while (0)
#define DR_GO(q, n_) do { DR_STEP(mR[q], nR[q], (n_)); if ((n_) + 4 < NTB) DR_LD(mR[q], nR[q], (n_) + 4); } while (0)
    DR_LD(mR[0], nR[0], 0); DR_LD(mR[1], nR[1], 1); DR_LD(mR[2], nR[2], 2); DR_LD(mR[3], nR[3], 3);
#pragma unroll 1
    for (int n = 0; n < NTB; n += 4) { DR_GO(0, n); DR_GO(1, n + 1); DR_GO(2, n + 2); DR_GO(3, n + 3); }
#undef DR_GO
#undef DR_LD
#undef DR_STEP
}
__device__ __forceinline__ void gdn_p2(const Cx& p, LAS unsigned char* lds, int layer, int b) {
    const int tid = p.tid, lane = tid & 63, wave = __builtin_amdgcn_readfirstlane(tid >> 6), fr = lane & 15, fq = lane >> 4;
    LAS unsigned char* qh = lds; LAS unsigned char* kh = lds + 64 * TS; LAS unsigned char* wt = lds + 2 * 64 * TS; LAS unsigned char* sT = lds + 3 * 64 * TS; LAS unsigned char* aq = lds + 4 * 64 * TS; LAS unsigned char* vnT = lds + 5 * 64 * TS;
    LAS float* GC = (LAS float*)(lds + 6 * 64 * TS);
    const int mt = wave >> 1, nt0 = (wave & 1) * 2;
    UNIT_LOOP(u, NUNIT, 192) { const int tb = u >> 3, h = (u >> 1) & 3, d = u & 1, s0 = 64 * tb;
        const bf16_t* dq = WSP(bf16_t, SC_DQ) + (size_t)s0 * 768; const float* dg = WSP(float, SC_DG) + (size_t)s0 * 16;
        const bf16_t* wu = WSP(bf16_t, SC_DR_WU) + (size_t)u * 8192; const bf16_t* st = WSP(bf16_t, SC_DR_NS) + (size_t)u * 4096;
        if (wave == 0) { const int i = d ? 63 - lane : lane; float pre = dg[i * 16 + 8 + d * 4 + h];
#pragma unroll
            for (int o = 1; o < 64; o <<= 1) { const float t = shup_(pre, lane, o); if (lane >= o) pre += t; }
            GC[lane] = pre; }
        { const int r = tid >> 3, c0 = (tid & 7) * 8, i = d ? 63 - r : r;
          *(LAS u32x4*)(qh + r * TS + c0 * 2) = *(const u32x4*)(dq + (size_t)i * 768 + 64 * h + c0);
          *(LAS u32x4*)(kh + r * TS + c0 * 2) = *(const u32x4*)(dq + (size_t)i * 768 + 256 + 64 * h + c0);
          *(LAS u32x4*)(wt + r * TS + c0 * 2) = *(const u32x4*)(wu + r * 128 + c0);
          *(LAS u32x4*)(sT + r * TS + c0 * 2) = *(const u32x4*)(st + r * 64 + c0); }
        __syncthreads();
        { f32x4 acc[2] = {(f32x4){0.f, 0.f, 0.f, 0.f}, (f32x4){0.f, 0.f, 0.f, 0.f}};
          mm_rows<64, 2>(qh, TS, kh, TS, mt, nt0, fr, fq, acc);
#pragma unroll
          for (int t = 0; t < 2; ++t)
#pragma unroll
              for (int j = 0; j < 4; ++j) { const int r = 16 * mt + 4 * fq + j, jj = 16 * (nt0 + t) + fr; *(LAS bf16_t*)(aq + r * TS + jj * 2) = (bf16_t)f2bf(jj <= r ? acc[t][j] * __expf(GC[r] - GC[jj]) : 0.f); }
          f32x4 av[2] = {(f32x4){0.f, 0.f, 0.f, 0.f}, (f32x4){0.f, 0.f, 0.f, 0.f}};
          mm_rows<64, 2>(wt, TS, sT, TS, mt, nt0, fr, fq, av);
#pragma unroll
          for (int t = 0; t < 2; ++t) { const int dv = 16 * (nt0 + t) + fr; float vn[4];
#pragma unroll
              for (int j = 0; j < 4; ++j) vn[j] = bf2f(wu[(16 * mt + 4 * fq + j) * 128 + 64 + dv]) - av[t][j];
              *(LAS u32x2*)(vnT + dv * TS + (16 * mt + 4 * fq) * 2) = (u32x2){pk2(vn[0], vn[1]), pk2(vn[2], vn[3])}; } }
        __syncthreads();
        { f32x4 acc[2] = {(f32x4){0.f, 0.f, 0.f, 0.f}, (f32x4){0.f, 0.f, 0.f, 0.f}};
          mm_rows<64, 2>(qh, TS, sT, TS, mt, nt0, fr, fq, acc);
#pragma unroll
          for (int j = 0; j < 4; ++j) { const float sc = __expf(GC[16 * mt + 4 * fq + j]); acc[0][j] *= sc; acc[1][j] *= sc; }
          mm_rows<64, 2>(aq, TS, vnT, TS, mt, nt0, fr, fq, acc);
          bf16_t* ob = WSP(bf16_t, d ? SC_OB : SC_OF);
#pragma unroll
          for (int t = 0; t < 2; ++t)
#pragma unroll
              for (int j = 0; j < 4; ++j) { const int r = 16 * mt + 4 * fq + j, i = d ? 63 - r : r; ob[(size_t)(s0 + i) * 1024 + 768 + 64 * h + 16 * (nt0 + t) + fr] = (bf16_t)f2bf(acc[t][j]); } }
        __syncthreads();
    }
}
constexpr int LPS = 65;
#define RW_LP(LP, GS, lwp) do { const int lane_ = lane_id_asm(), c_ = lane_, tg_ = wave; float loc_[8]; float run_ = 0.f; \
        _Pragma("unroll") for (int ii = 0; ii < 8; ++ii) { const int r_ = 8 * tg_ + ii; run_ += (lwp)[(size_t)(d ? 63 - r_ : r_) * 256 + c_]; loc_[ii] = run_; } \
        (GS)[tg_ * 64 + c_] = run_; __syncthreads(); float off_ = 0.f; \
        _Pragma("unroll") for (int g2 = 0; g2 < 8; ++g2) if (g2 < tg_) off_ += (GS)[g2 * 64 + c_]; \
        _Pragma("unroll") for (int ii = 0; ii < 8; ++ii) (LP)[(8 * tg_ + ii) * LPS + c_] = loc_[ii] + off_; __syncthreads(); } while (0)
struct RwRhs { const LAS unsigned char* zt; const LAS unsigned char* RU;
    __device__ __forceinline__ float operator()(int r, int col) const { return col < 64 ? bf2f(*(const LAS bf16_t*)(zt + r * TS + col * 2)) : bf2f(*(const LAS bf16_t*)(RU + (col - 64) * TS + r * 2)); } };
__device__ __forceinline__ void rw_p1(const Cx& p, LAS unsigned char* lds, int layer, int b) {
    const int wave = __builtin_amdgcn_readfirstlane(p.tid >> 6), mt = wave >> 1, nt0 = (wave & 1) * 2;
#define RW_LANES const int lane = lane_id_asm(), tid = wave * 64 + lane, fr = lane & 15, fq = lane >> 4; (void)tid; (void)fr; (void)fq
    LAS float* LP = (LAS float*)lds; LAS float* GS = (LAS float*)(lds + 16640);
    LAS unsigned char* zt = lds + 18688; LAS unsigned char* bt = lds + 27904; LAS unsigned char* kt = lds + 37120; LAS unsigned char* vT = lds + 46336; LAS unsigned char* Azk = lds + 55552;
    LAS float* Af = (LAS float*)(lds + 64768); LAS unsigned char* XT = lds + 82176; LAS unsigned char* Abf = lds + 100608; LAS unsigned char* RU = lds + 109824; LAS float* Dbuf = (LAS float*)(lds + 119040); LAS unsigned char* bhT = lds + 129280;
    const bf16_t* proj = WSP(bf16_t, WS_PROJ);
    UNIT_LOOP(u, NUNIT, 96) { const int tb = u >> 3, h = (u >> 1) & 3, d = u & 1, s0 = 64 * tb;
        const float* lwp = WSP(float, SC_RLW) + (size_t)d * SB * 256 + (size_t)s0 * 256 + 64 * h; const float* rk = WSP(float, SC_RK) + (size_t)s0 * 256 + 64 * h;
        const float* rkk = WSP(float, SC_RKK) + (size_t)s0 * 256 + 64 * h; const float* rb = WSP(float, SC_RB) + (size_t)s0 * 256 + 64 * h;
        const bf16_t* pr0 = proj + (size_t)tb_row0(b, tb) * NPROJ;
        RW_LP(LP, GS, lwp);
        { RW_LANES; const int r = tid >> 3, c0 = (tid & 7) * 8, i = d ? 63 - r : r; unsigned wz[4], wb[4], wk[4];
          f32x4 lwv[2], kkv[2], bv[2], kv[2];
#pragma unroll
          for (int q = 0; q < 2; ++q) { lwv[q] = *(const f32x4*)(lwp + (size_t)i * 256 + c0 + 4 * q); kkv[q] = *(const f32x4*)(rkk + (size_t)i * 256 + c0 + 4 * q); bv[q] = *(const f32x4*)(rb + (size_t)i * 256 + c0 + 4 * q); kv[q] = *(const f32x4*)(rk + (size_t)i * 256 + c0 + 4 * q); }
#pragma unroll
          for (int q = 0; q < 8; q += 2) { float z2[2], b2[2], k2[2];
#pragma unroll
              for (int e = 0; e < 2; ++e) { const int cq = q + e, c = c0 + cq; const float lp = LP[r * LPS + c], lw = lwv[cq >> 2][cq & 3], em = __expf(-lp);
                  z2[e] = -kkv[cq >> 2][cq & 3] * __expf(lp - lw); b2[e] = bv[cq >> 2][cq & 3] * em; k2[e] = kv[cq >> 2][cq & 3] * em; }
              wz[q >> 1] = pk2(z2[0], z2[1]); wb[q >> 1] = pk2(b2[0], b2[1]); wk[q >> 1] = pk2(k2[0], k2[1]); }
          *(LAS u32x4*)(zt + r * TS + c0 * 2) = (u32x4){wz[0], wz[1], wz[2], wz[3]}; *(LAS u32x4*)(bt + r * TS + c0 * 2) = (u32x4){wb[0], wb[1], wb[2], wb[3]}; *(LAS u32x4*)(kt + r * TS + c0 * 2) = (u32x4){wk[0], wk[1], wk[2], wk[3]};
          *(LAS u32x4*)(XT + (2 * r) * TS + c0 * 2) = (u32x4){0u, 0u, 0u, 0u}; *(LAS u32x4*)(XT + (2 * r + 1) * TS + c0 * 2) = (u32x4){0u, 0u, 0u, 0u};
#pragma unroll 2
          for (int q = 0; q < 8; ++q) { const int e = tid + NTHR * q, r2 = e >> 6, cc = e & 63; *(LAS bf16_t*)(vT + cc * TS + r2 * 2) = pr0[(size_t)(d ? 63 - r2 : r2) * NPROJ + PB_V + 64 * h + cc]; } }
        __syncthreads();
        { RW_LANES; f32x4 a1[2] = {(f32x4){0.f, 0.f, 0.f, 0.f}, (f32x4){0.f, 0.f, 0.f, 0.f}}, a2[2] = {(f32x4){0.f, 0.f, 0.f, 0.f}, (f32x4){0.f, 0.f, 0.f, 0.f}};
          mm_rows<64, 2>(zt, TS, bt, TS, mt, nt0, fr, fq, a1);
          mm_rows<64, 2>(zt, TS, kt, TS, mt, nt0, fr, fq, a2);
#pragma unroll
          for (int t = 0; t < 2; ++t)
#pragma unroll
              for (int j = 0; j < 4; ++j) { const int r = 16 * mt + 4 * fq + j, jj = 16 * (nt0 + t) + fr; const float a = jj < r ? a1[t][j] : 0.f;
                  Af[jj * AFS + r] = a; *(LAS bf16_t*)(Abf + r * TS + jj * 2) = (bf16_t)f2bf(a); *(LAS bf16_t*)(Azk + r * TS + jj * 2) = (bf16_t)f2bf(jj < r ? a2[t][j] : 0.f); } }
        __syncthreads();
        { RW_LANES; f32x4 a[2] = {(f32x4){0.f, 0.f, 0.f, 0.f}, (f32x4){0.f, 0.f, 0.f, 0.f}};
          mm_rows<64, 2>(Azk, TS, vT, TS, mt, nt0, fr, fq, a);
#pragma unroll
          for (int t = 0; t < 2; ++t) *(LAS u32x2*)(RU + (16 * (nt0 + t) + fr) * TS + (16 * mt + 4 * fq) * 2) = (u32x2){pk2(a[t][0], a[t][1]), pk2(a[t][2], a[t][3])};
        }
        __syncthreads();
        { RW_LANES;
#pragma unroll 2
          for (int q = 0; q < 8; ++q) { const int e = tid + NTHR * q, r2 = e >> 6, cc = e & 63; const float el = __expf(LP[63 * LPS + cc]);
              *(LAS bf16_t*)(bhT + cc * TS + r2 * 2) = (bf16_t)f2bf(bf2f(*(const LAS bf16_t*)(bt + r2 * TS + cc * 2)) * el); *(LAS bf16_t*)(Azk + cc * TS + r2 * 2) = (bf16_t)f2bf(bf2f(*(const LAS bf16_t*)(kt + r2 * TS + cc * 2)) * el); } }
        __syncthreads();
        { const RwRhs rhs{zt, RU}; dr_block_solve(Abf, Af, XT, Dbuf, -1.0f, wave, rhs, WSP(bf16_t, SC_RW_WU) + (size_t)u * 8192); }
        { RW_LANES; f32x4 am[2] = {(f32x4){0.f, 0.f, 0.f, 0.f}, (f32x4){0.f, 0.f, 0.f, 0.f}}, an[2] = {(f32x4){0.f, 0.f, 0.f, 0.f}, (f32x4){0.f, 0.f, 0.f, 0.f}};
          mm_rows<64, 2>(bhT, TS, XT, TS, mt, nt0, fr, fq, am);
          mm_rows<64, 2>(bhT, TS, XT + 64 * TS, TS, mt, nt0, fr, fq, an);
          mm_rows<64, 2>(Azk, TS, vT, TS, mt, nt0, fr, fq, an);
          bf16_t* Mg = WSP(bf16_t, SC_RW_M) + (size_t)u * 4096; bf16_t* Ng = WSP(bf16_t, SC_RW_NS) + (size_t)u * 4096;
#pragma unroll
          for (int t = 0; t < 2; ++t) {
#pragma unroll
              for (int j = 0; j < 4; ++j) { const int row = 16 * mt + 4 * fq + j, col = 16 * (nt0 + t) + fr; Mg[dr_mfrag_idx(row, col)] = (bf16_t)f2bf((row == col ? __expf(LP[63 * LPS + row]) : 0.f) + am[t][j]); }
              *(u32x2*)(Ng + (((nt0 + t) * 4 + mt) * 64 + lane) * 4) = (u32x2){pk2(an[t][0], an[t][1]), pk2(an[t][2], an[t][3])}; } }
        __syncthreads();
    }
}
__device__ __forceinline__ void rw_p2(const Cx& p, LAS unsigned char* lds, int layer, int b) {
    const int wave = __builtin_amdgcn_readfirstlane(p.tid >> 6), mt = wave >> 1, nt0 = (wave & 1) * 2;
    LAS float* LP = (LAS float*)lds; LAS float* GS = (LAS float*)(lds + 16640);
    LAS unsigned char* rt = lds + 18688; LAS unsigned char* bt = lds + 27904; LAS unsigned char* kt = lds + 37120; LAS unsigned char* vT = lds + 46336; LAS unsigned char* sT = lds + 55552; LAS unsigned char* wt = lds + 64768;
    LAS unsigned char* Arb = lds + 73984; LAS unsigned char* Ark = lds + 83200; LAS unsigned char* UT = lds + 92416;
    const bf16_t* proj = WSP(bf16_t, WS_PROJ);
    UNIT_LOOP(u, NUNIT, 224) { const int tb = u >> 3, h = (u >> 1) & 3, d = u & 1, s0 = 64 * tb;
        const float* lwp = WSP(float, SC_RLW) + (size_t)d * SB * 256 + (size_t)s0 * 256 + 64 * h; const float* rk = WSP(float, SC_RK) + (size_t)s0 * 256 + 64 * h; const float* rb = WSP(float, SC_RB) + (size_t)s0 * 256 + 64 * h;
        const bf16_t* pr0 = proj + (size_t)tb_row0(b, tb) * NPROJ; const bf16_t* wu = WSP(bf16_t, SC_RW_WU) + (size_t)u * 8192; const bf16_t* st = WSP(bf16_t, SC_RW_NS) + (size_t)u * 4096;
        RW_LP(LP, GS, lwp);
        { RW_LANES; const int r = tid >> 3, c0 = (tid & 7) * 8, i = d ? 63 - r : r; unsigned wr[4], wb[4], wk[4];
          const u32x4 rv = *(const u32x4*)(pr0 + (size_t)i * NPROJ + PB_R + 64 * h + c0);
          f32x4 bv[2], kv[2];
#pragma unroll
          for (int q = 0; q < 2; ++q) { bv[q] = *(const f32x4*)(rb + (size_t)i * 256 + c0 + 4 * q); kv[q] = *(const f32x4*)(rk + (size_t)i * 256 + c0 + 4 * q); }
#pragma unroll
          for (int q = 0; q < 8; q += 2) { float r2[2], b2[2], k2[2];
#pragma unroll
              for (int e = 0; e < 2; ++e) { const int cq = q + e, c = c0 + cq; const float lp = LP[r * LPS + c], em = __expf(-lp); const unsigned w = rv[q >> 1];
                  r2[e] = (e ? __uint_as_float(w & 0xffff0000u) : __uint_as_float(w << 16)) * __expf(lp); b2[e] = bv[cq >> 2][cq & 3] * em; k2[e] = kv[cq >> 2][cq & 3] * em; }
              wr[q >> 1] = pk2(r2[0], r2[1]); wb[q >> 1] = pk2(b2[0], b2[1]); wk[q >> 1] = pk2(k2[0], k2[1]); }
          *(LAS u32x4*)(rt + r * TS + c0 * 2) = (u32x4){wr[0], wr[1], wr[2], wr[3]}; *(LAS u32x4*)(bt + r * TS + c0 * 2) = (u32x4){wb[0], wb[1], wb[2], wb[3]}; *(LAS u32x4*)(kt + r * TS + c0 * 2) = (u32x4){wk[0], wk[1], wk[2], wk[3]};
          *(LAS u32x4*)(wt + r * TS + c0 * 2) = *(const u32x4*)(wu + r * 128 + c0);
          *(LAS u32x4*)(sT + r * TS + c0 * 2) = *(const u32x4*)(st + r * 64 + c0);
#pragma unroll 2
          for (int q = 0; q < 8; ++q) { const int e = tid + NTHR * q, r2 = e >> 6, cc = e & 63; *(LAS bf16_t*)(vT + cc * TS + r2 * 2) = pr0[(size_t)(d ? 63 - r2 : r2) * NPROJ + PB_V + 64 * h + cc]; } }
        __syncthreads();
        { RW_LANES; f32x4 a1[2] = {(f32x4){0.f, 0.f, 0.f, 0.f}, (f32x4){0.f, 0.f, 0.f, 0.f}}, a2[2] = {(f32x4){0.f, 0.f, 0.f, 0.f}, (f32x4){0.f, 0.f, 0.f, 0.f}}, a3[2] = {(f32x4){0.f, 0.f, 0.f, 0.f}, (f32x4){0.f, 0.f, 0.f, 0.f}};
          mm_rows<64, 2>(rt, TS, bt, TS, mt, nt0, fr, fq, a1); mm_rows<64, 2>(rt, TS, kt, TS, mt, nt0, fr, fq, a2); mm_rows<64, 2>(wt, TS, sT, TS, mt, nt0, fr, fq, a3);
#pragma unroll
          for (int t = 0; t < 2; ++t) { const int dv = 16 * (nt0 + t) + fr; float uu[4];
#pragma unroll
              for (int j = 0; j < 4; ++j) { const int r = 16 * mt + 4 * fq + j, jj = dv; const bool keep = jj <= r;
                  *(LAS bf16_t*)(Arb + r * TS + jj * 2) = (bf16_t)f2bf(keep ? a1[t][j] : 0.f); *(LAS bf16_t*)(Ark + r * TS + jj * 2) = (bf16_t)f2bf(keep ? a2[t][j] : 0.f);
                  uu[j] = bf2f(wu[r * 128 + 64 + dv]) + a3[t][j]; }
              *(LAS u32x2*)(UT + dv * TS + (16 * mt + 4 * fq) * 2) = (u32x2){pk2(uu[0], uu[1]), pk2(uu[2], uu[3])}; } }
        __syncthreads();
        { RW_LANES; f32x4 acc[2] = {(f32x4){0.f, 0.f, 0.f, 0.f}, (f32x4){0.f, 0.f, 0.f, 0.f}};
          mm_rows<64, 2>(rt, TS, sT, TS, mt, nt0, fr, fq, acc); mm_rows<64, 2>(Arb, TS, UT, TS, mt, nt0, fr, fq, acc); mm_rows<64, 2>(Ark, TS, vT, TS, mt, nt0, fr, fq, acc);
          bf16_t* ob = WSP(bf16_t, d ? SC_OB : SC_OF);
#pragma unroll
          for (int t = 0; t < 2; ++t)
#pragma unroll
              for (int j = 0; j < 4; ++j) { const int r = 16 * mt + 4 * fq + j, i = d ? 63 - r : r; ob[(size_t)(s0 + i) * 1024 + 256 + 64 * h + 16 * (nt0 + t) + fr] = (bf16_t)f2bf(acc[t][j]); } }
        __syncthreads();
    }
#undef RW_LANES
}
__device__ __forceinline__ void phase_scan(const Cx& p, int layer, int b) {
    for (int w = p.bid; w < 160; w += p.G) {
        if (w < 64) ssd_chain(p, (w >> 4) & 3, (w >> 3) & 1, w & 7);
        else if (w < 96) gla_chain(p, ((w - 64) >> 3) & 3, ((w - 64) >> 2) & 1, (w - 64) & 3);
        else { const int i = w - 96, h = (i >> 3) & 3, d = (i >> 2) & 1, cb = i & 3;
            if (i < 32) dr_chain(p, SC_RW_M, SC_RW_NS, h, d, cb); else dr_chain(p, SC_DR_M, SC_DR_NS, h, d, cb); } }
}
#ifndef MK_ONE_LAUNCH
#define MK_ONE_LAUNCH 1
#endif
constexpr int PH_PER_LAYER = 2 + 5 * NB + 7;
constexpr int N_PHASES = 1 + NL * PH_PER_LAYER + 1;

__global__ void __launch_bounds__(NTHR, 2) mega_fwd(Params pp) {
    extern __shared__ __attribute__((aligned(16))) unsigned char lds_raw[];
    LAS unsigned char* lds = (LAS unsigned char*)lds_raw;
    const int swave = __builtin_amdgcn_readfirstlane(threadIdx.x >> 6);
    for (int i = threadIdx.x; i < (LDS_BYTES - LDS_CTL) / 4; i += NTHR) ((LAS unsigned*)(lds + LDS_CTL))[i] = 0u;
    __syncthreads();
    if (threadIdx.x < N_IN + 2) { const unsigned long long a = threadIdx.x < N_IN ? (unsigned long long)pp.in[threadIdx.x] : (threadIdx.x == N_IN ? (unsigned long long)pp.out : (unsigned long long)pp.ws); ((LAS unsigned*)(lds + LDS_PTRS))[2 * threadIdx.x] = (unsigned)a; ((LAS unsigned*)(lds + LDS_PTRS))[2 * threadIdx.x + 1] = (unsigned)(a >> 32); }
    __syncthreads();
    XcdBarrier bar = xcd_barrier_post((unsigned*)(pp.ws + WS_CTL) + CW_BAR + pp.li * XCD_BAR_WORDS, (volatile LAS unsigned*)(lds + LDS_CTL), threadIdx.x);
    LAS int* tb = (LAS int*)(lds + LDS_CTL + 64);
    int pc = 0; const int lo = pp.lo, hi = pp.hi;
#define PH_BEGIN if (pc >= lo && pc < hi) { Cx p; p.out = (float*)PIN(N_IN); p.ws = (unsigned char*)PIN(N_IN + 1); p.tid = swave * 64 + lane_id_asm(); p.bid = blockIdx.x; p.G = gridDim.x; p.pad = 0; asm volatile("" : "+s"(p.out), "+s"(p.ws), "+v"(p.tid), "+s"(p.bid), "+s"(p.G)); const int G = p.G, bid = p.bid; (void)G; (void)bid;
#define PH_END if (pc + 1 < hi) { XcdBarrier b2 = bar; asm volatile("" : "+s"(b2.bar), "+s"(b2.x)); xcd_barrier(b2, (unsigned)(swave * 64 + lane_id_asm())); } } ++pc;

    PH_BEGIN
        for (int u = bid; u < CONV_A_UNITS; u += G) conv_unit_A(p, (LAS float*)lds, u);
        __syncthreads();
        phase_mod(p, lds);
    PH_END

#pragma unroll
    for (int layer = 0; layer < NL; ++layer) {
        const int row_lo = layer == NL - 1 ? CROWS : 0;
        PH_BEGIN phase_norm1(p, layer); PH_END
        PH_BEGIN
            DenseSched S; S.init(ROWS, NPROJ, D, WSP(bf16_t, WS_WIN) + (size_t)layer * NPROJ * D, G, bid);
            EpiProj E{WSP(bf16_t, WS_PROJ), NPROJ};
            pg8::gemm_phase<D>(p.tid, lds, (const char*)WSP(bf16_t, WS_HBUF), S, E);
        PH_END
#pragma unroll 1
        for (int b = 0; b < NB; ++b) {
            PH_BEGIN phase_prep(p, lds, layer, b); PH_END
            PH_BEGIN gla_p1(p, lds, layer, b); __syncthreads(); ssd_p1(p, lds, layer, b); __syncthreads(); gdn_p1(p, lds, layer, b); __syncthreads(); rw_p1(p, lds, layer, b); PH_END
            PH_BEGIN phase_scan(p, layer, b); PH_END
            PH_BEGIN gla_p2(p, lds, layer, b); __syncthreads(); ssd_p2(p, lds, layer, b); __syncthreads(); gdn_p2(p, lds, layer, b); __syncthreads(); rw_p2(p, lds, layer, b); PH_END
            PH_BEGIN phase_post(p, layer, b); PH_END
        }
        PH_BEGIN
            DenseSched S; S.init(ROWS, D, D, WSP(bf16_t, WS_WOUT) + (size_t)layer * D * D, G, bid);
            EpiRes E{layer == 0 ? PIN(I_X) : (const float*)p.out, layer == 0 ? PIN(I_CTX) : (const float*)WSP(float, WS_CTXRES), p.out, WSP(float, WS_CTXRES), WSP(float, WS_MOD) + (size_t)layer * 5 * 6144 + 2048};
            pg8::gemm_phase<D>(p.tid, lds, (const char*)WSP(bf16_t, WS_HBUF), S, E);
        PH_END
        PH_BEGIN phase_norm2(p, lds, layer, row_lo);
            __syncthreads();
            for (int u = bid; u < CONV_E_UNITS; u += G) conv_unit_E(p, (LAS float*)lds, layer, u);
        PH_END
        PH_BEGIN
            moe_table(p, tb, layer, row_lo);
            MoeSched<true> S{tb + 128, tb, 2, G, bid, D, row_lo, WSP(int, WS_LTOK), (const char*)WSP(bf16_t, WS_EXPGU), (size_t)512 * D * 2};
            EpiGU E{WSP(bf16_t, WS_H)};
            pg8::gemm_phase<D>(p.tid, lds, (const char*)WSP(bf16_t, WS_HBUF), S, E);
        PH_END
#pragma unroll
        for (int half = 0; half < 2; ++half) {
            PH_BEGIN
                moe_table(p, tb, layer, row_lo);
                MoeSched<false> S{tb + 128, tb, 2, G, bid, EH, row_lo, WSP(int, WS_LTOK), (const char*)(WSP(bf16_t, WS_EXPD) + (size_t)half * 512 * EH), (size_t)D * EH * 2};
                EpiY E{WSP(bf16_t, WS_Y)};
                pg8::gemm_phase<EH>(p.tid, lds, (const char*)WSP(bf16_t, WS_H), S, E);
            PH_END
            PH_BEGIN
                moe_table(p, tb, layer, row_lo);
                phase_combine(p, tb, layer, row_lo, half);
            PH_END
        }
    }
    PH_BEGIN phase_final(p);
    PH_END
#undef PH_BEGIN
#undef PH_END
}

extern "C" void kernel_launch(void* const* d_in, const int* in_sizes, int n_in, void* d_out, int out_size, void* d_ws, size_t ws_size, hipStream_t stream) {
    static int grid = 0;
    if (grid == 0) {
        if (n_in != N_IN || in_sizes[0] != NB * SEQ * D || out_size != NB * SEQ * D || ws_size < WS_END) {
            fprintf(stderr, "kernel_launch: unexpected shapes (n_in %d, in0 %d, out %d, ws %zu); nothing launched\n", n_in, n_in > 0 ? in_sizes[0] : -1, out_size, ws_size); grid = -1; return; }
        int dev = 0, cus = 0, per_cu = 0;
        if (hipGetDevice(&dev) != hipSuccess || hipDeviceGetAttribute(&cus, hipDeviceAttributeMultiprocessorCount, dev) != hipSuccess) { grid = -1; return; }
        if (hipFuncSetAttribute((const void*)mega_fwd, hipFuncAttributeMaxDynamicSharedMemorySize, LDS_BYTES) != hipSuccess) { fprintf(stderr, "kernel_launch: hipFuncSetAttribute failed\n"); grid = -1; return; }
        if (hipOccupancyMaxActiveBlocksPerMultiprocessor(&per_cu, (const void*)mega_fwd, NTHR, LDS_BYTES) != hipSuccess || per_cu < 1) { fprintf(stderr, "kernel_launch: occupancy query says %d\n", per_cu); per_cu = 1; }
        (void)hipGetLastError();
        grid = cus * 1;
    }
    if (grid < 0) return;
    if (hipMemsetAsync((char*)d_ws + WS_CTL, 0, CTL_ZERO_BYTES, stream) != hipSuccess) return;
    Params p{};
    for (int i = 0; i < N_IN; ++i) p.in[i] = (const float*)d_in[i];
    p.out = (float*)d_out; p.ws = (unsigned char*)d_ws; p.pad = 0;
#if MK_ONE_LAUNCH
    p.lo = 0; p.hi = N_PHASES; p.li = 0;
    hipLaunchKernelGGL(mega_fwd, dim3(grid), dim3(NTHR), LDS_BYTES, stream, p);
#else
    for (int k = 0; k < N_PHASES; ++k) { p.lo = k; p.hi = k + 1; p.li = k;
        hipLaunchKernelGGL(mega_fwd, dim3(grid), dim3(NTHR), LDS_BYTES, stream, p); }
#endif
}
```

```cpp
#include <hip/hip_runtime.h>
#include <cstdio>
#include <cstdint>

typedef unsigned short bf16_t;
typedef short bf16x8 __attribute__((ext_vector_type(8)));
typedef float f32x4 __attribute__((ext_vector_type(4)));
typedef float f32x2 __attribute__((ext_vector_type(2)));
typedef unsigned u32x4 __attribute__((ext_vector_type(4)));
typedef unsigned u32x2 __attribute__((ext_vector_type(2)));

constexpr int NB = 4, SEQ = 8192, NCTX = 256, D = 1024, NL = 2;
constexpr int CROWS = NB * NCTX;
constexpr int ROWS = CROWS + NB * SEQ;
constexpr int SB = NCTX + SEQ;
constexpr int INW = 4056, NPROJ = 4096;
constexpr int NE = 64, NE1 = 65, TOPK = 8, EH = 256;
constexpr int GRIDW = 64, GRIDH = SEQ / GRIDW;
constexpr int PA_Q = 0, PA_K = 256, PA_V = 512, PA_G = 768, PA_GF = 1024, PA_GB = 1040;
constexpr int PB_R = 1056, PB_K = 1312, PB_V = 1568, PB_WF = 1824, PB_WB = 1856, PB_A = 1888, PB_G = 1920;
constexpr int PC_Z = 1984, PC_X = 2240, PC_DF = 3008, PC_DB = 3012;
constexpr int PD_Q = 3016, PD_Z = 3784, PD_BF = 4040, PD_BB = 4044, PD_AF = 4048, PD_AB = 4052;
enum { I_X = 0, I_C, I_CTX, I_CCTX, I_N1G, I_N2G, I_WMOD, I_BMOD, I_WIN, I_WOUT, I_GLA_W2, I_GLA_B, I_GLA_NG,
       I_RW_W2, I_RW_W0, I_RW_AW2, I_RW_A0, I_RW_GW2, I_RW_KK, I_RW_KA, I_RW_RK, I_RW_LNG, I_RW_LNB,
       I_SS_CW, I_SS_CB, I_SS_ALOG, I_SS_DTB, I_SS_D, I_SS_NG, I_DN_CW, I_DN_ALOG, I_DN_DTB, I_DN_NG,
       I_ROUT_W, I_ROUT_B, I_EXP_G, I_EXP_U, I_EXP_D, I_SH_G, I_SH_U, I_SH_D, I_FNG, N_IN };
static_assert(N_IN == 42, "input count");

constexpr size_t MiB = 1u << 20;
constexpr size_t WS_CTL = 0, CTL_ZERO_BYTES = 1 * MiB;
constexpr size_t WS_MOD = 1 * MiB;
constexpr size_t WS_WIN = 2 * MiB;
constexpr size_t WS_WOUT = 18 * MiB;
constexpr size_t WS_ROUT = 22 * MiB;
constexpr size_t WS_CTXRES = 23 * MiB;
constexpr size_t WS_EXPGU = 27 * MiB;
constexpr size_t WS_EXPD = 92 * MiB;
constexpr size_t WS_HBUF = 125 * MiB;
constexpr size_t WS_PROJ = 191 * MiB;
constexpr size_t WS_SCR = 455 * MiB;
constexpr size_t WS_END = 640455456;
constexpr int HROWS_MAX = ROWS * 9 + NE1 * 256;
constexpr size_t WS_Y = WS_HBUF;
constexpr size_t WS_H = 443 * MiB;
constexpr size_t WS_LTOK = 600 * MiB;
constexpr size_t WS_TOKT = WS_LTOK + (size_t)NE * ROWS * 4;
static_assert(WS_Y + (size_t)HROWS_MAX * 512 * 2 <= WS_H && WS_H + (size_t)HROWS_MAX * 256 * 2 <= WS_LTOK && WS_TOKT + (size_t)ROWS * 64 <= WS_END, "moe overlay");
constexpr size_t SC_OF = WS_SCR;
constexpr size_t SC_OB = SC_OF + (size_t)SB * 1024 * 2;
constexpr size_t SC_RK = SC_OB + (size_t)SB * 1024 * 2;
constexpr size_t SC_RKK = SC_RK + (size_t)SB * 256 * 4;
constexpr size_t SC_RB = SC_RKK + (size_t)SB * 256 * 4;
constexpr size_t SC_RLW = SC_RB + (size_t)SB * 256 * 4;
constexpr size_t SC_SX = SC_RLW + (size_t)2 * SB * 256 * 4;
constexpr size_t SC_DQ = SC_SX + (size_t)SB * 768 * 2;
constexpr size_t SC_SDT = SC_DQ + (size_t)SB * 768 * 2;
constexpr size_t SC_DG = SC_SDT + (size_t)SB * 8 * 4;
constexpr size_t SC_FEND = SC_DG + (size_t)SB * 16 * 4;
constexpr int NTB = SB / 64, NUNIT = NTB * 4 * 2;
constexpr size_t SC_RW_M = SC_FEND;
constexpr size_t SC_RW_NS = SC_RW_M + (size_t)(SB / 64 * 8) * 4096 * 2;
constexpr size_t SC_RW_WU = SC_RW_NS + (size_t)(SB / 64 * 8) * 4096 * 2;
constexpr size_t SC_END = SC_RW_WU + (size_t)(SB / 64 * 8) * 8192 * 2;
constexpr size_t SC2 = WS_EXPGU;
constexpr size_t SC_GLA_S = SC2;
constexpr size_t SC_GLA_DEC = SC_GLA_S + (size_t)NUNIT * 4096 * 4;
constexpr size_t SC_SSD_S = SC_GLA_DEC + (size_t)NUNIT * 64 * 4;
constexpr size_t SC_SSD_CD = SC_SSD_S + (size_t)NUNIT * 8192 * 4;
constexpr size_t SC_DR_M = SC_SSD_CD + (size_t)NUNIT * 4 + 4096;
constexpr size_t SC_DR_NS = SC_DR_M + (size_t)NUNIT * 4096 * 2;
constexpr size_t SC_DR_WU = SC_DR_NS + (size_t)NUNIT * 4096 * 2;
constexpr size_t SC2_END = SC_DR_WU + (size_t)NUNIT * 8192 * 2;
static_assert(SC2_END <= WS_HBUF, "chunk slots fit in the expert-weight region");
static_assert(SC_END <= WS_END, "scratch fits");
constexpr int CW_CNT = 1024;
constexpr int CW_BAR = 4096;

#define LAS __attribute__((address_space(3)))
constexpr int NTHR = 512;
constexpr int LDS_BYTES = 147456;
constexpr int LDS_CTL = 143360;
constexpr int LDS_PTRS = LDS_CTL + 2048;

__device__ __forceinline__ int lane_id_asm() { int l; asm volatile("v_mbcnt_lo_u32_b32 %0, -1, 0\n\tv_mbcnt_hi_u32_b32 %0, -1, %0" : "=v"(l)); return l; }
__device__ __forceinline__ float bf2f(bf16_t b) { return __uint_as_float(((unsigned)b) << 16); }
__device__ __forceinline__ unsigned f2bf(float f) { unsigned u = __float_as_uint(f); u += 0x7FFFu + ((u >> 16) & 1u); return u >> 16; }
__device__ __forceinline__ unsigned pk2(float lo, float hi) { return f2bf(lo) | (f2bf(hi) << 16); }
__device__ __forceinline__ float rl(float x, int k) { return __uint_as_float(__builtin_amdgcn_readlane(__float_as_uint(x), k)); }
__device__ __forceinline__ float shx_(float v, int lane, int o) { return __uint_as_float(__builtin_amdgcn_ds_bpermute((lane ^ o) << 2, __float_as_uint(v))); }
__device__ __forceinline__ int shxi_(int v, int lane, int o) { return __builtin_amdgcn_ds_bpermute((lane ^ o) << 2, v); }
__device__ __forceinline__ float shup_(float v, int lane, int o) { return __uint_as_float(__builtin_amdgcn_ds_bpermute((lane - o) << 2, __float_as_uint(v))); }
#define DPPF(v, ctrl) __uint_as_float(__builtin_amdgcn_update_dpp(0, __float_as_uint(v), ctrl, 0xf, 0xf, false))
#define DPPI(v, ctrl) __builtin_amdgcn_update_dpp(0, (v), ctrl, 0xf, 0xf, false)
__device__ __forceinline__ float wsum(float v) {
    v += DPPF(v, 0xB1); v += DPPF(v, 0x4E); v += DPPF(v, 0x141); v += DPPF(v, 0x140);
    v += __uint_as_float(__builtin_amdgcn_ds_swizzle(__float_as_uint(v), 0x401F));
    return rl(v, 0) + rl(v, 32);
}
__device__ __forceinline__ float sigmoidf_(float x) { return 1.0f / (1.0f + __expf(-x)); }
__device__ __forceinline__ float siluf_(float x) { return x / (1.0f + __expf(-x)); }
__device__ __forceinline__ float log1pexp_(float t  ) { return t < 1e-4f ? t - 0.5f * t * t : __logf(1.0f + t); }
__device__ __forceinline__ float softplusf_(float x) { return x > 15.f ? x : log1pexp_(__expf(x)); }
__device__ __forceinline__ float logsigmoidf_(float x) { return fminf(x, 0.f) - log1pexp_(__expf(-fabsf(x))); }
__device__ __forceinline__ float tanhf_(float x) { const float e = __expf(2.0f * fminf(fmaxf(x, -15.f), 15.f)); return (e - 1.0f) / (e + 1.0f); }
__device__ __forceinline__ int seq_tok(int i, int d) { return d == 0 ? i : (i < NCTX ? NCTX - 1 - i : SB + NCTX - 1 - i); }
__device__ __forceinline__ int tok_row(int b, int s) { return s < NCTX ? b * NCTX + s : CROWS + b * SEQ + (s - NCTX); }

struct Params { const float* in[N_IN]; float* out; unsigned char* ws; int lo, hi, li, pad; };
struct Cx { float* out; unsigned char* ws; int tid, bid, G, pad; };
__device__ __forceinline__ const float* PIN(int i) {
    extern __shared__ __attribute__((aligned(16))) unsigned char lds_raw_[];
    int off = __builtin_amdgcn_readfirstlane(LDS_PTRS + 8 * i); asm volatile("" : "+s"(off));
    const LAS unsigned* t = (const LAS unsigned*)((LAS unsigned char*)lds_raw_ + off);
    const unsigned lo = __builtin_amdgcn_readfirstlane(t[0]), hi = __builtin_amdgcn_readfirstlane(t[1]);
    return (const float*)(((unsigned long long)hi << 32) | lo);
}
#define XB_TMO      128
#define XB_XCNT(j)  (256  + 64 * (j))
#define XB_XSUB(j)  (1280 + 64 * (j))
#define XB_XGEN(j)  (2304 + 64 * (j))
#define XB_TOP      3328
#define XB_TOPGEN   3392
#define XCD_BAR_WORDS 3456
#define XB_SPIN_CAP (1u << 18)

__device__ __forceinline__ unsigned xb_ld(unsigned* p)              { return __hip_atomic_load(p, __ATOMIC_RELAXED, __HIP_MEMORY_SCOPE_AGENT); }
__device__ __forceinline__ unsigned xb_add(unsigned* p, unsigned v) { return __hip_atomic_fetch_add(p, v, __ATOMIC_RELAXED, __HIP_MEMORY_SCOPE_AGENT); }
__device__ __forceinline__ unsigned xb_xcc_id() { return (unsigned)__builtin_amdgcn_s_getreg((3 << 11) | 20) & 0xFu; }
#define XB_SPIN(cond, bar) do { unsigned _sp = 0; while (cond) { __builtin_amdgcn_s_sleep(1); \
    if ((++_sp & 255u) == 0u) { if (xb_ld(&(bar)[XB_TMO])) break; if (_sp > XB_SPIN_CAP) { atomicAdd(&(bar)[XB_TMO], 1u); break; } } } } while (0)

struct XcdBarrier {
    unsigned* bar; unsigned x;
    volatile LAS unsigned* st;
};

__device__ __forceinline__ XcdBarrier xcd_barrier_post(unsigned* bar, volatile LAS unsigned* st, const unsigned xb_tid) {
    XcdBarrier b; b.bar = bar; b.x = xb_xcc_id(); b.st = st;
    if (xb_tid == 0) (void)xb_add(&bar[XB_XCNT(b.x)], 1u);
    return b;
}
__device__ __forceinline__ void xcd_barrier_complete(unsigned* bar, unsigned x, unsigned& nloc, unsigned& nx) {
    const unsigned G = gridDim.x * gridDim.y * gridDim.z;
    unsigned sum, cnt, mine, sp = 0u;
    for (;;) {
        sum = 0u; cnt = 0u; mine = 0u;
#pragma unroll
        for (unsigned j = 0; j < 16; ++j) { const unsigned c = xb_ld(&bar[XB_XCNT(j)]); sum += c; cnt += (c > 0u) ? 1u : 0u; mine = (j == x) ? c : mine; }
        if (sum == G) break;
        __builtin_amdgcn_s_sleep(1);
        if ((++sp & 255u) == 0u) { if (xb_ld(&bar[XB_TMO])) break; if (sp > XB_SPIN_CAP) { atomicAdd(&bar[XB_TMO], 1u); break; } }
    }
    nloc = mine > 0u ? mine : 1u; nx = cnt > 0u ? cnt : 1u;
}

__device__ __forceinline__ void xcd_barrier(const XcdBarrier& b, const unsigned xb_tid) {
    asm volatile("s_waitcnt vmcnt(0)" ::: "memory");
    __syncthreads();
    if (xb_tid == 0) {
        unsigned* bar = b.bar;
        __builtin_amdgcn_s_waitcnt(0);
        unsigned nloc = b.st[0], nx = b.st[1];
        if (nloc == 0u) { xcd_barrier_complete(bar, b.x, nloc, nx); b.st[0] = nloc; b.st[1] = nx; }
        const unsigned old = xb_add(&bar[XB_XSUB(b.x)], 1u);
        const unsigned gen = old / nloc;
        if (old + 1u == (gen + 1u) * nloc) {
            __builtin_amdgcn_fence(__ATOMIC_RELEASE, "agent");
            asm volatile("s_waitcnt vmcnt(0)" ::: "memory");
            const unsigned og = xb_add(&bar[XB_TOP], 1u);
            const unsigned tg = og / nx;
            if (og + 1u == (tg + 1u) * nx) xb_add(&bar[XB_TOPGEN], 1u);
            else XB_SPIN(xb_ld(&bar[XB_TOPGEN]) == tg, bar);
            __builtin_amdgcn_fence(__ATOMIC_ACQUIRE, "agent");
            xb_add(&bar[XB_XGEN(b.x)], 1u);
            asm volatile("s_waitcnt vmcnt(0)" ::: "memory");
        } else {
            XB_SPIN(xb_ld(&bar[XB_XGEN(b.x)]) == gen, bar);
            __builtin_amdgcn_fence(__ATOMIC_ACQUIRE, "agent");
            asm volatile("s_waitcnt vmcnt(0)" ::: "memory");
        }
    }
    __syncthreads();
}

namespace pg8 {
constexpr int BM = 256, BK = 64, HALF = 128, HTB = HALF * BK * 2  , STAGE_BYTES = 8 * HTB, NXCD = 8, WGM = 8;
__host__ __device__ __forceinline__ int lds_byte(int r, int c) { const int st = (r >> 4) * 2 + (c >> 5), rr = r & 15, cc = c & 31, ob = rr * 64 + cc * 2; return st * 1024 + (ob ^ (((ob >> 9) & 1) << 5)); }
__host__ __device__ __forceinline__ void stage_rc(int b, int& R, int& C) { const int st = b / 1024, sb = b % 1024, swz = sb ^ (((sb >> 9) & 1) << 5); R = (st >> 1) * 16 + swz / 64; C = (st & 1) * 32 + (swz % 64) / 2; }
__host__ __device__ __forceinline__ int perm32(int rho) { const int n = rho >> 4, i = rho & 15; return 8 * (i >> 2) + 4 * n + (i & 3); }

struct Unit { int pm, pn, e, r0; };

__device__ __forceinline__ unsigned cvt_pk_bf16(float lo, float hi) { unsigned r; asm volatile("v_cvt_pk_bf16_f32 %0, %1, %2" : "=v"(r) : "v"(lo), "v"(hi)); return r; }

template <int K, class Epi, class Sched>
__device__ __forceinline__ void gemm_phase(const int tid, LAS unsigned char* lds, const char* Abase, const Sched& S, const Epi& E) {
    const int wid = __builtin_amdgcn_readfirstlane(tid >> 6), lane = tid & 63, wr = wid >> 2, wc = wid & 3, fr = lane & 15, fq = lane >> 4;
    const int nt = K / BK;
    constexpr bool DN = Sched::DENSE;
    int RA[2], CA[2]; unsigned voffB[2], voffA[2];
#pragma unroll
    for (int i = 0; i < 2; ++i) { int R, C; stage_rc(tid * 16 + i * 8192, R, C); const int Rb = Epi::PERM ? ((R & ~31) + perm32(R & 31)) : R;
        RA[i] = R; CA[i] = C; voffB[i] = (unsigned)(Rb * K + C) * 2u; voffA[i] = (unsigned)(R * K + C) * 2u; }
    const size_t kstep = (size_t)(BK * 2);
    const size_t hstep = (size_t)HALF * K * 2;
    const size_t tstep = 2 * hstep;
    const unsigned ldsw = (unsigned)wid * 1024u;
    const int aoff = lds_byte(wr * 64 + fr, fq * 8), boff = lds_byte(wc * 32 + fr, fq * 8);
#define PG8_SA(b, h) (((b) * 2 + (h)) * HTB)
#define PG8_SB(b, h) ((4 + (b) * 2 + (h)) * HTB)
#define PG8_STAGE(bufoff, gbase, voff) do { _Pragma("unroll") for (int _i = 0; _i < 2; ++_i) \
        __builtin_amdgcn_global_load_lds((const __attribute__((address_space(1))) unsigned*)((const __attribute__((address_space(1))) char*)(gbase) + (voff)[_i]), (LAS unsigned*)(lds + (bufoff) + ldsw + _i * 8192), 16, 0, 0); } while (0)
#define PG8_LDA(dst, b, h) do { _Pragma("unroll") for (int m = 0; m < 4; ++m) _Pragma("unroll") for (int k = 0; k < 2; ++k) dst[m][k] = *(const LAS bf16x8*)(lds + PG8_SA(b, h) + aoff + m * 2048 + k * 1024); } while (0)
#define PG8_LDB(dst, b, h) do { _Pragma("unroll") for (int n = 0; n < 2; ++n) _Pragma("unroll") for (int k = 0; k < 2; ++k) dst[n][k] = *(const LAS bf16x8*)(lds + PG8_SB(b, h) + boff + n * 2048 + k * 1024); } while (0)
#define PG8_MMA(ai, bj, At, Bt) do { __builtin_amdgcn_s_setprio(1); _Pragma("unroll") for (int m = 0; m < 4; ++m) _Pragma("unroll") for (int n = 0; n < 2; ++n) _Pragma("unroll") for (int k = 0; k < 2; ++k) \
        acc[ai][bj][m][n] = __builtin_amdgcn_mfma_f32_16x16x32_bf16(Bt[n][k], At[m][k], acc[ai][bj][m][n], 0, 0, 0); __builtin_amdgcn_s_setprio(0); } while (0)
#define PG8_WAIT_V(n) asm volatile("s_waitcnt vmcnt(" #n ")" ::: "memory")
#define PG8_WAIT_L(n) asm volatile("s_waitcnt lgkmcnt(" #n ")" ::: "memory")
#define PG8_BAR __builtin_amdgcn_s_barrier()
#define PG8_SCHED __builtin_amdgcn_sched_barrier(0)
#define PG8_AOFF(dst, u) do { _Pragma("unroll") for (int _h = 0; _h < 2; ++_h) _Pragma("unroll") for (int _i = 0; _i < 2; ++_i) \
        dst[_h][_i] = ((unsigned)S.a_row(u, _h * HALF + RA[_i]) * (unsigned)K + (unsigned)CA[_i]) * 2u; } while (0)
    Unit cur, nxt; int ui = 0;
    if (!S.next(0, cur)) return;
    f32x4 acc[2][2][4][2];
#pragma unroll
    for (int a = 0; a < 2; ++a)
#pragma unroll
        for (int b = 0; b < 2; ++b)
#pragma unroll
            for (int m = 0; m < 4; ++m)
#pragma unroll
                for (int n = 0; n < 2; ++n) acc[a][b][m][n] = (f32x4){0.f, 0.f, 0.f, 0.f};
    bf16x8 At[4][2], B0[2][2], B1[2][2];
    unsigned cO[2][2], nO[2][2];
    const char* cA = Abase; const char* nA = Abase;
    if constexpr (DN) cA = Abase + (size_t)S.a_row(cur, 0) * K * 2; else PG8_AOFF(cO, cur);
    const char* cB = S.b_ptr(cur);
#define PG8_STA(bufoff, h_, kb_, nx_) do { if constexpr (DN) PG8_STAGE(bufoff, ((nx_) ? nA : cA) + (h_) * hstep + (kb_), voffA); else PG8_STAGE(bufoff, Abase + (kb_), ((nx_) ? nO : cO)[h_]); } while (0)
    PG8_STAGE(PG8_SB(0, 0), cB, voffB); PG8_SCHED; PG8_STA(PG8_SA(0, 0), 0, 0, false); PG8_SCHED; PG8_STAGE(PG8_SB(0, 1), cB + hstep, voffB); PG8_SCHED; PG8_STA(PG8_SA(0, 1), 1, 0, false); PG8_SCHED;
    if (wr == 1) PG8_BAR;
    PG8_WAIT_V(4); PG8_BAR;
    PG8_STAGE(PG8_SB(1, 0), cB + kstep, voffB); PG8_SCHED; PG8_STA(PG8_SA(1, 0), 0, kstep, false); PG8_SCHED; PG8_STAGE(PG8_SB(1, 1), cB + hstep + kstep, voffB); PG8_SCHED;
    PG8_WAIT_V(6); PG8_BAR;
    for (;;) {
        const bool has_next = S.next(ui + 1, nxt);
        const char* nB = cB; nA = cA;
        if (has_next) { if constexpr (DN) nA = Abase + (size_t)S.a_row(nxt, 0) * K * 2; else PG8_AOFF(nO, nxt); nB = S.b_ptr(nxt); }
        else if constexpr (!DN) {
#pragma unroll
            for (int h = 0; h < 2; ++h)
#pragma unroll
                for (int i = 0; i < 2; ++i) nO[h][i] = cO[h][i]; }
        for (int t = 0; t < nt; t += 2) {
            const bool last = (t == nt - 2);
            const size_t k1 = (size_t)(t + 1) * kstep, k2 = last ? 0 : (size_t)(t + 2) * kstep, k3 = k2 + kstep;
            const char* b2 = last ? nB : cB + (size_t)(t + 2) * kstep; const char* b3 = b2 + kstep;
            PG8_LDB(B0, 0, 0); PG8_SCHED; PG8_LDA(At, 0, 0); PG8_STA(PG8_SA(1, 1), 1, k1, false);
            PG8_WAIT_L(8); PG8_BAR; PG8_WAIT_L(0); PG8_MMA(0, 0, At, B0); PG8_BAR; PG8_SCHED;
            PG8_LDB(B1, 0, 1); PG8_STAGE(PG8_SB(0, 0), b2, voffB);
            PG8_BAR; PG8_WAIT_L(0); PG8_MMA(0, 1, At, B1); PG8_BAR;
            PG8_LDA(At, 0, 1); PG8_STA(PG8_SA(0, 0), 0, k2, last);
            PG8_BAR; PG8_WAIT_L(0); PG8_MMA(1, 0, At, B0); PG8_BAR; PG8_SCHED;
            PG8_STAGE(PG8_SB(0, 1), b2 + hstep, voffB);
            PG8_WAIT_V(6); PG8_BAR; PG8_MMA(1, 1, At, B1); PG8_BAR;
            PG8_LDB(B0, 1, 0); PG8_SCHED; PG8_LDA(At, 1, 0); PG8_STA(PG8_SA(0, 1), 1, k2, last);
            PG8_WAIT_L(8); PG8_BAR; PG8_WAIT_L(0); PG8_MMA(0, 0, At, B0); PG8_BAR; PG8_SCHED;
            PG8_LDB(B1, 1, 1); PG8_STAGE(PG8_SB(1, 0), b3, voffB);
            PG8_BAR; PG8_WAIT_L(0); PG8_MMA(0, 1, At, B1); PG8_BAR;
            PG8_LDA(At, 1, 1); PG8_STA(PG8_SA(1, 0), 0, k3, last);
            PG8_BAR; PG8_WAIT_L(0); PG8_MMA(1, 0, At, B0); PG8_BAR; PG8_SCHED;
            PG8_STAGE(PG8_SB(1, 1), b3 + hstep, voffB);
            PG8_WAIT_V(6); PG8_BAR; PG8_MMA(1, 1, At, B1); PG8_BAR;
        }
        E(acc, cur, wid);
        if (!has_next) break;
#pragma unroll
        for (int a = 0; a < 2; ++a)
#pragma unroll
            for (int b = 0; b < 2; ++b)
#pragma unroll
                for (int m = 0; m < 4; ++m)
#pragma unroll
                    for (int n = 0; n < 2; ++n) acc[a][b][m][n] = (f32x4){0.f, 0.f, 0.f, 0.f};
        cur = nxt; cB = nB; cA = nA; ++ui;
        if constexpr (!DN) {
#pragma unroll
        for (int h = 0; h < 2; ++h)
#pragma unroll
            for (int i = 0; i < 2; ++i) cO[h][i] = nO[h][i]; }
    }
    PG8_WAIT_V(0);
    if (wr == 0) PG8_BAR;
    PG8_BAR;
#undef PG8_SA
#undef PG8_SB
#undef PG8_STAGE
#undef PG8_LDA
#undef PG8_LDB
#undef PG8_MMA
#undef PG8_WAIT_V
#undef PG8_WAIT_L
#undef PG8_BAR
#undef PG8_SCHED
#undef PG8_AOFF
#undef PG8_STA
}
}
struct DenseSched {
    static constexpr bool DENSE = true;
    int nM, nN, nwg, G, c, K; const char* Bt;
    __device__ __forceinline__ void init(int M, int N, int K_, const bf16_t* Bt_, int G_, int c_) { nM = M / 256; nN = N / 256; nwg = nM * nN; G = G_; c = c_; K = K_; Bt = (const char*)Bt_; }
    __device__ __forceinline__ bool next(int i, pg8::Unit& u) const {
        const long L = (long)i * G + c; if (L >= nwg) return false;
        int wgid = (int)L; { const int q = nwg / 8, r = nwg % 8, xcd = wgid % 8, off = wgid / 8; wgid = (xcd < r ? xcd * (q + 1) : r * (q + 1) + (xcd - r) * q) + off; }
        const int nig = 8 * nN, gid = wgid / nig, fm = gid * 8, gsz = (nM - fm) < 8 ? (nM - fm) : 8;
        u.pm = fm + ((wgid % nig) % gsz); u.pn = (wgid % nig) / gsz; u.e = 0; u.r0 = 0; return true;
    }
    __device__ __forceinline__ int a_row(const pg8::Unit& u, int r) const { return u.pm * 256 + r; }
    __device__ __forceinline__ const char* b_ptr(const pg8::Unit& u) const { return Bt + (size_t)u.pn * 256 * K * 2; }
};
template <bool GATHER> struct MoeSched {
    static constexpr bool DENSE = !GATHER;
    const LAS int* tstart; const LAS int* cnt; int nN, G, c, K, row_lo; const int* ltok; const char* Bt; size_t bstride;
    __device__ __forceinline__ bool next(int i, pg8::Unit& u) const {
        const long L = (long)i * G + c; const int ntile = __builtin_amdgcn_readfirstlane(tstart[NE1]); if (L >= (long)ntile * nN) return false;
        const int tile = (int)(L / nN); u.pn = (int)(L % nN);
        int e = 0;
#pragma unroll 1
        for (int step = 64; step >= 1; step >>= 1) { const int e2 = e + step; if (e2 <= NE && tstart[e2] <= tile) e = e2; }
        e = __builtin_amdgcn_readfirstlane(e); u.e = e; u.pm = __builtin_amdgcn_readfirstlane(tile); u.pn = __builtin_amdgcn_readfirstlane(u.pn); u.r0 = __builtin_amdgcn_readfirstlane((tile - tstart[e]) * 256); return true;
    }
    __device__ __forceinline__ int a_row(const pg8::Unit& u, int r) const {
        if (!GATHER) return u.pm * 256 + r;
        const int ri = u.r0 + r;
        if (u.e == NE) return ri < cnt[NE] ? row_lo + ri : row_lo;
        return ri < cnt[u.e] ? ltok[(size_t)u.e * ROWS + ri] : row_lo;
    }
    __device__ __forceinline__ const char* b_ptr(const pg8::Unit& u) const { return Bt + (size_t)u.e * bstride + (size_t)u.pn * 256 * K * 2; }
};

struct EpiProj {
    static constexpr bool PERM = true;
    bf16_t* O; int ldc;
    __device__ __forceinline__ void operator()(const f32x4 (&acc)[2][2][4][2], const pg8::Unit& u, const int wid) const {
        const int lane_ = lane_id_asm(), fr = lane_ & 15, fq = lane_ >> 4, wr = wid >> 2, wc = wid & 3;
        const int row0 = u.pm * 256 + wr * 64 + fr, col0 = u.pn * 256 + wc * 32 + 8 * fq;
#pragma unroll
        for (int ai = 0; ai < 2; ++ai)
#pragma unroll
            for (int m = 0; m < 4; ++m) { bf16_t* rowp = O + (size_t)(row0 + ai * 128 + m * 16) * ldc + col0;
#pragma unroll
                for (int bj = 0; bj < 2; ++bj) { const f32x4 v0 = acc[ai][bj][m][0], v1 = acc[ai][bj][m][1];
                    u32x4 w; w.x = pg8::cvt_pk_bf16(v0[0], v0[1]); w.y = pg8::cvt_pk_bf16(v0[2], v0[3]); w.z = pg8::cvt_pk_bf16(v1[0], v1[1]); w.w = pg8::cvt_pk_bf16(v1[2], v1[3]);
                    *(u32x4*)(rowp + bj * 128) = w; } }
    }
};
struct EpiRes {
    static constexpr bool PERM = false;
    const float* xsrc; const float* csrc; float* xdst; float* cdst; const float* gate;
    __device__ __forceinline__ void operator()(const f32x4 (&acc)[2][2][4][2], const pg8::Unit& u, const int wid) const {
        const int lane_ = lane_id_asm(), fr = lane_ & 15, fq = lane_ >> 4, wr = wid >> 2, wc = wid & 3;
        const int col0 = u.pn * 256 + wc * 32 + 4 * fq;
        const bool isc = u.pm < 4; const int sel = isc ? 4 : (u.pm - 4) >> 5;
        const float* src = isc ? csrc + (size_t)u.pm * 256 * D : xsrc + (size_t)(u.pm - 4) * 256 * D;
        float* dst = isc ? cdst + (size_t)u.pm * 256 * D : xdst + (size_t)(u.pm - 4) * 256 * D;
        f32x4 gv[2][2];
#pragma unroll
        for (int bj = 0; bj < 2; ++bj)
#pragma unroll
            for (int n = 0; n < 2; ++n) gv[bj][n] = *(const f32x4*)(gate + sel * 6144 + col0 + bj * 128 + n * 16);
#pragma unroll
        for (int ai = 0; ai < 2; ++ai)
#pragma unroll
            for (int m = 0; m < 4; ++m) { const size_t off = (size_t)(ai * 128 + wr * 64 + m * 16 + fr) * D + col0;
#pragma unroll
                for (int bj = 0; bj < 2; ++bj)
#pragma unroll
                    for (int n = 0; n < 2; ++n) { const f32x4 s = *(const f32x4*)(src + off + bj * 128 + n * 16); *(f32x4*)(dst + off + bj * 128 + n * 16) = s + gv[bj][n] * acc[ai][bj][m][n]; }
                asm volatile("" ::: "memory"); }
    }
};
struct EpiGU {
    static constexpr bool PERM = false;
    bf16_t* H;
    __device__ __forceinline__ void operator()(const f32x4 (&acc)[2][2][4][2], const pg8::Unit& u, const int wid) const {
        const int lane_ = lane_id_asm(), fr = lane_ & 15, fq = lane_ >> 4, wr = wid >> 2, wc = wid & 3;
        const int row0 = u.pm * 256 + wr * 64 + fr;
#pragma unroll
        for (int ai = 0; ai < 2; ++ai)
#pragma unroll
            for (int m = 0; m < 4; ++m) { bf16_t* rowp = H + (size_t)(row0 + ai * 128 + m * 16) * EH + 4 * fq;
#pragma unroll
                for (int bj = 0; bj < 2; ++bj) { const f32x4 g = acc[ai][bj][m][0], up = acc[ai][bj][m][1]; float h[4];
#pragma unroll
                    for (int j = 0; j < 4; ++j) h[j] = g[j] / (1.0f + __expf(-g[j])) * up[j];
                    u32x2 w; w.x = pg8::cvt_pk_bf16(h[0], h[1]); w.y = pg8::cvt_pk_bf16(h[2], h[3]);
                    *(u32x2*)(rowp + (u.pn * 256 + bj * 128 + wc * 32) / 2) = w; } }
    }
};
struct EpiY {
    static constexpr bool PERM = true;
    bf16_t* Y;
    __device__ __forceinline__ void operator()(const f32x4 (&acc)[2][2][4][2], const pg8::Unit& u, const int wid) const {
        const int lane_ = lane_id_asm(), fr = lane_ & 15, fq = lane_ >> 4, wr = wid >> 2, wc = wid & 3;
        const int row0 = u.pm * 256 + wr * 64 + fr, col0 = u.pn * 256 + wc * 32 + 8 * fq;
#pragma unroll
        for (int ai = 0; ai < 2; ++ai)
#pragma unroll
            for (int m = 0; m < 4; ++m) { bf16_t* rowp = Y + (size_t)(row0 + ai * 128 + m * 16) * 512 + col0;
#pragma unroll
                for (int bj = 0; bj < 2; ++bj) { const f32x4 v0 = acc[ai][bj][m][0], v1 = acc[ai][bj][m][1];
                    u32x4 w; w.x = pg8::cvt_pk_bf16(v0[0], v0[1]); w.y = pg8::cvt_pk_bf16(v0[2], v0[3]); w.z = pg8::cvt_pk_bf16(v1[0], v1[1]); w.w = pg8::cvt_pk_bf16(v1[2], v1[3]);
                    *(u32x4*)(rowp + bj * 128) = w; } }
    }
};
#define WSP(T, off) ((T*)(p.ws + (off)))

__device__ __forceinline__ void conv_tile(const int t, LAS float* tl, const float* __restrict__ src, int ldsrc, int k0, int n0, int nvalid, bf16_t* dst, int lddst, int mode) {
#pragma unroll
    for (int j = 0; j < 8; ++j) { const int idx = t + NTHR * j, k = idx >> 6, n = idx & 63; float v = 0.f; if (n0 + n < nvalid) v = src[(size_t)(k0 + k) * ldsrc + n0 + n]; tl[k * 65 + n] = v; }
    __syncthreads();
#pragma unroll
    for (int j = 0; j < 4; ++j) { const int pi = t + NTHR * j, n = pi >> 5, k = (pi & 31) * 2; const int nn = n0 + n;
        const int row = (mode == 0 || mode == 3) ? nn : ((nn >> 4) * 32 + (nn & 15) + (mode == 2 ? 16 : 0));
        float v0 = tl[k * 65 + n], v1 = tl[(k + 1) * 65 + n];
        if (mode == 3) { v0 -= bf2f((bf16_t)f2bf(v0)); v1 -= bf2f((bf16_t)f2bf(v1)); }
        *(unsigned*)(dst + (size_t)row * lddst + k0 + k) = pk2(v0, v1); }
    __syncthreads();
}
constexpr int CONV_A_UNITS = 2048 + 512 + 64;
__device__ __forceinline__ void conv_unit_A(const Cx& p, LAS float* tl, int u) {
    if (u < 2048) { const int l = u >> 10, r = u & 1023; conv_tile(p.tid, tl, PIN(I_WIN) + (size_t)l * D * INW, INW, (r >> 6) * 64, (r & 63) * 64, INW, WSP(bf16_t, WS_WIN) + (size_t)l * NPROJ * D, D, 0); }
    else if (u < 2560) { const int v = u - 2048, l = v >> 8, r = v & 255; conv_tile(p.tid, tl, PIN(I_WOUT) + (size_t)l * D * D, D, (r >> 4) * 64, (r & 15) * 64, D, WSP(bf16_t, WS_WOUT) + (size_t)l * D * D, D, 0); }
    else { const int v = u - 2560, l = v >> 5, lo = (v >> 4) & 1, r = v & 15; conv_tile(p.tid, tl, PIN(I_ROUT_W) + (size_t)l * D * NE, NE, r * 64, 0, NE, WSP(bf16_t, WS_ROUT) + (size_t)(l * 2 + lo) * NE * D, D, lo ? 3 : 0); }
}
constexpr int CONV_E_UNITS = NE1 * 192;
struct ConvDesc { const float* src; bf16_t* dst; int ldsrc, lddst, k0, n0, mode; };
__device__ __forceinline__ ConvDesc conv_desc_E(const Cx& p, int l, int u) {
    ConvDesc c; const int e = u / 192, r = u % 192;
    if (r < 128) { const int up = r >> 6, q = r & 63;
        c.src = e < NE ? PIN(up ? I_EXP_U : I_EXP_G) + ((size_t)l * NE + e) * D * EH : PIN(up ? I_SH_U : I_SH_G) + (size_t)l * D * EH;
        c.ldsrc = EH; c.k0 = (q >> 2) * 64; c.n0 = (q & 3) * 64; c.dst = WSP(bf16_t, WS_EXPGU) + (size_t)e * 512 * D; c.lddst = D; c.mode = 1 + up; }
    else { const int q = r - 128;
        c.src = e < NE ? PIN(I_EXP_D) + ((size_t)l * NE + e) * EH * D : PIN(I_SH_D) + (size_t)l * EH * D;
        c.ldsrc = D; c.k0 = (q >> 4) * 64; c.n0 = (q & 15) * 64; c.dst = WSP(bf16_t, WS_EXPD) + (size_t)e * D * EH; c.lddst = EH; c.mode = 0; }
    return c;
}
__device__ __forceinline__ void conv_experts(const Cx& p, LAS float* tl, int l) {
    const int t = p.tid; int u = p.bid; if (u >= CONV_E_UNITS) return;
    float v[8]; ConvDesc c = conv_desc_E(p, l, u);
#pragma unroll
    for (int j = 0; j < 8; ++j) { const int idx = t + NTHR * j; v[j] = c.src[(size_t)(c.k0 + (idx >> 6)) * c.ldsrc + c.n0 + (idx & 63)]; }
    for (;;) {
#pragma unroll
        for (int j = 0; j < 8; ++j) { const int idx = t + NTHR * j; tl[(idx >> 6) * 65 + (idx & 63)] = v[j]; }
        __syncthreads();
        const int un = u + p.G; const bool more = un < CONV_E_UNITS; const ConvDesc cn = conv_desc_E(p, l, more ? un : u);
        if (more) {
#pragma unroll
            for (int j = 0; j < 8; ++j) { const int idx = t + NTHR * j; v[j] = cn.src[(size_t)(cn.k0 + (idx >> 6)) * cn.ldsrc + cn.n0 + (idx & 63)]; } }
#pragma unroll
        for (int j = 0; j < 4; ++j) { const int pi = t + NTHR * j, n = pi >> 5, k = (pi & 31) * 2; const int nn = c.n0 + n;
            const int row = c.mode == 0 ? nn : ((nn >> 4) * 32 + (nn & 15) + (c.mode == 2 ? 16 : 0));
            *(unsigned*)(c.dst + (size_t)row * c.lddst + c.k0 + k) = pk2(tl[k * 65 + n], tl[(k + 1) * 65 + n]); }
        __syncthreads();
        if (!more) break;
        c = cn; u = un;
    }
}
__device__ __forceinline__ void phase_mod(const Cx& p, LAS unsigned char* lds) {
    LAS float* sv = (LAS float*)lds; LAS float* red = sv + 5 * D;
    const int tid = p.tid;
    if (p.bid >= 192) return;
    for (int i = tid; i < 5 * D; i += NTHR) { const int j = i >> 10, k = i & 1023; const float c = j < 4 ? PIN(I_C)[j * D + k] : PIN(I_CCTX)[k]; sv[i] = siluf_(c); }
    __syncthreads();
    for (int u = p.bid; u < 192; u += p.G) {
        const int l = u / 96, cb = u % 96, kg = tid >> 6, cl = tid & 63;
        const float* w = PIN(I_WMOD) + (size_t)l * D * 6144 + cb * 64 + cl;
        float a0 = 0.f, a1 = 0.f, a2 = 0.f, a3 = 0.f, a4 = 0.f;
#pragma unroll 8
        for (int kk = 0; kk < 128; ++kk) { const int k = kg * 128 + kk; const float wv = w[(size_t)k * 6144];
            a0 += sv[k] * wv; a1 += sv[D + k] * wv; a2 += sv[2 * D + k] * wv; a3 += sv[3 * D + k] * wv; a4 += sv[4 * D + k] * wv; }
        red[(kg * 5 + 0) * 64 + cl] = a0; red[(kg * 5 + 1) * 64 + cl] = a1; red[(kg * 5 + 2) * 64 + cl] = a2; red[(kg * 5 + 3) * 64 + cl] = a3; red[(kg * 5 + 4) * 64 + cl] = a4;
        __syncthreads();
        if (tid < 320) { const int j = tid >> 6; float s = 0.f;
#pragma unroll
            for (int g = 0; g < 8; ++g) s += red[(g * 5 + j) * 64 + cl];
            WSP(float, WS_MOD)[((size_t)l * 5 + j) * 6144 + cb * 64 + cl] = s + PIN(I_BMOD)[l * 6144 + cb * 64 + cl]; }
        __syncthreads();
    }
}
__device__ __forceinline__ const float* res_row(const Cx& p, int layer_src0, int r) {
    if (r < CROWS) return (layer_src0 ? PIN(I_CTX) : (const float*)WSP(float, WS_CTXRES)) + (size_t)r * D;
    return (layer_src0 ? PIN(I_X) : (const float*)p.out) + (size_t)(r - CROWS) * D;
}
__device__ __forceinline__ int row_sel(int r) { return r < CROWS ? 4 : (r - CROWS) >> 13; }

__device__ __forceinline__ void norm_ld(const float* src, f32x4 (&v)[4], int lane) {
#pragma unroll
    for (int i = 0; i < 4; ++i) v[i] = *(const f32x4*)(src + 256 * i + 4 * lane);
}
__device__ __forceinline__ void norm_fin(const f32x4 (&v)[4], const float* g, const float* shift, const float* scale, bf16_t* dst, const bool tolds, LAS bf16_t* ldst, LAS bf16_t* ldlo, int lane) {
    float ss = 0.f;
#pragma unroll
    for (int i = 0; i < 4; ++i) ss += v[i][0] * v[i][0] + v[i][1] * v[i][1] + v[i][2] * v[i][2] + v[i][3] * v[i][3];
    ss = wsum(ss); const float rstd = rsqrtf(ss * (1.0f / D) + 1e-6f);
#pragma unroll
    for (int i = 0; i < 4; ++i) { const int col = 256 * i + 4 * lane; const f32x4 gv = *(const f32x4*)(g + col), sh = *(const f32x4*)(shift + col), sc = *(const f32x4*)(scale + col);
        const f32x4 y = v[i] * rstd * gv * (sc + 1.0f) + sh; u32x2 w; w.x = pk2(y[0], y[1]); w.y = pk2(y[2], y[3]);
        *(u32x2*)(dst + col) = w;
        if (tolds) { *(LAS u32x2*)(ldst + col) = w; u32x2 wl;
            wl.x = pk2(y[0] - __uint_as_float(w.x << 16), y[1] - __uint_as_float(w.x & 0xffff0000u)); wl.y = pk2(y[2] - __uint_as_float(w.y << 16), y[3] - __uint_as_float(w.y & 0xffff0000u));
            *(LAS u32x2*)(ldlo + col) = wl; } }
}
__device__ __forceinline__ void phase_norm1(const Cx& p, int layer) {
    const int lane = p.tid & 63, wave = p.tid >> 6;
    const float* mod = WSP(float, WS_MOD) + (size_t)layer * 5 * 6144; const float* g = PIN(I_N1G) + layer * D; bf16_t* hb = WSP(bf16_t, WS_HBUF);
    for (int r = p.bid * 16 + wave * 2; r < ROWS; r += p.G * 16) { f32x4 v0[4], v1[4];
        norm_ld(res_row(p, layer == 0, r), v0, lane); norm_ld(res_row(p, layer == 0, r + 1), v1, lane);
        const int s0 = row_sel(r), s1 = row_sel(r + 1);
        norm_fin(v0, g, mod + s0 * 6144 + 0, mod + s0 * 6144 + 1024, hb + (size_t)r * D, false, (LAS bf16_t*)0, (LAS bf16_t*)0, lane);
        norm_fin(v1, g, mod + s1 * 6144 + 0, mod + s1 * 6144 + 1024, hb + (size_t)(r + 1) * D, false, (LAS bf16_t*)0, (LAS bf16_t*)0, lane); }
}
__device__ __forceinline__ void phase_prep(const Cx& p, LAS unsigned char* lds, int layer, int b) {
    const int lane = p.tid & 63, wave = __builtin_amdgcn_readfirstlane(p.tid >> 6);
    const bf16_t* proj = WSP(bf16_t, WS_PROJ);
    if (p.bid < SB / 33) {
        LAS float* wl = (LAS float*)lds;
        { const float* AW = PIN(I_RW_AW2) + (size_t)layer * 32 * 256; const float* WW = PIN(I_RW_W2) + (size_t)layer * 2 * 32 * 256;
          for (int i = p.tid; i < 96 * 256; i += NTHR) wl[i] = i < 32 * 256 ? AW[i] : WW[i - 32 * 256]; }
        __syncthreads();
        const int h = wave & 3, half = wave >> 2, c = 64 * h + lane;
        const float a0 = PIN(I_RW_A0)[layer * 256 + c], w0f = PIN(I_RW_W0)[(layer * 2 + 0) * 256 + c], w0b = PIN(I_RW_W0)[(layer * 2 + 1) * 256 + c];
        const float kkm = PIN(I_RW_KK)[layer * 256 + c], kam = PIN(I_RW_KA)[layer * 256 + c];
        for (int u = p.bid; u < SB / 33; u += p.G) {
#pragma unroll 1
            for (int i0 = 0; i0 < (half ? 15 : 18); i0 += 3) {
                float xa[3], xf[3], xb[3], kv[3], sa[3], sf[3], sb[3];
#pragma unroll
                for (int t = 0; t < 3; ++t) { const bf16_t* pr = proj + (size_t)tok_row(b, u * 33 + half * 18 + i0 + t) * NPROJ; xa[t] = 0.f; xf[t] = 0.f; xb[t] = 0.f;
                    if (lane < 32) { xa[t] = bf2f(pr[PB_A + lane]); xf[t] = bf2f(pr[PB_WF + lane]); xb[t] = bf2f(pr[PB_WB + lane]); }
                    kv[t] = bf2f(pr[PB_K + c]); sa[t] = a0; sf[t] = w0f; sb[t] = w0b; }
#pragma unroll
                for (int t = 0; t < 3; ++t) { xf[t] = tanhf_(xf[t]); xb[t] = tanhf_(xb[t]); }
#pragma unroll 4
                for (int j = 0; j < 32; ++j) { const float wa = wl[j * 256 + c], wf = wl[(32 + j) * 256 + c], wb = wl[(64 + j) * 256 + c];
#pragma unroll
                    for (int t = 0; t < 3; ++t) { sa[t] += rl(xa[t], j) * wa; sf[t] += rl(xf[t], j) * wf; sb[t] += rl(xb[t], j) * wb; } }
#pragma unroll
                for (int t = 0; t < 3; ++t) { const int s = u * 33 + half * 18 + i0 + t; const float a = sigmoidf_(sa[t]);
                    const float lwf = -__expf(-softplusf_(-sf[t]) - 0.5f), lwb = -__expf(-softplusf_(-sb[t]) - 0.5f);
                    const float kr = kv[t] * kkm; const float ss = wsum(kr * kr); const float kk = kr * rsqrtf(ss + 1e-6f);
                    const size_t o = (size_t)s * 256 + c;
                    WSP(float, SC_RK)[o] = kv[t] * (1.0f + (a - 1.0f) * kam); WSP(float, SC_RKK)[o] = kk; WSP(float, SC_RB)[o] = kk * a;
                    WSP(float, SC_RLW)[o] = lwf; WSP(float, SC_RLW)[(size_t)SB * 256 + o] = lwb; } }
        }
    }
    __syncthreads();
    { LAS bf16_t* T = (LAS bf16_t*)lds; const int tid = p.tid;
#define PC_LOAD(uu, v, vh) do { const int mixer_ = (uu) / (NTB * 3), r2_ = (uu) % (NTB * 3), rb_ = r2_ / 3, colbase_ = (mixer_ ? PD_Q : PC_X) + 256 * (r2_ % 3); \
          _Pragma("unroll") for (int q = 0; q < 12; ++q) { const int e = tid + NTHR * q, rr = e >> 11, tok = (e >> 5) & 63, ch = (e & 31) * 8; v[q] = (u32x4){0u, 0u, 0u, 0u}; \
              if (rb_ < 4) { if (rr == 1) v[q] = *(const u32x4*)(proj + (size_t)(b * NCTX + 64 * rb_ + tok) * NPROJ + colbase_ + ch); } \
              else { const int gr = rb_ - 4 + rr - 1; if (gr >= 0 && gr < GRIDH) v[q] = *(const u32x4*)(proj + (size_t)(CROWS + b * SEQ + gr * 64 + tok) * NPROJ + colbase_ + ch); } } \
          vh = (u32x4){0u, 0u, 0u, 0u}; if (tid < 192) { const int rr = tid >> 6, side = (tid >> 5) & 1, ch = (tid & 31) * 8;       \
              if (rb_ < 4 && rr == 1) { const int tk = side ? 64 * (rb_ + 1) : 64 * rb_ - 1; if (tk >= 0 && tk < NCTX) vh = *(const u32x4*)(proj + (size_t)(b * NCTX + tk) * NPROJ + colbase_ + ch); } } } while (0)
      int u = p.bid;
      if (u < 2 * NTB * 3) { u32x4 v[12], vh; PC_LOAD(u, v, vh);
        for (;;) { const int mixer = u / (NTB * 3), r2 = u % (NTB * 3), rb = r2 / 3, third = r2 % 3;
#pragma unroll
          for (int q = 0; q < 12; ++q) { const int e = tid + NTHR * q, rr = e >> 11, tok = (e >> 5) & 63, ch = (e & 31) * 8; *(LAS u32x4*)(T + (rr * 66 + tok + 1) * 256 + ch) = v[q]; }
          if (tid < 192) { const int rr = tid >> 6, side = (tid >> 5) & 1, ch = (tid & 31) * 8; *(LAS u32x4*)(T + (rr * 66 + (side ? 65 : 0)) * 256 + ch) = vh; }
          __syncthreads();
          const int un = u + p.G; const bool more = un < 2 * NTB * 3;
          if (more) PC_LOAD(un, v, vh);
          { const int c = tid & 255, th = tid >> 8, chn = 256 * third + c; float w[9];
            const float* cw = (mixer ? PIN(I_DN_CW) : PIN(I_SS_CW)) + (size_t)layer * 9 * 768 + chn;
#pragma unroll
            for (int k = 0; k < 9; ++k) w[k] = cw[k * 768];
            const float bias = mixer ? 0.f : PIN(I_SS_CB)[layer * 768 + chn];
            bf16_t* dst = (mixer ? WSP(bf16_t, SC_DQ) : WSP(bf16_t, SC_SX)) + (size_t)(64 * rb) * 768 + chn;
#pragma unroll 2
            for (int tk = 0; tk < 32; ++tk) { const int x = 32 * th + tk; float acc = bias;
#pragma unroll
                for (int dy = 0; dy < 3; ++dy)
#pragma unroll
                    for (int dx = 0; dx < 3; ++dx) acc += w[dy * 3 + dx] * bf2f(T[(dy * 66 + x + dx) * 256 + c]);
                float y = siluf_(acc);
                if (mixer && third < 2) { const float ss = wsum(y * y); y *= rsqrtf(ss + 1e-6f); if (third == 0) y *= 0.125f; }
                dst[(size_t)x * 768] = (bf16_t)f2bf(y); } }
          __syncthreads();
          if (!more) break;
          u = un; } }
#undef PC_LOAD
      for (int e = p.bid * NTHR + tid; e < SB * 24; e += p.G * NTHR) { const int s = e / 24, q = e % 24; const bf16_t* pr = proj + (size_t)tok_row(b, s) * NPROJ;
          if (q < 8) { const int d = q >> 2, h = q & 3; WSP(float, SC_SDT)[(size_t)s * 8 + q] = softplusf_(bf2f(pr[PC_DF + q]) + PIN(I_SS_DTB)[(layer * 2 + d) * 4 + h]); }
          else if (q < 16) { WSP(float, SC_DG)[(size_t)s * 16 + (q - 8)] = sigmoidf_(bf2f(pr[PD_BF + (q - 8)])); }
          else { const int q2 = q - 16, d = q2 >> 2, h = q2 & 3; WSP(float, SC_DG)[(size_t)s * 16 + 8 + q2] = -__expf(PIN(I_DN_ALOG)[(layer * 2 + d) * 4 + h]) * softplusf_(bf2f(pr[PD_AF + q2]) + PIN(I_DN_DTB)[(layer * 2 + d) * 4 + h]); } }
    }
}
__device__ __forceinline__ void phase_scan(const Cx& p, LAS unsigned char* lds, int layer, int b);
__device__ __forceinline__ float sum8_(float v) { v += DPPF(v, 0xB1); v += DPPF(v, 0x4E); v += DPPF(v, 0x141); return v; }
__device__ __forceinline__ float sum16_(float v) { v = sum8_(v); v += DPPF(v, 0x140); return v; }
__device__ __forceinline__ void bf8_to_f(const u32x4 w, float (&f)[8]) {
#pragma unroll
    for (int q = 0; q < 4; ++q) { f[2 * q] = __uint_as_float(w[q] << 16); f[2 * q + 1] = __uint_as_float(w[q] & 0xffff0000u); } }
__device__ __forceinline__ void phase_post(const Cx& p, LAS unsigned char* lds, int layer, int b) {
    const int tid = p.tid, tsub = tid >> 7, c8 = (tid & 127) * 8, mixer = c8 >> 8, cm = c8 & 255, hh = cm >> 6;
    const bf16_t* proj = WSP(bf16_t, WS_PROJ); const bf16_t* of = WSP(bf16_t, SC_OF); const bf16_t* obk = WSP(bf16_t, SC_OB); bf16_t* yc = WSP(bf16_t, WS_HBUF);
    LAS float* GW = (LAS float*)lds; LAS float* SG = GW + 64 * 256;
    if ((int)p.bid < SB / 33) { const float* gsrc = PIN(I_RW_GW2) + (size_t)layer * 64 * 256; for (int i = tid; i < 64 * 256; i += NTHR) GW[i] = gsrc[i]; }
    float g0[8], g1[8], g2[8];
#pragma unroll
    for (int q = 0; q < 8; ++q) { const int c = cm + q; g0[q] = 0.f; g1[q] = 0.f; g2[q] = 0.f;
        if (mixer == 0) g0[q] = PIN(I_GLA_NG)[layer * 256 + c];
        else if (mixer == 1) { g0[q] = PIN(I_RW_LNG)[layer * 256 + c]; g1[q] = PIN(I_RW_LNB)[layer * 256 + c]; g2[q] = PIN(I_RW_RK)[layer * 256 + c]; }
        else if (mixer == 2) { g0[q] = PIN(I_SS_NG)[layer * 256 + c]; g1[q] = PIN(I_SS_D)[layer * 4 + hh]; }
        else g0[q] = PIN(I_DN_NG)[layer * 256 + c]; }
    for (int u = p.bid; u < SB / 33; u += p.G) {
#pragma unroll 1
        for (int t0 = 0; t0 < 33; t0 += 4) { const int tk = t0 + tsub; const bool live = tk < 33; const int s = u * 33 + (live ? tk : 32), row = tok_row(b, s);
            const bf16_t* pr = proj + (size_t)row * NPROJ; float o[8], a[8], y[8];
            { float t1[8], t2[8]; bf8_to_f(*(const u32x4*)(of + (size_t)s * 1024 + c8), t1); bf8_to_f(*(const u32x4*)(obk + (size_t)s * 1024 + c8), t2);
#pragma unroll
              for (int q = 0; q < 8; ++q) o[q] = t1[q] + t2[q]; }
            __syncthreads();
            if (mixer == 1 && hh == 0) { float gl[8]; bf8_to_f(*(const u32x4*)(pr + PB_G + cm), gl);
#pragma unroll
                for (int q = 0; q < 8; ++q) SG[tsub * 64 + cm + q] = sigmoidf_(gl[q]); }
            if (mixer == 0) { bf8_to_f(*(const u32x4*)(pr + PA_G + cm), a); float ss = 0.f;
#pragma unroll
                for (int q = 0; q < 8; ++q) ss += o[q] * o[q];
                const float rs = rsqrtf(sum8_(ss) * (1.0f / 64.0f) + 1e-6f);
#pragma unroll
                for (int q = 0; q < 8; ++q) y[q] = o[q] * rs * g0[q] * siluf_(a[q]);
            } else if (mixer == 3) { bf8_to_f(*(const u32x4*)(pr + PD_Z + cm), a); float ss = 0.f;
#pragma unroll
                for (int q = 0; q < 8; ++q) ss += o[q] * o[q];
                const float rs = rsqrtf(sum8_(ss) * (1.0f / 64.0f) + 1e-6f);
#pragma unroll
                for (int q = 0; q < 8; ++q) y[q] = o[q] * rs * g0[q] * siluf_(a[q]);
            } else if (mixer == 2) { float xs[8]; bf8_to_f(*(const u32x4*)(pr + PC_Z + cm), a); bf8_to_f(*(const u32x4*)(WSP(bf16_t, SC_SX) + (size_t)s * 768 + cm), xs); float ss = 0.f;
#pragma unroll
                for (int q = 0; q < 8; ++q) { y[q] = (o[q] + g1[q] * xs[q]) * siluf_(a[q]); ss += y[q] * y[q]; }
                const float rs = rsqrtf(sum16_(ss) * (1.0f / 128.0f) + 1e-6f);
#pragma unroll
                for (int q = 0; q < 8; ++q) y[q] *= rs * g0[q];
            } else { float rr[8], vv[8]; bf8_to_f(*(const u32x4*)(pr + PB_R + cm), rr); bf8_to_f(*(const u32x4*)(pr + PB_V + cm), vv);
                const f32x4 k0 = *(const f32x4*)(WSP(float, SC_RK) + (size_t)s * 256 + cm), k1 = *(const f32x4*)(WSP(float, SC_RK) + (size_t)s * 256 + cm + 4);
                float su = 0.f, bo = 0.f;
#pragma unroll
                for (int q = 0; q < 8; ++q) { su += o[q]; bo += rr[q] * (q < 4 ? k0[q & 3] : k1[q & 3]) * g2[q]; }
                const float mu = sum8_(su) * (1.0f / 64.0f); bo = sum8_(bo); float va = 0.f;
#pragma unroll
                for (int q = 0; q < 8; ++q) { o[q] -= mu; va += o[q] * o[q]; }
                const float rs = rsqrtf(sum8_(va) * (1.0f / 64.0f) + 64e-5f);
#pragma unroll
                for (int q = 0; q < 8; ++q) y[q] = o[q] * rs * g0[q] + g1[q] + bo * vv[q]; }
            __syncthreads();
            if (mixer == 1) { float gt[8];
#pragma unroll
                for (int q = 0; q < 8; ++q) gt[q] = 0.f;
#pragma unroll 4
                for (int j = 0; j < 64; ++j) { const float sg = SG[tsub * 64 + j]; const f32x4 w0 = *(const LAS f32x4*)(GW + j * 256 + cm), w1 = *(const LAS f32x4*)(GW + j * 256 + cm + 4);
                    gt[0] += sg * w0[0]; gt[1] += sg * w0[1]; gt[2] += sg * w0[2]; gt[3] += sg * w0[3]; gt[4] += sg * w1[0]; gt[5] += sg * w1[1]; gt[6] += sg * w1[2]; gt[7] += sg * w1[3]; }
#pragma unroll
                for (int q = 0; q < 8; ++q) y[q] *= gt[q]; }
            if (live) *(u32x4*)(yc + (size_t)row * D + c8) = (u32x4){pk2(y[0], y[1]), pk2(y[2], y[3]), pk2(y[4], y[5]), pk2(y[6], y[7])};
        }
    }
}
constexpr int N2_TILE = 32, N2_STRIDE = 2064;
__device__ __forceinline__ void phase_norm2(const Cx& p, LAS unsigned char* lds, int layer, int row_lo) {
    const int tid = p.tid, lane = tid & 63, wave = __builtin_amdgcn_readfirstlane(tid >> 6), fr = lane & 15, fq = lane >> 4;
    const float* mod = WSP(float, WS_MOD) + (size_t)layer * 5 * 6144; const float* g = PIN(I_N2G) + layer * D; bf16_t* hb = WSP(bf16_t, WS_HBUF);
    const bf16_t* rt = WSP(bf16_t, WS_ROUT) + (size_t)layer * 2 * NE * D;
    LAS float* lg = (LAS float*)(lds + 2 * N2_TILE * N2_STRIDE);
    unsigned* cnt = WSP(unsigned, WS_CTL) + CW_CNT + layer * 80 * 16; int* ltok = WSP(int, WS_LTOK); int* tokt = WSP(int, WS_TOKT);
    const float rbias = PIN(I_ROUT_B)[layer * NE + lane];
    const int nun = (ROWS - row_lo) / N2_TILE;
    for (int u = p.bid; u < nun; u += p.G) { const int r0 = row_lo + u * N2_TILE;
#pragma unroll 1
        for (int i = 0; i < 4; i += 2) { const int tr = 4 * wave + i, r = r0 + tr; f32x4 v0[4], v1[4];
            norm_ld(res_row(p, 0, r), v0, lane); norm_ld(res_row(p, 0, r + 1), v1, lane);
            const int s0 = row_sel(r), s1 = row_sel(r + 1);
            norm_fin(v0, g, mod + s0 * 6144 + 3072, mod + s0 * 6144 + 4096, hb + (size_t)r * D, true, (LAS bf16_t*)(lds + tr * N2_STRIDE), (LAS bf16_t*)(lds + N2_TILE * N2_STRIDE + tr * N2_STRIDE), lane);
            norm_fin(v1, g, mod + s1 * 6144 + 3072, mod + s1 * 6144 + 4096, hb + (size_t)(r + 1) * D, true, (LAS bf16_t*)(lds + (tr + 1) * N2_STRIDE), (LAS bf16_t*)(lds + N2_TILE * N2_STRIDE + (tr + 1) * N2_STRIDE), lane); }
        __syncthreads();
        { const int mt = wave >> 2, nt = wave & 3; f32x4 acc = (f32x4){0.f, 0.f, 0.f, 0.f};
          const LAS unsigned char* ap = lds + (16 * mt + fr) * N2_STRIDE + fq * 16; const bf16_t* bp = rt + (size_t)(16 * nt + fr) * D + fq * 8;
#pragma unroll 4
          for (int ks = 0; ks < 32; ++ks) { const bf16x8 a = *(const LAS bf16x8*)(ap + ks * 64), al = *(const LAS bf16x8*)(ap + N2_TILE * N2_STRIDE + ks * 64);
              const bf16x8 bb = *(const bf16x8*)(bp + ks * 32), bl = *(const bf16x8*)(bp + NE * D + ks * 32);
              acc = __builtin_amdgcn_mfma_f32_16x16x32_bf16(a, bb, acc, 0, 0, 0); acc = __builtin_amdgcn_mfma_f32_16x16x32_bf16(al, bb, acc, 0, 0, 0); acc = __builtin_amdgcn_mfma_f32_16x16x32_bf16(a, bl, acc, 0, 0, 0); }
#pragma unroll
          for (int j = 0; j < 4; ++j) lg[(16 * mt + 4 * fq + j) * 64 + 16 * nt + fr] = acc[j]; }
        __syncthreads();
#pragma unroll 1
        for (int i = 0; i < 4; ++i) { const int tr = 4 * wave + i, r = r0 + tr;
            const float sc = sigmoidf_(lg[tr * 64 + lane]); float sel = sc + rbias; float ssum = 0.f; int myE = 0; float myS = 0.f;
#pragma unroll 1
            for (int k = 0; k < TOPK; ++k) { float bv = sel; int bi = lane;
#define ARGSTEP(OV, OI) do { const float ov_ = (OV); const int oi_ = (OI); if (ov_ > bv || (ov_ == bv && oi_ < bi)) { bv = ov_; bi = oi_; } } while (0)
                ARGSTEP(DPPF(bv, 0xB1), DPPI(bi, 0xB1)); ARGSTEP(DPPF(bv, 0x4E), DPPI(bi, 0x4E)); ARGSTEP(DPPF(bv, 0x141), DPPI(bi, 0x141)); ARGSTEP(DPPF(bv, 0x140), DPPI(bi, 0x140));
                ARGSTEP(__uint_as_float(__builtin_amdgcn_ds_swizzle(__float_as_uint(bv), 0x401F)), __builtin_amdgcn_ds_swizzle(bi, 0x401F));
                { const float v0 = rl(bv, 0), v1 = rl(bv, 32); const int i0 = __builtin_amdgcn_readlane(bi, 0), i1 = __builtin_amdgcn_readlane(bi, 32); if (v1 > v0 || (v1 == v0 && i1 < i0)) { bv = v1; bi = i1; } else { bv = v0; bi = i0; } }
#undef ARGSTEP
                const int e = __builtin_amdgcn_readfirstlane(bi); const float se = rl(sc, e);
                ssum += se; if (lane == k) { myE = e; myS = se; } if (lane == e) sel = -1e30f; }
            if (lane < TOPK) { const unsigned pos = atomicAdd(cnt + myE * 16, 1u); ltok[(size_t)myE * ROWS + pos] = r; tokt[(size_t)r * 16 + lane] = (myE << 16) | (int)pos; ((float*)tokt)[(size_t)r * 16 + 8 + lane] = myS / ssum * 2.5f; } }
        __syncthreads();
    }
}
__device__ __forceinline__ void moe_table(const Cx& p, LAS int* tb, int layer, int row_lo) {
    const unsigned* cnt = WSP(unsigned, WS_CTL) + CW_CNT + layer * 80 * 16;
    if (p.tid == 0) { int acc = 0;
#pragma unroll 1
        for (int e = 0; e < NE1; ++e) { const int c = e < NE ? (int)__hip_atomic_load(cnt + e * 16, __ATOMIC_RELAXED, __HIP_MEMORY_SCOPE_AGENT) : ROWS - row_lo; tb[e] = c; tb[128 + e] = acc; acc += (c + 255) >> 8; }
        tb[128 + NE1] = acc; }
    __syncthreads();
}
__device__ __forceinline__ void phase_combine(const Cx& p, const LAS int* tb, int layer, int row_lo, int half) {
    const int lane = p.tid & 63, wave = p.tid >> 6; const bf16_t* Y = WSP(bf16_t, WS_Y); const int* tokt = WSP(int, WS_TOKT);
    const float* gate = WSP(float, WS_MOD) + (size_t)layer * 5 * 6144 + 5120; const int col = 512 * half + 8 * lane; const int shbase = tb[128 + NE] * 256;
#pragma unroll 2
    for (int r = row_lo + p.bid * 8 + wave; r < ROWS; r += p.G * 8) {
        const int sw = lane < 16 ? tokt[(size_t)r * 16 + lane] : 0;
        float a[8];
        { const u32x4 y = *(const u32x4*)(Y + (size_t)(shbase + (r - row_lo)) * 512 + 8 * lane);
#pragma unroll
          for (int q = 0; q < 4; ++q) { a[2 * q] = __uint_as_float(y[q] << 16); a[2 * q + 1] = __uint_as_float(y[q] & 0xffff0000u); } }
#pragma unroll
        for (int k = 0; k < 8; ++k) { const int sl = __builtin_amdgcn_readlane(sw, k); const float w = __uint_as_float(__builtin_amdgcn_readlane(sw, 8 + k));
            const int hrow = tb[128 + (sl >> 16)] * 256 + (sl & 0xffff); const u32x4 y = *(const u32x4*)(Y + (size_t)hrow * 512 + 8 * lane);
#pragma unroll
            for (int q = 0; q < 4; ++q) { a[2 * q] += w * __uint_as_float(y[q] << 16); a[2 * q + 1] += w * __uint_as_float(y[q] & 0xffff0000u); } }
        float* x = (float*)res_row(p, 0, r) + col; const float* gp = gate + row_sel(r) * 6144 + col;
#pragma unroll
        for (int q = 0; q < 2; ++q) { const f32x4 gv = *(const f32x4*)(gp + 4 * q); f32x4 xv = *(const f32x4*)(x + 4 * q);
            xv[0] += gv[0] * a[4 * q]; xv[1] += gv[1] * a[4 * q + 1]; xv[2] += gv[2] * a[4 * q + 2]; xv[3] += gv[3] * a[4 * q + 3]; *(f32x4*)(x + 4 * q) = xv; }
    }
}
__device__ __forceinline__ void phase_final(const Cx& p) {
    const int lane = p.tid & 63, wave = p.tid >> 6; const float* g = PIN(I_FNG);
    for (int r = p.bid * 16 + wave * 2; r < NB * SEQ; r += p.G * 16) { f32x4 v[2][4];
        norm_ld(p.out + (size_t)r * D, v[0], lane); norm_ld(p.out + (size_t)(r + 1) * D, v[1], lane);
#pragma unroll
        for (int q = 0; q < 2; ++q) { float* x = p.out + (size_t)(r + q) * D; float ss = 0.f;
#pragma unroll
            for (int i = 0; i < 4; ++i) ss += v[q][i][0] * v[q][i][0] + v[q][i][1] * v[q][i][1] + v[q][i][2] * v[q][i][2] + v[q][i][3] * v[q][i][3];
            ss = wsum(ss); const float rstd = rsqrtf(ss * (1.0f / D) + 1e-6f);
#pragma unroll
            for (int i = 0; i < 4; ++i) *(f32x4*)(x + 256 * i + 4 * lane) = v[q][i] * rstd * *(const f32x4*)(g + 256 * i + 4 * lane); } }
}
__device__ __forceinline__ int chain_tb(int n, int d) { return d == 0 ? n : (n < 4 ? 3 - n : 135 - n); }
__device__ __forceinline__ int tb_row0(int b, int tb) { return tb < 4 ? b * NCTX + 64 * tb : CROWS + b * SEQ + 64 * (tb - 4); }
constexpr int TS = 144;
template <int K, int NT> __device__ __forceinline__ void mm_rows(const LAS unsigned char* A, int lda, const LAS unsigned char* Bt, int ldb, int mt, int nt0, int fr, int fq, f32x4 (&acc)[NT]) {
#pragma unroll
    for (int ks = 0; ks < K / 32; ++ks) { const bf16x8 a = *(const LAS bf16x8*)(A + (16 * mt + fr) * lda + ks * 64 + fq * 16);
#pragma unroll
        for (int nt = 0; nt < NT; ++nt) { const bf16x8 bb = *(const LAS bf16x8*)(Bt + (16 * (nt0 + nt) + fr) * ldb + ks * 64 + fq * 16);
            acc[nt] = __builtin_amdgcn_mfma_f32_16x16x32_bf16(a, bb, acc[nt], 0, 0, 0); } }
}
#define UNIT_LOOP(u, N, OFF) for (int u = (p.bid + p.G - ((OFF) % p.G)) % p.G; u < (N); u += p.G)
__device__ __forceinline__ void gla_p1(const Cx& p, LAS unsigned char* lds, int layer, int b) {
    const int tid = p.tid, lane = tid & 63, wave = __builtin_amdgcn_readfirstlane(tid >> 6), fr = lane & 15, fq = lane >> 4;
    LAS unsigned char* ksT = lds; LAS unsigned char* vT = lds + 64 * TS; LAS float* gs = (LAS float*)(lds + 2 * 64 * TS); LAS float* glb = gs + 512;
    const bf16_t* proj = WSP(bf16_t, WS_PROJ); const int mt = wave >> 1, nt0 = (wave & 1) * 2;
    UNIT_LOOP(u, NUNIT, 0) { const int tb = u >> 3, h = (u >> 1) & 3, d = u & 1; const int cl = lane, tg = wave, c = 64 * h + cl;
        const bf16_t* pr0 = proj + (size_t)tb_row0(b, tb) * NPROJ;
        float w2[16];
#pragma unroll
        for (int r = 0; r < 16; ++r) w2[r] = PIN(I_GLA_W2)[((size_t)(layer * 2 + d) * 16 + r) * 256 + c];
        const float gb = PIN(I_GLA_B)[(layer * 2 + d) * 256 + c];
        { const int e = tid * 2, i = e >> 4, r = e & 15; const unsigned w = *(const unsigned*)(pr0 + (size_t)i * NPROJ + (d ? PA_GB : PA_GF) + r); glb[e] = __uint_as_float(w << 16); glb[e + 1] = __uint_as_float(w & 0xffff0000u); }
        __syncthreads();
        float bl[8]; float run = 0.f;
#pragma unroll
        for (int ii = 0; ii < 8; ++ii) { const int i8 = d ? 7 - ii : ii; const LAS float* gl_ = glb + (8 * tg + i8) * 16; float z = gb;
#pragma unroll
            for (int r = 0; r < 16; ++r) z += gl_[r] * w2[r];
            run += logsigmoidf_(z) * (1.0f / 16.0f); if (d) bl[7 - ii] = run; else bl[ii] = run; }
        gs[tg * 64 + cl] = run;
        __syncthreads();
        float off = 0.f, total = 0.f;
#pragma unroll
        for (int g2 = 0; g2 < 8; ++g2) { const float t = gs[g2 * 64 + cl]; total += t; if (d ? g2 > tg : g2 < tg) off += t; }
#pragma unroll
        for (int i8 = 0; i8 < 8; i8 += 2) { const int i = 8 * tg + i8; const bf16_t* pa = pr0 + (size_t)i * NPROJ; const bf16_t* pb = pa + NPROJ;
            const float ka = bf2f(pa[PA_K + c]) * __expf(total - (bl[i8] + off)), kb = bf2f(pb[PA_K + c]) * __expf(total - (bl[i8 + 1] + off));
            *(LAS unsigned*)(ksT + cl * TS + i * 2) = pk2(ka, kb); *(LAS unsigned*)(vT + cl * TS + i * 2) = (unsigned)pa[PA_V + c] | ((unsigned)pb[PA_V + c] << 16); }
        if (tg == 0) WSP(float, SC_GLA_DEC)[(size_t)u * 64 + cl] = __expf(total);
        __syncthreads();
        { f32x4 acc[2] = {(f32x4){0.f, 0.f, 0.f, 0.f}, (f32x4){0.f, 0.f, 0.f, 0.f}}; float* kv = WSP(float, SC_GLA_S) + (size_t)u * 4096;
          mm_rows<64, 2>(ksT, TS, vT, TS, mt, nt0, fr, fq, acc);
#pragma unroll
          for (int t = 0; t < 2; ++t)
#pragma unroll
              for (int j = 0; j < 4; ++j) kv[(16 * mt + 4 * fq + j) * 64 + 16 * (nt0 + t) + fr] = acc[t][j]; }
        __syncthreads();
    }
}
__device__ __forceinline__ void gla_chain(const Cx& p, int h, int d, int part) {
    if (p.tid >= 256) return;
    const int e0 = part * 1024 + p.tid * 4, dk = e0 >> 6;
    f32x4 s0 = (f32x4){0.f, 0.f, 0.f, 0.f};
    f32x4 n0[6]; float dc[6];
#define GC_LD(q, n_) do { const int u_ = (chain_tb((n_), d) * 4 + h) * 2 + d; n0[q] = *(const f32x4*)(WSP(float, SC_GLA_S) + (size_t)u_ * 4096 + e0); dc[q] = WSP(float, SC_GLA_DEC)[(size_t)u_ * 64 + dk]; } while (0)
#define GC_ST(q, n_) do { const int u_ = (chain_tb((n_), d) * 4 + h) * 2 + d; float* k_ = WSP(float, SC_GLA_S) + (size_t)u_ * 4096 + e0; \
        const f32x4 a0_ = n0[q]; const float de_ = dc[q]; if ((n_) + 6 < NTB) GC_LD(q, (n_) + 6); *(f32x4*)k_ = s0; s0 = s0 * de_ + a0_; } while (0)
    GC_LD(0, 0); GC_LD(1, 1); GC_LD(2, 2); GC_LD(3, 3); GC_LD(4, 4); GC_LD(5, 5);
#pragma unroll 1
    for (int n = 0; n < NTB; n += 6) { GC_ST(0, n); GC_ST(1, n + 1); GC_ST(2, n + 2); GC_ST(3, n + 3); GC_ST(4, n + 4); GC_ST(5, n + 5); }
#undef GC_LD
#undef GC_ST
}
__device__ __forceinline__ void gla_p2(const Cx& p, LAS unsigned char* lds, int layer, int b) {
    const int tid = p.tid, lane = tid & 63, wave = __builtin_amdgcn_readfirstlane(tid >> 6), fr = lane & 15, fq = lane >> 4;
    LAS unsigned char* qt = lds; LAS unsigned char* kt = lds + 64 * TS; LAS unsigned char* vT = lds + 2 * 64 * TS; LAS unsigned char* sT = lds + 3 * 64 * TS; LAS unsigned char* att = lds + 4 * 64 * TS;
    LAS float* gs = (LAS float*)(lds + 5 * 64 * TS); LAS float* glb = gs + 512;
    const bf16_t* proj = WSP(bf16_t, WS_PROJ);
    UNIT_LOOP(u, NUNIT, 128) { const int tb = u >> 3, h = (u >> 1) & 3, d = u & 1; const int cl = tid & 63, tg = tid >> 6, c = 64 * h + cl;
        const int row0 = tb_row0(b, tb), s0 = 64 * tb; const bf16_t* pr0 = proj + (size_t)row0 * NPROJ;
        float w2[16];
#pragma unroll
        for (int r = 0; r < 16; ++r) w2[r] = PIN(I_GLA_W2)[((size_t)(layer * 2 + d) * 16 + r) * 256 + c];
        const float gb = PIN(I_GLA_B)[(layer * 2 + d) * 256 + c];
        { const int e = tid * 2, i = e >> 4, r = e & 15; const unsigned w = *(const unsigned*)(pr0 + (size_t)i * NPROJ + (d ? PA_GB : PA_GF) + r); glb[e] = __uint_as_float(w << 16); glb[e + 1] = __uint_as_float(w & 0xffff0000u); }
        __syncthreads();
        float bl[8]; float run = 0.f;
#pragma unroll
        for (int ii = 0; ii < 8; ++ii) { const int i8 = d ? 7 - ii : ii; const LAS float* gl_ = glb + (8 * tg + i8) * 16; float z = gb;
#pragma unroll
            for (int r = 0; r < 16; ++r) z += gl_[r] * w2[r];
            run += logsigmoidf_(z) * (1.0f / 16.0f); if (d) bl[7 - ii] = run; else bl[ii] = run; }
        gs[tg * 64 + cl] = run;
        { const float* sp = WSP(float, SC_GLA_S) + (size_t)u * 4096;
#pragma unroll
          for (int q = 0; q < 8; ++q) { const int e = tid + NTHR * q, dk = e >> 6, dv = e & 63; *(LAS bf16_t*)(sT + dv * TS + dk * 2) = (bf16_t)f2bf(sp[e]); } }
        __syncthreads();
        float off = 0.f;
#pragma unroll
        for (int g2 = 0; g2 < 8; ++g2) if (d ? g2 > tg : g2 < tg) off += gs[g2 * 64 + cl];
#pragma unroll
        for (int i8 = 0; i8 < 8; ++i8) { const int i = 8 * tg + i8; const bf16_t* pr = pr0 + (size_t)i * NPROJ; const float bi = bl[i8] + off;
            *(LAS bf16_t*)(qt + i * TS + cl * 2) = (bf16_t)f2bf(bf2f(pr[PA_Q + c]) * 0.125f * __expf(bi));
            *(LAS bf16_t*)(kt + i * TS + cl * 2) = (bf16_t)f2bf(bf2f(pr[PA_K + c]) * __expf(-bi));
            *(LAS bf16_t*)(vT + cl * TS + i * 2) = pr[PA_V + c]; }
        __syncthreads();
        const int mt = wave >> 1, nt0 = (wave & 1) * 2;
        { f32x4 acc[2] = {(f32x4){0.f, 0.f, 0.f, 0.f}, (f32x4){0.f, 0.f, 0.f, 0.f}};
          mm_rows<64, 2>(qt, TS, kt, TS, mt, nt0, fr, fq, acc);
#pragma unroll
          for (int t = 0; t < 2; ++t)
#pragma unroll
              for (int j = 0; j < 4; ++j) { const int i = 16 * mt + 4 * fq + j, jj = 16 * (nt0 + t) + fr; const bool keep = d ? jj >= i : jj <= i;
                  *(LAS bf16_t*)(att + i * TS + jj * 2) = (bf16_t)f2bf(keep ? acc[t][j] : 0.f); } }
        __syncthreads();
        { f32x4 acc[2] = {(f32x4){0.f, 0.f, 0.f, 0.f}, (f32x4){0.f, 0.f, 0.f, 0.f}};
          mm_rows<64, 2>(att, TS, vT, TS, mt, nt0, fr, fq, acc);
          mm_rows<64, 2>(qt, TS, sT, TS, mt, nt0, fr, fq, acc);
          bf16_t* ob = WSP(bf16_t, d ? SC_OB : SC_OF);
#pragma unroll
          for (int t = 0; t < 2; ++t)
#pragma unroll
              for (int j = 0; j < 4; ++j) ob[(size_t)(s0 + 16 * mt + 4 * fq + j) * 1024 + 64 * h + 16 * (nt0 + t) + fr] = (bf16_t)f2bf(acc[t][j]); }
        __syncthreads();
    }
}
constexpr int TS2 = 272;
__device__ __forceinline__ float ssd_acum(float a, int d, int lane, float& total) {
    float pre = a;
#pragma unroll
    for (int o = 1; o < 64; o <<= 1) { const float t = shup_(pre, lane, o); if (lane >= o) pre += t; }
    total = rl(pre, 63);
    return d ? total - pre + a : pre;
}
__device__ __forceinline__ void ssd_p1(const Cx& p, LAS unsigned char* lds, int layer, int b) {
    const int tid = p.tid, lane = tid & 63, wave = __builtin_amdgcn_readfirstlane(tid >> 6), fr = lane & 15, fq = lane >> 4;
    LAS unsigned char* BT = lds; LAS unsigned char* xT = lds + 128 * TS; LAS float* AC = (LAS float*)(lds + 128 * TS + 64 * TS);
    UNIT_LOOP(u3, NTB * 8, 32) { const int tb = u3 >> 3, g = (u3 >> 2) & 1, hd = u3 & 3, h = 2 * g + (hd >> 1), d = hd & 1, s0 = 64 * tb;
        const bf16_t* sx = WSP(bf16_t, SC_SX) + (size_t)s0 * 768; const float* sdt = WSP(float, SC_SDT) + (size_t)s0 * 8;
        if (wave == 0) { const float aneg = -__expf(PIN(I_SS_ALOG)[(layer * 2 + d) * 4 + h]);
            float tot; const float ac = ssd_acum(aneg * sdt[lane * 8 + d * 4 + h], d, lane, tot); AC[lane] = ac; if (lane == 0) { AC[64] = tot; WSP(float, SC_SSD_CD)[(tb * 4 + h) * 2 + d] = __expf(tot); } }
#pragma unroll 2
        for (int q = 0; q < 16; ++q) { const int e = tid + NTHR * q, i = e >> 7, s = e & 127; *(LAS bf16_t*)(BT + s * TS + i * 2) = sx[(size_t)i * 768 + 256 + 128 * g + s]; }
        __syncthreads();
#pragma unroll 2
        for (int q = 0; q < 8; ++q) { const int e = tid + NTHR * q, i = e >> 6, pp = e & 63;
            const float x = bf2f(sx[(size_t)i * 768 + 64 * h + pp]) * sdt[i * 8 + d * 4 + h] * __expf(AC[64] - AC[i]);
            *(LAS bf16_t*)(xT + pp * TS + i * 2) = (bf16_t)f2bf(x); }
        __syncthreads();
        { const int mt = wave >> 1, nt0 = (wave & 1) * 4; float* cs = WSP(float, SC_SSD_S) + (size_t)((tb * 4 + h) * 2 + d) * 8192; f32x4 acc[4];
#pragma unroll
          for (int t = 0; t < 4; ++t) acc[t] = (f32x4){0.f, 0.f, 0.f, 0.f};
          mm_rows<64, 4>(xT, TS, BT, TS, mt, nt0, fr, fq, acc);
#pragma unroll
          for (int t = 0; t < 4; ++t)
#pragma unroll
              for (int j = 0; j < 4; ++j) cs[(16 * mt + 4 * fq + j) * 128 + 16 * (nt0 + t) + fr] = acc[t][j]; }
        __syncthreads();
    }
}
__device__ __forceinline__ void ssd_chain(const Cx& p, int h, int d, int part) {
    if (p.tid >= 256) return;
    const int e0 = part * 1024 + p.tid * 4;
    f32x4 s = (f32x4){0.f, 0.f, 0.f, 0.f}; f32x4 nx[6]; float cd[6];
#define SC_LD(q, n_) do { const int u_ = (chain_tb((n_), d) * 4 + h) * 2 + d; nx[q] = *(const f32x4*)(WSP(float, SC_SSD_S) + (size_t)u_ * 8192 + e0); cd[q] = WSP(float, SC_SSD_CD)[u_]; } while (0)
#define SC_ST(q, n_) do { const int u_ = (chain_tb((n_), d) * 4 + h) * 2 + d; float* c_ = WSP(float, SC_SSD_S) + (size_t)u_ * 8192 + e0; const f32x4 a_ = nx[q]; const float de_ = cd[q]; \
        if ((n_) + 6 < NTB) SC_LD(q, (n_) + 6); *(f32x4*)c_ = s; s = s * de_ + a_; } while (0)
    SC_LD(0, 0); SC_LD(1, 1); SC_LD(2, 2); SC_LD(3, 3); SC_LD(4, 4); SC_LD(5, 5);
#pragma unroll 1
    for (int n = 0; n < NTB; n += 6) { SC_ST(0, n); SC_ST(1, n + 1); SC_ST(2, n + 2); SC_ST(3, n + 3); SC_ST(4, n + 4); SC_ST(5, n + 5); }
#undef SC_LD
#undef SC_ST
}
__device__ __forceinline__ void ssd_p2(const Cx& p, LAS unsigned char* lds, int layer, int b) {
    const int tid = p.tid, lane = tid & 63, wave = __builtin_amdgcn_readfirstlane(tid >> 6), fr = lane & 15, fq = lane >> 4;
    LAS unsigned char* Ct = lds; LAS unsigned char* Bt2 = lds + 64 * TS2; LAS float* cb = (LAS float*)(lds + 2 * 64 * TS2); LAS float* AC = cb + 64 * 65;
    LAS unsigned char* Mt = (LAS unsigned char*)(AC + 64 + 4); LAS unsigned char* xT = Mt + 64 * TS; LAS unsigned char* Sb = xT + 64 * TS;
    const int mt = wave >> 1, nt0 = (wave & 1) * 2;
    UNIT_LOOP(u3, NTB * 8, 160) { const int tb = u3 >> 3, g = (u3 >> 2) & 1, hd = u3 & 3, h = 2 * g + (hd >> 1), d = hd & 1, s0 = 64 * tb;
        const bf16_t* sx = WSP(bf16_t, SC_SX) + (size_t)s0 * 768; const float* sdt = WSP(float, SC_SDT) + (size_t)s0 * 8;
        if (wave == 0) { const float aneg = -__expf(PIN(I_SS_ALOG)[(layer * 2 + d) * 4 + h]); float tot; AC[lane] = ssd_acum(aneg * sdt[lane * 8 + d * 4 + h], d, lane, tot); }
#pragma unroll
        for (int q = 0; q < 2; ++q) { const int e = tid + NTHR * q, i = e >> 4, ch = e & 15;
            *(LAS u32x4*)(Ct + i * TS2 + ch * 16) = *(const u32x4*)(sx + (size_t)i * 768 + 512 + 128 * g + ch * 8);
            *(LAS u32x4*)(Bt2 + i * TS2 + ch * 16) = *(const u32x4*)(sx + (size_t)i * 768 + 256 + 128 * g + ch * 8); }
#pragma unroll 2
        for (int q = 0; q < 8; ++q) { const int e = tid + NTHR * q, j = e >> 6, pp = e & 63;
            *(LAS bf16_t*)(xT + pp * TS + j * 2) = (bf16_t)f2bf(bf2f(sx[(size_t)j * 768 + 64 * h + pp]) * sdt[j * 8 + d * 4 + h]); }
        { const float* sp = WSP(float, SC_SSD_S) + (size_t)((tb * 4 + h) * 2 + d) * 8192;
#pragma unroll
          for (int q = 0; q < 4; ++q) { const int e = (tid + NTHR * q) * 4, pp = e >> 7, s = e & 127; const f32x4 v = *(const f32x4*)(sp + e);
              *(LAS u32x2*)(Sb + pp * TS2 + s * 2) = (u32x2){pk2(v[0], v[1]), pk2(v[2], v[3])}; } }
        __syncthreads();
        { f32x4 acc[2] = {(f32x4){0.f, 0.f, 0.f, 0.f}, (f32x4){0.f, 0.f, 0.f, 0.f}};
          mm_rows<128, 2>(Ct, TS2, Bt2, TS2, mt, nt0, fr, fq, acc);
#pragma unroll
          for (int t = 0; t < 2; ++t)
#pragma unroll
              for (int j = 0; j < 4; ++j) cb[(16 * mt + 4 * fq + j) * 65 + 16 * (nt0 + t) + fr] = acc[t][j]; }
        __syncthreads();
        { const int i = tid >> 3, j0 = (tid & 7) * 8; const float ai = AC[i]; unsigned w[4];
#pragma unroll
          for (int jj = 0; jj < 8; jj += 2) { float m[2];
#pragma unroll
              for (int q = 0; q < 2; ++q) { const int j = j0 + jj + q; const bool keep = d ? j >= i : j <= i; m[q] = keep ? cb[i * 65 + j] * __expf(ai - AC[j]) : 0.f; }
              w[jj >> 1] = pk2(m[0], m[1]); }
          *(LAS u32x4*)(Mt + i * TS + j0 * 2) = (u32x4){w[0], w[1], w[2], w[3]}; }
        __syncthreads();
        { f32x4 acc[2] = {(f32x4){0.f, 0.f, 0.f, 0.f}, (f32x4){0.f, 0.f, 0.f, 0.f}};
          mm_rows<128, 2>(Ct, TS2, Sb, TS2, mt, nt0, fr, fq, acc);
#pragma unroll
          for (int j = 0; j < 4; ++j) { const float sc = __expf(AC[16 * mt + 4 * fq + j]); acc[0][j] *= sc; acc[1][j] *= sc; }
          mm_rows<64, 2>(Mt, TS, xT, TS, mt, nt0, fr, fq, acc);
          bf16_t* ob = WSP(bf16_t, d ? SC_OB : SC_OF);
#pragma unroll
          for (int t = 0; t < 2; ++t)
#pragma unroll
              for (int j = 0; j < 4; ++j) ob[(size_t)(s0 + 16 * mt + 4 * fq + j) * 1024 + 512 + 64 * h + 16 * (nt0 + t) + fr] = (bf16_t)f2bf(acc[t][j]); }
        __syncthreads();
    }
}
constexpr int AFS = 68;
__device__ __forceinline__ int dr_mfrag_idx(int row, int col) { return (((row >> 4) * 2 + (col >> 5)) * 64 + ((col >> 2) & 3) * 16 + (row & 15)) * 8 + ((col >> 4) & 1) * 4 + (col & 3); }
template <class RhsF> __device__ __forceinline__ void dr_block_solve(const LAS unsigned char* Abf, const LAS float* AfT, LAS unsigned char* XT, LAS float* Dbuf, const float sgn, const int wave, const RhsF& rhs, bf16_t* wu) {
#pragma unroll 1
    for (int kb_ = 0; kb_ < 4; ++kb_) {
        { const int lane = lane_id_asm(), fr = lane & 15, fq = lane >> 4; f32x4 acc = (f32x4){0.f, 0.f, 0.f, 0.f};
          if (kb_ > 0) {
#pragma unroll
              for (int ks = 0; ks < 2; ++ks) { const bf16x8 a = *(const LAS bf16x8*)(Abf + (16 * kb_ + fr) * TS + ks * 64 + fq * 16), bb = *(const LAS bf16x8*)(XT + (16 * wave + fr) * TS + ks * 64 + fq * 16);
                  acc = __builtin_amdgcn_mfma_f32_16x16x32_bf16(a, bb, acc, 0, 0, 0); } }
          *(LAS f32x4*)(Dbuf + (16 * wave + fr) * 20 + 4 * fq) = acc; }
        __syncthreads();
        if (wave < 2) { const int col = wave * 64 + lane_id_asm(); float x[16];
#pragma unroll
            for (int i = 0; i < 16; ++i) x[i] = rhs(16 * kb_ + i, col) - sgn * Dbuf[col * 20 + i];
            const LAS float* Ab = AfT + (16 * kb_) * AFS + 16 * kb_;
#pragma unroll
            for (int j = 0; j < 15; ++j) { const float xj = sgn * x[j];
#pragma unroll
                for (int i = j + 1; i < 16; ++i) x[i] -= Ab[j * AFS + i] * xj; }
            u32x4 w0, w1;
#pragma unroll
            for (int q = 0; q < 4; ++q) { w0[q] = pk2(x[2 * q], x[2 * q + 1]); w1[q] = pk2(x[8 + 2 * q], x[8 + 2 * q + 1]); }
            *(LAS u32x4*)(XT + col * TS + (16 * kb_) * 2) = w0; *(LAS u32x4*)(XT + col * TS + (16 * kb_ + 8) * 2) = w1;
#pragma unroll
            for (int i = 0; i < 16; ++i) wu[(16 * kb_ + i) * 128 + col] = (bf16_t)f2bf(x[i]); }
        __syncthreads();
    }
}
struct GdnRhs { const LAS unsigned char* kb; const LAS unsigned char* vb; const LAS float* GC;
    __device__ __forceinline__ float operator()(int r, int col) const { return col < 64 ? bf2f(*(const LAS bf16_t*)(kb + r * TS + col * 2)) * __expf(GC[r]) : bf2f(*(const LAS bf16_t*)(vb + r * TS + (col - 64) * 2)); } };
__device__ __forceinline__ void gdn_p1(const Cx& p, LAS unsigned char* lds, int layer, int b) {
    const int wave = __builtin_amdgcn_readfirstlane(p.tid >> 6);
#define GDN_LANES const int lane = lane_id_asm(), tid = wave * 64 + lane, fr = lane & 15, fq = lane >> 4; (void)tid; (void)fr; (void)fq
    LAS unsigned char* kh = lds; LAS unsigned char* kb = lds + 64 * TS; LAS unsigned char* vb = lds + 2 * 64 * TS; LAS unsigned char* Abf = lds + 3 * 64 * TS; LAS unsigned char* kdT = lds + 4 * 64 * TS; LAS unsigned char* XT = lds + 5 * 64 * TS;
    LAS float* Af = (LAS float*)(lds + 7 * 64 * TS); LAS float* Dbuf = Af + 64 * AFS; LAS float* GC = Dbuf + 128 * 20;
    const int mt = wave >> 1, nt0 = (wave & 1) * 2;
    UNIT_LOOP(u, NUNIT, 64) { const int tb = u >> 3, h = (u >> 1) & 3, d = u & 1, s0 = 64 * tb;
        const bf16_t* dq = WSP(bf16_t, SC_DQ) + (size_t)s0 * 768; const float* dg = WSP(float, SC_DG) + (size_t)s0 * 16;
        if (wave == 0) { GDN_LANES; const int i = d ? 63 - lane : lane; float pre = dg[i * 16 + 8 + d * 4 + h];
#pragma unroll
            for (int o = 1; o < 64; o <<= 1) { const float t = shup_(pre, lane, o); if (lane >= o) pre += t; }
            GC[lane] = pre; }
        { GDN_LANES; const int r = tid >> 3, c0 = (tid & 7) * 8, i = d ? 63 - r : r; const float beta = dg[i * 16 + d * 4 + h];
          const u32x4 kv = *(const u32x4*)(dq + (size_t)i * 768 + 256 + 64 * h + c0), vv = *(const u32x4*)(dq + (size_t)i * 768 + 512 + 64 * h + c0); u32x4 kw, vw;
#pragma unroll
          for (int q = 0; q < 4; ++q) { kw[q] = pk2(__uint_as_float(kv[q] << 16) * beta, __uint_as_float(kv[q] & 0xffff0000u) * beta); vw[q] = pk2(__uint_as_float(vv[q] << 16) * beta, __uint_as_float(vv[q] & 0xffff0000u) * beta); }
          *(LAS u32x4*)(kh + r * TS + c0 * 2) = kv; *(LAS u32x4*)(kb + r * TS + c0 * 2) = kw; *(LAS u32x4*)(vb + r * TS + c0 * 2) = vw;
          *(LAS u32x4*)(XT + (2 * r) * TS + c0 * 2) = (u32x4){0u, 0u, 0u, 0u}; *(LAS u32x4*)(XT + (2 * r + 1) * TS + c0 * 2) = (u32x4){0u, 0u, 0u, 0u}; }
        __syncthreads();
        const float gtot = GC[63];
        { GDN_LANES; f32x4 acc[2] = {(f32x4){0.f, 0.f, 0.f, 0.f}, (f32x4){0.f, 0.f, 0.f, 0.f}};
          mm_rows<64, 2>(kb, TS, kh, TS, mt, nt0, fr, fq, acc);
#pragma unroll
          for (int t = 0; t < 2; ++t)
#pragma unroll
              for (int j = 0; j < 4; ++j) { const int r = 16 * mt + 4 * fq + j, jj = 16 * (nt0 + t) + fr; const float a = jj < r ? acc[t][j] * __expf(GC[r] - GC[jj]) : 0.f;
                  Af[jj * AFS + r] = a; *(LAS bf16_t*)(Abf + r * TS + jj * 2) = (bf16_t)f2bf(a); }
#pragma unroll 2
          for (int q = 0; q < 8; ++q) { const int e = tid + NTHR * q, r = e >> 6, cc = e & 63;
              *(LAS bf16_t*)(kdT + cc * TS + r * 2) = (bf16_t)f2bf(bf2f(*(const LAS bf16_t*)(kh + r * TS + cc * 2)) * __expf(gtot - GC[r])); } }
        __syncthreads();
        { const GdnRhs rhs{kb, vb, GC}; dr_block_solve(Abf, Af, XT, Dbuf, 1.0f, wave, rhs, WSP(bf16_t, SC_DR_WU) + (size_t)u * 8192); }
        { GDN_LANES; f32x4 am[2] = {(f32x4){0.f, 0.f, 0.f, 0.f}, (f32x4){0.f, 0.f, 0.f, 0.f}}, an[2] = {(f32x4){0.f, 0.f, 0.f, 0.f}, (f32x4){0.f, 0.f, 0.f, 0.f}};
          mm_rows<64, 2>(kdT, TS, XT, TS, mt, nt0, fr, fq, am);
          mm_rows<64, 2>(kdT, TS, XT + 64 * TS, TS, mt, nt0, fr, fq, an);
          bf16_t* Mg = WSP(bf16_t, SC_DR_M) + (size_t)u * 4096; bf16_t* Ng = WSP(bf16_t, SC_DR_NS) + (size_t)u * 4096; const float eg = __expf(gtot);
#pragma unroll
          for (int t = 0; t < 2; ++t) {
#pragma unroll
              for (int j = 0; j < 4; ++j) { const int row = 16 * mt + 4 * fq + j, col = 16 * (nt0 + t) + fr; Mg[dr_mfrag_idx(row, col)] = (bf16_t)f2bf((row == col ? eg : 0.f) - am[t][j]); }
              *(u32x2*)(Ng + (((nt0 + t) * 4 + mt) * 64 + lane) * 4) = (u32x2){pk2(an[t][0], an[t][1]), pk2(an[t][2], an[t][3])}; } }
        __syncthreads();
    }
#undef GDN_LANES
}
__device__ __forceinline__ void dr_chain(const Cx& p, size_t offM, size_t offNS, int h, int d, int cb) {
    const int lane = p.tid & 63, fr = lane & 15, fq = lane >> 4;
    if (p.tid >= 64) return;
    f32x4 acc[4];
#pragma unroll
    for (int t = 0; t < 4; ++t) acc[t] = (f32x4){0.f, 0.f, 0.f, 0.f};
    bf16x8 mR[4][4][2]; u32x2 nR[4][4];
#define DR_LD(m, nn, n_) do { const int u_ = (chain_tb((n_), d) * 4 + h) * 2 + d; const bf16_t* M_ = WSP(bf16_t, offM) + (size_t)u_ * 4096; const bf16_t* N_ = WSP(bf16_t, offNS) + (size_t)u_ * 4096; \
        _Pragma("unroll") for (int t = 0; t < 4; ++t) { _Pragma("unroll") for (int ks = 0; ks < 2; ++ks) m[t][ks] = *(const bf16x8*)(M_ + ((t * 2 + ks) * 64 + lane) * 8); nn[t] = *(const u32x2*)(N_ + ((cb * 4 + t) * 64 + lane) * 4); } } while (0)
#define DR_STEP(m, nn, n_) do { const int u_ = (chain_tb((n_), d) * 4 + h) * 2 + d; bf16_t* ST_ = WSP(bf16_t, offNS) + (size_t)u_ * 4096 + (16 * cb + fr) * 64 + 4 * fq; \
        u32x2 sp_[4]; _Pragma("unroll") for (int t = 0; t < 4; ++t) { sp_[t] = (u32x2){pk2(acc[t][0], acc[t][1]), pk2(acc[t][2], acc[t][3])}; *(u32x2*)(ST_ + 16 * t) = sp_[t]; } \
        bf16x8 bf_[2]; _Pragma("unroll") for (int ks = 0; ks < 2; ++ks) { u32x4 w_ = (u32x4){sp_[2 * ks][0], sp_[2 * ks][1], sp_[2 * ks + 1][0], sp_[2 * ks + 1][1]}; bf_[ks] = __builtin_bit_cast(bf16x8, w_); } \
        _Pragma("unroll") for (int t = 0; t < 4; ++t) { f32x4 a_ = (f32x4){__uint_as_float(nn[t][0] << 16), __uint_as_float(nn[t][0] & 0xffff0000u), __uint_as_float(nn[t][1] << 16), __uint_as_float(nn[t][1] & 0xffff0000u)}; \
            a_ = __builtin_amdgcn_mfma_f32_16x16x32_bf16(m[t][0], bf_[0], a_, 0, 0, 0); acc[t] = __builtin_amdgcn_mfma_f32_16x16x32_bf16(m[t][1], bf_[1], a_, 0, 0, 0); } } while (0)
#define DR_GO(q, n_) do { DR_STEP(mR[q], nR[q], (n_)); if ((n_) + 4 < NTB) DR_LD(mR[q], nR[q], (n_) + 4); } while (0)
    DR_LD(mR[0], nR[0], 0); DR_LD(mR[1], nR[1], 1); DR_LD(mR[2], nR[2], 2); DR_LD(mR[3], nR[3], 3);
#pragma unroll 1
    for (int n = 0; n < NTB; n += 4) { DR_GO(0, n); DR_GO(1, n + 1); DR_GO(2, n + 2); DR_GO(3, n + 3); }
#undef DR_GO
#undef DR_LD
#undef DR_STEP
}
__device__ __forceinline__ void gdn_p2(const Cx& p, LAS unsigned char* lds, int layer, int b) {
    const int tid = p.tid, lane = tid & 63, wave = __builtin_amdgcn_readfirstlane(tid >> 6), fr = lane & 15, fq = lane >> 4;
    LAS unsigned char* qh = lds; LAS unsigned char* kh = lds + 64 * TS; LAS unsigned char* wt = lds + 2 * 64 * TS; LAS unsigned char* sT = lds + 3 * 64 * TS; LAS unsigned char* aq = lds + 4 * 64 * TS; LAS unsigned char* vnT = lds + 5 * 64 * TS;
    LAS float* GC = (LAS float*)(lds + 6 * 64 * TS);
    const int mt = wave >> 1, nt0 = (wave & 1) * 2;
    UNIT_LOOP(u, NUNIT, 192) { const int tb = u >> 3, h = (u >> 1) & 3, d = u & 1, s0 = 64 * tb;
        const bf16_t* dq = WSP(bf16_t, SC_DQ) + (size_t)s0 * 768; const float* dg = WSP(float, SC_DG) + (size_t)s0 * 16;
        const bf16_t* wu = WSP(bf16_t, SC_DR_WU) + (size_t)u * 8192; const bf16_t* st = WSP(bf16_t, SC_DR_NS) + (size_t)u * 4096;
        if (wave == 0) { const int i = d ? 63 - lane : lane; float pre = dg[i * 16 + 8 + d * 4 + h];
#pragma unroll
            for (int o = 1; o < 64; o <<= 1) { const float t = shup_(pre, lane, o); if (lane >= o) pre += t; }
            GC[lane] = pre; }
        bf16_t upre[2][4];
#pragma unroll
        for (int t = 0; t < 2; ++t)
#pragma unroll
            for (int j = 0; j < 4; ++j) upre[t][j] = wu[(16 * mt + 4 * fq + j) * 128 + 64 + 16 * (nt0 + t) + fr];
        { const int r = tid >> 3, c0 = (tid & 7) * 8, i = d ? 63 - r : r;
          *(LAS u32x4*)(qh + r * TS + c0 * 2) = *(const u32x4*)(dq + (size_t)i * 768 + 64 * h + c0);
          *(LAS u32x4*)(kh + r * TS + c0 * 2) = *(const u32x4*)(dq + (size_t)i * 768 + 256 + 64 * h + c0);
          *(LAS u32x4*)(wt + r * TS + c0 * 2) = *(const u32x4*)(wu + r * 128 + c0);
          *(LAS u32x4*)(sT + r * TS + c0 * 2) = *(const u32x4*)(st + r * 64 + c0); }
        __syncthreads();
        { f32x4 acc[2] = {(f32x4){0.f, 0.f, 0.f, 0.f}, (f32x4){0.f, 0.f, 0.f, 0.f}};
          mm_rows<64, 2>(qh, TS, kh, TS, mt, nt0, fr, fq, acc);
#pragma unroll
          for (int t = 0; t < 2; ++t)
#pragma unroll
              for (int j = 0; j < 4; ++j) { const int r = 16 * mt + 4 * fq + j, jj = 16 * (nt0 + t) + fr; *(LAS bf16_t*)(aq + r * TS + jj * 2) = (bf16_t)f2bf(jj <= r ? acc[t][j] * __expf(GC[r] - GC[jj]) : 0.f); }
          f32x4 av[2] = {(f32x4){0.f, 0.f, 0.f, 0.f}, (f32x4){0.f, 0.f, 0.f, 0.f}};
          mm_rows<64, 2>(wt, TS, sT, TS, mt, nt0, fr, fq, av);
#pragma unroll
          for (int t = 0; t < 2; ++t) { const int dv = 16 * (nt0 + t) + fr; float vn[4];
#pragma unroll
              for (int j = 0; j < 4; ++j) vn[j] = bf2f(upre[t][j]) - av[t][j];
              *(LAS u32x2*)(vnT + dv * TS + (16 * mt + 4 * fq) * 2) = (u32x2){pk2(vn[0], vn[1]), pk2(vn[2], vn[3])}; } }
        __syncthreads();
        { f32x4 acc[2] = {(f32x4){0.f, 0.f, 0.f, 0.f}, (f32x4){0.f, 0.f, 0.f, 0.f}};
          mm_rows<64, 2>(qh, TS, sT, TS, mt, nt0, fr, fq, acc);
#pragma unroll
          for (int j = 0; j < 4; ++j) { const float sc = __expf(GC[16 * mt + 4 * fq + j]); acc[0][j] *= sc; acc[1][j] *= sc; }
          mm_rows<64, 2>(aq, TS, vnT, TS, mt, nt0, fr, fq, acc);
          bf16_t* ob = WSP(bf16_t, d ? SC_OB : SC_OF);
#pragma unroll
          for (int t = 0; t < 2; ++t)
#pragma unroll
              for (int j = 0; j < 4; ++j) { const int r = 16 * mt + 4 * fq + j, i = d ? 63 - r : r; ob[(size_t)(s0 + i) * 1024 + 768 + 64 * h + 16 * (nt0 + t) + fr] = (bf16_t)f2bf(acc[t][j]); } }
        __syncthreads();
    }
}
constexpr int LPS = 65;
#define RW_LP(LP, GS, lw8) do { const int lane_ = lane_id_asm(), c_ = lane_, tg_ = wave; float loc_[8]; float run_ = 0.f; \
        _Pragma("unroll") for (int ii = 0; ii < 8; ++ii) { run_ += (lw8)[ii]; loc_[ii] = run_; } \
        (GS)[tg_ * 64 + c_] = run_; __syncthreads(); float off_ = 0.f; \
        _Pragma("unroll") for (int g2 = 0; g2 < 8; ++g2) if (g2 < tg_) off_ += (GS)[g2 * 64 + c_]; \
        _Pragma("unroll") for (int ii = 0; ii < 8; ++ii) (LP)[(8 * tg_ + ii) * LPS + c_] = loc_[ii] + off_; __syncthreads(); } while (0)
struct RwRhs { const LAS unsigned char* zt; const LAS unsigned char* RU;
    __device__ __forceinline__ float operator()(int r, int col) const { return col < 64 ? bf2f(*(const LAS bf16_t*)(zt + r * TS + col * 2)) : bf2f(*(const LAS bf16_t*)(RU + (col - 64) * TS + r * 2)); } };
__device__ __forceinline__ void rw_p1(const Cx& p, LAS unsigned char* lds, int layer, int b) {
    const int wave = __builtin_amdgcn_readfirstlane(p.tid >> 6), mt = wave >> 1, nt0 = (wave & 1) * 2;
#define RW_LANES const int lane = lane_id_asm(), tid = wave * 64 + lane, fr = lane & 15, fq = lane >> 4; (void)tid; (void)fr; (void)fq
    LAS float* LP = (LAS float*)lds; LAS float* GS = (LAS float*)(lds + 16640);
    LAS unsigned char* zt = lds + 18688; LAS unsigned char* bt = lds + 27904; LAS unsigned char* kt = lds + 37120; LAS unsigned char* vT = lds + 46336; LAS unsigned char* Azk = lds + 55552;
    LAS float* Af = (LAS float*)(lds + 64768); LAS unsigned char* XT = lds + 82176; LAS unsigned char* Abf = lds + 100608; LAS unsigned char* RU = lds + 109824; LAS float* Dbuf = (LAS float*)(lds + 119040); LAS unsigned char* bhT = lds + 129280;
    const bf16_t* proj = WSP(bf16_t, WS_PROJ);
    float lw8[8]; f32x4 lwv[2], kkv[2], bv[2], kv[2]; bf16_t v8[8];
#define RW1_LOAD(uu) do { const int tb_ = (uu) >> 3, h_ = ((uu) >> 1) & 3, d_ = (uu) & 1, s0_ = 64 * tb_; const int lane_ = lane_id_asm(), tid_ = wave * 64 + lane_; \
        const float* lwp_ = WSP(float, SC_RLW) + (size_t)d_ * SB * 256 + (size_t)s0_ * 256 + 64 * h_; const size_t fo_ = (size_t)s0_ * 256 + 64 * h_; \
        _Pragma("unroll") for (int ii = 0; ii < 8; ++ii) { const int r_ = 8 * wave + ii; lw8[ii] = lwp_[(size_t)(d_ ? 63 - r_ : r_) * 256 + lane_]; } \
        { const int r_ = tid_ >> 3, c0_ = (tid_ & 7) * 8, i_ = d_ ? 63 - r_ : r_; \
          _Pragma("unroll") for (int q = 0; q < 2; ++q) { lwv[q] = *(const f32x4*)(lwp_ + (size_t)i_ * 256 + c0_ + 4 * q); kkv[q] = *(const f32x4*)(WSP(float, SC_RKK) + fo_ + (size_t)i_ * 256 + c0_ + 4 * q); \
              bv[q] = *(const f32x4*)(WSP(float, SC_RB) + fo_ + (size_t)i_ * 256 + c0_ + 4 * q); kv[q] = *(const f32x4*)(WSP(float, SC_RK) + fo_ + (size_t)i_ * 256 + c0_ + 4 * q); } } \
        { const bf16_t* pr0_ = proj + (size_t)tb_row0(b, tb_) * NPROJ; \
          _Pragma("unroll") for (int q = 0; q < 8; ++q) { const int e = tid_ + NTHR * q, r2 = e >> 6, cc = e & 63; v8[q] = pr0_[(size_t)(d_ ? 63 - r2 : r2) * NPROJ + PB_V + 64 * h_ + cc]; } } } while (0)
    int u = (p.bid + p.G - (96 % p.G)) % p.G; if (u >= NUNIT) return;
    RW1_LOAD(u);
    for (;;) { const int d = u & 1;
        RW_LP(LP, GS, lw8);
        { RW_LANES; const int r = tid >> 3, c0 = (tid & 7) * 8; unsigned wz[4], wb[4], wk[4];
#pragma unroll
          for (int q = 0; q < 8; q += 2) { float z2[2], b2[2], k2[2];
#pragma unroll
              for (int e = 0; e < 2; ++e) { const int cq = q + e, c = c0 + cq; const float lp = LP[r * LPS + c], lw = lwv[cq >> 2][cq & 3], em = __expf(-lp);
                  z2[e] = -kkv[cq >> 2][cq & 3] * __expf(lp - lw); b2[e] = bv[cq >> 2][cq & 3] * em; k2[e] = kv[cq >> 2][cq & 3] * em; }
              wz[q >> 1] = pk2(z2[0], z2[1]); wb[q >> 1] = pk2(b2[0], b2[1]); wk[q >> 1] = pk2(k2[0], k2[1]); }
          *(LAS u32x4*)(zt + r * TS + c0 * 2) = (u32x4){wz[0], wz[1], wz[2], wz[3]}; *(LAS u32x4*)(bt + r * TS + c0 * 2) = (u32x4){wb[0], wb[1], wb[2], wb[3]}; *(LAS u32x4*)(kt + r * TS + c0 * 2) = (u32x4){wk[0], wk[1], wk[2], wk[3]};
          *(LAS u32x4*)(XT + (2 * r) * TS + c0 * 2) = (u32x4){0u, 0u, 0u, 0u}; *(LAS u32x4*)(XT + (2 * r + 1) * TS + c0 * 2) = (u32x4){0u, 0u, 0u, 0u};
#pragma unroll 2
          for (int q = 0; q < 8; ++q) { const int e = tid + NTHR * q, r2 = e >> 6, cc = e & 63; *(LAS bf16_t*)(vT + cc * TS + r2 * 2) = v8[q]; } }
        __syncthreads();
        const int un = u + p.G; const bool more = un < NUNIT;
        if (more) RW1_LOAD(un);
        { RW_LANES; f32x4 a1[2] = {(f32x4){0.f, 0.f, 0.f, 0.f}, (f32x4){0.f, 0.f, 0.f, 0.f}}, a2[2] = {(f32x4){0.f, 0.f, 0.f, 0.f}, (f32x4){0.f, 0.f, 0.f, 0.f}};
          mm_rows<64, 2>(zt, TS, bt, TS, mt, nt0, fr, fq, a1);
          mm_rows<64, 2>(zt, TS, kt, TS, mt, nt0, fr, fq, a2);
#pragma unroll
          for (int t = 0; t < 2; ++t)
#pragma unroll
              for (int j = 0; j < 4; ++j) { const int r = 16 * mt + 4 * fq + j, jj = 16 * (nt0 + t) + fr; const float a = jj < r ? a1[t][j] : 0.f;
                  Af[jj * AFS + r] = a; *(LAS bf16_t*)(Abf + r * TS + jj * 2) = (bf16_t)f2bf(a); *(LAS bf16_t*)(Azk + r * TS + jj * 2) = (bf16_t)f2bf(jj < r ? a2[t][j] : 0.f); } }
        __syncthreads();
        { RW_LANES; f32x4 a[2] = {(f32x4){0.f, 0.f, 0.f, 0.f}, (f32x4){0.f, 0.f, 0.f, 0.f}};
          mm_rows<64, 2>(Azk, TS, vT, TS, mt, nt0, fr, fq, a);
#pragma unroll
          for (int t = 0; t < 2; ++t) *(LAS u32x2*)(RU + (16 * (nt0 + t) + fr) * TS + (16 * mt + 4 * fq) * 2) = (u32x2){pk2(a[t][0], a[t][1]), pk2(a[t][2], a[t][3])};
        }
        __syncthreads();
        { RW_LANES;
#pragma unroll 2
          for (int q = 0; q < 8; ++q) { const int e = tid + NTHR * q, r2 = e >> 6, cc = e & 63; const float el = __expf(LP[63 * LPS + cc]);
              *(LAS bf16_t*)(bhT + cc * TS + r2 * 2) = (bf16_t)f2bf(bf2f(*(const LAS bf16_t*)(bt + r2 * TS + cc * 2)) * el); *(LAS bf16_t*)(Azk + cc * TS + r2 * 2) = (bf16_t)f2bf(bf2f(*(const LAS bf16_t*)(kt + r2 * TS + cc * 2)) * el); } }
        __syncthreads();
        { const RwRhs rhs{zt, RU}; dr_block_solve(Abf, Af, XT, Dbuf, -1.0f, wave, rhs, WSP(bf16_t, SC_RW_WU) + (size_t)u * 8192); }
        { RW_LANES; f32x4 am[2] = {(f32x4){0.f, 0.f, 0.f, 0.f}, (f32x4){0.f, 0.f, 0.f, 0.f}}, an[2] = {(f32x4){0.f, 0.f, 0.f, 0.f}, (f32x4){0.f, 0.f, 0.f, 0.f}};
          mm_rows<64, 2>(bhT, TS, XT, TS, mt, nt0, fr, fq, am);
          mm_rows<64, 2>(bhT, TS, XT + 64 * TS, TS, mt, nt0, fr, fq, an);
          mm_rows<64, 2>(Azk, TS, vT, TS, mt, nt0, fr, fq, an);
          bf16_t* Mg = WSP(bf16_t, SC_RW_M) + (size_t)u * 4096; bf16_t* Ng = WSP(bf16_t, SC_RW_NS) + (size_t)u * 4096;
#pragma unroll
          for (int t = 0; t < 2; ++t) {
#pragma unroll
              for (int j = 0; j < 4; ++j) { const int row = 16 * mt + 4 * fq + j, col = 16 * (nt0 + t) + fr; Mg[dr_mfrag_idx(row, col)] = (bf16_t)f2bf((row == col ? __expf(LP[63 * LPS + row]) : 0.f) + am[t][j]); }
              *(u32x2*)(Ng + (((nt0 + t) * 4 + mt) * 64 + lane) * 4) = (u32x2){pk2(an[t][0], an[t][1]), pk2(an[t][2], an[t][3])}; } }
        __syncthreads();
        if (!more) break;
        u = un;
    }
#undef RW1_LOAD
}
__device__ __forceinline__ void rw_p2(const Cx& p, LAS unsigned char* lds, int layer, int b) {
    const int wave = __builtin_amdgcn_readfirstlane(p.tid >> 6), mt = wave >> 1, nt0 = (wave & 1) * 2;
    LAS float* LP = (LAS float*)lds; LAS float* GS = (LAS float*)(lds + 16640);
    LAS unsigned char* rt = lds + 18688; LAS unsigned char* bt = lds + 27904; LAS unsigned char* kt = lds + 37120; LAS unsigned char* vT = lds + 46336; LAS unsigned char* sT = lds + 55552; LAS unsigned char* wt = lds + 64768;
    LAS unsigned char* Arb = lds + 73984; LAS unsigned char* Ark = lds + 83200; LAS unsigned char* UT = lds + 92416;
    const bf16_t* proj = WSP(bf16_t, WS_PROJ);
    UNIT_LOOP(u, NUNIT, 224) { const int tb = u >> 3, h = (u >> 1) & 3, d = u & 1, s0 = 64 * tb;
        const float* lwp = WSP(float, SC_RLW) + (size_t)d * SB * 256 + (size_t)s0 * 256 + 64 * h; const float* rk = WSP(float, SC_RK) + (size_t)s0 * 256 + 64 * h; const float* rb = WSP(float, SC_RB) + (size_t)s0 * 256 + 64 * h;
        const bf16_t* pr0 = proj + (size_t)tb_row0(b, tb) * NPROJ; const bf16_t* wu = WSP(bf16_t, SC_RW_WU) + (size_t)u * 8192; const bf16_t* st = WSP(bf16_t, SC_RW_NS) + (size_t)u * 4096;
        bf16_t upre[2][4];
        { const int lane_ = lane_id_asm(), fr_ = lane_ & 15, fq_ = lane_ >> 4;
#pragma unroll
          for (int t = 0; t < 2; ++t)
#pragma unroll
              for (int j = 0; j < 4; ++j) upre[t][j] = wu[(16 * mt + 4 * fq_ + j) * 128 + 64 + 16 * (nt0 + t) + fr_]; }
        { float lw8[8]; const int lane_ = lane_id_asm();
#pragma unroll
          for (int ii = 0; ii < 8; ++ii) { const int r_ = 8 * wave + ii; lw8[ii] = lwp[(size_t)(d ? 63 - r_ : r_) * 256 + lane_]; }
          RW_LP(LP, GS, lw8); }
        { RW_LANES; const int r = tid >> 3, c0 = (tid & 7) * 8, i = d ? 63 - r : r; unsigned wr[4], wb[4], wk[4];
          const u32x4 rv = *(const u32x4*)(pr0 + (size_t)i * NPROJ + PB_R + 64 * h + c0);
          f32x4 bv[2], kv[2];
#pragma unroll
          for (int q = 0; q < 2; ++q) { bv[q] = *(const f32x4*)(rb + (size_t)i * 256 + c0 + 4 * q); kv[q] = *(const f32x4*)(rk + (size_t)i * 256 + c0 + 4 * q); }
#pragma unroll
          for (int q = 0; q < 8; q += 2) { float r2[2], b2[2], k2[2];
#pragma unroll
              for (int e = 0; e < 2; ++e) { const int cq = q + e, c = c0 + cq; const float lp = LP[r * LPS + c], em = __expf(-lp); const unsigned w = rv[q >> 1];
                  r2[e] = (e ? __uint_as_float(w & 0xffff0000u) : __uint_as_float(w << 16)) * __expf(lp); b2[e] = bv[cq >> 2][cq & 3] * em; k2[e] = kv[cq >> 2][cq & 3] * em; }
              wr[q >> 1] = pk2(r2[0], r2[1]); wb[q >> 1] = pk2(b2[0], b2[1]); wk[q >> 1] = pk2(k2[0], k2[1]); }
          *(LAS u32x4*)(rt + r * TS + c0 * 2) = (u32x4){wr[0], wr[1], wr[2], wr[3]}; *(LAS u32x4*)(bt + r * TS + c0 * 2) = (u32x4){wb[0], wb[1], wb[2], wb[3]}; *(LAS u32x4*)(kt + r * TS + c0 * 2) = (u32x4){wk[0], wk[1], wk[2], wk[3]};
          *(LAS u32x4*)(wt + r * TS + c0 * 2) = *(const u32x4*)(wu + r * 128 + c0);
          *(LAS u32x4*)(sT + r * TS + c0 * 2) = *(const u32x4*)(st + r * 64 + c0);
#pragma unroll 2
          for (int q = 0; q < 8; ++q) { const int e = tid + NTHR * q, r2 = e >> 6, cc = e & 63; *(LAS bf16_t*)(vT + cc * TS + r2 * 2) = pr0[(size_t)(d ? 63 - r2 : r2) * NPROJ + PB_V + 64 * h + cc]; } }
        __syncthreads();
        { RW_LANES; f32x4 a1[2] = {(f32x4){0.f, 0.f, 0.f, 0.f}, (f32x4){0.f, 0.f, 0.f, 0.f}}, a2[2] = {(f32x4){0.f, 0.f, 0.f, 0.f}, (f32x4){0.f, 0.f, 0.f, 0.f}}, a3[2] = {(f32x4){0.f, 0.f, 0.f, 0.f}, (f32x4){0.f, 0.f, 0.f, 0.f}};
          mm_rows<64, 2>(rt, TS, bt, TS, mt, nt0, fr, fq, a1); mm_rows<64, 2>(rt, TS, kt, TS, mt, nt0, fr, fq, a2); mm_rows<64, 2>(wt, TS, sT, TS, mt, nt0, fr, fq, a3);
#pragma unroll
          for (int t = 0; t < 2; ++t) { const int dv = 16 * (nt0 + t) + fr; float uu[4];
#pragma unroll
              for (int j = 0; j < 4; ++j) { const int r = 16 * mt + 4 * fq + j, jj = dv; const bool keep = jj <= r;
                  *(LAS bf16_t*)(Arb + r * TS + jj * 2) = (bf16_t)f2bf(keep ? a1[t][j] : 0.f); *(LAS bf16_t*)(Ark + r * TS + jj * 2) = (bf16_t)f2bf(keep ? a2[t][j] : 0.f);
                  uu[j] = bf2f(upre[t][j]) + a3[t][j]; }
              *(LAS u32x2*)(UT + dv * TS + (16 * mt + 4 * fq) * 2) = (u32x2){pk2(uu[0], uu[1]), pk2(uu[2], uu[3])}; } }
        __syncthreads();
        { RW_LANES; f32x4 acc[2] = {(f32x4){0.f, 0.f, 0.f, 0.f}, (f32x4){0.f, 0.f, 0.f, 0.f}};
          mm_rows<64, 2>(rt, TS, sT, TS, mt, nt0, fr, fq, acc); mm_rows<64, 2>(Arb, TS, UT, TS, mt, nt0, fr, fq, acc); mm_rows<64, 2>(Ark, TS, vT, TS, mt, nt0, fr, fq, acc);
          bf16_t* ob = WSP(bf16_t, d ? SC_OB : SC_OF);
#pragma unroll
          for (int t = 0; t < 2; ++t)
#pragma unroll
              for (int j = 0; j < 4; ++j) { const int r = 16 * mt + 4 * fq + j, i = d ? 63 - r : r; ob[(size_t)(s0 + i) * 1024 + 256 + 64 * h + 16 * (nt0 + t) + fr] = (bf16_t)f2bf(acc[t][j]); } }
        __syncthreads();
    }
#undef RW_LANES
}
__device__ __forceinline__ void phase_scan(const Cx& p, LAS unsigned char* lds, int layer, int b) {
    for (int w = p.bid; w < 160; w += p.G) {
        if (w < 64) ssd_chain(p, (w >> 4) & 3, (w >> 3) & 1, w & 7);
        else if (w < 96) gla_chain(p, ((w - 64) >> 3) & 3, ((w - 64) >> 2) & 1, (w - 64) & 3);
        else { const int i = w - 96, h = (i >> 3) & 3, d = (i >> 2) & 1, cb = i & 3;
            if (i < 32) dr_chain(p, SC_RW_M, SC_RW_NS, h, d, cb); else dr_chain(p, SC_DR_M, SC_DR_NS, h, d, cb); } }
}
#ifndef MK_ONE_LAUNCH
#define MK_ONE_LAUNCH 1
#endif
constexpr int PH_PER_LAYER = 2 + 5 * NB + 7;
constexpr int N_PHASES = 1 + NL * PH_PER_LAYER + 1;

__global__ void __launch_bounds__(NTHR, 2) mega_fwd(Params pp) {
    extern __shared__ __attribute__((aligned(16))) unsigned char lds_raw[];
    LAS unsigned char* lds = (LAS unsigned char*)lds_raw;
    const int swave = __builtin_amdgcn_readfirstlane(threadIdx.x >> 6);
    for (int i = threadIdx.x; i < (LDS_BYTES - LDS_CTL) / 4; i += NTHR) ((LAS unsigned*)(lds + LDS_CTL))[i] = 0u;
    __syncthreads();
    if (threadIdx.x < N_IN + 2) { const unsigned long long a = threadIdx.x < N_IN ? (unsigned long long)pp.in[threadIdx.x] : (threadIdx.x == N_IN ? (unsigned long long)pp.out : (unsigned long long)pp.ws); ((LAS unsigned*)(lds + LDS_PTRS))[2 * threadIdx.x] = (unsigned)a; ((LAS unsigned*)(lds + LDS_PTRS))[2 * threadIdx.x + 1] = (unsigned)(a >> 32); }
    __syncthreads();
    XcdBarrier bar = xcd_barrier_post((unsigned*)(pp.ws + WS_CTL) + CW_BAR + pp.li * XCD_BAR_WORDS, (volatile LAS unsigned*)(lds + LDS_CTL), threadIdx.x);
    LAS int* tb = (LAS int*)(lds + LDS_CTL + 64);
    int pc = 0; const int lo = pp.lo, hi = pp.hi;
#define PH_BEGIN if (pc >= lo && pc < hi) { Cx p; p.out = (float*)PIN(N_IN); p.ws = (unsigned char*)PIN(N_IN + 1); p.tid = swave * 64 + lane_id_asm(); p.bid = blockIdx.x; p.G = gridDim.x; p.pad = 0; asm volatile("" : "+s"(p.out), "+s"(p.ws), "+v"(p.tid), "+s"(p.bid), "+s"(p.G)); const int G = p.G, bid = p.bid; (void)G; (void)bid;
#define PH_END if (pc + 1 < hi) { XcdBarrier b2 = bar; asm volatile("" : "+s"(b2.bar), "+s"(b2.x)); xcd_barrier(b2, (unsigned)(swave * 64 + lane_id_asm())); } } ++pc;

    PH_BEGIN
        for (int u = bid; u < CONV_A_UNITS; u += G) conv_unit_A(p, (LAS float*)lds, u);
        __syncthreads();
        phase_mod(p, lds);
    PH_END

#pragma unroll
    for (int layer = 0; layer < NL; ++layer) {
        const int row_lo = layer == NL - 1 ? CROWS : 0;
        PH_BEGIN phase_norm1(p, layer); PH_END
        PH_BEGIN
            DenseSched S; S.init(ROWS, NPROJ, D, WSP(bf16_t, WS_WIN) + (size_t)layer * NPROJ * D, G, bid);
            EpiProj E{WSP(bf16_t, WS_PROJ), NPROJ};
            pg8::gemm_phase<D>(p.tid, lds, (const char*)WSP(bf16_t, WS_HBUF), S, E);
        PH_END
#pragma unroll 1
        for (int b = 0; b < NB; ++b) {
            PH_BEGIN phase_prep(p, lds, layer, b); PH_END
            PH_BEGIN gla_p1(p, lds, layer, b); __syncthreads(); ssd_p1(p, lds, layer, b); __syncthreads(); gdn_p1(p, lds, layer, b); __syncthreads(); rw_p1(p, lds, layer, b); PH_END
            PH_BEGIN phase_scan(p, lds, layer, b); PH_END
            PH_BEGIN gla_p2(p, lds, layer, b); __syncthreads(); ssd_p2(p, lds, layer, b); __syncthreads(); gdn_p2(p, lds, layer, b); __syncthreads(); rw_p2(p, lds, layer, b); PH_END
            PH_BEGIN phase_post(p, lds, layer, b); PH_END
        }
        PH_BEGIN
            DenseSched S; S.init(ROWS, D, D, WSP(bf16_t, WS_WOUT) + (size_t)layer * D * D, G, bid);
            EpiRes E{layer == 0 ? PIN(I_X) : (const float*)p.out, layer == 0 ? PIN(I_CTX) : (const float*)WSP(float, WS_CTXRES), p.out, WSP(float, WS_CTXRES), WSP(float, WS_MOD) + (size_t)layer * 5 * 6144 + 2048};
            pg8::gemm_phase<D>(p.tid, lds, (const char*)WSP(bf16_t, WS_HBUF), S, E);
        PH_END
        PH_BEGIN phase_norm2(p, lds, layer, row_lo);
            __syncthreads();
            conv_experts(p, (LAS float*)lds, layer);
        PH_END
        PH_BEGIN
            moe_table(p, tb, layer, row_lo);
            MoeSched<true> S{tb + 128, tb, 2, G, bid, D, row_lo, WSP(int, WS_LTOK), (const char*)WSP(bf16_t, WS_EXPGU), (size_t)512 * D * 2};
            EpiGU E{WSP(bf16_t, WS_H)};
            pg8::gemm_phase<D>(p.tid, lds, (const char*)WSP(bf16_t, WS_HBUF), S, E);
        PH_END
#pragma unroll
        for (int half = 0; half < 2; ++half) {
            PH_BEGIN
                moe_table(p, tb, layer, row_lo);
                MoeSched<false> S{tb + 128, tb, 2, G, bid, EH, row_lo, WSP(int, WS_LTOK), (const char*)(WSP(bf16_t, WS_EXPD) + (size_t)half * 512 * EH), (size_t)D * EH * 2};
                EpiY E{WSP(bf16_t, WS_Y)};
                pg8::gemm_phase<EH>(p.tid, lds, (const char*)WSP(bf16_t, WS_H), S, E);
            PH_END
            PH_BEGIN
                moe_table(p, tb, layer, row_lo);
                phase_combine(p, tb, layer, row_lo, half);
            PH_END
        }
    }
    PH_BEGIN phase_final(p);
    PH_END
#undef PH_BEGIN
#undef PH_END
}

extern "C" void kernel_launch(void* const* d_in, const int* in_sizes, int n_in, void* d_out, int out_size, void* d_ws, size_t ws_size, hipStream_t stream) {
    static int grid = 0;
    if (grid == 0) {
        if (n_in != N_IN || in_sizes[0] != NB * SEQ * D || out_size != NB * SEQ * D || ws_size < WS_END) {
            fprintf(stderr, "kernel_launch: unexpected shapes (n_in %d, in0 %d, out %d, ws %zu); nothing launched\n", n_in, n_in > 0 ? in_sizes[0] : -1, out_size, ws_size); grid = -1; return; }
        int dev = 0, cus = 0, per_cu = 0;
        if (hipGetDevice(&dev) != hipSuccess || hipDeviceGetAttribute(&cus, hipDeviceAttributeMultiprocessorCount, dev) != hipSuccess) { grid = -1; return; }
        if (hipFuncSetAttribute((const void*)mega_fwd, hipFuncAttributeMaxDynamicSharedMemorySize, LDS_BYTES) != hipSuccess) { fprintf(stderr, "kernel_launch: hipFuncSetAttribute failed\n"); grid = -1; return; }
        if (hipOccupancyMaxActiveBlocksPerMultiprocessor(&per_cu, (const void*)mega_fwd, NTHR, LDS_BYTES) != hipSuccess || per_cu < 1) { fprintf(stderr, "kernel_launch: occupancy query says %d\n", per_cu); per_cu = 1; }
        (void)hipGetLastError();
        grid = cus * 1;
    }
    if (grid < 0) return;
    if (hipMemsetAsync((char*)d_ws + WS_CTL, 0, CTL_ZERO_BYTES, stream) != hipSuccess) return;
    Params p{};
    for (int i = 0; i < N_IN; ++i) p.in[i] = (const float*)d_in[i];
    p.out = (float*)d_out; p.ws = (unsigned char*)d_ws; p.pad = 0;
#if MK_ONE_LAUNCH
    p.lo = 0; p.hi = N_PHASES; p.li = 0;
    hipLaunchKernelGGL(mega_fwd, dim3(grid), dim3(NTHR), LDS_BYTES, stream, p);
#else
    for (int k = 0; k < N_PHASES; ++k) { p.lo = k; p.hi = k + 1; p.li = k;
        hipLaunchKernelGGL(mega_fwd, dim3(grid), dim3(NTHR), LDS_BYTES, stream, p); }
#endif
}
```

```cpp
#include <hip/hip_runtime.h>
#include <cstdio>
#include <cstdint>

typedef unsigned short bf16_t;
typedef short bf16x8 __attribute__((ext_vector_type(8)));
typedef float f32x4 __attribute__((ext_vector_type(4)));
typedef float f32x2 __attribute__((ext_vector_type(2)));
typedef unsigned u32x4 __attribute__((ext_vector_type(4)));
typedef unsigned u32x2 __attribute__((ext_vector_type(2)));

constexpr int NB = 4, SEQ = 8192, NCTX = 256, D = 1024, NL = 2;
constexpr int CROWS = NB * NCTX;
constexpr int ROWS = CROWS + NB * SEQ;
constexpr int SB = NCTX + SEQ;
constexpr int INW = 4056, NPROJ = 4096;
constexpr int NE = 64, NE1 = 65, TOPK = 8, EH = 256;
constexpr int GRIDW = 64, GRIDH = SEQ / GRIDW;
constexpr int PA_Q = 0, PA_K = 256, PA_V = 512, PA_G = 768, PA_GF = 1024, PA_GB = 1040;
constexpr int PB_R = 1056, PB_K = 1312, PB_V = 1568, PB_WF = 1824, PB_WB = 1856, PB_A = 1888, PB_G = 1920;
constexpr int PC_Z = 1984, PC_X = 2240, PC_DF = 3008, PC_DB = 3012;
constexpr int PD_Q = 3016, PD_Z = 3784, PD_BF = 4040, PD_BB = 4044, PD_AF = 4048, PD_AB = 4052;
enum { I_X = 0, I_C, I_CTX, I_CCTX, I_N1G, I_N2G, I_WMOD, I_BMOD, I_WIN, I_WOUT, I_GLA_W2, I_GLA_B, I_GLA_NG,
       I_RW_W2, I_RW_W0, I_RW_AW2, I_RW_A0, I_RW_GW2, I_RW_KK, I_RW_KA, I_RW_RK, I_RW_LNG, I_RW_LNB,
       I_SS_CW, I_SS_CB, I_SS_ALOG, I_SS_DTB, I_SS_D, I_SS_NG, I_DN_CW, I_DN_ALOG, I_DN_DTB, I_DN_NG,
       I_ROUT_W, I_ROUT_B, I_EXP_G, I_EXP_U, I_EXP_D, I_SH_G, I_SH_U, I_SH_D, I_FNG, N_IN };
static_assert(N_IN == 42, "input count");

constexpr size_t MiB = 1u << 20;
constexpr size_t WS_CTL = 0, CTL_ZERO_BYTES = 1 * MiB;
constexpr size_t WS_MOD = 1 * MiB;
constexpr size_t WS_WIN = 2 * MiB;
constexpr size_t WS_WOUT = 18 * MiB;
constexpr size_t WS_ROUT = 22 * MiB;
constexpr size_t WS_CTXRES = 23 * MiB;
constexpr size_t WS_EXPGU = 27 * MiB;
constexpr size_t WS_EXPD = 92 * MiB;
constexpr size_t WS_HBUF = 125 * MiB;
constexpr size_t WS_PROJ = 191 * MiB;
constexpr size_t WS_SCR = 455 * MiB;
constexpr size_t WS_END = 640455456;
constexpr int HROWS_MAX = ROWS * 9 + NE1 * 256;
constexpr size_t WS_Y = WS_HBUF;
constexpr size_t WS_H = 443 * MiB;
constexpr size_t WS_LTOK = 600 * MiB;
constexpr size_t WS_TOKT = WS_LTOK + (size_t)NE * ROWS * 4;
static_assert(WS_Y + (size_t)HROWS_MAX * 512 * 2 <= WS_H && WS_H + (size_t)HROWS_MAX * 256 * 2 <= WS_LTOK && WS_TOKT + (size_t)ROWS * 64 <= WS_END, "moe overlay");
constexpr size_t SC_OF = WS_SCR;
constexpr size_t SC_OB = SC_OF + (size_t)SB * 1024 * 2;
constexpr size_t SC_RK = SC_OB + (size_t)SB * 1024 * 2;
constexpr size_t SC_RKK = SC_RK + (size_t)SB * 256 * 4;
constexpr size_t SC_RB = SC_RKK + (size_t)SB * 256 * 4;
constexpr size_t SC_RLW = SC_RB + (size_t)SB * 256 * 4;
constexpr size_t SC_SX = SC_RLW + (size_t)2 * SB * 256 * 4;
constexpr size_t SC_DQ = SC_SX + (size_t)SB * 768 * 2;
constexpr size_t SC_SDT = SC_DQ + (size_t)SB * 768 * 2;
constexpr size_t SC_DG = SC_SDT + (size_t)SB * 8 * 4;
constexpr size_t SC_FEND = SC_DG + (size_t)SB * 16 * 4;
constexpr int NTB = SB / 64, NUNIT = NTB * 4 * 2;
constexpr size_t SC_RW_M = SC_FEND;
constexpr size_t SC_RW_NS = SC_RW_M + (size_t)(SB / 64 * 8) * 4096 * 2;
constexpr size_t SC_RW_WU = SC_RW_NS + (size_t)(SB / 64 * 8) * 4096 * 2;
constexpr size_t SC_END = SC_RW_WU + (size_t)(SB / 64 * 8) * 8192 * 2;
constexpr size_t SC2 = WS_EXPGU;
constexpr size_t SC_GLA_S = SC2;
constexpr size_t SC_GLA_DEC = SC_GLA_S + (size_t)NUNIT * 4096 * 4;
constexpr size_t SC_SSD_S = SC_GLA_DEC + (size_t)NUNIT * 64 * 4;
constexpr size_t SC_SSD_CD = SC_SSD_S + (size_t)NUNIT * 8192 * 4;
constexpr size_t SC_DR_M = SC_SSD_CD + (size_t)NUNIT * 4 + 4096;
constexpr size_t SC_DR_NS = SC_DR_M + (size_t)NUNIT * 4096 * 2;
constexpr size_t SC_DR_WU = SC_DR_NS + (size_t)NUNIT * 4096 * 2;
constexpr size_t SC2_END = SC_DR_WU + (size_t)NUNIT * 8192 * 2;
static_assert(SC2_END <= WS_HBUF, "chunk slots fit in the expert-weight region");
static_assert(SC_END <= WS_END, "scratch fits");
constexpr int CW_CNT = 1024;
constexpr int CW_BAR = 4096;

#define LAS __attribute__((address_space(3)))
constexpr int NTHR = 512;
constexpr int LDS_BYTES = 147456;
constexpr int LDS_CTL = 143360;
constexpr int LDS_PTRS = LDS_CTL + 2048;

__device__ __forceinline__ int lane_id_asm() { int l; asm volatile("v_mbcnt_lo_u32_b32 %0, -1, 0\n\tv_mbcnt_hi_u32_b32 %0, -1, %0" : "=v"(l)); return l; }
__device__ __forceinline__ float bf2f(bf16_t b) { return __uint_as_float(((unsigned)b) << 16); }
__device__ __forceinline__ unsigned f2bf(float f) { unsigned u = __float_as_uint(f); u += 0x7FFFu + ((u >> 16) & 1u); return u >> 16; }
__device__ __forceinline__ unsigned pk2(float lo, float hi) { return f2bf(lo) | (f2bf(hi) << 16); }
__device__ __forceinline__ float rl(float x, int k) { return __uint_as_float(__builtin_amdgcn_readlane(__float_as_uint(x), k)); }
__device__ __forceinline__ float shx_(float v, int lane, int o) { return __uint_as_float(__builtin_amdgcn_ds_bpermute((lane ^ o) << 2, __float_as_uint(v))); }
__device__ __forceinline__ int shxi_(int v, int lane, int o) { return __builtin_amdgcn_ds_bpermute((lane ^ o) << 2, v); }
__device__ __forceinline__ float shup_(float v, int lane, int o) { return __uint_as_float(__builtin_amdgcn_ds_bpermute((lane - o) << 2, __float_as_uint(v))); }
#define DPPF(v, ctrl) __uint_as_float(__builtin_amdgcn_update_dpp(0, __float_as_uint(v), ctrl, 0xf, 0xf, false))
#define DPPI(v, ctrl) __builtin_amdgcn_update_dpp(0, (v), ctrl, 0xf, 0xf, false)
__device__ __forceinline__ float wsum(float v) {
    v += DPPF(v, 0xB1); v += DPPF(v, 0x4E); v += DPPF(v, 0x141); v += DPPF(v, 0x140);
    v += __uint_as_float(__builtin_amdgcn_ds_swizzle(__float_as_uint(v), 0x401F));
    return rl(v, 0) + rl(v, 32);
}
__device__ __forceinline__ float sigmoidf_(float x) { return 1.0f / (1.0f + __expf(-x)); }
__device__ __forceinline__ float siluf_(float x) { return x / (1.0f + __expf(-x)); }
__device__ __forceinline__ float log1pexp_(float t  ) { return t < 1e-4f ? t - 0.5f * t * t : __logf(1.0f + t); }
__device__ __forceinline__ float softplusf_(float x) { return x > 15.f ? x : log1pexp_(__expf(x)); }
__device__ __forceinline__ float logsigmoidf_(float x) { return fminf(x, 0.f) - log1pexp_(__expf(-fabsf(x))); }
__device__ __forceinline__ float tanhf_(float x) { const float e = __expf(2.0f * fminf(fmaxf(x, -15.f), 15.f)); return (e - 1.0f) / (e + 1.0f); }
__device__ __forceinline__ int seq_tok(int i, int d) { return d == 0 ? i : (i < NCTX ? NCTX - 1 - i : SB + NCTX - 1 - i); }
__device__ __forceinline__ int tok_row(int b, int s) { return s < NCTX ? b * NCTX + s : CROWS + b * SEQ + (s - NCTX); }

struct Params { const float* in[N_IN]; float* out; unsigned char* ws; int lo, hi, li, pad; };
struct Cx { float* out; unsigned char* ws; int tid, bid, G, pad; };
__device__ __forceinline__ const float* PIN(int i) {
    extern __shared__ __attribute__((aligned(16))) unsigned char lds_raw_[];
    int off = __builtin_amdgcn_readfirstlane(LDS_PTRS + 8 * i); asm volatile("" : "+s"(off));
    const LAS unsigned* t = (const LAS unsigned*)((LAS unsigned char*)lds_raw_ + off);
    const unsigned lo = __builtin_amdgcn_readfirstlane(t[0]), hi = __builtin_amdgcn_readfirstlane(t[1]);
    return (const float*)(((unsigned long long)hi << 32) | lo);
}
#define XB_TMO      128
#define XB_XCNT(j)  (256  + 64 * (j))
#define XB_XSUB(j)  (1280 + 64 * (j))
#define XB_XGEN(j)  (2304 + 64 * (j))
#define XB_TOP      3328
#define XB_TOPGEN   3392
#define XCD_BAR_WORDS 3456
#define XB_SPIN_CAP (1u << 18)

__device__ __forceinline__ unsigned xb_ld(unsigned* p)              { return __hip_atomic_load(p, __ATOMIC_RELAXED, __HIP_MEMORY_SCOPE_AGENT); }
__device__ __forceinline__ unsigned xb_add(unsigned* p, unsigned v) { return __hip_atomic_fetch_add(p, v, __ATOMIC_RELAXED, __HIP_MEMORY_SCOPE_AGENT); }
__device__ __forceinline__ unsigned xb_xcc_id() { return (unsigned)__builtin_amdgcn_s_getreg((3 << 11) | 20) & 0xFu; }
#define XB_SPIN(cond, bar) do { unsigned _sp = 0; while (cond) { __builtin_amdgcn_s_sleep(1); \
    if ((++_sp & 255u) == 0u) { if (xb_ld(&(bar)[XB_TMO])) break; if (_sp > XB_SPIN_CAP) { atomicAdd(&(bar)[XB_TMO], 1u); break; } } } } while (0)

struct XcdBarrier {
    unsigned* bar; unsigned x;
    volatile LAS unsigned* st;
};

__device__ __forceinline__ XcdBarrier xcd_barrier_post(unsigned* bar, volatile LAS unsigned* st, const unsigned xb_tid) {
    XcdBarrier b; b.bar = bar; b.x = xb_xcc_id(); b.st = st;
    if (xb_tid == 0) (void)xb_add(&bar[XB_XCNT(b.x)], 1u);
    return b;
}
__device__ __forceinline__ void xcd_barrier_complete(unsigned* bar, unsigned x, unsigned& nloc, unsigned& nx) {
    const unsigned G = gridDim.x * gridDim.y * gridDim.z;
    unsigned sum, cnt, mine, sp = 0u;
    for (;;) {
        sum = 0u; cnt = 0u; mine = 0u;
#pragma unroll
        for (unsigned j = 0; j < 16; ++j) { const unsigned c = xb_ld(&bar[XB_XCNT(j)]); sum += c; cnt += (c > 0u) ? 1u : 0u; mine = (j == x) ? c : mine; }
        if (sum == G) break;
        __builtin_amdgcn_s_sleep(1);
        if ((++sp & 255u) == 0u) { if (xb_ld(&bar[XB_TMO])) break; if (sp > XB_SPIN_CAP) { atomicAdd(&bar[XB_TMO], 1u); break; } }
    }
    nloc = mine > 0u ? mine : 1u; nx = cnt > 0u ? cnt : 1u;
}

__device__ __forceinline__ void xcd_barrier(const XcdBarrier& b, const unsigned xb_tid) {
    asm volatile("s_waitcnt vmcnt(0)" ::: "memory");
    __syncthreads();
    if (xb_tid == 0) {
        unsigned* bar = b.bar;
        __builtin_amdgcn_s_waitcnt(0);
        unsigned nloc = b.st[0], nx = b.st[1];
        if (nloc == 0u) { xcd_barrier_complete(bar, b.x, nloc, nx); b.st[0] = nloc; b.st[1] = nx; }
        const unsigned old = xb_add(&bar[XB_XSUB(b.x)], 1u);
        const unsigned gen = old / nloc;
        if (old + 1u == (gen + 1u) * nloc) {
            __builtin_amdgcn_fence(__ATOMIC_RELEASE, "agent");
            asm volatile("s_waitcnt vmcnt(0)" ::: "memory");
            const unsigned og = xb_add(&bar[XB_TOP], 1u);
            const unsigned tg = og / nx;
            if (og + 1u == (tg + 1u) * nx) xb_add(&bar[XB_TOPGEN], 1u);
            else XB_SPIN(xb_ld(&bar[XB_TOPGEN]) == tg, bar);
            __builtin_amdgcn_fence(__ATOMIC_ACQUIRE, "agent");
            xb_add(&bar[XB_XGEN(b.x)], 1u);
            asm volatile("s_waitcnt vmcnt(0)" ::: "memory");
        } else {
            XB_SPIN(xb_ld(&bar[XB_XGEN(b.x)]) == gen, bar);
            __builtin_amdgcn_fence(__ATOMIC_ACQUIRE, "agent");
            asm volatile("s_waitcnt vmcnt(0)" ::: "memory");
        }
    }
    __syncthreads();
}

namespace pg8 {
constexpr int BM = 256, BK = 64, HALF = 128, HTB = HALF * BK * 2  , STAGE_BYTES = 8 * HTB, NXCD = 8, WGM = 8;
__host__ __device__ __forceinline__ int lds_byte(int r, int c) { const int st = (r >> 4) * 2 + (c >> 5), rr = r & 15, cc = c & 31, ob = rr * 64 + cc * 2; return st * 1024 + (ob ^ (((ob >> 9) & 1) << 5)); }
__host__ __device__ __forceinline__ void stage_rc(int b, int& R, int& C) { const int st = b / 1024, sb = b % 1024, swz = sb ^ (((sb >> 9) & 1) << 5); R = (st >> 1) * 16 + swz / 64; C = (st & 1) * 32 + (swz % 64) / 2; }
__host__ __device__ __forceinline__ int perm32(int rho) { const int n = rho >> 4, i = rho & 15; return 8 * (i >> 2) + 4 * n + (i & 3); }

struct Unit { int pm, pn, e, r0; };

__device__ __forceinline__ unsigned cvt_pk_bf16(float lo, float hi) { unsigned r; asm volatile("v_cvt_pk_bf16_f32 %0, %1, %2" : "=v"(r) : "v"(lo), "v"(hi)); return r; }

template <int K, class Epi, class Sched>
__device__ __forceinline__ void gemm_phase(const int tid, LAS unsigned char* lds, const char* Abase, const Sched& S, const Epi& E) {
    const int wid = __builtin_amdgcn_readfirstlane(tid >> 6), lane = tid & 63, wr = wid >> 2, wc = wid & 3, fr = lane & 15, fq = lane >> 4;
    const int nt = K / BK;
    constexpr bool DN = Sched::DENSE;
    int RA[2], CA[2]; unsigned voffB[2], voffA[2];
#pragma unroll
    for (int i = 0; i < 2; ++i) { int R, C; stage_rc(tid * 16 + i * 8192, R, C); const int Rb = Epi::PERM ? ((R & ~31) + perm32(R & 31)) : R;
        RA[i] = R; CA[i] = C; voffB[i] = (unsigned)(Rb * K + C) * 2u; voffA[i] = (unsigned)(R * K + C) * 2u; }
    const size_t kstep = (size_t)(BK * 2);
    const size_t hstep = (size_t)HALF * K * 2;
    const size_t tstep = 2 * hstep;
    const unsigned ldsw = (unsigned)wid * 1024u;
    const int aoff = lds_byte(wr * 64 + fr, fq * 8), boff = lds_byte(wc * 32 + fr, fq * 8);
#define PG8_SA(b, h) (((b) * 2 + (h)) * HTB)
#define PG8_SB(b, h) ((4 + (b) * 2 + (h)) * HTB)
#define PG8_STAGE(bufoff, gbase, voff) do { _Pragma("unroll") for (int _i = 0; _i < 2; ++_i) \
        __builtin_amdgcn_global_load_lds((const __attribute__((address_space(1))) unsigned*)((const __attribute__((address_space(1))) char*)(gbase) + (voff)[_i]), (LAS unsigned*)(lds + (bufoff) + ldsw + _i * 8192), 16, 0, 0); } while (0)
#define PG8_LDA(dst, b, h) do { _Pragma("unroll") for (int m = 0; m < 4; ++m) _Pragma("unroll") for (int k = 0; k < 2; ++k) dst[m][k] = *(const LAS bf16x8*)(lds + PG8_SA(b, h) + aoff + m * 2048 + k * 1024); } while (0)
#define PG8_LDB(dst, b, h) do { _Pragma("unroll") for (int n = 0; n < 2; ++n) _Pragma("unroll") for (int k = 0; k < 2; ++k) dst[n][k] = *(const LAS bf16x8*)(lds + PG8_SB(b, h) + boff + n * 2048 + k * 1024); } while (0)
#define PG8_MMA(ai, bj, At, Bt) do { __builtin_amdgcn_s_setprio(1); _Pragma("unroll") for (int m = 0; m < 4; ++m) _Pragma("unroll") for (int n = 0; n < 2; ++n) _Pragma("unroll") for (int k = 0; k < 2; ++k) \
        acc[ai][bj][m][n] = __builtin_amdgcn_mfma_f32_16x16x32_bf16(Bt[n][k], At[m][k], acc[ai][bj][m][n], 0, 0, 0); __builtin_amdgcn_s_setprio(0); } while (0)
#define PG8_WAIT_V(n) asm volatile("s_waitcnt vmcnt(" #n ")" ::: "memory")
#define PG8_WAIT_L(n) asm volatile("s_waitcnt lgkmcnt(" #n ")" ::: "memory")
#define PG8_BAR __builtin_amdgcn_s_barrier()
#define PG8_SCHED __builtin_amdgcn_sched_barrier(0)
#define PG8_AOFF(dst, u) do { _Pragma("unroll") for (int _h = 0; _h < 2; ++_h) _Pragma("unroll") for (int _i = 0; _i < 2; ++_i) \
        dst[_h][_i] = ((unsigned)S.a_row(u, _h * HALF + RA[_i]) * (unsigned)K + (unsigned)CA[_i]) * 2u; } while (0)
    Unit cur, nxt; int ui = 0;
    if (!S.next(0, cur)) return;
    f32x4 acc[2][2][4][2];
#pragma unroll
    for (int a = 0; a < 2; ++a)
#pragma unroll
        for (int b = 0; b < 2; ++b)
#pragma unroll
            for (int m = 0; m < 4; ++m)
#pragma unroll
                for (int n = 0; n < 2; ++n) acc[a][b][m][n] = (f32x4){0.f, 0.f, 0.f, 0.f};
    bf16x8 At[4][2], B0[2][2], B1[2][2];
    unsigned cO[2][2], nO[2][2];
    const char* cA = Abase; const char* nA = Abase;
    if constexpr (DN) cA = Abase + (size_t)S.a_row(cur, 0) * K * 2; else PG8_AOFF(cO, cur);
    const char* cB = S.b_ptr(cur);
#define PG8_STA(bufoff, h_, kb_, nx_) do { if constexpr (DN) PG8_STAGE(bufoff, ((nx_) ? nA : cA) + (h_) * hstep + (kb_), voffA); else PG8_STAGE(bufoff, Abase + (kb_), ((nx_) ? nO : cO)[h_]); } while (0)
    PG8_STAGE(PG8_SB(0, 0), cB, voffB); PG8_SCHED; PG8_STA(PG8_SA(0, 0), 0, 0, false); PG8_SCHED; PG8_STAGE(PG8_SB(0, 1), cB + hstep, voffB); PG8_SCHED; PG8_STA(PG8_SA(0, 1), 1, 0, false); PG8_SCHED;
    if (wr == 1) PG8_BAR;
    PG8_WAIT_V(4); PG8_BAR;
    PG8_STAGE(PG8_SB(1, 0), cB + kstep, voffB); PG8_SCHED; PG8_STA(PG8_SA(1, 0), 0, kstep, false); PG8_SCHED; PG8_STAGE(PG8_SB(1, 1), cB + hstep + kstep, voffB); PG8_SCHED;
    PG8_WAIT_V(6); PG8_BAR;
    for (;;) {
        const bool has_next = S.next(ui + 1, nxt);
        const char* nB = cB; nA = cA;
        if (has_next) { if constexpr (DN) nA = Abase + (size_t)S.a_row(nxt, 0) * K * 2; else PG8_AOFF(nO, nxt); nB = S.b_ptr(nxt); }
        else if constexpr (!DN) {
#pragma unroll
            for (int h = 0; h < 2; ++h)
#pragma unroll
                for (int i = 0; i < 2; ++i) nO[h][i] = cO[h][i]; }
        for (int t = 0; t < nt; t += 2) {
            const bool last = (t == nt - 2);
            const size_t k1 = (size_t)(t + 1) * kstep, k2 = last ? 0 : (size_t)(t + 2) * kstep, k3 = k2 + kstep;
            const char* b2 = last ? nB : cB + (size_t)(t + 2) * kstep; const char* b3 = b2 + kstep;
            PG8_LDB(B0, 0, 0); PG8_SCHED; PG8_LDA(At, 0, 0); PG8_STA(PG8_SA(1, 1), 1, k1, false);
            PG8_WAIT_L(8); PG8_BAR; PG8_WAIT_L(0); PG8_MMA(0, 0, At, B0); PG8_BAR; PG8_SCHED;
            PG8_LDB(B1, 0, 1); PG8_STAGE(PG8_SB(0, 0), b2, voffB);
            PG8_BAR; PG8_WAIT_L(0); PG8_MMA(0, 1, At, B1); PG8_BAR;
            PG8_LDA(At, 0, 1); PG8_STA(PG8_SA(0, 0), 0, k2, last);
            PG8_BAR; PG8_WAIT_L(0); PG8_MMA(1, 0, At, B0); PG8_BAR; PG8_SCHED;
            PG8_STAGE(PG8_SB(0, 1), b2 + hstep, voffB);
            PG8_WAIT_V(6); PG8_BAR; PG8_MMA(1, 1, At, B1); PG8_BAR;
            PG8_LDB(B0, 1, 0); PG8_SCHED; PG8_LDA(At, 1, 0); PG8_STA(PG8_SA(0, 1), 1, k2, last);
            PG8_WAIT_L(8); PG8_BAR; PG8_WAIT_L(0); PG8_MMA(0, 0, At, B0); PG8_BAR; PG8_SCHED;
            PG8_LDB(B1, 1, 1); PG8_STAGE(PG8_SB(1, 0), b3, voffB);
            PG8_BAR; PG8_WAIT_L(0); PG8_MMA(0, 1, At, B1); PG8_BAR;
            PG8_LDA(At, 1, 1); PG8_STA(PG8_SA(1, 0), 0, k3, last);
            PG8_BAR; PG8_WAIT_L(0); PG8_MMA(1, 0, At, B0); PG8_BAR; PG8_SCHED;
            PG8_STAGE(PG8_SB(1, 1), b3 + hstep, voffB);
            PG8_WAIT_V(6); PG8_BAR; PG8_MMA(1, 1, At, B1); PG8_BAR;
        }
        E(acc, cur, wid);
        if (!has_next) break;
#pragma unroll
        for (int a = 0; a < 2; ++a)
#pragma unroll
            for (int b = 0; b < 2; ++b)
#pragma unroll
                for (int m = 0; m < 4; ++m)
#pragma unroll
                    for (int n = 0; n < 2; ++n) acc[a][b][m][n] = (f32x4){0.f, 0.f, 0.f, 0.f};
        cur = nxt; cB = nB; cA = nA; ++ui;
        if constexpr (!DN) {
#pragma unroll
        for (int h = 0; h < 2; ++h)
#pragma unroll
            for (int i = 0; i < 2; ++i) cO[h][i] = nO[h][i]; }
    }
    PG8_WAIT_V(0);
    if (wr == 0) PG8_BAR;
    PG8_BAR;
#undef PG8_SA
#undef PG8_SB
#undef PG8_STAGE
#undef PG8_LDA
#undef PG8_LDB
#undef PG8_MMA
#undef PG8_WAIT_V
#undef PG8_WAIT_L
#undef PG8_BAR
#undef PG8_SCHED
#undef PG8_AOFF
#undef PG8_STA
}
}
struct DenseSched {
    static constexpr bool DENSE = true;
    int nM, nN, nwg, G, c, K; const char* Bt;
    __device__ __forceinline__ void init(int M, int N, int K_, const bf16_t* Bt_, int G_, int c_) { nM = M / 256; nN = N / 256; nwg = nM * nN; G = G_; c = c_; K = K_; Bt = (const char*)Bt_; }
    __device__ __forceinline__ bool next(int i, pg8::Unit& u) const {
        const long L = (long)i * G + c; if (L >= nwg) return false;
        int wgid = (int)L; { const int q = nwg / 8, r = nwg % 8, xcd = wgid % 8, off = wgid / 8; wgid = (xcd < r ? xcd * (q + 1) : r * (q + 1) + (xcd - r) * q) + off; }
        const int nig = 8 * nN, gid = wgid / nig, fm = gid * 8, gsz = (nM - fm) < 8 ? (nM - fm) : 8;
        u.pm = fm + ((wgid % nig) % gsz); u.pn = (wgid % nig) / gsz; u.e = 0; u.r0 = 0; return true;
    }
    __device__ __forceinline__ int a_row(const pg8::Unit& u, int r) const { return u.pm * 256 + r; }
    __device__ __forceinline__ const char* b_ptr(const pg8::Unit& u) const { return Bt + (size_t)u.pn * 256 * K * 2; }
};
template <bool GATHER> struct MoeSched {
    static constexpr bool DENSE = !GATHER;
    const LAS int* tstart; const LAS int* cnt; int nN, G, c, K, row_lo; const int* ltok; const char* Bt; size_t bstride;
    __device__ __forceinline__ bool next(int i, pg8::Unit& u) const {
        const long L = (long)i * G + c; const int ntile = __builtin_amdgcn_readfirstlane(tstart[NE1]); if (L >= (long)ntile * nN) return false;
        const int tile = (int)(L / nN); u.pn = (int)(L % nN);
        int e = 0;
#pragma unroll 1
        for (int step = 64; step >= 1; step >>= 1) { const int e2 = e + step; if (e2 <= NE && tstart[e2] <= tile) e = e2; }
        e = __builtin_amdgcn_readfirstlane(e); u.e = e; u.pm = __builtin_amdgcn_readfirstlane(tile); u.pn = __builtin_amdgcn_readfirstlane(u.pn); u.r0 = __builtin_amdgcn_readfirstlane((tile - tstart[e]) * 256); return true;
    }
    __device__ __forceinline__ int a_row(const pg8::Unit& u, int r) const {
        if (!GATHER) return u.pm * 256 + r;
        const int ri = u.r0 + r;
        if (u.e == NE) return ri < cnt[NE] ? row_lo + ri : row_lo;
        return ri < cnt[u.e] ? ltok[(size_t)u.e * ROWS + ri] : row_lo;
    }
    __device__ __forceinline__ const char* b_ptr(const pg8::Unit& u) const { return Bt + (size_t)u.e * bstride + (size_t)u.pn * 256 * K * 2; }
};

struct EpiProj {
    static constexpr bool PERM = true;
    bf16_t* O; int ldc;
    __device__ __forceinline__ void operator()(const f32x4 (&acc)[2][2][4][2], const pg8::Unit& u, const int wid) const {
        const int lane_ = lane_id_asm(), fr = lane_ & 15, fq = lane_ >> 4, wr = wid >> 2, wc = wid & 3;
        const int row0 = u.pm * 256 + wr * 64 + fr, col0 = u.pn * 256 + wc * 32 + 8 * fq;
#pragma unroll
        for (int ai = 0; ai < 2; ++ai)
#pragma unroll
            for (int m = 0; m < 4; ++m) { bf16_t* rowp = O + (size_t)(row0 + ai * 128 + m * 16) * ldc + col0;
#pragma unroll
                for (int bj = 0; bj < 2; ++bj) { const f32x4 v0 = acc[ai][bj][m][0], v1 = acc[ai][bj][m][1];
                    u32x4 w; w.x = pg8::cvt_pk_bf16(v0[0], v0[1]); w.y = pg8::cvt_pk_bf16(v0[2], v0[3]); w.z = pg8::cvt_pk_bf16(v1[0], v1[1]); w.w = pg8::cvt_pk_bf16(v1[2], v1[3]);
                    *(u32x4*)(rowp + bj * 128) = w; } }
    }
};
struct EpiRes {
    static constexpr bool PERM = false;
    const float* xsrc; const float* csrc; float* xdst; float* cdst; const float* gate;
    __device__ __forceinline__ void operator()(const f32x4 (&acc)[2][2][4][2], const pg8::Unit& u, const int wid) const {
        const int lane_ = lane_id_asm(), fr = lane_ & 15, fq = lane_ >> 4, wr = wid >> 2, wc = wid & 3;
        const int col0 = u.pn * 256 + wc * 32 + 4 * fq;
        const bool isc = u.pm < 4; const int sel = isc ? 4 : (u.pm - 4) >> 5;
        const float* src = isc ? csrc + (size_t)u.pm * 256 * D : xsrc + (size_t)(u.pm - 4) * 256 * D;
        float* dst = isc ? cdst + (size_t)u.pm * 256 * D : xdst + (size_t)(u.pm - 4) * 256 * D;
        f32x4 gv[2][2];
#pragma unroll
        for (int bj = 0; bj < 2; ++bj)
#pragma unroll
            for (int n = 0; n < 2; ++n) gv[bj][n] = *(const f32x4*)(gate + sel * 6144 + col0 + bj * 128 + n * 16);
#pragma unroll
        for (int ai = 0; ai < 2; ++ai)
#pragma unroll
            for (int m = 0; m < 4; ++m) { const size_t off = (size_t)(ai * 128 + wr * 64 + m * 16 + fr) * D + col0;
#pragma unroll
                for (int bj = 0; bj < 2; ++bj)
#pragma unroll
                    for (int n = 0; n < 2; ++n) { const f32x4 s = *(const f32x4*)(src + off + bj * 128 + n * 16); *(f32x4*)(dst + off + bj * 128 + n * 16) = s + gv[bj][n] * acc[ai][bj][m][n]; }
                asm volatile("" ::: "memory"); }
    }
};
struct EpiGU {
    static constexpr bool PERM = false;
    bf16_t* H;
    __device__ __forceinline__ void operator()(const f32x4 (&acc)[2][2][4][2], const pg8::Unit& u, const int wid) const {
        const int lane_ = lane_id_asm(), fr = lane_ & 15, fq = lane_ >> 4, wr = wid >> 2, wc = wid & 3;
        const int row0 = u.pm * 256 + wr * 64 + fr;
#pragma unroll
        for (int ai = 0; ai < 2; ++ai)
#pragma unroll
            for (int m = 0; m < 4; ++m) { bf16_t* rowp = H + (size_t)(row0 + ai * 128 + m * 16) * EH + 4 * fq;
#pragma unroll
                for (int bj = 0; bj < 2; ++bj) { const f32x4 g = acc[ai][bj][m][0], up = acc[ai][bj][m][1]; float h[4];
#pragma unroll
                    for (int j = 0; j < 4; ++j) h[j] = g[j] / (1.0f + __expf(-g[j])) * up[j];
                    u32x2 w; w.x = pg8::cvt_pk_bf16(h[0], h[1]); w.y = pg8::cvt_pk_bf16(h[2], h[3]);
                    *(u32x2*)(rowp + (u.pn * 256 + bj * 128 + wc * 32) / 2) = w; } }
    }
};
struct EpiY {
    static constexpr bool PERM = true;
    bf16_t* Y;
    __device__ __forceinline__ void operator()(const f32x4 (&acc)[2][2][4][2], const pg8::Unit& u, const int wid) const {
        const int lane_ = lane_id_asm(), fr = lane_ & 15, fq = lane_ >> 4, wr = wid >> 2, wc = wid & 3;
        const int row0 = u.pm * 256 + wr * 64 + fr, col0 = u.pn * 256 + wc * 32 + 8 * fq;
#pragma unroll
        for (int ai = 0; ai < 2; ++ai)
#pragma unroll
            for (int m = 0; m < 4; ++m) { bf16_t* rowp = Y + (size_t)(row0 + ai * 128 + m * 16) * 512 + col0;
#pragma unroll
                for (int bj = 0; bj < 2; ++bj) { const f32x4 v0 = acc[ai][bj][m][0], v1 = acc[ai][bj][m][1];
                    u32x4 w; w.x = pg8::cvt_pk_bf16(v0[0], v0[1]); w.y = pg8::cvt_pk_bf16(v0[2], v0[3]); w.z = pg8::cvt_pk_bf16(v1[0], v1[1]); w.w = pg8::cvt_pk_bf16(v1[2], v1[3]);
                    *(u32x4*)(rowp + bj * 128) = w; } }
    }
};
#define WSP(T, off) ((T*)(p.ws + (off)))

__device__ __forceinline__ void conv_tile(const int t, LAS float* tl, const float* __restrict__ src, int ldsrc, int k0, int n0, int nvalid, bf16_t* dst, int lddst, int mode) {
#pragma unroll
    for (int j = 0; j < 8; ++j) { const int idx = t + NTHR * j, k = idx >> 6, n = idx & 63; float v = 0.f; if (n0 + n < nvalid) v = src[(size_t)(k0 + k) * ldsrc + n0 + n]; tl[k * 65 + n] = v; }
    __syncthreads();
#pragma unroll
    for (int j = 0; j < 4; ++j) { const int pi = t + NTHR * j, n = pi >> 5, k = (pi & 31) * 2; const int nn = n0 + n;
        const int row = (mode == 0 || mode == 3) ? nn : ((nn >> 4) * 32 + (nn & 15) + (mode == 2 ? 16 : 0));
        float v0 = tl[k * 65 + n], v1 = tl[(k + 1) * 65 + n];
        if (mode == 3) { v0 -= bf2f((bf16_t)f2bf(v0)); v1 -= bf2f((bf16_t)f2bf(v1)); }
        *(unsigned*)(dst + (size_t)row * lddst + k0 + k) = pk2(v0, v1); }
    __syncthreads();
}
constexpr int CONV_A_UNITS = 2048 + 512 + 64;
__device__ __forceinline__ void conv_unit_A(const Cx& p, LAS float* tl, int u) {
    if (u < 2048) { const int l = u >> 10, r = u & 1023; conv_tile(p.tid, tl, PIN(I_WIN) + (size_t)l * D * INW, INW, (r >> 6) * 64, (r & 63) * 64, INW, WSP(bf16_t, WS_WIN) + (size_t)l * NPROJ * D, D, 0); }
    else if (u < 2560) { const int v = u - 2048, l = v >> 8, r = v & 255; conv_tile(p.tid, tl, PIN(I_WOUT) + (size_t)l * D * D, D, (r >> 4) * 64, (r & 15) * 64, D, WSP(bf16_t, WS_WOUT) + (size_t)l * D * D, D, 0); }
    else { const int v = u - 2560, l = v >> 5, lo = (v >> 4) & 1, r = v & 15; conv_tile(p.tid, tl, PIN(I_ROUT_W) + (size_t)l * D * NE, NE, r * 64, 0, NE, WSP(bf16_t, WS_ROUT) + (size_t)(l * 2 + lo) * NE * D, D, lo ? 3 : 0); }
}
constexpr int CONV_E_UNITS = NE1 * 192;
struct ConvDesc { const float* src; bf16_t* dst; int ldsrc, lddst, k0, n0, mode; };
__device__ __forceinline__ ConvDesc conv_desc_E(const Cx& p, int l, int u) {
    ConvDesc c; const int e = u / 192, r = u % 192;
    if (r < 128) { const int up = r >> 6, q = r & 63;
        c.src = e < NE ? PIN(up ? I_EXP_U : I_EXP_G) + ((size_t)l * NE + e) * D * EH : PIN(up ? I_SH_U : I_SH_G) + (size_t)l * D * EH;
        c.ldsrc = EH; c.k0 = (q >> 2) * 64; c.n0 = (q & 3) * 64; c.dst = WSP(bf16_t, WS_EXPGU) + (size_t)e * 512 * D; c.lddst = D; c.mode = 1 + up; }
    else { const int q = r - 128;
        c.src = e < NE ? PIN(I_EXP_D) + ((size_t)l * NE + e) * EH * D : PIN(I_SH_D) + (size_t)l * EH * D;
        c.ldsrc = D; c.k0 = (q >> 4) * 64; c.n0 = (q & 15) * 64; c.dst = WSP(bf16_t, WS_EXPD) + (size_t)e * D * EH; c.lddst = EH; c.mode = 0; }
    return c;
}
__device__ __forceinline__ void conv_experts(const Cx& p, LAS float* tl, int l) {
    const int t = p.tid; int u = p.bid; if (u >= CONV_E_UNITS) return;
    float v[8]; ConvDesc c = conv_desc_E(p, l, u);
#pragma unroll
    for (int j = 0; j < 8; ++j) { const int idx = t + NTHR * j; v[j] = c.src[(size_t)(c.k0 + (idx >> 6)) * c.ldsrc + c.n0 + (idx & 63)]; }
    for (;;) {
#pragma unroll
        for (int j = 0; j < 8; ++j) { const int idx = t + NTHR * j; tl[(idx >> 6) * 65 + (idx & 63)] = v[j]; }
        __syncthreads();
        const int un = u + p.G; const bool more = un < CONV_E_UNITS; const ConvDesc cn = conv_desc_E(p, l, more ? un : u);
        if (more) {
#pragma unroll
            for (int j = 0; j < 8; ++j) { const int idx = t + NTHR * j; v[j] = cn.src[(size_t)(cn.k0 + (idx >> 6)) * cn.ldsrc + cn.n0 + (idx & 63)]; } }
#pragma unroll
        for (int j = 0; j < 4; ++j) { const int pi = t + NTHR * j, n = pi >> 5, k = (pi & 31) * 2; const int nn = c.n0 + n;
            const int row = c.mode == 0 ? nn : ((nn >> 4) * 32 + (nn & 15) + (c.mode == 2 ? 16 : 0));
            *(unsigned*)(c.dst + (size_t)row * c.lddst + c.k0 + k) = pk2(tl[k * 65 + n], tl[(k + 1) * 65 + n]); }
        __syncthreads();
        if (!more) break;
        c = cn; u = un;
    }
}
__device__ __forceinline__ void phase_mod(const Cx& p, LAS unsigned char* lds) {
    LAS float* sv = (LAS float*)lds; LAS float* red = sv + 5 * D;
    const int tid = p.tid;
    if (p.bid >= 192) return;
    for (int i = tid; i < 5 * D; i += NTHR) { const int j = i >> 10, k = i & 1023; const float c = j < 4 ? PIN(I_C)[j * D + k] : PIN(I_CCTX)[k]; sv[i] = siluf_(c); }
    __syncthreads();
    for (int u = p.bid; u < 192; u += p.G) {
        const int l = u / 96, cb = u % 96, kg = tid >> 6, cl = tid & 63;
        const float* w = PIN(I_WMOD) + (size_t)l * D * 6144 + cb * 64 + cl;
        float a0 = 0.f, a1 = 0.f, a2 = 0.f, a3 = 0.f, a4 = 0.f;
#pragma unroll 8
        for (int kk = 0; kk < 128; ++kk) { const int k = kg * 128 + kk; const float wv = w[(size_t)k * 6144];
            a0 += sv[k] * wv; a1 += sv[D + k] * wv; a2 += sv[2 * D + k] * wv; a3 += sv[3 * D + k] * wv; a4 += sv[4 * D + k] * wv; }
        red[(kg * 5 + 0) * 64 + cl] = a0; red[(kg * 5 + 1) * 64 + cl] = a1; red[(kg * 5 + 2) * 64 + cl] = a2; red[(kg * 5 + 3) * 64 + cl] = a3; red[(kg * 5 + 4) * 64 + cl] = a4;
        __syncthreads();
        if (tid < 320) { const int j = tid >> 6; float s = 0.f;
#pragma unroll
            for (int g = 0; g < 8; ++g) s += red[(g * 5 + j) * 64 + cl];
            WSP(float, WS_MOD)[((size_t)l * 5 + j) * 6144 + cb * 64 + cl] = s + PIN(I_BMOD)[l * 6144 + cb * 64 + cl]; }
        __syncthreads();
    }
}
__device__ __forceinline__ const float* res_row(const Cx& p, int layer_src0, int r) {
    if (r < CROWS) return (layer_src0 ? PIN(I_CTX) : (const float*)WSP(float, WS_CTXRES)) + (size_t)r * D;
    return (layer_src0 ? PIN(I_X) : (const float*)p.out) + (size_t)(r - CROWS) * D;
}
__device__ __forceinline__ int row_sel(int r) { return r < CROWS ? 4 : (r - CROWS) >> 13; }

__device__ __forceinline__ void norm_ld(const float* src, f32x4 (&v)[4], int lane) {
#pragma unroll
    for (int i = 0; i < 4; ++i) v[i] = *(const f32x4*)(src + 256 * i + 4 * lane);
}
__device__ __forceinline__ void norm_fin(const f32x4 (&v)[4], const float* g, const float* shift, const float* scale, bf16_t* dst, const bool tolds, LAS bf16_t* ldst, LAS bf16_t* ldlo, int lane) {
    float ss = 0.f;
#pragma unroll
    for (int i = 0; i < 4; ++i) ss += v[i][0] * v[i][0] + v[i][1] * v[i][1] + v[i][2] * v[i][2] + v[i][3] * v[i][3];
    ss = wsum(ss); const float rstd = rsqrtf(ss * (1.0f / D) + 1e-6f);
#pragma unroll
    for (int i = 0; i < 4; ++i) { const int col = 256 * i + 4 * lane; const f32x4 gv = *(const f32x4*)(g + col), sh = *(const f32x4*)(shift + col), sc = *(const f32x4*)(scale + col);
        const f32x4 y = v[i] * rstd * gv * (sc + 1.0f) + sh; u32x2 w; w.x = pk2(y[0], y[1]); w.y = pk2(y[2], y[3]);
        *(u32x2*)(dst + col) = w;
        if (tolds) { *(LAS u32x2*)(ldst + col) = w; u32x2 wl;
            wl.x = pk2(y[0] - __uint_as_float(w.x << 16), y[1] - __uint_as_float(w.x & 0xffff0000u)); wl.y = pk2(y[2] - __uint_as_float(w.y << 16), y[3] - __uint_as_float(w.y & 0xffff0000u));
            *(LAS u32x2*)(ldlo + col) = wl; } }
}
__device__ __forceinline__ void phase_norm1(const Cx& p, int layer) {
    const int lane = p.tid & 63, wave = p.tid >> 6;
    const float* mod = WSP(float, WS_MOD) + (size_t)layer * 5 * 6144; const float* g = PIN(I_N1G) + layer * D; bf16_t* hb = WSP(bf16_t, WS_HBUF);
    for (int r = p.bid * 16 + wave * 2; r < ROWS; r += p.G * 16) { f32x4 v0[4], v1[4];
        norm_ld(res_row(p, layer == 0, r), v0, lane); norm_ld(res_row(p, layer == 0, r + 1), v1, lane);
        const int s0 = row_sel(r), s1 = row_sel(r + 1);
        norm_fin(v0, g, mod + s0 * 6144 + 0, mod + s0 * 6144 + 1024, hb + (size_t)r * D, false, (LAS bf16_t*)0, (LAS bf16_t*)0, lane);
        norm_fin(v1, g, mod + s1 * 6144 + 0, mod + s1 * 6144 + 1024, hb + (size_t)(r + 1) * D, false, (LAS bf16_t*)0, (LAS bf16_t*)0, lane); }
}
__device__ __forceinline__ void phase_prep(const Cx& p, LAS unsigned char* lds, int layer, int b) {
    const int lane = p.tid & 63, wave = __builtin_amdgcn_readfirstlane(p.tid >> 6);
    const bf16_t* proj = WSP(bf16_t, WS_PROJ);
    if (p.bid < SB / 33) {
        LAS float* wl = (LAS float*)lds;
        { const float* AW = PIN(I_RW_AW2) + (size_t)layer * 32 * 256; const float* WW = PIN(I_RW_W2) + (size_t)layer * 2 * 32 * 256;
          for (int i = p.tid; i < 96 * 256; i += NTHR) wl[i] = i < 32 * 256 ? AW[i] : WW[i - 32 * 256]; }
        __syncthreads();
        const int h = wave & 3, half = wave >> 2, c = 64 * h + lane;
        const float a0 = PIN(I_RW_A0)[layer * 256 + c], w0f = PIN(I_RW_W0)[(layer * 2 + 0) * 256 + c], w0b = PIN(I_RW_W0)[(layer * 2 + 1) * 256 + c];
        const float kkm = PIN(I_RW_KK)[layer * 256 + c], kam = PIN(I_RW_KA)[layer * 256 + c];
        for (int u = p.bid; u < SB / 33; u += p.G) {
#pragma unroll 1
            for (int i0 = 0; i0 < (half ? 15 : 18); i0 += 3) {
                float xa[3], xf[3], xb[3], kv[3], sa[3], sf[3], sb[3];
#pragma unroll
                for (int t = 0; t < 3; ++t) { const bf16_t* pr = proj + (size_t)tok_row(b, u * 33 + half * 18 + i0 + t) * NPROJ; xa[t] = 0.f; xf[t] = 0.f; xb[t] = 0.f;
                    if (lane < 32) { xa[t] = bf2f(pr[PB_A + lane]); xf[t] = bf2f(pr[PB_WF + lane]); xb[t] = bf2f(pr[PB_WB + lane]); }
                    kv[t] = bf2f(pr[PB_K + c]); sa[t] = a0; sf[t] = w0f; sb[t] = w0b; }
#pragma unroll
                for (int t = 0; t < 3; ++t) { xf[t] = tanhf_(xf[t]); xb[t] = tanhf_(xb[t]); }
#pragma unroll 4
                for (int j = 0; j < 32; ++j) { const float wa = wl[j * 256 + c], wf = wl[(32 + j) * 256 + c], wb = wl[(64 + j) * 256 + c];
#pragma unroll
                    for (int t = 0; t < 3; ++t) { sa[t] += rl(xa[t], j) * wa; sf[t] += rl(xf[t], j) * wf; sb[t] += rl(xb[t], j) * wb; } }
#pragma unroll
                for (int t = 0; t < 3; ++t) { const int s = u * 33 + half * 18 + i0 + t; const float a = sigmoidf_(sa[t]);
                    const float lwf = -__expf(-softplusf_(-sf[t]) - 0.5f), lwb = -__expf(-softplusf_(-sb[t]) - 0.5f);
                    const float kr = kv[t] * kkm; const float ss = wsum(kr * kr); const float kk = kr * rsqrtf(ss + 1e-6f);
                    const size_t o = (size_t)s * 256 + c;
                    WSP(float, SC_RK)[o] = kv[t] * (1.0f + (a - 1.0f) * kam); WSP(float, SC_RKK)[o] = kk; WSP(float, SC_RB)[o] = kk * a;
                    WSP(float, SC_RLW)[o] = lwf; WSP(float, SC_RLW)[(size_t)SB * 256 + o] = lwb; } }
        }
    }
    __syncthreads();
    { LAS bf16_t* T = (LAS bf16_t*)lds; const int tid = p.tid;
#define PC_LOAD(uu, v, vh) do { const int mixer_ = (uu) / (NTB * 3), r2_ = (uu) % (NTB * 3), rb_ = r2_ / 3, colbase_ = (mixer_ ? PD_Q : PC_X) + 256 * (r2_ % 3); \
          _Pragma("unroll") for (int q = 0; q < 12; ++q) { const int e = tid + NTHR * q, rr = e >> 11, tok = (e >> 5) & 63, ch = (e & 31) * 8; v[q] = (u32x4){0u, 0u, 0u, 0u}; \
              if (rb_ < 4) { if (rr == 1) v[q] = *(const u32x4*)(proj + (size_t)(b * NCTX + 64 * rb_ + tok) * NPROJ + colbase_ + ch); } \
              else { const int gr = rb_ - 4 + rr - 1; if (gr >= 0 && gr < GRIDH) v[q] = *(const u32x4*)(proj + (size_t)(CROWS + b * SEQ + gr * 64 + tok) * NPROJ + colbase_ + ch); } } \
          vh = (u32x4){0u, 0u, 0u, 0u}; if (tid < 192) { const int rr = tid >> 6, side = (tid >> 5) & 1, ch = (tid & 31) * 8;       \
              if (rb_ < 4 && rr == 1) { const int tk = side ? 64 * (rb_ + 1) : 64 * rb_ - 1; if (tk >= 0 && tk < NCTX) vh = *(const u32x4*)(proj + (size_t)(b * NCTX + tk) * NPROJ + colbase_ + ch); } } } while (0)
      int u = p.bid;
      if (u < 2 * NTB * 3) { u32x4 v[12], vh; PC_LOAD(u, v, vh);
        for (;;) { const int mixer = u / (NTB * 3), r2 = u % (NTB * 3), rb = r2 / 3, third = r2 % 3;
#pragma unroll
          for (int q = 0; q < 12; ++q) { const int e = tid + NTHR * q, rr = e >> 11, tok = (e >> 5) & 63, ch = (e & 31) * 8; *(LAS u32x4*)(T + (rr * 66 + tok + 1) * 256 + ch) = v[q]; }
          if (tid < 192) { const int rr = tid >> 6, side = (tid >> 5) & 1, ch = (tid & 31) * 8; *(LAS u32x4*)(T + (rr * 66 + (side ? 65 : 0)) * 256 + ch) = vh; }
          __syncthreads();
          const int un = u + p.G; const bool more = un < 2 * NTB * 3;
          if (more) PC_LOAD(un, v, vh);
          { const int c = tid & 255, th = tid >> 8, chn = 256 * third + c; float w[9];
            const float* cw = (mixer ? PIN(I_DN_CW) : PIN(I_SS_CW)) + (size_t)layer * 9 * 768 + chn;
#pragma unroll
            for (int k = 0; k < 9; ++k) w[k] = cw[k * 768];
            const float bias = mixer ? 0.f : PIN(I_SS_CB)[layer * 768 + chn];
            bf16_t* dst = (mixer ? WSP(bf16_t, SC_DQ) : WSP(bf16_t, SC_SX)) + (size_t)(64 * rb) * 768 + chn;
#pragma unroll 2
            for (int tk = 0; tk < 32; ++tk) { const int x = 32 * th + tk; float acc = bias;
#pragma unroll
                for (int dy = 0; dy < 3; ++dy)
#pragma unroll
                    for (int dx = 0; dx < 3; ++dx) acc += w[dy * 3 + dx] * bf2f(T[(dy * 66 + x + dx) * 256 + c]);
                float y = siluf_(acc);
                if (mixer && third < 2) { const float ss = wsum(y * y); y *= rsqrtf(ss + 1e-6f); if (third == 0) y *= 0.125f; }
                dst[(size_t)x * 768] = (bf16_t)f2bf(y); } }
          __syncthreads();
          if (!more) break;
          u = un; } }
#undef PC_LOAD
      for (int e = p.bid * NTHR + tid; e < SB * 24; e += p.G * NTHR) { const int s = e / 24, q = e % 24; const bf16_t* pr = proj + (size_t)tok_row(b, s) * NPROJ;
          if (q < 8) { const int d = q >> 2, h = q & 3; WSP(float, SC_SDT)[(size_t)s * 8 + q] = softplusf_(bf2f(pr[PC_DF + q]) + PIN(I_SS_DTB)[(layer * 2 + d) * 4 + h]); }
          else if (q < 16) { WSP(float, SC_DG)[(size_t)s * 16 + (q - 8)] = sigmoidf_(bf2f(pr[PD_BF + (q - 8)])); }
          else { const int q2 = q - 16, d = q2 >> 2, h = q2 & 3; WSP(float, SC_DG)[(size_t)s * 16 + 8 + q2] = -__expf(PIN(I_DN_ALOG)[(layer * 2 + d) * 4 + h]) * softplusf_(bf2f(pr[PD_AF + q2]) + PIN(I_DN_DTB)[(layer * 2 + d) * 4 + h]); } }
    }
}
__device__ __forceinline__ void phase_scan(const Cx& p, LAS unsigned char* lds, int layer, int b);
__device__ __forceinline__ float sum8_(float v) { v += DPPF(v, 0xB1); v += DPPF(v, 0x4E); v += DPPF(v, 0x141); return v; }
__device__ __forceinline__ float sum16_(float v) { v = sum8_(v); v += DPPF(v, 0x140); return v; }
__device__ __forceinline__ void bf8_to_f(const u32x4 w, float (&f)[8]) {
#pragma unroll
    for (int q = 0; q < 4; ++q) { f[2 * q] = __uint_as_float(w[q] << 16); f[2 * q + 1] = __uint_as_float(w[q] & 0xffff0000u); } }
__device__ __forceinline__ void phase_post(const Cx& p, LAS unsigned char* lds, int layer, int b) {
    const int tid = p.tid, tsub = tid >> 7, c8 = (tid & 127) * 8, mixer = c8 >> 8, cm = c8 & 255, hh = cm >> 6;
    const bf16_t* proj = WSP(bf16_t, WS_PROJ); const bf16_t* of = WSP(bf16_t, SC_OF); const bf16_t* obk = WSP(bf16_t, SC_OB); bf16_t* yc = WSP(bf16_t, WS_HBUF);
    LAS float* GW = (LAS float*)lds; LAS float* SG = GW + 64 * 256;
    if ((int)p.bid < SB / 33) { const float* gsrc = PIN(I_RW_GW2) + (size_t)layer * 64 * 256; for (int i = tid; i < 64 * 256; i += NTHR) GW[i] = gsrc[i]; }
    float g0[8], g1[8], g2[8];
#pragma unroll
    for (int q = 0; q < 8; ++q) { const int c = cm + q; g0[q] = 0.f; g1[q] = 0.f; g2[q] = 0.f;
        if (mixer == 0) g0[q] = PIN(I_GLA_NG)[layer * 256 + c];
        else if (mixer == 1) { g0[q] = PIN(I_RW_LNG)[layer * 256 + c]; g1[q] = PIN(I_RW_LNB)[layer * 256 + c]; g2[q] = PIN(I_RW_RK)[layer * 256 + c]; }
        else if (mixer == 2) { g0[q] = PIN(I_SS_NG)[layer * 256 + c]; g1[q] = PIN(I_SS_D)[layer * 4 + hh]; }
        else g0[q] = PIN(I_DN_NG)[layer * 256 + c]; }
    for (int u = p.bid; u < SB / 33; u += p.G) {
#pragma unroll 1
        for (int t0 = 0; t0 < 33; t0 += 4) { const int tk = t0 + tsub; const bool live = tk < 33; const int s = u * 33 + (live ? tk : 32), row = tok_row(b, s);
            const bf16_t* pr = proj + (size_t)row * NPROJ; float o[8], a[8], y[8];
            { float t1[8], t2[8]; bf8_to_f(*(const u32x4*)(of + (size_t)s * 1024 + c8), t1); bf8_to_f(*(const u32x4*)(obk + (size_t)s * 1024 + c8), t2);
#pragma unroll
              for (int q = 0; q < 8; ++q) o[q] = t1[q] + t2[q]; }
            __syncthreads();
            if (mixer == 1 && hh == 0) { float gl[8]; bf8_to_f(*(const u32x4*)(pr + PB_G + cm), gl);
#pragma unroll
                for (int q = 0; q < 8; ++q) SG[tsub * 64 + cm + q] = sigmoidf_(gl[q]); }
            if (mixer == 0) { bf8_to_f(*(const u32x4*)(pr + PA_G + cm), a); float ss = 0.f;
#pragma unroll
                for (int q = 0; q < 8; ++q) ss += o[q] * o[q];
                const float rs = rsqrtf(sum8_(ss) * (1.0f / 64.0f) + 1e-6f);
#pragma unroll
                for (int q = 0; q < 8; ++q) y[q] = o[q] * rs * g0[q] * siluf_(a[q]);
            } else if (mixer == 3) { bf8_to_f(*(const u32x4*)(pr + PD_Z + cm), a); float ss = 0.f;
#pragma unroll
                for (int q = 0; q < 8; ++q) ss += o[q] * o[q];
                const float rs = rsqrtf(sum8_(ss) * (1.0f / 64.0f) + 1e-6f);
#pragma unroll
                for (int q = 0; q < 8; ++q) y[q] = o[q] * rs * g0[q] * siluf_(a[q]);
            } else if (mixer == 2) { float xs[8]; bf8_to_f(*(const u32x4*)(pr + PC_Z + cm), a); bf8_to_f(*(const u32x4*)(WSP(bf16_t, SC_SX) + (size_t)s * 768 + cm), xs); float ss = 0.f;
#pragma unroll
                for (int q = 0; q < 8; ++q) { y[q] = (o[q] + g1[q] * xs[q]) * siluf_(a[q]); ss += y[q] * y[q]; }
                const float rs = rsqrtf(sum16_(ss) * (1.0f / 128.0f) + 1e-6f);
#pragma unroll
                for (int q = 0; q < 8; ++q) y[q] *= rs * g0[q];
            } else { float rr[8], vv[8]; bf8_to_f(*(const u32x4*)(pr + PB_R + cm), rr); bf8_to_f(*(const u32x4*)(pr + PB_V + cm), vv);
                const f32x4 k0 = *(const f32x4*)(WSP(float, SC_RK) + (size_t)s * 256 + cm), k1 = *(const f32x4*)(WSP(float, SC_RK) + (size_t)s * 256 + cm + 4);
                float su = 0.f, bo = 0.f;
#pragma unroll
                for (int q = 0; q < 8; ++q) { su += o[q]; bo += rr[q] * (q < 4 ? k0[q & 3] : k1[q & 3]) * g2[q]; }
                const float mu = sum8_(su) * (1.0f / 64.0f); bo = sum8_(bo); float va = 0.f;
#pragma unroll
                for (int q = 0; q < 8; ++q) { o[q] -= mu; va += o[q] * o[q]; }
                const float rs = rsqrtf(sum8_(va) * (1.0f / 64.0f) + 64e-5f);
#pragma unroll
                for (int q = 0; q < 8; ++q) y[q] = o[q] * rs * g0[q] + g1[q] + bo * vv[q]; }
            __syncthreads();
            if (mixer == 1) { float gt[8];
#pragma unroll
                for (int q = 0; q < 8; ++q) gt[q] = 0.f;
#pragma unroll 4
                for (int j = 0; j < 64; ++j) { const float sg = SG[tsub * 64 + j]; const f32x4 w0 = *(const LAS f32x4*)(GW + j * 256 + cm), w1 = *(const LAS f32x4*)(GW + j * 256 + cm + 4);
                    gt[0] += sg * w0[0]; gt[1] += sg * w0[1]; gt[2] += sg * w0[2]; gt[3] += sg * w0[3]; gt[4] += sg * w1[0]; gt[5] += sg * w1[1]; gt[6] += sg * w1[2]; gt[7] += sg * w1[3]; }
#pragma unroll
                for (int q = 0; q < 8; ++q) y[q] *= gt[q]; }
            if (live) *(u32x4*)(yc + (size_t)row * D + c8) = (u32x4){pk2(y[0], y[1]), pk2(y[2], y[3]), pk2(y[4], y[5]), pk2(y[6], y[7])};
        }
    }
}
constexpr int N2_TILE = 32, N2_STRIDE = 2064;
__device__ __forceinline__ void phase_norm2(const Cx& p, LAS unsigned char* lds, int layer, int row_lo) {
    const int tid = p.tid, lane = tid & 63, wave = __builtin_amdgcn_readfirstlane(tid >> 6), fr = lane & 15, fq = lane >> 4;
    const float* mod = WSP(float, WS_MOD) + (size_t)layer * 5 * 6144; const float* g = PIN(I_N2G) + layer * D; bf16_t* hb = WSP(bf16_t, WS_HBUF);
    const bf16_t* rt = WSP(bf16_t, WS_ROUT) + (size_t)layer * 2 * NE * D;
    LAS float* lg = (LAS float*)(lds + 2 * N2_TILE * N2_STRIDE);
    unsigned* cnt = WSP(unsigned, WS_CTL) + CW_CNT + layer * 80 * 16; int* ltok = WSP(int, WS_LTOK); int* tokt = WSP(int, WS_TOKT);
    const float rbias = PIN(I_ROUT_B)[layer * NE + lane];
    const int nun = (ROWS - row_lo) / N2_TILE;
    for (int u = p.bid; u < nun; u += p.G) { const int r0 = row_lo + u * N2_TILE;
#pragma unroll 1
        for (int i = 0; i < 4; i += 2) { const int tr = 4 * wave + i, r = r0 + tr; f32x4 v0[4], v1[4];
            norm_ld(res_row(p, 0, r), v0, lane); norm_ld(res_row(p, 0, r + 1), v1, lane);
            const int s0 = row_sel(r), s1 = row_sel(r + 1);
            norm_fin(v0, g, mod + s0 * 6144 + 3072, mod + s0 * 6144 + 4096, hb + (size_t)r * D, true, (LAS bf16_t*)(lds + tr * N2_STRIDE), (LAS bf16_t*)(lds + N2_TILE * N2_STRIDE + tr * N2_STRIDE), lane);
            norm_fin(v1, g, mod + s1 * 6144 + 3072, mod + s1 * 6144 + 4096, hb + (size_t)(r + 1) * D, true, (LAS bf16_t*)(lds + (tr + 1) * N2_STRIDE), (LAS bf16_t*)(lds + N2_TILE * N2_STRIDE + (tr + 1) * N2_STRIDE), lane); }
        __syncthreads();
        { const int mt = wave >> 2, nt = wave & 3; f32x4 acc = (f32x4){0.f, 0.f, 0.f, 0.f};
          const LAS unsigned char* ap = lds + (16 * mt + fr) * N2_STRIDE + fq * 16; const bf16_t* bp = rt + (size_t)(16 * nt + fr) * D + fq * 8;
#pragma unroll 4
          for (int ks = 0; ks < 32; ++ks) { const bf16x8 a = *(const LAS bf16x8*)(ap + ks * 64), al = *(const LAS bf16x8*)(ap + N2_TILE * N2_STRIDE + ks * 64);
              const bf16x8 bb = *(const bf16x8*)(bp + ks * 32), bl = *(const bf16x8*)(bp + NE * D + ks * 32);
              acc = __builtin_amdgcn_mfma_f32_16x16x32_bf16(a, bb, acc, 0, 0, 0); acc = __builtin_amdgcn_mfma_f32_16x16x32_bf16(al, bb, acc, 0, 0, 0); acc = __builtin_amdgcn_mfma_f32_16x16x32_bf16(a, bl, acc, 0, 0, 0); }
#pragma unroll
          for (int j = 0; j < 4; ++j) lg[(16 * mt + 4 * fq + j) * 64 + 16 * nt + fr] = acc[j]; }
        __syncthreads();
#pragma unroll 1
        for (int i = 0; i < 4; ++i) { const int tr = 4 * wave + i, r = r0 + tr;
            const float sc = sigmoidf_(lg[tr * 64 + lane]); float sel = sc + rbias; float ssum = 0.f; int myE = 0; float myS = 0.f;
#pragma unroll 1
            for (int k = 0; k < TOPK; ++k) { float bv = sel; int bi = lane;
#define ARGSTEP(OV, OI) do { const float ov_ = (OV); const int oi_ = (OI); if (ov_ > bv || (ov_ == bv && oi_ < bi)) { bv = ov_; bi = oi_; } } while (0)
                ARGSTEP(DPPF(bv, 0xB1), DPPI(bi, 0xB1)); ARGSTEP(DPPF(bv, 0x4E), DPPI(bi, 0x4E)); ARGSTEP(DPPF(bv, 0x141), DPPI(bi, 0x141)); ARGSTEP(DPPF(bv, 0x140), DPPI(bi, 0x140));
                ARGSTEP(__uint_as_float(__builtin_amdgcn_ds_swizzle(__float_as_uint(bv), 0x401F)), __builtin_amdgcn_ds_swizzle(bi, 0x401F));
                { const float v0 = rl(bv, 0), v1 = rl(bv, 32); const int i0 = __builtin_amdgcn_readlane(bi, 0), i1 = __builtin_amdgcn_readlane(bi, 32); if (v1 > v0 || (v1 == v0 && i1 < i0)) { bv = v1; bi = i1; } else { bv = v0; bi = i0; } }
#undef ARGSTEP
                const int e = __builtin_amdgcn_readfirstlane(bi); const float se = rl(sc, e);
                ssum += se; if (lane == k) { myE = e; myS = se; } if (lane == e) sel = -1e30f; }
            if (lane < TOPK) { const unsigned pos = atomicAdd(cnt + myE * 16, 1u); ltok[(size_t)myE * ROWS + pos] = r; tokt[(size_t)r * 16 + lane] = (myE << 16) | (int)pos; ((float*)tokt)[(size_t)r * 16 + 8 + lane] = myS / ssum * 2.5f; } }
        __syncthreads();
    }
}
__device__ __forceinline__ void moe_table(const Cx& p, LAS int* tb, int layer, int row_lo) {
    const unsigned* cnt = WSP(unsigned, WS_CTL) + CW_CNT + layer * 80 * 16;
    if (p.tid == 0) { int acc = 0;
#pragma unroll 1
        for (int e = 0; e < NE1; ++e) { const int c = e < NE ? (int)__hip_atomic_load(cnt + e * 16, __ATOMIC_RELAXED, __HIP_MEMORY_SCOPE_AGENT) : ROWS - row_lo; tb[e] = c; tb[128 + e] = acc; acc += (c + 255) >> 8; }
        tb[128 + NE1] = acc; }
    __syncthreads();
}
__device__ __forceinline__ void phase_combine(const Cx& p, const LAS int* tb, int layer, int row_lo, int half) {
    const int lane = p.tid & 63, wave = p.tid >> 6; const bf16_t* Y = WSP(bf16_t, WS_Y); const int* tokt = WSP(int, WS_TOKT);
    const float* gate = WSP(float, WS_MOD) + (size_t)layer * 5 * 6144 + 5120; const int col = 512 * half + 8 * lane; const int shbase = tb[128 + NE] * 256;
#pragma unroll 2
    for (int r = row_lo + p.bid * 8 + wave; r < ROWS; r += p.G * 8) {
        const int sw = lane < 16 ? tokt[(size_t)r * 16 + lane] : 0;
        float a[8];
        { const u32x4 y = *(const u32x4*)(Y + (size_t)(shbase + (r - row_lo)) * 512 + 8 * lane);
#pragma unroll
          for (int q = 0; q < 4; ++q) { a[2 * q] = __uint_as_float(y[q] << 16); a[2 * q + 1] = __uint_as_float(y[q] & 0xffff0000u); } }
#pragma unroll
        for (int k = 0; k < 8; ++k) { const int sl = __builtin_amdgcn_readlane(sw, k); const float w = __uint_as_float(__builtin_amdgcn_readlane(sw, 8 + k));
            const int hrow = tb[128 + (sl >> 16)] * 256 + (sl & 0xffff); const u32x4 y = *(const u32x4*)(Y + (size_t)hrow * 512 + 8 * lane);
#pragma unroll
            for (int q = 0; q < 4; ++q) { a[2 * q] += w * __uint_as_float(y[q] << 16); a[2 * q + 1] += w * __uint_as_float(y[q] & 0xffff0000u); } }
        float* x = (float*)res_row(p, 0, r) + col; const float* gp = gate + row_sel(r) * 6144 + col;
#pragma unroll
        for (int q = 0; q < 2; ++q) { const f32x4 gv = *(const f32x4*)(gp + 4 * q); f32x4 xv = *(const f32x4*)(x + 4 * q);
            xv[0] += gv[0] * a[4 * q]; xv[1] += gv[1] * a[4 * q + 1]; xv[2] += gv[2] * a[4 * q + 2]; xv[3] += gv[3] * a[4 * q + 3]; *(f32x4*)(x + 4 * q) = xv; }
    }
}
__device__ __forceinline__ void phase_final(const Cx& p) {
    const int lane = p.tid & 63, wave = p.tid >> 6; const float* g = PIN(I_FNG);
    for (int r = p.bid * 16 + wave * 2; r < NB * SEQ; r += p.G * 16) { f32x4 v[2][4];
        norm_ld(p.out + (size_t)r * D, v[0], lane); norm_ld(p.out + (size_t)(r + 1) * D, v[1], lane);
#pragma unroll
        for (int q = 0; q < 2; ++q) { float* x = p.out + (size_t)(r + q) * D; float ss = 0.f;
#pragma unroll
            for (int i = 0; i < 4; ++i) ss += v[q][i][0] * v[q][i][0] + v[q][i][1] * v[q][i][1] + v[q][i][2] * v[q][i][2] + v[q][i][3] * v[q][i][3];
            ss = wsum(ss); const float rstd = rsqrtf(ss * (1.0f / D) + 1e-6f);
#pragma unroll
            for (int i = 0; i < 4; ++i) *(f32x4*)(x + 256 * i + 4 * lane) = v[q][i] * rstd * *(const f32x4*)(g + 256 * i + 4 * lane); } }
}
__device__ __forceinline__ int chain_tb(int n, int d) { return d == 0 ? n : (n < 4 ? 3 - n : 135 - n); }
__device__ __forceinline__ int tb_row0(int b, int tb) { return tb < 4 ? b * NCTX + 64 * tb : CROWS + b * SEQ + 64 * (tb - 4); }
constexpr int TS = 144;
template <int K, int NT> __device__ __forceinline__ void mm_rows(const LAS unsigned char* A, int lda, const LAS unsigned char* Bt, int ldb, int mt, int nt0, int fr, int fq, f32x4 (&acc)[NT]) {
#pragma unroll
    for (int ks = 0; ks < K / 32; ++ks) { const bf16x8 a = *(const LAS bf16x8*)(A + (16 * mt + fr) * lda + ks * 64 + fq * 16);
#pragma unroll
        for (int nt = 0; nt < NT; ++nt) { const bf16x8 bb = *(const LAS bf16x8*)(Bt + (16 * (nt0 + nt) + fr) * ldb + ks * 64 + fq * 16);
            acc[nt] = __builtin_amdgcn_mfma_f32_16x16x32_bf16(a, bb, acc[nt], 0, 0, 0); } }
}
#define UNIT_LOOP(u, N, OFF) for (int u = (p.bid + p.G - ((OFF) % p.G)) % p.G; u < (N); u += p.G)
__device__ __forceinline__ void gla_p1(const Cx& p, LAS unsigned char* lds, int layer, int b) {
    const int tid = p.tid, lane = tid & 63, wave = __builtin_amdgcn_readfirstlane(tid >> 6), fr = lane & 15, fq = lane >> 4;
    LAS unsigned char* ksT = lds; LAS unsigned char* vT = lds + 64 * TS; LAS float* gs = (LAS float*)(lds + 2 * 64 * TS); LAS float* glb = gs + 512;
    const bf16_t* proj = WSP(bf16_t, WS_PROJ); const int mt = wave >> 1, nt0 = (wave & 1) * 2;
    UNIT_LOOP(u, NUNIT, 0) { const int tb = u >> 3, h = (u >> 1) & 3, d = u & 1; const int cl = lane, tg = wave, c = 64 * h + cl;
        const bf16_t* pr0 = proj + (size_t)tb_row0(b, tb) * NPROJ;
        float w2[16];
#pragma unroll
        for (int r = 0; r < 16; ++r) w2[r] = PIN(I_GLA_W2)[((size_t)(layer * 2 + d) * 16 + r) * 256 + c];
        const float gb = PIN(I_GLA_B)[(layer * 2 + d) * 256 + c];
        { const int e = tid * 2, i = e >> 4, r = e & 15; const unsigned w = *(const unsigned*)(pr0 + (size_t)i * NPROJ + (d ? PA_GB : PA_GF) + r); glb[e] = __uint_as_float(w << 16); glb[e + 1] = __uint_as_float(w & 0xffff0000u); }
        __syncthreads();
        float bl[8]; float run = 0.f;
#pragma unroll
        for (int ii = 0; ii < 8; ++ii) { const int i8 = d ? 7 - ii : ii; const LAS float* gl_ = glb + (8 * tg + i8) * 16; float z = gb;
#pragma unroll
            for (int r = 0; r < 16; ++r) z += gl_[r] * w2[r];
            run += logsigmoidf_(z) * (1.0f / 16.0f); if (d) bl[7 - ii] = run; else bl[ii] = run; }
        bf16_t kq[8], vq[8];
#pragma unroll
        for (int i8 = 0; i8 < 8; ++i8) { const bf16_t* pa = pr0 + (size_t)(8 * tg + i8) * NPROJ; kq[i8] = pa[PA_K + c]; vq[i8] = pa[PA_V + c]; }
        gs[tg * 64 + cl] = run;
        __syncthreads();
        float off = 0.f, total = 0.f;
#pragma unroll
        for (int g2 = 0; g2 < 8; ++g2) { const float t = gs[g2 * 64 + cl]; total += t; if (d ? g2 > tg : g2 < tg) off += t; }
#pragma unroll
        for (int i8 = 0; i8 < 8; i8 += 2) { const int i = 8 * tg + i8;
            const float ka = bf2f(kq[i8]) * __expf(total - (bl[i8] + off)), kb = bf2f(kq[i8 + 1]) * __expf(total - (bl[i8 + 1] + off));
            *(LAS unsigned*)(ksT + cl * TS + i * 2) = pk2(ka, kb); *(LAS unsigned*)(vT + cl * TS + i * 2) = (unsigned)vq[i8] | ((unsigned)vq[i8 + 1] << 16); }
        if (tg == 0) WSP(float, SC_GLA_DEC)[(size_t)u * 64 + cl] = __expf(total);
        __syncthreads();
        { f32x4 acc[2] = {(f32x4){0.f, 0.f, 0.f, 0.f}, (f32x4){0.f, 0.f, 0.f, 0.f}}; float* kv = WSP(float, SC_GLA_S) + (size_t)u * 4096;
          mm_rows<64, 2>(ksT, TS, vT, TS, mt, nt0, fr, fq, acc);
#pragma unroll
          for (int t = 0; t < 2; ++t)
#pragma unroll
              for (int j = 0; j < 4; ++j) kv[(16 * mt + 4 * fq + j) * 64 + 16 * (nt0 + t) + fr] = acc[t][j]; }
        __syncthreads();
    }
}
__device__ __forceinline__ void gla_chain(const Cx& p, int h, int d, int part) {
    if (p.tid >= 256) return;
    const int e0 = part * 1024 + p.tid * 4, dk = e0 >> 6;
    f32x4 s0 = (f32x4){0.f, 0.f, 0.f, 0.f};
    f32x4 n0[6]; float dc[6];
#define GC_LD(q, n_) do { const int u_ = (chain_tb((n_), d) * 4 + h) * 2 + d; n0[q] = *(const f32x4*)(WSP(float, SC_GLA_S) + (size_t)u_ * 4096 + e0); dc[q] = WSP(float, SC_GLA_DEC)[(size_t)u_ * 64 + dk]; } while (0)
#define GC_ST(q, n_) do { const int u_ = (chain_tb((n_), d) * 4 + h) * 2 + d; float* k_ = WSP(float, SC_GLA_S) + (size_t)u_ * 4096 + e0; \
        const f32x4 a0_ = n0[q]; const float de_ = dc[q]; if ((n_) + 6 < NTB) GC_LD(q, (n_) + 6); *(f32x4*)k_ = s0; s0 = s0 * de_ + a0_; } while (0)
    GC_LD(0, 0); GC_LD(1, 1); GC_LD(2, 2); GC_LD(3, 3); GC_LD(4, 4); GC_LD(5, 5);
#pragma unroll 1
    for (int n = 0; n < NTB; n += 6) { GC_ST(0, n); GC_ST(1, n + 1); GC_ST(2, n + 2); GC_ST(3, n + 3); GC_ST(4, n + 4); GC_ST(5, n + 5); }
#undef GC_LD
#undef GC_ST
}
__device__ __forceinline__ void gla_p2(const Cx& p, LAS unsigned char* lds, int layer, int b) {
    const int tid = p.tid, lane = tid & 63, wave = __builtin_amdgcn_readfirstlane(tid >> 6), fr = lane & 15, fq = lane >> 4;
    LAS unsigned char* qt = lds; LAS unsigned char* kt = lds + 64 * TS; LAS unsigned char* vT = lds + 2 * 64 * TS; LAS unsigned char* sT = lds + 3 * 64 * TS; LAS unsigned char* att = lds + 4 * 64 * TS;
    LAS float* gs = (LAS float*)(lds + 5 * 64 * TS); LAS float* glb = gs + 512;
    const bf16_t* proj = WSP(bf16_t, WS_PROJ);
    UNIT_LOOP(u, NUNIT, 128) { const int tb = u >> 3, h = (u >> 1) & 3, d = u & 1; const int cl = tid & 63, tg = tid >> 6, c = 64 * h + cl;
        const int row0 = tb_row0(b, tb), s0 = 64 * tb; const bf16_t* pr0 = proj + (size_t)row0 * NPROJ;
        float w2[16];
#pragma unroll
        for (int r = 0; r < 16; ++r) w2[r] = PIN(I_GLA_W2)[((size_t)(layer * 2 + d) * 16 + r) * 256 + c];
        const float gb = PIN(I_GLA_B)[(layer * 2 + d) * 256 + c];
        { const int e = tid * 2, i = e >> 4, r = e & 15; const unsigned w = *(const unsigned*)(pr0 + (size_t)i * NPROJ + (d ? PA_GB : PA_GF) + r); glb[e] = __uint_as_float(w << 16); glb[e + 1] = __uint_as_float(w & 0xffff0000u); }
        __syncthreads();
        float bl[8]; float run = 0.f;
#pragma unroll
        for (int ii = 0; ii < 8; ++ii) { const int i8 = d ? 7 - ii : ii; const LAS float* gl_ = glb + (8 * tg + i8) * 16; float z = gb;
#pragma unroll
            for (int r = 0; r < 16; ++r) z += gl_[r] * w2[r];
            run += logsigmoidf_(z) * (1.0f / 16.0f); if (d) bl[7 - ii] = run; else bl[ii] = run; }
        bf16_t qq[8], kq[8], vq[8];
#pragma unroll
        for (int i8 = 0; i8 < 8; ++i8) { const bf16_t* pr = pr0 + (size_t)(8 * tg + i8) * NPROJ; qq[i8] = pr[PA_Q + c]; kq[i8] = pr[PA_K + c]; vq[i8] = pr[PA_V + c]; }
        gs[tg * 64 + cl] = run;
        { const float* sp = WSP(float, SC_GLA_S) + (size_t)u * 4096;
#pragma unroll
          for (int q = 0; q < 8; ++q) { const int e = tid + NTHR * q, dk = e >> 6, dv = e & 63; *(LAS bf16_t*)(sT + dv * TS + dk * 2) = (bf16_t)f2bf(sp[e]); } }
        __syncthreads();
        float off = 0.f;
#pragma unroll
        for (int g2 = 0; g2 < 8; ++g2) if (d ? g2 > tg : g2 < tg) off += gs[g2 * 64 + cl];
#pragma unroll
        for (int i8 = 0; i8 < 8; ++i8) { const int i = 8 * tg + i8; const float bi = bl[i8] + off;
            *(LAS bf16_t*)(qt + i * TS + cl * 2) = (bf16_t)f2bf(bf2f(qq[i8]) * 0.125f * __expf(bi));
            *(LAS bf16_t*)(kt + i * TS + cl * 2) = (bf16_t)f2bf(bf2f(kq[i8]) * __expf(-bi));
            *(LAS bf16_t*)(vT + cl * TS + i * 2) = vq[i8]; }
        __syncthreads();
        const int mt = wave >> 1, nt0 = (wave & 1) * 2;
        { f32x4 acc[2] = {(f32x4){0.f, 0.f, 0.f, 0.f}, (f32x4){0.f, 0.f, 0.f, 0.f}};
          mm_rows<64, 2>(qt, TS, kt, TS, mt, nt0, fr, fq, acc);
#pragma unroll
          for (int t = 0; t < 2; ++t)
#pragma unroll
              for (int j = 0; j < 4; ++j) { const int i = 16 * mt + 4 * fq + j, jj = 16 * (nt0 + t) + fr; const bool keep = d ? jj >= i : jj <= i;
                  *(LAS bf16_t*)(att + i * TS + jj * 2) = (bf16_t)f2bf(keep ? acc[t][j] : 0.f); } }
        __syncthreads();
        { f32x4 acc[2] = {(f32x4){0.f, 0.f, 0.f, 0.f}, (f32x4){0.f, 0.f, 0.f, 0.f}};
          mm_rows<64, 2>(att, TS, vT, TS, mt, nt0, fr, fq, acc);
          mm_rows<64, 2>(qt, TS, sT, TS, mt, nt0, fr, fq, acc);
          bf16_t* ob = WSP(bf16_t, d ? SC_OB : SC_OF);
#pragma unroll
          for (int t = 0; t < 2; ++t)
#pragma unroll
              for (int j = 0; j < 4; ++j) ob[(size_t)(s0 + 16 * mt + 4 * fq + j) * 1024 + 64 * h + 16 * (nt0 + t) + fr] = (bf16_t)f2bf(acc[t][j]); }
        __syncthreads();
    }
}
constexpr int TS2 = 272;
__device__ __forceinline__ float ssd_acum(float a, int d, int lane, float& total) {
    float pre = a;
#pragma unroll
    for (int o = 1; o < 64; o <<= 1) { const float t = shup_(pre, lane, o); if (lane >= o) pre += t; }
    total = rl(pre, 63);
    return d ? total - pre + a : pre;
}
__device__ __forceinline__ void ssd_p1(const Cx& p, LAS unsigned char* lds, int layer, int b) {
    const int tid = p.tid, lane = tid & 63, wave = __builtin_amdgcn_readfirstlane(tid >> 6), fr = lane & 15, fq = lane >> 4;
    LAS unsigned char* BT = lds; LAS unsigned char* xT = lds + 128 * TS; LAS float* AC = (LAS float*)(lds + 128 * TS + 64 * TS);
    UNIT_LOOP(u3, NTB * 8, 32) { const int tb = u3 >> 3, g = (u3 >> 2) & 1, hd = u3 & 3, h = 2 * g + (hd >> 1), d = hd & 1, s0 = 64 * tb;
        const bf16_t* sx = WSP(bf16_t, SC_SX) + (size_t)s0 * 768; const float* sdt = WSP(float, SC_SDT) + (size_t)s0 * 8;
        if (wave == 0) { const float aneg = -__expf(PIN(I_SS_ALOG)[(layer * 2 + d) * 4 + h]);
            float tot; const float ac = ssd_acum(aneg * sdt[lane * 8 + d * 4 + h], d, lane, tot); AC[lane] = ac; if (lane == 0) { AC[64] = tot; WSP(float, SC_SSD_CD)[(tb * 4 + h) * 2 + d] = __expf(tot); } }
#pragma unroll 2
        for (int q = 0; q < 16; ++q) { const int e = tid + NTHR * q, i = e >> 7, s = e & 127; *(LAS bf16_t*)(BT + s * TS + i * 2) = sx[(size_t)i * 768 + 256 + 128 * g + s]; }
        __syncthreads();
#pragma unroll 2
        for (int q = 0; q < 8; ++q) { const int e = tid + NTHR * q, i = e >> 6, pp = e & 63;
            const float x = bf2f(sx[(size_t)i * 768 + 64 * h + pp]) * sdt[i * 8 + d * 4 + h] * __expf(AC[64] - AC[i]);
            *(LAS bf16_t*)(xT + pp * TS + i * 2) = (bf16_t)f2bf(x); }
        __syncthreads();
        { const int mt = wave >> 1, nt0 = (wave & 1) * 4; float* cs = WSP(float, SC_SSD_S) + (size_t)((tb * 4 + h) * 2 + d) * 8192; f32x4 acc[4];
#pragma unroll
          for (int t = 0; t < 4; ++t) acc[t] = (f32x4){0.f, 0.f, 0.f, 0.f};
          mm_rows<64, 4>(xT, TS, BT, TS, mt, nt0, fr, fq, acc);
#pragma unroll
          for (int t = 0; t < 4; ++t)
#pragma unroll
              for (int j = 0; j < 4; ++j) cs[(16 * mt + 4 * fq + j) * 128 + 16 * (nt0 + t) + fr] = acc[t][j]; }
        __syncthreads();
    }
}
__device__ __forceinline__ void ssd_chain(const Cx& p, int h, int d, int part) {
    if (p.tid >= 256) return;
    const int e0 = part * 1024 + p.tid * 4;
    f32x4 s = (f32x4){0.f, 0.f, 0.f, 0.f}; f32x4 nx[6]; float cd[6];
#define SC_LD(q, n_) do { const int u_ = (chain_tb((n_), d) * 4 + h) * 2 + d; nx[q] = *(const f32x4*)(WSP(float, SC_SSD_S) + (size_t)u_ * 8192 + e0); cd[q] = WSP(float, SC_SSD_CD)[u_]; } while (0)
#define SC_ST(q, n_) do { const int u_ = (chain_tb((n_), d) * 4 + h) * 2 + d; float* c_ = WSP(float, SC_SSD_S) + (size_t)u_ * 8192 + e0; const f32x4 a_ = nx[q]; const float de_ = cd[q]; \
        if ((n_) + 6 < NTB) SC_LD(q, (n_) + 6); *(f32x4*)c_ = s; s = s * de_ + a_; } while (0)
    SC_LD(0, 0); SC_LD(1, 1); SC_LD(2, 2); SC_LD(3, 3); SC_LD(4, 4); SC_LD(5, 5);
#pragma unroll 1
    for (int n = 0; n < NTB; n += 6) { SC_ST(0, n); SC_ST(1, n + 1); SC_ST(2, n + 2); SC_ST(3, n + 3); SC_ST(4, n + 4); SC_ST(5, n + 5); }
#undef SC_LD
#undef SC_ST
}
__device__ __forceinline__ void ssd_p2(const Cx& p, LAS unsigned char* lds, int layer, int b) {
    const int tid = p.tid, lane = tid & 63, wave = __builtin_amdgcn_readfirstlane(tid >> 6), fr = lane & 15, fq = lane >> 4;
    LAS unsigned char* Ct = lds; LAS unsigned char* Bt2 = lds + 64 * TS2; LAS float* cb = (LAS float*)(lds + 2 * 64 * TS2); LAS float* AC = cb + 64 * 65;
    LAS unsigned char* Mt = (LAS unsigned char*)(AC + 64 + 4); LAS unsigned char* xT = Mt + 64 * TS; LAS unsigned char* Sb = xT + 64 * TS;
    const int mt = wave >> 1, nt0 = (wave & 1) * 2;
    UNIT_LOOP(u3, NTB * 8, 160) { const int tb = u3 >> 3, g = (u3 >> 2) & 1, hd = u3 & 3, h = 2 * g + (hd >> 1), d = hd & 1, s0 = 64 * tb;
        const bf16_t* sx = WSP(bf16_t, SC_SX) + (size_t)s0 * 768; const float* sdt = WSP(float, SC_SDT) + (size_t)s0 * 8;
        if (wave == 0) { const float aneg = -__expf(PIN(I_SS_ALOG)[(layer * 2 + d) * 4 + h]); float tot; AC[lane] = ssd_acum(aneg * sdt[lane * 8 + d * 4 + h], d, lane, tot); }
#pragma unroll
        for (int q = 0; q < 2; ++q) { const int e = tid + NTHR * q, i = e >> 4, ch = e & 15;
            *(LAS u32x4*)(Ct + i * TS2 + ch * 16) = *(const u32x4*)(sx + (size_t)i * 768 + 512 + 128 * g + ch * 8);
            *(LAS u32x4*)(Bt2 + i * TS2 + ch * 16) = *(const u32x4*)(sx + (size_t)i * 768 + 256 + 128 * g + ch * 8); }
#pragma unroll 2
        for (int q = 0; q < 8; ++q) { const int e = tid + NTHR * q, j = e >> 6, pp = e & 63;
            *(LAS bf16_t*)(xT + pp * TS + j * 2) = (bf16_t)f2bf(bf2f(sx[(size_t)j * 768 + 64 * h + pp]) * sdt[j * 8 + d * 4 + h]); }
        { const float* sp = WSP(float, SC_SSD_S) + (size_t)((tb * 4 + h) * 2 + d) * 8192;
#pragma unroll
          for (int q = 0; q < 4; ++q) { const int e = (tid + NTHR * q) * 4, pp = e >> 7, s = e & 127; const f32x4 v = *(const f32x4*)(sp + e);
              *(LAS u32x2*)(Sb + pp * TS2 + s * 2) = (u32x2){pk2(v[0], v[1]), pk2(v[2], v[3])}; } }
        __syncthreads();
        { f32x4 acc[2] = {(f32x4){0.f, 0.f, 0.f, 0.f}, (f32x4){0.f, 0.f, 0.f, 0.f}};
          mm_rows<128, 2>(Ct, TS2, Bt2, TS2, mt, nt0, fr, fq, acc);
#pragma unroll
          for (int t = 0; t < 2; ++t)
#pragma unroll
              for (int j = 0; j < 4; ++j) cb[(16 * mt + 4 * fq + j) * 65 + 16 * (nt0 + t) + fr] = acc[t][j]; }
        __syncthreads();
        { const int i = tid >> 3, j0 = (tid & 7) * 8; const float ai = AC[i]; unsigned w[4];
#pragma unroll
          for (int jj = 0; jj < 8; jj += 2) { float m[2];
#pragma unroll
              for (int q = 0; q < 2; ++q) { const int j = j0 + jj + q; const bool keep = d ? j >= i : j <= i; m[q] = keep ? cb[i * 65 + j] * __expf(ai - AC[j]) : 0.f; }
              w[jj >> 1] = pk2(m[0], m[1]); }
          *(LAS u32x4*)(Mt + i * TS + j0 * 2) = (u32x4){w[0], w[1], w[2], w[3]}; }
        __syncthreads();
        { f32x4 acc[2] = {(f32x4){0.f, 0.f, 0.f, 0.f}, (f32x4){0.f, 0.f, 0.f, 0.f}};
          mm_rows<128, 2>(Ct, TS2, Sb, TS2, mt, nt0, fr, fq, acc);
#pragma unroll
          for (int j = 0; j < 4; ++j) { const float sc = __expf(AC[16 * mt + 4 * fq + j]); acc[0][j] *= sc; acc[1][j] *= sc; }
          mm_rows<64, 2>(Mt, TS, xT, TS, mt, nt0, fr, fq, acc);
          bf16_t* ob = WSP(bf16_t, d ? SC_OB : SC_OF);
#pragma unroll
          for (int t = 0; t < 2; ++t)
#pragma unroll
              for (int j = 0; j < 4; ++j) ob[(size_t)(s0 + 16 * mt + 4 * fq + j) * 1024 + 512 + 64 * h + 16 * (nt0 + t) + fr] = (bf16_t)f2bf(acc[t][j]); }
        __syncthreads();
    }
}
constexpr int AFS = 68;
__device__ __forceinline__ int dr_mfrag_idx(int row, int col) { return (((row >> 4) * 2 + (col >> 5)) * 64 + ((col >> 2) & 3) * 16 + (row & 15)) * 8 + ((col >> 4) & 1) * 4 + (col & 3); }
template <class RhsF> __device__ __forceinline__ void dr_block_solve(const LAS unsigned char* Abf, const LAS float* AfT, LAS unsigned char* XT, LAS float* Dbuf, const float sgn, const int wave, const RhsF& rhs, bf16_t* wu) {
#pragma unroll 1
    for (int kb_ = 0; kb_ < 4; ++kb_) {
        { const int lane = lane_id_asm(), fr = lane & 15, fq = lane >> 4; f32x4 acc = (f32x4){0.f, 0.f, 0.f, 0.f};
          if (kb_ > 0) {
#pragma unroll
              for (int ks = 0; ks < 2; ++ks) { const bf16x8 a = *(const LAS bf16x8*)(Abf + (16 * kb_ + fr) * TS + ks * 64 + fq * 16), bb = *(const LAS bf16x8*)(XT + (16 * wave + fr) * TS + ks * 64 + fq * 16);
                  acc = __builtin_amdgcn_mfma_f32_16x16x32_bf16(a, bb, acc, 0, 0, 0); } }
          *(LAS f32x4*)(Dbuf + (16 * wave + fr) * 20 + 4 * fq) = acc; }
        __syncthreads();
        if (wave < 2) { const int col = wave * 64 + lane_id_asm(); float x[16];
#pragma unroll
            for (int i = 0; i < 16; ++i) x[i] = rhs(16 * kb_ + i, col) - sgn * Dbuf[col * 20 + i];
            const LAS float* Ab = AfT + (16 * kb_) * AFS + 16 * kb_;
#pragma unroll
            for (int j = 0; j < 15; ++j) { const float xj = sgn * x[j];
#pragma unroll
                for (int i = j + 1; i < 16; ++i) x[i] -= Ab[j * AFS + i] * xj; }
            u32x4 w0, w1;
#pragma unroll
            for (int q = 0; q < 4; ++q) { w0[q] = pk2(x[2 * q], x[2 * q + 1]); w1[q] = pk2(x[8 + 2 * q], x[8 + 2 * q + 1]); }
            *(LAS u32x4*)(XT + col * TS + (16 * kb_) * 2) = w0; *(LAS u32x4*)(XT + col * TS + (16 * kb_ + 8) * 2) = w1;
#pragma unroll
            for (int i = 0; i < 16; ++i) wu[(16 * kb_ + i) * 128 + col] = (bf16_t)f2bf(x[i]); }
        __syncthreads();
    }
}
struct GdnRhs { const LAS unsigned char* kb; const LAS unsigned char* vb; const LAS float* GC;
    __device__ __forceinline__ float operator()(int r, int col) const { return col < 64 ? bf2f(*(const LAS bf16_t*)(kb + r * TS + col * 2)) * __expf(GC[r]) : bf2f(*(const LAS bf16_t*)(vb + r * TS + (col - 64) * 2)); } };
__device__ __forceinline__ void gdn_p1(const Cx& p, LAS unsigned char* lds, int layer, int b) {
    const int wave = __builtin_amdgcn_readfirstlane(p.tid >> 6);
#define GDN_LANES const int lane = lane_id_asm(), tid = wave * 64 + lane, fr = lane & 15, fq = lane >> 4; (void)tid; (void)fr; (void)fq
    LAS unsigned char* kh = lds; LAS unsigned char* kb = lds + 64 * TS; LAS unsigned char* vb = lds + 2 * 64 * TS; LAS unsigned char* Abf = lds + 3 * 64 * TS; LAS unsigned char* kdT = lds + 4 * 64 * TS; LAS unsigned char* XT = lds + 5 * 64 * TS;
    LAS float* Af = (LAS float*)(lds + 7 * 64 * TS); LAS float* Dbuf = Af + 64 * AFS; LAS float* GC = Dbuf + 128 * 20;
    const int mt = wave >> 1, nt0 = (wave & 1) * 2;
    UNIT_LOOP(u, NUNIT, 64) { const int tb = u >> 3, h = (u >> 1) & 3, d = u & 1, s0 = 64 * tb;
        const bf16_t* dq = WSP(bf16_t, SC_DQ) + (size_t)s0 * 768; const float* dg = WSP(float, SC_DG) + (size_t)s0 * 16;
        if (wave == 0) { GDN_LANES; const int i = d ? 63 - lane : lane; float pre = dg[i * 16 + 8 + d * 4 + h];
#pragma unroll
            for (int o = 1; o < 64; o <<= 1) { const float t = shup_(pre, lane, o); if (lane >= o) pre += t; }
            GC[lane] = pre; }
        { GDN_LANES; const int r = tid >> 3, c0 = (tid & 7) * 8, i = d ? 63 - r : r; const float beta = dg[i * 16 + d * 4 + h];
          const u32x4 kv = *(const u32x4*)(dq + (size_t)i * 768 + 256 + 64 * h + c0), vv = *(const u32x4*)(dq + (size_t)i * 768 + 512 + 64 * h + c0); u32x4 kw, vw;
#pragma unroll
          for (int q = 0; q < 4; ++q) { kw[q] = pk2(__uint_as_float(kv[q] << 16) * beta, __uint_as_float(kv[q] & 0xffff0000u) * beta); vw[q] = pk2(__uint_as_float(vv[q] << 16) * beta, __uint_as_float(vv[q] & 0xffff0000u) * beta); }
          *(LAS u32x4*)(kh + r * TS + c0 * 2) = kv; *(LAS u32x4*)(kb + r * TS + c0 * 2) = kw; *(LAS u32x4*)(vb + r * TS + c0 * 2) = vw;
          *(LAS u32x4*)(XT + (2 * r) * TS + c0 * 2) = (u32x4){0u, 0u, 0u, 0u}; *(LAS u32x4*)(XT + (2 * r + 1) * TS + c0 * 2) = (u32x4){0u, 0u, 0u, 0u}; }
        __syncthreads();
        const float gtot = GC[63];
        { GDN_LANES; f32x4 acc[2] = {(f32x4){0.f, 0.f, 0.f, 0.f}, (f32x4){0.f, 0.f, 0.f, 0.f}};
          mm_rows<64, 2>(kb, TS, kh, TS, mt, nt0, fr, fq, acc);
#pragma unroll
          for (int t = 0; t < 2; ++t)
#pragma unroll
              for (int j = 0; j < 4; ++j) { const int r = 16 * mt + 4 * fq + j, jj = 16 * (nt0 + t) + fr; const float a = jj < r ? acc[t][j] * __expf(GC[r] - GC[jj]) : 0.f;
                  Af[jj * AFS + r] = a; *(LAS bf16_t*)(Abf + r * TS + jj * 2) = (bf16_t)f2bf(a); }
#pragma unroll 2
          for (int q = 0; q < 8; ++q) { const int e = tid + NTHR * q, r = e >> 6, cc = e & 63;
              *(LAS bf16_t*)(kdT + cc * TS + r * 2) = (bf16_t)f2bf(bf2f(*(const LAS bf16_t*)(kh + r * TS + cc * 2)) * __expf(gtot - GC[r])); } }
        __syncthreads();
        { const GdnRhs rhs{kb, vb, GC}; dr_block_solve(Abf, Af, XT, Dbuf, 1.0f, wave, rhs, WSP(bf16_t, SC_DR_WU) + (size_t)u * 8192); }
        { GDN_LANES; f32x4 am[2] = {(f32x4){0.f, 0.f, 0.f, 0.f}, (f32x4){0.f, 0.f, 0.f, 0.f}}, an[2] = {(f32x4){0.f, 0.f, 0.f, 0.f}, (f32x4){0.f, 0.f, 0.f, 0.f}};
          mm_rows<64, 2>(kdT, TS, XT, TS, mt, nt0, fr, fq, am);
          mm_rows<64, 2>(kdT, TS, XT + 64 * TS, TS, mt, nt0, fr, fq, an);
          bf16_t* Mg = WSP(bf16_t, SC_DR_M) + (size_t)u * 4096; bf16_t* Ng = WSP(bf16_t, SC_DR_NS) + (size_t)u * 4096; const float eg = __expf(gtot);
#pragma unroll
          for (int t = 0; t < 2; ++t) {
#pragma unroll
              for (int j = 0; j < 4; ++j) { const int row = 16 * mt + 4 * fq + j, col = 16 * (nt0 + t) + fr; Mg[dr_mfrag_idx(row, col)] = (bf16_t)f2bf((row == col ? eg : 0.f) - am[t][j]); }
              *(u32x2*)(Ng + (((nt0 + t) * 4 + mt) * 64 + lane) * 4) = (u32x2){pk2(an[t][0], an[t][1]), pk2(an[t][2], an[t][3])}; } }
        __syncthreads();
    }
#undef GDN_LANES
}
__device__ __forceinline__ void dr_chain(const Cx& p, size_t offM, size_t offNS, int h, int d, int cb) {
    const int lane = p.tid & 63, fr = lane & 15, fq = lane >> 4;
    if (p.tid >= 64) return;
    f32x4 acc[4];
#pragma unroll
    for (int t = 0; t < 4; ++t) acc[t] = (f32x4){0.f, 0.f, 0.f, 0.f};
    bf16x8 mR[4][4][2]; u32x2 nR[4][4];
#define DR_LD(m, nn, n_) do { const int u_ = (chain_tb((n_), d) * 4 + h) * 2 + d; const bf16_t* M_ = WSP(bf16_t, offM) + (size_t)u_ * 4096; const bf16_t* N_ = WSP(bf16_t, offNS) + (size_t)u_ * 4096; \
        _Pragma("unroll") for (int t = 0; t < 4; ++t) { _Pragma("unroll") for (int ks = 0; ks < 2; ++ks) m[t][ks] = *(const bf16x8*)(M_ + ((t * 2 + ks) * 64 + lane) * 8); nn[t] = *(const u32x2*)(N_ + ((cb * 4 + t) * 64 + lane) * 4); } } while (0)
#define DR_STEP(m, nn, n_) do { const int u_ = (chain_tb((n_), d) * 4 + h) * 2 + d; bf16_t* ST_ = WSP(bf16_t, offNS) + (size_t)u_ * 4096 + (16 * cb + fr) * 64 + 4 * fq; \
        u32x2 sp_[4]; _Pragma("unroll") for (int t = 0; t < 4; ++t) { sp_[t] = (u32x2){pk2(acc[t][0], acc[t][1]), pk2(acc[t][2], acc[t][3])}; *(u32x2*)(ST_ + 16 * t) = sp_[t]; } \
        bf16x8 bf_[2]; _Pragma("unroll") for (int ks = 0; ks < 2; ++ks) { u32x4 w_ = (u32x4){sp_[2 * ks][0], sp_[2 * ks][1], sp_[2 * ks + 1][0], sp_[2 * ks + 1][1]}; bf_[ks] = __builtin_bit_cast(bf16x8, w_); } \
        _Pragma("unroll") for (int t = 0; t < 4; ++t) { f32x4 a_ = (f32x4){__uint_as_float(nn[t][0] << 16), __uint_as_float(nn[t][0] & 0xffff0000u), __uint_as_float(nn[t][1] << 16), __uint_as_float(nn[t][1] & 0xffff0000u)}; \
            a_ = __builtin_amdgcn_mfma_f32_16x16x32_bf16(m[t][0], bf_[0], a_, 0, 0, 0); acc[t] = __builtin_amdgcn_mfma_f32_16x16x32_bf16(m[t][1], bf_[1], a_, 0, 0, 0); } } while (0)
#define DR_GO(q, n_) do { DR_STEP(mR[q], nR[q], (n_)); if ((n_) + 4 < NTB) DR_LD(mR[q], nR[q], (n_) + 4); } while (0)
    DR_LD(mR[0], nR[0], 0); DR_LD(mR[1], nR[1], 1); DR_LD(mR[2], nR[2], 2); DR_LD(mR[3], nR[3], 3);
#pragma unroll 1
    for (int n = 0; n < NTB; n += 4) { DR_GO(0, n); DR_GO(1, n + 1); DR_GO(2, n + 2); DR_GO(3, n + 3); }
#undef DR_GO
#undef DR_LD
#undef DR_STEP
}
__device__ __forceinline__ void gdn_p2(const Cx& p, LAS unsigned char* lds, int layer, int b) {
    const int tid = p.tid, lane = tid & 63, wave = __builtin_amdgcn_readfirstlane(tid >> 6), fr = lane & 15, fq = lane >> 4;
    LAS unsigned char* qh = lds; LAS unsigned char* kh = lds + 64 * TS; LAS unsigned char* wt = lds + 2 * 64 * TS; LAS unsigned char* sT = lds + 3 * 64 * TS; LAS unsigned char* aq = lds + 4 * 64 * TS; LAS unsigned char* vnT = lds + 5 * 64 * TS;
    LAS float* GC = (LAS float*)(lds + 6 * 64 * TS);
    const int mt = wave >> 1, nt0 = (wave & 1) * 2;
    UNIT_LOOP(u, NUNIT, 192) { const int tb = u >> 3, h = (u >> 1) & 3, d = u & 1, s0 = 64 * tb;
        const bf16_t* dq = WSP(bf16_t, SC_DQ) + (size_t)s0 * 768; const float* dg = WSP(float, SC_DG) + (size_t)s0 * 16;
        const bf16_t* wu = WSP(bf16_t, SC_DR_WU) + (size_t)u * 8192; const bf16_t* st = WSP(bf16_t, SC_DR_NS) + (size_t)u * 4096;
        if (wave == 0) { const int i = d ? 63 - lane : lane; float pre = dg[i * 16 + 8 + d * 4 + h];
#pragma unroll
            for (int o = 1; o < 64; o <<= 1) { const float t = shup_(pre, lane, o); if (lane >= o) pre += t; }
            GC[lane] = pre; }
        bf16_t upre[2][4];
#pragma unroll
        for (int t = 0; t < 2; ++t)
#pragma unroll
            for (int j = 0; j < 4; ++j) upre[t][j] = wu[(16 * mt + 4 * fq + j) * 128 + 64 + 16 * (nt0 + t) + fr];
        { const int r = tid >> 3, c0 = (tid & 7) * 8, i = d ? 63 - r : r;
          *(LAS u32x4*)(qh + r * TS + c0 * 2) = *(const u32x4*)(dq + (size_t)i * 768 + 64 * h + c0);
          *(LAS u32x4*)(kh + r * TS + c0 * 2) = *(const u32x4*)(dq + (size_t)i * 768 + 256 + 64 * h + c0);
          *(LAS u32x4*)(wt + r * TS + c0 * 2) = *(const u32x4*)(wu + r * 128 + c0);
          *(LAS u32x4*)(sT + r * TS + c0 * 2) = *(const u32x4*)(st + r * 64 + c0); }
        __syncthreads();
        { f32x4 acc[2] = {(f32x4){0.f, 0.f, 0.f, 0.f}, (f32x4){0.f, 0.f, 0.f, 0.f}};
          mm_rows<64, 2>(qh, TS, kh, TS, mt, nt0, fr, fq, acc);
#pragma unroll
          for (int t = 0; t < 2; ++t)
#pragma unroll
              for (int j = 0; j < 4; ++j) { const int r = 16 * mt + 4 * fq + j, jj = 16 * (nt0 + t) + fr; *(LAS bf16_t*)(aq + r * TS + jj * 2) = (bf16_t)f2bf(jj <= r ? acc[t][j] * __expf(GC[r] - GC[jj]) : 0.f); }
          f32x4 av[2] = {(f32x4){0.f, 0.f, 0.f, 0.f}, (f32x4){0.f, 0.f, 0.f, 0.f}};
          mm_rows<64, 2>(wt, TS, sT, TS, mt, nt0, fr, fq, av);
#pragma unroll
          for (int t = 0; t < 2; ++t) { const int dv = 16 * (nt0 + t) + fr; float vn[4];
#pragma unroll
              for (int j = 0; j < 4; ++j) vn[j] = bf2f(upre[t][j]) - av[t][j];
              *(LAS u32x2*)(vnT + dv * TS + (16 * mt + 4 * fq) * 2) = (u32x2){pk2(vn[0], vn[1]), pk2(vn[2], vn[3])}; } }
        __syncthreads();
        { f32x4 acc[2] = {(f32x4){0.f, 0.f, 0.f, 0.f}, (f32x4){0.f, 0.f, 0.f, 0.f}};
          mm_rows<64, 2>(qh, TS, sT, TS, mt, nt0, fr, fq, acc);
#pragma unroll
          for (int j = 0; j < 4; ++j) { const float sc = __expf(GC[16 * mt + 4 * fq + j]); acc[0][j] *= sc; acc[1][j] *= sc; }
          mm_rows<64, 2>(aq, TS, vnT, TS, mt, nt0, fr, fq, acc);
          bf16_t* ob = WSP(bf16_t, d ? SC_OB : SC_OF);
#pragma unroll
          for (int t = 0; t < 2; ++t)
#pragma unroll
              for (int j = 0; j < 4; ++j) { const int r = 16 * mt + 4 * fq + j, i = d ? 63 - r : r; ob[(size_t)(s0 + i) * 1024 + 768 + 64 * h + 16 * (nt0 + t) + fr] = (bf16_t)f2bf(acc[t][j]); } }
        __syncthreads();
    }
}
constexpr int LPS = 65;
#define RW_LP(LP, GS, lw8) do { const int lane_ = lane_id_asm(), c_ = lane_, tg_ = wave; float loc_[8]; float run_ = 0.f; \
        _Pragma("unroll") for (int ii = 0; ii < 8; ++ii) { run_ += (lw8)[ii]; loc_[ii] = run_; } \
        (GS)[tg_ * 64 + c_] = run_; __syncthreads(); float off_ = 0.f; \
        _Pragma("unroll") for (int g2 = 0; g2 < 8; ++g2) if (g2 < tg_) off_ += (GS)[g2 * 64 + c_]; \
        _Pragma("unroll") for (int ii = 0; ii < 8; ++ii) (LP)[(8 * tg_ + ii) * LPS + c_] = loc_[ii] + off_; __syncthreads(); } while (0)
struct RwRhs { const LAS unsigned char* zt; const LAS unsigned char* RU;
    __device__ __forceinline__ float operator()(int r, int col) const { return col < 64 ? bf2f(*(const LAS bf16_t*)(zt + r * TS + col * 2)) : bf2f(*(const LAS bf16_t*)(RU + (col - 64) * TS + r * 2)); } };
__device__ __forceinline__ void rw_p1(const Cx& p, LAS unsigned char* lds, int layer, int b) {
    const int wave = __builtin_amdgcn_readfirstlane(p.tid >> 6), mt = wave >> 1, nt0 = (wave & 1) * 2;
#define RW_LANES const int lane = lane_id_asm(), tid = wave * 64 + lane, fr = lane & 15, fq = lane >> 4; (void)tid; (void)fr; (void)fq
    LAS float* LP = (LAS float*)lds; LAS float* GS = (LAS float*)(lds + 16640);
    LAS unsigned char* zt = lds + 18688; LAS unsigned char* bt = lds + 27904; LAS unsigned char* kt = lds + 37120; LAS unsigned char* vT = lds + 46336; LAS unsigned char* Azk = lds + 55552;
    LAS float* Af = (LAS float*)(lds + 64768); LAS unsigned char* XT = lds + 82176; LAS unsigned char* Abf = lds + 100608; LAS unsigned char* RU = lds + 109824; LAS float* Dbuf = (LAS float*)(lds + 119040); LAS unsigned char* bhT = lds + 129280;
    const bf16_t* proj = WSP(bf16_t, WS_PROJ);
    float lw8[8]; f32x4 lwv[2], kkv[2], bv[2], kv[2]; bf16_t v8[8];
#define RW1_LOAD(uu) do { const int tb_ = (uu) >> 3, h_ = ((uu) >> 1) & 3, d_ = (uu) & 1, s0_ = 64 * tb_; const int lane_ = lane_id_asm(), tid_ = wave * 64 + lane_; \
        const float* lwp_ = WSP(float, SC_RLW) + (size_t)d_ * SB * 256 + (size_t)s0_ * 256 + 64 * h_; const size_t fo_ = (size_t)s0_ * 256 + 64 * h_; \
        _Pragma("unroll") for (int ii = 0; ii < 8; ++ii) { const int r_ = 8 * wave + ii; lw8[ii] = lwp_[(size_t)(d_ ? 63 - r_ : r_) * 256 + lane_]; } \
        { const int r_ = tid_ >> 3, c0_ = (tid_ & 7) * 8, i_ = d_ ? 63 - r_ : r_; \
          _Pragma("unroll") for (int q = 0; q < 2; ++q) { lwv[q] = *(const f32x4*)(lwp_ + (size_t)i_ * 256 + c0_ + 4 * q); kkv[q] = *(const f32x4*)(WSP(float, SC_RKK) + fo_ + (size_t)i_ * 256 + c0_ + 4 * q); \
              bv[q] = *(const f32x4*)(WSP(float, SC_RB) + fo_ + (size_t)i_ * 256 + c0_ + 4 * q); kv[q] = *(const f32x4*)(WSP(float, SC_RK) + fo_ + (size_t)i_ * 256 + c0_ + 4 * q); } } \
        { const bf16_t* pr0_ = proj + (size_t)tb_row0(b, tb_) * NPROJ; \
          _Pragma("unroll") for (int q = 0; q < 8; ++q) { const int e = tid_ + NTHR * q, r2 = e >> 6, cc = e & 63; v8[q] = pr0_[(size_t)(d_ ? 63 - r2 : r2) * NPROJ + PB_V + 64 * h_ + cc]; } } } while (0)
    int u = (p.bid + p.G - (96 % p.G)) % p.G; if (u >= NUNIT) return;
    RW1_LOAD(u);
    for (;;) { const int d = u & 1;
        RW_LP(LP, GS, lw8);
        { RW_LANES; const int r = tid >> 3, c0 = (tid & 7) * 8; unsigned wz[4], wb[4], wk[4];
#pragma unroll
          for (int q = 0; q < 8; q += 2) { float z2[2], b2[2], k2[2];
#pragma unroll
              for (int e = 0; e < 2; ++e) { const int cq = q + e, c = c0 + cq; const float lp = LP[r * LPS + c], lw = lwv[cq >> 2][cq & 3], em = __expf(-lp);
                  z2[e] = -kkv[cq >> 2][cq & 3] * __expf(lp - lw); b2[e] = bv[cq >> 2][cq & 3] * em; k2[e] = kv[cq >> 2][cq & 3] * em; }
              wz[q >> 1] = pk2(z2[0], z2[1]); wb[q >> 1] = pk2(b2[0], b2[1]); wk[q >> 1] = pk2(k2[0], k2[1]); }
          *(LAS u32x4*)(zt + r * TS + c0 * 2) = (u32x4){wz[0], wz[1], wz[2], wz[3]}; *(LAS u32x4*)(bt + r * TS + c0 * 2) = (u32x4){wb[0], wb[1], wb[2], wb[3]}; *(LAS u32x4*)(kt + r * TS + c0 * 2) = (u32x4){wk[0], wk[1], wk[2], wk[3]};
          *(LAS u32x4*)(XT + (2 * r) * TS + c0 * 2) = (u32x4){0u, 0u, 0u, 0u}; *(LAS u32x4*)(XT + (2 * r + 1) * TS + c0 * 2) = (u32x4){0u, 0u, 0u, 0u};
#pragma unroll 2
          for (int q = 0; q < 8; ++q) { const int e = tid + NTHR * q, r2 = e >> 6, cc = e & 63; *(LAS bf16_t*)(vT + cc * TS + r2 * 2) = v8[q]; } }
        __syncthreads();
        const int un = u + p.G; const bool more = un < NUNIT;
        if (more) RW1_LOAD(un);
        { RW_LANES; f32x4 a1[2] = {(f32x4){0.f, 0.f, 0.f, 0.f}, (f32x4){0.f, 0.f, 0.f, 0.f}}, a2[2] = {(f32x4){0.f, 0.f, 0.f, 0.f}, (f32x4){0.f, 0.f, 0.f, 0.f}};
          mm_rows<64, 2>(zt, TS, bt, TS, mt, nt0, fr, fq, a1);
          mm_rows<64, 2>(zt, TS, kt, TS, mt, nt0, fr, fq, a2);
#pragma unroll
          for (int t = 0; t < 2; ++t)
#pragma unroll
              for (int j = 0; j < 4; ++j) { const int r = 16 * mt + 4 * fq + j, jj = 16 * (nt0 + t) + fr; const float a = jj < r ? a1[t][j] : 0.f;
                  Af[jj * AFS + r] = a; *(LAS bf16_t*)(Abf + r * TS + jj * 2) = (bf16_t)f2bf(a); *(LAS bf16_t*)(Azk + r * TS + jj * 2) = (bf16_t)f2bf(jj < r ? a2[t][j] : 0.f); } }
        __syncthreads();
        { RW_LANES; f32x4 a[2] = {(f32x4){0.f, 0.f, 0.f, 0.f}, (f32x4){0.f, 0.f, 0.f, 0.f}};
          mm_rows<64, 2>(Azk, TS, vT, TS, mt, nt0, fr, fq, a);
#pragma unroll
          for (int t = 0; t < 2; ++t) *(LAS u32x2*)(RU + (16 * (nt0 + t) + fr) * TS + (16 * mt + 4 * fq) * 2) = (u32x2){pk2(a[t][0], a[t][1]), pk2(a[t][2], a[t][3])};
        }
        __syncthreads();
        { RW_LANES;
#pragma unroll 2
          for (int q = 0; q < 8; ++q) { const int e = tid + NTHR * q, r2 = e >> 6, cc = e & 63; const float el = __expf(LP[63 * LPS + cc]);
              *(LAS bf16_t*)(bhT + cc * TS + r2 * 2) = (bf16_t)f2bf(bf2f(*(const LAS bf16_t*)(bt + r2 * TS + cc * 2)) * el); *(LAS bf16_t*)(Azk + cc * TS + r2 * 2) = (bf16_t)f2bf(bf2f(*(const LAS bf16_t*)(kt + r2 * TS + cc * 2)) * el); } }
        __syncthreads();
        { const RwRhs rhs{zt, RU}; dr_block_solve(Abf, Af, XT, Dbuf, -1.0f, wave, rhs, WSP(bf16_t, SC_RW_WU) + (size_t)u * 8192); }
        { RW_LANES; f32x4 am[2] = {(f32x4){0.f, 0.f, 0.f, 0.f}, (f32x4){0.f, 0.f, 0.f, 0.f}}, an[2] = {(f32x4){0.f, 0.f, 0.f, 0.f}, (f32x4){0.f, 0.f, 0.f, 0.f}};
          mm_rows<64, 2>(bhT, TS, XT, TS, mt, nt0, fr, fq, am);
          mm_rows<64, 2>(bhT, TS, XT + 64 * TS, TS, mt, nt0, fr, fq, an);
          mm_rows<64, 2>(Azk, TS, vT, TS, mt, nt0, fr, fq, an);
          bf16_t* Mg = WSP(bf16_t, SC_RW_M) + (size_t)u * 4096; bf16_t* Ng = WSP(bf16_t, SC_RW_NS) + (size_t)u * 4096;
#pragma unroll
          for (int t = 0; t < 2; ++t) {
#pragma unroll
              for (int j = 0; j < 4; ++j) { const int row = 16 * mt + 4 * fq + j, col = 16 * (nt0 + t) + fr; Mg[dr_mfrag_idx(row, col)] = (bf16_t)f2bf((row == col ? __expf(LP[63 * LPS + row]) : 0.f) + am[t][j]); }
              *(u32x2*)(Ng + (((nt0 + t) * 4 + mt) * 64 + lane) * 4) = (u32x2){pk2(an[t][0], an[t][1]), pk2(an[t][2], an[t][3])}; } }
        __syncthreads();
        if (!more) break;
        u = un;
    }
#undef RW1_LOAD
}
__device__ __forceinline__ void rw_p2(const Cx& p, LAS unsigned char* lds, int layer, int b) {
    const int wave = __builtin_amdgcn_readfirstlane(p.tid >> 6), mt = wave >> 1, nt0 = (wave & 1) * 2;
    LAS float* LP = (LAS float*)lds; LAS float* GS = (LAS float*)(lds + 16640);
    LAS unsigned char* rt = lds + 18688; LAS unsigned char* bt = lds + 27904; LAS unsigned char* kt = lds + 37120; LAS unsigned char* vT = lds + 46336; LAS unsigned char* sT = lds + 55552; LAS unsigned char* wt = lds + 64768;
    LAS unsigned char* Arb = lds + 73984; LAS unsigned char* Ark = lds + 83200; LAS unsigned char* UT = lds + 92416;
    const bf16_t* proj = WSP(bf16_t, WS_PROJ);
    UNIT_LOOP(u, NUNIT, 224) { const int tb = u >> 3, h = (u >> 1) & 3, d = u & 1, s0 = 64 * tb;
        const float* lwp = WSP(float, SC_RLW) + (size_t)d * SB * 256 + (size_t)s0 * 256 + 64 * h; const float* rk = WSP(float, SC_RK) + (size_t)s0 * 256 + 64 * h; const float* rb = WSP(float, SC_RB) + (size_t)s0 * 256 + 64 * h;
        const bf16_t* pr0 = proj + (size_t)tb_row0(b, tb) * NPROJ; const bf16_t* wu = WSP(bf16_t, SC_RW_WU) + (size_t)u * 8192; const bf16_t* st = WSP(bf16_t, SC_RW_NS) + (size_t)u * 4096;
        bf16_t upre[2][4];
        { const int lane_ = lane_id_asm(), fr_ = lane_ & 15, fq_ = lane_ >> 4;
#pragma unroll
          for (int t = 0; t < 2; ++t)
#pragma unroll
              for (int j = 0; j < 4; ++j) upre[t][j] = wu[(16 * mt + 4 * fq_ + j) * 128 + 64 + 16 * (nt0 + t) + fr_]; }
        { float lw8[8]; const int lane_ = lane_id_asm();
#pragma unroll
          for (int ii = 0; ii < 8; ++ii) { const int r_ = 8 * wave + ii; lw8[ii] = lwp[(size_t)(d ? 63 - r_ : r_) * 256 + lane_]; }
          RW_LP(LP, GS, lw8); }
        { RW_LANES; const int r = tid >> 3, c0 = (tid & 7) * 8, i = d ? 63 - r : r; unsigned wr[4], wb[4], wk[4];
          const u32x4 rv = *(const u32x4*)(pr0 + (size_t)i * NPROJ + PB_R + 64 * h + c0);
          f32x4 bv[2], kv[2];
#pragma unroll
          for (int q = 0; q < 2; ++q) { bv[q] = *(const f32x4*)(rb + (size_t)i * 256 + c0 + 4 * q); kv[q] = *(const f32x4*)(rk + (size_t)i * 256 + c0 + 4 * q); }
#pragma unroll
          for (int q = 0; q < 8; q += 2) { float r2[2], b2[2], k2[2];
#pragma unroll
              for (int e = 0; e < 2; ++e) { const int cq = q + e, c = c0 + cq; const float lp = LP[r * LPS + c], em = __expf(-lp); const unsigned w = rv[q >> 1];
                  r2[e] = (e ? __uint_as_float(w & 0xffff0000u) : __uint_as_float(w << 16)) * __expf(lp); b2[e] = bv[cq >> 2][cq & 3] * em; k2[e] = kv[cq >> 2][cq & 3] * em; }
              wr[q >> 1] = pk2(r2[0], r2[1]); wb[q >> 1] = pk2(b2[0], b2[1]); wk[q >> 1] = pk2(k2[0], k2[1]); }
          *(LAS u32x4*)(rt + r * TS + c0 * 2) = (u32x4){wr[0], wr[1], wr[2], wr[3]}; *(LAS u32x4*)(bt + r * TS + c0 * 2) = (u32x4){wb[0], wb[1], wb[2], wb[3]}; *(LAS u32x4*)(kt + r * TS + c0 * 2) = (u32x4){wk[0], wk[1], wk[2], wk[3]};
          *(LAS u32x4*)(wt + r * TS + c0 * 2) = *(const u32x4*)(wu + r * 128 + c0);
          *(LAS u32x4*)(sT + r * TS + c0 * 2) = *(const u32x4*)(st + r * 64 + c0);
#pragma unroll 2
          for (int q = 0; q < 8; ++q) { const int e = tid + NTHR * q, r2 = e >> 6, cc = e & 63; *(LAS bf16_t*)(vT + cc * TS + r2 * 2) = pr0[(size_t)(d ? 63 - r2 : r2) * NPROJ + PB_V + 64 * h + cc]; } }
        __syncthreads();
        { RW_LANES; f32x4 a1[2] = {(f32x4){0.f, 0.f, 0.f, 0.f}, (f32x4){0.f, 0.f, 0.f, 0.f}}, a2[2] = {(f32x4){0.f, 0.f, 0.f, 0.f}, (f32x4){0.f, 0.f, 0.f, 0.f}}, a3[2] = {(f32x4){0.f, 0.f, 0.f, 0.f}, (f32x4){0.f, 0.f, 0.f, 0.f}};
          mm_rows<64, 2>(rt, TS, bt, TS, mt, nt0, fr, fq, a1); mm_rows<64, 2>(rt, TS, kt, TS, mt, nt0, fr, fq, a2); mm_rows<64, 2>(wt, TS, sT, TS, mt, nt0, fr, fq, a3);
#pragma unroll
          for (int t = 0; t < 2; ++t) { const int dv = 16 * (nt0 + t) + fr; float uu[4];
#pragma unroll
              for (int j = 0; j < 4; ++j) { const int r = 16 * mt + 4 * fq + j, jj = dv; const bool keep = jj <= r;
                  *(LAS bf16_t*)(Arb + r * TS + jj * 2) = (bf16_t)f2bf(keep ? a1[t][j] : 0.f); *(LAS bf16_t*)(Ark + r * TS + jj * 2) = (bf16_t)f2bf(keep ? a2[t][j] : 0.f);
                  uu[j] = bf2f(upre[t][j]) + a3[t][j]; }
              *(LAS u32x2*)(UT + dv * TS + (16 * mt + 4 * fq) * 2) = (u32x2){pk2(uu[0], uu[1]), pk2(uu[2], uu[3])}; } }
        __syncthreads();
        { RW_LANES; f32x4 acc[2] = {(f32x4){0.f, 0.f, 0.f, 0.f}, (f32x4){0.f, 0.f, 0.f, 0.f}};
          mm_rows<64, 2>(rt, TS, sT, TS, mt, nt0, fr, fq, acc); mm_rows<64, 2>(Arb, TS, UT, TS, mt, nt0, fr, fq, acc); mm_rows<64, 2>(Ark, TS, vT, TS, mt, nt0, fr, fq, acc);
          bf16_t* ob = WSP(bf16_t, d ? SC_OB : SC_OF);
#pragma unroll
          for (int t = 0; t < 2; ++t)
#pragma unroll
              for (int j = 0; j < 4; ++j) { const int r = 16 * mt + 4 * fq + j, i = d ? 63 - r : r; ob[(size_t)(s0 + i) * 1024 + 256 + 64 * h + 16 * (nt0 + t) + fr] = (bf16_t)f2bf(acc[t][j]); } }
        __syncthreads();
    }
#undef RW_LANES
}
__device__ __forceinline__ void phase_scan(const Cx& p, LAS unsigned char* lds, int layer, int b) {
    for (int w = p.bid; w < 160; w += p.G) {
        if (w < 64) ssd_chain(p, (w >> 4) & 3, (w >> 3) & 1, w & 7);
        else if (w < 96) gla_chain(p, ((w - 64) >> 3) & 3, ((w - 64) >> 2) & 1, (w - 64) & 3);
        else { const int i = w - 96, h = (i >> 3) & 3, d = (i >> 2) & 1, cb = i & 3;
            if (i < 32) dr_chain(p, SC_RW_M, SC_RW_NS, h, d, cb); else dr_chain(p, SC_DR_M, SC_DR_NS, h, d, cb); } }
}
#ifndef MK_ONE_LAUNCH
#define MK_ONE_LAUNCH 1
#endif
constexpr int PH_PER_LAYER = 2 + 5 * NB + 7;
constexpr int N_PHASES = 1 + NL * PH_PER_LAYER + 1;

__global__ void __launch_bounds__(NTHR, 2) mega_fwd(Params pp) {
    extern __shared__ __attribute__((aligned(16))) unsigned char lds_raw[];
    LAS unsigned char* lds = (LAS unsigned char*)lds_raw;
    const int swave = __builtin_amdgcn_readfirstlane(threadIdx.x >> 6);
    for (int i = threadIdx.x; i < (LDS_BYTES - LDS_CTL) / 4; i += NTHR) ((LAS unsigned*)(lds + LDS_CTL))[i] = 0u;
    __syncthreads();
    if (threadIdx.x < N_IN + 2) { const unsigned long long a = threadIdx.x < N_IN ? (unsigned long long)pp.in[threadIdx.x] : (threadIdx.x == N_IN ? (unsigned long long)pp.out : (unsigned long long)pp.ws); ((LAS unsigned*)(lds + LDS_PTRS))[2 * threadIdx.x] = (unsigned)a; ((LAS unsigned*)(lds + LDS_PTRS))[2 * threadIdx.x + 1] = (unsigned)(a >> 32); }
    __syncthreads();
    XcdBarrier bar = xcd_barrier_post((unsigned*)(pp.ws + WS_CTL) + CW_BAR + pp.li * XCD_BAR_WORDS, (volatile LAS unsigned*)(lds + LDS_CTL), threadIdx.x);
    LAS int* tb = (LAS int*)(lds + LDS_CTL + 64);
    int pc = 0; const int lo = pp.lo, hi = pp.hi;
#define PH_BEGIN if (pc >= lo && pc < hi) { Cx p; p.out = (float*)PIN(N_IN); p.ws = (unsigned char*)PIN(N_IN + 1); p.tid = swave * 64 + lane_id_asm(); p.bid = blockIdx.x; p.G = gridDim.x; p.pad = 0; asm volatile("" : "+s"(p.out), "+s"(p.ws), "+v"(p.tid), "+s"(p.bid), "+s"(p.G)); const int G = p.G, bid = p.bid; (void)G; (void)bid;
#define PH_END if (pc + 1 < hi) { XcdBarrier b2 = bar; asm volatile("" : "+s"(b2.bar), "+s"(b2.x)); xcd_barrier(b2, (unsigned)(swave * 64 + lane_id_asm())); } } ++pc;

    PH_BEGIN
        for (int u = bid; u < CONV_A_UNITS; u += G) conv_unit_A(p, (LAS float*)lds, u);
        __syncthreads();
        phase_mod(p, lds);
    PH_END

#pragma unroll
    for (int layer = 0; layer < NL; ++layer) {
        const int row_lo = layer == NL - 1 ? CROWS : 0;
        PH_BEGIN phase_norm1(p, layer); PH_END
        PH_BEGIN
            DenseSched S; S.init(ROWS, NPROJ, D, WSP(bf16_t, WS_WIN) + (size_t)layer * NPROJ * D, G, bid);
            EpiProj E{WSP(bf16_t, WS_PROJ), NPROJ};
            pg8::gemm_phase<D>(p.tid, lds, (const char*)WSP(bf16_t, WS_HBUF), S, E);
        PH_END
#pragma unroll 1
        for (int b = 0; b < NB; ++b) {
            PH_BEGIN phase_prep(p, lds, layer, b); PH_END
            PH_BEGIN gla_p1(p, lds, layer, b); __syncthreads(); ssd_p1(p, lds, layer, b); __syncthreads(); gdn_p1(p, lds, layer, b); __syncthreads(); rw_p1(p, lds, layer, b); PH_END
            PH_BEGIN phase_scan(p, lds, layer, b); PH_END
            PH_BEGIN gla_p2(p, lds, layer, b); __syncthreads(); ssd_p2(p, lds, layer, b); __syncthreads(); gdn_p2(p, lds, layer, b); __syncthreads(); rw_p2(p, lds, layer, b); PH_END
            PH_BEGIN phase_post(p, lds, layer, b); PH_END
        }
        PH_BEGIN
            DenseSched S; S.init(ROWS, D, D, WSP(bf16_t, WS_WOUT) + (size_t)layer * D * D, G, bid);
            EpiRes E{layer == 0 ? PIN(I_X) : (const float*)p.out, layer == 0 ? PIN(I_CTX) : (const float*)WSP(float, WS_CTXRES), p.out, WSP(float, WS_CTXRES), WSP(float, WS_MOD) + (size_t)layer * 5 * 6144 + 2048};
            pg8::gemm_phase<D>(p.tid, lds, (const char*)WSP(bf16_t, WS_HBUF), S, E);
        PH_END
        PH_BEGIN phase_norm2(p, lds, layer, row_lo);
            __syncthreads();
            conv_experts(p, (LAS float*)lds, layer);
        PH_END
        PH_BEGIN
            moe_table(p, tb, layer, row_lo);
            MoeSched<true> S{tb + 128, tb, 2, G, bid, D, row_lo, WSP(int, WS_LTOK), (const char*)WSP(bf16_t, WS_EXPGU), (size_t)512 * D * 2};
            EpiGU E{WSP(bf16_t, WS_H)};
            pg8::gemm_phase<D>(p.tid, lds, (const char*)WSP(bf16_t, WS_HBUF), S, E);
        PH_END
#pragma unroll
        for (int half = 0; half < 2; ++half) {
            PH_BEGIN
                moe_table(p, tb, layer, row_lo);
                MoeSched<false> S{tb + 128, tb, 2, G, bid, EH, row_lo, WSP(int, WS_LTOK), (const char*)(WSP(bf16_t, WS_EXPD) + (size_t)half * 512 * EH), (size_t)D * EH * 2};
                EpiY E{WSP(bf16_t, WS_Y)};
                pg8::gemm_phase<EH>(p.tid, lds, (const char*)WSP(bf16_t, WS_H), S, E);
            PH_END
            PH_BEGIN
                moe_table(p, tb, layer, row_lo);
                phase_combine(p, tb, layer, row_lo, half);
            PH_END
        }
    }
    PH_BEGIN phase_final(p);
    PH_END
#undef PH_BEGIN
#undef PH_END
}

extern "C" void kernel_launch(void* const* d_in, const int* in_sizes, int n_in, void* d_out, int out_size, void* d_ws, size_t ws_size, hipStream_t stream) {
    static int grid = 0;
    if (grid == 0) {
        if (n_in != N_IN || in_sizes[0] != NB * SEQ * D || out_size != NB * SEQ * D || ws_size < WS_END) {
            fprintf(stderr, "kernel_launch: unexpected shapes (n_in %d, in0 %d, out %d, ws %zu); nothing launched\n", n_in, n_in > 0 ? in_sizes[0] : -1, out_size, ws_size); grid = -1; return; }
        int dev = 0, cus = 0, per_cu = 0;
        if (hipGetDevice(&dev) != hipSuccess || hipDeviceGetAttribute(&cus, hipDeviceAttributeMultiprocessorCount, dev) != hipSuccess) { grid = -1; return; }
        if (hipFuncSetAttribute((const void*)mega_fwd, hipFuncAttributeMaxDynamicSharedMemorySize, LDS_BYTES) != hipSuccess) { fprintf(stderr, "kernel_launch: hipFuncSetAttribute failed\n"); grid = -1; return; }
        if (hipOccupancyMaxActiveBlocksPerMultiprocessor(&per_cu, (const void*)mega_fwd, NTHR, LDS_BYTES) != hipSuccess || per_cu < 1) { fprintf(stderr, "kernel_launch: occupancy query says %d\n", per_cu); per_cu = 1; }
        (void)hipGetLastError();
        grid = cus * 1;
    }
    if (grid < 0) return;
    if (hipMemsetAsync((char*)d_ws + WS_CTL, 0, CTL_ZERO_BYTES, stream) != hipSuccess) return;
    Params p{};
    for (int i = 0; i < N_IN; ++i) p.in[i] = (const float*)d_in[i];
    p.out = (float*)d_out; p.ws = (unsigned char*)d_ws; p.pad = 0;
#if MK_ONE_LAUNCH
    p.lo = 0; p.hi = N_PHASES; p.li = 0;
    hipLaunchKernelGGL(mega_fwd, dim3(grid), dim3(NTHR), LDS_BYTES, stream, p);
#else
    for (int k = 0; k < N_PHASES; ++k) { p.lo = k; p.hi = k + 1; p.li = k;
        hipLaunchKernelGGL(mega_fwd, dim3(grid), dim3(NTHR), LDS_BYTES, stream, p); }
#endif
}
```

```cpp
#include <hip/hip_runtime.h>
#include <cstdio>
#include <cstdint>

typedef unsigned short bf16_t;
typedef short bf16x8 __attribute__((ext_vector_type(8)));
typedef float f32x4 __attribute__((ext_vector_type(4)));
typedef float f32x2 __attribute__((ext_vector_type(2)));
typedef unsigned u32x4 __attribute__((ext_vector_type(4)));
typedef unsigned u32x2 __attribute__((ext_vector_type(2)));

constexpr int NB = 4, SEQ = 8192, NCTX = 256, D = 1024, NL = 2;
constexpr int CROWS = NB * NCTX;
constexpr int ROWS = CROWS + NB * SEQ;
constexpr int SB = NCTX + SEQ;
constexpr int INW = 4056, NPROJ = 4096;
constexpr int NE = 64, NE1 = 65, TOPK = 8, EH = 256;
constexpr int GRIDW = 64, GRIDH = SEQ / GRIDW;
constexpr int PA_Q = 0, PA_K = 256, PA_V = 512, PA_G = 768, PA_GF = 1024, PA_GB = 1040;
constexpr int PB_R = 1056, PB_K = 1312, PB_V = 1568, PB_WF = 1824, PB_WB = 1856, PB_A = 1888, PB_G = 1920;
constexpr int PC_Z = 1984, PC_X = 2240, PC_DF = 3008, PC_DB = 3012;
constexpr int PD_Q = 3016, PD_Z = 3784, PD_BF = 4040, PD_BB = 4044, PD_AF = 4048, PD_AB = 4052;
enum { I_X = 0, I_C, I_CTX, I_CCTX, I_N1G, I_N2G, I_WMOD, I_BMOD, I_WIN, I_WOUT, I_GLA_W2, I_GLA_B, I_GLA_NG,
       I_RW_W2, I_RW_W0, I_RW_AW2, I_RW_A0, I_RW_GW2, I_RW_KK, I_RW_KA, I_RW_RK, I_RW_LNG, I_RW_LNB,
       I_SS_CW, I_SS_CB, I_SS_ALOG, I_SS_DTB, I_SS_D, I_SS_NG, I_DN_CW, I_DN_ALOG, I_DN_DTB, I_DN_NG,
       I_ROUT_W, I_ROUT_B, I_EXP_G, I_EXP_U, I_EXP_D, I_SH_G, I_SH_U, I_SH_D, I_FNG, N_IN };
static_assert(N_IN == 42, "input count");

constexpr size_t MiB = 1u << 20;
constexpr size_t WS_CTL = 0, CTL_ZERO_BYTES = 1 * MiB;
constexpr size_t WS_MOD = 1 * MiB;
constexpr size_t WS_WIN = 2 * MiB;
constexpr size_t WS_WOUT = 18 * MiB;
constexpr size_t WS_ROUT = 22 * MiB;
constexpr size_t WS_CTXRES = 23 * MiB;
constexpr size_t WS_EXPGU = 27 * MiB;
constexpr size_t WS_EXPD = 92 * MiB;
constexpr size_t WS_HBUF = 125 * MiB;
constexpr size_t WS_PROJ = 191 * MiB;
constexpr size_t WS_SCR = 455 * MiB;
constexpr size_t WS_END = 640455456;
constexpr int HROWS_MAX = ROWS * 9 + NE1 * 256;
constexpr size_t WS_Y = WS_HBUF;
constexpr size_t WS_H = 443 * MiB;
constexpr size_t WS_LTOK = 600 * MiB;
constexpr size_t WS_TOKT = WS_LTOK + (size_t)NE * ROWS * 4;
static_assert(WS_Y + (size_t)HROWS_MAX * 512 * 2 <= WS_H && WS_H + (size_t)HROWS_MAX * 256 * 2 <= WS_LTOK && WS_TOKT + (size_t)ROWS * 64 <= WS_END, "moe overlay");
constexpr size_t SC_OF = WS_SCR;
constexpr size_t SC_OB = SC_OF + (size_t)SB * 1024 * 2;
constexpr size_t SC_RK = SC_OB + (size_t)SB * 1024 * 2;
constexpr size_t SC_RKK = SC_RK + (size_t)SB * 256 * 4;
constexpr size_t SC_RB = SC_RKK + (size_t)SB * 256 * 4;
constexpr size_t SC_RLW = SC_RB + (size_t)SB * 256 * 4;
constexpr size_t SC_SX = SC_RLW + (size_t)2 * SB * 256 * 4;
constexpr size_t SC_DQ = SC_SX + (size_t)SB * 768 * 2;
constexpr size_t SC_SDT = SC_DQ + (size_t)SB * 768 * 2;
constexpr size_t SC_DG = SC_SDT + (size_t)SB * 8 * 4;
constexpr size_t SC_FEND = SC_DG + (size_t)SB * 16 * 4;
constexpr int NTB = SB / 64, NUNIT = NTB * 4 * 2;
constexpr size_t SC_RW_M = SC_FEND;
constexpr size_t SC_RW_NS = SC_RW_M + (size_t)(SB / 64 * 8) * 4096 * 2;
constexpr size_t SC_RW_WU = SC_RW_NS + (size_t)(SB / 64 * 8) * 4096 * 2;
constexpr size_t SC_END = SC_RW_WU + (size_t)(SB / 64 * 8) * 8192 * 2;
constexpr size_t SC2 = WS_EXPGU;
constexpr size_t SC_GLA_S = SC2;
constexpr size_t SC_GLA_DEC = SC_GLA_S + (size_t)NUNIT * 4096 * 4;
constexpr size_t SC_SSD_S = SC_GLA_DEC + (size_t)NUNIT * 64 * 4;
constexpr size_t SC_SSD_CD = SC_SSD_S + (size_t)NUNIT * 8192 * 4;
constexpr size_t SC_DR_M = SC_SSD_CD + (size_t)NUNIT * 4 + 4096;
constexpr size_t SC_DR_NS = SC_DR_M + (size_t)NUNIT * 4096 * 2;
constexpr size_t SC_DR_WU = SC_DR_NS + (size_t)NUNIT * 4096 * 2;
constexpr size_t SC2_END = SC_DR_WU + (size_t)NUNIT * 8192 * 2;
static_assert(SC2_END <= WS_HBUF, "chunk slots fit in the expert-weight region");
static_assert(SC_END <= WS_END, "scratch fits");
constexpr int CW_CNT = 1024;
constexpr int CW_BAR = 4096;

#define LAS __attribute__((address_space(3)))
constexpr int NTHR = 512;
constexpr int LDS_BYTES = 147456;
constexpr int LDS_CTL = 143360;
constexpr int LDS_PTRS = LDS_CTL + 2048;

__device__ __forceinline__ int lane_id_asm() { int l; asm volatile("v_mbcnt_lo_u32_b32 %0, -1, 0\n\tv_mbcnt_hi_u32_b32 %0, -1, %0" : "=v"(l)); return l; }
__device__ __forceinline__ float bf2f(bf16_t b) { return __uint_as_float(((unsigned)b) << 16); }
__device__ __forceinline__ unsigned f2bf(float f) { unsigned u = __float_as_uint(f); u += 0x7FFFu + ((u >> 16) & 1u); return u >> 16; }
__device__ __forceinline__ unsigned pk2(float lo, float hi) { return f2bf(lo) | (f2bf(hi) << 16); }
__device__ __forceinline__ float rl(float x, int k) { return __uint_as_float(__builtin_amdgcn_readlane(__float_as_uint(x), k)); }
__device__ __forceinline__ float shx_(float v, int lane, int o) { return __uint_as_float(__builtin_amdgcn_ds_bpermute((lane ^ o) << 2, __float_as_uint(v))); }
__device__ __forceinline__ int shxi_(int v, int lane, int o) { return __builtin_amdgcn_ds_bpermute((lane ^ o) << 2, v); }
__device__ __forceinline__ float shup_(float v, int lane, int o) { return __uint_as_float(__builtin_amdgcn_ds_bpermute((lane - o) << 2, __float_as_uint(v))); }
#define DPPF(v, ctrl) __uint_as_float(__builtin_amdgcn_update_dpp(0, __float_as_uint(v), ctrl, 0xf, 0xf, false))
#define DPPI(v, ctrl) __builtin_amdgcn_update_dpp(0, (v), ctrl, 0xf, 0xf, false)
__device__ __forceinline__ float wsum(float v) {
    v += DPPF(v, 0xB1); v += DPPF(v, 0x4E); v += DPPF(v, 0x141); v += DPPF(v, 0x140);
    v += __uint_as_float(__builtin_amdgcn_ds_swizzle(__float_as_uint(v), 0x401F));
    return rl(v, 0) + rl(v, 32);
}
__device__ __forceinline__ float sigmoidf_(float x) { return 1.0f / (1.0f + __expf(-x)); }
__device__ __forceinline__ float siluf_(float x) { return x / (1.0f + __expf(-x)); }
__device__ __forceinline__ float log1pexp_(float t  ) { return t < 1e-4f ? t - 0.5f * t * t : __logf(1.0f + t); }
__device__ __forceinline__ float softplusf_(float x) { return x > 15.f ? x : log1pexp_(__expf(x)); }
__device__ __forceinline__ float logsigmoidf_(float x) { return fminf(x, 0.f) - log1pexp_(__expf(-fabsf(x))); }
__device__ __forceinline__ float tanhf_(float x) { const float e = __expf(2.0f * fminf(fmaxf(x, -15.f), 15.f)); return (e - 1.0f) / (e + 1.0f); }
__device__ __forceinline__ int seq_tok(int i, int d) { return d == 0 ? i : (i < NCTX ? NCTX - 1 - i : SB + NCTX - 1 - i); }
__device__ __forceinline__ int tok_row(int b, int s) { return s < NCTX ? b * NCTX + s : CROWS + b * SEQ + (s - NCTX); }

struct Params { const float* in[N_IN]; float* out; unsigned char* ws; int lo, hi, li, pad; };
struct Cx { float* out; unsigned char* ws; int tid, bid, G, pad; };
__device__ __forceinline__ const float* PIN(int i) {
    extern __shared__ __attribute__((aligned(16))) unsigned char lds_raw_[];
    int off = __builtin_amdgcn_readfirstlane(LDS_PTRS + 8 * i); asm volatile("" : "+s"(off));
    const LAS unsigned* t = (const LAS unsigned*)((LAS unsigned char*)lds_raw_ + off);
    const unsigned lo = __builtin_amdgcn_readfirstlane(t[0]), hi = __builtin_amdgcn_readfirstlane(t[1]);
    return (const float*)(((unsigned long long)hi << 32) | lo);
}
#define XB_TMO      128
#define XB_XCNT(j)  (256  + 64 * (j))
#define XB_XSUB(j)  (1280 + 64 * (j))
#define XB_XGEN(j)  (2304 + 64 * (j))
#define XB_TOP      3328
#define XB_TOPGEN   3392
#define XCD_BAR_WORDS 3456
#define XB_SPIN_CAP (1u << 18)

__device__ __forceinline__ unsigned xb_ld(unsigned* p)              { return __hip_atomic_load(p, __ATOMIC_RELAXED, __HIP_MEMORY_SCOPE_AGENT); }
__device__ __forceinline__ unsigned xb_add(unsigned* p, unsigned v) { return __hip_atomic_fetch_add(p, v, __ATOMIC_RELAXED, __HIP_MEMORY_SCOPE_AGENT); }
__device__ __forceinline__ unsigned xb_xcc_id() { return (unsigned)__builtin_amdgcn_s_getreg((3 << 11) | 20) & 0xFu; }
#define XB_SPIN(cond, bar) do { unsigned _sp = 0; while (cond) { __builtin_amdgcn_s_sleep(1); \
    if ((++_sp & 255u) == 0u) { if (xb_ld(&(bar)[XB_TMO])) break; if (_sp > XB_SPIN_CAP) { atomicAdd(&(bar)[XB_TMO], 1u); break; } } } } while (0)

struct XcdBarrier {
    unsigned* bar; unsigned x;
    volatile LAS unsigned* st;
};

__device__ __forceinline__ XcdBarrier xcd_barrier_post(unsigned* bar, volatile LAS unsigned* st, const unsigned xb_tid) {
    XcdBarrier b; b.bar = bar; b.x = xb_xcc_id(); b.st = st;
    if (xb_tid == 0) (void)xb_add(&bar[XB_XCNT(b.x)], 1u);
    return b;
}
__device__ __forceinline__ void xcd_barrier_complete(unsigned* bar, unsigned x, unsigned& nloc, unsigned& nx) {
    const unsigned G = gridDim.x * gridDim.y * gridDim.z;
    unsigned sum, cnt, mine, sp = 0u;
    for (;;) {
        sum = 0u; cnt = 0u; mine = 0u;
#pragma unroll
        for (unsigned j = 0; j < 16; ++j) { const unsigned c = xb_ld(&bar[XB_XCNT(j)]); sum += c; cnt += (c > 0u) ? 1u : 0u; mine = (j == x) ? c : mine; }
        if (sum == G) break;
        __builtin_amdgcn_s_sleep(1);
        if ((++sp & 255u) == 0u) { if (xb_ld(&bar[XB_TMO])) break; if (sp > XB_SPIN_CAP) { atomicAdd(&bar[XB_TMO], 1u); break; } }
    }
    nloc = mine > 0u ? mine : 1u; nx = cnt > 0u ? cnt : 1u;
}

__device__ __forceinline__ void xcd_barrier(const XcdBarrier& b, const unsigned xb_tid) {
    asm volatile("s_waitcnt vmcnt(0)" ::: "memory");
    __syncthreads();
    if (xb_tid == 0) {
        unsigned* bar = b.bar;
        __builtin_amdgcn_s_waitcnt(0);
        unsigned nloc = b.st[0], nx = b.st[1];
        if (nloc == 0u) { xcd_barrier_complete(bar, b.x, nloc, nx); b.st[0] = nloc; b.st[1] = nx; }
        const unsigned old = xb_add(&bar[XB_XSUB(b.x)], 1u);
        const unsigned gen = old / nloc;
        if (old + 1u == (gen + 1u) * nloc) {
            __builtin_amdgcn_fence(__ATOMIC_RELEASE, "agent");
            asm volatile("s_waitcnt vmcnt(0)" ::: "memory");
            const unsigned og = xb_add(&bar[XB_TOP], 1u);
            const unsigned tg = og / nx;
            if (og + 1u == (tg + 1u) * nx) xb_add(&bar[XB_TOPGEN], 1u);
            else XB_SPIN(xb_ld(&bar[XB_TOPGEN]) == tg, bar);
            __builtin_amdgcn_fence(__ATOMIC_ACQUIRE, "agent");
            xb_add(&bar[XB_XGEN(b.x)], 1u);
            asm volatile("s_waitcnt vmcnt(0)" ::: "memory");
        } else {
            XB_SPIN(xb_ld(&bar[XB_XGEN(b.x)]) == gen, bar);
            __builtin_amdgcn_fence(__ATOMIC_ACQUIRE, "agent");
            asm volatile("s_waitcnt vmcnt(0)" ::: "memory");
        }
    }
    __syncthreads();
}

namespace pg8 {
constexpr int BM = 256, BK = 64, HALF = 128, HTB = HALF * BK * 2  , STAGE_BYTES = 8 * HTB, NXCD = 8, WGM = 8;
__host__ __device__ __forceinline__ int lds_byte(int r, int c) { const int st = (r >> 4) * 2 + (c >> 5), rr = r & 15, cc = c & 31, ob = rr * 64 + cc * 2; return st * 1024 + (ob ^ (((ob >> 9) & 1) << 5)); }
__host__ __device__ __forceinline__ void stage_rc(int b, int& R, int& C) { const int st = b / 1024, sb = b % 1024, swz = sb ^ (((sb >> 9) & 1) << 5); R = (st >> 1) * 16 + swz / 64; C = (st & 1) * 32 + (swz % 64) / 2; }
__host__ __device__ __forceinline__ int perm32(int rho) { const int n = rho >> 4, i = rho & 15; return 8 * (i >> 2) + 4 * n + (i & 3); }

struct Unit { int pm, pn, e, r0; };

__device__ __forceinline__ unsigned cvt_pk_bf16(float lo, float hi) { unsigned r; asm volatile("v_cvt_pk_bf16_f32 %0, %1, %2" : "=v"(r) : "v"(lo), "v"(hi)); return r; }

template <int K, class Epi, class Sched>
__device__ __forceinline__ void gemm_phase(const int tid, LAS unsigned char* lds, const char* Abase, const Sched& S, const Epi& E) {
    const int wid = __builtin_amdgcn_readfirstlane(tid >> 6), lane = tid & 63, wr = wid >> 2, wc = wid & 3, fr = lane & 15, fq = lane >> 4;
    const int nt = K / BK;
    constexpr bool DN = Sched::DENSE;
    int RA[2], CA[2]; unsigned voffB[2], voffA[2];
#pragma unroll
    for (int i = 0; i < 2; ++i) { int R, C; stage_rc(tid * 16 + i * 8192, R, C); const int Rb = Epi::PERM ? ((R & ~31) + perm32(R & 31)) : R;
        RA[i] = R; CA[i] = C; voffB[i] = (unsigned)(Rb * K + C) * 2u; voffA[i] = (unsigned)(R * K + C) * 2u; }
    const size_t kstep = (size_t)(BK * 2);
    const size_t hstep = (size_t)HALF * K * 2;
    const size_t tstep = 2 * hstep;
    const unsigned ldsw = (unsigned)wid * 1024u;
    const int aoff = lds_byte(wr * 64 + fr, fq * 8), boff = lds_byte(wc * 32 + fr, fq * 8);
#define PG8_SA(b, h) (((b) * 2 + (h)) * HTB)
#define PG8_SB(b, h) ((4 + (b) * 2 + (h)) * HTB)
#define PG8_STAGE(bufoff, gbase, voff) do { _Pragma("unroll") for (int _i = 0; _i < 2; ++_i) \
        __builtin_amdgcn_global_load_lds((const __attribute__((address_space(1))) unsigned*)((const __attribute__((address_space(1))) char*)(gbase) + (voff)[_i]), (LAS unsigned*)(lds + (bufoff) + ldsw + _i * 8192), 16, 0, 0); } while (0)
#define PG8_LDA(dst, b, h) do { _Pragma("unroll") for (int m = 0; m < 4; ++m) _Pragma("unroll") for (int k = 0; k < 2; ++k) dst[m][k] = *(const LAS bf16x8*)(lds + PG8_SA(b, h) + aoff + m * 2048 + k * 1024); } while (0)
#define PG8_LDB(dst, b, h) do { _Pragma("unroll") for (int n = 0; n < 2; ++n) _Pragma("unroll") for (int k = 0; k < 2; ++k) dst[n][k] = *(const LAS bf16x8*)(lds + PG8_SB(b, h) + boff + n * 2048 + k * 1024); } while (0)
#define PG8_MMA(ai, bj, At, Bt) do { __builtin_amdgcn_s_setprio(1); _Pragma("unroll") for (int m = 0; m < 4; ++m) _Pragma("unroll") for (int n = 0; n < 2; ++n) _Pragma("unroll") for (int k = 0; k < 2; ++k) \
        acc[ai][bj][m][n] = __builtin_amdgcn_mfma_f32_16x16x32_bf16(Bt[n][k], At[m][k], acc[ai][bj][m][n], 0, 0, 0); __builtin_amdgcn_s_setprio(0); } while (0)
#define PG8_WAIT_V(n) asm volatile("s_waitcnt vmcnt(" #n ")" ::: "memory")
#define PG8_WAIT_L(n) asm volatile("s_waitcnt lgkmcnt(" #n ")" ::: "memory")
#define PG8_BAR __builtin_amdgcn_s_barrier()
#define PG8_SCHED __builtin_amdgcn_sched_barrier(0)
#define PG8_AOFF(dst, u) do { _Pragma("unroll") for (int _h = 0; _h < 2; ++_h) _Pragma("unroll") for (int _i = 0; _i < 2; ++_i) \
        dst[_h][_i] = ((unsigned)S.a_row(u, _h * HALF + RA[_i]) * (unsigned)K + (unsigned)CA[_i]) * 2u; } while (0)
    Unit cur, nxt; int ui = 0;
    if (!S.next(0, cur)) return;
    f32x4 acc[2][2][4][2];
#pragma unroll
    for (int a = 0; a < 2; ++a)
#pragma unroll
        for (int b = 0; b < 2; ++b)
#pragma unroll
            for (int m = 0; m < 4; ++m)
#pragma unroll
                for (int n = 0; n < 2; ++n) acc[a][b][m][n] = (f32x4){0.f, 0.f, 0.f, 0.f};
    bf16x8 At[4][2], B0[2][2], B1[2][2];
    unsigned cO[2][2], nO[2][2];
    const char* cA = Abase; const char* nA = Abase;
    if constexpr (DN) cA = Abase + (size_t)S.a_row(cur, 0) * K * 2; else PG8_AOFF(cO, cur);
    const char* cB = S.b_ptr(cur);
#define PG8_STA(bufoff, h_, kb_, nx_) do { if constexpr (DN) PG8_STAGE(bufoff, ((nx_) ? nA : cA) + (h_) * hstep + (kb_), voffA); else PG8_STAGE(bufoff, Abase + (kb_), ((nx_) ? nO : cO)[h_]); } while (0)
    PG8_STAGE(PG8_SB(0, 0), cB, voffB); PG8_SCHED; PG8_STA(PG8_SA(0, 0), 0, 0, false); PG8_SCHED; PG8_STAGE(PG8_SB(0, 1), cB + hstep, voffB); PG8_SCHED; PG8_STA(PG8_SA(0, 1), 1, 0, false); PG8_SCHED;
    if (wr == 1) PG8_BAR;
    PG8_WAIT_V(4); PG8_BAR;
    PG8_STAGE(PG8_SB(1, 0), cB + kstep, voffB); PG8_SCHED; PG8_STA(PG8_SA(1, 0), 0, kstep, false); PG8_SCHED; PG8_STAGE(PG8_SB(1, 1), cB + hstep + kstep, voffB); PG8_SCHED;
    PG8_WAIT_V(6); PG8_BAR;
    for (;;) {
        const bool has_next = S.next(ui + 1, nxt);
        const char* nB = cB; nA = cA;
        if (has_next) { if constexpr (DN) nA = Abase + (size_t)S.a_row(nxt, 0) * K * 2; else PG8_AOFF(nO, nxt); nB = S.b_ptr(nxt); }
        else if constexpr (!DN) {
#pragma unroll
            for (int h = 0; h < 2; ++h)
#pragma unroll
                for (int i = 0; i < 2; ++i) nO[h][i] = cO[h][i]; }
        for (int t = 0; t < nt; t += 2) {
            const bool last = (t == nt - 2);
            const size_t k1 = (size_t)(t + 1) * kstep, k2 = last ? 0 : (size_t)(t + 2) * kstep, k3 = k2 + kstep;
            const char* b2 = last ? nB : cB + (size_t)(t + 2) * kstep; const char* b3 = b2 + kstep;
            PG8_LDB(B0, 0, 0); PG8_SCHED; PG8_LDA(At, 0, 0); PG8_STA(PG8_SA(1, 1), 1, k1, false);
            PG8_WAIT_L(8); PG8_BAR; PG8_WAIT_L(0); PG8_MMA(0, 0, At, B0); PG8_BAR; PG8_SCHED;
            PG8_LDB(B1, 0, 1); PG8_STAGE(PG8_SB(0, 0), b2, voffB);
            PG8_BAR; PG8_WAIT_L(0); PG8_MMA(0, 1, At, B1); PG8_BAR;
            PG8_LDA(At, 0, 1); PG8_STA(PG8_SA(0, 0), 0, k2, last);
            PG8_BAR; PG8_WAIT_L(0); PG8_MMA(1, 0, At, B0); PG8_BAR; PG8_SCHED;
            PG8_STAGE(PG8_SB(0, 1), b2 + hstep, voffB);
            PG8_WAIT_V(6); PG8_BAR; PG8_MMA(1, 1, At, B1); PG8_BAR;
            PG8_LDB(B0, 1, 0); PG8_SCHED; PG8_LDA(At, 1, 0); PG8_STA(PG8_SA(0, 1), 1, k2, last);
            PG8_WAIT_L(8); PG8_BAR; PG8_WAIT_L(0); PG8_MMA(0, 0, At, B0); PG8_BAR; PG8_SCHED;
            PG8_LDB(B1, 1, 1); PG8_STAGE(PG8_SB(1, 0), b3, voffB);
            PG8_BAR; PG8_WAIT_L(0); PG8_MMA(0, 1, At, B1); PG8_BAR;
            PG8_LDA(At, 1, 1); PG8_STA(PG8_SA(1, 0), 0, k3, last);
            PG8_BAR; PG8_WAIT_L(0); PG8_MMA(1, 0, At, B0); PG8_BAR; PG8_SCHED;
            PG8_STAGE(PG8_SB(1, 1), b3 + hstep, voffB);
            PG8_WAIT_V(6); PG8_BAR; PG8_MMA(1, 1, At, B1); PG8_BAR;
        }
        E(acc, cur, wid);
        if (!has_next) break;
#pragma unroll
        for (int a = 0; a < 2; ++a)
#pragma unroll
            for (int b = 0; b < 2; ++b)
#pragma unroll
                for (int m = 0; m < 4; ++m)
#pragma unroll
                    for (int n = 0; n < 2; ++n) acc[a][b][m][n] = (f32x4){0.f, 0.f, 0.f, 0.f};
        cur = nxt; cB = nB; cA = nA; ++ui;
        if constexpr (!DN) {
#pragma unroll
        for (int h = 0; h < 2; ++h)
#pragma unroll
            for (int i = 0; i < 2; ++i) cO[h][i] = nO[h][i]; }
    }
    PG8_WAIT_V(0);
    if (wr == 0) PG8_BAR;
    PG8_BAR;
#undef PG8_SA
#undef PG8_SB
#undef PG8_STAGE
#undef PG8_LDA
#undef PG8_LDB
#undef PG8_MMA
#undef PG8_WAIT_V
#undef PG8_WAIT_L
#undef PG8_BAR
#undef PG8_SCHED
#undef PG8_AOFF
#undef PG8_STA
}
}
struct DenseSched {
    static constexpr bool DENSE = true;
    int nM, nN, nwg, G, c, K; const char* Bt;
    __device__ __forceinline__ void init(int M, int N, int K_, const bf16_t* Bt_, int G_, int c_) { nM = M / 256; nN = N / 256; nwg = nM * nN; G = G_; c = c_; K = K_; Bt = (const char*)Bt_; }
    __device__ __forceinline__ bool next(int i, pg8::Unit& u) const {
        const long L = (long)i * G + c; if (L >= nwg) return false;
        int wgid = (int)L; { const int q = nwg / 8, r = nwg % 8, xcd = wgid % 8, off = wgid / 8; wgid = (xcd < r ? xcd * (q + 1) : r * (q + 1) + (xcd - r) * q) + off; }
        const int nig = 8 * nN, gid = wgid / nig, fm = gid * 8, gsz = (nM - fm) < 8 ? (nM - fm) : 8;
        u.pm = fm + ((wgid % nig) % gsz); u.pn = (wgid % nig) / gsz; u.e = 0; u.r0 = 0; return true;
    }
    __device__ __forceinline__ int a_row(const pg8::Unit& u, int r) const { return u.pm * 256 + r; }
    __device__ __forceinline__ const char* b_ptr(const pg8::Unit& u) const { return Bt + (size_t)u.pn * 256 * K * 2; }
};
template <bool GATHER> struct MoeSched {
    static constexpr bool DENSE = !GATHER;
    const LAS int* tstart; const LAS int* cnt; int nN, G, c, K, row_lo; const int* ltok; const char* Bt; size_t bstride;
    __device__ __forceinline__ bool next(int i, pg8::Unit& u) const {
        const long L = (long)i * G + c; const int ntile = __builtin_amdgcn_readfirstlane(tstart[NE1]); if (L >= (long)ntile * nN) return false;
        const int tile = (int)(L / nN); u.pn = (int)(L % nN);
        int e = 0;
#pragma unroll 1
        for (int step = 64; step >= 1; step >>= 1) { const int e2 = e + step; if (e2 <= NE && tstart[e2] <= tile) e = e2; }
        e = __builtin_amdgcn_readfirstlane(e); u.e = e; u.pm = __builtin_amdgcn_readfirstlane(tile); u.pn = __builtin_amdgcn_readfirstlane(u.pn); u.r0 = __builtin_amdgcn_readfirstlane((tile - tstart[e]) * 256); return true;
    }
    __device__ __forceinline__ int a_row(const pg8::Unit& u, int r) const {
        if (!GATHER) return u.pm * 256 + r;
        const int ri = u.r0 + r;
        if (u.e == NE) return ri < cnt[NE] ? row_lo + ri : row_lo;
        return ri < cnt[u.e] ? ltok[(size_t)u.e * ROWS + ri] : row_lo;
    }
    __device__ __forceinline__ const char* b_ptr(const pg8::Unit& u) const { return Bt + (size_t)u.e * bstride + (size_t)u.pn * 256 * K * 2; }
};

struct EpiProj {
    static constexpr bool PERM = true;
    bf16_t* O; int ldc;
    __device__ __forceinline__ void operator()(const f32x4 (&acc)[2][2][4][2], const pg8::Unit& u, const int wid) const {
        const int lane_ = lane_id_asm(), fr = lane_ & 15, fq = lane_ >> 4, wr = wid >> 2, wc = wid & 3;
        const int row0 = u.pm * 256 + wr * 64 + fr, col0 = u.pn * 256 + wc * 32 + 8 * fq;
#pragma unroll
        for (int ai = 0; ai < 2; ++ai)
#pragma unroll
            for (int m = 0; m < 4; ++m) { bf16_t* rowp = O + (size_t)(row0 + ai * 128 + m * 16) * ldc + col0;
#pragma unroll
                for (int bj = 0; bj < 2; ++bj) { const f32x4 v0 = acc[ai][bj][m][0], v1 = acc[ai][bj][m][1];
                    u32x4 w; w.x = pg8::cvt_pk_bf16(v0[0], v0[1]); w.y = pg8::cvt_pk_bf16(v0[2], v0[3]); w.z = pg8::cvt_pk_bf16(v1[0], v1[1]); w.w = pg8::cvt_pk_bf16(v1[2], v1[3]);
                    *(u32x4*)(rowp + bj * 128) = w; } }
    }
};
struct EpiRes {
    static constexpr bool PERM = false;
    const float* xsrc; const float* csrc; float* xdst; float* cdst; const float* gate;
    __device__ __forceinline__ void operator()(const f32x4 (&acc)[2][2][4][2], const pg8::Unit& u, const int wid) const {
        const int lane_ = lane_id_asm(), fr = lane_ & 15, fq = lane_ >> 4, wr = wid >> 2, wc = wid & 3;
        const int col0 = u.pn * 256 + wc * 32 + 4 * fq;
        const bool isc = u.pm < 4; const int sel = isc ? 4 : (u.pm - 4) >> 5;
        const float* src = isc ? csrc + (size_t)u.pm * 256 * D : xsrc + (size_t)(u.pm - 4) * 256 * D;
        float* dst = isc ? cdst + (size_t)u.pm * 256 * D : xdst + (size_t)(u.pm - 4) * 256 * D;
        f32x4 gv[2][2];
#pragma unroll
        for (int bj = 0; bj < 2; ++bj)
#pragma unroll
            for (int n = 0; n < 2; ++n) gv[bj][n] = *(const f32x4*)(gate + sel * 6144 + col0 + bj * 128 + n * 16);
#pragma unroll
        for (int ai = 0; ai < 2; ++ai)
#pragma unroll
            for (int m = 0; m < 4; ++m) { const size_t off = (size_t)(ai * 128 + wr * 64 + m * 16 + fr) * D + col0;
#pragma unroll
                for (int bj = 0; bj < 2; ++bj)
#pragma unroll
                    for (int n = 0; n < 2; ++n) { const f32x4 s = *(const f32x4*)(src + off + bj * 128 + n * 16); *(f32x4*)(dst + off + bj * 128 + n * 16) = s + gv[bj][n] * acc[ai][bj][m][n]; }
                asm volatile("" ::: "memory"); }
    }
};
struct EpiGU {
    static constexpr bool PERM = false;
    bf16_t* H;
    __device__ __forceinline__ void operator()(const f32x4 (&acc)[2][2][4][2], const pg8::Unit& u, const int wid) const {
        const int lane_ = lane_id_asm(), fr = lane_ & 15, fq = lane_ >> 4, wr = wid >> 2, wc = wid & 3;
        const int row0 = u.pm * 256 + wr * 64 + fr;
#pragma unroll
        for (int ai = 0; ai < 2; ++ai)
#pragma unroll
            for (int m = 0; m < 4; ++m) { bf16_t* rowp = H + (size_t)(row0 + ai * 128 + m * 16) * EH + 4 * fq;
#pragma unroll
                for (int bj = 0; bj < 2; ++bj) { const f32x4 g = acc[ai][bj][m][0], up = acc[ai][bj][m][1]; float h[4];
#pragma unroll
                    for (int j = 0; j < 4; ++j) h[j] = g[j] / (1.0f + __expf(-g[j])) * up[j];
                    u32x2 w; w.x = pg8::cvt_pk_bf16(h[0], h[1]); w.y = pg8::cvt_pk_bf16(h[2], h[3]);
                    *(u32x2*)(rowp + (u.pn * 256 + bj * 128 + wc * 32) / 2) = w; } }
    }
};
struct EpiY {
    static constexpr bool PERM = true;
    bf16_t* Y;
    __device__ __forceinline__ void operator()(const f32x4 (&acc)[2][2][4][2], const pg8::Unit& u, const int wid) const {
        const int lane_ = lane_id_asm(), fr = lane_ & 15, fq = lane_ >> 4, wr = wid >> 2, wc = wid & 3;
        const int row0 = u.pm * 256 + wr * 64 + fr, col0 = u.pn * 256 + wc * 32 + 8 * fq;
#pragma unroll
        for (int ai = 0; ai < 2; ++ai)
#pragma unroll
            for (int m = 0; m < 4; ++m) { bf16_t* rowp = Y + (size_t)(row0 + ai * 128 + m * 16) * 512 + col0;
#pragma unroll
                for (int bj = 0; bj < 2; ++bj) { const f32x4 v0 = acc[ai][bj][m][0], v1 = acc[ai][bj][m][1];
                    u32x4 w; w.x = pg8::cvt_pk_bf16(v0[0], v0[1]); w.y = pg8::cvt_pk_bf16(v0[2], v0[3]); w.z = pg8::cvt_pk_bf16(v1[0], v1[1]); w.w = pg8::cvt_pk_bf16(v1[2], v1[3]);
                    *(u32x4*)(rowp + bj * 128) = w; } }
    }
};
#define WSP(T, off) ((T*)(p.ws + (off)))

__device__ __forceinline__ void conv_tile(const int t, LAS float* tl, const float* __restrict__ src, int ldsrc, int k0, int n0, int nvalid, bf16_t* dst, int lddst, int mode) {
#pragma unroll
    for (int j = 0; j < 8; ++j) { const int idx = t + NTHR * j, k = idx >> 6, n = idx & 63; float v = 0.f; if (n0 + n < nvalid) v = src[(size_t)(k0 + k) * ldsrc + n0 + n]; tl[k * 65 + n] = v; }
    __syncthreads();
#pragma unroll
    for (int j = 0; j < 4; ++j) { const int pi = t + NTHR * j, n = pi >> 5, k = (pi & 31) * 2; const int nn = n0 + n;
        const int row = (mode == 0 || mode == 3) ? nn : ((nn >> 4) * 32 + (nn & 15) + (mode == 2 ? 16 : 0));
        float v0 = tl[k * 65 + n], v1 = tl[(k + 1) * 65 + n];
        if (mode == 3) { v0 -= bf2f((bf16_t)f2bf(v0)); v1 -= bf2f((bf16_t)f2bf(v1)); }
        *(unsigned*)(dst + (size_t)row * lddst + k0 + k) = pk2(v0, v1); }
    __syncthreads();
}
constexpr int CONV_A_UNITS = 2048 + 512 + 64;
__device__ __forceinline__ void conv_unit_A(const Cx& p, LAS float* tl, int u) {
    if (u < 2048) { const int l = u >> 10, r = u & 1023; conv_tile(p.tid, tl, PIN(I_WIN) + (size_t)l * D * INW, INW, (r >> 6) * 64, (r & 63) * 64, INW, WSP(bf16_t, WS_WIN) + (size_t)l * NPROJ * D, D, 0); }
    else if (u < 2560) { const int v = u - 2048, l = v >> 8, r = v & 255; conv_tile(p.tid, tl, PIN(I_WOUT) + (size_t)l * D * D, D, (r >> 4) * 64, (r & 15) * 64, D, WSP(bf16_t, WS_WOUT) + (size_t)l * D * D, D, 0); }
    else { const int v = u - 2560, l = v >> 5, lo = (v >> 4) & 1, r = v & 15; conv_tile(p.tid, tl, PIN(I_ROUT_W) + (size_t)l * D * NE, NE, r * 64, 0, NE, WSP(bf16_t, WS_ROUT) + (size_t)(l * 2 + lo) * NE * D, D, lo ? 3 : 0); }
}
constexpr int CONV_E_UNITS = NE1 * 192;
struct ConvDesc { const float* src; bf16_t* dst; int ldsrc, lddst, k0, n0, mode; };
__device__ __forceinline__ ConvDesc conv_desc_E(const Cx& p, int l, int u) {
    ConvDesc c; const int e = u / 192, r = u % 192;
    if (r < 128) { const int up = r >> 6, q = r & 63;
        c.src = e < NE ? PIN(up ? I_EXP_U : I_EXP_G) + ((size_t)l * NE + e) * D * EH : PIN(up ? I_SH_U : I_SH_G) + (size_t)l * D * EH;
        c.ldsrc = EH; c.k0 = (q >> 2) * 64; c.n0 = (q & 3) * 64; c.dst = WSP(bf16_t, WS_EXPGU) + (size_t)e * 512 * D; c.lddst = D; c.mode = 1 + up; }
    else { const int q = r - 128;
        c.src = e < NE ? PIN(I_EXP_D) + ((size_t)l * NE + e) * EH * D : PIN(I_SH_D) + (size_t)l * EH * D;
        c.ldsrc = D; c.k0 = (q >> 4) * 64; c.n0 = (q & 15) * 64; c.dst = WSP(bf16_t, WS_EXPD) + (size_t)e * D * EH; c.lddst = EH; c.mode = 0; }
    return c;
}
__device__ __forceinline__ void conv_experts(const Cx& p, LAS float* tl, int l) {
    const int t = p.tid; int u = p.bid; if (u >= CONV_E_UNITS) return;
    float v[8]; ConvDesc c = conv_desc_E(p, l, u);
#pragma unroll
    for (int j = 0; j < 8; ++j) { const int idx = t + NTHR * j; v[j] = c.src[(size_t)(c.k0 + (idx >> 6)) * c.ldsrc + c.n0 + (idx & 63)]; }
    for (;;) {
#pragma unroll
        for (int j = 0; j < 8; ++j) { const int idx = t + NTHR * j; tl[(idx >> 6) * 65 + (idx & 63)] = v[j]; }
        __syncthreads();
        const int un = u + p.G; const bool more = un < CONV_E_UNITS; const ConvDesc cn = conv_desc_E(p, l, more ? un : u);
        if (more) {
#pragma unroll
            for (int j = 0; j < 8; ++j) { const int idx = t + NTHR * j; v[j] = cn.src[(size_t)(cn.k0 + (idx >> 6)) * cn.ldsrc + cn.n0 + (idx & 63)]; } }
#pragma unroll
        for (int j = 0; j < 4; ++j) { const int pi = t + NTHR * j, n = pi >> 5, k = (pi & 31) * 2; const int nn = c.n0 + n;
            const int row = c.mode == 0 ? nn : ((nn >> 4) * 32 + (nn & 15) + (c.mode == 2 ? 16 : 0));
            *(unsigned*)(c.dst + (size_t)row * c.lddst + c.k0 + k) = pk2(tl[k * 65 + n], tl[(k + 1) * 65 + n]); }
        __syncthreads();
        if (!more) break;
        c = cn; u = un;
    }
}
__device__ __forceinline__ void phase_mod(const Cx& p, LAS unsigned char* lds) {
    LAS float* sv = (LAS float*)lds; LAS float* red = sv + 5 * D;
    const int tid = p.tid;
    if (p.bid >= 192) return;
    for (int i = tid; i < 5 * D; i += NTHR) { const int j = i >> 10, k = i & 1023; const float c = j < 4 ? PIN(I_C)[j * D + k] : PIN(I_CCTX)[k]; sv[i] = siluf_(c); }
    __syncthreads();
    for (int u = p.bid; u < 192; u += p.G) {
        const int l = u / 96, cb = u % 96, kg = tid >> 6, cl = tid & 63;
        const float* w = PIN(I_WMOD) + (size_t)l * D * 6144 + cb * 64 + cl;
        float a0 = 0.f, a1 = 0.f, a2 = 0.f, a3 = 0.f, a4 = 0.f;
#pragma unroll 8
        for (int kk = 0; kk < 128; ++kk) { const int k = kg * 128 + kk; const float wv = w[(size_t)k * 6144];
            a0 += sv[k] * wv; a1 += sv[D + k] * wv; a2 += sv[2 * D + k] * wv; a3 += sv[3 * D + k] * wv; a4 += sv[4 * D + k] * wv; }
        red[(kg * 5 + 0) * 64 + cl] = a0; red[(kg * 5 + 1) * 64 + cl] = a1; red[(kg * 5 + 2) * 64 + cl] = a2; red[(kg * 5 + 3) * 64 + cl] = a3; red[(kg * 5 + 4) * 64 + cl] = a4;
        __syncthreads();
        if (tid < 320) { const int j = tid >> 6; float s = 0.f;
#pragma unroll
            for (int g = 0; g < 8; ++g) s += red[(g * 5 + j) * 64 + cl];
            WSP(float, WS_MOD)[((size_t)l * 5 + j) * 6144 + cb * 64 + cl] = s + PIN(I_BMOD)[l * 6144 + cb * 64 + cl]; }
        __syncthreads();
    }
}
__device__ __forceinline__ const float* res_row(const Cx& p, int layer_src0, int r) {
    if (r < CROWS) return (layer_src0 ? PIN(I_CTX) : (const float*)WSP(float, WS_CTXRES)) + (size_t)r * D;
    return (layer_src0 ? PIN(I_X) : (const float*)p.out) + (size_t)(r - CROWS) * D;
}
__device__ __forceinline__ int row_sel(int r) { return r < CROWS ? 4 : (r - CROWS) >> 13; }

__device__ __forceinline__ void norm_ld(const float* src, f32x4 (&v)[4], int lane) {
#pragma unroll
    for (int i = 0; i < 4; ++i) v[i] = *(const f32x4*)(src + 256 * i + 4 * lane);
}
__device__ __forceinline__ void norm_fin(const f32x4 (&v)[4], const float* g, const float* shift, const float* scale, bf16_t* dst, const bool tolds, LAS bf16_t* ldst, LAS bf16_t* ldlo, int lane) {
    float ss = 0.f;
#pragma unroll
    for (int i = 0; i < 4; ++i) ss += v[i][0] * v[i][0] + v[i][1] * v[i][1] + v[i][2] * v[i][2] + v[i][3] * v[i][3];
    ss = wsum(ss); const float rstd = rsqrtf(ss * (1.0f / D) + 1e-6f);
#pragma unroll
    for (int i = 0; i < 4; ++i) { const int col = 256 * i + 4 * lane; const f32x4 gv = *(const f32x4*)(g + col), sh = *(const f32x4*)(shift + col), sc = *(const f32x4*)(scale + col);
        const f32x4 y = v[i] * rstd * gv * (sc + 1.0f) + sh; u32x2 w; w.x = pk2(y[0], y[1]); w.y = pk2(y[2], y[3]);
        *(u32x2*)(dst + col) = w;
        if (tolds) { *(LAS u32x2*)(ldst + col) = w; u32x2 wl;
            wl.x = pk2(y[0] - __uint_as_float(w.x << 16), y[1] - __uint_as_float(w.x & 0xffff0000u)); wl.y = pk2(y[2] - __uint_as_float(w.y << 16), y[3] - __uint_as_float(w.y & 0xffff0000u));
            *(LAS u32x2*)(ldlo + col) = wl; } }
}
__device__ __forceinline__ void phase_norm1(const Cx& p, int layer) {
    const int lane = p.tid & 63, wave = p.tid >> 6;
    const float* mod = WSP(float, WS_MOD) + (size_t)layer * 5 * 6144; const float* g = PIN(I_N1G) + layer * D; bf16_t* hb = WSP(bf16_t, WS_HBUF);
    for (int r = p.bid * 16 + wave * 2; r < ROWS; r += p.G * 16) { f32x4 v0[4], v1[4];
        norm_ld(res_row(p, layer == 0, r), v0, lane); norm_ld(res_row(p, layer == 0, r + 1), v1, lane);
        const int s0 = row_sel(r), s1 = row_sel(r + 1);
        norm_fin(v0, g, mod + s0 * 6144 + 0, mod + s0 * 6144 + 1024, hb + (size_t)r * D, false, (LAS bf16_t*)0, (LAS bf16_t*)0, lane);
        norm_fin(v1, g, mod + s1 * 6144 + 0, mod + s1 * 6144 + 1024, hb + (size_t)(r + 1) * D, false, (LAS bf16_t*)0, (LAS bf16_t*)0, lane); }
}
__device__ __forceinline__ void phase_prep(const Cx& p, LAS unsigned char* lds, int layer, int b) {
    const int lane = p.tid & 63, wave = __builtin_amdgcn_readfirstlane(p.tid >> 6);
    const bf16_t* proj = WSP(bf16_t, WS_PROJ);
    if (p.bid < SB / 33) {
        LAS float* wl = (LAS float*)lds;
        { const float* AW = PIN(I_RW_AW2) + (size_t)layer * 32 * 256; const float* WW = PIN(I_RW_W2) + (size_t)layer * 2 * 32 * 256;
          for (int i = p.tid; i < 96 * 256; i += NTHR) wl[i] = i < 32 * 256 ? AW[i] : WW[i - 32 * 256]; }
        __syncthreads();
        const int h = wave & 3, half = wave >> 2, c = 64 * h + lane;
        const float a0 = PIN(I_RW_A0)[layer * 256 + c], w0f = PIN(I_RW_W0)[(layer * 2 + 0) * 256 + c], w0b = PIN(I_RW_W0)[(layer * 2 + 1) * 256 + c];
        const float kkm = PIN(I_RW_KK)[layer * 256 + c], kam = PIN(I_RW_KA)[layer * 256 + c];
        for (int u = p.bid; u < SB / 33; u += p.G) {
#pragma unroll 1
            for (int i0 = 0; i0 < (half ? 15 : 18); i0 += 3) {
                float xa[3], xf[3], xb[3], kv[3], sa[3], sf[3], sb[3];
#pragma unroll
                for (int t = 0; t < 3; ++t) { const bf16_t* pr = proj + (size_t)tok_row(b, u * 33 + half * 18 + i0 + t) * NPROJ; xa[t] = 0.f; xf[t] = 0.f; xb[t] = 0.f;
                    if (lane < 32) { xa[t] = bf2f(pr[PB_A + lane]); xf[t] = bf2f(pr[PB_WF + lane]); xb[t] = bf2f(pr[PB_WB + lane]); }
                    kv[t] = bf2f(pr[PB_K + c]); sa[t] = a0; sf[t] = w0f; sb[t] = w0b; }
#pragma unroll
                for (int t = 0; t < 3; ++t) { xf[t] = tanhf_(xf[t]); xb[t] = tanhf_(xb[t]); }
#pragma unroll 4
                for (int j = 0; j < 32; ++j) { const float wa = wl[j * 256 + c], wf = wl[(32 + j) * 256 + c], wb = wl[(64 + j) * 256 + c];
#pragma unroll
                    for (int t = 0; t < 3; ++t) { sa[t] += rl(xa[t], j) * wa; sf[t] += rl(xf[t], j) * wf; sb[t] += rl(xb[t], j) * wb; } }
#pragma unroll
                for (int t = 0; t < 3; ++t) { const int s = u * 33 + half * 18 + i0 + t; const float a = sigmoidf_(sa[t]);
                    const float lwf = -__expf(-softplusf_(-sf[t]) - 0.5f), lwb = -__expf(-softplusf_(-sb[t]) - 0.5f);
                    const float kr = kv[t] * kkm; const float ss = wsum(kr * kr); const float kk = kr * rsqrtf(ss + 1e-6f);
                    const size_t o = (size_t)s * 256 + c;
                    WSP(float, SC_RK)[o] = kv[t] * (1.0f + (a - 1.0f) * kam); WSP(float, SC_RKK)[o] = kk; WSP(float, SC_RB)[o] = kk * a;
                    WSP(float, SC_RLW)[o] = lwf; WSP(float, SC_RLW)[(size_t)SB * 256 + o] = lwb; } }
        }
    }
    __syncthreads();
    { LAS bf16_t* T = (LAS bf16_t*)lds; const int tid = p.tid;
#define PC_LOAD(uu, v, vh) do { const int mixer_ = (uu) / (NTB * 3), r2_ = (uu) % (NTB * 3), rb_ = r2_ / 3, colbase_ = (mixer_ ? PD_Q : PC_X) + 256 * (r2_ % 3); \
          _Pragma("unroll") for (int q = 0; q < 12; ++q) { const int e = tid + NTHR * q, rr = e >> 11, tok = (e >> 5) & 63, ch = (e & 31) * 8; v[q] = (u32x4){0u, 0u, 0u, 0u}; \
              if (rb_ < 4) { if (rr == 1) v[q] = *(const u32x4*)(proj + (size_t)(b * NCTX + 64 * rb_ + tok) * NPROJ + colbase_ + ch); } \
              else { const int gr = rb_ - 4 + rr - 1; if (gr >= 0 && gr < GRIDH) v[q] = *(const u32x4*)(proj + (size_t)(CROWS + b * SEQ + gr * 64 + tok) * NPROJ + colbase_ + ch); } } \
          vh = (u32x4){0u, 0u, 0u, 0u}; if (tid < 192) { const int rr = tid >> 6, side = (tid >> 5) & 1, ch = (tid & 31) * 8;       \
              if (rb_ < 4 && rr == 1) { const int tk = side ? 64 * (rb_ + 1) : 64 * rb_ - 1; if (tk >= 0 && tk < NCTX) vh = *(const u32x4*)(proj + (size_t)(b * NCTX + tk) * NPROJ + colbase_ + ch); } } } while (0)
      int u = p.bid;
      if (u < 2 * NTB * 3) { u32x4 v[12], vh; PC_LOAD(u, v, vh);
        for (;;) { const int mixer = u / (NTB * 3), r2 = u % (NTB * 3), rb = r2 / 3, third = r2 % 3;
#pragma unroll
          for (int q = 0; q < 12; ++q) { const int e = tid + NTHR * q, rr = e >> 11, tok = (e >> 5) & 63, ch = (e & 31) * 8; *(LAS u32x4*)(T + (rr * 66 + tok + 1) * 256 + ch) = v[q]; }
          if (tid < 192) { const int rr = tid >> 6, side = (tid >> 5) & 1, ch = (tid & 31) * 8; *(LAS u32x4*)(T + (rr * 66 + (side ? 65 : 0)) * 256 + ch) = vh; }
          __syncthreads();
          const int un = u + p.G; const bool more = un < 2 * NTB * 3;
          if (more) PC_LOAD(un, v, vh);
          { const int c = tid & 255, th = tid >> 8, chn = 256 * third + c; float w[9];
            const float* cw = (mixer ? PIN(I_DN_CW) : PIN(I_SS_CW)) + (size_t)layer * 9 * 768 + chn;
#pragma unroll
            for (int k = 0; k < 9; ++k) w[k] = cw[k * 768];
            const float bias = mixer ? 0.f : PIN(I_SS_CB)[layer * 768 + chn];
            bf16_t* dst = (mixer ? WSP(bf16_t, SC_DQ) : WSP(bf16_t, SC_SX)) + (size_t)(64 * rb) * 768 + chn;
#pragma unroll 2
            for (int tk = 0; tk < 32; ++tk) { const int x = 32 * th + tk; float acc = bias;
#pragma unroll
                for (int dy = 0; dy < 3; ++dy)
#pragma unroll
                    for (int dx = 0; dx < 3; ++dx) acc += w[dy * 3 + dx] * bf2f(T[(dy * 66 + x + dx) * 256 + c]);
                float y = siluf_(acc);
                if (mixer && third < 2) { const float ss = wsum(y * y); y *= rsqrtf(ss + 1e-6f); if (third == 0) y *= 0.125f; }
                dst[(size_t)x * 768] = (bf16_t)f2bf(y); } }
          __syncthreads();
          if (!more) break;
          u = un; } }
#undef PC_LOAD
      for (int e = p.bid * NTHR + tid; e < SB * 24; e += p.G * NTHR) { const int s = e / 24, q = e % 24; const bf16_t* pr = proj + (size_t)tok_row(b, s) * NPROJ;
          if (q < 8) { const int d = q >> 2, h = q & 3; WSP(float, SC_SDT)[(size_t)s * 8 + q] = softplusf_(bf2f(pr[PC_DF + q]) + PIN(I_SS_DTB)[(layer * 2 + d) * 4 + h]); }
          else if (q < 16) { WSP(float, SC_DG)[(size_t)s * 16 + (q - 8)] = sigmoidf_(bf2f(pr[PD_BF + (q - 8)])); }
          else { const int q2 = q - 16, d = q2 >> 2, h = q2 & 3; WSP(float, SC_DG)[(size_t)s * 16 + 8 + q2] = -__expf(PIN(I_DN_ALOG)[(layer * 2 + d) * 4 + h]) * softplusf_(bf2f(pr[PD_AF + q2]) + PIN(I_DN_DTB)[(layer * 2 + d) * 4 + h]); } }
    }
}
__device__ __forceinline__ void phase_scan(const Cx& p, LAS unsigned char* lds, int layer, int b);
__device__ __forceinline__ float sum8_(float v) { v += DPPF(v, 0xB1); v += DPPF(v, 0x4E); v += DPPF(v, 0x141); return v; }
__device__ __forceinline__ float sum16_(float v) { v = sum8_(v); v += DPPF(v, 0x140); return v; }
__device__ __forceinline__ void bf8_to_f(const u32x4 w, float (&f)[8]) {
#pragma unroll
    for (int q = 0; q < 4; ++q) { f[2 * q] = __uint_as_float(w[q] << 16); f[2 * q + 1] = __uint_as_float(w[q] & 0xffff0000u); } }
__device__ __forceinline__ void phase_post(const Cx& p, LAS unsigned char* lds, int layer, int b) {
    const int tid = p.tid, tsub = tid >> 7, c8 = (tid & 127) * 8, mixer = c8 >> 8, cm = c8 & 255, hh = cm >> 6;
    const bf16_t* proj = WSP(bf16_t, WS_PROJ); const bf16_t* of = WSP(bf16_t, SC_OF); const bf16_t* obk = WSP(bf16_t, SC_OB); bf16_t* yc = WSP(bf16_t, WS_HBUF);
    LAS float* GW = (LAS float*)lds; LAS float* SG = GW + 64 * 256;
    if ((int)p.bid < SB / 33) { const float* gsrc = PIN(I_RW_GW2) + (size_t)layer * 64 * 256; for (int i = tid; i < 64 * 256; i += NTHR) GW[i] = gsrc[i]; }
    float g0[8], g1[8], g2[8];
#pragma unroll
    for (int q = 0; q < 8; ++q) { const int c = cm + q; g0[q] = 0.f; g1[q] = 0.f; g2[q] = 0.f;
        if (mixer == 0) g0[q] = PIN(I_GLA_NG)[layer * 256 + c];
        else if (mixer == 1) { g0[q] = PIN(I_RW_LNG)[layer * 256 + c]; g1[q] = PIN(I_RW_LNB)[layer * 256 + c]; g2[q] = PIN(I_RW_RK)[layer * 256 + c]; }
        else if (mixer == 2) { g0[q] = PIN(I_SS_NG)[layer * 256 + c]; g1[q] = PIN(I_SS_D)[layer * 4 + hh]; }
        else g0[q] = PIN(I_DN_NG)[layer * 256 + c]; }
    for (int u = p.bid; u < SB / 33; u += p.G) {
#pragma unroll 1
        for (int t0 = 0; t0 < 33; t0 += 4) { const int tk = t0 + tsub; const bool live = tk < 33; const int s = u * 33 + (live ? tk : 32), row = tok_row(b, s);
            const bf16_t* pr = proj + (size_t)row * NPROJ; float o[8], a[8], y[8];
            { float t1[8], t2[8]; bf8_to_f(*(const u32x4*)(of + (size_t)s * 1024 + c8), t1); bf8_to_f(*(const u32x4*)(obk + (size_t)s * 1024 + c8), t2);
#pragma unroll
              for (int q = 0; q < 8; ++q) o[q] = t1[q] + t2[q]; }
            __syncthreads();
            if (mixer == 1 && hh == 0) { float gl[8]; bf8_to_f(*(const u32x4*)(pr + PB_G + cm), gl);
#pragma unroll
                for (int q = 0; q < 8; ++q) SG[tsub * 64 + cm + q] = sigmoidf_(gl[q]); }
            if (mixer == 0) { bf8_to_f(*(const u32x4*)(pr + PA_G + cm), a); float ss = 0.f;
#pragma unroll
                for (int q = 0; q < 8; ++q) ss += o[q] * o[q];
                const float rs = rsqrtf(sum8_(ss) * (1.0f / 64.0f) + 1e-6f);
#pragma unroll
                for (int q = 0; q < 8; ++q) y[q] = o[q] * rs * g0[q] * siluf_(a[q]);
            } else if (mixer == 3) { bf8_to_f(*(const u32x4*)(pr + PD_Z + cm), a); float ss = 0.f;
#pragma unroll
                for (int q = 0; q < 8; ++q) ss += o[q] * o[q];
                const float rs = rsqrtf(sum8_(ss) * (1.0f / 64.0f) + 1e-6f);
#pragma unroll
                for (int q = 0; q < 8; ++q) y[q] = o[q] * rs * g0[q] * siluf_(a[q]);
            } else if (mixer == 2) { float xs[8]; bf8_to_f(*(const u32x4*)(pr + PC_Z + cm), a); bf8_to_f(*(const u32x4*)(WSP(bf16_t, SC_SX) + (size_t)s * 768 + cm), xs); float ss = 0.f;
#pragma unroll
                for (int q = 0; q < 8; ++q) { y[q] = (o[q] + g1[q] * xs[q]) * siluf_(a[q]); ss += y[q] * y[q]; }
                const float rs = rsqrtf(sum16_(ss) * (1.0f / 128.0f) + 1e-6f);
#pragma unroll
                for (int q = 0; q < 8; ++q) y[q] *= rs * g0[q];
            } else { float rr[8], vv[8]; bf8_to_f(*(const u32x4*)(pr + PB_R + cm), rr); bf8_to_f(*(const u32x4*)(pr + PB_V + cm), vv);
                const f32x4 k0 = *(const f32x4*)(WSP(float, SC_RK) + (size_t)s * 256 + cm), k1 = *(const f32x4*)(WSP(float, SC_RK) + (size_t)s * 256 + cm + 4);
                float su = 0.f, bo = 0.f;
#pragma unroll
                for (int q = 0; q < 8; ++q) { su += o[q]; bo += rr[q] * (q < 4 ? k0[q & 3] : k1[q & 3]) * g2[q]; }
                const float mu = sum8_(su) * (1.0f / 64.0f); bo = sum8_(bo); float va = 0.f;
#pragma unroll
                for (int q = 0; q < 8; ++q) { o[q] -= mu; va += o[q] * o[q]; }
                const float rs = rsqrtf(sum8_(va) * (1.0f / 64.0f) + 64e-5f);
#pragma unroll
                for (int q = 0; q < 8; ++q) y[q] = o[q] * rs * g0[q] + g1[q] + bo * vv[q]; }
            __syncthreads();
            if (mixer == 1) { float gt[8];
#pragma unroll
                for (int q = 0; q < 8; ++q) gt[q] = 0.f;
#pragma unroll 4
                for (int j = 0; j < 64; ++j) { const float sg = SG[tsub * 64 + j]; const f32x4 w0 = *(const LAS f32x4*)(GW + j * 256 + cm), w1 = *(const LAS f32x4*)(GW + j * 256 + cm + 4);
                    gt[0] += sg * w0[0]; gt[1] += sg * w0[1]; gt[2] += sg * w0[2]; gt[3] += sg * w0[3]; gt[4] += sg * w1[0]; gt[5] += sg * w1[1]; gt[6] += sg * w1[2]; gt[7] += sg * w1[3]; }
#pragma unroll
                for (int q = 0; q < 8; ++q) y[q] *= gt[q]; }
            if (live) *(u32x4*)(yc + (size_t)row * D + c8) = (u32x4){pk2(y[0], y[1]), pk2(y[2], y[3]), pk2(y[4], y[5]), pk2(y[6], y[7])};
        }
    }
}
constexpr int N2_TILE = 32, N2_STRIDE = 2064;
__device__ __forceinline__ void phase_norm2(const Cx& p, LAS unsigned char* lds, int layer, int row_lo) {
    const int tid = p.tid, lane = tid & 63, wave = __builtin_amdgcn_readfirstlane(tid >> 6), fr = lane & 15, fq = lane >> 4;
    const float* mod = WSP(float, WS_MOD) + (size_t)layer * 5 * 6144; const float* g = PIN(I_N2G) + layer * D; bf16_t* hb = WSP(bf16_t, WS_HBUF);
    const bf16_t* rt = WSP(bf16_t, WS_ROUT) + (size_t)layer * 2 * NE * D;
    LAS float* lg = (LAS float*)(lds + 2 * N2_TILE * N2_STRIDE);
    unsigned* cnt = WSP(unsigned, WS_CTL) + CW_CNT + layer * 80 * 16; int* ltok = WSP(int, WS_LTOK); int* tokt = WSP(int, WS_TOKT);
    const float rbias = PIN(I_ROUT_B)[layer * NE + lane];
    const int nun = (ROWS - row_lo) / N2_TILE;
    for (int u = p.bid; u < nun; u += p.G) { const int r0 = row_lo + u * N2_TILE;
#pragma unroll 1
        for (int i = 0; i < 4; i += 2) { const int tr = 4 * wave + i, r = r0 + tr; f32x4 v0[4], v1[4];
            norm_ld(res_row(p, 0, r), v0, lane); norm_ld(res_row(p, 0, r + 1), v1, lane);
            const int s0 = row_sel(r), s1 = row_sel(r + 1);
            norm_fin(v0, g, mod + s0 * 6144 + 3072, mod + s0 * 6144 + 4096, hb + (size_t)r * D, true, (LAS bf16_t*)(lds + tr * N2_STRIDE), (LAS bf16_t*)(lds + N2_TILE * N2_STRIDE + tr * N2_STRIDE), lane);
            norm_fin(v1, g, mod + s1 * 6144 + 3072, mod + s1 * 6144 + 4096, hb + (size_t)(r + 1) * D, true, (LAS bf16_t*)(lds + (tr + 1) * N2_STRIDE), (LAS bf16_t*)(lds + N2_TILE * N2_STRIDE + (tr + 1) * N2_STRIDE), lane); }
        __syncthreads();
        { const int mt = wave >> 2, nt = wave & 3; f32x4 acc = (f32x4){0.f, 0.f, 0.f, 0.f};
          const LAS unsigned char* ap = lds + (16 * mt + fr) * N2_STRIDE + fq * 16; const bf16_t* bp = rt + (size_t)(16 * nt + fr) * D + fq * 8;
#pragma unroll 4
          for (int ks = 0; ks < 32; ++ks) { const bf16x8 a = *(const LAS bf16x8*)(ap + ks * 64), al = *(const LAS bf16x8*)(ap + N2_TILE * N2_STRIDE + ks * 64);
              const bf16x8 bb = *(const bf16x8*)(bp + ks * 32), bl = *(const bf16x8*)(bp + NE * D + ks * 32);
              acc = __builtin_amdgcn_mfma_f32_16x16x32_bf16(a, bb, acc, 0, 0, 0); acc = __builtin_amdgcn_mfma_f32_16x16x32_bf16(al, bb, acc, 0, 0, 0); acc = __builtin_amdgcn_mfma_f32_16x16x32_bf16(a, bl, acc, 0, 0, 0); }
#pragma unroll
          for (int j = 0; j < 4; ++j) lg[(16 * mt + 4 * fq + j) * 64 + 16 * nt + fr] = acc[j]; }
        __syncthreads();
#pragma unroll 1
        for (int i = 0; i < 4; ++i) { const int tr = 4 * wave + i, r = r0 + tr;
            const float sc = sigmoidf_(lg[tr * 64 + lane]); float sel = sc + rbias; float ssum = 0.f; int myE = 0; float myS = 0.f;
#pragma unroll 1
            for (int k = 0; k < TOPK; ++k) { float bv = sel; int bi = lane;
#define ARGSTEP(OV, OI) do { const float ov_ = (OV); const int oi_ = (OI); if (ov_ > bv || (ov_ == bv && oi_ < bi)) { bv = ov_; bi = oi_; } } while (0)
                ARGSTEP(DPPF(bv, 0xB1), DPPI(bi, 0xB1)); ARGSTEP(DPPF(bv, 0x4E), DPPI(bi, 0x4E)); ARGSTEP(DPPF(bv, 0x141), DPPI(bi, 0x141)); ARGSTEP(DPPF(bv, 0x140), DPPI(bi, 0x140));
                ARGSTEP(__uint_as_float(__builtin_amdgcn_ds_swizzle(__float_as_uint(bv), 0x401F)), __builtin_amdgcn_ds_swizzle(bi, 0x401F));
                { const float v0 = rl(bv, 0), v1 = rl(bv, 32); const int i0 = __builtin_amdgcn_readlane(bi, 0), i1 = __builtin_amdgcn_readlane(bi, 32); if (v1 > v0 || (v1 == v0 && i1 < i0)) { bv = v1; bi = i1; } else { bv = v0; bi = i0; } }
#undef ARGSTEP
                const int e = __builtin_amdgcn_readfirstlane(bi); const float se = rl(sc, e);
                ssum += se; if (lane == k) { myE = e; myS = se; } if (lane == e) sel = -1e30f; }
            if (lane < TOPK) { const unsigned pos = atomicAdd(cnt + myE * 16, 1u); ltok[(size_t)myE * ROWS + pos] = r; tokt[(size_t)r * 16 + lane] = (myE << 16) | (int)pos; ((float*)tokt)[(size_t)r * 16 + 8 + lane] = myS / ssum * 2.5f; } }
        __syncthreads();
    }
}
__device__ __forceinline__ void moe_table(const Cx& p, LAS int* tb, int layer, int row_lo) {
    const unsigned* cnt = WSP(unsigned, WS_CTL) + CW_CNT + layer * 80 * 16;
    if (p.tid == 0) { int acc = 0;
#pragma unroll 1
        for (int e = 0; e < NE1; ++e) { const int c = e < NE ? (int)__hip_atomic_load(cnt + e * 16, __ATOMIC_RELAXED, __HIP_MEMORY_SCOPE_AGENT) : ROWS - row_lo; tb[e] = c; tb[128 + e] = acc; acc += (c + 255) >> 8; }
        tb[128 + NE1] = acc; }
    __syncthreads();
}
__device__ __forceinline__ void phase_combine(const Cx& p, const LAS int* tb, int layer, int row_lo, int half) {
    const int lane = p.tid & 63, wave = p.tid >> 6; const bf16_t* Y = WSP(bf16_t, WS_Y); const int* tokt = WSP(int, WS_TOKT);
    const float* gate = WSP(float, WS_MOD) + (size_t)layer * 5 * 6144 + 5120; const int col = 512 * half + 8 * lane; const int shbase = tb[128 + NE] * 256;
#pragma unroll 2
    for (int r = row_lo + p.bid * 8 + wave; r < ROWS; r += p.G * 8) {
        const int sw = lane < 16 ? tokt[(size_t)r * 16 + lane] : 0;
        float a[8];
        { const u32x4 y = *(const u32x4*)(Y + (size_t)(shbase + (r - row_lo)) * 512 + 8 * lane);
#pragma unroll
          for (int q = 0; q < 4; ++q) { a[2 * q] = __uint_as_float(y[q] << 16); a[2 * q + 1] = __uint_as_float(y[q] & 0xffff0000u); } }
#pragma unroll
        for (int k = 0; k < 8; ++k) { const int sl = __builtin_amdgcn_readlane(sw, k); const float w = __uint_as_float(__builtin_amdgcn_readlane(sw, 8 + k));
            const int hrow = tb[128 + (sl >> 16)] * 256 + (sl & 0xffff); const u32x4 y = *(const u32x4*)(Y + (size_t)hrow * 512 + 8 * lane);
#pragma unroll
            for (int q = 0; q < 4; ++q) { a[2 * q] += w * __uint_as_float(y[q] << 16); a[2 * q + 1] += w * __uint_as_float(y[q] & 0xffff0000u); } }
        float* x = (float*)res_row(p, 0, r) + col; const float* gp = gate + row_sel(r) * 6144 + col;
#pragma unroll
        for (int q = 0; q < 2; ++q) { const f32x4 gv = *(const f32x4*)(gp + 4 * q); f32x4 xv = *(const f32x4*)(x + 4 * q);
            xv[0] += gv[0] * a[4 * q]; xv[1] += gv[1] * a[4 * q + 1]; xv[2] += gv[2] * a[4 * q + 2]; xv[3] += gv[3] * a[4 * q + 3]; *(f32x4*)(x + 4 * q) = xv; }
    }
}
__device__ __forceinline__ void phase_final(const Cx& p) {
    const int lane = p.tid & 63, wave = p.tid >> 6; const float* g = PIN(I_FNG);
    for (int r = p.bid * 16 + wave * 2; r < NB * SEQ; r += p.G * 16) { f32x4 v[2][4];
        norm_ld(p.out + (size_t)r * D, v[0], lane); norm_ld(p.out + (size_t)(r + 1) * D, v[1], lane);
#pragma unroll
        for (int q = 0; q < 2; ++q) { float* x = p.out + (size_t)(r + q) * D; float ss = 0.f;
#pragma unroll
            for (int i = 0; i < 4; ++i) ss += v[q][i][0] * v[q][i][0] + v[q][i][1] * v[q][i][1] + v[q][i][2] * v[q][i][2] + v[q][i][3] * v[q][i][3];
            ss = wsum(ss); const float rstd = rsqrtf(ss * (1.0f / D) + 1e-6f);
#pragma unroll
            for (int i = 0; i < 4; ++i) *(f32x4*)(x + 256 * i + 4 * lane) = v[q][i] * rstd * *(const f32x4*)(g + 256 * i + 4 * lane); } }
}
__device__ __forceinline__ int chain_tb(int n, int d) { return d == 0 ? n : (n < 4 ? 3 - n : 135 - n); }
__device__ __forceinline__ int tb_row0(int b, int tb) { return tb < 4 ? b * NCTX + 64 * tb : CROWS + b * SEQ + 64 * (tb - 4); }
constexpr int TS = 144;
template <int K, int NT> __device__ __forceinline__ void mm_rows(const LAS unsigned char* A, int lda, const LAS unsigned char* Bt, int ldb, int mt, int nt0, int fr, int fq, f32x4 (&acc)[NT]) {
#pragma unroll
    for (int ks = 0; ks < K / 32; ++ks) { const bf16x8 a = *(const LAS bf16x8*)(A + (16 * mt + fr) * lda + ks * 64 + fq * 16);
#pragma unroll
        for (int nt = 0; nt < NT; ++nt) { const bf16x8 bb = *(const LAS bf16x8*)(Bt + (16 * (nt0 + nt) + fr) * ldb + ks * 64 + fq * 16);
            acc[nt] = __builtin_amdgcn_mfma_f32_16x16x32_bf16(a, bb, acc[nt], 0, 0, 0); } }
}
#define UNIT_LOOP(u, N, OFF) for (int u = (p.bid + p.G - ((OFF) % p.G)) % p.G; u < (N); u += p.G)
__device__ __forceinline__ void gla_p1(const Cx& p, LAS unsigned char* lds, int layer, int b) {
    const int tid = p.tid, lane = tid & 63, wave = __builtin_amdgcn_readfirstlane(tid >> 6), fr = lane & 15, fq = lane >> 4;
    LAS unsigned char* ksT = lds; LAS unsigned char* vT = lds + 64 * TS; LAS float* gs = (LAS float*)(lds + 2 * 64 * TS); LAS float* glb = gs + 512;
    const bf16_t* proj = WSP(bf16_t, WS_PROJ); const int mt = wave >> 1, nt0 = (wave & 1) * 2; const int cl = lane, tg = wave;
    float w2[16], gb; unsigned gw; bf16_t kq[8], vq[8];
#define GLA1_LOAD(uu) do { const int tb_ = (uu) >> 3, h_ = ((uu) >> 1) & 3, d_ = (uu) & 1, c_ = 64 * h_ + cl; const bf16_t* pr_ = proj + (size_t)tb_row0(b, tb_) * NPROJ; \
        _Pragma("unroll") for (int r = 0; r < 16; ++r) w2[r] = PIN(I_GLA_W2)[((size_t)(layer * 2 + d_) * 16 + r) * 256 + c_]; \
        gb = PIN(I_GLA_B)[(layer * 2 + d_) * 256 + c_]; \
        { const int e = tid * 2, i = e >> 4, r = e & 15; gw = *(const unsigned*)(pr_ + (size_t)i * NPROJ + (d_ ? PA_GB : PA_GF) + r); } \
        _Pragma("unroll") for (int i8 = 0; i8 < 8; ++i8) { const bf16_t* pa = pr_ + (size_t)(8 * tg + i8) * NPROJ; kq[i8] = pa[PA_K + c_]; vq[i8] = pa[PA_V + c_]; } } while (0)
    int u = (p.bid + p.G) % p.G;
    if (u < NUNIT) GLA1_LOAD(u);
    for (; u < NUNIT; u += p.G) { const int d = u & 1;
        glb[tid * 2] = __uint_as_float(gw << 16); glb[tid * 2 + 1] = __uint_as_float(gw & 0xffff0000u);
        __syncthreads();
        float bl[8]; float run = 0.f;
#pragma unroll
        for (int ii = 0; ii < 8; ++ii) { const int i8 = d ? 7 - ii : ii; const LAS float* gl_ = glb + (8 * tg + i8) * 16; float z = gb;
#pragma unroll
            for (int r = 0; r < 16; ++r) z += gl_[r] * w2[r];
            run += logsigmoidf_(z) * (1.0f / 16.0f); if (d) bl[7 - ii] = run; else bl[ii] = run; }
        gs[tg * 64 + cl] = run;
        __syncthreads();
        float off = 0.f, total = 0.f;
#pragma unroll
        for (int g2 = 0; g2 < 8; ++g2) { const float t = gs[g2 * 64 + cl]; total += t; if (d ? g2 > tg : g2 < tg) off += t; }
#pragma unroll
        for (int i8 = 0; i8 < 8; i8 += 2) { const int i = 8 * tg + i8;
            const float ka = bf2f(kq[i8]) * __expf(total - (bl[i8] + off)), kb = bf2f(kq[i8 + 1]) * __expf(total - (bl[i8 + 1] + off));
            *(LAS unsigned*)(ksT + cl * TS + i * 2) = pk2(ka, kb); *(LAS unsigned*)(vT + cl * TS + i * 2) = (unsigned)vq[i8] | ((unsigned)vq[i8 + 1] << 16); }
        if (u + p.G < NUNIT) GLA1_LOAD(u + p.G);
        if (tg == 0) WSP(float, SC_GLA_DEC)[(size_t)u * 64 + cl] = __expf(total);
        __syncthreads();
        { f32x4 acc[2] = {(f32x4){0.f, 0.f, 0.f, 0.f}, (f32x4){0.f, 0.f, 0.f, 0.f}}; float* kv = WSP(float, SC_GLA_S) + (size_t)u * 4096;
          mm_rows<64, 2>(ksT, TS, vT, TS, mt, nt0, fr, fq, acc);
#pragma unroll
          for (int t = 0; t < 2; ++t)
#pragma unroll
              for (int j = 0; j < 4; ++j) kv[(16 * mt + 4 * fq + j) * 64 + 16 * (nt0 + t) + fr] = acc[t][j]; }
        __syncthreads();
    }
#undef GLA1_LOAD
}
__device__ __forceinline__ void gla_chain(const Cx& p, int h, int d, int part) {
    if (p.tid >= 256) return;
    const int e0 = part * 1024 + p.tid * 4, dk = e0 >> 6;
    f32x4 s0 = (f32x4){0.f, 0.f, 0.f, 0.f};
    f32x4 n0[6]; float dc[6];
#define GC_LD(q, n_) do { const int u_ = (chain_tb((n_), d) * 4 + h) * 2 + d; n0[q] = *(const f32x4*)(WSP(float, SC_GLA_S) + (size_t)u_ * 4096 + e0); dc[q] = WSP(float, SC_GLA_DEC)[(size_t)u_ * 64 + dk]; } while (0)
#define GC_ST(q, n_) do { const int u_ = (chain_tb((n_), d) * 4 + h) * 2 + d; float* k_ = WSP(float, SC_GLA_S) + (size_t)u_ * 4096 + e0; \
        const f32x4 a0_ = n0[q]; const float de_ = dc[q]; if ((n_) + 6 < NTB) GC_LD(q, (n_) + 6); *(f32x4*)k_ = s0; s0 = s0 * de_ + a0_; } while (0)
    GC_LD(0, 0); GC_LD(1, 1); GC_LD(2, 2); GC_LD(3, 3); GC_LD(4, 4); GC_LD(5, 5);
#pragma unroll 1
    for (int n = 0; n < NTB; n += 6) { GC_ST(0, n); GC_ST(1, n + 1); GC_ST(2, n + 2); GC_ST(3, n + 3); GC_ST(4, n + 4); GC_ST(5, n + 5); }
#undef GC_LD
#undef GC_ST
}
__device__ __forceinline__ void gla_p2(const Cx& p, LAS unsigned char* lds, int layer, int b) {
    const int tid = p.tid, lane = tid & 63, wave = __builtin_amdgcn_readfirstlane(tid >> 6), fr = lane & 15, fq = lane >> 4;
    LAS unsigned char* qt = lds; LAS unsigned char* kt = lds + 64 * TS; LAS unsigned char* vT = lds + 2 * 64 * TS; LAS unsigned char* sT = lds + 3 * 64 * TS; LAS unsigned char* att = lds + 4 * 64 * TS;
    LAS float* gs = (LAS float*)(lds + 5 * 64 * TS); LAS float* glb = gs + 512;
    const bf16_t* proj = WSP(bf16_t, WS_PROJ); const int cl = lane, tg = wave;
    float w2[16], gb; unsigned gw; bf16_t qq[8], kq[8], vq[8]; float sq[8];
#define GLA2_LOAD(uu) do { const int tb_ = (uu) >> 3, h_ = ((uu) >> 1) & 3, d_ = (uu) & 1, c_ = 64 * h_ + cl; const bf16_t* pr_ = proj + (size_t)tb_row0(b, tb_) * NPROJ; \
        _Pragma("unroll") for (int r = 0; r < 16; ++r) w2[r] = PIN(I_GLA_W2)[((size_t)(layer * 2 + d_) * 16 + r) * 256 + c_]; \
        gb = PIN(I_GLA_B)[(layer * 2 + d_) * 256 + c_]; \
        { const int e = tid * 2, i = e >> 4, r = e & 15; gw = *(const unsigned*)(pr_ + (size_t)i * NPROJ + (d_ ? PA_GB : PA_GF) + r); } \
        _Pragma("unroll") for (int i8 = 0; i8 < 8; ++i8) { const bf16_t* pa = pr_ + (size_t)(8 * tg + i8) * NPROJ; qq[i8] = pa[PA_Q + c_]; kq[i8] = pa[PA_K + c_]; vq[i8] = pa[PA_V + c_]; } \
        { const float* sp_ = WSP(float, SC_GLA_S) + (size_t)(uu) * 4096; _Pragma("unroll") for (int q = 0; q < 8; ++q) sq[q] = sp_[tid + NTHR * q]; } } while (0)
    int u = (p.bid + p.G - (128 % p.G)) % p.G;
    if (u < NUNIT) GLA2_LOAD(u);
    for (; u < NUNIT; u += p.G) { const int tb = u >> 3, h = (u >> 1) & 3, d = u & 1; const int s0 = 64 * tb;
        glb[tid * 2] = __uint_as_float(gw << 16); glb[tid * 2 + 1] = __uint_as_float(gw & 0xffff0000u);
#pragma unroll
        for (int q = 0; q < 8; ++q) { const int e = tid + NTHR * q, dk = e >> 6, dv = e & 63; *(LAS bf16_t*)(sT + dv * TS + dk * 2) = (bf16_t)f2bf(sq[q]); }
        __syncthreads();
        float bl[8]; float run = 0.f;
#pragma unroll
        for (int ii = 0; ii < 8; ++ii) { const int i8 = d ? 7 - ii : ii; const LAS float* gl_ = glb + (8 * tg + i8) * 16; float z = gb;
#pragma unroll
            for (int r = 0; r < 16; ++r) z += gl_[r] * w2[r];
            run += logsigmoidf_(z) * (1.0f / 16.0f); if (d) bl[7 - ii] = run; else bl[ii] = run; }
        gs[tg * 64 + cl] = run;
        __syncthreads();
        float off = 0.f;
#pragma unroll
        for (int g2 = 0; g2 < 8; ++g2) if (d ? g2 > tg : g2 < tg) off += gs[g2 * 64 + cl];
#pragma unroll
        for (int i8 = 0; i8 < 8; ++i8) { const int i = 8 * tg + i8; const float bi = bl[i8] + off;
            *(LAS bf16_t*)(qt + i * TS + cl * 2) = (bf16_t)f2bf(bf2f(qq[i8]) * 0.125f * __expf(bi));
            *(LAS bf16_t*)(kt + i * TS + cl * 2) = (bf16_t)f2bf(bf2f(kq[i8]) * __expf(-bi));
            *(LAS bf16_t*)(vT + cl * TS + i * 2) = vq[i8]; }
        if (u + p.G < NUNIT) GLA2_LOAD(u + p.G);
        __syncthreads();
        const int mt = wave >> 1, nt0 = (wave & 1) * 2;
        { f32x4 acc[2] = {(f32x4){0.f, 0.f, 0.f, 0.f}, (f32x4){0.f, 0.f, 0.f, 0.f}};
          mm_rows<64, 2>(qt, TS, kt, TS, mt, nt0, fr, fq, acc);
#pragma unroll
          for (int t = 0; t < 2; ++t)
#pragma unroll
              for (int j = 0; j < 4; ++j) { const int i = 16 * mt + 4 * fq + j, jj = 16 * (nt0 + t) + fr; const bool keep = d ? jj >= i : jj <= i;
                  *(LAS bf16_t*)(att + i * TS + jj * 2) = (bf16_t)f2bf(keep ? acc[t][j] : 0.f); } }
        __syncthreads();
        { f32x4 acc[2] = {(f32x4){0.f, 0.f, 0.f, 0.f}, (f32x4){0.f, 0.f, 0.f, 0.f}};
          mm_rows<64, 2>(att, TS, vT, TS, mt, nt0, fr, fq, acc);
          mm_rows<64, 2>(qt, TS, sT, TS, mt, nt0, fr, fq, acc);
          bf16_t* ob = WSP(bf16_t, d ? SC_OB : SC_OF);
#pragma unroll
          for (int t = 0; t < 2; ++t)
#pragma unroll
              for (int j = 0; j < 4; ++j) ob[(size_t)(s0 + 16 * mt + 4 * fq + j) * 1024 + 64 * h + 16 * (nt0 + t) + fr] = (bf16_t)f2bf(acc[t][j]); }
        __syncthreads();
    }
}
#undef GLA2_LOAD
constexpr int TS2 = 272;
__device__ __forceinline__ float ssd_acum(float a, int d, int lane, float& total) {
    float pre = a;
#pragma unroll
    for (int o = 1; o < 64; o <<= 1) { const float t = shup_(pre, lane, o); if (lane >= o) pre += t; }
    total = rl(pre, 63);
    return d ? total - pre + a : pre;
}
__device__ __forceinline__ void ssd_p1(const Cx& p, LAS unsigned char* lds, int layer, int b) {
    const int tid = p.tid, lane = tid & 63, wave = __builtin_amdgcn_readfirstlane(tid >> 6), fr = lane & 15, fq = lane >> 4;
    LAS unsigned char* BT = lds; LAS unsigned char* xT = lds + 128 * TS; LAS float* AC = (LAS float*)(lds + 128 * TS + 64 * TS);
    u32x4 bq[2], xq; float dtq;
#define SSD1_LOAD(uu) do { const int tb_ = (uu) >> 3, g_ = ((uu) >> 2) & 1, hd_ = (uu) & 3, h_ = 2 * g_ + (hd_ >> 1), d_ = hd_ & 1; \
        const bf16_t* sx_ = WSP(bf16_t, SC_SX) + (size_t)(64 * tb_ + lane) * 768; \
        bq[0] = *(const u32x4*)(sx_ + 256 + 128 * g_ + 16 * wave); bq[1] = *(const u32x4*)(sx_ + 256 + 128 * g_ + 16 * wave + 8); \
        xq = *(const u32x4*)(sx_ + 64 * h_ + 8 * wave); dtq = WSP(float, SC_SDT)[(size_t)(64 * tb_ + lane) * 8 + d_ * 4 + h_]; } while (0)
    int u3 = (p.bid + p.G - (32 % p.G)) % p.G;
    if (u3 < NTB * 8) SSD1_LOAD(u3);
    for (; u3 < NTB * 8; u3 += p.G) { const int tb = u3 >> 3, g = (u3 >> 2) & 1, hd = u3 & 3, h = 2 * g + (hd >> 1), d = hd & 1;
        if (wave == 0) { const float aneg = -__expf(PIN(I_SS_ALOG)[(layer * 2 + d) * 4 + h]);
            float tot; const float ac = ssd_acum(aneg * dtq, d, lane, tot); AC[lane] = ac; if (lane == 0) { AC[64] = tot; WSP(float, SC_SSD_CD)[(tb * 4 + h) * 2 + d] = __expf(tot); } }
#pragma unroll
        for (int q = 0; q < 2; ++q)
#pragma unroll
            for (int k = 0; k < 8; ++k) *(LAS bf16_t*)(BT + (16 * wave + 8 * q + k) * TS + lane * 2) = (bf16_t)(bq[q][k >> 1] >> (16 * (k & 1)));
        __syncthreads();
        { const float f = dtq * __expf(AC[64] - AC[lane]);
#pragma unroll
          for (int k = 0; k < 8; ++k) *(LAS bf16_t*)(xT + (8 * wave + k) * TS + lane * 2) = (bf16_t)f2bf(bf2f((bf16_t)(xq[k >> 1] >> (16 * (k & 1)))) * f); }
        if (u3 + p.G < NTB * 8) SSD1_LOAD(u3 + p.G);
        __syncthreads();
        { const int mt = wave >> 1, nt0 = (wave & 1) * 4; float* cs = WSP(float, SC_SSD_S) + (size_t)((tb * 4 + h) * 2 + d) * 8192; f32x4 acc[4];
#pragma unroll
          for (int t = 0; t < 4; ++t) acc[t] = (f32x4){0.f, 0.f, 0.f, 0.f};
          mm_rows<64, 4>(xT, TS, BT, TS, mt, nt0, fr, fq, acc);
#pragma unroll
          for (int t = 0; t < 4; ++t)
#pragma unroll
              for (int j = 0; j < 4; ++j) cs[(16 * mt + 4 * fq + j) * 128 + 16 * (nt0 + t) + fr] = acc[t][j]; }
        __syncthreads();
    }
#undef SSD1_LOAD
}
__device__ __forceinline__ void ssd_chain(const Cx& p, int h, int d, int part) {
    if (p.tid >= 256) return;
    const int e0 = part * 1024 + p.tid * 4;
    f32x4 s = (f32x4){0.f, 0.f, 0.f, 0.f}; f32x4 nx[6]; float cd[6];
#define SC_LD(q, n_) do { const int u_ = (chain_tb((n_), d) * 4 + h) * 2 + d; nx[q] = *(const f32x4*)(WSP(float, SC_SSD_S) + (size_t)u_ * 8192 + e0); cd[q] = WSP(float, SC_SSD_CD)[u_]; } while (0)
#define SC_ST(q, n_) do { const int u_ = (chain_tb((n_), d) * 4 + h) * 2 + d; float* c_ = WSP(float, SC_SSD_S) + (size_t)u_ * 8192 + e0; const f32x4 a_ = nx[q]; const float de_ = cd[q]; \
        if ((n_) + 6 < NTB) SC_LD(q, (n_) + 6); *(f32x4*)c_ = s; s = s * de_ + a_; } while (0)
    SC_LD(0, 0); SC_LD(1, 1); SC_LD(2, 2); SC_LD(3, 3); SC_LD(4, 4); SC_LD(5, 5);
#pragma unroll 1
    for (int n = 0; n < NTB; n += 6) { SC_ST(0, n); SC_ST(1, n + 1); SC_ST(2, n + 2); SC_ST(3, n + 3); SC_ST(4, n + 4); SC_ST(5, n + 5); }
#undef SC_LD
#undef SC_ST
}
__device__ __forceinline__ void ssd_p2(const Cx& p, LAS unsigned char* lds, int layer, int b) {
    const int tid = p.tid, lane = tid & 63, wave = __builtin_amdgcn_readfirstlane(tid >> 6), fr = lane & 15, fq = lane >> 4;
    LAS unsigned char* Ct = lds; LAS unsigned char* Bt2 = lds + 64 * TS2; LAS float* cb = (LAS float*)(lds + 2 * 64 * TS2); LAS float* AC = cb + 64 * 65;
    LAS unsigned char* Mt = (LAS unsigned char*)(AC + 64 + 4); LAS unsigned char* xT = Mt + 64 * TS; LAS unsigned char* Sb = xT + 64 * TS;
    const int mt = wave >> 1, nt0 = (wave & 1) * 2;
    u32x4 cq[2], bq[2], xq; float dtq; f32x4 sq[4];
#define SSD2_LOAD(uu) do { const int tb_ = (uu) >> 3, g_ = ((uu) >> 2) & 1, hd_ = (uu) & 3, h_ = 2 * g_ + (hd_ >> 1), d_ = hd_ & 1; \
        const bf16_t* sx_ = WSP(bf16_t, SC_SX) + (size_t)(64 * tb_) * 768; \
        _Pragma("unroll") for (int q = 0; q < 2; ++q) { const int e = tid + NTHR * q, i = e >> 4, ch = e & 15; \
            cq[q] = *(const u32x4*)(sx_ + (size_t)i * 768 + 512 + 128 * g_ + ch * 8); bq[q] = *(const u32x4*)(sx_ + (size_t)i * 768 + 256 + 128 * g_ + ch * 8); } \
        xq = *(const u32x4*)(sx_ + (size_t)lane * 768 + 64 * h_ + 8 * wave); dtq = WSP(float, SC_SDT)[(size_t)(64 * tb_ + lane) * 8 + d_ * 4 + h_]; \
        const float* sp_ = WSP(float, SC_SSD_S) + (size_t)((tb_ * 4 + h_) * 2 + d_) * 8192; \
        _Pragma("unroll") for (int q = 0; q < 4; ++q) sq[q] = *(const f32x4*)(sp_ + (tid + NTHR * q) * 4); } while (0)
    int u3 = (p.bid + p.G - (160 % p.G)) % p.G;
    if (u3 < NTB * 8) SSD2_LOAD(u3);
    for (; u3 < NTB * 8; u3 += p.G) { const int tb = u3 >> 3, g = (u3 >> 2) & 1, hd = u3 & 3, h = 2 * g + (hd >> 1), d = hd & 1, s0 = 64 * tb; (void)g;
        if (wave == 0) { const float aneg = -__expf(PIN(I_SS_ALOG)[(layer * 2 + d) * 4 + h]); float tot; AC[lane] = ssd_acum(aneg * dtq, d, lane, tot); }
#pragma unroll
        for (int q = 0; q < 2; ++q) { const int e = tid + NTHR * q, i = e >> 4, ch = e & 15;
            *(LAS u32x4*)(Ct + i * TS2 + ch * 16) = cq[q]; *(LAS u32x4*)(Bt2 + i * TS2 + ch * 16) = bq[q]; }
#pragma unroll
        for (int k = 0; k < 8; ++k) *(LAS bf16_t*)(xT + (8 * wave + k) * TS + lane * 2) = (bf16_t)f2bf(bf2f((bf16_t)(xq[k >> 1] >> (16 * (k & 1)))) * dtq);
#pragma unroll
        for (int q = 0; q < 4; ++q) { const int e = (tid + NTHR * q) * 4, pp = e >> 7, s = e & 127; const f32x4 v = sq[q];
            *(LAS u32x2*)(Sb + pp * TS2 + s * 2) = (u32x2){pk2(v[0], v[1]), pk2(v[2], v[3])}; }
        if (u3 + p.G < NTB * 8) SSD2_LOAD(u3 + p.G);
        __syncthreads();
        { f32x4 acc[2] = {(f32x4){0.f, 0.f, 0.f, 0.f}, (f32x4){0.f, 0.f, 0.f, 0.f}};
          mm_rows<128, 2>(Ct, TS2, Bt2, TS2, mt, nt0, fr, fq, acc);
#pragma unroll
          for (int t = 0; t < 2; ++t)
#pragma unroll
              for (int j = 0; j < 4; ++j) cb[(16 * mt + 4 * fq + j) * 65 + 16 * (nt0 + t) + fr] = acc[t][j]; }
        __syncthreads();
        { const int i = tid >> 3, j0 = (tid & 7) * 8; const float ai = AC[i]; unsigned w[4];
#pragma unroll
          for (int jj = 0; jj < 8; jj += 2) { float m[2];
#pragma unroll
              for (int q = 0; q < 2; ++q) { const int j = j0 + jj + q; const bool keep = d ? j >= i : j <= i; m[q] = keep ? cb[i * 65 + j] * __expf(ai - AC[j]) : 0.f; }
              w[jj >> 1] = pk2(m[0], m[1]); }
          *(LAS u32x4*)(Mt + i * TS + j0 * 2) = (u32x4){w[0], w[1], w[2], w[3]}; }
        __syncthreads();
        { f32x4 acc[2] = {(f32x4){0.f, 0.f, 0.f, 0.f}, (f32x4){0.f, 0.f, 0.f, 0.f}};
          mm_rows<128, 2>(Ct, TS2, Sb, TS2, mt, nt0, fr, fq, acc);
#pragma unroll
          for (int j = 0; j < 4; ++j) { const float sc = __expf(AC[16 * mt + 4 * fq + j]); acc[0][j] *= sc; acc[1][j] *= sc; }
          mm_rows<64, 2>(Mt, TS, xT, TS, mt, nt0, fr, fq, acc);
          bf16_t* ob = WSP(bf16_t, d ? SC_OB : SC_OF);
#pragma unroll
          for (int t = 0; t < 2; ++t)
#pragma unroll
              for (int j = 0; j < 4; ++j) ob[(size_t)(s0 + 16 * mt + 4 * fq + j) * 1024 + 512 + 64 * h + 16 * (nt0 + t) + fr] = (bf16_t)f2bf(acc[t][j]); }
        __syncthreads();
    }
}
#undef SSD2_LOAD
constexpr int AFS = 68;
__device__ __forceinline__ int dr_mfrag_idx(int row, int col) { return (((row >> 4) * 2 + (col >> 5)) * 64 + ((col >> 2) & 3) * 16 + (row & 15)) * 8 + ((col >> 4) & 1) * 4 + (col & 3); }
template <class RhsF> __device__ __forceinline__ void dr_block_solve(const LAS unsigned char* Abf, const LAS float* AfT, LAS unsigned char* XT, LAS float* Dbuf, const float sgn, const int wave, const RhsF& rhs, bf16_t* wu) {
#pragma unroll 1
    for (int kb_ = 0; kb_ < 4; ++kb_) {
        { const int lane = lane_id_asm(), fr = lane & 15, fq = lane >> 4; f32x4 acc = (f32x4){0.f, 0.f, 0.f, 0.f};
          if (kb_ > 0) {
#pragma unroll
              for (int ks = 0; ks < 2; ++ks) { const bf16x8 a = *(const LAS bf16x8*)(Abf + (16 * kb_ + fr) * TS + ks * 64 + fq * 16), bb = *(const LAS bf16x8*)(XT + (16 * wave + fr) * TS + ks * 64 + fq * 16);
                  acc = __builtin_amdgcn_mfma_f32_16x16x32_bf16(a, bb, acc, 0, 0, 0); } }
          *(LAS f32x4*)(Dbuf + (16 * wave + fr) * 20 + 4 * fq) = acc; }
        __syncthreads();
        if (wave < 2) { const int col = wave * 64 + lane_id_asm(); float x[16];
#pragma unroll
            for (int i = 0; i < 16; ++i) x[i] = rhs(16 * kb_ + i, col) - sgn * Dbuf[col * 20 + i];
            const LAS float* Ab = AfT + (16 * kb_) * AFS + 16 * kb_;
#pragma unroll
            for (int j = 0; j < 15; ++j) { const float xj = sgn * x[j];
#pragma unroll
                for (int i = j + 1; i < 16; ++i) x[i] -= Ab[j * AFS + i] * xj; }
            u32x4 w0, w1;
#pragma unroll
            for (int q = 0; q < 4; ++q) { w0[q] = pk2(x[2 * q], x[2 * q + 1]); w1[q] = pk2(x[8 + 2 * q], x[8 + 2 * q + 1]); }
            *(LAS u32x4*)(XT + col * TS + (16 * kb_) * 2) = w0; *(LAS u32x4*)(XT + col * TS + (16 * kb_ + 8) * 2) = w1;
#pragma unroll
            for (int i = 0; i < 16; ++i) wu[(16 * kb_ + i) * 128 + col] = (bf16_t)f2bf(x[i]); }
        __syncthreads();
    }
}
struct GdnRhs { const LAS unsigned char* kb; const LAS unsigned char* vb; const LAS float* GC;
    __device__ __forceinline__ float operator()(int r, int col) const { return col < 64 ? bf2f(*(const LAS bf16_t*)(kb + r * TS + col * 2)) * __expf(GC[r]) : bf2f(*(const LAS bf16_t*)(vb + r * TS + (col - 64) * 2)); } };
__device__ __forceinline__ void gdn_p1(const Cx& p, LAS unsigned char* lds, int layer, int b) {
    const int wave = __builtin_amdgcn_readfirstlane(p.tid >> 6);
#define GDN_LANES const int lane = lane_id_asm(), tid = wave * 64 + lane, fr = lane & 15, fq = lane >> 4; (void)tid; (void)fr; (void)fq
    LAS unsigned char* kh = lds; LAS unsigned char* kb = lds + 64 * TS; LAS unsigned char* vb = lds + 2 * 64 * TS; LAS unsigned char* Abf = lds + 3 * 64 * TS; LAS unsigned char* kdT = lds + 4 * 64 * TS; LAS unsigned char* XT = lds + 5 * 64 * TS;
    LAS float* Af = (LAS float*)(lds + 7 * 64 * TS); LAS float* Dbuf = Af + 64 * AFS; LAS float* GC = Dbuf + 128 * 20;
    const int mt = wave >> 1, nt0 = (wave & 1) * 2;
    float gq, beta; u32x4 kv, vv;
#define GDN1_LOAD(uu) do { const int tb_ = (uu) >> 3, h_ = ((uu) >> 1) & 3, d_ = (uu) & 1; const int lane_ = lane_id_asm(), tid_ = wave * 64 + lane_; \
        const bf16_t* dq_ = WSP(bf16_t, SC_DQ) + (size_t)(64 * tb_) * 768; const float* dg_ = WSP(float, SC_DG) + (size_t)(64 * tb_) * 16; \
        gq = dg_[(d_ ? 63 - lane_ : lane_) * 16 + 8 + d_ * 4 + h_]; \
        { const int r_ = tid_ >> 3, c0_ = (tid_ & 7) * 8, i_ = d_ ? 63 - r_ : r_; beta = dg_[i_ * 16 + d_ * 4 + h_]; \
          kv = *(const u32x4*)(dq_ + (size_t)i_ * 768 + 256 + 64 * h_ + c0_); vv = *(const u32x4*)(dq_ + (size_t)i_ * 768 + 512 + 64 * h_ + c0_); } } while (0)
    int u = (p.bid + p.G - (64 % p.G)) % p.G;
    if (u < NUNIT) GDN1_LOAD(u);
    for (; u < NUNIT; u += p.G) {
        if (wave == 0) { GDN_LANES; float pre = gq;
#pragma unroll
            for (int o = 1; o < 64; o <<= 1) { const float t = shup_(pre, lane, o); if (lane >= o) pre += t; }
            GC[lane] = pre; }
        { GDN_LANES; const int r = tid >> 3, c0 = (tid & 7) * 8; u32x4 kw, vw;
#pragma unroll
          for (int q = 0; q < 4; ++q) { kw[q] = pk2(__uint_as_float(kv[q] << 16) * beta, __uint_as_float(kv[q] & 0xffff0000u) * beta); vw[q] = pk2(__uint_as_float(vv[q] << 16) * beta, __uint_as_float(vv[q] & 0xffff0000u) * beta); }
          *(LAS u32x4*)(kh + r * TS + c0 * 2) = kv; *(LAS u32x4*)(kb + r * TS + c0 * 2) = kw; *(LAS u32x4*)(vb + r * TS + c0 * 2) = vw;
          *(LAS u32x4*)(XT + (2 * r) * TS + c0 * 2) = (u32x4){0u, 0u, 0u, 0u}; *(LAS u32x4*)(XT + (2 * r + 1) * TS + c0 * 2) = (u32x4){0u, 0u, 0u, 0u}; }
        if (u + p.G < NUNIT) GDN1_LOAD(u + p.G);
        __syncthreads();
        const float gtot = GC[63];
        { GDN_LANES; f32x4 acc[2] = {(f32x4){0.f, 0.f, 0.f, 0.f}, (f32x4){0.f, 0.f, 0.f, 0.f}};
          mm_rows<64, 2>(kb, TS, kh, TS, mt, nt0, fr, fq, acc);
#pragma unroll
          for (int t = 0; t < 2; ++t)
#pragma unroll
              for (int j = 0; j < 4; ++j) { const int r = 16 * mt + 4 * fq + j, jj = 16 * (nt0 + t) + fr; const float a = jj < r ? acc[t][j] * __expf(GC[r] - GC[jj]) : 0.f;
                  Af[jj * AFS + r] = a; *(LAS bf16_t*)(Abf + r * TS + jj * 2) = (bf16_t)f2bf(a); }
#pragma unroll 2
          for (int q = 0; q < 8; ++q) { const int e = tid + NTHR * q, r = e >> 6, cc = e & 63;
              *(LAS bf16_t*)(kdT + cc * TS + r * 2) = (bf16_t)f2bf(bf2f(*(const LAS bf16_t*)(kh + r * TS + cc * 2)) * __expf(gtot - GC[r])); } }
        __syncthreads();
        { const GdnRhs rhs{kb, vb, GC}; dr_block_solve(Abf, Af, XT, Dbuf, 1.0f, wave, rhs, WSP(bf16_t, SC_DR_WU) + (size_t)u * 8192); }
        { GDN_LANES; f32x4 am[2] = {(f32x4){0.f, 0.f, 0.f, 0.f}, (f32x4){0.f, 0.f, 0.f, 0.f}}, an[2] = {(f32x4){0.f, 0.f, 0.f, 0.f}, (f32x4){0.f, 0.f, 0.f, 0.f}};
          mm_rows<64, 2>(kdT, TS, XT, TS, mt, nt0, fr, fq, am);
          mm_rows<64, 2>(kdT, TS, XT + 64 * TS, TS, mt, nt0, fr, fq, an);
          bf16_t* Mg = WSP(bf16_t, SC_DR_M) + (size_t)u * 4096; bf16_t* Ng = WSP(bf16_t, SC_DR_NS) + (size_t)u * 4096; const float eg = __expf(gtot);
#pragma unroll
          for (int t = 0; t < 2; ++t) {
#pragma unroll
              for (int j = 0; j < 4; ++j) { const int row = 16 * mt + 4 * fq + j, col = 16 * (nt0 + t) + fr; Mg[dr_mfrag_idx(row, col)] = (bf16_t)f2bf((row == col ? eg : 0.f) - am[t][j]); }
              *(u32x2*)(Ng + (((nt0 + t) * 4 + mt) * 64 + lane) * 4) = (u32x2){pk2(an[t][0], an[t][1]), pk2(an[t][2], an[t][3])}; } }
        __syncthreads();
    }
#undef GDN_LANES
#undef GDN1_LOAD
}
__device__ __forceinline__ void dr_chain(const Cx& p, size_t offM, size_t offNS, int h, int d, int cb) {
    const int lane = p.tid & 63, fr = lane & 15, fq = lane >> 4;
    if (p.tid >= 64) return;
    f32x4 acc[4];
#pragma unroll
    for (int t = 0; t < 4; ++t) acc[t] = (f32x4){0.f, 0.f, 0.f, 0.f};
    bf16x8 mR[4][4][2]; u32x2 nR[4][4];
#define DR_LD(m, nn, n_) do { const int u_ = (chain_tb((n_), d) * 4 + h) * 2 + d; const bf16_t* M_ = WSP(bf16_t, offM) + (size_t)u_ * 4096; const bf16_t* N_ = WSP(bf16_t, offNS) + (size_t)u_ * 4096; \
        _Pragma("unroll") for (int t = 0; t < 4; ++t) { _Pragma("unroll") for (int ks = 0; ks < 2; ++ks) m[t][ks] = *(const bf16x8*)(M_ + ((t * 2 + ks) * 64 + lane) * 8); nn[t] = *(const u32x2*)(N_ + ((cb * 4 + t) * 64 + lane) * 4); } } while (0)
#define DR_STEP(m, nn, n_) do { const int u_ = (chain_tb((n_), d) * 4 + h) * 2 + d; bf16_t* ST_ = WSP(bf16_t, offNS) + (size_t)u_ * 4096 + (16 * cb + fr) * 64 + 4 * fq; \
        u32x2 sp_[4]; _Pragma("unroll") for (int t = 0; t < 4; ++t) { sp_[t] = (u32x2){pk2(acc[t][0], acc[t][1]), pk2(acc[t][2], acc[t][3])}; *(u32x2*)(ST_ + 16 * t) = sp_[t]; } \
        bf16x8 bf_[2]; _Pragma("unroll") for (int ks = 0; ks < 2; ++ks) { u32x4 w_ = (u32x4){sp_[2 * ks][0], sp_[2 * ks][1], sp_[2 * ks + 1][0], sp_[2 * ks + 1][1]}; bf_[ks] = __builtin_bit_cast(bf16x8, w_); } \
        _Pragma("unroll") for (int t = 0; t < 4; ++t) { f32x4 a_ = (f32x4){__uint_as_float(nn[t][0] << 16), __uint_as_float(nn[t][0] & 0xffff0000u), __uint_as_float(nn[t][1] << 16), __uint_as_float(nn[t][1] & 0xffff0000u)}; \
            a_ = __builtin_amdgcn_mfma_f32_16x16x32_bf16(m[t][0], bf_[0], a_, 0, 0, 0); acc[t] = __builtin_amdgcn_mfma_f32_16x16x32_bf16(m[t][1], bf_[1], a_, 0, 0, 0); } } while (0)
#define DR_GO(q, n_) do { DR_STEP(mR[q], nR[q], (n_)); if ((n_) + 4 < NTB) DR_LD(mR[q], nR[q], (n_) + 4); } while (0)
    DR_LD(mR[0], nR[0], 0); DR_LD(mR[1], nR[1], 1); DR_LD(mR[2], nR[2], 2); DR_LD(mR[3], nR[3], 3);
#pragma unroll 1
    for (int n = 0; n < NTB; n += 4) { DR_GO(0, n); DR_GO(1, n + 1); DR_GO(2, n + 2); DR_GO(3, n + 3); }
#undef DR_GO
#undef DR_LD
#undef DR_STEP
}
__device__ __forceinline__ void gdn_p2(const Cx& p, LAS unsigned char* lds, int layer, int b) {
    const int tid = p.tid, lane = tid & 63, wave = __builtin_amdgcn_readfirstlane(tid >> 6), fr = lane & 15, fq = lane >> 4;
    LAS unsigned char* qh = lds; LAS unsigned char* kh = lds + 64 * TS; LAS unsigned char* wt = lds + 2 * 64 * TS; LAS unsigned char* sT = lds + 3 * 64 * TS; LAS unsigned char* aq = lds + 4 * 64 * TS; LAS unsigned char* vnT = lds + 5 * 64 * TS;
    LAS float* GC = (LAS float*)(lds + 6 * 64 * TS);
    const int mt = wave >> 1, nt0 = (wave & 1) * 2;
    float gq; bf16_t upre[2][4]; u32x4 qv, kv, wv, sv;
#define GDN2_LOAD(uu) do { const int tb_ = (uu) >> 3, h_ = ((uu) >> 1) & 3, d_ = (uu) & 1; \
        const bf16_t* dq_ = WSP(bf16_t, SC_DQ) + (size_t)(64 * tb_) * 768; const float* dg_ = WSP(float, SC_DG) + (size_t)(64 * tb_) * 16; \
        const bf16_t* wu_ = WSP(bf16_t, SC_DR_WU) + (size_t)(uu) * 8192; const bf16_t* st_ = WSP(bf16_t, SC_DR_NS) + (size_t)(uu) * 4096; \
        gq = dg_[(d_ ? 63 - lane : lane) * 16 + 8 + d_ * 4 + h_]; \
        _Pragma("unroll") for (int t = 0; t < 2; ++t) { _Pragma("unroll") for (int j = 0; j < 4; ++j) upre[t][j] = wu_[(16 * mt + 4 * fq + j) * 128 + 64 + 16 * (nt0 + t) + fr]; } \
        { const int r_ = tid >> 3, c0_ = (tid & 7) * 8, i_ = d_ ? 63 - r_ : r_; \
          qv = *(const u32x4*)(dq_ + (size_t)i_ * 768 + 64 * h_ + c0_); kv = *(const u32x4*)(dq_ + (size_t)i_ * 768 + 256 + 64 * h_ + c0_); \
          wv = *(const u32x4*)(wu_ + r_ * 128 + c0_); sv = *(const u32x4*)(st_ + r_ * 64 + c0_); } } while (0)
    int u = (p.bid + p.G - (192 % p.G)) % p.G;
    if (u < NUNIT) GDN2_LOAD(u);
    for (; u < NUNIT; u += p.G) { const int tb = u >> 3, h = (u >> 1) & 3, d = u & 1, s0 = 64 * tb;
        if (wave == 0) { float pre = gq;
#pragma unroll
            for (int o = 1; o < 64; o <<= 1) { const float t = shup_(pre, lane, o); if (lane >= o) pre += t; }
            GC[lane] = pre; }
        bf16_t ucur[2][4];
#pragma unroll
        for (int t = 0; t < 2; ++t)
#pragma unroll
            for (int j = 0; j < 4; ++j) ucur[t][j] = upre[t][j];
        { const int r = tid >> 3, c0 = (tid & 7) * 8;
          *(LAS u32x4*)(qh + r * TS + c0 * 2) = qv; *(LAS u32x4*)(kh + r * TS + c0 * 2) = kv; *(LAS u32x4*)(wt + r * TS + c0 * 2) = wv; *(LAS u32x4*)(sT + r * TS + c0 * 2) = sv; }
        if (u + p.G < NUNIT) GDN2_LOAD(u + p.G);
        __syncthreads();
        { f32x4 acc[2] = {(f32x4){0.f, 0.f, 0.f, 0.f}, (f32x4){0.f, 0.f, 0.f, 0.f}};
          mm_rows<64, 2>(qh, TS, kh, TS, mt, nt0, fr, fq, acc);
#pragma unroll
          for (int t = 0; t < 2; ++t)
#pragma unroll
              for (int j = 0; j < 4; ++j) { const int r = 16 * mt + 4 * fq + j, jj = 16 * (nt0 + t) + fr; *(LAS bf16_t*)(aq + r * TS + jj * 2) = (bf16_t)f2bf(jj <= r ? acc[t][j] * __expf(GC[r] - GC[jj]) : 0.f); }
          f32x4 av[2] = {(f32x4){0.f, 0.f, 0.f, 0.f}, (f32x4){0.f, 0.f, 0.f, 0.f}};
          mm_rows<64, 2>(wt, TS, sT, TS, mt, nt0, fr, fq, av);
#pragma unroll
          for (int t = 0; t < 2; ++t) { const int dv = 16 * (nt0 + t) + fr; float vn[4];
#pragma unroll
              for (int j = 0; j < 4; ++j) vn[j] = bf2f(ucur[t][j]) - av[t][j];
              *(LAS u32x2*)(vnT + dv * TS + (16 * mt + 4 * fq) * 2) = (u32x2){pk2(vn[0], vn[1]), pk2(vn[2], vn[3])}; } }
        __syncthreads();
        { f32x4 acc[2] = {(f32x4){0.f, 0.f, 0.f, 0.f}, (f32x4){0.f, 0.f, 0.f, 0.f}};
          mm_rows<64, 2>(qh, TS, sT, TS, mt, nt0, fr, fq, acc);
#pragma unroll
          for (int j = 0; j < 4; ++j) { const float sc = __expf(GC[16 * mt + 4 * fq + j]); acc[0][j] *= sc; acc[1][j] *= sc; }
          mm_rows<64, 2>(aq, TS, vnT, TS, mt, nt0, fr, fq, acc);
          bf16_t* ob = WSP(bf16_t, d ? SC_OB : SC_OF);
#pragma unroll
          for (int t = 0; t < 2; ++t)
#pragma unroll
              for (int j = 0; j < 4; ++j) { const int r = 16 * mt + 4 * fq + j, i = d ? 63 - r : r; ob[(size_t)(s0 + i) * 1024 + 768 + 64 * h + 16 * (nt0 + t) + fr] = (bf16_t)f2bf(acc[t][j]); } }
        __syncthreads();
    }
}
#undef GDN2_LOAD
constexpr int LPS = 65;
#define RW_LP(LP, GS, lw8) do { const int lane_ = lane_id_asm(), c_ = lane_, tg_ = wave; float loc_[8]; float run_ = 0.f; \
        _Pragma("unroll") for (int ii = 0; ii < 8; ++ii) { run_ += (lw8)[ii]; loc_[ii] = run_; } \
        (GS)[tg_ * 64 + c_] = run_; __syncthreads(); float off_ = 0.f; \
        _Pragma("unroll") for (int g2 = 0; g2 < 8; ++g2) if (g2 < tg_) off_ += (GS)[g2 * 64 + c_]; \
        _Pragma("unroll") for (int ii = 0; ii < 8; ++ii) (LP)[(8 * tg_ + ii) * LPS + c_] = loc_[ii] + off_; __syncthreads(); } while (0)
struct RwRhs { const LAS unsigned char* zt; const LAS unsigned char* RU;
    __device__ __forceinline__ float operator()(int r, int col) const { return col < 64 ? bf2f(*(const LAS bf16_t*)(zt + r * TS + col * 2)) : bf2f(*(const LAS bf16_t*)(RU + (col - 64) * TS + r * 2)); } };
__device__ __forceinline__ void rw_p1(const Cx& p, LAS unsigned char* lds, int layer, int b) {
    const int wave = __builtin_amdgcn_readfirstlane(p.tid >> 6), mt = wave >> 1, nt0 = (wave & 1) * 2;
#define RW_LANES const int lane = lane_id_asm(), tid = wave * 64 + lane, fr = lane & 15, fq = lane >> 4; (void)tid; (void)fr; (void)fq
    LAS float* LP = (LAS float*)lds; LAS float* GS = (LAS float*)(lds + 16640);
    LAS unsigned char* zt = lds + 18688; LAS unsigned char* bt = lds + 27904; LAS unsigned char* kt = lds + 37120; LAS unsigned char* vT = lds + 46336; LAS unsigned char* Azk = lds + 55552;
    LAS float* Af = (LAS float*)(lds + 64768); LAS unsigned char* XT = lds + 82176; LAS unsigned char* Abf = lds + 100608; LAS unsigned char* RU = lds + 109824; LAS float* Dbuf = (LAS float*)(lds + 119040); LAS unsigned char* bhT = lds + 129280;
    const bf16_t* proj = WSP(bf16_t, WS_PROJ);
    float lw8[8]; f32x4 lwv[2], kkv[2], bv[2], kv[2]; bf16_t v8[8];
#define RW1_LOAD(uu) do { const int tb_ = (uu) >> 3, h_ = ((uu) >> 1) & 3, d_ = (uu) & 1, s0_ = 64 * tb_; const int lane_ = lane_id_asm(), tid_ = wave * 64 + lane_; \
        const float* lwp_ = WSP(float, SC_RLW) + (size_t)d_ * SB * 256 + (size_t)s0_ * 256 + 64 * h_; const size_t fo_ = (size_t)s0_ * 256 + 64 * h_; \
        _Pragma("unroll") for (int ii = 0; ii < 8; ++ii) { const int r_ = 8 * wave + ii; lw8[ii] = lwp_[(size_t)(d_ ? 63 - r_ : r_) * 256 + lane_]; } \
        { const int r_ = tid_ >> 3, c0_ = (tid_ & 7) * 8, i_ = d_ ? 63 - r_ : r_; \
          _Pragma("unroll") for (int q = 0; q < 2; ++q) { lwv[q] = *(const f32x4*)(lwp_ + (size_t)i_ * 256 + c0_ + 4 * q); kkv[q] = *(const f32x4*)(WSP(float, SC_RKK) + fo_ + (size_t)i_ * 256 + c0_ + 4 * q); \
              bv[q] = *(const f32x4*)(WSP(float, SC_RB) + fo_ + (size_t)i_ * 256 + c0_ + 4 * q); kv[q] = *(const f32x4*)(WSP(float, SC_RK) + fo_ + (size_t)i_ * 256 + c0_ + 4 * q); } } \
        { const bf16_t* pr0_ = proj + (size_t)tb_row0(b, tb_) * NPROJ; \
          _Pragma("unroll") for (int q = 0; q < 8; ++q) { const int e = tid_ + NTHR * q, r2 = e >> 6, cc = e & 63; v8[q] = pr0_[(size_t)(d_ ? 63 - r2 : r2) * NPROJ + PB_V + 64 * h_ + cc]; } } } while (0)
    int u = (p.bid + p.G - (96 % p.G)) % p.G; if (u >= NUNIT) return;
    RW1_LOAD(u);
    for (;;) { const int d = u & 1;
        RW_LP(LP, GS, lw8);
        { RW_LANES; const int r = tid >> 3, c0 = (tid & 7) * 8; unsigned wz[4], wb[4], wk[4];
#pragma unroll
          for (int q = 0; q < 8; q += 2) { float z2[2], b2[2], k2[2];
#pragma unroll
              for (int e = 0; e < 2; ++e) { const int cq = q + e, c = c0 + cq; const float lp = LP[r * LPS + c], lw = lwv[cq >> 2][cq & 3], em = __expf(-lp);
                  z2[e] = -kkv[cq >> 2][cq & 3] * __expf(lp - lw); b2[e] = bv[cq >> 2][cq & 3] * em; k2[e] = kv[cq >> 2][cq & 3] * em; }
              wz[q >> 1] = pk2(z2[0], z2[1]); wb[q >> 1] = pk2(b2[0], b2[1]); wk[q >> 1] = pk2(k2[0], k2[1]); }
          *(LAS u32x4*)(zt + r * TS + c0 * 2) = (u32x4){wz[0], wz[1], wz[2], wz[3]}; *(LAS u32x4*)(bt + r * TS + c0 * 2) = (u32x4){wb[0], wb[1], wb[2], wb[3]}; *(LAS u32x4*)(kt + r * TS + c0 * 2) = (u32x4){wk[0], wk[1], wk[2], wk[3]};
          *(LAS u32x4*)(XT + (2 * r) * TS + c0 * 2) = (u32x4){0u, 0u, 0u, 0u}; *(LAS u32x4*)(XT + (2 * r + 1) * TS + c0 * 2) = (u32x4){0u, 0u, 0u, 0u};
#pragma unroll 2
          for (int q = 0; q < 8; ++q) { const int e = tid + NTHR * q, r2 = e >> 6, cc = e & 63; *(LAS bf16_t*)(vT + cc * TS + r2 * 2) = v8[q]; } }
        __syncthreads();
        const int un = u + p.G; const bool more = un < NUNIT;
        if (more) RW1_LOAD(un);
        { RW_LANES; f32x4 a1[2] = {(f32x4){0.f, 0.f, 0.f, 0.f}, (f32x4){0.f, 0.f, 0.f, 0.f}}, a2[2] = {(f32x4){0.f, 0.f, 0.f, 0.f}, (f32x4){0.f, 0.f, 0.f, 0.f}};
          mm_rows<64, 2>(zt, TS, bt, TS, mt, nt0, fr, fq, a1);
          mm_rows<64, 2>(zt, TS, kt, TS, mt, nt0, fr, fq, a2);
#pragma unroll
          for (int t = 0; t < 2; ++t)
#pragma unroll
              for (int j = 0; j < 4; ++j) { const int r = 16 * mt + 4 * fq + j, jj = 16 * (nt0 + t) + fr; const float a = jj < r ? a1[t][j] : 0.f;
                  Af[jj * AFS + r] = a; *(LAS bf16_t*)(Abf + r * TS + jj * 2) = (bf16_t)f2bf(a); *(LAS bf16_t*)(Azk + r * TS + jj * 2) = (bf16_t)f2bf(jj < r ? a2[t][j] : 0.f); } }
        __syncthreads();
        { RW_LANES; f32x4 a[2] = {(f32x4){0.f, 0.f, 0.f, 0.f}, (f32x4){0.f, 0.f, 0.f, 0.f}};
          mm_rows<64, 2>(Azk, TS, vT, TS, mt, nt0, fr, fq, a);
#pragma unroll
          for (int t = 0; t < 2; ++t) *(LAS u32x2*)(RU + (16 * (nt0 + t) + fr) * TS + (16 * mt + 4 * fq) * 2) = (u32x2){pk2(a[t][0], a[t][1]), pk2(a[t][2], a[t][3])};
        }
        __syncthreads();
        { RW_LANES;
#pragma unroll 2
          for (int q = 0; q < 8; ++q) { const int e = tid + NTHR * q, r2 = e >> 6, cc = e & 63; const float el = __expf(LP[63 * LPS + cc]);
              *(LAS bf16_t*)(bhT + cc * TS + r2 * 2) = (bf16_t)f2bf(bf2f(*(const LAS bf16_t*)(bt + r2 * TS + cc * 2)) * el); *(LAS bf16_t*)(Azk + cc * TS + r2 * 2) = (bf16_t)f2bf(bf2f(*(const LAS bf16_t*)(kt + r2 * TS + cc * 2)) * el); } }
        __syncthreads();
        { const RwRhs rhs{zt, RU}; dr_block_solve(Abf, Af, XT, Dbuf, -1.0f, wave, rhs, WSP(bf16_t, SC_RW_WU) + (size_t)u * 8192); }
        { RW_LANES; f32x4 am[2] = {(f32x4){0.f, 0.f, 0.f, 0.f}, (f32x4){0.f, 0.f, 0.f, 0.f}}, an[2] = {(f32x4){0.f, 0.f, 0.f, 0.f}, (f32x4){0.f, 0.f, 0.f, 0.f}};
          mm_rows<64, 2>(bhT, TS, XT, TS, mt, nt0, fr, fq, am);
          mm_rows<64, 2>(bhT, TS, XT + 64 * TS, TS, mt, nt0, fr, fq, an);
          mm_rows<64, 2>(Azk, TS, vT, TS, mt, nt0, fr, fq, an);
          bf16_t* Mg = WSP(bf16_t, SC_RW_M) + (size_t)u * 4096; bf16_t* Ng = WSP(bf16_t, SC_RW_NS) + (size_t)u * 4096;
#pragma unroll
          for (int t = 0; t < 2; ++t) {
#pragma unroll
              for (int j = 0; j < 4; ++j) { const int row = 16 * mt + 4 * fq + j, col = 16 * (nt0 + t) + fr; Mg[dr_mfrag_idx(row, col)] = (bf16_t)f2bf((row == col ? __expf(LP[63 * LPS + row]) : 0.f) + am[t][j]); }
              *(u32x2*)(Ng + (((nt0 + t) * 4 + mt) * 64 + lane) * 4) = (u32x2){pk2(an[t][0], an[t][1]), pk2(an[t][2], an[t][3])}; } }
        __syncthreads();
        if (!more) break;
        u = un;
    }
#undef RW1_LOAD
}
__device__ __forceinline__ void rw_p2(const Cx& p, LAS unsigned char* lds, int layer, int b) {
    const int wave = __builtin_amdgcn_readfirstlane(p.tid >> 6), mt = wave >> 1, nt0 = (wave & 1) * 2;
    LAS float* LP = (LAS float*)lds; LAS float* GS = (LAS float*)(lds + 16640);
    LAS unsigned char* rt = lds + 18688; LAS unsigned char* bt = lds + 27904; LAS unsigned char* kt = lds + 37120; LAS unsigned char* vT = lds + 46336; LAS unsigned char* sT = lds + 55552; LAS unsigned char* wt = lds + 64768;
    LAS unsigned char* Arb = lds + 73984; LAS unsigned char* Ark = lds + 83200; LAS unsigned char* UT = lds + 92416;
    const bf16_t* proj = WSP(bf16_t, WS_PROJ);
    bf16_t upre[2][4]; float lw8[8]; u32x4 rv, wv, sv, vq; f32x4 bv[2], kv[2];
#define RW2_LOAD(uu) do { const int tb_ = (uu) >> 3, h_ = ((uu) >> 1) & 3, d_ = (uu) & 1, s0_ = 64 * tb_; const int lane_ = lane_id_asm(), tid_ = wave * 64 + lane_, fr_ = lane_ & 15, fq_ = lane_ >> 4; \
        const float* lwp_ = WSP(float, SC_RLW) + (size_t)d_ * SB * 256 + (size_t)s0_ * 256 + 64 * h_; const float* rk_ = WSP(float, SC_RK) + (size_t)s0_ * 256 + 64 * h_; const float* rb_ = WSP(float, SC_RB) + (size_t)s0_ * 256 + 64 * h_; \
        const bf16_t* pr_ = proj + (size_t)tb_row0(b, tb_) * NPROJ; const bf16_t* wu_ = WSP(bf16_t, SC_RW_WU) + (size_t)(uu) * 8192; const bf16_t* st_ = WSP(bf16_t, SC_RW_NS) + (size_t)(uu) * 4096; \
        _Pragma("unroll") for (int t = 0; t < 2; ++t) { _Pragma("unroll") for (int j = 0; j < 4; ++j) upre[t][j] = wu_[(16 * mt + 4 * fq_ + j) * 128 + 64 + 16 * (nt0 + t) + fr_]; } \
        _Pragma("unroll") for (int ii = 0; ii < 8; ++ii) { const int r_ = 8 * wave + ii; lw8[ii] = lwp_[(size_t)(d_ ? 63 - r_ : r_) * 256 + lane_]; } \
        { const int r_ = tid_ >> 3, c0_ = (tid_ & 7) * 8, i_ = d_ ? 63 - r_ : r_; rv = *(const u32x4*)(pr_ + (size_t)i_ * NPROJ + PB_R + 64 * h_ + c0_); \
          _Pragma("unroll") for (int q = 0; q < 2; ++q) { bv[q] = *(const f32x4*)(rb_ + (size_t)i_ * 256 + c0_ + 4 * q); kv[q] = *(const f32x4*)(rk_ + (size_t)i_ * 256 + c0_ + 4 * q); } \
          wv = *(const u32x4*)(wu_ + r_ * 128 + c0_); sv = *(const u32x4*)(st_ + r_ * 64 + c0_); } \
        vq = *(const u32x4*)(pr_ + (size_t)(d_ ? 63 - lane_ : lane_) * NPROJ + PB_V + 64 * h_ + 8 * wave); } while (0)
    int u = (p.bid + p.G - (224 % p.G)) % p.G;
    if (u < NUNIT) RW2_LOAD(u);
    for (; u < NUNIT; u += p.G) { const int tb = u >> 3, h = (u >> 1) & 3, d = u & 1, s0 = 64 * tb;
        bf16_t ucur[2][4];
#pragma unroll
        for (int t = 0; t < 2; ++t)
#pragma unroll
            for (int j = 0; j < 4; ++j) ucur[t][j] = upre[t][j];
        RW_LP(LP, GS, lw8);
        { RW_LANES; const int r = tid >> 3, c0 = (tid & 7) * 8; unsigned wr[4], wb[4], wk[4];
#pragma unroll
          for (int q = 0; q < 8; q += 2) { float r2[2], b2[2], k2[2];
#pragma unroll
              for (int e = 0; e < 2; ++e) { const int cq = q + e, c = c0 + cq; const float lp = LP[r * LPS + c], em = __expf(-lp); const unsigned w = rv[q >> 1];
                  r2[e] = (e ? __uint_as_float(w & 0xffff0000u) : __uint_as_float(w << 16)) * __expf(lp); b2[e] = bv[cq >> 2][cq & 3] * em; k2[e] = kv[cq >> 2][cq & 3] * em; }
              wr[q >> 1] = pk2(r2[0], r2[1]); wb[q >> 1] = pk2(b2[0], b2[1]); wk[q >> 1] = pk2(k2[0], k2[1]); }
          *(LAS u32x4*)(rt + r * TS + c0 * 2) = (u32x4){wr[0], wr[1], wr[2], wr[3]}; *(LAS u32x4*)(bt + r * TS + c0 * 2) = (u32x4){wb[0], wb[1], wb[2], wb[3]}; *(LAS u32x4*)(kt + r * TS + c0 * 2) = (u32x4){wk[0], wk[1], wk[2], wk[3]};
          *(LAS u32x4*)(wt + r * TS + c0 * 2) = wv; *(LAS u32x4*)(sT + r * TS + c0 * 2) = sv;
#pragma unroll
          for (int k = 0; k < 8; ++k) *(LAS bf16_t*)(vT + (8 * wave + k) * TS + lane * 2) = (bf16_t)(vq[k >> 1] >> (16 * (k & 1))); }
        if (u + p.G < NUNIT) RW2_LOAD(u + p.G);
        __syncthreads();
        { RW_LANES; f32x4 a1[2] = {(f32x4){0.f, 0.f, 0.f, 0.f}, (f32x4){0.f, 0.f, 0.f, 0.f}}, a2[2] = {(f32x4){0.f, 0.f, 0.f, 0.f}, (f32x4){0.f, 0.f, 0.f, 0.f}}, a3[2] = {(f32x4){0.f, 0.f, 0.f, 0.f}, (f32x4){0.f, 0.f, 0.f, 0.f}};
          mm_rows<64, 2>(rt, TS, bt, TS, mt, nt0, fr, fq, a1); mm_rows<64, 2>(rt, TS, kt, TS, mt, nt0, fr, fq, a2); mm_rows<64, 2>(wt, TS, sT, TS, mt, nt0, fr, fq, a3);
#pragma unroll
          for (int t = 0; t < 2; ++t) { const int dv = 16 * (nt0 + t) + fr; float uu[4];
#pragma unroll
              for (int j = 0; j < 4; ++j) { const int r = 16 * mt + 4 * fq + j, jj = dv; const bool keep = jj <= r;
                  *(LAS bf16_t*)(Arb + r * TS + jj * 2) = (bf16_t)f2bf(keep ? a1[t][j] : 0.f); *(LAS bf16_t*)(Ark + r * TS + jj * 2) = (bf16_t)f2bf(keep ? a2[t][j] : 0.f);
                  uu[j] = bf2f(ucur[t][j]) + a3[t][j]; }
              *(LAS u32x2*)(UT + dv * TS + (16 * mt + 4 * fq) * 2) = (u32x2){pk2(uu[0], uu[1]), pk2(uu[2], uu[3])}; } }
        __syncthreads();
        { RW_LANES; f32x4 acc[2] = {(f32x4){0.f, 0.f, 0.f, 0.f}, (f32x4){0.f, 0.f, 0.f, 0.f}};
          mm_rows<64, 2>(rt, TS, sT, TS, mt, nt0, fr, fq, acc); mm_rows<64, 2>(Arb, TS, UT, TS, mt, nt0, fr, fq, acc); mm_rows<64, 2>(Ark, TS, vT, TS, mt, nt0, fr, fq, acc);
          bf16_t* ob = WSP(bf16_t, d ? SC_OB : SC_OF);
#pragma unroll
          for (int t = 0; t < 2; ++t)
#pragma unroll
              for (int j = 0; j < 4; ++j) { const int r = 16 * mt + 4 * fq + j, i = d ? 63 - r : r; ob[(size_t)(s0 + i) * 1024 + 256 + 64 * h + 16 * (nt0 + t) + fr] = (bf16_t)f2bf(acc[t][j]); } }
        __syncthreads();
    }
#undef RW_LANES
#undef RW2_LOAD
}
__device__ __forceinline__ void phase_scan(const Cx& p, LAS unsigned char* lds, int layer, int b) {
    for (int w = p.bid; w < 160; w += p.G) {
        if (w < 64) ssd_chain(p, (w >> 4) & 3, (w >> 3) & 1, w & 7);
        else if (w < 96) gla_chain(p, ((w - 64) >> 3) & 3, ((w - 64) >> 2) & 1, (w - 64) & 3);
        else { const int i = w - 96, h = (i >> 3) & 3, d = (i >> 2) & 1, cb = i & 3;
            if (i < 32) dr_chain(p, SC_RW_M, SC_RW_NS, h, d, cb); else dr_chain(p, SC_DR_M, SC_DR_NS, h, d, cb); } }
}
#ifndef MK_ONE_LAUNCH
#define MK_ONE_LAUNCH 1
#endif
constexpr int PH_PER_LAYER = 2 + 5 * NB + 7;
constexpr int N_PHASES = 1 + NL * PH_PER_LAYER + 1;

__global__ void __launch_bounds__(NTHR, 2) mega_fwd(Params pp) {
    extern __shared__ __attribute__((aligned(16))) unsigned char lds_raw[];
    LAS unsigned char* lds = (LAS unsigned char*)lds_raw;
    const int swave = __builtin_amdgcn_readfirstlane(threadIdx.x >> 6);
    for (int i = threadIdx.x; i < (LDS_BYTES - LDS_CTL) / 4; i += NTHR) ((LAS unsigned*)(lds + LDS_CTL))[i] = 0u;
    __syncthreads();
    if (threadIdx.x < N_IN + 2) { const unsigned long long a = threadIdx.x < N_IN ? (unsigned long long)pp.in[threadIdx.x] : (threadIdx.x == N_IN ? (unsigned long long)pp.out : (unsigned long long)pp.ws); ((LAS unsigned*)(lds + LDS_PTRS))[2 * threadIdx.x] = (unsigned)a; ((LAS unsigned*)(lds + LDS_PTRS))[2 * threadIdx.x + 1] = (unsigned)(a >> 32); }
    __syncthreads();
    XcdBarrier bar = xcd_barrier_post((unsigned*)(pp.ws + WS_CTL) + CW_BAR + pp.li * XCD_BAR_WORDS, (volatile LAS unsigned*)(lds + LDS_CTL), threadIdx.x);
    LAS int* tb = (LAS int*)(lds + LDS_CTL + 64);
    int pc = 0; const int lo = pp.lo, hi = pp.hi;
#define PH_BEGIN if (pc >= lo && pc < hi) { Cx p; p.out = (float*)PIN(N_IN); p.ws = (unsigned char*)PIN(N_IN + 1); p.tid = swave * 64 + lane_id_asm(); p.bid = blockIdx.x; p.G = gridDim.x; p.pad = 0; asm volatile("" : "+s"(p.out), "+s"(p.ws), "+v"(p.tid), "+s"(p.bid), "+s"(p.G)); const int G = p.G, bid = p.bid; (void)G; (void)bid;
#define PH_END if (pc + 1 < hi) { XcdBarrier b2 = bar; asm volatile("" : "+s"(b2.bar), "+s"(b2.x)); xcd_barrier(b2, (unsigned)(swave * 64 + lane_id_asm())); } } ++pc;

    PH_BEGIN
        for (int u = bid; u < CONV_A_UNITS; u += G) conv_unit_A(p, (LAS float*)lds, u);
        __syncthreads();
        phase_mod(p, lds);
    PH_END

#pragma unroll
    for (int layer = 0; layer < NL; ++layer) {
        const int row_lo = layer == NL - 1 ? CROWS : 0;
        PH_BEGIN phase_norm1(p, layer); PH_END
        PH_BEGIN
            DenseSched S; S.init(ROWS, NPROJ, D, WSP(bf16_t, WS_WIN) + (size_t)layer * NPROJ * D, G, bid);
            EpiProj E{WSP(bf16_t, WS_PROJ), NPROJ};
            pg8::gemm_phase<D>(p.tid, lds, (const char*)WSP(bf16_t, WS_HBUF), S, E);
        PH_END
#pragma unroll 1
        for (int b = 0; b < NB; ++b) {
            PH_BEGIN phase_prep(p, lds, layer, b); PH_END
            PH_BEGIN gla_p1(p, lds, layer, b); __syncthreads(); ssd_p1(p, lds, layer, b); __syncthreads(); gdn_p1(p, lds, layer, b); __syncthreads(); rw_p1(p, lds, layer, b); PH_END
            PH_BEGIN phase_scan(p, lds, layer, b); PH_END
            PH_BEGIN gla_p2(p, lds, layer, b); __syncthreads(); ssd_p2(p, lds, layer, b); __syncthreads(); gdn_p2(p, lds, layer, b); __syncthreads(); rw_p2(p, lds, layer, b); PH_END
            PH_BEGIN phase_post(p, lds, layer, b); PH_END
        }
        PH_BEGIN
            DenseSched S; S.init(ROWS, D, D, WSP(bf16_t, WS_WOUT) + (size_t)layer * D * D, G, bid);
            EpiRes E{layer == 0 ? PIN(I_X) : (const float*)p.out, layer == 0 ? PIN(I_CTX) : (const float*)WSP(float, WS_CTXRES), p.out, WSP(float, WS_CTXRES), WSP(float, WS_MOD) + (size_t)layer * 5 * 6144 + 2048};
            pg8::gemm_phase<D>(p.tid, lds, (const char*)WSP(bf16_t, WS_HBUF), S, E);
        PH_END
        PH_BEGIN phase_norm2(p, lds, layer, row_lo);
            __syncthreads();
            conv_experts(p, (LAS float*)lds, layer);
        PH_END
        PH_BEGIN
            moe_table(p, tb, layer, row_lo);
            MoeSched<true> S{tb + 128, tb, 2, G, bid, D, row_lo, WSP(int, WS_LTOK), (const char*)WSP(bf16_t, WS_EXPGU), (size_t)512 * D * 2};
            EpiGU E{WSP(bf16_t, WS_H)};
            pg8::gemm_phase<D>(p.tid, lds, (const char*)WSP(bf16_t, WS_HBUF), S, E);
        PH_END
#pragma unroll
        for (int half = 0; half < 2; ++half) {
            PH_BEGIN
                moe_table(p, tb, layer, row_lo);
                MoeSched<false> S{tb + 128, tb, 2, G, bid, EH, row_lo, WSP(int, WS_LTOK), (const char*)(WSP(bf16_t, WS_EXPD) + (size_t)half * 512 * EH), (size_t)D * EH * 2};
                EpiY E{WSP(bf16_t, WS_Y)};
                pg8::gemm_phase<EH>(p.tid, lds, (const char*)WSP(bf16_t, WS_H), S, E);
            PH_END
            PH_BEGIN
                moe_table(p, tb, layer, row_lo);
                phase_combine(p, tb, layer, row_lo, half);
            PH_END
        }
    }
    PH_BEGIN phase_final(p);
    PH_END
#undef PH_BEGIN
#undef PH_END
}

extern "C" void kernel_launch(void* const* d_in, const int* in_sizes, int n_in, void* d_out, int out_size, void* d_ws, size_t ws_size, hipStream_t stream) {
    static int grid = 0;
    if (grid == 0) {
        if (n_in != N_IN || in_sizes[0] != NB * SEQ * D || out_size != NB * SEQ * D || ws_size < WS_END) {
            fprintf(stderr, "kernel_launch: unexpected shapes (n_in %d, in0 %d, out %d, ws %zu); nothing launched\n", n_in, n_in > 0 ? in_sizes[0] : -1, out_size, ws_size); grid = -1; return; }
        int dev = 0, cus = 0, per_cu = 0;
        if (hipGetDevice(&dev) != hipSuccess || hipDeviceGetAttribute(&cus, hipDeviceAttributeMultiprocessorCount, dev) != hipSuccess) { grid = -1; return; }
        if (hipFuncSetAttribute((const void*)mega_fwd, hipFuncAttributeMaxDynamicSharedMemorySize, LDS_BYTES) != hipSuccess) { fprintf(stderr, "kernel_launch: hipFuncSetAttribute failed\n"); grid = -1; return; }
        if (hipOccupancyMaxActiveBlocksPerMultiprocessor(&per_cu, (const void*)mega_fwd, NTHR, LDS_BYTES) != hipSuccess || per_cu < 1) { fprintf(stderr, "kernel_launch: occupancy query says %d\n", per_cu); per_cu = 1; }
        (void)hipGetLastError();
        grid = cus * 1;
    }
    if (grid < 0) return;
    if (hipMemsetAsync((char*)d_ws + WS_CTL, 0, CTL_ZERO_BYTES, stream) != hipSuccess) return;
    Params p{};
    for (int i = 0; i < N_IN; ++i) p.in[i] = (const float*)d_in[i];
    p.out = (float*)d_out; p.ws = (unsigned char*)d_ws; p.pad = 0;
#if MK_ONE_LAUNCH
    p.lo = 0; p.hi = N_PHASES; p.li = 0;
    hipLaunchKernelGGL(mega_fwd, dim3(grid), dim3(NTHR), LDS_BYTES, stream, p);
#else
    for (int k = 0; k < N_PHASES; ++k) { p.lo = k; p.hi = k + 1; p.li = k;
        hipLaunchKernelGGL(mega_fwd, dim3(grid), dim3(NTHR), LDS_BYTES, stream, p); }
#endif
}
```

```cpp
#include <hip/hip_runtime.h>
#include <cstdio>
#include <cstdint>

typedef unsigned short bf16_t;
typedef short bf16x8 __attribute__((ext_vector_type(8)));
typedef float f32x4 __attribute__((ext_vector_type(4)));
typedef float f32x2 __attribute__((ext_vector_type(2)));
typedef unsigned u32x4 __attribute__((ext_vector_type(4)));
typedef unsigned u32x2 __attribute__((ext_vector_type(2)));

constexpr int NB = 4, SEQ = 8192, NCTX = 256, D = 1024, NL = 2;
constexpr int CROWS = NB * NCTX;
constexpr int ROWS = CROWS + NB * SEQ;
constexpr int SB = NCTX + SEQ;
constexpr int INW = 4056, NPROJ = 4096;
constexpr int NE = 64, NE1 = 65, TOPK = 8, EH = 256;
constexpr int GRIDW = 64, GRIDH = SEQ / GRIDW;
constexpr int PA_Q = 0, PA_K = 256, PA_V = 512, PA_G = 768, PA_GF = 1024, PA_GB = 1040;
constexpr int PB_R = 1056, PB_K = 1312, PB_V = 1568, PB_WF = 1824, PB_WB = 1856, PB_A = 1888, PB_G = 1920;
constexpr int PC_Z = 1984, PC_X = 2240, PC_DF = 3008, PC_DB = 3012;
constexpr int PD_Q = 3016, PD_Z = 3784, PD_BF = 4040, PD_BB = 4044, PD_AF = 4048, PD_AB = 4052;
enum { I_X = 0, I_C, I_CTX, I_CCTX, I_N1G, I_N2G, I_WMOD, I_BMOD, I_WIN, I_WOUT, I_GLA_W2, I_GLA_B, I_GLA_NG,
       I_RW_W2, I_RW_W0, I_RW_AW2, I_RW_A0, I_RW_GW2, I_RW_KK, I_RW_KA, I_RW_RK, I_RW_LNG, I_RW_LNB,
       I_SS_CW, I_SS_CB, I_SS_ALOG, I_SS_DTB, I_SS_D, I_SS_NG, I_DN_CW, I_DN_ALOG, I_DN_DTB, I_DN_NG,
       I_ROUT_W, I_ROUT_B, I_EXP_G, I_EXP_U, I_EXP_D, I_SH_G, I_SH_U, I_SH_D, I_FNG, N_IN };
static_assert(N_IN == 42, "input count");

constexpr size_t MiB = 1u << 20;
constexpr size_t WS_CTL = 0, CTL_ZERO_BYTES = 1 * MiB;
constexpr size_t WS_MOD = 1 * MiB;
constexpr size_t WS_RWGW = WS_MOD + 256 * 1024;
constexpr size_t WS_RWLR = WS_MOD + 384 * 1024;
constexpr size_t WS_WIN = 2 * MiB;
constexpr size_t WS_WOUT = 18 * MiB;
constexpr size_t WS_ROUT = 22 * MiB;
constexpr size_t WS_CTXRES = 23 * MiB;
constexpr size_t WS_EXPGU = 27 * MiB;
constexpr size_t WS_EXPD = 92 * MiB;
constexpr size_t WS_HBUF = 125 * MiB;
constexpr size_t WS_PROJ = 191 * MiB;
constexpr size_t WS_SCR = 455 * MiB;
constexpr size_t WS_END = 640455456;
constexpr int HROWS_MAX = ROWS * 9 + NE1 * 256;
constexpr size_t WS_Y = WS_HBUF;
constexpr size_t WS_H = 443 * MiB;
constexpr size_t WS_LTOK = 600 * MiB;
constexpr size_t WS_TOKT = WS_LTOK + (size_t)NE * ROWS * 4;
static_assert(WS_Y + (size_t)HROWS_MAX * 512 * 2 <= WS_H && WS_H + (size_t)HROWS_MAX * 256 * 2 <= WS_LTOK && WS_TOKT + (size_t)ROWS * 64 <= WS_END, "moe overlay");
constexpr size_t SC_OF = WS_SCR;
constexpr size_t SC_OB = SC_OF + (size_t)SB * 1024 * 2;
constexpr size_t SC_RK = SC_OB + (size_t)SB * 1024 * 2;
constexpr size_t SC_RKK = SC_RK + (size_t)SB * 256 * 4;
constexpr size_t SC_RB = SC_RKK + (size_t)SB * 256 * 4;
constexpr size_t SC_RLW = SC_RB + (size_t)SB * 256 * 4;
constexpr size_t SC_SX = SC_RLW + (size_t)2 * SB * 256 * 4;
constexpr size_t SC_DQ = SC_SX + (size_t)SB * 768 * 2;
constexpr size_t SC_SDT = SC_DQ + (size_t)SB * 768 * 2;
constexpr size_t SC_DG = SC_SDT + (size_t)SB * 8 * 4;
constexpr size_t SC_FEND = SC_DG + (size_t)SB * 16 * 4;
constexpr int NTB = SB / 64, NUNIT = NTB * 4 * 2;
constexpr size_t SC_RW_M = SC_FEND;
constexpr size_t SC_RW_NS = SC_RW_M + (size_t)(SB / 64 * 8) * 4096 * 2;
constexpr size_t SC_RW_WU = SC_RW_NS + (size_t)(SB / 64 * 8) * 4096 * 2;
constexpr size_t SC_END = SC_RW_WU + (size_t)(SB / 64 * 8) * 8192 * 2;
constexpr size_t SC2 = WS_EXPGU;
constexpr size_t SC_GLA_S = SC2;
constexpr size_t SC_GLA_DEC = SC_GLA_S + (size_t)NUNIT * 4096 * 4;
constexpr size_t SC_SSD_S = SC_GLA_DEC + (size_t)NUNIT * 64 * 4;
constexpr size_t SC_SSD_CD = SC_SSD_S + (size_t)NUNIT * 8192 * 4;
constexpr size_t SC_DR_M = SC_SSD_CD + (size_t)NUNIT * 4 + 4096;
constexpr size_t SC_DR_NS = SC_DR_M + (size_t)NUNIT * 4096 * 2;
constexpr size_t SC_DR_WU = SC_DR_NS + (size_t)NUNIT * 4096 * 2;
constexpr size_t SC2_END = SC_DR_WU + (size_t)NUNIT * 8192 * 2;
static_assert(SC2_END <= WS_HBUF, "chunk slots fit in the expert-weight region");
static_assert(SC_END <= WS_END, "scratch fits");
constexpr int CW_CNT = 1024;
constexpr int CW_BAR = 4096;

#define LAS __attribute__((address_space(3)))
constexpr int NTHR = 512;
constexpr int LDS_BYTES = 147456;
constexpr int LDS_CTL = 143360;
constexpr int LDS_PTRS = LDS_CTL + 2048;

__device__ __forceinline__ int lane_id_asm() { int l; asm volatile("v_mbcnt_lo_u32_b32 %0, -1, 0\n\tv_mbcnt_hi_u32_b32 %0, -1, %0" : "=v"(l)); return l; }
__device__ __forceinline__ float bf2f(bf16_t b) { return __uint_as_float(((unsigned)b) << 16); }
__device__ __forceinline__ unsigned f2bf(float f) { unsigned u = __float_as_uint(f); u += 0x7FFFu + ((u >> 16) & 1u); return u >> 16; }
__device__ __forceinline__ unsigned pk2(float lo, float hi) { return f2bf(lo) | (f2bf(hi) << 16); }
__device__ __forceinline__ float rl(float x, int k) { return __uint_as_float(__builtin_amdgcn_readlane(__float_as_uint(x), k)); }
__device__ __forceinline__ float shx_(float v, int lane, int o) { return __uint_as_float(__builtin_amdgcn_ds_bpermute((lane ^ o) << 2, __float_as_uint(v))); }
__device__ __forceinline__ int shxi_(int v, int lane, int o) { return __builtin_amdgcn_ds_bpermute((lane ^ o) << 2, v); }
__device__ __forceinline__ float shup_(float v, int lane, int o) { return __uint_as_float(__builtin_amdgcn_ds_bpermute((lane - o) << 2, __float_as_uint(v))); }
#define DPPF(v, ctrl) __uint_as_float(__builtin_amdgcn_update_dpp(0, __float_as_uint(v), ctrl, 0xf, 0xf, false))
#define DPPI(v, ctrl) __builtin_amdgcn_update_dpp(0, (v), ctrl, 0xf, 0xf, false)
__device__ __forceinline__ float wsum(float v) {
    v += DPPF(v, 0xB1); v += DPPF(v, 0x4E); v += DPPF(v, 0x141); v += DPPF(v, 0x140);
    v += __uint_as_float(__builtin_amdgcn_ds_swizzle(__float_as_uint(v), 0x401F));
    return rl(v, 0) + rl(v, 32);
}
__device__ __forceinline__ float sigmoidf_(float x) { return 1.0f / (1.0f + __expf(-x)); }
__device__ __forceinline__ float siluf_(float x) { return x / (1.0f + __expf(-x)); }
__device__ __forceinline__ float log1pexp_(float t  ) { return t < 1e-4f ? t - 0.5f * t * t : __logf(1.0f + t); }
__device__ __forceinline__ float softplusf_(float x) { return x > 15.f ? x : log1pexp_(__expf(x)); }
__device__ __forceinline__ float logsigmoidf_(float x) { return fminf(x, 0.f) - log1pexp_(__expf(-fabsf(x))); }
__device__ __forceinline__ float tanhf_(float x) { const float e = __expf(2.0f * fminf(fmaxf(x, -15.f), 15.f)); return (e - 1.0f) / (e + 1.0f); }
__device__ __forceinline__ int seq_tok(int i, int d) { return d == 0 ? i : (i < NCTX ? NCTX - 1 - i : SB + NCTX - 1 - i); }
__device__ __forceinline__ int tok_row(int b, int s) { return s < NCTX ? b * NCTX + s : CROWS + b * SEQ + (s - NCTX); }

struct Params { const float* in[N_IN]; float* out; unsigned char* ws; int lo, hi, li, pad; };
struct Cx { float* out; unsigned char* ws; int tid, bid, G, pad; };
__device__ __forceinline__ const float* PIN(int i) {
    extern __shared__ __attribute__((aligned(16))) unsigned char lds_raw_[];
    int off = __builtin_amdgcn_readfirstlane(LDS_PTRS + 8 * i); asm volatile("" : "+s"(off));
    const LAS unsigned* t = (const LAS unsigned*)((LAS unsigned char*)lds_raw_ + off);
    const unsigned lo = __builtin_amdgcn_readfirstlane(t[0]), hi = __builtin_amdgcn_readfirstlane(t[1]);
    return (const float*)(((unsigned long long)hi << 32) | lo);
}
#define XB_TMO      128
#define XB_XCNT(j)  (256  + 64 * (j))
#define XB_XSUB(j)  (1280 + 64 * (j))
#define XB_XGEN(j)  (2304 + 64 * (j))
#define XB_TOP      3328
#define XB_TOPGEN   3392
#define XCD_BAR_WORDS 3456
#define XB_SPIN_CAP (1u << 18)

__device__ __forceinline__ unsigned xb_ld(unsigned* p)              { return __hip_atomic_load(p, __ATOMIC_RELAXED, __HIP_MEMORY_SCOPE_AGENT); }
__device__ __forceinline__ unsigned xb_add(unsigned* p, unsigned v) { return __hip_atomic_fetch_add(p, v, __ATOMIC_RELAXED, __HIP_MEMORY_SCOPE_AGENT); }
__device__ __forceinline__ unsigned xb_xcc_id() { return (unsigned)__builtin_amdgcn_s_getreg((3 << 11) | 20) & 0xFu; }
#define XB_SPIN(cond, bar) do { unsigned _sp = 0; while (cond) { __builtin_amdgcn_s_sleep(1); \
    if ((++_sp & 255u) == 0u) { if (xb_ld(&(bar)[XB_TMO])) break; if (_sp > XB_SPIN_CAP) { atomicAdd(&(bar)[XB_TMO], 1u); break; } } } } while (0)

struct XcdBarrier {
    unsigned* bar; unsigned x;
    volatile LAS unsigned* st;
};

__device__ __forceinline__ XcdBarrier xcd_barrier_post(unsigned* bar, volatile LAS unsigned* st, const unsigned xb_tid) {
    XcdBarrier b; b.bar = bar; b.x = xb_xcc_id(); b.st = st;
    if (xb_tid == 0) (void)xb_add(&bar[XB_XCNT(b.x)], 1u);
    return b;
}
__device__ __forceinline__ void xcd_barrier_complete(unsigned* bar, unsigned x, unsigned& nloc, unsigned& nx) {
    const unsigned G = gridDim.x * gridDim.y * gridDim.z;
    unsigned sum, cnt, mine, sp = 0u;
    for (;;) {
        sum = 0u; cnt = 0u; mine = 0u;
#pragma unroll
        for (unsigned j = 0; j < 16; ++j) { const unsigned c = xb_ld(&bar[XB_XCNT(j)]); sum += c; cnt += (c > 0u) ? 1u : 0u; mine = (j == x) ? c : mine; }
        if (sum == G) break;
        __builtin_amdgcn_s_sleep(1);
        if ((++sp & 255u) == 0u) { if (xb_ld(&bar[XB_TMO])) break; if (sp > XB_SPIN_CAP) { atomicAdd(&bar[XB_TMO], 1u); break; } }
    }
    nloc = mine > 0u ? mine : 1u; nx = cnt > 0u ? cnt : 1u;
}

__device__ __forceinline__ void xcd_barrier(const XcdBarrier& b, const unsigned xb_tid) {
    asm volatile("s_waitcnt vmcnt(0)" ::: "memory");
    __syncthreads();
    if (xb_tid == 0) {
        unsigned* bar = b.bar;
        __builtin_amdgcn_s_waitcnt(0);
        unsigned nloc = b.st[0], nx = b.st[1];
        if (nloc == 0u) { xcd_barrier_complete(bar, b.x, nloc, nx); b.st[0] = nloc; b.st[1] = nx; }
        const unsigned old = xb_add(&bar[XB_XSUB(b.x)], 1u);
        const unsigned gen = old / nloc;
        if (old + 1u == (gen + 1u) * nloc) {
            __builtin_amdgcn_fence(__ATOMIC_RELEASE, "agent");
            asm volatile("s_waitcnt vmcnt(0)" ::: "memory");
            const unsigned og = xb_add(&bar[XB_TOP], 1u);
            const unsigned tg = og / nx;
            if (og + 1u == (tg + 1u) * nx) xb_add(&bar[XB_TOPGEN], 1u);
            else XB_SPIN(xb_ld(&bar[XB_TOPGEN]) == tg, bar);
            __builtin_amdgcn_fence(__ATOMIC_ACQUIRE, "agent");
            xb_add(&bar[XB_XGEN(b.x)], 1u);
            asm volatile("s_waitcnt vmcnt(0)" ::: "memory");
        } else {
            XB_SPIN(xb_ld(&bar[XB_XGEN(b.x)]) == gen, bar);
            __builtin_amdgcn_fence(__ATOMIC_ACQUIRE, "agent");
            asm volatile("s_waitcnt vmcnt(0)" ::: "memory");
        }
    }
    __syncthreads();
}

namespace pg8 {
constexpr int BM = 256, BK = 64, HALF = 128, HTB = HALF * BK * 2  , STAGE_BYTES = 8 * HTB, NXCD = 8, WGM = 8;
__host__ __device__ __forceinline__ int lds_byte(int r, int c) { const int st = (r >> 4) * 2 + (c >> 5), rr = r & 15, cc = c & 31, ob = rr * 64 + cc * 2; return st * 1024 + (ob ^ (((ob >> 9) & 1) << 5)); }
__host__ __device__ __forceinline__ void stage_rc(int b, int& R, int& C) { const int st = b / 1024, sb = b % 1024, swz = sb ^ (((sb >> 9) & 1) << 5); R = (st >> 1) * 16 + swz / 64; C = (st & 1) * 32 + (swz % 64) / 2; }
__host__ __device__ __forceinline__ int perm32(int rho) { const int n = rho >> 4, i = rho & 15; return 8 * (i >> 2) + 4 * n + (i & 3); }

struct Unit { int pm, pn, e, r0; };

__device__ __forceinline__ unsigned cvt_pk_bf16(float lo, float hi) { unsigned r; asm volatile("v_cvt_pk_bf16_f32 %0, %1, %2" : "=v"(r) : "v"(lo), "v"(hi)); return r; }

template <int K, class Epi, class Sched>
__device__ __forceinline__ void gemm_phase(const int tid, LAS unsigned char* lds, const char* Abase, const Sched& S, const Epi& E) {
    const int wid = __builtin_amdgcn_readfirstlane(tid >> 6), lane = tid & 63, wr = wid >> 2, wc = wid & 3, fr = lane & 15, fq = lane >> 4;
    const int nt = K / BK;
    constexpr bool DN = Sched::DENSE;
    int RA[2], CA[2]; unsigned voffB[2], voffA[2];
#pragma unroll
    for (int i = 0; i < 2; ++i) { int R, C; stage_rc(tid * 16 + i * 8192, R, C); const int Rb = Epi::PERM ? ((R & ~31) + perm32(R & 31)) : R;
        RA[i] = R; CA[i] = C; voffB[i] = (unsigned)(Rb * K + C) * 2u; voffA[i] = (unsigned)(R * K + C) * 2u; }
    const size_t kstep = (size_t)(BK * 2);
    const size_t hstep = (size_t)HALF * K * 2;
    const size_t tstep = 2 * hstep;
    const unsigned ldsw = (unsigned)wid * 1024u;
    const int aoff = lds_byte(wr * 64 + fr, fq * 8), boff = lds_byte(wc * 32 + fr, fq * 8);
#define PG8_SA(b, h) (((b) * 2 + (h)) * HTB)
#define PG8_SB(b, h) ((4 + (b) * 2 + (h)) * HTB)
#define PG8_STAGE(bufoff, gbase, voff) do { _Pragma("unroll") for (int _i = 0; _i < 2; ++_i) \
        __builtin_amdgcn_global_load_lds((const __attribute__((address_space(1))) unsigned*)((const __attribute__((address_space(1))) char*)(gbase) + (voff)[_i]), (LAS unsigned*)(lds + (bufoff) + ldsw + _i * 8192), 16, 0, 0); } while (0)
#define PG8_LDA(dst, b, h) do { _Pragma("unroll") for (int m = 0; m < 4; ++m) _Pragma("unroll") for (int k = 0; k < 2; ++k) dst[m][k] = *(const LAS bf16x8*)(lds + PG8_SA(b, h) + aoff + m * 2048 + k * 1024); } while (0)
#define PG8_LDB(dst, b, h) do { _Pragma("unroll") for (int n = 0; n < 2; ++n) _Pragma("unroll") for (int k = 0; k < 2; ++k) dst[n][k] = *(const LAS bf16x8*)(lds + PG8_SB(b, h) + boff + n * 2048 + k * 1024); } while (0)
#define PG8_MMA(ai, bj, At, Bt) do { __builtin_amdgcn_s_setprio(1); _Pragma("unroll") for (int m = 0; m < 4; ++m) _Pragma("unroll") for (int n = 0; n < 2; ++n) _Pragma("unroll") for (int k = 0; k < 2; ++k) \
        acc[ai][bj][m][n] = __builtin_amdgcn_mfma_f32_16x16x32_bf16(Bt[n][k], At[m][k], acc[ai][bj][m][n], 0, 0, 0); __builtin_amdgcn_s_setprio(0); } while (0)
#define PG8_WAIT_V(n) asm volatile("s_waitcnt vmcnt(" #n ")" ::: "memory")
#define PG8_WAIT_L(n) asm volatile("s_waitcnt lgkmcnt(" #n ")" ::: "memory")
#define PG8_BAR __builtin_amdgcn_s_barrier()
#define PG8_SCHED __builtin_amdgcn_sched_barrier(0)
#define PG8_AOFF(dst, u) do { _Pragma("unroll") for (int _h = 0; _h < 2; ++_h) _Pragma("unroll") for (int _i = 0; _i < 2; ++_i) \
        dst[_h][_i] = ((unsigned)S.a_row(u, _h * HALF + RA[_i]) * (unsigned)K + (unsigned)CA[_i]) * 2u; } while (0)
    Unit cur, nxt; int ui = 0;
    if (!S.next(0, cur)) return;
    f32x4 acc[2][2][4][2];
#pragma unroll
    for (int a = 0; a < 2; ++a)
#pragma unroll
        for (int b = 0; b < 2; ++b)
#pragma unroll
            for (int m = 0; m < 4; ++m)
#pragma unroll
                for (int n = 0; n < 2; ++n) acc[a][b][m][n] = (f32x4){0.f, 0.f, 0.f, 0.f};
    bf16x8 At[4][2], B0[2][2], B1[2][2];
    unsigned cO[2][2], nO[2][2];
    const char* cA = Abase; const char* nA = Abase;
    if constexpr (DN) cA = Abase + (size_t)S.a_row(cur, 0) * K * 2; else PG8_AOFF(cO, cur);
    const char* cB = S.b_ptr(cur);
#define PG8_STA(bufoff, h_, kb_, nx_) do { if constexpr (DN) PG8_STAGE(bufoff, ((nx_) ? nA : cA) + (h_) * hstep + (kb_), voffA); else PG8_STAGE(bufoff, Abase + (kb_), ((nx_) ? nO : cO)[h_]); } while (0)
    PG8_STAGE(PG8_SB(0, 0), cB, voffB); PG8_SCHED; PG8_STA(PG8_SA(0, 0), 0, 0, false); PG8_SCHED; PG8_STAGE(PG8_SB(0, 1), cB + hstep, voffB); PG8_SCHED; PG8_STA(PG8_SA(0, 1), 1, 0, false); PG8_SCHED;
    if (wr == 1) PG8_BAR;
    PG8_WAIT_V(4); PG8_BAR;
    PG8_STAGE(PG8_SB(1, 0), cB + kstep, voffB); PG8_SCHED; PG8_STA(PG8_SA(1, 0), 0, kstep, false); PG8_SCHED; PG8_STAGE(PG8_SB(1, 1), cB + hstep + kstep, voffB); PG8_SCHED;
    PG8_WAIT_V(6); PG8_BAR;
    for (;;) {
        const bool has_next = S.next(ui + 1, nxt);
        const char* nB = cB; nA = cA;
        if (has_next) { if constexpr (DN) nA = Abase + (size_t)S.a_row(nxt, 0) * K * 2; else PG8_AOFF(nO, nxt); nB = S.b_ptr(nxt); }
        else if constexpr (!DN) {
#pragma unroll
            for (int h = 0; h < 2; ++h)
#pragma unroll
                for (int i = 0; i < 2; ++i) nO[h][i] = cO[h][i]; }
        for (int t = 0; t < nt; t += 2) {
            const bool last = (t == nt - 2);
            const size_t k1 = (size_t)(t + 1) * kstep, k2 = last ? 0 : (size_t)(t + 2) * kstep, k3 = k2 + kstep;
            const char* b2 = last ? nB : cB + (size_t)(t + 2) * kstep; const char* b3 = b2 + kstep;
            PG8_LDB(B0, 0, 0); PG8_SCHED; PG8_LDA(At, 0, 0); PG8_STA(PG8_SA(1, 1), 1, k1, false);
            PG8_WAIT_L(8); PG8_BAR; PG8_WAIT_L(0); PG8_MMA(0, 0, At, B0); PG8_BAR; PG8_SCHED;
            PG8_LDB(B1, 0, 1); PG8_STAGE(PG8_SB(0, 0), b2, voffB);
            PG8_BAR; PG8_WAIT_L(0); PG8_MMA(0, 1, At, B1); PG8_BAR;
            PG8_LDA(At, 0, 1); PG8_STA(PG8_SA(0, 0), 0, k2, last);
            PG8_BAR; PG8_WAIT_L(0); PG8_MMA(1, 0, At, B0); PG8_BAR; PG8_SCHED;
            PG8_STAGE(PG8_SB(0, 1), b2 + hstep, voffB);
            PG8_WAIT_V(6); PG8_BAR; PG8_MMA(1, 1, At, B1); PG8_BAR;
            PG8_LDB(B0, 1, 0); PG8_SCHED; PG8_LDA(At, 1, 0); PG8_STA(PG8_SA(0, 1), 1, k2, last);
            PG8_WAIT_L(8); PG8_BAR; PG8_WAIT_L(0); PG8_MMA(0, 0, At, B0); PG8_BAR; PG8_SCHED;
            PG8_LDB(B1, 1, 1); PG8_STAGE(PG8_SB(1, 0), b3, voffB);
            PG8_BAR; PG8_WAIT_L(0); PG8_MMA(0, 1, At, B1); PG8_BAR;
            PG8_LDA(At, 1, 1); PG8_STA(PG8_SA(1, 0), 0, k3, last);
            PG8_BAR; PG8_WAIT_L(0); PG8_MMA(1, 0, At, B0); PG8_BAR; PG8_SCHED;
            PG8_STAGE(PG8_SB(1, 1), b3 + hstep, voffB);
            PG8_WAIT_V(6); PG8_BAR; PG8_MMA(1, 1, At, B1); PG8_BAR;
        }
        E(acc, cur, wid);
        if (!has_next) break;
#pragma unroll
        for (int a = 0; a < 2; ++a)
#pragma unroll
            for (int b = 0; b < 2; ++b)
#pragma unroll
                for (int m = 0; m < 4; ++m)
#pragma unroll
                    for (int n = 0; n < 2; ++n) acc[a][b][m][n] = (f32x4){0.f, 0.f, 0.f, 0.f};
        cur = nxt; cB = nB; cA = nA; ++ui;
        if constexpr (!DN) {
#pragma unroll
        for (int h = 0; h < 2; ++h)
#pragma unroll
            for (int i = 0; i < 2; ++i) cO[h][i] = nO[h][i]; }
    }
    PG8_WAIT_V(0);
    if (wr == 0) PG8_BAR;
    PG8_BAR;
#undef PG8_SA
#undef PG8_SB
#undef PG8_STAGE
#undef PG8_LDA
#undef PG8_LDB
#undef PG8_MMA
#undef PG8_WAIT_V
#undef PG8_WAIT_L
#undef PG8_BAR
#undef PG8_SCHED
#undef PG8_AOFF
#undef PG8_STA
}
}
struct DenseSched {
    static constexpr bool DENSE = true;
    int nM, nN, nwg, G, c, K; const char* Bt;
    __device__ __forceinline__ void init(int M, int N, int K_, const bf16_t* Bt_, int G_, int c_) { nM = M / 256; nN = N / 256; nwg = nM * nN; G = G_; c = c_; K = K_; Bt = (const char*)Bt_; }
    __device__ __forceinline__ bool next(int i, pg8::Unit& u) const {
        const long L = (long)i * G + c; if (L >= nwg) return false;
        int wgid = (int)L; { const int q = nwg / 8, r = nwg % 8, xcd = wgid % 8, off = wgid / 8; wgid = (xcd < r ? xcd * (q + 1) : r * (q + 1) + (xcd - r) * q) + off; }
        const int nig = 8 * nN, gid = wgid / nig, fm = gid * 8, gsz = (nM - fm) < 8 ? (nM - fm) : 8;
        u.pm = fm + ((wgid % nig) % gsz); u.pn = (wgid % nig) / gsz; u.e = 0; u.r0 = 0; return true;
    }
    __device__ __forceinline__ int a_row(const pg8::Unit& u, int r) const { return u.pm * 256 + r; }
    __device__ __forceinline__ const char* b_ptr(const pg8::Unit& u) const { return Bt + (size_t)u.pn * 256 * K * 2; }
};
template <bool GATHER> struct MoeSched {
    static constexpr bool DENSE = !GATHER;
    const LAS int* tstart; const LAS int* cnt; int nN, G, c, K, row_lo; const int* ltok; const char* Bt; size_t bstride;
    __device__ __forceinline__ bool next(int i, pg8::Unit& u) const {
        const long L = (long)i * G + c; const int ntile = __builtin_amdgcn_readfirstlane(tstart[NE1]); if (L >= (long)ntile * nN) return false;
        const int tile = (int)(L / nN); u.pn = (int)(L % nN);
        int e = 0;
#pragma unroll 1
        for (int step = 64; step >= 1; step >>= 1) { const int e2 = e + step; if (e2 <= NE && tstart[e2] <= tile) e = e2; }
        e = __builtin_amdgcn_readfirstlane(e); u.e = e; u.pm = __builtin_amdgcn_readfirstlane(tile); u.pn = __builtin_amdgcn_readfirstlane(u.pn); u.r0 = __builtin_amdgcn_readfirstlane((tile - tstart[e]) * 256); return true;
    }
    __device__ __forceinline__ int a_row(const pg8::Unit& u, int r) const {
        if (!GATHER) return u.pm * 256 + r;
        const int ri = u.r0 + r;
        if (u.e == NE) return ri < cnt[NE] ? row_lo + ri : row_lo;
        return ri < cnt[u.e] ? ltok[(size_t)u.e * ROWS + ri] : row_lo;
    }
    __device__ __forceinline__ const char* b_ptr(const pg8::Unit& u) const { return Bt + (size_t)u.e * bstride + (size_t)u.pn * 256 * K * 2; }
};

struct EpiProj {
    static constexpr bool PERM = true;
    bf16_t* O; int ldc;
    __device__ __forceinline__ void operator()(const f32x4 (&acc)[2][2][4][2], const pg8::Unit& u, const int wid) const {
        const int lane_ = lane_id_asm(), fr = lane_ & 15, fq = lane_ >> 4, wr = wid >> 2, wc = wid & 3;
        const int row0 = u.pm * 256 + wr * 64 + fr, col0 = u.pn * 256 + wc * 32 + 8 * fq;
#pragma unroll
        for (int ai = 0; ai < 2; ++ai)
#pragma unroll
            for (int m = 0; m < 4; ++m) { bf16_t* rowp = O + (size_t)(row0 + ai * 128 + m * 16) * ldc + col0;
#pragma unroll
                for (int bj = 0; bj < 2; ++bj) { const f32x4 v0 = acc[ai][bj][m][0], v1 = acc[ai][bj][m][1];
                    u32x4 w; w.x = pg8::cvt_pk_bf16(v0[0], v0[1]); w.y = pg8::cvt_pk_bf16(v0[2], v0[3]); w.z = pg8::cvt_pk_bf16(v1[0], v1[1]); w.w = pg8::cvt_pk_bf16(v1[2], v1[3]);
                    *(u32x4*)(rowp + bj * 128) = w; } }
    }
};
struct EpiRes {
    static constexpr bool PERM = false;
    const float* xsrc; const float* csrc; float* xdst; float* cdst; const float* gate;
    __device__ __forceinline__ void operator()(const f32x4 (&acc)[2][2][4][2], const pg8::Unit& u, const int wid) const {
        const int lane_ = lane_id_asm(), fr = lane_ & 15, fq = lane_ >> 4, wr = wid >> 2, wc = wid & 3;
        const int col0 = u.pn * 256 + wc * 32 + 4 * fq;
        const bool isc = u.pm < 4; const int sel = isc ? 4 : (u.pm - 4) >> 5;
        const float* src = isc ? csrc + (size_t)u.pm * 256 * D : xsrc + (size_t)(u.pm - 4) * 256 * D;
        float* dst = isc ? cdst + (size_t)u.pm * 256 * D : xdst + (size_t)(u.pm - 4) * 256 * D;
        f32x4 gv[2][2];
#pragma unroll
        for (int bj = 0; bj < 2; ++bj)
#pragma unroll
            for (int n = 0; n < 2; ++n) gv[bj][n] = *(const f32x4*)(gate + sel * 6144 + col0 + bj * 128 + n * 16);
#pragma unroll
        for (int ai = 0; ai < 2; ++ai)
#pragma unroll
            for (int m = 0; m < 4; ++m) { const size_t off = (size_t)(ai * 128 + wr * 64 + m * 16 + fr) * D + col0;
#pragma unroll
                for (int bj = 0; bj < 2; ++bj)
#pragma unroll
                    for (int n = 0; n < 2; ++n) { const f32x4 s = *(const f32x4*)(src + off + bj * 128 + n * 16); *(f32x4*)(dst + off + bj * 128 + n * 16) = s + gv[bj][n] * acc[ai][bj][m][n]; }
                asm volatile("" ::: "memory"); }
    }
};
struct EpiGU {
    static constexpr bool PERM = false;
    bf16_t* H;
    __device__ __forceinline__ void operator()(const f32x4 (&acc)[2][2][4][2], const pg8::Unit& u, const int wid) const {
        const int lane_ = lane_id_asm(), fr = lane_ & 15, fq = lane_ >> 4, wr = wid >> 2, wc = wid & 3;
        const int row0 = u.pm * 256 + wr * 64 + fr;
#pragma unroll
        for (int ai = 0; ai < 2; ++ai)
#pragma unroll
            for (int m = 0; m < 4; ++m) { bf16_t* rowp = H + (size_t)(row0 + ai * 128 + m * 16) * EH + 4 * fq;
#pragma unroll
                for (int bj = 0; bj < 2; ++bj) { const f32x4 g = acc[ai][bj][m][0], up = acc[ai][bj][m][1]; float h[4];
#pragma unroll
                    for (int j = 0; j < 4; ++j) h[j] = g[j] / (1.0f + __expf(-g[j])) * up[j];
                    u32x2 w; w.x = pg8::cvt_pk_bf16(h[0], h[1]); w.y = pg8::cvt_pk_bf16(h[2], h[3]);
                    *(u32x2*)(rowp + (u.pn * 256 + bj * 128 + wc * 32) / 2) = w; } }
    }
};
struct EpiY {
    static constexpr bool PERM = true;
    bf16_t* Y;
    __device__ __forceinline__ void operator()(const f32x4 (&acc)[2][2][4][2], const pg8::Unit& u, const int wid) const {
        const int lane_ = lane_id_asm(), fr = lane_ & 15, fq = lane_ >> 4, wr = wid >> 2, wc = wid & 3;
        const int row0 = u.pm * 256 + wr * 64 + fr, col0 = u.pn * 256 + wc * 32 + 8 * fq;
#pragma unroll
        for (int ai = 0; ai < 2; ++ai)
#pragma unroll
            for (int m = 0; m < 4; ++m) { bf16_t* rowp = Y + (size_t)(row0 + ai * 128 + m * 16) * 512 + col0;
#pragma unroll
                for (int bj = 0; bj < 2; ++bj) { const f32x4 v0 = acc[ai][bj][m][0], v1 = acc[ai][bj][m][1];
                    u32x4 w; w.x = pg8::cvt_pk_bf16(v0[0], v0[1]); w.y = pg8::cvt_pk_bf16(v0[2], v0[3]); w.z = pg8::cvt_pk_bf16(v1[0], v1[1]); w.w = pg8::cvt_pk_bf16(v1[2], v1[3]);
                    *(u32x4*)(rowp + bj * 128) = w; } }
    }
};
#define WSP(T, off) ((T*)(p.ws + (off)))

__device__ __forceinline__ void conv_tile(const int t, LAS float* tl, const float* __restrict__ src, int ldsrc, int k0, int n0, int nvalid, bf16_t* dst, int lddst, int mode) {
#pragma unroll
    for (int j = 0; j < 8; ++j) { const int idx = t + NTHR * j, k = idx >> 6, n = idx & 63; float v = 0.f; if (n0 + n < nvalid) v = src[(size_t)(k0 + k) * ldsrc + n0 + n]; tl[k * 65 + n] = v; }
    __syncthreads();
#pragma unroll
    for (int j = 0; j < 4; ++j) { const int pi = t + NTHR * j, n = pi >> 5, k = (pi & 31) * 2; const int nn = n0 + n;
        const int row = (mode == 0 || mode == 3) ? nn : ((nn >> 4) * 32 + (nn & 15) + (mode == 2 ? 16 : 0));
        float v0 = tl[k * 65 + n], v1 = tl[(k + 1) * 65 + n];
        if (mode == 3) { v0 -= bf2f((bf16_t)f2bf(v0)); v1 -= bf2f((bf16_t)f2bf(v1)); }
        *(unsigned*)(dst + (size_t)row * lddst + k0 + k) = pk2(v0, v1); }
    __syncthreads();
}
constexpr int CONV_A_UNITS = 2048 + 512 + 64 + 8 + 12;
__device__ __forceinline__ void conv_unit_A(const Cx& p, LAS float* tl, int u) {
    if (u < 2048) { const int l = u >> 10, r = u & 1023; conv_tile(p.tid, tl, PIN(I_WIN) + (size_t)l * D * INW, INW, (r >> 6) * 64, (r & 63) * 64, INW, WSP(bf16_t, WS_WIN) + (size_t)l * NPROJ * D, D, 0); }
    else if (u < 2560) { const int v = u - 2048, l = v >> 8, r = v & 255; conv_tile(p.tid, tl, PIN(I_WOUT) + (size_t)l * D * D, D, (r >> 4) * 64, (r & 15) * 64, D, WSP(bf16_t, WS_WOUT) + (size_t)l * D * D, D, 0); }
    else if (u >= 2632) { const int v = u - 2632, m = v >> 2, r = v & 3;
        conv_tile(p.tid, tl, m < NL ? PIN(I_RW_W2) + (size_t)m * 64 * 256 : PIN(I_RW_AW2), 256, 0, r * 64, 256, WSP(bf16_t, WS_RWLR) + (size_t)m * 256 * 64, 64, 0); }
    else if (u >= 2624) { const int v = u - 2624, l = v >> 2, r = v & 3; conv_tile(p.tid, tl, PIN(I_RW_GW2) + (size_t)l * 64 * 256, 256, 0, r * 64, 256, WSP(bf16_t, WS_RWGW) + (size_t)l * 256 * 64, 64, 0); }
    else { const int v = u - 2560, l = v >> 5, lo = (v >> 4) & 1, r = v & 15; conv_tile(p.tid, tl, PIN(I_ROUT_W) + (size_t)l * D * NE, NE, r * 64, 0, NE, WSP(bf16_t, WS_ROUT) + (size_t)(l * 2 + lo) * NE * D, D, lo ? 3 : 0); }
}
constexpr int CONV_E_UNITS = NE1 * 192;
struct ConvDesc { const float* src; bf16_t* dst; int ldsrc, lddst, k0, n0, mode; };
__device__ __forceinline__ ConvDesc conv_desc_E(const Cx& p, int l, int u) {
    ConvDesc c; const int e = u / 192, r = u % 192;
    if (r < 128) { const int up = r >> 6, q = r & 63;
        c.src = e < NE ? PIN(up ? I_EXP_U : I_EXP_G) + ((size_t)l * NE + e) * D * EH : PIN(up ? I_SH_U : I_SH_G) + (size_t)l * D * EH;
        c.ldsrc = EH; c.k0 = (q >> 2) * 64; c.n0 = (q & 3) * 64; c.dst = WSP(bf16_t, WS_EXPGU) + (size_t)e * 512 * D; c.lddst = D; c.mode = 1 + up; }
    else { const int q = r - 128;
        c.src = e < NE ? PIN(I_EXP_D) + ((size_t)l * NE + e) * EH * D : PIN(I_SH_D) + (size_t)l * EH * D;
        c.ldsrc = D; c.k0 = (q >> 4) * 64; c.n0 = (q & 15) * 64; c.dst = WSP(bf16_t, WS_EXPD) + (size_t)e * D * EH; c.lddst = EH; c.mode = 0; }
    return c;
}
__device__ __forceinline__ void conv_experts(const Cx& p, LAS float* tl, int l) {
    const int t = p.tid; int u = p.bid; if (u >= CONV_E_UNITS) return;
    float v[8]; ConvDesc c = conv_desc_E(p, l, u);
#pragma unroll
    for (int j = 0; j < 8; ++j) { const int idx = t + NTHR * j; v[j] = c.src[(size_t)(c.k0 + (idx >> 6)) * c.ldsrc + c.n0 + (idx & 63)]; }
    for (;;) {
#pragma unroll
        for (int j = 0; j < 8; ++j) { const int idx = t + NTHR * j; tl[(idx >> 6) * 65 + (idx & 63)] = v[j]; }
        __syncthreads();
        const int un = u + p.G; const bool more = un < CONV_E_UNITS; const ConvDesc cn = conv_desc_E(p, l, more ? un : u);
        if (more) {
#pragma unroll
            for (int j = 0; j < 8; ++j) { const int idx = t + NTHR * j; v[j] = cn.src[(size_t)(cn.k0 + (idx >> 6)) * cn.ldsrc + cn.n0 + (idx & 63)]; } }
#pragma unroll
        for (int j = 0; j < 4; ++j) { const int pi = t + NTHR * j, n = pi >> 5, k = (pi & 31) * 2; const int nn = c.n0 + n;
            const int row = c.mode == 0 ? nn : ((nn >> 4) * 32 + (nn & 15) + (c.mode == 2 ? 16 : 0));
            *(unsigned*)(c.dst + (size_t)row * c.lddst + c.k0 + k) = pk2(tl[k * 65 + n], tl[(k + 1) * 65 + n]); }
        __syncthreads();
        if (!more) break;
        c = cn; u = un;
    }
}
__device__ __forceinline__ void phase_mod(const Cx& p, LAS unsigned char* lds) {
    LAS float* sv = (LAS float*)lds; LAS float* red = sv + 5 * D;
    const int tid = p.tid;
    if (p.bid >= 192) return;
    for (int i = tid; i < 5 * D; i += NTHR) { const int j = i >> 10, k = i & 1023; const float c = j < 4 ? PIN(I_C)[j * D + k] : PIN(I_CCTX)[k]; sv[i] = siluf_(c); }
    __syncthreads();
    for (int u = p.bid; u < 192; u += p.G) {
        const int l = u / 96, cb = u % 96, kg = tid >> 6, cl = tid & 63;
        const float* w = PIN(I_WMOD) + (size_t)l * D * 6144 + cb * 64 + cl;
        float a0 = 0.f, a1 = 0.f, a2 = 0.f, a3 = 0.f, a4 = 0.f;
#pragma unroll 8
        for (int kk = 0; kk < 128; ++kk) { const int k = kg * 128 + kk; const float wv = w[(size_t)k * 6144];
            a0 += sv[k] * wv; a1 += sv[D + k] * wv; a2 += sv[2 * D + k] * wv; a3 += sv[3 * D + k] * wv; a4 += sv[4 * D + k] * wv; }
        red[(kg * 5 + 0) * 64 + cl] = a0; red[(kg * 5 + 1) * 64 + cl] = a1; red[(kg * 5 + 2) * 64 + cl] = a2; red[(kg * 5 + 3) * 64 + cl] = a3; red[(kg * 5 + 4) * 64 + cl] = a4;
        __syncthreads();
        if (tid < 320) { const int j = tid >> 6; float s = 0.f;
#pragma unroll
            for (int g = 0; g < 8; ++g) s += red[(g * 5 + j) * 64 + cl];
            WSP(float, WS_MOD)[((size_t)l * 5 + j) * 6144 + cb * 64 + cl] = s + PIN(I_BMOD)[l * 6144 + cb * 64 + cl]; }
        __syncthreads();
    }
}
__device__ __forceinline__ const float* res_row(const Cx& p, int layer_src0, int r) {
    if (r < CROWS) return (layer_src0 ? PIN(I_CTX) : (const float*)WSP(float, WS_CTXRES)) + (size_t)r * D;
    return (layer_src0 ? PIN(I_X) : (const float*)p.out) + (size_t)(r - CROWS) * D;
}
__device__ __forceinline__ int row_sel(int r) { return r < CROWS ? 4 : (r - CROWS) >> 13; }

__device__ __forceinline__ void norm_ld(const float* src, f32x4 (&v)[4], int lane) {
#pragma unroll
    for (int i = 0; i < 4; ++i) v[i] = *(const f32x4*)(src + 256 * i + 4 * lane);
}
__device__ __forceinline__ void norm_fin(const f32x4 (&v)[4], const float* g, const float* shift, const float* scale, bf16_t* dst, const bool tolds, LAS bf16_t* ldst, LAS bf16_t* ldlo, int lane) {
    float ss = 0.f;
#pragma unroll
    for (int i = 0; i < 4; ++i) ss += v[i][0] * v[i][0] + v[i][1] * v[i][1] + v[i][2] * v[i][2] + v[i][3] * v[i][3];
    ss = wsum(ss); const float rstd = rsqrtf(ss * (1.0f / D) + 1e-6f);
#pragma unroll
    for (int i = 0; i < 4; ++i) { const int col = 256 * i + 4 * lane; const f32x4 gv = *(const f32x4*)(g + col), sh = *(const f32x4*)(shift + col), sc = *(const f32x4*)(scale + col);
        const f32x4 y = v[i] * rstd * gv * (sc + 1.0f) + sh; u32x2 w; w.x = pk2(y[0], y[1]); w.y = pk2(y[2], y[3]);
        *(u32x2*)(dst + col) = w;
        if (tolds) { *(LAS u32x2*)(ldst + col) = w; u32x2 wl;
            wl.x = pk2(y[0] - __uint_as_float(w.x << 16), y[1] - __uint_as_float(w.x & 0xffff0000u)); wl.y = pk2(y[2] - __uint_as_float(w.y << 16), y[3] - __uint_as_float(w.y & 0xffff0000u));
            *(LAS u32x2*)(ldlo + col) = wl; } }
}
__device__ __forceinline__ void phase_norm1(const Cx& p, int layer) {
    const int lane = p.tid & 63, wave = p.tid >> 6;
    const float* mod = WSP(float, WS_MOD) + (size_t)layer * 5 * 6144; const float* g = PIN(I_N1G) + layer * D; bf16_t* hb = WSP(bf16_t, WS_HBUF);
    for (int r = p.bid * 16 + wave * 2; r < ROWS; r += p.G * 16) { f32x4 v0[4], v1[4];
        norm_ld(res_row(p, layer == 0, r), v0, lane); norm_ld(res_row(p, layer == 0, r + 1), v1, lane);
        const int s0 = row_sel(r), s1 = row_sel(r + 1);
        norm_fin(v0, g, mod + s0 * 6144 + 0, mod + s0 * 6144 + 1024, hb + (size_t)r * D, false, (LAS bf16_t*)0, (LAS bf16_t*)0, lane);
        norm_fin(v1, g, mod + s1 * 6144 + 0, mod + s1 * 6144 + 1024, hb + (size_t)(r + 1) * D, false, (LAS bf16_t*)0, (LAS bf16_t*)0, lane); }
}
__device__ __forceinline__ float sum8_(float v) { v += DPPF(v, 0xB1); v += DPPF(v, 0x4E); v += DPPF(v, 0x141); return v; }
__device__ __forceinline__ float sum16_(float v) { v = sum8_(v); v += DPPF(v, 0x140); return v; }
__device__ __forceinline__ void bf8_to_f(const u32x4 w, float (&f)[8]) {
#pragma unroll
    for (int q = 0; q < 4; ++q) { f[2 * q] = __uint_as_float(w[q] << 16); f[2 * q + 1] = __uint_as_float(w[q] & 0xffff0000u); } }
__device__ __forceinline__ void phase_prep(const Cx& p, LAS unsigned char* lds, int layer, int b) {
    const int lane = p.tid & 63, wave = __builtin_amdgcn_readfirstlane(p.tid >> 6);
    const bf16_t* proj = WSP(bf16_t, WS_PROJ);
    const int e0 = p.bid * NTHR + p.tid, e1 = e0 + p.G * NTHR; bf16_t sq0 = 0, sq1 = 0;
#define SCAL_COL(q) ((q) < 8 ? PC_DF + (q) : (q) < 16 ? PD_BF + ((q) - 8) : PD_AF + ((q) - 16))
    if (e0 < SB * 24) sq0 = proj[(size_t)tok_row(b, e0 / 24) * NPROJ + SCAL_COL(e0 % 24)];
    if (e1 < SB * 24) sq1 = proj[(size_t)tok_row(b, e1 / 24) * NPROJ + SCAL_COL(e1 % 24)];
    if (p.bid < SB / 33) {
        constexpr int ATS = 208;
        LAS unsigned char* WWt = lds; LAS unsigned char* AWt = lds + 256 * 144; LAS unsigned char* At = lds + 2 * 256 * 144;
        { const bf16_t* w2c = WSP(bf16_t, WS_RWLR) + (size_t)layer * 256 * 64; const bf16_t* awc = WSP(bf16_t, WS_RWLR) + (size_t)NL * 256 * 64;
#pragma unroll
          for (int q = 0; q < 4; ++q) { const int e = p.tid + NTHR * q, n = e >> 3, ch = e & 7;
              *(LAS u32x4*)(WWt + n * 144 + ch * 16) = *(const u32x4*)(w2c + n * 64 + ch * 8); *(LAS u32x4*)(AWt + n * 144 + ch * 16) = *(const u32x4*)(awc + n * 64 + ch * 8); } }
        const int h = wave & 3, half = wave >> 2, fr = lane & 15, fq = lane >> 4;
        float a0c[4], w0fc[4], w0bc[4], kkc[4], kac[4];
#pragma unroll
        for (int nt = 0; nt < 4; ++nt) { const int c = 64 * h + 16 * nt + fr; a0c[nt] = PIN(I_RW_A0)[layer * 256 + c]; w0fc[nt] = PIN(I_RW_W0)[(layer * 2 + 0) * 256 + c]; w0bc[nt] = PIN(I_RW_W0)[(layer * 2 + 1) * 256 + c];
            kkc[nt] = PIN(I_RW_KK)[layer * 256 + c]; kac[nt] = PIN(I_RW_KA)[layer * 256 + c]; }
        for (int u = p.bid; u < SB / 33; u += p.G) {
            if (p.tid < 33 * 12) { const int tk = p.tid / 12, ch = p.tid % 12; u32x4 w = *(const u32x4*)(proj + (size_t)tok_row(b, u * 33 + tk) * NPROJ + PB_WF + 8 * ch);
                if (ch < 8) {
#pragma unroll
                    for (int q = 0; q < 4; ++q) w[q] = pk2(tanhf_(__uint_as_float(w[q] << 16)), tanhf_(__uint_as_float(w[q] & 0xffff0000u))); }
                *(LAS u32x4*)(At + tk * ATS + ch * 16) = w; }
            bf16_t kvA[4][4], kvB[4];
#pragma unroll
            for (int j = 0; j < 4; ++j) { const bf16_t* pr = proj + (size_t)tok_row(b, u * 33 + 16 * half + 4 * fq + j) * NPROJ + PB_K + 64 * h + fr;
#pragma unroll
                for (int nt = 0; nt < 4; ++nt) kvA[nt][j] = pr[16 * nt]; }
            { const bf16_t* pr = proj + (size_t)tok_row(b, u * 33 + 32) * NPROJ + PB_K + 64 * h + fr;
#pragma unroll
              for (int nt = 0; nt < 4; ++nt) kvB[nt] = pr[16 * nt]; }
            __syncthreads();
#pragma unroll
            for (int pass = 0; pass < 2; ++pass) { if (pass == 1 && half != 0) break;
                const int mt = pass ? 2 : half; f32x4 sa[4], sf[4], sb[4];
                const bf16x8 awf = *(const LAS bf16x8*)(At + (16 * mt + fr) * ATS + fq * 16), awb = *(const LAS bf16x8*)(At + (16 * mt + fr) * ATS + 64 + fq * 16), aa = *(const LAS bf16x8*)(At + (16 * mt + fr) * ATS + 128 + fq * 16);
#pragma unroll
                for (int nt = 0; nt < 4; ++nt) { const int n = 64 * h + 16 * nt + fr; const f32x4 z = (f32x4){0.f, 0.f, 0.f, 0.f};
                    sf[nt] = __builtin_amdgcn_mfma_f32_16x16x32_bf16(awf, *(const LAS bf16x8*)(WWt + n * 144 + fq * 16), z, 0, 0, 0);
                    sb[nt] = __builtin_amdgcn_mfma_f32_16x16x32_bf16(awb, *(const LAS bf16x8*)(WWt + n * 144 + 64 + fq * 16), z, 0, 0, 0);
                    sa[nt] = __builtin_amdgcn_mfma_f32_16x16x32_bf16(aa, *(const LAS bf16x8*)(AWt + n * 144 + layer * 64 + fq * 16), z, 0, 0, 0); }
#pragma unroll
                for (int j = 0; j < 4; ++j) { if (pass == 1 && j > 0) break;
                    const int tk = 16 * mt + 4 * fq + j; const bool valid = tk < 33; const int s = u * 33 + tk;
                    float kv[4], kr[4], ssq = 0.f;
#pragma unroll
                    for (int nt = 0; nt < 4; ++nt) { kv[nt] = bf2f(pass ? kvB[nt] : kvA[nt][j]); kr[nt] = kv[nt] * kkc[nt]; ssq += kr[nt] * kr[nt]; }
                    const float rs = rsqrtf(sum16_(ssq) + 1e-6f);
#pragma unroll
                    for (int nt = 0; nt < 4; ++nt) { const float a = sigmoidf_(sa[nt][j] + a0c[nt]);
                        const float lwf = -__expf(-softplusf_(-(sf[nt][j] + w0fc[nt])) - 0.5f), lwb = -__expf(-softplusf_(-(sb[nt][j] + w0bc[nt])) - 0.5f);
                        const float kk = kr[nt] * rs; const size_t o = (size_t)s * 256 + 64 * h + 16 * nt + fr;
                        if (valid) { WSP(float, SC_RK)[o] = kv[nt] * (1.0f + (a - 1.0f) * kac[nt]); WSP(float, SC_RKK)[o] = kk; WSP(float, SC_RB)[o] = kk * a;
                            WSP(float, SC_RLW)[o] = lwf; WSP(float, SC_RLW)[(size_t)SB * 256 + o] = lwb; } } } }
            __syncthreads();
        }
    }
    __syncthreads();
    { LAS bf16_t* T = (LAS bf16_t*)lds; const int tid = p.tid;
#define PC_LOAD(uu, v, vh) do { const int mixer_ = (uu) / (NTB * 3), r2_ = (uu) % (NTB * 3), rb_ = r2_ / 3, colbase_ = (mixer_ ? PD_Q : PC_X) + 256 * (r2_ % 3); \
          _Pragma("unroll") for (int q = 0; q < 12; ++q) { const int e = tid + NTHR * q, rr = e >> 11, tok = (e >> 5) & 63, ch = (e & 31) * 8; v[q] = (u32x4){0u, 0u, 0u, 0u}; \
              if (rb_ < 4) { if (rr == 1) v[q] = *(const u32x4*)(proj + (size_t)(b * NCTX + 64 * rb_ + tok) * NPROJ + colbase_ + ch); } \
              else { const int gr = rb_ - 4 + rr - 1; if (gr >= 0 && gr < GRIDH) v[q] = *(const u32x4*)(proj + (size_t)(CROWS + b * SEQ + gr * 64 + tok) * NPROJ + colbase_ + ch); } } \
          vh = (u32x4){0u, 0u, 0u, 0u}; if (tid < 192) { const int rr = tid >> 6, side = (tid >> 5) & 1, ch = (tid & 31) * 8;       \
              if (rb_ < 4 && rr == 1) { const int tk = side ? 64 * (rb_ + 1) : 64 * rb_ - 1; if (tk >= 0 && tk < NCTX) vh = *(const u32x4*)(proj + (size_t)(b * NCTX + tk) * NPROJ + colbase_ + ch); } } } while (0)
      int u = p.bid;
      if (u < 2 * NTB * 3) { u32x4 v[12], vh; PC_LOAD(u, v, vh);
        for (;;) { const int mixer = u / (NTB * 3), r2 = u % (NTB * 3), rb = r2 / 3, third = r2 % 3;
#pragma unroll
          for (int q = 0; q < 12; ++q) { const int e = tid + NTHR * q, rr = e >> 11, tok = (e >> 5) & 63, ch = (e & 31) * 8; *(LAS u32x4*)(T + (rr * 66 + tok + 1) * 256 + ch) = v[q]; }
          if (tid < 192) { const int rr = tid >> 6, side = (tid >> 5) & 1, ch = (tid & 31) * 8; *(LAS u32x4*)(T + (rr * 66 + (side ? 65 : 0)) * 256 + ch) = vh; }
          __syncthreads();
          const int un = u + p.G; const bool more = un < 2 * NTB * 3;
          if (more) PC_LOAD(un, v, vh);
          { const int c = tid & 255, th = tid >> 8, chn = 256 * third + c; float w[9];
            const float* cw = (mixer ? PIN(I_DN_CW) : PIN(I_SS_CW)) + (size_t)layer * 9 * 768 + chn;
#pragma unroll
            for (int k = 0; k < 9; ++k) w[k] = cw[k * 768];
            const float bias = mixer ? 0.f : PIN(I_SS_CB)[layer * 768 + chn];
            bf16_t* dst = (mixer ? WSP(bf16_t, SC_DQ) : WSP(bf16_t, SC_SX)) + (size_t)(64 * rb) * 768 + chn;
#pragma unroll 2
            for (int tk = 0; tk < 32; ++tk) { const int x = 32 * th + tk; float acc = bias;
#pragma unroll
                for (int dy = 0; dy < 3; ++dy)
#pragma unroll
                    for (int dx = 0; dx < 3; ++dx) acc += w[dy * 3 + dx] * bf2f(T[(dy * 66 + x + dx) * 256 + c]);
                float y = siluf_(acc);
                if (mixer && third < 2) { const float ss = wsum(y * y); y *= rsqrtf(ss + 1e-6f); if (third == 0) y *= 0.125f; }
                dst[(size_t)x * 768] = (bf16_t)f2bf(y); } }
          __syncthreads();
          if (!more) break;
          u = un; } }
#undef PC_LOAD
#define SCAL_FIN(e_, raw_) do { const int s = (e_) / 24, q = (e_) % 24; const float xv = bf2f(raw_); \
          if (q < 8) { const int d = q >> 2, h = q & 3; WSP(float, SC_SDT)[(size_t)s * 8 + q] = softplusf_(xv + PIN(I_SS_DTB)[(layer * 2 + d) * 4 + h]); } \
          else if (q < 16) { WSP(float, SC_DG)[(size_t)s * 16 + (q - 8)] = sigmoidf_(xv); } \
          else { const int q2 = q - 16, d = q2 >> 2, h = q2 & 3; WSP(float, SC_DG)[(size_t)s * 16 + 8 + q2] = -__expf(PIN(I_DN_ALOG)[(layer * 2 + d) * 4 + h]) * softplusf_(xv + PIN(I_DN_DTB)[(layer * 2 + d) * 4 + h]); } } while (0)
      if (e0 < SB * 24) SCAL_FIN(e0, sq0);
      if (e1 < SB * 24) SCAL_FIN(e1, sq1);
      for (int e = e1 + p.G * NTHR; e < SB * 24; e += p.G * NTHR) { const bf16_t raw = proj[(size_t)tok_row(b, e / 24) * NPROJ + SCAL_COL(e % 24)]; SCAL_FIN(e, raw); }
#undef SCAL_FIN
#undef SCAL_COL
    }
}
__device__ __forceinline__ void phase_scan(const Cx& p, LAS unsigned char* lds, int layer, int b);
__device__ __forceinline__ void phase_post(const Cx& p, LAS unsigned char* lds, int layer, int b) {
    const int tid = p.tid, tsub = tid >> 7, c8 = (tid & 127) * 8, mixer = c8 >> 8, cm = c8 & 255, hh = cm >> 6;
    const bf16_t* proj = WSP(bf16_t, WS_PROJ); const bf16_t* of = WSP(bf16_t, SC_OF); const bf16_t* obk = WSP(bf16_t, SC_OB); bf16_t* yc = WSP(bf16_t, WS_HBUF);
    constexpr int PTS = 144, GTS = 260;
    LAS unsigned char* GWb = lds; LAS unsigned char* SGb = lds + 256 * PTS; LAS float* GT = (LAS float*)(lds + 256 * PTS + 48 * PTS);
    if ((int)p.bid < SB / 33) { const bf16_t* gsrc = WSP(bf16_t, WS_RWGW) + (size_t)layer * 256 * 64;
#pragma unroll
        for (int q = 0; q < 4; ++q) { const int e = tid + NTHR * q, n = e >> 3, ch = e & 7; *(LAS u32x4*)(GWb + n * PTS + ch * 16) = *(const u32x4*)(gsrc + n * 64 + ch * 8); } }
    float g0[8], g1[8], g2[8];
#pragma unroll
    for (int q = 0; q < 8; ++q) { const int c = cm + q; g0[q] = 0.f; g1[q] = 0.f; g2[q] = 0.f;
        if (mixer == 0) g0[q] = PIN(I_GLA_NG)[layer * 256 + c];
        else if (mixer == 1) { g0[q] = PIN(I_RW_LNG)[layer * 256 + c]; g1[q] = PIN(I_RW_LNB)[layer * 256 + c]; g2[q] = PIN(I_RW_RK)[layer * 256 + c]; }
        else if (mixer == 2) { g0[q] = PIN(I_SS_NG)[layer * 256 + c]; g1[q] = PIN(I_SS_D)[layer * 4 + hh]; }
        else g0[q] = PIN(I_DN_NG)[layer * 256 + c]; }
    const int col1 = (mixer == 0 ? PA_G : mixer == 1 ? PB_R : mixer == 2 ? PC_Z : PD_Z) + cm;
    for (int u = p.bid; u < SB / 33; u += p.G) {
        if (tid < 33 * 8) { const int tk = tid >> 3, ch = tid & 7; float gl[8]; bf8_to_f(*(const u32x4*)(proj + (size_t)tok_row(b, u * 33 + tk) * NPROJ + PB_G + 8 * ch), gl);
            *(LAS u32x4*)(SGb + tk * PTS + ch * 16) = (u32x4){pk2(sigmoidf_(gl[0]), sigmoidf_(gl[1])), pk2(sigmoidf_(gl[2]), sigmoidf_(gl[3])), pk2(sigmoidf_(gl[4]), sigmoidf_(gl[5])), pk2(sigmoidf_(gl[6]), sigmoidf_(gl[7]))}; }
        u32x4 rof, rob, ra1, ra2 = (u32x4){0u, 0u, 0u, 0u}; f32x4 rk0 = (f32x4){0.f, 0.f, 0.f, 0.f}, rk1 = rk0;
#define POST_LOAD(t0_) do { const int tk_ = (t0_) + tsub; const int s_ = u * 33 + (tk_ < 33 ? tk_ : 32); const bf16_t* pr_ = proj + (size_t)tok_row(b, s_) * NPROJ; \
        rof = *(const u32x4*)(of + (size_t)s_ * 1024 + c8); rob = *(const u32x4*)(obk + (size_t)s_ * 1024 + c8); ra1 = *(const u32x4*)(pr_ + col1); \
        if (mixer == 1) { ra2 = *(const u32x4*)(pr_ + PB_V + cm); rk0 = *(const f32x4*)(WSP(float, SC_RK) + (size_t)s_ * 256 + cm); rk1 = *(const f32x4*)(WSP(float, SC_RK) + (size_t)s_ * 256 + cm + 4); } \
        else if (mixer == 2) ra2 = *(const u32x4*)(WSP(bf16_t, SC_SX) + (size_t)s_ * 768 + cm); } while (0)
        POST_LOAD(0);
        __syncthreads();
        { const int lane = tid & 63, wave = tid >> 6, fr = lane & 15, fq = lane >> 4; f32x4 acc[3][2];
#pragma unroll
          for (int mt = 0; mt < 3; ++mt) { acc[mt][0] = (f32x4){0.f, 0.f, 0.f, 0.f}; acc[mt][1] = (f32x4){0.f, 0.f, 0.f, 0.f}; }
#pragma unroll
          for (int ks = 0; ks < 2; ++ks) { bf16x8 bb[2];
#pragma unroll
              for (int nt = 0; nt < 2; ++nt) bb[nt] = *(const LAS bf16x8*)(GWb + (16 * (2 * wave + nt) + fr) * PTS + ks * 64 + fq * 16);
#pragma unroll
              for (int mt = 0; mt < 3; ++mt) { const bf16x8 a = *(const LAS bf16x8*)(SGb + (16 * mt + fr) * PTS + ks * 64 + fq * 16);
                  acc[mt][0] = __builtin_amdgcn_mfma_f32_16x16x32_bf16(a, bb[0], acc[mt][0], 0, 0, 0); acc[mt][1] = __builtin_amdgcn_mfma_f32_16x16x32_bf16(a, bb[1], acc[mt][1], 0, 0, 0); } }
#pragma unroll
          for (int mt = 0; mt < 3; ++mt)
#pragma unroll
              for (int nt = 0; nt < 2; ++nt)
#pragma unroll
                  for (int j = 0; j < 4; ++j) GT[(16 * mt + 4 * fq + j) * GTS + 16 * (2 * wave + nt) + fr] = acc[mt][nt][j]; }
        __syncthreads();
#pragma unroll 1
        for (int t0 = 0; t0 < 36; t0 += 4) { const int tk = t0 + tsub; const bool live = tk < 33; const int tkc = live ? tk : 32, s = u * 33 + tkc, row = tok_row(b, s);
            const u32x4 cof = rof, cob = rob, ca1 = ra1, ca2 = ra2; const f32x4 k0 = rk0, k1 = rk1;
            if (t0 + 4 < 36) POST_LOAD(t0 + 4);
            float o[8], a[8], y[8];
            { float t1[8], t2[8]; bf8_to_f(cof, t1); bf8_to_f(cob, t2);
#pragma unroll
              for (int q = 0; q < 8; ++q) o[q] = t1[q] + t2[q]; }
            bf8_to_f(ca1, a);
            if (mixer == 0 || mixer == 3) { float ss = 0.f;
#pragma unroll
                for (int q = 0; q < 8; ++q) ss += o[q] * o[q];
                const float rs = rsqrtf(sum8_(ss) * (1.0f / 64.0f) + 1e-6f);
#pragma unroll
                for (int q = 0; q < 8; ++q) y[q] = o[q] * rs * g0[q] * siluf_(a[q]);
            } else if (mixer == 2) { float xs[8]; bf8_to_f(ca2, xs); float ss = 0.f;
#pragma unroll
                for (int q = 0; q < 8; ++q) { y[q] = (o[q] + g1[q] * xs[q]) * siluf_(a[q]); ss += y[q] * y[q]; }
                const float rs = rsqrtf(sum16_(ss) * (1.0f / 128.0f) + 1e-6f);
#pragma unroll
                for (int q = 0; q < 8; ++q) y[q] *= rs * g0[q];
            } else { float vv[8]; bf8_to_f(ca2, vv);
                float su = 0.f, bo = 0.f;
#pragma unroll
                for (int q = 0; q < 8; ++q) { su += o[q]; bo += a[q] * (q < 4 ? k0[q & 3] : k1[q & 3]) * g2[q]; }
                const float mu = sum8_(su) * (1.0f / 64.0f); bo = sum8_(bo); float va = 0.f;
#pragma unroll
                for (int q = 0; q < 8; ++q) { o[q] -= mu; va += o[q] * o[q]; }
                const float rs = rsqrtf(sum8_(va) * (1.0f / 64.0f) + 64e-5f);
                const f32x4 gt0 = *(const LAS f32x4*)(GT + tkc * GTS + cm), gt1 = *(const LAS f32x4*)(GT + tkc * GTS + cm + 4);
#pragma unroll
                for (int q = 0; q < 8; ++q) y[q] = (o[q] * rs * g0[q] + g1[q] + bo * vv[q]) * (q < 4 ? gt0[q & 3] : gt1[q & 3]); }
            if (live) *(u32x4*)(yc + (size_t)row * D + c8) = (u32x4){pk2(y[0], y[1]), pk2(y[2], y[3]), pk2(y[4], y[5]), pk2(y[6], y[7])};
        }
#undef POST_LOAD
    }
}
constexpr int N2_TILE = 32, N2_STRIDE = 2064;
__device__ __forceinline__ void phase_norm2(const Cx& p, LAS unsigned char* lds, int layer, int row_lo) {
    const int tid = p.tid, lane = tid & 63, wave = __builtin_amdgcn_readfirstlane(tid >> 6), fr = lane & 15, fq = lane >> 4;
    const float* mod = WSP(float, WS_MOD) + (size_t)layer * 5 * 6144; const float* g = PIN(I_N2G) + layer * D; bf16_t* hb = WSP(bf16_t, WS_HBUF);
    const bf16_t* rt = WSP(bf16_t, WS_ROUT) + (size_t)layer * 2 * NE * D;
    LAS float* lg = (LAS float*)(lds + 2 * N2_TILE * N2_STRIDE);
    unsigned* cnt = WSP(unsigned, WS_CTL) + CW_CNT + layer * 80 * 16; int* ltok = WSP(int, WS_LTOK); int* tokt = WSP(int, WS_TOKT);
    const float rbias = PIN(I_ROUT_B)[layer * NE + lane];
    const int nun = (ROWS - row_lo) / N2_TILE;
    for (int u = p.bid; u < nun; u += p.G) { const int r0 = row_lo + u * N2_TILE;
#pragma unroll 1
        for (int i = 0; i < 4; i += 2) { const int tr = 4 * wave + i, r = r0 + tr; f32x4 v0[4], v1[4];
            norm_ld(res_row(p, 0, r), v0, lane); norm_ld(res_row(p, 0, r + 1), v1, lane);
            const int s0 = row_sel(r), s1 = row_sel(r + 1);
            norm_fin(v0, g, mod + s0 * 6144 + 3072, mod + s0 * 6144 + 4096, hb + (size_t)r * D, true, (LAS bf16_t*)(lds + tr * N2_STRIDE), (LAS bf16_t*)(lds + N2_TILE * N2_STRIDE + tr * N2_STRIDE), lane);
            norm_fin(v1, g, mod + s1 * 6144 + 3072, mod + s1 * 6144 + 4096, hb + (size_t)(r + 1) * D, true, (LAS bf16_t*)(lds + (tr + 1) * N2_STRIDE), (LAS bf16_t*)(lds + N2_TILE * N2_STRIDE + (tr + 1) * N2_STRIDE), lane); }
        __syncthreads();
        { const int mt = wave >> 2, nt = wave & 3; f32x4 acc = (f32x4){0.f, 0.f, 0.f, 0.f};
          const LAS unsigned char* ap = lds + (16 * mt + fr) * N2_STRIDE + fq * 16; const bf16_t* bp = rt + (size_t)(16 * nt + fr) * D + fq * 8;
#pragma unroll 4
          for (int ks = 0; ks < 32; ++ks) { const bf16x8 a = *(const LAS bf16x8*)(ap + ks * 64), al = *(const LAS bf16x8*)(ap + N2_TILE * N2_STRIDE + ks * 64);
              const bf16x8 bb = *(const bf16x8*)(bp + ks * 32), bl = *(const bf16x8*)(bp + NE * D + ks * 32);
              acc = __builtin_amdgcn_mfma_f32_16x16x32_bf16(a, bb, acc, 0, 0, 0); acc = __builtin_amdgcn_mfma_f32_16x16x32_bf16(al, bb, acc, 0, 0, 0); acc = __builtin_amdgcn_mfma_f32_16x16x32_bf16(a, bl, acc, 0, 0, 0); }
#pragma unroll
          for (int j = 0; j < 4; ++j) lg[(16 * mt + 4 * fq + j) * 64 + 16 * nt + fr] = acc[j]; }
        __syncthreads();
#pragma unroll 1
        for (int i = 0; i < 4; ++i) { const int tr = 4 * wave + i, r = r0 + tr;
            const float sc = sigmoidf_(lg[tr * 64 + lane]); float sel = sc + rbias; float ssum = 0.f; int myE = 0; float myS = 0.f;
#pragma unroll 1
            for (int k = 0; k < TOPK; ++k) { float bv = sel; int bi = lane;
#define ARGSTEP(OV, OI) do { const float ov_ = (OV); const int oi_ = (OI); if (ov_ > bv || (ov_ == bv && oi_ < bi)) { bv = ov_; bi = oi_; } } while (0)
                ARGSTEP(DPPF(bv, 0xB1), DPPI(bi, 0xB1)); ARGSTEP(DPPF(bv, 0x4E), DPPI(bi, 0x4E)); ARGSTEP(DPPF(bv, 0x141), DPPI(bi, 0x141)); ARGSTEP(DPPF(bv, 0x140), DPPI(bi, 0x140));
                ARGSTEP(__uint_as_float(__builtin_amdgcn_ds_swizzle(__float_as_uint(bv), 0x401F)), __builtin_amdgcn_ds_swizzle(bi, 0x401F));
                { const float v0 = rl(bv, 0), v1 = rl(bv, 32); const int i0 = __builtin_amdgcn_readlane(bi, 0), i1 = __builtin_amdgcn_readlane(bi, 32); if (v1 > v0 || (v1 == v0 && i1 < i0)) { bv = v1; bi = i1; } else { bv = v0; bi = i0; } }
#undef ARGSTEP
                const int e = __builtin_amdgcn_readfirstlane(bi); const float se = rl(sc, e);
                ssum += se; if (lane == k) { myE = e; myS = se; } if (lane == e) sel = -1e30f; }
            if (lane < TOPK) { const unsigned pos = atomicAdd(cnt + myE * 16, 1u); ltok[(size_t)myE * ROWS + pos] = r; tokt[(size_t)r * 16 + lane] = (myE << 16) | (int)pos; ((float*)tokt)[(size_t)r * 16 + 8 + lane] = myS / ssum * 2.5f; } }
        __syncthreads();
    }
}
__device__ __forceinline__ void moe_table(const Cx& p, LAS int* tb, int layer, int row_lo) {
    const unsigned* cnt = WSP(unsigned, WS_CTL) + CW_CNT + layer * 80 * 16;
    if (p.tid == 0) { int acc = 0;
#pragma unroll 1
        for (int e = 0; e < NE1; ++e) { const int c = e < NE ? (int)__hip_atomic_load(cnt + e * 16, __ATOMIC_RELAXED, __HIP_MEMORY_SCOPE_AGENT) : ROWS - row_lo; tb[e] = c; tb[128 + e] = acc; acc += (c + 255) >> 8; }
        tb[128 + NE1] = acc; }
    __syncthreads();
}
__device__ __forceinline__ void phase_combine(const Cx& p, const LAS int* tb, int layer, int row_lo, int half) {
    const int lane = p.tid & 63, wave = p.tid >> 6; const bf16_t* Y = WSP(bf16_t, WS_Y); const int* tokt = WSP(int, WS_TOKT);
    const float* gate = WSP(float, WS_MOD) + (size_t)layer * 5 * 6144 + 5120; const int col = 512 * half + 8 * lane; const int shbase = tb[128 + NE] * 256;
#pragma unroll 2
    for (int r = row_lo + p.bid * 8 + wave; r < ROWS; r += p.G * 8) {
        const int sw = lane < 16 ? tokt[(size_t)r * 16 + lane] : 0;
        float a[8];
        { const u32x4 y = *(const u32x4*)(Y + (size_t)(shbase + (r - row_lo)) * 512 + 8 * lane);
#pragma unroll
          for (int q = 0; q < 4; ++q) { a[2 * q] = __uint_as_float(y[q] << 16); a[2 * q + 1] = __uint_as_float(y[q] & 0xffff0000u); } }
#pragma unroll
        for (int k = 0; k < 8; ++k) { const int sl = __builtin_amdgcn_readlane(sw, k); const float w = __uint_as_float(__builtin_amdgcn_readlane(sw, 8 + k));
            const int hrow = tb[128 + (sl >> 16)] * 256 + (sl & 0xffff); const u32x4 y = *(const u32x4*)(Y + (size_t)hrow * 512 + 8 * lane);
#pragma unroll
            for (int q = 0; q < 4; ++q) { a[2 * q] += w * __uint_as_float(y[q] << 16); a[2 * q + 1] += w * __uint_as_float(y[q] & 0xffff0000u); } }
        float* x = (float*)res_row(p, 0, r) + col; const float* gp = gate + row_sel(r) * 6144 + col;
#pragma unroll
        for (int q = 0; q < 2; ++q) { const f32x4 gv = *(const f32x4*)(gp + 4 * q); f32x4 xv = *(const f32x4*)(x + 4 * q);
            xv[0] += gv[0] * a[4 * q]; xv[1] += gv[1] * a[4 * q + 1]; xv[2] += gv[2] * a[4 * q + 2]; xv[3] += gv[3] * a[4 * q + 3]; *(f32x4*)(x + 4 * q) = xv; }
    }
}
__device__ __forceinline__ void phase_final(const Cx& p) {
    const int lane = p.tid & 63, wave = p.tid >> 6; const float* g = PIN(I_FNG);
    for (int r = p.bid * 16 + wave * 2; r < NB * SEQ; r += p.G * 16) { f32x4 v[2][4];
        norm_ld(p.out + (size_t)r * D, v[0], lane); norm_ld(p.out + (size_t)(r + 1) * D, v[1], lane);
#pragma unroll
        for (int q = 0; q < 2; ++q) { float* x = p.out + (size_t)(r + q) * D; float ss = 0.f;
#pragma unroll
            for (int i = 0; i < 4; ++i) ss += v[q][i][0] * v[q][i][0] + v[q][i][1] * v[q][i][1] + v[q][i][2] * v[q][i][2] + v[q][i][3] * v[q][i][3];
            ss = wsum(ss); const float rstd = rsqrtf(ss * (1.0f / D) + 1e-6f);
#pragma unroll
            for (int i = 0; i < 4; ++i) *(f32x4*)(x + 256 * i + 4 * lane) = v[q][i] * rstd * *(const f32x4*)(g + 256 * i + 4 * lane); } }
}
__device__ __forceinline__ int chain_tb(int n, int d) { return d == 0 ? n : (n < 4 ? 3 - n : 135 - n); }
__device__ __forceinline__ int tb_row0(int b, int tb) { return tb < 4 ? b * NCTX + 64 * tb : CROWS + b * SEQ + 64 * (tb - 4); }
constexpr int TS = 144;
template <int K, int NT> __device__ __forceinline__ void mm_rows(const LAS unsigned char* A, int lda, const LAS unsigned char* Bt, int ldb, int mt, int nt0, int fr, int fq, f32x4 (&acc)[NT]) {
#pragma unroll
    for (int ks = 0; ks < K / 32; ++ks) { const bf16x8 a = *(const LAS bf16x8*)(A + (16 * mt + fr) * lda + ks * 64 + fq * 16);
#pragma unroll
        for (int nt = 0; nt < NT; ++nt) { const bf16x8 bb = *(const LAS bf16x8*)(Bt + (16 * (nt0 + nt) + fr) * ldb + ks * 64 + fq * 16);
            acc[nt] = __builtin_amdgcn_mfma_f32_16x16x32_bf16(a, bb, acc[nt], 0, 0, 0); } }
}
#define UNIT_LOOP(u, N, OFF) for (int u = (p.bid + p.G - ((OFF) % p.G)) % p.G; u < (N); u += p.G)
__device__ __forceinline__ void gla_p1(const Cx& p, LAS unsigned char* lds, int layer, int b) {
    const int tid = p.tid, lane = tid & 63, wave = __builtin_amdgcn_readfirstlane(tid >> 6), fr = lane & 15, fq = lane >> 4;
    LAS unsigned char* ksT = lds; LAS unsigned char* vT = lds + 64 * TS; LAS float* gs = (LAS float*)(lds + 2 * 64 * TS); LAS float* glb = gs + 512;
    const bf16_t* proj = WSP(bf16_t, WS_PROJ); const int mt = wave >> 1, nt0 = (wave & 1) * 2; const int cl = lane, tg = wave;
    float w2[16], gb; unsigned gw; bf16_t kq[8], vq[8];
#define GLA1_LOAD(uu) do { const int tb_ = (uu) >> 3, h_ = ((uu) >> 1) & 3, d_ = (uu) & 1, c_ = 64 * h_ + cl; const bf16_t* pr_ = proj + (size_t)tb_row0(b, tb_) * NPROJ; \
        _Pragma("unroll") for (int r = 0; r < 16; ++r) w2[r] = PIN(I_GLA_W2)[((size_t)(layer * 2 + d_) * 16 + r) * 256 + c_]; \
        gb = PIN(I_GLA_B)[(layer * 2 + d_) * 256 + c_]; \
        { const int e = tid * 2, i = e >> 4, r = e & 15; gw = *(const unsigned*)(pr_ + (size_t)i * NPROJ + (d_ ? PA_GB : PA_GF) + r); } \
        _Pragma("unroll") for (int i8 = 0; i8 < 8; ++i8) { const bf16_t* pa = pr_ + (size_t)(8 * tg + i8) * NPROJ; kq[i8] = pa[PA_K + c_]; vq[i8] = pa[PA_V + c_]; } } while (0)
    int u = (p.bid + p.G) % p.G;
    if (u < NUNIT) GLA1_LOAD(u);
    for (; u < NUNIT; u += p.G) { const int d = u & 1;
        glb[tid * 2] = __uint_as_float(gw << 16); glb[tid * 2 + 1] = __uint_as_float(gw & 0xffff0000u);
        __syncthreads();
        float bl[8]; float run = 0.f;
#pragma unroll
        for (int ii = 0; ii < 8; ++ii) { const int i8 = d ? 7 - ii : ii; const LAS float* gl_ = glb + (8 * tg + i8) * 16; float z = gb;
#pragma unroll
            for (int r = 0; r < 16; ++r) z += gl_[r] * w2[r];
            run += logsigmoidf_(z) * (1.0f / 16.0f); if (d) bl[7 - ii] = run; else bl[ii] = run; }
        gs[tg * 64 + cl] = run;
        __syncthreads();
        float off = 0.f, total = 0.f;
#pragma unroll
        for (int g2 = 0; g2 < 8; ++g2) { const float t = gs[g2 * 64 + cl]; total += t; if (d ? g2 > tg : g2 < tg) off += t; }
#pragma unroll
        for (int i8 = 0; i8 < 8; i8 += 2) { const int i = 8 * tg + i8;
            const float ka = bf2f(kq[i8]) * __expf(total - (bl[i8] + off)), kb = bf2f(kq[i8 + 1]) * __expf(total - (bl[i8 + 1] + off));
            *(LAS unsigned*)(ksT + cl * TS + i * 2) = pk2(ka, kb); *(LAS unsigned*)(vT + cl * TS + i * 2) = (unsigned)vq[i8] | ((unsigned)vq[i8 + 1] << 16); }
        if (u + p.G < NUNIT) GLA1_LOAD(u + p.G);
        if (tg == 0) WSP(float, SC_GLA_DEC)[(size_t)u * 64 + cl] = __expf(total);
        __syncthreads();
        { f32x4 acc[2] = {(f32x4){0.f, 0.f, 0.f, 0.f}, (f32x4){0.f, 0.f, 0.f, 0.f}}; float* kv = WSP(float, SC_GLA_S) + (size_t)u * 4096;
          mm_rows<64, 2>(ksT, TS, vT, TS, mt, nt0, fr, fq, acc);
#pragma unroll
          for (int t = 0; t < 2; ++t)
#pragma unroll
              for (int j = 0; j < 4; ++j) kv[(16 * mt + 4 * fq + j) * 64 + 16 * (nt0 + t) + fr] = acc[t][j]; }
        __syncthreads();
    }
#undef GLA1_LOAD
}
__device__ __forceinline__ void gla_chain(const Cx& p, int h, int d, int part) {
    if (p.tid >= 256) return;
    const int e0 = part * 1024 + p.tid * 4, dk = e0 >> 6;
    f32x4 s0 = (f32x4){0.f, 0.f, 0.f, 0.f};
    f32x4 n0[6]; float dc[6];
#define GC_LD(q, n_) do { const int u_ = (chain_tb((n_), d) * 4 + h) * 2 + d; n0[q] = *(const f32x4*)(WSP(float, SC_GLA_S) + (size_t)u_ * 4096 + e0); dc[q] = WSP(float, SC_GLA_DEC)[(size_t)u_ * 64 + dk]; } while (0)
#define GC_ST(q, n_) do { const int u_ = (chain_tb((n_), d) * 4 + h) * 2 + d; float* k_ = WSP(float, SC_GLA_S) + (size_t)u_ * 4096 + e0; \
        const f32x4 a0_ = n0[q]; const float de_ = dc[q]; if ((n_) + 6 < NTB) GC_LD(q, (n_) + 6); *(f32x4*)k_ = s0; s0 = s0 * de_ + a0_; } while (0)
    GC_LD(0, 0); GC_LD(1, 1); GC_LD(2, 2); GC_LD(3, 3); GC_LD(4, 4); GC_LD(5, 5);
#pragma unroll 1
    for (int n = 0; n < NTB; n += 6) { GC_ST(0, n); GC_ST(1, n + 1); GC_ST(2, n + 2); GC_ST(3, n + 3); GC_ST(4, n + 4); GC_ST(5, n + 5); }
#undef GC_LD
#undef GC_ST
}
__device__ __forceinline__ void gla_p2(const Cx& p, LAS unsigned char* lds, int layer, int b) {
    const int tid = p.tid, lane = tid & 63, wave = __builtin_amdgcn_readfirstlane(tid >> 6), fr = lane & 15, fq = lane >> 4;
    LAS unsigned char* qt = lds; LAS unsigned char* kt = lds + 64 * TS; LAS unsigned char* vT = lds + 2 * 64 * TS; LAS unsigned char* sT = lds + 3 * 64 * TS; LAS unsigned char* att = lds + 4 * 64 * TS;
    LAS float* gs = (LAS float*)(lds + 5 * 64 * TS); LAS float* glb = gs + 512;
    const bf16_t* proj = WSP(bf16_t, WS_PROJ); const int cl = lane, tg = wave;
    float w2[16], gb; unsigned gw; bf16_t qq[8], kq[8], vq[8]; float sq[8];
#define GLA2_LOAD(uu) do { const int tb_ = (uu) >> 3, h_ = ((uu) >> 1) & 3, d_ = (uu) & 1, c_ = 64 * h_ + cl; const bf16_t* pr_ = proj + (size_t)tb_row0(b, tb_) * NPROJ; \
        _Pragma("unroll") for (int r = 0; r < 16; ++r) w2[r] = PIN(I_GLA_W2)[((size_t)(layer * 2 + d_) * 16 + r) * 256 + c_]; \
        gb = PIN(I_GLA_B)[(layer * 2 + d_) * 256 + c_]; \
        { const int e = tid * 2, i = e >> 4, r = e & 15; gw = *(const unsigned*)(pr_ + (size_t)i * NPROJ + (d_ ? PA_GB : PA_GF) + r); } \
        _Pragma("unroll") for (int i8 = 0; i8 < 8; ++i8) { const bf16_t* pa = pr_ + (size_t)(8 * tg + i8) * NPROJ; qq[i8] = pa[PA_Q + c_]; kq[i8] = pa[PA_K + c_]; vq[i8] = pa[PA_V + c_]; } \
        { const float* sp_ = WSP(float, SC_GLA_S) + (size_t)(uu) * 4096; _Pragma("unroll") for (int q = 0; q < 8; ++q) sq[q] = sp_[tid + NTHR * q]; } } while (0)
    int u = (p.bid + p.G - (128 % p.G)) % p.G;
    if (u < NUNIT) GLA2_LOAD(u);
    for (; u < NUNIT; u += p.G) { const int tb = u >> 3, h = (u >> 1) & 3, d = u & 1; const int s0 = 64 * tb;
        glb[tid * 2] = __uint_as_float(gw << 16); glb[tid * 2 + 1] = __uint_as_float(gw & 0xffff0000u);
#pragma unroll
        for (int q = 0; q < 8; ++q) { const int e = tid + NTHR * q, dk = e >> 6, dv = e & 63; *(LAS bf16_t*)(sT + dv * TS + dk * 2) = (bf16_t)f2bf(sq[q]); }
        __syncthreads();
        float bl[8]; float run = 0.f;
#pragma unroll
        for (int ii = 0; ii < 8; ++ii) { const int i8 = d ? 7 - ii : ii; const LAS float* gl_ = glb + (8 * tg + i8) * 16; float z = gb;
#pragma unroll
            for (int r = 0; r < 16; ++r) z += gl_[r] * w2[r];
            run += logsigmoidf_(z) * (1.0f / 16.0f); if (d) bl[7 - ii] = run; else bl[ii] = run; }
        gs[tg * 64 + cl] = run;
        __syncthreads();
        float off = 0.f;
#pragma unroll
        for (int g2 = 0; g2 < 8; ++g2) if (d ? g2 > tg : g2 < tg) off += gs[g2 * 64 + cl];
#pragma unroll
        for (int i8 = 0; i8 < 8; ++i8) { const int i = 8 * tg + i8; const float bi = bl[i8] + off;
            *(LAS bf16_t*)(qt + i * TS + cl * 2) = (bf16_t)f2bf(bf2f(qq[i8]) * 0.125f * __expf(bi));
            *(LAS bf16_t*)(kt + i * TS + cl * 2) = (bf16_t)f2bf(bf2f(kq[i8]) * __expf(-bi));
            *(LAS bf16_t*)(vT + cl * TS + i * 2) = vq[i8]; }
        if (u + p.G < NUNIT) GLA2_LOAD(u + p.G);
        __syncthreads();
        const int mt = wave >> 1, nt0 = (wave & 1) * 2;
        { f32x4 acc[2] = {(f32x4){0.f, 0.f, 0.f, 0.f}, (f32x4){0.f, 0.f, 0.f, 0.f}};
          mm_rows<64, 2>(qt, TS, kt, TS, mt, nt0, fr, fq, acc);
#pragma unroll
          for (int t = 0; t < 2; ++t)
#pragma unroll
              for (int j = 0; j < 4; ++j) { const int i = 16 * mt + 4 * fq + j, jj = 16 * (nt0 + t) + fr; const bool keep = d ? jj >= i : jj <= i;
                  *(LAS bf16_t*)(att + i * TS + jj * 2) = (bf16_t)f2bf(keep ? acc[t][j] : 0.f); } }
        __syncthreads();
        { f32x4 acc[2] = {(f32x4){0.f, 0.f, 0.f, 0.f}, (f32x4){0.f, 0.f, 0.f, 0.f}};
          mm_rows<64, 2>(att, TS, vT, TS, mt, nt0, fr, fq, acc);
          mm_rows<64, 2>(qt, TS, sT, TS, mt, nt0, fr, fq, acc);
          bf16_t* ob = WSP(bf16_t, d ? SC_OB : SC_OF);
#pragma unroll
          for (int t = 0; t < 2; ++t)
#pragma unroll
              for (int j = 0; j < 4; ++j) ob[(size_t)(s0 + 16 * mt + 4 * fq + j) * 1024 + 64 * h + 16 * (nt0 + t) + fr] = (bf16_t)f2bf(acc[t][j]); }
        __syncthreads();
    }
}
#undef GLA2_LOAD
constexpr int TS2 = 272;
__device__ __forceinline__ float ssd_acum(float a, int d, int lane, float& total) {
    float pre = a;
#pragma unroll
    for (int o = 1; o < 64; o <<= 1) { const float t = shup_(pre, lane, o); if (lane >= o) pre += t; }
    total = rl(pre, 63);
    return d ? total - pre + a : pre;
}
__device__ __forceinline__ void ssd_p1(const Cx& p, LAS unsigned char* lds, int layer, int b) {
    const int tid = p.tid, lane = tid & 63, wave = __builtin_amdgcn_readfirstlane(tid >> 6), fr = lane & 15, fq = lane >> 4;
    LAS unsigned char* BT = lds; LAS unsigned char* xT = lds + 128 * TS; LAS float* AC = (LAS float*)(lds + 128 * TS + 64 * TS);
    u32x4 bq[2], xq; float dtq;
#define SSD1_LOAD(uu) do { const int tb_ = (uu) >> 3, g_ = ((uu) >> 2) & 1, hd_ = (uu) & 3, h_ = 2 * g_ + (hd_ >> 1), d_ = hd_ & 1; \
        const bf16_t* sx_ = WSP(bf16_t, SC_SX) + (size_t)(64 * tb_ + lane) * 768; \
        bq[0] = *(const u32x4*)(sx_ + 256 + 128 * g_ + 16 * wave); bq[1] = *(const u32x4*)(sx_ + 256 + 128 * g_ + 16 * wave + 8); \
        xq = *(const u32x4*)(sx_ + 64 * h_ + 8 * wave); dtq = WSP(float, SC_SDT)[(size_t)(64 * tb_ + lane) * 8 + d_ * 4 + h_]; } while (0)
    int u3 = (p.bid + p.G - (32 % p.G)) % p.G;
    if (u3 < NTB * 8) SSD1_LOAD(u3);
    for (; u3 < NTB * 8; u3 += p.G) { const int tb = u3 >> 3, g = (u3 >> 2) & 1, hd = u3 & 3, h = 2 * g + (hd >> 1), d = hd & 1;
        if (wave == 0) { const float aneg = -__expf(PIN(I_SS_ALOG)[(layer * 2 + d) * 4 + h]);
            float tot; const float ac = ssd_acum(aneg * dtq, d, lane, tot); AC[lane] = ac; if (lane == 0) { AC[64] = tot; WSP(float, SC_SSD_CD)[(tb * 4 + h) * 2 + d] = __expf(tot); } }
#pragma unroll
        for (int q = 0; q < 2; ++q)
#pragma unroll
            for (int k = 0; k < 8; ++k) *(LAS bf16_t*)(BT + (16 * wave + 8 * q + k) * TS + lane * 2) = (bf16_t)(bq[q][k >> 1] >> (16 * (k & 1)));
        __syncthreads();
        { const float f = dtq * __expf(AC[64] - AC[lane]);
#pragma unroll
          for (int k = 0; k < 8; ++k) *(LAS bf16_t*)(xT + (8 * wave + k) * TS + lane * 2) = (bf16_t)f2bf(bf2f((bf16_t)(xq[k >> 1] >> (16 * (k & 1)))) * f); }
        if (u3 + p.G < NTB * 8) SSD1_LOAD(u3 + p.G);
        __syncthreads();
        { const int mt = wave >> 1, nt0 = (wave & 1) * 4; float* cs = WSP(float, SC_SSD_S) + (size_t)((tb * 4 + h) * 2 + d) * 8192; f32x4 acc[4];
#pragma unroll
          for (int t = 0; t < 4; ++t) acc[t] = (f32x4){0.f, 0.f, 0.f, 0.f};
          mm_rows<64, 4>(xT, TS, BT, TS, mt, nt0, fr, fq, acc);
#pragma unroll
          for (int t = 0; t < 4; ++t)
#pragma unroll
              for (int j = 0; j < 4; ++j) cs[(16 * mt + 4 * fq + j) * 128 + 16 * (nt0 + t) + fr] = acc[t][j]; }
        __syncthreads();
    }
#undef SSD1_LOAD
}
__device__ __forceinline__ void ssd_chain(const Cx& p, int h, int d, int part) {
    if (p.tid >= 256) return;
    const int e0 = part * 1024 + p.tid * 4;
    f32x4 s = (f32x4){0.f, 0.f, 0.f, 0.f}; f32x4 nx[6]; float cd[6];
#define SC_LD(q, n_) do { const int u_ = (chain_tb((n_), d) * 4 + h) * 2 + d; nx[q] = *(const f32x4*)(WSP(float, SC_SSD_S) + (size_t)u_ * 8192 + e0); cd[q] = WSP(float, SC_SSD_CD)[u_]; } while (0)
#define SC_ST(q, n_) do { const int u_ = (chain_tb((n_), d) * 4 + h) * 2 + d; float* c_ = WSP(float, SC_SSD_S) + (size_t)u_ * 8192 + e0; const f32x4 a_ = nx[q]; const float de_ = cd[q]; \
        if ((n_) + 6 < NTB) SC_LD(q, (n_) + 6); *(f32x4*)c_ = s; s = s * de_ + a_; } while (0)
    SC_LD(0, 0); SC_LD(1, 1); SC_LD(2, 2); SC_LD(3, 3); SC_LD(4, 4); SC_LD(5, 5);
#pragma unroll 1
    for (int n = 0; n < NTB; n += 6) { SC_ST(0, n); SC_ST(1, n + 1); SC_ST(2, n + 2); SC_ST(3, n + 3); SC_ST(4, n + 4); SC_ST(5, n + 5); }
#undef SC_LD
#undef SC_ST
}
__device__ __forceinline__ void ssd_p2(const Cx& p, LAS unsigned char* lds, int layer, int b) {
    const int tid = p.tid, lane = tid & 63, wave = __builtin_amdgcn_readfirstlane(tid >> 6), fr = lane & 15, fq = lane >> 4;
    LAS unsigned char* Ct = lds; LAS unsigned char* Bt2 = lds + 64 * TS2; LAS float* cb = (LAS float*)(lds + 2 * 64 * TS2); LAS float* AC = cb + 64 * 65;
    LAS unsigned char* Mt = (LAS unsigned char*)(AC + 64 + 4); LAS unsigned char* xT = Mt + 64 * TS; LAS unsigned char* Sb = xT + 64 * TS;
    const int mt = wave >> 1, nt0 = (wave & 1) * 2;
    u32x4 cq[2], bq[2], xq; float dtq; f32x4 sq[4];
#define SSD2_LOAD(uu) do { const int tb_ = (uu) >> 3, g_ = ((uu) >> 2) & 1, hd_ = (uu) & 3, h_ = 2 * g_ + (hd_ >> 1), d_ = hd_ & 1; \
        const bf16_t* sx_ = WSP(bf16_t, SC_SX) + (size_t)(64 * tb_) * 768; \
        _Pragma("unroll") for (int q = 0; q < 2; ++q) { const int e = tid + NTHR * q, i = e >> 4, ch = e & 15; \
            cq[q] = *(const u32x4*)(sx_ + (size_t)i * 768 + 512 + 128 * g_ + ch * 8); bq[q] = *(const u32x4*)(sx_ + (size_t)i * 768 + 256 + 128 * g_ + ch * 8); } \
        xq = *(const u32x4*)(sx_ + (size_t)lane * 768 + 64 * h_ + 8 * wave); dtq = WSP(float, SC_SDT)[(size_t)(64 * tb_ + lane) * 8 + d_ * 4 + h_]; \
        const float* sp_ = WSP(float, SC_SSD_S) + (size_t)((tb_ * 4 + h_) * 2 + d_) * 8192; \
        _Pragma("unroll") for (int q = 0; q < 4; ++q) sq[q] = *(const f32x4*)(sp_ + (tid + NTHR * q) * 4); } while (0)
    int u3 = (p.bid + p.G - (160 % p.G)) % p.G;
    if (u3 < NTB * 8) SSD2_LOAD(u3);
    for (; u3 < NTB * 8; u3 += p.G) { const int tb = u3 >> 3, g = (u3 >> 2) & 1, hd = u3 & 3, h = 2 * g + (hd >> 1), d = hd & 1, s0 = 64 * tb; (void)g;
        if (wave == 0) { const float aneg = -__expf(PIN(I_SS_ALOG)[(layer * 2 + d) * 4 + h]); float tot; AC[lane] = ssd_acum(aneg * dtq, d, lane, tot); }
#pragma unroll
        for (int q = 0; q < 2; ++q) { const int e = tid + NTHR * q, i = e >> 4, ch = e & 15;
            *(LAS u32x4*)(Ct + i * TS2 + ch * 16) = cq[q]; *(LAS u32x4*)(Bt2 + i * TS2 + ch * 16) = bq[q]; }
#pragma unroll
        for (int k = 0; k < 8; ++k) *(LAS bf16_t*)(xT + (8 * wave + k) * TS + lane * 2) = (bf16_t)f2bf(bf2f((bf16_t)(xq[k >> 1] >> (16 * (k & 1)))) * dtq);
#pragma unroll
        for (int q = 0; q < 4; ++q) { const int e = (tid + NTHR * q) * 4, pp = e >> 7, s = e & 127; const f32x4 v = sq[q];
            *(LAS u32x2*)(Sb + pp * TS2 + s * 2) = (u32x2){pk2(v[0], v[1]), pk2(v[2], v[3])}; }
        if (u3 + p.G < NTB * 8) SSD2_LOAD(u3 + p.G);
        __syncthreads();
        { f32x4 acc[2] = {(f32x4){0.f, 0.f, 0.f, 0.f}, (f32x4){0.f, 0.f, 0.f, 0.f}};
          mm_rows<128, 2>(Ct, TS2, Bt2, TS2, mt, nt0, fr, fq, acc);
#pragma unroll
          for (int t = 0; t < 2; ++t)
#pragma unroll
              for (int j = 0; j < 4; ++j) cb[(16 * mt + 4 * fq + j) * 65 + 16 * (nt0 + t) + fr] = acc[t][j]; }
        __syncthreads();
        { const int i = tid >> 3, j0 = (tid & 7) * 8; const float ai = AC[i]; unsigned w[4];
#pragma unroll
          for (int jj = 0; jj < 8; jj += 2) { float m[2];
#pragma unroll
              for (int q = 0; q < 2; ++q) { const int j = j0 + jj + q; const bool keep = d ? j >= i : j <= i; m[q] = keep ? cb[i * 65 + j] * __expf(ai - AC[j]) : 0.f; }
              w[jj >> 1] = pk2(m[0], m[1]); }
          *(LAS u32x4*)(Mt + i * TS + j0 * 2) = (u32x4){w[0], w[1], w[2], w[3]}; }
        __syncthreads();
        { f32x4 acc[2] = {(f32x4){0.f, 0.f, 0.f, 0.f}, (f32x4){0.f, 0.f, 0.f, 0.f}};
          mm_rows<128, 2>(Ct, TS2, Sb, TS2, mt, nt0, fr, fq, acc);
#pragma unroll
          for (int j = 0; j < 4; ++j) { const float sc = __expf(AC[16 * mt + 4 * fq + j]); acc[0][j] *= sc; acc[1][j] *= sc; }
          mm_rows<64, 2>(Mt, TS, xT, TS, mt, nt0, fr, fq, acc);
          bf16_t* ob = WSP(bf16_t, d ? SC_OB : SC_OF);
#pragma unroll
          for (int t = 0; t < 2; ++t)
#pragma unroll
              for (int j = 0; j < 4; ++j) ob[(size_t)(s0 + 16 * mt + 4 * fq + j) * 1024 + 512 + 64 * h + 16 * (nt0 + t) + fr] = (bf16_t)f2bf(acc[t][j]); }
        __syncthreads();
    }
}
#undef SSD2_LOAD
constexpr int AFS = 68;
__device__ __forceinline__ int dr_mfrag_idx(int row, int col) { return (((row >> 4) * 2 + (col >> 5)) * 64 + ((col >> 2) & 3) * 16 + (row & 15)) * 8 + ((col >> 4) & 1) * 4 + (col & 3); }
template <class RhsF> __device__ __forceinline__ void dr_block_solve(const LAS unsigned char* Abf, const LAS float* AfT, LAS unsigned char* XT, LAS float* Dbuf, const float sgn, const int wave, const RhsF& rhs, bf16_t* wu) {
#pragma unroll 1
    for (int kb_ = 0; kb_ < 4; ++kb_) {
        { const int lane = lane_id_asm(), fr = lane & 15, fq = lane >> 4; f32x4 acc = (f32x4){0.f, 0.f, 0.f, 0.f};
          if (kb_ > 0) {
#pragma unroll
              for (int ks = 0; ks < 2; ++ks) { const bf16x8 a = *(const LAS bf16x8*)(Abf + (16 * kb_ + fr) * TS + ks * 64 + fq * 16), bb = *(const LAS bf16x8*)(XT + (16 * wave + fr) * TS + ks * 64 + fq * 16);
                  acc = __builtin_amdgcn_mfma_f32_16x16x32_bf16(a, bb, acc, 0, 0, 0); } }
          *(LAS f32x4*)(Dbuf + (16 * wave + fr) * 20 + 4 * fq) = acc; }
        __syncthreads();
        if (wave < 2) { const int col = wave * 64 + lane_id_asm(); float x[16];
#pragma unroll
            for (int i = 0; i < 16; ++i) x[i] = rhs(16 * kb_ + i, col) - sgn * Dbuf[col * 20 + i];
            const LAS float* Ab = AfT + (16 * kb_) * AFS + 16 * kb_;
#pragma unroll
            for (int j = 0; j < 15; ++j) { const float xj = sgn * x[j];
#pragma unroll
                for (int i = j + 1; i < 16; ++i) x[i] -= Ab[j * AFS + i] * xj; }
            u32x4 w0, w1;
#pragma unroll
            for (int q = 0; q < 4; ++q) { w0[q] = pk2(x[2 * q], x[2 * q + 1]); w1[q] = pk2(x[8 + 2 * q], x[8 + 2 * q + 1]); }
            *(LAS u32x4*)(XT + col * TS + (16 * kb_) * 2) = w0; *(LAS u32x4*)(XT + col * TS + (16 * kb_ + 8) * 2) = w1;
#pragma unroll
            for (int i = 0; i < 16; ++i) wu[(16 * kb_ + i) * 128 + col] = (bf16_t)f2bf(x[i]); }
        __syncthreads();
    }
}
struct GdnRhs { const LAS unsigned char* kb; const LAS unsigned char* vb; const LAS float* GC;
    __device__ __forceinline__ float operator()(int r, int col) const { return col < 64 ? bf2f(*(const LAS bf16_t*)(kb + r * TS + col * 2)) * __expf(GC[r]) : bf2f(*(const LAS bf16_t*)(vb + r * TS + (col - 64) * 2)); } };
__device__ __forceinline__ void gdn_p1(const Cx& p, LAS unsigned char* lds, int layer, int b) {
    const int wave = __builtin_amdgcn_readfirstlane(p.tid >> 6);
#define GDN_LANES const int lane = lane_id_asm(), tid = wave * 64 + lane, fr = lane & 15, fq = lane >> 4; (void)tid; (void)fr; (void)fq
    LAS unsigned char* kh = lds; LAS unsigned char* kb = lds + 64 * TS; LAS unsigned char* vb = lds + 2 * 64 * TS; LAS unsigned char* Abf = lds + 3 * 64 * TS; LAS unsigned char* kdT = lds + 4 * 64 * TS; LAS unsigned char* XT = lds + 5 * 64 * TS;
    LAS float* Af = (LAS float*)(lds + 7 * 64 * TS); LAS float* Dbuf = Af + 64 * AFS; LAS float* GC = Dbuf + 128 * 20;
    const int mt = wave >> 1, nt0 = (wave & 1) * 2;
    float gq, beta; u32x4 kv, vv;
#define GDN1_LOAD(uu) do { const int tb_ = (uu) >> 3, h_ = ((uu) >> 1) & 3, d_ = (uu) & 1; const int lane_ = lane_id_asm(), tid_ = wave * 64 + lane_; \
        const bf16_t* dq_ = WSP(bf16_t, SC_DQ) + (size_t)(64 * tb_) * 768; const float* dg_ = WSP(float, SC_DG) + (size_t)(64 * tb_) * 16; \
        gq = dg_[(d_ ? 63 - lane_ : lane_) * 16 + 8 + d_ * 4 + h_]; \
        { const int r_ = tid_ >> 3, c0_ = (tid_ & 7) * 8, i_ = d_ ? 63 - r_ : r_; beta = dg_[i_ * 16 + d_ * 4 + h_]; \
          kv = *(const u32x4*)(dq_ + (size_t)i_ * 768 + 256 + 64 * h_ + c0_); vv = *(const u32x4*)(dq_ + (size_t)i_ * 768 + 512 + 64 * h_ + c0_); } } while (0)
    int u = (p.bid + p.G - (64 % p.G)) % p.G;
    if (u < NUNIT) GDN1_LOAD(u);
    for (; u < NUNIT; u += p.G) {
        if (wave == 0) { GDN_LANES; float pre = gq;
#pragma unroll
            for (int o = 1; o < 64; o <<= 1) { const float t = shup_(pre, lane, o); if (lane >= o) pre += t; }
            GC[lane] = pre; }
        { GDN_LANES; const int r = tid >> 3, c0 = (tid & 7) * 8; u32x4 kw, vw;
#pragma unroll
          for (int q = 0; q < 4; ++q) { kw[q] = pk2(__uint_as_float(kv[q] << 16) * beta, __uint_as_float(kv[q] & 0xffff0000u) * beta); vw[q] = pk2(__uint_as_float(vv[q] << 16) * beta, __uint_as_float(vv[q] & 0xffff0000u) * beta); }
          *(LAS u32x4*)(kh + r * TS + c0 * 2) = kv; *(LAS u32x4*)(kb + r * TS + c0 * 2) = kw; *(LAS u32x4*)(vb + r * TS + c0 * 2) = vw;
          *(LAS u32x4*)(XT + (2 * r) * TS + c0 * 2) = (u32x4){0u, 0u, 0u, 0u}; *(LAS u32x4*)(XT + (2 * r + 1) * TS + c0 * 2) = (u32x4){0u, 0u, 0u, 0u}; }
        if (u + p.G < NUNIT) GDN1_LOAD(u + p.G);
        __syncthreads();
        const float gtot = GC[63];
        { GDN_LANES; f32x4 acc[2] = {(f32x4){0.f, 0.f, 0.f, 0.f}, (f32x4){0.f, 0.f, 0.f, 0.f}};
          mm_rows<64, 2>(kb, TS, kh, TS, mt, nt0, fr, fq, acc);
#pragma unroll
          for (int t = 0; t < 2; ++t)
#pragma unroll
              for (int j = 0; j < 4; ++j) { const int r = 16 * mt + 4 * fq + j, jj = 16 * (nt0 + t) + fr; const float a = jj < r ? acc[t][j] * __expf(GC[r] - GC[jj]) : 0.f;
                  Af[jj * AFS + r] = a; *(LAS bf16_t*)(Abf + r * TS + jj * 2) = (bf16_t)f2bf(a); }
#pragma unroll 2
          for (int q = 0; q < 8; ++q) { const int e = tid + NTHR * q, r = e >> 6, cc = e & 63;
              *(LAS bf16_t*)(kdT + cc * TS + r * 2) = (bf16_t)f2bf(bf2f(*(const LAS bf16_t*)(kh + r * TS + cc * 2)) * __expf(gtot - GC[r])); } }
        __syncthreads();
        { const GdnRhs rhs{kb, vb, GC}; dr_block_solve(Abf, Af, XT, Dbuf, 1.0f, wave, rhs, WSP(bf16_t, SC_DR_WU) + (size_t)u * 8192); }
        { GDN_LANES; f32x4 am[2] = {(f32x4){0.f, 0.f, 0.f, 0.f}, (f32x4){0.f, 0.f, 0.f, 0.f}}, an[2] = {(f32x4){0.f, 0.f, 0.f, 0.f}, (f32x4){0.f, 0.f, 0.f, 0.f}};
          mm_rows<64, 2>(kdT, TS, XT, TS, mt, nt0, fr, fq, am);
          mm_rows<64, 2>(kdT, TS, XT + 64 * TS, TS, mt, nt0, fr, fq, an);
          bf16_t* Mg = WSP(bf16_t, SC_DR_M) + (size_t)u * 4096; bf16_t* Ng = WSP(bf16_t, SC_DR_NS) + (size_t)u * 4096; const float eg = __expf(gtot);
#pragma unroll
          for (int t = 0; t < 2; ++t) {
#pragma unroll
              for (int j = 0; j < 4; ++j) { const int row = 16 * mt + 4 * fq + j, col = 16 * (nt0 + t) + fr; Mg[dr_mfrag_idx(row, col)] = (bf16_t)f2bf((row == col ? eg : 0.f) - am[t][j]); }
              *(u32x2*)(Ng + (((nt0 + t) * 4 + mt) * 64 + lane) * 4) = (u32x2){pk2(an[t][0], an[t][1]), pk2(an[t][2], an[t][3])}; } }
        __syncthreads();
    }
#undef GDN_LANES
#undef GDN1_LOAD
}
__device__ __forceinline__ void dr_chain(const Cx& p, size_t offM, size_t offNS, int h, int d, int cb) {
    const int lane = p.tid & 63, fr = lane & 15, fq = lane >> 4;
    if (p.tid >= 64) return;
    f32x4 acc[4];
#pragma unroll
    for (int t = 0; t < 4; ++t) acc[t] = (f32x4){0.f, 0.f, 0.f, 0.f};
    bf16x8 mR[4][4][2]; u32x2 nR[4][4];
#define DR_LD(m, nn, n_) do { const int u_ = (chain_tb((n_), d) * 4 + h) * 2 + d; const bf16_t* M_ = WSP(bf16_t, offM) + (size_t)u_ * 4096; const bf16_t* N_ = WSP(bf16_t, offNS) + (size_t)u_ * 4096; \
        _Pragma("unroll") for (int t = 0; t < 4; ++t) { _Pragma("unroll") for (int ks = 0; ks < 2; ++ks) m[t][ks] = *(const bf16x8*)(M_ + ((t * 2 + ks) * 64 + lane) * 8); nn[t] = *(const u32x2*)(N_ + ((cb * 4 + t) * 64 + lane) * 4); } } while (0)
#define DR_STEP(m, nn, n_) do { const int u_ = (chain_tb((n_), d) * 4 + h) * 2 + d; bf16_t* ST_ = WSP(bf16_t, offNS) + (size_t)u_ * 4096 + (16 * cb + fr) * 64 + 4 * fq; \
        u32x2 sp_[4]; _Pragma("unroll") for (int t = 0; t < 4; ++t) { sp_[t] = (u32x2){pk2(acc[t][0], acc[t][1]), pk2(acc[t][2], acc[t][3])}; *(u32x2*)(ST_ + 16 * t) = sp_[t]; } \
        bf16x8 bf_[2]; _Pragma("unroll") for (int ks = 0; ks < 2; ++ks) { u32x4 w_ = (u32x4){sp_[2 * ks][0], sp_[2 * ks][1], sp_[2 * ks + 1][0], sp_[2 * ks + 1][1]}; bf_[ks] = __builtin_bit_cast(bf16x8, w_); } \
        _Pragma("unroll") for (int t = 0; t < 4; ++t) { f32x4 a_ = (f32x4){__uint_as_float(nn[t][0] << 16), __uint_as_float(nn[t][0] & 0xffff0000u), __uint_as_float(nn[t][1] << 16), __uint_as_float(nn[t][1] & 0xffff0000u)}; \
            a_ = __builtin_amdgcn_mfma_f32_16x16x32_bf16(m[t][0], bf_[0], a_, 0, 0, 0); acc[t] = __builtin_amdgcn_mfma_f32_16x16x32_bf16(m[t][1], bf_[1], a_, 0, 0, 0); } } while (0)
#define DR_GO(q, n_) do { DR_STEP(mR[q], nR[q], (n_)); if ((n_) + 4 < NTB) DR_LD(mR[q], nR[q], (n_) + 4); } while (0)
    DR_LD(mR[0], nR[0], 0); DR_LD(mR[1], nR[1], 1); DR_LD(mR[2], nR[2], 2); DR_LD(mR[3], nR[3], 3);
#pragma unroll 1
    for (int n = 0; n < NTB; n += 4) { DR_GO(0, n); DR_GO(1, n + 1); DR_GO(2, n + 2); DR_GO(3, n + 3); }
#undef DR_GO
#undef DR_LD
#undef DR_STEP
}
__device__ __forceinline__ void gdn_p2(const Cx& p, LAS unsigned char* lds, int layer, int b) {
    const int tid = p.tid, lane = tid & 63, wave = __builtin_amdgcn_readfirstlane(tid >> 6), fr = lane & 15, fq = lane >> 4;
    LAS unsigned char* qh = lds; LAS unsigned char* kh = lds + 64 * TS; LAS unsigned char* wt = lds + 2 * 64 * TS; LAS unsigned char* sT = lds + 3 * 64 * TS; LAS unsigned char* aq = lds + 4 * 64 * TS; LAS unsigned char* vnT = lds + 5 * 64 * TS;
    LAS float* GC = (LAS float*)(lds + 6 * 64 * TS);
    const int mt = wave >> 1, nt0 = (wave & 1) * 2;
    float gq; bf16_t upre[2][4]; u32x4 qv, kv, wv, sv;
#define GDN2_LOAD(uu) do { const int tb_ = (uu) >> 3, h_ = ((uu) >> 1) & 3, d_ = (uu) & 1; \
        const bf16_t* dq_ = WSP(bf16_t, SC_DQ) + (size_t)(64 * tb_) * 768; const float* dg_ = WSP(float, SC_DG) + (size_t)(64 * tb_) * 16; \
        const bf16_t* wu_ = WSP(bf16_t, SC_DR_WU) + (size_t)(uu) * 8192; const bf16_t* st_ = WSP(bf16_t, SC_DR_NS) + (size_t)(uu) * 4096; \
        gq = dg_[(d_ ? 63 - lane : lane) * 16 + 8 + d_ * 4 + h_]; \
        _Pragma("unroll") for (int t = 0; t < 2; ++t) { _Pragma("unroll") for (int j = 0; j < 4; ++j) upre[t][j] = wu_[(16 * mt + 4 * fq + j) * 128 + 64 + 16 * (nt0 + t) + fr]; } \
        { const int r_ = tid >> 3, c0_ = (tid & 7) * 8, i_ = d_ ? 63 - r_ : r_; \
          qv = *(const u32x4*)(dq_ + (size_t)i_ * 768 + 64 * h_ + c0_); kv = *(const u32x4*)(dq_ + (size_t)i_ * 768 + 256 + 64 * h_ + c0_); \
          wv = *(const u32x4*)(wu_ + r_ * 128 + c0_); sv = *(const u32x4*)(st_ + r_ * 64 + c0_); } } while (0)
    int u = (p.bid + p.G - (192 % p.G)) % p.G;
    if (u < NUNIT) GDN2_LOAD(u);
    for (; u < NUNIT; u += p.G) { const int tb = u >> 3, h = (u >> 1) & 3, d = u & 1, s0 = 64 * tb;
        if (wave == 0) { float pre = gq;
#pragma unroll
            for (int o = 1; o < 64; o <<= 1) { const float t = shup_(pre, lane, o); if (lane >= o) pre += t; }
            GC[lane] = pre; }
        bf16_t ucur[2][4];
#pragma unroll
        for (int t = 0; t < 2; ++t)
#pragma unroll
            for (int j = 0; j < 4; ++j) ucur[t][j] = upre[t][j];
        { const int r = tid >> 3, c0 = (tid & 7) * 8;
          *(LAS u32x4*)(qh + r * TS + c0 * 2) = qv; *(LAS u32x4*)(kh + r * TS + c0 * 2) = kv; *(LAS u32x4*)(wt + r * TS + c0 * 2) = wv; *(LAS u32x4*)(sT + r * TS + c0 * 2) = sv; }
        if (u + p.G < NUNIT) GDN2_LOAD(u + p.G);
        __syncthreads();
        { f32x4 acc[2] = {(f32x4){0.f, 0.f, 0.f, 0.f}, (f32x4){0.f, 0.f, 0.f, 0.f}};
          mm_rows<64, 2>(qh, TS, kh, TS, mt, nt0, fr, fq, acc);
#pragma unroll
          for (int t = 0; t < 2; ++t)
#pragma unroll
              for (int j = 0; j < 4; ++j) { const int r = 16 * mt + 4 * fq + j, jj = 16 * (nt0 + t) + fr; *(LAS bf16_t*)(aq + r * TS + jj * 2) = (bf16_t)f2bf(jj <= r ? acc[t][j] * __expf(GC[r] - GC[jj]) : 0.f); }
          f32x4 av[2] = {(f32x4){0.f, 0.f, 0.f, 0.f}, (f32x4){0.f, 0.f, 0.f, 0.f}};
          mm_rows<64, 2>(wt, TS, sT, TS, mt, nt0, fr, fq, av);
#pragma unroll
          for (int t = 0; t < 2; ++t) { const int dv = 16 * (nt0 + t) + fr; float vn[4];
#pragma unroll
              for (int j = 0; j < 4; ++j) vn[j] = bf2f(ucur[t][j]) - av[t][j];
              *(LAS u32x2*)(vnT + dv * TS + (16 * mt + 4 * fq) * 2) = (u32x2){pk2(vn[0], vn[1]), pk2(vn[2], vn[3])}; } }
        __syncthreads();
        { f32x4 acc[2] = {(f32x4){0.f, 0.f, 0.f, 0.f}, (f32x4){0.f, 0.f, 0.f, 0.f}};
          mm_rows<64, 2>(qh, TS, sT, TS, mt, nt0, fr, fq, acc);
#pragma unroll
          for (int j = 0; j < 4; ++j) { const float sc = __expf(GC[16 * mt + 4 * fq + j]); acc[0][j] *= sc; acc[1][j] *= sc; }
          mm_rows<64, 2>(aq, TS, vnT, TS, mt, nt0, fr, fq, acc);
          bf16_t* ob = WSP(bf16_t, d ? SC_OB : SC_OF);
#pragma unroll
          for (int t = 0; t < 2; ++t)
#pragma unroll
              for (int j = 0; j < 4; ++j) { const int r = 16 * mt + 4 * fq + j, i = d ? 63 - r : r; ob[(size_t)(s0 + i) * 1024 + 768 + 64 * h + 16 * (nt0 + t) + fr] = (bf16_t)f2bf(acc[t][j]); } }
        __syncthreads();
    }
}
#undef GDN2_LOAD
constexpr int LPS = 65;
#define RW_LP(LP, GS, lw8) do { const int lane_ = lane_id_asm(), c_ = lane_, tg_ = wave; float loc_[8]; float run_ = 0.f; \
        _Pragma("unroll") for (int ii = 0; ii < 8; ++ii) { run_ += (lw8)[ii]; loc_[ii] = run_; } \
        (GS)[tg_ * 64 + c_] = run_; __syncthreads(); float off_ = 0.f; \
        _Pragma("unroll") for (int g2 = 0; g2 < 8; ++g2) if (g2 < tg_) off_ += (GS)[g2 * 64 + c_]; \
        _Pragma("unroll") for (int ii = 0; ii < 8; ++ii) (LP)[(8 * tg_ + ii) * LPS + c_] = loc_[ii] + off_; __syncthreads(); } while (0)
struct RwRhs { const LAS unsigned char* zt; const LAS unsigned char* RU;
    __device__ __forceinline__ float operator()(int r, int col) const { return col < 64 ? bf2f(*(const LAS bf16_t*)(zt + r * TS + col * 2)) : bf2f(*(const LAS bf16_t*)(RU + (col - 64) * TS + r * 2)); } };
__device__ __forceinline__ void rw_p1(const Cx& p, LAS unsigned char* lds, int layer, int b) {
    const int wave = __builtin_amdgcn_readfirstlane(p.tid >> 6), mt = wave >> 1, nt0 = (wave & 1) * 2;
#define RW_LANES const int lane = lane_id_asm(), tid = wave * 64 + lane, fr = lane & 15, fq = lane >> 4; (void)tid; (void)fr; (void)fq
    LAS float* LP = (LAS float*)lds; LAS float* GS = (LAS float*)(lds + 16640);
    LAS unsigned char* zt = lds + 18688; LAS unsigned char* bt = lds + 27904; LAS unsigned char* kt = lds + 37120; LAS unsigned char* vT = lds + 46336; LAS unsigned char* Azk = lds + 55552;
    LAS float* Af = (LAS float*)(lds + 64768); LAS unsigned char* XT = lds + 82176; LAS unsigned char* Abf = lds + 100608; LAS unsigned char* RU = lds + 109824; LAS float* Dbuf = (LAS float*)(lds + 119040); LAS unsigned char* bhT = lds + 129280;
    const bf16_t* proj = WSP(bf16_t, WS_PROJ);
    float lw8[8]; f32x4 lwv[2], kkv[2], bv[2], kv[2]; bf16_t v8[8];
#define RW1_LOAD(uu) do { const int tb_ = (uu) >> 3, h_ = ((uu) >> 1) & 3, d_ = (uu) & 1, s0_ = 64 * tb_; const int lane_ = lane_id_asm(), tid_ = wave * 64 + lane_; \
        const float* lwp_ = WSP(float, SC_RLW) + (size_t)d_ * SB * 256 + (size_t)s0_ * 256 + 64 * h_; const size_t fo_ = (size_t)s0_ * 256 + 64 * h_; \
        _Pragma("unroll") for (int ii = 0; ii < 8; ++ii) { const int r_ = 8 * wave + ii; lw8[ii] = lwp_[(size_t)(d_ ? 63 - r_ : r_) * 256 + lane_]; } \
        { const int r_ = tid_ >> 3, c0_ = (tid_ & 7) * 8, i_ = d_ ? 63 - r_ : r_; \
          _Pragma("unroll") for (int q = 0; q < 2; ++q) { lwv[q] = *(const f32x4*)(lwp_ + (size_t)i_ * 256 + c0_ + 4 * q); kkv[q] = *(const f32x4*)(WSP(float, SC_RKK) + fo_ + (size_t)i_ * 256 + c0_ + 4 * q); \
              bv[q] = *(const f32x4*)(WSP(float, SC_RB) + fo_ + (size_t)i_ * 256 + c0_ + 4 * q); kv[q] = *(const f32x4*)(WSP(float, SC_RK) + fo_ + (size_t)i_ * 256 + c0_ + 4 * q); } } \
        { const bf16_t* pr0_ = proj + (size_t)tb_row0(b, tb_) * NPROJ; \
          _Pragma("unroll") for (int q = 0; q < 8; ++q) { const int e = tid_ + NTHR * q, r2 = e >> 6, cc = e & 63; v8[q] = pr0_[(size_t)(d_ ? 63 - r2 : r2) * NPROJ + PB_V + 64 * h_ + cc]; } } } while (0)
    int u = (p.bid + p.G - (96 % p.G)) % p.G; if (u >= NUNIT) return;
    RW1_LOAD(u);
    for (;;) { const int d = u & 1;
        RW_LP(LP, GS, lw8);
        { RW_LANES; const int r = tid >> 3, c0 = (tid & 7) * 8; unsigned wz[4], wb[4], wk[4];
#pragma unroll
          for (int q = 0; q < 8; q += 2) { float z2[2], b2[2], k2[2];
#pragma unroll
              for (int e = 0; e < 2; ++e) { const int cq = q + e, c = c0 + cq; const float lp = LP[r * LPS + c], lw = lwv[cq >> 2][cq & 3], em = __expf(-lp);
                  z2[e] = -kkv[cq >> 2][cq & 3] * __expf(lp - lw); b2[e] = bv[cq >> 2][cq & 3] * em; k2[e] = kv[cq >> 2][cq & 3] * em; }
              wz[q >> 1] = pk2(z2[0], z2[1]); wb[q >> 1] = pk2(b2[0], b2[1]); wk[q >> 1] = pk2(k2[0], k2[1]); }
          *(LAS u32x4*)(zt + r * TS + c0 * 2) = (u32x4){wz[0], wz[1], wz[2], wz[3]}; *(LAS u32x4*)(bt + r * TS + c0 * 2) = (u32x4){wb[0], wb[1], wb[2], wb[3]}; *(LAS u32x4*)(kt + r * TS + c0 * 2) = (u32x4){wk[0], wk[1], wk[2], wk[3]};
          *(LAS u32x4*)(XT + (2 * r) * TS + c0 * 2) = (u32x4){0u, 0u, 0u, 0u}; *(LAS u32x4*)(XT + (2 * r + 1) * TS + c0 * 2) = (u32x4){0u, 0u, 0u, 0u};
#pragma unroll 2
          for (int q = 0; q < 8; ++q) { const int e = tid + NTHR * q, r2 = e >> 6, cc = e & 63; *(LAS bf16_t*)(vT + cc * TS + r2 * 2) = v8[q]; } }
        __syncthreads();
        const int un = u + p.G; const bool more = un < NUNIT;
        if (more) RW1_LOAD(un);
        { RW_LANES; f32x4 a1[2] = {(f32x4){0.f, 0.f, 0.f, 0.f}, (f32x4){0.f, 0.f, 0.f, 0.f}}, a2[2] = {(f32x4){0.f, 0.f, 0.f, 0.f}, (f32x4){0.f, 0.f, 0.f, 0.f}};
          mm_rows<64, 2>(zt, TS, bt, TS, mt, nt0, fr, fq, a1);
          mm_rows<64, 2>(zt, TS, kt, TS, mt, nt0, fr, fq, a2);
#pragma unroll
          for (int t = 0; t < 2; ++t)
#pragma unroll
              for (int j = 0; j < 4; ++j) { const int r = 16 * mt + 4 * fq + j, jj = 16 * (nt0 + t) + fr; const float a = jj < r ? a1[t][j] : 0.f;
                  Af[jj * AFS + r] = a; *(LAS bf16_t*)(Abf + r * TS + jj * 2) = (bf16_t)f2bf(a); *(LAS bf16_t*)(Azk + r * TS + jj * 2) = (bf16_t)f2bf(jj < r ? a2[t][j] : 0.f); } }
        __syncthreads();
        { RW_LANES; f32x4 a[2] = {(f32x4){0.f, 0.f, 0.f, 0.f}, (f32x4){0.f, 0.f, 0.f, 0.f}};
          mm_rows<64, 2>(Azk, TS, vT, TS, mt, nt0, fr, fq, a);
#pragma unroll
          for (int t = 0; t < 2; ++t) *(LAS u32x2*)(RU + (16 * (nt0 + t) + fr) * TS + (16 * mt + 4 * fq) * 2) = (u32x2){pk2(a[t][0], a[t][1]), pk2(a[t][2], a[t][3])};
        }
        __syncthreads();
        { RW_LANES;
#pragma unroll 2
          for (int q = 0; q < 8; ++q) { const int e = tid + NTHR * q, r2 = e >> 6, cc = e & 63; const float el = __expf(LP[63 * LPS + cc]);
              *(LAS bf16_t*)(bhT + cc * TS + r2 * 2) = (bf16_t)f2bf(bf2f(*(const LAS bf16_t*)(bt + r2 * TS + cc * 2)) * el); *(LAS bf16_t*)(Azk + cc * TS + r2 * 2) = (bf16_t)f2bf(bf2f(*(const LAS bf16_t*)(kt + r2 * TS + cc * 2)) * el); } }
        __syncthreads();
        { const RwRhs rhs{zt, RU}; dr_block_solve(Abf, Af, XT, Dbuf, -1.0f, wave, rhs, WSP(bf16_t, SC_RW_WU) + (size_t)u * 8192); }
        { RW_LANES; f32x4 am[2] = {(f32x4){0.f, 0.f, 0.f, 0.f}, (f32x4){0.f, 0.f, 0.f, 0.f}}, an[2] = {(f32x4){0.f, 0.f, 0.f, 0.f}, (f32x4){0.f, 0.f, 0.f, 0.f}};
          mm_rows<64, 2>(bhT, TS, XT, TS, mt, nt0, fr, fq, am);
          mm_rows<64, 2>(bhT, TS, XT + 64 * TS, TS, mt, nt0, fr, fq, an);
          mm_rows<64, 2>(Azk, TS, vT, TS, mt, nt0, fr, fq, an);
          bf16_t* Mg = WSP(bf16_t, SC_RW_M) + (size_t)u * 4096; bf16_t* Ng = WSP(bf16_t, SC_RW_NS) + (size_t)u * 4096;
#pragma unroll
          for (int t = 0; t < 2; ++t) {
#pragma unroll
              for (int j = 0; j < 4; ++j) { const int row = 16 * mt + 4 * fq + j, col = 16 * (nt0 + t) + fr; Mg[dr_mfrag_idx(row, col)] = (bf16_t)f2bf((row == col ? __expf(LP[63 * LPS + row]) : 0.f) + am[t][j]); }
              *(u32x2*)(Ng + (((nt0 + t) * 4 + mt) * 64 + lane) * 4) = (u32x2){pk2(an[t][0], an[t][1]), pk2(an[t][2], an[t][3])}; } }
        __syncthreads();
        if (!more) break;
        u = un;
    }
#undef RW1_LOAD
}
__device__ __forceinline__ void rw_p2(const Cx& p, LAS unsigned char* lds, int layer, int b) {
    const int wave = __builtin_amdgcn_readfirstlane(p.tid >> 6), mt = wave >> 1, nt0 = (wave & 1) * 2;
    LAS float* LP = (LAS float*)lds; LAS float* GS = (LAS float*)(lds + 16640);
    LAS unsigned char* rt = lds + 18688; LAS unsigned char* bt = lds + 27904; LAS unsigned char* kt = lds + 37120; LAS unsigned char* vT = lds + 46336; LAS unsigned char* sT = lds + 55552; LAS unsigned char* wt = lds + 64768;
    LAS unsigned char* Arb = lds + 73984; LAS unsigned char* Ark = lds + 83200; LAS unsigned char* UT = lds + 92416;
    const bf16_t* proj = WSP(bf16_t, WS_PROJ);
    bf16_t upre[2][4]; float lw8[8]; u32x4 rv, wv, sv, vq; f32x4 bv[2], kv[2];
#define RW2_LOAD(uu) do { const int tb_ = (uu) >> 3, h_ = ((uu) >> 1) & 3, d_ = (uu) & 1, s0_ = 64 * tb_; const int lane_ = lane_id_asm(), tid_ = wave * 64 + lane_, fr_ = lane_ & 15, fq_ = lane_ >> 4; \
        const float* lwp_ = WSP(float, SC_RLW) + (size_t)d_ * SB * 256 + (size_t)s0_ * 256 + 64 * h_; const float* rk_ = WSP(float, SC_RK) + (size_t)s0_ * 256 + 64 * h_; const float* rb_ = WSP(float, SC_RB) + (size_t)s0_ * 256 + 64 * h_; \
        const bf16_t* pr_ = proj + (size_t)tb_row0(b, tb_) * NPROJ; const bf16_t* wu_ = WSP(bf16_t, SC_RW_WU) + (size_t)(uu) * 8192; const bf16_t* st_ = WSP(bf16_t, SC_RW_NS) + (size_t)(uu) * 4096; \
        _Pragma("unroll") for (int t = 0; t < 2; ++t) { _Pragma("unroll") for (int j = 0; j < 4; ++j) upre[t][j] = wu_[(16 * mt + 4 * fq_ + j) * 128 + 64 + 16 * (nt0 + t) + fr_]; } \
        _Pragma("unroll") for (int ii = 0; ii < 8; ++ii) { const int r_ = 8 * wave + ii; lw8[ii] = lwp_[(size_t)(d_ ? 63 - r_ : r_) * 256 + lane_]; } \
        { const int r_ = tid_ >> 3, c0_ = (tid_ & 7) * 8, i_ = d_ ? 63 - r_ : r_; rv = *(const u32x4*)(pr_ + (size_t)i_ * NPROJ + PB_R + 64 * h_ + c0_); \
          _Pragma("unroll") for (int q = 0; q < 2; ++q) { bv[q] = *(const f32x4*)(rb_ + (size_t)i_ * 256 + c0_ + 4 * q); kv[q] = *(const f32x4*)(rk_ + (size_t)i_ * 256 + c0_ + 4 * q); } \
          wv = *(const u32x4*)(wu_ + r_ * 128 + c0_); sv = *(const u32x4*)(st_ + r_ * 64 + c0_); } \
        vq = *(const u32x4*)(pr_ + (size_t)(d_ ? 63 - lane_ : lane_) * NPROJ + PB_V + 64 * h_ + 8 * wave); } while (0)
    int u = (p.bid + p.G - (224 % p.G)) % p.G;
    if (u < NUNIT) RW2_LOAD(u);
    for (; u < NUNIT; u += p.G) { const int tb = u >> 3, h = (u >> 1) & 3, d = u & 1, s0 = 64 * tb;
        bf16_t ucur[2][4];
#pragma unroll
        for (int t = 0; t < 2; ++t)
#pragma unroll
            for (int j = 0; j < 4; ++j) ucur[t][j] = upre[t][j];
        RW_LP(LP, GS, lw8);
        { RW_LANES; const int r = tid >> 3, c0 = (tid & 7) * 8; unsigned wr[4], wb[4], wk[4];
#pragma unroll
          for (int q = 0; q < 8; q += 2) { float r2[2], b2[2], k2[2];
#pragma unroll
              for (int e = 0; e < 2; ++e) { const int cq = q + e, c = c0 + cq; const float lp = LP[r * LPS + c], em = __expf(-lp); const unsigned w = rv[q >> 1];
                  r2[e] = (e ? __uint_as_float(w & 0xffff0000u) : __uint_as_float(w << 16)) * __expf(lp); b2[e] = bv[cq >> 2][cq & 3] * em; k2[e] = kv[cq >> 2][cq & 3] * em; }
              wr[q >> 1] = pk2(r2[0], r2[1]); wb[q >> 1] = pk2(b2[0], b2[1]); wk[q >> 1] = pk2(k2[0], k2[1]); }
          *(LAS u32x4*)(rt + r * TS + c0 * 2) = (u32x4){wr[0], wr[1], wr[2], wr[3]}; *(LAS u32x4*)(bt + r * TS + c0 * 2) = (u32x4){wb[0], wb[1], wb[2], wb[3]}; *(LAS u32x4*)(kt + r * TS + c0 * 2) = (u32x4){wk[0], wk[1], wk[2], wk[3]};
          *(LAS u32x4*)(wt + r * TS + c0 * 2) = wv; *(LAS u32x4*)(sT + r * TS + c0 * 2) = sv;
#pragma unroll
          for (int k = 0; k < 8; ++k) *(LAS bf16_t*)(vT + (8 * wave + k) * TS + lane * 2) = (bf16_t)(vq[k >> 1] >> (16 * (k & 1))); }
        if (u + p.G < NUNIT) RW2_LOAD(u + p.G);
        __syncthreads();
        { RW_LANES; f32x4 a1[2] = {(f32x4){0.f, 0.f, 0.f, 0.f}, (f32x4){0.f, 0.f, 0.f, 0.f}}, a2[2] = {(f32x4){0.f, 0.f, 0.f, 0.f}, (f32x4){0.f, 0.f, 0.f, 0.f}}, a3[2] = {(f32x4){0.f, 0.f, 0.f, 0.f}, (f32x4){0.f, 0.f, 0.f, 0.f}};
          mm_rows<64, 2>(rt, TS, bt, TS, mt, nt0, fr, fq, a1); mm_rows<64, 2>(rt, TS, kt, TS, mt, nt0, fr, fq, a2); mm_rows<64, 2>(wt, TS, sT, TS, mt, nt0, fr, fq, a3);
#pragma unroll
          for (int t = 0; t < 2; ++t) { const int dv = 16 * (nt0 + t) + fr; float uu[4];
#pragma unroll
              for (int j = 0; j < 4; ++j) { const int r = 16 * mt + 4 * fq + j, jj = dv; const bool keep = jj <= r;
                  *(LAS bf16_t*)(Arb + r * TS + jj * 2) = (bf16_t)f2bf(keep ? a1[t][j] : 0.f); *(LAS bf16_t*)(Ark + r * TS + jj * 2) = (bf16_t)f2bf(keep ? a2[t][j] : 0.f);
                  uu[j] = bf2f(ucur[t][j]) + a3[t][j]; }
              *(LAS u32x2*)(UT + dv * TS + (16 * mt + 4 * fq) * 2) = (u32x2){pk2(uu[0], uu[1]), pk2(uu[2], uu[3])}; } }
        __syncthreads();
        { RW_LANES; f32x4 acc[2] = {(f32x4){0.f, 0.f, 0.f, 0.f}, (f32x4){0.f, 0.f, 0.f, 0.f}};
          mm_rows<64, 2>(rt, TS, sT, TS, mt, nt0, fr, fq, acc); mm_rows<64, 2>(Arb, TS, UT, TS, mt, nt0, fr, fq, acc); mm_rows<64, 2>(Ark, TS, vT, TS, mt, nt0, fr, fq, acc);
          bf16_t* ob = WSP(bf16_t, d ? SC_OB : SC_OF);
#pragma unroll
          for (int t = 0; t < 2; ++t)
#pragma unroll
              for (int j = 0; j < 4; ++j) { const int r = 16 * mt + 4 * fq + j, i = d ? 63 - r : r; ob[(size_t)(s0 + i) * 1024 + 256 + 64 * h + 16 * (nt0 + t) + fr] = (bf16_t)f2bf(acc[t][j]); } }
        __syncthreads();
    }
#undef RW_LANES
#undef RW2_LOAD
}
__device__ __forceinline__ void phase_scan(const Cx& p, LAS unsigned char* lds, int layer, int b) {
    for (int w = p.bid; w < 160; w += p.G) {
        if (w < 64) ssd_chain(p, (w >> 4) & 3, (w >> 3) & 1, w & 7);
        else if (w < 96) gla_chain(p, ((w - 64) >> 3) & 3, ((w - 64) >> 2) & 1, (w - 64) & 3);
        else { const int i = w - 96, h = (i >> 3) & 3, d = (i >> 2) & 1, cb = i & 3;
            if (i < 32) dr_chain(p, SC_RW_M, SC_RW_NS, h, d, cb); else dr_chain(p, SC_DR_M, SC_DR_NS, h, d, cb); } }
}
#ifndef MK_ONE_LAUNCH
#define MK_ONE_LAUNCH 1
#endif
constexpr int PH_PER_LAYER = 2 + 5 * NB + 7;
constexpr int N_PHASES = 1 + NL * PH_PER_LAYER + 1;

__global__ void __launch_bounds__(NTHR, 2) mega_fwd(Params pp) {
    extern __shared__ __attribute__((aligned(16))) unsigned char lds_raw[];
    LAS unsigned char* lds = (LAS unsigned char*)lds_raw;
    const int swave = __builtin_amdgcn_readfirstlane(threadIdx.x >> 6);
    for (int i = threadIdx.x; i < (LDS_BYTES - LDS_CTL) / 4; i += NTHR) ((LAS unsigned*)(lds + LDS_CTL))[i] = 0u;
    __syncthreads();
    if (threadIdx.x < N_IN + 2) { const unsigned long long a = threadIdx.x < N_IN ? (unsigned long long)pp.in[threadIdx.x] : (threadIdx.x == N_IN ? (unsigned long long)pp.out : (unsigned long long)pp.ws); ((LAS unsigned*)(lds + LDS_PTRS))[2 * threadIdx.x] = (unsigned)a; ((LAS unsigned*)(lds + LDS_PTRS))[2 * threadIdx.x + 1] = (unsigned)(a >> 32); }
    __syncthreads();
    XcdBarrier bar = xcd_barrier_post((unsigned*)(pp.ws + WS_CTL) + CW_BAR + pp.li * XCD_BAR_WORDS, (volatile LAS unsigned*)(lds + LDS_CTL), threadIdx.x);
    LAS int* tb = (LAS int*)(lds + LDS_CTL + 64);
    int pc = 0; const int lo = pp.lo, hi = pp.hi;
#define PH_BEGIN if (pc >= lo && pc < hi) { Cx p; p.out = (float*)PIN(N_IN); p.ws = (unsigned char*)PIN(N_IN + 1); p.tid = swave * 64 + lane_id_asm(); p.bid = blockIdx.x; p.G = gridDim.x; p.pad = 0; asm volatile("" : "+s"(p.out), "+s"(p.ws), "+v"(p.tid), "+s"(p.bid), "+s"(p.G)); const int G = p.G, bid = p.bid; (void)G; (void)bid;
#define PH_END if (pc + 1 < hi) { XcdBarrier b2 = bar; asm volatile("" : "+s"(b2.bar), "+s"(b2.x)); xcd_barrier(b2, (unsigned)(swave * 64 + lane_id_asm())); } } ++pc;

    PH_BEGIN
        for (int u = bid; u < CONV_A_UNITS; u += G) conv_unit_A(p, (LAS float*)lds, u);
        __syncthreads();
        phase_mod(p, lds);
    PH_END

#pragma unroll
    for (int layer = 0; layer < NL; ++layer) {
        const int row_lo = layer == NL - 1 ? CROWS : 0;
        PH_BEGIN phase_norm1(p, layer); PH_END
        PH_BEGIN
            DenseSched S; S.init(ROWS, NPROJ, D, WSP(bf16_t, WS_WIN) + (size_t)layer * NPROJ * D, G, bid);
            EpiProj E{WSP(bf16_t, WS_PROJ), NPROJ};
            pg8::gemm_phase<D>(p.tid, lds, (const char*)WSP(bf16_t, WS_HBUF), S, E);
        PH_END
#pragma unroll 1
        for (int b = 0; b < NB; ++b) {
            PH_BEGIN phase_prep(p, lds, layer, b); PH_END
            PH_BEGIN gla_p1(p, lds, layer, b); __syncthreads(); ssd_p1(p, lds, layer, b); __syncthreads(); gdn_p1(p, lds, layer, b); __syncthreads(); rw_p1(p, lds, layer, b); PH_END
            PH_BEGIN phase_scan(p, lds, layer, b); PH_END
            PH_BEGIN gla_p2(p, lds, layer, b); __syncthreads(); ssd_p2(p, lds, layer, b); __syncthreads(); gdn_p2(p, lds, layer, b); __syncthreads(); rw_p2(p, lds, layer, b); PH_END
            PH_BEGIN phase_post(p, lds, layer, b); PH_END
        }
        PH_BEGIN
            DenseSched S; S.init(ROWS, D, D, WSP(bf16_t, WS_WOUT) + (size_t)layer * D * D, G, bid);
            EpiRes E{layer == 0 ? PIN(I_X) : (const float*)p.out, layer == 0 ? PIN(I_CTX) : (const float*)WSP(float, WS_CTXRES), p.out, WSP(float, WS_CTXRES), WSP(float, WS_MOD) + (size_t)layer * 5 * 6144 + 2048};
            pg8::gemm_phase<D>(p.tid, lds, (const char*)WSP(bf16_t, WS_HBUF), S, E);
        PH_END
        PH_BEGIN phase_norm2(p, lds, layer, row_lo);
            __syncthreads();
            conv_experts(p, (LAS float*)lds, layer);
        PH_END
        PH_BEGIN
            moe_table(p, tb, layer, row_lo);
            MoeSched<true> S{tb + 128, tb, 2, G, bid, D, row_lo, WSP(int, WS_LTOK), (const char*)WSP(bf16_t, WS_EXPGU), (size_t)512 * D * 2};
            EpiGU E{WSP(bf16_t, WS_H)};
            pg8::gemm_phase<D>(p.tid, lds, (const char*)WSP(bf16_t, WS_HBUF), S, E);
        PH_END
#pragma unroll
        for (int half = 0; half < 2; ++half) {
            PH_BEGIN
                moe_table(p, tb, layer, row_lo);
                MoeSched<false> S{tb + 128, tb, 2, G, bid, EH, row_lo, WSP(int, WS_LTOK), (const char*)(WSP(bf16_t, WS_EXPD) + (size_t)half * 512 * EH), (size_t)D * EH * 2};
                EpiY E{WSP(bf16_t, WS_Y)};
                pg8::gemm_phase<EH>(p.tid, lds, (const char*)WSP(bf16_t, WS_H), S, E);
            PH_END
            PH_BEGIN
                moe_table(p, tb, layer, row_lo);
                phase_combine(p, tb, layer, row_lo, half);
            PH_END
        }
    }
    PH_BEGIN phase_final(p);
    PH_END
#undef PH_BEGIN
#undef PH_END
}

extern "C" void kernel_launch(void* const* d_in, const int* in_sizes, int n_in, void* d_out, int out_size, void* d_ws, size_t ws_size, hipStream_t stream) {
    static int grid = 0;
    if (grid == 0) {
        if (n_in != N_IN || in_sizes[0] != NB * SEQ * D || out_size != NB * SEQ * D || ws_size < WS_END) {
            fprintf(stderr, "kernel_launch: unexpected shapes (n_in %d, in0 %d, out %d, ws %zu); nothing launched\n", n_in, n_in > 0 ? in_sizes[0] : -1, out_size, ws_size); grid = -1; return; }
        int dev = 0, cus = 0, per_cu = 0;
        if (hipGetDevice(&dev) != hipSuccess || hipDeviceGetAttribute(&cus, hipDeviceAttributeMultiprocessorCount, dev) != hipSuccess) { grid = -1; return; }
        if (hipFuncSetAttribute((const void*)mega_fwd, hipFuncAttributeMaxDynamicSharedMemorySize, LDS_BYTES) != hipSuccess) { fprintf(stderr, "kernel_launch: hipFuncSetAttribute failed\n"); grid = -1; return; }
        if (hipOccupancyMaxActiveBlocksPerMultiprocessor(&per_cu, (const void*)mega_fwd, NTHR, LDS_BYTES) != hipSuccess || per_cu < 1) { fprintf(stderr, "kernel_launch: occupancy query says %d\n", per_cu); per_cu = 1; }
        (void)hipGetLastError();
        grid = cus * 1;
    }
    if (grid < 0) return;
    if (hipMemsetAsync((char*)d_ws + WS_CTL, 0, CTL_ZERO_BYTES, stream) != hipSuccess) return;
    Params p{};
    for (int i = 0; i < N_IN; ++i) p.in[i] = (const float*)d_in[i];
    p.out = (float*)d_out; p.ws = (unsigned char*)d_ws; p.pad = 0;
#if MK_ONE_LAUNCH
    p.lo = 0; p.hi = N_PHASES; p.li = 0;
    hipLaunchKernelGGL(mega_fwd, dim3(grid), dim3(NTHR), LDS_BYTES, stream, p);
#else
    for (int k = 0; k < N_PHASES; ++k) { p.lo = k; p.hi = k + 1; p.li = k;
        hipLaunchKernelGGL(mega_fwd, dim3(grid), dim3(NTHR), LDS_BYTES, stream, p); }
#endif
}
```

```cpp
#include <hip/hip_runtime.h>
#include <cstdio>
#include <cstdint>

typedef unsigned short bf16_t;
typedef short bf16x8 __attribute__((ext_vector_type(8)));
typedef float f32x4 __attribute__((ext_vector_type(4)));
typedef float f32x2 __attribute__((ext_vector_type(2)));
typedef unsigned u32x4 __attribute__((ext_vector_type(4)));
typedef unsigned u32x2 __attribute__((ext_vector_type(2)));

constexpr int NB = 4, SEQ = 8192, NCTX = 256, D = 1024, NL = 2;
constexpr int CROWS = NB * NCTX;
constexpr int ROWS = CROWS + NB * SEQ;
constexpr int SB = NCTX + SEQ;
constexpr int INW = 4056, NPROJ = 4096;
constexpr int NE = 64, NE1 = 65, TOPK = 8, EH = 256;
constexpr int GRIDW = 64, GRIDH = SEQ / GRIDW;
constexpr int PA_Q = 0, PA_K = 256, PA_V = 512, PA_G = 768, PA_GF = 1024, PA_GB = 1040;
constexpr int PB_R = 1056, PB_K = 1312, PB_V = 1568, PB_WF = 1824, PB_WB = 1856, PB_A = 1888, PB_G = 1920;
constexpr int PC_Z = 1984, PC_X = 2240, PC_DF = 3008, PC_DB = 3012;
constexpr int PD_Q = 3016, PD_Z = 3784, PD_BF = 4040, PD_BB = 4044, PD_AF = 4048, PD_AB = 4052;
enum { I_X = 0, I_C, I_CTX, I_CCTX, I_N1G, I_N2G, I_WMOD, I_BMOD, I_WIN, I_WOUT, I_GLA_W2, I_GLA_B, I_GLA_NG,
       I_RW_W2, I_RW_W0, I_RW_AW2, I_RW_A0, I_RW_GW2, I_RW_KK, I_RW_KA, I_RW_RK, I_RW_LNG, I_RW_LNB,
       I_SS_CW, I_SS_CB, I_SS_ALOG, I_SS_DTB, I_SS_D, I_SS_NG, I_DN_CW, I_DN_ALOG, I_DN_DTB, I_DN_NG,
       I_ROUT_W, I_ROUT_B, I_EXP_G, I_EXP_U, I_EXP_D, I_SH_G, I_SH_U, I_SH_D, I_FNG, N_IN };
static_assert(N_IN == 42, "input count");

constexpr size_t MiB = 1u << 20;
constexpr size_t WS_CTL = 0, CTL_ZERO_BYTES = 1 * MiB;
constexpr size_t WS_MOD = 1 * MiB;
constexpr size_t WS_RWGW = WS_MOD + 256 * 1024;
constexpr size_t WS_RWLR = WS_MOD + 384 * 1024;
constexpr size_t WS_WIN = 2 * MiB;
constexpr size_t WS_WOUT = 18 * MiB;
constexpr size_t WS_ROUT = 22 * MiB;
constexpr size_t WS_CTXRES = 23 * MiB;
constexpr size_t WS_EXPGU = 27 * MiB;
constexpr size_t WS_EXPD = 92 * MiB;
constexpr size_t WS_HBUF = 125 * MiB;
constexpr size_t WS_PROJ = 191 * MiB;
constexpr size_t WS_SCR = 455 * MiB;
constexpr size_t WS_END = 640455456;
constexpr int HROWS_MAX = ROWS * 9 + NE1 * 256;
constexpr size_t WS_Y = WS_HBUF;
constexpr size_t WS_H = 443 * MiB;
constexpr size_t WS_LTOK = 600 * MiB;
constexpr size_t WS_TOKT = WS_LTOK + (size_t)NE * ROWS * 4;
static_assert(WS_Y + (size_t)HROWS_MAX * 512 * 2 <= WS_H && WS_H + (size_t)HROWS_MAX * 256 * 2 <= WS_LTOK && WS_TOKT + (size_t)ROWS * 64 <= WS_END, "moe overlay");
constexpr size_t SC_OF = WS_SCR;
constexpr size_t SC_OB = SC_OF + (size_t)SB * 1024 * 2;
constexpr size_t SC_RK = SC_OB + (size_t)SB * 1024 * 2;
constexpr size_t SC_RKK = SC_RK + (size_t)SB * 256 * 4;
constexpr size_t SC_RB = SC_RKK + (size_t)SB * 256 * 4;
constexpr size_t SC_RLW = SC_RB + (size_t)SB * 256 * 4;
constexpr size_t SC_SX = SC_RLW + (size_t)2 * SB * 256 * 4;
constexpr size_t SC_DQ = SC_SX + (size_t)SB * 768 * 2;
constexpr size_t SC_SDT = SC_DQ + (size_t)SB * 768 * 2;
constexpr size_t SC_DG = SC_SDT + (size_t)SB * 8 * 4;
constexpr size_t SC_FEND = SC_DG + (size_t)SB * 16 * 4;
constexpr int NTB = SB / 64, NUNIT = NTB * 4 * 2;
constexpr size_t SC_RW_M = SC_FEND;
constexpr size_t SC_RW_NS = SC_RW_M + (size_t)(SB / 64 * 8) * 4096 * 2;
constexpr size_t SC_RW_WU = SC_RW_NS + (size_t)(SB / 64 * 8) * 4096 * 2;
constexpr size_t SC_END = SC_RW_WU + (size_t)(SB / 64 * 8) * 8192 * 2;
constexpr size_t SC2 = WS_EXPGU;
constexpr size_t SC_GLA_S = SC2;
constexpr size_t SC_GLA_DEC = SC_GLA_S + (size_t)NUNIT * 4096 * 4;
constexpr size_t SC_SSD_S = SC_GLA_DEC + (size_t)NUNIT * 64 * 4;
constexpr size_t SC_SSD_CD = SC_SSD_S + (size_t)NUNIT * 8192 * 4;
constexpr size_t SC_DR_M = SC_SSD_CD + (size_t)NUNIT * 4 + 4096;
constexpr size_t SC_DR_NS = SC_DR_M + (size_t)NUNIT * 4096 * 2;
constexpr size_t SC_DR_WU = SC_DR_NS + (size_t)NUNIT * 4096 * 2;
constexpr size_t SC2_END = SC_DR_WU + (size_t)NUNIT * 8192 * 2;
static_assert(SC2_END <= WS_HBUF, "chunk slots fit in the expert-weight region");
static_assert(SC_END <= WS_END, "scratch fits");
constexpr int CW_CNT = 1024;
constexpr int CW_BAR = 4096;

#define LAS __attribute__((address_space(3)))
constexpr int NTHR = 512;
constexpr int LDS_BYTES = 147456;
constexpr int LDS_CTL = 143360;
constexpr int LDS_PTRS = LDS_CTL + 2048;

__device__ __forceinline__ int lane_id_asm() { int l; asm volatile("v_mbcnt_lo_u32_b32 %0, -1, 0\n\tv_mbcnt_hi_u32_b32 %0, -1, %0" : "=v"(l)); return l; }
__device__ __forceinline__ float bf2f(bf16_t b) { return __uint_as_float(((unsigned)b) << 16); }
__device__ __forceinline__ unsigned f2bf(float f) { unsigned u = __float_as_uint(f); u += 0x7FFFu + ((u >> 16) & 1u); return u >> 16; }
__device__ __forceinline__ unsigned pk2(float lo, float hi) { return f2bf(lo) | (f2bf(hi) << 16); }
__device__ __forceinline__ float rl(float x, int k) { return __uint_as_float(__builtin_amdgcn_readlane(__float_as_uint(x), k)); }
__device__ __forceinline__ float shx_(float v, int lane, int o) { return __uint_as_float(__builtin_amdgcn_ds_bpermute((lane ^ o) << 2, __float_as_uint(v))); }
__device__ __forceinline__ int shxi_(int v, int lane, int o) { return __builtin_amdgcn_ds_bpermute((lane ^ o) << 2, v); }
__device__ __forceinline__ float shup_(float v, int lane, int o) { return __uint_as_float(__builtin_amdgcn_ds_bpermute((lane - o) << 2, __float_as_uint(v))); }
#define DPPF(v, ctrl) __uint_as_float(__builtin_amdgcn_update_dpp(0, __float_as_uint(v), ctrl, 0xf, 0xf, false))
#define DPPI(v, ctrl) __builtin_amdgcn_update_dpp(0, (v), ctrl, 0xf, 0xf, false)
__device__ __forceinline__ float wsum(float v) {
    v += DPPF(v, 0xB1); v += DPPF(v, 0x4E); v += DPPF(v, 0x141); v += DPPF(v, 0x140);
    v += __uint_as_float(__builtin_amdgcn_ds_swizzle(__float_as_uint(v), 0x401F));
    return rl(v, 0) + rl(v, 32);
}
__device__ __forceinline__ float sigmoidf_(float x) { return 1.0f / (1.0f + __expf(-x)); }
__device__ __forceinline__ float siluf_(float x) { return x / (1.0f + __expf(-x)); }
__device__ __forceinline__ float log1pexp_(float t  ) { return t < 1e-4f ? t - 0.5f * t * t : __logf(1.0f + t); }
__device__ __forceinline__ float softplusf_(float x) { return x > 15.f ? x : log1pexp_(__expf(x)); }
__device__ __forceinline__ float logsigmoidf_(float x) { return fminf(x, 0.f) - log1pexp_(__expf(-fabsf(x))); }
__device__ __forceinline__ float tanhf_(float x) { const float e = __expf(2.0f * fminf(fmaxf(x, -15.f), 15.f)); return (e - 1.0f) / (e + 1.0f); }
__device__ __forceinline__ int seq_tok(int i, int d) { return d == 0 ? i : (i < NCTX ? NCTX - 1 - i : SB + NCTX - 1 - i); }
__device__ __forceinline__ int tok_row(int b, int s) { return s < NCTX ? b * NCTX + s : CROWS + b * SEQ + (s - NCTX); }

#define GAS __attribute__((address_space(1)))
struct Params { const float* in[N_IN]; float* out; unsigned char* ws; int lo, hi, li, pad; };
struct Cx { unsigned long long out, ws; int tid, bid, G, pad; };
__device__ __forceinline__ const float* PIN(int i) {
    extern __shared__ __attribute__((aligned(16))) unsigned char lds_raw_[];
    int off = __builtin_amdgcn_readfirstlane(LDS_PTRS + 8 * i); asm volatile("" : "+s"(off));
    const LAS unsigned* t = (const LAS unsigned*)((LAS unsigned char*)lds_raw_ + off);
    const unsigned lo = __builtin_amdgcn_readfirstlane(t[0]), hi = __builtin_amdgcn_readfirstlane(t[1]);
    return (const float*)(const GAS float*)(((unsigned long long)hi << 32) | lo);
}
#define XB_TMO      128
#define XB_XCNT(j)  (256  + 64 * (j))
#define XB_XSUB(j)  (1280 + 64 * (j))
#define XB_XGEN(j)  (2304 + 64 * (j))
#define XB_TOP      3328
#define XB_TOPGEN   3392
#define XCD_BAR_WORDS 3456
#define XB_SPIN_CAP (1u << 18)

__device__ __forceinline__ unsigned xb_ld(unsigned* p)              { return __hip_atomic_load(p, __ATOMIC_RELAXED, __HIP_MEMORY_SCOPE_AGENT); }
__device__ __forceinline__ unsigned xb_add(unsigned* p, unsigned v) { return __hip_atomic_fetch_add(p, v, __ATOMIC_RELAXED, __HIP_MEMORY_SCOPE_AGENT); }
__device__ __forceinline__ unsigned xb_xcc_id() { return (unsigned)__builtin_amdgcn_s_getreg((3 << 11) | 20) & 0xFu; }
#define XB_SPIN(cond, bar) do { unsigned _sp = 0; while (cond) { __builtin_amdgcn_s_sleep(1); \
    if ((++_sp & 255u) == 0u) { if (xb_ld(&(bar)[XB_TMO])) break; if (_sp > XB_SPIN_CAP) { atomicAdd(&(bar)[XB_TMO], 1u); break; } } } } while (0)

struct XcdBarrier {
    unsigned* bar; unsigned x;
    volatile LAS unsigned* st;
};

__device__ __forceinline__ XcdBarrier xcd_barrier_post(unsigned* bar, volatile LAS unsigned* st, const unsigned xb_tid) {
    XcdBarrier b; b.bar = bar; b.x = xb_xcc_id(); b.st = st;
    if (xb_tid == 0) (void)xb_add(&bar[XB_XCNT(b.x)], 1u);
    return b;
}
__device__ __forceinline__ void xcd_barrier_complete(unsigned* bar, unsigned x, unsigned& nloc, unsigned& nx) {
    const unsigned G = gridDim.x * gridDim.y * gridDim.z;
    unsigned sum, cnt, mine, sp = 0u;
    for (;;) {
        sum = 0u; cnt = 0u; mine = 0u;
#pragma unroll
        for (unsigned j = 0; j < 16; ++j) { const unsigned c = xb_ld(&bar[XB_XCNT(j)]); sum += c; cnt += (c > 0u) ? 1u : 0u; mine = (j == x) ? c : mine; }
        if (sum == G) break;
        __builtin_amdgcn_s_sleep(1);
        if ((++sp & 255u) == 0u) { if (xb_ld(&bar[XB_TMO])) break; if (sp > XB_SPIN_CAP) { atomicAdd(&bar[XB_TMO], 1u); break; } }
    }
    nloc = mine > 0u ? mine : 1u; nx = cnt > 0u ? cnt : 1u;
}

__device__ __forceinline__ void xcd_barrier(const XcdBarrier& b, const unsigned xb_tid) {
    asm volatile("s_waitcnt vmcnt(0)" ::: "memory");
    __syncthreads();
    if (xb_tid == 0) {
        unsigned* bar = b.bar;
        __builtin_amdgcn_s_waitcnt(0);
        unsigned nloc = b.st[0], nx = b.st[1];
        if (nloc == 0u) { xcd_barrier_complete(bar, b.x, nloc, nx); b.st[0] = nloc; b.st[1] = nx; }
        const unsigned old = xb_add(&bar[XB_XSUB(b.x)], 1u);
        const unsigned gen = old / nloc;
        if (old + 1u == (gen + 1u) * nloc) {
            __builtin_amdgcn_fence(__ATOMIC_RELEASE, "agent");
            asm volatile("s_waitcnt vmcnt(0)" ::: "memory");
            const unsigned og = xb_add(&bar[XB_TOP], 1u);
            const unsigned tg = og / nx;
            if (og + 1u == (tg + 1u) * nx) xb_add(&bar[XB_TOPGEN], 1u);
            else XB_SPIN(xb_ld(&bar[XB_TOPGEN]) == tg, bar);
            __builtin_amdgcn_fence(__ATOMIC_ACQUIRE, "agent");
            xb_add(&bar[XB_XGEN(b.x)], 1u);
            asm volatile("s_waitcnt vmcnt(0)" ::: "memory");
        } else {
            XB_SPIN(xb_ld(&bar[XB_XGEN(b.x)]) == gen, bar);
            __builtin_amdgcn_fence(__ATOMIC_ACQUIRE, "agent");
            asm volatile("s_waitcnt vmcnt(0)" ::: "memory");
        }
    }
    __syncthreads();
}

namespace pg8 {
constexpr int BM = 256, BK = 64, HALF = 128, HTB = HALF * BK * 2  , STAGE_BYTES = 8 * HTB, NXCD = 8, WGM = 8;
__host__ __device__ __forceinline__ int lds_byte(int r, int c) { const int st = (r >> 4) * 2 + (c >> 5), rr = r & 15, cc = c & 31, ob = rr * 64 + cc * 2; return st * 1024 + (ob ^ (((ob >> 9) & 1) << 5)); }
__host__ __device__ __forceinline__ void stage_rc(int b, int& R, int& C) { const int st = b / 1024, sb = b % 1024, swz = sb ^ (((sb >> 9) & 1) << 5); R = (st >> 1) * 16 + swz / 64; C = (st & 1) * 32 + (swz % 64) / 2; }
__host__ __device__ __forceinline__ int perm32(int rho) { const int n = rho >> 4, i = rho & 15; return 8 * (i >> 2) + 4 * n + (i & 3); }

struct Unit { int pm, pn, e, r0; };

__device__ __forceinline__ unsigned cvt_pk_bf16(float lo, float hi) { unsigned r; asm volatile("v_cvt_pk_bf16_f32 %0, %1, %2" : "=v"(r) : "v"(lo), "v"(hi)); return r; }

template <int K, class Epi, class Sched>
__device__ __forceinline__ void gemm_phase(const int tid, LAS unsigned char* lds, const char* Abase, const Sched& S, const Epi& E) {
    const int wid = __builtin_amdgcn_readfirstlane(tid >> 6), lane = tid & 63, wr = wid >> 2, wc = wid & 3, fr = lane & 15, fq = lane >> 4;
    const int nt = K / BK;
    constexpr bool DN = Sched::DENSE;
    int RA[2], CA[2]; unsigned voffB[2], voffA[2];
#pragma unroll
    for (int i = 0; i < 2; ++i) { int R, C; stage_rc(tid * 16 + i * 8192, R, C); const int Rb = Epi::PERM ? ((R & ~31) + perm32(R & 31)) : R;
        RA[i] = R; CA[i] = C; voffB[i] = (unsigned)(Rb * K + C) * 2u; voffA[i] = (unsigned)(R * K + C) * 2u; }
    const size_t kstep = (size_t)(BK * 2);
    const size_t hstep = (size_t)HALF * K * 2;
    const size_t tstep = 2 * hstep;
    const unsigned ldsw = (unsigned)wid * 1024u;
    const int aoff = lds_byte(wr * 64 + fr, fq * 8), boff = lds_byte(wc * 32 + fr, fq * 8);
#define PG8_SA(b, h) (((b) * 2 + (h)) * HTB)
#define PG8_SB(b, h) ((4 + (b) * 2 + (h)) * HTB)
#define PG8_STAGE(bufoff, gbase, voff) do { _Pragma("unroll") for (int _i = 0; _i < 2; ++_i) \
        __builtin_amdgcn_global_load_lds((const __attribute__((address_space(1))) unsigned*)((const __attribute__((address_space(1))) char*)(gbase) + (voff)[_i]), (LAS unsigned*)(lds + (bufoff) + ldsw + _i * 8192), 16, 0, 0); } while (0)
#define PG8_LDA(dst, b, h) do { _Pragma("unroll") for (int m = 0; m < 4; ++m) _Pragma("unroll") for (int k = 0; k < 2; ++k) dst[m][k] = *(const LAS bf16x8*)(lds + PG8_SA(b, h) + aoff + m * 2048 + k * 1024); } while (0)
#define PG8_LDB(dst, b, h) do { _Pragma("unroll") for (int n = 0; n < 2; ++n) _Pragma("unroll") for (int k = 0; k < 2; ++k) dst[n][k] = *(const LAS bf16x8*)(lds + PG8_SB(b, h) + boff + n * 2048 + k * 1024); } while (0)
#define PG8_MMA(ai, bj, At, Bt) do { __builtin_amdgcn_s_setprio(1); _Pragma("unroll") for (int m = 0; m < 4; ++m) _Pragma("unroll") for (int n = 0; n < 2; ++n) _Pragma("unroll") for (int k = 0; k < 2; ++k) \
        acc[ai][bj][m][n] = __builtin_amdgcn_mfma_f32_16x16x32_bf16(Bt[n][k], At[m][k], acc[ai][bj][m][n], 0, 0, 0); __builtin_amdgcn_s_setprio(0); } while (0)
#define PG8_WAIT_V(n) asm volatile("s_waitcnt vmcnt(" #n ")" ::: "memory")
#define PG8_WAIT_L(n) asm volatile("s_waitcnt lgkmcnt(" #n ")" ::: "memory")
#define PG8_BAR __builtin_amdgcn_s_barrier()
#define PG8_SCHED __builtin_amdgcn_sched_barrier(0)
#define PG8_AOFF(dst, u) do { _Pragma("unroll") for (int _h = 0; _h < 2; ++_h) _Pragma("unroll") for (int _i = 0; _i < 2; ++_i) \
        dst[_h][_i] = ((unsigned)S.a_row(u, _h * HALF + RA[_i]) * (unsigned)K + (unsigned)CA[_i]) * 2u; } while (0)
    Unit cur, nxt; int ui = 0;
    if (!S.next(0, cur)) return;
    f32x4 acc[2][2][4][2];
#pragma unroll
    for (int a = 0; a < 2; ++a)
#pragma unroll
        for (int b = 0; b < 2; ++b)
#pragma unroll
            for (int m = 0; m < 4; ++m)
#pragma unroll
                for (int n = 0; n < 2; ++n) acc[a][b][m][n] = (f32x4){0.f, 0.f, 0.f, 0.f};
    bf16x8 At[4][2], B0[2][2], B1[2][2];
    unsigned cO[2][2], nO[2][2];
    const char* cA = Abase; const char* nA = Abase;
    if constexpr (DN) cA = Abase + (size_t)S.a_row(cur, 0) * K * 2; else PG8_AOFF(cO, cur);
    const char* cB = S.b_ptr(cur);
#define PG8_STA(bufoff, h_, kb_, nx_) do { if constexpr (DN) PG8_STAGE(bufoff, ((nx_) ? nA : cA) + (h_) * hstep + (kb_), voffA); else PG8_STAGE(bufoff, Abase + (kb_), ((nx_) ? nO : cO)[h_]); } while (0)
    PG8_STAGE(PG8_SB(0, 0), cB, voffB); PG8_SCHED; PG8_STA(PG8_SA(0, 0), 0, 0, false); PG8_SCHED; PG8_STAGE(PG8_SB(0, 1), cB + hstep, voffB); PG8_SCHED; PG8_STA(PG8_SA(0, 1), 1, 0, false); PG8_SCHED;
    if (wr == 1) PG8_BAR;
    PG8_WAIT_V(4); PG8_BAR;
    PG8_STAGE(PG8_SB(1, 0), cB + kstep, voffB); PG8_SCHED; PG8_STA(PG8_SA(1, 0), 0, kstep, false); PG8_SCHED; PG8_STAGE(PG8_SB(1, 1), cB + hstep + kstep, voffB); PG8_SCHED;
    PG8_WAIT_V(6); PG8_BAR;
    for (;;) {
        const bool has_next = S.next(ui + 1, nxt);
        const char* nB = cB; nA = cA;
        if (has_next) { if constexpr (DN) nA = Abase + (size_t)S.a_row(nxt, 0) * K * 2; else PG8_AOFF(nO, nxt); nB = S.b_ptr(nxt); }
        else if constexpr (!DN) {
#pragma unroll
            for (int h = 0; h < 2; ++h)
#pragma unroll
                for (int i = 0; i < 2; ++i) nO[h][i] = cO[h][i]; }
        for (int t = 0; t < nt; t += 2) {
            const bool last = (t == nt - 2);
            const size_t k1 = (size_t)(t + 1) * kstep, k2 = last ? 0 : (size_t)(t + 2) * kstep, k3 = k2 + kstep;
            const char* b2 = last ? nB : cB + (size_t)(t + 2) * kstep; const char* b3 = b2 + kstep;
            PG8_LDB(B0, 0, 0); PG8_SCHED; PG8_LDA(At, 0, 0); PG8_STA(PG8_SA(1, 1), 1, k1, false);
            PG8_WAIT_L(8); PG8_BAR; PG8_WAIT_L(0); PG8_MMA(0, 0, At, B0); PG8_BAR; PG8_SCHED;
            PG8_LDB(B1, 0, 1); PG8_STAGE(PG8_SB(0, 0), b2, voffB);
            PG8_BAR; PG8_WAIT_L(0); PG8_MMA(0, 1, At, B1); PG8_BAR;
            PG8_LDA(At, 0, 1); PG8_STA(PG8_SA(0, 0), 0, k2, last);
            PG8_BAR; PG8_WAIT_L(0); PG8_MMA(1, 0, At, B0); PG8_BAR; PG8_SCHED;
            PG8_STAGE(PG8_SB(0, 1), b2 + hstep, voffB);
            PG8_WAIT_V(6); PG8_BAR; PG8_MMA(1, 1, At, B1); PG8_BAR;
            PG8_LDB(B0, 1, 0); PG8_SCHED; PG8_LDA(At, 1, 0); PG8_STA(PG8_SA(0, 1), 1, k2, last);
            PG8_WAIT_L(8); PG8_BAR; PG8_WAIT_L(0); PG8_MMA(0, 0, At, B0); PG8_BAR; PG8_SCHED;
            PG8_LDB(B1, 1, 1); PG8_STAGE(PG8_SB(1, 0), b3, voffB);
            PG8_BAR; PG8_WAIT_L(0); PG8_MMA(0, 1, At, B1); PG8_BAR;
            PG8_LDA(At, 1, 1); PG8_STA(PG8_SA(1, 0), 0, k3, last);
            PG8_BAR; PG8_WAIT_L(0); PG8_MMA(1, 0, At, B0); PG8_BAR; PG8_SCHED;
            PG8_STAGE(PG8_SB(1, 1), b3 + hstep, voffB);
            PG8_WAIT_V(6); PG8_BAR; PG8_MMA(1, 1, At, B1); PG8_BAR;
        }
        E(acc, cur, wid);
        if (!has_next) break;
#pragma unroll
        for (int a = 0; a < 2; ++a)
#pragma unroll
            for (int b = 0; b < 2; ++b)
#pragma unroll
                for (int m = 0; m < 4; ++m)
#pragma unroll
                    for (int n = 0; n < 2; ++n) acc[a][b][m][n] = (f32x4){0.f, 0.f, 0.f, 0.f};
        cur = nxt; cB = nB; cA = nA; ++ui;
        if constexpr (!DN) {
#pragma unroll
        for (int h = 0; h < 2; ++h)
#pragma unroll
            for (int i = 0; i < 2; ++i) cO[h][i] = nO[h][i]; }
    }
    PG8_WAIT_V(0);
    if (wr == 0) PG8_BAR;
    PG8_BAR;
#undef PG8_SA
#undef PG8_SB
#undef PG8_STAGE
#undef PG8_LDA
#undef PG8_LDB
#undef PG8_MMA
#undef PG8_WAIT_V
#undef PG8_WAIT_L
#undef PG8_BAR
#undef PG8_SCHED
#undef PG8_AOFF
#undef PG8_STA
}
}
struct DenseSched {
    static constexpr bool DENSE = true;
    int nM, nN, nwg, G, c, K; const char* Bt;
    __device__ __forceinline__ void init(int M, int N, int K_, const bf16_t* Bt_, int G_, int c_) { nM = M / 256; nN = N / 256; nwg = nM * nN; G = G_; c = c_; K = K_; Bt = (const char*)Bt_; }
    __device__ __forceinline__ bool next(int i, pg8::Unit& u) const {
        const long L = (long)i * G + c; if (L >= nwg) return false;
        int wgid = (int)L; { const int q = nwg / 8, r = nwg % 8, xcd = wgid % 8, off = wgid / 8; wgid = (xcd < r ? xcd * (q + 1) : r * (q + 1) + (xcd - r) * q) + off; }
        const int nig = 8 * nN, gid = wgid / nig, fm = gid * 8, gsz = (nM - fm) < 8 ? (nM - fm) : 8;
        u.pm = fm + ((wgid % nig) % gsz); u.pn = (wgid % nig) / gsz; u.e = 0; u.r0 = 0; return true;
    }
    __device__ __forceinline__ int a_row(const pg8::Unit& u, int r) const { return u.pm * 256 + r; }
    __device__ __forceinline__ const char* b_ptr(const pg8::Unit& u) const { return Bt + (size_t)u.pn * 256 * K * 2; }
};
template <bool GATHER> struct MoeSched {
    static constexpr bool DENSE = !GATHER;
    const LAS int* tstart; const LAS int* cnt; int nN, G, c, K, row_lo; const int* ltok; const char* Bt; size_t bstride;
    __device__ __forceinline__ bool next(int i, pg8::Unit& u) const {
        const long L = (long)i * G + c; const int ntile = __builtin_amdgcn_readfirstlane(tstart[NE1]); if (L >= (long)ntile * nN) return false;
        const int tile = (int)(L / nN); u.pn = (int)(L % nN);
        int e = 0;
#pragma unroll 1
        for (int step = 64; step >= 1; step >>= 1) { const int e2 = e + step; if (e2 <= NE && tstart[e2] <= tile) e = e2; }
        e = __builtin_amdgcn_readfirstlane(e); u.e = e; u.pm = __builtin_amdgcn_readfirstlane(tile); u.pn = __builtin_amdgcn_readfirstlane(u.pn); u.r0 = __builtin_amdgcn_readfirstlane((tile - tstart[e]) * 256); return true;
    }
    __device__ __forceinline__ int a_row(const pg8::Unit& u, int r) const {
        if (!GATHER) return u.pm * 256 + r;
        const int ri = u.r0 + r;
        if (u.e == NE) return ri < cnt[NE] ? row_lo + ri : row_lo;
        return ri < cnt[u.e] ? ltok[(size_t)u.e * ROWS + ri] : row_lo;
    }
    __device__ __forceinline__ const char* b_ptr(const pg8::Unit& u) const { return Bt + (size_t)u.e * bstride + (size_t)u.pn * 256 * K * 2; }
};

struct EpiProj {
    static constexpr bool PERM = true;
    bf16_t* O; int ldc;
    __device__ __forceinline__ void operator()(const f32x4 (&acc)[2][2][4][2], const pg8::Unit& u, const int wid) const {
        const int lane_ = lane_id_asm(), fr = lane_ & 15, fq = lane_ >> 4, wr = wid >> 2, wc = wid & 3;
        const int row0 = u.pm * 256 + wr * 64 + fr, col0 = u.pn * 256 + wc * 32 + 8 * fq;
#pragma unroll
        for (int ai = 0; ai < 2; ++ai)
#pragma unroll
            for (int m = 0; m < 4; ++m) { bf16_t* rowp = O + (size_t)(row0 + ai * 128 + m * 16) * ldc + col0;
#pragma unroll
                for (int bj = 0; bj < 2; ++bj) { const f32x4 v0 = acc[ai][bj][m][0], v1 = acc[ai][bj][m][1];
                    u32x4 w; w.x = pg8::cvt_pk_bf16(v0[0], v0[1]); w.y = pg8::cvt_pk_bf16(v0[2], v0[3]); w.z = pg8::cvt_pk_bf16(v1[0], v1[1]); w.w = pg8::cvt_pk_bf16(v1[2], v1[3]);
                    *(u32x4*)(rowp + bj * 128) = w; } }
    }
};
struct EpiRes {
    static constexpr bool PERM = false;
    const float* xsrc; const float* csrc; float* xdst; float* cdst; const float* gate;
    __device__ __forceinline__ void operator()(const f32x4 (&acc)[2][2][4][2], const pg8::Unit& u, const int wid) const {
        const int lane_ = lane_id_asm(), fr = lane_ & 15, fq = lane_ >> 4, wr = wid >> 2, wc = wid & 3;
        const int col0 = u.pn * 256 + wc * 32 + 4 * fq;
        const bool isc = u.pm < 4; const int sel = isc ? 4 : (u.pm - 4) >> 5;
        const float* src = isc ? csrc + (size_t)u.pm * 256 * D : xsrc + (size_t)(u.pm - 4) * 256 * D;
        float* dst = isc ? cdst + (size_t)u.pm * 256 * D : xdst + (size_t)(u.pm - 4) * 256 * D;
        f32x4 gv[2][2];
#pragma unroll
        for (int bj = 0; bj < 2; ++bj)
#pragma unroll
            for (int n = 0; n < 2; ++n) gv[bj][n] = *(const f32x4*)(gate + sel * 6144 + col0 + bj * 128 + n * 16);
#pragma unroll
        for (int ai = 0; ai < 2; ++ai)
#pragma unroll
            for (int m = 0; m < 4; ++m) { const size_t off = (size_t)(ai * 128 + wr * 64 + m * 16 + fr) * D + col0;
#pragma unroll
                for (int bj = 0; bj < 2; ++bj)
#pragma unroll
                    for (int n = 0; n < 2; ++n) { const f32x4 s = *(const f32x4*)(src + off + bj * 128 + n * 16); *(f32x4*)(dst + off + bj * 128 + n * 16) = s + gv[bj][n] * acc[ai][bj][m][n]; }
                asm volatile("" ::: "memory"); }
    }
};
struct EpiGU {
    static constexpr bool PERM = false;
    bf16_t* H;
    __device__ __forceinline__ void operator()(const f32x4 (&acc)[2][2][4][2], const pg8::Unit& u, const int wid) const {
        const int lane_ = lane_id_asm(), fr = lane_ & 15, fq = lane_ >> 4, wr = wid >> 2, wc = wid & 3;
        const int row0 = u.pm * 256 + wr * 64 + fr;
#pragma unroll
        for (int ai = 0; ai < 2; ++ai)
#pragma unroll
            for (int m = 0; m < 4; ++m) { bf16_t* rowp = H + (size_t)(row0 + ai * 128 + m * 16) * EH + 4 * fq;
#pragma unroll
                for (int bj = 0; bj < 2; ++bj) { const f32x4 g = acc[ai][bj][m][0], up = acc[ai][bj][m][1]; float h[4];
#pragma unroll
                    for (int j = 0; j < 4; ++j) h[j] = g[j] / (1.0f + __expf(-g[j])) * up[j];
                    u32x2 w; w.x = pg8::cvt_pk_bf16(h[0], h[1]); w.y = pg8::cvt_pk_bf16(h[2], h[3]);
                    *(u32x2*)(rowp + (u.pn * 256 + bj * 128 + wc * 32) / 2) = w; } }
    }
};
struct EpiY {
    static constexpr bool PERM = true;
    bf16_t* Y;
    __device__ __forceinline__ void operator()(const f32x4 (&acc)[2][2][4][2], const pg8::Unit& u, const int wid) const {
        const int lane_ = lane_id_asm(), fr = lane_ & 15, fq = lane_ >> 4, wr = wid >> 2, wc = wid & 3;
        const int row0 = u.pm * 256 + wr * 64 + fr, col0 = u.pn * 256 + wc * 32 + 8 * fq;
#pragma unroll
        for (int ai = 0; ai < 2; ++ai)
#pragma unroll
            for (int m = 0; m < 4; ++m) { bf16_t* rowp = Y + (size_t)(row0 + ai * 128 + m * 16) * 512 + col0;
#pragma unroll
                for (int bj = 0; bj < 2; ++bj) { const f32x4 v0 = acc[ai][bj][m][0], v1 = acc[ai][bj][m][1];
                    u32x4 w; w.x = pg8::cvt_pk_bf16(v0[0], v0[1]); w.y = pg8::cvt_pk_bf16(v0[2], v0[3]); w.z = pg8::cvt_pk_bf16(v1[0], v1[1]); w.w = pg8::cvt_pk_bf16(v1[2], v1[3]);
                    *(u32x4*)(rowp + bj * 128) = w; } }
    }
};
#define WSP(T, off) ((T*)(GAS T*)(p.ws + (unsigned long long)(off)))
#define POUT ((float*)(GAS float*)p.out)

__device__ __forceinline__ void conv_tile(const int t, LAS float* tl, const float* __restrict__ src, int ldsrc, int k0, int n0, int nvalid, bf16_t* dst, int lddst, int mode) {
#pragma unroll
    for (int j = 0; j < 8; ++j) { const int idx = t + NTHR * j, k = idx >> 6, n = idx & 63; float v = 0.f; if (n0 + n < nvalid) v = src[(size_t)(k0 + k) * ldsrc + n0 + n]; tl[k * 65 + n] = v; }
    __syncthreads();
#pragma unroll
    for (int j = 0; j < 4; ++j) { const int pi = t + NTHR * j, n = pi >> 5, k = (pi & 31) * 2; const int nn = n0 + n;
        const int row = (mode == 0 || mode == 3) ? nn : ((nn >> 4) * 32 + (nn & 15) + (mode == 2 ? 16 : 0));
        float v0 = tl[k * 65 + n], v1 = tl[(k + 1) * 65 + n];
        if (mode == 3) { v0 -= bf2f((bf16_t)f2bf(v0)); v1 -= bf2f((bf16_t)f2bf(v1)); }
        *(unsigned*)(dst + (size_t)row * lddst + k0 + k) = pk2(v0, v1); }
    __syncthreads();
}
constexpr int CONV_A_UNITS = 2048 + 512 + 64 + 8 + 12;
__device__ __forceinline__ void conv_unit_A(const Cx& p, LAS float* tl, int u) {
    if (u < 2048) { const int l = u >> 10, r = u & 1023; conv_tile(p.tid, tl, PIN(I_WIN) + (size_t)l * D * INW, INW, (r >> 6) * 64, (r & 63) * 64, INW, WSP(bf16_t, WS_WIN) + (size_t)l * NPROJ * D, D, 0); }
    else if (u < 2560) { const int v = u - 2048, l = v >> 8, r = v & 255; conv_tile(p.tid, tl, PIN(I_WOUT) + (size_t)l * D * D, D, (r >> 4) * 64, (r & 15) * 64, D, WSP(bf16_t, WS_WOUT) + (size_t)l * D * D, D, 0); }
    else if (u >= 2632) { const int v = u - 2632, m = v >> 2, r = v & 3;
        conv_tile(p.tid, tl, m < NL ? PIN(I_RW_W2) + (size_t)m * 64 * 256 : PIN(I_RW_AW2), 256, 0, r * 64, 256, WSP(bf16_t, WS_RWLR) + (size_t)m * 256 * 64, 64, 0); }
    else if (u >= 2624) { const int v = u - 2624, l = v >> 2, r = v & 3; conv_tile(p.tid, tl, PIN(I_RW_GW2) + (size_t)l * 64 * 256, 256, 0, r * 64, 256, WSP(bf16_t, WS_RWGW) + (size_t)l * 256 * 64, 64, 0); }
    else { const int v = u - 2560, l = v >> 5, lo = (v >> 4) & 1, r = v & 15; conv_tile(p.tid, tl, PIN(I_ROUT_W) + (size_t)l * D * NE, NE, r * 64, 0, NE, WSP(bf16_t, WS_ROUT) + (size_t)(l * 2 + lo) * NE * D, D, lo ? 3 : 0); }
}
constexpr int CONV_E_UNITS = NE1 * 192;
struct ConvDesc { const float* src; bf16_t* dst; int ldsrc, lddst, k0, n0, mode; };
__device__ __forceinline__ ConvDesc conv_desc_E(const Cx& p, int l, int u) {
    ConvDesc c; const int e = u / 192, r = u % 192;
    if (r < 128) { const int up = r >> 6, q = r & 63;
        c.src = e < NE ? PIN(up ? I_EXP_U : I_EXP_G) + ((size_t)l * NE + e) * D * EH : PIN(up ? I_SH_U : I_SH_G) + (size_t)l * D * EH;
        c.ldsrc = EH; c.k0 = (q >> 2) * 64; c.n0 = (q & 3) * 64; c.dst = WSP(bf16_t, WS_EXPGU) + (size_t)e * 512 * D; c.lddst = D; c.mode = 1 + up; }
    else { const int q = r - 128;
        c.src = e < NE ? PIN(I_EXP_D) + ((size_t)l * NE + e) * EH * D : PIN(I_SH_D) + (size_t)l * EH * D;
        c.ldsrc = D; c.k0 = (q >> 4) * 64; c.n0 = (q & 15) * 64; c.dst = WSP(bf16_t, WS_EXPD) + (size_t)e * D * EH; c.lddst = EH; c.mode = 0; }
    return c;
}
__device__ __forceinline__ void conv_experts(const Cx& p, LAS float* tl, int l) {
    const int t = p.tid; int u = p.bid; if (u >= CONV_E_UNITS) return;
    float v[8]; ConvDesc c = conv_desc_E(p, l, u);
#pragma unroll
    for (int j = 0; j < 8; ++j) { const int idx = t + NTHR * j; v[j] = c.src[(size_t)(c.k0 + (idx >> 6)) * c.ldsrc + c.n0 + (idx & 63)]; }
    for (;;) {
#pragma unroll
        for (int j = 0; j < 8; ++j) { const int idx = t + NTHR * j; tl[(idx >> 6) * 65 + (idx & 63)] = v[j]; }
        __syncthreads();
        const int un = u + p.G; const bool more = un < CONV_E_UNITS; const ConvDesc cn = conv_desc_E(p, l, more ? un : u);
        if (more) {
#pragma unroll
            for (int j = 0; j < 8; ++j) { const int idx = t + NTHR * j; v[j] = cn.src[(size_t)(cn.k0 + (idx >> 6)) * cn.ldsrc + cn.n0 + (idx & 63)]; } }
#pragma unroll
        for (int j = 0; j < 4; ++j) { const int pi = t + NTHR * j, n = pi >> 5, k = (pi & 31) * 2; const int nn = c.n0 + n;
            const int row = c.mode == 0 ? nn : ((nn >> 4) * 32 + (nn & 15) + (c.mode == 2 ? 16 : 0));
            *(unsigned*)(c.dst + (size_t)row * c.lddst + c.k0 + k) = pk2(tl[k * 65 + n], tl[(k + 1) * 65 + n]); }
        __syncthreads();
        if (!more) break;
        c = cn; u = un;
    }
}
__device__ __forceinline__ void phase_mod(const Cx& p, LAS unsigned char* lds) {
    LAS float* sv = (LAS float*)lds; LAS float* red = sv + 5 * D;
    const int tid = p.tid;
    if (p.bid >= 192) return;
    for (int i = tid; i < 5 * D; i += NTHR) { const int j = i >> 10, k = i & 1023; const float c = j < 4 ? PIN(I_C)[j * D + k] : PIN(I_CCTX)[k]; sv[i] = siluf_(c); }
    __syncthreads();
    for (int u = p.bid; u < 192; u += p.G) {
        const int l = u / 96, cb = u % 96, kg = tid >> 6, cl = tid & 63;
        const float* w = PIN(I_WMOD) + (size_t)l * D * 6144 + cb * 64 + cl;
        float a0 = 0.f, a1 = 0.f, a2 = 0.f, a3 = 0.f, a4 = 0.f;
#pragma unroll 8
        for (int kk = 0; kk < 128; ++kk) { const int k = kg * 128 + kk; const float wv = w[(size_t)k * 6144];
            a0 += sv[k] * wv; a1 += sv[D + k] * wv; a2 += sv[2 * D + k] * wv; a3 += sv[3 * D + k] * wv; a4 += sv[4 * D + k] * wv; }
        red[(kg * 5 + 0) * 64 + cl] = a0; red[(kg * 5 + 1) * 64 + cl] = a1; red[(kg * 5 + 2) * 64 + cl] = a2; red[(kg * 5 + 3) * 64 + cl] = a3; red[(kg * 5 + 4) * 64 + cl] = a4;
        __syncthreads();
        if (tid < 320) { const int j = tid >> 6; float s = 0.f;
#pragma unroll
            for (int g = 0; g < 8; ++g) s += red[(g * 5 + j) * 64 + cl];
            WSP(float, WS_MOD)[((size_t)l * 5 + j) * 6144 + cb * 64 + cl] = s + PIN(I_BMOD)[l * 6144 + cb * 64 + cl]; }
        __syncthreads();
    }
}
__device__ __forceinline__ const float* res_row(const Cx& p, int layer_src0, int r) {
    if (r < CROWS) return (layer_src0 ? PIN(I_CTX) : (const float*)WSP(float, WS_CTXRES)) + (size_t)r * D;
    return (layer_src0 ? PIN(I_X) : (const float*)POUT) + (size_t)(r - CROWS) * D;
}
__device__ __forceinline__ int row_sel(int r) { return r < CROWS ? 4 : (r - CROWS) >> 13; }

__device__ __forceinline__ void norm_ld(const float* src, f32x4 (&v)[4], int lane) {
#pragma unroll
    for (int i = 0; i < 4; ++i) v[i] = *(const f32x4*)(src + 256 * i + 4 * lane);
}
__device__ __forceinline__ void norm_fin(const f32x4 (&v)[4], const float* g, const float* shift, const float* scale, bf16_t* dst, const bool tolds, LAS bf16_t* ldst, LAS bf16_t* ldlo, int lane) {
    float ss = 0.f;
#pragma unroll
    for (int i = 0; i < 4; ++i) ss += v[i][0] * v[i][0] + v[i][1] * v[i][1] + v[i][2] * v[i][2] + v[i][3] * v[i][3];
    ss = wsum(ss); const float rstd = rsqrtf(ss * (1.0f / D) + 1e-6f);
#pragma unroll
    for (int i = 0; i < 4; ++i) { const int col = 256 * i + 4 * lane; const f32x4 gv = *(const f32x4*)(g + col), sh = *(const f32x4*)(shift + col), sc = *(const f32x4*)(scale + col);
        const f32x4 y = v[i] * rstd * gv * (sc + 1.0f) + sh; u32x2 w; w.x = pk2(y[0], y[1]); w.y = pk2(y[2], y[3]);
        *(u32x2*)(dst + col) = w;
        if (tolds) { *(LAS u32x2*)(ldst + col) = w; u32x2 wl;
            wl.x = pk2(y[0] - __uint_as_float(w.x << 16), y[1] - __uint_as_float(w.x & 0xffff0000u)); wl.y = pk2(y[2] - __uint_as_float(w.y << 16), y[3] - __uint_as_float(w.y & 0xffff0000u));
            *(LAS u32x2*)(ldlo + col) = wl; } }
}
__device__ __forceinline__ void phase_norm1(const Cx& p, int layer) {
    const int lane = p.tid & 63, wave = p.tid >> 6;
    const float* mod = WSP(float, WS_MOD) + (size_t)layer * 5 * 6144; const float* g = PIN(I_N1G) + layer * D; bf16_t* hb = WSP(bf16_t, WS_HBUF);
    for (int r = p.bid * 16 + wave * 2; r < ROWS; r += p.G * 16) { f32x4 v0[4], v1[4];
        norm_ld(res_row(p, layer == 0, r), v0, lane); norm_ld(res_row(p, layer == 0, r + 1), v1, lane);
        const int s0 = row_sel(r), s1 = row_sel(r + 1);
        norm_fin(v0, g, mod + s0 * 6144 + 0, mod + s0 * 6144 + 1024, hb + (size_t)r * D, false, (LAS bf16_t*)0, (LAS bf16_t*)0, lane);
        norm_fin(v1, g, mod + s1 * 6144 + 0, mod + s1 * 6144 + 1024, hb + (size_t)(r + 1) * D, false, (LAS bf16_t*)0, (LAS bf16_t*)0, lane); }
}
__device__ __forceinline__ float sum8_(float v) { v += DPPF(v, 0xB1); v += DPPF(v, 0x4E); v += DPPF(v, 0x141); return v; }
__device__ __forceinline__ float sum16_(float v) { v = sum8_(v); v += DPPF(v, 0x140); return v; }
__device__ __forceinline__ void bf8_to_f(const u32x4 w, float (&f)[8]) {
#pragma unroll
    for (int q = 0; q < 4; ++q) { f[2 * q] = __uint_as_float(w[q] << 16); f[2 * q + 1] = __uint_as_float(w[q] & 0xffff0000u); } }
__device__ __forceinline__ void phase_prep(const Cx& p, LAS unsigned char* lds, int layer, int b) {
    const int lane = p.tid & 63, wave = __builtin_amdgcn_readfirstlane(p.tid >> 6);
    const bf16_t* proj = WSP(bf16_t, WS_PROJ);
    const int e0 = p.bid * NTHR + p.tid, e1 = e0 + p.G * NTHR; bf16_t sq0 = 0, sq1 = 0;
#define SCAL_COL(q) ((q) < 8 ? PC_DF + (q) : (q) < 16 ? PD_BF + ((q) - 8) : PD_AF + ((q) - 16))
    if (e0 < SB * 24) sq0 = proj[(size_t)tok_row(b, e0 / 24) * NPROJ + SCAL_COL(e0 % 24)];
    if (e1 < SB * 24) sq1 = proj[(size_t)tok_row(b, e1 / 24) * NPROJ + SCAL_COL(e1 % 24)];
    if (p.bid < SB / 33) {
        constexpr int ATS = 208;
        LAS unsigned char* WWt = lds; LAS unsigned char* AWt = lds + 256 * 144; LAS unsigned char* At = lds + 2 * 256 * 144;
        { const bf16_t* w2c = WSP(bf16_t, WS_RWLR) + (size_t)layer * 256 * 64; const bf16_t* awc = WSP(bf16_t, WS_RWLR) + (size_t)NL * 256 * 64;
#pragma unroll
          for (int q = 0; q < 4; ++q) { const int e = p.tid + NTHR * q, n = e >> 3, ch = e & 7;
              *(LAS u32x4*)(WWt + n * 144 + ch * 16) = *(const u32x4*)(w2c + n * 64 + ch * 8); *(LAS u32x4*)(AWt + n * 144 + ch * 16) = *(const u32x4*)(awc + n * 64 + ch * 8); } }
        const int h = wave & 3, half = wave >> 2, fr = lane & 15, fq = lane >> 4;
        float a0c[4], w0fc[4], w0bc[4], kkc[4], kac[4];
#pragma unroll
        for (int nt = 0; nt < 4; ++nt) { const int c = 64 * h + 16 * nt + fr; a0c[nt] = PIN(I_RW_A0)[layer * 256 + c]; w0fc[nt] = PIN(I_RW_W0)[(layer * 2 + 0) * 256 + c]; w0bc[nt] = PIN(I_RW_W0)[(layer * 2 + 1) * 256 + c];
            kkc[nt] = PIN(I_RW_KK)[layer * 256 + c]; kac[nt] = PIN(I_RW_KA)[layer * 256 + c]; }
        for (int u = p.bid; u < SB / 33; u += p.G) {
            if (p.tid < 33 * 12) { const int tk = p.tid / 12, ch = p.tid % 12; u32x4 w = *(const u32x4*)(proj + (size_t)tok_row(b, u * 33 + tk) * NPROJ + PB_WF + 8 * ch);
                if (ch < 8) {
#pragma unroll
                    for (int q = 0; q < 4; ++q) w[q] = pk2(tanhf_(__uint_as_float(w[q] << 16)), tanhf_(__uint_as_float(w[q] & 0xffff0000u))); }
                *(LAS u32x4*)(At + tk * ATS + ch * 16) = w; }
            bf16_t kvA[4][4], kvB[4];
#pragma unroll
            for (int j = 0; j < 4; ++j) { const bf16_t* pr = proj + (size_t)tok_row(b, u * 33 + 16 * half + 4 * fq + j) * NPROJ + PB_K + 64 * h + fr;
#pragma unroll
                for (int nt = 0; nt < 4; ++nt) kvA[nt][j] = pr[16 * nt]; }
            { const bf16_t* pr = proj + (size_t)tok_row(b, u * 33 + 32) * NPROJ + PB_K + 64 * h + fr;
#pragma unroll
              for (int nt = 0; nt < 4; ++nt) kvB[nt] = pr[16 * nt]; }
            __syncthreads();
#pragma unroll
            for (int pass = 0; pass < 2; ++pass) { if (pass == 1 && half != 0) break;
                const int mt = pass ? 2 : half; f32x4 sa[4], sf[4], sb[4];
                const bf16x8 awf = *(const LAS bf16x8*)(At + (16 * mt + fr) * ATS + fq * 16), awb = *(const LAS bf16x8*)(At + (16 * mt + fr) * ATS + 64 + fq * 16), aa = *(const LAS bf16x8*)(At + (16 * mt + fr) * ATS + 128 + fq * 16);
#pragma unroll
                for (int nt = 0; nt < 4; ++nt) { const int n = 64 * h + 16 * nt + fr; const f32x4 z = (f32x4){0.f, 0.f, 0.f, 0.f};
                    sf[nt] = __builtin_amdgcn_mfma_f32_16x16x32_bf16(awf, *(const LAS bf16x8*)(WWt + n * 144 + fq * 16), z, 0, 0, 0);
                    sb[nt] = __builtin_amdgcn_mfma_f32_16x16x32_bf16(awb, *(const LAS bf16x8*)(WWt + n * 144 + 64 + fq * 16), z, 0, 0, 0);
                    sa[nt] = __builtin_amdgcn_mfma_f32_16x16x32_bf16(aa, *(const LAS bf16x8*)(AWt + n * 144 + layer * 64 + fq * 16), z, 0, 0, 0); }
#pragma unroll
                for (int j = 0; j < 4; ++j) { if (pass == 1 && j > 0) break;
                    const int tk = 16 * mt + 4 * fq + j; const bool valid = tk < 33; const int s = u * 33 + tk;
                    float kv[4], kr[4], ssq = 0.f;
#pragma unroll
                    for (int nt = 0; nt < 4; ++nt) { kv[nt] = bf2f(pass ? kvB[nt] : kvA[nt][j]); kr[nt] = kv[nt] * kkc[nt]; ssq += kr[nt] * kr[nt]; }
                    const float rs = rsqrtf(sum16_(ssq) + 1e-6f);
#pragma unroll
                    for (int nt = 0; nt < 4; ++nt) { const float a = sigmoidf_(sa[nt][j] + a0c[nt]);
                        const float lwf = -__expf(-softplusf_(-(sf[nt][j] + w0fc[nt])) - 0.5f), lwb = -__expf(-softplusf_(-(sb[nt][j] + w0bc[nt])) - 0.5f);
                        const float kk = kr[nt] * rs; const size_t o = (size_t)s * 256 + 64 * h + 16 * nt + fr;
                        if (valid) { WSP(float, SC_RK)[o] = kv[nt] * (1.0f + (a - 1.0f) * kac[nt]); WSP(float, SC_RKK)[o] = kk; WSP(float, SC_RB)[o] = kk * a;
                            WSP(float, SC_RLW)[o] = lwf; WSP(float, SC_RLW)[(size_t)SB * 256 + o] = lwb; } } } }
            __syncthreads();
        }
    }
    __syncthreads();
    { LAS bf16_t* T = (LAS bf16_t*)lds; const int tid = p.tid;
#define PC_LOAD(uu, v, vh) do { const int mixer_ = (uu) / (NTB * 3), r2_ = (uu) % (NTB * 3), rb_ = r2_ / 3, colbase_ = (mixer_ ? PD_Q : PC_X) + 256 * (r2_ % 3); \
          _Pragma("unroll") for (int q = 0; q < 12; ++q) { const int e = tid + NTHR * q, rr = e >> 11, tok = (e >> 5) & 63, ch = (e & 31) * 8; v[q] = (u32x4){0u, 0u, 0u, 0u}; \
              if (rb_ < 4) { if (rr == 1) v[q] = *(const u32x4*)(proj + (size_t)(b * NCTX + 64 * rb_ + tok) * NPROJ + colbase_ + ch); } \
              else { const int gr = rb_ - 4 + rr - 1; if (gr >= 0 && gr < GRIDH) v[q] = *(const u32x4*)(proj + (size_t)(CROWS + b * SEQ + gr * 64 + tok) * NPROJ + colbase_ + ch); } } \
          vh = (u32x4){0u, 0u, 0u, 0u}; if (tid < 192) { const int rr = tid >> 6, side = (tid >> 5) & 1, ch = (tid & 31) * 8;       \
              if (rb_ < 4 && rr == 1) { const int tk = side ? 64 * (rb_ + 1) : 64 * rb_ - 1; if (tk >= 0 && tk < NCTX) vh = *(const u32x4*)(proj + (size_t)(b * NCTX + tk) * NPROJ + colbase_ + ch); } } } while (0)
      int u = p.bid;
      if (u < 2 * NTB * 3) { u32x4 v[12], vh; PC_LOAD(u, v, vh);
        for (;;) { const int mixer = u / (NTB * 3), r2 = u % (NTB * 3), rb = r2 / 3, third = r2 % 3;
#pragma unroll
          for (int q = 0; q < 12; ++q) { const int e = tid + NTHR * q, rr = e >> 11, tok = (e >> 5) & 63, ch = (e & 31) * 8; *(LAS u32x4*)(T + (rr * 66 + tok + 1) * 256 + ch) = v[q]; }
          if (tid < 192) { const int rr = tid >> 6, side = (tid >> 5) & 1, ch = (tid & 31) * 8; *(LAS u32x4*)(T + (rr * 66 + (side ? 65 : 0)) * 256 + ch) = vh; }
          __syncthreads();
          const int un = u + p.G; const bool more = un < 2 * NTB * 3;
          if (more) PC_LOAD(un, v, vh);
          { const int c = tid & 255, th = tid >> 8, chn = 256 * third + c; float w[9];
            const float* cw = (mixer ? PIN(I_DN_CW) : PIN(I_SS_CW)) + (size_t)layer * 9 * 768 + chn;
#pragma unroll
            for (int k = 0; k < 9; ++k) w[k] = cw[k * 768];
            const float bias = mixer ? 0.f : PIN(I_SS_CB)[layer * 768 + chn];
            bf16_t* dst = (mixer ? WSP(bf16_t, SC_DQ) : WSP(bf16_t, SC_SX)) + (size_t)(64 * rb) * 768 + chn;
#pragma unroll 2
            for (int tk = 0; tk < 32; ++tk) { const int x = 32 * th + tk; float acc = bias;
#pragma unroll
                for (int dy = 0; dy < 3; ++dy)
#pragma unroll
                    for (int dx = 0; dx < 3; ++dx) acc += w[dy * 3 + dx] * bf2f(T[(dy * 66 + x + dx) * 256 + c]);
                float y = siluf_(acc);
                if (mixer && third < 2) { const float ss = wsum(y * y); y *= rsqrtf(ss + 1e-6f); if (third == 0) y *= 0.125f; }
                dst[(size_t)x * 768] = (bf16_t)f2bf(y); } }
          __syncthreads();
          if (!more) break;
          u = un; } }
#undef PC_LOAD
#define SCAL_FIN(e_, raw_) do { const int s = (e_) / 24, q = (e_) % 24; const float xv = bf2f(raw_); \
          if (q < 8) { const int d = q >> 2, h = q & 3; WSP(float, SC_SDT)[(size_t)s * 8 + q] = softplusf_(xv + PIN(I_SS_DTB)[(layer * 2 + d) * 4 + h]); } \
          else if (q < 16) { WSP(float, SC_DG)[(size_t)s * 16 + (q - 8)] = sigmoidf_(xv); } \
          else { const int q2 = q - 16, d = q2 >> 2, h = q2 & 3; WSP(float, SC_DG)[(size_t)s * 16 + 8 + q2] = -__expf(PIN(I_DN_ALOG)[(layer * 2 + d) * 4 + h]) * softplusf_(xv + PIN(I_DN_DTB)[(layer * 2 + d) * 4 + h]); } } while (0)
      if (e0 < SB * 24) SCAL_FIN(e0, sq0);
      if (e1 < SB * 24) SCAL_FIN(e1, sq1);
      for (int e = e1 + p.G * NTHR; e < SB * 24; e += p.G * NTHR) { const bf16_t raw = proj[(size_t)tok_row(b, e / 24) * NPROJ + SCAL_COL(e % 24)]; SCAL_FIN(e, raw); }
#undef SCAL_FIN
#undef SCAL_COL
    }
}
__device__ __forceinline__ void phase_scan(const Cx& p, LAS unsigned char* lds, int layer, int b);
__device__ __forceinline__ void phase_post(const Cx& p, LAS unsigned char* lds, int layer, int b) {
    const int tid = p.tid, tsub = tid >> 7, c8 = (tid & 127) * 8, mixer = c8 >> 8, cm = c8 & 255, hh = cm >> 6;
    const bf16_t* proj = WSP(bf16_t, WS_PROJ); const bf16_t* of = WSP(bf16_t, SC_OF); const bf16_t* obk = WSP(bf16_t, SC_OB); bf16_t* yc = WSP(bf16_t, WS_HBUF);
    constexpr int PTS = 144, GTS = 260;
    LAS unsigned char* GWb = lds; LAS unsigned char* SGb = lds + 256 * PTS; LAS float* GT = (LAS float*)(lds + 256 * PTS + 48 * PTS);
    if ((int)p.bid < SB / 33) { const bf16_t* gsrc = WSP(bf16_t, WS_RWGW) + (size_t)layer * 256 * 64;
#pragma unroll
        for (int q = 0; q < 4; ++q) { const int e = tid + NTHR * q, n = e >> 3, ch = e & 7; *(LAS u32x4*)(GWb + n * PTS + ch * 16) = *(const u32x4*)(gsrc + n * 64 + ch * 8); } }
    float g0[8], g1[8], g2[8];
#pragma unroll
    for (int q = 0; q < 8; ++q) { const int c = cm + q; g0[q] = 0.f; g1[q] = 0.f; g2[q] = 0.f;
        if (mixer == 0) g0[q] = PIN(I_GLA_NG)[layer * 256 + c];
        else if (mixer == 1) { g0[q] = PIN(I_RW_LNG)[layer * 256 + c]; g1[q] = PIN(I_RW_LNB)[layer * 256 + c]; g2[q] = PIN(I_RW_RK)[layer * 256 + c]; }
        else if (mixer == 2) { g0[q] = PIN(I_SS_NG)[layer * 256 + c]; g1[q] = PIN(I_SS_D)[layer * 4 + hh]; }
        else g0[q] = PIN(I_DN_NG)[layer * 256 + c]; }
    const int col1 = (mixer == 0 ? PA_G : mixer == 1 ? PB_R : mixer == 2 ? PC_Z : PD_Z) + cm;
    for (int u = p.bid; u < SB / 33; u += p.G) {
        if (tid < 33 * 8) { const int tk = tid >> 3, ch = tid & 7; float gl[8]; bf8_to_f(*(const u32x4*)(proj + (size_t)tok_row(b, u * 33 + tk) * NPROJ + PB_G + 8 * ch), gl);
            *(LAS u32x4*)(SGb + tk * PTS + ch * 16) = (u32x4){pk2(sigmoidf_(gl[0]), sigmoidf_(gl[1])), pk2(sigmoidf_(gl[2]), sigmoidf_(gl[3])), pk2(sigmoidf_(gl[4]), sigmoidf_(gl[5])), pk2(sigmoidf_(gl[6]), sigmoidf_(gl[7]))}; }
        u32x4 rof, rob, ra1, ra2 = (u32x4){0u, 0u, 0u, 0u}; f32x4 rk0 = (f32x4){0.f, 0.f, 0.f, 0.f}, rk1 = rk0;
#define POST_LOAD(t0_) do { const int tk_ = (t0_) + tsub; const int s_ = u * 33 + (tk_ < 33 ? tk_ : 32); const bf16_t* pr_ = proj + (size_t)tok_row(b, s_) * NPROJ; \
        rof = *(const u32x4*)(of + (size_t)s_ * 1024 + c8); rob = *(const u32x4*)(obk + (size_t)s_ * 1024 + c8); ra1 = *(const u32x4*)(pr_ + col1); \
        if (mixer == 1) { ra2 = *(const u32x4*)(pr_ + PB_V + cm); rk0 = *(const f32x4*)(WSP(float, SC_RK) + (size_t)s_ * 256 + cm); rk1 = *(const f32x4*)(WSP(float, SC_RK) + (size_t)s_ * 256 + cm + 4); } \
        else if (mixer == 2) ra2 = *(const u32x4*)(WSP(bf16_t, SC_SX) + (size_t)s_ * 768 + cm); } while (0)
        POST_LOAD(0);
        __syncthreads();
        { const int lane = tid & 63, wave = tid >> 6, fr = lane & 15, fq = lane >> 4; f32x4 acc[3][2];
#pragma unroll
          for (int mt = 0; mt < 3; ++mt) { acc[mt][0] = (f32x4){0.f, 0.f, 0.f, 0.f}; acc[mt][1] = (f32x4){0.f, 0.f, 0.f, 0.f}; }
#pragma unroll
          for (int ks = 0; ks < 2; ++ks) { bf16x8 bb[2];
#pragma unroll
              for (int nt = 0; nt < 2; ++nt) bb[nt] = *(const LAS bf16x8*)(GWb + (16 * (2 * wave + nt) + fr) * PTS + ks * 64 + fq * 16);
#pragma unroll
              for (int mt = 0; mt < 3; ++mt) { const bf16x8 a = *(const LAS bf16x8*)(SGb + (16 * mt + fr) * PTS + ks * 64 + fq * 16);
                  acc[mt][0] = __builtin_amdgcn_mfma_f32_16x16x32_bf16(a, bb[0], acc[mt][0], 0, 0, 0); acc[mt][1] = __builtin_amdgcn_mfma_f32_16x16x32_bf16(a, bb[1], acc[mt][1], 0, 0, 0); } }
#pragma unroll
          for (int mt = 0; mt < 3; ++mt)
#pragma unroll
              for (int nt = 0; nt < 2; ++nt)
#pragma unroll
                  for (int j = 0; j < 4; ++j) GT[(16 * mt + 4 * fq + j) * GTS + 16 * (2 * wave + nt) + fr] = acc[mt][nt][j]; }
        __syncthreads();
#pragma unroll 1
        for (int t0 = 0; t0 < 36; t0 += 4) { const int tk = t0 + tsub; const bool live = tk < 33; const int tkc = live ? tk : 32, s = u * 33 + tkc, row = tok_row(b, s);
            const u32x4 cof = rof, cob = rob, ca1 = ra1, ca2 = ra2; const f32x4 k0 = rk0, k1 = rk1;
            if (t0 + 4 < 36) POST_LOAD(t0 + 4);
            float o[8], a[8], y[8];
            { float t1[8], t2[8]; bf8_to_f(cof, t1); bf8_to_f(cob, t2);
#pragma unroll
              for (int q = 0; q < 8; ++q) o[q] = t1[q] + t2[q]; }
            bf8_to_f(ca1, a);
            if (mixer == 0 || mixer == 3) { float ss = 0.f;
#pragma unroll
                for (int q = 0; q < 8; ++q) ss += o[q] * o[q];
                const float rs = rsqrtf(sum8_(ss) * (1.0f / 64.0f) + 1e-6f);
#pragma unroll
                for (int q = 0; q < 8; ++q) y[q] = o[q] * rs * g0[q] * siluf_(a[q]);
            } else if (mixer == 2) { float xs[8]; bf8_to_f(ca2, xs); float ss = 0.f;
#pragma unroll
                for (int q = 0; q < 8; ++q) { y[q] = (o[q] + g1[q] * xs[q]) * siluf_(a[q]); ss += y[q] * y[q]; }
                const float rs = rsqrtf(sum16_(ss) * (1.0f / 128.0f) + 1e-6f);
#pragma unroll
                for (int q = 0; q < 8; ++q) y[q] *= rs * g0[q];
            } else { float vv[8]; bf8_to_f(ca2, vv);
                float su = 0.f, bo = 0.f;
#pragma unroll
                for (int q = 0; q < 8; ++q) { su += o[q]; bo += a[q] * (q < 4 ? k0[q & 3] : k1[q & 3]) * g2[q]; }
                const float mu = sum8_(su) * (1.0f / 64.0f); bo = sum8_(bo); float va = 0.f;
#pragma unroll
                for (int q = 0; q < 8; ++q) { o[q] -= mu; va += o[q] * o[q]; }
                const float rs = rsqrtf(sum8_(va) * (1.0f / 64.0f) + 64e-5f);
                const f32x4 gt0 = *(const LAS f32x4*)(GT + tkc * GTS + cm), gt1 = *(const LAS f32x4*)(GT + tkc * GTS + cm + 4);
#pragma unroll
                for (int q = 0; q < 8; ++q) y[q] = (o[q] * rs * g0[q] + g1[q] + bo * vv[q]) * (q < 4 ? gt0[q & 3] : gt1[q & 3]); }
            if (live) *(u32x4*)(yc + (size_t)row * D + c8) = (u32x4){pk2(y[0], y[1]), pk2(y[2], y[3]), pk2(y[4], y[5]), pk2(y[6], y[7])};
        }
#undef POST_LOAD
    }
}
constexpr int N2_TILE = 32, N2_STRIDE = 2064;
__device__ __forceinline__ void phase_norm2(const Cx& p, LAS unsigned char* lds, int layer, int row_lo) {
    const int tid = p.tid, lane = tid & 63, wave = __builtin_amdgcn_readfirstlane(tid >> 6), fr = lane & 15, fq = lane >> 4;
    const float* mod = WSP(float, WS_MOD) + (size_t)layer * 5 * 6144; const float* g = PIN(I_N2G) + layer * D; bf16_t* hb = WSP(bf16_t, WS_HBUF);
    const bf16_t* rt = WSP(bf16_t, WS_ROUT) + (size_t)layer * 2 * NE * D;
    LAS float* lg = (LAS float*)(lds + 2 * N2_TILE * N2_STRIDE);
    unsigned* cnt = WSP(unsigned, WS_CTL) + CW_CNT + layer * 80 * 16; int* ltok = WSP(int, WS_LTOK); int* tokt = WSP(int, WS_TOKT);
    const float rbias = PIN(I_ROUT_B)[layer * NE + lane];
    const int nun = (ROWS - row_lo) / N2_TILE;
    for (int u = p.bid; u < nun; u += p.G) { const int r0 = row_lo + u * N2_TILE;
#pragma unroll 1
        for (int i = 0; i < 4; i += 2) { const int tr = 4 * wave + i, r = r0 + tr; f32x4 v0[4], v1[4];
            norm_ld(res_row(p, 0, r), v0, lane); norm_ld(res_row(p, 0, r + 1), v1, lane);
            const int s0 = row_sel(r), s1 = row_sel(r + 1);
            norm_fin(v0, g, mod + s0 * 6144 + 3072, mod + s0 * 6144 + 4096, hb + (size_t)r * D, true, (LAS bf16_t*)(lds + tr * N2_STRIDE), (LAS bf16_t*)(lds + N2_TILE * N2_STRIDE + tr * N2_STRIDE), lane);
            norm_fin(v1, g, mod + s1 * 6144 + 3072, mod + s1 * 6144 + 4096, hb + (size_t)(r + 1) * D, true, (LAS bf16_t*)(lds + (tr + 1) * N2_STRIDE), (LAS bf16_t*)(lds + N2_TILE * N2_STRIDE + (tr + 1) * N2_STRIDE), lane); }
        __syncthreads();
        { const int mt = wave >> 2, nt = wave & 3; f32x4 acc = (f32x4){0.f, 0.f, 0.f, 0.f};
          const LAS unsigned char* ap = lds + (16 * mt + fr) * N2_STRIDE + fq * 16; const bf16_t* bp = rt + (size_t)(16 * nt + fr) * D + fq * 8;
#pragma unroll 4
          for (int ks = 0; ks < 32; ++ks) { const bf16x8 a = *(const LAS bf16x8*)(ap + ks * 64), al = *(const LAS bf16x8*)(ap + N2_TILE * N2_STRIDE + ks * 64);
              const bf16x8 bb = *(const bf16x8*)(bp + ks * 32), bl = *(const bf16x8*)(bp + NE * D + ks * 32);
              acc = __builtin_amdgcn_mfma_f32_16x16x32_bf16(a, bb, acc, 0, 0, 0); acc = __builtin_amdgcn_mfma_f32_16x16x32_bf16(al, bb, acc, 0, 0, 0); acc = __builtin_amdgcn_mfma_f32_16x16x32_bf16(a, bl, acc, 0, 0, 0); }
#pragma unroll
          for (int j = 0; j < 4; ++j) lg[(16 * mt + 4 * fq + j) * 64 + 16 * nt + fr] = acc[j]; }
        __syncthreads();
#pragma unroll 1
        for (int i = 0; i < 4; ++i) { const int tr = 4 * wave + i, r = r0 + tr;
            const float sc = sigmoidf_(lg[tr * 64 + lane]); float sel = sc + rbias; float ssum = 0.f; int myE = 0; float myS = 0.f;
#pragma unroll 1
            for (int k = 0; k < TOPK; ++k) { float bv = sel; int bi = lane;
#define ARGSTEP(OV, OI) do { const float ov_ = (OV); const int oi_ = (OI); if (ov_ > bv || (ov_ == bv && oi_ < bi)) { bv = ov_; bi = oi_; } } while (0)
                ARGSTEP(DPPF(bv, 0xB1), DPPI(bi, 0xB1)); ARGSTEP(DPPF(bv, 0x4E), DPPI(bi, 0x4E)); ARGSTEP(DPPF(bv, 0x141), DPPI(bi, 0x141)); ARGSTEP(DPPF(bv, 0x140), DPPI(bi, 0x140));
                ARGSTEP(__uint_as_float(__builtin_amdgcn_ds_swizzle(__float_as_uint(bv), 0x401F)), __builtin_amdgcn_ds_swizzle(bi, 0x401F));
                { const float v0 = rl(bv, 0), v1 = rl(bv, 32); const int i0 = __builtin_amdgcn_readlane(bi, 0), i1 = __builtin_amdgcn_readlane(bi, 32); if (v1 > v0 || (v1 == v0 && i1 < i0)) { bv = v1; bi = i1; } else { bv = v0; bi = i0; } }
#undef ARGSTEP
                const int e = __builtin_amdgcn_readfirstlane(bi); const float se = rl(sc, e);
                ssum += se; if (lane == k) { myE = e; myS = se; } if (lane == e) sel = -1e30f; }
            if (lane < TOPK) { const unsigned pos = atomicAdd(cnt + myE * 16, 1u); ltok[(size_t)myE * ROWS + pos] = r; tokt[(size_t)r * 16 + lane] = (myE << 16) | (int)pos; ((float*)tokt)[(size_t)r * 16 + 8 + lane] = myS / ssum * 2.5f; } }
        __syncthreads();
    }
}
__device__ __forceinline__ void moe_table(const Cx& p, LAS int* tb, int layer, int row_lo) {
    const unsigned* cnt = WSP(unsigned, WS_CTL) + CW_CNT + layer * 80 * 16;
    if (p.tid == 0) { int acc = 0;
#pragma unroll 1
        for (int e = 0; e < NE1; ++e) { const int c = e < NE ? (int)__hip_atomic_load(cnt + e * 16, __ATOMIC_RELAXED, __HIP_MEMORY_SCOPE_AGENT) : ROWS - row_lo; tb[e] = c; tb[128 + e] = acc; acc += (c + 255) >> 8; }
        tb[128 + NE1] = acc; }
    __syncthreads();
}
__device__ __forceinline__ void phase_combine(const Cx& p, const LAS int* tb, int layer, int row_lo, int half) {
    const int lane = p.tid & 63, wave = p.tid >> 6; const bf16_t* Y = WSP(bf16_t, WS_Y); const int* tokt = WSP(int, WS_TOKT);
    const float* gate = WSP(float, WS_MOD) + (size_t)layer * 5 * 6144 + 5120; const int col = 512 * half + 8 * lane; const int shbase = tb[128 + NE] * 256;
#pragma unroll 2
    for (int r = row_lo + p.bid * 8 + wave; r < ROWS; r += p.G * 8) {
        const int sw = lane < 16 ? tokt[(size_t)r * 16 + lane] : 0;
        float a[8];
        { const u32x4 y = *(const u32x4*)(Y + (size_t)(shbase + (r - row_lo)) * 512 + 8 * lane);
#pragma unroll
          for (int q = 0; q < 4; ++q) { a[2 * q] = __uint_as_float(y[q] << 16); a[2 * q + 1] = __uint_as_float(y[q] & 0xffff0000u); } }
#pragma unroll
        for (int k = 0; k < 8; ++k) { const int sl = __builtin_amdgcn_readlane(sw, k); const float w = __uint_as_float(__builtin_amdgcn_readlane(sw, 8 + k));
            const int hrow = tb[128 + (sl >> 16)] * 256 + (sl & 0xffff); const u32x4 y = *(const u32x4*)(Y + (size_t)hrow * 512 + 8 * lane);
#pragma unroll
            for (int q = 0; q < 4; ++q) { a[2 * q] += w * __uint_as_float(y[q] << 16); a[2 * q + 1] += w * __uint_as_float(y[q] & 0xffff0000u); } }
        float* x = (float*)res_row(p, 0, r) + col; const float* gp = gate + row_sel(r) * 6144 + col;
#pragma unroll
        for (int q = 0; q < 2; ++q) { const f32x4 gv = *(const f32x4*)(gp + 4 * q); f32x4 xv = *(const f32x4*)(x + 4 * q);
            xv[0] += gv[0] * a[4 * q]; xv[1] += gv[1] * a[4 * q + 1]; xv[2] += gv[2] * a[4 * q + 2]; xv[3] += gv[3] * a[4 * q + 3]; *(f32x4*)(x + 4 * q) = xv; }
    }
}
__device__ __forceinline__ void phase_final(const Cx& p) {
    const int lane = p.tid & 63, wave = p.tid >> 6; const float* g = PIN(I_FNG);
    for (int r = p.bid * 16 + wave * 2; r < NB * SEQ; r += p.G * 16) { f32x4 v[2][4];
        norm_ld(POUT + (size_t)r * D, v[0], lane); norm_ld(POUT + (size_t)(r + 1) * D, v[1], lane);
#pragma unroll
        for (int q = 0; q < 2; ++q) { float* x = POUT + (size_t)(r + q) * D; float ss = 0.f;
#pragma unroll
            for (int i = 0; i < 4; ++i) ss += v[q][i][0] * v[q][i][0] + v[q][i][1] * v[q][i][1] + v[q][i][2] * v[q][i][2] + v[q][i][3] * v[q][i][3];
            ss = wsum(ss); const float rstd = rsqrtf(ss * (1.0f / D) + 1e-6f);
#pragma unroll
            for (int i = 0; i < 4; ++i) *(f32x4*)(x + 256 * i + 4 * lane) = v[q][i] * rstd * *(const f32x4*)(g + 256 * i + 4 * lane); } }
}
__device__ __forceinline__ int chain_tb(int n, int d) { return d == 0 ? n : (n < 4 ? 3 - n : 135 - n); }
__device__ __forceinline__ int tb_row0(int b, int tb) { return tb < 4 ? b * NCTX + 64 * tb : CROWS + b * SEQ + 64 * (tb - 4); }
constexpr int TS = 144;
template <int K, int NT> __device__ __forceinline__ void mm_rows(const LAS unsigned char* A, int lda, const LAS unsigned char* Bt, int ldb, int mt, int nt0, int fr, int fq, f32x4 (&acc)[NT]) {
#pragma unroll
    for (int ks = 0; ks < K / 32; ++ks) { const bf16x8 a = *(const LAS bf16x8*)(A + (16 * mt + fr) * lda + ks * 64 + fq * 16);
#pragma unroll
        for (int nt = 0; nt < NT; ++nt) { const bf16x8 bb = *(const LAS bf16x8*)(Bt + (16 * (nt0 + nt) + fr) * ldb + ks * 64 + fq * 16);
            acc[nt] = __builtin_amdgcn_mfma_f32_16x16x32_bf16(a, bb, acc[nt], 0, 0, 0); } }
}
#define UNIT_LOOP(u, N, OFF) for (int u = (p.bid + p.G - ((OFF) % p.G)) % p.G; u < (N); u += p.G)
__device__ __forceinline__ void gla_p1(const Cx& p, LAS unsigned char* lds, int layer, int b) {
    const int tid = p.tid, lane = tid & 63, wave = __builtin_amdgcn_readfirstlane(tid >> 6), fr = lane & 15, fq = lane >> 4;
    LAS unsigned char* ksT = lds; LAS unsigned char* vT = lds + 64 * TS; LAS float* gs = (LAS float*)(lds + 2 * 64 * TS); LAS float* glb = gs + 512;
    const bf16_t* proj = WSP(bf16_t, WS_PROJ); const int mt = wave >> 1, nt0 = (wave & 1) * 2; const int cl = lane, tg = wave;
    float w2[16], gb; unsigned gw; bf16_t kq[8], vq[8];
#define GLA1_LOAD(uu) do { const int tb_ = (uu) >> 3, h_ = ((uu) >> 1) & 3, d_ = (uu) & 1, c_ = 64 * h_ + cl; const bf16_t* pr_ = proj + (size_t)tb_row0(b, tb_) * NPROJ; \
        _Pragma("unroll") for (int r = 0; r < 16; ++r) w2[r] = PIN(I_GLA_W2)[((size_t)(layer * 2 + d_) * 16 + r) * 256 + c_]; \
        gb = PIN(I_GLA_B)[(layer * 2 + d_) * 256 + c_]; \
        { const int e = tid * 2, i = e >> 4, r = e & 15; gw = *(const unsigned*)(pr_ + (size_t)i * NPROJ + (d_ ? PA_GB : PA_GF) + r); } \
        _Pragma("unroll") for (int i8 = 0; i8 < 8; ++i8) { const bf16_t* pa = pr_ + (size_t)(8 * tg + i8) * NPROJ; kq[i8] = pa[PA_K + c_]; vq[i8] = pa[PA_V + c_]; } } while (0)
    int u = (p.bid + p.G) % p.G;
    if (u < NUNIT) GLA1_LOAD(u);
    for (; u < NUNIT; u += p.G) { const int d = u & 1;
        glb[tid * 2] = __uint_as_float(gw << 16); glb[tid * 2 + 1] = __uint_as_float(gw & 0xffff0000u);
        __syncthreads();
        float bl[8]; float run = 0.f;
#pragma unroll
        for (int ii = 0; ii < 8; ++ii) { const int i8 = d ? 7 - ii : ii; const LAS float* gl_ = glb + (8 * tg + i8) * 16; float z = gb;
#pragma unroll
            for (int r = 0; r < 16; ++r) z += gl_[r] * w2[r];
            run += logsigmoidf_(z) * (1.0f / 16.0f); if (d) bl[7 - ii] = run; else bl[ii] = run; }
        gs[tg * 64 + cl] = run;
        __syncthreads();
        float off = 0.f, total = 0.f;
#pragma unroll
        for (int g2 = 0; g2 < 8; ++g2) { const float t = gs[g2 * 64 + cl]; total += t; if (d ? g2 > tg : g2 < tg) off += t; }
#pragma unroll
        for (int i8 = 0; i8 < 8; i8 += 2) { const int i = 8 * tg + i8;
            const float ka = bf2f(kq[i8]) * __expf(total - (bl[i8] + off)), kb = bf2f(kq[i8 + 1]) * __expf(total - (bl[i8 + 1] + off));
            *(LAS unsigned*)(ksT + cl * TS + i * 2) = pk2(ka, kb); *(LAS unsigned*)(vT + cl * TS + i * 2) = (unsigned)vq[i8] | ((unsigned)vq[i8 + 1] << 16); }
        if (u + p.G < NUNIT) GLA1_LOAD(u + p.G);
        if (tg == 0) WSP(float, SC_GLA_DEC)[(size_t)u * 64 + cl] = __expf(total);
        __syncthreads();
        { f32x4 acc[2] = {(f32x4){0.f, 0.f, 0.f, 0.f}, (f32x4){0.f, 0.f, 0.f, 0.f}}; float* kv = WSP(float, SC_GLA_S) + (size_t)u * 4096;
          mm_rows<64, 2>(ksT, TS, vT, TS, mt, nt0, fr, fq, acc);
#pragma unroll
          for (int t = 0; t < 2; ++t)
#pragma unroll
              for (int j = 0; j < 4; ++j) kv[(16 * mt + 4 * fq + j) * 64 + 16 * (nt0 + t) + fr] = acc[t][j]; }
        __syncthreads();
    }
#undef GLA1_LOAD
}
__device__ __forceinline__ void gla_chain(const Cx& p, int h, int d, int part) {
    if (p.tid >= 256) return;
    const int e0 = part * 1024 + p.tid * 4, dk = e0 >> 6;
    f32x4 s0 = (f32x4){0.f, 0.f, 0.f, 0.f};
    f32x4 n0[6]; float dc[6];
#define GC_LD(q, n_) do { const int u_ = (chain_tb((n_), d) * 4 + h) * 2 + d; n0[q] = *(const f32x4*)(WSP(float, SC_GLA_S) + (size_t)u_ * 4096 + e0); dc[q] = WSP(float, SC_GLA_DEC)[(size_t)u_ * 64 + dk]; } while (0)
#define GC_ST(q, n_) do { const int u_ = (chain_tb((n_), d) * 4 + h) * 2 + d; float* k_ = WSP(float, SC_GLA_S) + (size_t)u_ * 4096 + e0; \
        const f32x4 a0_ = n0[q]; const float de_ = dc[q]; if ((n_) + 6 < NTB) GC_LD(q, (n_) + 6); *(f32x4*)k_ = s0; s0 = s0 * de_ + a0_; } while (0)
    GC_LD(0, 0); GC_LD(1, 1); GC_LD(2, 2); GC_LD(3, 3); GC_LD(4, 4); GC_LD(5, 5);
#pragma unroll 1
    for (int n = 0; n < NTB; n += 6) { GC_ST(0, n); GC_ST(1, n + 1); GC_ST(2, n + 2); GC_ST(3, n + 3); GC_ST(4, n + 4); GC_ST(5, n + 5); }
#undef GC_LD
#undef GC_ST
}
__device__ __forceinline__ void gla_p2(const Cx& p, LAS unsigned char* lds, int layer, int b) {
    const int tid = p.tid, lane = tid & 63, wave = __builtin_amdgcn_readfirstlane(tid >> 6), fr = lane & 15, fq = lane >> 4;
    LAS unsigned char* qt = lds; LAS unsigned char* kt = lds + 64 * TS; LAS unsigned char* vT = lds + 2 * 64 * TS; LAS unsigned char* sT = lds + 3 * 64 * TS; LAS unsigned char* att = lds + 4 * 64 * TS;
    LAS float* gs = (LAS float*)(lds + 5 * 64 * TS); LAS float* glb = gs + 512;
    const bf16_t* proj = WSP(bf16_t, WS_PROJ); const int cl = lane, tg = wave;
    float w2[16], gb; unsigned gw; bf16_t qq[8], kq[8], vq[8]; float sq[8];
#define GLA2_LOAD(uu) do { const int tb_ = (uu) >> 3, h_ = ((uu) >> 1) & 3, d_ = (uu) & 1, c_ = 64 * h_ + cl; const bf16_t* pr_ = proj + (size_t)tb_row0(b, tb_) * NPROJ; \
        _Pragma("unroll") for (int r = 0; r < 16; ++r) w2[r] = PIN(I_GLA_W2)[((size_t)(layer * 2 + d_) * 16 + r) * 256 + c_]; \
        gb = PIN(I_GLA_B)[(layer * 2 + d_) * 256 + c_]; \
        { const int e = tid * 2, i = e >> 4, r = e & 15; gw = *(const unsigned*)(pr_ + (size_t)i * NPROJ + (d_ ? PA_GB : PA_GF) + r); } \
        _Pragma("unroll") for (int i8 = 0; i8 < 8; ++i8) { const bf16_t* pa = pr_ + (size_t)(8 * tg + i8) * NPROJ; qq[i8] = pa[PA_Q + c_]; kq[i8] = pa[PA_K + c_]; vq[i8] = pa[PA_V + c_]; } \
        { const float* sp_ = WSP(float, SC_GLA_S) + (size_t)(uu) * 4096; _Pragma("unroll") for (int q = 0; q < 8; ++q) sq[q] = sp_[tid + NTHR * q]; } } while (0)
    int u = (p.bid + p.G - (128 % p.G)) % p.G;
    if (u < NUNIT) GLA2_LOAD(u);
    for (; u < NUNIT; u += p.G) { const int tb = u >> 3, h = (u >> 1) & 3, d = u & 1; const int s0 = 64 * tb;
        glb[tid * 2] = __uint_as_float(gw << 16); glb[tid * 2 + 1] = __uint_as_float(gw & 0xffff0000u);
#pragma unroll
        for (int q = 0; q < 8; ++q) { const int e = tid + NTHR * q, dk = e >> 6, dv = e & 63; *(LAS bf16_t*)(sT + dv * TS + dk * 2) = (bf16_t)f2bf(sq[q]); }
        __syncthreads();
        float bl[8]; float run = 0.f;
#pragma unroll
        for (int ii = 0; ii < 8; ++ii) { const int i8 = d ? 7 - ii : ii; const LAS float* gl_ = glb + (8 * tg + i8) * 16; float z = gb;
#pragma unroll
            for (int r = 0; r < 16; ++r) z += gl_[r] * w2[r];
            run += logsigmoidf_(z) * (1.0f / 16.0f); if (d) bl[7 - ii] = run; else bl[ii] = run; }
        gs[tg * 64 + cl] = run;
        __syncthreads();
        float off = 0.f;
#pragma unroll
        for (int g2 = 0; g2 < 8; ++g2) if (d ? g2 > tg : g2 < tg) off += gs[g2 * 64 + cl];
#pragma unroll
        for (int i8 = 0; i8 < 8; ++i8) { const int i = 8 * tg + i8; const float bi = bl[i8] + off;
            *(LAS bf16_t*)(qt + i * TS + cl * 2) = (bf16_t)f2bf(bf2f(qq[i8]) * 0.125f * __expf(bi));
            *(LAS bf16_t*)(kt + i * TS + cl * 2) = (bf16_t)f2bf(bf2f(kq[i8]) * __expf(-bi));
            *(LAS bf16_t*)(vT + cl * TS + i * 2) = vq[i8]; }
        if (u + p.G < NUNIT) GLA2_LOAD(u + p.G);
        __syncthreads();
        const int mt = wave >> 1, nt0 = (wave & 1) * 2;
        { f32x4 acc[2] = {(f32x4){0.f, 0.f, 0.f, 0.f}, (f32x4){0.f, 0.f, 0.f, 0.f}};
          mm_rows<64, 2>(qt, TS, kt, TS, mt, nt0, fr, fq, acc);
#pragma unroll
          for (int t = 0; t < 2; ++t)
#pragma unroll
              for (int j = 0; j < 4; ++j) { const int i = 16 * mt + 4 * fq + j, jj = 16 * (nt0 + t) + fr; const bool keep = d ? jj >= i : jj <= i;
                  *(LAS bf16_t*)(att + i * TS + jj * 2) = (bf16_t)f2bf(keep ? acc[t][j] : 0.f); } }
        __syncthreads();
        { f32x4 acc[2] = {(f32x4){0.f, 0.f, 0.f, 0.f}, (f32x4){0.f, 0.f, 0.f, 0.f}};
          mm_rows<64, 2>(att, TS, vT, TS, mt, nt0, fr, fq, acc);
          mm_rows<64, 2>(qt, TS, sT, TS, mt, nt0, fr, fq, acc);
          bf16_t* ob = WSP(bf16_t, d ? SC_OB : SC_OF);
#pragma unroll
          for (int t = 0; t < 2; ++t)
#pragma unroll
              for (int j = 0; j < 4; ++j) ob[(size_t)(s0 + 16 * mt + 4 * fq + j) * 1024 + 64 * h + 16 * (nt0 + t) + fr] = (bf16_t)f2bf(acc[t][j]); }
        __syncthreads();
    }
}
#undef GLA2_LOAD
constexpr int TS2 = 272;
__device__ __forceinline__ float ssd_acum(float a, int d, int lane, float& total) {
    float pre = a;
#pragma unroll
    for (int o = 1; o < 64; o <<= 1) { const float t = shup_(pre, lane, o); if (lane >= o) pre += t; }
    total = rl(pre, 63);
    return d ? total - pre + a : pre;
}
__device__ __forceinline__ void ssd_p1(const Cx& p, LAS unsigned char* lds, int layer, int b) {
    const int tid = p.tid, lane = tid & 63, wave = __builtin_amdgcn_readfirstlane(tid >> 6), fr = lane & 15, fq = lane >> 4;
    LAS unsigned char* BT = lds; LAS unsigned char* xT = lds + 128 * TS; LAS float* AC = (LAS float*)(lds + 128 * TS + 64 * TS);
    u32x4 bq[2], xq; float dtq;
#define SSD1_LOAD(uu) do { const int tb_ = (uu) >> 3, g_ = ((uu) >> 2) & 1, hd_ = (uu) & 3, h_ = 2 * g_ + (hd_ >> 1), d_ = hd_ & 1; \
        const bf16_t* sx_ = WSP(bf16_t, SC_SX) + (size_t)(64 * tb_ + lane) * 768; \
        bq[0] = *(const u32x4*)(sx_ + 256 + 128 * g_ + 16 * wave); bq[1] = *(const u32x4*)(sx_ + 256 + 128 * g_ + 16 * wave + 8); \
        xq = *(const u32x4*)(sx_ + 64 * h_ + 8 * wave); dtq = WSP(float, SC_SDT)[(size_t)(64 * tb_ + lane) * 8 + d_ * 4 + h_]; } while (0)
    int u3 = (p.bid + p.G - (32 % p.G)) % p.G;
    if (u3 < NTB * 8) SSD1_LOAD(u3);
    for (; u3 < NTB * 8; u3 += p.G) { const int tb = u3 >> 3, g = (u3 >> 2) & 1, hd = u3 & 3, h = 2 * g + (hd >> 1), d = hd & 1;
        if (wave == 0) { const float aneg = -__expf(PIN(I_SS_ALOG)[(layer * 2 + d) * 4 + h]);
            float tot; const float ac = ssd_acum(aneg * dtq, d, lane, tot); AC[lane] = ac; if (lane == 0) { AC[64] = tot; WSP(float, SC_SSD_CD)[(tb * 4 + h) * 2 + d] = __expf(tot); } }
#pragma unroll
        for (int q = 0; q < 2; ++q)
#pragma unroll
            for (int k = 0; k < 8; ++k) *(LAS bf16_t*)(BT + (16 * wave + 8 * q + k) * TS + lane * 2) = (bf16_t)(bq[q][k >> 1] >> (16 * (k & 1)));
        __syncthreads();
        { const float f = dtq * __expf(AC[64] - AC[lane]);
#pragma unroll
          for (int k = 0; k < 8; ++k) *(LAS bf16_t*)(xT + (8 * wave + k) * TS + lane * 2) = (bf16_t)f2bf(bf2f((bf16_t)(xq[k >> 1] >> (16 * (k & 1)))) * f); }
        if (u3 + p.G < NTB * 8) SSD1_LOAD(u3 + p.G);
        __syncthreads();
        { const int mt = wave >> 1, nt0 = (wave & 1) * 4; float* cs = WSP(float, SC_SSD_S) + (size_t)((tb * 4 + h) * 2 + d) * 8192; f32x4 acc[4];
#pragma unroll
          for (int t = 0; t < 4; ++t) acc[t] = (f32x4){0.f, 0.f, 0.f, 0.f};
          mm_rows<64, 4>(xT, TS, BT, TS, mt, nt0, fr, fq, acc);
#pragma unroll
          for (int t = 0; t < 4; ++t)
#pragma unroll
              for (int j = 0; j < 4; ++j) cs[(16 * mt + 4 * fq + j) * 128 + 16 * (nt0 + t) + fr] = acc[t][j]; }
        __syncthreads();
    }
#undef SSD1_LOAD
}
__device__ __forceinline__ void ssd_chain(const Cx& p, int h, int d, int part) {
    if (p.tid >= 256) return;
    const int e0 = part * 1024 + p.tid * 4;
    f32x4 s = (f32x4){0.f, 0.f, 0.f, 0.f}; f32x4 nx[6]; float cd[6];
#define SC_LD(q, n_) do { const int u_ = (chain_tb((n_), d) * 4 + h) * 2 + d; nx[q] = *(const f32x4*)(WSP(float, SC_SSD_S) + (size_t)u_ * 8192 + e0); cd[q] = WSP(float, SC_SSD_CD)[u_]; } while (0)
#define SC_ST(q, n_) do { const int u_ = (chain_tb((n_), d) * 4 + h) * 2 + d; float* c_ = WSP(float, SC_SSD_S) + (size_t)u_ * 8192 + e0; const f32x4 a_ = nx[q]; const float de_ = cd[q]; \
        if ((n_) + 6 < NTB) SC_LD(q, (n_) + 6); *(f32x4*)c_ = s; s = s * de_ + a_; } while (0)
    SC_LD(0, 0); SC_LD(1, 1); SC_LD(2, 2); SC_LD(3, 3); SC_LD(4, 4); SC_LD(5, 5);
#pragma unroll 1
    for (int n = 0; n < NTB; n += 6) { SC_ST(0, n); SC_ST(1, n + 1); SC_ST(2, n + 2); SC_ST(3, n + 3); SC_ST(4, n + 4); SC_ST(5, n + 5); }
#undef SC_LD
#undef SC_ST
}
__device__ __forceinline__ void ssd_p2(const Cx& p, LAS unsigned char* lds, int layer, int b) {
    const int tid = p.tid, lane = tid & 63, wave = __builtin_amdgcn_readfirstlane(tid >> 6), fr = lane & 15, fq = lane >> 4;
    LAS unsigned char* Ct = lds; LAS unsigned char* Bt2 = lds + 64 * TS2; LAS float* cb = (LAS float*)(lds + 2 * 64 * TS2); LAS float* AC = cb + 64 * 65;
    LAS unsigned char* Mt = (LAS unsigned char*)(AC + 64 + 4); LAS unsigned char* xT = Mt + 64 * TS; LAS unsigned char* Sb = xT + 64 * TS;
    const int mt = wave >> 1, nt0 = (wave & 1) * 2;
    u32x4 cq[2], bq[2], xq; float dtq; f32x4 sq[4];
#define SSD2_LOAD(uu) do { const int tb_ = (uu) >> 3, g_ = ((uu) >> 2) & 1, hd_ = (uu) & 3, h_ = 2 * g_ + (hd_ >> 1), d_ = hd_ & 1; \
        const bf16_t* sx_ = WSP(bf16_t, SC_SX) + (size_t)(64 * tb_) * 768; \
        _Pragma("unroll") for (int q = 0; q < 2; ++q) { const int e = tid + NTHR * q, i = e >> 4, ch = e & 15; \
            cq[q] = *(const u32x4*)(sx_ + (size_t)i * 768 + 512 + 128 * g_ + ch * 8); bq[q] = *(const u32x4*)(sx_ + (size_t)i * 768 + 256 + 128 * g_ + ch * 8); } \
        xq = *(const u32x4*)(sx_ + (size_t)lane * 768 + 64 * h_ + 8 * wave); dtq = WSP(float, SC_SDT)[(size_t)(64 * tb_ + lane) * 8 + d_ * 4 + h_]; \
        const float* sp_ = WSP(float, SC_SSD_S) + (size_t)((tb_ * 4 + h_) * 2 + d_) * 8192; \
        _Pragma("unroll") for (int q = 0; q < 4; ++q) sq[q] = *(const f32x4*)(sp_ + (tid + NTHR * q) * 4); } while (0)
    int u3 = (p.bid + p.G - (160 % p.G)) % p.G;
    if (u3 < NTB * 8) SSD2_LOAD(u3);
    for (; u3 < NTB * 8; u3 += p.G) { const int tb = u3 >> 3, g = (u3 >> 2) & 1, hd = u3 & 3, h = 2 * g + (hd >> 1), d = hd & 1, s0 = 64 * tb; (void)g;
        if (wave == 0) { const float aneg = -__expf(PIN(I_SS_ALOG)[(layer * 2 + d) * 4 + h]); float tot; AC[lane] = ssd_acum(aneg * dtq, d, lane, tot); }
#pragma unroll
        for (int q = 0; q < 2; ++q) { const int e = tid + NTHR * q, i = e >> 4, ch = e & 15;
            *(LAS u32x4*)(Ct + i * TS2 + ch * 16) = cq[q]; *(LAS u32x4*)(Bt2 + i * TS2 + ch * 16) = bq[q]; }
#pragma unroll
        for (int k = 0; k < 8; ++k) *(LAS bf16_t*)(xT + (8 * wave + k) * TS + lane * 2) = (bf16_t)f2bf(bf2f((bf16_t)(xq[k >> 1] >> (16 * (k & 1)))) * dtq);
#pragma unroll
        for (int q = 0; q < 4; ++q) { const int e = (tid + NTHR * q) * 4, pp = e >> 7, s = e & 127; const f32x4 v = sq[q];
            *(LAS u32x2*)(Sb + pp * TS2 + s * 2) = (u32x2){pk2(v[0], v[1]), pk2(v[2], v[3])}; }
        if (u3 + p.G < NTB * 8) SSD2_LOAD(u3 + p.G);
        __syncthreads();
        { f32x4 acc[2] = {(f32x4){0.f, 0.f, 0.f, 0.f}, (f32x4){0.f, 0.f, 0.f, 0.f}};
          mm_rows<128, 2>(Ct, TS2, Bt2, TS2, mt, nt0, fr, fq, acc);
#pragma unroll
          for (int t = 0; t < 2; ++t)
#pragma unroll
              for (int j = 0; j < 4; ++j) cb[(16 * mt + 4 * fq + j) * 65 + 16 * (nt0 + t) + fr] = acc[t][j]; }
        __syncthreads();
        { const int i = tid >> 3, j0 = (tid & 7) * 8; const float ai = AC[i]; unsigned w[4];
#pragma unroll
          for (int jj = 0; jj < 8; jj += 2) { float m[2];
#pragma unroll
              for (int q = 0; q < 2; ++q) { const int j = j0 + jj + q; const bool keep = d ? j >= i : j <= i; const float cv = cb[i * 65 + j], aj = AC[j]; m[q] = keep ? cv * __expf(ai - aj) : 0.f; }
              w[jj >> 1] = pk2(m[0], m[1]); }
          *(LAS u32x4*)(Mt + i * TS + j0 * 2) = (u32x4){w[0], w[1], w[2], w[3]}; }
        __syncthreads();
        { f32x4 acc[2] = {(f32x4){0.f, 0.f, 0.f, 0.f}, (f32x4){0.f, 0.f, 0.f, 0.f}};
          mm_rows<128, 2>(Ct, TS2, Sb, TS2, mt, nt0, fr, fq, acc);
#pragma unroll
          for (int j = 0; j < 4; ++j) { const float sc = __expf(AC[16 * mt + 4 * fq + j]); acc[0][j] *= sc; acc[1][j] *= sc; }
          mm_rows<64, 2>(Mt, TS, xT, TS, mt, nt0, fr, fq, acc);
          bf16_t* ob = WSP(bf16_t, d ? SC_OB : SC_OF);
#pragma unroll
          for (int t = 0; t < 2; ++t)
#pragma unroll
              for (int j = 0; j < 4; ++j) ob[(size_t)(s0 + 16 * mt + 4 * fq + j) * 1024 + 512 + 64 * h + 16 * (nt0 + t) + fr] = (bf16_t)f2bf(acc[t][j]); }
        __syncthreads();
    }
}
#undef SSD2_LOAD
constexpr int AFS = 68;
__device__ __forceinline__ int dr_mfrag_idx(int row, int col) { return (((row >> 4) * 2 + (col >> 5)) * 64 + ((col >> 2) & 3) * 16 + (row & 15)) * 8 + ((col >> 4) & 1) * 4 + (col & 3); }
template <class RhsF> __device__ __forceinline__ void dr_block_solve(const LAS unsigned char* Abf, const LAS float* AfT, LAS unsigned char* XT, LAS float* Dbuf, const float sgn, const int wave, const RhsF& rhs, bf16_t* wu) {
    LAS unsigned char* TI = (LAS unsigned char*)Dbuf;
    if (wave == 0) { const int lane = lane_id_asm(), kb_ = lane >> 4, cc = lane & 15; float x[16];
#pragma unroll
        for (int i = 0; i < 16; ++i) x[i] = i == cc ? 1.f : 0.f;
        const LAS float* Ab = AfT + (16 * kb_) * AFS + 16 * kb_;
#pragma unroll
        for (int j = 0; j < 15; ++j) { const float xj = sgn * x[j];
#pragma unroll
            for (int i = j + 1; i < 16; ++i) x[i] -= Ab[j * AFS + i] * xj; }
#pragma unroll
        for (int i = 0; i < 16; ++i) *(LAS bf16_t*)(TI + ((kb_ * 16 + i) * 16 + cc) * 2) = (bf16_t)f2bf(x[i]); }
    __syncthreads();
    { const int lane = lane_id_asm(), fr = lane & 15, fq = lane >> 4, col = 16 * wave + fr; u32x4 bx[2] = {(u32x4){0u, 0u, 0u, 0u}, (u32x4){0u, 0u, 0u, 0u}};
#pragma unroll
      for (int k = 0; k < 4; ++k) { f32x4 acc = (f32x4){0.f, 0.f, 0.f, 0.f};
#pragma unroll
          for (int ks = 0; ks < 2; ++ks) if (k > 2 * ks) { const u32x2 a0 = *(const LAS u32x2*)(Abf + (16 * k + fr) * TS + (32 * ks + 4 * fq) * 2), a1 = *(const LAS u32x2*)(Abf + (16 * k + fr) * TS + (32 * ks + 16 + 4 * fq) * 2);
              acc = __builtin_amdgcn_mfma_f32_16x16x32_bf16(__builtin_bit_cast(bf16x8, (u32x4){a0[0], a0[1], a1[0], a1[1]}), __builtin_bit_cast(bf16x8, bx[ks]), acc, 0, 0, 0); }
          float dd[4];
#pragma unroll
          for (int j = 0; j < 4; ++j) dd[j] = rhs(16 * k + 4 * fq + j, col) - sgn * acc[j];
          const u32x2 t2 = *(const LAS u32x2*)(TI + ((k * 16 + fr) * 16 + 4 * fq) * 2);
          const f32x4 xk = __builtin_amdgcn_mfma_f32_16x16x32_bf16(__builtin_bit_cast(bf16x8, (u32x4){t2[0], t2[1], 0u, 0u}), __builtin_bit_cast(bf16x8, (u32x4){pk2(dd[0], dd[1]), pk2(dd[2], dd[3]), 0u, 0u}), (f32x4){0.f, 0.f, 0.f, 0.f}, 0, 0, 0);
          const unsigned p0 = pk2(xk[0], xk[1]), p1 = pk2(xk[2], xk[3]);
          bx[k >> 1][(k & 1) * 2] = p0; bx[k >> 1][(k & 1) * 2 + 1] = p1;
          *(LAS u32x2*)(XT + col * TS + (16 * k + 4 * fq) * 2) = (u32x2){p0, p1};
#pragma unroll
          for (int j = 0; j < 4; ++j) wu[(16 * k + 4 * fq + j) * 128 + col] = (bf16_t)f2bf(xk[j]); } }
    __syncthreads();
}
struct GdnRhs { const LAS unsigned char* kb; const LAS unsigned char* vb; const LAS float* GC;
    __device__ __forceinline__ float operator()(int r, int col) const { return col < 64 ? bf2f(*(const LAS bf16_t*)(kb + r * TS + col * 2)) * __expf(GC[r]) : bf2f(*(const LAS bf16_t*)(vb + r * TS + (col - 64) * 2)); } };
__device__ __forceinline__ void gdn_p1(const Cx& p, LAS unsigned char* lds, int layer, int b) {
    const int wave = __builtin_amdgcn_readfirstlane(p.tid >> 6);
#define GDN_LANES const int lane = lane_id_asm(), tid = wave * 64 + lane, fr = lane & 15, fq = lane >> 4; (void)tid; (void)fr; (void)fq
    LAS unsigned char* kh = lds; LAS unsigned char* kb = lds + 64 * TS; LAS unsigned char* vb = lds + 2 * 64 * TS; LAS unsigned char* Abf = lds + 3 * 64 * TS; LAS unsigned char* kdT = lds + 4 * 64 * TS; LAS unsigned char* XT = lds + 5 * 64 * TS;
    LAS float* Af = (LAS float*)(lds + 7 * 64 * TS); LAS float* Dbuf = Af + 64 * AFS; LAS float* GC = Dbuf + 128 * 20;
    const int mt = wave >> 1, nt0 = (wave & 1) * 2;
    float gq, beta; u32x4 kv, vv;
#define GDN1_LOAD(uu) do { const int tb_ = (uu) >> 3, h_ = ((uu) >> 1) & 3, d_ = (uu) & 1; const int lane_ = lane_id_asm(), tid_ = wave * 64 + lane_; \
        const bf16_t* dq_ = WSP(bf16_t, SC_DQ) + (size_t)(64 * tb_) * 768; const float* dg_ = WSP(float, SC_DG) + (size_t)(64 * tb_) * 16; \
        gq = dg_[(d_ ? 63 - lane_ : lane_) * 16 + 8 + d_ * 4 + h_]; \
        { const int r_ = tid_ >> 3, c0_ = (tid_ & 7) * 8, i_ = d_ ? 63 - r_ : r_; beta = dg_[i_ * 16 + d_ * 4 + h_]; \
          kv = *(const u32x4*)(dq_ + (size_t)i_ * 768 + 256 + 64 * h_ + c0_); vv = *(const u32x4*)(dq_ + (size_t)i_ * 768 + 512 + 64 * h_ + c0_); } } while (0)
    int u = (p.bid + p.G - (64 % p.G)) % p.G;
    if (u < NUNIT) GDN1_LOAD(u);
    for (; u < NUNIT; u += p.G) {
        if (wave == 0) { GDN_LANES; float pre = gq;
#pragma unroll
            for (int o = 1; o < 64; o <<= 1) { const float t = shup_(pre, lane, o); if (lane >= o) pre += t; }
            GC[lane] = pre; }
        { GDN_LANES; const int r = tid >> 3, c0 = (tid & 7) * 8; u32x4 kw, vw;
#pragma unroll
          for (int q = 0; q < 4; ++q) { kw[q] = pk2(__uint_as_float(kv[q] << 16) * beta, __uint_as_float(kv[q] & 0xffff0000u) * beta); vw[q] = pk2(__uint_as_float(vv[q] << 16) * beta, __uint_as_float(vv[q] & 0xffff0000u) * beta); }
          *(LAS u32x4*)(kh + r * TS + c0 * 2) = kv; *(LAS u32x4*)(kb + r * TS + c0 * 2) = kw; *(LAS u32x4*)(vb + r * TS + c0 * 2) = vw;
          *(LAS u32x4*)(XT + (2 * r) * TS + c0 * 2) = (u32x4){0u, 0u, 0u, 0u}; *(LAS u32x4*)(XT + (2 * r + 1) * TS + c0 * 2) = (u32x4){0u, 0u, 0u, 0u}; }
        if (u + p.G < NUNIT) GDN1_LOAD(u + p.G);
        __syncthreads();
        const float gtot = GC[63];
        { GDN_LANES; f32x4 acc[2] = {(f32x4){0.f, 0.f, 0.f, 0.f}, (f32x4){0.f, 0.f, 0.f, 0.f}};
          mm_rows<64, 2>(kb, TS, kh, TS, mt, nt0, fr, fq, acc);
          float gr[4], gj[2];
#pragma unroll
          for (int j = 0; j < 4; ++j) gr[j] = GC[16 * mt + 4 * fq + j];
#pragma unroll
          for (int t = 0; t < 2; ++t) gj[t] = GC[16 * (nt0 + t) + fr];
#pragma unroll
          for (int t = 0; t < 2; ++t)
#pragma unroll
              for (int j = 0; j < 4; ++j) { const int r = 16 * mt + 4 * fq + j, jj = 16 * (nt0 + t) + fr; const float a = jj < r ? acc[t][j] * __expf(gr[j] - gj[t]) : 0.f;
                  Af[jj * AFS + r] = a; *(LAS bf16_t*)(Abf + r * TS + jj * 2) = (bf16_t)f2bf(a); }
#pragma unroll 2
          for (int q = 0; q < 8; ++q) { const int e = tid + NTHR * q, r = e >> 6, cc = e & 63;
              *(LAS bf16_t*)(kdT + cc * TS + r * 2) = (bf16_t)f2bf(bf2f(*(const LAS bf16_t*)(kh + r * TS + cc * 2)) * __expf(gtot - GC[r])); } }
        __syncthreads();
        { const GdnRhs rhs{kb, vb, GC}; dr_block_solve(Abf, Af, XT, Dbuf, 1.0f, wave, rhs, WSP(bf16_t, SC_DR_WU) + (size_t)u * 8192); }
        { GDN_LANES; f32x4 am[2] = {(f32x4){0.f, 0.f, 0.f, 0.f}, (f32x4){0.f, 0.f, 0.f, 0.f}}, an[2] = {(f32x4){0.f, 0.f, 0.f, 0.f}, (f32x4){0.f, 0.f, 0.f, 0.f}};
          mm_rows<64, 2>(kdT, TS, XT, TS, mt, nt0, fr, fq, am);
          mm_rows<64, 2>(kdT, TS, XT + 64 * TS, TS, mt, nt0, fr, fq, an);
          bf16_t* Mg = WSP(bf16_t, SC_DR_M) + (size_t)u * 4096; bf16_t* Ng = WSP(bf16_t, SC_DR_NS) + (size_t)u * 4096; const float eg = __expf(gtot);
#pragma unroll
          for (int t = 0; t < 2; ++t) {
#pragma unroll
              for (int j = 0; j < 4; ++j) { const int row = 16 * mt + 4 * fq + j, col = 16 * (nt0 + t) + fr; Mg[dr_mfrag_idx(row, col)] = (bf16_t)f2bf((row == col ? eg : 0.f) - am[t][j]); }
              *(u32x2*)(Ng + (((nt0 + t) * 4 + mt) * 64 + lane) * 4) = (u32x2){pk2(an[t][0], an[t][1]), pk2(an[t][2], an[t][3])}; } }
        __syncthreads();
    }
#undef GDN_LANES
#undef GDN1_LOAD
}
__device__ __forceinline__ void dr_chain(const Cx& p, size_t offM, size_t offNS, int h, int d, int cb) {
    const int lane = p.tid & 63, fr = lane & 15, fq = lane >> 4;
    if (p.tid >= 64) return;
    f32x4 acc[4];
#pragma unroll
    for (int t = 0; t < 4; ++t) acc[t] = (f32x4){0.f, 0.f, 0.f, 0.f};
    bf16x8 mR[4][4][2]; u32x2 nR[4][4];
#define DR_LD(m, nn, n_) do { const int u_ = (chain_tb((n_), d) * 4 + h) * 2 + d; const bf16_t* M_ = WSP(bf16_t, offM) + (size_t)u_ * 4096; const bf16_t* N_ = WSP(bf16_t, offNS) + (size_t)u_ * 4096; \
        _Pragma("unroll") for (int t = 0; t < 4; ++t) { _Pragma("unroll") for (int ks = 0; ks < 2; ++ks) m[t][ks] = *(const bf16x8*)(M_ + ((t * 2 + ks) * 64 + lane) * 8); nn[t] = *(const u32x2*)(N_ + ((cb * 4 + t) * 64 + lane) * 4); } } while (0)
#define DR_STEP(m, nn, n_) do { const int u_ = (chain_tb((n_), d) * 4 + h) * 2 + d; bf16_t* ST_ = WSP(bf16_t, offNS) + (size_t)u_ * 4096 + (16 * cb + fr) * 64 + 4 * fq; \
        u32x2 sp_[4]; _Pragma("unroll") for (int t = 0; t < 4; ++t) { sp_[t] = (u32x2){pk2(acc[t][0], acc[t][1]), pk2(acc[t][2], acc[t][3])}; *(u32x2*)(ST_ + 16 * t) = sp_[t]; } \
        bf16x8 bf_[2]; _Pragma("unroll") for (int ks = 0; ks < 2; ++ks) { u32x4 w_ = (u32x4){sp_[2 * ks][0], sp_[2 * ks][1], sp_[2 * ks + 1][0], sp_[2 * ks + 1][1]}; bf_[ks] = __builtin_bit_cast(bf16x8, w_); } \
        _Pragma("unroll") for (int t = 0; t < 4; ++t) { f32x4 a_ = (f32x4){__uint_as_float(nn[t][0] << 16), __uint_as_float(nn[t][0] & 0xffff0000u), __uint_as_float(nn[t][1] << 16), __uint_as_float(nn[t][1] & 0xffff0000u)}; \
            a_ = __builtin_amdgcn_mfma_f32_16x16x32_bf16(m[t][0], bf_[0], a_, 0, 0, 0); acc[t] = __builtin_amdgcn_mfma_f32_16x16x32_bf16(m[t][1], bf_[1], a_, 0, 0, 0); } } while (0)
#define DR_GO(q, n_) do { DR_STEP(mR[q], nR[q], (n_)); if ((n_) + 4 < NTB) DR_LD(mR[q], nR[q], (n_) + 4); } while (0)
    DR_LD(mR[0], nR[0], 0); DR_LD(mR[1], nR[1], 1); DR_LD(mR[2], nR[2], 2); DR_LD(mR[3], nR[3], 3);
#pragma unroll 1
    for (int n = 0; n < NTB; n += 4) { DR_GO(0, n); DR_GO(1, n + 1); DR_GO(2, n + 2); DR_GO(3, n + 3); }
#undef DR_GO
#undef DR_LD
#undef DR_STEP
}
__device__ __forceinline__ void gdn_p2(const Cx& p, LAS unsigned char* lds, int layer, int b) {
    const int tid = p.tid, lane = tid & 63, wave = __builtin_amdgcn_readfirstlane(tid >> 6), fr = lane & 15, fq = lane >> 4;
    LAS unsigned char* qh = lds; LAS unsigned char* kh = lds + 64 * TS; LAS unsigned char* wt = lds + 2 * 64 * TS; LAS unsigned char* sT = lds + 3 * 64 * TS; LAS unsigned char* aq = lds + 4 * 64 * TS; LAS unsigned char* vnT = lds + 5 * 64 * TS;
    LAS float* GC = (LAS float*)(lds + 6 * 64 * TS);
    const int mt = wave >> 1, nt0 = (wave & 1) * 2;
    float gq; bf16_t upre[2][4]; u32x4 qv, kv, wv, sv;
#define GDN2_LOAD(uu) do { const int tb_ = (uu) >> 3, h_ = ((uu) >> 1) & 3, d_ = (uu) & 1; \
        const bf16_t* dq_ = WSP(bf16_t, SC_DQ) + (size_t)(64 * tb_) * 768; const float* dg_ = WSP(float, SC_DG) + (size_t)(64 * tb_) * 16; \
        const bf16_t* wu_ = WSP(bf16_t, SC_DR_WU) + (size_t)(uu) * 8192; const bf16_t* st_ = WSP(bf16_t, SC_DR_NS) + (size_t)(uu) * 4096; \
        gq = dg_[(d_ ? 63 - lane : lane) * 16 + 8 + d_ * 4 + h_]; \
        _Pragma("unroll") for (int t = 0; t < 2; ++t) { _Pragma("unroll") for (int j = 0; j < 4; ++j) upre[t][j] = wu_[(16 * mt + 4 * fq + j) * 128 + 64 + 16 * (nt0 + t) + fr]; } \
        { const int r_ = tid >> 3, c0_ = (tid & 7) * 8, i_ = d_ ? 63 - r_ : r_; \
          qv = *(const u32x4*)(dq_ + (size_t)i_ * 768 + 64 * h_ + c0_); kv = *(const u32x4*)(dq_ + (size_t)i_ * 768 + 256 + 64 * h_ + c0_); \
          wv = *(const u32x4*)(wu_ + r_ * 128 + c0_); sv = *(const u32x4*)(st_ + r_ * 64 + c0_); } } while (0)
    int u = (p.bid + p.G - (192 % p.G)) % p.G;
    if (u < NUNIT) GDN2_LOAD(u);
    for (; u < NUNIT; u += p.G) { const int tb = u >> 3, h = (u >> 1) & 3, d = u & 1, s0 = 64 * tb;
        if (wave == 0) { float pre = gq;
#pragma unroll
            for (int o = 1; o < 64; o <<= 1) { const float t = shup_(pre, lane, o); if (lane >= o) pre += t; }
            GC[lane] = pre; }
        bf16_t ucur[2][4];
#pragma unroll
        for (int t = 0; t < 2; ++t)
#pragma unroll
            for (int j = 0; j < 4; ++j) ucur[t][j] = upre[t][j];
        { const int r = tid >> 3, c0 = (tid & 7) * 8;
          *(LAS u32x4*)(qh + r * TS + c0 * 2) = qv; *(LAS u32x4*)(kh + r * TS + c0 * 2) = kv; *(LAS u32x4*)(wt + r * TS + c0 * 2) = wv; *(LAS u32x4*)(sT + r * TS + c0 * 2) = sv; }
        if (u + p.G < NUNIT) GDN2_LOAD(u + p.G);
        __syncthreads();
        { f32x4 acc[2] = {(f32x4){0.f, 0.f, 0.f, 0.f}, (f32x4){0.f, 0.f, 0.f, 0.f}};
          mm_rows<64, 2>(qh, TS, kh, TS, mt, nt0, fr, fq, acc);
          float gr[4], gj[2];
#pragma unroll
          for (int j = 0; j < 4; ++j) gr[j] = GC[16 * mt + 4 * fq + j];
#pragma unroll
          for (int t = 0; t < 2; ++t) gj[t] = GC[16 * (nt0 + t) + fr];
#pragma unroll
          for (int t = 0; t < 2; ++t)
#pragma unroll
              for (int j = 0; j < 4; ++j) { const int r = 16 * mt + 4 * fq + j, jj = 16 * (nt0 + t) + fr; *(LAS bf16_t*)(aq + r * TS + jj * 2) = (bf16_t)f2bf(jj <= r ? acc[t][j] * __expf(gr[j] - gj[t]) : 0.f); }
          f32x4 av[2] = {(f32x4){0.f, 0.f, 0.f, 0.f}, (f32x4){0.f, 0.f, 0.f, 0.f}};
          mm_rows<64, 2>(wt, TS, sT, TS, mt, nt0, fr, fq, av);
#pragma unroll
          for (int t = 0; t < 2; ++t) { const int dv = 16 * (nt0 + t) + fr; float vn[4];
#pragma unroll
              for (int j = 0; j < 4; ++j) vn[j] = bf2f(ucur[t][j]) - av[t][j];
              *(LAS u32x2*)(vnT + dv * TS + (16 * mt + 4 * fq) * 2) = (u32x2){pk2(vn[0], vn[1]), pk2(vn[2], vn[3])}; } }
        __syncthreads();
        { f32x4 acc[2] = {(f32x4){0.f, 0.f, 0.f, 0.f}, (f32x4){0.f, 0.f, 0.f, 0.f}};
          mm_rows<64, 2>(qh, TS, sT, TS, mt, nt0, fr, fq, acc);
#pragma unroll
          for (int j = 0; j < 4; ++j) { const float sc = __expf(GC[16 * mt + 4 * fq + j]); acc[0][j] *= sc; acc[1][j] *= sc; }
          mm_rows<64, 2>(aq, TS, vnT, TS, mt, nt0, fr, fq, acc);
          bf16_t* ob = WSP(bf16_t, d ? SC_OB : SC_OF);
#pragma unroll
          for (int t = 0; t < 2; ++t)
#pragma unroll
              for (int j = 0; j < 4; ++j) { const int r = 16 * mt + 4 * fq + j, i = d ? 63 - r : r; ob[(size_t)(s0 + i) * 1024 + 768 + 64 * h + 16 * (nt0 + t) + fr] = (bf16_t)f2bf(acc[t][j]); } }
        __syncthreads();
    }
}
#undef GDN2_LOAD
constexpr int LPS = 65;
#define RW_LP(LP, GS, lw8) do { const int lane_ = lane_id_asm(), c_ = lane_, tg_ = wave; float loc_[8]; float run_ = 0.f; \
        _Pragma("unroll") for (int ii = 0; ii < 8; ++ii) { run_ += (lw8)[ii]; loc_[ii] = run_; } \
        (GS)[tg_ * 64 + c_] = run_; __syncthreads(); float off_ = 0.f; \
        _Pragma("unroll") for (int g2 = 0; g2 < 8; ++g2) if (g2 < tg_) off_ += (GS)[g2 * 64 + c_]; \
        _Pragma("unroll") for (int ii = 0; ii < 8; ++ii) (LP)[(8 * tg_ + ii) * LPS + c_] = loc_[ii] + off_; __syncthreads(); } while (0)
struct RwRhs { const LAS unsigned char* zt; const LAS unsigned char* RU;
    __device__ __forceinline__ float operator()(int r, int col) const { return col < 64 ? bf2f(*(const LAS bf16_t*)(zt + r * TS + col * 2)) : bf2f(*(const LAS bf16_t*)(RU + (col - 64) * TS + r * 2)); } };
__device__ __forceinline__ void rw_p1(const Cx& p, LAS unsigned char* lds, int layer, int b) {
    const int wave = __builtin_amdgcn_readfirstlane(p.tid >> 6), mt = wave >> 1, nt0 = (wave & 1) * 2;
#define RW_LANES const int lane = lane_id_asm(), tid = wave * 64 + lane, fr = lane & 15, fq = lane >> 4; (void)tid; (void)fr; (void)fq
    LAS float* LP = (LAS float*)lds; LAS float* GS = (LAS float*)(lds + 16640);
    LAS unsigned char* zt = lds + 18688; LAS unsigned char* bt = lds + 27904; LAS unsigned char* kt = lds + 37120; LAS unsigned char* vT = lds + 46336; LAS unsigned char* Azk = lds + 55552;
    LAS float* Af = (LAS float*)(lds + 64768); LAS unsigned char* XT = lds + 82176; LAS unsigned char* Abf = lds + 100608; LAS unsigned char* RU = lds + 109824; LAS float* Dbuf = (LAS float*)(lds + 119040); LAS unsigned char* bhT = lds + 129280;
    const bf16_t* proj = WSP(bf16_t, WS_PROJ);
    float lw8[8]; f32x4 lwv[2], kkv[2], bv[2], kv[2]; bf16_t v8[8];
#define RW1_LOAD(uu) do { const int tb_ = (uu) >> 3, h_ = ((uu) >> 1) & 3, d_ = (uu) & 1, s0_ = 64 * tb_; const int lane_ = lane_id_asm(), tid_ = wave * 64 + lane_; \
        const float* lwp_ = WSP(float, SC_RLW) + (size_t)d_ * SB * 256 + (size_t)s0_ * 256 + 64 * h_; const size_t fo_ = (size_t)s0_ * 256 + 64 * h_; \
        _Pragma("unroll") for (int ii = 0; ii < 8; ++ii) { const int r_ = 8 * wave + ii; lw8[ii] = lwp_[(size_t)(d_ ? 63 - r_ : r_) * 256 + lane_]; } \
        { const int r_ = tid_ >> 3, c0_ = (tid_ & 7) * 8, i_ = d_ ? 63 - r_ : r_; \
          _Pragma("unroll") for (int q = 0; q < 2; ++q) { lwv[q] = *(const f32x4*)(lwp_ + (size_t)i_ * 256 + c0_ + 4 * q); kkv[q] = *(const f32x4*)(WSP(float, SC_RKK) + fo_ + (size_t)i_ * 256 + c0_ + 4 * q); \
              bv[q] = *(const f32x4*)(WSP(float, SC_RB) + fo_ + (size_t)i_ * 256 + c0_ + 4 * q); kv[q] = *(const f32x4*)(WSP(float, SC_RK) + fo_ + (size_t)i_ * 256 + c0_ + 4 * q); } } \
        { const bf16_t* pr0_ = proj + (size_t)tb_row0(b, tb_) * NPROJ; \
          _Pragma("unroll") for (int q = 0; q < 8; ++q) { const int e = tid_ + NTHR * q, r2 = e >> 6, cc = e & 63; v8[q] = pr0_[(size_t)(d_ ? 63 - r2 : r2) * NPROJ + PB_V + 64 * h_ + cc]; } } } while (0)
    int u = (p.bid + p.G - (96 % p.G)) % p.G; if (u >= NUNIT) return;
    RW1_LOAD(u);
    for (;;) { const int d = u & 1;
        RW_LP(LP, GS, lw8);
        { RW_LANES; const int r = tid >> 3, c0 = (tid & 7) * 8; unsigned wz[4], wb[4], wk[4];
#pragma unroll
          for (int q = 0; q < 8; q += 2) { float z2[2], b2[2], k2[2];
#pragma unroll
              for (int e = 0; e < 2; ++e) { const int cq = q + e, c = c0 + cq; const float lp = LP[r * LPS + c], lw = lwv[cq >> 2][cq & 3], em = __expf(-lp);
                  z2[e] = -kkv[cq >> 2][cq & 3] * __expf(lp - lw); b2[e] = bv[cq >> 2][cq & 3] * em; k2[e] = kv[cq >> 2][cq & 3] * em; }
              wz[q >> 1] = pk2(z2[0], z2[1]); wb[q >> 1] = pk2(b2[0], b2[1]); wk[q >> 1] = pk2(k2[0], k2[1]); }
          *(LAS u32x4*)(zt + r * TS + c0 * 2) = (u32x4){wz[0], wz[1], wz[2], wz[3]}; *(LAS u32x4*)(bt + r * TS + c0 * 2) = (u32x4){wb[0], wb[1], wb[2], wb[3]}; *(LAS u32x4*)(kt + r * TS + c0 * 2) = (u32x4){wk[0], wk[1], wk[2], wk[3]};
          *(LAS u32x4*)(XT + (2 * r) * TS + c0 * 2) = (u32x4){0u, 0u, 0u, 0u}; *(LAS u32x4*)(XT + (2 * r + 1) * TS + c0 * 2) = (u32x4){0u, 0u, 0u, 0u};
#pragma unroll 2
          for (int q = 0; q < 8; ++q) { const int e = tid + NTHR * q, r2 = e >> 6, cc = e & 63; *(LAS bf16_t*)(vT + cc * TS + r2 * 2) = v8[q]; } }
        __syncthreads();
        const int un = u + p.G; const bool more = un < NUNIT;
        if (more) RW1_LOAD(un);
        { RW_LANES; f32x4 a1[2] = {(f32x4){0.f, 0.f, 0.f, 0.f}, (f32x4){0.f, 0.f, 0.f, 0.f}}, a2[2] = {(f32x4){0.f, 0.f, 0.f, 0.f}, (f32x4){0.f, 0.f, 0.f, 0.f}};
          mm_rows<64, 2>(zt, TS, bt, TS, mt, nt0, fr, fq, a1);
          mm_rows<64, 2>(zt, TS, kt, TS, mt, nt0, fr, fq, a2);
#pragma unroll
          for (int t = 0; t < 2; ++t)
#pragma unroll
              for (int j = 0; j < 4; ++j) { const int r = 16 * mt + 4 * fq + j, jj = 16 * (nt0 + t) + fr; const float a = jj < r ? a1[t][j] : 0.f;
                  Af[jj * AFS + r] = a; *(LAS bf16_t*)(Abf + r * TS + jj * 2) = (bf16_t)f2bf(a); *(LAS bf16_t*)(Azk + r * TS + jj * 2) = (bf16_t)f2bf(jj < r ? a2[t][j] : 0.f); } }
        __syncthreads();
        { RW_LANES; f32x4 a[2] = {(f32x4){0.f, 0.f, 0.f, 0.f}, (f32x4){0.f, 0.f, 0.f, 0.f}};
          mm_rows<64, 2>(Azk, TS, vT, TS, mt, nt0, fr, fq, a);
#pragma unroll
          for (int t = 0; t < 2; ++t) *(LAS u32x2*)(RU + (16 * (nt0 + t) + fr) * TS + (16 * mt + 4 * fq) * 2) = (u32x2){pk2(a[t][0], a[t][1]), pk2(a[t][2], a[t][3])};
        }
        __syncthreads();
        { RW_LANES;
#pragma unroll 2
          for (int q = 0; q < 8; ++q) { const int e = tid + NTHR * q, r2 = e >> 6, cc = e & 63; const float el = __expf(LP[63 * LPS + cc]);
              *(LAS bf16_t*)(bhT + cc * TS + r2 * 2) = (bf16_t)f2bf(bf2f(*(const LAS bf16_t*)(bt + r2 * TS + cc * 2)) * el); *(LAS bf16_t*)(Azk + cc * TS + r2 * 2) = (bf16_t)f2bf(bf2f(*(const LAS bf16_t*)(kt + r2 * TS + cc * 2)) * el); } }
        __syncthreads();
        { const RwRhs rhs{zt, RU}; dr_block_solve(Abf, Af, XT, Dbuf, -1.0f, wave, rhs, WSP(bf16_t, SC_RW_WU) + (size_t)u * 8192); }
        { RW_LANES; f32x4 am[2] = {(f32x4){0.f, 0.f, 0.f, 0.f}, (f32x4){0.f, 0.f, 0.f, 0.f}}, an[2] = {(f32x4){0.f, 0.f, 0.f, 0.f}, (f32x4){0.f, 0.f, 0.f, 0.f}};
          mm_rows<64, 2>(bhT, TS, XT, TS, mt, nt0, fr, fq, am);
          mm_rows<64, 2>(bhT, TS, XT + 64 * TS, TS, mt, nt0, fr, fq, an);
          mm_rows<64, 2>(Azk, TS, vT, TS, mt, nt0, fr, fq, an);
          bf16_t* Mg = WSP(bf16_t, SC_RW_M) + (size_t)u * 4096; bf16_t* Ng = WSP(bf16_t, SC_RW_NS) + (size_t)u * 4096;
#pragma unroll
          for (int t = 0; t < 2; ++t) {
#pragma unroll
              for (int j = 0; j < 4; ++j) { const int row = 16 * mt + 4 * fq + j, col = 16 * (nt0 + t) + fr; Mg[dr_mfrag_idx(row, col)] = (bf16_t)f2bf((row == col ? __expf(LP[63 * LPS + row]) : 0.f) + am[t][j]); }
              *(u32x2*)(Ng + (((nt0 + t) * 4 + mt) * 64 + lane) * 4) = (u32x2){pk2(an[t][0], an[t][1]), pk2(an[t][2], an[t][3])}; } }
        __syncthreads();
        if (!more) break;
        u = un;
    }
#undef RW1_LOAD
}
__device__ __forceinline__ void rw_p2(const Cx& p, LAS unsigned char* lds, int layer, int b) {
    const int wave = __builtin_amdgcn_readfirstlane(p.tid >> 6), mt = wave >> 1, nt0 = (wave & 1) * 2;
    LAS float* LP = (LAS float*)lds; LAS float* GS = (LAS float*)(lds + 16640);
    LAS unsigned char* rt = lds + 18688; LAS unsigned char* bt = lds + 27904; LAS unsigned char* kt = lds + 37120; LAS unsigned char* vT = lds + 46336; LAS unsigned char* sT = lds + 55552; LAS unsigned char* wt = lds + 64768;
    LAS unsigned char* Arb = lds + 73984; LAS unsigned char* Ark = lds + 83200; LAS unsigned char* UT = lds + 92416;
    const bf16_t* proj = WSP(bf16_t, WS_PROJ);
    bf16_t upre[2][4]; float lw8[8]; u32x4 rv, wv, sv, vq; f32x4 bv[2], kv[2];
#define RW2_LOAD(uu) do { const int tb_ = (uu) >> 3, h_ = ((uu) >> 1) & 3, d_ = (uu) & 1, s0_ = 64 * tb_; const int lane_ = lane_id_asm(), tid_ = wave * 64 + lane_, fr_ = lane_ & 15, fq_ = lane_ >> 4; \
        const float* lwp_ = WSP(float, SC_RLW) + (size_t)d_ * SB * 256 + (size_t)s0_ * 256 + 64 * h_; const float* rk_ = WSP(float, SC_RK) + (size_t)s0_ * 256 + 64 * h_; const float* rb_ = WSP(float, SC_RB) + (size_t)s0_ * 256 + 64 * h_; \
        const bf16_t* pr_ = proj + (size_t)tb_row0(b, tb_) * NPROJ; const bf16_t* wu_ = WSP(bf16_t, SC_RW_WU) + (size_t)(uu) * 8192; const bf16_t* st_ = WSP(bf16_t, SC_RW_NS) + (size_t)(uu) * 4096; \
        _Pragma("unroll") for (int t = 0; t < 2; ++t) { _Pragma("unroll") for (int j = 0; j < 4; ++j) upre[t][j] = wu_[(16 * mt + 4 * fq_ + j) * 128 + 64 + 16 * (nt0 + t) + fr_]; } \
        _Pragma("unroll") for (int ii = 0; ii < 8; ++ii) { const int r_ = 8 * wave + ii; lw8[ii] = lwp_[(size_t)(d_ ? 63 - r_ : r_) * 256 + lane_]; } \
        { const int r_ = tid_ >> 3, c0_ = (tid_ & 7) * 8, i_ = d_ ? 63 - r_ : r_; rv = *(const u32x4*)(pr_ + (size_t)i_ * NPROJ + PB_R + 64 * h_ + c0_); \
          _Pragma("unroll") for (int q = 0; q < 2; ++q) { bv[q] = *(const f32x4*)(rb_ + (size_t)i_ * 256 + c0_ + 4 * q); kv[q] = *(const f32x4*)(rk_ + (size_t)i_ * 256 + c0_ + 4 * q); } \
          wv = *(const u32x4*)(wu_ + r_ * 128 + c0_); sv = *(const u32x4*)(st_ + r_ * 64 + c0_); } \
        vq = *(const u32x4*)(pr_ + (size_t)(d_ ? 63 - lane_ : lane_) * NPROJ + PB_V + 64 * h_ + 8 * wave); } while (0)
    int u = (p.bid + p.G - (224 % p.G)) % p.G;
    if (u < NUNIT) RW2_LOAD(u);
    for (; u < NUNIT; u += p.G) { const int tb = u >> 3, h = (u >> 1) & 3, d = u & 1, s0 = 64 * tb;
        bf16_t ucur[2][4];
#pragma unroll
        for (int t = 0; t < 2; ++t)
#pragma unroll
            for (int j = 0; j < 4; ++j) ucur[t][j] = upre[t][j];
        RW_LP(LP, GS, lw8);
        { RW_LANES; const int r = tid >> 3, c0 = (tid & 7) * 8; unsigned wr[4], wb[4], wk[4];
#pragma unroll
          for (int q = 0; q < 8; q += 2) { float r2[2], b2[2], k2[2];
#pragma unroll
              for (int e = 0; e < 2; ++e) { const int cq = q + e, c = c0 + cq; const float lp = LP[r * LPS + c], em = __expf(-lp); const unsigned w = rv[q >> 1];
                  r2[e] = (e ? __uint_as_float(w & 0xffff0000u) : __uint_as_float(w << 16)) * __expf(lp); b2[e] = bv[cq >> 2][cq & 3] * em; k2[e] = kv[cq >> 2][cq & 3] * em; }
              wr[q >> 1] = pk2(r2[0], r2[1]); wb[q >> 1] = pk2(b2[0], b2[1]); wk[q >> 1] = pk2(k2[0], k2[1]); }
          *(LAS u32x4*)(rt + r * TS + c0 * 2) = (u32x4){wr[0], wr[1], wr[2], wr[3]}; *(LAS u32x4*)(bt + r * TS + c0 * 2) = (u32x4){wb[0], wb[1], wb[2], wb[3]}; *(LAS u32x4*)(kt + r * TS + c0 * 2) = (u32x4){wk[0], wk[1], wk[2], wk[3]};
          *(LAS u32x4*)(wt + r * TS + c0 * 2) = wv; *(LAS u32x4*)(sT + r * TS + c0 * 2) = sv;
#pragma unroll
          for (int k = 0; k < 8; ++k) *(LAS bf16_t*)(vT + (8 * wave + k) * TS + lane * 2) = (bf16_t)(vq[k >> 1] >> (16 * (k & 1))); }
        if (u + p.G < NUNIT) RW2_LOAD(u + p.G);
        __syncthreads();
        { RW_LANES; f32x4 a1[2] = {(f32x4){0.f, 0.f, 0.f, 0.f}, (f32x4){0.f, 0.f, 0.f, 0.f}}, a2[2] = {(f32x4){0.f, 0.f, 0.f, 0.f}, (f32x4){0.f, 0.f, 0.f, 0.f}}, a3[2] = {(f32x4){0.f, 0.f, 0.f, 0.f}, (f32x4){0.f, 0.f, 0.f, 0.f}};
          mm_rows<64, 2>(rt, TS, bt, TS, mt, nt0, fr, fq, a1); mm_rows<64, 2>(rt, TS, kt, TS, mt, nt0, fr, fq, a2); mm_rows<64, 2>(wt, TS, sT, TS, mt, nt0, fr, fq, a3);
#pragma unroll
          for (int t = 0; t < 2; ++t) { const int dv = 16 * (nt0 + t) + fr; float uu[4];
#pragma unroll
              for (int j = 0; j < 4; ++j) { const int r = 16 * mt + 4 * fq + j, jj = dv; const bool keep = jj <= r;
                  *(LAS bf16_t*)(Arb + r * TS + jj * 2) = (bf16_t)f2bf(keep ? a1[t][j] : 0.f); *(LAS bf16_t*)(Ark + r * TS + jj * 2) = (bf16_t)f2bf(keep ? a2[t][j] : 0.f);
                  uu[j] = bf2f(ucur[t][j]) + a3[t][j]; }
              *(LAS u32x2*)(UT + dv * TS + (16 * mt + 4 * fq) * 2) = (u32x2){pk2(uu[0], uu[1]), pk2(uu[2], uu[3])}; } }
        __syncthreads();
        { RW_LANES; f32x4 acc[2] = {(f32x4){0.f, 0.f, 0.f, 0.f}, (f32x4){0.f, 0.f, 0.f, 0.f}};
          mm_rows<64, 2>(rt, TS, sT, TS, mt, nt0, fr, fq, acc); mm_rows<64, 2>(Arb, TS, UT, TS, mt, nt0, fr, fq, acc); mm_rows<64, 2>(Ark, TS, vT, TS, mt, nt0, fr, fq, acc);
          bf16_t* ob = WSP(bf16_t, d ? SC_OB : SC_OF);
#pragma unroll
          for (int t = 0; t < 2; ++t)
#pragma unroll
              for (int j = 0; j < 4; ++j) { const int r = 16 * mt + 4 * fq + j, i = d ? 63 - r : r; ob[(size_t)(s0 + i) * 1024 + 256 + 64 * h + 16 * (nt0 + t) + fr] = (bf16_t)f2bf(acc[t][j]); } }
        __syncthreads();
    }
#undef RW_LANES
#undef RW2_LOAD
}
__device__ __forceinline__ void phase_scan(const Cx& p, LAS unsigned char* lds, int layer, int b) {
    for (int w = p.bid; w < 160; w += p.G) {
        if (w < 64) ssd_chain(p, (w >> 4) & 3, (w >> 3) & 1, w & 7);
        else if (w < 96) gla_chain(p, ((w - 64) >> 3) & 3, ((w - 64) >> 2) & 1, (w - 64) & 3);
        else { const int i = w - 96, h = (i >> 3) & 3, d = (i >> 2) & 1, cb = i & 3;
            if (i < 32) dr_chain(p, SC_RW_M, SC_RW_NS, h, d, cb); else dr_chain(p, SC_DR_M, SC_DR_NS, h, d, cb); } }
}
#ifndef MK_ONE_LAUNCH
#define MK_ONE_LAUNCH 1
#endif
constexpr int PH_PER_LAYER = 2 + 5 * NB + 7;
constexpr int N_PHASES = 1 + NL * PH_PER_LAYER + 1;

__global__ void __launch_bounds__(NTHR, 2) mega_fwd(Params pp) {
    extern __shared__ __attribute__((aligned(16))) unsigned char lds_raw[];
    LAS unsigned char* lds = (LAS unsigned char*)lds_raw;
    const int swave = __builtin_amdgcn_readfirstlane(threadIdx.x >> 6);
    for (int i = threadIdx.x; i < (LDS_BYTES - LDS_CTL) / 4; i += NTHR) ((LAS unsigned*)(lds + LDS_CTL))[i] = 0u;
    __syncthreads();
    if (threadIdx.x < N_IN + 2) { const unsigned long long a = threadIdx.x < N_IN ? (unsigned long long)pp.in[threadIdx.x] : (threadIdx.x == N_IN ? (unsigned long long)pp.out : (unsigned long long)pp.ws); ((LAS unsigned*)(lds + LDS_PTRS))[2 * threadIdx.x] = (unsigned)a; ((LAS unsigned*)(lds + LDS_PTRS))[2 * threadIdx.x + 1] = (unsigned)(a >> 32); }
    __syncthreads();
    XcdBarrier bar = xcd_barrier_post((unsigned*)(pp.ws + WS_CTL) + CW_BAR + pp.li * XCD_BAR_WORDS, (volatile LAS unsigned*)(lds + LDS_CTL), threadIdx.x);
    LAS int* tb = (LAS int*)(lds + LDS_CTL + 64);
    int pc = 0; const int lo = pp.lo, hi = pp.hi;
#define PH_BEGIN if (pc >= lo && pc < hi) { Cx p; p.out = (unsigned long long)PIN(N_IN); p.ws = (unsigned long long)PIN(N_IN + 1); p.tid = swave * 64 + lane_id_asm(); p.bid = blockIdx.x; p.G = gridDim.x; p.pad = 0; asm volatile("" : "+s"(p.out), "+s"(p.ws), "+v"(p.tid), "+s"(p.bid), "+s"(p.G)); const int G = p.G, bid = p.bid; (void)G; (void)bid;
#define PH_END if (pc + 1 < hi) { XcdBarrier b2 = bar; asm volatile("" : "+s"(b2.bar), "+s"(b2.x)); xcd_barrier(b2, (unsigned)(swave * 64 + lane_id_asm())); } } ++pc;

    PH_BEGIN
        for (int u = bid; u < CONV_A_UNITS; u += G) conv_unit_A(p, (LAS float*)lds, u);
        __syncthreads();
        phase_mod(p, lds);
    PH_END

#pragma unroll
    for (int layer = 0; layer < NL; ++layer) {
        const int row_lo = layer == NL - 1 ? CROWS : 0;
        PH_BEGIN phase_norm1(p, layer); PH_END
        PH_BEGIN
            DenseSched S; S.init(ROWS, NPROJ, D, WSP(bf16_t, WS_WIN) + (size_t)layer * NPROJ * D, G, bid);
            EpiProj E{WSP(bf16_t, WS_PROJ), NPROJ};
            pg8::gemm_phase<D>(p.tid, lds, (const char*)WSP(bf16_t, WS_HBUF), S, E);
        PH_END
#pragma unroll 1
        for (int b = 0; b < NB; ++b) {
            PH_BEGIN phase_prep(p, lds, layer, b); PH_END
            PH_BEGIN gla_p1(p, lds, layer, b); __syncthreads(); ssd_p1(p, lds, layer, b); __syncthreads(); gdn_p1(p, lds, layer, b); __syncthreads(); rw_p1(p, lds, layer, b); PH_END
            PH_BEGIN phase_scan(p, lds, layer, b); PH_END
            PH_BEGIN gla_p2(p, lds, layer, b); __syncthreads(); ssd_p2(p, lds, layer, b); __syncthreads(); gdn_p2(p, lds, layer, b); __syncthreads(); rw_p2(p, lds, layer, b); PH_END
            PH_BEGIN phase_post(p, lds, layer, b); PH_END
        }
        PH_BEGIN
            DenseSched S; S.init(ROWS, D, D, WSP(bf16_t, WS_WOUT) + (size_t)layer * D * D, G, bid);
            EpiRes E{layer == 0 ? PIN(I_X) : (const float*)POUT, layer == 0 ? PIN(I_CTX) : (const float*)WSP(float, WS_CTXRES), POUT, WSP(float, WS_CTXRES), WSP(float, WS_MOD) + (size_t)layer * 5 * 6144 + 2048};
            pg8::gemm_phase<D>(p.tid, lds, (const char*)WSP(bf16_t, WS_HBUF), S, E);
        PH_END
        PH_BEGIN phase_norm2(p, lds, layer, row_lo);
            __syncthreads();
            conv_experts(p, (LAS float*)lds, layer);
        PH_END
        PH_BEGIN
            moe_table(p, tb, layer, row_lo);
            MoeSched<true> S{tb + 128, tb, 2, G, bid, D, row_lo, WSP(int, WS_LTOK), (const char*)WSP(bf16_t, WS_EXPGU), (size_t)512 * D * 2};
            EpiGU E{WSP(bf16_t, WS_H)};
            pg8::gemm_phase<D>(p.tid, lds, (const char*)WSP(bf16_t, WS_HBUF), S, E);
        PH_END
#pragma unroll
        for (int half = 0; half < 2; ++half) {
            PH_BEGIN
                moe_table(p, tb, layer, row_lo);
                MoeSched<false> S{tb + 128, tb, 2, G, bid, EH, row_lo, WSP(int, WS_LTOK), (const char*)(WSP(bf16_t, WS_EXPD) + (size_t)half * 512 * EH), (size_t)D * EH * 2};
                EpiY E{WSP(bf16_t, WS_Y)};
                pg8::gemm_phase<EH>(p.tid, lds, (const char*)WSP(bf16_t, WS_H), S, E);
            PH_END
            PH_BEGIN
                moe_table(p, tb, layer, row_lo);
                phase_combine(p, tb, layer, row_lo, half);
            PH_END
        }
    }
    PH_BEGIN phase_final(p);
    PH_END
#undef PH_BEGIN
#undef PH_END
}

extern "C" void kernel_launch(void* const* d_in, const int* in_sizes, int n_in, void* d_out, int out_size, void* d_ws, size_t ws_size, hipStream_t stream) {
    static int grid = 0;
    if (grid == 0) {
        if (n_in != N_IN || in_sizes[0] != NB * SEQ * D || out_size != NB * SEQ * D || ws_size < WS_END) {
            fprintf(stderr, "kernel_launch: unexpected shapes (n_in %d, in0 %d, out %d, ws %zu); nothing launched\n", n_in, n_in > 0 ? in_sizes[0] : -1, out_size, ws_size); grid = -1; return; }
        int dev = 0, cus = 0, per_cu = 0;
        if (hipGetDevice(&dev) != hipSuccess || hipDeviceGetAttribute(&cus, hipDeviceAttributeMultiprocessorCount, dev) != hipSuccess) { grid = -1; return; }
        if (hipFuncSetAttribute((const void*)mega_fwd, hipFuncAttributeMaxDynamicSharedMemorySize, LDS_BYTES) != hipSuccess) { fprintf(stderr, "kernel_launch: hipFuncSetAttribute failed\n"); grid = -1; return; }
        if (hipOccupancyMaxActiveBlocksPerMultiprocessor(&per_cu, (const void*)mega_fwd, NTHR, LDS_BYTES) != hipSuccess || per_cu < 1) { fprintf(stderr, "kernel_launch: occupancy query says %d\n", per_cu); per_cu = 1; }
        (void)hipGetLastError();
        grid = cus * 1;
    }
    if (grid < 0) return;
    if (hipMemsetAsync((char*)d_ws + WS_CTL, 0, CTL_ZERO_BYTES, stream) != hipSuccess) return;
    Params p{};
    for (int i = 0; i < N_IN; ++i) p.in[i] = (const float*)d_in[i];
    p.out = (float*)d_out; p.ws = (unsigned char*)d_ws; p.pad = 0;
#if MK_ONE_LAUNCH
    p.lo = 0; p.hi = N_PHASES; p.li = 0;
    hipLaunchKernelGGL(mega_fwd, dim3(grid), dim3(NTHR), LDS_BYTES, stream, p);
#else
    for (int k = 0; k < N_PHASES; ++k) { p.lo = k; p.hi = k + 1; p.li = k;
        hipLaunchKernelGGL(mega_fwd, dim3(grid), dim3(NTHR), LDS_BYTES, stream, p); }
#endif
}
```

```cpp
#include <hip/hip_runtime.h>
#include <cstdio>
#include <cstdint>

typedef unsigned short bf16_t;
typedef short bf16x8 __attribute__((ext_vector_type(8)));
typedef float f32x4 __attribute__((ext_vector_type(4)));
typedef float f32x2 __attribute__((ext_vector_type(2)));
typedef unsigned u32x4 __attribute__((ext_vector_type(4)));
typedef unsigned u32x2 __attribute__((ext_vector_type(2)));

constexpr int NB = 4, SEQ = 8192, NCTX = 256, D = 1024, NL = 2;
constexpr int CROWS = NB * NCTX;
constexpr int ROWS = CROWS + NB * SEQ;
constexpr int SB = NCTX + SEQ;
constexpr int INW = 4056, NPROJ = 4096;
constexpr int NE = 64, NE1 = 65, TOPK = 8, EH = 256;
constexpr int GRIDW = 64, GRIDH = SEQ / GRIDW;
constexpr int PA_Q = 0, PA_K = 256, PA_V = 512, PA_G = 768, PA_GF = 1024, PA_GB = 1040;
constexpr int PB_R = 1056, PB_K = 1312, PB_V = 1568, PB_WF = 1824, PB_WB = 1856, PB_A = 1888, PB_G = 1920;
constexpr int PC_Z = 1984, PC_X = 2240, PC_DF = 3008, PC_DB = 3012;
constexpr int PD_Q = 3016, PD_Z = 3784, PD_BF = 4040, PD_BB = 4044, PD_AF = 4048, PD_AB = 4052;
enum { I_X = 0, I_C, I_CTX, I_CCTX, I_N1G, I_N2G, I_WMOD, I_BMOD, I_WIN, I_WOUT, I_GLA_W2, I_GLA_B, I_GLA_NG,
       I_RW_W2, I_RW_W0, I_RW_AW2, I_RW_A0, I_RW_GW2, I_RW_KK, I_RW_KA, I_RW_RK, I_RW_LNG, I_RW_LNB,
       I_SS_CW, I_SS_CB, I_SS_ALOG, I_SS_DTB, I_SS_D, I_SS_NG, I_DN_CW, I_DN_ALOG, I_DN_DTB, I_DN_NG,
       I_ROUT_W, I_ROUT_B, I_EXP_G, I_EXP_U, I_EXP_D, I_SH_G, I_SH_U, I_SH_D, I_FNG, N_IN };
static_assert(N_IN == 42, "input count");

constexpr size_t MiB = 1u << 20;
constexpr size_t WS_CTL = 0, CTL_ZERO_BYTES = 1 * MiB;
constexpr size_t WS_MOD = 1 * MiB;
constexpr size_t WS_RWGW = WS_MOD + 256 * 1024;
constexpr size_t WS_RWLR = WS_MOD + 384 * 1024;
constexpr size_t WS_WIN = 2 * MiB;
constexpr size_t WS_WOUT = 18 * MiB;
constexpr size_t WS_ROUT = 22 * MiB;
constexpr size_t WS_CTXRES = 23 * MiB;
constexpr size_t WS_EXPGU = 27 * MiB;
constexpr size_t WS_EXPD = 92 * MiB;
constexpr size_t WS_HBUF = 125 * MiB;
constexpr size_t WS_PROJ = 191 * MiB;
constexpr size_t WS_SCR = 455 * MiB;
constexpr size_t WS_END = 640455456;
constexpr int HROWS_MAX = ROWS * 9 + NE1 * 256;
constexpr size_t WS_Y = WS_HBUF;
constexpr size_t WS_H = 443 * MiB;
constexpr size_t WS_LTOK = 600 * MiB;
constexpr size_t WS_TOKT = WS_LTOK + (size_t)NE * ROWS * 4;
static_assert(WS_Y + (size_t)HROWS_MAX * 512 * 2 <= WS_H && WS_H + (size_t)HROWS_MAX * 256 * 2 <= WS_LTOK && WS_TOKT + (size_t)ROWS * 64 <= WS_END, "moe overlay");
constexpr size_t SC_OF = WS_SCR;
constexpr size_t SC_OB = SC_OF + (size_t)SB * 1024 * 2;
constexpr size_t SC_RK = SC_OB + (size_t)SB * 1024 * 2;
constexpr size_t SC_RKK = SC_RK + (size_t)SB * 256 * 4;
constexpr size_t SC_RB = SC_RKK + (size_t)SB * 256 * 4;
constexpr size_t SC_RLW = SC_RB + (size_t)SB * 256 * 4;
constexpr size_t SC_SX = SC_RLW + (size_t)2 * SB * 256 * 4;
constexpr size_t SC_DQ = SC_SX + (size_t)SB * 768 * 2;
constexpr size_t SC_SDT = SC_DQ + (size_t)SB * 768 * 2;
constexpr size_t SC_DG = SC_SDT + (size_t)SB * 8 * 4;
constexpr size_t SC_FEND = SC_DG + (size_t)SB * 16 * 4;
constexpr int NTB = SB / 64, NUNIT = NTB * 4 * 2;
constexpr size_t SC_RW_M = SC_FEND;
constexpr size_t SC_RW_NS = SC_RW_M + (size_t)(SB / 64 * 8) * 4096 * 2;
constexpr size_t SC_RW_WU = SC_RW_NS + (size_t)(SB / 64 * 8) * 4096 * 2;
constexpr size_t SC_END = SC_RW_WU + (size_t)(SB / 64 * 8) * 8192 * 2;
constexpr size_t SC2 = WS_EXPGU;
constexpr size_t SC_GLA_S = SC2;
constexpr size_t SC_GLA_DEC = SC_GLA_S + (size_t)NUNIT * 4096 * 4;
constexpr size_t SC_SSD_S = SC_GLA_DEC + (size_t)NUNIT * 64 * 4;
constexpr size_t SC_SSD_CD = SC_SSD_S + (size_t)NUNIT * 8192 * 4;
constexpr size_t SC_DR_M = SC_SSD_CD + (size_t)NUNIT * 4 + 4096;
constexpr size_t SC_DR_NS = SC_DR_M + (size_t)NUNIT * 4096 * 2;
constexpr size_t SC_DR_WU = SC_DR_NS + (size_t)NUNIT * 4096 * 2;
constexpr size_t SC2_END = SC_DR_WU + (size_t)NUNIT * 8192 * 2;
static_assert(SC2_END <= WS_HBUF, "chunk slots fit in the expert-weight region");
static_assert(SC_END <= WS_END, "scratch fits");
constexpr int CW_CNT = 1024;
constexpr int CW_BAR = 4096;

#define LAS __attribute__((address_space(3)))
constexpr int NTHR = 512;
constexpr int LDS_BYTES = 147456;
constexpr int LDS_CTL = 143360;
constexpr int LDS_PTRS = LDS_CTL + 2048;

__device__ __forceinline__ int lane_id_asm() { int l; asm volatile("v_mbcnt_lo_u32_b32 %0, -1, 0\n\tv_mbcnt_hi_u32_b32 %0, -1, %0" : "=v"(l)); return l; }
__device__ __forceinline__ float bf2f(bf16_t b) { return __uint_as_float(((unsigned)b) << 16); }
__device__ __forceinline__ unsigned f2bf(float f) { unsigned u = __float_as_uint(f); u += 0x7FFFu + ((u >> 16) & 1u); return u >> 16; }
__device__ __forceinline__ unsigned pk2(float lo, float hi) { return f2bf(lo) | (f2bf(hi) << 16); }
__device__ __forceinline__ float rl(float x, int k) { return __uint_as_float(__builtin_amdgcn_readlane(__float_as_uint(x), k)); }
__device__ __forceinline__ float shx_(float v, int lane, int o) { return __uint_as_float(__builtin_amdgcn_ds_bpermute((lane ^ o) << 2, __float_as_uint(v))); }
__device__ __forceinline__ int shxi_(int v, int lane, int o) { return __builtin_amdgcn_ds_bpermute((lane ^ o) << 2, v); }
__device__ __forceinline__ float shup_(float v, int lane, int o) { return __uint_as_float(__builtin_amdgcn_ds_bpermute((lane - o) << 2, __float_as_uint(v))); }
#define DPPF(v, ctrl) __uint_as_float(__builtin_amdgcn_update_dpp(0, __float_as_uint(v), ctrl, 0xf, 0xf, false))
#define DPPI(v, ctrl) __builtin_amdgcn_update_dpp(0, (v), ctrl, 0xf, 0xf, false)
__device__ __forceinline__ float wsum(float v) {
    v += DPPF(v, 0xB1); v += DPPF(v, 0x4E); v += DPPF(v, 0x141); v += DPPF(v, 0x140);
    v += __uint_as_float(__builtin_amdgcn_ds_swizzle(__float_as_uint(v), 0x401F));
    return rl(v, 0) + rl(v, 32);
}
__device__ __forceinline__ float rcp_(float x) { return __builtin_amdgcn_rcpf(x); }
__device__ __forceinline__ float rsq_(float x) { return __builtin_amdgcn_rsqf(x); }
__device__ __forceinline__ float sigmoidf_(float x) { return rcp_(1.0f + __expf(-x)); }
__device__ __forceinline__ float siluf_(float x) { return x * rcp_(1.0f + __expf(-x)); }
__device__ __forceinline__ float log1pexp_(float t  ) { return t < 1e-4f ? t - 0.5f * t * t : __logf(1.0f + t); }
__device__ __forceinline__ float softplusf_(float x) { return x > 15.f ? x : log1pexp_(__expf(x)); }
__device__ __forceinline__ float logsigmoidf_(float x) { return fminf(x, 0.f) - log1pexp_(__expf(-fabsf(x))); }
__device__ __forceinline__ float tanhf_(float x) { const float e = __expf(2.0f * fminf(fmaxf(x, -15.f), 15.f)); return (e - 1.0f) * rcp_(e + 1.0f); }
__device__ __forceinline__ int seq_tok(int i, int d) { return d == 0 ? i : (i < NCTX ? NCTX - 1 - i : SB + NCTX - 1 - i); }
__device__ __forceinline__ int tok_row(int b, int s) { return s < NCTX ? b * NCTX + s : CROWS + b * SEQ + (s - NCTX); }

#define GAS __attribute__((address_space(1)))
struct Params { const float* in[N_IN]; float* out; unsigned char* ws; int lo, hi, li, pad; };
struct Cx { unsigned long long out, ws; int tid, bid, G, pad; };
__device__ __forceinline__ const float* PIN(int i) {
    extern __shared__ __attribute__((aligned(16))) unsigned char lds_raw_[];
    int off = __builtin_amdgcn_readfirstlane(LDS_PTRS + 8 * i); asm volatile("" : "+s"(off));
    const LAS unsigned* t = (const LAS unsigned*)((LAS unsigned char*)lds_raw_ + off);
    const unsigned lo = __builtin_amdgcn_readfirstlane(t[0]), hi = __builtin_amdgcn_readfirstlane(t[1]);
    return (const float*)(const GAS float*)(((unsigned long long)hi << 32) | lo);
}
#define XB_TMO      128
#define XB_XCNT(j)  (256  + 64 * (j))
#define XB_XSUB(j)  (1280 + 64 * (j))
#define XB_XGEN(j)  (2304 + 64 * (j))
#define XB_TOP      3328
#define XB_TOPGEN   3392
#define XCD_BAR_WORDS 3456
#define XB_SPIN_CAP (1u << 18)

__device__ __forceinline__ unsigned xb_ld(unsigned* p)              { return __hip_atomic_load(p, __ATOMIC_RELAXED, __HIP_MEMORY_SCOPE_AGENT); }
__device__ __forceinline__ unsigned xb_add(unsigned* p, unsigned v) { return __hip_atomic_fetch_add(p, v, __ATOMIC_RELAXED, __HIP_MEMORY_SCOPE_AGENT); }
__device__ __forceinline__ unsigned xb_xcc_id() { return (unsigned)__builtin_amdgcn_s_getreg((3 << 11) | 20) & 0xFu; }
#define XB_SPIN(cond, bar) do { unsigned _sp = 0; while (cond) { __builtin_amdgcn_s_sleep(1); \
    if ((++_sp & 255u) == 0u) { if (xb_ld(&(bar)[XB_TMO])) break; if (_sp > XB_SPIN_CAP) { atomicAdd(&(bar)[XB_TMO], 1u); break; } } } } while (0)

struct XcdBarrier {
    unsigned* bar; unsigned x;
    volatile LAS unsigned* st;
};

__device__ __forceinline__ XcdBarrier xcd_barrier_post(unsigned* bar, volatile LAS unsigned* st, const unsigned xb_tid) {
    XcdBarrier b; b.bar = bar; b.x = xb_xcc_id(); b.st = st;
    if (xb_tid == 0) (void)xb_add(&bar[XB_XCNT(b.x)], 1u);
    return b;
}
__device__ __forceinline__ void xcd_barrier_complete(unsigned* bar, unsigned x, unsigned& nloc, unsigned& nx) {
    const unsigned G = gridDim.x * gridDim.y * gridDim.z;
    unsigned sum, cnt, mine, sp = 0u;
    for (;;) {
        sum = 0u; cnt = 0u; mine = 0u;
#pragma unroll
        for (unsigned j = 0; j < 16; ++j) { const unsigned c = xb_ld(&bar[XB_XCNT(j)]); sum += c; cnt += (c > 0u) ? 1u : 0u; mine = (j == x) ? c : mine; }
        if (sum == G) break;
        __builtin_amdgcn_s_sleep(1);
        if ((++sp & 255u) == 0u) { if (xb_ld(&bar[XB_TMO])) break; if (sp > XB_SPIN_CAP) { atomicAdd(&bar[XB_TMO], 1u); break; } }
    }
    nloc = mine > 0u ? mine : 1u; nx = cnt > 0u ? cnt : 1u;
}

__device__ __forceinline__ void xcd_barrier(const XcdBarrier& b, const unsigned xb_tid) {
    asm volatile("s_waitcnt vmcnt(0)" ::: "memory");
    __syncthreads();
    if (xb_tid == 0) {
        unsigned* bar = b.bar;
        __builtin_amdgcn_s_waitcnt(0);
        unsigned nloc = b.st[0], nx = b.st[1];
        if (nloc == 0u) { xcd_barrier_complete(bar, b.x, nloc, nx); b.st[0] = nloc; b.st[1] = nx; }
        const unsigned old = xb_add(&bar[XB_XSUB(b.x)], 1u);
        const unsigned gen = old / nloc;
        if (old + 1u == (gen + 1u) * nloc) {
            __builtin_amdgcn_fence(__ATOMIC_RELEASE, "agent");
            asm volatile("s_waitcnt vmcnt(0)" ::: "memory");
            const unsigned og = xb_add(&bar[XB_TOP], 1u);
            const unsigned tg = og / nx;
            if (og + 1u == (tg + 1u) * nx) xb_add(&bar[XB_TOPGEN], 1u);
            else XB_SPIN(xb_ld(&bar[XB_TOPGEN]) == tg, bar);
            __builtin_amdgcn_fence(__ATOMIC_ACQUIRE, "agent");
            xb_add(&bar[XB_XGEN(b.x)], 1u);
            asm volatile("s_waitcnt vmcnt(0)" ::: "memory");
        } else {
            XB_SPIN(xb_ld(&bar[XB_XGEN(b.x)]) == gen, bar);
            __builtin_amdgcn_fence(__ATOMIC_ACQUIRE, "agent");
            asm volatile("s_waitcnt vmcnt(0)" ::: "memory");
        }
    }
    __syncthreads();
}

namespace pg8 {
constexpr int BM = 256, BK = 64, HALF = 128, HTB = HALF * BK * 2  , STAGE_BYTES = 8 * HTB, NXCD = 8, WGM = 8;
__host__ __device__ __forceinline__ int lds_byte(int r, int c) { const int st = (r >> 4) * 2 + (c >> 5), rr = r & 15, cc = c & 31, ob = rr * 64 + cc * 2; return st * 1024 + (ob ^ (((ob >> 9) & 1) << 5)); }
__host__ __device__ __forceinline__ void stage_rc(int b, int& R, int& C) { const int st = b / 1024, sb = b % 1024, swz = sb ^ (((sb >> 9) & 1) << 5); R = (st >> 1) * 16 + swz / 64; C = (st & 1) * 32 + (swz % 64) / 2; }
__host__ __device__ __forceinline__ int perm32(int rho) { const int n = rho >> 4, i = rho & 15; return 8 * (i >> 2) + 4 * n + (i & 3); }

struct Unit { int pm, pn, e, r0; };

__device__ __forceinline__ unsigned cvt_pk_bf16(float lo, float hi) { unsigned r; asm volatile("v_cvt_pk_bf16_f32 %0, %1, %2" : "=v"(r) : "v"(lo), "v"(hi)); return r; }

template <int K, class Epi, class Sched>
__device__ __forceinline__ void gemm_phase(const int tid, LAS unsigned char* lds, const char* Abase, const Sched& S, const Epi& E) {
    const int wid = __builtin_amdgcn_readfirstlane(tid >> 6), lane = tid & 63, wr = wid >> 2, wc = wid & 3, fr = lane & 15, fq = lane >> 4;
    const int nt = K / BK;
    constexpr bool DN = Sched::DENSE;
    int RA[2], CA[2]; unsigned voffB[2], voffA[2];
#pragma unroll
    for (int i = 0; i < 2; ++i) { int R, C; stage_rc(tid * 16 + i * 8192, R, C); const int Rb = Epi::PERM ? ((R & ~31) + perm32(R & 31)) : R;
        RA[i] = R; CA[i] = C; voffB[i] = (unsigned)(Rb * K + C) * 2u; voffA[i] = (unsigned)(R * K + C) * 2u; }
    const size_t kstep = (size_t)(BK * 2);
    const size_t hstep = (size_t)HALF * K * 2;
    const size_t tstep = 2 * hstep;
    const unsigned ldsw = (unsigned)wid * 1024u;
    const int aoff = lds_byte(wr * 64 + fr, fq * 8), boff = lds_byte(wc * 32 + fr, fq * 8);
#define PG8_SA(b, h) (((b) * 2 + (h)) * HTB)
#define PG8_SB(b, h) ((4 + (b) * 2 + (h)) * HTB)
#define PG8_STAGE(bufoff, gbase, voff) do { _Pragma("unroll") for (int _i = 0; _i < 2; ++_i) \
        __builtin_amdgcn_global_load_lds((const __attribute__((address_space(1))) unsigned*)((const __attribute__((address_space(1))) char*)(gbase) + (voff)[_i]), (LAS unsigned*)(lds + (bufoff) + ldsw + _i * 8192), 16, 0, 0); } while (0)
#define PG8_LDA(dst, b, h) do { _Pragma("unroll") for (int m = 0; m < 4; ++m) _Pragma("unroll") for (int k = 0; k < 2; ++k) dst[m][k] = *(const LAS bf16x8*)(lds + PG8_SA(b, h) + aoff + m * 2048 + k * 1024); } while (0)
#define PG8_LDB(dst, b, h) do { _Pragma("unroll") for (int n = 0; n < 2; ++n) _Pragma("unroll") for (int k = 0; k < 2; ++k) dst[n][k] = *(const LAS bf16x8*)(lds + PG8_SB(b, h) + boff + n * 2048 + k * 1024); } while (0)
#define PG8_MMA(ai, bj, At, Bt) do { __builtin_amdgcn_s_setprio(1); _Pragma("unroll") for (int m = 0; m < 4; ++m) _Pragma("unroll") for (int n = 0; n < 2; ++n) _Pragma("unroll") for (int k = 0; k < 2; ++k) \
        acc[ai][bj][m][n] = __builtin_amdgcn_mfma_f32_16x16x32_bf16(Bt[n][k], At[m][k], acc[ai][bj][m][n], 0, 0, 0); __builtin_amdgcn_s_setprio(0); } while (0)
#define PG8_WAIT_V(n) asm volatile("s_waitcnt vmcnt(" #n ")" ::: "memory")
#define PG8_WAIT_L(n) asm volatile("s_waitcnt lgkmcnt(" #n ")" ::: "memory")
#define PG8_BAR __builtin_amdgcn_s_barrier()
#define PG8_SCHED __builtin_amdgcn_sched_barrier(0)
#define PG8_AOFF(dst, u) do { _Pragma("unroll") for (int _h = 0; _h < 2; ++_h) _Pragma("unroll") for (int _i = 0; _i < 2; ++_i) \
        dst[_h][_i] = ((unsigned)S.a_row(u, _h * HALF + RA[_i]) * (unsigned)K + (unsigned)CA[_i]) * 2u; } while (0)
    Unit cur, nxt; int ui = 0;
    if (!S.next(0, cur)) return;
    f32x4 acc[2][2][4][2];
#pragma unroll
    for (int a = 0; a < 2; ++a)
#pragma unroll
        for (int b = 0; b < 2; ++b)
#pragma unroll
            for (int m = 0; m < 4; ++m)
#pragma unroll
                for (int n = 0; n < 2; ++n) acc[a][b][m][n] = (f32x4){0.f, 0.f, 0.f, 0.f};
    bf16x8 At[4][2], B0[2][2], B1[2][2];
    unsigned cO[2][2], nO[2][2];
    const char* cA = Abase; const char* nA = Abase;
    if constexpr (DN) cA = Abase + (size_t)S.a_row(cur, 0) * K * 2; else PG8_AOFF(cO, cur);
    const char* cB = S.b_ptr(cur);
#define PG8_STA(bufoff, h_, kb_, nx_) do { if constexpr (DN) PG8_STAGE(bufoff, ((nx_) ? nA : cA) + (h_) * hstep + (kb_), voffA); else PG8_STAGE(bufoff, Abase + (kb_), ((nx_) ? nO : cO)[h_]); } while (0)
    PG8_STAGE(PG8_SB(0, 0), cB, voffB); PG8_SCHED; PG8_STA(PG8_SA(0, 0), 0, 0, false); PG8_SCHED; PG8_STAGE(PG8_SB(0, 1), cB + hstep, voffB); PG8_SCHED; PG8_STA(PG8_SA(0, 1), 1, 0, false); PG8_SCHED;
    if (wr == 1) PG8_BAR;
    PG8_WAIT_V(4); PG8_BAR;
    PG8_STAGE(PG8_SB(1, 0), cB + kstep, voffB); PG8_SCHED; PG8_STA(PG8_SA(1, 0), 0, kstep, false); PG8_SCHED; PG8_STAGE(PG8_SB(1, 1), cB + hstep + kstep, voffB); PG8_SCHED;
    PG8_WAIT_V(6); PG8_BAR;
    for (;;) {
        const bool has_next = S.next(ui + 1, nxt);
        const char* nB = cB; nA = cA;
        if (has_next) { if constexpr (DN) nA = Abase + (size_t)S.a_row(nxt, 0) * K * 2; else PG8_AOFF(nO, nxt); nB = S.b_ptr(nxt); }
        else if constexpr (!DN) {
#pragma unroll
            for (int h = 0; h < 2; ++h)
#pragma unroll
                for (int i = 0; i < 2; ++i) nO[h][i] = cO[h][i]; }
        for (int t = 0; t < nt; t += 2) {
            const bool last = (t == nt - 2);
            const size_t k1 = (size_t)(t + 1) * kstep, k2 = last ? 0 : (size_t)(t + 2) * kstep, k3 = k2 + kstep;
            const char* b2 = last ? nB : cB + (size_t)(t + 2) * kstep; const char* b3 = b2 + kstep;
            PG8_LDB(B0, 0, 0); PG8_SCHED; PG8_LDA(At, 0, 0); PG8_STA(PG8_SA(1, 1), 1, k1, false);
            PG8_WAIT_L(8); PG8_BAR; PG8_WAIT_L(0); PG8_MMA(0, 0, At, B0); PG8_BAR; PG8_SCHED;
            PG8_LDB(B1, 0, 1); PG8_STAGE(PG8_SB(0, 0), b2, voffB);
            PG8_BAR; PG8_WAIT_L(0); PG8_MMA(0, 1, At, B1); PG8_BAR;
            PG8_LDA(At, 0, 1); PG8_STA(PG8_SA(0, 0), 0, k2, last);
            PG8_BAR; PG8_WAIT_L(0); PG8_MMA(1, 0, At, B0); PG8_BAR; PG8_SCHED;
            PG8_STAGE(PG8_SB(0, 1), b2 + hstep, voffB);
            PG8_WAIT_V(6); PG8_BAR; PG8_MMA(1, 1, At, B1); PG8_BAR;
            PG8_LDB(B0, 1, 0); PG8_SCHED; PG8_LDA(At, 1, 0); PG8_STA(PG8_SA(0, 1), 1, k2, last);
            PG8_WAIT_L(8); PG8_BAR; PG8_WAIT_L(0); PG8_MMA(0, 0, At, B0); PG8_BAR; PG8_SCHED;
            PG8_LDB(B1, 1, 1); PG8_STAGE(PG8_SB(1, 0), b3, voffB);
            PG8_BAR; PG8_WAIT_L(0); PG8_MMA(0, 1, At, B1); PG8_BAR;
            PG8_LDA(At, 1, 1); PG8_STA(PG8_SA(1, 0), 0, k3, last);
            PG8_BAR; PG8_WAIT_L(0); PG8_MMA(1, 0, At, B0); PG8_BAR; PG8_SCHED;
            PG8_STAGE(PG8_SB(1, 1), b3 + hstep, voffB);
            PG8_WAIT_V(6); PG8_BAR; PG8_MMA(1, 1, At, B1); PG8_BAR;
        }
        E(acc, cur, wid);
        if (!has_next) break;
#pragma unroll
        for (int a = 0; a < 2; ++a)
#pragma unroll
            for (int b = 0; b < 2; ++b)
#pragma unroll
                for (int m = 0; m < 4; ++m)
#pragma unroll
                    for (int n = 0; n < 2; ++n) acc[a][b][m][n] = (f32x4){0.f, 0.f, 0.f, 0.f};
        cur = nxt; cB = nB; cA = nA; ++ui;
        if constexpr (!DN) {
#pragma unroll
        for (int h = 0; h < 2; ++h)
#pragma unroll
            for (int i = 0; i < 2; ++i) cO[h][i] = nO[h][i]; }
    }
    PG8_WAIT_V(0);
    if (wr == 0) PG8_BAR;
    PG8_BAR;
#undef PG8_SA
#undef PG8_SB
#undef PG8_STAGE
#undef PG8_LDA
#undef PG8_LDB
#undef PG8_MMA
#undef PG8_WAIT_V
#undef PG8_WAIT_L
#undef PG8_BAR
#undef PG8_SCHED
#undef PG8_AOFF
#undef PG8_STA
}
}
struct DenseSched {
    static constexpr bool DENSE = true;
    int nM, nN, nwg, G, c, K; const char* Bt;
    __device__ __forceinline__ void init(int M, int N, int K_, const bf16_t* Bt_, int G_, int c_) { nM = M / 256; nN = N / 256; nwg = nM * nN; G = G_; c = c_; K = K_; Bt = (const char*)Bt_; }
    __device__ __forceinline__ bool next(int i, pg8::Unit& u) const {
        const long L = (long)i * G + c; if (L >= nwg) return false;
        int wgid = (int)L; { const int q = nwg / 8, r = nwg % 8, xcd = wgid % 8, off = wgid / 8; wgid = (xcd < r ? xcd * (q + 1) : r * (q + 1) + (xcd - r) * q) + off; }
        const int nig = 8 * nN, gid = wgid / nig, fm = gid * 8, gsz = (nM - fm) < 8 ? (nM - fm) : 8;
        u.pm = fm + ((wgid % nig) % gsz); u.pn = (wgid % nig) / gsz; u.e = 0; u.r0 = 0; return true;
    }
    __device__ __forceinline__ int a_row(const pg8::Unit& u, int r) const { return u.pm * 256 + r; }
    __device__ __forceinline__ const char* b_ptr(const pg8::Unit& u) const { return Bt + (size_t)u.pn * 256 * K * 2; }
};
template <bool GATHER> struct MoeSched {
    static constexpr bool DENSE = !GATHER;
    const LAS int* tstart; const LAS int* cnt; int nN, G, c, K, row_lo; const int* ltok; const char* Bt; size_t bstride;
    __device__ __forceinline__ bool next(int i, pg8::Unit& u) const {
        const long L = (long)i * G + c; const int ntile = __builtin_amdgcn_readfirstlane(tstart[NE1]); if (L >= (long)ntile * nN) return false;
        const int tile = (int)(L / nN); u.pn = (int)(L % nN);
        int e = 0;
#pragma unroll 1
        for (int step = 64; step >= 1; step >>= 1) { const int e2 = e + step; if (e2 <= NE && tstart[e2] <= tile) e = e2; }
        e = __builtin_amdgcn_readfirstlane(e); u.e = e; u.pm = __builtin_amdgcn_readfirstlane(tile); u.pn = __builtin_amdgcn_readfirstlane(u.pn); u.r0 = __builtin_amdgcn_readfirstlane((tile - tstart[e]) * 256); return true;
    }
    __device__ __forceinline__ int a_row(const pg8::Unit& u, int r) const {
        if (!GATHER) return u.pm * 256 + r;
        const int ri = u.r0 + r;
        if (u.e == NE) return ri < cnt[NE] ? row_lo + ri : row_lo;
        return ri < cnt[u.e] ? ltok[(size_t)u.e * ROWS + ri] : row_lo;
    }
    __device__ __forceinline__ const char* b_ptr(const pg8::Unit& u) const { return Bt + (size_t)u.e * bstride + (size_t)u.pn * 256 * K * 2; }
};

struct EpiProj {
    static constexpr bool PERM = true;
    bf16_t* O; int ldc;
    __device__ __forceinline__ void operator()(const f32x4 (&acc)[2][2][4][2], const pg8::Unit& u, const int wid) const {
        const int lane_ = lane_id_asm(), fr = lane_ & 15, fq = lane_ >> 4, wr = wid >> 2, wc = wid & 3;
        const int row0 = u.pm * 256 + wr * 64 + fr, col0 = u.pn * 256 + wc * 32 + 8 * fq;
#pragma unroll
        for (int ai = 0; ai < 2; ++ai)
#pragma unroll
            for (int m = 0; m < 4; ++m) { bf16_t* rowp = O + (size_t)(row0 + ai * 128 + m * 16) * ldc + col0;
#pragma unroll
                for (int bj = 0; bj < 2; ++bj) { const f32x4 v0 = acc[ai][bj][m][0], v1 = acc[ai][bj][m][1];
                    u32x4 w; w.x = pg8::cvt_pk_bf16(v0[0], v0[1]); w.y = pg8::cvt_pk_bf16(v0[2], v0[3]); w.z = pg8::cvt_pk_bf16(v1[0], v1[1]); w.w = pg8::cvt_pk_bf16(v1[2], v1[3]);
                    *(u32x4*)(rowp + bj * 128) = w; } }
    }
};
struct EpiRes {
    static constexpr bool PERM = false;
    const float* xsrc; const float* csrc; float* xdst; float* cdst; const float* gate;
    __device__ __forceinline__ void operator()(const f32x4 (&acc)[2][2][4][2], const pg8::Unit& u, const int wid) const {
        const int lane_ = lane_id_asm(), fr = lane_ & 15, fq = lane_ >> 4, wr = wid >> 2, wc = wid & 3;
        const int col0 = u.pn * 256 + wc * 32 + 4 * fq;
        const bool isc = u.pm < 4; const int sel = isc ? 4 : (u.pm - 4) >> 5;
        const float* src = isc ? csrc + (size_t)u.pm * 256 * D : xsrc + (size_t)(u.pm - 4) * 256 * D;
        float* dst = isc ? cdst + (size_t)u.pm * 256 * D : xdst + (size_t)(u.pm - 4) * 256 * D;
        f32x4 gv[2][2];
#pragma unroll
        for (int bj = 0; bj < 2; ++bj)
#pragma unroll
            for (int n = 0; n < 2; ++n) gv[bj][n] = *(const f32x4*)(gate + sel * 6144 + col0 + bj * 128 + n * 16);
#pragma unroll
        for (int ai = 0; ai < 2; ++ai)
#pragma unroll
            for (int m = 0; m < 4; ++m) { const size_t off = (size_t)(ai * 128 + wr * 64 + m * 16 + fr) * D + col0;
#pragma unroll
                for (int bj = 0; bj < 2; ++bj)
#pragma unroll
                    for (int n = 0; n < 2; ++n) { const f32x4 s = *(const f32x4*)(src + off + bj * 128 + n * 16); *(f32x4*)(dst + off + bj * 128 + n * 16) = s + gv[bj][n] * acc[ai][bj][m][n]; }
                asm volatile("" ::: "memory"); }
    }
};
struct EpiGU {
    static constexpr bool PERM = false;
    bf16_t* H;
    __device__ __forceinline__ void operator()(const f32x4 (&acc)[2][2][4][2], const pg8::Unit& u, const int wid) const {
        const int lane_ = lane_id_asm(), fr = lane_ & 15, fq = lane_ >> 4, wr = wid >> 2, wc = wid & 3;
        const int row0 = u.pm * 256 + wr * 64 + fr;
#pragma unroll
        for (int ai = 0; ai < 2; ++ai)
#pragma unroll
            for (int m = 0; m < 4; ++m) { bf16_t* rowp = H + (size_t)(row0 + ai * 128 + m * 16) * EH + 4 * fq;
#pragma unroll
                for (int bj = 0; bj < 2; ++bj) { const f32x4 g = acc[ai][bj][m][0], up = acc[ai][bj][m][1]; float h[4];
#pragma unroll
                    for (int j = 0; j < 4; ++j) h[j] = g[j] * rcp_(1.0f + __expf(-g[j])) * up[j];
                    u32x2 w; w.x = pg8::cvt_pk_bf16(h[0], h[1]); w.y = pg8::cvt_pk_bf16(h[2], h[3]);
                    *(u32x2*)(rowp + (u.pn * 256 + bj * 128 + wc * 32) / 2) = w; } }
    }
};
struct EpiY {
    static constexpr bool PERM = true;
    bf16_t* Y;
    __device__ __forceinline__ void operator()(const f32x4 (&acc)[2][2][4][2], const pg8::Unit& u, const int wid) const {
        const int lane_ = lane_id_asm(), fr = lane_ & 15, fq = lane_ >> 4, wr = wid >> 2, wc = wid & 3;
        const int row0 = u.pm * 256 + wr * 64 + fr, col0 = u.pn * 256 + wc * 32 + 8 * fq;
#pragma unroll
        for (int ai = 0; ai < 2; ++ai)
#pragma unroll
            for (int m = 0; m < 4; ++m) { bf16_t* rowp = Y + (size_t)(row0 + ai * 128 + m * 16) * 512 + col0;
#pragma unroll
                for (int bj = 0; bj < 2; ++bj) { const f32x4 v0 = acc[ai][bj][m][0], v1 = acc[ai][bj][m][1];
                    u32x4 w; w.x = pg8::cvt_pk_bf16(v0[0], v0[1]); w.y = pg8::cvt_pk_bf16(v0[2], v0[3]); w.z = pg8::cvt_pk_bf16(v1[0], v1[1]); w.w = pg8::cvt_pk_bf16(v1[2], v1[3]);
                    *(u32x4*)(rowp + bj * 128) = w; } }
    }
};
#define WSP(T, off) ((T*)(GAS T*)(p.ws + (unsigned long long)(off)))
#define POUT ((float*)(GAS float*)p.out)

constexpr int CONV_A_UNITS = 2048 + 512 + 64 + 8 + 12;
struct ConvDesc { const float* src; bf16_t* dst; int ldsrc, lddst, k0, n0, mode, nvalid; };
struct ConvDescA { int dummy;
    __device__ __forceinline__ ConvDesc operator()(const Cx& p, int u) const { ConvDesc c;
        if (u < 2048) { const int l = u >> 10, r = u & 1023; c.src = PIN(I_WIN) + (size_t)l * D * INW; c.ldsrc = INW; c.k0 = (r >> 6) * 64; c.n0 = (r & 63) * 64; c.nvalid = INW; c.dst = WSP(bf16_t, WS_WIN) + (size_t)l * NPROJ * D; c.lddst = D; c.mode = 0; }
        else if (u < 2560) { const int v = u - 2048, l = v >> 8, r = v & 255; c.src = PIN(I_WOUT) + (size_t)l * D * D; c.ldsrc = D; c.k0 = (r >> 4) * 64; c.n0 = (r & 15) * 64; c.nvalid = D; c.dst = WSP(bf16_t, WS_WOUT) + (size_t)l * D * D; c.lddst = D; c.mode = 0; }
        else if (u >= 2632) { const int v = u - 2632, m = v >> 2, r = v & 3;
            c.src = m < NL ? PIN(I_RW_W2) + (size_t)m * 64 * 256 : PIN(I_RW_AW2); c.ldsrc = 256; c.k0 = 0; c.n0 = r * 64; c.nvalid = 256; c.dst = WSP(bf16_t, WS_RWLR) + (size_t)m * 256 * 64; c.lddst = 64; c.mode = 0; }
        else if (u >= 2624) { const int v = u - 2624, l = v >> 2, r = v & 3;
            c.src = PIN(I_RW_GW2) + (size_t)l * 64 * 256; c.ldsrc = 256; c.k0 = 0; c.n0 = r * 64; c.nvalid = 256; c.dst = WSP(bf16_t, WS_RWGW) + (size_t)l * 256 * 64; c.lddst = 64; c.mode = 0; }
        else { const int v = u - 2560, l = v >> 5, lo = (v >> 4) & 1, r = v & 15;
            c.src = PIN(I_ROUT_W) + (size_t)l * D * NE; c.ldsrc = NE; c.k0 = r * 64; c.n0 = 0; c.nvalid = NE; c.dst = WSP(bf16_t, WS_ROUT) + (size_t)(l * 2 + lo) * NE * D; c.lddst = D; c.mode = lo ? 3 : 0; }
        return c; } };
constexpr int CONV_E_UNITS = NE1 * 192;
struct ConvDescE { int l;
    __device__ __forceinline__ ConvDesc operator()(const Cx& p, int u) const { ConvDesc c; const int e = u / 192, r = u % 192; c.nvalid = 1 << 30;
        if (r < 128) { const int up = r >> 6, q = r & 63;
            c.src = e < NE ? PIN(up ? I_EXP_U : I_EXP_G) + ((size_t)l * NE + e) * D * EH : PIN(up ? I_SH_U : I_SH_G) + (size_t)l * D * EH;
            c.ldsrc = EH; c.k0 = (q >> 2) * 64; c.n0 = (q & 3) * 64; c.dst = WSP(bf16_t, WS_EXPGU) + (size_t)e * 512 * D; c.lddst = D; c.mode = 1 + up; }
        else { const int q = r - 128;
            c.src = e < NE ? PIN(I_EXP_D) + ((size_t)l * NE + e) * EH * D : PIN(I_SH_D) + (size_t)l * EH * D;
            c.ldsrc = D; c.k0 = (q >> 4) * 64; c.n0 = (q & 15) * 64; c.dst = WSP(bf16_t, WS_EXPD) + (size_t)e * D * EH; c.lddst = EH; c.mode = 0; }
        return c; } };
template <class DescF> __device__ __forceinline__ void conv_run(const Cx& p, LAS float* tl, int total, const DescF& df) {
    const int t = p.tid; int u = p.bid; if (u >= total) return;
    float v[8]; ConvDesc c = df(p, u);
#define CONV_LD(cc) _Pragma("unroll") for (int j = 0; j < 8; ++j) { const int idx = t + NTHR * j, k = idx >> 6, n = idx & 63; v[j] = (cc).n0 + n < (cc).nvalid ? (cc).src[(size_t)((cc).k0 + k) * (cc).ldsrc + (cc).n0 + n] : 0.f; }
    CONV_LD(c)
    for (;;) {
#pragma unroll
        for (int j = 0; j < 8; ++j) { const int idx = t + NTHR * j; tl[(idx >> 6) * 65 + (idx & 63)] = v[j]; }
        __syncthreads();
        const int un = u + p.G; const bool more = un < total; const ConvDesc cn = df(p, more ? un : u);
        if (more) { CONV_LD(cn) }
#pragma unroll
        for (int j = 0; j < 4; ++j) { const int pi = t + NTHR * j, n = pi >> 5, k = (pi & 31) * 2; const int nn = c.n0 + n;
            const int row = (c.mode == 0 || c.mode == 3) ? nn : ((nn >> 4) * 32 + (nn & 15) + (c.mode == 2 ? 16 : 0));
            float v0 = tl[k * 65 + n], v1 = tl[(k + 1) * 65 + n];
            if (c.mode == 3) { v0 -= bf2f((bf16_t)f2bf(v0)); v1 -= bf2f((bf16_t)f2bf(v1)); }
            *(unsigned*)(c.dst + (size_t)row * c.lddst + c.k0 + k) = pk2(v0, v1); }
        __syncthreads();
        if (!more) break;
        c = cn; u = un;
    }
#undef CONV_LD
}
__device__ __forceinline__ void phase_mod(const Cx& p, LAS unsigned char* lds) {
    LAS float* sv = (LAS float*)lds; LAS float* red = sv + 5 * D;
    const int tid = p.tid;
    if (p.bid >= 192) return;
    for (int i = tid; i < 5 * D; i += NTHR) { const int j = i >> 10, k = i & 1023; const float c = j < 4 ? PIN(I_C)[j * D + k] : PIN(I_CCTX)[k]; sv[i] = siluf_(c); }
    __syncthreads();
    for (int u = p.bid; u < 192; u += p.G) {
        const int l = u / 96, cb = u % 96, kg = tid >> 6, cl = tid & 63;
        const float* w = PIN(I_WMOD) + (size_t)l * D * 6144 + cb * 64 + cl;
        float a0 = 0.f, a1 = 0.f, a2 = 0.f, a3 = 0.f, a4 = 0.f;
#pragma unroll 32
        for (int kk = 0; kk < 128; ++kk) { const int k = kg * 128 + kk; const float wv = w[(size_t)k * 6144];
            a0 += sv[k] * wv; a1 += sv[D + k] * wv; a2 += sv[2 * D + k] * wv; a3 += sv[3 * D + k] * wv; a4 += sv[4 * D + k] * wv; }
        red[(kg * 5 + 0) * 64 + cl] = a0; red[(kg * 5 + 1) * 64 + cl] = a1; red[(kg * 5 + 2) * 64 + cl] = a2; red[(kg * 5 + 3) * 64 + cl] = a3; red[(kg * 5 + 4) * 64 + cl] = a4;
        __syncthreads();
        if (tid < 320) { const int j = tid >> 6; float s = 0.f;
#pragma unroll
            for (int g = 0; g < 8; ++g) s += red[(g * 5 + j) * 64 + cl];
            WSP(float, WS_MOD)[((size_t)l * 5 + j) * 6144 + cb * 64 + cl] = s + PIN(I_BMOD)[l * 6144 + cb * 64 + cl]; }
        __syncthreads();
    }
}
__device__ __forceinline__ const float* res_row(const Cx& p, int layer_src0, int r) {
    if (r < CROWS) return (layer_src0 ? PIN(I_CTX) : (const float*)WSP(float, WS_CTXRES)) + (size_t)r * D;
    return (layer_src0 ? PIN(I_X) : (const float*)POUT) + (size_t)(r - CROWS) * D;
}
__device__ __forceinline__ int row_sel(int r) { return r < CROWS ? 4 : (r - CROWS) >> 13; }

__device__ __forceinline__ void norm_ld(const float* src, f32x4 (&v)[4], int lane) {
#pragma unroll
    for (int i = 0; i < 4; ++i) v[i] = *(const f32x4*)(src + 256 * i + 4 * lane);
}
__device__ __forceinline__ void norm_fin(const f32x4 (&v)[4], const float* g, const float* shift, const float* scale, bf16_t* dst, const bool tolds, LAS bf16_t* ldst, LAS bf16_t* ldlo, int lane) {
    float ss = 0.f;
#pragma unroll
    for (int i = 0; i < 4; ++i) ss += v[i][0] * v[i][0] + v[i][1] * v[i][1] + v[i][2] * v[i][2] + v[i][3] * v[i][3];
    ss = wsum(ss); const float rstd = rsq_(ss * (1.0f / D) + 1e-6f);
#pragma unroll
    for (int i = 0; i < 4; ++i) { const int col = 256 * i + 4 * lane; const f32x4 gv = *(const f32x4*)(g + col), sh = *(const f32x4*)(shift + col), sc = *(const f32x4*)(scale + col);
        const f32x4 y = v[i] * rstd * gv * (sc + 1.0f) + sh; u32x2 w; w.x = pk2(y[0], y[1]); w.y = pk2(y[2], y[3]);
        *(u32x2*)(dst + col) = w;
        if (tolds) { *(LAS u32x2*)(ldst + col) = w; u32x2 wl;
            wl.x = pk2(y[0] - __uint_as_float(w.x << 16), y[1] - __uint_as_float(w.x & 0xffff0000u)); wl.y = pk2(y[2] - __uint_as_float(w.y << 16), y[3] - __uint_as_float(w.y & 0xffff0000u));
            *(LAS u32x2*)(ldlo + col) = wl; } }
}
__device__ __forceinline__ void phase_norm1(const Cx& p, int layer) {
    const int lane = p.tid & 63, wave = p.tid >> 6;
    const float* mod = WSP(float, WS_MOD) + (size_t)layer * 5 * 6144; const float* g = PIN(I_N1G) + layer * D; bf16_t* hb = WSP(bf16_t, WS_HBUF);
    for (int r = p.bid * 16 + wave * 2; r < ROWS; r += p.G * 16) { f32x4 v0[4], v1[4];
        norm_ld(res_row(p, layer == 0, r), v0, lane); norm_ld(res_row(p, layer == 0, r + 1), v1, lane);
        const int s0 = row_sel(r), s1 = row_sel(r + 1);
        norm_fin(v0, g, mod + s0 * 6144 + 0, mod + s0 * 6144 + 1024, hb + (size_t)r * D, false, (LAS bf16_t*)0, (LAS bf16_t*)0, lane);
        norm_fin(v1, g, mod + s1 * 6144 + 0, mod + s1 * 6144 + 1024, hb + (size_t)(r + 1) * D, false, (LAS bf16_t*)0, (LAS bf16_t*)0, lane); }
}
__device__ __forceinline__ float sum8_(float v) { v += DPPF(v, 0xB1); v += DPPF(v, 0x4E); v += DPPF(v, 0x141); return v; }
__device__ __forceinline__ float sum16_(float v) { v = sum8_(v); v += DPPF(v, 0x140); return v; }
__device__ __forceinline__ void bf8_to_f(const u32x4 w, float (&f)[8]) {
#pragma unroll
    for (int q = 0; q < 4; ++q) { f[2 * q] = __uint_as_float(w[q] << 16); f[2 * q + 1] = __uint_as_float(w[q] & 0xffff0000u); } }
__device__ __forceinline__ void phase_prep(const Cx& p, LAS unsigned char* lds, int layer, int b) {
    const int lane = p.tid & 63, wave = __builtin_amdgcn_readfirstlane(p.tid >> 6);
    const bf16_t* proj = WSP(bf16_t, WS_PROJ);
    const int e0 = p.bid * NTHR + p.tid, e1 = e0 + p.G * NTHR; bf16_t sq0 = 0, sq1 = 0;
#define SCAL_COL(q) ((q) < 8 ? PC_DF + (q) : (q) < 16 ? PD_BF + ((q) - 8) : PD_AF + ((q) - 16))
    if (e0 < SB * 24) sq0 = proj[(size_t)tok_row(b, e0 / 24) * NPROJ + SCAL_COL(e0 % 24)];
    if (e1 < SB * 24) sq1 = proj[(size_t)tok_row(b, e1 / 24) * NPROJ + SCAL_COL(e1 % 24)];
    if (p.bid < SB / 33) {
        constexpr int ATS = 208;
        LAS unsigned char* WWt = lds; LAS unsigned char* AWt = lds + 256 * 144; LAS unsigned char* At = lds + 2 * 256 * 144;
        { const bf16_t* w2c = WSP(bf16_t, WS_RWLR) + (size_t)layer * 256 * 64; const bf16_t* awc = WSP(bf16_t, WS_RWLR) + (size_t)NL * 256 * 64;
#pragma unroll
          for (int q = 0; q < 4; ++q) { const int e = p.tid + NTHR * q, n = e >> 3, ch = e & 7;
              *(LAS u32x4*)(WWt + n * 144 + ch * 16) = *(const u32x4*)(w2c + n * 64 + ch * 8); *(LAS u32x4*)(AWt + n * 144 + ch * 16) = *(const u32x4*)(awc + n * 64 + ch * 8); } }
        const int h = wave & 3, half = wave >> 2, fr = lane & 15, fq = lane >> 4;
        float a0c[4], w0fc[4], w0bc[4], kkc[4], kac[4];
#pragma unroll
        for (int nt = 0; nt < 4; ++nt) { const int c = 64 * h + 16 * nt + fr; a0c[nt] = PIN(I_RW_A0)[layer * 256 + c]; w0fc[nt] = PIN(I_RW_W0)[(layer * 2 + 0) * 256 + c]; w0bc[nt] = PIN(I_RW_W0)[(layer * 2 + 1) * 256 + c];
            kkc[nt] = PIN(I_RW_KK)[layer * 256 + c]; kac[nt] = PIN(I_RW_KA)[layer * 256 + c]; }
        for (int u = p.bid; u < SB / 33; u += p.G) {
            if (p.tid < 33 * 12) { const int tk = p.tid / 12, ch = p.tid % 12; u32x4 w = *(const u32x4*)(proj + (size_t)tok_row(b, u * 33 + tk) * NPROJ + PB_WF + 8 * ch);
                if (ch < 8) {
#pragma unroll
                    for (int q = 0; q < 4; ++q) w[q] = pk2(tanhf_(__uint_as_float(w[q] << 16)), tanhf_(__uint_as_float(w[q] & 0xffff0000u))); }
                *(LAS u32x4*)(At + tk * ATS + ch * 16) = w; }
            bf16_t kvA[4][4], kvB[4];
#pragma unroll
            for (int j = 0; j < 4; ++j) { const bf16_t* pr = proj + (size_t)tok_row(b, u * 33 + 16 * half + 4 * fq + j) * NPROJ + PB_K + 64 * h + fr;
#pragma unroll
                for (int nt = 0; nt < 4; ++nt) kvA[nt][j] = pr[16 * nt]; }
            { const bf16_t* pr = proj + (size_t)tok_row(b, u * 33 + 32) * NPROJ + PB_K + 64 * h + fr;
#pragma unroll
              for (int nt = 0; nt < 4; ++nt) kvB[nt] = pr[16 * nt]; }
            __syncthreads();
#pragma unroll
            for (int pass = 0; pass < 2; ++pass) { if (pass == 1 && half != 0) break;
                const int mt = pass ? 2 : half; f32x4 sa[4], sf[4], sb[4];
                const bf16x8 awf = *(const LAS bf16x8*)(At + (16 * mt + fr) * ATS + fq * 16), awb = *(const LAS bf16x8*)(At + (16 * mt + fr) * ATS + 64 + fq * 16), aa = *(const LAS bf16x8*)(At + (16 * mt + fr) * ATS + 128 + fq * 16);
#pragma unroll
                for (int nt = 0; nt < 4; ++nt) { const int n = 64 * h + 16 * nt + fr; const f32x4 z = (f32x4){0.f, 0.f, 0.f, 0.f};
                    sf[nt] = __builtin_amdgcn_mfma_f32_16x16x32_bf16(awf, *(const LAS bf16x8*)(WWt + n * 144 + fq * 16), z, 0, 0, 0);
                    sb[nt] = __builtin_amdgcn_mfma_f32_16x16x32_bf16(awb, *(const LAS bf16x8*)(WWt + n * 144 + 64 + fq * 16), z, 0, 0, 0);
                    sa[nt] = __builtin_amdgcn_mfma_f32_16x16x32_bf16(aa, *(const LAS bf16x8*)(AWt + n * 144 + layer * 64 + fq * 16), z, 0, 0, 0); }
#pragma unroll
                for (int j = 0; j < 4; ++j) { if (pass == 1 && j > 0) break;
                    const int tk = 16 * mt + 4 * fq + j; const bool valid = tk < 33; const int s = u * 33 + tk;
                    float kv[4], kr[4], ssq = 0.f;
#pragma unroll
                    for (int nt = 0; nt < 4; ++nt) { kv[nt] = bf2f(pass ? kvB[nt] : kvA[nt][j]); kr[nt] = kv[nt] * kkc[nt]; ssq += kr[nt] * kr[nt]; }
                    const float rs = rsq_(sum16_(ssq) + 1e-6f);
#pragma unroll
                    for (int nt = 0; nt < 4; ++nt) { const float a = sigmoidf_(sa[nt][j] + a0c[nt]);
                        const float lwf = -__expf(-softplusf_(-(sf[nt][j] + w0fc[nt])) - 0.5f), lwb = -__expf(-softplusf_(-(sb[nt][j] + w0bc[nt])) - 0.5f);
                        const float kk = kr[nt] * rs; const size_t o = (size_t)s * 256 + 64 * h + 16 * nt + fr;
                        if (valid) { WSP(float, SC_RK)[o] = kv[nt] * (1.0f + (a - 1.0f) * kac[nt]); WSP(float, SC_RKK)[o] = kk; WSP(float, SC_RB)[o] = kk * a;
                            WSP(float, SC_RLW)[o] = lwf; WSP(float, SC_RLW)[(size_t)SB * 256 + o] = lwb; } } } }
            __syncthreads();
        }
    }
    __syncthreads();
    { LAS bf16_t* T = (LAS bf16_t*)lds; const int tid = p.tid; const float* dncw = PIN(I_DN_CW); const float* sscw = PIN(I_SS_CW); const float* sscb = PIN(I_SS_CB);
#define PC_LOAD(uu, v, vh) do { const int mixer_ = (uu) / (NTB * 3), r2_ = (uu) % (NTB * 3), rb_ = r2_ / 3, colbase_ = (mixer_ ? PD_Q : PC_X) + 256 * (r2_ % 3); \
          _Pragma("unroll") for (int q = 0; q < 12; ++q) { const int e = tid + NTHR * q, rr = e >> 11, tok = (e >> 5) & 63, ch = (e & 31) * 8; v[q] = (u32x4){0u, 0u, 0u, 0u}; \
              if (rb_ < 4) { if (rr == 1) v[q] = *(const u32x4*)(proj + (size_t)(b * NCTX + 64 * rb_ + tok) * NPROJ + colbase_ + ch); } \
              else { const int gr = rb_ - 4 + rr - 1; if (gr >= 0 && gr < GRIDH) v[q] = *(const u32x4*)(proj + (size_t)(CROWS + b * SEQ + gr * 64 + tok) * NPROJ + colbase_ + ch); } } \
          vh = (u32x4){0u, 0u, 0u, 0u}; if (tid < 192) { const int rr = tid >> 6, side = (tid >> 5) & 1, ch = (tid & 31) * 8;       \
              if (rb_ < 4 && rr == 1) { const int tk = side ? 64 * (rb_ + 1) : 64 * rb_ - 1; if (tk >= 0 && tk < NCTX) vh = *(const u32x4*)(proj + (size_t)(b * NCTX + tk) * NPROJ + colbase_ + ch); } } } while (0)
      int u = p.bid;
      if (u < 2 * NTB * 3) { u32x4 v[12], vh; PC_LOAD(u, v, vh);
        for (;;) { const int mixer = u / (NTB * 3), r2 = u % (NTB * 3), rb = r2 / 3, third = r2 % 3;
#pragma unroll
          for (int q = 0; q < 12; ++q) { const int e = tid + NTHR * q, rr = e >> 11, tok = (e >> 5) & 63, ch = (e & 31) * 8; *(LAS u32x4*)(T + (rr * 66 + tok + 1) * 256 + ch) = v[q]; }
          if (tid < 192) { const int rr = tid >> 6, side = (tid >> 5) & 1, ch = (tid & 31) * 8; *(LAS u32x4*)(T + (rr * 66 + (side ? 65 : 0)) * 256 + ch) = vh; }
          __syncthreads();
          const int un = u + p.G; const bool more = un < 2 * NTB * 3;
          if (more) PC_LOAD(un, v, vh);
          { const int c = tid & 255, th = tid >> 8, chn = 256 * third + c; float w[9];
            const float* cw = (mixer ? dncw : sscw) + (size_t)layer * 9 * 768 + chn;
#pragma unroll
            for (int k = 0; k < 9; ++k) w[k] = cw[k * 768];
            const float bias = mixer ? 0.f : sscb[layer * 768 + chn];
            bf16_t* dst = (mixer ? WSP(bf16_t, SC_DQ) : WSP(bf16_t, SC_SX)) + (size_t)(64 * rb) * 768 + chn;
#pragma unroll 2
            for (int tk = 0; tk < 32; ++tk) { const int x = 32 * th + tk; float acc = bias;
#pragma unroll
                for (int dy = 0; dy < 3; ++dy)
#pragma unroll
                    for (int dx = 0; dx < 3; ++dx) acc += w[dy * 3 + dx] * bf2f(T[(dy * 66 + x + dx) * 256 + c]);
                float y = siluf_(acc);
                if (mixer && third < 2) { const float ss = wsum(y * y); y *= rsq_(ss + 1e-6f); if (third == 0) y *= 0.125f; }
                dst[(size_t)x * 768] = (bf16_t)f2bf(y); } }
          __syncthreads();
          if (!more) break;
          u = un; } }
#undef PC_LOAD
#define SCAL_FIN(e_, raw_) do { const int s = (e_) / 24, q = (e_) % 24; const float xv = bf2f(raw_); \
          if (q < 8) { const int d = q >> 2, h = q & 3; WSP(float, SC_SDT)[(size_t)s * 8 + q] = softplusf_(xv + PIN(I_SS_DTB)[(layer * 2 + d) * 4 + h]); } \
          else if (q < 16) { WSP(float, SC_DG)[(size_t)s * 16 + (q - 8)] = sigmoidf_(xv); } \
          else { const int q2 = q - 16, d = q2 >> 2, h = q2 & 3; WSP(float, SC_DG)[(size_t)s * 16 + 8 + q2] = -__expf(PIN(I_DN_ALOG)[(layer * 2 + d) * 4 + h]) * softplusf_(xv + PIN(I_DN_DTB)[(layer * 2 + d) * 4 + h]); } } while (0)
      if (e0 < SB * 24) SCAL_FIN(e0, sq0);
      if (e1 < SB * 24) SCAL_FIN(e1, sq1);
      for (int e = e1 + p.G * NTHR; e < SB * 24; e += p.G * NTHR) { const bf16_t raw = proj[(size_t)tok_row(b, e / 24) * NPROJ + SCAL_COL(e % 24)]; SCAL_FIN(e, raw); }
#undef SCAL_FIN
#undef SCAL_COL
    }
}
__device__ __forceinline__ void phase_scan(const Cx& p, LAS unsigned char* lds, int layer, int b);
__device__ __forceinline__ void phase_post(const Cx& p, LAS unsigned char* lds, int layer, int b) {
    const int tid = p.tid, tsub = tid >> 7, c8 = (tid & 127) * 8, mixer = c8 >> 8, cm = c8 & 255, hh = cm >> 6;
    const bf16_t* proj = WSP(bf16_t, WS_PROJ); const bf16_t* of = WSP(bf16_t, SC_OF); const bf16_t* obk = WSP(bf16_t, SC_OB); bf16_t* yc = WSP(bf16_t, WS_HBUF);
    constexpr int PTS = 144, GTS = 260;
    LAS unsigned char* GWb = lds; LAS unsigned char* SGb = lds + 256 * PTS; LAS float* GT = (LAS float*)(lds + 256 * PTS + 48 * PTS);
    if ((int)p.bid < SB / 33) { const bf16_t* gsrc = WSP(bf16_t, WS_RWGW) + (size_t)layer * 256 * 64;
#pragma unroll
        for (int q = 0; q < 4; ++q) { const int e = tid + NTHR * q, n = e >> 3, ch = e & 7; *(LAS u32x4*)(GWb + n * PTS + ch * 16) = *(const u32x4*)(gsrc + n * 64 + ch * 8); } }
    float g0[8], g1[8], g2[8];
#pragma unroll
    for (int q = 0; q < 8; ++q) { const int c = cm + q; g0[q] = 0.f; g1[q] = 0.f; g2[q] = 0.f;
        if (mixer == 0) g0[q] = PIN(I_GLA_NG)[layer * 256 + c];
        else if (mixer == 1) { g0[q] = PIN(I_RW_LNG)[layer * 256 + c]; g1[q] = PIN(I_RW_LNB)[layer * 256 + c]; g2[q] = PIN(I_RW_RK)[layer * 256 + c]; }
        else if (mixer == 2) { g0[q] = PIN(I_SS_NG)[layer * 256 + c]; g1[q] = PIN(I_SS_D)[layer * 4 + hh]; }
        else g0[q] = PIN(I_DN_NG)[layer * 256 + c]; }
    const int col1 = (mixer == 0 ? PA_G : mixer == 1 ? PB_R : mixer == 2 ? PC_Z : PD_Z) + cm;
    for (int u = p.bid; u < SB / 33; u += p.G) {
        if (tid < 33 * 8) { const int tk = tid >> 3, ch = tid & 7; float gl[8]; bf8_to_f(*(const u32x4*)(proj + (size_t)tok_row(b, u * 33 + tk) * NPROJ + PB_G + 8 * ch), gl);
            *(LAS u32x4*)(SGb + tk * PTS + ch * 16) = (u32x4){pk2(sigmoidf_(gl[0]), sigmoidf_(gl[1])), pk2(sigmoidf_(gl[2]), sigmoidf_(gl[3])), pk2(sigmoidf_(gl[4]), sigmoidf_(gl[5])), pk2(sigmoidf_(gl[6]), sigmoidf_(gl[7]))}; }
        u32x4 rof, rob, ra1, ra2 = (u32x4){0u, 0u, 0u, 0u}; f32x4 rk0 = (f32x4){0.f, 0.f, 0.f, 0.f}, rk1 = rk0;
#define POST_LOAD(t0_) do { const int tk_ = (t0_) + tsub; const int s_ = u * 33 + (tk_ < 33 ? tk_ : 32); const bf16_t* pr_ = proj + (size_t)tok_row(b, s_) * NPROJ; \
        rof = *(const u32x4*)(of + (size_t)s_ * 1024 + c8); rob = *(const u32x4*)(obk + (size_t)s_ * 1024 + c8); ra1 = *(const u32x4*)(pr_ + col1); \
        if (mixer == 1) { ra2 = *(const u32x4*)(pr_ + PB_V + cm); rk0 = *(const f32x4*)(WSP(float, SC_RK) + (size_t)s_ * 256 + cm); rk1 = *(const f32x4*)(WSP(float, SC_RK) + (size_t)s_ * 256 + cm + 4); } \
        else if (mixer == 2) ra2 = *(const u32x4*)(WSP(bf16_t, SC_SX) + (size_t)s_ * 768 + cm); } while (0)
        POST_LOAD(0);
        __syncthreads();
        { const int lane = tid & 63, wave = tid >> 6, fr = lane & 15, fq = lane >> 4; f32x4 acc[3][2];
#pragma unroll
          for (int mt = 0; mt < 3; ++mt) { acc[mt][0] = (f32x4){0.f, 0.f, 0.f, 0.f}; acc[mt][1] = (f32x4){0.f, 0.f, 0.f, 0.f}; }
#pragma unroll
          for (int ks = 0; ks < 2; ++ks) { bf16x8 bb[2];
#pragma unroll
              for (int nt = 0; nt < 2; ++nt) bb[nt] = *(const LAS bf16x8*)(GWb + (16 * (2 * wave + nt) + fr) * PTS + ks * 64 + fq * 16);
#pragma unroll
              for (int mt = 0; mt < 3; ++mt) { const bf16x8 a = *(const LAS bf16x8*)(SGb + (16 * mt + fr) * PTS + ks * 64 + fq * 16);
                  acc[mt][0] = __builtin_amdgcn_mfma_f32_16x16x32_bf16(a, bb[0], acc[mt][0], 0, 0, 0); acc[mt][1] = __builtin_amdgcn_mfma_f32_16x16x32_bf16(a, bb[1], acc[mt][1], 0, 0, 0); } }
#pragma unroll
          for (int mt = 0; mt < 3; ++mt)
#pragma unroll
              for (int nt = 0; nt < 2; ++nt)
#pragma unroll
                  for (int j = 0; j < 4; ++j) GT[(16 * mt + 4 * fq + j) * GTS + 16 * (2 * wave + nt) + fr] = acc[mt][nt][j]; }
        __syncthreads();
#pragma unroll 1
        for (int t0 = 0; t0 < 36; t0 += 4) { const int tk = t0 + tsub; const bool live = tk < 33; const int tkc = live ? tk : 32, s = u * 33 + tkc, row = tok_row(b, s);
            const u32x4 cof = rof, cob = rob, ca1 = ra1, ca2 = ra2; const f32x4 k0 = rk0, k1 = rk1;
            if (t0 + 4 < 36) POST_LOAD(t0 + 4);
            float o[8], a[8], y[8];
            { float t1[8], t2[8]; bf8_to_f(cof, t1); bf8_to_f(cob, t2);
#pragma unroll
              for (int q = 0; q < 8; ++q) o[q] = t1[q] + t2[q]; }
            bf8_to_f(ca1, a);
            if (mixer == 0 || mixer == 3) { float ss = 0.f;
#pragma unroll
                for (int q = 0; q < 8; ++q) ss += o[q] * o[q];
                const float rs = rsq_(sum8_(ss) * (1.0f / 64.0f) + 1e-6f);
#pragma unroll
                for (int q = 0; q < 8; ++q) y[q] = o[q] * rs * g0[q] * siluf_(a[q]);
            } else if (mixer == 2) { float xs[8]; bf8_to_f(ca2, xs); float ss = 0.f;
#pragma unroll
                for (int q = 0; q < 8; ++q) { y[q] = (o[q] + g1[q] * xs[q]) * siluf_(a[q]); ss += y[q] * y[q]; }
                const float rs = rsq_(sum16_(ss) * (1.0f / 128.0f) + 1e-6f);
#pragma unroll
                for (int q = 0; q < 8; ++q) y[q] *= rs * g0[q];
            } else { float vv[8]; bf8_to_f(ca2, vv);
                float su = 0.f, bo = 0.f;
#pragma unroll
                for (int q = 0; q < 8; ++q) { su += o[q]; bo += a[q] * (q < 4 ? k0[q & 3] : k1[q & 3]) * g2[q]; }
                const float mu = sum8_(su) * (1.0f / 64.0f); bo = sum8_(bo); float va = 0.f;
#pragma unroll
                for (int q = 0; q < 8; ++q) { o[q] -= mu; va += o[q] * o[q]; }
                const float rs = rsq_(sum8_(va) * (1.0f / 64.0f) + 64e-5f);
                const f32x4 gt0 = *(const LAS f32x4*)(GT + tkc * GTS + cm), gt1 = *(const LAS f32x4*)(GT + tkc * GTS + cm + 4);
#pragma unroll
                for (int q = 0; q < 8; ++q) y[q] = (o[q] * rs * g0[q] + g1[q] + bo * vv[q]) * (q < 4 ? gt0[q & 3] : gt1[q & 3]); }
            if (live) *(u32x4*)(yc + (size_t)row * D + c8) = (u32x4){pk2(y[0], y[1]), pk2(y[2], y[3]), pk2(y[4], y[5]), pk2(y[6], y[7])};
        }
#undef POST_LOAD
    }
}
constexpr int N2_TILE = 32, N2_STRIDE = 2064;
__device__ __forceinline__ void phase_norm2(const Cx& p, LAS unsigned char* lds, int layer, int row_lo) {
    const int tid = p.tid, lane = tid & 63, wave = __builtin_amdgcn_readfirstlane(tid >> 6), fr = lane & 15, fq = lane >> 4;
    const float* mod = WSP(float, WS_MOD) + (size_t)layer * 5 * 6144; const float* g = PIN(I_N2G) + layer * D; bf16_t* hb = WSP(bf16_t, WS_HBUF);
    const bf16_t* rt = WSP(bf16_t, WS_ROUT) + (size_t)layer * 2 * NE * D;
    LAS float* lg = (LAS float*)(lds + 2 * N2_TILE * N2_STRIDE);
    unsigned* cnt = WSP(unsigned, WS_CTL) + CW_CNT + layer * 80 * 16; int* ltok = WSP(int, WS_LTOK); int* tokt = WSP(int, WS_TOKT);
    const float rbias = PIN(I_ROUT_B)[layer * NE + lane];
    const int nun = (ROWS - row_lo) / N2_TILE;
    for (int u = p.bid; u < nun; u += p.G) { const int r0 = row_lo + u * N2_TILE;
#pragma unroll 1
        for (int i = 0; i < 4; i += 2) { const int tr = 4 * wave + i, r = r0 + tr; f32x4 v0[4], v1[4];
            norm_ld(res_row(p, 0, r), v0, lane); norm_ld(res_row(p, 0, r + 1), v1, lane);
            const int s0 = row_sel(r), s1 = row_sel(r + 1);
            norm_fin(v0, g, mod + s0 * 6144 + 3072, mod + s0 * 6144 + 4096, hb + (size_t)r * D, true, (LAS bf16_t*)(lds + tr * N2_STRIDE), (LAS bf16_t*)(lds + N2_TILE * N2_STRIDE + tr * N2_STRIDE), lane);
            norm_fin(v1, g, mod + s1 * 6144 + 3072, mod + s1 * 6144 + 4096, hb + (size_t)(r + 1) * D, true, (LAS bf16_t*)(lds + (tr + 1) * N2_STRIDE), (LAS bf16_t*)(lds + N2_TILE * N2_STRIDE + (tr + 1) * N2_STRIDE), lane); }
        __syncthreads();
        { const int mt = wave >> 2, nt = wave & 3; f32x4 acc = (f32x4){0.f, 0.f, 0.f, 0.f};
          const LAS unsigned char* ap = lds + (16 * mt + fr) * N2_STRIDE + fq * 16; const bf16_t* bp = rt + (size_t)(16 * nt + fr) * D + fq * 8;
#pragma unroll 4
          for (int ks = 0; ks < 32; ++ks) { const bf16x8 a = *(const LAS bf16x8*)(ap + ks * 64), al = *(const LAS bf16x8*)(ap + N2_TILE * N2_STRIDE + ks * 64);
              const bf16x8 bb = *(const bf16x8*)(bp + ks * 32), bl = *(const bf16x8*)(bp + NE * D + ks * 32);
              acc = __builtin_amdgcn_mfma_f32_16x16x32_bf16(a, bb, acc, 0, 0, 0); acc = __builtin_amdgcn_mfma_f32_16x16x32_bf16(al, bb, acc, 0, 0, 0); acc = __builtin_amdgcn_mfma_f32_16x16x32_bf16(a, bl, acc, 0, 0, 0); }
#pragma unroll
          for (int j = 0; j < 4; ++j) lg[(16 * mt + 4 * fq + j) * 64 + 16 * nt + fr] = acc[j]; }
        __syncthreads();
#pragma unroll 1
        for (int i = 0; i < 4; ++i) { const int tr = 4 * wave + i, r = r0 + tr;
            const float sc = sigmoidf_(lg[tr * 64 + lane]); float sel = sc + rbias; float ssum = 0.f; int myE = 0; float myS = 0.f;
#pragma unroll 1
            for (int k = 0; k < TOPK; ++k) { float bv = sel; int bi = lane;
#define ARGSTEP(OV, OI) do { const float ov_ = (OV); const int oi_ = (OI); if (ov_ > bv || (ov_ == bv && oi_ < bi)) { bv = ov_; bi = oi_; } } while (0)
                ARGSTEP(DPPF(bv, 0xB1), DPPI(bi, 0xB1)); ARGSTEP(DPPF(bv, 0x4E), DPPI(bi, 0x4E)); ARGSTEP(DPPF(bv, 0x141), DPPI(bi, 0x141)); ARGSTEP(DPPF(bv, 0x140), DPPI(bi, 0x140));
                ARGSTEP(__uint_as_float(__builtin_amdgcn_ds_swizzle(__float_as_uint(bv), 0x401F)), __builtin_amdgcn_ds_swizzle(bi, 0x401F));
                { const float v0 = rl(bv, 0), v1 = rl(bv, 32); const int i0 = __builtin_amdgcn_readlane(bi, 0), i1 = __builtin_amdgcn_readlane(bi, 32); if (v1 > v0 || (v1 == v0 && i1 < i0)) { bv = v1; bi = i1; } else { bv = v0; bi = i0; } }
#undef ARGSTEP
                const int e = __builtin_amdgcn_readfirstlane(bi); const float se = rl(sc, e);
                ssum += se; if (lane == k) { myE = e; myS = se; } if (lane == e) sel = -1e30f; }
            if (lane < TOPK) { const unsigned pos = atomicAdd(cnt + myE * 16, 1u); ltok[(size_t)myE * ROWS + pos] = r; tokt[(size_t)r * 16 + lane] = (myE << 16) | (int)pos; ((float*)tokt)[(size_t)r * 16 + 8 + lane] = myS / ssum * 2.5f; } }
        __syncthreads();
    }
}
__device__ __forceinline__ void moe_table(const Cx& p, LAS int* tb, int layer, int row_lo) {
    const unsigned* cnt = WSP(unsigned, WS_CTL) + CW_CNT + layer * 80 * 16;
    if (p.tid < 64) { const int lane = p.tid;
        const int c = (int)__hip_atomic_load(cnt + lane * 16, __ATOMIC_RELAXED, __HIP_MEMORY_SCOPE_AGENT); const int t = (c + 255) >> 8; int incl = t;
#pragma unroll
        for (int o = 1; o < 64; o <<= 1) { const int v = __builtin_amdgcn_ds_bpermute((lane - o) << 2, incl); if (lane >= o) incl += v; }
        tb[lane] = c; tb[128 + lane] = incl - t;
        if (lane == 63) { const int cs = ROWS - row_lo; tb[NE] = cs; tb[128 + NE] = incl; tb[128 + NE1] = incl + ((cs + 255) >> 8); } }
    __syncthreads();
}
__device__ __forceinline__ void phase_combine(const Cx& p, const LAS int* tb, int layer, int row_lo, int half) {
    const int lane = p.tid & 63, wave = p.tid >> 6; const bf16_t* Y = WSP(bf16_t, WS_Y); const int* tokt = WSP(int, WS_TOKT);
    const float* gate = WSP(float, WS_MOD) + (size_t)layer * 5 * 6144 + 5120; const int col = 512 * half + 8 * lane; const int shbase = tb[128 + NE] * 256;
#pragma unroll 2
    for (int r = row_lo + p.bid * 8 + wave; r < ROWS; r += p.G * 8) {
        const int sw = lane < 16 ? tokt[(size_t)r * 16 + lane] : 0;
        float a[8];
        { const u32x4 y = *(const u32x4*)(Y + (size_t)(shbase + (r - row_lo)) * 512 + 8 * lane);
#pragma unroll
          for (int q = 0; q < 4; ++q) { a[2 * q] = __uint_as_float(y[q] << 16); a[2 * q + 1] = __uint_as_float(y[q] & 0xffff0000u); } }
#pragma unroll
        for (int k = 0; k < 8; ++k) { const int sl = __builtin_amdgcn_readlane(sw, k); const float w = __uint_as_float(__builtin_amdgcn_readlane(sw, 8 + k));
            const int hrow = tb[128 + (sl >> 16)] * 256 + (sl & 0xffff); const u32x4 y = *(const u32x4*)(Y + (size_t)hrow * 512 + 8 * lane);
#pragma unroll
            for (int q = 0; q < 4; ++q) { a[2 * q] += w * __uint_as_float(y[q] << 16); a[2 * q + 1] += w * __uint_as_float(y[q] & 0xffff0000u); } }
        float* x = (float*)res_row(p, 0, r) + col; const float* gp = gate + row_sel(r) * 6144 + col;
#pragma unroll
        for (int q = 0; q < 2; ++q) { const f32x4 gv = *(const f32x4*)(gp + 4 * q); f32x4 xv = *(const f32x4*)(x + 4 * q);
            xv[0] += gv[0] * a[4 * q]; xv[1] += gv[1] * a[4 * q + 1]; xv[2] += gv[2] * a[4 * q + 2]; xv[3] += gv[3] * a[4 * q + 3]; *(f32x4*)(x + 4 * q) = xv; }
    }
}
__device__ __forceinline__ void phase_final(const Cx& p) {
    const int lane = p.tid & 63, wave = p.tid >> 6; const float* g = PIN(I_FNG);
    for (int r = p.bid * 16 + wave * 2; r < NB * SEQ; r += p.G * 16) { f32x4 v[2][4];
        norm_ld(POUT + (size_t)r * D, v[0], lane); norm_ld(POUT + (size_t)(r + 1) * D, v[1], lane);
#pragma unroll
        for (int q = 0; q < 2; ++q) { float* x = POUT + (size_t)(r + q) * D; float ss = 0.f;
#pragma unroll
            for (int i = 0; i < 4; ++i) ss += v[q][i][0] * v[q][i][0] + v[q][i][1] * v[q][i][1] + v[q][i][2] * v[q][i][2] + v[q][i][3] * v[q][i][3];
            ss = wsum(ss); const float rstd = rsq_(ss * (1.0f / D) + 1e-6f);
#pragma unroll
            for (int i = 0; i < 4; ++i) *(f32x4*)(x + 256 * i + 4 * lane) = v[q][i] * rstd * *(const f32x4*)(g + 256 * i + 4 * lane); } }
}
__device__ __forceinline__ int chain_tb(int n, int d) { return d == 0 ? n : (n < 4 ? 3 - n : 135 - n); }
__device__ __forceinline__ int cslot(int u) { return (u & 7) * NTB + (u >> 3); }
__device__ __forceinline__ int tb_row0(int b, int tb) { return tb < 4 ? b * NCTX + 64 * tb : CROWS + b * SEQ + 64 * (tb - 4); }
constexpr int TS = 144;
template <int K, int NT> __device__ __forceinline__ void mm_rows(const LAS unsigned char* A, int lda, const LAS unsigned char* Bt, int ldb, int mt, int nt0, int fr, int fq, f32x4 (&acc)[NT]) {
#pragma unroll
    for (int ks = 0; ks < K / 32; ++ks) { const bf16x8 a = *(const LAS bf16x8*)(A + (16 * mt + fr) * lda + ks * 64 + fq * 16);
#pragma unroll
        for (int nt = 0; nt < NT; ++nt) { const bf16x8 bb = *(const LAS bf16x8*)(Bt + (16 * (nt0 + nt) + fr) * ldb + ks * 64 + fq * 16);
            acc[nt] = __builtin_amdgcn_mfma_f32_16x16x32_bf16(a, bb, acc[nt], 0, 0, 0); } }
}
#define UNIT_LOOP(u, N, OFF) for (int u = (p.bid + p.G - ((OFF) % p.G)) % p.G; u < (N); u += p.G)
__device__ __forceinline__ void gla_p1(const Cx& p, LAS unsigned char* lds, int layer, int b) {
    const int tid = p.tid, lane = tid & 63, wave = __builtin_amdgcn_readfirstlane(tid >> 6), fr = lane & 15, fq = lane >> 4;
    LAS unsigned char* ksT = lds; LAS unsigned char* vT = lds + 64 * TS; LAS float* gs = (LAS float*)(lds + 2 * 64 * TS); LAS float* glb = gs + 512;
    const bf16_t* proj = WSP(bf16_t, WS_PROJ); const int mt = wave >> 1, nt0 = (wave & 1) * 2; const int cl = lane, tg = wave;
    const float* w2p = PIN(I_GLA_W2); const float* gbp = PIN(I_GLA_B);
    float w2[16], gb; unsigned gw; bf16_t kq[8], vq[8];
#define GLA1_LOAD(uu) do { const int tb_ = (uu) >> 3, h_ = ((uu) >> 1) & 3, d_ = (uu) & 1, c_ = 64 * h_ + cl; const bf16_t* pr_ = proj + (size_t)tb_row0(b, tb_) * NPROJ; \
        _Pragma("unroll") for (int r = 0; r < 16; ++r) w2[r] = w2p[((size_t)(layer * 2 + d_) * 16 + r) * 256 + c_]; \
        gb = gbp[(layer * 2 + d_) * 256 + c_]; \
        { const int e = tid * 2, i = e >> 4, r = e & 15; gw = *(const unsigned*)(pr_ + (size_t)i * NPROJ + (d_ ? PA_GB : PA_GF) + r); } \
        _Pragma("unroll") for (int i8 = 0; i8 < 8; ++i8) { const bf16_t* pa = pr_ + (size_t)(8 * tg + i8) * NPROJ; kq[i8] = pa[PA_K + c_]; vq[i8] = pa[PA_V + c_]; } } while (0)
    int u = (p.bid + p.G) % p.G;
    if (u < NUNIT) GLA1_LOAD(u);
    for (; u < NUNIT; u += p.G) { const int d = u & 1;
        glb[tid * 2] = __uint_as_float(gw << 16); glb[tid * 2 + 1] = __uint_as_float(gw & 0xffff0000u);
        __syncthreads();
        float bl[8]; float run = 0.f;
#pragma unroll
        for (int ii = 0; ii < 8; ++ii) { const int i8 = d ? 7 - ii : ii; const LAS float* gl_ = glb + (8 * tg + i8) * 16; float z = gb;
#pragma unroll
            for (int r = 0; r < 16; ++r) z += gl_[r] * w2[r];
            run += logsigmoidf_(z) * (1.0f / 16.0f); if (d) bl[7 - ii] = run; else bl[ii] = run; }
        gs[tg * 64 + cl] = run;
        __syncthreads();
        float off = 0.f, total = 0.f;
#pragma unroll
        for (int g2 = 0; g2 < 8; ++g2) { const float t = gs[g2 * 64 + cl]; total += t; if (d ? g2 > tg : g2 < tg) off += t; }
#pragma unroll
        for (int i8 = 0; i8 < 8; i8 += 2) { const int i = 8 * tg + i8;
            const float ka = bf2f(kq[i8]) * __expf(total - (bl[i8] + off)), kb = bf2f(kq[i8 + 1]) * __expf(total - (bl[i8 + 1] + off));
            *(LAS unsigned*)(ksT + cl * TS + i * 2) = pk2(ka, kb); *(LAS unsigned*)(vT + cl * TS + i * 2) = (unsigned)vq[i8] | ((unsigned)vq[i8 + 1] << 16); }
        if (u + p.G < NUNIT) GLA1_LOAD(u + p.G);
        if (tg == 0) WSP(float, SC_GLA_DEC)[(size_t)cslot(u) * 64 + cl] = __expf(total);
        __syncthreads();
        { f32x4 acc[2] = {(f32x4){0.f, 0.f, 0.f, 0.f}, (f32x4){0.f, 0.f, 0.f, 0.f}}; float* kv = WSP(float, SC_GLA_S) + (size_t)cslot(u) * 4096;
          mm_rows<64, 2>(vT, TS, ksT, TS, mt, nt0, fr, fq, acc);
#pragma unroll
          for (int t = 0; t < 2; ++t) *(f32x4*)(kv + (16 * (nt0 + t) + fr) * 64 + 16 * mt + 4 * fq) = acc[t]; }
        __syncthreads();
    }
#undef GLA1_LOAD
}
__device__ __forceinline__ void gla_chain(const Cx& p, int h, int d, int part) {
    if (p.tid >= 256) return;
    const int e0 = part * 1024 + p.tid * 4, dk = e0 >> 6;
    f32x4 s0 = (f32x4){0.f, 0.f, 0.f, 0.f};
    f32x4 n0[6]; float dc[6];
#define GC_LD(q, n_) do { const int u_ = cslot((chain_tb((n_), d) * 4 + h) * 2 + d); n0[q] = *(const f32x4*)(WSP(float, SC_GLA_S) + (size_t)u_ * 4096 + e0); dc[q] = WSP(float, SC_GLA_DEC)[(size_t)u_ * 64 + dk]; } while (0)
#define GC_ST(q, n_) do { const int u_ = cslot((chain_tb((n_), d) * 4 + h) * 2 + d); float* k_ = WSP(float, SC_GLA_S) + (size_t)u_ * 4096 + e0; \
        const f32x4 a0_ = n0[q]; const float de_ = dc[q]; GC_LD(q, (n_) + 6 < NTB ? (n_) + 6 : NTB - 1); *(f32x4*)k_ = s0; s0 = s0 * de_ + a0_; } while (0)
    GC_LD(0, 0); GC_LD(1, 1); GC_LD(2, 2); GC_LD(3, 3); GC_LD(4, 4); GC_LD(5, 5);
#pragma unroll 1
    for (int n = 0; n < NTB; n += 6) { GC_ST(0, n); GC_ST(1, n + 1); GC_ST(2, n + 2); GC_ST(3, n + 3); GC_ST(4, n + 4); GC_ST(5, n + 5); }
#undef GC_LD
#undef GC_ST
}
__device__ __forceinline__ void gla_p2(const Cx& p, LAS unsigned char* lds, int layer, int b) {
    const int tid = p.tid, lane = tid & 63, wave = __builtin_amdgcn_readfirstlane(tid >> 6), fr = lane & 15, fq = lane >> 4;
    LAS unsigned char* qt = lds; LAS unsigned char* kt = lds + 64 * TS; LAS unsigned char* vT = lds + 2 * 64 * TS; LAS unsigned char* sT = lds + 3 * 64 * TS; LAS unsigned char* att = lds + 4 * 64 * TS;
    LAS float* gs = (LAS float*)(lds + 5 * 64 * TS); LAS float* glb = gs + 512;
    const bf16_t* proj = WSP(bf16_t, WS_PROJ); const int cl = lane, tg = wave;
    const float* w2p = PIN(I_GLA_W2); const float* gbp = PIN(I_GLA_B);
    float w2[16], gb; unsigned gw; bf16_t qq[8], kq[8], vq[8]; float sq[8];
#define GLA2_LOAD(uu) do { const int tb_ = (uu) >> 3, h_ = ((uu) >> 1) & 3, d_ = (uu) & 1, c_ = 64 * h_ + cl; const bf16_t* pr_ = proj + (size_t)tb_row0(b, tb_) * NPROJ; \
        _Pragma("unroll") for (int r = 0; r < 16; ++r) w2[r] = w2p[((size_t)(layer * 2 + d_) * 16 + r) * 256 + c_]; \
        gb = gbp[(layer * 2 + d_) * 256 + c_]; \
        { const int e = tid * 2, i = e >> 4, r = e & 15; gw = *(const unsigned*)(pr_ + (size_t)i * NPROJ + (d_ ? PA_GB : PA_GF) + r); } \
        _Pragma("unroll") for (int i8 = 0; i8 < 8; ++i8) { const bf16_t* pa = pr_ + (size_t)(8 * tg + i8) * NPROJ; qq[i8] = pa[PA_Q + c_]; kq[i8] = pa[PA_K + c_]; vq[i8] = pa[PA_V + c_]; } \
        { const float* sp_ = WSP(float, SC_GLA_S) + (size_t)cslot(uu) * 4096; _Pragma("unroll") for (int q = 0; q < 8; ++q) sq[q] = sp_[tid + NTHR * q]; } } while (0)
    int u = (p.bid + p.G - (128 % p.G)) % p.G;
    if (u < NUNIT) GLA2_LOAD(u);
    for (; u < NUNIT; u += p.G) { const int tb = u >> 3, h = (u >> 1) & 3, d = u & 1; const int s0 = 64 * tb;
        glb[tid * 2] = __uint_as_float(gw << 16); glb[tid * 2 + 1] = __uint_as_float(gw & 0xffff0000u);
#pragma unroll
        for (int q = 0; q < 8; ++q) { const int e = tid + NTHR * q, dk = e >> 6, dv = e & 63; *(LAS bf16_t*)(sT + dv * TS + dk * 2) = (bf16_t)f2bf(sq[q]); }
        __syncthreads();
        float bl[8]; float run = 0.f;
#pragma unroll
        for (int ii = 0; ii < 8; ++ii) { const int i8 = d ? 7 - ii : ii; const LAS float* gl_ = glb + (8 * tg + i8) * 16; float z = gb;
#pragma unroll
            for (int r = 0; r < 16; ++r) z += gl_[r] * w2[r];
            run += logsigmoidf_(z) * (1.0f / 16.0f); if (d) bl[7 - ii] = run; else bl[ii] = run; }
        gs[tg * 64 + cl] = run;
        __syncthreads();
        float off = 0.f;
#pragma unroll
        for (int g2 = 0; g2 < 8; ++g2) if (d ? g2 > tg : g2 < tg) off += gs[g2 * 64 + cl];
#pragma unroll
        for (int i8 = 0; i8 < 8; ++i8) { const int i = 8 * tg + i8; const float bi = bl[i8] + off;
            *(LAS bf16_t*)(qt + i * TS + cl * 2) = (bf16_t)f2bf(bf2f(qq[i8]) * 0.125f * __expf(bi));
            *(LAS bf16_t*)(kt + i * TS + cl * 2) = (bf16_t)f2bf(bf2f(kq[i8]) * __expf(-bi));
            *(LAS bf16_t*)(vT + cl * TS + i * 2) = vq[i8]; }
        if (u + p.G < NUNIT) GLA2_LOAD(u + p.G);
        __syncthreads();
        const int mt = wave >> 1, nt0 = (wave & 1) * 2;
        { f32x4 acc[2] = {(f32x4){0.f, 0.f, 0.f, 0.f}, (f32x4){0.f, 0.f, 0.f, 0.f}};
          mm_rows<64, 2>(qt, TS, kt, TS, mt, nt0, fr, fq, acc);
#pragma unroll
          for (int t = 0; t < 2; ++t)
#pragma unroll
              for (int j = 0; j < 4; ++j) { const int i = 16 * mt + 4 * fq + j, jj = 16 * (nt0 + t) + fr; const bool keep = d ? jj >= i : jj <= i;
                  *(LAS bf16_t*)(att + i * TS + jj * 2) = (bf16_t)f2bf(keep ? acc[t][j] : 0.f); } }
        __syncthreads();
        { f32x4 acc[2] = {(f32x4){0.f, 0.f, 0.f, 0.f}, (f32x4){0.f, 0.f, 0.f, 0.f}};
          mm_rows<64, 2>(att, TS, vT, TS, mt, nt0, fr, fq, acc);
          mm_rows<64, 2>(qt, TS, sT, TS, mt, nt0, fr, fq, acc);
          bf16_t* ob = WSP(bf16_t, d ? SC_OB : SC_OF);
#pragma unroll
          for (int t = 0; t < 2; ++t)
#pragma unroll
              for (int j = 0; j < 4; ++j) ob[(size_t)(s0 + 16 * mt + 4 * fq + j) * 1024 + 64 * h + 16 * (nt0 + t) + fr] = (bf16_t)f2bf(acc[t][j]); }
        __syncthreads();
    }
}
#undef GLA2_LOAD
constexpr int TS2 = 272;
__device__ __forceinline__ float ssd_acum(float a, int d, int lane, float& total) {
    float pre = a;
#pragma unroll
    for (int o = 1; o < 64; o <<= 1) { const float t = shup_(pre, lane, o); if (lane >= o) pre += t; }
    total = rl(pre, 63);
    return d ? total - pre + a : pre;
}
__device__ __forceinline__ void ssd_p1(const Cx& p, LAS unsigned char* lds, int layer, int b) {
    const int tid = p.tid, lane = tid & 63, wave = __builtin_amdgcn_readfirstlane(tid >> 6), fr = lane & 15, fq = lane >> 4;
    LAS unsigned char* BT = lds; LAS unsigned char* xT = lds + 128 * TS; LAS float* AC = (LAS float*)(lds + 128 * TS + 64 * TS);
    const float* alogp = PIN(I_SS_ALOG);
    u32x4 bq[2], xq; float dtq;
#define SSD1_LOAD(uu) do { const int tb_ = (uu) >> 3, g_ = ((uu) >> 2) & 1, hd_ = (uu) & 3, h_ = 2 * g_ + (hd_ >> 1), d_ = hd_ & 1; \
        const bf16_t* sx_ = WSP(bf16_t, SC_SX) + (size_t)(64 * tb_ + lane) * 768; \
        bq[0] = *(const u32x4*)(sx_ + 256 + 128 * g_ + 16 * wave); bq[1] = *(const u32x4*)(sx_ + 256 + 128 * g_ + 16 * wave + 8); \
        xq = *(const u32x4*)(sx_ + 64 * h_ + 8 * wave); dtq = WSP(float, SC_SDT)[(size_t)(64 * tb_ + lane) * 8 + d_ * 4 + h_]; } while (0)
    int u3 = (p.bid + p.G - (32 % p.G)) % p.G;
    if (u3 < NTB * 8) SSD1_LOAD(u3);
    for (; u3 < NTB * 8; u3 += p.G) { const int tb = u3 >> 3, g = (u3 >> 2) & 1, hd = u3 & 3, h = 2 * g + (hd >> 1), d = hd & 1;
        if (wave == 0) { const float aneg = -__expf(alogp[(layer * 2 + d) * 4 + h]);
            float tot; const float ac = ssd_acum(aneg * dtq, d, lane, tot); AC[lane] = ac; if (lane == 0) { AC[64] = tot; WSP(float, SC_SSD_CD)[cslot((tb * 4 + h) * 2 + d)] = __expf(tot); } }
#pragma unroll
        for (int q = 0; q < 2; ++q)
#pragma unroll
            for (int k = 0; k < 8; ++k) *(LAS bf16_t*)(BT + (16 * wave + 8 * q + k) * TS + lane * 2) = (bf16_t)(bq[q][k >> 1] >> (16 * (k & 1)));
        __syncthreads();
        { const float f = dtq * __expf(AC[64] - AC[lane]);
#pragma unroll
          for (int k = 0; k < 8; ++k) *(LAS bf16_t*)(xT + (8 * wave + k) * TS + lane * 2) = (bf16_t)f2bf(bf2f((bf16_t)(xq[k >> 1] >> (16 * (k & 1)))) * f); }
        if (u3 + p.G < NTB * 8) SSD1_LOAD(u3 + p.G);
        __syncthreads();
        { float* cs = WSP(float, SC_SSD_S) + (size_t)cslot((tb * 4 + h) * 2 + d) * 8192; f32x4 acc[4];
#pragma unroll
          for (int t = 0; t < 4; ++t) acc[t] = (f32x4){0.f, 0.f, 0.f, 0.f};
          mm_rows<64, 4>(BT, TS, xT, TS, wave, 0, fr, fq, acc);
#pragma unroll
          for (int t = 0; t < 4; ++t) *(f32x4*)(cs + (16 * t + fr) * 128 + 16 * wave + 4 * fq) = acc[t]; }
        __syncthreads();
    }
#undef SSD1_LOAD
}
__device__ __forceinline__ void ssd_chain(const Cx& p, int h, int d, int part) {
    if (p.tid >= 256) return;
    const int e0 = part * 1024 + p.tid * 4;
    f32x4 s = (f32x4){0.f, 0.f, 0.f, 0.f}; f32x4 nx[6]; float cd[6];
#define SC_LD(q, n_) do { const int u_ = cslot((chain_tb((n_), d) * 4 + h) * 2 + d); nx[q] = *(const f32x4*)(WSP(float, SC_SSD_S) + (size_t)u_ * 8192 + e0); cd[q] = WSP(float, SC_SSD_CD)[u_]; } while (0)
#define SC_ST(q, n_) do { const int u_ = cslot((chain_tb((n_), d) * 4 + h) * 2 + d); float* c_ = WSP(float, SC_SSD_S) + (size_t)u_ * 8192 + e0; const f32x4 a_ = nx[q]; const float de_ = cd[q]; \
        SC_LD(q, (n_) + 6 < NTB ? (n_) + 6 : NTB - 1); *(f32x4*)c_ = s; s = s * de_ + a_; } while (0)
    SC_LD(0, 0); SC_LD(1, 1); SC_LD(2, 2); SC_LD(3, 3); SC_LD(4, 4); SC_LD(5, 5);
#pragma unroll 1
    for (int n = 0; n < NTB; n += 6) { SC_ST(0, n); SC_ST(1, n + 1); SC_ST(2, n + 2); SC_ST(3, n + 3); SC_ST(4, n + 4); SC_ST(5, n + 5); }
#undef SC_LD
#undef SC_ST
}
__device__ __forceinline__ void ssd_p2(const Cx& p, LAS unsigned char* lds, int layer, int b) {
    const int tid = p.tid, lane = tid & 63, wave = __builtin_amdgcn_readfirstlane(tid >> 6), fr = lane & 15, fq = lane >> 4;
    LAS unsigned char* Ct = lds; LAS unsigned char* Bt2 = lds + 64 * TS2; LAS float* cb = (LAS float*)(lds + 2 * 64 * TS2); LAS float* AC = cb + 64 * 65;
    LAS unsigned char* Mt = (LAS unsigned char*)(AC + 64 + 4); LAS unsigned char* xT = Mt + 64 * TS; LAS unsigned char* Sb = xT + 64 * TS;
    const int mt = wave >> 1, nt0 = (wave & 1) * 2;
    const float* alogp = PIN(I_SS_ALOG);
    u32x4 cq[2], bq[2], xq; float dtq; f32x4 sq[4];
#define SSD2_LOAD(uu) do { const int tb_ = (uu) >> 3, g_ = ((uu) >> 2) & 1, hd_ = (uu) & 3, h_ = 2 * g_ + (hd_ >> 1), d_ = hd_ & 1; \
        const bf16_t* sx_ = WSP(bf16_t, SC_SX) + (size_t)(64 * tb_) * 768; \
        _Pragma("unroll") for (int q = 0; q < 2; ++q) { const int e = tid + NTHR * q, i = e >> 4, ch = e & 15; \
            cq[q] = *(const u32x4*)(sx_ + (size_t)i * 768 + 512 + 128 * g_ + ch * 8); bq[q] = *(const u32x4*)(sx_ + (size_t)i * 768 + 256 + 128 * g_ + ch * 8); } \
        xq = *(const u32x4*)(sx_ + (size_t)lane * 768 + 64 * h_ + 8 * wave); dtq = WSP(float, SC_SDT)[(size_t)(64 * tb_ + lane) * 8 + d_ * 4 + h_]; \
        const float* sp_ = WSP(float, SC_SSD_S) + (size_t)cslot((tb_ * 4 + h_) * 2 + d_) * 8192; \
        _Pragma("unroll") for (int q = 0; q < 4; ++q) sq[q] = *(const f32x4*)(sp_ + (tid + NTHR * q) * 4); } while (0)
    int u3 = (p.bid + p.G - (160 % p.G)) % p.G;
    if (u3 < NTB * 8) SSD2_LOAD(u3);
    for (; u3 < NTB * 8; u3 += p.G) { const int tb = u3 >> 3, g = (u3 >> 2) & 1, hd = u3 & 3, h = 2 * g + (hd >> 1), d = hd & 1, s0 = 64 * tb; (void)g;
        if (wave == 0) { const float aneg = -__expf(alogp[(layer * 2 + d) * 4 + h]); float tot; AC[lane] = ssd_acum(aneg * dtq, d, lane, tot); }
#pragma unroll
        for (int q = 0; q < 2; ++q) { const int e = tid + NTHR * q, i = e >> 4, ch = e & 15;
            *(LAS u32x4*)(Ct + i * TS2 + ch * 16) = cq[q]; *(LAS u32x4*)(Bt2 + i * TS2 + ch * 16) = bq[q]; }
#pragma unroll
        for (int k = 0; k < 8; ++k) *(LAS bf16_t*)(xT + (8 * wave + k) * TS + lane * 2) = (bf16_t)f2bf(bf2f((bf16_t)(xq[k >> 1] >> (16 * (k & 1)))) * dtq);
#pragma unroll
        for (int q = 0; q < 4; ++q) { const int e = (tid + NTHR * q) * 4, pp = e >> 7, s = e & 127; const f32x4 v = sq[q];
            *(LAS u32x2*)(Sb + pp * TS2 + s * 2) = (u32x2){pk2(v[0], v[1]), pk2(v[2], v[3])}; }
        if (u3 + p.G < NTB * 8) SSD2_LOAD(u3 + p.G);
        __syncthreads();
        { f32x4 acc[2] = {(f32x4){0.f, 0.f, 0.f, 0.f}, (f32x4){0.f, 0.f, 0.f, 0.f}};
          mm_rows<128, 2>(Ct, TS2, Bt2, TS2, mt, nt0, fr, fq, acc);
#pragma unroll
          for (int t = 0; t < 2; ++t)
#pragma unroll
              for (int j = 0; j < 4; ++j) cb[(16 * mt + 4 * fq + j) * 65 + 16 * (nt0 + t) + fr] = acc[t][j]; }
        __syncthreads();
        { const int i = tid >> 3, j0 = (tid & 7) * 8; const float ai = AC[i]; unsigned w[4];
#pragma unroll
          for (int jj = 0; jj < 8; jj += 2) { float m[2];
#pragma unroll
              for (int q = 0; q < 2; ++q) { const int j = j0 + jj + q; const bool keep = d ? j >= i : j <= i; const float cv = cb[i * 65 + j], aj = AC[j]; m[q] = keep ? cv * __expf(ai - aj) : 0.f; }
              w[jj >> 1] = pk2(m[0], m[1]); }
          *(LAS u32x4*)(Mt + i * TS + j0 * 2) = (u32x4){w[0], w[1], w[2], w[3]}; }
        __syncthreads();
        { f32x4 acc[2] = {(f32x4){0.f, 0.f, 0.f, 0.f}, (f32x4){0.f, 0.f, 0.f, 0.f}};
          mm_rows<128, 2>(Ct, TS2, Sb, TS2, mt, nt0, fr, fq, acc);
#pragma unroll
          for (int j = 0; j < 4; ++j) { const float sc = __expf(AC[16 * mt + 4 * fq + j]); acc[0][j] *= sc; acc[1][j] *= sc; }
          mm_rows<64, 2>(Mt, TS, xT, TS, mt, nt0, fr, fq, acc);
          bf16_t* ob = WSP(bf16_t, d ? SC_OB : SC_OF);
#pragma unroll
          for (int t = 0; t < 2; ++t)
#pragma unroll
              for (int j = 0; j < 4; ++j) ob[(size_t)(s0 + 16 * mt + 4 * fq + j) * 1024 + 512 + 64 * h + 16 * (nt0 + t) + fr] = (bf16_t)f2bf(acc[t][j]); }
        __syncthreads();
    }
}
#undef SSD2_LOAD
constexpr int AFS = 68;
__device__ __forceinline__ int dr_mfrag_idx(int row, int col) { return (((row >> 4) * 2 + (col >> 5)) * 64 + ((col >> 2) & 3) * 16 + (row & 15)) * 8 + ((col >> 4) & 1) * 4 + (col & 3); }
template <class RhsF> __device__ __forceinline__ void dr_block_solve(const LAS unsigned char* Abf, const LAS float* AfT, LAS unsigned char* XT, LAS float* Dbuf, const float sgn, const int wave, const RhsF& rhs, bf16_t* wu) {
    LAS unsigned char* TI = (LAS unsigned char*)Dbuf;
    if (wave == 0) { const int lane = lane_id_asm(), kb_ = lane >> 4, cc = lane & 15; float x[16];
#pragma unroll
        for (int i = 0; i < 16; ++i) x[i] = i == cc ? 1.f : 0.f;
        const LAS float* Ab = AfT + (16 * kb_) * AFS + 16 * kb_;
        f32x4 tri[36];
        { int q = 0;
#pragma unroll
          for (int j = 0; j < 15; ++j)
#pragma unroll
              for (int c4 = (j + 1) / 4; c4 < 4; ++c4) tri[q++] = *(const LAS f32x4*)(Ab + j * AFS + 4 * c4); }
        asm volatile("s_waitcnt lgkmcnt(0)" ::: "memory");
        { int q = 0;
#pragma unroll
          for (int j = 0; j < 15; ++j) { const float xj = sgn * x[j];
#pragma unroll
              for (int c4 = (j + 1) / 4; c4 < 4; ++c4) { const f32x4 t = tri[q++];
#pragma unroll
                  for (int e = 0; e < 4; ++e) if (4 * c4 + e > j) x[4 * c4 + e] -= t[e] * xj; } } }
        { u32x4 w0, w1;
#pragma unroll
          for (int i = 0; i < 16; ++i) *(LAS bf16_t*)(TI + ((kb_ * 16 + i) * 16 + cc) * 2) = (bf16_t)f2bf(x[i]); (void)w0; (void)w1; } }
    __syncthreads();
    { const int lane = lane_id_asm(), fr = lane & 15, fq = lane >> 4, col = 16 * wave + fr; u32x4 bx[2] = {(u32x4){0u, 0u, 0u, 0u}, (u32x4){0u, 0u, 0u, 0u}};
      float rv[4][4]; u32x2 af[6][2], tf[4];
#pragma unroll
      for (int k = 0; k < 4; ++k) {
#pragma unroll
          for (int j = 0; j < 4; ++j) rv[k][j] = rhs(16 * k + 4 * fq + j, col);
          tf[k] = *(const LAS u32x2*)(TI + ((k * 16 + fr) * 16 + 4 * fq) * 2); }
#pragma unroll
      for (int k = 1; k < 4; ++k)
#pragma unroll
          for (int ks = 0; ks < 2; ++ks) if (k > 2 * ks) { const int s = (k - 1) + (ks ? 2 : 0) + (k == 3 && ks == 0 ? 0 : 0);
              af[s][0] = *(const LAS u32x2*)(Abf + (16 * k + fr) * TS + (32 * ks + 4 * fq) * 2); af[s][1] = *(const LAS u32x2*)(Abf + (16 * k + fr) * TS + (32 * ks + 16 + 4 * fq) * 2); }
#pragma unroll
      for (int k = 0; k < 4; ++k) { f32x4 acc = (f32x4){0.f, 0.f, 0.f, 0.f};
#pragma unroll
          for (int ks = 0; ks < 2; ++ks) if (k > 2 * ks) { const int s = (k - 1) + (ks ? 2 : 0);
              acc = __builtin_amdgcn_mfma_f32_16x16x32_bf16(__builtin_bit_cast(bf16x8, (u32x4){af[s][0][0], af[s][0][1], af[s][1][0], af[s][1][1]}), __builtin_bit_cast(bf16x8, bx[ks]), acc, 0, 0, 0); }
          float dd[4];
#pragma unroll
          for (int j = 0; j < 4; ++j) dd[j] = rv[k][j] - sgn * acc[j];
          const f32x4 xk = __builtin_amdgcn_mfma_f32_16x16x32_bf16(__builtin_bit_cast(bf16x8, (u32x4){tf[k][0], tf[k][1], 0u, 0u}), __builtin_bit_cast(bf16x8, (u32x4){pk2(dd[0], dd[1]), pk2(dd[2], dd[3]), 0u, 0u}), (f32x4){0.f, 0.f, 0.f, 0.f}, 0, 0, 0);
          const unsigned p0 = pk2(xk[0], xk[1]), p1 = pk2(xk[2], xk[3]);
          bx[k >> 1][(k & 1) * 2] = p0; bx[k >> 1][(k & 1) * 2 + 1] = p1;
          *(LAS u32x2*)(XT + col * TS + (16 * k + 4 * fq) * 2) = (u32x2){p0, p1};
#pragma unroll
          for (int j = 0; j < 4; ++j) wu[(16 * k + 4 * fq + j) * 128 + col] = (bf16_t)f2bf(xk[j]); } }
    __syncthreads();
}
struct GdnRhs { const LAS unsigned char* kb; const LAS unsigned char* vb; const LAS float* GC;
    __device__ __forceinline__ float operator()(int r, int col) const { return col < 64 ? bf2f(*(const LAS bf16_t*)(kb + r * TS + col * 2)) * __expf(GC[r]) : bf2f(*(const LAS bf16_t*)(vb + r * TS + (col - 64) * 2)); } };
__device__ __forceinline__ void gdn_p1(const Cx& p, LAS unsigned char* lds, int layer, int b) {
    const int wave = __builtin_amdgcn_readfirstlane(p.tid >> 6);
#define GDN_LANES const int lane = lane_id_asm(), tid = wave * 64 + lane, fr = lane & 15, fq = lane >> 4; (void)tid; (void)fr; (void)fq
    LAS unsigned char* kh = lds; LAS unsigned char* kb = lds + 64 * TS; LAS unsigned char* vb = lds + 2 * 64 * TS; LAS unsigned char* Abf = lds + 3 * 64 * TS; LAS unsigned char* kdT = lds + 4 * 64 * TS; LAS unsigned char* XT = lds + 5 * 64 * TS;
    LAS float* Af = (LAS float*)(lds + 7 * 64 * TS); LAS float* Dbuf = Af + 64 * AFS; LAS float* GC = Dbuf + 128 * 20;
    const int mt = wave >> 1, nt0 = (wave & 1) * 2;
    float gq, beta; u32x4 kv, vv;
#define GDN1_LOAD(uu) do { const int tb_ = (uu) >> 3, h_ = ((uu) >> 1) & 3, d_ = (uu) & 1; const int lane_ = lane_id_asm(), tid_ = wave * 64 + lane_; \
        const bf16_t* dq_ = WSP(bf16_t, SC_DQ) + (size_t)(64 * tb_) * 768; const float* dg_ = WSP(float, SC_DG) + (size_t)(64 * tb_) * 16; \
        gq = dg_[(d_ ? 63 - lane_ : lane_) * 16 + 8 + d_ * 4 + h_]; \
        { const int r_ = tid_ >> 3, c0_ = (tid_ & 7) * 8, i_ = d_ ? 63 - r_ : r_; beta = dg_[i_ * 16 + d_ * 4 + h_]; \
          kv = *(const u32x4*)(dq_ + (size_t)i_ * 768 + 256 + 64 * h_ + c0_); vv = *(const u32x4*)(dq_ + (size_t)i_ * 768 + 512 + 64 * h_ + c0_); } } while (0)
    int u = (p.bid + p.G - (64 % p.G)) % p.G;
    if (u < NUNIT) GDN1_LOAD(u);
    for (; u < NUNIT; u += p.G) {
        if (wave == 0) { GDN_LANES; float pre = gq;
#pragma unroll
            for (int o = 1; o < 64; o <<= 1) { const float t = shup_(pre, lane, o); if (lane >= o) pre += t; }
            GC[lane] = pre; }
        { GDN_LANES; const int r = tid >> 3, c0 = (tid & 7) * 8; u32x4 kw, vw;
#pragma unroll
          for (int q = 0; q < 4; ++q) { kw[q] = pk2(__uint_as_float(kv[q] << 16) * beta, __uint_as_float(kv[q] & 0xffff0000u) * beta); vw[q] = pk2(__uint_as_float(vv[q] << 16) * beta, __uint_as_float(vv[q] & 0xffff0000u) * beta); }
          *(LAS u32x4*)(kh + r * TS + c0 * 2) = kv; *(LAS u32x4*)(kb + r * TS + c0 * 2) = kw; *(LAS u32x4*)(vb + r * TS + c0 * 2) = vw;
          *(LAS u32x4*)(XT + (2 * r) * TS + c0 * 2) = (u32x4){0u, 0u, 0u, 0u}; *(LAS u32x4*)(XT + (2 * r + 1) * TS + c0 * 2) = (u32x4){0u, 0u, 0u, 0u}; }
        if (u + p.G < NUNIT) GDN1_LOAD(u + p.G);
        __syncthreads();
        const float gtot = GC[63];
        { GDN_LANES; f32x4 acc[2] = {(f32x4){0.f, 0.f, 0.f, 0.f}, (f32x4){0.f, 0.f, 0.f, 0.f}};
          mm_rows<64, 2>(kb, TS, kh, TS, mt, nt0, fr, fq, acc);
          float gr[4], gj[2];
#pragma unroll
          for (int j = 0; j < 4; ++j) gr[j] = GC[16 * mt + 4 * fq + j];
#pragma unroll
          for (int t = 0; t < 2; ++t) gj[t] = GC[16 * (nt0 + t) + fr];
#pragma unroll
          for (int t = 0; t < 2; ++t)
#pragma unroll
              for (int j = 0; j < 4; ++j) { const int r = 16 * mt + 4 * fq + j, jj = 16 * (nt0 + t) + fr; const float a = jj < r ? acc[t][j] * __expf(gr[j] - gj[t]) : 0.f;
                  Af[jj * AFS + r] = a; *(LAS bf16_t*)(Abf + r * TS + jj * 2) = (bf16_t)f2bf(a); }
          { bf16_t kraw[8]; float gcr[8];
#pragma unroll
            for (int q = 0; q < 8; ++q) { const int e = tid + NTHR * q, r = e >> 6, cc = e & 63; kraw[q] = *(const LAS bf16_t*)(kh + r * TS + cc * 2); gcr[q] = GC[r]; }
#pragma unroll
            for (int q = 0; q < 8; ++q) { const int e = tid + NTHR * q, r = e >> 6, cc = e & 63; *(LAS bf16_t*)(kdT + cc * TS + r * 2) = (bf16_t)f2bf(bf2f(kraw[q]) * __expf(gtot - gcr[q])); } } }
        __syncthreads();
        { const GdnRhs rhs{kb, vb, GC}; dr_block_solve(Abf, Af, XT, Dbuf, 1.0f, wave, rhs, WSP(bf16_t, SC_DR_WU) + (size_t)u * 8192); }
        { GDN_LANES; f32x4 am[2] = {(f32x4){0.f, 0.f, 0.f, 0.f}, (f32x4){0.f, 0.f, 0.f, 0.f}}, an[2] = {(f32x4){0.f, 0.f, 0.f, 0.f}, (f32x4){0.f, 0.f, 0.f, 0.f}};
          mm_rows<64, 2>(kdT, TS, XT, TS, mt, nt0, fr, fq, am);
          mm_rows<64, 2>(kdT, TS, XT + 64 * TS, TS, mt, nt0, fr, fq, an);
          bf16_t* Mg = WSP(bf16_t, SC_DR_M) + (size_t)cslot(u) * 4096; bf16_t* Ng = WSP(bf16_t, SC_DR_NS) + (size_t)cslot(u) * 4096; const float eg = __expf(gtot);
#pragma unroll
          for (int t = 0; t < 2; ++t) {
#pragma unroll
              for (int j = 0; j < 4; ++j) { const int row = 16 * mt + 4 * fq + j, col = 16 * (nt0 + t) + fr; Mg[dr_mfrag_idx(row, col)] = (bf16_t)f2bf((row == col ? eg : 0.f) - am[t][j]); }
              *(u32x2*)(Ng + (((nt0 + t) * 4 + mt) * 64 + lane) * 4) = (u32x2){pk2(an[t][0], an[t][1]), pk2(an[t][2], an[t][3])}; } }
        __syncthreads();
    }
#undef GDN_LANES
#undef GDN1_LOAD
}
__device__ __forceinline__ void dr_chain(const Cx& p, size_t offM, size_t offNS, int h, int d, int cb) {
    const int lane = p.tid & 63, fr = lane & 15, fq = lane >> 4;
    if (p.tid >= 64) return;
    f32x4 acc[4];
#pragma unroll
    for (int t = 0; t < 4; ++t) acc[t] = (f32x4){0.f, 0.f, 0.f, 0.f};
    bf16x8 mR[3][4][2]; u32x2 nR[3][4];
#define DR_LD(m, nn, n_) do { const int u_ = cslot((chain_tb((n_), d) * 4 + h) * 2 + d); const bf16_t* M_ = WSP(bf16_t, offM) + (size_t)u_ * 4096; const bf16_t* N_ = WSP(bf16_t, offNS) + (size_t)u_ * 4096; \
        _Pragma("unroll") for (int t = 0; t < 4; ++t) { _Pragma("unroll") for (int ks = 0; ks < 2; ++ks) m[t][ks] = *(const bf16x8*)(M_ + ((t * 2 + ks) * 64 + lane) * 8); nn[t] = *(const u32x2*)(N_ + ((cb * 4 + t) * 64 + lane) * 4); } } while (0)
#define DR_STEP(m, nn, n_) do { const int u_ = cslot((chain_tb((n_), d) * 4 + h) * 2 + d); bf16_t* ST_ = WSP(bf16_t, offNS) + (size_t)u_ * 4096 + (16 * cb + fr) * 64 + 4 * fq; \
        u32x2 sp_[4]; _Pragma("unroll") for (int t = 0; t < 4; ++t) { sp_[t] = (u32x2){pk2(acc[t][0], acc[t][1]), pk2(acc[t][2], acc[t][3])}; *(u32x2*)(ST_ + 16 * t) = sp_[t]; } \
        bf16x8 bf_[2]; _Pragma("unroll") for (int ks = 0; ks < 2; ++ks) { u32x4 w_ = (u32x4){sp_[2 * ks][0], sp_[2 * ks][1], sp_[2 * ks + 1][0], sp_[2 * ks + 1][1]}; bf_[ks] = __builtin_bit_cast(bf16x8, w_); } \
        _Pragma("unroll") for (int t = 0; t < 4; ++t) { f32x4 a_ = (f32x4){__uint_as_float(nn[t][0] << 16), __uint_as_float(nn[t][0] & 0xffff0000u), __uint_as_float(nn[t][1] << 16), __uint_as_float(nn[t][1] & 0xffff0000u)}; \
            a_ = __builtin_amdgcn_mfma_f32_16x16x32_bf16(m[t][0], bf_[0], a_, 0, 0, 0); acc[t] = __builtin_amdgcn_mfma_f32_16x16x32_bf16(m[t][1], bf_[1], a_, 0, 0, 0); } } while (0)
#define DR_GO(q, n_) do { DR_STEP(mR[q], nR[q], (n_)); DR_LD(mR[q], nR[q], (n_) + 3 < NTB ? (n_) + 3 : NTB - 1); } while (0)
    DR_LD(mR[0], nR[0], 0); DR_LD(mR[1], nR[1], 1); DR_LD(mR[2], nR[2], 2);
#pragma unroll 1
    for (int n = 0; n < NTB; n += 3) { DR_GO(0, n); DR_GO(1, n + 1); DR_GO(2, n + 2); }
#undef DR_GO
#undef DR_LD
#undef DR_STEP
}
__device__ __forceinline__ void gdn_p2(const Cx& p, LAS unsigned char* lds, int layer, int b) {
    const int tid = p.tid, lane = tid & 63, wave = __builtin_amdgcn_readfirstlane(tid >> 6), fr = lane & 15, fq = lane >> 4;
    LAS unsigned char* qh = lds; LAS unsigned char* kh = lds + 64 * TS; LAS unsigned char* wt = lds + 2 * 64 * TS; LAS unsigned char* sT = lds + 3 * 64 * TS; LAS unsigned char* aq = lds + 4 * 64 * TS; LAS unsigned char* vnT = lds + 5 * 64 * TS;
    LAS float* GC = (LAS float*)(lds + 6 * 64 * TS);
    const int mt = wave >> 1, nt0 = (wave & 1) * 2;
    float gq; bf16_t upre[2][4]; u32x4 qv, kv, wv, sv;
#define GDN2_LOAD(uu) do { const int tb_ = (uu) >> 3, h_ = ((uu) >> 1) & 3, d_ = (uu) & 1; \
        const bf16_t* dq_ = WSP(bf16_t, SC_DQ) + (size_t)(64 * tb_) * 768; const float* dg_ = WSP(float, SC_DG) + (size_t)(64 * tb_) * 16; \
        const bf16_t* wu_ = WSP(bf16_t, SC_DR_WU) + (size_t)(uu) * 8192; const bf16_t* st_ = WSP(bf16_t, SC_DR_NS) + (size_t)cslot(uu) * 4096; \
        gq = dg_[(d_ ? 63 - lane : lane) * 16 + 8 + d_ * 4 + h_]; \
        _Pragma("unroll") for (int t = 0; t < 2; ++t) { _Pragma("unroll") for (int j = 0; j < 4; ++j) upre[t][j] = wu_[(16 * mt + 4 * fq + j) * 128 + 64 + 16 * (nt0 + t) + fr]; } \
        { const int r_ = tid >> 3, c0_ = (tid & 7) * 8, i_ = d_ ? 63 - r_ : r_; \
          qv = *(const u32x4*)(dq_ + (size_t)i_ * 768 + 64 * h_ + c0_); kv = *(const u32x4*)(dq_ + (size_t)i_ * 768 + 256 + 64 * h_ + c0_); \
          wv = *(const u32x4*)(wu_ + r_ * 128 + c0_); sv = *(const u32x4*)(st_ + r_ * 64 + c0_); } } while (0)
    int u = (p.bid + p.G - (192 % p.G)) % p.G;
    if (u < NUNIT) GDN2_LOAD(u);
    for (; u < NUNIT; u += p.G) { const int tb = u >> 3, h = (u >> 1) & 3, d = u & 1, s0 = 64 * tb;
        if (wave == 0) { float pre = gq;
#pragma unroll
            for (int o = 1; o < 64; o <<= 1) { const float t = shup_(pre, lane, o); if (lane >= o) pre += t; }
            GC[lane] = pre; }
        bf16_t ucur[2][4];
#pragma unroll
        for (int t = 0; t < 2; ++t)
#pragma unroll
            for (int j = 0; j < 4; ++j) ucur[t][j] = upre[t][j];
        { const int r = tid >> 3, c0 = (tid & 7) * 8;
          *(LAS u32x4*)(qh + r * TS + c0 * 2) = qv; *(LAS u32x4*)(kh + r * TS + c0 * 2) = kv; *(LAS u32x4*)(wt + r * TS + c0 * 2) = wv; *(LAS u32x4*)(sT + r * TS + c0 * 2) = sv; }
        if (u + p.G < NUNIT) GDN2_LOAD(u + p.G);
        __syncthreads();
        { f32x4 acc[2] = {(f32x4){0.f, 0.f, 0.f, 0.f}, (f32x4){0.f, 0.f, 0.f, 0.f}};
          mm_rows<64, 2>(qh, TS, kh, TS, mt, nt0, fr, fq, acc);
          float gr[4], gj[2];
#pragma unroll
          for (int j = 0; j < 4; ++j) gr[j] = GC[16 * mt + 4 * fq + j];
#pragma unroll
          for (int t = 0; t < 2; ++t) gj[t] = GC[16 * (nt0 + t) + fr];
#pragma unroll
          for (int t = 0; t < 2; ++t)
#pragma unroll
              for (int j = 0; j < 4; ++j) { const int r = 16 * mt + 4 * fq + j, jj = 16 * (nt0 + t) + fr; *(LAS bf16_t*)(aq + r * TS + jj * 2) = (bf16_t)f2bf(jj <= r ? acc[t][j] * __expf(gr[j] - gj[t]) : 0.f); }
          f32x4 av[2] = {(f32x4){0.f, 0.f, 0.f, 0.f}, (f32x4){0.f, 0.f, 0.f, 0.f}};
          mm_rows<64, 2>(wt, TS, sT, TS, mt, nt0, fr, fq, av);
#pragma unroll
          for (int t = 0; t < 2; ++t) { const int dv = 16 * (nt0 + t) + fr; float vn[4];
#pragma unroll
              for (int j = 0; j < 4; ++j) vn[j] = bf2f(ucur[t][j]) - av[t][j];
              *(LAS u32x2*)(vnT + dv * TS + (16 * mt + 4 * fq) * 2) = (u32x2){pk2(vn[0], vn[1]), pk2(vn[2], vn[3])}; } }
        __syncthreads();
        { f32x4 acc[2] = {(f32x4){0.f, 0.f, 0.f, 0.f}, (f32x4){0.f, 0.f, 0.f, 0.f}};
          mm_rows<64, 2>(qh, TS, sT, TS, mt, nt0, fr, fq, acc);
#pragma unroll
          for (int j = 0; j < 4; ++j) { const float sc = __expf(GC[16 * mt + 4 * fq + j]); acc[0][j] *= sc; acc[1][j] *= sc; }
          mm_rows<64, 2>(aq, TS, vnT, TS, mt, nt0, fr, fq, acc);
          bf16_t* ob = WSP(bf16_t, d ? SC_OB : SC_OF);
#pragma unroll
          for (int t = 0; t < 2; ++t)
#pragma unroll
              for (int j = 0; j < 4; ++j) { const int r = 16 * mt + 4 * fq + j, i = d ? 63 - r : r; ob[(size_t)(s0 + i) * 1024 + 768 + 64 * h + 16 * (nt0 + t) + fr] = (bf16_t)f2bf(acc[t][j]); } }
        __syncthreads();
    }
}
#undef GDN2_LOAD
constexpr int LPS = 65;
#define RW_LP(LP, GS, lw8) do { const int lane_ = lane_id_asm(), c_ = lane_, tg_ = wave; float loc_[8]; float run_ = 0.f; \
        _Pragma("unroll") for (int ii = 0; ii < 8; ++ii) { run_ += (lw8)[ii]; loc_[ii] = run_; } \
        (GS)[tg_ * 64 + c_] = run_; __syncthreads(); float off_ = 0.f; \
        _Pragma("unroll") for (int g2 = 0; g2 < 8; ++g2) if (g2 < tg_) off_ += (GS)[g2 * 64 + c_]; \
        _Pragma("unroll") for (int ii = 0; ii < 8; ++ii) (LP)[(8 * tg_ + ii) * LPS + c_] = loc_[ii] + off_; __syncthreads(); } while (0)
struct RwRhs { const LAS unsigned char* zt; const LAS unsigned char* RU;
    __device__ __forceinline__ float operator()(int r, int col) const { return col < 64 ? bf2f(*(const LAS bf16_t*)(zt + r * TS + col * 2)) : bf2f(*(const LAS bf16_t*)(RU + (col - 64) * TS + r * 2)); } };
__device__ __forceinline__ void rw_p1(const Cx& p, LAS unsigned char* lds, int layer, int b) {
    const int wave = __builtin_amdgcn_readfirstlane(p.tid >> 6), mt = wave >> 1, nt0 = (wave & 1) * 2;
#define RW_LANES const int lane = lane_id_asm(), tid = wave * 64 + lane, fr = lane & 15, fq = lane >> 4; (void)tid; (void)fr; (void)fq
    LAS float* LP = (LAS float*)lds; LAS float* GS = (LAS float*)(lds + 16640);
    LAS unsigned char* zt = lds + 18688; LAS unsigned char* bt = lds + 27904; LAS unsigned char* kt = lds + 37120; LAS unsigned char* vT = lds + 46336; LAS unsigned char* Azk = lds + 55552;
    LAS float* Af = (LAS float*)(lds + 64768); LAS unsigned char* XT = lds + 82176; LAS unsigned char* Abf = lds + 100608; LAS unsigned char* RU = lds + 109824; LAS float* Dbuf = (LAS float*)(lds + 119040); LAS unsigned char* bhT = lds + 129280;
    const bf16_t* proj = WSP(bf16_t, WS_PROJ);
    float lw8[8]; f32x4 lwv[2], kkv[2], bv[2], kv[2]; bf16_t v8[8];
#define RW1_LOAD(uu) do { const int tb_ = (uu) >> 3, h_ = ((uu) >> 1) & 3, d_ = (uu) & 1, s0_ = 64 * tb_; const int lane_ = lane_id_asm(), tid_ = wave * 64 + lane_; \
        const float* lwp_ = WSP(float, SC_RLW) + (size_t)d_ * SB * 256 + (size_t)s0_ * 256 + 64 * h_; const size_t fo_ = (size_t)s0_ * 256 + 64 * h_; \
        _Pragma("unroll") for (int ii = 0; ii < 8; ++ii) { const int r_ = 8 * wave + ii; lw8[ii] = lwp_[(size_t)(d_ ? 63 - r_ : r_) * 256 + lane_]; } \
        { const int r_ = tid_ >> 3, c0_ = (tid_ & 7) * 8, i_ = d_ ? 63 - r_ : r_; \
          _Pragma("unroll") for (int q = 0; q < 2; ++q) { lwv[q] = *(const f32x4*)(lwp_ + (size_t)i_ * 256 + c0_ + 4 * q); kkv[q] = *(const f32x4*)(WSP(float, SC_RKK) + fo_ + (size_t)i_ * 256 + c0_ + 4 * q); \
              bv[q] = *(const f32x4*)(WSP(float, SC_RB) + fo_ + (size_t)i_ * 256 + c0_ + 4 * q); kv[q] = *(const f32x4*)(WSP(float, SC_RK) + fo_ + (size_t)i_ * 256 + c0_ + 4 * q); } } \
        { const bf16_t* pr0_ = proj + (size_t)tb_row0(b, tb_) * NPROJ; \
          _Pragma("unroll") for (int q = 0; q < 8; ++q) { const int e = tid_ + NTHR * q, r2 = e >> 6, cc = e & 63; v8[q] = pr0_[(size_t)(d_ ? 63 - r2 : r2) * NPROJ + PB_V + 64 * h_ + cc]; } } } while (0)
    int u = (p.bid + p.G - (96 % p.G)) % p.G; if (u >= NUNIT) return;
    RW1_LOAD(u);
    for (;;) { const int d = u & 1;
        RW_LP(LP, GS, lw8);
        { RW_LANES; const int r = tid >> 3, c0 = (tid & 7) * 8; unsigned wz[4], wb[4], wk[4];
#pragma unroll
          for (int q = 0; q < 8; q += 2) { float z2[2], b2[2], k2[2];
#pragma unroll
              for (int e = 0; e < 2; ++e) { const int cq = q + e, c = c0 + cq; const float lp = LP[r * LPS + c], lw = lwv[cq >> 2][cq & 3], em = __expf(-lp);
                  z2[e] = -kkv[cq >> 2][cq & 3] * __expf(lp - lw); b2[e] = bv[cq >> 2][cq & 3] * em; k2[e] = kv[cq >> 2][cq & 3] * em; }
              wz[q >> 1] = pk2(z2[0], z2[1]); wb[q >> 1] = pk2(b2[0], b2[1]); wk[q >> 1] = pk2(k2[0], k2[1]); }
          *(LAS u32x4*)(zt + r * TS + c0 * 2) = (u32x4){wz[0], wz[1], wz[2], wz[3]}; *(LAS u32x4*)(bt + r * TS + c0 * 2) = (u32x4){wb[0], wb[1], wb[2], wb[3]}; *(LAS u32x4*)(kt + r * TS + c0 * 2) = (u32x4){wk[0], wk[1], wk[2], wk[3]};
          *(LAS u32x4*)(XT + (2 * r) * TS + c0 * 2) = (u32x4){0u, 0u, 0u, 0u}; *(LAS u32x4*)(XT + (2 * r + 1) * TS + c0 * 2) = (u32x4){0u, 0u, 0u, 0u};
#pragma unroll
          for (int q = 0; q < 8; ++q) { const int e = tid + NTHR * q, r2 = e >> 6, cc = e & 63; *(LAS bf16_t*)(vT + cc * TS + r2 * 2) = v8[q]; } }
        __syncthreads();
        const int un = u + p.G; const bool more = un < NUNIT;
        if (more) RW1_LOAD(un);
        { RW_LANES; f32x4 a1[2] = {(f32x4){0.f, 0.f, 0.f, 0.f}, (f32x4){0.f, 0.f, 0.f, 0.f}}, a2[2] = {(f32x4){0.f, 0.f, 0.f, 0.f}, (f32x4){0.f, 0.f, 0.f, 0.f}};
          mm_rows<64, 2>(zt, TS, bt, TS, mt, nt0, fr, fq, a1);
          mm_rows<64, 2>(zt, TS, kt, TS, mt, nt0, fr, fq, a2);
#pragma unroll
          for (int t = 0; t < 2; ++t)
#pragma unroll
              for (int j = 0; j < 4; ++j) { const int r = 16 * mt + 4 * fq + j, jj = 16 * (nt0 + t) + fr; const float a = jj < r ? a1[t][j] : 0.f;
                  Af[jj * AFS + r] = a; *(LAS bf16_t*)(Abf + r * TS + jj * 2) = (bf16_t)f2bf(a); *(LAS bf16_t*)(Azk + r * TS + jj * 2) = (bf16_t)f2bf(jj < r ? a2[t][j] : 0.f); } }
        __syncthreads();
        { RW_LANES; f32x4 a[2] = {(f32x4){0.f, 0.f, 0.f, 0.f}, (f32x4){0.f, 0.f, 0.f, 0.f}};
          mm_rows<64, 2>(Azk, TS, vT, TS, mt, nt0, fr, fq, a);
#pragma unroll
          for (int t = 0; t < 2; ++t) *(LAS u32x2*)(RU + (16 * (nt0 + t) + fr) * TS + (16 * mt + 4 * fq) * 2) = (u32x2){pk2(a[t][0], a[t][1]), pk2(a[t][2], a[t][3])};
        }
        __syncthreads();
        { RW_LANES;
          const float el = __expf(LP[63 * LPS + (tid & 63)]); bf16_t braw[8], kraw[8];
#pragma unroll
          for (int q = 0; q < 8; ++q) { const int e = tid + NTHR * q, r2 = e >> 6, cc = e & 63; braw[q] = *(const LAS bf16_t*)(bt + r2 * TS + cc * 2); kraw[q] = *(const LAS bf16_t*)(kt + r2 * TS + cc * 2); }
#pragma unroll
          for (int q = 0; q < 8; ++q) { const int e = tid + NTHR * q, r2 = e >> 6, cc = e & 63;
              *(LAS bf16_t*)(bhT + cc * TS + r2 * 2) = (bf16_t)f2bf(bf2f(braw[q]) * el); *(LAS bf16_t*)(Azk + cc * TS + r2 * 2) = (bf16_t)f2bf(bf2f(kraw[q]) * el); } }
        __syncthreads();
        { const RwRhs rhs{zt, RU}; dr_block_solve(Abf, Af, XT, Dbuf, -1.0f, wave, rhs, WSP(bf16_t, SC_RW_WU) + (size_t)u * 8192); }
        { RW_LANES; f32x4 am[2] = {(f32x4){0.f, 0.f, 0.f, 0.f}, (f32x4){0.f, 0.f, 0.f, 0.f}}, an[2] = {(f32x4){0.f, 0.f, 0.f, 0.f}, (f32x4){0.f, 0.f, 0.f, 0.f}};
          mm_rows<64, 2>(bhT, TS, XT, TS, mt, nt0, fr, fq, am);
          mm_rows<64, 2>(bhT, TS, XT + 64 * TS, TS, mt, nt0, fr, fq, an);
          mm_rows<64, 2>(Azk, TS, vT, TS, mt, nt0, fr, fq, an);
          bf16_t* Mg = WSP(bf16_t, SC_RW_M) + (size_t)cslot(u) * 4096; bf16_t* Ng = WSP(bf16_t, SC_RW_NS) + (size_t)cslot(u) * 4096;
#pragma unroll
          for (int t = 0; t < 2; ++t) {
#pragma unroll
              for (int j = 0; j < 4; ++j) { const int row = 16 * mt + 4 * fq + j, col = 16 * (nt0 + t) + fr; Mg[dr_mfrag_idx(row, col)] = (bf16_t)f2bf((row == col ? __expf(LP[63 * LPS + row]) : 0.f) + am[t][j]); }
              *(u32x2*)(Ng + (((nt0 + t) * 4 + mt) * 64 + lane) * 4) = (u32x2){pk2(an[t][0], an[t][1]), pk2(an[t][2], an[t][3])}; } }
        __syncthreads();
        if (!more) break;
        u = un;
    }
#undef RW1_LOAD
}
__device__ __forceinline__ void rw_p2(const Cx& p, LAS unsigned char* lds, int layer, int b) {
    const int wave = __builtin_amdgcn_readfirstlane(p.tid >> 6), mt = wave >> 1, nt0 = (wave & 1) * 2;
    LAS float* LP = (LAS float*)lds; LAS float* GS = (LAS float*)(lds + 16640);
    LAS unsigned char* rt = lds + 18688; LAS unsigned char* bt = lds + 27904; LAS unsigned char* kt = lds + 37120; LAS unsigned char* vT = lds + 46336; LAS unsigned char* sT = lds + 55552; LAS unsigned char* wt = lds + 64768;
    LAS unsigned char* Arb = lds + 73984; LAS unsigned char* Ark = lds + 83200; LAS unsigned char* UT = lds + 92416;
    const bf16_t* proj = WSP(bf16_t, WS_PROJ);
    bf16_t upre[2][4]; float lw8[8]; u32x4 rv, wv, sv, vq; f32x4 bv[2], kv[2];
#define RW2_LOAD(uu) do { const int tb_ = (uu) >> 3, h_ = ((uu) >> 1) & 3, d_ = (uu) & 1, s0_ = 64 * tb_; const int lane_ = lane_id_asm(), tid_ = wave * 64 + lane_, fr_ = lane_ & 15, fq_ = lane_ >> 4; \
        const float* lwp_ = WSP(float, SC_RLW) + (size_t)d_ * SB * 256 + (size_t)s0_ * 256 + 64 * h_; const float* rk_ = WSP(float, SC_RK) + (size_t)s0_ * 256 + 64 * h_; const float* rb_ = WSP(float, SC_RB) + (size_t)s0_ * 256 + 64 * h_; \
        const bf16_t* pr_ = proj + (size_t)tb_row0(b, tb_) * NPROJ; const bf16_t* wu_ = WSP(bf16_t, SC_RW_WU) + (size_t)(uu) * 8192; const bf16_t* st_ = WSP(bf16_t, SC_RW_NS) + (size_t)cslot(uu) * 4096; \
        _Pragma("unroll") for (int t = 0; t < 2; ++t) { _Pragma("unroll") for (int j = 0; j < 4; ++j) upre[t][j] = wu_[(16 * mt + 4 * fq_ + j) * 128 + 64 + 16 * (nt0 + t) + fr_]; } \
        _Pragma("unroll") for (int ii = 0; ii < 8; ++ii) { const int r_ = 8 * wave + ii; lw8[ii] = lwp_[(size_t)(d_ ? 63 - r_ : r_) * 256 + lane_]; } \
        { const int r_ = tid_ >> 3, c0_ = (tid_ & 7) * 8, i_ = d_ ? 63 - r_ : r_; rv = *(const u32x4*)(pr_ + (size_t)i_ * NPROJ + PB_R + 64 * h_ + c0_); \
          _Pragma("unroll") for (int q = 0; q < 2; ++q) { bv[q] = *(const f32x4*)(rb_ + (size_t)i_ * 256 + c0_ + 4 * q); kv[q] = *(const f32x4*)(rk_ + (size_t)i_ * 256 + c0_ + 4 * q); } \
          wv = *(const u32x4*)(wu_ + r_ * 128 + c0_); sv = *(const u32x4*)(st_ + r_ * 64 + c0_); } \
        vq = *(const u32x4*)(pr_ + (size_t)(d_ ? 63 - lane_ : lane_) * NPROJ + PB_V + 64 * h_ + 8 * wave); } while (0)
    int u = (p.bid + p.G - (224 % p.G)) % p.G;
    if (u < NUNIT) RW2_LOAD(u);
    for (; u < NUNIT; u += p.G) { const int tb = u >> 3, h = (u >> 1) & 3, d = u & 1, s0 = 64 * tb;
        bf16_t ucur[2][4];
#pragma unroll
        for (int t = 0; t < 2; ++t)
#pragma unroll
            for (int j = 0; j < 4; ++j) ucur[t][j] = upre[t][j];
        RW_LP(LP, GS, lw8);
        { RW_LANES; const int r = tid >> 3, c0 = (tid & 7) * 8; unsigned wr[4], wb[4], wk[4];
#pragma unroll
          for (int q = 0; q < 8; q += 2) { float r2[2], b2[2], k2[2];
#pragma unroll
              for (int e = 0; e < 2; ++e) { const int cq = q + e, c = c0 + cq; const float lp = LP[r * LPS + c], em = __expf(-lp); const unsigned w = rv[q >> 1];
                  r2[e] = (e ? __uint_as_float(w & 0xffff0000u) : __uint_as_float(w << 16)) * __expf(lp); b2[e] = bv[cq >> 2][cq & 3] * em; k2[e] = kv[cq >> 2][cq & 3] * em; }
              wr[q >> 1] = pk2(r2[0], r2[1]); wb[q >> 1] = pk2(b2[0], b2[1]); wk[q >> 1] = pk2(k2[0], k2[1]); }
          *(LAS u32x4*)(rt + r * TS + c0 * 2) = (u32x4){wr[0], wr[1], wr[2], wr[3]}; *(LAS u32x4*)(bt + r * TS + c0 * 2) = (u32x4){wb[0], wb[1], wb[2], wb[3]}; *(LAS u32x4*)(kt + r * TS + c0 * 2) = (u32x4){wk[0], wk[1], wk[2], wk[3]};
          *(LAS u32x4*)(wt + r * TS + c0 * 2) = wv; *(LAS u32x4*)(sT + r * TS + c0 * 2) = sv;
#pragma unroll
          for (int k = 0; k < 8; ++k) *(LAS bf16_t*)(vT + (8 * wave + k) * TS + lane * 2) = (bf16_t)(vq[k >> 1] >> (16 * (k & 1))); }
        if (u + p.G < NUNIT) RW2_LOAD(u + p.G);
        __syncthreads();
        { RW_LANES; f32x4 a1[2] = {(f32x4){0.f, 0.f, 0.f, 0.f}, (f32x4){0.f, 0.f, 0.f, 0.f}}, a2[2] = {(f32x4){0.f, 0.f, 0.f, 0.f}, (f32x4){0.f, 0.f, 0.f, 0.f}}, a3[2] = {(f32x4){0.f, 0.f, 0.f, 0.f}, (f32x4){0.f, 0.f, 0.f, 0.f}};
          mm_rows<64, 2>(rt, TS, bt, TS, mt, nt0, fr, fq, a1); mm_rows<64, 2>(rt, TS, kt, TS, mt, nt0, fr, fq, a2); mm_rows<64, 2>(wt, TS, sT, TS, mt, nt0, fr, fq, a3);
#pragma unroll
          for (int t = 0; t < 2; ++t) { const int dv = 16 * (nt0 + t) + fr; float uu[4];
#pragma unroll
              for (int j = 0; j < 4; ++j) { const int r = 16 * mt + 4 * fq + j, jj = dv; const bool keep = jj <= r;
                  *(LAS bf16_t*)(Arb + r * TS + jj * 2) = (bf16_t)f2bf(keep ? a1[t][j] : 0.f); *(LAS bf16_t*)(Ark + r * TS + jj * 2) = (bf16_t)f2bf(keep ? a2[t][j] : 0.f);
                  uu[j] = bf2f(ucur[t][j]) + a3[t][j]; }
              *(LAS u32x2*)(UT + dv * TS + (16 * mt + 4 * fq) * 2) = (u32x2){pk2(uu[0], uu[1]), pk2(uu[2], uu[3])}; } }
        __syncthreads();
        { RW_LANES; f32x4 acc[2] = {(f32x4){0.f, 0.f, 0.f, 0.f}, (f32x4){0.f, 0.f, 0.f, 0.f}};
          mm_rows<64, 2>(rt, TS, sT, TS, mt, nt0, fr, fq, acc); mm_rows<64, 2>(Arb, TS, UT, TS, mt, nt0, fr, fq, acc); mm_rows<64, 2>(Ark, TS, vT, TS, mt, nt0, fr, fq, acc);
          bf16_t* ob = WSP(bf16_t, d ? SC_OB : SC_OF);
#pragma unroll
          for (int t = 0; t < 2; ++t)
#pragma unroll
              for (int j = 0; j < 4; ++j) { const int r = 16 * mt + 4 * fq + j, i = d ? 63 - r : r; ob[(size_t)(s0 + i) * 1024 + 256 + 64 * h + 16 * (nt0 + t) + fr] = (bf16_t)f2bf(acc[t][j]); } }
        __syncthreads();
    }
#undef RW_LANES
#undef RW2_LOAD
}
__device__ __forceinline__ void phase_scan(const Cx& p, LAS unsigned char* lds, int layer, int b) {
    for (int w = p.bid; w < 160; w += p.G) {
        if (w < 64) ssd_chain(p, (w >> 4) & 3, (w >> 3) & 1, w & 7);
        else if (w < 96) gla_chain(p, ((w - 64) >> 3) & 3, ((w - 64) >> 2) & 1, (w - 64) & 3);
        else { const int i = w - 96, h = (i >> 3) & 3, d = (i >> 2) & 1, cb = i & 3;
            if (i < 32) dr_chain(p, SC_RW_M, SC_RW_NS, h, d, cb); else dr_chain(p, SC_DR_M, SC_DR_NS, h, d, cb); } }
}
#ifndef MK_ONE_LAUNCH
#define MK_ONE_LAUNCH 1
#endif
constexpr int PH_PER_LAYER = 2 + 5 * NB + 7;
constexpr int N_PHASES = 1 + NL * PH_PER_LAYER + 1;

__global__ void __launch_bounds__(NTHR, 2) mega_fwd(Params pp) {
    extern __shared__ __attribute__((aligned(16))) unsigned char lds_raw[];
    LAS unsigned char* lds = (LAS unsigned char*)lds_raw;
    const int swave = __builtin_amdgcn_readfirstlane(threadIdx.x >> 6);
    for (int i = threadIdx.x; i < (LDS_BYTES - LDS_CTL) / 4; i += NTHR) ((LAS unsigned*)(lds + LDS_CTL))[i] = 0u;
    __syncthreads();
    if (threadIdx.x < N_IN + 2) { const unsigned long long a = threadIdx.x < N_IN ? (unsigned long long)pp.in[threadIdx.x] : (threadIdx.x == N_IN ? (unsigned long long)pp.out : (unsigned long long)pp.ws); ((LAS unsigned*)(lds + LDS_PTRS))[2 * threadIdx.x] = (unsigned)a; ((LAS unsigned*)(lds + LDS_PTRS))[2 * threadIdx.x + 1] = (unsigned)(a >> 32); }
    __syncthreads();
    XcdBarrier bar = xcd_barrier_post((unsigned*)(pp.ws + WS_CTL) + CW_BAR + pp.li * XCD_BAR_WORDS, (volatile LAS unsigned*)(lds + LDS_CTL), threadIdx.x);
    LAS int* tb = (LAS int*)(lds + LDS_CTL + 64);
    int pc = 0; const int lo = pp.lo, hi = pp.hi;
#define PH_BEGIN if (pc >= lo && pc < hi) { Cx p; p.out = (unsigned long long)PIN(N_IN); p.ws = (unsigned long long)PIN(N_IN + 1); p.tid = swave * 64 + lane_id_asm(); p.bid = blockIdx.x; p.G = gridDim.x; p.pad = 0; asm volatile("" : "+s"(p.out), "+s"(p.ws), "+v"(p.tid), "+s"(p.bid), "+s"(p.G)); const int G = p.G, bid = p.bid; (void)G; (void)bid;
#define PH_END if (pc + 1 < hi) { XcdBarrier b2 = bar; asm volatile("" : "+s"(b2.bar), "+s"(b2.x)); xcd_barrier(b2, (unsigned)(swave * 64 + lane_id_asm())); } } ++pc;

    PH_BEGIN
        conv_run(p, (LAS float*)lds, CONV_A_UNITS, ConvDescA{0});
        __syncthreads();
        phase_mod(p, lds);
    PH_END

#pragma unroll
    for (int layer = 0; layer < NL; ++layer) {
        const int row_lo = layer == NL - 1 ? CROWS : 0;
        PH_BEGIN phase_norm1(p, layer); PH_END
        PH_BEGIN
            DenseSched S; S.init(ROWS, NPROJ, D, WSP(bf16_t, WS_WIN) + (size_t)layer * NPROJ * D, G, bid);
            EpiProj E{WSP(bf16_t, WS_PROJ), NPROJ};
            pg8::gemm_phase<D>(p.tid, lds, (const char*)WSP(bf16_t, WS_HBUF), S, E);
        PH_END
#pragma unroll 1
        for (int b = 0; b < NB; ++b) {
            PH_BEGIN phase_prep(p, lds, layer, b); PH_END
            PH_BEGIN gla_p1(p, lds, layer, b); __syncthreads(); ssd_p1(p, lds, layer, b); __syncthreads(); gdn_p1(p, lds, layer, b); __syncthreads(); rw_p1(p, lds, layer, b); PH_END
            PH_BEGIN phase_scan(p, lds, layer, b); PH_END
            PH_BEGIN gla_p2(p, lds, layer, b); __syncthreads(); ssd_p2(p, lds, layer, b); __syncthreads(); gdn_p2(p, lds, layer, b); __syncthreads(); rw_p2(p, lds, layer, b); PH_END
            PH_BEGIN phase_post(p, lds, layer, b); PH_END
        }
        PH_BEGIN
            DenseSched S; S.init(ROWS, D, D, WSP(bf16_t, WS_WOUT) + (size_t)layer * D * D, G, bid);
            EpiRes E{layer == 0 ? PIN(I_X) : (const float*)POUT, layer == 0 ? PIN(I_CTX) : (const float*)WSP(float, WS_CTXRES), POUT, WSP(float, WS_CTXRES), WSP(float, WS_MOD) + (size_t)layer * 5 * 6144 + 2048};
            pg8::gemm_phase<D>(p.tid, lds, (const char*)WSP(bf16_t, WS_HBUF), S, E);
        PH_END
        PH_BEGIN phase_norm2(p, lds, layer, row_lo);
            __syncthreads();
            conv_run(p, (LAS float*)lds, CONV_E_UNITS, ConvDescE{layer});
        PH_END
        PH_BEGIN
            moe_table(p, tb, layer, row_lo);
            MoeSched<true> S{tb + 128, tb, 2, G, bid, D, row_lo, WSP(int, WS_LTOK), (const char*)WSP(bf16_t, WS_EXPGU), (size_t)512 * D * 2};
            EpiGU E{WSP(bf16_t, WS_H)};
            pg8::gemm_phase<D>(p.tid, lds, (const char*)WSP(bf16_t, WS_HBUF), S, E);
        PH_END
#pragma unroll
        for (int half = 0; half < 2; ++half) {
            PH_BEGIN
                moe_table(p, tb, layer, row_lo);
                MoeSched<false> S{tb + 128, tb, 2, G, bid, EH, row_lo, WSP(int, WS_LTOK), (const char*)(WSP(bf16_t, WS_EXPD) + (size_t)half * 512 * EH), (size_t)D * EH * 2};
                EpiY E{WSP(bf16_t, WS_Y)};
                pg8::gemm_phase<EH>(p.tid, lds, (const char*)WSP(bf16_t, WS_H), S, E);
            PH_END
            PH_BEGIN
                moe_table(p, tb, layer, row_lo);
                phase_combine(p, tb, layer, row_lo, half);
            PH_END
        }
    }
    PH_BEGIN phase_final(p);
    PH_END
#undef PH_BEGIN
#undef PH_END
}

extern "C" void kernel_launch(void* const* d_in, const int* in_sizes, int n_in, void* d_out, int out_size, void* d_ws, size_t ws_size, hipStream_t stream) {
    static int grid = 0;
    if (grid == 0) {
        if (n_in != N_IN || in_sizes[0] != NB * SEQ * D || out_size != NB * SEQ * D || ws_size < WS_END) {
            fprintf(stderr, "kernel_launch: unexpected shapes (n_in %d, in0 %d, out %d, ws %zu); nothing launched\n", n_in, n_in > 0 ? in_sizes[0] : -1, out_size, ws_size); grid = -1; return; }
        int dev = 0, cus = 0, per_cu = 0;
        if (hipGetDevice(&dev) != hipSuccess || hipDeviceGetAttribute(&cus, hipDeviceAttributeMultiprocessorCount, dev) != hipSuccess) { grid = -1; return; }
        if (hipFuncSetAttribute((const void*)mega_fwd, hipFuncAttributeMaxDynamicSharedMemorySize, LDS_BYTES) != hipSuccess) { fprintf(stderr, "kernel_launch: hipFuncSetAttribute failed\n"); grid = -1; return; }
        if (hipOccupancyMaxActiveBlocksPerMultiprocessor(&per_cu, (const void*)mega_fwd, NTHR, LDS_BYTES) != hipSuccess || per_cu < 1) { fprintf(stderr, "kernel_launch: occupancy query says %d\n", per_cu); per_cu = 1; }
        (void)hipGetLastError();
        grid = cus * 1;
    }
    if (grid < 0) return;
    if (hipMemsetAsync((char*)d_ws + WS_CTL, 0, CTL_ZERO_BYTES, stream) != hipSuccess) return;
    Params p{};
    for (int i = 0; i < N_IN; ++i) p.in[i] = (const float*)d_in[i];
    p.out = (float*)d_out; p.ws = (unsigned char*)d_ws; p.pad = 0;
#if MK_ONE_LAUNCH
    p.lo = 0; p.hi = N_PHASES; p.li = 0;
    hipLaunchKernelGGL(mega_fwd, dim3(grid), dim3(NTHR), LDS_BYTES, stream, p);
#else
    for (int k = 0; k < N_PHASES; ++k) { p.lo = k; p.hi = k + 1; p.li = k;
        hipLaunchKernelGGL(mega_fwd, dim3(grid), dim3(NTHR), LDS_BYTES, stream, p); }
#endif
}
```

```cpp
#include <hip/hip_runtime.h>
#include <cstdio>
#include <cstdint>

typedef unsigned short bf16_t;
typedef short bf16x8 __attribute__((ext_vector_type(8)));
typedef float f32x4 __attribute__((ext_vector_type(4)));
typedef float f32x2 __attribute__((ext_vector_type(2)));
typedef unsigned u32x4 __attribute__((ext_vector_type(4)));
typedef unsigned u32x2 __attribute__((ext_vector_type(2)));

constexpr int NB = 4, SEQ = 8192, NCTX = 256, D = 1024, NL = 2;
constexpr int CROWS = NB * NCTX;
constexpr int ROWS = CROWS + NB * SEQ;
constexpr int SB = NCTX + SEQ;
constexpr int INW = 4056, NPROJ = 4096;
constexpr int NE = 64, NE1 = 65, TOPK = 8, EH = 256;
constexpr int GRIDW = 64, GRIDH = SEQ / GRIDW;
constexpr int PA_Q = 0, PA_K = 256, PA_V = 512, PA_G = 768, PA_GF = 1024, PA_GB = 1040;
constexpr int PB_R = 1056, PB_K = 1312, PB_V = 1568, PB_WF = 1824, PB_WB = 1856, PB_A = 1888, PB_G = 1920;
constexpr int PC_Z = 1984, PC_X = 2240, PC_DF = 3008, PC_DB = 3012;
constexpr int PD_Q = 3016, PD_Z = 3784, PD_BF = 4040, PD_BB = 4044, PD_AF = 4048, PD_AB = 4052;
enum { I_X = 0, I_C, I_CTX, I_CCTX, I_N1G, I_N2G, I_WMOD, I_BMOD, I_WIN, I_WOUT, I_GLA_W2, I_GLA_B, I_GLA_NG,
       I_RW_W2, I_RW_W0, I_RW_AW2, I_RW_A0, I_RW_GW2, I_RW_KK, I_RW_KA, I_RW_RK, I_RW_LNG, I_RW_LNB,
       I_SS_CW, I_SS_CB, I_SS_ALOG, I_SS_DTB, I_SS_D, I_SS_NG, I_DN_CW, I_DN_ALOG, I_DN_DTB, I_DN_NG,
       I_ROUT_W, I_ROUT_B, I_EXP_G, I_EXP_U, I_EXP_D, I_SH_G, I_SH_U, I_SH_D, I_FNG, N_IN };
static_assert(N_IN == 42, "input count");

constexpr size_t MiB = 1u << 20;
constexpr size_t WS_CTL = 0, CTL_ZERO_BYTES = 1 * MiB;
constexpr size_t WS_MOD = 1 * MiB;
constexpr size_t WS_RWGW = WS_MOD + 256 * 1024;
constexpr size_t WS_RWLR = WS_MOD + 384 * 1024;
constexpr size_t WS_WIN = 2 * MiB;
constexpr size_t WS_WOUT = 18 * MiB;
constexpr size_t WS_ROUT = 22 * MiB;
constexpr size_t WS_CTXRES = 23 * MiB;
constexpr size_t WS_EXPGU = 27 * MiB;
constexpr size_t WS_EXPD = 92 * MiB;
constexpr size_t WS_HBUF = 125 * MiB;
constexpr size_t WS_PROJ = 191 * MiB;
constexpr size_t WS_SCR = 455 * MiB;
constexpr size_t WS_END = 640455456;
constexpr int HROWS_MAX = ROWS * 9 + NE1 * 256;
constexpr size_t WS_Y = WS_HBUF;
constexpr size_t WS_H = 443 * MiB;
constexpr size_t WS_LTOK = 600 * MiB;
constexpr size_t WS_TOKT = WS_LTOK + (size_t)NE * ROWS * 4;
static_assert(WS_Y + (size_t)HROWS_MAX * 512 * 2 <= WS_H && WS_H + (size_t)HROWS_MAX * 256 * 2 <= WS_LTOK && WS_TOKT + (size_t)ROWS * 64 <= WS_END, "moe overlay");
constexpr size_t SC_OF = WS_SCR;
constexpr size_t SC_OB = SC_OF + (size_t)SB * 1024 * 2;
constexpr size_t SC_RK = SC_OB + (size_t)SB * 1024 * 2;
constexpr size_t SC_RKK = SC_RK + (size_t)SB * 256 * 4;
constexpr size_t SC_RB = SC_RKK + (size_t)SB * 256 * 4;
constexpr size_t SC_RLW = SC_RB + (size_t)SB * 256 * 4;
constexpr size_t SC_SX = SC_RLW + (size_t)2 * SB * 256 * 4;
constexpr size_t SC_DQ = SC_SX + (size_t)SB * 768 * 2;
constexpr size_t SC_SDT = SC_DQ + (size_t)SB * 768 * 2;
constexpr size_t SC_DG = SC_SDT + (size_t)SB * 8 * 4;
constexpr size_t SC_FEND = SC_DG + (size_t)SB * 16 * 4;
constexpr int NTB = SB / 64, NUNIT = NTB * 4 * 2;
constexpr size_t SC_RW_M = SC_FEND;
constexpr size_t SC_RW_NS = SC_RW_M + (size_t)(SB / 64 * 8) * 4096 * 2;
constexpr size_t SC_RW_WU = SC_RW_NS + (size_t)(SB / 64 * 8) * 4096 * 2;
constexpr size_t SC_END = SC_RW_WU + (size_t)(SB / 64 * 8) * 8192 * 2;
constexpr size_t SC2 = WS_EXPGU;
constexpr size_t SC_GLA_S = SC2;
constexpr size_t SC_GLA_DEC = SC_GLA_S + (size_t)NUNIT * 4096 * 4;
constexpr size_t SC_SSD_S = SC_GLA_DEC + (size_t)NUNIT * 64 * 4;
constexpr size_t SC_SSD_CD = SC_SSD_S + (size_t)NUNIT * 8192 * 4;
constexpr size_t SC_DR_M = SC_SSD_CD + (size_t)NUNIT * 4 + 4096;
constexpr size_t SC_DR_NS = SC_DR_M + (size_t)NUNIT * 4096 * 2;
constexpr size_t SC_DR_WU = SC_DR_NS + (size_t)NUNIT * 4096 * 2;
constexpr size_t SC2_END = SC_DR_WU + (size_t)NUNIT * 8192 * 2;
static_assert(SC2_END <= WS_HBUF, "chunk slots fit in the expert-weight region");
static_assert(SC_END <= WS_END, "scratch fits");
constexpr int CW_CNT = 1024;
constexpr int CW_BAR = 4096;

#define LAS __attribute__((address_space(3)))
constexpr int NTHR = 512;
constexpr int LDS_BYTES = 147456;
constexpr int LDS_CTL = 143360;
constexpr int LDS_PTRS = LDS_CTL + 2048;

__device__ __forceinline__ int lane_id_asm() { int l; asm volatile("v_mbcnt_lo_u32_b32 %0, -1, 0\n\tv_mbcnt_hi_u32_b32 %0, -1, %0" : "=v"(l)); return l; }
__device__ __forceinline__ float bf2f(bf16_t b) { return __uint_as_float(((unsigned)b) << 16); }
__device__ __forceinline__ unsigned f2bf(float f) { unsigned u = __float_as_uint(f); u += 0x7FFFu + ((u >> 16) & 1u); return u >> 16; }
__device__ __forceinline__ unsigned pk2(float lo, float hi) { return f2bf(lo) | (f2bf(hi) << 16); }
__device__ __forceinline__ float rl(float x, int k) { return __uint_as_float(__builtin_amdgcn_readlane(__float_as_uint(x), k)); }
__device__ __forceinline__ float shx_(float v, int lane, int o) { return __uint_as_float(__builtin_amdgcn_ds_bpermute((lane ^ o) << 2, __float_as_uint(v))); }
__device__ __forceinline__ int shxi_(int v, int lane, int o) { return __builtin_amdgcn_ds_bpermute((lane ^ o) << 2, v); }
__device__ __forceinline__ float shup_(float v, int lane, int o) { return __uint_as_float(__builtin_amdgcn_ds_bpermute((lane - o) << 2, __float_as_uint(v))); }
#define DPPF(v, ctrl) __uint_as_float(__builtin_amdgcn_update_dpp(0, __float_as_uint(v), ctrl, 0xf, 0xf, false))
#define DPPI(v, ctrl) __builtin_amdgcn_update_dpp(0, (v), ctrl, 0xf, 0xf, false)
__device__ __forceinline__ float wsum(float v) {
    v += DPPF(v, 0xB1); v += DPPF(v, 0x4E); v += DPPF(v, 0x141); v += DPPF(v, 0x140);
    v += __uint_as_float(__builtin_amdgcn_ds_swizzle(__float_as_uint(v), 0x401F));
    return rl(v, 0) + rl(v, 32);
}
__device__ __forceinline__ float rcp_(float x) { return __builtin_amdgcn_rcpf(x); }
__device__ __forceinline__ float rsq_(float x) { return __builtin_amdgcn_rsqf(x); }
__device__ __forceinline__ float sigmoidf_(float x) { return rcp_(1.0f + __expf(-x)); }
__device__ __forceinline__ float siluf_(float x) { return x * rcp_(1.0f + __expf(-x)); }
__device__ __forceinline__ float log1pexp_(float t  ) { return t < 1e-4f ? t - 0.5f * t * t : __logf(1.0f + t); }
__device__ __forceinline__ float softplusf_(float x) { return x > 15.f ? x : log1pexp_(__expf(x)); }
__device__ __forceinline__ float logsigmoidf_(float x) { return fminf(x, 0.f) - log1pexp_(__expf(-fabsf(x))); }
__device__ __forceinline__ float tanhf_(float x) { const float e = __expf(2.0f * fminf(fmaxf(x, -15.f), 15.f)); return (e - 1.0f) * rcp_(e + 1.0f); }
__device__ __forceinline__ int seq_tok(int i, int d) { return d == 0 ? i : (i < NCTX ? NCTX - 1 - i : SB + NCTX - 1 - i); }
__device__ __forceinline__ int tok_row(int b, int s) { return s < NCTX ? b * NCTX + s : CROWS + b * SEQ + (s - NCTX); }

#define GAS __attribute__((address_space(1)))
struct Params { const float* in[N_IN]; float* out; unsigned char* ws; int lo, hi, li, pad; };
struct Cx { unsigned long long out, ws; int tid, bid, G, pad; };
__device__ __forceinline__ const float* PIN(int i) {
    extern __shared__ __attribute__((aligned(16))) unsigned char lds_raw_[];
    int off = __builtin_amdgcn_readfirstlane(LDS_PTRS + 8 * i); asm volatile("" : "+s"(off));
    const LAS unsigned* t = (const LAS unsigned*)((LAS unsigned char*)lds_raw_ + off);
    const unsigned lo = __builtin_amdgcn_readfirstlane(t[0]), hi = __builtin_amdgcn_readfirstlane(t[1]);
    return (const float*)(const GAS float*)(((unsigned long long)hi << 32) | lo);
}
#define XB_TMO      128
#define XB_XCNT(j)  (256  + 64 * (j))
#define XB_XSUB(j)  (1280 + 64 * (j))
#define XB_XGEN(j)  (2304 + 64 * (j))
#define XB_TOP      3328
#define XB_TOPGEN   3392
#define XCD_BAR_WORDS 3456
#define XB_SPIN_CAP (1u << 18)

__device__ __forceinline__ unsigned xb_ld(unsigned* p)              { return __hip_atomic_load(p, __ATOMIC_RELAXED, __HIP_MEMORY_SCOPE_AGENT); }
__device__ __forceinline__ unsigned xb_add(unsigned* p, unsigned v) { return __hip_atomic_fetch_add(p, v, __ATOMIC_RELAXED, __HIP_MEMORY_SCOPE_AGENT); }
__device__ __forceinline__ unsigned xb_xcc_id() { return (unsigned)__builtin_amdgcn_s_getreg((3 << 11) | 20) & 0xFu; }
#define XB_SPIN(cond, bar) do { unsigned _sp = 0; while (cond) { __builtin_amdgcn_s_sleep(1); \
    if ((++_sp & 255u) == 0u) { if (xb_ld(&(bar)[XB_TMO])) break; if (_sp > XB_SPIN_CAP) { atomicAdd(&(bar)[XB_TMO], 1u); break; } } } } while (0)

struct XcdBarrier {
    unsigned* bar; unsigned x;
    volatile LAS unsigned* st;
};

__device__ __forceinline__ XcdBarrier xcd_barrier_post(unsigned* bar, volatile LAS unsigned* st, const unsigned xb_tid) {
    XcdBarrier b; b.bar = bar; b.x = xb_xcc_id(); b.st = st;
    if (xb_tid == 0) (void)xb_add(&bar[XB_XCNT(b.x)], 1u);
    return b;
}
__device__ __forceinline__ void xcd_barrier_complete(unsigned* bar, unsigned x, unsigned& nloc, unsigned& nx) {
    const unsigned G = gridDim.x * gridDim.y * gridDim.z;
    unsigned sum, cnt, mine, sp = 0u;
    for (;;) {
        sum = 0u; cnt = 0u; mine = 0u;
#pragma unroll
        for (unsigned j = 0; j < 16; ++j) { const unsigned c = xb_ld(&bar[XB_XCNT(j)]); sum += c; cnt += (c > 0u) ? 1u : 0u; mine = (j == x) ? c : mine; }
        if (sum == G) break;
        __builtin_amdgcn_s_sleep(1);
        if ((++sp & 255u) == 0u) { if (xb_ld(&bar[XB_TMO])) break; if (sp > XB_SPIN_CAP) { atomicAdd(&bar[XB_TMO], 1u); break; } }
    }
    nloc = mine > 0u ? mine : 1u; nx = cnt > 0u ? cnt : 1u;
}

__device__ __forceinline__ void xcd_barrier(const XcdBarrier& b, const unsigned xb_tid) {
    asm volatile("s_waitcnt vmcnt(0)" ::: "memory");
    __syncthreads();
    if (xb_tid == 0) {
        unsigned* bar = b.bar;
        __builtin_amdgcn_s_waitcnt(0);
        unsigned nloc = b.st[0], nx = b.st[1];
        if (nloc == 0u) { xcd_barrier_complete(bar, b.x, nloc, nx); b.st[0] = nloc; b.st[1] = nx; }
        const unsigned old = xb_add(&bar[XB_XSUB(b.x)], 1u);
        const unsigned gen = old / nloc;
        if (old + 1u == (gen + 1u) * nloc) {
            __builtin_amdgcn_fence(__ATOMIC_RELEASE, "agent");
            asm volatile("s_waitcnt vmcnt(0)" ::: "memory");
            const unsigned og = xb_add(&bar[XB_TOP], 1u);
            const unsigned tg = og / nx;
            if (og + 1u == (tg + 1u) * nx) xb_add(&bar[XB_TOPGEN], 1u);
            else XB_SPIN(xb_ld(&bar[XB_TOPGEN]) == tg, bar);
            __builtin_amdgcn_fence(__ATOMIC_ACQUIRE, "agent");
            xb_add(&bar[XB_XGEN(b.x)], 1u);
            asm volatile("s_waitcnt vmcnt(0)" ::: "memory");
        } else {
            XB_SPIN(xb_ld(&bar[XB_XGEN(b.x)]) == gen, bar);
            __builtin_amdgcn_fence(__ATOMIC_ACQUIRE, "agent");
            asm volatile("s_waitcnt vmcnt(0)" ::: "memory");
        }
    }
    __syncthreads();
}

namespace pg8 {
constexpr int BM = 256, BK = 64, HALF = 128, HTB = HALF * BK * 2  , STAGE_BYTES = 8 * HTB, NXCD = 8, WGM = 8;
__host__ __device__ __forceinline__ int lds_byte(int r, int c) { const int st = (r >> 4) * 2 + (c >> 5), rr = r & 15, cc = c & 31, ob = rr * 64 + cc * 2; return st * 1024 + (ob ^ (((ob >> 9) & 1) << 5)); }
__host__ __device__ __forceinline__ void stage_rc(int b, int& R, int& C) { const int st = b / 1024, sb = b % 1024, swz = sb ^ (((sb >> 9) & 1) << 5); R = (st >> 1) * 16 + swz / 64; C = (st & 1) * 32 + (swz % 64) / 2; }
__host__ __device__ __forceinline__ int perm32(int rho) { const int n = rho >> 4, i = rho & 15; return 8 * (i >> 2) + 4 * n + (i & 3); }

struct Unit { int pm, pn, e, r0; };

__device__ __forceinline__ unsigned cvt_pk_bf16(float lo, float hi) { unsigned r; asm volatile("v_cvt_pk_bf16_f32 %0, %1, %2" : "=v"(r) : "v"(lo), "v"(hi)); return r; }

template <int K, class Epi, class Sched>
__device__ __forceinline__ void gemm_phase(const int tid, LAS unsigned char* lds, const char* Abase, const Sched& S, const Epi& E) {
    const int wid = __builtin_amdgcn_readfirstlane(tid >> 6), lane = tid & 63, wr = wid >> 2, wc = wid & 3, fr = lane & 15, fq = lane >> 4;
    const int nt = K / BK;
    constexpr bool DN = Sched::DENSE;
    int RA[2], CA[2]; unsigned voffB[2], voffA[2];
#pragma unroll
    for (int i = 0; i < 2; ++i) { int R, C; stage_rc(tid * 16 + i * 8192, R, C); const int Rb = Epi::PERM ? ((R & ~31) + perm32(R & 31)) : R;
        RA[i] = R; CA[i] = C; voffB[i] = (unsigned)(Rb * K + C) * 2u; voffA[i] = (unsigned)(R * K + C) * 2u; }
    const size_t kstep = (size_t)(BK * 2);
    const size_t hstep = (size_t)HALF * K * 2;
    const size_t tstep = 2 * hstep;
    const unsigned ldsw = (unsigned)wid * 1024u;
    const int aoff = lds_byte(wr * 64 + fr, fq * 8), boff = lds_byte(wc * 32 + fr, fq * 8);
#define PG8_SA(b, h) (((b) * 2 + (h)) * HTB)
#define PG8_SB(b, h) ((4 + (b) * 2 + (h)) * HTB)
#define PG8_STAGE(bufoff, gbase, voff) do { _Pragma("unroll") for (int _i = 0; _i < 2; ++_i) \
        __builtin_amdgcn_global_load_lds((const __attribute__((address_space(1))) unsigned*)((const __attribute__((address_space(1))) char*)(gbase) + (voff)[_i]), (LAS unsigned*)(lds + (bufoff) + ldsw + _i * 8192), 16, 0, 0); } while (0)
#define PG8_LDA(dst, b, h) do { _Pragma("unroll") for (int m = 0; m < 4; ++m) _Pragma("unroll") for (int k = 0; k < 2; ++k) dst[m][k] = *(const LAS bf16x8*)(lds + PG8_SA(b, h) + aoff + m * 2048 + k * 1024); } while (0)
#define PG8_LDB(dst, b, h) do { _Pragma("unroll") for (int n = 0; n < 2; ++n) _Pragma("unroll") for (int k = 0; k < 2; ++k) dst[n][k] = *(const LAS bf16x8*)(lds + PG8_SB(b, h) + boff + n * 2048 + k * 1024); } while (0)
#define PG8_MMA(ai, bj, At, Bt) do { __builtin_amdgcn_s_setprio(1); _Pragma("unroll") for (int m = 0; m < 4; ++m) _Pragma("unroll") for (int n = 0; n < 2; ++n) _Pragma("unroll") for (int k = 0; k < 2; ++k) \
        acc[ai][bj][m][n] = __builtin_amdgcn_mfma_f32_16x16x32_bf16(Bt[n][k], At[m][k], acc[ai][bj][m][n], 0, 0, 0); __builtin_amdgcn_s_setprio(0); } while (0)
#define PG8_WAIT_V(n) asm volatile("s_waitcnt vmcnt(" #n ")" ::: "memory")
#define PG8_WAIT_L(n) asm volatile("s_waitcnt lgkmcnt(" #n ")" ::: "memory")
#define PG8_BAR __builtin_amdgcn_s_barrier()
#define PG8_SCHED __builtin_amdgcn_sched_barrier(0)
#define PG8_AOFF(dst, u) do { _Pragma("unroll") for (int _h = 0; _h < 2; ++_h) _Pragma("unroll") for (int _i = 0; _i < 2; ++_i) \
        dst[_h][_i] = ((unsigned)S.a_row(u, _h * HALF + RA[_i]) * (unsigned)K + (unsigned)CA[_i]) * 2u; } while (0)
    Unit cur, nxt; int ui = 0;
    if (!S.next(0, cur)) return;
    f32x4 acc[2][2][4][2];
#pragma unroll
    for (int a = 0; a < 2; ++a)
#pragma unroll
        for (int b = 0; b < 2; ++b)
#pragma unroll
            for (int m = 0; m < 4; ++m)
#pragma unroll
                for (int n = 0; n < 2; ++n) acc[a][b][m][n] = (f32x4){0.f, 0.f, 0.f, 0.f};
    bf16x8 At[4][2], B0[2][2], B1[2][2];
    unsigned cO[2][2], nO[2][2];
    const char* cA = Abase; const char* nA = Abase;
    if constexpr (DN) cA = Abase + (size_t)S.a_row(cur, 0) * K * 2; else PG8_AOFF(cO, cur);
    const char* cB = S.b_ptr(cur);
#define PG8_STA(bufoff, h_, kb_, nx_) do { if constexpr (DN) PG8_STAGE(bufoff, ((nx_) ? nA : cA) + (h_) * hstep + (kb_), voffA); else PG8_STAGE(bufoff, Abase + (kb_), ((nx_) ? nO : cO)[h_]); } while (0)
    PG8_STAGE(PG8_SB(0, 0), cB, voffB); PG8_SCHED; PG8_STA(PG8_SA(0, 0), 0, 0, false); PG8_SCHED; PG8_STAGE(PG8_SB(0, 1), cB + hstep, voffB); PG8_SCHED; PG8_STA(PG8_SA(0, 1), 1, 0, false); PG8_SCHED;
    if (wr == 1) PG8_BAR;
    PG8_WAIT_V(4); PG8_BAR;
    PG8_STAGE(PG8_SB(1, 0), cB + kstep, voffB); PG8_SCHED; PG8_STA(PG8_SA(1, 0), 0, kstep, false); PG8_SCHED; PG8_STAGE(PG8_SB(1, 1), cB + hstep + kstep, voffB); PG8_SCHED;
    PG8_WAIT_V(6); PG8_BAR;
    for (;;) {
        const bool has_next = S.next(ui + 1, nxt);
        const char* nB = cB; nA = cA;
        if (has_next) { if constexpr (DN) nA = Abase + (size_t)S.a_row(nxt, 0) * K * 2; else PG8_AOFF(nO, nxt); nB = S.b_ptr(nxt); }
        else if constexpr (!DN) {
#pragma unroll
            for (int h = 0; h < 2; ++h)
#pragma unroll
                for (int i = 0; i < 2; ++i) nO[h][i] = cO[h][i]; }
        for (int t = 0; t < nt; t += 2) {
            const bool last = (t == nt - 2);
            const size_t k1 = (size_t)(t + 1) * kstep, k2 = last ? 0 : (size_t)(t + 2) * kstep, k3 = k2 + kstep;
            const char* b2 = last ? nB : cB + (size_t)(t + 2) * kstep; const char* b3 = b2 + kstep;
            PG8_LDB(B0, 0, 0); PG8_SCHED; PG8_LDA(At, 0, 0); PG8_STA(PG8_SA(1, 1), 1, k1, false);
            PG8_WAIT_L(8); PG8_BAR; PG8_WAIT_L(0); PG8_MMA(0, 0, At, B0); PG8_BAR; PG8_SCHED;
            PG8_LDB(B1, 0, 1); PG8_STAGE(PG8_SB(0, 0), b2, voffB);
            PG8_BAR; PG8_WAIT_L(0); PG8_MMA(0, 1, At, B1); PG8_BAR;
            PG8_LDA(At, 0, 1); PG8_STA(PG8_SA(0, 0), 0, k2, last);
            PG8_BAR; PG8_WAIT_L(0); PG8_MMA(1, 0, At, B0); PG8_BAR; PG8_SCHED;
            PG8_STAGE(PG8_SB(0, 1), b2 + hstep, voffB);
            PG8_WAIT_V(6); PG8_BAR; PG8_MMA(1, 1, At, B1); PG8_BAR;
            PG8_LDB(B0, 1, 0); PG8_SCHED; PG8_LDA(At, 1, 0); PG8_STA(PG8_SA(0, 1), 1, k2, last);
            PG8_WAIT_L(8); PG8_BAR; PG8_WAIT_L(0); PG8_MMA(0, 0, At, B0); PG8_BAR; PG8_SCHED;
            PG8_LDB(B1, 1, 1); PG8_STAGE(PG8_SB(1, 0), b3, voffB);
            PG8_BAR; PG8_WAIT_L(0); PG8_MMA(0, 1, At, B1); PG8_BAR;
            PG8_LDA(At, 1, 1); PG8_STA(PG8_SA(1, 0), 0, k3, last);
            PG8_BAR; PG8_WAIT_L(0); PG8_MMA(1, 0, At, B0); PG8_BAR; PG8_SCHED;
            PG8_STAGE(PG8_SB(1, 1), b3 + hstep, voffB);
            PG8_WAIT_V(6); PG8_BAR; PG8_MMA(1, 1, At, B1); PG8_BAR;
        }
        E(acc, cur, wid);
        if (!has_next) break;
#pragma unroll
        for (int a = 0; a < 2; ++a)
#pragma unroll
            for (int b = 0; b < 2; ++b)
#pragma unroll
                for (int m = 0; m < 4; ++m)
#pragma unroll
                    for (int n = 0; n < 2; ++n) acc[a][b][m][n] = (f32x4){0.f, 0.f, 0.f, 0.f};
        cur = nxt; cB = nB; cA = nA; ++ui;
        if constexpr (!DN) {
#pragma unroll
        for (int h = 0; h < 2; ++h)
#pragma unroll
            for (int i = 0; i < 2; ++i) cO[h][i] = nO[h][i]; }
    }
    PG8_WAIT_V(0);
    if (wr == 0) PG8_BAR;
    PG8_BAR;
#undef PG8_SA
#undef PG8_SB
#undef PG8_STAGE
#undef PG8_LDA
#undef PG8_LDB
#undef PG8_MMA
#undef PG8_WAIT_V
#undef PG8_WAIT_L
#undef PG8_BAR
#undef PG8_SCHED
#undef PG8_AOFF
#undef PG8_STA
}
}
struct DenseSched {
    static constexpr bool DENSE = true;
    int nM, nN, nwg, G, c, K; const char* Bt;
    __device__ __forceinline__ void init(int M, int N, int K_, const bf16_t* Bt_, int G_, int c_) { nM = M / 256; nN = N / 256; nwg = nM * nN; G = G_; c = c_; K = K_; Bt = (const char*)Bt_; }
    __device__ __forceinline__ bool next(int i, pg8::Unit& u) const {
        const long L = (long)i * G + c; if (L >= nwg) return false;
        int wgid = (int)L; { const int q = nwg / 8, r = nwg % 8, xcd = wgid % 8, off = wgid / 8; wgid = (xcd < r ? xcd * (q + 1) : r * (q + 1) + (xcd - r) * q) + off; }
        const int nig = 8 * nN, gid = wgid / nig, fm = gid * 8, gsz = (nM - fm) < 8 ? (nM - fm) : 8;
        u.pm = fm + ((wgid % nig) % gsz); u.pn = (wgid % nig) / gsz; u.e = 0; u.r0 = 0; return true;
    }
    __device__ __forceinline__ int a_row(const pg8::Unit& u, int r) const { return u.pm * 256 + r; }
    __device__ __forceinline__ const char* b_ptr(const pg8::Unit& u) const { return Bt + (size_t)u.pn * 256 * K * 2; }
};
template <bool GATHER> struct MoeSched {
    static constexpr bool DENSE = !GATHER;
    const LAS int* tstart; const LAS int* cnt; int nN, G, c, K, row_lo; const int* ltok; const char* Bt; size_t bstride;
    __device__ __forceinline__ bool next(int i, pg8::Unit& u) const {
        const long L = (long)i * G + c; const int ntile = __builtin_amdgcn_readfirstlane(tstart[NE1]); if (L >= (long)ntile * nN) return false;
        const int tile = (int)(L / nN); u.pn = (int)(L % nN);
        int e = 0;
#pragma unroll 1
        for (int step = 64; step >= 1; step >>= 1) { const int e2 = e + step; if (e2 <= NE && tstart[e2] <= tile) e = e2; }
        e = __builtin_amdgcn_readfirstlane(e); u.e = e; u.pm = __builtin_amdgcn_readfirstlane(tile); u.pn = __builtin_amdgcn_readfirstlane(u.pn); u.r0 = __builtin_amdgcn_readfirstlane((tile - tstart[e]) * 256); return true;
    }
    __device__ __forceinline__ int a_row(const pg8::Unit& u, int r) const {
        if (!GATHER) return u.pm * 256 + r;
        const int ri = u.r0 + r;
        if (u.e == NE) return ri < cnt[NE] ? row_lo + ri : row_lo;
        return ri < cnt[u.e] ? ltok[(size_t)u.e * ROWS + ri] : row_lo;
    }
    __device__ __forceinline__ const char* b_ptr(const pg8::Unit& u) const { return Bt + (size_t)u.e * bstride + (size_t)u.pn * 256 * K * 2; }
};

struct EpiProj {
    static constexpr bool PERM = true;
    bf16_t* O; int ldc;
    __device__ __forceinline__ void operator()(const f32x4 (&acc)[2][2][4][2], const pg8::Unit& u, const int wid) const {
        const int lane_ = lane_id_asm(), fr = lane_ & 15, fq = lane_ >> 4, wr = wid >> 2, wc = wid & 3;
        const int row0 = u.pm * 256 + wr * 64 + fr, col0 = u.pn * 256 + wc * 32 + 8 * fq;
#pragma unroll
        for (int ai = 0; ai < 2; ++ai)
#pragma unroll
            for (int m = 0; m < 4; ++m) { bf16_t* rowp = O + (size_t)(row0 + ai * 128 + m * 16) * ldc + col0;
#pragma unroll
                for (int bj = 0; bj < 2; ++bj) { const f32x4 v0 = acc[ai][bj][m][0], v1 = acc[ai][bj][m][1];
                    u32x4 w; w.x = pg8::cvt_pk_bf16(v0[0], v0[1]); w.y = pg8::cvt_pk_bf16(v0[2], v0[3]); w.z = pg8::cvt_pk_bf16(v1[0], v1[1]); w.w = pg8::cvt_pk_bf16(v1[2], v1[3]);
                    *(u32x4*)(rowp + bj * 128) = w; } }
    }
};
struct EpiRes {
    static constexpr bool PERM = false;
    const float* xsrc; const float* csrc; float* xdst; float* cdst; const float* gate;
    __device__ __forceinline__ void operator()(const f32x4 (&acc)[2][2][4][2], const pg8::Unit& u, const int wid) const {
        const int lane_ = lane_id_asm(), fr = lane_ & 15, fq = lane_ >> 4, wr = wid >> 2, wc = wid & 3;
        const int col0 = u.pn * 256 + wc * 32 + 4 * fq;
        const bool isc = u.pm < 4; const int sel = isc ? 4 : (u.pm - 4) >> 5;
        const float* src = isc ? csrc + (size_t)u.pm * 256 * D : xsrc + (size_t)(u.pm - 4) * 256 * D;
        float* dst = isc ? cdst + (size_t)u.pm * 256 * D : xdst + (size_t)(u.pm - 4) * 256 * D;
        f32x4 gv[2][2];
#pragma unroll
        for (int bj = 0; bj < 2; ++bj)
#pragma unroll
            for (int n = 0; n < 2; ++n) gv[bj][n] = *(const f32x4*)(gate + sel * 6144 + col0 + bj * 128 + n * 16);
#pragma unroll
        for (int ai = 0; ai < 2; ++ai)
#pragma unroll
            for (int m = 0; m < 4; ++m) { const size_t off = (size_t)(ai * 128 + wr * 64 + m * 16 + fr) * D + col0;
#pragma unroll
                for (int bj = 0; bj < 2; ++bj)
#pragma unroll
                    for (int n = 0; n < 2; ++n) { const f32x4 s = *(const f32x4*)(src + off + bj * 128 + n * 16); *(f32x4*)(dst + off + bj * 128 + n * 16) = s + gv[bj][n] * acc[ai][bj][m][n]; }
                asm volatile("" ::: "memory"); }
    }
};
struct EpiGU {
    static constexpr bool PERM = false;
    bf16_t* H;
    __device__ __forceinline__ void operator()(const f32x4 (&acc)[2][2][4][2], const pg8::Unit& u, const int wid) const {
        const int lane_ = lane_id_asm(), fr = lane_ & 15, fq = lane_ >> 4, wr = wid >> 2, wc = wid & 3;
        const int row0 = u.pm * 256 + wr * 64 + fr;
#pragma unroll
        for (int ai = 0; ai < 2; ++ai)
#pragma unroll
            for (int m = 0; m < 4; ++m) { bf16_t* rowp = H + (size_t)(row0 + ai * 128 + m * 16) * EH + 4 * fq;
#pragma unroll
                for (int bj = 0; bj < 2; ++bj) { const f32x4 g = acc[ai][bj][m][0], up = acc[ai][bj][m][1]; float h[4];
#pragma unroll
                    for (int j = 0; j < 4; ++j) h[j] = g[j] * rcp_(1.0f + __expf(-g[j])) * up[j];
                    u32x2 w; w.x = pg8::cvt_pk_bf16(h[0], h[1]); w.y = pg8::cvt_pk_bf16(h[2], h[3]);
                    *(u32x2*)(rowp + (u.pn * 256 + bj * 128 + wc * 32) / 2) = w; } }
    }
};
struct EpiY {
    static constexpr bool PERM = true;
    bf16_t* Y;
    __device__ __forceinline__ void operator()(const f32x4 (&acc)[2][2][4][2], const pg8::Unit& u, const int wid) const {
        const int lane_ = lane_id_asm(), fr = lane_ & 15, fq = lane_ >> 4, wr = wid >> 2, wc = wid & 3;
        const int row0 = u.pm * 256 + wr * 64 + fr, col0 = u.pn * 256 + wc * 32 + 8 * fq;
#pragma unroll
        for (int ai = 0; ai < 2; ++ai)
#pragma unroll
            for (int m = 0; m < 4; ++m) { bf16_t* rowp = Y + (size_t)(row0 + ai * 128 + m * 16) * 512 + col0;
#pragma unroll
                for (int bj = 0; bj < 2; ++bj) { const f32x4 v0 = acc[ai][bj][m][0], v1 = acc[ai][bj][m][1];
                    u32x4 w; w.x = pg8::cvt_pk_bf16(v0[0], v0[1]); w.y = pg8::cvt_pk_bf16(v0[2], v0[3]); w.z = pg8::cvt_pk_bf16(v1[0], v1[1]); w.w = pg8::cvt_pk_bf16(v1[2], v1[3]);
                    *(u32x4*)(rowp + bj * 128) = w; } }
    }
};
#define WSP(T, off) ((T*)(GAS T*)(p.ws + (unsigned long long)(off)))
#define POUT ((float*)(GAS float*)p.out)

constexpr int CONV_A_UNITS = 2048 + 512 + 64 + 8 + 12;
struct ConvDesc { const float* src; bf16_t* dst; int ldsrc, lddst, k0, n0, mode, nvalid; };
struct ConvDescA { int dummy;
    __device__ __forceinline__ ConvDesc operator()(const Cx& p, int u) const { ConvDesc c;
        if (u < 2048) { const int l = u >> 10, r = u & 1023; c.src = PIN(I_WIN) + (size_t)l * D * INW; c.ldsrc = INW; c.k0 = (r >> 6) * 64; c.n0 = (r & 63) * 64; c.nvalid = INW; c.dst = WSP(bf16_t, WS_WIN) + (size_t)l * NPROJ * D; c.lddst = D; c.mode = 0; }
        else if (u < 2560) { const int v = u - 2048, l = v >> 8, r = v & 255; c.src = PIN(I_WOUT) + (size_t)l * D * D; c.ldsrc = D; c.k0 = (r >> 4) * 64; c.n0 = (r & 15) * 64; c.nvalid = D; c.dst = WSP(bf16_t, WS_WOUT) + (size_t)l * D * D; c.lddst = D; c.mode = 0; }
        else if (u >= 2632) { const int v = u - 2632, m = v >> 2, r = v & 3;
            c.src = m < NL ? PIN(I_RW_W2) + (size_t)m * 64 * 256 : PIN(I_RW_AW2); c.ldsrc = 256; c.k0 = 0; c.n0 = r * 64; c.nvalid = 256; c.dst = WSP(bf16_t, WS_RWLR) + (size_t)m * 256 * 64; c.lddst = 64; c.mode = 0; }
        else if (u >= 2624) { const int v = u - 2624, l = v >> 2, r = v & 3;
            c.src = PIN(I_RW_GW2) + (size_t)l * 64 * 256; c.ldsrc = 256; c.k0 = 0; c.n0 = r * 64; c.nvalid = 256; c.dst = WSP(bf16_t, WS_RWGW) + (size_t)l * 256 * 64; c.lddst = 64; c.mode = 0; }
        else { const int v = u - 2560, l = v >> 5, lo = (v >> 4) & 1, r = v & 15;
            c.src = PIN(I_ROUT_W) + (size_t)l * D * NE; c.ldsrc = NE; c.k0 = r * 64; c.n0 = 0; c.nvalid = NE; c.dst = WSP(bf16_t, WS_ROUT) + (size_t)(l * 2 + lo) * NE * D; c.lddst = D; c.mode = lo ? 3 : 0; }
        return c; } };
constexpr int CONV_E_UNITS = NE1 * 192;
struct ConvDescE { int l;
    __device__ __forceinline__ ConvDesc operator()(const Cx& p, int u) const { ConvDesc c; const int e = u / 192, r = u % 192; c.nvalid = 1 << 30;
        if (r < 128) { const int up = r >> 6, q = r & 63;
            c.src = e < NE ? PIN(up ? I_EXP_U : I_EXP_G) + ((size_t)l * NE + e) * D * EH : PIN(up ? I_SH_U : I_SH_G) + (size_t)l * D * EH;
            c.ldsrc = EH; c.k0 = (q >> 2) * 64; c.n0 = (q & 3) * 64; c.dst = WSP(bf16_t, WS_EXPGU) + (size_t)e * 512 * D; c.lddst = D; c.mode = 1 + up; }
        else { const int q = r - 128;
            c.src = e < NE ? PIN(I_EXP_D) + ((size_t)l * NE + e) * EH * D : PIN(I_SH_D) + (size_t)l * EH * D;
            c.ldsrc = D; c.k0 = (q >> 4) * 64; c.n0 = (q & 15) * 64; c.dst = WSP(bf16_t, WS_EXPD) + (size_t)e * D * EH; c.lddst = EH; c.mode = 0; }
        return c; } };
template <class DescF> __device__ __forceinline__ void conv_run(const Cx& p, LAS float* tl, int total, const DescF& df) {
    const int t = p.tid; int u = p.bid; if (u >= total) return;
    float v[8]; ConvDesc c = df(p, u);
#define CONV_LD(cc) _Pragma("unroll") for (int j = 0; j < 8; ++j) { const int idx = t + NTHR * j, k = idx >> 6, n = idx & 63; v[j] = (cc).n0 + n < (cc).nvalid ? (cc).src[(size_t)((cc).k0 + k) * (cc).ldsrc + (cc).n0 + n] : 0.f; }
    CONV_LD(c)
    for (;;) {
#pragma unroll
        for (int j = 0; j < 8; ++j) { const int idx = t + NTHR * j; tl[(idx >> 6) * 65 + (idx & 63)] = v[j]; }
        __syncthreads();
        const int un = u + p.G; const bool more = un < total; const ConvDesc cn = df(p, more ? un : u);
        if (more) { CONV_LD(cn) }
#pragma unroll
        for (int j = 0; j < 4; ++j) { const int pi = t + NTHR * j, n = pi >> 5, k = (pi & 31) * 2; const int nn = c.n0 + n;
            const int row = (c.mode == 0 || c.mode == 3) ? nn : ((nn >> 4) * 32 + (nn & 15) + (c.mode == 2 ? 16 : 0));
            float v0 = tl[k * 65 + n], v1 = tl[(k + 1) * 65 + n];
            if (c.mode == 3) { v0 -= bf2f((bf16_t)f2bf(v0)); v1 -= bf2f((bf16_t)f2bf(v1)); }
            *(unsigned*)(c.dst + (size_t)row * c.lddst + c.k0 + k) = pk2(v0, v1); }
        __syncthreads();
        if (!more) break;
        c = cn; u = un;
    }
#undef CONV_LD
}
__device__ __forceinline__ void phase_mod(const Cx& p, LAS unsigned char* lds) {
    LAS float* sv = (LAS float*)lds; LAS float* red = sv + 5 * D;
    const int tid = p.tid;
    if (p.bid >= 192) return;
    for (int i = tid; i < 5 * D; i += NTHR) { const int j = i >> 10, k = i & 1023; const float c = j < 4 ? PIN(I_C)[j * D + k] : PIN(I_CCTX)[k]; sv[i] = siluf_(c); }
    __syncthreads();
    for (int u = p.bid; u < 192; u += p.G) {
        const int l = u / 96, cb = u % 96, kg = tid >> 6, cl = tid & 63;
        const float* w = PIN(I_WMOD) + (size_t)l * D * 6144 + cb * 64 + cl;
        float a0 = 0.f, a1 = 0.f, a2 = 0.f, a3 = 0.f, a4 = 0.f;
#pragma unroll 32
        for (int kk = 0; kk < 128; ++kk) { const int k = kg * 128 + kk; const float wv = w[(size_t)k * 6144];
            a0 += sv[k] * wv; a1 += sv[D + k] * wv; a2 += sv[2 * D + k] * wv; a3 += sv[3 * D + k] * wv; a4 += sv[4 * D + k] * wv; }
        red[(kg * 5 + 0) * 64 + cl] = a0; red[(kg * 5 + 1) * 64 + cl] = a1; red[(kg * 5 + 2) * 64 + cl] = a2; red[(kg * 5 + 3) * 64 + cl] = a3; red[(kg * 5 + 4) * 64 + cl] = a4;
        __syncthreads();
        if (tid < 320) { const int j = tid >> 6; float s = 0.f;
#pragma unroll
            for (int g = 0; g < 8; ++g) s += red[(g * 5 + j) * 64 + cl];
            WSP(float, WS_MOD)[((size_t)l * 5 + j) * 6144 + cb * 64 + cl] = s + PIN(I_BMOD)[l * 6144 + cb * 64 + cl]; }
        __syncthreads();
    }
}
__device__ __forceinline__ const float* res_row(const Cx& p, int layer_src0, int r) {
    if (r < CROWS) return (layer_src0 ? PIN(I_CTX) : (const float*)WSP(float, WS_CTXRES)) + (size_t)r * D;
    return (layer_src0 ? PIN(I_X) : (const float*)POUT) + (size_t)(r - CROWS) * D;
}
__device__ __forceinline__ int row_sel(int r) { return r < CROWS ? 4 : (r - CROWS) >> 13; }

__device__ __forceinline__ void norm_ld(const float* src, f32x4 (&v)[4], int lane) {
#pragma unroll
    for (int i = 0; i < 4; ++i) v[i] = *(const f32x4*)(src + 256 * i + 4 * lane);
}
__device__ __forceinline__ void norm_fin(const f32x4 (&v)[4], const float* g, const float* shift, const float* scale, bf16_t* dst, const bool tolds, LAS bf16_t* ldst, LAS bf16_t* ldlo, int lane) {
    float ss = 0.f;
#pragma unroll
    for (int i = 0; i < 4; ++i) ss += v[i][0] * v[i][0] + v[i][1] * v[i][1] + v[i][2] * v[i][2] + v[i][3] * v[i][3];
    ss = wsum(ss); const float rstd = rsq_(ss * (1.0f / D) + 1e-6f);
#pragma unroll
    for (int i = 0; i < 4; ++i) { const int col = 256 * i + 4 * lane; const f32x4 gv = *(const f32x4*)(g + col), sh = *(const f32x4*)(shift + col), sc = *(const f32x4*)(scale + col);
        const f32x4 y = v[i] * rstd * gv * (sc + 1.0f) + sh; u32x2 w; w.x = pk2(y[0], y[1]); w.y = pk2(y[2], y[3]);
        *(u32x2*)(dst + col) = w;
        if (tolds) { *(LAS u32x2*)(ldst + col) = w; u32x2 wl;
            wl.x = pk2(y[0] - __uint_as_float(w.x << 16), y[1] - __uint_as_float(w.x & 0xffff0000u)); wl.y = pk2(y[2] - __uint_as_float(w.y << 16), y[3] - __uint_as_float(w.y & 0xffff0000u));
            *(LAS u32x2*)(ldlo + col) = wl; } }
}
struct ModC { int s; f32x4 A[4], B[4];
    __device__ __forceinline__ void load(const float* g, const float* shift, const float* scale, int s_, int lane) { s = s_;
#pragma unroll
        for (int i = 0; i < 4; ++i) { const int col = 256 * i + 4 * lane; A[i] = *(const f32x4*)(g + col) * (*(const f32x4*)(scale + col) + 1.0f); B[i] = *(const f32x4*)(shift + col); } } };
__device__ __forceinline__ void norm_fin2(const f32x4 (&v)[4], const ModC& mc, bf16_t* dst, const bool tolds, LAS bf16_t* ldst, LAS bf16_t* ldlo, int lane) {
    float ss = 0.f;
#pragma unroll
    for (int i = 0; i < 4; ++i) ss += v[i][0] * v[i][0] + v[i][1] * v[i][1] + v[i][2] * v[i][2] + v[i][3] * v[i][3];
    ss = wsum(ss); const float rstd = rsq_(ss * (1.0f / D) + 1e-6f);
#pragma unroll
    for (int i = 0; i < 4; ++i) { const int col = 256 * i + 4 * lane;
        const f32x4 y = v[i] * rstd * mc.A[i] + mc.B[i]; u32x2 w; w.x = pk2(y[0], y[1]); w.y = pk2(y[2], y[3]);
        *(u32x2*)(dst + col) = w;
        if (tolds) { *(LAS u32x2*)(ldst + col) = w; u32x2 wl;
            wl.x = pk2(y[0] - __uint_as_float(w.x << 16), y[1] - __uint_as_float(w.x & 0xffff0000u)); wl.y = pk2(y[2] - __uint_as_float(w.y << 16), y[3] - __uint_as_float(w.y & 0xffff0000u));
            *(LAS u32x2*)(ldlo + col) = wl; } }
}
__device__ __forceinline__ void phase_norm1(const Cx& p, int layer) {
    const int lane = p.tid & 63, wave = p.tid >> 6;
    const float* mod = WSP(float, WS_MOD) + (size_t)layer * 5 * 6144; const float* g = PIN(I_N1G) + layer * D; bf16_t* hb = WSP(bf16_t, WS_HBUF);
    ModC mc; mc.s = -1; f32x4 n0[4], n1[4];
    int r = p.bid * 16 + wave * 2;
    if (r < ROWS) { norm_ld(res_row(p, layer == 0, r), n0, lane); norm_ld(res_row(p, layer == 0, r + 1), n1, lane); }
    for (; r < ROWS; r += p.G * 16) { f32x4 v0[4], v1[4];
#pragma unroll
        for (int i = 0; i < 4; ++i) { v0[i] = n0[i]; v1[i] = n1[i]; }
        const int rn = r + p.G * 16; if (rn < ROWS) { norm_ld(res_row(p, layer == 0, rn), n0, lane); norm_ld(res_row(p, layer == 0, rn + 1), n1, lane); }
        const int s = row_sel(r); if (s != mc.s) mc.load(g, mod + s * 6144 + 0, mod + s * 6144 + 1024, s, lane);
        norm_fin2(v0, mc, hb + (size_t)r * D, false, (LAS bf16_t*)0, (LAS bf16_t*)0, lane);
        norm_fin2(v1, mc, hb + (size_t)(r + 1) * D, false, (LAS bf16_t*)0, (LAS bf16_t*)0, lane); }
}
__device__ __forceinline__ float sum8_(float v) { v += DPPF(v, 0xB1); v += DPPF(v, 0x4E); v += DPPF(v, 0x141); return v; }
__device__ __forceinline__ float sum16_(float v) { v = sum8_(v); v += DPPF(v, 0x140); return v; }
__device__ __forceinline__ void bf8_to_f(const u32x4 w, float (&f)[8]) {
#pragma unroll
    for (int q = 0; q < 4; ++q) { f[2 * q] = __uint_as_float(w[q] << 16); f[2 * q + 1] = __uint_as_float(w[q] & 0xffff0000u); } }
__device__ __forceinline__ void phase_prep(const Cx& p, LAS unsigned char* lds, int layer, int b) {
    const int lane = p.tid & 63, wave = __builtin_amdgcn_readfirstlane(p.tid >> 6);
    const bf16_t* proj = WSP(bf16_t, WS_PROJ);
    const int e0 = p.bid * NTHR + p.tid, e1 = e0 + p.G * NTHR; bf16_t sq0 = 0, sq1 = 0;
#define SCAL_COL(q) ((q) < 8 ? PC_DF + (q) : (q) < 16 ? PD_BF + ((q) - 8) : PD_AF + ((q) - 16))
    if (e0 < SB * 24) sq0 = proj[(size_t)tok_row(b, e0 / 24) * NPROJ + SCAL_COL(e0 % 24)];
    if (e1 < SB * 24) sq1 = proj[(size_t)tok_row(b, e1 / 24) * NPROJ + SCAL_COL(e1 % 24)];
    if (p.bid < SB / 33) {
        constexpr int ATS = 208;
        LAS unsigned char* WWt = lds; LAS unsigned char* AWt = lds + 256 * 144; LAS unsigned char* At = lds + 2 * 256 * 144;
        { const bf16_t* w2c = WSP(bf16_t, WS_RWLR) + (size_t)layer * 256 * 64; const bf16_t* awc = WSP(bf16_t, WS_RWLR) + (size_t)NL * 256 * 64;
#pragma unroll
          for (int q = 0; q < 4; ++q) { const int e = p.tid + NTHR * q, n = e >> 3, ch = e & 7;
              *(LAS u32x4*)(WWt + n * 144 + ch * 16) = *(const u32x4*)(w2c + n * 64 + ch * 8); *(LAS u32x4*)(AWt + n * 144 + ch * 16) = *(const u32x4*)(awc + n * 64 + ch * 8); } }
        const int h = wave & 3, half = wave >> 2, fr = lane & 15, fq = lane >> 4;
        float a0c[4], w0fc[4], w0bc[4], kkc[4], kac[4];
#pragma unroll
        for (int nt = 0; nt < 4; ++nt) { const int c = 64 * h + 16 * nt + fr; a0c[nt] = PIN(I_RW_A0)[layer * 256 + c]; w0fc[nt] = PIN(I_RW_W0)[(layer * 2 + 0) * 256 + c]; w0bc[nt] = PIN(I_RW_W0)[(layer * 2 + 1) * 256 + c];
            kkc[nt] = PIN(I_RW_KK)[layer * 256 + c]; kac[nt] = PIN(I_RW_KA)[layer * 256 + c]; }
        for (int u = p.bid; u < SB / 33; u += p.G) {
            if (p.tid < 33 * 12) { const int tk = p.tid / 12, ch = p.tid % 12; u32x4 w = *(const u32x4*)(proj + (size_t)tok_row(b, u * 33 + tk) * NPROJ + PB_WF + 8 * ch);
                if (ch < 8) {
#pragma unroll
                    for (int q = 0; q < 4; ++q) w[q] = pk2(tanhf_(__uint_as_float(w[q] << 16)), tanhf_(__uint_as_float(w[q] & 0xffff0000u))); }
                *(LAS u32x4*)(At + tk * ATS + ch * 16) = w; }
            bf16_t kvA[4][4], kvB[4];
#pragma unroll
            for (int j = 0; j < 4; ++j) { const bf16_t* pr = proj + (size_t)tok_row(b, u * 33 + 16 * half + 4 * fq + j) * NPROJ + PB_K + 64 * h + fr;
#pragma unroll
                for (int nt = 0; nt < 4; ++nt) kvA[nt][j] = pr[16 * nt]; }
            { const bf16_t* pr = proj + (size_t)tok_row(b, u * 33 + 32) * NPROJ + PB_K + 64 * h + fr;
#pragma unroll
              for (int nt = 0; nt < 4; ++nt) kvB[nt] = pr[16 * nt]; }
            __syncthreads();
#pragma unroll
            for (int pass = 0; pass < 2; ++pass) { if (pass == 1 && half != 0) break;
                const int mt = pass ? 2 : half; f32x4 sa[4], sf[4], sb[4];
                const bf16x8 awf = *(const LAS bf16x8*)(At + (16 * mt + fr) * ATS + fq * 16), awb = *(const LAS bf16x8*)(At + (16 * mt + fr) * ATS + 64 + fq * 16), aa = *(const LAS bf16x8*)(At + (16 * mt + fr) * ATS + 128 + fq * 16);
#pragma unroll
                for (int nt = 0; nt < 4; ++nt) { const int n = 64 * h + 16 * nt + fr; const f32x4 z = (f32x4){0.f, 0.f, 0.f, 0.f};
                    sf[nt] = __builtin_amdgcn_mfma_f32_16x16x32_bf16(awf, *(const LAS bf16x8*)(WWt + n * 144 + fq * 16), z, 0, 0, 0);
                    sb[nt] = __builtin_amdgcn_mfma_f32_16x16x32_bf16(awb, *(const LAS bf16x8*)(WWt + n * 144 + 64 + fq * 16), z, 0, 0, 0);
                    sa[nt] = __builtin_amdgcn_mfma_f32_16x16x32_bf16(aa, *(const LAS bf16x8*)(AWt + n * 144 + layer * 64 + fq * 16), z, 0, 0, 0); }
#pragma unroll
                for (int j = 0; j < 4; ++j) { if (pass == 1 && j > 0) break;
                    const int tk = 16 * mt + 4 * fq + j; const bool valid = tk < 33; const int s = u * 33 + tk;
                    float kv[4], kr[4], ssq = 0.f;
#pragma unroll
                    for (int nt = 0; nt < 4; ++nt) { kv[nt] = bf2f(pass ? kvB[nt] : kvA[nt][j]); kr[nt] = kv[nt] * kkc[nt]; ssq += kr[nt] * kr[nt]; }
                    const float rs = rsq_(sum16_(ssq) + 1e-6f);
#pragma unroll
                    for (int nt = 0; nt < 4; ++nt) { const float a = sigmoidf_(sa[nt][j] + a0c[nt]);
                        const float lwf = -__expf(-softplusf_(-(sf[nt][j] + w0fc[nt])) - 0.5f), lwb = -__expf(-softplusf_(-(sb[nt][j] + w0bc[nt])) - 0.5f);
                        const float kk = kr[nt] * rs; const size_t o = (size_t)s * 256 + 64 * h + 16 * nt + fr;
                        if (valid) { WSP(float, SC_RK)[o] = kv[nt] * (1.0f + (a - 1.0f) * kac[nt]); WSP(float, SC_RKK)[o] = kk; WSP(float, SC_RB)[o] = kk * a;
                            WSP(float, SC_RLW)[o] = lwf; WSP(float, SC_RLW)[(size_t)SB * 256 + o] = lwb; } } } }
            __syncthreads();
        }
    }
    __syncthreads();
    { LAS bf16_t* T = (LAS bf16_t*)lds; const int tid = p.tid; const float* dncw = PIN(I_DN_CW); const float* sscw = PIN(I_SS_CW); const float* sscb = PIN(I_SS_CB);
#define PC_LOAD(uu, v, vh) do { const int mixer_ = (uu) / (NTB * 3), r2_ = (uu) % (NTB * 3), rb_ = r2_ / 3, colbase_ = (mixer_ ? PD_Q : PC_X) + 256 * (r2_ % 3); \
          _Pragma("unroll") for (int q = 0; q < 12; ++q) { const int e = tid + NTHR * q, rr = e >> 11, tok = (e >> 5) & 63, ch = (e & 31) * 8; v[q] = (u32x4){0u, 0u, 0u, 0u}; \
              if (rb_ < 4) { if (rr == 1) v[q] = *(const u32x4*)(proj + (size_t)(b * NCTX + 64 * rb_ + tok) * NPROJ + colbase_ + ch); } \
              else { const int gr = rb_ - 4 + rr - 1; if (gr >= 0 && gr < GRIDH) v[q] = *(const u32x4*)(proj + (size_t)(CROWS + b * SEQ + gr * 64 + tok) * NPROJ + colbase_ + ch); } } \
          vh = (u32x4){0u, 0u, 0u, 0u}; if (tid < 192) { const int rr = tid >> 6, side = (tid >> 5) & 1, ch = (tid & 31) * 8;       \
              if (rb_ < 4 && rr == 1) { const int tk = side ? 64 * (rb_ + 1) : 64 * rb_ - 1; if (tk >= 0 && tk < NCTX) vh = *(const u32x4*)(proj + (size_t)(b * NCTX + tk) * NPROJ + colbase_ + ch); } } } while (0)
      int u = p.bid;
      if (u < 2 * NTB * 3) { u32x4 v[12], vh; PC_LOAD(u, v, vh);
        for (;;) { const int mixer = u / (NTB * 3), r2 = u % (NTB * 3), rb = r2 / 3, third = r2 % 3;
#pragma unroll
          for (int q = 0; q < 12; ++q) { const int e = tid + NTHR * q, rr = e >> 11, tok = (e >> 5) & 63, ch = (e & 31) * 8; *(LAS u32x4*)(T + (rr * 66 + tok + 1) * 256 + ch) = v[q]; }
          if (tid < 192) { const int rr = tid >> 6, side = (tid >> 5) & 1, ch = (tid & 31) * 8; *(LAS u32x4*)(T + (rr * 66 + (side ? 65 : 0)) * 256 + ch) = vh; }
          __syncthreads();
          const int un = u + p.G; const bool more = un < 2 * NTB * 3;
          if (more) PC_LOAD(un, v, vh);
          { const int c = tid & 255, th = tid >> 8, chn = 256 * third + c; float w[9];
            const float* cw = (mixer ? dncw : sscw) + (size_t)layer * 9 * 768 + chn;
#pragma unroll
            for (int k = 0; k < 9; ++k) w[k] = cw[k * 768];
            const float bias = mixer ? 0.f : sscb[layer * 768 + chn];
            bf16_t* dst = (mixer ? WSP(bf16_t, SC_DQ) : WSP(bf16_t, SC_SX)) + (size_t)(64 * rb) * 768 + chn;
#pragma unroll 2
            for (int tk = 0; tk < 32; ++tk) { const int x = 32 * th + tk; float acc = bias;
#pragma unroll
                for (int dy = 0; dy < 3; ++dy)
#pragma unroll
                    for (int dx = 0; dx < 3; ++dx) acc += w[dy * 3 + dx] * bf2f(T[(dy * 66 + x + dx) * 256 + c]);
                float y = siluf_(acc);
                if (mixer && third < 2) { const float ss = wsum(y * y); y *= rsq_(ss + 1e-6f); if (third == 0) y *= 0.125f; }
                dst[(size_t)x * 768] = (bf16_t)f2bf(y); } }
          __syncthreads();
          if (!more) break;
          u = un; } }
#undef PC_LOAD
#define SCAL_FIN(e_, raw_) do { const int s = (e_) / 24, q = (e_) % 24; const float xv = bf2f(raw_); \
          if (q < 8) { const int d = q >> 2, h = q & 3; WSP(float, SC_SDT)[(size_t)s * 8 + q] = softplusf_(xv + PIN(I_SS_DTB)[(layer * 2 + d) * 4 + h]); } \
          else if (q < 16) { WSP(float, SC_DG)[(size_t)s * 16 + (q - 8)] = sigmoidf_(xv); } \
          else { const int q2 = q - 16, d = q2 >> 2, h = q2 & 3; WSP(float, SC_DG)[(size_t)s * 16 + 8 + q2] = -__expf(PIN(I_DN_ALOG)[(layer * 2 + d) * 4 + h]) * softplusf_(xv + PIN(I_DN_DTB)[(layer * 2 + d) * 4 + h]); } } while (0)
      if (e0 < SB * 24) SCAL_FIN(e0, sq0);
      if (e1 < SB * 24) SCAL_FIN(e1, sq1);
      for (int e = e1 + p.G * NTHR; e < SB * 24; e += p.G * NTHR) { const bf16_t raw = proj[(size_t)tok_row(b, e / 24) * NPROJ + SCAL_COL(e % 24)]; SCAL_FIN(e, raw); }
#undef SCAL_FIN
#undef SCAL_COL
    }
}
__device__ __forceinline__ void phase_scan(const Cx& p, LAS unsigned char* lds, int layer, int b);
__device__ __forceinline__ void phase_post(const Cx& p, LAS unsigned char* lds, int layer, int b) {
    const int tid = p.tid, tsub = tid >> 7, c8 = (tid & 127) * 8, mixer = c8 >> 8, cm = c8 & 255, hh = cm >> 6;
    const bf16_t* proj = WSP(bf16_t, WS_PROJ); const bf16_t* of = WSP(bf16_t, SC_OF); const bf16_t* obk = WSP(bf16_t, SC_OB); bf16_t* yc = WSP(bf16_t, WS_HBUF);
    constexpr int PTS = 144, GTS = 260;
    LAS unsigned char* GWb = lds; LAS unsigned char* SGb = lds + 256 * PTS; LAS float* GT = (LAS float*)(lds + 256 * PTS + 48 * PTS);
    if ((int)p.bid < SB / 33) { const bf16_t* gsrc = WSP(bf16_t, WS_RWGW) + (size_t)layer * 256 * 64;
#pragma unroll
        for (int q = 0; q < 4; ++q) { const int e = tid + NTHR * q, n = e >> 3, ch = e & 7; *(LAS u32x4*)(GWb + n * PTS + ch * 16) = *(const u32x4*)(gsrc + n * 64 + ch * 8); } }
    float g0[8], g1[8], g2[8];
#pragma unroll
    for (int q = 0; q < 8; ++q) { const int c = cm + q; g0[q] = 0.f; g1[q] = 0.f; g2[q] = 0.f;
        if (mixer == 0) g0[q] = PIN(I_GLA_NG)[layer * 256 + c];
        else if (mixer == 1) { g0[q] = PIN(I_RW_LNG)[layer * 256 + c]; g1[q] = PIN(I_RW_LNB)[layer * 256 + c]; g2[q] = PIN(I_RW_RK)[layer * 256 + c]; }
        else if (mixer == 2) { g0[q] = PIN(I_SS_NG)[layer * 256 + c]; g1[q] = PIN(I_SS_D)[layer * 4 + hh]; }
        else g0[q] = PIN(I_DN_NG)[layer * 256 + c]; }
    const int col1 = (mixer == 0 ? PA_G : mixer == 1 ? PB_R : mixer == 2 ? PC_Z : PD_Z) + cm;
    for (int u = p.bid; u < SB / 33; u += p.G) {
        if (tid < 33 * 8) { const int tk = tid >> 3, ch = tid & 7; float gl[8]; bf8_to_f(*(const u32x4*)(proj + (size_t)tok_row(b, u * 33 + tk) * NPROJ + PB_G + 8 * ch), gl);
            *(LAS u32x4*)(SGb + tk * PTS + ch * 16) = (u32x4){pk2(sigmoidf_(gl[0]), sigmoidf_(gl[1])), pk2(sigmoidf_(gl[2]), sigmoidf_(gl[3])), pk2(sigmoidf_(gl[4]), sigmoidf_(gl[5])), pk2(sigmoidf_(gl[6]), sigmoidf_(gl[7]))}; }
        u32x4 rof, rob, ra1, ra2 = (u32x4){0u, 0u, 0u, 0u}; f32x4 rk0 = (f32x4){0.f, 0.f, 0.f, 0.f}, rk1 = rk0;
#define POST_LOAD(t0_) do { const int tk_ = (t0_) + tsub; const int s_ = u * 33 + (tk_ < 33 ? tk_ : 32); const bf16_t* pr_ = proj + (size_t)tok_row(b, s_) * NPROJ; \
        rof = *(const u32x4*)(of + (size_t)s_ * 1024 + c8); rob = *(const u32x4*)(obk + (size_t)s_ * 1024 + c8); ra1 = *(const u32x4*)(pr_ + col1); \
        if (mixer == 1) { ra2 = *(const u32x4*)(pr_ + PB_V + cm); rk0 = *(const f32x4*)(WSP(float, SC_RK) + (size_t)s_ * 256 + cm); rk1 = *(const f32x4*)(WSP(float, SC_RK) + (size_t)s_ * 256 + cm + 4); } \
        else if (mixer == 2) ra2 = *(const u32x4*)(WSP(bf16_t, SC_SX) + (size_t)s_ * 768 + cm); } while (0)
        POST_LOAD(0);
        __syncthreads();
        { const int lane = tid & 63, wave = tid >> 6, fr = lane & 15, fq = lane >> 4; f32x4 acc[3][2];
#pragma unroll
          for (int mt = 0; mt < 3; ++mt) { acc[mt][0] = (f32x4){0.f, 0.f, 0.f, 0.f}; acc[mt][1] = (f32x4){0.f, 0.f, 0.f, 0.f}; }
#pragma unroll
          for (int ks = 0; ks < 2; ++ks) { bf16x8 bb[2];
#pragma unroll
              for (int nt = 0; nt < 2; ++nt) bb[nt] = *(const LAS bf16x8*)(GWb + (16 * (2 * wave + nt) + fr) * PTS + ks * 64 + fq * 16);
#pragma unroll
              for (int mt = 0; mt < 3; ++mt) { const bf16x8 a = *(const LAS bf16x8*)(SGb + (16 * mt + fr) * PTS + ks * 64 + fq * 16);
                  acc[mt][0] = __builtin_amdgcn_mfma_f32_16x16x32_bf16(a, bb[0], acc[mt][0], 0, 0, 0); acc[mt][1] = __builtin_amdgcn_mfma_f32_16x16x32_bf16(a, bb[1], acc[mt][1], 0, 0, 0); } }
#pragma unroll
          for (int mt = 0; mt < 3; ++mt)
#pragma unroll
              for (int nt = 0; nt < 2; ++nt)
#pragma unroll
                  for (int j = 0; j < 4; ++j) GT[(16 * mt + 4 * fq + j) * GTS + 16 * (2 * wave + nt) + fr] = acc[mt][nt][j]; }
        __syncthreads();
#pragma unroll 1
        for (int t0 = 0; t0 < 36; t0 += 4) { const int tk = t0 + tsub; const bool live = tk < 33; const int tkc = live ? tk : 32, s = u * 33 + tkc, row = tok_row(b, s);
            const u32x4 cof = rof, cob = rob, ca1 = ra1, ca2 = ra2; const f32x4 k0 = rk0, k1 = rk1;
            if (t0 + 4 < 36) POST_LOAD(t0 + 4);
            float o[8], a[8], y[8];
            { float t1[8], t2[8]; bf8_to_f(cof, t1); bf8_to_f(cob, t2);
#pragma unroll
              for (int q = 0; q < 8; ++q) o[q] = t1[q] + t2[q]; }
            bf8_to_f(ca1, a);
            if (mixer == 0 || mixer == 3) { float ss = 0.f;
#pragma unroll
                for (int q = 0; q < 8; ++q) ss += o[q] * o[q];
                const float rs = rsq_(sum8_(ss) * (1.0f / 64.0f) + 1e-6f);
#pragma unroll
                for (int q = 0; q < 8; ++q) y[q] = o[q] * rs * g0[q] * siluf_(a[q]);
            } else if (mixer == 2) { float xs[8]; bf8_to_f(ca2, xs); float ss = 0.f;
#pragma unroll
                for (int q = 0; q < 8; ++q) { y[q] = (o[q] + g1[q] * xs[q]) * siluf_(a[q]); ss += y[q] * y[q]; }
                const float rs = rsq_(sum16_(ss) * (1.0f / 128.0f) + 1e-6f);
#pragma unroll
                for (int q = 0; q < 8; ++q) y[q] *= rs * g0[q];
            } else { float vv[8]; bf8_to_f(ca2, vv);
                float su = 0.f, bo = 0.f;
#pragma unroll
                for (int q = 0; q < 8; ++q) { su += o[q]; bo += a[q] * (q < 4 ? k0[q & 3] : k1[q & 3]) * g2[q]; }
                const float mu = sum8_(su) * (1.0f / 64.0f); bo = sum8_(bo); float va = 0.f;
#pragma unroll
                for (int q = 0; q < 8; ++q) { o[q] -= mu; va += o[q] * o[q]; }
                const float rs = rsq_(sum8_(va) * (1.0f / 64.0f) + 64e-5f);
                const f32x4 gt0 = *(const LAS f32x4*)(GT + tkc * GTS + cm), gt1 = *(const LAS f32x4*)(GT + tkc * GTS + cm + 4);
#pragma unroll
                for (int q = 0; q < 8; ++q) y[q] = (o[q] * rs * g0[q] + g1[q] + bo * vv[q]) * (q < 4 ? gt0[q & 3] : gt1[q & 3]); }
            if (live) *(u32x4*)(yc + (size_t)row * D + c8) = (u32x4){pk2(y[0], y[1]), pk2(y[2], y[3]), pk2(y[4], y[5]), pk2(y[6], y[7])};
        }
#undef POST_LOAD
    }
}
constexpr int N2_TILE = 32, N2_STRIDE = 2064;
__device__ __forceinline__ void phase_norm2(const Cx& p, LAS unsigned char* lds, int layer, int row_lo) {
    const int tid = p.tid, lane = tid & 63, wave = __builtin_amdgcn_readfirstlane(tid >> 6), fr = lane & 15, fq = lane >> 4;
    const float* mod = WSP(float, WS_MOD) + (size_t)layer * 5 * 6144; const float* g = PIN(I_N2G) + layer * D; bf16_t* hb = WSP(bf16_t, WS_HBUF);
    const bf16_t* rt = WSP(bf16_t, WS_ROUT) + (size_t)layer * 2 * NE * D;
    LAS float* lg = (LAS float*)(lds + 2 * N2_TILE * N2_STRIDE);
    unsigned* cnt = WSP(unsigned, WS_CTL) + CW_CNT + layer * 80 * 16; int* ltok = WSP(int, WS_LTOK); int* tokt = WSP(int, WS_TOKT);
    const float rbias = PIN(I_ROUT_B)[layer * NE + lane];
    const int nun = (ROWS - row_lo) / N2_TILE;
    ModC mc; mc.s = -1; f32x4 n0[4], n1[4];
    if ((int)p.bid < nun) { const int r = row_lo + p.bid * N2_TILE + 4 * wave; norm_ld(res_row(p, 0, r), n0, lane); norm_ld(res_row(p, 0, r + 1), n1, lane); }
    for (int u = p.bid; u < nun; u += p.G) { const int r0 = row_lo + u * N2_TILE;
        { const int tr = 4 * wave, r = r0 + tr; f32x4 v2[4], v3[4];
          norm_ld(res_row(p, 0, r + 2), v2, lane); norm_ld(res_row(p, 0, r + 3), v3, lane);
          const int s = row_sel(r); if (s != mc.s) mc.load(g, mod + s * 6144 + 3072, mod + s * 6144 + 4096, s, lane);
          norm_fin2(n0, mc, hb + (size_t)r * D, true, (LAS bf16_t*)(lds + tr * N2_STRIDE), (LAS bf16_t*)(lds + N2_TILE * N2_STRIDE + tr * N2_STRIDE), lane);
          norm_fin2(n1, mc, hb + (size_t)(r + 1) * D, true, (LAS bf16_t*)(lds + (tr + 1) * N2_STRIDE), (LAS bf16_t*)(lds + N2_TILE * N2_STRIDE + (tr + 1) * N2_STRIDE), lane);
          norm_fin2(v2, mc, hb + (size_t)(r + 2) * D, true, (LAS bf16_t*)(lds + (tr + 2) * N2_STRIDE), (LAS bf16_t*)(lds + N2_TILE * N2_STRIDE + (tr + 2) * N2_STRIDE), lane);
          norm_fin2(v3, mc, hb + (size_t)(r + 3) * D, true, (LAS bf16_t*)(lds + (tr + 3) * N2_STRIDE), (LAS bf16_t*)(lds + N2_TILE * N2_STRIDE + (tr + 3) * N2_STRIDE), lane);
          const int un = u + p.G; if (un < nun) { const int rn = row_lo + un * N2_TILE + tr; norm_ld(res_row(p, 0, rn), n0, lane); norm_ld(res_row(p, 0, rn + 1), n1, lane); } }
        __syncthreads();
        { const int mt = wave >> 2, nt = wave & 3; f32x4 acc = (f32x4){0.f, 0.f, 0.f, 0.f};
          const LAS unsigned char* ap = lds + (16 * mt + fr) * N2_STRIDE + fq * 16; const bf16_t* bp = rt + (size_t)(16 * nt + fr) * D + fq * 8;
#pragma unroll 8
          for (int ks = 0; ks < 32; ++ks) { const bf16x8 a = *(const LAS bf16x8*)(ap + ks * 64), al = *(const LAS bf16x8*)(ap + N2_TILE * N2_STRIDE + ks * 64);
              const bf16x8 bb = *(const bf16x8*)(bp + ks * 32), bl = *(const bf16x8*)(bp + NE * D + ks * 32);
              acc = __builtin_amdgcn_mfma_f32_16x16x32_bf16(a, bb, acc, 0, 0, 0); acc = __builtin_amdgcn_mfma_f32_16x16x32_bf16(al, bb, acc, 0, 0, 0); acc = __builtin_amdgcn_mfma_f32_16x16x32_bf16(a, bl, acc, 0, 0, 0); }
#pragma unroll
          for (int j = 0; j < 4; ++j) lg[(16 * mt + 4 * fq + j) * 64 + 16 * nt + fr] = acc[j]; }
        __syncthreads();
#pragma unroll 1
        for (int i = 0; i < 4; ++i) { const int tr = 4 * wave + i, r = r0 + tr;
            const float sc = sigmoidf_(lg[tr * 64 + lane]); float sel = sc + rbias; float ssum = 0.f; int myE = 0; float myS = 0.f;
#pragma unroll 1
            for (int k = 0; k < TOPK; ++k) { float bv = sel; int bi = lane;
#define ARGSTEP(OV, OI) do { const float ov_ = (OV); const int oi_ = (OI); if (ov_ > bv || (ov_ == bv && oi_ < bi)) { bv = ov_; bi = oi_; } } while (0)
                ARGSTEP(DPPF(bv, 0xB1), DPPI(bi, 0xB1)); ARGSTEP(DPPF(bv, 0x4E), DPPI(bi, 0x4E)); ARGSTEP(DPPF(bv, 0x141), DPPI(bi, 0x141)); ARGSTEP(DPPF(bv, 0x140), DPPI(bi, 0x140));
                ARGSTEP(__uint_as_float(__builtin_amdgcn_ds_swizzle(__float_as_uint(bv), 0x401F)), __builtin_amdgcn_ds_swizzle(bi, 0x401F));
                { const float v0 = rl(bv, 0), v1 = rl(bv, 32); const int i0 = __builtin_amdgcn_readlane(bi, 0), i1 = __builtin_amdgcn_readlane(bi, 32); if (v1 > v0 || (v1 == v0 && i1 < i0)) { bv = v1; bi = i1; } else { bv = v0; bi = i0; } }
#undef ARGSTEP
                const int e = __builtin_amdgcn_readfirstlane(bi); const float se = rl(sc, e);
                ssum += se; if (lane == k) { myE = e; myS = se; } if (lane == e) sel = -1e30f; }
            if (lane < TOPK) { const unsigned pos = atomicAdd(cnt + myE * 16, 1u); ltok[(size_t)myE * ROWS + pos] = r; tokt[(size_t)r * 16 + lane] = (myE << 16) | (int)pos; ((float*)tokt)[(size_t)r * 16 + 8 + lane] = myS / ssum * 2.5f; } }
        __syncthreads();
    }
}
__device__ __forceinline__ void moe_table(const Cx& p, LAS int* tb, int layer, int row_lo) {
    const unsigned* cnt = WSP(unsigned, WS_CTL) + CW_CNT + layer * 80 * 16;
    if (p.tid < 64) { const int lane = p.tid;
        const int c = (int)__hip_atomic_load(cnt + lane * 16, __ATOMIC_RELAXED, __HIP_MEMORY_SCOPE_AGENT); const int t = (c + 255) >> 8; int incl = t;
#pragma unroll
        for (int o = 1; o < 64; o <<= 1) { const int v = __builtin_amdgcn_ds_bpermute((lane - o) << 2, incl); if (lane >= o) incl += v; }
        tb[lane] = c; tb[128 + lane] = incl - t;
        if (lane == 63) { const int cs = ROWS - row_lo; tb[NE] = cs; tb[128 + NE] = incl; tb[128 + NE1] = incl + ((cs + 255) >> 8); } }
    __syncthreads();
}
__device__ __forceinline__ void phase_combine(const Cx& p, const LAS int* tb, int layer, int row_lo, int half) {
    const int lane = p.tid & 63, wave = p.tid >> 6; const bf16_t* Y = WSP(bf16_t, WS_Y); const int* tokt = WSP(int, WS_TOKT);
    const float* gate = WSP(float, WS_MOD) + (size_t)layer * 5 * 6144 + 5120; const int col = 512 * half + 8 * lane; const int shbase = tb[128 + NE] * 256;
#pragma unroll 2
    for (int r = row_lo + p.bid * 8 + wave; r < ROWS; r += p.G * 8) {
        const int sw = lane < 16 ? tokt[(size_t)r * 16 + lane] : 0;
        float a[8];
        { const u32x4 y = *(const u32x4*)(Y + (size_t)(shbase + (r - row_lo)) * 512 + 8 * lane);
#pragma unroll
          for (int q = 0; q < 4; ++q) { a[2 * q] = __uint_as_float(y[q] << 16); a[2 * q + 1] = __uint_as_float(y[q] & 0xffff0000u); } }
#pragma unroll
        for (int k = 0; k < 8; ++k) { const int sl = __builtin_amdgcn_readlane(sw, k); const float w = __uint_as_float(__builtin_amdgcn_readlane(sw, 8 + k));
            const int hrow = tb[128 + (sl >> 16)] * 256 + (sl & 0xffff); const u32x4 y = *(const u32x4*)(Y + (size_t)hrow * 512 + 8 * lane);
#pragma unroll
            for (int q = 0; q < 4; ++q) { a[2 * q] += w * __uint_as_float(y[q] << 16); a[2 * q + 1] += w * __uint_as_float(y[q] & 0xffff0000u); } }
        float* x = (float*)res_row(p, 0, r) + col; const float* gp = gate + row_sel(r) * 6144 + col;
#pragma unroll
        for (int q = 0; q < 2; ++q) { const f32x4 gv = *(const f32x4*)(gp + 4 * q); f32x4 xv = *(const f32x4*)(x + 4 * q);
            xv[0] += gv[0] * a[4 * q]; xv[1] += gv[1] * a[4 * q + 1]; xv[2] += gv[2] * a[4 * q + 2]; xv[3] += gv[3] * a[4 * q + 3]; *(f32x4*)(x + 4 * q) = xv; }
    }
}
__device__ __forceinline__ void phase_final(const Cx& p) {
    const int lane = p.tid & 63, wave = p.tid >> 6; const float* g = PIN(I_FNG); f32x4 gv[4], n[2][4];
#pragma unroll
    for (int i = 0; i < 4; ++i) gv[i] = *(const f32x4*)(g + 256 * i + 4 * lane);
    int r = p.bid * 16 + wave * 2;
    if (r < NB * SEQ) { norm_ld(POUT + (size_t)r * D, n[0], lane); norm_ld(POUT + (size_t)(r + 1) * D, n[1], lane); }
    for (; r < NB * SEQ; r += p.G * 16) { f32x4 v[2][4];
#pragma unroll
        for (int q = 0; q < 2; ++q)
#pragma unroll
            for (int i = 0; i < 4; ++i) v[q][i] = n[q][i];
        const int rn = r + p.G * 16; if (rn < NB * SEQ) { norm_ld(POUT + (size_t)rn * D, n[0], lane); norm_ld(POUT + (size_t)(rn + 1) * D, n[1], lane); }
#pragma unroll
        for (int q = 0; q < 2; ++q) { float* x = POUT + (size_t)(r + q) * D; float ss = 0.f;
#pragma unroll
            for (int i = 0; i < 4; ++i) ss += v[q][i][0] * v[q][i][0] + v[q][i][1] * v[q][i][1] + v[q][i][2] * v[q][i][2] + v[q][i][3] * v[q][i][3];
            ss = wsum(ss); const float rstd = rsq_(ss * (1.0f / D) + 1e-6f);
#pragma unroll
            for (int i = 0; i < 4; ++i) *(f32x4*)(x + 256 * i + 4 * lane) = v[q][i] * rstd * gv[i]; } }
}
__device__ __forceinline__ int chain_tb(int n, int d) { return d == 0 ? n : (n < 4 ? 3 - n : 135 - n); }
__device__ __forceinline__ int cslot(int u) { return (u & 7) * NTB + (u >> 3); }
__device__ __forceinline__ int tb_row0(int b, int tb) { return tb < 4 ? b * NCTX + 64 * tb : CROWS + b * SEQ + 64 * (tb - 4); }
constexpr int TS = 144;
template <int K, int NT> __device__ __forceinline__ void mm_rows(const LAS unsigned char* A, int lda, const LAS unsigned char* Bt, int ldb, int mt, int nt0, int fr, int fq, f32x4 (&acc)[NT]) {
#pragma unroll
    for (int ks = 0; ks < K / 32; ++ks) { const bf16x8 a = *(const LAS bf16x8*)(A + (16 * mt + fr) * lda + ks * 64 + fq * 16);
#pragma unroll
        for (int nt = 0; nt < NT; ++nt) { const bf16x8 bb = *(const LAS bf16x8*)(Bt + (16 * (nt0 + nt) + fr) * ldb + ks * 64 + fq * 16);
            acc[nt] = __builtin_amdgcn_mfma_f32_16x16x32_bf16(a, bb, acc[nt], 0, 0, 0); } }
}
#define UNIT_LOOP(u, N, OFF) for (int u = (p.bid + p.G - ((OFF) % p.G)) % p.G; u < (N); u += p.G)
__device__ __forceinline__ void gla_p1(const Cx& p, LAS unsigned char* lds, int layer, int b) {
    const int tid = p.tid, lane = tid & 63, wave = __builtin_amdgcn_readfirstlane(tid >> 6), fr = lane & 15, fq = lane >> 4;
    LAS unsigned char* ksT = lds; LAS unsigned char* vT = lds + 64 * TS; LAS float* gs = (LAS float*)(lds + 2 * 64 * TS); LAS float* glb = gs + 512;
    const bf16_t* proj = WSP(bf16_t, WS_PROJ); const int mt = wave >> 1, nt0 = (wave & 1) * 2; const int cl = lane, tg = wave;
    const float* w2p = PIN(I_GLA_W2); const float* gbp = PIN(I_GLA_B);
    float w2[16], gb; unsigned gw; bf16_t kq[8], vq[8];
#define GLA1_LOAD(uu) do { const int tb_ = (uu) >> 3, h_ = ((uu) >> 1) & 3, d_ = (uu) & 1, c_ = 64 * h_ + cl; const bf16_t* pr_ = proj + (size_t)tb_row0(b, tb_) * NPROJ; \
        _Pragma("unroll") for (int r = 0; r < 16; ++r) w2[r] = w2p[((size_t)(layer * 2 + d_) * 16 + r) * 256 + c_]; \
        gb = gbp[(layer * 2 + d_) * 256 + c_]; \
        { const int e = tid * 2, i = e >> 4, r = e & 15; gw = *(const unsigned*)(pr_ + (size_t)i * NPROJ + (d_ ? PA_GB : PA_GF) + r); } \
        _Pragma("unroll") for (int i8 = 0; i8 < 8; ++i8) { const bf16_t* pa = pr_ + (size_t)(8 * tg + i8) * NPROJ; kq[i8] = pa[PA_K + c_]; vq[i8] = pa[PA_V + c_]; } } while (0)
    int u = (p.bid + p.G) % p.G;
    if (u < NUNIT) GLA1_LOAD(u);
    for (; u < NUNIT; u += p.G) { const int d = u & 1;
        glb[tid * 2] = __uint_as_float(gw << 16); glb[tid * 2 + 1] = __uint_as_float(gw & 0xffff0000u);
        __syncthreads();
        float bl[8]; float run = 0.f;
#pragma unroll
        for (int ii = 0; ii < 8; ++ii) { const int i8 = d ? 7 - ii : ii; const LAS float* gl_ = glb + (8 * tg + i8) * 16; float z = gb;
#pragma unroll
            for (int r = 0; r < 16; ++r) z += gl_[r] * w2[r];
            run += logsigmoidf_(z) * (1.0f / 16.0f); if (d) bl[7 - ii] = run; else bl[ii] = run; }
        gs[tg * 64 + cl] = run;
        __syncthreads();
        float off = 0.f, total = 0.f;
#pragma unroll
        for (int g2 = 0; g2 < 8; ++g2) { const float t = gs[g2 * 64 + cl]; total += t; if (d ? g2 > tg : g2 < tg) off += t; }
#pragma unroll
        for (int i8 = 0; i8 < 8; i8 += 2) { const int i = 8 * tg + i8;
            const float ka = bf2f(kq[i8]) * __expf(total - (bl[i8] + off)), kb = bf2f(kq[i8 + 1]) * __expf(total - (bl[i8 + 1] + off));
            *(LAS unsigned*)(ksT + cl * TS + i * 2) = pk2(ka, kb); *(LAS unsigned*)(vT + cl * TS + i * 2) = (unsigned)vq[i8] | ((unsigned)vq[i8 + 1] << 16); }
        if (u + p.G < NUNIT) GLA1_LOAD(u + p.G);
        if (tg == 0) WSP(float, SC_GLA_DEC)[(size_t)cslot(u) * 64 + cl] = __expf(total);
        __syncthreads();
        { f32x4 acc[2] = {(f32x4){0.f, 0.f, 0.f, 0.f}, (f32x4){0.f, 0.f, 0.f, 0.f}}; float* kv = WSP(float, SC_GLA_S) + (size_t)cslot(u) * 4096;
          mm_rows<64, 2>(vT, TS, ksT, TS, mt, nt0, fr, fq, acc);
#pragma unroll
          for (int t = 0; t < 2; ++t) *(f32x4*)(kv + (16 * (nt0 + t) + fr) * 64 + 16 * mt + 4 * fq) = acc[t]; }
        __syncthreads();
    }
#undef GLA1_LOAD
}
__device__ __forceinline__ void gla_chain(const Cx& p, int h, int d, int part) {
    if (p.tid >= 256) return;
    const int e0 = part * 1024 + p.tid * 4, dk = e0 >> 6;
    f32x4 s0 = (f32x4){0.f, 0.f, 0.f, 0.f};
    f32x4 n0[6]; float dc[6];
#define GC_LD(q, n_) do { const int u_ = cslot((chain_tb((n_), d) * 4 + h) * 2 + d); n0[q] = *(const f32x4*)(WSP(float, SC_GLA_S) + (size_t)u_ * 4096 + e0); dc[q] = WSP(float, SC_GLA_DEC)[(size_t)u_ * 64 + dk]; } while (0)
#define GC_ST(q, n_) do { const int u_ = cslot((chain_tb((n_), d) * 4 + h) * 2 + d); float* k_ = WSP(float, SC_GLA_S) + (size_t)u_ * 4096 + e0; \
        const f32x4 a0_ = n0[q]; const float de_ = dc[q]; GC_LD(q, (n_) + 6 < NTB ? (n_) + 6 : NTB - 1); *(f32x4*)k_ = s0; s0 = s0 * de_ + a0_; } while (0)
    GC_LD(0, 0); GC_LD(1, 1); GC_LD(2, 2); GC_LD(3, 3); GC_LD(4, 4); GC_LD(5, 5);
#pragma unroll 1
    for (int n = 0; n < NTB; n += 6) { GC_ST(0, n); GC_ST(1, n + 1); GC_ST(2, n + 2); GC_ST(3, n + 3); GC_ST(4, n + 4); GC_ST(5, n + 5); }
#undef GC_LD
#undef GC_ST
}
__device__ __forceinline__ void gla_p2(const Cx& p, LAS unsigned char* lds, int layer, int b) {
    const int tid = p.tid, lane = tid & 63, wave = __builtin_amdgcn_readfirstlane(tid >> 6), fr = lane & 15, fq = lane >> 4;
    LAS unsigned char* qt = lds; LAS unsigned char* kt = lds + 64 * TS; LAS unsigned char* vT = lds + 2 * 64 * TS; LAS unsigned char* sT = lds + 3 * 64 * TS; LAS unsigned char* att = lds + 4 * 64 * TS;
    LAS float* gs = (LAS float*)(lds + 5 * 64 * TS); LAS float* glb = gs + 512;
    const bf16_t* proj = WSP(bf16_t, WS_PROJ); const int cl = lane, tg = wave;
    const float* w2p = PIN(I_GLA_W2); const float* gbp = PIN(I_GLA_B);
    float w2[16], gb; unsigned gw; bf16_t qq[8], kq[8], vq[8]; float sq[8];
#define GLA2_LOAD(uu) do { const int tb_ = (uu) >> 3, h_ = ((uu) >> 1) & 3, d_ = (uu) & 1, c_ = 64 * h_ + cl; const bf16_t* pr_ = proj + (size_t)tb_row0(b, tb_) * NPROJ; \
        _Pragma("unroll") for (int r = 0; r < 16; ++r) w2[r] = w2p[((size_t)(layer * 2 + d_) * 16 + r) * 256 + c_]; \
        gb = gbp[(layer * 2 + d_) * 256 + c_]; \
        { const int e = tid * 2, i = e >> 4, r = e & 15; gw = *(const unsigned*)(pr_ + (size_t)i * NPROJ + (d_ ? PA_GB : PA_GF) + r); } \
        _Pragma("unroll") for (int i8 = 0; i8 < 8; ++i8) { const bf16_t* pa = pr_ + (size_t)(8 * tg + i8) * NPROJ; qq[i8] = pa[PA_Q + c_]; kq[i8] = pa[PA_K + c_]; vq[i8] = pa[PA_V + c_]; } \
        { const float* sp_ = WSP(float, SC_GLA_S) + (size_t)cslot(uu) * 4096; _Pragma("unroll") for (int q = 0; q < 8; ++q) sq[q] = sp_[tid + NTHR * q]; } } while (0)
    int u = (p.bid + p.G - (128 % p.G)) % p.G;
    if (u < NUNIT) GLA2_LOAD(u);
    for (; u < NUNIT; u += p.G) { const int tb = u >> 3, h = (u >> 1) & 3, d = u & 1; const int s0 = 64 * tb;
        glb[tid * 2] = __uint_as_float(gw << 16); glb[tid * 2 + 1] = __uint_as_float(gw & 0xffff0000u);
#pragma unroll
        for (int q = 0; q < 8; ++q) { const int e = tid + NTHR * q, dk = e >> 6, dv = e & 63; *(LAS bf16_t*)(sT + dv * TS + dk * 2) = (bf16_t)f2bf(sq[q]); }
        __syncthreads();
        float bl[8]; float run = 0.f;
#pragma unroll
        for (int ii = 0; ii < 8; ++ii) { const int i8 = d ? 7 - ii : ii; const LAS float* gl_ = glb + (8 * tg + i8) * 16; float z = gb;
#pragma unroll
            for (int r = 0; r < 16; ++r) z += gl_[r] * w2[r];
            run += logsigmoidf_(z) * (1.0f / 16.0f); if (d) bl[7 - ii] = run; else bl[ii] = run; }
        gs[tg * 64 + cl] = run;
        __syncthreads();
        float off = 0.f;
#pragma unroll
        for (int g2 = 0; g2 < 8; ++g2) if (d ? g2 > tg : g2 < tg) off += gs[g2 * 64 + cl];
#pragma unroll
        for (int i8 = 0; i8 < 8; ++i8) { const int i = 8 * tg + i8; const float bi = bl[i8] + off;
            *(LAS bf16_t*)(qt + i * TS + cl * 2) = (bf16_t)f2bf(bf2f(qq[i8]) * 0.125f * __expf(bi));
            *(LAS bf16_t*)(kt + i * TS + cl * 2) = (bf16_t)f2bf(bf2f(kq[i8]) * __expf(-bi));
            *(LAS bf16_t*)(vT + cl * TS + i * 2) = vq[i8]; }
        if (u + p.G < NUNIT) GLA2_LOAD(u + p.G);
        __syncthreads();
        const int mt = wave >> 1, nt0 = (wave & 1) * 2;
        { f32x4 acc[2] = {(f32x4){0.f, 0.f, 0.f, 0.f}, (f32x4){0.f, 0.f, 0.f, 0.f}};
          mm_rows<64, 2>(qt, TS, kt, TS, mt, nt0, fr, fq, acc);
#pragma unroll
          for (int t = 0; t < 2; ++t)
#pragma unroll
              for (int j = 0; j < 4; ++j) { const int i = 16 * mt + 4 * fq + j, jj = 16 * (nt0 + t) + fr; const bool keep = d ? jj >= i : jj <= i;
                  *(LAS bf16_t*)(att + i * TS + jj * 2) = (bf16_t)f2bf(keep ? acc[t][j] : 0.f); } }
        __syncthreads();
        { f32x4 acc[2] = {(f32x4){0.f, 0.f, 0.f, 0.f}, (f32x4){0.f, 0.f, 0.f, 0.f}};
          mm_rows<64, 2>(att, TS, vT, TS, mt, nt0, fr, fq, acc);
          mm_rows<64, 2>(qt, TS, sT, TS, mt, nt0, fr, fq, acc);
          bf16_t* ob = WSP(bf16_t, d ? SC_OB : SC_OF);
#pragma unroll
          for (int t = 0; t < 2; ++t)
#pragma unroll
              for (int j = 0; j < 4; ++j) ob[(size_t)(s0 + 16 * mt + 4 * fq + j) * 1024 + 64 * h + 16 * (nt0 + t) + fr] = (bf16_t)f2bf(acc[t][j]); }
        __syncthreads();
    }
}
#undef GLA2_LOAD
constexpr int TS2 = 272;
__device__ __forceinline__ float ssd_acum(float a, int d, int lane, float& total) {
    float pre = a;
#pragma unroll
    for (int o = 1; o < 64; o <<= 1) { const float t = shup_(pre, lane, o); if (lane >= o) pre += t; }
    total = rl(pre, 63);
    return d ? total - pre + a : pre;
}
__device__ __forceinline__ void ssd_p1(const Cx& p, LAS unsigned char* lds, int layer, int b) {
    const int tid = p.tid, lane = tid & 63, wave = __builtin_amdgcn_readfirstlane(tid >> 6), fr = lane & 15, fq = lane >> 4;
    LAS unsigned char* BT = lds; LAS unsigned char* xT = lds + 128 * TS; LAS float* AC = (LAS float*)(lds + 128 * TS + 64 * TS);
    const float* alogp = PIN(I_SS_ALOG);
    u32x4 bq[2], xq; float dtq;
#define SSD1_LOAD(uu) do { const int tb_ = (uu) >> 3, g_ = ((uu) >> 2) & 1, hd_ = (uu) & 3, h_ = 2 * g_ + (hd_ >> 1), d_ = hd_ & 1; \
        const bf16_t* sx_ = WSP(bf16_t, SC_SX) + (size_t)(64 * tb_ + lane) * 768; \
        bq[0] = *(const u32x4*)(sx_ + 256 + 128 * g_ + 16 * wave); bq[1] = *(const u32x4*)(sx_ + 256 + 128 * g_ + 16 * wave + 8); \
        xq = *(const u32x4*)(sx_ + 64 * h_ + 8 * wave); dtq = WSP(float, SC_SDT)[(size_t)(64 * tb_ + lane) * 8 + d_ * 4 + h_]; } while (0)
    int u3 = (p.bid + p.G - (32 % p.G)) % p.G;
    if (u3 < NTB * 8) SSD1_LOAD(u3);
    for (; u3 < NTB * 8; u3 += p.G) { const int tb = u3 >> 3, g = (u3 >> 2) & 1, hd = u3 & 3, h = 2 * g + (hd >> 1), d = hd & 1;
        if (wave == 0) { const float aneg = -__expf(alogp[(layer * 2 + d) * 4 + h]);
            float tot; const float ac = ssd_acum(aneg * dtq, d, lane, tot); AC[lane] = ac; if (lane == 0) { AC[64] = tot; WSP(float, SC_SSD_CD)[cslot((tb * 4 + h) * 2 + d)] = __expf(tot); } }
#pragma unroll
        for (int q = 0; q < 2; ++q)
#pragma unroll
            for (int k = 0; k < 8; ++k) *(LAS bf16_t*)(BT + (16 * wave + 8 * q + k) * TS + lane * 2) = (bf16_t)(bq[q][k >> 1] >> (16 * (k & 1)));
        __syncthreads();
        { const float f = dtq * __expf(AC[64] - AC[lane]);
#pragma unroll
          for (int k = 0; k < 8; ++k) *(LAS bf16_t*)(xT + (8 * wave + k) * TS + lane * 2) = (bf16_t)f2bf(bf2f((bf16_t)(xq[k >> 1] >> (16 * (k & 1)))) * f); }
        if (u3 + p.G < NTB * 8) SSD1_LOAD(u3 + p.G);
        __syncthreads();
        { float* cs = WSP(float, SC_SSD_S) + (size_t)cslot((tb * 4 + h) * 2 + d) * 8192; f32x4 acc[4];
#pragma unroll
          for (int t = 0; t < 4; ++t) acc[t] = (f32x4){0.f, 0.f, 0.f, 0.f};
          mm_rows<64, 4>(BT, TS, xT, TS, wave, 0, fr, fq, acc);
#pragma unroll
          for (int t = 0; t < 4; ++t) *(f32x4*)(cs + (16 * t + fr) * 128 + 16 * wave + 4 * fq) = acc[t]; }
        __syncthreads();
    }
#undef SSD1_LOAD
}
__device__ __forceinline__ void ssd_chain(const Cx& p, int h, int d, int part) {
    if (p.tid >= 256) return;
    const int e0 = part * 1024 + p.tid * 4;
    f32x4 s = (f32x4){0.f, 0.f, 0.f, 0.f}; f32x4 nx[6]; float cd[6];
#define SC_LD(q, n_) do { const int u_ = cslot((chain_tb((n_), d) * 4 + h) * 2 + d); nx[q] = *(const f32x4*)(WSP(float, SC_SSD_S) + (size_t)u_ * 8192 + e0); cd[q] = WSP(float, SC_SSD_CD)[u_]; } while (0)
#define SC_ST(q, n_) do { const int u_ = cslot((chain_tb((n_), d) * 4 + h) * 2 + d); float* c_ = WSP(float, SC_SSD_S) + (size_t)u_ * 8192 + e0; const f32x4 a_ = nx[q]; const float de_ = cd[q]; \
        SC_LD(q, (n_) + 6 < NTB ? (n_) + 6 : NTB - 1); *(f32x4*)c_ = s; s = s * de_ + a_; } while (0)
    SC_LD(0, 0); SC_LD(1, 1); SC_LD(2, 2); SC_LD(3, 3); SC_LD(4, 4); SC_LD(5, 5);
#pragma unroll 1
    for (int n = 0; n < NTB; n += 6) { SC_ST(0, n); SC_ST(1, n + 1); SC_ST(2, n + 2); SC_ST(3, n + 3); SC_ST(4, n + 4); SC_ST(5, n + 5); }
#undef SC_LD
#undef SC_ST
}
__device__ __forceinline__ void ssd_p2(const Cx& p, LAS unsigned char* lds, int layer, int b) {
    const int tid = p.tid, lane = tid & 63, wave = __builtin_amdgcn_readfirstlane(tid >> 6), fr = lane & 15, fq = lane >> 4;
    LAS unsigned char* Ct = lds; LAS unsigned char* Bt2 = lds + 64 * TS2; LAS float* cb = (LAS float*)(lds + 2 * 64 * TS2); LAS float* AC = cb + 64 * 65;
    LAS unsigned char* Mt = (LAS unsigned char*)(AC + 64 + 4); LAS unsigned char* xT = Mt + 64 * TS; LAS unsigned char* Sb = xT + 64 * TS;
    const int mt = wave >> 1, nt0 = (wave & 1) * 2;
    const float* alogp = PIN(I_SS_ALOG);
    u32x4 cq[2], bq[2], xq; float dtq; f32x4 sq[4];
#define SSD2_LOAD(uu) do { const int tb_ = (uu) >> 3, g_ = ((uu) >> 2) & 1, hd_ = (uu) & 3, h_ = 2 * g_ + (hd_ >> 1), d_ = hd_ & 1; \
        const bf16_t* sx_ = WSP(bf16_t, SC_SX) + (size_t)(64 * tb_) * 768; \
        _Pragma("unroll") for (int q = 0; q < 2; ++q) { const int e = tid + NTHR * q, i = e >> 4, ch = e & 15; \
            cq[q] = *(const u32x4*)(sx_ + (size_t)i * 768 + 512 + 128 * g_ + ch * 8); bq[q] = *(const u32x4*)(sx_ + (size_t)i * 768 + 256 + 128 * g_ + ch * 8); } \
        xq = *(const u32x4*)(sx_ + (size_t)lane * 768 + 64 * h_ + 8 * wave); dtq = WSP(float, SC_SDT)[(size_t)(64 * tb_ + lane) * 8 + d_ * 4 + h_]; \
        const float* sp_ = WSP(float, SC_SSD_S) + (size_t)cslot((tb_ * 4 + h_) * 2 + d_) * 8192; \
        _Pragma("unroll") for (int q = 0; q < 4; ++q) sq[q] = *(const f32x4*)(sp_ + (tid + NTHR * q) * 4); } while (0)
    int u3 = (p.bid + p.G - (160 % p.G)) % p.G;
    if (u3 < NTB * 8) SSD2_LOAD(u3);
    for (; u3 < NTB * 8; u3 += p.G) { const int tb = u3 >> 3, g = (u3 >> 2) & 1, hd = u3 & 3, h = 2 * g + (hd >> 1), d = hd & 1, s0 = 64 * tb; (void)g;
        if (wave == 0) { const float aneg = -__expf(alogp[(layer * 2 + d) * 4 + h]); float tot; AC[lane] = ssd_acum(aneg * dtq, d, lane, tot); }
#pragma unroll
        for (int q = 0; q < 2; ++q) { const int e = tid + NTHR * q, i = e >> 4, ch = e & 15;
            *(LAS u32x4*)(Ct + i * TS2 + ch * 16) = cq[q]; *(LAS u32x4*)(Bt2 + i * TS2 + ch * 16) = bq[q]; }
#pragma unroll
        for (int k = 0; k < 8; ++k) *(LAS bf16_t*)(xT + (8 * wave + k) * TS + lane * 2) = (bf16_t)f2bf(bf2f((bf16_t)(xq[k >> 1] >> (16 * (k & 1)))) * dtq);
#pragma unroll
        for (int q = 0; q < 4; ++q) { const int e = (tid + NTHR * q) * 4, pp = e >> 7, s = e & 127; const f32x4 v = sq[q];
            *(LAS u32x2*)(Sb + pp * TS2 + s * 2) = (u32x2){pk2(v[0], v[1]), pk2(v[2], v[3])}; }
        if (u3 + p.G < NTB * 8) SSD2_LOAD(u3 + p.G);
        __syncthreads();
        { f32x4 acc[2] = {(f32x4){0.f, 0.f, 0.f, 0.f}, (f32x4){0.f, 0.f, 0.f, 0.f}};
          mm_rows<128, 2>(Ct, TS2, Bt2, TS2, mt, nt0, fr, fq, acc);
#pragma unroll
          for (int t = 0; t < 2; ++t)
#pragma unroll
              for (int j = 0; j < 4; ++j) cb[(16 * mt + 4 * fq + j) * 65 + 16 * (nt0 + t) + fr] = acc[t][j]; }
        __syncthreads();
        { const int i = tid >> 3, j0 = (tid & 7) * 8; const float ai = AC[i]; unsigned w[4];
#pragma unroll
          for (int jj = 0; jj < 8; jj += 2) { float m[2];
#pragma unroll
              for (int q = 0; q < 2; ++q) { const int j = j0 + jj + q; const bool keep = d ? j >= i : j <= i; const float cv = cb[i * 65 + j], aj = AC[j]; m[q] = keep ? cv * __expf(ai - aj) : 0.f; }
              w[jj >> 1] = pk2(m[0], m[1]); }
          *(LAS u32x4*)(Mt + i * TS + j0 * 2) = (u32x4){w[0], w[1], w[2], w[3]}; }
        __syncthreads();
        { f32x4 acc[2] = {(f32x4){0.f, 0.f, 0.f, 0.f}, (f32x4){0.f, 0.f, 0.f, 0.f}};
          mm_rows<128, 2>(Ct, TS2, Sb, TS2, mt, nt0, fr, fq, acc);
#pragma unroll
          for (int j = 0; j < 4; ++j) { const float sc = __expf(AC[16 * mt + 4 * fq + j]); acc[0][j] *= sc; acc[1][j] *= sc; }
          mm_rows<64, 2>(Mt, TS, xT, TS, mt, nt0, fr, fq, acc);
          bf16_t* ob = WSP(bf16_t, d ? SC_OB : SC_OF);
#pragma unroll
          for (int t = 0; t < 2; ++t)
#pragma unroll
              for (int j = 0; j < 4; ++j) ob[(size_t)(s0 + 16 * mt + 4 * fq + j) * 1024 + 512 + 64 * h + 16 * (nt0 + t) + fr] = (bf16_t)f2bf(acc[t][j]); }
        __syncthreads();
    }
}
#undef SSD2_LOAD
constexpr int AFS = 68;
__device__ __forceinline__ int dr_mfrag_idx(int row, int col) { return (((row >> 4) * 2 + (col >> 5)) * 64 + ((col >> 2) & 3) * 16 + (row & 15)) * 8 + ((col >> 4) & 1) * 4 + (col & 3); }
template <class RhsF> __device__ __forceinline__ void dr_block_solve(const LAS unsigned char* Abf, const LAS float* AfT, LAS unsigned char* XT, LAS float* Dbuf, const float sgn, const int wave, const RhsF& rhs, bf16_t* wu) {
    LAS unsigned char* TI = (LAS unsigned char*)Dbuf;
    if (wave == 0) { const int lane = lane_id_asm(), kb_ = lane >> 4, cc = lane & 15; float x[16];
#pragma unroll
        for (int i = 0; i < 16; ++i) x[i] = i == cc ? 1.f : 0.f;
        const LAS float* Ab = AfT + (16 * kb_) * AFS + 16 * kb_;
        f32x4 tri[36];
        { int q = 0;
#pragma unroll
          for (int j = 0; j < 15; ++j)
#pragma unroll
              for (int c4 = (j + 1) / 4; c4 < 4; ++c4) tri[q++] = *(const LAS f32x4*)(Ab + j * AFS + 4 * c4); }
        asm volatile("s_waitcnt lgkmcnt(0)" ::: "memory");
        { int q = 0;
#pragma unroll
          for (int j = 0; j < 15; ++j) { const float xj = sgn * x[j];
#pragma unroll
              for (int c4 = (j + 1) / 4; c4 < 4; ++c4) { const f32x4 t = tri[q++];
#pragma unroll
                  for (int e = 0; e < 4; ++e) if (4 * c4 + e > j) x[4 * c4 + e] -= t[e] * xj; } } }
        { u32x4 w0, w1;
#pragma unroll
          for (int i = 0; i < 16; ++i) *(LAS bf16_t*)(TI + ((kb_ * 16 + i) * 16 + cc) * 2) = (bf16_t)f2bf(x[i]); (void)w0; (void)w1; } }
    __syncthreads();
    { const int lane = lane_id_asm(), fr = lane & 15, fq = lane >> 4, col = 16 * wave + fr; u32x4 bx[2] = {(u32x4){0u, 0u, 0u, 0u}, (u32x4){0u, 0u, 0u, 0u}};
      float rv[4][4]; u32x2 af[6][2], tf[4];
#pragma unroll
      for (int k = 0; k < 4; ++k) {
#pragma unroll
          for (int j = 0; j < 4; ++j) rv[k][j] = rhs(16 * k + 4 * fq + j, col);
          tf[k] = *(const LAS u32x2*)(TI + ((k * 16 + fr) * 16 + 4 * fq) * 2); }
#pragma unroll
      for (int k = 1; k < 4; ++k)
#pragma unroll
          for (int ks = 0; ks < 2; ++ks) if (k > 2 * ks) { const int s = (k - 1) + (ks ? 2 : 0) + (k == 3 && ks == 0 ? 0 : 0);
              af[s][0] = *(const LAS u32x2*)(Abf + (16 * k + fr) * TS + (32 * ks + 4 * fq) * 2); af[s][1] = *(const LAS u32x2*)(Abf + (16 * k + fr) * TS + (32 * ks + 16 + 4 * fq) * 2); }
#pragma unroll
      for (int k = 0; k < 4; ++k) { f32x4 acc = (f32x4){0.f, 0.f, 0.f, 0.f};
#pragma unroll
          for (int ks = 0; ks < 2; ++ks) if (k > 2 * ks) { const int s = (k - 1) + (ks ? 2 : 0);
              acc = __builtin_amdgcn_mfma_f32_16x16x32_bf16(__builtin_bit_cast(bf16x8, (u32x4){af[s][0][0], af[s][0][1], af[s][1][0], af[s][1][1]}), __builtin_bit_cast(bf16x8, bx[ks]), acc, 0, 0, 0); }
          float dd[4];
#pragma unroll
          for (int j = 0; j < 4; ++j) dd[j] = rv[k][j] - sgn * acc[j];
          const f32x4 xk = __builtin_amdgcn_mfma_f32_16x16x32_bf16(__builtin_bit_cast(bf16x8, (u32x4){tf[k][0], tf[k][1], 0u, 0u}), __builtin_bit_cast(bf16x8, (u32x4){pk2(dd[0], dd[1]), pk2(dd[2], dd[3]), 0u, 0u}), (f32x4){0.f, 0.f, 0.f, 0.f}, 0, 0, 0);
          const unsigned p0 = pk2(xk[0], xk[1]), p1 = pk2(xk[2], xk[3]);
          bx[k >> 1][(k & 1) * 2] = p0; bx[k >> 1][(k & 1) * 2 + 1] = p1;
          *(LAS u32x2*)(XT + col * TS + (16 * k + 4 * fq) * 2) = (u32x2){p0, p1};
#pragma unroll
          for (int j = 0; j < 4; ++j) wu[(16 * k + 4 * fq + j) * 128 + col] = (bf16_t)f2bf(xk[j]); } }
    __syncthreads();
}
struct GdnRhs { const LAS unsigned char* kb; const LAS unsigned char* vb; const LAS float* GC;
    __device__ __forceinline__ float operator()(int r, int col) const { return col < 64 ? bf2f(*(const LAS bf16_t*)(kb + r * TS + col * 2)) * __expf(GC[r]) : bf2f(*(const LAS bf16_t*)(vb + r * TS + (col - 64) * 2)); } };
__device__ __forceinline__ void gdn_p1(const Cx& p, LAS unsigned char* lds, int layer, int b) {
    const int wave = __builtin_amdgcn_readfirstlane(p.tid >> 6);
#define GDN_LANES const int lane = lane_id_asm(), tid = wave * 64 + lane, fr = lane & 15, fq = lane >> 4; (void)tid; (void)fr; (void)fq
    LAS unsigned char* kh = lds; LAS unsigned char* kb = lds + 64 * TS; LAS unsigned char* vb = lds + 2 * 64 * TS; LAS unsigned char* Abf = lds + 3 * 64 * TS; LAS unsigned char* kdT = lds + 4 * 64 * TS; LAS unsigned char* XT = lds + 5 * 64 * TS;
    LAS float* Af = (LAS float*)(lds + 7 * 64 * TS); LAS float* Dbuf = Af + 64 * AFS; LAS float* GC = Dbuf + 128 * 20;
    const int mt = wave >> 1, nt0 = (wave & 1) * 2;
    float gq, beta; u32x4 kv, vv;
#define GDN1_LOAD(uu) do { const int tb_ = (uu) >> 3, h_ = ((uu) >> 1) & 3, d_ = (uu) & 1; const int lane_ = lane_id_asm(), tid_ = wave * 64 + lane_; \
        const bf16_t* dq_ = WSP(bf16_t, SC_DQ) + (size_t)(64 * tb_) * 768; const float* dg_ = WSP(float, SC_DG) + (size_t)(64 * tb_) * 16; \
        gq = dg_[(d_ ? 63 - lane_ : lane_) * 16 + 8 + d_ * 4 + h_]; \
        { const int r_ = tid_ >> 3, c0_ = (tid_ & 7) * 8, i_ = d_ ? 63 - r_ : r_; beta = dg_[i_ * 16 + d_ * 4 + h_]; \
          kv = *(const u32x4*)(dq_ + (size_t)i_ * 768 + 256 + 64 * h_ + c0_); vv = *(const u32x4*)(dq_ + (size_t)i_ * 768 + 512 + 64 * h_ + c0_); } } while (0)
    int u = (p.bid + p.G - (64 % p.G)) % p.G;
    if (u < NUNIT) GDN1_LOAD(u);
    for (; u < NUNIT; u += p.G) {
        if (wave == 0) { GDN_LANES; float pre = gq;
#pragma unroll
            for (int o = 1; o < 64; o <<= 1) { const float t = shup_(pre, lane, o); if (lane >= o) pre += t; }
            GC[lane] = pre; }
        { GDN_LANES; const int r = tid >> 3, c0 = (tid & 7) * 8; u32x4 kw, vw;
#pragma unroll
          for (int q = 0; q < 4; ++q) { kw[q] = pk2(__uint_as_float(kv[q] << 16) * beta, __uint_as_float(kv[q] & 0xffff0000u) * beta); vw[q] = pk2(__uint_as_float(vv[q] << 16) * beta, __uint_as_float(vv[q] & 0xffff0000u) * beta); }
          *(LAS u32x4*)(kh + r * TS + c0 * 2) = kv; *(LAS u32x4*)(kb + r * TS + c0 * 2) = kw; *(LAS u32x4*)(vb + r * TS + c0 * 2) = vw;
          *(LAS u32x4*)(XT + (2 * r) * TS + c0 * 2) = (u32x4){0u, 0u, 0u, 0u}; *(LAS u32x4*)(XT + (2 * r + 1) * TS + c0 * 2) = (u32x4){0u, 0u, 0u, 0u}; }
        if (u + p.G < NUNIT) GDN1_LOAD(u + p.G);
        __syncthreads();
        const float gtot = GC[63];
        { GDN_LANES; f32x4 acc[2] = {(f32x4){0.f, 0.f, 0.f, 0.f}, (f32x4){0.f, 0.f, 0.f, 0.f}};
          mm_rows<64, 2>(kb, TS, kh, TS, mt, nt0, fr, fq, acc);
          float gr[4], gj[2];
#pragma unroll
          for (int j = 0; j < 4; ++j) gr[j] = GC[16 * mt + 4 * fq + j];
#pragma unroll
          for (int t = 0; t < 2; ++t) gj[t] = GC[16 * (nt0 + t) + fr];
#pragma unroll
          for (int t = 0; t < 2; ++t)
#pragma unroll
              for (int j = 0; j < 4; ++j) { const int r = 16 * mt + 4 * fq + j, jj = 16 * (nt0 + t) + fr; const float a = jj < r ? acc[t][j] * __expf(gr[j] - gj[t]) : 0.f;
                  Af[jj * AFS + r] = a; *(LAS bf16_t*)(Abf + r * TS + jj * 2) = (bf16_t)f2bf(a); }
          { bf16_t kraw[8]; float gcr[8];
#pragma unroll
            for (int q = 0; q < 8; ++q) { const int e = tid + NTHR * q, r = e >> 6, cc = e & 63; kraw[q] = *(const LAS bf16_t*)(kh + r * TS + cc * 2); gcr[q] = GC[r]; }
#pragma unroll
            for (int q = 0; q < 8; ++q) { const int e = tid + NTHR * q, r = e >> 6, cc = e & 63; *(LAS bf16_t*)(kdT + cc * TS + r * 2) = (bf16_t)f2bf(bf2f(kraw[q]) * __expf(gtot - gcr[q])); } } }
        __syncthreads();
        { const GdnRhs rhs{kb, vb, GC}; dr_block_solve(Abf, Af, XT, Dbuf, 1.0f, wave, rhs, WSP(bf16_t, SC_DR_WU) + (size_t)u * 8192); }
        { GDN_LANES; f32x4 am[2] = {(f32x4){0.f, 0.f, 0.f, 0.f}, (f32x4){0.f, 0.f, 0.f, 0.f}}, an[2] = {(f32x4){0.f, 0.f, 0.f, 0.f}, (f32x4){0.f, 0.f, 0.f, 0.f}};
          mm_rows<64, 2>(kdT, TS, XT, TS, mt, nt0, fr, fq, am);
          mm_rows<64, 2>(kdT, TS, XT + 64 * TS, TS, mt, nt0, fr, fq, an);
          bf16_t* Mg = WSP(bf16_t, SC_DR_M) + (size_t)cslot(u) * 4096; bf16_t* Ng = WSP(bf16_t, SC_DR_NS) + (size_t)cslot(u) * 4096; const float eg = __expf(gtot);
#pragma unroll
          for (int t = 0; t < 2; ++t) {
#pragma unroll
              for (int j = 0; j < 4; ++j) { const int row = 16 * mt + 4 * fq + j, col = 16 * (nt0 + t) + fr; Mg[dr_mfrag_idx(row, col)] = (bf16_t)f2bf((row == col ? eg : 0.f) - am[t][j]); }
              *(u32x2*)(Ng + (((nt0 + t) * 4 + mt) * 64 + lane) * 4) = (u32x2){pk2(an[t][0], an[t][1]), pk2(an[t][2], an[t][3])}; } }
        __syncthreads();
    }
#undef GDN_LANES
#undef GDN1_LOAD
}
__device__ __forceinline__ void dr_chain(const Cx& p, size_t offM, size_t offNS, int h, int d, int cb) {
    const int lane = p.tid & 63, fr = lane & 15, fq = lane >> 4;
    if (p.tid >= 64) return;
    f32x4 acc[4];
#pragma unroll
    for (int t = 0; t < 4; ++t) acc[t] = (f32x4){0.f, 0.f, 0.f, 0.f};
    bf16x8 mR[3][4][2]; u32x2 nR[3][4];
#define DR_LD(m, nn, n_) do { const int u_ = cslot((chain_tb((n_), d) * 4 + h) * 2 + d); const bf16_t* M_ = WSP(bf16_t, offM) + (size_t)u_ * 4096; const bf16_t* N_ = WSP(bf16_t, offNS) + (size_t)u_ * 4096; \
        _Pragma("unroll") for (int t = 0; t < 4; ++t) { _Pragma("unroll") for (int ks = 0; ks < 2; ++ks) m[t][ks] = *(const bf16x8*)(M_ + ((t * 2 + ks) * 64 + lane) * 8); nn[t] = *(const u32x2*)(N_ + ((cb * 4 + t) * 64 + lane) * 4); } } while (0)
#define DR_STEP(m, nn, n_) do { const int u_ = cslot((chain_tb((n_), d) * 4 + h) * 2 + d); bf16_t* ST_ = WSP(bf16_t, offNS) + (size_t)u_ * 4096 + (16 * cb + fr) * 64 + 4 * fq; \
        u32x2 sp_[4]; _Pragma("unroll") for (int t = 0; t < 4; ++t) { sp_[t] = (u32x2){pk2(acc[t][0], acc[t][1]), pk2(acc[t][2], acc[t][3])}; *(u32x2*)(ST_ + 16 * t) = sp_[t]; } \
        bf16x8 bf_[2]; _Pragma("unroll") for (int ks = 0; ks < 2; ++ks) { u32x4 w_ = (u32x4){sp_[2 * ks][0], sp_[2 * ks][1], sp_[2 * ks + 1][0], sp_[2 * ks + 1][1]}; bf_[ks] = __builtin_bit_cast(bf16x8, w_); } \
        _Pragma("unroll") for (int t = 0; t < 4; ++t) { f32x4 a_ = (f32x4){__uint_as_float(nn[t][0] << 16), __uint_as_float(nn[t][0] & 0xffff0000u), __uint_as_float(nn[t][1] << 16), __uint_as_float(nn[t][1] & 0xffff0000u)}; \
            a_ = __builtin_amdgcn_mfma_f32_16x16x32_bf16(m[t][0], bf_[0], a_, 0, 0, 0); acc[t] = __builtin_amdgcn_mfma_f32_16x16x32_bf16(m[t][1], bf_[1], a_, 0, 0, 0); } } while (0)
#define DR_GO(q, n_) do { DR_STEP(mR[q], nR[q], (n_)); DR_LD(mR[q], nR[q], (n_) + 3 < NTB ? (n_) + 3 : NTB - 1); } while (0)
    DR_LD(mR[0], nR[0], 0); DR_LD(mR[1], nR[1], 1); DR_LD(mR[2], nR[2], 2);
#pragma unroll 1
    for (int n = 0; n < NTB; n += 3) { DR_GO(0, n); DR_GO(1, n + 1); DR_GO(2, n + 2); }
#undef DR_GO
#undef DR_LD
#undef DR_STEP
}
__device__ __forceinline__ void gdn_p2(const Cx& p, LAS unsigned char* lds, int layer, int b) {
    const int tid = p.tid, lane = tid & 63, wave = __builtin_amdgcn_readfirstlane(tid >> 6), fr = lane & 15, fq = lane >> 4;
    LAS unsigned char* qh = lds; LAS unsigned char* kh = lds + 64 * TS; LAS unsigned char* wt = lds + 2 * 64 * TS; LAS unsigned char* sT = lds + 3 * 64 * TS; LAS unsigned char* aq = lds + 4 * 64 * TS; LAS unsigned char* vnT = lds + 5 * 64 * TS;
    LAS float* GC = (LAS float*)(lds + 6 * 64 * TS);
    const int mt = wave >> 1, nt0 = (wave & 1) * 2;
    float gq; bf16_t upre[2][4]; u32x4 qv, kv, wv, sv;
#define GDN2_LOAD(uu) do { const int tb_ = (uu) >> 3, h_ = ((uu) >> 1) & 3, d_ = (uu) & 1; \
        const bf16_t* dq_ = WSP(bf16_t, SC_DQ) + (size_t)(64 * tb_) * 768; const float* dg_ = WSP(float, SC_DG) + (size_t)(64 * tb_) * 16; \
        const bf16_t* wu_ = WSP(bf16_t, SC_DR_WU) + (size_t)(uu) * 8192; const bf16_t* st_ = WSP(bf16_t, SC_DR_NS) + (size_t)cslot(uu) * 4096; \
        gq = dg_[(d_ ? 63 - lane : lane) * 16 + 8 + d_ * 4 + h_]; \
        _Pragma("unroll") for (int t = 0; t < 2; ++t) { _Pragma("unroll") for (int j = 0; j < 4; ++j) upre[t][j] = wu_[(16 * mt + 4 * fq + j) * 128 + 64 + 16 * (nt0 + t) + fr]; } \
        { const int r_ = tid >> 3, c0_ = (tid & 7) * 8, i_ = d_ ? 63 - r_ : r_; \
          qv = *(const u32x4*)(dq_ + (size_t)i_ * 768 + 64 * h_ + c0_); kv = *(const u32x4*)(dq_ + (size_t)i_ * 768 + 256 + 64 * h_ + c0_); \
          wv = *(const u32x4*)(wu_ + r_ * 128 + c0_); sv = *(const u32x4*)(st_ + r_ * 64 + c0_); } } while (0)
    int u = (p.bid + p.G - (192 % p.G)) % p.G;
    if (u < NUNIT) GDN2_LOAD(u);
    for (; u < NUNIT; u += p.G) { const int tb = u >> 3, h = (u >> 1) & 3, d = u & 1, s0 = 64 * tb;
        if (wave == 0) { float pre = gq;
#pragma unroll
            for (int o = 1; o < 64; o <<= 1) { const float t = shup_(pre, lane, o); if (lane >= o) pre += t; }
            GC[lane] = pre; }
        bf16_t ucur[2][4];
#pragma unroll
        for (int t = 0; t < 2; ++t)
#pragma unroll
            for (int j = 0; j < 4; ++j) ucur[t][j] = upre[t][j];
        { const int r = tid >> 3, c0 = (tid & 7) * 8;
          *(LAS u32x4*)(qh + r * TS + c0 * 2) = qv; *(LAS u32x4*)(kh + r * TS + c0 * 2) = kv; *(LAS u32x4*)(wt + r * TS + c0 * 2) = wv; *(LAS u32x4*)(sT + r * TS + c0 * 2) = sv; }
        if (u + p.G < NUNIT) GDN2_LOAD(u + p.G);
        __syncthreads();
        { f32x4 acc[2] = {(f32x4){0.f, 0.f, 0.f, 0.f}, (f32x4){0.f, 0.f, 0.f, 0.f}};
          mm_rows<64, 2>(qh, TS, kh, TS, mt, nt0, fr, fq, acc);
          float gr[4], gj[2];
#pragma unroll
          for (int j = 0; j < 4; ++j) gr[j] = GC[16 * mt + 4 * fq + j];
#pragma unroll
          for (int t = 0; t < 2; ++t) gj[t] = GC[16 * (nt0 + t) + fr];
#pragma unroll
          for (int t = 0; t < 2; ++t)
#pragma unroll
              for (int j = 0; j < 4; ++j) { const int r = 16 * mt + 4 * fq + j, jj = 16 * (nt0 + t) + fr; *(LAS bf16_t*)(aq + r * TS + jj * 2) = (bf16_t)f2bf(jj <= r ? acc[t][j] * __expf(gr[j] - gj[t]) : 0.f); }
          f32x4 av[2] = {(f32x4){0.f, 0.f, 0.f, 0.f}, (f32x4){0.f, 0.f, 0.f, 0.f}};
          mm_rows<64, 2>(wt, TS, sT, TS, mt, nt0, fr, fq, av);
#pragma unroll
          for (int t = 0; t < 2; ++t) { const int dv = 16 * (nt0 + t) + fr; float vn[4];
#pragma unroll
              for (int j = 0; j < 4; ++j) vn[j] = bf2f(ucur[t][j]) - av[t][j];
              *(LAS u32x2*)(vnT + dv * TS + (16 * mt + 4 * fq) * 2) = (u32x2){pk2(vn[0], vn[1]), pk2(vn[2], vn[3])}; } }
        __syncthreads();
        { f32x4 acc[2] = {(f32x4){0.f, 0.f, 0.f, 0.f}, (f32x4){0.f, 0.f, 0.f, 0.f}};
          mm_rows<64, 2>(qh, TS, sT, TS, mt, nt0, fr, fq, acc);
#pragma unroll
          for (int j = 0; j < 4; ++j) { const float sc = __expf(GC[16 * mt + 4 * fq + j]); acc[0][j] *= sc; acc[1][j] *= sc; }
          mm_rows<64, 2>(aq, TS, vnT, TS, mt, nt0, fr, fq, acc);
          bf16_t* ob = WSP(bf16_t, d ? SC_OB : SC_OF);
#pragma unroll
          for (int t = 0; t < 2; ++t)
#pragma unroll
              for (int j = 0; j < 4; ++j) { const int r = 16 * mt + 4 * fq + j, i = d ? 63 - r : r; ob[(size_t)(s0 + i) * 1024 + 768 + 64 * h + 16 * (nt0 + t) + fr] = (bf16_t)f2bf(acc[t][j]); } }
        __syncthreads();
    }
}
#undef GDN2_LOAD
constexpr int LPS = 65;
#define RW_LP(LP, GS, lw8) do { const int lane_ = lane_id_asm(), c_ = lane_, tg_ = wave; float loc_[8]; float run_ = 0.f; \
        _Pragma("unroll") for (int ii = 0; ii < 8; ++ii) { run_ += (lw8)[ii]; loc_[ii] = run_; } \
        (GS)[tg_ * 64 + c_] = run_; __syncthreads(); float off_ = 0.f; \
        _Pragma("unroll") for (int g2 = 0; g2 < 8; ++g2) if (g2 < tg_) off_ += (GS)[g2 * 64 + c_]; \
        _Pragma("unroll") for (int ii = 0; ii < 8; ++ii) (LP)[(8 * tg_ + ii) * LPS + c_] = loc_[ii] + off_; __syncthreads(); } while (0)
struct RwRhs { const LAS unsigned char* zt; const LAS unsigned char* RU;
    __device__ __forceinline__ float operator()(int r, int col) const { return col < 64 ? bf2f(*(const LAS bf16_t*)(zt + r * TS + col * 2)) : bf2f(*(const LAS bf16_t*)(RU + (col - 64) * TS + r * 2)); } };
__device__ __forceinline__ void rw_p1(const Cx& p, LAS unsigned char* lds, int layer, int b) {
    const int wave = __builtin_amdgcn_readfirstlane(p.tid >> 6), mt = wave >> 1, nt0 = (wave & 1) * 2;
#define RW_LANES const int lane = lane_id_asm(), tid = wave * 64 + lane, fr = lane & 15, fq = lane >> 4; (void)tid; (void)fr; (void)fq
    LAS float* LP = (LAS float*)lds; LAS float* GS = (LAS float*)(lds + 16640);
    LAS unsigned char* zt = lds + 18688; LAS unsigned char* bt = lds + 27904; LAS unsigned char* kt = lds + 37120; LAS unsigned char* vT = lds + 46336; LAS unsigned char* Azk = lds + 55552;
    LAS float* Af = (LAS float*)(lds + 64768); LAS unsigned char* XT = lds + 82176; LAS unsigned char* Abf = lds + 100608; LAS unsigned char* RU = lds + 109824; LAS float* Dbuf = (LAS float*)(lds + 119040); LAS unsigned char* bhT = lds + 129280;
    const bf16_t* proj = WSP(bf16_t, WS_PROJ);
    float lw8[8]; f32x4 lwv[2], kkv[2], bv[2], kv[2]; bf16_t v8[8];
#define RW1_LOAD(uu) do { const int tb_ = (uu) >> 3, h_ = ((uu) >> 1) & 3, d_ = (uu) & 1, s0_ = 64 * tb_; const int lane_ = lane_id_asm(), tid_ = wave * 64 + lane_; \
        const float* lwp_ = WSP(float, SC_RLW) + (size_t)d_ * SB * 256 + (size_t)s0_ * 256 + 64 * h_; const size_t fo_ = (size_t)s0_ * 256 + 64 * h_; \
        _Pragma("unroll") for (int ii = 0; ii < 8; ++ii) { const int r_ = 8 * wave + ii; lw8[ii] = lwp_[(size_t)(d_ ? 63 - r_ : r_) * 256 + lane_]; } \
        { const int r_ = tid_ >> 3, c0_ = (tid_ & 7) * 8, i_ = d_ ? 63 - r_ : r_; \
          _Pragma("unroll") for (int q = 0; q < 2; ++q) { lwv[q] = *(const f32x4*)(lwp_ + (size_t)i_ * 256 + c0_ + 4 * q); kkv[q] = *(const f32x4*)(WSP(float, SC_RKK) + fo_ + (size_t)i_ * 256 + c0_ + 4 * q); \
              bv[q] = *(const f32x4*)(WSP(float, SC_RB) + fo_ + (size_t)i_ * 256 + c0_ + 4 * q); kv[q] = *(const f32x4*)(WSP(float, SC_RK) + fo_ + (size_t)i_ * 256 + c0_ + 4 * q); } } \
        { const bf16_t* pr0_ = proj + (size_t)tb_row0(b, tb_) * NPROJ; \
          _Pragma("unroll") for (int q = 0; q < 8; ++q) { const int e = tid_ + NTHR * q, r2 = e >> 6, cc = e & 63; v8[q] = pr0_[(size_t)(d_ ? 63 - r2 : r2) * NPROJ + PB_V + 64 * h_ + cc]; } } } while (0)
    int u = (p.bid + p.G - (96 % p.G)) % p.G; if (u >= NUNIT) return;
    RW1_LOAD(u);
    for (;;) { const int d = u & 1;
        RW_LP(LP, GS, lw8);
        { RW_LANES; const int r = tid >> 3, c0 = (tid & 7) * 8; unsigned wz[4], wb[4], wk[4];
#pragma unroll
          for (int q = 0; q < 8; q += 2) { float z2[2], b2[2], k2[2];
#pragma unroll
              for (int e = 0; e < 2; ++e) { const int cq = q + e, c = c0 + cq; const float lp = LP[r * LPS + c], lw = lwv[cq >> 2][cq & 3], em = __expf(-lp);
                  z2[e] = -kkv[cq >> 2][cq & 3] * __expf(lp - lw); b2[e] = bv[cq >> 2][cq & 3] * em; k2[e] = kv[cq >> 2][cq & 3] * em; }
              wz[q >> 1] = pk2(z2[0], z2[1]); wb[q >> 1] = pk2(b2[0], b2[1]); wk[q >> 1] = pk2(k2[0], k2[1]); }
          *(LAS u32x4*)(zt + r * TS + c0 * 2) = (u32x4){wz[0], wz[1], wz[2], wz[3]}; *(LAS u32x4*)(bt + r * TS + c0 * 2) = (u32x4){wb[0], wb[1], wb[2], wb[3]}; *(LAS u32x4*)(kt + r * TS + c0 * 2) = (u32x4){wk[0], wk[1], wk[2], wk[3]};
          *(LAS u32x4*)(XT + (2 * r) * TS + c0 * 2) = (u32x4){0u, 0u, 0u, 0u}; *(LAS u32x4*)(XT + (2 * r + 1) * TS + c0 * 2) = (u32x4){0u, 0u, 0u, 0u};
#pragma unroll
          for (int q = 0; q < 8; ++q) { const int e = tid + NTHR * q, r2 = e >> 6, cc = e & 63; *(LAS bf16_t*)(vT + cc * TS + r2 * 2) = v8[q]; } }
        __syncthreads();
        const int un = u + p.G; const bool more = un < NUNIT;
        if (more) RW1_LOAD(un);
        { RW_LANES; f32x4 a1[2] = {(f32x4){0.f, 0.f, 0.f, 0.f}, (f32x4){0.f, 0.f, 0.f, 0.f}}, a2[2] = {(f32x4){0.f, 0.f, 0.f, 0.f}, (f32x4){0.f, 0.f, 0.f, 0.f}};
          mm_rows<64, 2>(zt, TS, bt, TS, mt, nt0, fr, fq, a1);
          mm_rows<64, 2>(zt, TS, kt, TS, mt, nt0, fr, fq, a2);
#pragma unroll
          for (int t = 0; t < 2; ++t)
#pragma unroll
              for (int j = 0; j < 4; ++j) { const int r = 16 * mt + 4 * fq + j, jj = 16 * (nt0 + t) + fr; const float a = jj < r ? a1[t][j] : 0.f;
                  Af[jj * AFS + r] = a; *(LAS bf16_t*)(Abf + r * TS + jj * 2) = (bf16_t)f2bf(a); *(LAS bf16_t*)(Azk + r * TS + jj * 2) = (bf16_t)f2bf(jj < r ? a2[t][j] : 0.f); } }
        __syncthreads();
        { RW_LANES; f32x4 a[2] = {(f32x4){0.f, 0.f, 0.f, 0.f}, (f32x4){0.f, 0.f, 0.f, 0.f}};
          mm_rows<64, 2>(Azk, TS, vT, TS, mt, nt0, fr, fq, a);
#pragma unroll
          for (int t = 0; t < 2; ++t) *(LAS u32x2*)(RU + (16 * (nt0 + t) + fr) * TS + (16 * mt + 4 * fq) * 2) = (u32x2){pk2(a[t][0], a[t][1]), pk2(a[t][2], a[t][3])};
        }
        __syncthreads();
        { RW_LANES;
          const float el = __expf(LP[63 * LPS + (tid & 63)]); bf16_t braw[8], kraw[8];
#pragma unroll
          for (int q = 0; q < 8; ++q) { const int e = tid + NTHR * q, r2 = e >> 6, cc = e & 63; braw[q] = *(const LAS bf16_t*)(bt + r2 * TS + cc * 2); kraw[q] = *(const LAS bf16_t*)(kt + r2 * TS + cc * 2); }
#pragma unroll
          for (int q = 0; q < 8; ++q) { const int e = tid + NTHR * q, r2 = e >> 6, cc = e & 63;
              *(LAS bf16_t*)(bhT + cc * TS + r2 * 2) = (bf16_t)f2bf(bf2f(braw[q]) * el); *(LAS bf16_t*)(Azk + cc * TS + r2 * 2) = (bf16_t)f2bf(bf2f(kraw[q]) * el); } }
        __syncthreads();
        { const RwRhs rhs{zt, RU}; dr_block_solve(Abf, Af, XT, Dbuf, -1.0f, wave, rhs, WSP(bf16_t, SC_RW_WU) + (size_t)u * 8192); }
        { RW_LANES; f32x4 am[2] = {(f32x4){0.f, 0.f, 0.f, 0.f}, (f32x4){0.f, 0.f, 0.f, 0.f}}, an[2] = {(f32x4){0.f, 0.f, 0.f, 0.f}, (f32x4){0.f, 0.f, 0.f, 0.f}};
          mm_rows<64, 2>(bhT, TS, XT, TS, mt, nt0, fr, fq, am);
          mm_rows<64, 2>(bhT, TS, XT + 64 * TS, TS, mt, nt0, fr, fq, an);
          mm_rows<64, 2>(Azk, TS, vT, TS, mt, nt0, fr, fq, an);
          bf16_t* Mg = WSP(bf16_t, SC_RW_M) + (size_t)cslot(u) * 4096; bf16_t* Ng = WSP(bf16_t, SC_RW_NS) + (size_t)cslot(u) * 4096;
#pragma unroll
          for (int t = 0; t < 2; ++t) {
#pragma unroll
              for (int j = 0; j < 4; ++j) { const int row = 16 * mt + 4 * fq + j, col = 16 * (nt0 + t) + fr; Mg[dr_mfrag_idx(row, col)] = (bf16_t)f2bf((row == col ? __expf(LP[63 * LPS + row]) : 0.f) + am[t][j]); }
              *(u32x2*)(Ng + (((nt0 + t) * 4 + mt) * 64 + lane) * 4) = (u32x2){pk2(an[t][0], an[t][1]), pk2(an[t][2], an[t][3])}; } }
        __syncthreads();
        if (!more) break;
        u = un;
    }
#undef RW1_LOAD
}
__device__ __forceinline__ void rw_p2(const Cx& p, LAS unsigned char* lds, int layer, int b) {
    const int wave = __builtin_amdgcn_readfirstlane(p.tid >> 6), mt = wave >> 1, nt0 = (wave & 1) * 2;
    LAS float* LP = (LAS float*)lds; LAS float* GS = (LAS float*)(lds + 16640);
    LAS unsigned char* rt = lds + 18688; LAS unsigned char* bt = lds + 27904; LAS unsigned char* kt = lds + 37120; LAS unsigned char* vT = lds + 46336; LAS unsigned char* sT = lds + 55552; LAS unsigned char* wt = lds + 64768;
    LAS unsigned char* Arb = lds + 73984; LAS unsigned char* Ark = lds + 83200; LAS unsigned char* UT = lds + 92416;
    const bf16_t* proj = WSP(bf16_t, WS_PROJ);
    bf16_t upre[2][4]; float lw8[8]; u32x4 rv, wv, sv, vq; f32x4 bv[2], kv[2];
#define RW2_LOAD(uu) do { const int tb_ = (uu) >> 3, h_ = ((uu) >> 1) & 3, d_ = (uu) & 1, s0_ = 64 * tb_; const int lane_ = lane_id_asm(), tid_ = wave * 64 + lane_, fr_ = lane_ & 15, fq_ = lane_ >> 4; \
        const float* lwp_ = WSP(float, SC_RLW) + (size_t)d_ * SB * 256 + (size_t)s0_ * 256 + 64 * h_; const float* rk_ = WSP(float, SC_RK) + (size_t)s0_ * 256 + 64 * h_; const float* rb_ = WSP(float, SC_RB) + (size_t)s0_ * 256 + 64 * h_; \
        const bf16_t* pr_ = proj + (size_t)tb_row0(b, tb_) * NPROJ; const bf16_t* wu_ = WSP(bf16_t, SC_RW_WU) + (size_t)(uu) * 8192; const bf16_t* st_ = WSP(bf16_t, SC_RW_NS) + (size_t)cslot(uu) * 4096; \
        _Pragma("unroll") for (int t = 0; t < 2; ++t) { _Pragma("unroll") for (int j = 0; j < 4; ++j) upre[t][j] = wu_[(16 * mt + 4 * fq_ + j) * 128 + 64 + 16 * (nt0 + t) + fr_]; } \
        _Pragma("unroll") for (int ii = 0; ii < 8; ++ii) { const int r_ = 8 * wave + ii; lw8[ii] = lwp_[(size_t)(d_ ? 63 - r_ : r_) * 256 + lane_]; } \
        { const int r_ = tid_ >> 3, c0_ = (tid_ & 7) * 8, i_ = d_ ? 63 - r_ : r_; rv = *(const u32x4*)(pr_ + (size_t)i_ * NPROJ + PB_R + 64 * h_ + c0_); \
          _Pragma("unroll") for (int q = 0; q < 2; ++q) { bv[q] = *(const f32x4*)(rb_ + (size_t)i_ * 256 + c0_ + 4 * q); kv[q] = *(const f32x4*)(rk_ + (size_t)i_ * 256 + c0_ + 4 * q); } \
          wv = *(const u32x4*)(wu_ + r_ * 128 + c0_); sv = *(const u32x4*)(st_ + r_ * 64 + c0_); } \
        vq = *(const u32x4*)(pr_ + (size_t)(d_ ? 63 - lane_ : lane_) * NPROJ + PB_V + 64 * h_ + 8 * wave); } while (0)
    int u = (p.bid + p.G - (224 % p.G)) % p.G;
    if (u < NUNIT) RW2_LOAD(u);
    for (; u < NUNIT; u += p.G) { const int tb = u >> 3, h = (u >> 1) & 3, d = u & 1, s0 = 64 * tb;
        bf16_t ucur[2][4];
#pragma unroll
        for (int t = 0; t < 2; ++t)
#pragma unroll
            for (int j = 0; j < 4; ++j) ucur[t][j] = upre[t][j];
        RW_LP(LP, GS, lw8);
        { RW_LANES; const int r = tid >> 3, c0 = (tid & 7) * 8; unsigned wr[4], wb[4], wk[4];
#pragma unroll
          for (int q = 0; q < 8; q += 2) { float r2[2], b2[2], k2[2];
#pragma unroll
              for (int e = 0; e < 2; ++e) { const int cq = q + e, c = c0 + cq; const float lp = LP[r * LPS + c], em = __expf(-lp); const unsigned w = rv[q >> 1];
                  r2[e] = (e ? __uint_as_float(w & 0xffff0000u) : __uint_as_float(w << 16)) * __expf(lp); b2[e] = bv[cq >> 2][cq & 3] * em; k2[e] = kv[cq >> 2][cq & 3] * em; }
              wr[q >> 1] = pk2(r2[0], r2[1]); wb[q >> 1] = pk2(b2[0], b2[1]); wk[q >> 1] = pk2(k2[0], k2[1]); }
          *(LAS u32x4*)(rt + r * TS + c0 * 2) = (u32x4){wr[0], wr[1], wr[2], wr[3]}; *(LAS u32x4*)(bt + r * TS + c0 * 2) = (u32x4){wb[0], wb[1], wb[2], wb[3]}; *(LAS u32x4*)(kt + r * TS + c0 * 2) = (u32x4){wk[0], wk[1], wk[2], wk[3]};
          *(LAS u32x4*)(wt + r * TS + c0 * 2) = wv; *(LAS u32x4*)(sT + r * TS + c0 * 2) = sv;
#pragma unroll
          for (int k = 0; k < 8; ++k) *(LAS bf16_t*)(vT + (8 * wave + k) * TS + lane * 2) = (bf16_t)(vq[k >> 1] >> (16 * (k & 1))); }
        if (u + p.G < NUNIT) RW2_LOAD(u + p.G);
        __syncthreads();
        { RW_LANES; f32x4 a1[2] = {(f32x4){0.f, 0.f, 0.f, 0.f}, (f32x4){0.f, 0.f, 0.f, 0.f}}, a2[2] = {(f32x4){0.f, 0.f, 0.f, 0.f}, (f32x4){0.f, 0.f, 0.f, 0.f}}, a3[2] = {(f32x4){0.f, 0.f, 0.f, 0.f}, (f32x4){0.f, 0.f, 0.f, 0.f}};
          mm_rows<64, 2>(rt, TS, bt, TS, mt, nt0, fr, fq, a1); mm_rows<64, 2>(rt, TS, kt, TS, mt, nt0, fr, fq, a2); mm_rows<64, 2>(wt, TS, sT, TS, mt, nt0, fr, fq, a3);
#pragma unroll
          for (int t = 0; t < 2; ++t) { const int dv = 16 * (nt0 + t) + fr; float uu[4];
#pragma unroll
              for (int j = 0; j < 4; ++j) { const int r = 16 * mt + 4 * fq + j, jj = dv; const bool keep = jj <= r;
                  *(LAS bf16_t*)(Arb + r * TS + jj * 2) = (bf16_t)f2bf(keep ? a1[t][j] : 0.f); *(LAS bf16_t*)(Ark + r * TS + jj * 2) = (bf16_t)f2bf(keep ? a2[t][j] : 0.f);
                  uu[j] = bf2f(ucur[t][j]) + a3[t][j]; }
              *(LAS u32x2*)(UT + dv * TS + (16 * mt + 4 * fq) * 2) = (u32x2){pk2(uu[0], uu[1]), pk2(uu[2], uu[3])}; } }
        __syncthreads();
        { RW_LANES; f32x4 acc[2] = {(f32x4){0.f, 0.f, 0.f, 0.f}, (f32x4){0.f, 0.f, 0.f, 0.f}};
          mm_rows<64, 2>(rt, TS, sT, TS, mt, nt0, fr, fq, acc); mm_rows<64, 2>(Arb, TS, UT, TS, mt, nt0, fr, fq, acc); mm_rows<64, 2>(Ark, TS, vT, TS, mt, nt0, fr, fq, acc);
          bf16_t* ob = WSP(bf16_t, d ? SC_OB : SC_OF);
#pragma unroll
          for (int t = 0; t < 2; ++t)
#pragma unroll
              for (int j = 0; j < 4; ++j) { const int r = 16 * mt + 4 * fq + j, i = d ? 63 - r : r; ob[(size_t)(s0 + i) * 1024 + 256 + 64 * h + 16 * (nt0 + t) + fr] = (bf16_t)f2bf(acc[t][j]); } }
        __syncthreads();
    }
#undef RW_LANES
#undef RW2_LOAD
}
__device__ __forceinline__ void phase_scan(const Cx& p, LAS unsigned char* lds, int layer, int b) {
    for (int w = p.bid; w < 160; w += p.G) {
        if (w < 64) ssd_chain(p, (w >> 4) & 3, (w >> 3) & 1, w & 7);
        else if (w < 96) gla_chain(p, ((w - 64) >> 3) & 3, ((w - 64) >> 2) & 1, (w - 64) & 3);
        else { const int i = w - 96, h = (i >> 3) & 3, d = (i >> 2) & 1, cb = i & 3;
            if (i < 32) dr_chain(p, SC_RW_M, SC_RW_NS, h, d, cb); else dr_chain(p, SC_DR_M, SC_DR_NS, h, d, cb); } }
}
#ifndef MK_ONE_LAUNCH
#define MK_ONE_LAUNCH 1
#endif
constexpr int PH_PER_LAYER = 2 + 5 * NB + 7;
constexpr int N_PHASES = 1 + NL * PH_PER_LAYER + 1;

__global__ void __launch_bounds__(NTHR, 2) mega_fwd(Params pp) {
    extern __shared__ __attribute__((aligned(16))) unsigned char lds_raw[];
    LAS unsigned char* lds = (LAS unsigned char*)lds_raw;
    const int swave = __builtin_amdgcn_readfirstlane(threadIdx.x >> 6);
    for (int i = threadIdx.x; i < (LDS_BYTES - LDS_CTL) / 4; i += NTHR) ((LAS unsigned*)(lds + LDS_CTL))[i] = 0u;
    __syncthreads();
    if (threadIdx.x < N_IN + 2) { const unsigned long long a = threadIdx.x < N_IN ? (unsigned long long)pp.in[threadIdx.x] : (threadIdx.x == N_IN ? (unsigned long long)pp.out : (unsigned long long)pp.ws); ((LAS unsigned*)(lds + LDS_PTRS))[2 * threadIdx.x] = (unsigned)a; ((LAS unsigned*)(lds + LDS_PTRS))[2 * threadIdx.x + 1] = (unsigned)(a >> 32); }
    __syncthreads();
    XcdBarrier bar = xcd_barrier_post((unsigned*)(pp.ws + WS_CTL) + CW_BAR + pp.li * XCD_BAR_WORDS, (volatile LAS unsigned*)(lds + LDS_CTL), threadIdx.x);
    LAS int* tb = (LAS int*)(lds + LDS_CTL + 64);
    int pc = 0; const int lo = pp.lo, hi = pp.hi;
#define PH_BEGIN if (pc >= lo && pc < hi) { Cx p; p.out = (unsigned long long)PIN(N_IN); p.ws = (unsigned long long)PIN(N_IN + 1); p.tid = swave * 64 + lane_id_asm(); p.bid = blockIdx.x; p.G = gridDim.x; p.pad = 0; asm volatile("" : "+s"(p.out), "+s"(p.ws), "+v"(p.tid), "+s"(p.bid), "+s"(p.G)); const int G = p.G, bid = p.bid; (void)G; (void)bid;
#define PH_END if (pc + 1 < hi) { XcdBarrier b2 = bar; asm volatile("" : "+s"(b2.bar), "+s"(b2.x)); xcd_barrier(b2, (unsigned)(swave * 64 + lane_id_asm())); } } ++pc;

    PH_BEGIN
        conv_run(p, (LAS float*)lds, CONV_A_UNITS, ConvDescA{0});
        __syncthreads();
        phase_mod(p, lds);
    PH_END

#pragma unroll
    for (int layer = 0; layer < NL; ++layer) {
        const int row_lo = layer == NL - 1 ? CROWS : 0;
        PH_BEGIN phase_norm1(p, layer); PH_END
        PH_BEGIN
            DenseSched S; S.init(ROWS, NPROJ, D, WSP(bf16_t, WS_WIN) + (size_t)layer * NPROJ * D, G, bid);
            EpiProj E{WSP(bf16_t, WS_PROJ), NPROJ};
            pg8::gemm_phase<D>(p.tid, lds, (const char*)WSP(bf16_t, WS_HBUF), S, E);
        PH_END
#pragma unroll 1
        for (int b = 0; b < NB; ++b) {
            PH_BEGIN phase_prep(p, lds, layer, b); PH_END
            PH_BEGIN gla_p1(p, lds, layer, b); __syncthreads(); ssd_p1(p, lds, layer, b); __syncthreads(); gdn_p1(p, lds, layer, b); __syncthreads(); rw_p1(p, lds, layer, b); PH_END
            PH_BEGIN phase_scan(p, lds, layer, b); PH_END
            PH_BEGIN gla_p2(p, lds, layer, b); __syncthreads(); ssd_p2(p, lds, layer, b); __syncthreads(); gdn_p2(p, lds, layer, b); __syncthreads(); rw_p2(p, lds, layer, b); PH_END
            PH_BEGIN phase_post(p, lds, layer, b); PH_END
        }
        PH_BEGIN
            DenseSched S; S.init(ROWS, D, D, WSP(bf16_t, WS_WOUT) + (size_t)layer * D * D, G, bid);
            EpiRes E{layer == 0 ? PIN(I_X) : (const float*)POUT, layer == 0 ? PIN(I_CTX) : (const float*)WSP(float, WS_CTXRES), POUT, WSP(float, WS_CTXRES), WSP(float, WS_MOD) + (size_t)layer * 5 * 6144 + 2048};
            pg8::gemm_phase<D>(p.tid, lds, (const char*)WSP(bf16_t, WS_HBUF), S, E);
        PH_END
        PH_BEGIN phase_norm2(p, lds, layer, row_lo);
            __syncthreads();
            conv_run(p, (LAS float*)lds, CONV_E_UNITS, ConvDescE{layer});
        PH_END
        PH_BEGIN
            moe_table(p, tb, layer, row_lo);
            MoeSched<true> S{tb + 128, tb, 2, G, bid, D, row_lo, WSP(int, WS_LTOK), (const char*)WSP(bf16_t, WS_EXPGU), (size_t)512 * D * 2};
            EpiGU E{WSP(bf16_t, WS_H)};
            pg8::gemm_phase<D>(p.tid, lds, (const char*)WSP(bf16_t, WS_HBUF), S, E);
        PH_END
#pragma unroll
        for (int half = 0; half < 2; ++half) {
            PH_BEGIN
                moe_table(p, tb, layer, row_lo);
                MoeSched<false> S{tb + 128, tb, 2, G, bid, EH, row_lo, WSP(int, WS_LTOK), (const char*)(WSP(bf16_t, WS_EXPD) + (size_t)half * 512 * EH), (size_t)D * EH * 2};
                EpiY E{WSP(bf16_t, WS_Y)};
                pg8::gemm_phase<EH>(p.tid, lds, (const char*)WSP(bf16_t, WS_H), S, E);
            PH_END
            PH_BEGIN
                moe_table(p, tb, layer, row_lo);
                phase_combine(p, tb, layer, row_lo, half);
            PH_END
        }
    }
    PH_BEGIN phase_final(p);
    PH_END
#undef PH_BEGIN
#undef PH_END
}

extern "C" void kernel_launch(void* const* d_in, const int* in_sizes, int n_in, void* d_out, int out_size, void* d_ws, size_t ws_size, hipStream_t stream) {
    static int grid = 0;
    if (grid == 0) {
        if (n_in != N_IN || in_sizes[0] != NB * SEQ * D || out_size != NB * SEQ * D || ws_size < WS_END) {
            fprintf(stderr, "kernel_launch: unexpected shapes (n_in %d, in0 %d, out %d, ws %zu); nothing launched\n", n_in, n_in > 0 ? in_sizes[0] : -1, out_size, ws_size); grid = -1; return; }
        int dev = 0, cus = 0, per_cu = 0;
        if (hipGetDevice(&dev) != hipSuccess || hipDeviceGetAttribute(&cus, hipDeviceAttributeMultiprocessorCount, dev) != hipSuccess) { grid = -1; return; }
        if (hipFuncSetAttribute((const void*)mega_fwd, hipFuncAttributeMaxDynamicSharedMemorySize, LDS_BYTES) != hipSuccess) { fprintf(stderr, "kernel_launch: hipFuncSetAttribute failed\n"); grid = -1; return; }
        if (hipOccupancyMaxActiveBlocksPerMultiprocessor(&per_cu, (const void*)mega_fwd, NTHR, LDS_BYTES) != hipSuccess || per_cu < 1) { fprintf(stderr, "kernel_launch: occupancy query says %d\n", per_cu); per_cu = 1; }
        (void)hipGetLastError();
        grid = cus * 1;
    }
    if (grid < 0) return;
    if (hipMemsetAsync((char*)d_ws + WS_CTL, 0, CTL_ZERO_BYTES, stream) != hipSuccess) return;
    Params p{};
    for (int i = 0; i < N_IN; ++i) p.in[i] = (const float*)d_in[i];
    p.out = (float*)d_out; p.ws = (unsigned char*)d_ws; p.pad = 0;
#if MK_ONE_LAUNCH
    p.lo = 0; p.hi = N_PHASES; p.li = 0;
    hipLaunchKernelGGL(mega_fwd, dim3(grid), dim3(NTHR), LDS_BYTES, stream, p);
#else
    for (int k = 0; k < N_PHASES; ++k) { p.lo = k; p.hi = k + 1; p.li = k;
        hipLaunchKernelGGL(mega_fwd, dim3(grid), dim3(NTHR), LDS_BYTES, stream, p); }
#endif
}
```

```cpp
#include <hip/hip_runtime.h>
#include <cstdio>
#include <cstdint>

typedef unsigned short bf16_t;
typedef short bf16x8 __attribute__((ext_vector_type(8)));
typedef float f32x4 __attribute__((ext_vector_type(4)));
typedef float f32x2 __attribute__((ext_vector_type(2)));
typedef unsigned u32x4 __attribute__((ext_vector_type(4)));
typedef unsigned u32x2 __attribute__((ext_vector_type(2)));

constexpr int NB = 4, SEQ = 8192, NCTX = 256, D = 1024, NL = 2;
constexpr int CROWS = NB * NCTX;
constexpr int ROWS = CROWS + NB * SEQ;
constexpr int SB = NCTX + SEQ;
constexpr int INW = 4056, NPROJ = 4096;
constexpr int NE = 64, NE1 = 65, TOPK = 8, EH = 256;
constexpr int GRIDW = 64, GRIDH = SEQ / GRIDW;
constexpr int PA_Q = 0, PA_K = 256, PA_V = 512, PA_G = 768, PA_GF = 1024, PA_GB = 1040;
constexpr int PB_R = 1056, PB_K = 1312, PB_V = 1568, PB_WF = 1824, PB_WB = 1856, PB_A = 1888, PB_G = 1920;
constexpr int PC_Z = 1984, PC_X = 2240, PC_DF = 3008, PC_DB = 3012;
constexpr int PD_Q = 3016, PD_Z = 3784, PD_BF = 4040, PD_BB = 4044, PD_AF = 4048, PD_AB = 4052;
enum { I_X = 0, I_C, I_CTX, I_CCTX, I_N1G, I_N2G, I_WMOD, I_BMOD, I_WIN, I_WOUT, I_GLA_W2, I_GLA_B, I_GLA_NG,
       I_RW_W2, I_RW_W0, I_RW_AW2, I_RW_A0, I_RW_GW2, I_RW_KK, I_RW_KA, I_RW_RK, I_RW_LNG, I_RW_LNB,
       I_SS_CW, I_SS_CB, I_SS_ALOG, I_SS_DTB, I_SS_D, I_SS_NG, I_DN_CW, I_DN_ALOG, I_DN_DTB, I_DN_NG,
       I_ROUT_W, I_ROUT_B, I_EXP_G, I_EXP_U, I_EXP_D, I_SH_G, I_SH_U, I_SH_D, I_FNG, N_IN };
static_assert(N_IN == 42, "input count");

constexpr size_t MiB = 1u << 20;
constexpr size_t WS_CTL = 0, CTL_ZERO_BYTES = 1 * MiB;
constexpr size_t WS_MOD = 1 * MiB;
constexpr size_t WS_RWGW = WS_MOD + 256 * 1024;
constexpr size_t WS_RWLR = WS_MOD + 384 * 1024;
constexpr size_t WS_WIN = 2 * MiB;
constexpr size_t WS_WOUT = 18 * MiB;
constexpr size_t WS_ROUT = 22 * MiB;
constexpr size_t WS_CTXRES = 23 * MiB;
constexpr size_t WS_EXPGU = 27 * MiB;
constexpr size_t WS_EXPD = 92 * MiB;
constexpr size_t WS_HBUF = 125 * MiB;
constexpr size_t WS_PROJ = 191 * MiB;
constexpr size_t WS_SCR = 455 * MiB;
constexpr size_t WS_END = 640455456;
constexpr int HROWS_MAX = ROWS * 9 + NE1 * 256;
constexpr size_t WS_Y = WS_HBUF;
constexpr size_t WS_H = 443 * MiB;
constexpr size_t WS_LTOK = 600 * MiB;
constexpr size_t WS_TOKT = WS_LTOK + (size_t)NE * ROWS * 4;
static_assert(WS_Y + (size_t)HROWS_MAX * 512 * 2 <= WS_H && WS_H + (size_t)HROWS_MAX * 256 * 2 <= WS_LTOK && WS_TOKT + (size_t)ROWS * 64 <= WS_END, "moe overlay");
constexpr size_t SC_OF = WS_SCR;
constexpr size_t SC_OB = SC_OF + (size_t)SB * 1024 * 2;
constexpr size_t SC_RK = SC_OB + (size_t)SB * 1024 * 2;
constexpr size_t SC_RKK = SC_RK + (size_t)SB * 256 * 4;
constexpr size_t SC_RB = SC_RKK + (size_t)SB * 256 * 4;
constexpr size_t SC_RLW = SC_RB + (size_t)SB * 256 * 4;
constexpr size_t SC_SX = SC_RLW + (size_t)2 * SB * 256 * 4;
constexpr size_t SC_DQ = SC_SX + (size_t)SB * 768 * 2;
constexpr size_t SC_SDT = SC_DQ + (size_t)SB * 768 * 2;
constexpr size_t SC_DG = SC_SDT + (size_t)SB * 8 * 4;
constexpr size_t SC_FEND = SC_DG + (size_t)SB * 16 * 4;
constexpr int NTB = SB / 64, NUNIT = NTB * 4 * 2;
constexpr size_t SC_RW_M = SC_FEND;
constexpr size_t SC_RW_NS = SC_RW_M + (size_t)(SB / 64 * 8) * 4096 * 2;
constexpr size_t SC_RW_WU = SC_RW_NS + (size_t)(SB / 64 * 8) * 4096 * 2;
constexpr size_t SC_END = SC_RW_WU + (size_t)(SB / 64 * 8) * 8192 * 2;
constexpr size_t SC2 = WS_EXPGU;
constexpr size_t SC_GLA_S = SC2;
constexpr size_t SC_GLA_DEC = SC_GLA_S + (size_t)NUNIT * 4096 * 4;
constexpr size_t SC_SSD_S = SC_GLA_DEC + (size_t)NUNIT * 64 * 4;
constexpr size_t SC_SSD_CD = SC_SSD_S + (size_t)NUNIT * 8192 * 4;
constexpr size_t SC_DR_M = SC_SSD_CD + (size_t)NUNIT * 4 + 4096;
constexpr size_t SC_DR_NS = SC_DR_M + (size_t)NUNIT * 4096 * 2;
constexpr size_t SC_DR_WU = SC_DR_NS + (size_t)NUNIT * 4096 * 2;
constexpr size_t SC2_END = SC_DR_WU + (size_t)NUNIT * 8192 * 2;
static_assert(SC2_END <= WS_HBUF, "chunk slots fit in the expert-weight region");
static_assert(SC_END <= WS_END, "scratch fits");
constexpr int CW_CNT = 1024;
constexpr int CW_BAR = 4096;

#define LAS __attribute__((address_space(3)))
constexpr int NTHR = 512;
constexpr int LDS_BYTES = 147456;
constexpr int LDS_CTL = 143360;
constexpr int LDS_PTRS = LDS_CTL + 2048;

__device__ __forceinline__ int lane_id_asm() { int l; asm volatile("v_mbcnt_lo_u32_b32 %0, -1, 0\n\tv_mbcnt_hi_u32_b32 %0, -1, %0" : "=v"(l)); return l; }
__device__ __forceinline__ float bf2f(bf16_t b) { return __uint_as_float(((unsigned)b) << 16); }
typedef float f32x2_t __attribute__((ext_vector_type(2))); typedef __bf16 bf16x2_t __attribute__((ext_vector_type(2)));
__device__ __forceinline__ unsigned pk2(float lo, float hi) { const f32x2_t v = {lo, hi}; return __builtin_bit_cast(unsigned, __builtin_convertvector(v, bf16x2_t)); }
__device__ __forceinline__ unsigned f2bf(float f) { return pk2(f, 0.f) & 0xffffu; }
__device__ __forceinline__ float rl(float x, int k) { return __uint_as_float(__builtin_amdgcn_readlane(__float_as_uint(x), k)); }
__device__ __forceinline__ float shx_(float v, int lane, int o) { return __uint_as_float(__builtin_amdgcn_ds_bpermute((lane ^ o) << 2, __float_as_uint(v))); }
__device__ __forceinline__ int shxi_(int v, int lane, int o) { return __builtin_amdgcn_ds_bpermute((lane ^ o) << 2, v); }
__device__ __forceinline__ float shup_(float v, int lane, int o) { return __uint_as_float(__builtin_amdgcn_ds_bpermute((lane - o) << 2, __float_as_uint(v))); }
#define DPPF(v, ctrl) __uint_as_float(__builtin_amdgcn_update_dpp(0, __float_as_uint(v), ctrl, 0xf, 0xf, false))
#define DPPI(v, ctrl) __builtin_amdgcn_update_dpp(0, (v), ctrl, 0xf, 0xf, false)
__device__ __forceinline__ float wsum(float v) {
    v += DPPF(v, 0xB1); v += DPPF(v, 0x4E); v += DPPF(v, 0x141); v += DPPF(v, 0x140);
    v += __uint_as_float(__builtin_amdgcn_ds_swizzle(__float_as_uint(v), 0x401F));
    return rl(v, 0) + rl(v, 32);
}
__device__ __forceinline__ float rcp_(float x) { return __builtin_amdgcn_rcpf(x); }
__device__ __forceinline__ float rsq_(float x) { return __builtin_amdgcn_rsqf(x); }
__device__ __forceinline__ float sigmoidf_(float x) { return rcp_(1.0f + __expf(-x)); }
__device__ __forceinline__ float siluf_(float x) { return x * rcp_(1.0f + __expf(-x)); }
__device__ __forceinline__ float log1pexp_(float t  ) { return t < 1e-4f ? t - 0.5f * t * t : __logf(1.0f + t); }
__device__ __forceinline__ float softplusf_(float x) { return x > 15.f ? x : log1pexp_(__expf(x)); }
__device__ __forceinline__ float logsigmoidf_(float x) { return fminf(x, 0.f) - log1pexp_(__expf(-fabsf(x))); }
__device__ __forceinline__ float tanhf_(float x) { const float e = __expf(2.0f * fminf(fmaxf(x, -15.f), 15.f)); return (e - 1.0f) * rcp_(e + 1.0f); }
__device__ __forceinline__ int seq_tok(int i, int d) { return d == 0 ? i : (i < NCTX ? NCTX - 1 - i : SB + NCTX - 1 - i); }
__device__ __forceinline__ int tok_row(int b, int s) { return s < NCTX ? b * NCTX + s : CROWS + b * SEQ + (s - NCTX); }

#define GAS __attribute__((address_space(1)))
struct Params { const float* in[N_IN]; float* out; unsigned char* ws; int lo, hi, li, pad; };
struct Cx { unsigned long long out, ws; int tid, bid, G, pad; };
__device__ __forceinline__ const float* PIN(int i) {
    extern __shared__ __attribute__((aligned(16))) unsigned char lds_raw_[];
    int off = __builtin_amdgcn_readfirstlane(LDS_PTRS + 8 * i); asm volatile("" : "+s"(off));
    const LAS unsigned* t = (const LAS unsigned*)((LAS unsigned char*)lds_raw_ + off);
    const unsigned lo = __builtin_amdgcn_readfirstlane(t[0]), hi = __builtin_amdgcn_readfirstlane(t[1]);
    return (const float*)(const GAS float*)(((unsigned long long)hi << 32) | lo);
}
#define XB_TMO      128
#define XB_XCNT(j)  (256  + 64 * (j))
#define XB_XSUB(j)  (1280 + 64 * (j))
#define XB_XGEN(j)  (2304 + 64 * (j))
#define XB_TOP      3328
#define XB_TOPGEN   3392
#define XCD_BAR_WORDS 3456
#define XB_SPIN_CAP (1u << 18)

__device__ __forceinline__ unsigned xb_ld(unsigned* p)              { return __hip_atomic_load(p, __ATOMIC_RELAXED, __HIP_MEMORY_SCOPE_AGENT); }
__device__ __forceinline__ unsigned xb_add(unsigned* p, unsigned v) { return __hip_atomic_fetch_add(p, v, __ATOMIC_RELAXED, __HIP_MEMORY_SCOPE_AGENT); }
__device__ __forceinline__ unsigned xb_xcc_id() { return (unsigned)__builtin_amdgcn_s_getreg((3 << 11) | 20) & 0xFu; }
#define XB_SPIN(cond, bar) do { unsigned _sp = 0; while (cond) { __builtin_amdgcn_s_sleep(1); \
    if ((++_sp & 255u) == 0u) { if (xb_ld(&(bar)[XB_TMO])) break; if (_sp > XB_SPIN_CAP) { atomicAdd(&(bar)[XB_TMO], 1u); break; } } } } while (0)

struct XcdBarrier {
    unsigned* bar; unsigned x;
    volatile LAS unsigned* st;
};

__device__ __forceinline__ XcdBarrier xcd_barrier_post(unsigned* bar, volatile LAS unsigned* st, const unsigned xb_tid) {
    XcdBarrier b; b.bar = bar; b.x = xb_xcc_id(); b.st = st;
    if (xb_tid == 0) (void)xb_add(&bar[XB_XCNT(b.x)], 1u);
    return b;
}
__device__ __forceinline__ void xcd_barrier_complete(unsigned* bar, unsigned x, unsigned& nloc, unsigned& nx) {
    const unsigned G = gridDim.x * gridDim.y * gridDim.z;
    unsigned sum, cnt, mine, sp = 0u;
    for (;;) {
        sum = 0u; cnt = 0u; mine = 0u;
#pragma unroll
        for (unsigned j = 0; j < 16; ++j) { const unsigned c = xb_ld(&bar[XB_XCNT(j)]); sum += c; cnt += (c > 0u) ? 1u : 0u; mine = (j == x) ? c : mine; }
        if (sum == G) break;
        __builtin_amdgcn_s_sleep(1);
        if ((++sp & 255u) == 0u) { if (xb_ld(&bar[XB_TMO])) break; if (sp > XB_SPIN_CAP) { atomicAdd(&bar[XB_TMO], 1u); break; } }
    }
    nloc = mine > 0u ? mine : 1u; nx = cnt > 0u ? cnt : 1u;
}

__device__ __forceinline__ void xcd_barrier(const XcdBarrier& b, const unsigned xb_tid) {
    asm volatile("s_waitcnt vmcnt(0)" ::: "memory");
    __syncthreads();
    if (xb_tid == 0) {
        unsigned* bar = b.bar;
        __builtin_amdgcn_s_waitcnt(0);
        unsigned nloc = b.st[0], nx = b.st[1];
        if (nloc == 0u) { xcd_barrier_complete(bar, b.x, nloc, nx); b.st[0] = nloc; b.st[1] = nx; }
        const unsigned old = xb_add(&bar[XB_XSUB(b.x)], 1u);
        const unsigned gen = old / nloc;
        if (old + 1u == (gen + 1u) * nloc) {
            __builtin_amdgcn_fence(__ATOMIC_RELEASE, "agent");
            asm volatile("s_waitcnt vmcnt(0)" ::: "memory");
            const unsigned og = xb_add(&bar[XB_TOP], 1u);
            const unsigned tg = og / nx;
            if (og + 1u == (tg + 1u) * nx) xb_add(&bar[XB_TOPGEN], 1u);
            else XB_SPIN(xb_ld(&bar[XB_TOPGEN]) == tg, bar);
            __builtin_amdgcn_fence(__ATOMIC_ACQUIRE, "agent");
            xb_add(&bar[XB_XGEN(b.x)], 1u);
            asm volatile("s_waitcnt vmcnt(0)" ::: "memory");
        } else {
            XB_SPIN(xb_ld(&bar[XB_XGEN(b.x)]) == gen, bar);
            __builtin_amdgcn_fence(__ATOMIC_ACQUIRE, "agent");
            asm volatile("s_waitcnt vmcnt(0)" ::: "memory");
        }
    }
    __syncthreads();
}

namespace pg8 {
constexpr int BM = 256, BK = 64, HALF = 128, HTB = HALF * BK * 2  , STAGE_BYTES = 8 * HTB, NXCD = 8, WGM = 8;
__host__ __device__ __forceinline__ int lds_byte(int r, int c) { const int st = (r >> 4) * 2 + (c >> 5), rr = r & 15, cc = c & 31, ob = rr * 64 + cc * 2; return st * 1024 + (ob ^ (((ob >> 9) & 1) << 5)); }
__host__ __device__ __forceinline__ void stage_rc(int b, int& R, int& C) { const int st = b / 1024, sb = b % 1024, swz = sb ^ (((sb >> 9) & 1) << 5); R = (st >> 1) * 16 + swz / 64; C = (st & 1) * 32 + (swz % 64) / 2; }
__host__ __device__ __forceinline__ int perm32(int rho) { const int n = rho >> 4, i = rho & 15; return 8 * (i >> 2) + 4 * n + (i & 3); }

struct Unit { int pm, pn, e, r0; };

__device__ __forceinline__ unsigned cvt_pk_bf16(float lo, float hi) { unsigned r; asm volatile("v_cvt_pk_bf16_f32 %0, %1, %2" : "=v"(r) : "v"(lo), "v"(hi)); return r; }

template <int K, class Epi, class Sched>
__device__ __forceinline__ void gemm_phase(const int tid, LAS unsigned char* lds, const char* Abase, const Sched& S, const Epi& E) {
    const int wid = __builtin_amdgcn_readfirstlane(tid >> 6), lane = tid & 63, wr = wid >> 2, wc = wid & 3, fr = lane & 15, fq = lane >> 4;
    const int nt = K / BK;
    constexpr bool DN = Sched::DENSE;
    int RA[2], CA[2]; unsigned voffB[2], voffA[2];
#pragma unroll
    for (int i = 0; i < 2; ++i) { int R, C; stage_rc(tid * 16 + i * 8192, R, C); const int Rb = Epi::PERM ? ((R & ~31) + perm32(R & 31)) : R;
        RA[i] = R; CA[i] = C; voffB[i] = (unsigned)(Rb * K + C) * 2u; voffA[i] = (unsigned)(R * K + C) * 2u; }
    const size_t kstep = (size_t)(BK * 2);
    const size_t hstep = (size_t)HALF * K * 2;
    const size_t tstep = 2 * hstep;
    const unsigned ldsw = (unsigned)wid * 1024u;
    const int aoff = lds_byte(wr * 64 + fr, fq * 8), boff = lds_byte(wc * 32 + fr, fq * 8);
#define PG8_SA(b, h) (((b) * 2 + (h)) * HTB)
#define PG8_SB(b, h) ((4 + (b) * 2 + (h)) * HTB)
#define PG8_STAGE(bufoff, gbase, voff) do { _Pragma("unroll") for (int _i = 0; _i < 2; ++_i) \
        __builtin_amdgcn_global_load_lds((const __attribute__((address_space(1))) unsigned*)((const __attribute__((address_space(1))) char*)(gbase) + (voff)[_i]), (LAS unsigned*)(lds + (bufoff) + ldsw + _i * 8192), 16, 0, 0); } while (0)
#define PG8_LDA(dst, b, h) do { _Pragma("unroll") for (int m = 0; m < 4; ++m) _Pragma("unroll") for (int k = 0; k < 2; ++k) dst[m][k] = *(const LAS bf16x8*)(lds + PG8_SA(b, h) + aoff + m * 2048 + k * 1024); } while (0)
#define PG8_LDB(dst, b, h) do { _Pragma("unroll") for (int n = 0; n < 2; ++n) _Pragma("unroll") for (int k = 0; k < 2; ++k) dst[n][k] = *(const LAS bf16x8*)(lds + PG8_SB(b, h) + boff + n * 2048 + k * 1024); } while (0)
#define PG8_MMA(ai, bj, At, Bt) do { __builtin_amdgcn_s_setprio(1); _Pragma("unroll") for (int m = 0; m < 4; ++m) _Pragma("unroll") for (int n = 0; n < 2; ++n) _Pragma("unroll") for (int k = 0; k < 2; ++k) \
        acc[ai][bj][m][n] = __builtin_amdgcn_mfma_f32_16x16x32_bf16(Bt[n][k], At[m][k], acc[ai][bj][m][n], 0, 0, 0); __builtin_amdgcn_s_setprio(0); } while (0)
#define PG8_WAIT_V(n) asm volatile("s_waitcnt vmcnt(" #n ")" ::: "memory")
#define PG8_WAIT_L(n) asm volatile("s_waitcnt lgkmcnt(" #n ")" ::: "memory")
#define PG8_BAR __builtin_amdgcn_s_barrier()
#define PG8_SCHED __builtin_amdgcn_sched_barrier(0)
#define PG8_AOFF(dst, u) do { _Pragma("unroll") for (int _h = 0; _h < 2; ++_h) _Pragma("unroll") for (int _i = 0; _i < 2; ++_i) \
        dst[_h][_i] = ((unsigned)S.a_row(u, _h * HALF + RA[_i]) * (unsigned)K + (unsigned)CA[_i]) * 2u; } while (0)
    Unit cur, nxt; int ui = 0;
    if (!S.next(0, cur)) return;
    f32x4 acc[2][2][4][2];
#pragma unroll
    for (int a = 0; a < 2; ++a)
#pragma unroll
        for (int b = 0; b < 2; ++b)
#pragma unroll
            for (int m = 0; m < 4; ++m)
#pragma unroll
                for (int n = 0; n < 2; ++n) acc[a][b][m][n] = (f32x4){0.f, 0.f, 0.f, 0.f};
    bf16x8 At[4][2], B0[2][2], B1[2][2];
    unsigned cO[2][2], nO[2][2];
    const char* cA = Abase; const char* nA = Abase;
    if constexpr (DN) cA = Abase + (size_t)S.a_row(cur, 0) * K * 2; else PG8_AOFF(cO, cur);
    const char* cB = S.b_ptr(cur);
#define PG8_STA(bufoff, h_, kb_, nx_) do { if constexpr (DN) PG8_STAGE(bufoff, ((nx_) ? nA : cA) + (h_) * hstep + (kb_), voffA); else PG8_STAGE(bufoff, Abase + (kb_), ((nx_) ? nO : cO)[h_]); } while (0)
    PG8_STAGE(PG8_SB(0, 0), cB, voffB); PG8_SCHED; PG8_STA(PG8_SA(0, 0), 0, 0, false); PG8_SCHED; PG8_STAGE(PG8_SB(0, 1), cB + hstep, voffB); PG8_SCHED; PG8_STA(PG8_SA(0, 1), 1, 0, false); PG8_SCHED;
    if (wr == 1) PG8_BAR;
    PG8_WAIT_V(4); PG8_BAR;
    PG8_STAGE(PG8_SB(1, 0), cB + kstep, voffB); PG8_SCHED; PG8_STA(PG8_SA(1, 0), 0, kstep, false); PG8_SCHED; PG8_STAGE(PG8_SB(1, 1), cB + hstep + kstep, voffB); PG8_SCHED;
    PG8_WAIT_V(6); PG8_BAR;
    for (;;) {
        const bool has_next = S.next(ui + 1, nxt);
        const char* nB = cB; nA = cA;
        if (has_next) { if constexpr (DN) nA = Abase + (size_t)S.a_row(nxt, 0) * K * 2; else PG8_AOFF(nO, nxt); nB = S.b_ptr(nxt); }
        else if constexpr (!DN) {
#pragma unroll
            for (int h = 0; h < 2; ++h)
#pragma unroll
                for (int i = 0; i < 2; ++i) nO[h][i] = cO[h][i]; }
        for (int t = 0; t < nt; t += 2) {
            const bool last = (t == nt - 2);
            const size_t k1 = (size_t)(t + 1) * kstep, k2 = last ? 0 : (size_t)(t + 2) * kstep, k3 = k2 + kstep;
            const char* b2 = last ? nB : cB + (size_t)(t + 2) * kstep; const char* b3 = b2 + kstep;
            PG8_LDB(B0, 0, 0); PG8_SCHED; PG8_LDA(At, 0, 0); PG8_STA(PG8_SA(1, 1), 1, k1, false);
            PG8_WAIT_L(8); PG8_BAR; PG8_WAIT_L(0); PG8_MMA(0, 0, At, B0); PG8_BAR; PG8_SCHED;
            PG8_LDB(B1, 0, 1); PG8_STAGE(PG8_SB(0, 0), b2, voffB);
            PG8_BAR; PG8_WAIT_L(0); PG8_MMA(0, 1, At, B1); PG8_BAR;
            PG8_LDA(At, 0, 1); PG8_STA(PG8_SA(0, 0), 0, k2, last);
            PG8_BAR; PG8_WAIT_L(0); PG8_MMA(1, 0, At, B0); PG8_BAR; PG8_SCHED;
            PG8_STAGE(PG8_SB(0, 1), b2 + hstep, voffB);
            PG8_WAIT_V(6); PG8_BAR; PG8_MMA(1, 1, At, B1); PG8_BAR;
            PG8_LDB(B0, 1, 0); PG8_SCHED; PG8_LDA(At, 1, 0); PG8_STA(PG8_SA(0, 1), 1, k2, last);
            PG8_WAIT_L(8); PG8_BAR; PG8_WAIT_L(0); PG8_MMA(0, 0, At, B0); PG8_BAR; PG8_SCHED;
            PG8_LDB(B1, 1, 1); PG8_STAGE(PG8_SB(1, 0), b3, voffB);
            PG8_BAR; PG8_WAIT_L(0); PG8_MMA(0, 1, At, B1); PG8_BAR;
            PG8_LDA(At, 1, 1); PG8_STA(PG8_SA(1, 0), 0, k3, last);
            PG8_BAR; PG8_WAIT_L(0); PG8_MMA(1, 0, At, B0); PG8_BAR; PG8_SCHED;
            PG8_STAGE(PG8_SB(1, 1), b3 + hstep, voffB);
            PG8_WAIT_V(6); PG8_BAR; PG8_MMA(1, 1, At, B1); PG8_BAR;
        }
        E(acc, cur, wid);
        if (!has_next) break;
#pragma unroll
        for (int a = 0; a < 2; ++a)
#pragma unroll
            for (int b = 0; b < 2; ++b)
#pragma unroll
                for (int m = 0; m < 4; ++m)
#pragma unroll
                    for (int n = 0; n < 2; ++n) acc[a][b][m][n] = (f32x4){0.f, 0.f, 0.f, 0.f};
        cur = nxt; cB = nB; cA = nA; ++ui;
        if constexpr (!DN) {
#pragma unroll
        for (int h = 0; h < 2; ++h)
#pragma unroll
            for (int i = 0; i < 2; ++i) cO[h][i] = nO[h][i]; }
    }
    PG8_WAIT_V(0);
    if (wr == 0) PG8_BAR;
    PG8_BAR;
#undef PG8_SA
#undef PG8_SB
#undef PG8_STAGE
#undef PG8_LDA
#undef PG8_LDB
#undef PG8_MMA
#undef PG8_WAIT_V
#undef PG8_WAIT_L
#undef PG8_BAR
#undef PG8_SCHED
#undef PG8_AOFF
#undef PG8_STA
}
}
struct DenseSched {
    static constexpr bool DENSE = true;
    int nM, nN, nwg, G, c, K; const char* Bt;
    __device__ __forceinline__ void init(int M, int N, int K_, const bf16_t* Bt_, int G_, int c_) { nM = M / 256; nN = N / 256; nwg = nM * nN; G = G_; c = c_; K = K_; Bt = (const char*)Bt_; }
    __device__ __forceinline__ bool next(int i, pg8::Unit& u) const {
        const long L = (long)i * G + c; if (L >= nwg) return false;
        int wgid = (int)L; { const int q = nwg / 8, r = nwg % 8, xcd = wgid % 8, off = wgid / 8; wgid = (xcd < r ? xcd * (q + 1) : r * (q + 1) + (xcd - r) * q) + off; }
        const int nig = 8 * nN, gid = wgid / nig, fm = gid * 8, gsz = (nM - fm) < 8 ? (nM - fm) : 8;
        u.pm = fm + ((wgid % nig) % gsz); u.pn = (wgid % nig) / gsz; u.e = 0; u.r0 = 0; return true;
    }
    __device__ __forceinline__ int a_row(const pg8::Unit& u, int r) const { return u.pm * 256 + r; }
    __device__ __forceinline__ const char* b_ptr(const pg8::Unit& u) const { return Bt + (size_t)u.pn * 256 * K * 2; }
};
template <bool GATHER> struct MoeSched {
    static constexpr bool DENSE = !GATHER;
    const LAS int* tstart; const LAS int* cnt; int nN, G, c, K, row_lo; const int* ltok; const char* Bt; size_t bstride;
    __device__ __forceinline__ bool next(int i, pg8::Unit& u) const {
        const long L = (long)i * G + c; const int ntile = __builtin_amdgcn_readfirstlane(tstart[NE1]); if (L >= (long)ntile * nN) return false;
        const int tile = (int)(L / nN); u.pn = (int)(L % nN);
        int e = 0;
#pragma unroll 1
        for (int step = 64; step >= 1; step >>= 1) { const int e2 = e + step; if (e2 <= NE && tstart[e2] <= tile) e = e2; }
        e = __builtin_amdgcn_readfirstlane(e); u.e = e; u.pm = __builtin_amdgcn_readfirstlane(tile); u.pn = __builtin_amdgcn_readfirstlane(u.pn); u.r0 = __builtin_amdgcn_readfirstlane((tile - tstart[e]) * 256); return true;
    }
    __device__ __forceinline__ int a_row(const pg8::Unit& u, int r) const {
        if (!GATHER) return u.pm * 256 + r;
        const int ri = u.r0 + r;
        if (u.e == NE) return ri < cnt[NE] ? row_lo + ri : row_lo;
        return ri < cnt[u.e] ? ltok[(size_t)u.e * ROWS + ri] : row_lo;
    }
    __device__ __forceinline__ const char* b_ptr(const pg8::Unit& u) const { return Bt + (size_t)u.e * bstride + (size_t)u.pn * 256 * K * 2; }
};

struct EpiProj {
    static constexpr bool PERM = true;
    bf16_t* O; int ldc;
    __device__ __forceinline__ void operator()(const f32x4 (&acc)[2][2][4][2], const pg8::Unit& u, const int wid) const {
        const int lane_ = lane_id_asm(), fr = lane_ & 15, fq = lane_ >> 4, wr = wid >> 2, wc = wid & 3;
        const int row0 = u.pm * 256 + wr * 64 + fr, col0 = u.pn * 256 + wc * 32 + 8 * fq;
#pragma unroll
        for (int ai = 0; ai < 2; ++ai)
#pragma unroll
            for (int m = 0; m < 4; ++m) { bf16_t* rowp = O + (size_t)(row0 + ai * 128 + m * 16) * ldc + col0;
#pragma unroll
                for (int bj = 0; bj < 2; ++bj) { const f32x4 v0 = acc[ai][bj][m][0], v1 = acc[ai][bj][m][1];
                    u32x4 w; w.x = pg8::cvt_pk_bf16(v0[0], v0[1]); w.y = pg8::cvt_pk_bf16(v0[2], v0[3]); w.z = pg8::cvt_pk_bf16(v1[0], v1[1]); w.w = pg8::cvt_pk_bf16(v1[2], v1[3]);
                    *(u32x4*)(rowp + bj * 128) = w; } }
    }
};
struct EpiRes {
    static constexpr bool PERM = false;
    const float* xsrc; const float* csrc; float* xdst; float* cdst; const float* gate;
    __device__ __forceinline__ void operator()(const f32x4 (&acc)[2][2][4][2], const pg8::Unit& u, const int wid) const {
        const int lane_ = lane_id_asm(), fr = lane_ & 15, fq = lane_ >> 4, wr = wid >> 2, wc = wid & 3;
        const int col0 = u.pn * 256 + wc * 32 + 4 * fq;
        const bool isc = u.pm < 4; const int sel = isc ? 4 : (u.pm - 4) >> 5;
        const float* src = isc ? csrc + (size_t)u.pm * 256 * D : xsrc + (size_t)(u.pm - 4) * 256 * D;
        float* dst = isc ? cdst + (size_t)u.pm * 256 * D : xdst + (size_t)(u.pm - 4) * 256 * D;
        f32x4 gv[2][2];
#pragma unroll
        for (int bj = 0; bj < 2; ++bj)
#pragma unroll
            for (int n = 0; n < 2; ++n) gv[bj][n] = *(const f32x4*)(gate + sel * 6144 + col0 + bj * 128 + n * 16);
#pragma unroll
        for (int ai = 0; ai < 2; ++ai)
#pragma unroll
            for (int m = 0; m < 4; ++m) { const size_t off = (size_t)(ai * 128 + wr * 64 + m * 16 + fr) * D + col0;
#pragma unroll
                for (int bj = 0; bj < 2; ++bj)
#pragma unroll
                    for (int n = 0; n < 2; ++n) { const f32x4 s = *(const f32x4*)(src + off + bj * 128 + n * 16); *(f32x4*)(dst + off + bj * 128 + n * 16) = s + gv[bj][n] * acc[ai][bj][m][n]; }
                asm volatile("" ::: "memory"); }
    }
};
struct EpiGU {
    static constexpr bool PERM = false;
    bf16_t* H;
    __device__ __forceinline__ void operator()(const f32x4 (&acc)[2][2][4][2], const pg8::Unit& u, const int wid) const {
        const int lane_ = lane_id_asm(), fr = lane_ & 15, fq = lane_ >> 4, wr = wid >> 2, wc = wid & 3;
        const int row0 = u.pm * 256 + wr * 64 + fr;
#pragma unroll
        for (int ai = 0; ai < 2; ++ai)
#pragma unroll
            for (int m = 0; m < 4; ++m) { bf16_t* rowp = H + (size_t)(row0 + ai * 128 + m * 16) * EH + 4 * fq;
#pragma unroll
                for (int bj = 0; bj < 2; ++bj) { const f32x4 g = acc[ai][bj][m][0], up = acc[ai][bj][m][1]; float h[4];
#pragma unroll
                    for (int j = 0; j < 4; ++j) h[j] = g[j] * rcp_(1.0f + __expf(-g[j])) * up[j];
                    u32x2 w; w.x = pg8::cvt_pk_bf16(h[0], h[1]); w.y = pg8::cvt_pk_bf16(h[2], h[3]);
                    *(u32x2*)(rowp + (u.pn * 256 + bj * 128 + wc * 32) / 2) = w; } }
    }
};
struct EpiY {
    static constexpr bool PERM = true;
    bf16_t* Y;
    __device__ __forceinline__ void operator()(const f32x4 (&acc)[2][2][4][2], const pg8::Unit& u, const int wid) const {
        const int lane_ = lane_id_asm(), fr = lane_ & 15, fq = lane_ >> 4, wr = wid >> 2, wc = wid & 3;
        const int row0 = u.pm * 256 + wr * 64 + fr, col0 = u.pn * 256 + wc * 32 + 8 * fq;
#pragma unroll
        for (int ai = 0; ai < 2; ++ai)
#pragma unroll
            for (int m = 0; m < 4; ++m) { bf16_t* rowp = Y + (size_t)(row0 + ai * 128 + m * 16) * 512 + col0;
#pragma unroll
                for (int bj = 0; bj < 2; ++bj) { const f32x4 v0 = acc[ai][bj][m][0], v1 = acc[ai][bj][m][1];
                    u32x4 w; w.x = pg8::cvt_pk_bf16(v0[0], v0[1]); w.y = pg8::cvt_pk_bf16(v0[2], v0[3]); w.z = pg8::cvt_pk_bf16(v1[0], v1[1]); w.w = pg8::cvt_pk_bf16(v1[2], v1[3]);
                    *(u32x4*)(rowp + bj * 128) = w; } }
    }
};
#define WSP(T, off) ((T*)(GAS T*)(p.ws + (unsigned long long)(off)))
#define POUT ((float*)(GAS float*)p.out)

constexpr int CONV_A_UNITS = 2048 + 512 + 64 + 8 + 12;
struct ConvDesc { const float* src; bf16_t* dst; int ldsrc, lddst, k0, n0, mode, nvalid; };
struct ConvDescA { int dummy;
    __device__ __forceinline__ ConvDesc operator()(const Cx& p, int u) const { ConvDesc c;
        if (u < 2048) { const int l = u >> 10, r = u & 1023; c.src = PIN(I_WIN) + (size_t)l * D * INW; c.ldsrc = INW; c.k0 = (r >> 6) * 64; c.n0 = (r & 63) * 64; c.nvalid = INW; c.dst = WSP(bf16_t, WS_WIN) + (size_t)l * NPROJ * D; c.lddst = D; c.mode = 0; }
        else if (u < 2560) { const int v = u - 2048, l = v >> 8, r = v & 255; c.src = PIN(I_WOUT) + (size_t)l * D * D; c.ldsrc = D; c.k0 = (r >> 4) * 64; c.n0 = (r & 15) * 64; c.nvalid = D; c.dst = WSP(bf16_t, WS_WOUT) + (size_t)l * D * D; c.lddst = D; c.mode = 0; }
        else if (u >= 2632) { const int v = u - 2632, m = v >> 2, r = v & 3;
            c.src = m < NL ? PIN(I_RW_W2) + (size_t)m * 64 * 256 : PIN(I_RW_AW2); c.ldsrc = 256; c.k0 = 0; c.n0 = r * 64; c.nvalid = 256; c.dst = WSP(bf16_t, WS_RWLR) + (size_t)m * 256 * 64; c.lddst = 64; c.mode = 0; }
        else if (u >= 2624) { const int v = u - 2624, l = v >> 2, r = v & 3;
            c.src = PIN(I_RW_GW2) + (size_t)l * 64 * 256; c.ldsrc = 256; c.k0 = 0; c.n0 = r * 64; c.nvalid = 256; c.dst = WSP(bf16_t, WS_RWGW) + (size_t)l * 256 * 64; c.lddst = 64; c.mode = 0; }
        else { const int v = u - 2560, l = v >> 5, lo = (v >> 4) & 1, r = v & 15;
            c.src = PIN(I_ROUT_W) + (size_t)l * D * NE; c.ldsrc = NE; c.k0 = r * 64; c.n0 = 0; c.nvalid = NE; c.dst = WSP(bf16_t, WS_ROUT) + (size_t)(l * 2 + lo) * NE * D; c.lddst = D; c.mode = lo ? 3 : 0; }
        return c; } };
constexpr int CONV_E_UNITS = NE1 * 192;
struct ConvDescE { int l;
    __device__ __forceinline__ ConvDesc operator()(const Cx& p, int u) const { ConvDesc c; const int e = u / 192, r = u % 192; c.nvalid = 1 << 30;
        if (r < 128) { const int up = r >> 6, q = r & 63;
            c.src = e < NE ? PIN(up ? I_EXP_U : I_EXP_G) + ((size_t)l * NE + e) * D * EH : PIN(up ? I_SH_U : I_SH_G) + (size_t)l * D * EH;
            c.ldsrc = EH; c.k0 = (q >> 2) * 64; c.n0 = (q & 3) * 64; c.dst = WSP(bf16_t, WS_EXPGU) + (size_t)e * 512 * D; c.lddst = D; c.mode = 1 + up; }
        else { const int q = r - 128;
            c.src = e < NE ? PIN(I_EXP_D) + ((size_t)l * NE + e) * EH * D : PIN(I_SH_D) + (size_t)l * EH * D;
            c.ldsrc = D; c.k0 = (q >> 4) * 64; c.n0 = (q & 15) * 64; c.dst = WSP(bf16_t, WS_EXPD) + (size_t)e * D * EH; c.lddst = EH; c.mode = 0; }
        return c; } };
template <class DescF> __device__ __forceinline__ void conv_run(const Cx& p, LAS float* tl, int total, const DescF& df) {
    const int t = p.tid; int u = p.bid; if (u >= total) return;
    float v[8]; ConvDesc c = df(p, u);
#define CONV_LD(cc) _Pragma("unroll") for (int j = 0; j < 8; ++j) { const int idx = t + NTHR * j, k = idx >> 6, n = idx & 63; v[j] = (cc).n0 + n < (cc).nvalid ? (cc).src[(size_t)((cc).k0 + k) * (cc).ldsrc + (cc).n0 + n] : 0.f; }
    CONV_LD(c)
    for (;;) {
#pragma unroll
        for (int j = 0; j < 8; ++j) { const int idx = t + NTHR * j; tl[(idx >> 6) * 65 + (idx & 63)] = v[j]; }
        __syncthreads();
        const int un = u + p.G; const bool more = un < total; const ConvDesc cn = df(p, more ? un : u);
        if (more) { CONV_LD(cn) }
#pragma unroll
        for (int j = 0; j < 4; ++j) { const int pi = t + NTHR * j, n = pi >> 5, k = (pi & 31) * 2; const int nn = c.n0 + n;
            const int row = (c.mode == 0 || c.mode == 3) ? nn : ((nn >> 4) * 32 + (nn & 15) + (c.mode == 2 ? 16 : 0));
            float v0 = tl[k * 65 + n], v1 = tl[(k + 1) * 65 + n];
            if (c.mode == 3) { v0 -= bf2f((bf16_t)f2bf(v0)); v1 -= bf2f((bf16_t)f2bf(v1)); }
            *(unsigned*)(c.dst + (size_t)row * c.lddst + c.k0 + k) = pk2(v0, v1); }
        __syncthreads();
        if (!more) break;
        c = cn; u = un;
    }
#undef CONV_LD
}
__device__ __forceinline__ void phase_mod(const Cx& p, LAS unsigned char* lds) {
    LAS float* sv = (LAS float*)lds; LAS float* red = sv + 5 * D;
    const int tid = p.tid;
    if (p.bid >= 192) return;
    for (int i = tid; i < 5 * D; i += NTHR) { const int j = i >> 10, k = i & 1023; const float c = j < 4 ? PIN(I_C)[j * D + k] : PIN(I_CCTX)[k]; sv[i] = siluf_(c); }
    __syncthreads();
    for (int u = p.bid; u < 192; u += p.G) {
        const int l = u / 96, cb = u % 96, kg = tid >> 6, cl = tid & 63;
        const float* w = PIN(I_WMOD) + (size_t)l * D * 6144 + cb * 64 + cl;
        float a0 = 0.f, a1 = 0.f, a2 = 0.f, a3 = 0.f, a4 = 0.f;
#pragma unroll 32
        for (int kk = 0; kk < 128; ++kk) { const int k = kg * 128 + kk; const float wv = w[(size_t)k * 6144];
            a0 += sv[k] * wv; a1 += sv[D + k] * wv; a2 += sv[2 * D + k] * wv; a3 += sv[3 * D + k] * wv; a4 += sv[4 * D + k] * wv; }
        red[(kg * 5 + 0) * 64 + cl] = a0; red[(kg * 5 + 1) * 64 + cl] = a1; red[(kg * 5 + 2) * 64 + cl] = a2; red[(kg * 5 + 3) * 64 + cl] = a3; red[(kg * 5 + 4) * 64 + cl] = a4;
        __syncthreads();
        if (tid < 320) { const int j = tid >> 6; float s = 0.f;
#pragma unroll
            for (int g = 0; g < 8; ++g) s += red[(g * 5 + j) * 64 + cl];
            WSP(float, WS_MOD)[((size_t)l * 5 + j) * 6144 + cb * 64 + cl] = s + PIN(I_BMOD)[l * 6144 + cb * 64 + cl]; }
        __syncthreads();
    }
}
__device__ __forceinline__ const float* res_row(const Cx& p, int layer_src0, int r) {
    if (r < CROWS) return (layer_src0 ? PIN(I_CTX) : (const float*)WSP(float, WS_CTXRES)) + (size_t)r * D;
    return (layer_src0 ? PIN(I_X) : (const float*)POUT) + (size_t)(r - CROWS) * D;
}
__device__ __forceinline__ int row_sel(int r) { return r < CROWS ? 4 : (r - CROWS) >> 13; }

__device__ __forceinline__ void norm_ld(const float* src, f32x4 (&v)[4], int lane) {
#pragma unroll
    for (int i = 0; i < 4; ++i) v[i] = *(const f32x4*)(src + 256 * i + 4 * lane);
}
__device__ __forceinline__ void norm_fin(const f32x4 (&v)[4], const float* g, const float* shift, const float* scale, bf16_t* dst, const bool tolds, LAS bf16_t* ldst, LAS bf16_t* ldlo, int lane) {
    float ss = 0.f;
#pragma unroll
    for (int i = 0; i < 4; ++i) ss += v[i][0] * v[i][0] + v[i][1] * v[i][1] + v[i][2] * v[i][2] + v[i][3] * v[i][3];
    ss = wsum(ss); const float rstd = rsq_(ss * (1.0f / D) + 1e-6f);
#pragma unroll
    for (int i = 0; i < 4; ++i) { const int col = 256 * i + 4 * lane; const f32x4 gv = *(const f32x4*)(g + col), sh = *(const f32x4*)(shift + col), sc = *(const f32x4*)(scale + col);
        const f32x4 y = v[i] * rstd * gv * (sc + 1.0f) + sh; u32x2 w; w.x = pk2(y[0], y[1]); w.y = pk2(y[2], y[3]);
        *(u32x2*)(dst + col) = w;
        if (tolds) { *(LAS u32x2*)(ldst + col) = w; u32x2 wl;
            wl.x = pk2(y[0] - __uint_as_float(w.x << 16), y[1] - __uint_as_float(w.x & 0xffff0000u)); wl.y = pk2(y[2] - __uint_as_float(w.y << 16), y[3] - __uint_as_float(w.y & 0xffff0000u));
            *(LAS u32x2*)(ldlo + col) = wl; } }
}
struct ModC { int s; f32x4 A[4], B[4];
    __device__ __forceinline__ void load(const float* g, const float* shift, const float* scale, int s_, int lane) { s = s_;
#pragma unroll
        for (int i = 0; i < 4; ++i) { const int col = 256 * i + 4 * lane; A[i] = *(const f32x4*)(g + col) * (*(const f32x4*)(scale + col) + 1.0f); B[i] = *(const f32x4*)(shift + col); } } };
__device__ __forceinline__ void norm_fin2(const f32x4 (&v)[4], const ModC& mc, bf16_t* dst, const bool tolds, LAS bf16_t* ldst, LAS bf16_t* ldlo, int lane) {
    float ss = 0.f;
#pragma unroll
    for (int i = 0; i < 4; ++i) ss += v[i][0] * v[i][0] + v[i][1] * v[i][1] + v[i][2] * v[i][2] + v[i][3] * v[i][3];
    ss = wsum(ss); const float rstd = rsq_(ss * (1.0f / D) + 1e-6f);
#pragma unroll
    for (int i = 0; i < 4; ++i) { const int col = 256 * i + 4 * lane;
        const f32x4 y = v[i] * rstd * mc.A[i] + mc.B[i]; u32x2 w; w.x = pk2(y[0], y[1]); w.y = pk2(y[2], y[3]);
        *(u32x2*)(dst + col) = w;
        if (tolds) { *(LAS u32x2*)(ldst + col) = w; u32x2 wl;
            wl.x = pk2(y[0] - __uint_as_float(w.x << 16), y[1] - __uint_as_float(w.x & 0xffff0000u)); wl.y = pk2(y[2] - __uint_as_float(w.y << 16), y[3] - __uint_as_float(w.y & 0xffff0000u));
            *(LAS u32x2*)(ldlo + col) = wl; } }
}
__device__ __forceinline__ void phase_norm1(const Cx& p, int layer) {
    const int lane = p.tid & 63, wave = p.tid >> 6;
    const float* mod = WSP(float, WS_MOD) + (size_t)layer * 5 * 6144; const float* g = PIN(I_N1G) + layer * D; bf16_t* hb = WSP(bf16_t, WS_HBUF);
    ModC mc; mc.s = -1; f32x4 n0[4], n1[4];
    int r = p.bid * 16 + wave * 2;
    if (r < ROWS) { norm_ld(res_row(p, layer == 0, r), n0, lane); norm_ld(res_row(p, layer == 0, r + 1), n1, lane); }
    for (; r < ROWS; r += p.G * 16) { f32x4 v0[4], v1[4];
#pragma unroll
        for (int i = 0; i < 4; ++i) { v0[i] = n0[i]; v1[i] = n1[i]; }
        const int rn = r + p.G * 16; if (rn < ROWS) { norm_ld(res_row(p, layer == 0, rn), n0, lane); norm_ld(res_row(p, layer == 0, rn + 1), n1, lane); }
        const int s = row_sel(r); if (s != mc.s) mc.load(g, mod + s * 6144 + 0, mod + s * 6144 + 1024, s, lane);
        norm_fin2(v0, mc, hb + (size_t)r * D, false, (LAS bf16_t*)0, (LAS bf16_t*)0, lane);
        norm_fin2(v1, mc, hb + (size_t)(r + 1) * D, false, (LAS bf16_t*)0, (LAS bf16_t*)0, lane); }
}
__device__ __forceinline__ float sum8_(float v) { v += DPPF(v, 0xB1); v += DPPF(v, 0x4E); v += DPPF(v, 0x141); return v; }
__device__ __forceinline__ float sum16_(float v) { v = sum8_(v); v += DPPF(v, 0x140); return v; }
__device__ __forceinline__ void bf8_to_f(const u32x4 w, float (&f)[8]) {
#pragma unroll
    for (int q = 0; q < 4; ++q) { f[2 * q] = __uint_as_float(w[q] << 16); f[2 * q + 1] = __uint_as_float(w[q] & 0xffff0000u); } }
__device__ __forceinline__ void phase_prep(const Cx& p, LAS unsigned char* lds, int layer, int b) {
    const int lane = p.tid & 63, wave = __builtin_amdgcn_readfirstlane(p.tid >> 6);
    const bf16_t* proj = WSP(bf16_t, WS_PROJ);
    const int e0 = p.bid * NTHR + p.tid, e1 = e0 + p.G * NTHR; bf16_t sq0 = 0, sq1 = 0;
#define SCAL_COL(q) ((q) < 8 ? PC_DF + (q) : (q) < 16 ? PD_BF + ((q) - 8) : PD_AF + ((q) - 16))
    if (e0 < SB * 24) sq0 = proj[(size_t)tok_row(b, e0 / 24) * NPROJ + SCAL_COL(e0 % 24)];
    if (e1 < SB * 24) sq1 = proj[(size_t)tok_row(b, e1 / 24) * NPROJ + SCAL_COL(e1 % 24)];
    if (p.bid < SB / 33) {
        constexpr int ATS = 208;
        LAS unsigned char* WWt = lds; LAS unsigned char* AWt = lds + 256 * 144; LAS unsigned char* At = lds + 2 * 256 * 144;
        { const bf16_t* w2c = WSP(bf16_t, WS_RWLR) + (size_t)layer * 256 * 64; const bf16_t* awc = WSP(bf16_t, WS_RWLR) + (size_t)NL * 256 * 64;
#pragma unroll
          for (int q = 0; q < 4; ++q) { const int e = p.tid + NTHR * q, n = e >> 3, ch = e & 7;
              *(LAS u32x4*)(WWt + n * 144 + ch * 16) = *(const u32x4*)(w2c + n * 64 + ch * 8); *(LAS u32x4*)(AWt + n * 144 + ch * 16) = *(const u32x4*)(awc + n * 64 + ch * 8); } }
        const int h = wave & 3, half = wave >> 2, fr = lane & 15, fq = lane >> 4;
        float a0c[4], w0fc[4], w0bc[4], kkc[4], kac[4];
#pragma unroll
        for (int nt = 0; nt < 4; ++nt) { const int c = 64 * h + 16 * nt + fr; a0c[nt] = PIN(I_RW_A0)[layer * 256 + c]; w0fc[nt] = PIN(I_RW_W0)[(layer * 2 + 0) * 256 + c]; w0bc[nt] = PIN(I_RW_W0)[(layer * 2 + 1) * 256 + c];
            kkc[nt] = PIN(I_RW_KK)[layer * 256 + c]; kac[nt] = PIN(I_RW_KA)[layer * 256 + c]; }
        for (int u = p.bid; u < SB / 33; u += p.G) {
            if (p.tid < 33 * 12) { const int tk = p.tid / 12, ch = p.tid % 12; u32x4 w = *(const u32x4*)(proj + (size_t)tok_row(b, u * 33 + tk) * NPROJ + PB_WF + 8 * ch);
                if (ch < 8) {
#pragma unroll
                    for (int q = 0; q < 4; ++q) w[q] = pk2(tanhf_(__uint_as_float(w[q] << 16)), tanhf_(__uint_as_float(w[q] & 0xffff0000u))); }
                *(LAS u32x4*)(At + tk * ATS + ch * 16) = w; }
            bf16_t kvA[4][4], kvB[4];
#pragma unroll
            for (int j = 0; j < 4; ++j) { const bf16_t* pr = proj + (size_t)tok_row(b, u * 33 + 16 * half + 4 * fq + j) * NPROJ + PB_K + 64 * h + fr;
#pragma unroll
                for (int nt = 0; nt < 4; ++nt) kvA[nt][j] = pr[16 * nt]; }
            { const bf16_t* pr = proj + (size_t)tok_row(b, u * 33 + 32) * NPROJ + PB_K + 64 * h + fr;
#pragma unroll
              for (int nt = 0; nt < 4; ++nt) kvB[nt] = pr[16 * nt]; }
            __syncthreads();
#pragma unroll
            for (int pass = 0; pass < 2; ++pass) { if (pass == 1 && half != 0) break;
                const int mt = pass ? 2 : half; f32x4 sa[4], sf[4], sb[4];
                const bf16x8 awf = *(const LAS bf16x8*)(At + (16 * mt + fr) * ATS + fq * 16), awb = *(const LAS bf16x8*)(At + (16 * mt + fr) * ATS + 64 + fq * 16), aa = *(const LAS bf16x8*)(At + (16 * mt + fr) * ATS + 128 + fq * 16);
#pragma unroll
                for (int nt = 0; nt < 4; ++nt) { const int n = 64 * h + 16 * nt + fr; const f32x4 z = (f32x4){0.f, 0.f, 0.f, 0.f};
                    sf[nt] = __builtin_amdgcn_mfma_f32_16x16x32_bf16(awf, *(const LAS bf16x8*)(WWt + n * 144 + fq * 16), z, 0, 0, 0);
                    sb[nt] = __builtin_amdgcn_mfma_f32_16x16x32_bf16(awb, *(const LAS bf16x8*)(WWt + n * 144 + 64 + fq * 16), z, 0, 0, 0);
                    sa[nt] = __builtin_amdgcn_mfma_f32_16x16x32_bf16(aa, *(const LAS bf16x8*)(AWt + n * 144 + layer * 64 + fq * 16), z, 0, 0, 0); }
#pragma unroll
                for (int j = 0; j < 4; ++j) { if (pass == 1 && j > 0) break;
                    const int tk = 16 * mt + 4 * fq + j; const bool valid = tk < 33; const int s = u * 33 + tk;
                    float kv[4], kr[4], ssq = 0.f;
#pragma unroll
                    for (int nt = 0; nt < 4; ++nt) { kv[nt] = bf2f(pass ? kvB[nt] : kvA[nt][j]); kr[nt] = kv[nt] * kkc[nt]; ssq += kr[nt] * kr[nt]; }
                    const float rs = rsq_(sum16_(ssq) + 1e-6f);
#pragma unroll
                    for (int nt = 0; nt < 4; ++nt) { const float a = sigmoidf_(sa[nt][j] + a0c[nt]);
                        const float lwf = -__expf(-softplusf_(-(sf[nt][j] + w0fc[nt])) - 0.5f), lwb = -__expf(-softplusf_(-(sb[nt][j] + w0bc[nt])) - 0.5f);
                        const float kk = kr[nt] * rs; const size_t o = (size_t)s * 256 + 64 * h + 16 * nt + fr;
                        if (valid) { WSP(float, SC_RK)[o] = kv[nt] * (1.0f + (a - 1.0f) * kac[nt]); WSP(float, SC_RKK)[o] = kk; WSP(float, SC_RB)[o] = kk * a;
                            WSP(float, SC_RLW)[o] = lwf; WSP(float, SC_RLW)[(size_t)SB * 256 + o] = lwb; } } } }
            __syncthreads();
        }
    }
    __syncthreads();
    { LAS bf16_t* T = (LAS bf16_t*)lds; const int tid = p.tid; const float* dncw = PIN(I_DN_CW); const float* sscw = PIN(I_SS_CW); const float* sscb = PIN(I_SS_CB);
#define PC_LOAD(uu, v, vh) do { const int mixer_ = (uu) / (NTB * 3), r2_ = (uu) % (NTB * 3), rb_ = r2_ / 3, colbase_ = (mixer_ ? PD_Q : PC_X) + 256 * (r2_ % 3); \
          _Pragma("unroll") for (int q = 0; q < 12; ++q) { const int e = tid + NTHR * q, rr = e >> 11, tok = (e >> 5) & 63, ch = (e & 31) * 8; v[q] = (u32x4){0u, 0u, 0u, 0u}; \
              if (rb_ < 4) { if (rr == 1) v[q] = *(const u32x4*)(proj + (size_t)(b * NCTX + 64 * rb_ + tok) * NPROJ + colbase_ + ch); } \
              else { const int gr = rb_ - 4 + rr - 1; if (gr >= 0 && gr < GRIDH) v[q] = *(const u32x4*)(proj + (size_t)(CROWS + b * SEQ + gr * 64 + tok) * NPROJ + colbase_ + ch); } } \
          vh = (u32x4){0u, 0u, 0u, 0u}; if (tid < 192) { const int rr = tid >> 6, side = (tid >> 5) & 1, ch = (tid & 31) * 8;       \
              if (rb_ < 4 && rr == 1) { const int tk = side ? 64 * (rb_ + 1) : 64 * rb_ - 1; if (tk >= 0 && tk < NCTX) vh = *(const u32x4*)(proj + (size_t)(b * NCTX + tk) * NPROJ + colbase_ + ch); } } \
          { const int chn_ = 256 * (r2_ % 3) + (tid & 255); const float* cw_ = (mixer_ ? dncw : sscw) + (size_t)layer * 9 * 768 + chn_;        \
            _Pragma("unroll") for (int k = 0; k < 9; ++k) w[k] = cw_[k * 768]; bias = mixer_ ? 0.f : sscb[layer * 768 + chn_]; } } while (0)
      int u = p.bid;
      if (u < 2 * NTB * 3) { u32x4 v[12], vh; float w[9], bias; PC_LOAD(u, v, vh);
        for (;;) { const int mixer = u / (NTB * 3), r2 = u % (NTB * 3), rb = r2 / 3, third = r2 % 3;
#pragma unroll
          for (int q = 0; q < 12; ++q) { const int e = tid + NTHR * q, rr = e >> 11, tok = (e >> 5) & 63, ch = (e & 31) * 8; *(LAS u32x4*)(T + (rr * 66 + tok + 1) * 256 + ch) = v[q]; }
          if (tid < 192) { const int rr = tid >> 6, side = (tid >> 5) & 1, ch = (tid & 31) * 8; *(LAS u32x4*)(T + (rr * 66 + (side ? 65 : 0)) * 256 + ch) = vh; }
          __syncthreads();
          const int un = u + p.G; const bool more = un < 2 * NTB * 3;
          float wc[9]; const float bc = bias;
#pragma unroll
          for (int k = 0; k < 9; ++k) wc[k] = w[k];
          if (more) PC_LOAD(un, v, vh);
          { const int c = tid & 255, th = tid >> 8, chn = 256 * third + c;
            bf16_t* dst = (mixer ? WSP(bf16_t, SC_DQ) : WSP(bf16_t, SC_SX)) + (size_t)(64 * rb) * 768 + chn;
#pragma unroll 2
            for (int tk = 0; tk < 32; ++tk) { const int x = 32 * th + tk; float acc = bc;
#pragma unroll
                for (int dy = 0; dy < 3; ++dy)
#pragma unroll
                    for (int dx = 0; dx < 3; ++dx) acc += wc[dy * 3 + dx] * bf2f(T[(dy * 66 + x + dx) * 256 + c]);
                float y = siluf_(acc);
                if (mixer && third < 2) { const float ss = wsum(y * y); y *= rsq_(ss + 1e-6f); if (third == 0) y *= 0.125f; }
                dst[(size_t)x * 768] = (bf16_t)f2bf(y); } }
          __syncthreads();
          if (!more) break;
          u = un; } }
#undef PC_LOAD
#define SCAL_FIN(e_, raw_) do { const int s = (e_) / 24, q = (e_) % 24; const float xv = bf2f(raw_); \
          if (q < 8) { const int d = q >> 2, h = q & 3; WSP(float, SC_SDT)[(size_t)s * 8 + q] = softplusf_(xv + PIN(I_SS_DTB)[(layer * 2 + d) * 4 + h]); } \
          else if (q < 16) { WSP(float, SC_DG)[(size_t)s * 16 + (q - 8)] = sigmoidf_(xv); } \
          else { const int q2 = q - 16, d = q2 >> 2, h = q2 & 3; WSP(float, SC_DG)[(size_t)s * 16 + 8 + q2] = -__expf(PIN(I_DN_ALOG)[(layer * 2 + d) * 4 + h]) * softplusf_(xv + PIN(I_DN_DTB)[(layer * 2 + d) * 4 + h]); } } while (0)
      if (e0 < SB * 24) SCAL_FIN(e0, sq0);
      if (e1 < SB * 24) SCAL_FIN(e1, sq1);
      for (int e = e1 + p.G * NTHR; e < SB * 24; e += p.G * NTHR) { const bf16_t raw = proj[(size_t)tok_row(b, e / 24) * NPROJ + SCAL_COL(e % 24)]; SCAL_FIN(e, raw); }
#undef SCAL_FIN
#undef SCAL_COL
    }
}
__device__ __forceinline__ void phase_scan(const Cx& p, LAS unsigned char* lds, int layer, int b);
__device__ __forceinline__ void phase_post(const Cx& p, LAS unsigned char* lds, int layer, int b) {
    const int tid = p.tid, tsub = tid >> 7, c8 = (tid & 127) * 8, mixer = c8 >> 8, cm = c8 & 255, hh = cm >> 6;
    const bf16_t* proj = WSP(bf16_t, WS_PROJ); const bf16_t* of = WSP(bf16_t, SC_OF); const bf16_t* obk = WSP(bf16_t, SC_OB); bf16_t* yc = WSP(bf16_t, WS_HBUF);
    constexpr int PTS = 144, GTS = 260;
    LAS unsigned char* GWb = lds; LAS unsigned char* SGb = lds + 256 * PTS; LAS float* GT = (LAS float*)(lds + 256 * PTS + 48 * PTS);
    if ((int)p.bid < SB / 33) { const bf16_t* gsrc = WSP(bf16_t, WS_RWGW) + (size_t)layer * 256 * 64;
#pragma unroll
        for (int q = 0; q < 4; ++q) { const int e = tid + NTHR * q, n = e >> 3, ch = e & 7; *(LAS u32x4*)(GWb + n * PTS + ch * 16) = *(const u32x4*)(gsrc + n * 64 + ch * 8); } }
    float g0[8], g1[8], g2[8];
#pragma unroll
    for (int q = 0; q < 8; ++q) { const int c = cm + q; g0[q] = 0.f; g1[q] = 0.f; g2[q] = 0.f;
        if (mixer == 0) g0[q] = PIN(I_GLA_NG)[layer * 256 + c];
        else if (mixer == 1) { g0[q] = PIN(I_RW_LNG)[layer * 256 + c]; g1[q] = PIN(I_RW_LNB)[layer * 256 + c]; g2[q] = PIN(I_RW_RK)[layer * 256 + c]; }
        else if (mixer == 2) { g0[q] = PIN(I_SS_NG)[layer * 256 + c]; g1[q] = PIN(I_SS_D)[layer * 4 + hh]; }
        else g0[q] = PIN(I_DN_NG)[layer * 256 + c]; }
    const int col1 = (mixer == 0 ? PA_G : mixer == 1 ? PB_R : mixer == 2 ? PC_Z : PD_Z) + cm;
    for (int u = p.bid; u < SB / 33; u += p.G) {
        if (tid < 33 * 8) { const int tk = tid >> 3, ch = tid & 7; float gl[8]; bf8_to_f(*(const u32x4*)(proj + (size_t)tok_row(b, u * 33 + tk) * NPROJ + PB_G + 8 * ch), gl);
            *(LAS u32x4*)(SGb + tk * PTS + ch * 16) = (u32x4){pk2(sigmoidf_(gl[0]), sigmoidf_(gl[1])), pk2(sigmoidf_(gl[2]), sigmoidf_(gl[3])), pk2(sigmoidf_(gl[4]), sigmoidf_(gl[5])), pk2(sigmoidf_(gl[6]), sigmoidf_(gl[7]))}; }
        u32x4 rof, rob, ra1, ra2 = (u32x4){0u, 0u, 0u, 0u}; f32x4 rk0 = (f32x4){0.f, 0.f, 0.f, 0.f}, rk1 = rk0;
#define POST_LOAD(t0_) do { const int tk_ = (t0_) + tsub; const int s_ = u * 33 + (tk_ < 33 ? tk_ : 32); const bf16_t* pr_ = proj + (size_t)tok_row(b, s_) * NPROJ; \
        rof = *(const u32x4*)(of + (size_t)s_ * 1024 + c8); rob = *(const u32x4*)(obk + (size_t)s_ * 1024 + c8); ra1 = *(const u32x4*)(pr_ + col1); \
        if (mixer == 1) { ra2 = *(const u32x4*)(pr_ + PB_V + cm); rk0 = *(const f32x4*)(WSP(float, SC_RK) + (size_t)s_ * 256 + cm); rk1 = *(const f32x4*)(WSP(float, SC_RK) + (size_t)s_ * 256 + cm + 4); } \
        else if (mixer == 2) ra2 = *(const u32x4*)(WSP(bf16_t, SC_SX) + (size_t)s_ * 768 + cm); } while (0)
        POST_LOAD(0);
        __syncthreads();
        { const int lane = tid & 63, wave = tid >> 6, fr = lane & 15, fq = lane >> 4; f32x4 acc[3][2];
#pragma unroll
          for (int mt = 0; mt < 3; ++mt) { acc[mt][0] = (f32x4){0.f, 0.f, 0.f, 0.f}; acc[mt][1] = (f32x4){0.f, 0.f, 0.f, 0.f}; }
#pragma unroll
          for (int ks = 0; ks < 2; ++ks) { bf16x8 bb[2];
#pragma unroll
              for (int nt = 0; nt < 2; ++nt) bb[nt] = *(const LAS bf16x8*)(GWb + (16 * (2 * wave + nt) + fr) * PTS + ks * 64 + fq * 16);
#pragma unroll
              for (int mt = 0; mt < 3; ++mt) { const bf16x8 a = *(const LAS bf16x8*)(SGb + (16 * mt + fr) * PTS + ks * 64 + fq * 16);
                  acc[mt][0] = __builtin_amdgcn_mfma_f32_16x16x32_bf16(a, bb[0], acc[mt][0], 0, 0, 0); acc[mt][1] = __builtin_amdgcn_mfma_f32_16x16x32_bf16(a, bb[1], acc[mt][1], 0, 0, 0); } }
#pragma unroll
          for (int mt = 0; mt < 3; ++mt)
#pragma unroll
              for (int nt = 0; nt < 2; ++nt)
#pragma unroll
                  for (int j = 0; j < 4; ++j) GT[(16 * mt + 4 * fq + j) * GTS + 16 * (2 * wave + nt) + fr] = acc[mt][nt][j]; }
        __syncthreads();
#pragma unroll 1
        for (int t0 = 0; t0 < 36; t0 += 4) { const int tk = t0 + tsub; const bool live = tk < 33; const int tkc = live ? tk : 32, s = u * 33 + tkc, row = tok_row(b, s);
            const u32x4 cof = rof, cob = rob, ca1 = ra1, ca2 = ra2; const f32x4 k0 = rk0, k1 = rk1;
            if (t0 + 4 < 36) POST_LOAD(t0 + 4);
            float o[8], a[8], y[8];
            { float t1[8], t2[8]; bf8_to_f(cof, t1); bf8_to_f(cob, t2);
#pragma unroll
              for (int q = 0; q < 8; ++q) o[q] = t1[q] + t2[q]; }
            bf8_to_f(ca1, a);
            if (mixer == 0 || mixer == 3) { float ss = 0.f;
#pragma unroll
                for (int q = 0; q < 8; ++q) ss += o[q] * o[q];
                const float rs = rsq_(sum8_(ss) * (1.0f / 64.0f) + 1e-6f);
#pragma unroll
                for (int q = 0; q < 8; ++q) y[q] = o[q] * rs * g0[q] * siluf_(a[q]);
            } else if (mixer == 2) { float xs[8]; bf8_to_f(ca2, xs); float ss = 0.f;
#pragma unroll
                for (int q = 0; q < 8; ++q) { y[q] = (o[q] + g1[q] * xs[q]) * siluf_(a[q]); ss += y[q] * y[q]; }
                const float rs = rsq_(sum16_(ss) * (1.0f / 128.0f) + 1e-6f);
#pragma unroll
                for (int q = 0; q < 8; ++q) y[q] *= rs * g0[q];
            } else { float vv[8]; bf8_to_f(ca2, vv);
                float su = 0.f, bo = 0.f;
#pragma unroll
                for (int q = 0; q < 8; ++q) { su += o[q]; bo += a[q] * (q < 4 ? k0[q & 3] : k1[q & 3]) * g2[q]; }
                const float mu = sum8_(su) * (1.0f / 64.0f); bo = sum8_(bo); float va = 0.f;
#pragma unroll
                for (int q = 0; q < 8; ++q) { o[q] -= mu; va += o[q] * o[q]; }
                const float rs = rsq_(sum8_(va) * (1.0f / 64.0f) + 64e-5f);
                const f32x4 gt0 = *(const LAS f32x4*)(GT + tkc * GTS + cm), gt1 = *(const LAS f32x4*)(GT + tkc * GTS + cm + 4);
#pragma unroll
                for (int q = 0; q < 8; ++q) y[q] = (o[q] * rs * g0[q] + g1[q] + bo * vv[q]) * (q < 4 ? gt0[q & 3] : gt1[q & 3]); }
            if (live) *(u32x4*)(yc + (size_t)row * D + c8) = (u32x4){pk2(y[0], y[1]), pk2(y[2], y[3]), pk2(y[4], y[5]), pk2(y[6], y[7])};
        }
#undef POST_LOAD
    }
}
constexpr int N2_TILE = 32, N2_STRIDE = 2064;
__device__ __forceinline__ void phase_norm2(const Cx& p, LAS unsigned char* lds, int layer, int row_lo) {
    const int tid = p.tid, lane = tid & 63, wave = __builtin_amdgcn_readfirstlane(tid >> 6), fr = lane & 15, fq = lane >> 4;
    const float* mod = WSP(float, WS_MOD) + (size_t)layer * 5 * 6144; const float* g = PIN(I_N2G) + layer * D; bf16_t* hb = WSP(bf16_t, WS_HBUF);
    const bf16_t* rt = WSP(bf16_t, WS_ROUT) + (size_t)layer * 2 * NE * D;
    LAS float* lg = (LAS float*)(lds + 2 * N2_TILE * N2_STRIDE);
    unsigned* cnt = WSP(unsigned, WS_CTL) + CW_CNT + layer * 80 * 16; int* ltok = WSP(int, WS_LTOK); int* tokt = WSP(int, WS_TOKT);
    const float rbias = PIN(I_ROUT_B)[layer * NE + lane];
    const int nun = (ROWS - row_lo) / N2_TILE;
    ModC mc; mc.s = -1; f32x4 n0[4], n1[4], n2[4], n3[4];
    if ((int)p.bid < nun) { const int r = row_lo + p.bid * N2_TILE + 4 * wave; norm_ld(res_row(p, 0, r), n0, lane); norm_ld(res_row(p, 0, r + 1), n1, lane); norm_ld(res_row(p, 0, r + 2), n2, lane); norm_ld(res_row(p, 0, r + 3), n3, lane); }
    for (int u = p.bid; u < nun; u += p.G) { const int r0 = row_lo + u * N2_TILE;
        { const int tr = 4 * wave, r = r0 + tr;
          const int s = row_sel(r); if (s != mc.s) mc.load(g, mod + s * 6144 + 3072, mod + s * 6144 + 4096, s, lane);
          norm_fin2(n0, mc, hb + (size_t)r * D, true, (LAS bf16_t*)(lds + tr * N2_STRIDE), (LAS bf16_t*)(lds + N2_TILE * N2_STRIDE + tr * N2_STRIDE), lane);
          norm_fin2(n1, mc, hb + (size_t)(r + 1) * D, true, (LAS bf16_t*)(lds + (tr + 1) * N2_STRIDE), (LAS bf16_t*)(lds + N2_TILE * N2_STRIDE + (tr + 1) * N2_STRIDE), lane);
          norm_fin2(n2, mc, hb + (size_t)(r + 2) * D, true, (LAS bf16_t*)(lds + (tr + 2) * N2_STRIDE), (LAS bf16_t*)(lds + N2_TILE * N2_STRIDE + (tr + 2) * N2_STRIDE), lane);
          norm_fin2(n3, mc, hb + (size_t)(r + 3) * D, true, (LAS bf16_t*)(lds + (tr + 3) * N2_STRIDE), (LAS bf16_t*)(lds + N2_TILE * N2_STRIDE + (tr + 3) * N2_STRIDE), lane); }
        __syncthreads();
        { const int mt = wave >> 2, nt = wave & 3; f32x4 acc = (f32x4){0.f, 0.f, 0.f, 0.f};
          const LAS unsigned char* ap = lds + (16 * mt + fr) * N2_STRIDE + fq * 16; const bf16_t* bp = rt + (size_t)(16 * nt + fr) * D + fq * 8;
#pragma unroll 8
          for (int ks = 0; ks < 32; ++ks) { const bf16x8 a = *(const LAS bf16x8*)(ap + ks * 64), al = *(const LAS bf16x8*)(ap + N2_TILE * N2_STRIDE + ks * 64);
              const bf16x8 bb = *(const bf16x8*)(bp + ks * 32), bl = *(const bf16x8*)(bp + NE * D + ks * 32);
              acc = __builtin_amdgcn_mfma_f32_16x16x32_bf16(a, bb, acc, 0, 0, 0); acc = __builtin_amdgcn_mfma_f32_16x16x32_bf16(al, bb, acc, 0, 0, 0); acc = __builtin_amdgcn_mfma_f32_16x16x32_bf16(a, bl, acc, 0, 0, 0); }
#pragma unroll
          for (int j = 0; j < 4; ++j) lg[(16 * mt + 4 * fq + j) * 64 + 16 * nt + fr] = acc[j]; }
        __syncthreads();
        { const int un = u + p.G; if (un < nun) { const int rn = row_lo + un * N2_TILE + 4 * wave; norm_ld(res_row(p, 0, rn), n0, lane); norm_ld(res_row(p, 0, rn + 1), n1, lane); norm_ld(res_row(p, 0, rn + 2), n2, lane); norm_ld(res_row(p, 0, rn + 3), n3, lane); } }
#pragma unroll 1
        for (int i = 0; i < 4; ++i) { const int tr = 4 * wave + i, r = r0 + tr;
            const float sc = sigmoidf_(lg[tr * 64 + lane]); float sel = sc + rbias; float ssum = 0.f; int myE = 0; float myS = 0.f;
#pragma unroll 1
            for (int k = 0; k < TOPK; ++k) { float bv = sel; int bi = lane;
#define ARGSTEP(OV, OI) do { const float ov_ = (OV); const int oi_ = (OI); if (ov_ > bv || (ov_ == bv && oi_ < bi)) { bv = ov_; bi = oi_; } } while (0)
                ARGSTEP(DPPF(bv, 0xB1), DPPI(bi, 0xB1)); ARGSTEP(DPPF(bv, 0x4E), DPPI(bi, 0x4E)); ARGSTEP(DPPF(bv, 0x141), DPPI(bi, 0x141)); ARGSTEP(DPPF(bv, 0x140), DPPI(bi, 0x140));
                ARGSTEP(__uint_as_float(__builtin_amdgcn_ds_swizzle(__float_as_uint(bv), 0x401F)), __builtin_amdgcn_ds_swizzle(bi, 0x401F));
                { const float v0 = rl(bv, 0), v1 = rl(bv, 32); const int i0 = __builtin_amdgcn_readlane(bi, 0), i1 = __builtin_amdgcn_readlane(bi, 32); if (v1 > v0 || (v1 == v0 && i1 < i0)) { bv = v1; bi = i1; } else { bv = v0; bi = i0; } }
#undef ARGSTEP
                const int e = __builtin_amdgcn_readfirstlane(bi); const float se = rl(sc, e);
                ssum += se; if (lane == k) { myE = e; myS = se; } if (lane == e) sel = -1e30f; }
            if (lane < TOPK) { const unsigned pos = atomicAdd(cnt + myE * 16, 1u); ltok[(size_t)myE * ROWS + pos] = r; tokt[(size_t)r * 16 + lane] = (myE << 16) | (int)pos; ((float*)tokt)[(size_t)r * 16 + 8 + lane] = myS / ssum * 2.5f; } }
        __syncthreads();
    }
}
__device__ __forceinline__ void moe_table(const Cx& p, LAS int* tb, int layer, int row_lo) {
    const unsigned* cnt = WSP(unsigned, WS_CTL) + CW_CNT + layer * 80 * 16;
    if (p.tid < 64) { const int lane = p.tid;
        const int c = (int)__hip_atomic_load(cnt + lane * 16, __ATOMIC_RELAXED, __HIP_MEMORY_SCOPE_AGENT); const int t = (c + 255) >> 8; int incl = t;
#pragma unroll
        for (int o = 1; o < 64; o <<= 1) { const int v = __builtin_amdgcn_ds_bpermute((lane - o) << 2, incl); if (lane >= o) incl += v; }
        tb[lane] = c; tb[128 + lane] = incl - t;
        if (lane == 63) { const int cs = ROWS - row_lo; tb[NE] = cs; tb[128 + NE] = incl; tb[128 + NE1] = incl + ((cs + 255) >> 8); } }
    __syncthreads();
}
__device__ __forceinline__ void phase_combine(const Cx& p, const LAS int* tb, int layer, int row_lo, int half) {
    const int lane = p.tid & 63, wave = p.tid >> 6; const bf16_t* Y = WSP(bf16_t, WS_Y); const int* tokt = WSP(int, WS_TOKT);
    const float* gate = WSP(float, WS_MOD) + (size_t)layer * 5 * 6144 + 5120; const int col = 512 * half + 8 * lane; const int shbase = tb[128 + NE] * 256;
#pragma unroll 2
    for (int r = row_lo + p.bid * 8 + wave; r < ROWS; r += p.G * 8) {
        const int sw = lane < 16 ? tokt[(size_t)r * 16 + lane] : 0;
        float a[8];
        { const u32x4 y = *(const u32x4*)(Y + (size_t)(shbase + (r - row_lo)) * 512 + 8 * lane);
#pragma unroll
          for (int q = 0; q < 4; ++q) { a[2 * q] = __uint_as_float(y[q] << 16); a[2 * q + 1] = __uint_as_float(y[q] & 0xffff0000u); } }
#pragma unroll
        for (int k = 0; k < 8; ++k) { const int sl = __builtin_amdgcn_readlane(sw, k); const float w = __uint_as_float(__builtin_amdgcn_readlane(sw, 8 + k));
            const int hrow = tb[128 + (sl >> 16)] * 256 + (sl & 0xffff); const u32x4 y = *(const u32x4*)(Y + (size_t)hrow * 512 + 8 * lane);
#pragma unroll
            for (int q = 0; q < 4; ++q) { a[2 * q] += w * __uint_as_float(y[q] << 16); a[2 * q + 1] += w * __uint_as_float(y[q] & 0xffff0000u); } }
        float* x = (float*)res_row(p, 0, r) + col; const float* gp = gate + row_sel(r) * 6144 + col;
#pragma unroll
        for (int q = 0; q < 2; ++q) { const f32x4 gv = *(const f32x4*)(gp + 4 * q); f32x4 xv = *(const f32x4*)(x + 4 * q);
            xv[0] += gv[0] * a[4 * q]; xv[1] += gv[1] * a[4 * q + 1]; xv[2] += gv[2] * a[4 * q + 2]; xv[3] += gv[3] * a[4 * q + 3]; *(f32x4*)(x + 4 * q) = xv; }
    }
}
__device__ __forceinline__ void phase_final(const Cx& p) {
    const int lane = p.tid & 63, wave = p.tid >> 6; const float* g = PIN(I_FNG); f32x4 gv[4], n[2][4];
#pragma unroll
    for (int i = 0; i < 4; ++i) gv[i] = *(const f32x4*)(g + 256 * i + 4 * lane);
    int r = p.bid * 16 + wave * 2;
    if (r < NB * SEQ) { norm_ld(POUT + (size_t)r * D, n[0], lane); norm_ld(POUT + (size_t)(r + 1) * D, n[1], lane); }
    for (; r < NB * SEQ; r += p.G * 16) { f32x4 v[2][4];
#pragma unroll
        for (int q = 0; q < 2; ++q)
#pragma unroll
            for (int i = 0; i < 4; ++i) v[q][i] = n[q][i];
        const int rn = r + p.G * 16; if (rn < NB * SEQ) { norm_ld(POUT + (size_t)rn * D, n[0], lane); norm_ld(POUT + (size_t)(rn + 1) * D, n[1], lane); }
#pragma unroll
        for (int q = 0; q < 2; ++q) { float* x = POUT + (size_t)(r + q) * D; float ss = 0.f;
#pragma unroll
            for (int i = 0; i < 4; ++i) ss += v[q][i][0] * v[q][i][0] + v[q][i][1] * v[q][i][1] + v[q][i][2] * v[q][i][2] + v[q][i][3] * v[q][i][3];
            ss = wsum(ss); const float rstd = rsq_(ss * (1.0f / D) + 1e-6f);
#pragma unroll
            for (int i = 0; i < 4; ++i) *(f32x4*)(x + 256 * i + 4 * lane) = v[q][i] * rstd * gv[i]; } }
}
__device__ __forceinline__ int chain_tb(int n, int d) { return d == 0 ? n : (n < 4 ? 3 - n : 135 - n); }
__device__ __forceinline__ int cslot(int u) { return (u & 7) * NTB + (u >> 3); }
__device__ __forceinline__ int tb_row0(int b, int tb) { return tb < 4 ? b * NCTX + 64 * tb : CROWS + b * SEQ + 64 * (tb - 4); }
constexpr int TS = 144;
template <int K, int NT> __device__ __forceinline__ void mm_rows(const LAS unsigned char* A, int lda, const LAS unsigned char* Bt, int ldb, int mt, int nt0, int fr, int fq, f32x4 (&acc)[NT]) {
#pragma unroll
    for (int ks = 0; ks < K / 32; ++ks) { const bf16x8 a = *(const LAS bf16x8*)(A + (16 * mt + fr) * lda + ks * 64 + fq * 16);
#pragma unroll
        for (int nt = 0; nt < NT; ++nt) { const bf16x8 bb = *(const LAS bf16x8*)(Bt + (16 * (nt0 + nt) + fr) * ldb + ks * 64 + fq * 16);
            acc[nt] = __builtin_amdgcn_mfma_f32_16x16x32_bf16(a, bb, acc[nt], 0, 0, 0); } }
}
#define UNIT_LOOP(u, N, OFF) for (int u = (p.bid + p.G - ((OFF) % p.G)) % p.G; u < (N); u += p.G)
__device__ __forceinline__ void gla_p1(const Cx& p, LAS unsigned char* lds, int layer, int b) {
    const int tid = p.tid, lane = tid & 63, wave = __builtin_amdgcn_readfirstlane(tid >> 6), fr = lane & 15, fq = lane >> 4;
    LAS unsigned char* ksT = lds; LAS unsigned char* vT = lds + 64 * TS; LAS float* gs = (LAS float*)(lds + 2 * 64 * TS); LAS float* glb = gs + 512;
    const bf16_t* proj = WSP(bf16_t, WS_PROJ); const int mt = wave >> 1, nt0 = (wave & 1) * 2; const int cl = lane, tg = wave;
    const float* w2p = PIN(I_GLA_W2); const float* gbp = PIN(I_GLA_B);
    float w2[16], gb; unsigned gw; bf16_t kq[8], vq[8];
#define GLA1_LOAD(uu) do { const int tb_ = (uu) >> 3, h_ = ((uu) >> 1) & 3, d_ = (uu) & 1, c_ = 64 * h_ + cl; const bf16_t* pr_ = proj + (size_t)tb_row0(b, tb_) * NPROJ; \
        _Pragma("unroll") for (int r = 0; r < 16; ++r) w2[r] = w2p[((size_t)(layer * 2 + d_) * 16 + r) * 256 + c_]; \
        gb = gbp[(layer * 2 + d_) * 256 + c_]; \
        { const int e = tid * 2, i = e >> 4, r = e & 15; gw = *(const unsigned*)(pr_ + (size_t)i * NPROJ + (d_ ? PA_GB : PA_GF) + r); } \
        _Pragma("unroll") for (int i8 = 0; i8 < 8; ++i8) { const bf16_t* pa = pr_ + (size_t)(8 * tg + i8) * NPROJ; kq[i8] = pa[PA_K + c_]; vq[i8] = pa[PA_V + c_]; } } while (0)
    int u = (p.bid + p.G) % p.G;
    if (u < NUNIT) GLA1_LOAD(u);
    for (; u < NUNIT; u += p.G) { const int d = u & 1;
        glb[tid * 2] = __uint_as_float(gw << 16); glb[tid * 2 + 1] = __uint_as_float(gw & 0xffff0000u);
        __syncthreads();
        float bl[8]; float run = 0.f;
#pragma unroll
        for (int ii = 0; ii < 8; ++ii) { const int i8 = d ? 7 - ii : ii; const LAS float* gl_ = glb + (8 * tg + i8) * 16; float z = gb;
#pragma unroll
            for (int r = 0; r < 16; ++r) z += gl_[r] * w2[r];
            run += logsigmoidf_(z) * (1.0f / 16.0f); if (d) bl[7 - ii] = run; else bl[ii] = run; }
        gs[tg * 64 + cl] = run;
        __syncthreads();
        float off = 0.f, total = 0.f;
#pragma unroll
        for (int g2 = 0; g2 < 8; ++g2) { const float t = gs[g2 * 64 + cl]; total += t; if (d ? g2 > tg : g2 < tg) off += t; }
#pragma unroll
        for (int i8 = 0; i8 < 8; i8 += 2) { const int i = 8 * tg + i8;
            const float ka = bf2f(kq[i8]) * __expf(total - (bl[i8] + off)), kb = bf2f(kq[i8 + 1]) * __expf(total - (bl[i8 + 1] + off));
            *(LAS unsigned*)(ksT + cl * TS + i * 2) = pk2(ka, kb); *(LAS unsigned*)(vT + cl * TS + i * 2) = (unsigned)vq[i8] | ((unsigned)vq[i8 + 1] << 16); }
        if (u + p.G < NUNIT) GLA1_LOAD(u + p.G);
        if (tg == 0) WSP(float, SC_GLA_DEC)[(size_t)cslot(u) * 64 + cl] = __expf(total);
        __syncthreads();
        { f32x4 acc[2] = {(f32x4){0.f, 0.f, 0.f, 0.f}, (f32x4){0.f, 0.f, 0.f, 0.f}}; float* kv = WSP(float, SC_GLA_S) + (size_t)cslot(u) * 4096;
          mm_rows<64, 2>(vT, TS, ksT, TS, mt, nt0, fr, fq, acc);
#pragma unroll
          for (int t = 0; t < 2; ++t) *(f32x4*)(kv + (16 * (nt0 + t) + fr) * 64 + 16 * mt + 4 * fq) = acc[t]; }
        __syncthreads();
    }
#undef GLA1_LOAD
}
__device__ __forceinline__ void gla_chain(const Cx& p, int h, int d, int part) {
    if (p.tid >= 256) return;
    const int e0 = part * 1024 + p.tid * 4, dk = e0 >> 6;
    f32x4 s0 = (f32x4){0.f, 0.f, 0.f, 0.f};
    f32x4 n0[12]; float dc[12];
#define GC_LD(q, n_) do { const int u_ = cslot((chain_tb((n_), d) * 4 + h) * 2 + d); n0[q] = *(const f32x4*)(WSP(float, SC_GLA_S) + (size_t)u_ * 4096 + e0); dc[q] = WSP(float, SC_GLA_DEC)[(size_t)u_ * 64 + dk]; } while (0)
#define GC_ST(q, n_) do { const int u_ = cslot((chain_tb((n_), d) * 4 + h) * 2 + d); float* k_ = WSP(float, SC_GLA_S) + (size_t)u_ * 4096 + e0; \
        const f32x4 a0_ = n0[q]; const float de_ = dc[q]; GC_LD(q, (n_) + 12 < NTB ? (n_) + 12 : NTB - 1); *(f32x4*)k_ = s0; s0 = s0 * de_ + a0_; } while (0)
    GC_LD(0, 0); GC_LD(1, 1); GC_LD(2, 2); GC_LD(3, 3); GC_LD(4, 4); GC_LD(5, 5); GC_LD(6, 6); GC_LD(7, 7); GC_LD(8, 8); GC_LD(9, 9); GC_LD(10, 10); GC_LD(11, 11);
#pragma unroll 1
    for (int n = 0; n < NTB; n += 12) { GC_ST(0, n + 0); GC_ST(1, n + 1); GC_ST(2, n + 2); GC_ST(3, n + 3); GC_ST(4, n + 4); GC_ST(5, n + 5); GC_ST(6, n + 6); GC_ST(7, n + 7); GC_ST(8, n + 8); GC_ST(9, n + 9); GC_ST(10, n + 10); GC_ST(11, n + 11); }
#undef GC_LD
#undef GC_ST
}
__device__ __forceinline__ void gla_p2(const Cx& p, LAS unsigned char* lds, int layer, int b) {
    const int tid = p.tid, lane = tid & 63, wave = __builtin_amdgcn_readfirstlane(tid >> 6), fr = lane & 15, fq = lane >> 4;
    LAS unsigned char* qt = lds; LAS unsigned char* kt = lds + 64 * TS; LAS unsigned char* vT = lds + 2 * 64 * TS; LAS unsigned char* sT = lds + 3 * 64 * TS; LAS unsigned char* att = lds + 4 * 64 * TS;
    LAS float* gs = (LAS float*)(lds + 5 * 64 * TS); LAS float* glb = gs + 512;
    const bf16_t* proj = WSP(bf16_t, WS_PROJ); const int cl = lane, tg = wave;
    const float* w2p = PIN(I_GLA_W2); const float* gbp = PIN(I_GLA_B);
    float w2[16], gb; unsigned gw; bf16_t qq[8], kq[8], vq[8]; float sq[8];
#define GLA2_LOAD(uu) do { const int tb_ = (uu) >> 3, h_ = ((uu) >> 1) & 3, d_ = (uu) & 1, c_ = 64 * h_ + cl; const bf16_t* pr_ = proj + (size_t)tb_row0(b, tb_) * NPROJ; \
        _Pragma("unroll") for (int r = 0; r < 16; ++r) w2[r] = w2p[((size_t)(layer * 2 + d_) * 16 + r) * 256 + c_]; \
        gb = gbp[(layer * 2 + d_) * 256 + c_]; \
        { const int e = tid * 2, i = e >> 4, r = e & 15; gw = *(const unsigned*)(pr_ + (size_t)i * NPROJ + (d_ ? PA_GB : PA_GF) + r); } \
        _Pragma("unroll") for (int i8 = 0; i8 < 8; ++i8) { const bf16_t* pa = pr_ + (size_t)(8 * tg + i8) * NPROJ; qq[i8] = pa[PA_Q + c_]; kq[i8] = pa[PA_K + c_]; vq[i8] = pa[PA_V + c_]; } \
        { const float* sp_ = WSP(float, SC_GLA_S) + (size_t)cslot(uu) * 4096; _Pragma("unroll") for (int q = 0; q < 8; ++q) sq[q] = sp_[tid + NTHR * q]; } } while (0)
    int u = (p.bid + p.G - (128 % p.G)) % p.G;
    if (u < NUNIT) GLA2_LOAD(u);
    for (; u < NUNIT; u += p.G) { const int tb = u >> 3, h = (u >> 1) & 3, d = u & 1; const int s0 = 64 * tb;
        glb[tid * 2] = __uint_as_float(gw << 16); glb[tid * 2 + 1] = __uint_as_float(gw & 0xffff0000u);
#pragma unroll
        for (int q = 0; q < 8; ++q) { const int e = tid + NTHR * q, dk = e >> 6, dv = e & 63; *(LAS bf16_t*)(sT + dv * TS + dk * 2) = (bf16_t)f2bf(sq[q]); }
        __syncthreads();
        float bl[8]; float run = 0.f;
#pragma unroll
        for (int ii = 0; ii < 8; ++ii) { const int i8 = d ? 7 - ii : ii; const LAS float* gl_ = glb + (8 * tg + i8) * 16; float z = gb;
#pragma unroll
            for (int r = 0; r < 16; ++r) z += gl_[r] * w2[r];
            run += logsigmoidf_(z) * (1.0f / 16.0f); if (d) bl[7 - ii] = run; else bl[ii] = run; }
        gs[tg * 64 + cl] = run;
        __syncthreads();
        float off = 0.f;
#pragma unroll
        for (int g2 = 0; g2 < 8; ++g2) if (d ? g2 > tg : g2 < tg) off += gs[g2 * 64 + cl];
#pragma unroll
        for (int i8 = 0; i8 < 8; ++i8) { const int i = 8 * tg + i8; const float bi = bl[i8] + off;
            *(LAS bf16_t*)(qt + i * TS + cl * 2) = (bf16_t)f2bf(bf2f(qq[i8]) * 0.125f * __expf(bi));
            *(LAS bf16_t*)(kt + i * TS + cl * 2) = (bf16_t)f2bf(bf2f(kq[i8]) * __expf(-bi));
            *(LAS bf16_t*)(vT + cl * TS + i * 2) = vq[i8]; }
        if (u + p.G < NUNIT) GLA2_LOAD(u + p.G);
        __syncthreads();
        const int mt = wave >> 1, nt0 = (wave & 1) * 2;
        { f32x4 acc[2] = {(f32x4){0.f, 0.f, 0.f, 0.f}, (f32x4){0.f, 0.f, 0.f, 0.f}};
          mm_rows<64, 2>(qt, TS, kt, TS, mt, nt0, fr, fq, acc);
#pragma unroll
          for (int t = 0; t < 2; ++t)
#pragma unroll
              for (int j = 0; j < 4; ++j) { const int i = 16 * mt + 4 * fq + j, jj = 16 * (nt0 + t) + fr; const bool keep = d ? jj >= i : jj <= i;
                  *(LAS bf16_t*)(att + i * TS + jj * 2) = (bf16_t)f2bf(keep ? acc[t][j] : 0.f); } }
        __syncthreads();
        { f32x4 acc[2] = {(f32x4){0.f, 0.f, 0.f, 0.f}, (f32x4){0.f, 0.f, 0.f, 0.f}};
          mm_rows<64, 2>(vT, TS, att, TS, mt, nt0, fr, fq, acc);
          mm_rows<64, 2>(sT, TS, qt, TS, mt, nt0, fr, fq, acc);
          bf16_t* ob = WSP(bf16_t, d ? SC_OB : SC_OF);
#pragma unroll
          for (int t = 0; t < 2; ++t) *(u32x2*)(ob + (size_t)(s0 + 16 * (nt0 + t) + fr) * 1024 + 64 * h + 16 * mt + 4 * fq) = (u32x2){pk2(acc[t][0], acc[t][1]), pk2(acc[t][2], acc[t][3])}; }
        __syncthreads();
    }
}
#undef GLA2_LOAD
constexpr int TS2 = 272;
__device__ __forceinline__ float ssd_acum(float a, int d, int lane, float& total) {
    float pre = a;
#pragma unroll
    for (int o = 1; o < 64; o <<= 1) { const float t = shup_(pre, lane, o); if (lane >= o) pre += t; }
    total = rl(pre, 63);
    return d ? total - pre + a : pre;
}
__device__ __forceinline__ void ssd_p1(const Cx& p, LAS unsigned char* lds, int layer, int b) {
    const int tid = p.tid, lane = tid & 63, wave = __builtin_amdgcn_readfirstlane(tid >> 6), fr = lane & 15, fq = lane >> 4;
    LAS unsigned char* BT = lds; LAS unsigned char* xT = lds + 128 * TS; LAS float* AC = (LAS float*)(lds + 128 * TS + 64 * TS);
    const float* alogp = PIN(I_SS_ALOG);
    u32x4 bq[2], xq; float dtq;
#define SSD1_LOAD(uu) do { const int tb_ = (uu) >> 3, g_ = ((uu) >> 2) & 1, hd_ = (uu) & 3, h_ = 2 * g_ + (hd_ >> 1), d_ = hd_ & 1; \
        const bf16_t* sx_ = WSP(bf16_t, SC_SX) + (size_t)(64 * tb_ + lane) * 768; \
        bq[0] = *(const u32x4*)(sx_ + 256 + 128 * g_ + 16 * wave); bq[1] = *(const u32x4*)(sx_ + 256 + 128 * g_ + 16 * wave + 8); \
        xq = *(const u32x4*)(sx_ + 64 * h_ + 8 * wave); dtq = WSP(float, SC_SDT)[(size_t)(64 * tb_ + lane) * 8 + d_ * 4 + h_]; } while (0)
    int u3 = (p.bid + p.G - (32 % p.G)) % p.G;
    if (u3 < NTB * 8) SSD1_LOAD(u3);
    for (; u3 < NTB * 8; u3 += p.G) { const int tb = u3 >> 3, g = (u3 >> 2) & 1, hd = u3 & 3, h = 2 * g + (hd >> 1), d = hd & 1;
        if (wave == 0) { const float aneg = -__expf(alogp[(layer * 2 + d) * 4 + h]);
            float tot; const float ac = ssd_acum(aneg * dtq, d, lane, tot); AC[lane] = ac; if (lane == 0) { AC[64] = tot; WSP(float, SC_SSD_CD)[cslot((tb * 4 + h) * 2 + d)] = __expf(tot); } }
#pragma unroll
        for (int q = 0; q < 2; ++q)
#pragma unroll
            for (int k = 0; k < 8; ++k) *(LAS bf16_t*)(BT + (16 * wave + 8 * q + k) * TS + lane * 2) = (bf16_t)(bq[q][k >> 1] >> (16 * (k & 1)));
        __syncthreads();
        { const float f = dtq * __expf(AC[64] - AC[lane]);
#pragma unroll
          for (int k = 0; k < 8; ++k) *(LAS bf16_t*)(xT + (8 * wave + k) * TS + lane * 2) = (bf16_t)f2bf(bf2f((bf16_t)(xq[k >> 1] >> (16 * (k & 1)))) * f); }
        if (u3 + p.G < NTB * 8) SSD1_LOAD(u3 + p.G);
        __syncthreads();
        { float* cs = WSP(float, SC_SSD_S) + (size_t)cslot((tb * 4 + h) * 2 + d) * 8192; f32x4 acc[4];
#pragma unroll
          for (int t = 0; t < 4; ++t) acc[t] = (f32x4){0.f, 0.f, 0.f, 0.f};
          mm_rows<64, 4>(BT, TS, xT, TS, wave, 0, fr, fq, acc);
#pragma unroll
          for (int t = 0; t < 4; ++t) *(f32x4*)(cs + (16 * t + fr) * 128 + 16 * wave + 4 * fq) = acc[t]; }
        __syncthreads();
    }
#undef SSD1_LOAD
}
__device__ __forceinline__ void ssd_chain(const Cx& p, int h, int d, int part) {
    if (p.tid >= 256) return;
    const int e0 = part * 1024 + p.tid * 4;
    f32x4 s = (f32x4){0.f, 0.f, 0.f, 0.f}; f32x4 nx[12]; float cd[12];
#define SC_LD(q, n_) do { const int u_ = cslot((chain_tb((n_), d) * 4 + h) * 2 + d); nx[q] = *(const f32x4*)(WSP(float, SC_SSD_S) + (size_t)u_ * 8192 + e0); cd[q] = WSP(float, SC_SSD_CD)[u_]; } while (0)
#define SC_ST(q, n_) do { const int u_ = cslot((chain_tb((n_), d) * 4 + h) * 2 + d); float* c_ = WSP(float, SC_SSD_S) + (size_t)u_ * 8192 + e0; const f32x4 a_ = nx[q]; const float de_ = cd[q]; \
        SC_LD(q, (n_) + 12 < NTB ? (n_) + 12 : NTB - 1); *(f32x4*)c_ = s; s = s * de_ + a_; } while (0)
    SC_LD(0, 0); SC_LD(1, 1); SC_LD(2, 2); SC_LD(3, 3); SC_LD(4, 4); SC_LD(5, 5); SC_LD(6, 6); SC_LD(7, 7); SC_LD(8, 8); SC_LD(9, 9); SC_LD(10, 10); SC_LD(11, 11);
#pragma unroll 1
    for (int n = 0; n < NTB; n += 12) { SC_ST(0, n + 0); SC_ST(1, n + 1); SC_ST(2, n + 2); SC_ST(3, n + 3); SC_ST(4, n + 4); SC_ST(5, n + 5); SC_ST(6, n + 6); SC_ST(7, n + 7); SC_ST(8, n + 8); SC_ST(9, n + 9); SC_ST(10, n + 10); SC_ST(11, n + 11); }
#undef SC_LD
#undef SC_ST
}
__device__ __forceinline__ void ssd_p2(const Cx& p, LAS unsigned char* lds, int layer, int b) {
    const int tid = p.tid, lane = tid & 63, wave = __builtin_amdgcn_readfirstlane(tid >> 6), fr = lane & 15, fq = lane >> 4;
    LAS unsigned char* Ct = lds; LAS unsigned char* Bt2 = lds + 64 * TS2; LAS float* cb = (LAS float*)(lds + 2 * 64 * TS2); LAS float* AC = cb + 64 * 65;
    LAS unsigned char* Mt = (LAS unsigned char*)(AC + 64 + 4); LAS unsigned char* xT = Mt + 64 * TS; LAS unsigned char* Sb = xT + 64 * TS;
    const int mt = wave >> 1, nt0 = (wave & 1) * 2;
    const float* alogp = PIN(I_SS_ALOG);
    u32x4 cq[2], bq[2], xq; float dtq; f32x4 sq[4];
#define SSD2_LOAD(uu) do { const int tb_ = (uu) >> 3, g_ = ((uu) >> 2) & 1, hd_ = (uu) & 3, h_ = 2 * g_ + (hd_ >> 1), d_ = hd_ & 1; \
        const bf16_t* sx_ = WSP(bf16_t, SC_SX) + (size_t)(64 * tb_) * 768; \
        _Pragma("unroll") for (int q = 0; q < 2; ++q) { const int e = tid + NTHR * q, i = e >> 4, ch = e & 15; \
            cq[q] = *(const u32x4*)(sx_ + (size_t)i * 768 + 512 + 128 * g_ + ch * 8); bq[q] = *(const u32x4*)(sx_ + (size_t)i * 768 + 256 + 128 * g_ + ch * 8); } \
        xq = *(const u32x4*)(sx_ + (size_t)lane * 768 + 64 * h_ + 8 * wave); dtq = WSP(float, SC_SDT)[(size_t)(64 * tb_ + lane) * 8 + d_ * 4 + h_]; \
        const float* sp_ = WSP(float, SC_SSD_S) + (size_t)cslot((tb_ * 4 + h_) * 2 + d_) * 8192; \
        _Pragma("unroll") for (int q = 0; q < 4; ++q) sq[q] = *(const f32x4*)(sp_ + (tid + NTHR * q) * 4); } while (0)
    int u3 = (p.bid + p.G - (160 % p.G)) % p.G;
    if (u3 < NTB * 8) SSD2_LOAD(u3);
    for (; u3 < NTB * 8; u3 += p.G) { const int tb = u3 >> 3, g = (u3 >> 2) & 1, hd = u3 & 3, h = 2 * g + (hd >> 1), d = hd & 1, s0 = 64 * tb; (void)g;
        if (wave == 0) { const float aneg = -__expf(alogp[(layer * 2 + d) * 4 + h]); float tot; AC[lane] = ssd_acum(aneg * dtq, d, lane, tot); }
#pragma unroll
        for (int q = 0; q < 2; ++q) { const int e = tid + NTHR * q, i = e >> 4, ch = e & 15;
            *(LAS u32x4*)(Ct + i * TS2 + ch * 16) = cq[q]; *(LAS u32x4*)(Bt2 + i * TS2 + ch * 16) = bq[q]; }
#pragma unroll
        for (int k = 0; k < 8; ++k) *(LAS bf16_t*)(xT + (8 * wave + k) * TS + lane * 2) = (bf16_t)f2bf(bf2f((bf16_t)(xq[k >> 1] >> (16 * (k & 1)))) * dtq);
#pragma unroll
        for (int q = 0; q < 4; ++q) { const int e = (tid + NTHR * q) * 4, pp = e >> 7, s = e & 127; const f32x4 v = sq[q];
            *(LAS u32x2*)(Sb + pp * TS2 + s * 2) = (u32x2){pk2(v[0], v[1]), pk2(v[2], v[3])}; }
        if (u3 + p.G < NTB * 8) SSD2_LOAD(u3 + p.G);
        __syncthreads();
        { f32x4 acc[2] = {(f32x4){0.f, 0.f, 0.f, 0.f}, (f32x4){0.f, 0.f, 0.f, 0.f}};
          mm_rows<128, 2>(Ct, TS2, Bt2, TS2, mt, nt0, fr, fq, acc);
#pragma unroll
          for (int t = 0; t < 2; ++t)
#pragma unroll
              for (int j = 0; j < 4; ++j) cb[(16 * mt + 4 * fq + j) * 65 + 16 * (nt0 + t) + fr] = acc[t][j]; }
        __syncthreads();
        { const int i = tid >> 3, j0 = (tid & 7) * 8; const float ai = AC[i]; unsigned w[4];
#pragma unroll
          for (int jj = 0; jj < 8; jj += 2) { float m[2];
#pragma unroll
              for (int q = 0; q < 2; ++q) { const int j = j0 + jj + q; const bool keep = d ? j >= i : j <= i; const float cv = cb[i * 65 + j], aj = AC[j]; m[q] = keep ? cv * __expf(ai - aj) : 0.f; }
              w[jj >> 1] = pk2(m[0], m[1]); }
          *(LAS u32x4*)(Mt + i * TS + j0 * 2) = (u32x4){w[0], w[1], w[2], w[3]}; }
        __syncthreads();
        { f32x4 acc[2] = {(f32x4){0.f, 0.f, 0.f, 0.f}, (f32x4){0.f, 0.f, 0.f, 0.f}};
          mm_rows<128, 2>(Sb, TS2, Ct, TS2, mt, nt0, fr, fq, acc);
#pragma unroll
          for (int t = 0; t < 2; ++t) { const float sc = __expf(AC[16 * (nt0 + t) + fr]); acc[t] *= sc; }
          mm_rows<64, 2>(xT, TS, Mt, TS, mt, nt0, fr, fq, acc);
          bf16_t* ob = WSP(bf16_t, d ? SC_OB : SC_OF);
#pragma unroll
          for (int t = 0; t < 2; ++t) *(u32x2*)(ob + (size_t)(s0 + 16 * (nt0 + t) + fr) * 1024 + 512 + 64 * h + 16 * mt + 4 * fq) = (u32x2){pk2(acc[t][0], acc[t][1]), pk2(acc[t][2], acc[t][3])}; }
        __syncthreads();
    }
}
#undef SSD2_LOAD
constexpr int AFS = 68;
__device__ __forceinline__ int dr_mfrag_idx(int row, int col) { return (((row >> 4) * 2 + (col >> 5)) * 64 + ((col >> 2) & 3) * 16 + (row & 15)) * 8 + ((col >> 4) & 1) * 4 + (col & 3); }
__device__ __forceinline__ void dr_tinv(const LAS float* AfT, LAS float* Dbuf, const float sgn) {
    LAS unsigned char* TI = (LAS unsigned char*)Dbuf;
    { const int lane = lane_id_asm(), kb_ = lane >> 4, cc = lane & 15; float x[16];
#pragma unroll
        for (int i = 0; i < 16; ++i) x[i] = i == cc ? 1.f : 0.f;
        const LAS float* Ab = AfT + (16 * kb_) * AFS + 16 * kb_;
        f32x4 tri[36];
        { int q = 0;
#pragma unroll
          for (int j = 0; j < 15; ++j)
#pragma unroll
              for (int c4 = (j + 1) / 4; c4 < 4; ++c4) tri[q++] = *(const LAS f32x4*)(Ab + j * AFS + 4 * c4); }
        asm volatile("s_waitcnt lgkmcnt(0)" ::: "memory");
        { int q = 0;
#pragma unroll
          for (int j = 0; j < 15; ++j) { const float xj = sgn * x[j];
#pragma unroll
              for (int c4 = (j + 1) / 4; c4 < 4; ++c4) { const f32x4 t = tri[q++];
#pragma unroll
                  for (int e = 0; e < 4; ++e) if (4 * c4 + e > j) x[4 * c4 + e] -= t[e] * xj; } } }
        { u32x4 w0, w1;
#pragma unroll
          for (int i = 0; i < 16; ++i) *(LAS bf16_t*)(TI + ((kb_ * 16 + i) * 16 + cc) * 2) = (bf16_t)f2bf(x[i]); (void)w0; (void)w1; } }
}
template <class RhsF> __device__ __forceinline__ void dr_solve(const LAS unsigned char* Abf, LAS unsigned char* XT, const LAS float* Dbuf, const float sgn, const int wave, const RhsF& rhs, bf16_t* wu) {
    const LAS unsigned char* TI = (const LAS unsigned char*)Dbuf;
    { const int lane = lane_id_asm(), fr = lane & 15, fq = lane >> 4, col = 16 * wave + fr; u32x4 bx[2] = {(u32x4){0u, 0u, 0u, 0u}, (u32x4){0u, 0u, 0u, 0u}};
      float rv[4][4]; u32x2 af[6][2], tf[4];
#pragma unroll
      for (int k = 0; k < 4; ++k) {
#pragma unroll
          for (int j = 0; j < 4; ++j) rv[k][j] = rhs(16 * k + 4 * fq + j, col);
          tf[k] = *(const LAS u32x2*)(TI + ((k * 16 + fr) * 16 + 4 * fq) * 2); }
#pragma unroll
      for (int k = 1; k < 4; ++k)
#pragma unroll
          for (int ks = 0; ks < 2; ++ks) if (k > 2 * ks) { const int s = (k - 1) + (ks ? 2 : 0) + (k == 3 && ks == 0 ? 0 : 0);
              af[s][0] = *(const LAS u32x2*)(Abf + (16 * k + fr) * TS + (32 * ks + 4 * fq) * 2); af[s][1] = *(const LAS u32x2*)(Abf + (16 * k + fr) * TS + (32 * ks + 16 + 4 * fq) * 2); }
#pragma unroll
      for (int k = 0; k < 4; ++k) { f32x4 acc = (f32x4){0.f, 0.f, 0.f, 0.f};
#pragma unroll
          for (int ks = 0; ks < 2; ++ks) if (k > 2 * ks) { const int s = (k - 1) + (ks ? 2 : 0);
              acc = __builtin_amdgcn_mfma_f32_16x16x32_bf16(__builtin_bit_cast(bf16x8, (u32x4){af[s][0][0], af[s][0][1], af[s][1][0], af[s][1][1]}), __builtin_bit_cast(bf16x8, bx[ks]), acc, 0, 0, 0); }
          float dd[4];
#pragma unroll
          for (int j = 0; j < 4; ++j) dd[j] = rv[k][j] - sgn * acc[j];
          const f32x4 xk = __builtin_amdgcn_mfma_f32_16x16x32_bf16(__builtin_bit_cast(bf16x8, (u32x4){tf[k][0], tf[k][1], 0u, 0u}), __builtin_bit_cast(bf16x8, (u32x4){pk2(dd[0], dd[1]), pk2(dd[2], dd[3]), 0u, 0u}), (f32x4){0.f, 0.f, 0.f, 0.f}, 0, 0, 0);
          const unsigned p0 = pk2(xk[0], xk[1]), p1 = pk2(xk[2], xk[3]);
          bx[k >> 1][(k & 1) * 2] = p0; bx[k >> 1][(k & 1) * 2 + 1] = p1;
          *(LAS u32x2*)(XT + col * TS + (16 * k + 4 * fq) * 2) = (u32x2){p0, p1};
#pragma unroll
          for (int j = 0; j < 4; ++j) wu[(16 * k + 4 * fq + j) * 128 + col] = (bf16_t)f2bf(xk[j]); } }
    __syncthreads();
}
template <class RhsF> __device__ __forceinline__ void dr_block_solve(const LAS unsigned char* Abf, const LAS float* AfT, LAS unsigned char* XT, LAS float* Dbuf, const float sgn, const int wave, const RhsF& rhs, bf16_t* wu) {
    if (wave == 0) dr_tinv(AfT, Dbuf, sgn);
    __syncthreads();
    dr_solve(Abf, XT, Dbuf, sgn, wave, rhs, wu);
}
struct GdnRhs { const LAS unsigned char* kb; const LAS unsigned char* vb; const LAS float* GC;
    __device__ __forceinline__ float operator()(int r, int col) const { return col < 64 ? bf2f(*(const LAS bf16_t*)(kb + r * TS + col * 2)) * __expf(GC[r]) : bf2f(*(const LAS bf16_t*)(vb + r * TS + (col - 64) * 2)); } };
__device__ __forceinline__ void gdn_p1(const Cx& p, LAS unsigned char* lds, int layer, int b) {
    const int wave = __builtin_amdgcn_readfirstlane(p.tid >> 6);
#define GDN_LANES const int lane = lane_id_asm(), tid = wave * 64 + lane, fr = lane & 15, fq = lane >> 4; (void)tid; (void)fr; (void)fq
    LAS unsigned char* kh = lds; LAS unsigned char* kb = lds + 64 * TS; LAS unsigned char* vb = lds + 2 * 64 * TS; LAS unsigned char* Abf = lds + 3 * 64 * TS; LAS unsigned char* kdT = lds + 4 * 64 * TS; LAS unsigned char* XT = lds + 5 * 64 * TS;
    LAS float* Af = (LAS float*)(lds + 7 * 64 * TS); LAS float* Dbuf = Af + 64 * AFS; LAS float* GC = Dbuf + 128 * 20;
    const int mt = wave >> 1, nt0 = (wave & 1) * 2;
    float gq, beta; u32x4 kv, vv;
#define GDN1_LOAD(uu) do { const int tb_ = (uu) >> 3, h_ = ((uu) >> 1) & 3, d_ = (uu) & 1; const int lane_ = lane_id_asm(), tid_ = wave * 64 + lane_; \
        const bf16_t* dq_ = WSP(bf16_t, SC_DQ) + (size_t)(64 * tb_) * 768; const float* dg_ = WSP(float, SC_DG) + (size_t)(64 * tb_) * 16; \
        gq = dg_[(d_ ? 63 - lane_ : lane_) * 16 + 8 + d_ * 4 + h_]; \
        { const int r_ = tid_ >> 3, c0_ = (tid_ & 7) * 8, i_ = d_ ? 63 - r_ : r_; beta = dg_[i_ * 16 + d_ * 4 + h_]; \
          kv = *(const u32x4*)(dq_ + (size_t)i_ * 768 + 256 + 64 * h_ + c0_); vv = *(const u32x4*)(dq_ + (size_t)i_ * 768 + 512 + 64 * h_ + c0_); } } while (0)
    int u = (p.bid + p.G - (64 % p.G)) % p.G;
    if (u < NUNIT) GDN1_LOAD(u);
    for (; u < NUNIT; u += p.G) {
        if (wave == 0) { GDN_LANES; float pre = gq;
#pragma unroll
            for (int o = 1; o < 64; o <<= 1) { const float t = shup_(pre, lane, o); if (lane >= o) pre += t; }
            GC[lane] = pre; }
        { GDN_LANES; const int r = tid >> 3, c0 = (tid & 7) * 8; u32x4 kw, vw;
#pragma unroll
          for (int q = 0; q < 4; ++q) { kw[q] = pk2(__uint_as_float(kv[q] << 16) * beta, __uint_as_float(kv[q] & 0xffff0000u) * beta); vw[q] = pk2(__uint_as_float(vv[q] << 16) * beta, __uint_as_float(vv[q] & 0xffff0000u) * beta); }
          *(LAS u32x4*)(kh + r * TS + c0 * 2) = kv; *(LAS u32x4*)(kb + r * TS + c0 * 2) = kw; *(LAS u32x4*)(vb + r * TS + c0 * 2) = vw;
 }
        if (u + p.G < NUNIT) GDN1_LOAD(u + p.G);
        __syncthreads();
        const float gtot = GC[63];
        { GDN_LANES; f32x4 acc[2] = {(f32x4){0.f, 0.f, 0.f, 0.f}, (f32x4){0.f, 0.f, 0.f, 0.f}};
          mm_rows<64, 2>(kb, TS, kh, TS, mt, nt0, fr, fq, acc);
          float gr[4], gj[2];
#pragma unroll
          for (int j = 0; j < 4; ++j) gr[j] = GC[16 * mt + 4 * fq + j];
#pragma unroll
          for (int t = 0; t < 2; ++t) gj[t] = GC[16 * (nt0 + t) + fr];
#pragma unroll
          for (int t = 0; t < 2; ++t)
#pragma unroll
              for (int j = 0; j < 4; ++j) { const int r = 16 * mt + 4 * fq + j, jj = 16 * (nt0 + t) + fr; const float a = jj < r ? acc[t][j] * __expf(gr[j] - gj[t]) : 0.f;
                  Af[jj * AFS + r] = a; *(LAS bf16_t*)(Abf + r * TS + jj * 2) = (bf16_t)f2bf(a); }
          { bf16_t kraw[8]; float gcr[8];
#pragma unroll
            for (int q = 0; q < 8; ++q) { const int e = tid + NTHR * q, r = e >> 6, cc = e & 63; kraw[q] = *(const LAS bf16_t*)(kh + r * TS + cc * 2); gcr[q] = GC[r]; }
#pragma unroll
            for (int q = 0; q < 8; ++q) { const int e = tid + NTHR * q, r = e >> 6, cc = e & 63; *(LAS bf16_t*)(kdT + cc * TS + r * 2) = (bf16_t)f2bf(bf2f(kraw[q]) * __expf(gtot - gcr[q])); } } }
        __syncthreads();
        { const GdnRhs rhs{kb, vb, GC}; dr_block_solve(Abf, Af, XT, Dbuf, 1.0f, wave, rhs, WSP(bf16_t, SC_DR_WU) + (size_t)u * 8192); }
        { GDN_LANES; f32x4 am[2] = {(f32x4){0.f, 0.f, 0.f, 0.f}, (f32x4){0.f, 0.f, 0.f, 0.f}}, an[2] = {(f32x4){0.f, 0.f, 0.f, 0.f}, (f32x4){0.f, 0.f, 0.f, 0.f}};
          mm_rows<64, 2>(kdT, TS, XT, TS, mt, nt0, fr, fq, am);
          mm_rows<64, 2>(kdT, TS, XT + 64 * TS, TS, mt, nt0, fr, fq, an);
          bf16_t* Mg = WSP(bf16_t, SC_DR_M) + (size_t)cslot(u) * 4096; bf16_t* Ng = WSP(bf16_t, SC_DR_NS) + (size_t)cslot(u) * 4096; const float eg = __expf(gtot);
#pragma unroll
          for (int t = 0; t < 2; ++t) {
#pragma unroll
              for (int j = 0; j < 4; ++j) { const int row = 16 * mt + 4 * fq + j, col = 16 * (nt0 + t) + fr; Mg[dr_mfrag_idx(row, col)] = (bf16_t)f2bf((row == col ? eg : 0.f) - am[t][j]); }
              *(u32x2*)(Ng + (((nt0 + t) * 2 + (mt >> 1)) * 64 + lane) * 8 + (mt & 1) * 4) = (u32x2){pk2(an[t][0], an[t][1]), pk2(an[t][2], an[t][3])}; } }
        __syncthreads();
    }
#undef GDN_LANES
#undef GDN1_LOAD
}
__device__ __forceinline__ void dr_chain(const Cx& p, size_t offM, size_t offNS, int h, int d, int cb) {
    const int lane = p.tid & 63, fr = lane & 15, fq = lane >> 4;
    if (p.tid >= 64) return;
    f32x4 acc[4];
#pragma unroll
    for (int t = 0; t < 4; ++t) acc[t] = (f32x4){0.f, 0.f, 0.f, 0.f};
    bf16x8 mR[4][4][2]; u32x4 nR[4][2];
#define DR_LD(m, nn, n_) do { const int u_ = cslot((chain_tb((n_), d) * 4 + h) * 2 + d); const bf16_t* M_ = WSP(bf16_t, offM) + (size_t)u_ * 4096; const bf16_t* N_ = WSP(bf16_t, offNS) + (size_t)u_ * 4096; \
        _Pragma("unroll") for (int t = 0; t < 4; ++t) { _Pragma("unroll") for (int ks = 0; ks < 2; ++ks) m[t][ks] = *(const bf16x8*)(M_ + ((t * 2 + ks) * 64 + lane) * 8); } \
        _Pragma("unroll") for (int pr = 0; pr < 2; ++pr) nn[pr] = *(const u32x4*)(N_ + ((cb * 2 + pr) * 64 + lane) * 8); } while (0)
#define DR_STEP(m, nn, n_) do { const int u_ = cslot((chain_tb((n_), d) * 4 + h) * 2 + d); bf16_t* ST_ = WSP(bf16_t, offNS) + (size_t)u_ * 4096 + (16 * cb + fr) * 64 + 16 * fq; \
        u32x2 sp_[4]; _Pragma("unroll") for (int t = 0; t < 4; ++t) sp_[t] = (u32x2){pk2(acc[t][0], acc[t][1]), pk2(acc[t][2], acc[t][3])}; \
        *(u32x4*)ST_ = (u32x4){sp_[0][0], sp_[0][1], sp_[1][0], sp_[1][1]}; *(u32x4*)(ST_ + 8) = (u32x4){sp_[2][0], sp_[2][1], sp_[3][0], sp_[3][1]};        \
        bf16x8 bf_[2]; _Pragma("unroll") for (int ks = 0; ks < 2; ++ks) { u32x4 w_ = (u32x4){sp_[2 * ks][0], sp_[2 * ks][1], sp_[2 * ks + 1][0], sp_[2 * ks + 1][1]}; bf_[ks] = __builtin_bit_cast(bf16x8, w_); } \
        _Pragma("unroll") for (int t = 0; t < 4; ++t) { const unsigned n0_ = nn[t >> 1][(t & 1) * 2], n1_ = nn[t >> 1][(t & 1) * 2 + 1]; f32x4 a_ = (f32x4){__uint_as_float(n0_ << 16), __uint_as_float(n0_ & 0xffff0000u), __uint_as_float(n1_ << 16), __uint_as_float(n1_ & 0xffff0000u)}; \
            a_ = __builtin_amdgcn_mfma_f32_16x16x32_bf16(m[t][0], bf_[0], a_, 0, 0, 0); acc[t] = __builtin_amdgcn_mfma_f32_16x16x32_bf16(m[t][1], bf_[1], a_, 0, 0, 0); } } while (0)
#define DR_GO(q, n_) do { DR_STEP(mR[q], nR[q], (n_)); DR_LD(mR[q], nR[q], (n_) + 4 < NTB ? (n_) + 4 : NTB - 1); } while (0)
    DR_LD(mR[0], nR[0], 0); DR_LD(mR[1], nR[1], 1); DR_LD(mR[2], nR[2], 2); DR_LD(mR[3], nR[3], 3);
#pragma unroll 1
    for (int n = 0; n < NTB; n += 4) { DR_GO(0, n); DR_GO(1, n + 1); DR_GO(2, n + 2); DR_GO(3, n + 3); }
#undef DR_GO
#undef DR_LD
#undef DR_STEP
}
__device__ __forceinline__ void gdn_p2(const Cx& p, LAS unsigned char* lds, int layer, int b) {
    const int tid = p.tid, lane = tid & 63, wave = __builtin_amdgcn_readfirstlane(tid >> 6), fr = lane & 15, fq = lane >> 4;
    LAS unsigned char* qh = lds; LAS unsigned char* kh = lds + 64 * TS; LAS unsigned char* wt = lds + 2 * 64 * TS; LAS unsigned char* sT = lds + 3 * 64 * TS; LAS unsigned char* aq = lds + 4 * 64 * TS; LAS unsigned char* vnT = lds + 5 * 64 * TS;
    LAS float* GC = (LAS float*)(lds + 6 * 64 * TS);
    const int mt = wave >> 1, nt0 = (wave & 1) * 2;
    float gq; bf16_t upre[2][4]; u32x4 qv, kv, wv, sv;
#define GDN2_LOAD(uu) do { const int tb_ = (uu) >> 3, h_ = ((uu) >> 1) & 3, d_ = (uu) & 1; \
        const bf16_t* dq_ = WSP(bf16_t, SC_DQ) + (size_t)(64 * tb_) * 768; const float* dg_ = WSP(float, SC_DG) + (size_t)(64 * tb_) * 16; \
        const bf16_t* wu_ = WSP(bf16_t, SC_DR_WU) + (size_t)(uu) * 8192; const bf16_t* st_ = WSP(bf16_t, SC_DR_NS) + (size_t)cslot(uu) * 4096; \
        gq = dg_[(d_ ? 63 - lane : lane) * 16 + 8 + d_ * 4 + h_]; \
        _Pragma("unroll") for (int t = 0; t < 2; ++t) { _Pragma("unroll") for (int j = 0; j < 4; ++j) upre[t][j] = wu_[(16 * mt + 4 * fq + j) * 128 + 64 + 16 * (nt0 + t) + fr]; } \
        { const int r_ = tid >> 3, c0_ = (tid & 7) * 8, i_ = d_ ? 63 - r_ : r_; \
          qv = *(const u32x4*)(dq_ + (size_t)i_ * 768 + 64 * h_ + c0_); kv = *(const u32x4*)(dq_ + (size_t)i_ * 768 + 256 + 64 * h_ + c0_); \
          wv = *(const u32x4*)(wu_ + r_ * 128 + c0_); sv = *(const u32x4*)(st_ + r_ * 64 + c0_); } } while (0)
    int u = (p.bid + p.G - (192 % p.G)) % p.G;
    if (u < NUNIT) GDN2_LOAD(u);
    for (; u < NUNIT; u += p.G) { const int tb = u >> 3, h = (u >> 1) & 3, d = u & 1, s0 = 64 * tb;
        if (wave == 0) { float pre = gq;
#pragma unroll
            for (int o = 1; o < 64; o <<= 1) { const float t = shup_(pre, lane, o); if (lane >= o) pre += t; }
            GC[lane] = pre; }
        bf16_t ucur[2][4];
#pragma unroll
        for (int t = 0; t < 2; ++t)
#pragma unroll
            for (int j = 0; j < 4; ++j) ucur[t][j] = upre[t][j];
        { const int r = tid >> 3, c0 = (tid & 7) * 8;
          *(LAS u32x4*)(qh + r * TS + c0 * 2) = qv; *(LAS u32x4*)(kh + r * TS + c0 * 2) = kv; *(LAS u32x4*)(wt + r * TS + c0 * 2) = wv; { const int ci = c0 >> 3, sq = ci >> 1, tp = ci & 1;
            *(LAS u32x2*)(sT + r * TS + (32 * tp + 4 * sq) * 2) = (u32x2){sv[0], sv[1]}; *(LAS u32x2*)(sT + r * TS + (32 * tp + 16 + 4 * sq) * 2) = (u32x2){sv[2], sv[3]}; } }
        if (u + p.G < NUNIT) GDN2_LOAD(u + p.G);
        __syncthreads();
        { f32x4 acc[2] = {(f32x4){0.f, 0.f, 0.f, 0.f}, (f32x4){0.f, 0.f, 0.f, 0.f}};
          mm_rows<64, 2>(qh, TS, kh, TS, mt, nt0, fr, fq, acc);
          float gr[4], gj[2];
#pragma unroll
          for (int j = 0; j < 4; ++j) gr[j] = GC[16 * mt + 4 * fq + j];
#pragma unroll
          for (int t = 0; t < 2; ++t) gj[t] = GC[16 * (nt0 + t) + fr];
#pragma unroll
          for (int t = 0; t < 2; ++t)
#pragma unroll
              for (int j = 0; j < 4; ++j) { const int r = 16 * mt + 4 * fq + j, jj = 16 * (nt0 + t) + fr; *(LAS bf16_t*)(aq + r * TS + jj * 2) = (bf16_t)f2bf(jj <= r ? acc[t][j] * __expf(gr[j] - gj[t]) : 0.f); }
          f32x4 av[2] = {(f32x4){0.f, 0.f, 0.f, 0.f}, (f32x4){0.f, 0.f, 0.f, 0.f}};
          mm_rows<64, 2>(wt, TS, sT, TS, mt, nt0, fr, fq, av);
#pragma unroll
          for (int t = 0; t < 2; ++t) { const int dv = 16 * (nt0 + t) + fr; float vn[4];
#pragma unroll
              for (int j = 0; j < 4; ++j) vn[j] = bf2f(ucur[t][j]) - av[t][j];
              *(LAS u32x2*)(vnT + dv * TS + (16 * mt + 4 * fq) * 2) = (u32x2){pk2(vn[0], vn[1]), pk2(vn[2], vn[3])}; } }
        __syncthreads();
        { f32x4 acc[2] = {(f32x4){0.f, 0.f, 0.f, 0.f}, (f32x4){0.f, 0.f, 0.f, 0.f}};
          mm_rows<64, 2>(sT, TS, qh, TS, mt, nt0, fr, fq, acc);
#pragma unroll
          for (int t = 0; t < 2; ++t) { const float sc = __expf(GC[16 * (nt0 + t) + fr]); acc[t] *= sc; }
          mm_rows<64, 2>(vnT, TS, aq, TS, mt, nt0, fr, fq, acc);
          bf16_t* ob = WSP(bf16_t, d ? SC_OB : SC_OF);
#pragma unroll
          for (int t = 0; t < 2; ++t) { const int r = 16 * (nt0 + t) + fr, i = d ? 63 - r : r; *(u32x2*)(ob + (size_t)(s0 + i) * 1024 + 768 + 64 * h + 16 * mt + 4 * fq) = (u32x2){pk2(acc[t][0], acc[t][1]), pk2(acc[t][2], acc[t][3])}; } }
        __syncthreads();
    }
}
#undef GDN2_LOAD
constexpr int LPS = 65;
#define RW_LP(LP, GS, lw8) do { const int lane_ = lane_id_asm(), c_ = lane_, tg_ = wave; float loc_[8]; float run_ = 0.f; \
        _Pragma("unroll") for (int ii = 0; ii < 8; ++ii) { run_ += (lw8)[ii]; loc_[ii] = run_; } \
        (GS)[tg_ * 64 + c_] = run_; __syncthreads(); float off_ = 0.f; \
        _Pragma("unroll") for (int g2 = 0; g2 < 8; ++g2) if (g2 < tg_) off_ += (GS)[g2 * 64 + c_]; \
        _Pragma("unroll") for (int ii = 0; ii < 8; ++ii) (LP)[(8 * tg_ + ii) * LPS + c_] = loc_[ii] + off_; __syncthreads(); } while (0)
struct RwRhs { const LAS unsigned char* zt; const LAS unsigned char* RU;
    __device__ __forceinline__ float operator()(int r, int col) const { return col < 64 ? bf2f(*(const LAS bf16_t*)(zt + r * TS + col * 2)) : bf2f(*(const LAS bf16_t*)(RU + (col - 64) * TS + r * 2)); } };
__device__ __forceinline__ void rw_p1(const Cx& p, LAS unsigned char* lds, int layer, int b) {
    const int wave = __builtin_amdgcn_readfirstlane(p.tid >> 6), mt = wave >> 1, nt0 = (wave & 1) * 2;
#define RW_LANES const int lane = lane_id_asm(), tid = wave * 64 + lane, fr = lane & 15, fq = lane >> 4; (void)tid; (void)fr; (void)fq
    LAS float* LP = (LAS float*)lds; LAS float* GS = (LAS float*)(lds + 16640);
    LAS unsigned char* zt = lds + 18688; LAS unsigned char* bt = lds + 27904; LAS unsigned char* kt = lds + 37120; LAS unsigned char* vT = lds + 46336; LAS unsigned char* Azk = lds + 55552;
    LAS float* Af = (LAS float*)(lds + 64768); LAS unsigned char* XT = lds + 82176; LAS unsigned char* Abf = lds + 100608; LAS unsigned char* RU = lds + 109824; LAS float* Dbuf = (LAS float*)(lds + 119040); LAS unsigned char* bhT = lds + 129280;
    const bf16_t* proj = WSP(bf16_t, WS_PROJ);
    float lw8[8]; f32x4 lwv[2], kkv[2], bv[2], kv[2]; bf16_t v8[8];
#define RW1_LOAD(uu) do { const int tb_ = (uu) >> 3, h_ = ((uu) >> 1) & 3, d_ = (uu) & 1, s0_ = 64 * tb_; const int lane_ = lane_id_asm(), tid_ = wave * 64 + lane_; \
        const float* lwp_ = WSP(float, SC_RLW) + (size_t)d_ * SB * 256 + (size_t)s0_ * 256 + 64 * h_; const size_t fo_ = (size_t)s0_ * 256 + 64 * h_; \
        _Pragma("unroll") for (int ii = 0; ii < 8; ++ii) { const int r_ = 8 * wave + ii; lw8[ii] = lwp_[(size_t)(d_ ? 63 - r_ : r_) * 256 + lane_]; } \
        { const int r_ = tid_ >> 3, c0_ = (tid_ & 7) * 8, i_ = d_ ? 63 - r_ : r_; \
          _Pragma("unroll") for (int q = 0; q < 2; ++q) { lwv[q] = *(const f32x4*)(lwp_ + (size_t)i_ * 256 + c0_ + 4 * q); kkv[q] = *(const f32x4*)(WSP(float, SC_RKK) + fo_ + (size_t)i_ * 256 + c0_ + 4 * q); \
              bv[q] = *(const f32x4*)(WSP(float, SC_RB) + fo_ + (size_t)i_ * 256 + c0_ + 4 * q); kv[q] = *(const f32x4*)(WSP(float, SC_RK) + fo_ + (size_t)i_ * 256 + c0_ + 4 * q); } } \
        { const bf16_t* pr0_ = proj + (size_t)tb_row0(b, tb_) * NPROJ; \
          _Pragma("unroll") for (int q = 0; q < 8; ++q) { const int e = tid_ + NTHR * q, r2 = e >> 6, cc = e & 63; v8[q] = pr0_[(size_t)(d_ ? 63 - r2 : r2) * NPROJ + PB_V + 64 * h_ + cc]; } } } while (0)
    int u = (p.bid + p.G - (96 % p.G)) % p.G; if (u >= NUNIT) return;
    RW1_LOAD(u);
    for (;;) { const int d = u & 1;
        RW_LP(LP, GS, lw8);
        { RW_LANES; const int r = tid >> 3, c0 = (tid & 7) * 8; unsigned wz[4], wb[4], wk[4];
#pragma unroll
          for (int q = 0; q < 8; q += 2) { float z2[2], b2[2], k2[2];
#pragma unroll
              for (int e = 0; e < 2; ++e) { const int cq = q + e, c = c0 + cq; const float lp = LP[r * LPS + c], lw = lwv[cq >> 2][cq & 3], em = __expf(-lp);
                  z2[e] = -kkv[cq >> 2][cq & 3] * __expf(lp - lw); b2[e] = bv[cq >> 2][cq & 3] * em; k2[e] = kv[cq >> 2][cq & 3] * em; }
              wz[q >> 1] = pk2(z2[0], z2[1]); wb[q >> 1] = pk2(b2[0], b2[1]); wk[q >> 1] = pk2(k2[0], k2[1]); }
          *(LAS u32x4*)(zt + r * TS + c0 * 2) = (u32x4){wz[0], wz[1], wz[2], wz[3]}; *(LAS u32x4*)(bt + r * TS + c0 * 2) = (u32x4){wb[0], wb[1], wb[2], wb[3]}; *(LAS u32x4*)(kt + r * TS + c0 * 2) = (u32x4){wk[0], wk[1], wk[2], wk[3]};
#pragma unroll
          for (int q = 0; q < 8; ++q) { const int e = tid + NTHR * q, r2 = e >> 6, cc = e & 63; *(LAS bf16_t*)(vT + cc * TS + r2 * 2) = v8[q]; } }
        __syncthreads();
        const int un = u + p.G; const bool more = un < NUNIT;
        if (more) RW1_LOAD(un);
        { RW_LANES; f32x4 a1[2] = {(f32x4){0.f, 0.f, 0.f, 0.f}, (f32x4){0.f, 0.f, 0.f, 0.f}}, a2[2] = {(f32x4){0.f, 0.f, 0.f, 0.f}, (f32x4){0.f, 0.f, 0.f, 0.f}};
          mm_rows<64, 2>(zt, TS, bt, TS, mt, nt0, fr, fq, a1);
          mm_rows<64, 2>(zt, TS, kt, TS, mt, nt0, fr, fq, a2);
#pragma unroll
          for (int t = 0; t < 2; ++t)
#pragma unroll
              for (int j = 0; j < 4; ++j) { const int r = 16 * mt + 4 * fq + j, jj = 16 * (nt0 + t) + fr; const float a = jj < r ? a1[t][j] : 0.f;
                  Af[jj * AFS + r] = a; *(LAS bf16_t*)(Abf + r * TS + jj * 2) = (bf16_t)f2bf(a); *(LAS bf16_t*)(Azk + r * TS + jj * 2) = (bf16_t)f2bf(jj < r ? a2[t][j] : 0.f); } }
        __syncthreads();
        { RW_LANES; f32x4 a[2] = {(f32x4){0.f, 0.f, 0.f, 0.f}, (f32x4){0.f, 0.f, 0.f, 0.f}};
          mm_rows<64, 2>(Azk, TS, vT, TS, mt, nt0, fr, fq, a);
#pragma unroll
          for (int t = 0; t < 2; ++t) *(LAS u32x2*)(RU + (16 * (nt0 + t) + fr) * TS + (16 * mt + 4 * fq) * 2) = (u32x2){pk2(a[t][0], a[t][1]), pk2(a[t][2], a[t][3])};
        }
        if (wave == 0) dr_tinv(Af, Dbuf, -1.0f);
        __syncthreads();
        { RW_LANES;
          const float el = __expf(LP[63 * LPS + (tid & 63)]); bf16_t braw[8], kraw[8];
#pragma unroll
          for (int q = 0; q < 8; ++q) { const int e = tid + NTHR * q, r2 = e >> 6, cc = e & 63; braw[q] = *(const LAS bf16_t*)(bt + r2 * TS + cc * 2); kraw[q] = *(const LAS bf16_t*)(kt + r2 * TS + cc * 2); }
#pragma unroll
          for (int q = 0; q < 8; ++q) { const int e = tid + NTHR * q, r2 = e >> 6, cc = e & 63;
              *(LAS bf16_t*)(bhT + cc * TS + r2 * 2) = (bf16_t)f2bf(bf2f(braw[q]) * el); *(LAS bf16_t*)(Azk + cc * TS + r2 * 2) = (bf16_t)f2bf(bf2f(kraw[q]) * el); } }
        __syncthreads();
        { const RwRhs rhs{zt, RU}; dr_solve(Abf, XT, Dbuf, -1.0f, wave, rhs, WSP(bf16_t, SC_RW_WU) + (size_t)u * 8192); }
        { RW_LANES; f32x4 am[2] = {(f32x4){0.f, 0.f, 0.f, 0.f}, (f32x4){0.f, 0.f, 0.f, 0.f}}, an[2] = {(f32x4){0.f, 0.f, 0.f, 0.f}, (f32x4){0.f, 0.f, 0.f, 0.f}};
          mm_rows<64, 2>(bhT, TS, XT, TS, mt, nt0, fr, fq, am);
          mm_rows<64, 2>(bhT, TS, XT + 64 * TS, TS, mt, nt0, fr, fq, an);
          mm_rows<64, 2>(Azk, TS, vT, TS, mt, nt0, fr, fq, an);
          bf16_t* Mg = WSP(bf16_t, SC_RW_M) + (size_t)cslot(u) * 4096; bf16_t* Ng = WSP(bf16_t, SC_RW_NS) + (size_t)cslot(u) * 4096;
#pragma unroll
          for (int t = 0; t < 2; ++t) {
#pragma unroll
              for (int j = 0; j < 4; ++j) { const int row = 16 * mt + 4 * fq + j, col = 16 * (nt0 + t) + fr; Mg[dr_mfrag_idx(row, col)] = (bf16_t)f2bf((row == col ? __expf(LP[63 * LPS + row]) : 0.f) + am[t][j]); }
              *(u32x2*)(Ng + (((nt0 + t) * 2 + (mt >> 1)) * 64 + lane) * 8 + (mt & 1) * 4) = (u32x2){pk2(an[t][0], an[t][1]), pk2(an[t][2], an[t][3])}; } }
        __syncthreads();
        if (!more) break;
        u = un;
    }
#undef RW1_LOAD
}
__device__ __forceinline__ void rw_p2(const Cx& p, LAS unsigned char* lds, int layer, int b) {
    const int wave = __builtin_amdgcn_readfirstlane(p.tid >> 6), mt = wave >> 1, nt0 = (wave & 1) * 2;
    LAS float* LP = (LAS float*)lds; LAS float* GS = (LAS float*)(lds + 16640);
    LAS unsigned char* rt = lds + 18688; LAS unsigned char* bt = lds + 27904; LAS unsigned char* kt = lds + 37120; LAS unsigned char* vT = lds + 46336; LAS unsigned char* sT = lds + 55552; LAS unsigned char* wt = lds + 64768;
    LAS unsigned char* Arb = lds + 73984; LAS unsigned char* Ark = lds + 83200; LAS unsigned char* UT = lds + 92416;
    const bf16_t* proj = WSP(bf16_t, WS_PROJ);
    bf16_t upre[2][4]; float lw8[8]; u32x4 rv, wv, sv, vq; f32x4 bv[2], kv[2];
#define RW2_LOAD(uu) do { const int tb_ = (uu) >> 3, h_ = ((uu) >> 1) & 3, d_ = (uu) & 1, s0_ = 64 * tb_; const int lane_ = lane_id_asm(), tid_ = wave * 64 + lane_, fr_ = lane_ & 15, fq_ = lane_ >> 4; \
        const float* lwp_ = WSP(float, SC_RLW) + (size_t)d_ * SB * 256 + (size_t)s0_ * 256 + 64 * h_; const float* rk_ = WSP(float, SC_RK) + (size_t)s0_ * 256 + 64 * h_; const float* rb_ = WSP(float, SC_RB) + (size_t)s0_ * 256 + 64 * h_; \
        const bf16_t* pr_ = proj + (size_t)tb_row0(b, tb_) * NPROJ; const bf16_t* wu_ = WSP(bf16_t, SC_RW_WU) + (size_t)(uu) * 8192; const bf16_t* st_ = WSP(bf16_t, SC_RW_NS) + (size_t)cslot(uu) * 4096; \
        _Pragma("unroll") for (int t = 0; t < 2; ++t) { _Pragma("unroll") for (int j = 0; j < 4; ++j) upre[t][j] = wu_[(16 * mt + 4 * fq_ + j) * 128 + 64 + 16 * (nt0 + t) + fr_]; } \
        _Pragma("unroll") for (int ii = 0; ii < 8; ++ii) { const int r_ = 8 * wave + ii; lw8[ii] = lwp_[(size_t)(d_ ? 63 - r_ : r_) * 256 + lane_]; } \
        { const int r_ = tid_ >> 3, c0_ = (tid_ & 7) * 8, i_ = d_ ? 63 - r_ : r_; rv = *(const u32x4*)(pr_ + (size_t)i_ * NPROJ + PB_R + 64 * h_ + c0_); \
          _Pragma("unroll") for (int q = 0; q < 2; ++q) { bv[q] = *(const f32x4*)(rb_ + (size_t)i_ * 256 + c0_ + 4 * q); kv[q] = *(const f32x4*)(rk_ + (size_t)i_ * 256 + c0_ + 4 * q); } \
          wv = *(const u32x4*)(wu_ + r_ * 128 + c0_); sv = *(const u32x4*)(st_ + r_ * 64 + c0_); } \
        vq = *(const u32x4*)(pr_ + (size_t)(d_ ? 63 - lane_ : lane_) * NPROJ + PB_V + 64 * h_ + 8 * wave); } while (0)
    int u = (p.bid + p.G - (224 % p.G)) % p.G;
    if (u < NUNIT) RW2_LOAD(u);
    for (; u < NUNIT; u += p.G) { const int tb = u >> 3, h = (u >> 1) & 3, d = u & 1, s0 = 64 * tb;
        bf16_t ucur[2][4];
#pragma unroll
        for (int t = 0; t < 2; ++t)
#pragma unroll
            for (int j = 0; j < 4; ++j) ucur[t][j] = upre[t][j];
        RW_LP(LP, GS, lw8);
        { RW_LANES; const int r = tid >> 3, c0 = (tid & 7) * 8; unsigned wr[4], wb[4], wk[4];
#pragma unroll
          for (int q = 0; q < 8; q += 2) { float r2[2], b2[2], k2[2];
#pragma unroll
              for (int e = 0; e < 2; ++e) { const int cq = q + e, c = c0 + cq; const float lp = LP[r * LPS + c], em = __expf(-lp); const unsigned w = rv[q >> 1];
                  r2[e] = (e ? __uint_as_float(w & 0xffff0000u) : __uint_as_float(w << 16)) * __expf(lp); b2[e] = bv[cq >> 2][cq & 3] * em; k2[e] = kv[cq >> 2][cq & 3] * em; }
              wr[q >> 1] = pk2(r2[0], r2[1]); wb[q >> 1] = pk2(b2[0], b2[1]); wk[q >> 1] = pk2(k2[0], k2[1]); }
          *(LAS u32x4*)(rt + r * TS + c0 * 2) = (u32x4){wr[0], wr[1], wr[2], wr[3]}; *(LAS u32x4*)(bt + r * TS + c0 * 2) = (u32x4){wb[0], wb[1], wb[2], wb[3]}; *(LAS u32x4*)(kt + r * TS + c0 * 2) = (u32x4){wk[0], wk[1], wk[2], wk[3]};
          *(LAS u32x4*)(wt + r * TS + c0 * 2) = wv; { const int ci = c0 >> 3, sq = ci >> 1, tp = ci & 1;
            *(LAS u32x2*)(sT + r * TS + (32 * tp + 4 * sq) * 2) = (u32x2){sv[0], sv[1]}; *(LAS u32x2*)(sT + r * TS + (32 * tp + 16 + 4 * sq) * 2) = (u32x2){sv[2], sv[3]}; }
#pragma unroll
          for (int k = 0; k < 8; ++k) *(LAS bf16_t*)(vT + (8 * wave + k) * TS + lane * 2) = (bf16_t)(vq[k >> 1] >> (16 * (k & 1))); }
        if (u + p.G < NUNIT) RW2_LOAD(u + p.G);
        __syncthreads();
        { RW_LANES; f32x4 a1[2] = {(f32x4){0.f, 0.f, 0.f, 0.f}, (f32x4){0.f, 0.f, 0.f, 0.f}}, a2[2] = {(f32x4){0.f, 0.f, 0.f, 0.f}, (f32x4){0.f, 0.f, 0.f, 0.f}}, a3[2] = {(f32x4){0.f, 0.f, 0.f, 0.f}, (f32x4){0.f, 0.f, 0.f, 0.f}};
          mm_rows<64, 2>(rt, TS, bt, TS, mt, nt0, fr, fq, a1); mm_rows<64, 2>(rt, TS, kt, TS, mt, nt0, fr, fq, a2); mm_rows<64, 2>(wt, TS, sT, TS, mt, nt0, fr, fq, a3);
#pragma unroll
          for (int t = 0; t < 2; ++t) { const int dv = 16 * (nt0 + t) + fr; float uu[4];
#pragma unroll
              for (int j = 0; j < 4; ++j) { const int r = 16 * mt + 4 * fq + j, jj = dv; const bool keep = jj <= r;
                  *(LAS bf16_t*)(Arb + r * TS + jj * 2) = (bf16_t)f2bf(keep ? a1[t][j] : 0.f); *(LAS bf16_t*)(Ark + r * TS + jj * 2) = (bf16_t)f2bf(keep ? a2[t][j] : 0.f);
                  uu[j] = bf2f(ucur[t][j]) + a3[t][j]; }
              *(LAS u32x2*)(UT + dv * TS + (16 * mt + 4 * fq) * 2) = (u32x2){pk2(uu[0], uu[1]), pk2(uu[2], uu[3])}; } }
        __syncthreads();
        { RW_LANES; f32x4 acc[2] = {(f32x4){0.f, 0.f, 0.f, 0.f}, (f32x4){0.f, 0.f, 0.f, 0.f}};
          mm_rows<64, 2>(sT, TS, rt, TS, mt, nt0, fr, fq, acc); mm_rows<64, 2>(UT, TS, Arb, TS, mt, nt0, fr, fq, acc); mm_rows<64, 2>(vT, TS, Ark, TS, mt, nt0, fr, fq, acc);
          bf16_t* ob = WSP(bf16_t, d ? SC_OB : SC_OF);
#pragma unroll
          for (int t = 0; t < 2; ++t) { const int r = 16 * (nt0 + t) + fr, i = d ? 63 - r : r; *(u32x2*)(ob + (size_t)(s0 + i) * 1024 + 256 + 64 * h + 16 * mt + 4 * fq) = (u32x2){pk2(acc[t][0], acc[t][1]), pk2(acc[t][2], acc[t][3])}; } }
        __syncthreads();
    }
#undef RW_LANES
#undef RW2_LOAD
}
__device__ __forceinline__ void phase_scan(const Cx& p, LAS unsigned char* lds, int layer, int b) {
    for (int w = p.bid; w < 160; w += p.G) {
        if (w < 64) ssd_chain(p, (w >> 4) & 3, (w >> 3) & 1, w & 7);
        else if (w < 96) gla_chain(p, ((w - 64) >> 3) & 3, ((w - 64) >> 2) & 1, (w - 64) & 3);
        else { const int i = w - 96, h = (i >> 3) & 3, d = (i >> 2) & 1, cb = i & 3;
            if (i < 32) dr_chain(p, SC_RW_M, SC_RW_NS, h, d, cb); else dr_chain(p, SC_DR_M, SC_DR_NS, h, d, cb); } }
}
#ifndef MK_ONE_LAUNCH
#define MK_ONE_LAUNCH 1
#endif
constexpr int PH_PER_LAYER = 2 + 5 * NB + 7;
constexpr int N_PHASES = 1 + NL * PH_PER_LAYER + 1;

__global__ void __launch_bounds__(NTHR, 2) mega_fwd(Params pp) {
    extern __shared__ __attribute__((aligned(16))) unsigned char lds_raw[];
    LAS unsigned char* lds = (LAS unsigned char*)lds_raw;
    const int swave = __builtin_amdgcn_readfirstlane(threadIdx.x >> 6);
    for (int i = threadIdx.x; i < (LDS_BYTES - LDS_CTL) / 4; i += NTHR) ((LAS unsigned*)(lds + LDS_CTL))[i] = 0u;
    __syncthreads();
    if (threadIdx.x < N_IN + 2) { const unsigned long long a = threadIdx.x < N_IN ? (unsigned long long)pp.in[threadIdx.x] : (threadIdx.x == N_IN ? (unsigned long long)pp.out : (unsigned long long)pp.ws); ((LAS unsigned*)(lds + LDS_PTRS))[2 * threadIdx.x] = (unsigned)a; ((LAS unsigned*)(lds + LDS_PTRS))[2 * threadIdx.x + 1] = (unsigned)(a >> 32); }
    __syncthreads();
    XcdBarrier bar = xcd_barrier_post((unsigned*)(pp.ws + WS_CTL) + CW_BAR + pp.li * XCD_BAR_WORDS, (volatile LAS unsigned*)(lds + LDS_CTL), threadIdx.x);
    LAS int* tb = (LAS int*)(lds + LDS_CTL + 64);
    int pc = 0; const int lo = pp.lo, hi = pp.hi;
#define PH_BEGIN if (pc >= lo && pc < hi) { Cx p; p.out = (unsigned long long)PIN(N_IN); p.ws = (unsigned long long)PIN(N_IN + 1); p.tid = swave * 64 + lane_id_asm(); p.bid = blockIdx.x; p.G = gridDim.x; p.pad = 0; asm volatile("" : "+s"(p.out), "+s"(p.ws), "+v"(p.tid), "+s"(p.bid), "+s"(p.G)); const int G = p.G, bid = p.bid; (void)G; (void)bid;
#define PH_END if (pc + 1 < hi) { XcdBarrier b2 = bar; asm volatile("" : "+s"(b2.bar), "+s"(b2.x)); xcd_barrier(b2, (unsigned)(swave * 64 + lane_id_asm())); } } ++pc;

    PH_BEGIN
        conv_run(p, (LAS float*)lds, CONV_A_UNITS, ConvDescA{0});
        __syncthreads();
        phase_mod(p, lds);
    PH_END

#pragma unroll
    for (int layer = 0; layer < NL; ++layer) {
        const int row_lo = layer == NL - 1 ? CROWS : 0;
        PH_BEGIN phase_norm1(p, layer); PH_END
        PH_BEGIN
            DenseSched S; S.init(ROWS, NPROJ, D, WSP(bf16_t, WS_WIN) + (size_t)layer * NPROJ * D, G, bid);
            EpiProj E{WSP(bf16_t, WS_PROJ), NPROJ};
            pg8::gemm_phase<D>(p.tid, lds, (const char*)WSP(bf16_t, WS_HBUF), S, E);
        PH_END
#pragma unroll 1
        for (int b = 0; b < NB; ++b) {
            PH_BEGIN phase_prep(p, lds, layer, b); PH_END
            PH_BEGIN gla_p1(p, lds, layer, b); __syncthreads(); ssd_p1(p, lds, layer, b); __syncthreads(); gdn_p1(p, lds, layer, b); __syncthreads(); rw_p1(p, lds, layer, b); PH_END
            PH_BEGIN phase_scan(p, lds, layer, b); PH_END
            PH_BEGIN gla_p2(p, lds, layer, b); __syncthreads(); ssd_p2(p, lds, layer, b); __syncthreads(); gdn_p2(p, lds, layer, b); __syncthreads(); rw_p2(p, lds, layer, b); PH_END
            PH_BEGIN phase_post(p, lds, layer, b); PH_END
        }
        PH_BEGIN
            DenseSched S; S.init(ROWS, D, D, WSP(bf16_t, WS_WOUT) + (size_t)layer * D * D, G, bid);
            EpiRes E{layer == 0 ? PIN(I_X) : (const float*)POUT, layer == 0 ? PIN(I_CTX) : (const float*)WSP(float, WS_CTXRES), POUT, WSP(float, WS_CTXRES), WSP(float, WS_MOD) + (size_t)layer * 5 * 6144 + 2048};
            pg8::gemm_phase<D>(p.tid, lds, (const char*)WSP(bf16_t, WS_HBUF), S, E);
        PH_END
        PH_BEGIN phase_norm2(p, lds, layer, row_lo);
            __syncthreads();
            conv_run(p, (LAS float*)lds, CONV_E_UNITS, ConvDescE{layer});
        PH_END
        PH_BEGIN
            moe_table(p, tb, layer, row_lo);
            MoeSched<true> S{tb + 128, tb, 2, G, bid, D, row_lo, WSP(int, WS_LTOK), (const char*)WSP(bf16_t, WS_EXPGU), (size_t)512 * D * 2};
            EpiGU E{WSP(bf16_t, WS_H)};
            pg8::gemm_phase<D>(p.tid, lds, (const char*)WSP(bf16_t, WS_HBUF), S, E);
        PH_END
#pragma unroll
        for (int half = 0; half < 2; ++half) {
            PH_BEGIN
                moe_table(p, tb, layer, row_lo);
                MoeSched<false> S{tb + 128, tb, 2, G, bid, EH, row_lo, WSP(int, WS_LTOK), (const char*)(WSP(bf16_t, WS_EXPD) + (size_t)half * 512 * EH), (size_t)D * EH * 2};
                EpiY E{WSP(bf16_t, WS_Y)};
                pg8::gemm_phase<EH>(p.tid, lds, (const char*)WSP(bf16_t, WS_H), S, E);
            PH_END
            PH_BEGIN
                moe_table(p, tb, layer, row_lo);
                phase_combine(p, tb, layer, row_lo, half);
            PH_END
        }
    }
    PH_BEGIN phase_final(p);
    PH_END
#undef PH_BEGIN
#undef PH_END
}

extern "C" void kernel_launch(void* const* d_in, const int* in_sizes, int n_in, void* d_out, int out_size, void* d_ws, size_t ws_size, hipStream_t stream) {
    static int grid = 0;
    if (grid == 0) {
        if (n_in != N_IN || in_sizes[0] != NB * SEQ * D || out_size != NB * SEQ * D || ws_size < WS_END) {
            fprintf(stderr, "kernel_launch: unexpected shapes (n_in %d, in0 %d, out %d, ws %zu); nothing launched\n", n_in, n_in > 0 ? in_sizes[0] : -1, out_size, ws_size); grid = -1; return; }
        int dev = 0, cus = 0, per_cu = 0;
        if (hipGetDevice(&dev) != hipSuccess || hipDeviceGetAttribute(&cus, hipDeviceAttributeMultiprocessorCount, dev) != hipSuccess) { grid = -1; return; }
        if (hipFuncSetAttribute((const void*)mega_fwd, hipFuncAttributeMaxDynamicSharedMemorySize, LDS_BYTES) != hipSuccess) { fprintf(stderr, "kernel_launch: hipFuncSetAttribute failed\n"); grid = -1; return; }
        if (hipOccupancyMaxActiveBlocksPerMultiprocessor(&per_cu, (const void*)mega_fwd, NTHR, LDS_BYTES) != hipSuccess || per_cu < 1) { fprintf(stderr, "kernel_launch: occupancy query says %d\n", per_cu); per_cu = 1; }
        (void)hipGetLastError();
        grid = cus * 1;
    }
    if (grid < 0) return;
    if (hipMemsetAsync((char*)d_ws + WS_CTL, 0, CTL_ZERO_BYTES, stream) != hipSuccess) return;
    Params p{};
    for (int i = 0; i < N_IN; ++i) p.in[i] = (const float*)d_in[i];
    p.out = (float*)d_out; p.ws = (unsigned char*)d_ws; p.pad = 0;
#if MK_ONE_LAUNCH
    p.lo = 0; p.hi = N_PHASES; p.li = 0;
    hipLaunchKernelGGL(mega_fwd, dim3(grid), dim3(NTHR), LDS_BYTES, stream, p);
#else
    for (int k = 0; k < N_PHASES; ++k) { p.lo = k; p.hi = k + 1; p.li = k;
        hipLaunchKernelGGL(mega_fwd, dim3(grid), dim3(NTHR), LDS_BYTES, stream, p); }
#endif
}
```

```cpp
#include <hip/hip_runtime.h>
#include <cstdio>
#include <cstdint>

typedef unsigned short bf16_t;
typedef short bf16x8 __attribute__((ext_vector_type(8)));
typedef float f32x4 __attribute__((ext_vector_type(4)));
typedef float f32x2 __attribute__((ext_vector_type(2)));
typedef unsigned u32x4 __attribute__((ext_vector_type(4)));
typedef unsigned u32x2 __attribute__((ext_vector_type(2)));

constexpr int NB = 4, SEQ = 8192, NCTX = 256, D = 1024, NL = 2;
constexpr int CROWS = NB * NCTX;
constexpr int ROWS = CROWS + NB * SEQ;
constexpr int SB = NCTX + SEQ;
constexpr int INW = 4056, NPROJ = 4096;
constexpr int NE = 64, NE1 = 65, TOPK = 8, EH = 256;
constexpr int GRIDW = 64, GRIDH = SEQ / GRIDW;
constexpr int PA_Q = 0, PA_K = 256, PA_V = 512, PA_G = 768, PA_GF = 1024, PA_GB = 1040;
constexpr int PB_R = 1056, PB_K = 1312, PB_V = 1568, PB_WF = 1824, PB_WB = 1856, PB_A = 1888, PB_G = 1920;
constexpr int PC_Z = 1984, PC_X = 2240, PC_DF = 3008, PC_DB = 3012;
constexpr int PD_Q = 3016, PD_Z = 3784, PD_BF = 4040, PD_BB = 4044, PD_AF = 4048, PD_AB = 4052;
enum { I_X = 0, I_C, I_CTX, I_CCTX, I_N1G, I_N2G, I_WMOD, I_BMOD, I_WIN, I_WOUT, I_GLA_W2, I_GLA_B, I_GLA_NG,
       I_RW_W2, I_RW_W0, I_RW_AW2, I_RW_A0, I_RW_GW2, I_RW_KK, I_RW_KA, I_RW_RK, I_RW_LNG, I_RW_LNB,
       I_SS_CW, I_SS_CB, I_SS_ALOG, I_SS_DTB, I_SS_D, I_SS_NG, I_DN_CW, I_DN_ALOG, I_DN_DTB, I_DN_NG,
       I_ROUT_W, I_ROUT_B, I_EXP_G, I_EXP_U, I_EXP_D, I_SH_G, I_SH_U, I_SH_D, I_FNG, N_IN };
static_assert(N_IN == 42, "input count");

constexpr size_t MiB = 1u << 20;
constexpr size_t WS_CTL = 0, CTL_ZERO_BYTES = 1 * MiB;
constexpr size_t WS_MOD = 1 * MiB;
constexpr size_t WS_RWGW = WS_MOD + 256 * 1024;
constexpr size_t WS_RWLR = WS_MOD + 384 * 1024;
constexpr size_t WS_WIN = 2 * MiB;
constexpr size_t WS_WOUT = 18 * MiB;
constexpr size_t WS_ROUT = 22 * MiB;
constexpr size_t WS_CTXRES = 23 * MiB;
constexpr size_t WS_EXPGU = 27 * MiB;
constexpr size_t WS_EXPD = 92 * MiB;
constexpr size_t WS_HBUF = 125 * MiB;
constexpr size_t WS_PROJ = 191 * MiB;
constexpr size_t WS_SCR = 455 * MiB;
constexpr size_t WS_END = 640455456;
constexpr int HROWS_MAX = ROWS * 9 + NE1 * 256;
constexpr size_t WS_Y = WS_HBUF;
constexpr size_t WS_H = 443 * MiB;
constexpr size_t WS_LTOK = 600 * MiB;
constexpr size_t WS_TOKT = WS_LTOK + (size_t)NE * ROWS * 4;
static_assert(WS_Y + (size_t)HROWS_MAX * 512 * 2 <= WS_H && WS_H + (size_t)HROWS_MAX * 256 * 2 <= WS_LTOK && WS_TOKT + (size_t)ROWS * 64 <= WS_END, "moe overlay");
constexpr size_t SC_OF = WS_SCR;
constexpr size_t SC_OB = SC_OF + (size_t)SB * 1024 * 2;
constexpr size_t SC_RK = SC_OB + (size_t)SB * 1024 * 2;
constexpr size_t SC_RKK = SC_RK + (size_t)SB * 256 * 4;
constexpr size_t SC_RB = SC_RKK + (size_t)SB * 256 * 4;
constexpr size_t SC_RLW = SC_RB + (size_t)SB * 256 * 4;
constexpr size_t SC_SX = SC_RLW + (size_t)2 * SB * 256 * 4;
constexpr size_t SC_DQ = SC_SX + (size_t)SB * 768 * 2;
constexpr size_t SC_SDT = SC_DQ + (size_t)SB * 768 * 2;
constexpr size_t SC_DG = SC_SDT + (size_t)SB * 8 * 4;
constexpr size_t SC_FEND = SC_DG + (size_t)SB * 16 * 4;
constexpr int NTB = SB / 64, NUNIT = NTB * 4 * 2;
constexpr size_t SC_RW_M = SC_FEND;
constexpr size_t SC_RW_NS = SC_RW_M + (size_t)(SB / 64 * 8) * 4096 * 2;
constexpr size_t SC_RW_WU = SC_RW_NS + (size_t)(SB / 64 * 8) * 4096 * 2;
constexpr size_t SC_END = SC_RW_WU + (size_t)(SB / 64 * 8) * 8192 * 2;
constexpr size_t SC2 = WS_EXPGU;
constexpr size_t SC_GLA_S = SC2;
constexpr size_t SC_GLA_DEC = SC_GLA_S + (size_t)NUNIT * 4096 * 4;
constexpr size_t SC_SSD_S = SC_GLA_DEC + (size_t)NUNIT * 64 * 4;
constexpr size_t SC_SSD_CD = SC_SSD_S + (size_t)NUNIT * 8192 * 4;
constexpr size_t SC_DR_M = SC_SSD_CD + (size_t)NUNIT * 4 + 4096;
constexpr size_t SC_DR_NS = SC_DR_M + (size_t)NUNIT * 4096 * 2;
constexpr size_t SC_DR_WU = SC_DR_NS + (size_t)NUNIT * 4096 * 2;
constexpr size_t SC2_END = SC_DR_WU + (size_t)NUNIT * 8192 * 2;
static_assert(SC2_END <= WS_HBUF, "chunk slots fit in the expert-weight region");
static_assert(SC_END <= WS_END, "scratch fits");
constexpr int CW_CNT = 1024;
constexpr int CW_BAR = 4096;

#define LAS __attribute__((address_space(3)))
constexpr int NTHR = 512;
constexpr int LDS_BYTES = 147456;
constexpr int LDS_CTL = 143360;
constexpr int LDS_PTRS = LDS_CTL + 2048;

__device__ __forceinline__ int lane_id_asm() { int l; asm volatile("v_mbcnt_lo_u32_b32 %0, -1, 0\n\tv_mbcnt_hi_u32_b32 %0, -1, %0" : "=v"(l)); return l; }
__device__ __forceinline__ float bf2f(bf16_t b) { return __uint_as_float(((unsigned)b) << 16); }
typedef float f32x2_t __attribute__((ext_vector_type(2))); typedef __bf16 bf16x2_t __attribute__((ext_vector_type(2)));
__device__ __forceinline__ unsigned pk2(float lo, float hi) { const f32x2_t v = {lo, hi}; return __builtin_bit_cast(unsigned, __builtin_convertvector(v, bf16x2_t)); }
__device__ __forceinline__ unsigned f2bf(float f) { return pk2(f, 0.f) & 0xffffu; }
__device__ __forceinline__ float rl(float x, int k) { return __uint_as_float(__builtin_amdgcn_readlane(__float_as_uint(x), k)); }
__device__ __forceinline__ float shx_(float v, int lane, int o) { return __uint_as_float(__builtin_amdgcn_ds_bpermute((lane ^ o) << 2, __float_as_uint(v))); }
__device__ __forceinline__ int shxi_(int v, int lane, int o) { return __builtin_amdgcn_ds_bpermute((lane ^ o) << 2, v); }
__device__ __forceinline__ float shup_(float v, int lane, int o) { return __uint_as_float(__builtin_amdgcn_ds_bpermute((lane - o) << 2, __float_as_uint(v))); }
#define DPPF(v, ctrl) __uint_as_float(__builtin_amdgcn_update_dpp(0, __float_as_uint(v), ctrl, 0xf, 0xf, false))
#define DPPI(v, ctrl) __builtin_amdgcn_update_dpp(0, (v), ctrl, 0xf, 0xf, false)
__device__ __forceinline__ float wsum(float v) {
    v += DPPF(v, 0xB1); v += DPPF(v, 0x4E); v += DPPF(v, 0x141); v += DPPF(v, 0x140);
    v += __uint_as_float(__builtin_amdgcn_ds_swizzle(__float_as_uint(v), 0x401F));
    return rl(v, 0) + rl(v, 32);
}
__device__ __forceinline__ float rcp_(float x) { return __builtin_amdgcn_rcpf(x); }
__device__ __forceinline__ float rsq_(float x) { return __builtin_amdgcn_rsqf(x); }
__device__ __forceinline__ float sigmoidf_(float x) { return rcp_(1.0f + __expf(-x)); }
__device__ __forceinline__ float siluf_(float x) { return x * rcp_(1.0f + __expf(-x)); }
__device__ __forceinline__ float log1pexp_(float t  ) { return t < 1e-4f ? t - 0.5f * t * t : __logf(1.0f + t); }
__device__ __forceinline__ float softplusf_(float x) { return x > 15.f ? x : log1pexp_(__expf(x)); }
__device__ __forceinline__ float logsigmoidf_(float x) { return fminf(x, 0.f) - log1pexp_(__expf(-fabsf(x))); }
__device__ __forceinline__ float tanhf_(float x) { const float e = __expf(2.0f * fminf(fmaxf(x, -15.f), 15.f)); return (e - 1.0f) * rcp_(e + 1.0f); }
__device__ __forceinline__ int seq_tok(int i, int d) { return d == 0 ? i : (i < NCTX ? NCTX - 1 - i : SB + NCTX - 1 - i); }
__device__ __forceinline__ int tok_row(int b, int s) { return s < NCTX ? b * NCTX + s : CROWS + b * SEQ + (s - NCTX); }

#define GAS __attribute__((address_space(1)))
struct Params { const float* in[N_IN]; float* out; unsigned char* ws; int lo, hi, li, pad; };
struct Cx { unsigned long long out, ws; int tid, bid, G, pad; };
__device__ __forceinline__ const float* PIN(int i) {
    extern __shared__ __attribute__((aligned(16))) unsigned char lds_raw_[];
    int off = __builtin_amdgcn_readfirstlane(LDS_PTRS + 8 * i); asm volatile("" : "+s"(off));
    const LAS unsigned* t = (const LAS unsigned*)((LAS unsigned char*)lds_raw_ + off);
    const unsigned lo = __builtin_amdgcn_readfirstlane(t[0]), hi = __builtin_amdgcn_readfirstlane(t[1]);
    return (const float*)(const GAS float*)(((unsigned long long)hi << 32) | lo);
}
#define XB_TMO      128
#define XB_XCNT(j)  (256  + 64 * (j))
#define XB_XSUB(j)  (1280 + 64 * (j))
#define XB_XGEN(j)  (2304 + 64 * (j))
#define XB_TOP      3328
#define XB_TOPGEN   3392
#define XCD_BAR_WORDS 3456
#define XB_SPIN_CAP (1u << 18)

__device__ __forceinline__ unsigned xb_ld(unsigned* p)              { return __hip_atomic_load(p, __ATOMIC_RELAXED, __HIP_MEMORY_SCOPE_AGENT); }
__device__ __forceinline__ unsigned xb_add(unsigned* p, unsigned v) { return __hip_atomic_fetch_add(p, v, __ATOMIC_RELAXED, __HIP_MEMORY_SCOPE_AGENT); }
__device__ __forceinline__ unsigned xb_xcc_id() { return (unsigned)__builtin_amdgcn_s_getreg((3 << 11) | 20) & 0xFu; }
#define XB_SPIN(cond, bar) do { unsigned _sp = 0; while (cond) { __builtin_amdgcn_s_sleep(1); \
    if ((++_sp & 255u) == 0u) { if (xb_ld(&(bar)[XB_TMO])) break; if (_sp > XB_SPIN_CAP) { atomicAdd(&(bar)[XB_TMO], 1u); break; } } } } while (0)

struct XcdBarrier {
    unsigned* bar; unsigned x;
    volatile LAS unsigned* st;
};

__device__ __forceinline__ XcdBarrier xcd_barrier_post(unsigned* bar, volatile LAS unsigned* st, const unsigned xb_tid) {
    XcdBarrier b; b.bar = bar; b.x = xb_xcc_id(); b.st = st;
    if (xb_tid == 0) (void)xb_add(&bar[XB_XCNT(b.x)], 1u);
    return b;
}
__device__ __forceinline__ void xcd_barrier_complete(unsigned* bar, unsigned x, unsigned& nloc, unsigned& nx) {
    const unsigned G = gridDim.x * gridDim.y * gridDim.z;
    unsigned sum, cnt, mine, sp = 0u;
    for (;;) {
        sum = 0u; cnt = 0u; mine = 0u;
#pragma unroll
        for (unsigned j = 0; j < 16; ++j) { const unsigned c = xb_ld(&bar[XB_XCNT(j)]); sum += c; cnt += (c > 0u) ? 1u : 0u; mine = (j == x) ? c : mine; }
        if (sum == G) break;
        __builtin_amdgcn_s_sleep(1);
        if ((++sp & 255u) == 0u) { if (xb_ld(&bar[XB_TMO])) break; if (sp > XB_SPIN_CAP) { atomicAdd(&bar[XB_TMO], 1u); break; } }
    }
    nloc = mine > 0u ? mine : 1u; nx = cnt > 0u ? cnt : 1u;
}

__device__ __forceinline__ void xcd_barrier(const XcdBarrier& b, const unsigned xb_tid) {
    asm volatile("s_waitcnt vmcnt(0)" ::: "memory");
    __syncthreads();
    if (xb_tid == 0) {
        unsigned* bar = b.bar;
        __builtin_amdgcn_s_waitcnt(0);
        unsigned nloc = b.st[0], nx = b.st[1];
        if (nloc == 0u) { xcd_barrier_complete(bar, b.x, nloc, nx); b.st[0] = nloc; b.st[1] = nx; }
        const unsigned old = xb_add(&bar[XB_XSUB(b.x)], 1u);
        const unsigned gen = old / nloc;
        if (old + 1u == (gen + 1u) * nloc) {
            __builtin_amdgcn_fence(__ATOMIC_RELEASE, "agent");
            asm volatile("s_waitcnt vmcnt(0)" ::: "memory");
            const unsigned og = xb_add(&bar[XB_TOP], 1u);
            const unsigned tg = og / nx;
            if (og + 1u == (tg + 1u) * nx) xb_add(&bar[XB_TOPGEN], 1u);
            else XB_SPIN(xb_ld(&bar[XB_TOPGEN]) == tg, bar);
            __builtin_amdgcn_fence(__ATOMIC_ACQUIRE, "agent");
            xb_add(&bar[XB_XGEN(b.x)], 1u);
            asm volatile("s_waitcnt vmcnt(0)" ::: "memory");
        } else {
            XB_SPIN(xb_ld(&bar[XB_XGEN(b.x)]) == gen, bar);
            __builtin_amdgcn_fence(__ATOMIC_ACQUIRE, "agent");
            asm volatile("s_waitcnt vmcnt(0)" ::: "memory");
        }
    }
    __syncthreads();
}

namespace pg8 {
constexpr int BM = 256, BK = 64, HALF = 128, HTB = HALF * BK * 2  , STAGE_BYTES = 8 * HTB, NXCD = 8, WGM = 8;
__host__ __device__ __forceinline__ int lds_byte(int r, int c) { const int st = (r >> 4) * 2 + (c >> 5), rr = r & 15, cc = c & 31, ob = rr * 64 + cc * 2; return st * 1024 + (ob ^ (((ob >> 9) & 1) << 5)); }
__host__ __device__ __forceinline__ void stage_rc(int b, int& R, int& C) { const int st = b / 1024, sb = b % 1024, swz = sb ^ (((sb >> 9) & 1) << 5); R = (st >> 1) * 16 + swz / 64; C = (st & 1) * 32 + (swz % 64) / 2; }
__host__ __device__ __forceinline__ int perm32(int rho) { const int n = rho >> 4, i = rho & 15; return 8 * (i >> 2) + 4 * n + (i & 3); }

struct Unit { int pm, pn, e, r0; };

__device__ __forceinline__ unsigned cvt_pk_bf16(float lo, float hi) { unsigned r; asm volatile("v_cvt_pk_bf16_f32 %0, %1, %2" : "=v"(r) : "v"(lo), "v"(hi)); return r; }

template <int K, class Epi, class Sched>
__device__ __forceinline__ void gemm_phase(const int tid, LAS unsigned char* lds, const char* Abase, const Sched& S, const Epi& E) {
    const int wid = __builtin_amdgcn_readfirstlane(tid >> 6), lane = tid & 63, wr = wid >> 2, wc = wid & 3, fr = lane & 15, fq = lane >> 4;
    const int nt = K / BK;
    constexpr bool DN = Sched::DENSE;
    int RA[2], CA[2]; unsigned voffB[2], voffA[2];
#pragma unroll
    for (int i = 0; i < 2; ++i) { int R, C; stage_rc(tid * 16 + i * 8192, R, C); const int Rb = Epi::PERM ? ((R & ~31) + perm32(R & 31)) : R;
        RA[i] = R; CA[i] = C; voffB[i] = (unsigned)(Rb * K + C) * 2u; voffA[i] = (unsigned)(R * K + C) * 2u; }
    const size_t kstep = (size_t)(BK * 2);
    const size_t hstep = (size_t)HALF * K * 2;
    const size_t tstep = 2 * hstep;
    const unsigned ldsw = (unsigned)wid * 1024u;
    const int aoff = lds_byte(wr * 64 + fr, fq * 8), boff = lds_byte(wc * 32 + fr, fq * 8);
#define PG8_SA(b, h) (((b) * 2 + (h)) * HTB)
#define PG8_SB(b, h) ((4 + (b) * 2 + (h)) * HTB)
#define PG8_STAGE(bufoff, gbase, voff) do { _Pragma("unroll") for (int _i = 0; _i < 2; ++_i) \
        __builtin_amdgcn_global_load_lds((const __attribute__((address_space(1))) unsigned*)((const __attribute__((address_space(1))) char*)(gbase) + (voff)[_i]), (LAS unsigned*)(lds + (bufoff) + ldsw + _i * 8192), 16, 0, 0); } while (0)
#define PG8_LDA(dst, b, h) do { _Pragma("unroll") for (int m = 0; m < 4; ++m) _Pragma("unroll") for (int k = 0; k < 2; ++k) dst[m][k] = *(const LAS bf16x8*)(lds + PG8_SA(b, h) + aoff + m * 2048 + k * 1024); } while (0)
#define PG8_LDB(dst, b, h) do { _Pragma("unroll") for (int n = 0; n < 2; ++n) _Pragma("unroll") for (int k = 0; k < 2; ++k) dst[n][k] = *(const LAS bf16x8*)(lds + PG8_SB(b, h) + boff + n * 2048 + k * 1024); } while (0)
#define PG8_MMA(ai, bj, At, Bt) do { __builtin_amdgcn_s_setprio(1); _Pragma("unroll") for (int m = 0; m < 4; ++m) _Pragma("unroll") for (int n = 0; n < 2; ++n) _Pragma("unroll") for (int k = 0; k < 2; ++k) \
        acc[ai][bj][m][n] = __builtin_amdgcn_mfma_f32_16x16x32_bf16(Bt[n][k], At[m][k], acc[ai][bj][m][n], 0, 0, 0); __builtin_amdgcn_s_setprio(0); } while (0)
#define PG8_WAIT_V(n) asm volatile("s_waitcnt vmcnt(" #n ")" ::: "memory")
#define PG8_WAIT_L(n) asm volatile("s_waitcnt lgkmcnt(" #n ")" ::: "memory")
#define PG8_BAR __builtin_amdgcn_s_barrier()
#define PG8_SCHED __builtin_amdgcn_sched_barrier(0)
#define PG8_AOFF(dst, u) do { _Pragma("unroll") for (int _h = 0; _h < 2; ++_h) _Pragma("unroll") for (int _i = 0; _i < 2; ++_i) \
        dst[_h][_i] = ((unsigned)S.a_row(u, _h * HALF + RA[_i]) * (unsigned)K + (unsigned)CA[_i]) * 2u; } while (0)
    Unit cur, nxt; int ui = 0;
    if (!S.next(0, cur)) return;
    f32x4 acc[2][2][4][2];
#pragma unroll
    for (int a = 0; a < 2; ++a)
#pragma unroll
        for (int b = 0; b < 2; ++b)
#pragma unroll
            for (int m = 0; m < 4; ++m)
#pragma unroll
                for (int n = 0; n < 2; ++n) acc[a][b][m][n] = (f32x4){0.f, 0.f, 0.f, 0.f};
    bf16x8 At[4][2], B0[2][2], B1[2][2];
    unsigned cO[2][2], nO[2][2];
    const char* cA = Abase; const char* nA = Abase;
    if constexpr (DN) cA = Abase + (size_t)S.a_row(cur, 0) * K * 2; else PG8_AOFF(cO, cur);
    const char* cB = S.b_ptr(cur);
#define PG8_STA(bufoff, h_, kb_, nx_) do { if constexpr (DN) PG8_STAGE(bufoff, ((nx_) ? nA : cA) + (h_) * hstep + (kb_), voffA); else PG8_STAGE(bufoff, Abase + (kb_), ((nx_) ? nO : cO)[h_]); } while (0)
    PG8_STAGE(PG8_SB(0, 0), cB, voffB); PG8_SCHED; PG8_STA(PG8_SA(0, 0), 0, 0, false); PG8_SCHED; PG8_STAGE(PG8_SB(0, 1), cB + hstep, voffB); PG8_SCHED; PG8_STA(PG8_SA(0, 1), 1, 0, false); PG8_SCHED;
    if (wr == 1) PG8_BAR;
    PG8_WAIT_V(4); PG8_BAR;
    PG8_STAGE(PG8_SB(1, 0), cB + kstep, voffB); PG8_SCHED; PG8_STA(PG8_SA(1, 0), 0, kstep, false); PG8_SCHED; PG8_STAGE(PG8_SB(1, 1), cB + hstep + kstep, voffB); PG8_SCHED;
    PG8_WAIT_V(6); PG8_BAR;
    for (;;) {
        const bool has_next = S.next(ui + 1, nxt);
        const char* nB = cB; nA = cA;
        if (has_next) { if constexpr (DN) nA = Abase + (size_t)S.a_row(nxt, 0) * K * 2; else PG8_AOFF(nO, nxt); nB = S.b_ptr(nxt); }
        else if constexpr (!DN) {
#pragma unroll
            for (int h = 0; h < 2; ++h)
#pragma unroll
                for (int i = 0; i < 2; ++i) nO[h][i] = cO[h][i]; }
        for (int t = 0; t < nt; t += 2) {
            const bool last = (t == nt - 2);
            const size_t k1 = (size_t)(t + 1) * kstep, k2 = last ? 0 : (size_t)(t + 2) * kstep, k3 = k2 + kstep;
            const char* b2 = last ? nB : cB + (size_t)(t + 2) * kstep; const char* b3 = b2 + kstep;
            PG8_LDB(B0, 0, 0); PG8_SCHED; PG8_LDA(At, 0, 0); PG8_STA(PG8_SA(1, 1), 1, k1, false);
            PG8_WAIT_L(8); PG8_BAR; PG8_WAIT_L(0); PG8_MMA(0, 0, At, B0); PG8_BAR; PG8_SCHED;
            PG8_LDB(B1, 0, 1); PG8_STAGE(PG8_SB(0, 0), b2, voffB);
            PG8_BAR; PG8_WAIT_L(0); PG8_MMA(0, 1, At, B1); PG8_BAR;
            PG8_LDA(At, 0, 1); PG8_STA(PG8_SA(0, 0), 0, k2, last);
            PG8_BAR; PG8_WAIT_L(0); PG8_MMA(1, 0, At, B0); PG8_BAR; PG8_SCHED;
            PG8_STAGE(PG8_SB(0, 1), b2 + hstep, voffB);
            PG8_WAIT_V(6); PG8_BAR; PG8_MMA(1, 1, At, B1); PG8_BAR;
            PG8_LDB(B0, 1, 0); PG8_SCHED; PG8_LDA(At, 1, 0); PG8_STA(PG8_SA(0, 1), 1, k2, last);
            PG8_WAIT_L(8); PG8_BAR; PG8_WAIT_L(0); PG8_MMA(0, 0, At, B0); PG8_BAR; PG8_SCHED;
            PG8_LDB(B1, 1, 1); PG8_STAGE(PG8_SB(1, 0), b3, voffB);
            PG8_BAR; PG8_WAIT_L(0); PG8_MMA(0, 1, At, B1); PG8_BAR;
            PG8_LDA(At, 1, 1); PG8_STA(PG8_SA(1, 0), 0, k3, last);
            PG8_BAR; PG8_WAIT_L(0); PG8_MMA(1, 0, At, B0); PG8_BAR; PG8_SCHED;
            PG8_STAGE(PG8_SB(1, 1), b3 + hstep, voffB);
            PG8_WAIT_V(6); PG8_BAR; PG8_MMA(1, 1, At, B1); PG8_BAR;
        }
        E(acc, cur, wid);
        if (!has_next) break;
#pragma unroll
        for (int a = 0; a < 2; ++a)
#pragma unroll
            for (int b = 0; b < 2; ++b)
#pragma unroll
                for (int m = 0; m < 4; ++m)
#pragma unroll
                    for (int n = 0; n < 2; ++n) acc[a][b][m][n] = (f32x4){0.f, 0.f, 0.f, 0.f};
        cur = nxt; cB = nB; cA = nA; ++ui;
        if constexpr (!DN) {
#pragma unroll
        for (int h = 0; h < 2; ++h)
#pragma unroll
            for (int i = 0; i < 2; ++i) cO[h][i] = nO[h][i]; }
    }
    PG8_WAIT_V(0);
    if (wr == 0) PG8_BAR;
    PG8_BAR;
#undef PG8_SA
#undef PG8_SB
#undef PG8_STAGE
#undef PG8_LDA
#undef PG8_LDB
#undef PG8_MMA
#undef PG8_WAIT_V
#undef PG8_WAIT_L
#undef PG8_BAR
#undef PG8_SCHED
#undef PG8_AOFF
#undef PG8_STA
}
}
struct DenseSched {
    static constexpr bool DENSE = true;
    int nM, nN, nwg, G, c, K; const char* Bt;
    __device__ __forceinline__ void init(int M, int N, int K_, const bf16_t* Bt_, int G_, int c_) { nM = M / 256; nN = N / 256; nwg = nM * nN; G = G_; c = c_; K = K_; Bt = (const char*)Bt_; }
    __device__ __forceinline__ bool next(int i, pg8::Unit& u) const {
        const long L = (long)i * G + c; if (L >= nwg) return false;
        int wgid = (int)L; { const int q = nwg / 8, r = nwg % 8, xcd = wgid % 8, off = wgid / 8; wgid = (xcd < r ? xcd * (q + 1) : r * (q + 1) + (xcd - r) * q) + off; }
        const int nig = 8 * nN, gid = wgid / nig, fm = gid * 8, gsz = (nM - fm) < 8 ? (nM - fm) : 8;
        u.pm = fm + ((wgid % nig) % gsz); u.pn = (wgid % nig) / gsz; u.e = 0; u.r0 = 0; return true;
    }
    __device__ __forceinline__ int a_row(const pg8::Unit& u, int r) const { return u.pm * 256 + r; }
    __device__ __forceinline__ const char* b_ptr(const pg8::Unit& u) const { return Bt + (size_t)u.pn * 256 * K * 2; }
};
template <bool GATHER> struct MoeSched {
    static constexpr bool DENSE = !GATHER;
    const LAS int* tstart; const LAS int* cnt; int nN, G, c, K, row_lo; const int* ltok; const char* Bt; size_t bstride;
    __device__ __forceinline__ bool next(int i, pg8::Unit& u) const {
        const long L = (long)i * G + c; const int ntile = __builtin_amdgcn_readfirstlane(tstart[NE1]); if (L >= (long)ntile * nN) return false;
        const int tile = (int)(L / nN); u.pn = (int)(L % nN);
        int e = 0;
#pragma unroll 1
        for (int step = 64; step >= 1; step >>= 1) { const int e2 = e + step; if (e2 <= NE && tstart[e2] <= tile) e = e2; }
        e = __builtin_amdgcn_readfirstlane(e); u.e = e; u.pm = __builtin_amdgcn_readfirstlane(tile); u.pn = __builtin_amdgcn_readfirstlane(u.pn); u.r0 = __builtin_amdgcn_readfirstlane((tile - tstart[e]) * 256); return true;
    }
    __device__ __forceinline__ int a_row(const pg8::Unit& u, int r) const {
        if (!GATHER) return u.pm * 256 + r;
        const int ri = u.r0 + r;
        if (u.e == NE) return ri < cnt[NE] ? row_lo + ri : row_lo;
        return ri < cnt[u.e] ? ltok[(size_t)u.e * ROWS + ri] : row_lo;
    }
    __device__ __forceinline__ const char* b_ptr(const pg8::Unit& u) const { return Bt + (size_t)u.e * bstride + (size_t)u.pn * 256 * K * 2; }
};

struct EpiProj {
    static constexpr bool PERM = true;
    bf16_t* O; int ldc;
    __device__ __forceinline__ void operator()(const f32x4 (&acc)[2][2][4][2], const pg8::Unit& u, const int wid) const {
        const int lane_ = lane_id_asm(), fr = lane_ & 15, fq = lane_ >> 4, wr = wid >> 2, wc = wid & 3;
        const int row0 = u.pm * 256 + wr * 64 + fr, col0 = u.pn * 256 + wc * 32 + 8 * fq;
#pragma unroll
        for (int ai = 0; ai < 2; ++ai)
#pragma unroll
            for (int m = 0; m < 4; ++m) { bf16_t* rowp = O + (size_t)(row0 + ai * 128 + m * 16) * ldc + col0;
#pragma unroll
                for (int bj = 0; bj < 2; ++bj) { const f32x4 v0 = acc[ai][bj][m][0], v1 = acc[ai][bj][m][1];
                    u32x4 w; w.x = pg8::cvt_pk_bf16(v0[0], v0[1]); w.y = pg8::cvt_pk_bf16(v0[2], v0[3]); w.z = pg8::cvt_pk_bf16(v1[0], v1[1]); w.w = pg8::cvt_pk_bf16(v1[2], v1[3]);
                    *(u32x4*)(rowp + bj * 128) = w; } }
    }
};
struct EpiRes {
    static constexpr bool PERM = false;
    const float* xsrc; const float* csrc; float* xdst; float* cdst; const float* gate;
    __device__ __forceinline__ void operator()(const f32x4 (&acc)[2][2][4][2], const pg8::Unit& u, const int wid) const {
        const int lane_ = lane_id_asm(), fr = lane_ & 15, fq = lane_ >> 4, wr = wid >> 2, wc = wid & 3;
        const int col0 = u.pn * 256 + wc * 32 + 4 * fq;
        const bool isc = u.pm < 4; const int sel = isc ? 4 : (u.pm - 4) >> 5;
        const float* src = isc ? csrc + (size_t)u.pm * 256 * D : xsrc + (size_t)(u.pm - 4) * 256 * D;
        float* dst = isc ? cdst + (size_t)u.pm * 256 * D : xdst + (size_t)(u.pm - 4) * 256 * D;
        f32x4 gv[2][2];
#pragma unroll
        for (int bj = 0; bj < 2; ++bj)
#pragma unroll
            for (int n = 0; n < 2; ++n) gv[bj][n] = *(const f32x4*)(gate + sel * 6144 + col0 + bj * 128 + n * 16);
#pragma unroll
        for (int ai = 0; ai < 2; ++ai)
#pragma unroll
            for (int m = 0; m < 4; ++m) { const size_t off = (size_t)(ai * 128 + wr * 64 + m * 16 + fr) * D + col0;
#pragma unroll
                for (int bj = 0; bj < 2; ++bj)
#pragma unroll
                    for (int n = 0; n < 2; ++n) { const f32x4 s = *(const f32x4*)(src + off + bj * 128 + n * 16); *(f32x4*)(dst + off + bj * 128 + n * 16) = s + gv[bj][n] * acc[ai][bj][m][n]; }
                asm volatile("" ::: "memory"); }
    }
};
struct EpiGU {
    static constexpr bool PERM = false;
    bf16_t* H;
    __device__ __forceinline__ void operator()(const f32x4 (&acc)[2][2][4][2], const pg8::Unit& u, const int wid) const {
        const int lane_ = lane_id_asm(), fr = lane_ & 15, fq = lane_ >> 4, wr = wid >> 2, wc = wid & 3;
        const int row0 = u.pm * 256 + wr * 64 + fr;
#pragma unroll
        for (int ai = 0; ai < 2; ++ai)
#pragma unroll
            for (int m = 0; m < 4; ++m) { bf16_t* rowp = H + (size_t)(row0 + ai * 128 + m * 16) * EH + 4 * fq;
#pragma unroll
                for (int bj = 0; bj < 2; ++bj) { const f32x4 g = acc[ai][bj][m][0], up = acc[ai][bj][m][1]; float h[4];
#pragma unroll
                    for (int j = 0; j < 4; ++j) h[j] = g[j] * rcp_(1.0f + __expf(-g[j])) * up[j];
                    u32x2 w; w.x = pg8::cvt_pk_bf16(h[0], h[1]); w.y = pg8::cvt_pk_bf16(h[2], h[3]);
                    *(u32x2*)(rowp + (u.pn * 256 + bj * 128 + wc * 32) / 2) = w; } }
    }
};
struct EpiY {
    static constexpr bool PERM = true;
    bf16_t* Y;
    __device__ __forceinline__ void operator()(const f32x4 (&acc)[2][2][4][2], const pg8::Unit& u, const int wid) const {
        const int lane_ = lane_id_asm(), fr = lane_ & 15, fq = lane_ >> 4, wr = wid >> 2, wc = wid & 3;
        const int row0 = u.pm * 256 + wr * 64 + fr, col0 = u.pn * 256 + wc * 32 + 8 * fq;
#pragma unroll
        for (int ai = 0; ai < 2; ++ai)
#pragma unroll
            for (int m = 0; m < 4; ++m) { bf16_t* rowp = Y + (size_t)(row0 + ai * 128 + m * 16) * 512 + col0;
#pragma unroll
                for (int bj = 0; bj < 2; ++bj) { const f32x4 v0 = acc[ai][bj][m][0], v1 = acc[ai][bj][m][1];
                    u32x4 w; w.x = pg8::cvt_pk_bf16(v0[0], v0[1]); w.y = pg8::cvt_pk_bf16(v0[2], v0[3]); w.z = pg8::cvt_pk_bf16(v1[0], v1[1]); w.w = pg8::cvt_pk_bf16(v1[2], v1[3]);
                    *(u32x4*)(rowp + bj * 128) = w; } }
    }
};
#define WSP(T, off) ((T*)(GAS T*)(p.ws + (unsigned long long)(off)))
#define POUT ((float*)(GAS float*)p.out)

constexpr int CONV_A_UNITS = 2048 + 512 + 64 + 8 + 12;
struct ConvDesc { const float* src; bf16_t* dst; int ldsrc, lddst, k0, n0, mode, nvalid; };
struct ConvDescA { int dummy;
    __device__ __forceinline__ ConvDesc operator()(const Cx& p, int u) const { ConvDesc c;
        if (u < 2048) { const int l = u >> 10, r = u & 1023; c.src = PIN(I_WIN) + (size_t)l * D * INW; c.ldsrc = INW; c.k0 = (r >> 6) * 64; c.n0 = (r & 63) * 64; c.nvalid = INW; c.dst = WSP(bf16_t, WS_WIN) + (size_t)l * NPROJ * D; c.lddst = D; c.mode = 0; }
        else if (u < 2560) { const int v = u - 2048, l = v >> 8, r = v & 255; c.src = PIN(I_WOUT) + (size_t)l * D * D; c.ldsrc = D; c.k0 = (r >> 4) * 64; c.n0 = (r & 15) * 64; c.nvalid = D; c.dst = WSP(bf16_t, WS_WOUT) + (size_t)l * D * D; c.lddst = D; c.mode = 0; }
        else if (u >= 2632) { const int v = u - 2632, m = v >> 2, r = v & 3;
            c.src = m < NL ? PIN(I_RW_W2) + (size_t)m * 64 * 256 : PIN(I_RW_AW2); c.ldsrc = 256; c.k0 = 0; c.n0 = r * 64; c.nvalid = 256; c.dst = WSP(bf16_t, WS_RWLR) + (size_t)m * 256 * 64; c.lddst = 64; c.mode = 0; }
        else if (u >= 2624) { const int v = u - 2624, l = v >> 2, r = v & 3;
            c.src = PIN(I_RW_GW2) + (size_t)l * 64 * 256; c.ldsrc = 256; c.k0 = 0; c.n0 = r * 64; c.nvalid = 256; c.dst = WSP(bf16_t, WS_RWGW) + (size_t)l * 256 * 64; c.lddst = 64; c.mode = 0; }
        else { const int v = u - 2560, l = v >> 5, lo = (v >> 4) & 1, r = v & 15;
            c.src = PIN(I_ROUT_W) + (size_t)l * D * NE; c.ldsrc = NE; c.k0 = r * 64; c.n0 = 0; c.nvalid = NE; c.dst = WSP(bf16_t, WS_ROUT) + (size_t)(l * 2 + lo) * NE * D; c.lddst = D; c.mode = lo ? 3 : 0; }
        return c; } };
constexpr int CONV_E_UNITS = NE1 * 192;
struct ConvDescE { int l;
    __device__ __forceinline__ ConvDesc operator()(const Cx& p, int u) const { ConvDesc c; const int e = u / 192, r = u % 192; c.nvalid = 1 << 30;
        if (r < 128) { const int up = r >> 6, q = r & 63;
            c.src = e < NE ? PIN(up ? I_EXP_U : I_EXP_G) + ((size_t)l * NE + e) * D * EH : PIN(up ? I_SH_U : I_SH_G) + (size_t)l * D * EH;
            c.ldsrc = EH; c.k0 = (q >> 2) * 64; c.n0 = (q & 3) * 64; c.dst = WSP(bf16_t, WS_EXPGU) + (size_t)e * 512 * D; c.lddst = D; c.mode = 1 + up; }
        else { const int q = r - 128;
            c.src = e < NE ? PIN(I_EXP_D) + ((size_t)l * NE + e) * EH * D : PIN(I_SH_D) + (size_t)l * EH * D;
            c.ldsrc = D; c.k0 = (q >> 4) * 64; c.n0 = (q & 15) * 64; c.dst = WSP(bf16_t, WS_EXPD) + (size_t)e * D * EH; c.lddst = EH; c.mode = 0; }
        return c; } };
template <class DescF> __device__ __forceinline__ void conv_run(const Cx& p, LAS float* tl, int total, const DescF& df) {
    const int t = p.tid; int u = p.bid; if (u >= total) return;
    float v[8]; ConvDesc c = df(p, u);
#define CONV_LD(cc) _Pragma("unroll") for (int j = 0; j < 8; ++j) { const int idx = t + NTHR * j, k = idx >> 6, n = idx & 63; v[j] = (cc).n0 + n < (cc).nvalid ? (cc).src[(size_t)((cc).k0 + k) * (cc).ldsrc + (cc).n0 + n] : 0.f; }
    CONV_LD(c)
    for (;;) {
#pragma unroll
        for (int j = 0; j < 8; ++j) { const int idx = t + NTHR * j; tl[(idx >> 6) * 65 + (idx & 63)] = v[j]; }
        __syncthreads();
        const int un = u + p.G; const bool more = un < total; const ConvDesc cn = df(p, more ? un : u);
        if (more) { CONV_LD(cn) }
#pragma unroll
        for (int j = 0; j < 4; ++j) { const int pi = t + NTHR * j, n = pi >> 5, k = (pi & 31) * 2; const int nn = c.n0 + n;
            const int row = (c.mode == 0 || c.mode == 3) ? nn : ((nn >> 4) * 32 + (nn & 15) + (c.mode == 2 ? 16 : 0));
            float v0 = tl[k * 65 + n], v1 = tl[(k + 1) * 65 + n];
            if (c.mode == 3) { v0 -= bf2f((bf16_t)f2bf(v0)); v1 -= bf2f((bf16_t)f2bf(v1)); }
            *(unsigned*)(c.dst + (size_t)row * c.lddst + c.k0 + k) = pk2(v0, v1); }
        __syncthreads();
        if (!more) break;
        c = cn; u = un;
    }
#undef CONV_LD
}
__device__ __forceinline__ void phase_mod(const Cx& p, LAS unsigned char* lds) {
    LAS float* sv = (LAS float*)lds; LAS float* red = sv + 5 * D;
    const int tid = p.tid;
    if (p.bid >= 192) return;
    for (int i = tid; i < 5 * D; i += NTHR) { const int j = i >> 10, k = i & 1023; const float c = j < 4 ? PIN(I_C)[j * D + k] : PIN(I_CCTX)[k]; sv[i] = siluf_(c); }
    __syncthreads();
    for (int u = p.bid; u < 192; u += p.G) {
        const int l = u / 96, cb = u % 96, kg = tid >> 6, cl = tid & 63;
        const float* w = PIN(I_WMOD) + (size_t)l * D * 6144 + cb * 64 + cl;
        float a0 = 0.f, a1 = 0.f, a2 = 0.f, a3 = 0.f, a4 = 0.f;
#pragma unroll 32
        for (int kk = 0; kk < 128; ++kk) { const int k = kg * 128 + kk; const float wv = w[(size_t)k * 6144];
            a0 += sv[k] * wv; a1 += sv[D + k] * wv; a2 += sv[2 * D + k] * wv; a3 += sv[3 * D + k] * wv; a4 += sv[4 * D + k] * wv; }
        red[(kg * 5 + 0) * 64 + cl] = a0; red[(kg * 5 + 1) * 64 + cl] = a1; red[(kg * 5 + 2) * 64 + cl] = a2; red[(kg * 5 + 3) * 64 + cl] = a3; red[(kg * 5 + 4) * 64 + cl] = a4;
        __syncthreads();
        if (tid < 320) { const int j = tid >> 6; float s = 0.f;
#pragma unroll
            for (int g = 0; g < 8; ++g) s += red[(g * 5 + j) * 64 + cl];
            WSP(float, WS_MOD)[((size_t)l * 5 + j) * 6144 + cb * 64 + cl] = s + PIN(I_BMOD)[l * 6144 + cb * 64 + cl]; }
        __syncthreads();
    }
}
__device__ __forceinline__ const float* res_row(const Cx& p, int layer_src0, int r) {
    if (r < CROWS) return (layer_src0 ? PIN(I_CTX) : (const float*)WSP(float, WS_CTXRES)) + (size_t)r * D;
    return (layer_src0 ? PIN(I_X) : (const float*)POUT) + (size_t)(r - CROWS) * D;
}
__device__ __forceinline__ int row_sel(int r) { return r < CROWS ? 4 : (r - CROWS) >> 13; }

__device__ __forceinline__ void norm_ld(const float* src, f32x4 (&v)[4], int lane) {
#pragma unroll
    for (int i = 0; i < 4; ++i) v[i] = *(const f32x4*)(src + 256 * i + 4 * lane);
}
__device__ __forceinline__ void norm_fin(const f32x4 (&v)[4], const float* g, const float* shift, const float* scale, bf16_t* dst, const bool tolds, LAS bf16_t* ldst, LAS bf16_t* ldlo, int lane) {
    float ss = 0.f;
#pragma unroll
    for (int i = 0; i < 4; ++i) ss += v[i][0] * v[i][0] + v[i][1] * v[i][1] + v[i][2] * v[i][2] + v[i][3] * v[i][3];
    ss = wsum(ss); const float rstd = rsq_(ss * (1.0f / D) + 1e-6f);
#pragma unroll
    for (int i = 0; i < 4; ++i) { const int col = 256 * i + 4 * lane; const f32x4 gv = *(const f32x4*)(g + col), sh = *(const f32x4*)(shift + col), sc = *(const f32x4*)(scale + col);
        const f32x4 y = v[i] * rstd * gv * (sc + 1.0f) + sh; u32x2 w; w.x = pk2(y[0], y[1]); w.y = pk2(y[2], y[3]);
        *(u32x2*)(dst + col) = w;
        if (tolds) { *(LAS u32x2*)(ldst + col) = w; u32x2 wl;
            wl.x = pk2(y[0] - __uint_as_float(w.x << 16), y[1] - __uint_as_float(w.x & 0xffff0000u)); wl.y = pk2(y[2] - __uint_as_float(w.y << 16), y[3] - __uint_as_float(w.y & 0xffff0000u));
            *(LAS u32x2*)(ldlo + col) = wl; } }
}
struct ModC { int s; f32x4 A[4], B[4];
    __device__ __forceinline__ void load(const float* g, const float* shift, const float* scale, int s_, int lane) { s = s_;
#pragma unroll
        for (int i = 0; i < 4; ++i) { const int col = 256 * i + 4 * lane; A[i] = *(const f32x4*)(g + col) * (*(const f32x4*)(scale + col) + 1.0f); B[i] = *(const f32x4*)(shift + col); } } };
__device__ __forceinline__ void norm_fin2(const f32x4 (&v)[4], const ModC& mc, bf16_t* dst, const bool tolds, LAS bf16_t* ldst, LAS bf16_t* ldlo, int lane) {
    float ss = 0.f;
#pragma unroll
    for (int i = 0; i < 4; ++i) ss += v[i][0] * v[i][0] + v[i][1] * v[i][1] + v[i][2] * v[i][2] + v[i][3] * v[i][3];
    ss = wsum(ss); const float rstd = rsq_(ss * (1.0f / D) + 1e-6f);
#pragma unroll
    for (int i = 0; i < 4; ++i) { const int col = 256 * i + 4 * lane;
        const f32x4 y = v[i] * rstd * mc.A[i] + mc.B[i]; u32x2 w; w.x = pk2(y[0], y[1]); w.y = pk2(y[2], y[3]);
        *(u32x2*)(dst + col) = w;
        if (tolds) { *(LAS u32x2*)(ldst + col) = w; u32x2 wl;
            wl.x = pk2(y[0] - __uint_as_float(w.x << 16), y[1] - __uint_as_float(w.x & 0xffff0000u)); wl.y = pk2(y[2] - __uint_as_float(w.y << 16), y[3] - __uint_as_float(w.y & 0xffff0000u));
            *(LAS u32x2*)(ldlo + col) = wl; } }
}
__device__ __forceinline__ void phase_norm1(const Cx& p, int layer) {
    const int lane = p.tid & 63, wave = p.tid >> 6;
    const float* mod = WSP(float, WS_MOD) + (size_t)layer * 5 * 6144; const float* g = PIN(I_N1G) + layer * D; bf16_t* hb = WSP(bf16_t, WS_HBUF);
    ModC mc; mc.s = -1; f32x4 n0[4], n1[4];
    int r = p.bid * 16 + wave * 2;
    if (r < ROWS) { norm_ld(res_row(p, layer == 0, r), n0, lane); norm_ld(res_row(p, layer == 0, r + 1), n1, lane); }
    for (; r < ROWS; r += p.G * 16) { f32x4 v0[4], v1[4];
#pragma unroll
        for (int i = 0; i < 4; ++i) { v0[i] = n0[i]; v1[i] = n1[i]; }
        const int rn = r + p.G * 16; if (rn < ROWS) { norm_ld(res_row(p, layer == 0, rn), n0, lane); norm_ld(res_row(p, layer == 0, rn + 1), n1, lane); }
        const int s = row_sel(r); if (s != mc.s) mc.load(g, mod + s * 6144 + 0, mod + s * 6144 + 1024, s, lane);
        norm_fin2(v0, mc, hb + (size_t)r * D, false, (LAS bf16_t*)0, (LAS bf16_t*)0, lane);
        norm_fin2(v1, mc, hb + (size_t)(r + 1) * D, false, (LAS bf16_t*)0, (LAS bf16_t*)0, lane); }
}
__device__ __forceinline__ float sum8_(float v) { v += DPPF(v, 0xB1); v += DPPF(v, 0x4E); v += DPPF(v, 0x141); return v; }
__device__ __forceinline__ float sum16_(float v) { v = sum8_(v); v += DPPF(v, 0x140); return v; }
__device__ __forceinline__ void bf8_to_f(const u32x4 w, float (&f)[8]) {
#pragma unroll
    for (int q = 0; q < 4; ++q) { f[2 * q] = __uint_as_float(w[q] << 16); f[2 * q + 1] = __uint_as_float(w[q] & 0xffff0000u); } }
__device__ __forceinline__ void phase_prep(const Cx& p, LAS unsigned char* lds, int layer, int b) {
    const int lane = p.tid & 63, wave = __builtin_amdgcn_readfirstlane(p.tid >> 6);
    const bf16_t* proj = WSP(bf16_t, WS_PROJ);
    const int e0 = p.bid * NTHR + p.tid, e1 = e0 + p.G * NTHR; bf16_t sq0 = 0, sq1 = 0;
#define SCAL_COL(q) ((q) < 8 ? PC_DF + (q) : (q) < 16 ? PD_BF + ((q) - 8) : PD_AF + ((q) - 16))
    if (e0 < SB * 24) sq0 = proj[(size_t)tok_row(b, e0 / 24) * NPROJ + SCAL_COL(e0 % 24)];
    if (e1 < SB * 24) sq1 = proj[(size_t)tok_row(b, e1 / 24) * NPROJ + SCAL_COL(e1 % 24)];
    if (p.bid < SB / 33) {
        constexpr int ATS = 208;
        LAS unsigned char* WWt = lds; LAS unsigned char* AWt = lds + 256 * 144; LAS unsigned char* At = lds + 2 * 256 * 144;
        { const bf16_t* w2c = WSP(bf16_t, WS_RWLR) + (size_t)layer * 256 * 64; const bf16_t* awc = WSP(bf16_t, WS_RWLR) + (size_t)NL * 256 * 64;
#pragma unroll
          for (int q = 0; q < 4; ++q) { const int e = p.tid + NTHR * q, n = e >> 3, ch = e & 7;
              *(LAS u32x4*)(WWt + n * 144 + ch * 16) = *(const u32x4*)(w2c + n * 64 + ch * 8); *(LAS u32x4*)(AWt + n * 144 + ch * 16) = *(const u32x4*)(awc + n * 64 + ch * 8); } }
        const int h = wave & 3, half = wave >> 2, fr = lane & 15, fq = lane >> 4;
        float a0c[4], w0fc[4], w0bc[4], kkc[4], kac[4];
#pragma unroll
        for (int nt = 0; nt < 4; ++nt) { const int c = 64 * h + 16 * nt + fr; a0c[nt] = PIN(I_RW_A0)[layer * 256 + c]; w0fc[nt] = PIN(I_RW_W0)[(layer * 2 + 0) * 256 + c]; w0bc[nt] = PIN(I_RW_W0)[(layer * 2 + 1) * 256 + c];
            kkc[nt] = PIN(I_RW_KK)[layer * 256 + c]; kac[nt] = PIN(I_RW_KA)[layer * 256 + c]; }
        for (int u = p.bid; u < SB / 33; u += p.G) {
            if (p.tid < 33 * 12) { const int tk = p.tid / 12, ch = p.tid % 12; u32x4 w = *(const u32x4*)(proj + (size_t)tok_row(b, u * 33 + tk) * NPROJ + PB_WF + 8 * ch);
                if (ch < 8) {
#pragma unroll
                    for (int q = 0; q < 4; ++q) w[q] = pk2(tanhf_(__uint_as_float(w[q] << 16)), tanhf_(__uint_as_float(w[q] & 0xffff0000u))); }
                *(LAS u32x4*)(At + tk * ATS + ch * 16) = w; }
            bf16_t kvA[4][4], kvB[4];
#pragma unroll
            for (int j = 0; j < 4; ++j) { const bf16_t* pr = proj + (size_t)tok_row(b, u * 33 + 16 * half + 4 * fq + j) * NPROJ + PB_K + 64 * h + fr;
#pragma unroll
                for (int nt = 0; nt < 4; ++nt) kvA[nt][j] = pr[16 * nt]; }
            { const bf16_t* pr = proj + (size_t)tok_row(b, u * 33 + 32) * NPROJ + PB_K + 64 * h + fr;
#pragma unroll
              for (int nt = 0; nt < 4; ++nt) kvB[nt] = pr[16 * nt]; }
            __syncthreads();
#pragma unroll
            for (int pass = 0; pass < 2; ++pass) { if (pass == 1 && half != 0) break;
                const int mt = pass ? 2 : half; f32x4 sa[4], sf[4], sb[4];
                const bf16x8 awf = *(const LAS bf16x8*)(At + (16 * mt + fr) * ATS + fq * 16), awb = *(const LAS bf16x8*)(At + (16 * mt + fr) * ATS + 64 + fq * 16), aa = *(const LAS bf16x8*)(At + (16 * mt + fr) * ATS + 128 + fq * 16);
#pragma unroll
                for (int nt = 0; nt < 4; ++nt) { const int n = 64 * h + 16 * nt + fr; const f32x4 z = (f32x4){0.f, 0.f, 0.f, 0.f};
                    sf[nt] = __builtin_amdgcn_mfma_f32_16x16x32_bf16(awf, *(const LAS bf16x8*)(WWt + n * 144 + fq * 16), z, 0, 0, 0);
                    sb[nt] = __builtin_amdgcn_mfma_f32_16x16x32_bf16(awb, *(const LAS bf16x8*)(WWt + n * 144 + 64 + fq * 16), z, 0, 0, 0);
                    sa[nt] = __builtin_amdgcn_mfma_f32_16x16x32_bf16(aa, *(const LAS bf16x8*)(AWt + n * 144 + layer * 64 + fq * 16), z, 0, 0, 0); }
#pragma unroll
                for (int j = 0; j < 4; ++j) { if (pass == 1 && j > 0) break;
                    const int tk = 16 * mt + 4 * fq + j; const bool valid = tk < 33; const int s = u * 33 + tk;
                    float kv[4], kr[4], ssq = 0.f;
#pragma unroll
                    for (int nt = 0; nt < 4; ++nt) { kv[nt] = bf2f(pass ? kvB[nt] : kvA[nt][j]); kr[nt] = kv[nt] * kkc[nt]; ssq += kr[nt] * kr[nt]; }
                    const float rs = rsq_(sum16_(ssq) + 1e-6f);
#pragma unroll
                    for (int nt = 0; nt < 4; ++nt) { const float a = sigmoidf_(sa[nt][j] + a0c[nt]);
                        const float lwf = -__expf(-softplusf_(-(sf[nt][j] + w0fc[nt])) - 0.5f), lwb = -__expf(-softplusf_(-(sb[nt][j] + w0bc[nt])) - 0.5f);
                        const float kk = kr[nt] * rs; const size_t o = (size_t)s * 256 + 64 * h + 16 * nt + fr;
                        if (valid) { WSP(float, SC_RK)[o] = kv[nt] * (1.0f + (a - 1.0f) * kac[nt]); WSP(float, SC_RKK)[o] = kk; WSP(float, SC_RB)[o] = kk * a;
                            WSP(float, SC_RLW)[o] = lwf; WSP(float, SC_RLW)[(size_t)SB * 256 + o] = lwb; } } } }
            __syncthreads();
        }
    }
    __syncthreads();
    { LAS bf16_t* T = (LAS bf16_t*)lds; const int tid = p.tid; const float* dncw = PIN(I_DN_CW); const float* sscw = PIN(I_SS_CW); const float* sscb = PIN(I_SS_CB);
#define PC_LOAD(uu, v, vh) do { const int mixer_ = (uu) / (NTB * 3), r2_ = (uu) % (NTB * 3), rb_ = r2_ / 3, colbase_ = (mixer_ ? PD_Q : PC_X) + 256 * (r2_ % 3); \
          _Pragma("unroll") for (int q = 0; q < 12; ++q) { const int e = tid + NTHR * q, rr = e >> 11, tok = (e >> 5) & 63, ch = (e & 31) * 8; v[q] = (u32x4){0u, 0u, 0u, 0u}; \
              if (rb_ < 4) { if (rr == 1) v[q] = *(const u32x4*)(proj + (size_t)(b * NCTX + 64 * rb_ + tok) * NPROJ + colbase_ + ch); } \
              else { const int gr = rb_ - 4 + rr - 1; if (gr >= 0 && gr < GRIDH) v[q] = *(const u32x4*)(proj + (size_t)(CROWS + b * SEQ + gr * 64 + tok) * NPROJ + colbase_ + ch); } } \
          vh = (u32x4){0u, 0u, 0u, 0u}; if (tid < 192) { const int rr = tid >> 6, side = (tid >> 5) & 1, ch = (tid & 31) * 8;       \
              if (rb_ < 4 && rr == 1) { const int tk = side ? 64 * (rb_ + 1) : 64 * rb_ - 1; if (tk >= 0 && tk < NCTX) vh = *(const u32x4*)(proj + (size_t)(b * NCTX + tk) * NPROJ + colbase_ + ch); } } \
          { const int chn_ = 256 * (r2_ % 3) + (tid & 255); const float* cw_ = (mixer_ ? dncw : sscw) + (size_t)layer * 9 * 768 + chn_;        \
            _Pragma("unroll") for (int k = 0; k < 9; ++k) w[k] = cw_[k * 768]; bias = mixer_ ? 0.f : sscb[layer * 768 + chn_]; } } while (0)
      int u = p.bid;
      if (u < 2 * NTB * 3) { u32x4 v[12], vh; float w[9], bias; PC_LOAD(u, v, vh);
        for (;;) { const int mixer = u / (NTB * 3), r2 = u % (NTB * 3), rb = r2 / 3, third = r2 % 3;
#pragma unroll
          for (int q = 0; q < 12; ++q) { const int e = tid + NTHR * q, rr = e >> 11, tok = (e >> 5) & 63, ch = (e & 31) * 8; *(LAS u32x4*)(T + (rr * 66 + tok + 1) * 256 + ch) = v[q]; }
          if (tid < 192) { const int rr = tid >> 6, side = (tid >> 5) & 1, ch = (tid & 31) * 8; *(LAS u32x4*)(T + (rr * 66 + (side ? 65 : 0)) * 256 + ch) = vh; }
          __syncthreads();
          const int un = u + p.G; const bool more = un < 2 * NTB * 3;
          float wc[9]; const float bc = bias;
#pragma unroll
          for (int k = 0; k < 9; ++k) wc[k] = w[k];
          if (more) PC_LOAD(un, v, vh);
          { const int c = tid & 255, th = tid >> 8, chn = 256 * third + c;
            bf16_t* dst = (mixer ? WSP(bf16_t, SC_DQ) : WSP(bf16_t, SC_SX)) + (size_t)(64 * rb) * 768 + chn;
#pragma unroll 2
            for (int tk = 0; tk < 32; ++tk) { const int x = 32 * th + tk; float acc = bc;
#pragma unroll
                for (int dy = 0; dy < 3; ++dy)
#pragma unroll
                    for (int dx = 0; dx < 3; ++dx) acc += wc[dy * 3 + dx] * bf2f(T[(dy * 66 + x + dx) * 256 + c]);
                float y = siluf_(acc);
                if (mixer && third < 2) { const float ss = wsum(y * y); y *= rsq_(ss + 1e-6f); if (third == 0) y *= 0.125f; }
                dst[(size_t)x * 768] = (bf16_t)f2bf(y); } }
          __syncthreads();
          if (!more) break;
          u = un; } }
#undef PC_LOAD
#define SCAL_FIN(e_, raw_) do { const int s = (e_) / 24, q = (e_) % 24; const float xv = bf2f(raw_); \
          if (q < 8) { const int d = q >> 2, h = q & 3; WSP(float, SC_SDT)[(size_t)s * 8 + q] = softplusf_(xv + PIN(I_SS_DTB)[(layer * 2 + d) * 4 + h]); } \
          else if (q < 16) { WSP(float, SC_DG)[(size_t)s * 16 + (q - 8)] = sigmoidf_(xv); } \
          else { const int q2 = q - 16, d = q2 >> 2, h = q2 & 3; WSP(float, SC_DG)[(size_t)s * 16 + 8 + q2] = -__expf(PIN(I_DN_ALOG)[(layer * 2 + d) * 4 + h]) * softplusf_(xv + PIN(I_DN_DTB)[(layer * 2 + d) * 4 + h]); } } while (0)
      if (e0 < SB * 24) SCAL_FIN(e0, sq0);
      if (e1 < SB * 24) SCAL_FIN(e1, sq1);
      for (int e = e1 + p.G * NTHR; e < SB * 24; e += p.G * NTHR) { const bf16_t raw = proj[(size_t)tok_row(b, e / 24) * NPROJ + SCAL_COL(e % 24)]; SCAL_FIN(e, raw); }
#undef SCAL_FIN
#undef SCAL_COL
    }
}
__device__ __forceinline__ void phase_scan(const Cx& p, LAS unsigned char* lds, int layer, int b);
__device__ __forceinline__ void phase_post(const Cx& p, LAS unsigned char* lds, int layer, int b) {
    const int tid = p.tid, tsub = tid >> 7, c8 = (tid & 127) * 8, mixer = c8 >> 8, cm = c8 & 255, hh = cm >> 6;
    const bf16_t* proj = WSP(bf16_t, WS_PROJ); const bf16_t* of = WSP(bf16_t, SC_OF); const bf16_t* obk = WSP(bf16_t, SC_OB); bf16_t* yc = WSP(bf16_t, WS_HBUF);
    constexpr int PTS = 144, GTS = 260;
    LAS unsigned char* GWb = lds; LAS unsigned char* SGb = lds + 256 * PTS; LAS float* GT = (LAS float*)(lds + 256 * PTS + 48 * PTS);
    if ((int)p.bid < SB / 33) { const bf16_t* gsrc = WSP(bf16_t, WS_RWGW) + (size_t)layer * 256 * 64;
#pragma unroll
        for (int q = 0; q < 4; ++q) { const int e = tid + NTHR * q, n = e >> 3, ch = e & 7; *(LAS u32x4*)(GWb + n * PTS + ch * 16) = *(const u32x4*)(gsrc + n * 64 + ch * 8); } }
    float g0[8], g1[8], g2[8];
#pragma unroll
    for (int q = 0; q < 8; ++q) { const int c = cm + q; g0[q] = 0.f; g1[q] = 0.f; g2[q] = 0.f;
        if (mixer == 0) g0[q] = PIN(I_GLA_NG)[layer * 256 + c];
        else if (mixer == 1) { g0[q] = PIN(I_RW_LNG)[layer * 256 + c]; g1[q] = PIN(I_RW_LNB)[layer * 256 + c]; g2[q] = PIN(I_RW_RK)[layer * 256 + c]; }
        else if (mixer == 2) { g0[q] = PIN(I_SS_NG)[layer * 256 + c]; g1[q] = PIN(I_SS_D)[layer * 4 + hh]; }
        else g0[q] = PIN(I_DN_NG)[layer * 256 + c]; }
    const int col1 = (mixer == 0 ? PA_G : mixer == 1 ? PB_R : mixer == 2 ? PC_Z : PD_Z) + cm;
    for (int u = p.bid; u < SB / 33; u += p.G) {
        if (tid < 33 * 8) { const int tk = tid >> 3, ch = tid & 7; float gl[8]; bf8_to_f(*(const u32x4*)(proj + (size_t)tok_row(b, u * 33 + tk) * NPROJ + PB_G + 8 * ch), gl);
            *(LAS u32x4*)(SGb + tk * PTS + ch * 16) = (u32x4){pk2(sigmoidf_(gl[0]), sigmoidf_(gl[1])), pk2(sigmoidf_(gl[2]), sigmoidf_(gl[3])), pk2(sigmoidf_(gl[4]), sigmoidf_(gl[5])), pk2(sigmoidf_(gl[6]), sigmoidf_(gl[7]))}; }
        u32x4 rof, rob, ra1, ra2 = (u32x4){0u, 0u, 0u, 0u}; f32x4 rk0 = (f32x4){0.f, 0.f, 0.f, 0.f}, rk1 = rk0;
#define POST_LOAD(t0_) do { const int tk_ = (t0_) + tsub; const int s_ = u * 33 + (tk_ < 33 ? tk_ : 32); const bf16_t* pr_ = proj + (size_t)tok_row(b, s_) * NPROJ; \
        rof = *(const u32x4*)(of + (size_t)s_ * 1024 + c8); rob = *(const u32x4*)(obk + (size_t)s_ * 1024 + c8); ra1 = *(const u32x4*)(pr_ + col1); \
        if (mixer == 1) { ra2 = *(const u32x4*)(pr_ + PB_V + cm); rk0 = *(const f32x4*)(WSP(float, SC_RK) + (size_t)s_ * 256 + cm); rk1 = *(const f32x4*)(WSP(float, SC_RK) + (size_t)s_ * 256 + cm + 4); } \
        else if (mixer == 2) ra2 = *(const u32x4*)(WSP(bf16_t, SC_SX) + (size_t)s_ * 768 + cm); } while (0)
        POST_LOAD(0);
        __syncthreads();
        { const int lane = tid & 63, wave = tid >> 6, fr = lane & 15, fq = lane >> 4; f32x4 acc[3][2];
#pragma unroll
          for (int mt = 0; mt < 3; ++mt) { acc[mt][0] = (f32x4){0.f, 0.f, 0.f, 0.f}; acc[mt][1] = (f32x4){0.f, 0.f, 0.f, 0.f}; }
#pragma unroll
          for (int ks = 0; ks < 2; ++ks) { bf16x8 bb[2];
#pragma unroll
              for (int nt = 0; nt < 2; ++nt) bb[nt] = *(const LAS bf16x8*)(GWb + (16 * (2 * wave + nt) + fr) * PTS + ks * 64 + fq * 16);
#pragma unroll
              for (int mt = 0; mt < 3; ++mt) { const bf16x8 a = *(const LAS bf16x8*)(SGb + (16 * mt + fr) * PTS + ks * 64 + fq * 16);
                  acc[mt][0] = __builtin_amdgcn_mfma_f32_16x16x32_bf16(a, bb[0], acc[mt][0], 0, 0, 0); acc[mt][1] = __builtin_amdgcn_mfma_f32_16x16x32_bf16(a, bb[1], acc[mt][1], 0, 0, 0); } }
#pragma unroll
          for (int mt = 0; mt < 3; ++mt)
#pragma unroll
              for (int nt = 0; nt < 2; ++nt)
#pragma unroll
                  for (int j = 0; j < 4; ++j) GT[(16 * mt + 4 * fq + j) * GTS + 16 * (2 * wave + nt) + fr] = acc[mt][nt][j]; }
        __syncthreads();
#pragma unroll 1
        for (int t0 = 0; t0 < 36; t0 += 4) { const int tk = t0 + tsub; const bool live = tk < 33; const int tkc = live ? tk : 32, s = u * 33 + tkc, row = tok_row(b, s);
            const u32x4 cof = rof, cob = rob, ca1 = ra1, ca2 = ra2; const f32x4 k0 = rk0, k1 = rk1;
            if (t0 + 4 < 36) POST_LOAD(t0 + 4);
            float o[8], a[8], y[8];
            { float t1[8], t2[8]; bf8_to_f(cof, t1); bf8_to_f(cob, t2);
#pragma unroll
              for (int q = 0; q < 8; ++q) o[q] = t1[q] + t2[q]; }
            bf8_to_f(ca1, a);
            if (mixer == 0 || mixer == 3) { float ss = 0.f;
#pragma unroll
                for (int q = 0; q < 8; ++q) ss += o[q] * o[q];
                const float rs = rsq_(sum8_(ss) * (1.0f / 64.0f) + 1e-6f);
#pragma unroll
                for (int q = 0; q < 8; ++q) y[q] = o[q] * rs * g0[q] * siluf_(a[q]);
            } else if (mixer == 2) { float xs[8]; bf8_to_f(ca2, xs); float ss = 0.f;
#pragma unroll
                for (int q = 0; q < 8; ++q) { y[q] = (o[q] + g1[q] * xs[q]) * siluf_(a[q]); ss += y[q] * y[q]; }
                const float rs = rsq_(sum16_(ss) * (1.0f / 128.0f) + 1e-6f);
#pragma unroll
                for (int q = 0; q < 8; ++q) y[q] *= rs * g0[q];
            } else { float vv[8]; bf8_to_f(ca2, vv);
                float su = 0.f, bo = 0.f;
#pragma unroll
                for (int q = 0; q < 8; ++q) { su += o[q]; bo += a[q] * (q < 4 ? k0[q & 3] : k1[q & 3]) * g2[q]; }
                const float mu = sum8_(su) * (1.0f / 64.0f); bo = sum8_(bo); float va = 0.f;
#pragma unroll
                for (int q = 0; q < 8; ++q) { o[q] -= mu; va += o[q] * o[q]; }
                const float rs = rsq_(sum8_(va) * (1.0f / 64.0f) + 64e-5f);
                const f32x4 gt0 = *(const LAS f32x4*)(GT + tkc * GTS + cm), gt1 = *(const LAS f32x4*)(GT + tkc * GTS + cm + 4);
#pragma unroll
                for (int q = 0; q < 8; ++q) y[q] = (o[q] * rs * g0[q] + g1[q] + bo * vv[q]) * (q < 4 ? gt0[q & 3] : gt1[q & 3]); }
            if (live) *(u32x4*)(yc + (size_t)row * D + c8) = (u32x4){pk2(y[0], y[1]), pk2(y[2], y[3]), pk2(y[4], y[5]), pk2(y[6], y[7])};
        }
#undef POST_LOAD
    }
}
constexpr int N2_TILE = 32, N2_STRIDE = 2064;
__device__ __forceinline__ void phase_norm2(const Cx& p, LAS unsigned char* lds, int layer, int row_lo) {
    const int tid = p.tid, lane = tid & 63, wave = __builtin_amdgcn_readfirstlane(tid >> 6), fr = lane & 15, fq = lane >> 4;
    const float* mod = WSP(float, WS_MOD) + (size_t)layer * 5 * 6144; const float* g = PIN(I_N2G) + layer * D; bf16_t* hb = WSP(bf16_t, WS_HBUF);
    const bf16_t* rt = WSP(bf16_t, WS_ROUT) + (size_t)layer * 2 * NE * D;
    LAS float* lg = (LAS float*)(lds + 2 * N2_TILE * N2_STRIDE);
    unsigned* cnt = WSP(unsigned, WS_CTL) + CW_CNT + layer * 80 * 16; int* ltok = WSP(int, WS_LTOK); int* tokt = WSP(int, WS_TOKT);
    const float rbias = PIN(I_ROUT_B)[layer * NE + lane];
    const int nun = (ROWS - row_lo) / N2_TILE;
    ModC mc; mc.s = -1; f32x4 n0[4], n1[4], n2[4], n3[4];
    if ((int)p.bid < nun) { const int r = row_lo + p.bid * N2_TILE + 4 * wave; norm_ld(res_row(p, 0, r), n0, lane); norm_ld(res_row(p, 0, r + 1), n1, lane); norm_ld(res_row(p, 0, r + 2), n2, lane); norm_ld(res_row(p, 0, r + 3), n3, lane); }
    for (int u = p.bid; u < nun; u += p.G) { const int r0 = row_lo + u * N2_TILE;
        { const int tr = 4 * wave, r = r0 + tr;
          const int s = row_sel(r); if (s != mc.s) mc.load(g, mod + s * 6144 + 3072, mod + s * 6144 + 4096, s, lane);
          norm_fin2(n0, mc, hb + (size_t)r * D, true, (LAS bf16_t*)(lds + tr * N2_STRIDE), (LAS bf16_t*)(lds + N2_TILE * N2_STRIDE + tr * N2_STRIDE), lane);
          norm_fin2(n1, mc, hb + (size_t)(r + 1) * D, true, (LAS bf16_t*)(lds + (tr + 1) * N2_STRIDE), (LAS bf16_t*)(lds + N2_TILE * N2_STRIDE + (tr + 1) * N2_STRIDE), lane);
          norm_fin2(n2, mc, hb + (size_t)(r + 2) * D, true, (LAS bf16_t*)(lds + (tr + 2) * N2_STRIDE), (LAS bf16_t*)(lds + N2_TILE * N2_STRIDE + (tr + 2) * N2_STRIDE), lane);
          norm_fin2(n3, mc, hb + (size_t)(r + 3) * D, true, (LAS bf16_t*)(lds + (tr + 3) * N2_STRIDE), (LAS bf16_t*)(lds + N2_TILE * N2_STRIDE + (tr + 3) * N2_STRIDE), lane); }
        __syncthreads();
        { const int mt = wave >> 2, nt = wave & 3; f32x4 acc = (f32x4){0.f, 0.f, 0.f, 0.f};
          const LAS unsigned char* ap = lds + (16 * mt + fr) * N2_STRIDE + fq * 16; const bf16_t* bp = rt + (size_t)(16 * nt + fr) * D + fq * 8;
#pragma unroll 8
          for (int ks = 0; ks < 32; ++ks) { const bf16x8 a = *(const LAS bf16x8*)(ap + ks * 64), al = *(const LAS bf16x8*)(ap + N2_TILE * N2_STRIDE + ks * 64);
              const bf16x8 bb = *(const bf16x8*)(bp + ks * 32), bl = *(const bf16x8*)(bp + NE * D + ks * 32);
              acc = __builtin_amdgcn_mfma_f32_16x16x32_bf16(a, bb, acc, 0, 0, 0); acc = __builtin_amdgcn_mfma_f32_16x16x32_bf16(al, bb, acc, 0, 0, 0); acc = __builtin_amdgcn_mfma_f32_16x16x32_bf16(a, bl, acc, 0, 0, 0); }
#pragma unroll
          for (int j = 0; j < 4; ++j) lg[(16 * mt + 4 * fq + j) * 64 + 16 * nt + fr] = acc[j]; }
        __syncthreads();
        { const int un = u + p.G; if (un < nun) { const int rn = row_lo + un * N2_TILE + 4 * wave; norm_ld(res_row(p, 0, rn), n0, lane); norm_ld(res_row(p, 0, rn + 1), n1, lane); norm_ld(res_row(p, 0, rn + 2), n2, lane); norm_ld(res_row(p, 0, rn + 3), n3, lane); } }
#pragma unroll 1
        for (int i = 0; i < 4; ++i) { const int tr = 4 * wave + i, r = r0 + tr;
            const float sc = sigmoidf_(lg[tr * 64 + lane]); float sel = sc + rbias; float ssum = 0.f; int myE = 0; float myS = 0.f;
#pragma unroll 1
            for (int k = 0; k < TOPK; ++k) { float bv = sel; int bi = lane;
#define ARGSTEP(OV, OI) do { const float ov_ = (OV); const int oi_ = (OI); if (ov_ > bv || (ov_ == bv && oi_ < bi)) { bv = ov_; bi = oi_; } } while (0)
                ARGSTEP(DPPF(bv, 0xB1), DPPI(bi, 0xB1)); ARGSTEP(DPPF(bv, 0x4E), DPPI(bi, 0x4E)); ARGSTEP(DPPF(bv, 0x141), DPPI(bi, 0x141)); ARGSTEP(DPPF(bv, 0x140), DPPI(bi, 0x140));
                ARGSTEP(__uint_as_float(__builtin_amdgcn_ds_swizzle(__float_as_uint(bv), 0x401F)), __builtin_amdgcn_ds_swizzle(bi, 0x401F));
                { const float v0 = rl(bv, 0), v1 = rl(bv, 32); const int i0 = __builtin_amdgcn_readlane(bi, 0), i1 = __builtin_amdgcn_readlane(bi, 32); if (v1 > v0 || (v1 == v0 && i1 < i0)) { bv = v1; bi = i1; } else { bv = v0; bi = i0; } }
#undef ARGSTEP
                const int e = __builtin_amdgcn_readfirstlane(bi); const float se = rl(sc, e);
                ssum += se; if (lane == k) { myE = e; myS = se; } if (lane == e) sel = -1e30f; }
            if (lane < TOPK) { const unsigned pos = atomicAdd(cnt + myE * 16, 1u); ltok[(size_t)myE * ROWS + pos] = r; tokt[(size_t)r * 16 + lane] = (myE << 16) | (int)pos; ((float*)tokt)[(size_t)r * 16 + 8 + lane] = myS / ssum * 2.5f; } }
        __syncthreads();
    }
}
__device__ __forceinline__ void moe_table(const Cx& p, LAS int* tb, int layer, int row_lo) {
    const unsigned* cnt = WSP(unsigned, WS_CTL) + CW_CNT + layer * 80 * 16;
    if (p.tid < 64) { const int lane = p.tid;
        const int c = (int)__hip_atomic_load(cnt + lane * 16, __ATOMIC_RELAXED, __HIP_MEMORY_SCOPE_AGENT); const int t = (c + 255) >> 8; int incl = t;
#pragma unroll
        for (int o = 1; o < 64; o <<= 1) { const int v = __builtin_amdgcn_ds_bpermute((lane - o) << 2, incl); if (lane >= o) incl += v; }
        tb[lane] = c; tb[128 + lane] = incl - t;
        if (lane == 63) { const int cs = ROWS - row_lo; tb[NE] = cs; tb[128 + NE] = incl; tb[128 + NE1] = incl + ((cs + 255) >> 8); } }
    __syncthreads();
}
__device__ __forceinline__ void phase_combine(const Cx& p, const LAS int* tb, int layer, int row_lo, int half) {
    const int lane = p.tid & 63, wave = p.tid >> 6; const bf16_t* Y = WSP(bf16_t, WS_Y); const int* tokt = WSP(int, WS_TOKT);
    const float* gate = WSP(float, WS_MOD) + (size_t)layer * 5 * 6144 + 5120; const int col = 512 * half + 8 * lane; const int shbase = tb[128 + NE] * 256;
#pragma unroll 2
    for (int r = row_lo + p.bid * 8 + wave; r < ROWS; r += p.G * 8) {
        const int sw = lane < 16 ? tokt[(size_t)r * 16 + lane] : 0;
        float a[8];
        { const u32x4 y = *(const u32x4*)(Y + (size_t)(shbase + (r - row_lo)) * 512 + 8 * lane);
#pragma unroll
          for (int q = 0; q < 4; ++q) { a[2 * q] = __uint_as_float(y[q] << 16); a[2 * q + 1] = __uint_as_float(y[q] & 0xffff0000u); } }
#pragma unroll
        for (int k = 0; k < 8; ++k) { const int sl = __builtin_amdgcn_readlane(sw, k); const float w = __uint_as_float(__builtin_amdgcn_readlane(sw, 8 + k));
            const int hrow = tb[128 + (sl >> 16)] * 256 + (sl & 0xffff); const u32x4 y = *(const u32x4*)(Y + (size_t)hrow * 512 + 8 * lane);
#pragma unroll
            for (int q = 0; q < 4; ++q) { a[2 * q] += w * __uint_as_float(y[q] << 16); a[2 * q + 1] += w * __uint_as_float(y[q] & 0xffff0000u); } }
        float* x = (float*)res_row(p, 0, r) + col; const float* gp = gate + row_sel(r) * 6144 + col;
#pragma unroll
        for (int q = 0; q < 2; ++q) { const f32x4 gv = *(const f32x4*)(gp + 4 * q); f32x4 xv = *(const f32x4*)(x + 4 * q);
            xv[0] += gv[0] * a[4 * q]; xv[1] += gv[1] * a[4 * q + 1]; xv[2] += gv[2] * a[4 * q + 2]; xv[3] += gv[3] * a[4 * q + 3]; *(f32x4*)(x + 4 * q) = xv; }
    }
}
__device__ __forceinline__ void phase_final(const Cx& p) {
    const int lane = p.tid & 63, wave = p.tid >> 6; const float* g = PIN(I_FNG); f32x4 gv[4], n[2][4];
#pragma unroll
    for (int i = 0; i < 4; ++i) gv[i] = *(const f32x4*)(g + 256 * i + 4 * lane);
    int r = p.bid * 16 + wave * 2;
    if (r < NB * SEQ) { norm_ld(POUT + (size_t)r * D, n[0], lane); norm_ld(POUT + (size_t)(r + 1) * D, n[1], lane); }
    for (; r < NB * SEQ; r += p.G * 16) { f32x4 v[2][4];
#pragma unroll
        for (int q = 0; q < 2; ++q)
#pragma unroll
            for (int i = 0; i < 4; ++i) v[q][i] = n[q][i];
        const int rn = r + p.G * 16; if (rn < NB * SEQ) { norm_ld(POUT + (size_t)rn * D, n[0], lane); norm_ld(POUT + (size_t)(rn + 1) * D, n[1], lane); }
#pragma unroll
        for (int q = 0; q < 2; ++q) { float* x = POUT + (size_t)(r + q) * D; float ss = 0.f;
#pragma unroll
            for (int i = 0; i < 4; ++i) ss += v[q][i][0] * v[q][i][0] + v[q][i][1] * v[q][i][1] + v[q][i][2] * v[q][i][2] + v[q][i][3] * v[q][i][3];
            ss = wsum(ss); const float rstd = rsq_(ss * (1.0f / D) + 1e-6f);
#pragma unroll
            for (int i = 0; i < 4; ++i) *(f32x4*)(x + 256 * i + 4 * lane) = v[q][i] * rstd * gv[i]; } }
}
__device__ __forceinline__ int chain_tb(int n, int d) { return d == 0 ? n : (n < 4 ? 3 - n : 135 - n); }
__device__ __forceinline__ int cslot(int u) { return (u & 7) * NTB + (u >> 3); }
__device__ __forceinline__ int tb_row0(int b, int tb) { return tb < 4 ? b * NCTX + 64 * tb : CROWS + b * SEQ + 64 * (tb - 4); }
constexpr int TS = 144;
template <int K, int NT> __device__ __forceinline__ void mm_rows(const LAS unsigned char* A, int lda, const LAS unsigned char* Bt, int ldb, int mt, int nt0, int fr, int fq, f32x4 (&acc)[NT]) {
#pragma unroll
    for (int ks = 0; ks < K / 32; ++ks) { const bf16x8 a = *(const LAS bf16x8*)(A + (16 * mt + fr) * lda + ks * 64 + fq * 16);
#pragma unroll
        for (int nt = 0; nt < NT; ++nt) { const bf16x8 bb = *(const LAS bf16x8*)(Bt + (16 * (nt0 + nt) + fr) * ldb + ks * 64 + fq * 16);
            acc[nt] = __builtin_amdgcn_mfma_f32_16x16x32_bf16(a, bb, acc[nt], 0, 0, 0); } }
}
#define UNIT_LOOP(u, N, OFF) for (int u = (p.bid + p.G - ((OFF) % p.G)) % p.G; u < (N); u += p.G)
__device__ __forceinline__ void gla_p1(const Cx& p, LAS unsigned char* lds0, int layer, int b) {
    const int tid = p.tid, lane = tid & 63, wave = __builtin_amdgcn_readfirstlane(tid >> 6), fr = lane & 15, fq = lane >> 4;
    int par = 0;
    const bf16_t* proj = WSP(bf16_t, WS_PROJ); const int mt = wave >> 1, nt0 = (wave & 1) * 2; const int cl = lane, tg = wave;
    const float* w2p = PIN(I_GLA_W2); const float* gbp = PIN(I_GLA_B);
    float w2[16], gb; unsigned gw; bf16_t kq[8], vq[8];
#define GLA1_LOAD(uu) do { const int tb_ = (uu) >> 3, h_ = ((uu) >> 1) & 3, d_ = (uu) & 1, c_ = 64 * h_ + cl; const bf16_t* pr_ = proj + (size_t)tb_row0(b, tb_) * NPROJ; \
        _Pragma("unroll") for (int r = 0; r < 16; ++r) w2[r] = w2p[((size_t)(layer * 2 + d_) * 16 + r) * 256 + c_]; \
        gb = gbp[(layer * 2 + d_) * 256 + c_]; \
        { const int e = tid * 2, i = e >> 4, r = e & 15; gw = *(const unsigned*)(pr_ + (size_t)i * NPROJ + (d_ ? PA_GB : PA_GF) + r); } \
        _Pragma("unroll") for (int i8 = 0; i8 < 8; ++i8) { const bf16_t* pa = pr_ + (size_t)(8 * tg + i8) * NPROJ; kq[i8] = pa[PA_K + c_]; vq[i8] = pa[PA_V + c_]; } } while (0)
    int u = (p.bid + p.G) % p.G;
    if (u < NUNIT) GLA1_LOAD(u);
    for (; u < NUNIT; u += p.G) { const int d = u & 1;
        LAS unsigned char* lds = lds0 + par * 32768; par ^= 1;
        LAS unsigned char* ksT = lds; LAS unsigned char* vT = lds + 64 * TS; LAS float* gs = (LAS float*)(lds + 2 * 64 * TS); LAS float* glb = gs + 512;
        glb[tid * 2] = __uint_as_float(gw << 16); glb[tid * 2 + 1] = __uint_as_float(gw & 0xffff0000u);
        __syncthreads();
        float bl[8]; float run = 0.f;
#pragma unroll
        for (int ii = 0; ii < 8; ++ii) { const int i8 = d ? 7 - ii : ii; const LAS float* gl_ = glb + (8 * tg + i8) * 16; float z = gb;
#pragma unroll
            for (int r = 0; r < 16; ++r) z += gl_[r] * w2[r];
            run += logsigmoidf_(z) * (1.0f / 16.0f); if (d) bl[7 - ii] = run; else bl[ii] = run; }
        gs[tg * 64 + cl] = run;
        __syncthreads();
        float off = 0.f, total = 0.f;
#pragma unroll
        for (int g2 = 0; g2 < 8; ++g2) { const float t = gs[g2 * 64 + cl]; total += t; if (d ? g2 > tg : g2 < tg) off += t; }
#pragma unroll
        for (int i8 = 0; i8 < 8; i8 += 2) { const int i = 8 * tg + i8;
            const float ka = bf2f(kq[i8]) * __expf(total - (bl[i8] + off)), kb = bf2f(kq[i8 + 1]) * __expf(total - (bl[i8 + 1] + off));
            *(LAS unsigned*)(ksT + cl * TS + i * 2) = pk2(ka, kb); *(LAS unsigned*)(vT + cl * TS + i * 2) = (unsigned)vq[i8] | ((unsigned)vq[i8 + 1] << 16); }
        if (u + p.G < NUNIT) GLA1_LOAD(u + p.G);
        if (tg == 0) WSP(float, SC_GLA_DEC)[(size_t)cslot(u) * 64 + cl] = __expf(total);
        __syncthreads();
        { f32x4 acc[2] = {(f32x4){0.f, 0.f, 0.f, 0.f}, (f32x4){0.f, 0.f, 0.f, 0.f}}; float* kv = WSP(float, SC_GLA_S) + (size_t)cslot(u) * 4096;
          mm_rows<64, 2>(vT, TS, ksT, TS, mt, nt0, fr, fq, acc);
#pragma unroll
          for (int t = 0; t < 2; ++t) *(f32x4*)(kv + (16 * (nt0 + t) + fr) * 64 + 16 * mt + 4 * fq) = acc[t]; }
    }
#undef GLA1_LOAD
}
__device__ __forceinline__ void gla_chain(const Cx& p, int h, int d, int part) {
    if (p.tid >= 256) return;
    const int e0 = part * 1024 + p.tid * 4, dk = e0 >> 6;
    f32x4 s0 = (f32x4){0.f, 0.f, 0.f, 0.f};
    f32x4 n0[12]; float dc[12];
#define GC_LD(q, n_) do { const int u_ = cslot((chain_tb((n_), d) * 4 + h) * 2 + d); n0[q] = *(const f32x4*)(WSP(float, SC_GLA_S) + (size_t)u_ * 4096 + e0); dc[q] = WSP(float, SC_GLA_DEC)[(size_t)u_ * 64 + dk]; } while (0)
#define GC_ST(q, n_) do { const int u_ = cslot((chain_tb((n_), d) * 4 + h) * 2 + d); float* k_ = WSP(float, SC_GLA_S) + (size_t)u_ * 4096 + e0; \
        const f32x4 a0_ = n0[q]; const float de_ = dc[q]; GC_LD(q, (n_) + 12 < NTB ? (n_) + 12 : NTB - 1); *(f32x4*)k_ = s0; s0 = s0 * de_ + a0_; } while (0)
    GC_LD(0, 0); GC_LD(1, 1); GC_LD(2, 2); GC_LD(3, 3); GC_LD(4, 4); GC_LD(5, 5); GC_LD(6, 6); GC_LD(7, 7); GC_LD(8, 8); GC_LD(9, 9); GC_LD(10, 10); GC_LD(11, 11);
#pragma unroll 1
    for (int n = 0; n < NTB; n += 12) { GC_ST(0, n + 0); GC_ST(1, n + 1); GC_ST(2, n + 2); GC_ST(3, n + 3); GC_ST(4, n + 4); GC_ST(5, n + 5); GC_ST(6, n + 6); GC_ST(7, n + 7); GC_ST(8, n + 8); GC_ST(9, n + 9); GC_ST(10, n + 10); GC_ST(11, n + 11); }
#undef GC_LD
#undef GC_ST
}
__device__ __forceinline__ void gla_p2(const Cx& p, LAS unsigned char* lds0, int layer, int b) {
    const int tid = p.tid, lane = tid & 63, wave = __builtin_amdgcn_readfirstlane(tid >> 6), fr = lane & 15, fq = lane >> 4;
    int par = 0;
    const bf16_t* proj = WSP(bf16_t, WS_PROJ); const int cl = lane, tg = wave;
    const float* w2p = PIN(I_GLA_W2); const float* gbp = PIN(I_GLA_B);
    float w2[16], gb; unsigned gw; bf16_t qq[8], kq[8], vq[8]; float sq[8];
#define GLA2_LOAD(uu) do { const int tb_ = (uu) >> 3, h_ = ((uu) >> 1) & 3, d_ = (uu) & 1, c_ = 64 * h_ + cl; const bf16_t* pr_ = proj + (size_t)tb_row0(b, tb_) * NPROJ; \
        _Pragma("unroll") for (int r = 0; r < 16; ++r) w2[r] = w2p[((size_t)(layer * 2 + d_) * 16 + r) * 256 + c_]; \
        gb = gbp[(layer * 2 + d_) * 256 + c_]; \
        { const int e = tid * 2, i = e >> 4, r = e & 15; gw = *(const unsigned*)(pr_ + (size_t)i * NPROJ + (d_ ? PA_GB : PA_GF) + r); } \
        _Pragma("unroll") for (int i8 = 0; i8 < 8; ++i8) { const bf16_t* pa = pr_ + (size_t)(8 * tg + i8) * NPROJ; qq[i8] = pa[PA_Q + c_]; kq[i8] = pa[PA_K + c_]; vq[i8] = pa[PA_V + c_]; } \
        { const float* sp_ = WSP(float, SC_GLA_S) + (size_t)cslot(uu) * 4096; _Pragma("unroll") for (int q = 0; q < 8; ++q) sq[q] = sp_[tid + NTHR * q]; } } while (0)
    int u = (p.bid + p.G - (128 % p.G)) % p.G;
    if (u < NUNIT) GLA2_LOAD(u);
    for (; u < NUNIT; u += p.G) { const int tb = u >> 3, h = (u >> 1) & 3, d = u & 1; const int s0 = 64 * tb;
        LAS unsigned char* lds = lds0 + par * 57344; par ^= 1;
        LAS unsigned char* qt = lds; LAS unsigned char* kt = lds + 64 * TS; LAS unsigned char* vT = lds + 2 * 64 * TS; LAS unsigned char* sT = lds + 3 * 64 * TS; LAS unsigned char* att = lds + 4 * 64 * TS;
        LAS float* gs = (LAS float*)(lds + 5 * 64 * TS); LAS float* glb = gs + 512;
        glb[tid * 2] = __uint_as_float(gw << 16); glb[tid * 2 + 1] = __uint_as_float(gw & 0xffff0000u);
#pragma unroll
        for (int q = 0; q < 8; ++q) { const int e = tid + NTHR * q, dk = e >> 6, dv = e & 63; *(LAS bf16_t*)(sT + dv * TS + dk * 2) = (bf16_t)f2bf(sq[q]); }
        __syncthreads();
        float bl[8]; float run = 0.f;
#pragma unroll
        for (int ii = 0; ii < 8; ++ii) { const int i8 = d ? 7 - ii : ii; const LAS float* gl_ = glb + (8 * tg + i8) * 16; float z = gb;
#pragma unroll
            for (int r = 0; r < 16; ++r) z += gl_[r] * w2[r];
            run += logsigmoidf_(z) * (1.0f / 16.0f); if (d) bl[7 - ii] = run; else bl[ii] = run; }
        gs[tg * 64 + cl] = run;
        __syncthreads();
        float off = 0.f;
#pragma unroll
        for (int g2 = 0; g2 < 8; ++g2) if (d ? g2 > tg : g2 < tg) off += gs[g2 * 64 + cl];
#pragma unroll
        for (int i8 = 0; i8 < 8; ++i8) { const int i = 8 * tg + i8; const float bi = bl[i8] + off;
            *(LAS bf16_t*)(qt + i * TS + cl * 2) = (bf16_t)f2bf(bf2f(qq[i8]) * 0.125f * __expf(bi));
            *(LAS bf16_t*)(kt + i * TS + cl * 2) = (bf16_t)f2bf(bf2f(kq[i8]) * __expf(-bi));
            *(LAS bf16_t*)(vT + cl * TS + i * 2) = vq[i8]; }
        if (u + p.G < NUNIT) GLA2_LOAD(u + p.G);
        __syncthreads();
        const int mt = wave >> 1, nt0 = (wave & 1) * 2;
        { f32x4 acc[2] = {(f32x4){0.f, 0.f, 0.f, 0.f}, (f32x4){0.f, 0.f, 0.f, 0.f}};
          mm_rows<64, 2>(qt, TS, kt, TS, mt, nt0, fr, fq, acc);
#pragma unroll
          for (int t = 0; t < 2; ++t)
#pragma unroll
              for (int j = 0; j < 4; ++j) { const int i = 16 * mt + 4 * fq + j, jj = 16 * (nt0 + t) + fr; const bool keep = d ? jj >= i : jj <= i;
                  *(LAS bf16_t*)(att + i * TS + jj * 2) = (bf16_t)f2bf(keep ? acc[t][j] : 0.f); } }
        __syncthreads();
        { f32x4 acc[2] = {(f32x4){0.f, 0.f, 0.f, 0.f}, (f32x4){0.f, 0.f, 0.f, 0.f}};
          mm_rows<64, 2>(vT, TS, att, TS, mt, nt0, fr, fq, acc);
          mm_rows<64, 2>(sT, TS, qt, TS, mt, nt0, fr, fq, acc);
          bf16_t* ob = WSP(bf16_t, d ? SC_OB : SC_OF);
#pragma unroll
          for (int t = 0; t < 2; ++t) *(u32x2*)(ob + (size_t)(s0 + 16 * (nt0 + t) + fr) * 1024 + 64 * h + 16 * mt + 4 * fq) = (u32x2){pk2(acc[t][0], acc[t][1]), pk2(acc[t][2], acc[t][3])}; }
    }
}
#undef GLA2_LOAD
constexpr int TS2 = 272;
__device__ __forceinline__ float ssd_acum(float a, int d, int lane, float& total) {
    float pre = a;
#pragma unroll
    for (int o = 1; o < 64; o <<= 1) { const float t = shup_(pre, lane, o); if (lane >= o) pre += t; }
    total = rl(pre, 63);
    return d ? total - pre + a : pre;
}
__device__ __forceinline__ void ssd_p1(const Cx& p, LAS unsigned char* lds0, int layer, int b) {
    const int tid = p.tid, lane = tid & 63, wave = __builtin_amdgcn_readfirstlane(tid >> 6), fr = lane & 15, fq = lane >> 4;
    int par = 0;
    const float* alogp = PIN(I_SS_ALOG);
    u32x4 bq[2], xq; float dtq;
#define SSD1_LOAD(uu) do { const int tb_ = (uu) >> 3, g_ = ((uu) >> 2) & 1, hd_ = (uu) & 3, h_ = 2 * g_ + (hd_ >> 1), d_ = hd_ & 1; \
        const bf16_t* sx_ = WSP(bf16_t, SC_SX) + (size_t)(64 * tb_ + lane) * 768; \
        bq[0] = *(const u32x4*)(sx_ + 256 + 128 * g_ + 16 * wave); bq[1] = *(const u32x4*)(sx_ + 256 + 128 * g_ + 16 * wave + 8); \
        xq = *(const u32x4*)(sx_ + 64 * h_ + 8 * wave); dtq = WSP(float, SC_SDT)[(size_t)(64 * tb_ + lane) * 8 + d_ * 4 + h_]; } while (0)
    int u3 = (p.bid + p.G - (32 % p.G)) % p.G;
    if (u3 < NTB * 8) SSD1_LOAD(u3);
    for (; u3 < NTB * 8; u3 += p.G) { const int tb = u3 >> 3, g = (u3 >> 2) & 1, hd = u3 & 3, h = 2 * g + (hd >> 1), d = hd & 1;
        LAS unsigned char* lds = lds0 + par * 32768; par ^= 1;
        LAS unsigned char* BT = lds; LAS unsigned char* xT = lds + 128 * TS; LAS float* AC = (LAS float*)(lds + 128 * TS + 64 * TS);
        if (wave == 0) { const float aneg = -__expf(alogp[(layer * 2 + d) * 4 + h]);
            float tot; const float ac = ssd_acum(aneg * dtq, d, lane, tot); AC[lane] = ac; if (lane == 0) { AC[64] = tot; WSP(float, SC_SSD_CD)[cslot((tb * 4 + h) * 2 + d)] = __expf(tot); } }
#pragma unroll
        for (int q = 0; q < 2; ++q)
#pragma unroll
            for (int k = 0; k < 8; ++k) *(LAS bf16_t*)(BT + (16 * wave + 8 * q + k) * TS + lane * 2) = (bf16_t)(bq[q][k >> 1] >> (16 * (k & 1)));
        __syncthreads();
        { const float f = dtq * __expf(AC[64] - AC[lane]);
#pragma unroll
          for (int k = 0; k < 8; ++k) *(LAS bf16_t*)(xT + (8 * wave + k) * TS + lane * 2) = (bf16_t)f2bf(bf2f((bf16_t)(xq[k >> 1] >> (16 * (k & 1)))) * f); }
        if (u3 + p.G < NTB * 8) SSD1_LOAD(u3 + p.G);
        __syncthreads();
        { float* cs = WSP(float, SC_SSD_S) + (size_t)cslot((tb * 4 + h) * 2 + d) * 8192; f32x4 acc[4];
#pragma unroll
          for (int t = 0; t < 4; ++t) acc[t] = (f32x4){0.f, 0.f, 0.f, 0.f};
          mm_rows<64, 4>(BT, TS, xT, TS, wave, 0, fr, fq, acc);
#pragma unroll
          for (int t = 0; t < 4; ++t) *(f32x4*)(cs + (16 * t + fr) * 128 + 16 * wave + 4 * fq) = acc[t]; }
    }
#undef SSD1_LOAD
}
__device__ __forceinline__ void ssd_chain(const Cx& p, int h, int d, int part) {
    if (p.tid >= 256) return;
    const int e0 = part * 1024 + p.tid * 4;
    f32x4 s = (f32x4){0.f, 0.f, 0.f, 0.f}; f32x4 nx[12]; float cd[12];
#define SC_LD(q, n_) do { const int u_ = cslot((chain_tb((n_), d) * 4 + h) * 2 + d); nx[q] = *(const f32x4*)(WSP(float, SC_SSD_S) + (size_t)u_ * 8192 + e0); cd[q] = WSP(float, SC_SSD_CD)[u_]; } while (0)
#define SC_ST(q, n_) do { const int u_ = cslot((chain_tb((n_), d) * 4 + h) * 2 + d); float* c_ = WSP(float, SC_SSD_S) + (size_t)u_ * 8192 + e0; const f32x4 a_ = nx[q]; const float de_ = cd[q]; \
        SC_LD(q, (n_) + 12 < NTB ? (n_) + 12 : NTB - 1); *(f32x4*)c_ = s; s = s * de_ + a_; } while (0)
    SC_LD(0, 0); SC_LD(1, 1); SC_LD(2, 2); SC_LD(3, 3); SC_LD(4, 4); SC_LD(5, 5); SC_LD(6, 6); SC_LD(7, 7); SC_LD(8, 8); SC_LD(9, 9); SC_LD(10, 10); SC_LD(11, 11);
#pragma unroll 1
    for (int n = 0; n < NTB; n += 12) { SC_ST(0, n + 0); SC_ST(1, n + 1); SC_ST(2, n + 2); SC_ST(3, n + 3); SC_ST(4, n + 4); SC_ST(5, n + 5); SC_ST(6, n + 6); SC_ST(7, n + 7); SC_ST(8, n + 8); SC_ST(9, n + 9); SC_ST(10, n + 10); SC_ST(11, n + 11); }
#undef SC_LD
#undef SC_ST
}
__device__ __forceinline__ void ssd_p2(const Cx& p, LAS unsigned char* lds, int layer, int b) {
    const int tid = p.tid, lane = tid & 63, wave = __builtin_amdgcn_readfirstlane(tid >> 6), fr = lane & 15, fq = lane >> 4;
    LAS unsigned char* Ct = lds; LAS unsigned char* Bt2 = lds + 64 * TS2; LAS float* cb = (LAS float*)(lds + 2 * 64 * TS2); LAS float* AC = cb + 64 * 65;
    LAS unsigned char* Mt = (LAS unsigned char*)(AC + 64 + 4); LAS unsigned char* xT = Mt + 64 * TS; LAS unsigned char* Sb = xT + 64 * TS;
    const int mt = wave >> 1, nt0 = (wave & 1) * 2;
    const float* alogp = PIN(I_SS_ALOG);
    u32x4 cq[2], bq[2], xq; float dtq; f32x4 sq[4];
#define SSD2_LOAD(uu) do { const int tb_ = (uu) >> 3, g_ = ((uu) >> 2) & 1, hd_ = (uu) & 3, h_ = 2 * g_ + (hd_ >> 1), d_ = hd_ & 1; \
        const bf16_t* sx_ = WSP(bf16_t, SC_SX) + (size_t)(64 * tb_) * 768; \
        _Pragma("unroll") for (int q = 0; q < 2; ++q) { const int e = tid + NTHR * q, i = e >> 4, ch = e & 15; \
            cq[q] = *(const u32x4*)(sx_ + (size_t)i * 768 + 512 + 128 * g_ + ch * 8); bq[q] = *(const u32x4*)(sx_ + (size_t)i * 768 + 256 + 128 * g_ + ch * 8); } \
        xq = *(const u32x4*)(sx_ + (size_t)lane * 768 + 64 * h_ + 8 * wave); dtq = WSP(float, SC_SDT)[(size_t)(64 * tb_ + lane) * 8 + d_ * 4 + h_]; \
        const float* sp_ = WSP(float, SC_SSD_S) + (size_t)cslot((tb_ * 4 + h_) * 2 + d_) * 8192; \
        _Pragma("unroll") for (int q = 0; q < 4; ++q) sq[q] = *(const f32x4*)(sp_ + (tid + NTHR * q) * 4); } while (0)
    int u3 = (p.bid + p.G - (160 % p.G)) % p.G;
    if (u3 < NTB * 8) SSD2_LOAD(u3);
    for (; u3 < NTB * 8; u3 += p.G) { const int tb = u3 >> 3, g = (u3 >> 2) & 1, hd = u3 & 3, h = 2 * g + (hd >> 1), d = hd & 1, s0 = 64 * tb; (void)g;
        if (wave == 0) { const float aneg = -__expf(alogp[(layer * 2 + d) * 4 + h]); float tot; AC[lane] = ssd_acum(aneg * dtq, d, lane, tot); }
#pragma unroll
        for (int q = 0; q < 2; ++q) { const int e = tid + NTHR * q, i = e >> 4, ch = e & 15;
            *(LAS u32x4*)(Ct + i * TS2 + ch * 16) = cq[q]; *(LAS u32x4*)(Bt2 + i * TS2 + ch * 16) = bq[q]; }
#pragma unroll
        for (int k = 0; k < 8; ++k) *(LAS bf16_t*)(xT + (8 * wave + k) * TS + lane * 2) = (bf16_t)f2bf(bf2f((bf16_t)(xq[k >> 1] >> (16 * (k & 1)))) * dtq);
#pragma unroll
        for (int q = 0; q < 4; ++q) { const int e = (tid + NTHR * q) * 4, pp = e >> 7, s = e & 127; const f32x4 v = sq[q];
            *(LAS u32x2*)(Sb + pp * TS2 + s * 2) = (u32x2){pk2(v[0], v[1]), pk2(v[2], v[3])}; }
        if (u3 + p.G < NTB * 8) SSD2_LOAD(u3 + p.G);
        __syncthreads();
        { f32x4 acc[2] = {(f32x4){0.f, 0.f, 0.f, 0.f}, (f32x4){0.f, 0.f, 0.f, 0.f}};
          mm_rows<128, 2>(Ct, TS2, Bt2, TS2, mt, nt0, fr, fq, acc);
#pragma unroll
          for (int t = 0; t < 2; ++t)
#pragma unroll
              for (int j = 0; j < 4; ++j) cb[(16 * mt + 4 * fq + j) * 65 + 16 * (nt0 + t) + fr] = acc[t][j]; }
        __syncthreads();
        { const int i = tid >> 3, j0 = (tid & 7) * 8; const float ai = AC[i]; unsigned w[4];
#pragma unroll
          for (int jj = 0; jj < 8; jj += 2) { float m[2];
#pragma unroll
              for (int q = 0; q < 2; ++q) { const int j = j0 + jj + q; const bool keep = d ? j >= i : j <= i; const float cv = cb[i * 65 + j], aj = AC[j]; m[q] = keep ? cv * __expf(ai - aj) : 0.f; }
              w[jj >> 1] = pk2(m[0], m[1]); }
          *(LAS u32x4*)(Mt + i * TS + j0 * 2) = (u32x4){w[0], w[1], w[2], w[3]}; }
        __syncthreads();
        { f32x4 acc[2] = {(f32x4){0.f, 0.f, 0.f, 0.f}, (f32x4){0.f, 0.f, 0.f, 0.f}};
          mm_rows<128, 2>(Sb, TS2, Ct, TS2, mt, nt0, fr, fq, acc);
#pragma unroll
          for (int t = 0; t < 2; ++t) { const float sc = __expf(AC[16 * (nt0 + t) + fr]); acc[t] *= sc; }
          mm_rows<64, 2>(xT, TS, Mt, TS, mt, nt0, fr, fq, acc);
          bf16_t* ob = WSP(bf16_t, d ? SC_OB : SC_OF);
#pragma unroll
          for (int t = 0; t < 2; ++t) *(u32x2*)(ob + (size_t)(s0 + 16 * (nt0 + t) + fr) * 1024 + 512 + 64 * h + 16 * mt + 4 * fq) = (u32x2){pk2(acc[t][0], acc[t][1]), pk2(acc[t][2], acc[t][3])}; }
        __syncthreads();
    }
}
#undef SSD2_LOAD
constexpr int AFS = 68;
__device__ __forceinline__ int dr_mfrag_idx(int row, int col) { return (((row >> 4) * 2 + (col >> 5)) * 64 + ((col >> 2) & 3) * 16 + (row & 15)) * 8 + ((col >> 4) & 1) * 4 + (col & 3); }
__device__ __forceinline__ void dr_tinv(const LAS float* AfT, LAS float* Dbuf, const float sgn) {
    LAS unsigned char* TI = (LAS unsigned char*)Dbuf;
    { const int lane = lane_id_asm(), kb_ = lane >> 4, cc = lane & 15; float x[16];
#pragma unroll
        for (int i = 0; i < 16; ++i) x[i] = i == cc ? 1.f : 0.f;
        const LAS float* Ab = AfT + (16 * kb_) * AFS + 16 * kb_;
        f32x4 tri[36];
        { int q = 0;
#pragma unroll
          for (int j = 0; j < 15; ++j)
#pragma unroll
              for (int c4 = (j + 1) / 4; c4 < 4; ++c4) tri[q++] = *(const LAS f32x4*)(Ab + j * AFS + 4 * c4); }
        asm volatile("s_waitcnt lgkmcnt(0)" ::: "memory");
        { int q = 0;
#pragma unroll
          for (int j = 0; j < 15; ++j) { const float xj = sgn * x[j];
#pragma unroll
              for (int c4 = (j + 1) / 4; c4 < 4; ++c4) { const f32x4 t = tri[q++];
#pragma unroll
                  for (int e = 0; e < 4; ++e) if (4 * c4 + e > j) x[4 * c4 + e] -= t[e] * xj; } } }
        { u32x4 w0, w1;
#pragma unroll
          for (int i = 0; i < 16; ++i) *(LAS bf16_t*)(TI + ((kb_ * 16 + i) * 16 + cc) * 2) = (bf16_t)f2bf(x[i]); (void)w0; (void)w1; } }
}
template <class RhsF> __device__ __forceinline__ void dr_solve(const LAS unsigned char* Abf, LAS unsigned char* XT, const LAS float* Dbuf, const float sgn, const int wave, const RhsF& rhs, bf16_t* wu) {
    const LAS unsigned char* TI = (const LAS unsigned char*)Dbuf;
    { const int lane = lane_id_asm(), fr = lane & 15, fq = lane >> 4, col = 16 * wave + fr; u32x4 bx[2] = {(u32x4){0u, 0u, 0u, 0u}, (u32x4){0u, 0u, 0u, 0u}};
      float rv[4][4]; u32x2 af[6][2], tf[4];
#pragma unroll
      for (int k = 0; k < 4; ++k) {
#pragma unroll
          for (int j = 0; j < 4; ++j) rv[k][j] = rhs(16 * k + 4 * fq + j, col);
          tf[k] = *(const LAS u32x2*)(TI + ((k * 16 + fr) * 16 + 4 * fq) * 2); }
#pragma unroll
      for (int k = 1; k < 4; ++k)
#pragma unroll
          for (int ks = 0; ks < 2; ++ks) if (k > 2 * ks) { const int s = (k - 1) + (ks ? 2 : 0) + (k == 3 && ks == 0 ? 0 : 0);
              af[s][0] = *(const LAS u32x2*)(Abf + (16 * k + fr) * TS + (32 * ks + 4 * fq) * 2); af[s][1] = *(const LAS u32x2*)(Abf + (16 * k + fr) * TS + (32 * ks + 16 + 4 * fq) * 2); }
#pragma unroll
      for (int k = 0; k < 4; ++k) { f32x4 acc = (f32x4){0.f, 0.f, 0.f, 0.f};
#pragma unroll
          for (int ks = 0; ks < 2; ++ks) if (k > 2 * ks) { const int s = (k - 1) + (ks ? 2 : 0);
              acc = __builtin_amdgcn_mfma_f32_16x16x32_bf16(__builtin_bit_cast(bf16x8, (u32x4){af[s][0][0], af[s][0][1], af[s][1][0], af[s][1][1]}), __builtin_bit_cast(bf16x8, bx[ks]), acc, 0, 0, 0); }
          float dd[4];
#pragma unroll
          for (int j = 0; j < 4; ++j) dd[j] = rv[k][j] - sgn * acc[j];
          const f32x4 xk = __builtin_amdgcn_mfma_f32_16x16x32_bf16(__builtin_bit_cast(bf16x8, (u32x4){tf[k][0], tf[k][1], 0u, 0u}), __builtin_bit_cast(bf16x8, (u32x4){pk2(dd[0], dd[1]), pk2(dd[2], dd[3]), 0u, 0u}), (f32x4){0.f, 0.f, 0.f, 0.f}, 0, 0, 0);
          const unsigned p0 = pk2(xk[0], xk[1]), p1 = pk2(xk[2], xk[3]);
          bx[k >> 1][(k & 1) * 2] = p0; bx[k >> 1][(k & 1) * 2 + 1] = p1;
          *(LAS u32x2*)(XT + col * TS + (16 * k + 4 * fq) * 2) = (u32x2){p0, p1};
#pragma unroll
          for (int j = 0; j < 4; ++j) wu[(16 * k + 4 * fq + j) * 128 + col] = (bf16_t)f2bf(xk[j]); } }
    __syncthreads();
}
template <class RhsF> __device__ __forceinline__ void dr_block_solve(const LAS unsigned char* Abf, const LAS float* AfT, LAS unsigned char* XT, LAS float* Dbuf, const float sgn, const int wave, const RhsF& rhs, bf16_t* wu) {
    if (wave == 0) dr_tinv(AfT, Dbuf, sgn);
    __syncthreads();
    dr_solve(Abf, XT, Dbuf, sgn, wave, rhs, wu);
}
struct GdnRhs { const LAS unsigned char* kb; const LAS unsigned char* vb; const LAS float* GC;
    __device__ __forceinline__ float operator()(int r, int col) const { return col < 64 ? bf2f(*(const LAS bf16_t*)(kb + r * TS + col * 2)) * __expf(GC[r]) : bf2f(*(const LAS bf16_t*)(vb + r * TS + (col - 64) * 2)); } };
__device__ __forceinline__ void gdn_p1(const Cx& p, LAS unsigned char* lds, int layer, int b) {
    const int wave = __builtin_amdgcn_readfirstlane(p.tid >> 6);
#define GDN_LANES const int lane = lane_id_asm(), tid = wave * 64 + lane, fr = lane & 15, fq = lane >> 4; (void)tid; (void)fr; (void)fq
    LAS unsigned char* kh = lds; LAS unsigned char* kb = lds + 64 * TS; LAS unsigned char* vb = lds + 2 * 64 * TS; LAS unsigned char* Abf = lds + 3 * 64 * TS; LAS unsigned char* kdT = lds + 4 * 64 * TS; LAS unsigned char* XT = lds + 5 * 64 * TS;
    LAS float* Af = (LAS float*)(lds + 7 * 64 * TS); LAS float* Dbuf = Af + 64 * AFS; LAS float* GC = Dbuf + 128 * 20;
    const int mt = wave >> 1, nt0 = (wave & 1) * 2;
    float gq, beta; u32x4 kv, vv;
#define GDN1_LOAD(uu) do { const int tb_ = (uu) >> 3, h_ = ((uu) >> 1) & 3, d_ = (uu) & 1; const int lane_ = lane_id_asm(), tid_ = wave * 64 + lane_; \
        const bf16_t* dq_ = WSP(bf16_t, SC_DQ) + (size_t)(64 * tb_) * 768; const float* dg_ = WSP(float, SC_DG) + (size_t)(64 * tb_) * 16; \
        gq = dg_[(d_ ? 63 - lane_ : lane_) * 16 + 8 + d_ * 4 + h_]; \
        { const int r_ = tid_ >> 3, c0_ = (tid_ & 7) * 8, i_ = d_ ? 63 - r_ : r_; beta = dg_[i_ * 16 + d_ * 4 + h_]; \
          kv = *(const u32x4*)(dq_ + (size_t)i_ * 768 + 256 + 64 * h_ + c0_); vv = *(const u32x4*)(dq_ + (size_t)i_ * 768 + 512 + 64 * h_ + c0_); } } while (0)
    int u = (p.bid + p.G - (64 % p.G)) % p.G;
    if (u < NUNIT) GDN1_LOAD(u);
    for (; u < NUNIT; u += p.G) {
        if (wave == 0) { GDN_LANES; float pre = gq;
#pragma unroll
            for (int o = 1; o < 64; o <<= 1) { const float t = shup_(pre, lane, o); if (lane >= o) pre += t; }
            GC[lane] = pre; }
        { GDN_LANES; const int r = tid >> 3, c0 = (tid & 7) * 8; u32x4 kw, vw;
#pragma unroll
          for (int q = 0; q < 4; ++q) { kw[q] = pk2(__uint_as_float(kv[q] << 16) * beta, __uint_as_float(kv[q] & 0xffff0000u) * beta); vw[q] = pk2(__uint_as_float(vv[q] << 16) * beta, __uint_as_float(vv[q] & 0xffff0000u) * beta); }
          *(LAS u32x4*)(kh + r * TS + c0 * 2) = kv; *(LAS u32x4*)(kb + r * TS + c0 * 2) = kw; *(LAS u32x4*)(vb + r * TS + c0 * 2) = vw;
 }
        if (u + p.G < NUNIT) GDN1_LOAD(u + p.G);
        __syncthreads();
        const float gtot = GC[63];
        { GDN_LANES; f32x4 acc[2] = {(f32x4){0.f, 0.f, 0.f, 0.f}, (f32x4){0.f, 0.f, 0.f, 0.f}};
          mm_rows<64, 2>(kb, TS, kh, TS, mt, nt0, fr, fq, acc);
          float gr[4], gj[2];
#pragma unroll
          for (int j = 0; j < 4; ++j) gr[j] = GC[16 * mt + 4 * fq + j];
#pragma unroll
          for (int t = 0; t < 2; ++t) gj[t] = GC[16 * (nt0 + t) + fr];
#pragma unroll
          for (int t = 0; t < 2; ++t)
#pragma unroll
              for (int j = 0; j < 4; ++j) { const int r = 16 * mt + 4 * fq + j, jj = 16 * (nt0 + t) + fr; const float a = jj < r ? acc[t][j] * __expf(gr[j] - gj[t]) : 0.f;
                  Af[jj * AFS + r] = a; *(LAS bf16_t*)(Abf + r * TS + jj * 2) = (bf16_t)f2bf(a); }
          { bf16_t kraw[8]; float gcr[8];
#pragma unroll
            for (int q = 0; q < 8; ++q) { const int e = tid + NTHR * q, r = e >> 6, cc = e & 63; kraw[q] = *(const LAS bf16_t*)(kh + r * TS + cc * 2); gcr[q] = GC[r]; }
#pragma unroll
            for (int q = 0; q < 8; ++q) { const int e = tid + NTHR * q, r = e >> 6, cc = e & 63; *(LAS bf16_t*)(kdT + cc * TS + r * 2) = (bf16_t)f2bf(bf2f(kraw[q]) * __expf(gtot - gcr[q])); } } }
        __syncthreads();
        { const GdnRhs rhs{kb, vb, GC}; dr_block_solve(Abf, Af, XT, Dbuf, 1.0f, wave, rhs, WSP(bf16_t, SC_DR_WU) + (size_t)u * 8192); }
        { GDN_LANES; f32x4 am[2] = {(f32x4){0.f, 0.f, 0.f, 0.f}, (f32x4){0.f, 0.f, 0.f, 0.f}}, an[2] = {(f32x4){0.f, 0.f, 0.f, 0.f}, (f32x4){0.f, 0.f, 0.f, 0.f}};
          mm_rows<64, 2>(kdT, TS, XT, TS, mt, nt0, fr, fq, am);
          mm_rows<64, 2>(kdT, TS, XT + 64 * TS, TS, mt, nt0, fr, fq, an);
          bf16_t* Mg = WSP(bf16_t, SC_DR_M) + (size_t)cslot(u) * 4096; bf16_t* Ng = WSP(bf16_t, SC_DR_NS) + (size_t)cslot(u) * 4096; const float eg = __expf(gtot);
#pragma unroll
          for (int t = 0; t < 2; ++t) {
#pragma unroll
              for (int j = 0; j < 4; ++j) { const int row = 16 * mt + 4 * fq + j, col = 16 * (nt0 + t) + fr; Mg[dr_mfrag_idx(row, col)] = (bf16_t)f2bf((row == col ? eg : 0.f) - am[t][j]); }
              *(u32x2*)(Ng + (((nt0 + t) * 2 + (mt >> 1)) * 64 + lane) * 8 + (mt & 1) * 4) = (u32x2){pk2(an[t][0], an[t][1]), pk2(an[t][2], an[t][3])}; } }
        __syncthreads();
    }
#undef GDN_LANES
#undef GDN1_LOAD
}
__device__ __forceinline__ void dr_chain(const Cx& p, size_t offM, size_t offNS, int h, int d, int cb) {
    const int lane = p.tid & 63, fr = lane & 15, fq = lane >> 4;
    if (p.tid >= 64) return;
    f32x4 acc[4];
#pragma unroll
    for (int t = 0; t < 4; ++t) acc[t] = (f32x4){0.f, 0.f, 0.f, 0.f};
    bf16x8 mR[4][4][2]; u32x4 nR[4][2];
#define DR_LD(m, nn, n_) do { const int u_ = cslot((chain_tb((n_), d) * 4 + h) * 2 + d); const bf16_t* M_ = WSP(bf16_t, offM) + (size_t)u_ * 4096; const bf16_t* N_ = WSP(bf16_t, offNS) + (size_t)u_ * 4096; \
        _Pragma("unroll") for (int t = 0; t < 4; ++t) { _Pragma("unroll") for (int ks = 0; ks < 2; ++ks) m[t][ks] = *(const bf16x8*)(M_ + ((t * 2 + ks) * 64 + lane) * 8); } \
        _Pragma("unroll") for (int pr = 0; pr < 2; ++pr) nn[pr] = *(const u32x4*)(N_ + ((cb * 2 + pr) * 64 + lane) * 8); } while (0)
#define DR_STEP(m, nn, n_) do { const int u_ = cslot((chain_tb((n_), d) * 4 + h) * 2 + d); bf16_t* ST_ = WSP(bf16_t, offNS) + (size_t)u_ * 4096 + (16 * cb + fr) * 64 + 16 * fq; \
        u32x2 sp_[4]; _Pragma("unroll") for (int t = 0; t < 4; ++t) sp_[t] = (u32x2){pk2(acc[t][0], acc[t][1]), pk2(acc[t][2], acc[t][3])}; \
        *(u32x4*)ST_ = (u32x4){sp_[0][0], sp_[0][1], sp_[1][0], sp_[1][1]}; *(u32x4*)(ST_ + 8) = (u32x4){sp_[2][0], sp_[2][1], sp_[3][0], sp_[3][1]};        \
        bf16x8 bf_[2]; _Pragma("unroll") for (int ks = 0; ks < 2; ++ks) { u32x4 w_ = (u32x4){sp_[2 * ks][0], sp_[2 * ks][1], sp_[2 * ks + 1][0], sp_[2 * ks + 1][1]}; bf_[ks] = __builtin_bit_cast(bf16x8, w_); } \
        _Pragma("unroll") for (int t = 0; t < 4; ++t) { const unsigned n0_ = nn[t >> 1][(t & 1) * 2], n1_ = nn[t >> 1][(t & 1) * 2 + 1]; f32x4 a_ = (f32x4){__uint_as_float(n0_ << 16), __uint_as_float(n0_ & 0xffff0000u), __uint_as_float(n1_ << 16), __uint_as_float(n1_ & 0xffff0000u)}; \
            a_ = __builtin_amdgcn_mfma_f32_16x16x32_bf16(m[t][0], bf_[0], a_, 0, 0, 0); acc[t] = __builtin_amdgcn_mfma_f32_16x16x32_bf16(m[t][1], bf_[1], a_, 0, 0, 0); } } while (0)
#define DR_GO(q, n_) do { DR_STEP(mR[q], nR[q], (n_)); DR_LD(mR[q], nR[q], (n_) + 4 < NTB ? (n_) + 4 : NTB - 1); } while (0)
    DR_LD(mR[0], nR[0], 0); DR_LD(mR[1], nR[1], 1); DR_LD(mR[2], nR[2], 2); DR_LD(mR[3], nR[3], 3);
#pragma unroll 1
    for (int n = 0; n < NTB; n += 4) { DR_GO(0, n); DR_GO(1, n + 1); DR_GO(2, n + 2); DR_GO(3, n + 3); }
#undef DR_GO
#undef DR_LD
#undef DR_STEP
}
__device__ __forceinline__ void gdn_p2(const Cx& p, LAS unsigned char* lds0, int layer, int b) {
    const int tid = p.tid, lane = tid & 63, wave = __builtin_amdgcn_readfirstlane(tid >> 6), fr = lane & 15, fq = lane >> 4;
    int par = 0;
    const int mt = wave >> 1, nt0 = (wave & 1) * 2;
    float gq; bf16_t upre[2][4]; u32x4 qv, kv, wv, sv;
#define GDN2_LOAD(uu) do { const int tb_ = (uu) >> 3, h_ = ((uu) >> 1) & 3, d_ = (uu) & 1; \
        const bf16_t* dq_ = WSP(bf16_t, SC_DQ) + (size_t)(64 * tb_) * 768; const float* dg_ = WSP(float, SC_DG) + (size_t)(64 * tb_) * 16; \
        const bf16_t* wu_ = WSP(bf16_t, SC_DR_WU) + (size_t)(uu) * 8192; const bf16_t* st_ = WSP(bf16_t, SC_DR_NS) + (size_t)cslot(uu) * 4096; \
        gq = dg_[(d_ ? 63 - lane : lane) * 16 + 8 + d_ * 4 + h_]; \
        _Pragma("unroll") for (int t = 0; t < 2; ++t) { _Pragma("unroll") for (int j = 0; j < 4; ++j) upre[t][j] = wu_[(16 * mt + 4 * fq + j) * 128 + 64 + 16 * (nt0 + t) + fr]; } \
        { const int r_ = tid >> 3, c0_ = (tid & 7) * 8, i_ = d_ ? 63 - r_ : r_; \
          qv = *(const u32x4*)(dq_ + (size_t)i_ * 768 + 64 * h_ + c0_); kv = *(const u32x4*)(dq_ + (size_t)i_ * 768 + 256 + 64 * h_ + c0_); \
          wv = *(const u32x4*)(wu_ + r_ * 128 + c0_); sv = *(const u32x4*)(st_ + r_ * 64 + c0_); } } while (0)
    int u = (p.bid + p.G - (192 % p.G)) % p.G;
    if (u < NUNIT) GDN2_LOAD(u);
    for (; u < NUNIT; u += p.G) { const int tb = u >> 3, h = (u >> 1) & 3, d = u & 1, s0 = 64 * tb;
        LAS unsigned char* lds = lds0 + par * 57344; par ^= 1;
        LAS unsigned char* qh = lds; LAS unsigned char* kh = lds + 64 * TS; LAS unsigned char* wt = lds + 2 * 64 * TS; LAS unsigned char* sT = lds + 3 * 64 * TS; LAS unsigned char* aq = lds + 4 * 64 * TS; LAS unsigned char* vnT = lds + 5 * 64 * TS;
        LAS float* GC = (LAS float*)(lds + 6 * 64 * TS);
        if (wave == 0) { float pre = gq;
#pragma unroll
            for (int o = 1; o < 64; o <<= 1) { const float t = shup_(pre, lane, o); if (lane >= o) pre += t; }
            GC[lane] = pre; }
        bf16_t ucur[2][4];
#pragma unroll
        for (int t = 0; t < 2; ++t)
#pragma unroll
            for (int j = 0; j < 4; ++j) ucur[t][j] = upre[t][j];
        { const int r = tid >> 3, c0 = (tid & 7) * 8;
          *(LAS u32x4*)(qh + r * TS + c0 * 2) = qv; *(LAS u32x4*)(kh + r * TS + c0 * 2) = kv; *(LAS u32x4*)(wt + r * TS + c0 * 2) = wv; { const int ci = c0 >> 3, sq = ci >> 1, tp = ci & 1;
            *(LAS u32x2*)(sT + r * TS + (32 * tp + 4 * sq) * 2) = (u32x2){sv[0], sv[1]}; *(LAS u32x2*)(sT + r * TS + (32 * tp + 16 + 4 * sq) * 2) = (u32x2){sv[2], sv[3]}; } }
        if (u + p.G < NUNIT) GDN2_LOAD(u + p.G);
        __syncthreads();
        { f32x4 acc[2] = {(f32x4){0.f, 0.f, 0.f, 0.f}, (f32x4){0.f, 0.f, 0.f, 0.f}};
          mm_rows<64, 2>(qh, TS, kh, TS, mt, nt0, fr, fq, acc);
          float gr[4], gj[2];
#pragma unroll
          for (int j = 0; j < 4; ++j) gr[j] = GC[16 * mt + 4 * fq + j];
#pragma unroll
          for (int t = 0; t < 2; ++t) gj[t] = GC[16 * (nt0 + t) + fr];
#pragma unroll
          for (int t = 0; t < 2; ++t)
#pragma unroll
              for (int j = 0; j < 4; ++j) { const int r = 16 * mt + 4 * fq + j, jj = 16 * (nt0 + t) + fr; *(LAS bf16_t*)(aq + r * TS + jj * 2) = (bf16_t)f2bf(jj <= r ? acc[t][j] * __expf(gr[j] - gj[t]) : 0.f); }
          f32x4 av[2] = {(f32x4){0.f, 0.f, 0.f, 0.f}, (f32x4){0.f, 0.f, 0.f, 0.f}};
          mm_rows<64, 2>(wt, TS, sT, TS, mt, nt0, fr, fq, av);
#pragma unroll
          for (int t = 0; t < 2; ++t) { const int dv = 16 * (nt0 + t) + fr; float vn[4];
#pragma unroll
              for (int j = 0; j < 4; ++j) vn[j] = bf2f(ucur[t][j]) - av[t][j];
              *(LAS u32x2*)(vnT + dv * TS + (16 * mt + 4 * fq) * 2) = (u32x2){pk2(vn[0], vn[1]), pk2(vn[2], vn[3])}; } }
        __syncthreads();
        { f32x4 acc[2] = {(f32x4){0.f, 0.f, 0.f, 0.f}, (f32x4){0.f, 0.f, 0.f, 0.f}};
          mm_rows<64, 2>(sT, TS, qh, TS, mt, nt0, fr, fq, acc);
#pragma unroll
          for (int t = 0; t < 2; ++t) { const float sc = __expf(GC[16 * (nt0 + t) + fr]); acc[t] *= sc; }
          mm_rows<64, 2>(vnT, TS, aq, TS, mt, nt0, fr, fq, acc);
          bf16_t* ob = WSP(bf16_t, d ? SC_OB : SC_OF);
#pragma unroll
          for (int t = 0; t < 2; ++t) { const int r = 16 * (nt0 + t) + fr, i = d ? 63 - r : r; *(u32x2*)(ob + (size_t)(s0 + i) * 1024 + 768 + 64 * h + 16 * mt + 4 * fq) = (u32x2){pk2(acc[t][0], acc[t][1]), pk2(acc[t][2], acc[t][3])}; } }
    }
}
#undef GDN2_LOAD
constexpr int LPS = 65;
#define RW_LP(LP, GS, lw8) do { const int lane_ = lane_id_asm(), c_ = lane_, tg_ = wave; float loc_[8]; float run_ = 0.f; \
        _Pragma("unroll") for (int ii = 0; ii < 8; ++ii) { run_ += (lw8)[ii]; loc_[ii] = run_; } \
        (GS)[tg_ * 64 + c_] = run_; __syncthreads(); float off_ = 0.f; \
        _Pragma("unroll") for (int g2 = 0; g2 < 8; ++g2) if (g2 < tg_) off_ += (GS)[g2 * 64 + c_]; \
        _Pragma("unroll") for (int ii = 0; ii < 8; ++ii) (LP)[(8 * tg_ + ii) * LPS + c_] = loc_[ii] + off_; __syncthreads(); } while (0)
struct RwRhs { const LAS unsigned char* zt; const LAS unsigned char* RU;
    __device__ __forceinline__ float operator()(int r, int col) const { return col < 64 ? bf2f(*(const LAS bf16_t*)(zt + r * TS + col * 2)) : bf2f(*(const LAS bf16_t*)(RU + (col - 64) * TS + r * 2)); } };
__device__ __forceinline__ void rw_p1(const Cx& p, LAS unsigned char* lds, int layer, int b) {
    const int wave = __builtin_amdgcn_readfirstlane(p.tid >> 6), mt = wave >> 1, nt0 = (wave & 1) * 2;
#define RW_LANES const int lane = lane_id_asm(), tid = wave * 64 + lane, fr = lane & 15, fq = lane >> 4; (void)tid; (void)fr; (void)fq
    LAS float* LP = (LAS float*)lds; LAS float* GS = (LAS float*)(lds + 16640);
    LAS unsigned char* zt = lds + 18688; LAS unsigned char* bt = lds + 27904; LAS unsigned char* kt = lds + 37120; LAS unsigned char* vT = lds + 46336; LAS unsigned char* Azk = lds + 55552;
    LAS float* Af = (LAS float*)(lds + 64768); LAS unsigned char* XT = lds + 82176; LAS unsigned char* Abf = lds + 100608; LAS unsigned char* RU = lds + 109824; LAS float* Dbuf = (LAS float*)(lds + 119040); LAS unsigned char* bhT = lds + 129280;
    const bf16_t* proj = WSP(bf16_t, WS_PROJ);
    float lw8[8]; f32x4 lwv[2], kkv[2], bv[2], kv[2]; bf16_t v8[8];
#define RW1_LOAD(uu) do { const int tb_ = (uu) >> 3, h_ = ((uu) >> 1) & 3, d_ = (uu) & 1, s0_ = 64 * tb_; const int lane_ = lane_id_asm(), tid_ = wave * 64 + lane_; \
        const float* lwp_ = WSP(float, SC_RLW) + (size_t)d_ * SB * 256 + (size_t)s0_ * 256 + 64 * h_; const size_t fo_ = (size_t)s0_ * 256 + 64 * h_; \
        _Pragma("unroll") for (int ii = 0; ii < 8; ++ii) { const int r_ = 8 * wave + ii; lw8[ii] = lwp_[(size_t)(d_ ? 63 - r_ : r_) * 256 + lane_]; } \
        { const int r_ = tid_ >> 3, c0_ = (tid_ & 7) * 8, i_ = d_ ? 63 - r_ : r_; \
          _Pragma("unroll") for (int q = 0; q < 2; ++q) { lwv[q] = *(const f32x4*)(lwp_ + (size_t)i_ * 256 + c0_ + 4 * q); kkv[q] = *(const f32x4*)(WSP(float, SC_RKK) + fo_ + (size_t)i_ * 256 + c0_ + 4 * q); \
              bv[q] = *(const f32x4*)(WSP(float, SC_RB) + fo_ + (size_t)i_ * 256 + c0_ + 4 * q); kv[q] = *(const f32x4*)(WSP(float, SC_RK) + fo_ + (size_t)i_ * 256 + c0_ + 4 * q); } } \
        { const bf16_t* pr0_ = proj + (size_t)tb_row0(b, tb_) * NPROJ; \
          _Pragma("unroll") for (int q = 0; q < 8; ++q) { const int e = tid_ + NTHR * q, r2 = e >> 6, cc = e & 63; v8[q] = pr0_[(size_t)(d_ ? 63 - r2 : r2) * NPROJ + PB_V + 64 * h_ + cc]; } } } while (0)
    int u = (p.bid + p.G - (96 % p.G)) % p.G; if (u >= NUNIT) return;
    RW1_LOAD(u);
    for (;;) { const int d = u & 1;
        RW_LP(LP, GS, lw8);
        { RW_LANES; const int r = tid >> 3, c0 = (tid & 7) * 8; unsigned wz[4], wb[4], wk[4];
#pragma unroll
          for (int q = 0; q < 8; q += 2) { float z2[2], b2[2], k2[2];
#pragma unroll
              for (int e = 0; e < 2; ++e) { const int cq = q + e, c = c0 + cq; const float lp = LP[r * LPS + c], lw = lwv[cq >> 2][cq & 3], em = __expf(-lp);
                  z2[e] = -kkv[cq >> 2][cq & 3] * __expf(lp - lw); b2[e] = bv[cq >> 2][cq & 3] * em; k2[e] = kv[cq >> 2][cq & 3] * em; }
              wz[q >> 1] = pk2(z2[0], z2[1]); wb[q >> 1] = pk2(b2[0], b2[1]); wk[q >> 1] = pk2(k2[0], k2[1]); }
          *(LAS u32x4*)(zt + r * TS + c0 * 2) = (u32x4){wz[0], wz[1], wz[2], wz[3]}; *(LAS u32x4*)(bt + r * TS + c0 * 2) = (u32x4){wb[0], wb[1], wb[2], wb[3]}; *(LAS u32x4*)(kt + r * TS + c0 * 2) = (u32x4){wk[0], wk[1], wk[2], wk[3]};
#pragma unroll
          for (int q = 0; q < 8; ++q) { const int e = tid + NTHR * q, r2 = e >> 6, cc = e & 63; *(LAS bf16_t*)(vT + cc * TS + r2 * 2) = v8[q]; } }
        __syncthreads();
        const int un = u + p.G; const bool more = un < NUNIT;
        if (more) RW1_LOAD(un);
        { RW_LANES; f32x4 a1[2] = {(f32x4){0.f, 0.f, 0.f, 0.f}, (f32x4){0.f, 0.f, 0.f, 0.f}}, a2[2] = {(f32x4){0.f, 0.f, 0.f, 0.f}, (f32x4){0.f, 0.f, 0.f, 0.f}};
          mm_rows<64, 2>(zt, TS, bt, TS, mt, nt0, fr, fq, a1);
          mm_rows<64, 2>(zt, TS, kt, TS, mt, nt0, fr, fq, a2);
#pragma unroll
          for (int t = 0; t < 2; ++t)
#pragma unroll
              for (int j = 0; j < 4; ++j) { const int r = 16 * mt + 4 * fq + j, jj = 16 * (nt0 + t) + fr; const float a = jj < r ? a1[t][j] : 0.f;
                  Af[jj * AFS + r] = a; *(LAS bf16_t*)(Abf + r * TS + jj * 2) = (bf16_t)f2bf(a); *(LAS bf16_t*)(Azk + r * TS + jj * 2) = (bf16_t)f2bf(jj < r ? a2[t][j] : 0.f); } }
        __syncthreads();
        { RW_LANES; f32x4 a[2] = {(f32x4){0.f, 0.f, 0.f, 0.f}, (f32x4){0.f, 0.f, 0.f, 0.f}};
          mm_rows<64, 2>(Azk, TS, vT, TS, mt, nt0, fr, fq, a);
#pragma unroll
          for (int t = 0; t < 2; ++t) *(LAS u32x2*)(RU + (16 * (nt0 + t) + fr) * TS + (16 * mt + 4 * fq) * 2) = (u32x2){pk2(a[t][0], a[t][1]), pk2(a[t][2], a[t][3])};
        }
        if (wave == 0) dr_tinv(Af, Dbuf, -1.0f);
        __syncthreads();
        { RW_LANES;
          const float el = __expf(LP[63 * LPS + (tid & 63)]); bf16_t braw[8], kraw[8];
#pragma unroll
          for (int q = 0; q < 8; ++q) { const int e = tid + NTHR * q, r2 = e >> 6, cc = e & 63; braw[q] = *(const LAS bf16_t*)(bt + r2 * TS + cc * 2); kraw[q] = *(const LAS bf16_t*)(kt + r2 * TS + cc * 2); }
#pragma unroll
          for (int q = 0; q < 8; ++q) { const int e = tid + NTHR * q, r2 = e >> 6, cc = e & 63;
              *(LAS bf16_t*)(bhT + cc * TS + r2 * 2) = (bf16_t)f2bf(bf2f(braw[q]) * el); *(LAS bf16_t*)(Azk + cc * TS + r2 * 2) = (bf16_t)f2bf(bf2f(kraw[q]) * el); } }
        __syncthreads();
        { const RwRhs rhs{zt, RU}; dr_solve(Abf, XT, Dbuf, -1.0f, wave, rhs, WSP(bf16_t, SC_RW_WU) + (size_t)u * 8192); }
        { RW_LANES; f32x4 am[2] = {(f32x4){0.f, 0.f, 0.f, 0.f}, (f32x4){0.f, 0.f, 0.f, 0.f}}, an[2] = {(f32x4){0.f, 0.f, 0.f, 0.f}, (f32x4){0.f, 0.f, 0.f, 0.f}};
          mm_rows<64, 2>(bhT, TS, XT, TS, mt, nt0, fr, fq, am);
          mm_rows<64, 2>(bhT, TS, XT + 64 * TS, TS, mt, nt0, fr, fq, an);
          mm_rows<64, 2>(Azk, TS, vT, TS, mt, nt0, fr, fq, an);
          bf16_t* Mg = WSP(bf16_t, SC_RW_M) + (size_t)cslot(u) * 4096; bf16_t* Ng = WSP(bf16_t, SC_RW_NS) + (size_t)cslot(u) * 4096;
#pragma unroll
          for (int t = 0; t < 2; ++t) {
#pragma unroll
              for (int j = 0; j < 4; ++j) { const int row = 16 * mt + 4 * fq + j, col = 16 * (nt0 + t) + fr; Mg[dr_mfrag_idx(row, col)] = (bf16_t)f2bf((row == col ? __expf(LP[63 * LPS + row]) : 0.f) + am[t][j]); }
              *(u32x2*)(Ng + (((nt0 + t) * 2 + (mt >> 1)) * 64 + lane) * 8 + (mt & 1) * 4) = (u32x2){pk2(an[t][0], an[t][1]), pk2(an[t][2], an[t][3])}; } }
        __syncthreads();
        if (!more) break;
        u = un;
    }
#undef RW1_LOAD
}
__device__ __forceinline__ void rw_p2(const Cx& p, LAS unsigned char* lds, int layer, int b) {
    const int wave = __builtin_amdgcn_readfirstlane(p.tid >> 6), mt = wave >> 1, nt0 = (wave & 1) * 2;
    LAS float* LP = (LAS float*)lds; LAS float* GS = (LAS float*)(lds + 16640);
    LAS unsigned char* rt = lds + 18688; LAS unsigned char* bt = lds + 27904; LAS unsigned char* kt = lds + 37120; LAS unsigned char* vT = lds + 46336; LAS unsigned char* sT = lds + 55552; LAS unsigned char* wt = lds + 64768;
    LAS unsigned char* Arb = lds + 73984; LAS unsigned char* Ark = lds + 83200; LAS unsigned char* UT = lds + 92416;
    const bf16_t* proj = WSP(bf16_t, WS_PROJ);
    bf16_t upre[2][4]; float lw8[8]; u32x4 rv, wv, sv, vq; f32x4 bv[2], kv[2];
#define RW2_LOAD(uu) do { const int tb_ = (uu) >> 3, h_ = ((uu) >> 1) & 3, d_ = (uu) & 1, s0_ = 64 * tb_; const int lane_ = lane_id_asm(), tid_ = wave * 64 + lane_, fr_ = lane_ & 15, fq_ = lane_ >> 4; \
        const float* lwp_ = WSP(float, SC_RLW) + (size_t)d_ * SB * 256 + (size_t)s0_ * 256 + 64 * h_; const float* rk_ = WSP(float, SC_RK) + (size_t)s0_ * 256 + 64 * h_; const float* rb_ = WSP(float, SC_RB) + (size_t)s0_ * 256 + 64 * h_; \
        const bf16_t* pr_ = proj + (size_t)tb_row0(b, tb_) * NPROJ; const bf16_t* wu_ = WSP(bf16_t, SC_RW_WU) + (size_t)(uu) * 8192; const bf16_t* st_ = WSP(bf16_t, SC_RW_NS) + (size_t)cslot(uu) * 4096; \
        _Pragma("unroll") for (int t = 0; t < 2; ++t) { _Pragma("unroll") for (int j = 0; j < 4; ++j) upre[t][j] = wu_[(16 * mt + 4 * fq_ + j) * 128 + 64 + 16 * (nt0 + t) + fr_]; } \
        _Pragma("unroll") for (int ii = 0; ii < 8; ++ii) { const int r_ = 8 * wave + ii; lw8[ii] = lwp_[(size_t)(d_ ? 63 - r_ : r_) * 256 + lane_]; } \
        { const int r_ = tid_ >> 3, c0_ = (tid_ & 7) * 8, i_ = d_ ? 63 - r_ : r_; rv = *(const u32x4*)(pr_ + (size_t)i_ * NPROJ + PB_R + 64 * h_ + c0_); \
          _Pragma("unroll") for (int q = 0; q < 2; ++q) { bv[q] = *(const f32x4*)(rb_ + (size_t)i_ * 256 + c0_ + 4 * q); kv[q] = *(const f32x4*)(rk_ + (size_t)i_ * 256 + c0_ + 4 * q); } \
          wv = *(const u32x4*)(wu_ + r_ * 128 + c0_); sv = *(const u32x4*)(st_ + r_ * 64 + c0_); } \
        vq = *(const u32x4*)(pr_ + (size_t)(d_ ? 63 - lane_ : lane_) * NPROJ + PB_V + 64 * h_ + 8 * wave); } while (0)
    int u = (p.bid + p.G - (224 % p.G)) % p.G;
    if (u < NUNIT) RW2_LOAD(u);
    for (; u < NUNIT; u += p.G) { const int tb = u >> 3, h = (u >> 1) & 3, d = u & 1, s0 = 64 * tb;
        bf16_t ucur[2][4];
#pragma unroll
        for (int t = 0; t < 2; ++t)
#pragma unroll
            for (int j = 0; j < 4; ++j) ucur[t][j] = upre[t][j];
        RW_LP(LP, GS, lw8);
        { RW_LANES; const int r = tid >> 3, c0 = (tid & 7) * 8; unsigned wr[4], wb[4], wk[4];
#pragma unroll
          for (int q = 0; q < 8; q += 2) { float r2[2], b2[2], k2[2];
#pragma unroll
              for (int e = 0; e < 2; ++e) { const int cq = q + e, c = c0 + cq; const float lp = LP[r * LPS + c], em = __expf(-lp); const unsigned w = rv[q >> 1];
                  r2[e] = (e ? __uint_as_float(w & 0xffff0000u) : __uint_as_float(w << 16)) * __expf(lp); b2[e] = bv[cq >> 2][cq & 3] * em; k2[e] = kv[cq >> 2][cq & 3] * em; }
              wr[q >> 1] = pk2(r2[0], r2[1]); wb[q >> 1] = pk2(b2[0], b2[1]); wk[q >> 1] = pk2(k2[0], k2[1]); }
          *(LAS u32x4*)(rt + r * TS + c0 * 2) = (u32x4){wr[0], wr[1], wr[2], wr[3]}; *(LAS u32x4*)(bt + r * TS + c0 * 2) = (u32x4){wb[0], wb[1], wb[2], wb[3]}; *(LAS u32x4*)(kt + r * TS + c0 * 2) = (u32x4){wk[0], wk[1], wk[2], wk[3]};
          *(LAS u32x4*)(wt + r * TS + c0 * 2) = wv; { const int ci = c0 >> 3, sq = ci >> 1, tp = ci & 1;
            *(LAS u32x2*)(sT + r * TS + (32 * tp + 4 * sq) * 2) = (u32x2){sv[0], sv[1]}; *(LAS u32x2*)(sT + r * TS + (32 * tp + 16 + 4 * sq) * 2) = (u32x2){sv[2], sv[3]}; }
#pragma unroll
          for (int k = 0; k < 8; ++k) *(LAS bf16_t*)(vT + (8 * wave + k) * TS + lane * 2) = (bf16_t)(vq[k >> 1] >> (16 * (k & 1))); }
        if (u + p.G < NUNIT) RW2_LOAD(u + p.G);
        __syncthreads();
        { RW_LANES; f32x4 a1[2] = {(f32x4){0.f, 0.f, 0.f, 0.f}, (f32x4){0.f, 0.f, 0.f, 0.f}}, a2[2] = {(f32x4){0.f, 0.f, 0.f, 0.f}, (f32x4){0.f, 0.f, 0.f, 0.f}}, a3[2] = {(f32x4){0.f, 0.f, 0.f, 0.f}, (f32x4){0.f, 0.f, 0.f, 0.f}};
          mm_rows<64, 2>(rt, TS, bt, TS, mt, nt0, fr, fq, a1); mm_rows<64, 2>(rt, TS, kt, TS, mt, nt0, fr, fq, a2); mm_rows<64, 2>(wt, TS, sT, TS, mt, nt0, fr, fq, a3);
#pragma unroll
          for (int t = 0; t < 2; ++t) { const int dv = 16 * (nt0 + t) + fr; float uu[4];
#pragma unroll
              for (int j = 0; j < 4; ++j) { const int r = 16 * mt + 4 * fq + j, jj = dv; const bool keep = jj <= r;
                  *(LAS bf16_t*)(Arb + r * TS + jj * 2) = (bf16_t)f2bf(keep ? a1[t][j] : 0.f); *(LAS bf16_t*)(Ark + r * TS + jj * 2) = (bf16_t)f2bf(keep ? a2[t][j] : 0.f);
                  uu[j] = bf2f(ucur[t][j]) + a3[t][j]; }
              *(LAS u32x2*)(UT + dv * TS + (16 * mt + 4 * fq) * 2) = (u32x2){pk2(uu[0], uu[1]), pk2(uu[2], uu[3])}; } }
        __syncthreads();
        { RW_LANES; f32x4 acc[2] = {(f32x4){0.f, 0.f, 0.f, 0.f}, (f32x4){0.f, 0.f, 0.f, 0.f}};
          mm_rows<64, 2>(sT, TS, rt, TS, mt, nt0, fr, fq, acc); mm_rows<64, 2>(UT, TS, Arb, TS, mt, nt0, fr, fq, acc); mm_rows<64, 2>(vT, TS, Ark, TS, mt, nt0, fr, fq, acc);
          bf16_t* ob = WSP(bf16_t, d ? SC_OB : SC_OF);
#pragma unroll
          for (int t = 0; t < 2; ++t) { const int r = 16 * (nt0 + t) + fr, i = d ? 63 - r : r; *(u32x2*)(ob + (size_t)(s0 + i) * 1024 + 256 + 64 * h + 16 * mt + 4 * fq) = (u32x2){pk2(acc[t][0], acc[t][1]), pk2(acc[t][2], acc[t][3])}; } }
        __syncthreads();
    }
#undef RW_LANES
#undef RW2_LOAD
}
__device__ __forceinline__ void phase_scan(const Cx& p, LAS unsigned char* lds, int layer, int b) {
    for (int w = p.bid; w < 160; w += p.G) {
        if (w < 64) ssd_chain(p, (w >> 4) & 3, (w >> 3) & 1, w & 7);
        else if (w < 96) gla_chain(p, ((w - 64) >> 3) & 3, ((w - 64) >> 2) & 1, (w - 64) & 3);
        else { const int i = w - 96, h = (i >> 3) & 3, d = (i >> 2) & 1, cb = i & 3;
            if (i < 32) dr_chain(p, SC_RW_M, SC_RW_NS, h, d, cb); else dr_chain(p, SC_DR_M, SC_DR_NS, h, d, cb); } }
}
#ifndef MK_ONE_LAUNCH
#define MK_ONE_LAUNCH 1
#endif
constexpr int PH_PER_LAYER = 2 + 5 * NB + 7;
constexpr int N_PHASES = 1 + NL * PH_PER_LAYER + 1;

__global__ void __launch_bounds__(NTHR, 2) mega_fwd(Params pp) {
    extern __shared__ __attribute__((aligned(16))) unsigned char lds_raw[];
    LAS unsigned char* lds = (LAS unsigned char*)lds_raw;
    const int swave = __builtin_amdgcn_readfirstlane(threadIdx.x >> 6);
    for (int i = threadIdx.x; i < (LDS_BYTES - LDS_CTL) / 4; i += NTHR) ((LAS unsigned*)(lds + LDS_CTL))[i] = 0u;
    __syncthreads();
    if (threadIdx.x < N_IN + 2) { const unsigned long long a = threadIdx.x < N_IN ? (unsigned long long)pp.in[threadIdx.x] : (threadIdx.x == N_IN ? (unsigned long long)pp.out : (unsigned long long)pp.ws); ((LAS unsigned*)(lds + LDS_PTRS))[2 * threadIdx.x] = (unsigned)a; ((LAS unsigned*)(lds + LDS_PTRS))[2 * threadIdx.x + 1] = (unsigned)(a >> 32); }
    __syncthreads();
    XcdBarrier bar = xcd_barrier_post((unsigned*)(pp.ws + WS_CTL) + CW_BAR + pp.li * XCD_BAR_WORDS, (volatile LAS unsigned*)(lds + LDS_CTL), threadIdx.x);
    LAS int* tb = (LAS int*)(lds + LDS_CTL + 64);
    int pc = 0; const int lo = pp.lo, hi = pp.hi;
#define PH_BEGIN if (pc >= lo && pc < hi) { Cx p; p.out = (unsigned long long)PIN(N_IN); p.ws = (unsigned long long)PIN(N_IN + 1); p.tid = swave * 64 + lane_id_asm(); p.bid = blockIdx.x; p.G = gridDim.x; p.pad = 0; asm volatile("" : "+s"(p.out), "+s"(p.ws), "+v"(p.tid), "+s"(p.bid), "+s"(p.G)); const int G = p.G, bid = p.bid; (void)G; (void)bid;
#define PH_END if (pc + 1 < hi) { XcdBarrier b2 = bar; asm volatile("" : "+s"(b2.bar), "+s"(b2.x)); xcd_barrier(b2, (unsigned)(swave * 64 + lane_id_asm())); } } ++pc;

    PH_BEGIN
        conv_run(p, (LAS float*)lds, CONV_A_UNITS, ConvDescA{0});
        __syncthreads();
        phase_mod(p, lds);
    PH_END

#pragma unroll
    for (int layer = 0; layer < NL; ++layer) {
        const int row_lo = layer == NL - 1 ? CROWS : 0;
        PH_BEGIN phase_norm1(p, layer); PH_END
        PH_BEGIN
            DenseSched S; S.init(ROWS, NPROJ, D, WSP(bf16_t, WS_WIN) + (size_t)layer * NPROJ * D, G, bid);
            EpiProj E{WSP(bf16_t, WS_PROJ), NPROJ};
            pg8::gemm_phase<D>(p.tid, lds, (const char*)WSP(bf16_t, WS_HBUF), S, E);
        PH_END
#pragma unroll 1
        for (int b = 0; b < NB; ++b) {
            PH_BEGIN phase_prep(p, lds, layer, b); PH_END
            PH_BEGIN gla_p1(p, lds, layer, b); __syncthreads(); ssd_p1(p, lds, layer, b); __syncthreads(); gdn_p1(p, lds, layer, b); __syncthreads(); rw_p1(p, lds, layer, b); PH_END
            PH_BEGIN phase_scan(p, lds, layer, b); PH_END
            PH_BEGIN gla_p2(p, lds, layer, b); __syncthreads(); ssd_p2(p, lds, layer, b); __syncthreads(); gdn_p2(p, lds, layer, b); __syncthreads(); rw_p2(p, lds, layer, b); PH_END
            PH_BEGIN phase_post(p, lds, layer, b); PH_END
        }
        PH_BEGIN
            DenseSched S; S.init(ROWS, D, D, WSP(bf16_t, WS_WOUT) + (size_t)layer * D * D, G, bid);
            EpiRes E{layer == 0 ? PIN(I_X) : (const float*)POUT, layer == 0 ? PIN(I_CTX) : (const float*)WSP(float, WS_CTXRES), POUT, WSP(float, WS_CTXRES), WSP(float, WS_MOD) + (size_t)layer * 5 * 6144 + 2048};
            pg8::gemm_phase<D>(p.tid, lds, (const char*)WSP(bf16_t, WS_HBUF), S, E);
        PH_END
        PH_BEGIN phase_norm2(p, lds, layer, row_lo);
            __syncthreads();
            conv_run(p, (LAS float*)lds, CONV_E_UNITS, ConvDescE{layer});
        PH_END
        PH_BEGIN
            moe_table(p, tb, layer, row_lo);
            MoeSched<true> S{tb + 128, tb, 2, G, bid, D, row_lo, WSP(int, WS_LTOK), (const char*)WSP(bf16_t, WS_EXPGU), (size_t)512 * D * 2};
            EpiGU E{WSP(bf16_t, WS_H)};
            pg8::gemm_phase<D>(p.tid, lds, (const char*)WSP(bf16_t, WS_HBUF), S, E);
        PH_END
#pragma unroll
        for (int half = 0; half < 2; ++half) {
            PH_BEGIN
                moe_table(p, tb, layer, row_lo);
                MoeSched<false> S{tb + 128, tb, 2, G, bid, EH, row_lo, WSP(int, WS_LTOK), (const char*)(WSP(bf16_t, WS_EXPD) + (size_t)half * 512 * EH), (size_t)D * EH * 2};
                EpiY E{WSP(bf16_t, WS_Y)};
                pg8::gemm_phase<EH>(p.tid, lds, (const char*)WSP(bf16_t, WS_H), S, E);
            PH_END
            PH_BEGIN
                moe_table(p, tb, layer, row_lo);
                phase_combine(p, tb, layer, row_lo, half);
            PH_END
        }
    }
    PH_BEGIN phase_final(p);
    PH_END
#undef PH_BEGIN
#undef PH_END
}

extern "C" void kernel_launch(void* const* d_in, const int* in_sizes, int n_in, void* d_out, int out_size, void* d_ws, size_t ws_size, hipStream_t stream) {
    static int grid = 0;
    if (grid == 0) {
        if (n_in != N_IN || in_sizes[0] != NB * SEQ * D || out_size != NB * SEQ * D || ws_size < WS_END) {
            fprintf(stderr, "kernel_launch: unexpected shapes (n_in %d, in0 %d, out %d, ws %zu); nothing launched\n", n_in, n_in > 0 ? in_sizes[0] : -1, out_size, ws_size); grid = -1; return; }
        int dev = 0, cus = 0, per_cu = 0;
        if (hipGetDevice(&dev) != hipSuccess || hipDeviceGetAttribute(&cus, hipDeviceAttributeMultiprocessorCount, dev) != hipSuccess) { grid = -1; return; }
        if (hipFuncSetAttribute((const void*)mega_fwd, hipFuncAttributeMaxDynamicSharedMemorySize, LDS_BYTES) != hipSuccess) { fprintf(stderr, "kernel_launch: hipFuncSetAttribute failed\n"); grid = -1; return; }
        if (hipOccupancyMaxActiveBlocksPerMultiprocessor(&per_cu, (const void*)mega_fwd, NTHR, LDS_BYTES) != hipSuccess || per_cu < 1) { fprintf(stderr, "kernel_launch: occupancy query says %d\n", per_cu); per_cu = 1; }
        (void)hipGetLastError();
        grid = cus * 1;
    }
    if (grid < 0) return;
    if (hipMemsetAsync((char*)d_ws + WS_CTL, 0, CTL_ZERO_BYTES, stream) != hipSuccess) return;
    Params p{};
    for (int i = 0; i < N_IN; ++i) p.in[i] = (const float*)d_in[i];
    p.out = (float*)d_out; p.ws = (unsigned char*)d_ws; p.pad = 0;
#if MK_ONE_LAUNCH
    p.lo = 0; p.hi = N_PHASES; p.li = 0;
    hipLaunchKernelGGL(mega_fwd, dim3(grid), dim3(NTHR), LDS_BYTES, stream, p);
#else
    for (int k = 0; k < N_PHASES; ++k) { p.lo = k; p.hi = k + 1; p.li = k;
        hipLaunchKernelGGL(mega_fwd, dim3(grid), dim3(NTHR), LDS_BYTES, stream, p); }
#endif
}
```

```cpp
#include <hip/hip_runtime.h>
#include <cstdio>
#include <cstdint>

typedef unsigned short bf16_t;
typedef short bf16x8 __attribute__((ext_vector_type(8)));
typedef float f32x4 __attribute__((ext_vector_type(4)));
typedef float f32x2 __attribute__((ext_vector_type(2)));
typedef unsigned u32x4 __attribute__((ext_vector_type(4)));
typedef unsigned u32x2 __attribute__((ext_vector_type(2)));

constexpr int NB = 4, SEQ = 8192, NCTX = 256, D = 1024, NL = 2;
constexpr int CROWS = NB * NCTX;
constexpr int ROWS = CROWS + NB * SEQ;
constexpr int SB = NCTX + SEQ;
constexpr int INW = 4056, NPROJ = 4096;
constexpr int NE = 64, NE1 = 65, TOPK = 8, EH = 256;
constexpr int GRIDW = 64, GRIDH = SEQ / GRIDW;
constexpr int PA_Q = 0, PA_K = 256, PA_V = 512, PA_G = 768, PA_GF = 1024, PA_GB = 1040;
constexpr int PB_R = 1056, PB_K = 1312, PB_V = 1568, PB_WF = 1824, PB_WB = 1856, PB_A = 1888, PB_G = 1920;
constexpr int PC_Z = 1984, PC_X = 2240, PC_DF = 3008, PC_DB = 3012;
constexpr int PD_Q = 3016, PD_Z = 3784, PD_BF = 4040, PD_BB = 4044, PD_AF = 4048, PD_AB = 4052;
enum { I_X = 0, I_C, I_CTX, I_CCTX, I_N1G, I_N2G, I_WMOD, I_BMOD, I_WIN, I_WOUT, I_GLA_W2, I_GLA_B, I_GLA_NG,
       I_RW_W2, I_RW_W0, I_RW_AW2, I_RW_A0, I_RW_GW2, I_RW_KK, I_RW_KA, I_RW_RK, I_RW_LNG, I_RW_LNB,
       I_SS_CW, I_SS_CB, I_SS_ALOG, I_SS_DTB, I_SS_D, I_SS_NG, I_DN_CW, I_DN_ALOG, I_DN_DTB, I_DN_NG,
       I_ROUT_W, I_ROUT_B, I_EXP_G, I_EXP_U, I_EXP_D, I_SH_G, I_SH_U, I_SH_D, I_FNG, N_IN };
static_assert(N_IN == 42, "input count");

constexpr size_t MiB = 1u << 20;
constexpr size_t WS_CTL = 0, CTL_ZERO_BYTES = 1 * MiB;
constexpr size_t WS_MOD = 1 * MiB;
constexpr size_t WS_RWGW = WS_MOD + 256 * 1024;
constexpr size_t WS_RWLR = WS_MOD + 384 * 1024;
constexpr size_t WS_WIN = 2 * MiB;
constexpr size_t WS_WOUT = 18 * MiB;
constexpr size_t WS_ROUT = 22 * MiB;
constexpr size_t WS_CTXRES = 23 * MiB;
constexpr size_t WS_EXPGU = 27 * MiB;
constexpr size_t WS_EXPD = 92 * MiB;
constexpr size_t WS_HBUF = 125 * MiB;
constexpr size_t WS_PROJ = 191 * MiB;
constexpr size_t WS_SCR = 455 * MiB;
constexpr size_t WS_END = 640455456;
constexpr int HROWS_MAX = ROWS * 9 + NE1 * 256;
constexpr size_t WS_Y = WS_HBUF;
constexpr size_t WS_H = 443 * MiB;
constexpr size_t WS_LTOK = 600 * MiB;
constexpr size_t WS_TOKT = WS_LTOK + (size_t)NE * ROWS * 4;
static_assert(WS_Y + (size_t)HROWS_MAX * 512 * 2 <= WS_H && WS_H + (size_t)HROWS_MAX * 256 * 2 <= WS_LTOK && WS_TOKT + (size_t)ROWS * 64 <= WS_END, "moe overlay");
constexpr size_t SC_OF = WS_SCR;
constexpr size_t SC_OB = SC_OF + (size_t)SB * 1024 * 2;
constexpr size_t SC_RK = SC_OB + (size_t)SB * 1024 * 2;
constexpr size_t SC_RKK = SC_RK + (size_t)SB * 256 * 4;
constexpr size_t SC_RB = SC_RKK + (size_t)SB * 256 * 4;
constexpr size_t SC_RLW = SC_RB + (size_t)SB * 256 * 4;
constexpr size_t SC_SX = SC_RLW + (size_t)2 * SB * 256 * 4;
constexpr size_t SC_DQ = SC_SX + (size_t)SB * 768 * 2;
constexpr size_t SC_SDT = SC_DQ + (size_t)SB * 768 * 2;
constexpr size_t SC_DG = SC_SDT + (size_t)SB * 8 * 4;
constexpr size_t SC_FEND = SC_DG + (size_t)SB * 16 * 4;
constexpr int NTB = SB / 64, NUNIT = NTB * 4 * 2;
constexpr size_t SC_RW_M = SC_FEND;
constexpr size_t SC_RW_NS = SC_RW_M + (size_t)(SB / 64 * 8) * 4096 * 2;
constexpr size_t SC_RW_WU = SC_RW_NS + (size_t)(SB / 64 * 8) * 4096 * 2;
constexpr size_t SC_END = SC_RW_WU + (size_t)(SB / 64 * 8) * 8192 * 2;
constexpr size_t SC2 = WS_EXPGU;
constexpr size_t SC_GLA_S = SC2;
constexpr size_t SC_GLA_DEC = SC_GLA_S + (size_t)NUNIT * 4096 * 4;
constexpr size_t SC_SSD_S = SC_GLA_DEC + (size_t)NUNIT * 64 * 4;
constexpr size_t SC_SSD_CD = SC_SSD_S + (size_t)NUNIT * 8192 * 4;
constexpr size_t SC_DR_M = SC_SSD_CD + (size_t)NUNIT * 4 + 4096;
constexpr size_t SC_DR_NS = SC_DR_M + (size_t)NUNIT * 4096 * 2;
constexpr size_t SC_DR_WU = SC_DR_NS + (size_t)NUNIT * 4096 * 2;
constexpr size_t SC2_END = SC_DR_WU + (size_t)NUNIT * 8192 * 2;
static_assert(SC2_END <= WS_HBUF, "chunk slots fit in the expert-weight region");
static_assert(SC_END <= WS_END, "scratch fits");
constexpr int CW_CNT = 1024;
constexpr int CW_BAR = 4096;

#define LAS __attribute__((address_space(3)))
constexpr int NTHR = 512;
constexpr int LDS_BYTES = 147456;
constexpr int LDS_CTL = 143360;
constexpr int LDS_PTRS = LDS_CTL + 2048;

__device__ __forceinline__ int lane_id_asm() { int l; asm volatile("v_mbcnt_lo_u32_b32 %0, -1, 0\n\tv_mbcnt_hi_u32_b32 %0, -1, %0" : "=v"(l)); return l; }
__device__ __forceinline__ float bf2f(bf16_t b) { return __uint_as_float(((unsigned)b) << 16); }
typedef float f32x2_t __attribute__((ext_vector_type(2))); typedef __bf16 bf16x2_t __attribute__((ext_vector_type(2)));
__device__ __forceinline__ unsigned pk2(float lo, float hi) { const f32x2_t v = {lo, hi}; return __builtin_bit_cast(unsigned, __builtin_convertvector(v, bf16x2_t)); }
__device__ __forceinline__ unsigned f2bf(float f) { return pk2(f, 0.f) & 0xffffu; }
__device__ __forceinline__ float rl(float x, int k) { return __uint_as_float(__builtin_amdgcn_readlane(__float_as_uint(x), k)); }
__device__ __forceinline__ float shx_(float v, int lane, int o) { return __uint_as_float(__builtin_amdgcn_ds_bpermute((lane ^ o) << 2, __float_as_uint(v))); }
__device__ __forceinline__ int shxi_(int v, int lane, int o) { return __builtin_amdgcn_ds_bpermute((lane ^ o) << 2, v); }
__device__ __forceinline__ float shup_(float v, int lane, int o) { return __uint_as_float(__builtin_amdgcn_ds_bpermute((lane - o) << 2, __float_as_uint(v))); }
#define DPPF(v, ctrl) __uint_as_float(__builtin_amdgcn_update_dpp(0, __float_as_uint(v), ctrl, 0xf, 0xf, false))
#define DPPI(v, ctrl) __builtin_amdgcn_update_dpp(0, (v), ctrl, 0xf, 0xf, false)
__device__ __forceinline__ float wsum(float v) {
    v += DPPF(v, 0xB1); v += DPPF(v, 0x4E); v += DPPF(v, 0x141); v += DPPF(v, 0x140);
    v += __uint_as_float(__builtin_amdgcn_ds_swizzle(__float_as_uint(v), 0x401F));
    return rl(v, 0) + rl(v, 32);
}
__device__ __forceinline__ float rcp_(float x) { return __builtin_amdgcn_rcpf(x); }
__device__ __forceinline__ float rsq_(float x) { return __builtin_amdgcn_rsqf(x); }
__device__ __forceinline__ float sigmoidf_(float x) { return rcp_(1.0f + __expf(-x)); }
__device__ __forceinline__ float siluf_(float x) { return x * rcp_(1.0f + __expf(-x)); }
__device__ __forceinline__ float log1pexp_(float t  ) { return t < 1e-4f ? t - 0.5f * t * t : __logf(1.0f + t); }
__device__ __forceinline__ float softplusf_(float x) { return x > 15.f ? x : log1pexp_(__expf(x)); }
__device__ __forceinline__ float logsigmoidf_(float x) { return fminf(x, 0.f) - log1pexp_(__expf(-fabsf(x))); }
__device__ __forceinline__ float tanhf_(float x) { const float e = __expf(2.0f * fminf(fmaxf(x, -15.f), 15.f)); return (e - 1.0f) * rcp_(e + 1.0f); }
__device__ __forceinline__ int seq_tok(int i, int d) { return d == 0 ? i : (i < NCTX ? NCTX - 1 - i : SB + NCTX - 1 - i); }
__device__ __forceinline__ int tok_row(int b, int s) { return s < NCTX ? b * NCTX + s : CROWS + b * SEQ + (s - NCTX); }

#define GAS __attribute__((address_space(1)))
struct Params { const float* in[N_IN]; float* out; unsigned char* ws; int lo, hi, li, pad; };
struct Cx { unsigned long long out, ws; int tid, bid, G, pad; };
__device__ __forceinline__ const float* PIN(int i) {
    extern __shared__ __attribute__((aligned(16))) unsigned char lds_raw_[];
    int off = __builtin_amdgcn_readfirstlane(LDS_PTRS + 8 * i); asm volatile("" : "+s"(off));
    const LAS unsigned* t = (const LAS unsigned*)((LAS unsigned char*)lds_raw_ + off);
    const unsigned lo = __builtin_amdgcn_readfirstlane(t[0]), hi = __builtin_amdgcn_readfirstlane(t[1]);
    return (const float*)(const GAS float*)(((unsigned long long)hi << 32) | lo);
}
#define XB_TMO      128
#define XB_XCNT(j)  (256  + 64 * (j))
#define XB_XSUB(j)  (1280 + 64 * (j))
#define XB_XGEN(j)  (2304 + 64 * (j))
#define XB_TOP      3328
#define XB_TOPGEN   3392
#define XCD_BAR_WORDS 3456
#define XB_SPIN_CAP (1u << 18)

__device__ __forceinline__ unsigned xb_ld(unsigned* p)              { return __hip_atomic_load(p, __ATOMIC_RELAXED, __HIP_MEMORY_SCOPE_AGENT); }
__device__ __forceinline__ unsigned xb_add(unsigned* p, unsigned v) { return __hip_atomic_fetch_add(p, v, __ATOMIC_RELAXED, __HIP_MEMORY_SCOPE_AGENT); }
__device__ __forceinline__ unsigned xb_xcc_id() { return (unsigned)__builtin_amdgcn_s_getreg((3 << 11) | 20) & 0xFu; }
#define XB_SPIN(cond, bar) do { unsigned _sp = 0; while (cond) { __builtin_amdgcn_s_sleep(1); \
    if ((++_sp & 255u) == 0u) { if (xb_ld(&(bar)[XB_TMO])) break; if (_sp > XB_SPIN_CAP) { atomicAdd(&(bar)[XB_TMO], 1u); break; } } } } while (0)

struct XcdBarrier {
    unsigned* bar; unsigned x;
    volatile LAS unsigned* st;
};

__device__ __forceinline__ XcdBarrier xcd_barrier_post(unsigned* bar, volatile LAS unsigned* st, const unsigned xb_tid) {
    XcdBarrier b; b.bar = bar; b.x = xb_xcc_id(); b.st = st;
    if (xb_tid == 0) (void)xb_add(&bar[XB_XCNT(b.x)], 1u);
    return b;
}
__device__ __forceinline__ void xcd_barrier_complete(unsigned* bar, unsigned x, unsigned& nloc, unsigned& nx) {
    const unsigned G = gridDim.x * gridDim.y * gridDim.z;
    unsigned sum, cnt, mine, sp = 0u;
    for (;;) {
        sum = 0u; cnt = 0u; mine = 0u;
#pragma unroll
        for (unsigned j = 0; j < 16; ++j) { const unsigned c = xb_ld(&bar[XB_XCNT(j)]); sum += c; cnt += (c > 0u) ? 1u : 0u; mine = (j == x) ? c : mine; }
        if (sum == G) break;
        __builtin_amdgcn_s_sleep(1);
        if ((++sp & 255u) == 0u) { if (xb_ld(&bar[XB_TMO])) break; if (sp > XB_SPIN_CAP) { atomicAdd(&bar[XB_TMO], 1u); break; } }
    }
    nloc = mine > 0u ? mine : 1u; nx = cnt > 0u ? cnt : 1u;
}

__device__ __forceinline__ void xcd_barrier(const XcdBarrier& b, const unsigned xb_tid) {
    asm volatile("s_waitcnt vmcnt(0)" ::: "memory");
    __syncthreads();
    if (xb_tid == 0) {
        unsigned* bar = b.bar;
        __builtin_amdgcn_s_waitcnt(0);
        unsigned nloc = b.st[0], nx = b.st[1];
        if (nloc == 0u) { xcd_barrier_complete(bar, b.x, nloc, nx); b.st[0] = nloc; b.st[1] = nx; }
        const unsigned old = xb_add(&bar[XB_XSUB(b.x)], 1u);
        const unsigned gen = old / nloc;
        if (old + 1u == (gen + 1u) * nloc) {
            __builtin_amdgcn_fence(__ATOMIC_RELEASE, "agent");
            asm volatile("s_waitcnt vmcnt(0)" ::: "memory");
            const unsigned og = xb_add(&bar[XB_TOP], 1u);
            const unsigned tg = og / nx;
            if (og + 1u == (tg + 1u) * nx) xb_add(&bar[XB_TOPGEN], 1u);
            else XB_SPIN(xb_ld(&bar[XB_TOPGEN]) == tg, bar);
            __builtin_amdgcn_fence(__ATOMIC_ACQUIRE, "agent");
            xb_add(&bar[XB_XGEN(b.x)], 1u);
            asm volatile("s_waitcnt vmcnt(0)" ::: "memory");
        } else {
            XB_SPIN(xb_ld(&bar[XB_XGEN(b.x)]) == gen, bar);
            __builtin_amdgcn_fence(__ATOMIC_ACQUIRE, "agent");
            asm volatile("s_waitcnt vmcnt(0)" ::: "memory");
        }
    }
    __syncthreads();
}

namespace pg8 {
constexpr int BM = 256, BK = 64, HALF = 128, HTB = HALF * BK * 2  , STAGE_BYTES = 8 * HTB, NXCD = 8, WGM = 8;
__host__ __device__ __forceinline__ int lds_byte(int r, int c) { const int st = (r >> 4) * 2 + (c >> 5), rr = r & 15, cc = c & 31, ob = rr * 64 + cc * 2; return st * 1024 + (ob ^ (((ob >> 9) & 1) << 5)); }
__host__ __device__ __forceinline__ void stage_rc(int b, int& R, int& C) { const int st = b / 1024, sb = b % 1024, swz = sb ^ (((sb >> 9) & 1) << 5); R = (st >> 1) * 16 + swz / 64; C = (st & 1) * 32 + (swz % 64) / 2; }
__host__ __device__ __forceinline__ int perm32(int rho) { const int n = rho >> 4, i = rho & 15; return 8 * (i >> 2) + 4 * n + (i & 3); }

struct Unit { int pm, pn, e, r0; };

__device__ __forceinline__ unsigned cvt_pk_bf16(float lo, float hi) { unsigned r; asm volatile("v_cvt_pk_bf16_f32 %0, %1, %2" : "=v"(r) : "v"(lo), "v"(hi)); return r; }

template <int K, class Epi, class Sched>
__device__ __forceinline__ void gemm_phase(const int tid, LAS unsigned char* lds, const char* Abase, const Sched& S, const Epi& E) {
    const int wid = __builtin_amdgcn_readfirstlane(tid >> 6), lane = tid & 63, wr = wid >> 2, wc = wid & 3, fr = lane & 15, fq = lane >> 4;
    const int nt = K / BK;
    constexpr bool DN = Sched::DENSE;
    int RA[2], CA[2]; unsigned voffB[2], voffA[2];
#pragma unroll
    for (int i = 0; i < 2; ++i) { int R, C; stage_rc(tid * 16 + i * 8192, R, C); const int Rb = Epi::PERM ? ((R & ~31) + perm32(R & 31)) : R;
        RA[i] = R; CA[i] = C; voffB[i] = (unsigned)(Rb * K + C) * 2u; voffA[i] = (unsigned)(R * K + C) * 2u; }
    const size_t kstep = (size_t)(BK * 2);
    const size_t hstep = (size_t)HALF * K * 2;
    const size_t tstep = 2 * hstep;
    const unsigned ldsw = (unsigned)wid * 1024u;
    const int aoff = lds_byte(wr * 64 + fr, fq * 8), boff = lds_byte(wc * 32 + fr, fq * 8);
#define PG8_SA(b, h) (((b) * 2 + (h)) * HTB)
#define PG8_SB(b, h) ((4 + (b) * 2 + (h)) * HTB)
#define PG8_STAGE(bufoff, gbase, voff) do { _Pragma("unroll") for (int _i = 0; _i < 2; ++_i) \
        __builtin_amdgcn_global_load_lds((const __attribute__((address_space(1))) unsigned*)((const __attribute__((address_space(1))) char*)(gbase) + (voff)[_i]), (LAS unsigned*)(lds + (bufoff) + ldsw + _i * 8192), 16, 0, 0); } while (0)
#define PG8_LDA(dst, b, h) do { _Pragma("unroll") for (int m = 0; m < 4; ++m) _Pragma("unroll") for (int k = 0; k < 2; ++k) dst[m][k] = *(const LAS bf16x8*)(lds + PG8_SA(b, h) + aoff + m * 2048 + k * 1024); } while (0)
#define PG8_LDB(dst, b, h) do { _Pragma("unroll") for (int n = 0; n < 2; ++n) _Pragma("unroll") for (int k = 0; k < 2; ++k) dst[n][k] = *(const LAS bf16x8*)(lds + PG8_SB(b, h) + boff + n * 2048 + k * 1024); } while (0)
#define PG8_MMA(ai, bj, At, Bt) do { __builtin_amdgcn_s_setprio(1); _Pragma("unroll") for (int m = 0; m < 4; ++m) _Pragma("unroll") for (int n = 0; n < 2; ++n) _Pragma("unroll") for (int k = 0; k < 2; ++k) \
        acc[ai][bj][m][n] = __builtin_amdgcn_mfma_f32_16x16x32_bf16(Bt[n][k], At[m][k], acc[ai][bj][m][n], 0, 0, 0); __builtin_amdgcn_s_setprio(0); } while (0)
#define PG8_WAIT_V(n) asm volatile("s_waitcnt vmcnt(" #n ")" ::: "memory")
#define PG8_WAIT_L(n) asm volatile("s_waitcnt lgkmcnt(" #n ")" ::: "memory")
#define PG8_BAR __builtin_amdgcn_s_barrier()
#define PG8_SCHED __builtin_amdgcn_sched_barrier(0)
#define PG8_AOFF(dst, u) do { _Pragma("unroll") for (int _h = 0; _h < 2; ++_h) _Pragma("unroll") for (int _i = 0; _i < 2; ++_i) \
        dst[_h][_i] = ((unsigned)S.a_row(u, _h * HALF + RA[_i]) * (unsigned)K + (unsigned)CA[_i]) * 2u; } while (0)
    Unit cur, nxt; int ui = 0;
    if (!S.next(0, cur)) return;
    f32x4 acc[2][2][4][2];
#pragma unroll
    for (int a = 0; a < 2; ++a)
#pragma unroll
        for (int b = 0; b < 2; ++b)
#pragma unroll
            for (int m = 0; m < 4; ++m)
#pragma unroll
                for (int n = 0; n < 2; ++n) acc[a][b][m][n] = (f32x4){0.f, 0.f, 0.f, 0.f};
    bf16x8 At[4][2], B0[2][2], B1[2][2];
    unsigned cO[2][2], nO[2][2];
    const char* cA = Abase; const char* nA = Abase;
    if constexpr (DN) cA = Abase + (size_t)S.a_row(cur, 0) * K * 2; else PG8_AOFF(cO, cur);
    const char* cB = S.b_ptr(cur);
#define PG8_STA(bufoff, h_, kb_, nx_) do { if constexpr (DN) PG8_STAGE(bufoff, ((nx_) ? nA : cA) + (h_) * hstep + (kb_), voffA); else PG8_STAGE(bufoff, Abase + (kb_), ((nx_) ? nO : cO)[h_]); } while (0)
    PG8_STAGE(PG8_SB(0, 0), cB, voffB); PG8_SCHED; PG8_STA(PG8_SA(0, 0), 0, 0, false); PG8_SCHED; PG8_STAGE(PG8_SB(0, 1), cB + hstep, voffB); PG8_SCHED; PG8_STA(PG8_SA(0, 1), 1, 0, false); PG8_SCHED;
    if (wr == 1) PG8_BAR;
    PG8_WAIT_V(4); PG8_BAR;
    PG8_STAGE(PG8_SB(1, 0), cB + kstep, voffB); PG8_SCHED; PG8_STA(PG8_SA(1, 0), 0, kstep, false); PG8_SCHED; PG8_STAGE(PG8_SB(1, 1), cB + hstep + kstep, voffB); PG8_SCHED;
    PG8_WAIT_V(6); PG8_BAR;
    for (;;) {
        const bool has_next = S.next(ui + 1, nxt);
        const char* nB = cB; nA = cA;
        if (has_next) { if constexpr (DN) nA = Abase + (size_t)S.a_row(nxt, 0) * K * 2; else PG8_AOFF(nO, nxt); nB = S.b_ptr(nxt); }
        else if constexpr (!DN) {
#pragma unroll
            for (int h = 0; h < 2; ++h)
#pragma unroll
                for (int i = 0; i < 2; ++i) nO[h][i] = cO[h][i]; }
        for (int t = 0; t < nt; t += 2) {
            const bool last = (t == nt - 2);
            const size_t k1 = (size_t)(t + 1) * kstep, k2 = last ? 0 : (size_t)(t + 2) * kstep, k3 = k2 + kstep;
            const char* b2 = last ? nB : cB + (size_t)(t + 2) * kstep; const char* b3 = b2 + kstep;
            PG8_LDB(B0, 0, 0); PG8_SCHED; PG8_LDA(At, 0, 0); PG8_STA(PG8_SA(1, 1), 1, k1, false);
            PG8_WAIT_L(8); PG8_BAR; PG8_WAIT_L(0); PG8_MMA(0, 0, At, B0); PG8_BAR; PG8_SCHED;
            PG8_LDB(B1, 0, 1); PG8_STAGE(PG8_SB(0, 0), b2, voffB);
            PG8_BAR; PG8_WAIT_L(0); PG8_MMA(0, 1, At, B1); PG8_BAR;
            PG8_LDA(At, 0, 1); PG8_STA(PG8_SA(0, 0), 0, k2, last);
            PG8_BAR; PG8_WAIT_L(0); PG8_MMA(1, 0, At, B0); PG8_BAR; PG8_SCHED;
            PG8_STAGE(PG8_SB(0, 1), b2 + hstep, voffB);
            PG8_WAIT_V(6); PG8_BAR; PG8_MMA(1, 1, At, B1); PG8_BAR;
            PG8_LDB(B0, 1, 0); PG8_SCHED; PG8_LDA(At, 1, 0); PG8_STA(PG8_SA(0, 1), 1, k2, last);
            PG8_WAIT_L(8); PG8_BAR; PG8_WAIT_L(0); PG8_MMA(0, 0, At, B0); PG8_BAR; PG8_SCHED;
            PG8_LDB(B1, 1, 1); PG8_STAGE(PG8_SB(1, 0), b3, voffB);
            PG8_BAR; PG8_WAIT_L(0); PG8_MMA(0, 1, At, B1); PG8_BAR;
            PG8_LDA(At, 1, 1); PG8_STA(PG8_SA(1, 0), 0, k3, last);
            PG8_BAR; PG8_WAIT_L(0); PG8_MMA(1, 0, At, B0); PG8_BAR; PG8_SCHED;
            PG8_STAGE(PG8_SB(1, 1), b3 + hstep, voffB);
            PG8_WAIT_V(6); PG8_BAR; PG8_MMA(1, 1, At, B1); PG8_BAR;
        }
        E(acc, cur, wid);
        if (!has_next) break;
#pragma unroll
        for (int a = 0; a < 2; ++a)
#pragma unroll
            for (int b = 0; b < 2; ++b)
#pragma unroll
                for (int m = 0; m < 4; ++m)
#pragma unroll
                    for (int n = 0; n < 2; ++n) acc[a][b][m][n] = (f32x4){0.f, 0.f, 0.f, 0.f};
        cur = nxt; cB = nB; cA = nA; ++ui;
        if constexpr (!DN) {
#pragma unroll
        for (int h = 0; h < 2; ++h)
#pragma unroll
            for (int i = 0; i < 2; ++i) cO[h][i] = nO[h][i]; }
    }
    PG8_WAIT_V(0);
    if (wr == 0) PG8_BAR;
    PG8_BAR;
#undef PG8_SA
#undef PG8_SB
#undef PG8_STAGE
#undef PG8_LDA
#undef PG8_LDB
#undef PG8_MMA
#undef PG8_WAIT_V
#undef PG8_WAIT_L
#undef PG8_BAR
#undef PG8_SCHED
#undef PG8_AOFF
#undef PG8_STA
}
}
struct DenseSched {
    static constexpr bool DENSE = true;
    int nM, nN, nwg, G, c, K; const char* Bt;
    __device__ __forceinline__ void init(int M, int N, int K_, const bf16_t* Bt_, int G_, int c_) { nM = M / 256; nN = N / 256; nwg = nM * nN; G = G_; c = c_; K = K_; Bt = (const char*)Bt_; }
    __device__ __forceinline__ bool next(int i, pg8::Unit& u) const {
        const long L = (long)i * G + c; if (L >= nwg) return false;
        int wgid = (int)L; { const int q = nwg / 8, r = nwg % 8, xcd = wgid % 8, off = wgid / 8; wgid = (xcd < r ? xcd * (q + 1) : r * (q + 1) + (xcd - r) * q) + off; }
        const int nig = 8 * nN, gid = wgid / nig, fm = gid * 8, gsz = (nM - fm) < 8 ? (nM - fm) : 8;
        u.pm = fm + ((wgid % nig) % gsz); u.pn = (wgid % nig) / gsz; u.e = 0; u.r0 = 0; return true;
    }
    __device__ __forceinline__ int a_row(const pg8::Unit& u, int r) const { return u.pm * 256 + r; }
    __device__ __forceinline__ const char* b_ptr(const pg8::Unit& u) const { return Bt + (size_t)u.pn * 256 * K * 2; }
};
template <bool GATHER> struct MoeSched {
    static constexpr bool DENSE = !GATHER;
    const LAS int* tstart; const LAS int* cnt; int nN, G, c, K, row_lo; const int* ltok; const char* Bt; size_t bstride;
    __device__ __forceinline__ bool next(int i, pg8::Unit& u) const {
        const long L = (long)i * G + c; const int ntile = __builtin_amdgcn_readfirstlane(tstart[NE1]); if (L >= (long)ntile * nN) return false;
        const int tile = (int)(L / nN); u.pn = (int)(L % nN);
        int e = 0;
#pragma unroll 1
        for (int step = 64; step >= 1; step >>= 1) { const int e2 = e + step; if (e2 <= NE && tstart[e2] <= tile) e = e2; }
        e = __builtin_amdgcn_readfirstlane(e); u.e = e; u.pm = __builtin_amdgcn_readfirstlane(tile); u.pn = __builtin_amdgcn_readfirstlane(u.pn); u.r0 = __builtin_amdgcn_readfirstlane((tile - tstart[e]) * 256); return true;
    }
    __device__ __forceinline__ int a_row(const pg8::Unit& u, int r) const {
        if (!GATHER) return u.pm * 256 + r;
        const int ri = u.r0 + r;
        if (u.e == NE) return ri < cnt[NE] ? row_lo + ri : row_lo;
        return ri < cnt[u.e] ? ltok[(size_t)u.e * ROWS + ri] : row_lo;
    }
    __device__ __forceinline__ const char* b_ptr(const pg8::Unit& u) const { return Bt + (size_t)u.e * bstride + (size_t)u.pn * 256 * K * 2; }
};

struct EpiProj {
    static constexpr bool PERM = true;
    bf16_t* O; int ldc;
    __device__ __forceinline__ void operator()(const f32x4 (&acc)[2][2][4][2], const pg8::Unit& u, const int wid) const {
        const int lane_ = lane_id_asm(), fr = lane_ & 15, fq = lane_ >> 4, wr = wid >> 2, wc = wid & 3;
        const int row0 = u.pm * 256 + wr * 64 + fr, col0 = u.pn * 256 + wc * 32 + 8 * fq;
#pragma unroll
        for (int ai = 0; ai < 2; ++ai)
#pragma unroll
            for (int m = 0; m < 4; ++m) { bf16_t* rowp = O + (size_t)(row0 + ai * 128 + m * 16) * ldc + col0;
#pragma unroll
                for (int bj = 0; bj < 2; ++bj) { const f32x4 v0 = acc[ai][bj][m][0], v1 = acc[ai][bj][m][1];
                    u32x4 w; w.x = pg8::cvt_pk_bf16(v0[0], v0[1]); w.y = pg8::cvt_pk_bf16(v0[2], v0[3]); w.z = pg8::cvt_pk_bf16(v1[0], v1[1]); w.w = pg8::cvt_pk_bf16(v1[2], v1[3]);
                    *(u32x4*)(rowp + bj * 128) = w; } }
    }
};
struct EpiRes {
    static constexpr bool PERM = false;
    const float* xsrc; const float* csrc; float* xdst; float* cdst; const float* gate;
    __device__ __forceinline__ void operator()(const f32x4 (&acc)[2][2][4][2], const pg8::Unit& u, const int wid) const {
        const int lane_ = lane_id_asm(), fr = lane_ & 15, fq = lane_ >> 4, wr = wid >> 2, wc = wid & 3;
        const int col0 = u.pn * 256 + wc * 32 + 4 * fq;
        const bool isc = u.pm < 4; const int sel = isc ? 4 : (u.pm - 4) >> 5;
        const float* src = isc ? csrc + (size_t)u.pm * 256 * D : xsrc + (size_t)(u.pm - 4) * 256 * D;
        float* dst = isc ? cdst + (size_t)u.pm * 256 * D : xdst + (size_t)(u.pm - 4) * 256 * D;
        f32x4 gv[2][2];
#pragma unroll
        for (int bj = 0; bj < 2; ++bj)
#pragma unroll
            for (int n = 0; n < 2; ++n) gv[bj][n] = *(const f32x4*)(gate + sel * 6144 + col0 + bj * 128 + n * 16);
#pragma unroll
        for (int ai = 0; ai < 2; ++ai)
#pragma unroll
            for (int m = 0; m < 4; ++m) { const size_t off = (size_t)(ai * 128 + wr * 64 + m * 16 + fr) * D + col0;
#pragma unroll
                for (int bj = 0; bj < 2; ++bj)
#pragma unroll
                    for (int n = 0; n < 2; ++n) { const f32x4 s = *(const f32x4*)(src + off + bj * 128 + n * 16); *(f32x4*)(dst + off + bj * 128 + n * 16) = s + gv[bj][n] * acc[ai][bj][m][n]; }
                asm volatile("" ::: "memory"); }
    }
};
struct EpiGU {
    static constexpr bool PERM = false;
    bf16_t* H;
    __device__ __forceinline__ void operator()(const f32x4 (&acc)[2][2][4][2], const pg8::Unit& u, const int wid) const {
        const int lane_ = lane_id_asm(), fr = lane_ & 15, fq = lane_ >> 4, wr = wid >> 2, wc = wid & 3;
        const int row0 = u.pm * 256 + wr * 64 + fr;
#pragma unroll
        for (int ai = 0; ai < 2; ++ai)
#pragma unroll
            for (int m = 0; m < 4; ++m) { bf16_t* rowp = H + (size_t)(row0 + ai * 128 + m * 16) * EH + 4 * fq;
#pragma unroll
                for (int bj = 0; bj < 2; ++bj) { const f32x4 g = acc[ai][bj][m][0], up = acc[ai][bj][m][1]; float h[4];
#pragma unroll
                    for (int j = 0; j < 4; ++j) h[j] = g[j] * rcp_(1.0f + __expf(-g[j])) * up[j];
                    u32x2 w; w.x = pg8::cvt_pk_bf16(h[0], h[1]); w.y = pg8::cvt_pk_bf16(h[2], h[3]);
                    *(u32x2*)(rowp + (u.pn * 256 + bj * 128 + wc * 32) / 2) = w; } }
    }
};
struct EpiY {
    static constexpr bool PERM = true;
    bf16_t* Y;
    __device__ __forceinline__ void operator()(const f32x4 (&acc)[2][2][4][2], const pg8::Unit& u, const int wid) const {
        const int lane_ = lane_id_asm(), fr = lane_ & 15, fq = lane_ >> 4, wr = wid >> 2, wc = wid & 3;
        const int row0 = u.pm * 256 + wr * 64 + fr, col0 = u.pn * 256 + wc * 32 + 8 * fq;
#pragma unroll
        for (int ai = 0; ai < 2; ++ai)
#pragma unroll
            for (int m = 0; m < 4; ++m) { bf16_t* rowp = Y + (size_t)(row0 + ai * 128 + m * 16) * 512 + col0;
#pragma unroll
                for (int bj = 0; bj < 2; ++bj) { const f32x4 v0 = acc[ai][bj][m][0], v1 = acc[ai][bj][m][1];
                    u32x4 w; w.x = pg8::cvt_pk_bf16(v0[0], v0[1]); w.y = pg8::cvt_pk_bf16(v0[2], v0[3]); w.z = pg8::cvt_pk_bf16(v1[0], v1[1]); w.w = pg8::cvt_pk_bf16(v1[2], v1[3]);
                    *(u32x4*)(rowp + bj * 128) = w; } }
    }
};
#define WSP(T, off) ((T*)(GAS T*)(p.ws + (unsigned long long)(off)))
#define POUT ((float*)(GAS float*)p.out)

constexpr int CONV_A_UNITS = 2048 + 512 + 64 + 8 + 12;
struct ConvDesc { const float* src; bf16_t* dst; int ldsrc, lddst, k0, n0, mode, nvalid; };
struct ConvDescA { int dummy;
    __device__ __forceinline__ ConvDesc operator()(const Cx& p, int u) const { ConvDesc c;
        if (u < 2048) { const int l = u >> 10, r = u & 1023; c.src = PIN(I_WIN) + (size_t)l * D * INW; c.ldsrc = INW; c.k0 = (r >> 6) * 64; c.n0 = (r & 63) * 64; c.nvalid = INW; c.dst = WSP(bf16_t, WS_WIN) + (size_t)l * NPROJ * D; c.lddst = D; c.mode = 0; }
        else if (u < 2560) { const int v = u - 2048, l = v >> 8, r = v & 255; c.src = PIN(I_WOUT) + (size_t)l * D * D; c.ldsrc = D; c.k0 = (r >> 4) * 64; c.n0 = (r & 15) * 64; c.nvalid = D; c.dst = WSP(bf16_t, WS_WOUT) + (size_t)l * D * D; c.lddst = D; c.mode = 0; }
        else if (u >= 2632) { const int v = u - 2632, m = v >> 2, r = v & 3;
            c.src = m < NL ? PIN(I_RW_W2) + (size_t)m * 64 * 256 : PIN(I_RW_AW2); c.ldsrc = 256; c.k0 = 0; c.n0 = r * 64; c.nvalid = 256; c.dst = WSP(bf16_t, WS_RWLR) + (size_t)m * 256 * 64; c.lddst = 64; c.mode = 0; }
        else if (u >= 2624) { const int v = u - 2624, l = v >> 2, r = v & 3;
            c.src = PIN(I_RW_GW2) + (size_t)l * 64 * 256; c.ldsrc = 256; c.k0 = 0; c.n0 = r * 64; c.nvalid = 256; c.dst = WSP(bf16_t, WS_RWGW) + (size_t)l * 256 * 64; c.lddst = 64; c.mode = 0; }
        else { const int v = u - 2560, l = v >> 5, lo = (v >> 4) & 1, r = v & 15;
            c.src = PIN(I_ROUT_W) + (size_t)l * D * NE; c.ldsrc = NE; c.k0 = r * 64; c.n0 = 0; c.nvalid = NE; c.dst = WSP(bf16_t, WS_ROUT) + (size_t)(l * 2 + lo) * NE * D; c.lddst = D; c.mode = lo ? 3 : 0; }
        return c; } };
constexpr int CONV_E_UNITS = NE1 * 192;
struct ConvDescE { int l;
    __device__ __forceinline__ ConvDesc operator()(const Cx& p, int u) const { ConvDesc c; const int e = u / 192, r = u % 192; c.nvalid = 1 << 30;
        if (r < 128) { const int up = r >> 6, q = r & 63;
            c.src = e < NE ? PIN(up ? I_EXP_U : I_EXP_G) + ((size_t)l * NE + e) * D * EH : PIN(up ? I_SH_U : I_SH_G) + (size_t)l * D * EH;
            c.ldsrc = EH; c.k0 = (q >> 2) * 64; c.n0 = (q & 3) * 64; c.dst = WSP(bf16_t, WS_EXPGU) + (size_t)e * 512 * D; c.lddst = D; c.mode = 1 + up; }
        else { const int q = r - 128;
            c.src = e < NE ? PIN(I_EXP_D) + ((size_t)l * NE + e) * EH * D : PIN(I_SH_D) + (size_t)l * EH * D;
            c.ldsrc = D; c.k0 = (q >> 4) * 64; c.n0 = (q & 15) * 64; c.dst = WSP(bf16_t, WS_EXPD) + (size_t)e * D * EH; c.lddst = EH; c.mode = 0; }
        return c; } };
template <class DescF> __device__ __forceinline__ void conv_run(const Cx& p, LAS float* tl, int total, const DescF& df) {
    const int t = p.tid; int u = p.bid; if (u >= total) return;
    float v[8]; ConvDesc c = df(p, u);
#define CONV_LD(cc) _Pragma("unroll") for (int j = 0; j < 8; ++j) { const int idx = t + NTHR * j, k = idx >> 6, n = idx & 63; v[j] = (cc).n0 + n < (cc).nvalid ? (cc).src[(size_t)((cc).k0 + k) * (cc).ldsrc + (cc).n0 + n] : 0.f; }
    CONV_LD(c)
    for (;;) {
#pragma unroll
        for (int j = 0; j < 8; ++j) { const int idx = t + NTHR * j; tl[(idx >> 6) * 65 + (idx & 63)] = v[j]; }
        __syncthreads();
        const int un = u + p.G; const bool more = un < total; const ConvDesc cn = df(p, more ? un : u);
        if (more) { CONV_LD(cn) }
#pragma unroll
        for (int j = 0; j < 4; ++j) { const int pi = t + NTHR * j, n = pi >> 5, k = (pi & 31) * 2; const int nn = c.n0 + n;
            const int row = (c.mode == 0 || c.mode == 3) ? nn : ((nn >> 4) * 32 + (nn & 15) + (c.mode == 2 ? 16 : 0));
            float v0 = tl[k * 65 + n], v1 = tl[(k + 1) * 65 + n];
            if (c.mode == 3) { v0 -= bf2f((bf16_t)f2bf(v0)); v1 -= bf2f((bf16_t)f2bf(v1)); }
            *(unsigned*)(c.dst + (size_t)row * c.lddst + c.k0 + k) = pk2(v0, v1); }
        __syncthreads();
        if (!more) break;
        c = cn; u = un;
    }
#undef CONV_LD
}
__device__ __forceinline__ void phase_mod(const Cx& p, LAS unsigned char* lds) {
    LAS float* sv = (LAS float*)lds; LAS float* red = sv + 5 * D;
    const int tid = p.tid;
    if (p.bid >= 192) return;
    for (int i = tid; i < 5 * D; i += NTHR) { const int j = i >> 10, k = i & 1023; const float c = j < 4 ? PIN(I_C)[j * D + k] : PIN(I_CCTX)[k]; sv[i] = siluf_(c); }
    __syncthreads();
    for (int u = p.bid; u < 192; u += p.G) {
        const int l = u / 96, cb = u % 96, kg = tid >> 6, cl = tid & 63;
        const float* w = PIN(I_WMOD) + (size_t)l * D * 6144 + cb * 64 + cl;
        float a0 = 0.f, a1 = 0.f, a2 = 0.f, a3 = 0.f, a4 = 0.f;
#pragma unroll 32
        for (int kk = 0; kk < 128; ++kk) { const int k = kg * 128 + kk; const float wv = w[(size_t)k * 6144];
            a0 += sv[k] * wv; a1 += sv[D + k] * wv; a2 += sv[2 * D + k] * wv; a3 += sv[3 * D + k] * wv; a4 += sv[4 * D + k] * wv; }
        red[(kg * 5 + 0) * 64 + cl] = a0; red[(kg * 5 + 1) * 64 + cl] = a1; red[(kg * 5 + 2) * 64 + cl] = a2; red[(kg * 5 + 3) * 64 + cl] = a3; red[(kg * 5 + 4) * 64 + cl] = a4;
        __syncthreads();
        if (tid < 320) { const int j = tid >> 6; float s = 0.f;
#pragma unroll
            for (int g = 0; g < 8; ++g) s += red[(g * 5 + j) * 64 + cl];
            WSP(float, WS_MOD)[((size_t)l * 5 + j) * 6144 + cb * 64 + cl] = s + PIN(I_BMOD)[l * 6144 + cb * 64 + cl]; }
        __syncthreads();
    }
}
__device__ __forceinline__ const float* res_row(const Cx& p, int layer_src0, int r) {
    if (r < CROWS) return (layer_src0 ? PIN(I_CTX) : (const float*)WSP(float, WS_CTXRES)) + (size_t)r * D;
    return (layer_src0 ? PIN(I_X) : (const float*)POUT) + (size_t)(r - CROWS) * D;
}
__device__ __forceinline__ int row_sel(int r) { return r < CROWS ? 4 : (r - CROWS) >> 13; }

__device__ __forceinline__ void norm_ld(const float* src, f32x4 (&v)[4], int lane) {
#pragma unroll
    for (int i = 0; i < 4; ++i) v[i] = *(const f32x4*)(src + 256 * i + 4 * lane);
}
__device__ __forceinline__ void norm_fin(const f32x4 (&v)[4], const float* g, const float* shift, const float* scale, bf16_t* dst, const bool tolds, LAS bf16_t* ldst, LAS bf16_t* ldlo, int lane) {
    float ss = 0.f;
#pragma unroll
    for (int i = 0; i < 4; ++i) ss += v[i][0] * v[i][0] + v[i][1] * v[i][1] + v[i][2] * v[i][2] + v[i][3] * v[i][3];
    ss = wsum(ss); const float rstd = rsq_(ss * (1.0f / D) + 1e-6f);
#pragma unroll
    for (int i = 0; i < 4; ++i) { const int col = 256 * i + 4 * lane; const f32x4 gv = *(const f32x4*)(g + col), sh = *(const f32x4*)(shift + col), sc = *(const f32x4*)(scale + col);
        const f32x4 y = v[i] * rstd * gv * (sc + 1.0f) + sh; u32x2 w; w.x = pk2(y[0], y[1]); w.y = pk2(y[2], y[3]);
        *(u32x2*)(dst + col) = w;
        if (tolds) { *(LAS u32x2*)(ldst + col) = w; u32x2 wl;
            wl.x = pk2(y[0] - __uint_as_float(w.x << 16), y[1] - __uint_as_float(w.x & 0xffff0000u)); wl.y = pk2(y[2] - __uint_as_float(w.y << 16), y[3] - __uint_as_float(w.y & 0xffff0000u));
            *(LAS u32x2*)(ldlo + col) = wl; } }
}
struct ModC { int s; f32x4 A[4], B[4];
    __device__ __forceinline__ void load(const float* g, const float* shift, const float* scale, int s_, int lane) { s = s_;
#pragma unroll
        for (int i = 0; i < 4; ++i) { const int col = 256 * i + 4 * lane; A[i] = *(const f32x4*)(g + col) * (*(const f32x4*)(scale + col) + 1.0f); B[i] = *(const f32x4*)(shift + col); } } };
__device__ __forceinline__ void norm_fin2(const f32x4 (&v)[4], const ModC& mc, bf16_t* dst, const bool tolds, LAS bf16_t* ldst, LAS bf16_t* ldlo, int lane) {
    float ss = 0.f;
#pragma unroll
    for (int i = 0; i < 4; ++i) ss += v[i][0] * v[i][0] + v[i][1] * v[i][1] + v[i][2] * v[i][2] + v[i][3] * v[i][3];
    ss = wsum(ss); const float rstd = rsq_(ss * (1.0f / D) + 1e-6f);
#pragma unroll
    for (int i = 0; i < 4; ++i) { const int col = 256 * i + 4 * lane;
        const f32x4 y = v[i] * rstd * mc.A[i] + mc.B[i]; u32x2 w; w.x = pk2(y[0], y[1]); w.y = pk2(y[2], y[3]);
        *(u32x2*)(dst + col) = w;
        if (tolds) { *(LAS u32x2*)(ldst + col) = w; u32x2 wl;
            wl.x = pk2(y[0] - __uint_as_float(w.x << 16), y[1] - __uint_as_float(w.x & 0xffff0000u)); wl.y = pk2(y[2] - __uint_as_float(w.y << 16), y[3] - __uint_as_float(w.y & 0xffff0000u));
            *(LAS u32x2*)(ldlo + col) = wl; } }
}
__device__ __forceinline__ void phase_norm1(const Cx& p, int layer) {
    const int lane = p.tid & 63, wave = p.tid >> 6;
    const float* mod = WSP(float, WS_MOD) + (size_t)layer * 5 * 6144; const float* g = PIN(I_N1G) + layer * D; bf16_t* hb = WSP(bf16_t, WS_HBUF);
    ModC mc; mc.s = -1; f32x4 n0[4], n1[4];
    int r = p.bid * 16 + wave * 2;
    if (r < ROWS) { norm_ld(res_row(p, layer == 0, r), n0, lane); norm_ld(res_row(p, layer == 0, r + 1), n1, lane); }
    for (; r < ROWS; r += p.G * 16) { f32x4 v0[4], v1[4];
#pragma unroll
        for (int i = 0; i < 4; ++i) { v0[i] = n0[i]; v1[i] = n1[i]; }
        const int rn = r + p.G * 16; if (rn < ROWS) { norm_ld(res_row(p, layer == 0, rn), n0, lane); norm_ld(res_row(p, layer == 0, rn + 1), n1, lane); }
        const int s = row_sel(r); if (s != mc.s) mc.load(g, mod + s * 6144 + 0, mod + s * 6144 + 1024, s, lane);
        norm_fin2(v0, mc, hb + (size_t)r * D, false, (LAS bf16_t*)0, (LAS bf16_t*)0, lane);
        norm_fin2(v1, mc, hb + (size_t)(r + 1) * D, false, (LAS bf16_t*)0, (LAS bf16_t*)0, lane); }
}
__device__ __forceinline__ float sum8_(float v) { v += DPPF(v, 0xB1); v += DPPF(v, 0x4E); v += DPPF(v, 0x141); return v; }
__device__ __forceinline__ float sum16_(float v) { v = sum8_(v); v += DPPF(v, 0x140); return v; }
__device__ __forceinline__ void bf8_to_f(const u32x4 w, float (&f)[8]) {
#pragma unroll
    for (int q = 0; q < 4; ++q) { f[2 * q] = __uint_as_float(w[q] << 16); f[2 * q + 1] = __uint_as_float(w[q] & 0xffff0000u); } }
__device__ __forceinline__ void phase_prep(const Cx& p, LAS unsigned char* lds, int layer, int b) {
    const int lane = p.tid & 63, wave = __builtin_amdgcn_readfirstlane(p.tid >> 6);
    const bf16_t* proj = WSP(bf16_t, WS_PROJ);
    const int e0 = p.bid * NTHR + p.tid, e1 = e0 + p.G * NTHR; bf16_t sq0 = 0, sq1 = 0;
#define SCAL_COL(q) ((q) < 8 ? PC_DF + (q) : (q) < 16 ? PD_BF + ((q) - 8) : PD_AF + ((q) - 16))
    if (e0 < SB * 24) sq0 = proj[(size_t)tok_row(b, e0 / 24) * NPROJ + SCAL_COL(e0 % 24)];
    if (e1 < SB * 24) sq1 = proj[(size_t)tok_row(b, e1 / 24) * NPROJ + SCAL_COL(e1 % 24)];
    if (p.bid < SB / 33) {
        constexpr int ATS = 208;
        LAS unsigned char* WWt = lds; LAS unsigned char* AWt = lds + 256 * 144; LAS unsigned char* At = lds + 2 * 256 * 144;
        { const bf16_t* w2c = WSP(bf16_t, WS_RWLR) + (size_t)layer * 256 * 64; const bf16_t* awc = WSP(bf16_t, WS_RWLR) + (size_t)NL * 256 * 64;
#pragma unroll
          for (int q = 0; q < 4; ++q) { const int e = p.tid + NTHR * q, n = e >> 3, ch = e & 7;
              *(LAS u32x4*)(WWt + n * 144 + ch * 16) = *(const u32x4*)(w2c + n * 64 + ch * 8); *(LAS u32x4*)(AWt + n * 144 + ch * 16) = *(const u32x4*)(awc + n * 64 + ch * 8); } }
        const int h = wave & 3, half = wave >> 2, fr = lane & 15, fq = lane >> 4;
        float a0c[4], w0fc[4], w0bc[4], kkc[4], kac[4];
#pragma unroll
        for (int nt = 0; nt < 4; ++nt) { const int c = 64 * h + 16 * nt + fr; a0c[nt] = PIN(I_RW_A0)[layer * 256 + c]; w0fc[nt] = PIN(I_RW_W0)[(layer * 2 + 0) * 256 + c]; w0bc[nt] = PIN(I_RW_W0)[(layer * 2 + 1) * 256 + c];
            kkc[nt] = PIN(I_RW_KK)[layer * 256 + c]; kac[nt] = PIN(I_RW_KA)[layer * 256 + c]; }
        for (int u = p.bid; u < SB / 33; u += p.G) {
            if (p.tid < 33 * 12) { const int tk = p.tid / 12, ch = p.tid % 12; u32x4 w = *(const u32x4*)(proj + (size_t)tok_row(b, u * 33 + tk) * NPROJ + PB_WF + 8 * ch);
                if (ch < 8) {
#pragma unroll
                    for (int q = 0; q < 4; ++q) w[q] = pk2(tanhf_(__uint_as_float(w[q] << 16)), tanhf_(__uint_as_float(w[q] & 0xffff0000u))); }
                *(LAS u32x4*)(At + tk * ATS + ch * 16) = w; }
            bf16_t kvA[4][4], kvB[4];
#pragma unroll
            for (int j = 0; j < 4; ++j) { const bf16_t* pr = proj + (size_t)tok_row(b, u * 33 + 16 * half + 4 * fq + j) * NPROJ + PB_K + 64 * h + fr;
#pragma unroll
                for (int nt = 0; nt < 4; ++nt) kvA[nt][j] = pr[16 * nt]; }
            { const bf16_t* pr = proj + (size_t)tok_row(b, u * 33 + 32) * NPROJ + PB_K + 64 * h + fr;
#pragma unroll
              for (int nt = 0; nt < 4; ++nt) kvB[nt] = pr[16 * nt]; }
            __syncthreads();
#pragma unroll
            for (int pass = 0; pass < 2; ++pass) { if (pass == 1 && half != 0) break;
                const int mt = pass ? 2 : half; f32x4 sa[4], sf[4], sb[4];
                const bf16x8 awf = *(const LAS bf16x8*)(At + (16 * mt + fr) * ATS + fq * 16), awb = *(const LAS bf16x8*)(At + (16 * mt + fr) * ATS + 64 + fq * 16), aa = *(const LAS bf16x8*)(At + (16 * mt + fr) * ATS + 128 + fq * 16);
#pragma unroll
                for (int nt = 0; nt < 4; ++nt) { const int n = 64 * h + 16 * nt + fr; const f32x4 z = (f32x4){0.f, 0.f, 0.f, 0.f};
                    sf[nt] = __builtin_amdgcn_mfma_f32_16x16x32_bf16(awf, *(const LAS bf16x8*)(WWt + n * 144 + fq * 16), z, 0, 0, 0);
                    sb[nt] = __builtin_amdgcn_mfma_f32_16x16x32_bf16(awb, *(const LAS bf16x8*)(WWt + n * 144 + 64 + fq * 16), z, 0, 0, 0);
                    sa[nt] = __builtin_amdgcn_mfma_f32_16x16x32_bf16(aa, *(const LAS bf16x8*)(AWt + n * 144 + layer * 64 + fq * 16), z, 0, 0, 0); }
#pragma unroll
                for (int j = 0; j < 4; ++j) { if (pass == 1 && j > 0) break;
                    const int tk = 16 * mt + 4 * fq + j; const bool valid = tk < 33; const int s = u * 33 + tk;
                    float kv[4], kr[4], ssq = 0.f;
#pragma unroll
                    for (int nt = 0; nt < 4; ++nt) { kv[nt] = bf2f(pass ? kvB[nt] : kvA[nt][j]); kr[nt] = kv[nt] * kkc[nt]; ssq += kr[nt] * kr[nt]; }
                    const float rs = rsq_(sum16_(ssq) + 1e-6f);
#pragma unroll
                    for (int nt = 0; nt < 4; ++nt) { const float a = sigmoidf_(sa[nt][j] + a0c[nt]);
                        const float lwf = -__expf(-softplusf_(-(sf[nt][j] + w0fc[nt])) - 0.5f), lwb = -__expf(-softplusf_(-(sb[nt][j] + w0bc[nt])) - 0.5f);
                        const float kk = kr[nt] * rs; const size_t o = (size_t)s * 256 + 64 * h + 16 * nt + fr;
                        if (valid) { WSP(float, SC_RK)[o] = kv[nt] * (1.0f + (a - 1.0f) * kac[nt]); WSP(float, SC_RKK)[o] = kk; WSP(float, SC_RB)[o] = kk * a;
                            WSP(float, SC_RLW)[o] = lwf; WSP(float, SC_RLW)[(size_t)SB * 256 + o] = lwb; } } } }
            __syncthreads();
        }
    }
    __syncthreads();
    { LAS bf16_t* T = (LAS bf16_t*)lds; const int tid = p.tid; const float* dncw = PIN(I_DN_CW); const float* sscw = PIN(I_SS_CW); const float* sscb = PIN(I_SS_CB);
#define PC_LOAD(uu, v, vh) do { const int mixer_ = (uu) / (NTB * 3), r2_ = (uu) % (NTB * 3), rb_ = r2_ / 3, colbase_ = (mixer_ ? PD_Q : PC_X) + 256 * (r2_ % 3); \
          _Pragma("unroll") for (int q = 0; q < 12; ++q) { const int e = tid + NTHR * q, rr = e >> 11, tok = (e >> 5) & 63, ch = (e & 31) * 8; v[q] = (u32x4){0u, 0u, 0u, 0u}; \
              if (rb_ < 4) { if (rr == 1) v[q] = *(const u32x4*)(proj + (size_t)(b * NCTX + 64 * rb_ + tok) * NPROJ + colbase_ + ch); } \
              else { const int gr = rb_ - 4 + rr - 1; if (gr >= 0 && gr < GRIDH) v[q] = *(const u32x4*)(proj + (size_t)(CROWS + b * SEQ + gr * 64 + tok) * NPROJ + colbase_ + ch); } } \
          vh = (u32x4){0u, 0u, 0u, 0u}; if (tid < 192) { const int rr = tid >> 6, side = (tid >> 5) & 1, ch = (tid & 31) * 8;       \
              if (rb_ < 4 && rr == 1) { const int tk = side ? 64 * (rb_ + 1) : 64 * rb_ - 1; if (tk >= 0 && tk < NCTX) vh = *(const u32x4*)(proj + (size_t)(b * NCTX + tk) * NPROJ + colbase_ + ch); } } \
          { const int chn_ = 256 * (r2_ % 3) + (tid & 255); const float* cw_ = (mixer_ ? dncw : sscw) + (size_t)layer * 9 * 768 + chn_;        \
            _Pragma("unroll") for (int k = 0; k < 9; ++k) w[k] = cw_[k * 768]; bias = mixer_ ? 0.f : sscb[layer * 768 + chn_]; } } while (0)
      int u = p.bid;
      if (u < 2 * NTB * 3) { u32x4 v[12], vh; float w[9], bias; PC_LOAD(u, v, vh);
        for (;;) { const int mixer = u / (NTB * 3), r2 = u % (NTB * 3), rb = r2 / 3, third = r2 % 3;
#pragma unroll
          for (int q = 0; q < 12; ++q) { const int e = tid + NTHR * q, rr = e >> 11, tok = (e >> 5) & 63, ch = (e & 31) * 8; *(LAS u32x4*)(T + (rr * 66 + tok + 1) * 256 + ch) = v[q]; }
          if (tid < 192) { const int rr = tid >> 6, side = (tid >> 5) & 1, ch = (tid & 31) * 8; *(LAS u32x4*)(T + (rr * 66 + (side ? 65 : 0)) * 256 + ch) = vh; }
          __syncthreads();
          const int un = u + p.G; const bool more = un < 2 * NTB * 3;
          float wc[9]; const float bc = bias;
#pragma unroll
          for (int k = 0; k < 9; ++k) wc[k] = w[k];
          if (more) PC_LOAD(un, v, vh);
          { const int c = tid & 255, th = tid >> 8, chn = 256 * third + c;
            bf16_t* dst = (mixer ? WSP(bf16_t, SC_DQ) : WSP(bf16_t, SC_SX)) + (size_t)(64 * rb) * 768 + chn;
#pragma unroll 2
            for (int tk = 0; tk < 32; ++tk) { const int x = 32 * th + tk; float acc = bc;
#pragma unroll
                for (int dy = 0; dy < 3; ++dy)
#pragma unroll
                    for (int dx = 0; dx < 3; ++dx) acc += wc[dy * 3 + dx] * bf2f(T[(dy * 66 + x + dx) * 256 + c]);
                float y = siluf_(acc);
                if (mixer && third < 2) { const float ss = wsum(y * y); y *= rsq_(ss + 1e-6f); if (third == 0) y *= 0.125f; }
                dst[(size_t)x * 768] = (bf16_t)f2bf(y); } }
          __syncthreads();
          if (!more) break;
          u = un; } }
#undef PC_LOAD
#define SCAL_FIN(e_, raw_) do { const int s = (e_) / 24, q = (e_) % 24; const float xv = bf2f(raw_); \
          if (q < 8) { const int d = q >> 2, h = q & 3; WSP(float, SC_SDT)[(size_t)s * 8 + q] = softplusf_(xv + PIN(I_SS_DTB)[(layer * 2 + d) * 4 + h]); } \
          else if (q < 16) { WSP(float, SC_DG)[(size_t)s * 16 + (q - 8)] = sigmoidf_(xv); } \
          else { const int q2 = q - 16, d = q2 >> 2, h = q2 & 3; WSP(float, SC_DG)[(size_t)s * 16 + 8 + q2] = -__expf(PIN(I_DN_ALOG)[(layer * 2 + d) * 4 + h]) * softplusf_(xv + PIN(I_DN_DTB)[(layer * 2 + d) * 4 + h]); } } while (0)
      if (e0 < SB * 24) SCAL_FIN(e0, sq0);
      if (e1 < SB * 24) SCAL_FIN(e1, sq1);
      for (int e = e1 + p.G * NTHR; e < SB * 24; e += p.G * NTHR) { const bf16_t raw = proj[(size_t)tok_row(b, e / 24) * NPROJ + SCAL_COL(e % 24)]; SCAL_FIN(e, raw); }
#undef SCAL_FIN
#undef SCAL_COL
    }
}
__device__ __forceinline__ void phase_scan(const Cx& p, LAS unsigned char* lds, int layer, int b);
__device__ __forceinline__ void phase_post(const Cx& p, LAS unsigned char* lds, int layer, int b) {
    const int tid = p.tid, tsub = tid >> 7, c8 = (tid & 127) * 8, mixer = c8 >> 8, cm = c8 & 255, hh = cm >> 6;
    const bf16_t* proj = WSP(bf16_t, WS_PROJ); const bf16_t* of = WSP(bf16_t, SC_OF); const bf16_t* obk = WSP(bf16_t, SC_OB); bf16_t* yc = WSP(bf16_t, WS_HBUF);
    constexpr int PTS = 144, GTS = 260;
    LAS unsigned char* GWb = lds; LAS unsigned char* SGb = lds + 256 * PTS; LAS float* GT = (LAS float*)(lds + 256 * PTS + 48 * PTS);
    if ((int)p.bid < SB / 33) { const bf16_t* gsrc = WSP(bf16_t, WS_RWGW) + (size_t)layer * 256 * 64;
#pragma unroll
        for (int q = 0; q < 4; ++q) { const int e = tid + NTHR * q, n = e >> 3, ch = e & 7; *(LAS u32x4*)(GWb + n * PTS + ch * 16) = *(const u32x4*)(gsrc + n * 64 + ch * 8); } }
    float g0[8], g1[8], g2[8];
#pragma unroll
    for (int q = 0; q < 8; ++q) { const int c = cm + q; g0[q] = 0.f; g1[q] = 0.f; g2[q] = 0.f;
        if (mixer == 0) g0[q] = PIN(I_GLA_NG)[layer * 256 + c];
        else if (mixer == 1) { g0[q] = PIN(I_RW_LNG)[layer * 256 + c]; g1[q] = PIN(I_RW_LNB)[layer * 256 + c]; g2[q] = PIN(I_RW_RK)[layer * 256 + c]; }
        else if (mixer == 2) { g0[q] = PIN(I_SS_NG)[layer * 256 + c]; g1[q] = PIN(I_SS_D)[layer * 4 + hh]; }
        else g0[q] = PIN(I_DN_NG)[layer * 256 + c]; }
    const int col1 = (mixer == 0 ? PA_G : mixer == 1 ? PB_R : mixer == 2 ? PC_Z : PD_Z) + cm;
    for (int u = p.bid; u < SB / 33; u += p.G) {
        if (tid < 33 * 8) { const int tk = tid >> 3, ch = tid & 7; float gl[8]; bf8_to_f(*(const u32x4*)(proj + (size_t)tok_row(b, u * 33 + tk) * NPROJ + PB_G + 8 * ch), gl);
            *(LAS u32x4*)(SGb + tk * PTS + ch * 16) = (u32x4){pk2(sigmoidf_(gl[0]), sigmoidf_(gl[1])), pk2(sigmoidf_(gl[2]), sigmoidf_(gl[3])), pk2(sigmoidf_(gl[4]), sigmoidf_(gl[5])), pk2(sigmoidf_(gl[6]), sigmoidf_(gl[7]))}; }
        u32x4 rof, rob, ra1, ra2 = (u32x4){0u, 0u, 0u, 0u}; f32x4 rk0 = (f32x4){0.f, 0.f, 0.f, 0.f}, rk1 = rk0;
#define POST_LOAD(t0_) do { const int tk_ = (t0_) + tsub; const int s_ = u * 33 + (tk_ < 33 ? tk_ : 32); const bf16_t* pr_ = proj + (size_t)tok_row(b, s_) * NPROJ; \
        rof = *(const u32x4*)(of + (size_t)s_ * 1024 + c8); rob = *(const u32x4*)(obk + (size_t)s_ * 1024 + c8); ra1 = *(const u32x4*)(pr_ + col1); \
        if (mixer == 1) { ra2 = *(const u32x4*)(pr_ + PB_V + cm); rk0 = *(const f32x4*)(WSP(float, SC_RK) + (size_t)s_ * 256 + cm); rk1 = *(const f32x4*)(WSP(float, SC_RK) + (size_t)s_ * 256 + cm + 4); } \
        else if (mixer == 2) ra2 = *(const u32x4*)(WSP(bf16_t, SC_SX) + (size_t)s_ * 768 + cm); } while (0)
        POST_LOAD(0);
        __syncthreads();
        { const int lane = tid & 63, wave = tid >> 6, fr = lane & 15, fq = lane >> 4; f32x4 acc[3][2];
#pragma unroll
          for (int mt = 0; mt < 3; ++mt) { acc[mt][0] = (f32x4){0.f, 0.f, 0.f, 0.f}; acc[mt][1] = (f32x4){0.f, 0.f, 0.f, 0.f}; }
#pragma unroll
          for (int ks = 0; ks < 2; ++ks) { bf16x8 bb[2];
#pragma unroll
              for (int nt = 0; nt < 2; ++nt) bb[nt] = *(const LAS bf16x8*)(GWb + (16 * (2 * wave + nt) + fr) * PTS + ks * 64 + fq * 16);
#pragma unroll
              for (int mt = 0; mt < 3; ++mt) { const bf16x8 a = *(const LAS bf16x8*)(SGb + (16 * mt + fr) * PTS + ks * 64 + fq * 16);
                  acc[mt][0] = __builtin_amdgcn_mfma_f32_16x16x32_bf16(a, bb[0], acc[mt][0], 0, 0, 0); acc[mt][1] = __builtin_amdgcn_mfma_f32_16x16x32_bf16(a, bb[1], acc[mt][1], 0, 0, 0); } }
#pragma unroll
          for (int mt = 0; mt < 3; ++mt)
#pragma unroll
              for (int nt = 0; nt < 2; ++nt)
#pragma unroll
                  for (int j = 0; j < 4; ++j) GT[(16 * mt + 4 * fq + j) * GTS + 16 * (2 * wave + nt) + fr] = acc[mt][nt][j]; }
        __syncthreads();
#pragma unroll 1
        for (int t0 = 0; t0 < 36; t0 += 4) { const int tk = t0 + tsub; const bool live = tk < 33; const int tkc = live ? tk : 32, s = u * 33 + tkc, row = tok_row(b, s);
            const u32x4 cof = rof, cob = rob, ca1 = ra1, ca2 = ra2; const f32x4 k0 = rk0, k1 = rk1;
            if (t0 + 4 < 36) POST_LOAD(t0 + 4);
            float o[8], a[8], y[8];
            { float t1[8], t2[8]; bf8_to_f(cof, t1); bf8_to_f(cob, t2);
#pragma unroll
              for (int q = 0; q < 8; ++q) o[q] = t1[q] + t2[q]; }
            bf8_to_f(ca1, a);
            if (mixer == 0 || mixer == 3) { float ss = 0.f;
#pragma unroll
                for (int q = 0; q < 8; ++q) ss += o[q] * o[q];
                const float rs = rsq_(sum8_(ss) * (1.0f / 64.0f) + 1e-6f);
#pragma unroll
                for (int q = 0; q < 8; ++q) y[q] = o[q] * rs * g0[q] * siluf_(a[q]);
            } else if (mixer == 2) { float xs[8]; bf8_to_f(ca2, xs); float ss = 0.f;
#pragma unroll
                for (int q = 0; q < 8; ++q) { y[q] = (o[q] + g1[q] * xs[q]) * siluf_(a[q]); ss += y[q] * y[q]; }
                const float rs = rsq_(sum16_(ss) * (1.0f / 128.0f) + 1e-6f);
#pragma unroll
                for (int q = 0; q < 8; ++q) y[q] *= rs * g0[q];
            } else { float vv[8]; bf8_to_f(ca2, vv);
                float su = 0.f, bo = 0.f;
#pragma unroll
                for (int q = 0; q < 8; ++q) { su += o[q]; bo += a[q] * (q < 4 ? k0[q & 3] : k1[q & 3]) * g2[q]; }
                const float mu = sum8_(su) * (1.0f / 64.0f); bo = sum8_(bo); float va = 0.f;
#pragma unroll
                for (int q = 0; q < 8; ++q) { o[q] -= mu; va += o[q] * o[q]; }
                const float rs = rsq_(sum8_(va) * (1.0f / 64.0f) + 64e-5f);
                const f32x4 gt0 = *(const LAS f32x4*)(GT + tkc * GTS + cm), gt1 = *(const LAS f32x4*)(GT + tkc * GTS + cm + 4);
#pragma unroll
                for (int q = 0; q < 8; ++q) y[q] = (o[q] * rs * g0[q] + g1[q] + bo * vv[q]) * (q < 4 ? gt0[q & 3] : gt1[q & 3]); }
            if (live) *(u32x4*)(yc + (size_t)row * D + c8) = (u32x4){pk2(y[0], y[1]), pk2(y[2], y[3]), pk2(y[4], y[5]), pk2(y[6], y[7])};
        }
#undef POST_LOAD
    }
}
constexpr int N2_TILE = 32, N2_STRIDE = 2064;
__device__ __forceinline__ void phase_norm2(const Cx& p, LAS unsigned char* lds, int layer, int row_lo) {
    const int tid = p.tid, lane = tid & 63, wave = __builtin_amdgcn_readfirstlane(tid >> 6), fr = lane & 15, fq = lane >> 4;
    const float* mod = WSP(float, WS_MOD) + (size_t)layer * 5 * 6144; const float* g = PIN(I_N2G) + layer * D; bf16_t* hb = WSP(bf16_t, WS_HBUF);
    const bf16_t* rt = WSP(bf16_t, WS_ROUT) + (size_t)layer * 2 * NE * D;
    LAS float* lg = (LAS float*)(lds + 2 * N2_TILE * N2_STRIDE);
    unsigned* cnt = WSP(unsigned, WS_CTL) + CW_CNT + layer * 80 * 16; int* ltok = WSP(int, WS_LTOK); int* tokt = WSP(int, WS_TOKT);
    const float rbias = PIN(I_ROUT_B)[layer * NE + lane];
    const int nun = (ROWS - row_lo) / N2_TILE;
    ModC mc; mc.s = -1; f32x4 n0[4], n1[4], n2[4], n3[4];
    if ((int)p.bid < nun) { const int r = row_lo + p.bid * N2_TILE + 4 * wave; norm_ld(res_row(p, 0, r), n0, lane); norm_ld(res_row(p, 0, r + 1), n1, lane); norm_ld(res_row(p, 0, r + 2), n2, lane); norm_ld(res_row(p, 0, r + 3), n3, lane); }
    for (int u = p.bid; u < nun; u += p.G) { const int r0 = row_lo + u * N2_TILE;
        { const int tr = 4 * wave, r = r0 + tr;
          const int s = row_sel(r); if (s != mc.s) mc.load(g, mod + s * 6144 + 3072, mod + s * 6144 + 4096, s, lane);
          norm_fin2(n0, mc, hb + (size_t)r * D, true, (LAS bf16_t*)(lds + tr * N2_STRIDE), (LAS bf16_t*)(lds + N2_TILE * N2_STRIDE + tr * N2_STRIDE), lane);
          norm_fin2(n1, mc, hb + (size_t)(r + 1) * D, true, (LAS bf16_t*)(lds + (tr + 1) * N2_STRIDE), (LAS bf16_t*)(lds + N2_TILE * N2_STRIDE + (tr + 1) * N2_STRIDE), lane);
          norm_fin2(n2, mc, hb + (size_t)(r + 2) * D, true, (LAS bf16_t*)(lds + (tr + 2) * N2_STRIDE), (LAS bf16_t*)(lds + N2_TILE * N2_STRIDE + (tr + 2) * N2_STRIDE), lane);
          norm_fin2(n3, mc, hb + (size_t)(r + 3) * D, true, (LAS bf16_t*)(lds + (tr + 3) * N2_STRIDE), (LAS bf16_t*)(lds + N2_TILE * N2_STRIDE + (tr + 3) * N2_STRIDE), lane); }
        __syncthreads();
        { const int mt = wave >> 2, nt = wave & 3; f32x4 acc = (f32x4){0.f, 0.f, 0.f, 0.f};
          const LAS unsigned char* ap = lds + (16 * mt + fr) * N2_STRIDE + fq * 16; const bf16_t* bp = rt + (size_t)(16 * nt + fr) * D + fq * 8;
#pragma unroll 8
          for (int ks = 0; ks < 32; ++ks) { const bf16x8 a = *(const LAS bf16x8*)(ap + ks * 64), al = *(const LAS bf16x8*)(ap + N2_TILE * N2_STRIDE + ks * 64);
              const bf16x8 bb = *(const bf16x8*)(bp + ks * 32), bl = *(const bf16x8*)(bp + NE * D + ks * 32);
              acc = __builtin_amdgcn_mfma_f32_16x16x32_bf16(a, bb, acc, 0, 0, 0); acc = __builtin_amdgcn_mfma_f32_16x16x32_bf16(al, bb, acc, 0, 0, 0); acc = __builtin_amdgcn_mfma_f32_16x16x32_bf16(a, bl, acc, 0, 0, 0); }
#pragma unroll
          for (int j = 0; j < 4; ++j) lg[(16 * mt + 4 * fq + j) * 64 + 16 * nt + fr] = acc[j]; }
        __syncthreads();
        { const int un = u + p.G; if (un < nun) { const int rn = row_lo + un * N2_TILE + 4 * wave; norm_ld(res_row(p, 0, rn), n0, lane); norm_ld(res_row(p, 0, rn + 1), n1, lane); norm_ld(res_row(p, 0, rn + 2), n2, lane); norm_ld(res_row(p, 0, rn + 3), n3, lane); } }
#pragma unroll 1
        for (int i = 0; i < 4; ++i) { const int tr = 4 * wave + i, r = r0 + tr;
            const float sc = sigmoidf_(lg[tr * 64 + lane]); float sel = sc + rbias; float ssum = 0.f; int myE = 0; float myS = 0.f;
#pragma unroll 1
            for (int k = 0; k < TOPK; ++k) { float bv = sel; int bi = lane;
#define ARGSTEP(OV, OI) do { const float ov_ = (OV); const int oi_ = (OI); if (ov_ > bv || (ov_ == bv && oi_ < bi)) { bv = ov_; bi = oi_; } } while (0)
                ARGSTEP(DPPF(bv, 0xB1), DPPI(bi, 0xB1)); ARGSTEP(DPPF(bv, 0x4E), DPPI(bi, 0x4E)); ARGSTEP(DPPF(bv, 0x141), DPPI(bi, 0x141)); ARGSTEP(DPPF(bv, 0x140), DPPI(bi, 0x140));
                ARGSTEP(__uint_as_float(__builtin_amdgcn_ds_swizzle(__float_as_uint(bv), 0x401F)), __builtin_amdgcn_ds_swizzle(bi, 0x401F));
                { const float v0 = rl(bv, 0), v1 = rl(bv, 32); const int i0 = __builtin_amdgcn_readlane(bi, 0), i1 = __builtin_amdgcn_readlane(bi, 32); if (v1 > v0 || (v1 == v0 && i1 < i0)) { bv = v1; bi = i1; } else { bv = v0; bi = i0; } }
#undef ARGSTEP
                const int e = __builtin_amdgcn_readfirstlane(bi); const float se = rl(sc, e);
                ssum += se; if (lane == k) { myE = e; myS = se; } if (lane == e) sel = -1e30f; }
            if (lane < TOPK) { const unsigned pos = atomicAdd(cnt + myE * 16, 1u); ltok[(size_t)myE * ROWS + pos] = r; tokt[(size_t)r * 16 + lane] = (myE << 16) | (int)pos; ((float*)tokt)[(size_t)r * 16 + 8 + lane] = myS / ssum * 2.5f; } }
        __syncthreads();
    }
}
__device__ __forceinline__ void moe_table(const Cx& p, LAS int* tb, int layer, int row_lo) {
    const unsigned* cnt = WSP(unsigned, WS_CTL) + CW_CNT + layer * 80 * 16;
    if (p.tid < 64) { const int lane = p.tid;
        const int c = (int)__hip_atomic_load(cnt + lane * 16, __ATOMIC_RELAXED, __HIP_MEMORY_SCOPE_AGENT); const int t = (c + 255) >> 8; int incl = t;
#pragma unroll
        for (int o = 1; o < 64; o <<= 1) { const int v = __builtin_amdgcn_ds_bpermute((lane - o) << 2, incl); if (lane >= o) incl += v; }
        tb[lane] = c; tb[128 + lane] = incl - t;
        if (lane == 63) { const int cs = ROWS - row_lo; tb[NE] = cs; tb[128 + NE] = incl; tb[128 + NE1] = incl + ((cs + 255) >> 8); } }
    __syncthreads();
}
__device__ __forceinline__ void phase_combine(const Cx& p, const LAS int* tb, int layer, int row_lo, int half) {
    const int lane = p.tid & 63, wave = p.tid >> 6; const bf16_t* Y = WSP(bf16_t, WS_Y); const int* tokt = WSP(int, WS_TOKT);
    const float* gate = WSP(float, WS_MOD) + (size_t)layer * 5 * 6144 + 5120; const int col = 512 * half + 8 * lane; const int shbase = tb[128 + NE] * 256;
#pragma unroll 2
    for (int r = row_lo + p.bid * 8 + wave; r < ROWS; r += p.G * 8) {
        const int sw = lane < 16 ? tokt[(size_t)r * 16 + lane] : 0;
        float a[8];
        { const u32x4 y = *(const u32x4*)(Y + (size_t)(shbase + (r - row_lo)) * 512 + 8 * lane);
#pragma unroll
          for (int q = 0; q < 4; ++q) { a[2 * q] = __uint_as_float(y[q] << 16); a[2 * q + 1] = __uint_as_float(y[q] & 0xffff0000u); } }
#pragma unroll
        for (int k = 0; k < 8; ++k) { const int sl = __builtin_amdgcn_readlane(sw, k); const float w = __uint_as_float(__builtin_amdgcn_readlane(sw, 8 + k));
            const int hrow = tb[128 + (sl >> 16)] * 256 + (sl & 0xffff); const u32x4 y = *(const u32x4*)(Y + (size_t)hrow * 512 + 8 * lane);
#pragma unroll
            for (int q = 0; q < 4; ++q) { a[2 * q] += w * __uint_as_float(y[q] << 16); a[2 * q + 1] += w * __uint_as_float(y[q] & 0xffff0000u); } }
        float* x = (float*)res_row(p, 0, r) + col; const float* gp = gate + row_sel(r) * 6144 + col;
#pragma unroll
        for (int q = 0; q < 2; ++q) { const f32x4 gv = *(const f32x4*)(gp + 4 * q); f32x4 xv = *(const f32x4*)(x + 4 * q);
            xv[0] += gv[0] * a[4 * q]; xv[1] += gv[1] * a[4 * q + 1]; xv[2] += gv[2] * a[4 * q + 2]; xv[3] += gv[3] * a[4 * q + 3]; *(f32x4*)(x + 4 * q) = xv; }
    }
}
__device__ __forceinline__ void phase_final(const Cx& p) {
    const int lane = p.tid & 63, wave = p.tid >> 6; const float* g = PIN(I_FNG); f32x4 gv[4], n[2][4];
#pragma unroll
    for (int i = 0; i < 4; ++i) gv[i] = *(const f32x4*)(g + 256 * i + 4 * lane);
    int r = p.bid * 16 + wave * 2;
    if (r < NB * SEQ) { norm_ld(POUT + (size_t)r * D, n[0], lane); norm_ld(POUT + (size_t)(r + 1) * D, n[1], lane); }
    for (; r < NB * SEQ; r += p.G * 16) { f32x4 v[2][4];
#pragma unroll
        for (int q = 0; q < 2; ++q)
#pragma unroll
            for (int i = 0; i < 4; ++i) v[q][i] = n[q][i];
        const int rn = r + p.G * 16; if (rn < NB * SEQ) { norm_ld(POUT + (size_t)rn * D, n[0], lane); norm_ld(POUT + (size_t)(rn + 1) * D, n[1], lane); }
#pragma unroll
        for (int q = 0; q < 2; ++q) { float* x = POUT + (size_t)(r + q) * D; float ss = 0.f;
#pragma unroll
            for (int i = 0; i < 4; ++i) ss += v[q][i][0] * v[q][i][0] + v[q][i][1] * v[q][i][1] + v[q][i][2] * v[q][i][2] + v[q][i][3] * v[q][i][3];
            ss = wsum(ss); const float rstd = rsq_(ss * (1.0f / D) + 1e-6f);
#pragma unroll
            for (int i = 0; i < 4; ++i) *(f32x4*)(x + 256 * i + 4 * lane) = v[q][i] * rstd * gv[i]; } }
}
__device__ __forceinline__ int chain_tb(int n, int d) { return d == 0 ? n : (n < 4 ? 3 - n : 135 - n); }
__device__ __forceinline__ int cslot(int u) { return (u & 7) * NTB + (u >> 3); }
__device__ __forceinline__ int tb_row0(int b, int tb) { return tb < 4 ? b * NCTX + 64 * tb : CROWS + b * SEQ + 64 * (tb - 4); }
constexpr int TS = 144;
template <int K, int NT> __device__ __forceinline__ void mm_rows(const LAS unsigned char* A, int lda, const LAS unsigned char* Bt, int ldb, int mt, int nt0, int fr, int fq, f32x4 (&acc)[NT]) {
#pragma unroll
    for (int ks = 0; ks < K / 32; ++ks) { const bf16x8 a = *(const LAS bf16x8*)(A + (16 * mt + fr) * lda + ks * 64 + fq * 16);
#pragma unroll
        for (int nt = 0; nt < NT; ++nt) { const bf16x8 bb = *(const LAS bf16x8*)(Bt + (16 * (nt0 + nt) + fr) * ldb + ks * 64 + fq * 16);
            acc[nt] = __builtin_amdgcn_mfma_f32_16x16x32_bf16(a, bb, acc[nt], 0, 0, 0); } }
}
#define UNIT_LOOP(u, N, OFF) for (int u = (p.bid + p.G - ((OFF) % p.G)) % p.G; u < (N); u += p.G)
__device__ __forceinline__ void gla_p1(const Cx& p, LAS unsigned char* lds0, int layer, int b) {
    const int tid = p.tid, lane = tid & 63, wave = __builtin_amdgcn_readfirstlane(tid >> 6), fr = lane & 15, fq = lane >> 4;
    int par = 0;
    const bf16_t* proj = WSP(bf16_t, WS_PROJ); const int mt = wave >> 1, nt0 = (wave & 1) * 2; const int cl = lane, tg = wave;
    const float* w2p = PIN(I_GLA_W2); const float* gbp = PIN(I_GLA_B);
    float w2[16], gb; unsigned gw; bf16_t kq[8], vq[8];
#define GLA1_LOAD(uu) do { const int tb_ = (uu) >> 3, h_ = ((uu) >> 1) & 3, d_ = (uu) & 1, c_ = 64 * h_ + cl; const bf16_t* pr_ = proj + (size_t)tb_row0(b, tb_) * NPROJ; \
        _Pragma("unroll") for (int r = 0; r < 16; ++r) w2[r] = w2p[((size_t)(layer * 2 + d_) * 16 + r) * 256 + c_]; \
        gb = gbp[(layer * 2 + d_) * 256 + c_]; \
        { const int e = tid * 2, i = e >> 4, r = e & 15; gw = *(const unsigned*)(pr_ + (size_t)i * NPROJ + (d_ ? PA_GB : PA_GF) + r); } \
        _Pragma("unroll") for (int i8 = 0; i8 < 8; ++i8) { const bf16_t* pa = pr_ + (size_t)(8 * tg + i8) * NPROJ; kq[i8] = pa[PA_K + c_]; vq[i8] = pa[PA_V + c_]; } } while (0)
    int u = (p.bid + p.G) % p.G;
    if (u < NUNIT) GLA1_LOAD(u);
    for (; u < NUNIT; u += p.G) { const int d = u & 1;
        LAS unsigned char* lds = lds0 + par * 32768; par ^= 1;
        LAS unsigned char* ksT = lds; LAS unsigned char* vT = lds + 64 * TS; LAS float* gs = (LAS float*)(lds + 2 * 64 * TS); LAS float* glb = gs + 512;
        glb[tid * 2] = __uint_as_float(gw << 16); glb[tid * 2 + 1] = __uint_as_float(gw & 0xffff0000u);
        __syncthreads();
        float bl[8]; float run = 0.f;
#pragma unroll
        for (int ii = 0; ii < 8; ++ii) { const int i8 = d ? 7 - ii : ii; const LAS float* gl_ = glb + (8 * tg + i8) * 16; float z = gb;
#pragma unroll
            for (int r = 0; r < 16; ++r) z += gl_[r] * w2[r];
            run += logsigmoidf_(z) * (1.0f / 16.0f); if (d) bl[7 - ii] = run; else bl[ii] = run; }
        gs[tg * 64 + cl] = run;
        __syncthreads();
        float off = 0.f, total = 0.f;
#pragma unroll
        for (int g2 = 0; g2 < 8; ++g2) { const float t = gs[g2 * 64 + cl]; total += t; if (d ? g2 > tg : g2 < tg) off += t; }
#pragma unroll
        for (int i8 = 0; i8 < 8; i8 += 2) { const int i = 8 * tg + i8;
            const float ka = bf2f(kq[i8]) * __expf(total - (bl[i8] + off)), kb = bf2f(kq[i8 + 1]) * __expf(total - (bl[i8 + 1] + off));
            *(LAS unsigned*)(ksT + cl * TS + i * 2) = pk2(ka, kb); *(LAS unsigned*)(vT + cl * TS + i * 2) = (unsigned)vq[i8] | ((unsigned)vq[i8 + 1] << 16); }
        if (u + p.G < NUNIT) GLA1_LOAD(u + p.G);
        if (tg == 0) WSP(float, SC_GLA_DEC)[(size_t)cslot(u) * 64 + cl] = __expf(total);
        __syncthreads();
        { f32x4 acc[2] = {(f32x4){0.f, 0.f, 0.f, 0.f}, (f32x4){0.f, 0.f, 0.f, 0.f}}; float* kv = WSP(float, SC_GLA_S) + (size_t)cslot(u) * 4096;
          mm_rows<64, 2>(vT, TS, ksT, TS, mt, nt0, fr, fq, acc);
#pragma unroll
          for (int t = 0; t < 2; ++t) *(f32x4*)(kv + (16 * (nt0 + t) + fr) * 64 + 16 * mt + 4 * fq) = acc[t]; }
    }
#undef GLA1_LOAD
}
__device__ __forceinline__ void gla_chain(const Cx& p, int h, int d, int part) {
    if (p.tid >= 256) return;
    const int e0 = part * 1024 + p.tid * 4, dk = e0 >> 6;
    f32x4 s0 = (f32x4){0.f, 0.f, 0.f, 0.f};
    f32x4 n0[12]; float dc[12];
#define GC_LD(q, n_) do { const int u_ = cslot((chain_tb((n_), d) * 4 + h) * 2 + d); n0[q] = *(const f32x4*)(WSP(float, SC_GLA_S) + (size_t)u_ * 4096 + e0); dc[q] = WSP(float, SC_GLA_DEC)[(size_t)u_ * 64 + dk]; } while (0)
#define GC_ST(q, n_) do { const int u_ = cslot((chain_tb((n_), d) * 4 + h) * 2 + d); float* k_ = WSP(float, SC_GLA_S) + (size_t)u_ * 4096 + e0; \
        const f32x4 a0_ = n0[q]; const float de_ = dc[q]; GC_LD(q, (n_) + 12 < NTB ? (n_) + 12 : NTB - 1); *(f32x4*)k_ = s0; s0 = s0 * de_ + a0_; } while (0)
    GC_LD(0, 0); GC_LD(1, 1); GC_LD(2, 2); GC_LD(3, 3); GC_LD(4, 4); GC_LD(5, 5); GC_LD(6, 6); GC_LD(7, 7); GC_LD(8, 8); GC_LD(9, 9); GC_LD(10, 10); GC_LD(11, 11);
#pragma unroll 1
    for (int n = 0; n < NTB; n += 12) { GC_ST(0, n + 0); GC_ST(1, n + 1); GC_ST(2, n + 2); GC_ST(3, n + 3); GC_ST(4, n + 4); GC_ST(5, n + 5); GC_ST(6, n + 6); GC_ST(7, n + 7); GC_ST(8, n + 8); GC_ST(9, n + 9); GC_ST(10, n + 10); GC_ST(11, n + 11); }
#undef GC_LD
#undef GC_ST
}
__device__ __forceinline__ void gla_p2(const Cx& p, LAS unsigned char* lds0, int layer, int b) {
    const int tid = p.tid, lane = tid & 63, wave = __builtin_amdgcn_readfirstlane(tid >> 6), fr = lane & 15, fq = lane >> 4;
    int par = 0;
    const bf16_t* proj = WSP(bf16_t, WS_PROJ); const int cl = lane, tg = wave;
    const float* w2p = PIN(I_GLA_W2); const float* gbp = PIN(I_GLA_B);
    float w2[16], gb; unsigned gw; bf16_t qq[8], kq[8], vq[8]; float sq[8];
#define GLA2_LOAD(uu) do { const int tb_ = (uu) >> 3, h_ = ((uu) >> 1) & 3, d_ = (uu) & 1, c_ = 64 * h_ + cl; const bf16_t* pr_ = proj + (size_t)tb_row0(b, tb_) * NPROJ; \
        _Pragma("unroll") for (int r = 0; r < 16; ++r) w2[r] = w2p[((size_t)(layer * 2 + d_) * 16 + r) * 256 + c_]; \
        gb = gbp[(layer * 2 + d_) * 256 + c_]; \
        { const int e = tid * 2, i = e >> 4, r = e & 15; gw = *(const unsigned*)(pr_ + (size_t)i * NPROJ + (d_ ? PA_GB : PA_GF) + r); } \
        _Pragma("unroll") for (int i8 = 0; i8 < 8; ++i8) { const bf16_t* pa = pr_ + (size_t)(8 * tg + i8) * NPROJ; qq[i8] = pa[PA_Q + c_]; kq[i8] = pa[PA_K + c_]; vq[i8] = pa[PA_V + c_]; } \
        { const float* sp_ = WSP(float, SC_GLA_S) + (size_t)cslot(uu) * 4096; _Pragma("unroll") for (int q = 0; q < 8; ++q) sq[q] = sp_[tid + NTHR * q]; } } while (0)
    int u = (p.bid + p.G - (128 % p.G)) % p.G;
    if (u < NUNIT) GLA2_LOAD(u);
    for (; u < NUNIT; u += p.G) { const int tb = u >> 3, h = (u >> 1) & 3, d = u & 1; const int s0 = 64 * tb;
        LAS unsigned char* lds = lds0 + par * 57344; par ^= 1;
        LAS unsigned char* qt = lds; LAS unsigned char* kt = lds + 64 * TS; LAS unsigned char* vT = lds + 2 * 64 * TS; LAS unsigned char* sT = lds + 3 * 64 * TS; LAS unsigned char* att = lds + 4 * 64 * TS;
        LAS float* gs = (LAS float*)(lds + 5 * 64 * TS); LAS float* glb = gs + 512;
        glb[tid * 2] = __uint_as_float(gw << 16); glb[tid * 2 + 1] = __uint_as_float(gw & 0xffff0000u);
#pragma unroll
        for (int q = 0; q < 8; ++q) { const int e = tid + NTHR * q, dk = e >> 6, dv = e & 63; *(LAS bf16_t*)(sT + dv * TS + dk * 2) = (bf16_t)f2bf(sq[q]); }
        __syncthreads();
        float bl[8]; float run = 0.f;
#pragma unroll
        for (int ii = 0; ii < 8; ++ii) { const int i8 = d ? 7 - ii : ii; const LAS float* gl_ = glb + (8 * tg + i8) * 16; float z = gb;
#pragma unroll
            for (int r = 0; r < 16; ++r) z += gl_[r] * w2[r];
            run += logsigmoidf_(z) * (1.0f / 16.0f); if (d) bl[7 - ii] = run; else bl[ii] = run; }
        gs[tg * 64 + cl] = run;
        __syncthreads();
        float off = 0.f;
#pragma unroll
        for (int g2 = 0; g2 < 8; ++g2) if (d ? g2 > tg : g2 < tg) off += gs[g2 * 64 + cl];
#pragma unroll
        for (int i8 = 0; i8 < 8; ++i8) { const int i = 8 * tg + i8; const float bi = bl[i8] + off;
            *(LAS bf16_t*)(qt + i * TS + cl * 2) = (bf16_t)f2bf(bf2f(qq[i8]) * 0.125f * __expf(bi));
            *(LAS bf16_t*)(kt + i * TS + cl * 2) = (bf16_t)f2bf(bf2f(kq[i8]) * __expf(-bi));
            *(LAS bf16_t*)(vT + cl * TS + i * 2) = vq[i8]; }
        if (u + p.G < NUNIT) GLA2_LOAD(u + p.G);
        __syncthreads();
        const int mt = wave >> 1, nt0 = (wave & 1) * 2;
        { f32x4 acc[2] = {(f32x4){0.f, 0.f, 0.f, 0.f}, (f32x4){0.f, 0.f, 0.f, 0.f}};
          mm_rows<64, 2>(qt, TS, kt, TS, mt, nt0, fr, fq, acc);
#pragma unroll
          for (int t = 0; t < 2; ++t)
#pragma unroll
              for (int j = 0; j < 4; ++j) { const int i = 16 * mt + 4 * fq + j, jj = 16 * (nt0 + t) + fr; const bool keep = d ? jj >= i : jj <= i;
                  *(LAS bf16_t*)(att + i * TS + jj * 2) = (bf16_t)f2bf(keep ? acc[t][j] : 0.f); } }
        __syncthreads();
        { f32x4 acc[2] = {(f32x4){0.f, 0.f, 0.f, 0.f}, (f32x4){0.f, 0.f, 0.f, 0.f}};
          mm_rows<64, 2>(vT, TS, att, TS, mt, nt0, fr, fq, acc);
          mm_rows<64, 2>(sT, TS, qt, TS, mt, nt0, fr, fq, acc);
          bf16_t* ob = WSP(bf16_t, d ? SC_OB : SC_OF);
#pragma unroll
          for (int t = 0; t < 2; ++t) *(u32x2*)(ob + (size_t)(s0 + 16 * (nt0 + t) + fr) * 1024 + 64 * h + 16 * mt + 4 * fq) = (u32x2){pk2(acc[t][0], acc[t][1]), pk2(acc[t][2], acc[t][3])}; }
    }
}
#undef GLA2_LOAD
constexpr int TS2 = 272;
__device__ __forceinline__ float ssd_acum(float a, int d, int lane, float& total) {
    float pre = a;
#pragma unroll
    for (int o = 1; o < 64; o <<= 1) { const float t = shup_(pre, lane, o); if (lane >= o) pre += t; }
    total = rl(pre, 63);
    return d ? total - pre + a : pre;
}
__device__ __forceinline__ void ssd_p1(const Cx& p, LAS unsigned char* lds0, int layer, int b) {
    const int tid = p.tid, lane = tid & 63, wave = __builtin_amdgcn_readfirstlane(tid >> 6), fr = lane & 15, fq = lane >> 4;
    int par = 0;
    const float* alogp = PIN(I_SS_ALOG);
    u32x4 bq[2], xq; float dtq;
#define SSD1_LOAD(uu) do { const int tb_ = (uu) >> 3, g_ = ((uu) >> 2) & 1, hd_ = (uu) & 3, h_ = 2 * g_ + (hd_ >> 1), d_ = hd_ & 1; \
        const bf16_t* sx_ = WSP(bf16_t, SC_SX) + (size_t)(64 * tb_ + lane) * 768; \
        bq[0] = *(const u32x4*)(sx_ + 256 + 128 * g_ + 16 * wave); bq[1] = *(const u32x4*)(sx_ + 256 + 128 * g_ + 16 * wave + 8); \
        xq = *(const u32x4*)(sx_ + 64 * h_ + 8 * wave); dtq = WSP(float, SC_SDT)[(size_t)(64 * tb_ + lane) * 8 + d_ * 4 + h_]; } while (0)
    int u3 = (p.bid + p.G - (32 % p.G)) % p.G;
    if (u3 < NTB * 8) SSD1_LOAD(u3);
    for (; u3 < NTB * 8; u3 += p.G) { const int tb = u3 >> 3, g = (u3 >> 2) & 1, hd = u3 & 3, h = 2 * g + (hd >> 1), d = hd & 1;
        LAS unsigned char* lds = lds0 + par * 32768; par ^= 1;
        LAS unsigned char* BT = lds; LAS unsigned char* xT = lds + 128 * TS; LAS float* AC = (LAS float*)(lds + 128 * TS + 64 * TS);
        if (wave == 0) { const float aneg = -__expf(alogp[(layer * 2 + d) * 4 + h]);
            float tot; const float ac = ssd_acum(aneg * dtq, d, lane, tot); AC[lane] = ac; if (lane == 0) { AC[64] = tot; WSP(float, SC_SSD_CD)[cslot((tb * 4 + h) * 2 + d)] = __expf(tot); } }
#pragma unroll
        for (int q = 0; q < 2; ++q)
#pragma unroll
            for (int k = 0; k < 8; ++k) *(LAS bf16_t*)(BT + (16 * wave + 8 * q + k) * TS + lane * 2) = (bf16_t)(bq[q][k >> 1] >> (16 * (k & 1)));
        __syncthreads();
        { const float f = dtq * __expf(AC[64] - AC[lane]);
#pragma unroll
          for (int k = 0; k < 8; ++k) *(LAS bf16_t*)(xT + (8 * wave + k) * TS + lane * 2) = (bf16_t)f2bf(bf2f((bf16_t)(xq[k >> 1] >> (16 * (k & 1)))) * f); }
        if (u3 + p.G < NTB * 8) SSD1_LOAD(u3 + p.G);
        __syncthreads();
        { float* cs = WSP(float, SC_SSD_S) + (size_t)cslot((tb * 4 + h) * 2 + d) * 8192; f32x4 acc[4];
#pragma unroll
          for (int t = 0; t < 4; ++t) acc[t] = (f32x4){0.f, 0.f, 0.f, 0.f};
          mm_rows<64, 4>(BT, TS, xT, TS, wave, 0, fr, fq, acc);
#pragma unroll
          for (int t = 0; t < 4; ++t) *(f32x4*)(cs + (16 * t + fr) * 128 + 16 * wave + 4 * fq) = acc[t]; }
    }
#undef SSD1_LOAD
}
__device__ __forceinline__ void ssd_chain(const Cx& p, int h, int d, int part) {
    if (p.tid >= 256) return;
    const int e0 = part * 1024 + p.tid * 4;
    f32x4 s = (f32x4){0.f, 0.f, 0.f, 0.f}; f32x4 nx[12]; float cd[12];
#define SC_LD(q, n_) do { const int u_ = cslot((chain_tb((n_), d) * 4 + h) * 2 + d); nx[q] = *(const f32x4*)(WSP(float, SC_SSD_S) + (size_t)u_ * 8192 + e0); cd[q] = WSP(float, SC_SSD_CD)[u_]; } while (0)
#define SC_ST(q, n_) do { const int u_ = cslot((chain_tb((n_), d) * 4 + h) * 2 + d); float* c_ = WSP(float, SC_SSD_S) + (size_t)u_ * 8192 + e0; const f32x4 a_ = nx[q]; const float de_ = cd[q]; \
        SC_LD(q, (n_) + 12 < NTB ? (n_) + 12 : NTB - 1); *(f32x4*)c_ = s; s = s * de_ + a_; } while (0)
    SC_LD(0, 0); SC_LD(1, 1); SC_LD(2, 2); SC_LD(3, 3); SC_LD(4, 4); SC_LD(5, 5); SC_LD(6, 6); SC_LD(7, 7); SC_LD(8, 8); SC_LD(9, 9); SC_LD(10, 10); SC_LD(11, 11);
#pragma unroll 1
    for (int n = 0; n < NTB; n += 12) { SC_ST(0, n + 0); SC_ST(1, n + 1); SC_ST(2, n + 2); SC_ST(3, n + 3); SC_ST(4, n + 4); SC_ST(5, n + 5); SC_ST(6, n + 6); SC_ST(7, n + 7); SC_ST(8, n + 8); SC_ST(9, n + 9); SC_ST(10, n + 10); SC_ST(11, n + 11); }
#undef SC_LD
#undef SC_ST
}
__device__ __forceinline__ void ssd_p2(const Cx& p, LAS unsigned char* lds, int layer, int b) {
    const int tid = p.tid, lane = tid & 63, wave = __builtin_amdgcn_readfirstlane(tid >> 6), fr = lane & 15, fq = lane >> 4;
    LAS unsigned char* Ct = lds; LAS unsigned char* Bt2 = lds + 64 * TS2; LAS float* cb = (LAS float*)(lds + 2 * 64 * TS2); LAS float* AC = cb + 64 * 65;
    LAS unsigned char* Mt = (LAS unsigned char*)(AC + 64 + 4); LAS unsigned char* xT = Mt + 64 * TS; LAS unsigned char* Sb = xT + 64 * TS;
    const int mt = wave >> 1, nt0 = (wave & 1) * 2;
    const float* alogp = PIN(I_SS_ALOG);
    u32x4 cq[2], bq[2], xq; float dtq; f32x4 sq[4];
#define SSD2_LOAD(uu) do { const int tb_ = (uu) >> 3, g_ = ((uu) >> 2) & 1, hd_ = (uu) & 3, h_ = 2 * g_ + (hd_ >> 1), d_ = hd_ & 1; \
        const bf16_t* sx_ = WSP(bf16_t, SC_SX) + (size_t)(64 * tb_) * 768; \
        _Pragma("unroll") for (int q = 0; q < 2; ++q) { const int e = tid + NTHR * q, i = e >> 4, ch = e & 15; \
            cq[q] = *(const u32x4*)(sx_ + (size_t)i * 768 + 512 + 128 * g_ + ch * 8); bq[q] = *(const u32x4*)(sx_ + (size_t)i * 768 + 256 + 128 * g_ + ch * 8); } \
        xq = *(const u32x4*)(sx_ + (size_t)lane * 768 + 64 * h_ + 8 * wave); dtq = WSP(float, SC_SDT)[(size_t)(64 * tb_ + lane) * 8 + d_ * 4 + h_]; \
        const float* sp_ = WSP(float, SC_SSD_S) + (size_t)cslot((tb_ * 4 + h_) * 2 + d_) * 8192; \
        _Pragma("unroll") for (int q = 0; q < 4; ++q) sq[q] = *(const f32x4*)(sp_ + (tid + NTHR * q) * 4); } while (0)
    int u3 = (p.bid + p.G - (160 % p.G)) % p.G;
    if (u3 < NTB * 8) SSD2_LOAD(u3);
    for (; u3 < NTB * 8; u3 += p.G) { const int tb = u3 >> 3, g = (u3 >> 2) & 1, hd = u3 & 3, h = 2 * g + (hd >> 1), d = hd & 1, s0 = 64 * tb; (void)g;
        if (wave == 0) { const float aneg = -__expf(alogp[(layer * 2 + d) * 4 + h]); float tot; AC[lane] = ssd_acum(aneg * dtq, d, lane, tot); }
#pragma unroll
        for (int q = 0; q < 2; ++q) { const int e = tid + NTHR * q, i = e >> 4, ch = e & 15;
            *(LAS u32x4*)(Ct + i * TS2 + ch * 16) = cq[q]; *(LAS u32x4*)(Bt2 + i * TS2 + ch * 16) = bq[q]; }
#pragma unroll
        for (int k = 0; k < 8; ++k) *(LAS bf16_t*)(xT + (8 * wave + k) * TS + lane * 2) = (bf16_t)f2bf(bf2f((bf16_t)(xq[k >> 1] >> (16 * (k & 1)))) * dtq);
#pragma unroll
        for (int q = 0; q < 4; ++q) { const int e = (tid + NTHR * q) * 4, pp = e >> 7, s = e & 127; const f32x4 v = sq[q];
            *(LAS u32x2*)(Sb + pp * TS2 + s * 2) = (u32x2){pk2(v[0], v[1]), pk2(v[2], v[3])}; }
        if (u3 + p.G < NTB * 8) SSD2_LOAD(u3 + p.G);
        __syncthreads();
        { f32x4 acc[2] = {(f32x4){0.f, 0.f, 0.f, 0.f}, (f32x4){0.f, 0.f, 0.f, 0.f}};
          mm_rows<128, 2>(Ct, TS2, Bt2, TS2, mt, nt0, fr, fq, acc);
#pragma unroll
          for (int t = 0; t < 2; ++t)
#pragma unroll
              for (int j = 0; j < 4; ++j) cb[(16 * mt + 4 * fq + j) * 65 + 16 * (nt0 + t) + fr] = acc[t][j]; }
        __syncthreads();
        { const int i = tid >> 3, j0 = (tid & 7) * 8; const float ai = AC[i]; unsigned w[4];
#pragma unroll
          for (int jj = 0; jj < 8; jj += 2) { float m[2];
#pragma unroll
              for (int q = 0; q < 2; ++q) { const int j = j0 + jj + q; const bool keep = d ? j >= i : j <= i; const float cv = cb[i * 65 + j], aj = AC[j]; m[q] = keep ? cv * __expf(ai - aj) : 0.f; }
              w[jj >> 1] = pk2(m[0], m[1]); }
          *(LAS u32x4*)(Mt + i * TS + j0 * 2) = (u32x4){w[0], w[1], w[2], w[3]}; }
        __syncthreads();
        { f32x4 acc[2] = {(f32x4){0.f, 0.f, 0.f, 0.f}, (f32x4){0.f, 0.f, 0.f, 0.f}};
          mm_rows<128, 2>(Sb, TS2, Ct, TS2, mt, nt0, fr, fq, acc);
#pragma unroll
          for (int t = 0; t < 2; ++t) { const float sc = __expf(AC[16 * (nt0 + t) + fr]); acc[t] *= sc; }
          mm_rows<64, 2>(xT, TS, Mt, TS, mt, nt0, fr, fq, acc);
          bf16_t* ob = WSP(bf16_t, d ? SC_OB : SC_OF);
#pragma unroll
          for (int t = 0; t < 2; ++t) *(u32x2*)(ob + (size_t)(s0 + 16 * (nt0 + t) + fr) * 1024 + 512 + 64 * h + 16 * mt + 4 * fq) = (u32x2){pk2(acc[t][0], acc[t][1]), pk2(acc[t][2], acc[t][3])}; }
        __syncthreads();
    }
}
#undef SSD2_LOAD
constexpr int AFS = 68;
__device__ __forceinline__ int dr_mfrag_idx(int row, int col) { return (((row >> 4) * 2 + (col >> 5)) * 64 + ((col >> 2) & 3) * 16 + (row & 15)) * 8 + ((col >> 4) & 1) * 4 + (col & 3); }
__device__ __forceinline__ void dr_tinv(const LAS float* AfT, LAS float* Dbuf, const float sgn) {
    LAS unsigned char* TI = (LAS unsigned char*)Dbuf;
    { const int lane = lane_id_asm(), kb_ = lane >> 4, cc = lane & 15; float x[16];
#pragma unroll
        for (int i = 0; i < 16; ++i) x[i] = i == cc ? 1.f : 0.f;
        const LAS float* Ab = AfT + (16 * kb_) * AFS + 16 * kb_;
        f32x4 tri[36];
        { int q = 0;
#pragma unroll
          for (int j = 0; j < 15; ++j)
#pragma unroll
              for (int c4 = (j + 1) / 4; c4 < 4; ++c4) tri[q++] = *(const LAS f32x4*)(Ab + j * AFS + 4 * c4); }
        asm volatile("s_waitcnt lgkmcnt(0)" ::: "memory");
        { int q = 0;
#pragma unroll
          for (int j = 0; j < 15; ++j) { const float xj = sgn * x[j];
#pragma unroll
              for (int c4 = (j + 1) / 4; c4 < 4; ++c4) { const f32x4 t = tri[q++];
#pragma unroll
                  for (int e = 0; e < 4; ++e) if (4 * c4 + e > j) x[4 * c4 + e] -= t[e] * xj; } } }
        { u32x4 w0, w1;
#pragma unroll
          for (int i = 0; i < 16; ++i) *(LAS bf16_t*)(TI + ((kb_ * 16 + i) * 16 + cc) * 2) = (bf16_t)f2bf(x[i]); (void)w0; (void)w1; } }
}
template <class RhsF> __device__ __forceinline__ void dr_solve(const LAS unsigned char* Abf, LAS unsigned char* XT, const LAS float* Dbuf, const float sgn, const int wave, const RhsF& rhs, bf16_t* wu) {
    const LAS unsigned char* TI = (const LAS unsigned char*)Dbuf;
    { const int lane = lane_id_asm(), fr = lane & 15, fq = lane >> 4, col = 16 * wave + fr; u32x4 bx[2] = {(u32x4){0u, 0u, 0u, 0u}, (u32x4){0u, 0u, 0u, 0u}};
      float rv[4][4]; u32x2 af[6][2], tf[4];
#pragma unroll
      for (int k = 0; k < 4; ++k) {
#pragma unroll
          for (int j = 0; j < 4; ++j) rv[k][j] = rhs(16 * k + 4 * fq + j, col);
          tf[k] = *(const LAS u32x2*)(TI + ((k * 16 + fr) * 16 + 4 * fq) * 2); }
#pragma unroll
      for (int k = 1; k < 4; ++k)
#pragma unroll
          for (int ks = 0; ks < 2; ++ks) if (k > 2 * ks) { const int s = (k - 1) + (ks ? 2 : 0) + (k == 3 && ks == 0 ? 0 : 0);
              af[s][0] = *(const LAS u32x2*)(Abf + (16 * k + fr) * TS + (32 * ks + 4 * fq) * 2); af[s][1] = *(const LAS u32x2*)(Abf + (16 * k + fr) * TS + (32 * ks + 16 + 4 * fq) * 2); }
#pragma unroll
      for (int k = 0; k < 4; ++k) { f32x4 acc = (f32x4){0.f, 0.f, 0.f, 0.f};
#pragma unroll
          for (int ks = 0; ks < 2; ++ks) if (k > 2 * ks) { const int s = (k - 1) + (ks ? 2 : 0);
              acc = __builtin_amdgcn_mfma_f32_16x16x32_bf16(__builtin_bit_cast(bf16x8, (u32x4){af[s][0][0], af[s][0][1], af[s][1][0], af[s][1][1]}), __builtin_bit_cast(bf16x8, bx[ks]), acc, 0, 0, 0); }
          float dd[4];
#pragma unroll
          for (int j = 0; j < 4; ++j) dd[j] = rv[k][j] - sgn * acc[j];
          const f32x4 xk = __builtin_amdgcn_mfma_f32_16x16x32_bf16(__builtin_bit_cast(bf16x8, (u32x4){tf[k][0], tf[k][1], 0u, 0u}), __builtin_bit_cast(bf16x8, (u32x4){pk2(dd[0], dd[1]), pk2(dd[2], dd[3]), 0u, 0u}), (f32x4){0.f, 0.f, 0.f, 0.f}, 0, 0, 0);
          const unsigned p0 = pk2(xk[0], xk[1]), p1 = pk2(xk[2], xk[3]);
          bx[k >> 1][(k & 1) * 2] = p0; bx[k >> 1][(k & 1) * 2 + 1] = p1;
          *(LAS u32x2*)(XT + col * TS + (16 * k + 4 * fq) * 2) = (u32x2){p0, p1};
#pragma unroll
          for (int j = 0; j < 4; ++j) wu[(16 * k + 4 * fq + j) * 128 + col] = (bf16_t)f2bf(xk[j]); } }
    __syncthreads();
}
template <class RhsF> __device__ __forceinline__ void dr_block_solve(const LAS unsigned char* Abf, const LAS float* AfT, LAS unsigned char* XT, LAS float* Dbuf, const float sgn, const int wave, const RhsF& rhs, bf16_t* wu) {
    if (wave == 0) dr_tinv(AfT, Dbuf, sgn);
    __syncthreads();
    dr_solve(Abf, XT, Dbuf, sgn, wave, rhs, wu);
}
struct GdnRhs { const LAS unsigned char* kb; const LAS unsigned char* vb; const LAS float* GC;
    __device__ __forceinline__ float operator()(int r, int col) const { return col < 64 ? bf2f(*(const LAS bf16_t*)(kb + r * TS + col * 2)) * __expf(GC[r]) : bf2f(*(const LAS bf16_t*)(vb + r * TS + (col - 64) * 2)); } };
__device__ __forceinline__ void gdn_p1(const Cx& p, LAS unsigned char* lds, int layer, int b) {
    const int wave = __builtin_amdgcn_readfirstlane(p.tid >> 6);
#define GDN_LANES const int lane = lane_id_asm(), tid = wave * 64 + lane, fr = lane & 15, fq = lane >> 4; (void)tid; (void)fr; (void)fq
    LAS unsigned char* kh = lds; LAS unsigned char* kb = lds + 64 * TS; LAS unsigned char* vb = lds + 2 * 64 * TS; LAS unsigned char* Abf = lds + 3 * 64 * TS; LAS unsigned char* kdT = lds + 4 * 64 * TS; LAS unsigned char* XT = lds + 5 * 64 * TS;
    LAS float* Af = (LAS float*)(lds + 7 * 64 * TS); LAS float* Dbuf = Af + 64 * AFS; LAS float* GC = Dbuf + 128 * 20;
    const int mt = wave >> 1, nt0 = (wave & 1) * 2;
    float gq, beta; u32x4 kv, vv;
#define GDN1_LOAD(uu) do { const int tb_ = (uu) >> 3, h_ = ((uu) >> 1) & 3, d_ = (uu) & 1; const int lane_ = lane_id_asm(), tid_ = wave * 64 + lane_; \
        const bf16_t* dq_ = WSP(bf16_t, SC_DQ) + (size_t)(64 * tb_) * 768; const float* dg_ = WSP(float, SC_DG) + (size_t)(64 * tb_) * 16; \
        gq = dg_[(d_ ? 63 - lane_ : lane_) * 16 + 8 + d_ * 4 + h_]; \
        { const int r_ = tid_ >> 3, c0_ = (tid_ & 7) * 8, i_ = d_ ? 63 - r_ : r_; beta = dg_[i_ * 16 + d_ * 4 + h_]; \
          kv = *(const u32x4*)(dq_ + (size_t)i_ * 768 + 256 + 64 * h_ + c0_); vv = *(const u32x4*)(dq_ + (size_t)i_ * 768 + 512 + 64 * h_ + c0_); } } while (0)
    int u = (p.bid + p.G - (64 % p.G)) % p.G;
    if (u < NUNIT) GDN1_LOAD(u);
    for (; u < NUNIT; u += p.G) {
        if (wave == 0) { GDN_LANES; float pre = gq;
#pragma unroll
            for (int o = 1; o < 64; o <<= 1) { const float t = shup_(pre, lane, o); if (lane >= o) pre += t; }
            GC[lane] = pre; }
        { GDN_LANES; const int r = tid >> 3, c0 = (tid & 7) * 8; u32x4 kw, vw;
#pragma unroll
          for (int q = 0; q < 4; ++q) { kw[q] = pk2(__uint_as_float(kv[q] << 16) * beta, __uint_as_float(kv[q] & 0xffff0000u) * beta); vw[q] = pk2(__uint_as_float(vv[q] << 16) * beta, __uint_as_float(vv[q] & 0xffff0000u) * beta); }
          *(LAS u32x4*)(kh + r * TS + c0 * 2) = kv; *(LAS u32x4*)(kb + r * TS + c0 * 2) = kw; *(LAS u32x4*)(vb + r * TS + c0 * 2) = vw;
 }
        if (u + p.G < NUNIT) GDN1_LOAD(u + p.G);
        __syncthreads();
        const float gtot = GC[63];
        { GDN_LANES; f32x4 acc[2] = {(f32x4){0.f, 0.f, 0.f, 0.f}, (f32x4){0.f, 0.f, 0.f, 0.f}};
          mm_rows<64, 2>(kb, TS, kh, TS, mt, nt0, fr, fq, acc);
          float gr[4], gj[2];
#pragma unroll
          for (int j = 0; j < 4; ++j) gr[j] = GC[16 * mt + 4 * fq + j];
#pragma unroll
          for (int t = 0; t < 2; ++t) gj[t] = GC[16 * (nt0 + t) + fr];
#pragma unroll
          for (int t = 0; t < 2; ++t)
#pragma unroll
              for (int j = 0; j < 4; ++j) { const int r = 16 * mt + 4 * fq + j, jj = 16 * (nt0 + t) + fr; const float a = jj < r ? acc[t][j] * __expf(gr[j] - gj[t]) : 0.f;
                  Af[jj * AFS + r] = a; *(LAS bf16_t*)(Abf + r * TS + jj * 2) = (bf16_t)f2bf(a); }
          { bf16_t kraw[8]; float gcr[8];
#pragma unroll
            for (int q = 0; q < 8; ++q) { const int e = tid + NTHR * q, r = e >> 6, cc = e & 63; kraw[q] = *(const LAS bf16_t*)(kh + r * TS + cc * 2); gcr[q] = GC[r]; }
#pragma unroll
            for (int q = 0; q < 8; ++q) { const int e = tid + NTHR * q, r = e >> 6, cc = e & 63; *(LAS bf16_t*)(kdT + cc * TS + r * 2) = (bf16_t)f2bf(bf2f(kraw[q]) * __expf(gtot - gcr[q])); } } }
        __syncthreads();
        { const GdnRhs rhs{kb, vb, GC}; dr_block_solve(Abf, Af, XT, Dbuf, 1.0f, wave, rhs, WSP(bf16_t, SC_DR_WU) + (size_t)u * 8192); }
        { GDN_LANES; f32x4 am[2] = {(f32x4){0.f, 0.f, 0.f, 0.f}, (f32x4){0.f, 0.f, 0.f, 0.f}}, an[2] = {(f32x4){0.f, 0.f, 0.f, 0.f}, (f32x4){0.f, 0.f, 0.f, 0.f}};
          mm_rows<64, 2>(kdT, TS, XT, TS, mt, nt0, fr, fq, am);
          mm_rows<64, 2>(kdT, TS, XT + 64 * TS, TS, mt, nt0, fr, fq, an);
          bf16_t* Mg = WSP(bf16_t, SC_DR_M) + (size_t)cslot(u) * 4096; bf16_t* Ng = WSP(bf16_t, SC_DR_NS) + (size_t)cslot(u) * 4096; const float eg = __expf(gtot);
#pragma unroll
          for (int t = 0; t < 2; ++t) {
#pragma unroll
              for (int j = 0; j < 4; ++j) { const int row = 16 * mt + 4 * fq + j, col = 16 * (nt0 + t) + fr; Mg[dr_mfrag_idx(row, col)] = (bf16_t)f2bf((row == col ? eg : 0.f) - am[t][j]); }
              *(u32x2*)(Ng + (((nt0 + t) * 2 + (mt >> 1)) * 64 + lane) * 8 + (mt & 1) * 4) = (u32x2){pk2(an[t][0], an[t][1]), pk2(an[t][2], an[t][3])}; } }
    }
#undef GDN_LANES
#undef GDN1_LOAD
}
__device__ __forceinline__ void dr_chain(const Cx& p, size_t offM, size_t offNS, int h, int d, int cb) {
    const int lane = p.tid & 63, fr = lane & 15, fq = lane >> 4;
    if (p.tid >= 64) return;
    f32x4 acc[4];
#pragma unroll
    for (int t = 0; t < 4; ++t) acc[t] = (f32x4){0.f, 0.f, 0.f, 0.f};
    bf16x8 mR[4][4][2]; u32x4 nR[4][2];
#define DR_LD(m, nn, n_) do { const int u_ = cslot((chain_tb((n_), d) * 4 + h) * 2 + d); const bf16_t* M_ = WSP(bf16_t, offM) + (size_t)u_ * 4096; const bf16_t* N_ = WSP(bf16_t, offNS) + (size_t)u_ * 4096; \
        _Pragma("unroll") for (int t = 0; t < 4; ++t) { _Pragma("unroll") for (int ks = 0; ks < 2; ++ks) m[t][ks] = *(const bf16x8*)(M_ + ((t * 2 + ks) * 64 + lane) * 8); } \
        _Pragma("unroll") for (int pr = 0; pr < 2; ++pr) nn[pr] = *(const u32x4*)(N_ + ((cb * 2 + pr) * 64 + lane) * 8); } while (0)
#define DR_STEP(m, nn, n_) do { const int u_ = cslot((chain_tb((n_), d) * 4 + h) * 2 + d); bf16_t* ST_ = WSP(bf16_t, offNS) + (size_t)u_ * 4096 + (16 * cb + fr) * 64 + 16 * fq; \
        u32x2 sp_[4]; _Pragma("unroll") for (int t = 0; t < 4; ++t) sp_[t] = (u32x2){pk2(acc[t][0], acc[t][1]), pk2(acc[t][2], acc[t][3])}; \
        *(u32x4*)ST_ = (u32x4){sp_[0][0], sp_[0][1], sp_[1][0], sp_[1][1]}; *(u32x4*)(ST_ + 8) = (u32x4){sp_[2][0], sp_[2][1], sp_[3][0], sp_[3][1]};        \
        bf16x8 bf_[2]; _Pragma("unroll") for (int ks = 0; ks < 2; ++ks) { u32x4 w_ = (u32x4){sp_[2 * ks][0], sp_[2 * ks][1], sp_[2 * ks + 1][0], sp_[2 * ks + 1][1]}; bf_[ks] = __builtin_bit_cast(bf16x8, w_); } \
        _Pragma("unroll") for (int t = 0; t < 4; ++t) { const unsigned n0_ = nn[t >> 1][(t & 1) * 2], n1_ = nn[t >> 1][(t & 1) * 2 + 1]; f32x4 a_ = (f32x4){__uint_as_float(n0_ << 16), __uint_as_float(n0_ & 0xffff0000u), __uint_as_float(n1_ << 16), __uint_as_float(n1_ & 0xffff0000u)}; \
            a_ = __builtin_amdgcn_mfma_f32_16x16x32_bf16(m[t][0], bf_[0], a_, 0, 0, 0); acc[t] = __builtin_amdgcn_mfma_f32_16x16x32_bf16(m[t][1], bf_[1], a_, 0, 0, 0); } } while (0)
#define DR_GO(q, n_) do { DR_STEP(mR[q], nR[q], (n_)); DR_LD(mR[q], nR[q], (n_) + 4 < NTB ? (n_) + 4 : NTB - 1); } while (0)
    DR_LD(mR[0], nR[0], 0); DR_LD(mR[1], nR[1], 1); DR_LD(mR[2], nR[2], 2); DR_LD(mR[3], nR[3], 3);
#pragma unroll 1
    for (int n = 0; n < NTB; n += 4) { DR_GO(0, n); DR_GO(1, n + 1); DR_GO(2, n + 2); DR_GO(3, n + 3); }
#undef DR_GO
#undef DR_LD
#undef DR_STEP
}
__device__ __forceinline__ void gdn_p2(const Cx& p, LAS unsigned char* lds0, int layer, int b) {
    const int tid = p.tid, lane = tid & 63, wave = __builtin_amdgcn_readfirstlane(tid >> 6), fr = lane & 15, fq = lane >> 4;
    int par = 0;
    const int mt = wave >> 1, nt0 = (wave & 1) * 2;
    float gq; bf16_t upre[2][4]; u32x4 qv, kv, wv, sv;
#define GDN2_LOAD(uu) do { const int tb_ = (uu) >> 3, h_ = ((uu) >> 1) & 3, d_ = (uu) & 1; \
        const bf16_t* dq_ = WSP(bf16_t, SC_DQ) + (size_t)(64 * tb_) * 768; const float* dg_ = WSP(float, SC_DG) + (size_t)(64 * tb_) * 16; \
        const bf16_t* wu_ = WSP(bf16_t, SC_DR_WU) + (size_t)(uu) * 8192; const bf16_t* st_ = WSP(bf16_t, SC_DR_NS) + (size_t)cslot(uu) * 4096; \
        gq = dg_[(d_ ? 63 - lane : lane) * 16 + 8 + d_ * 4 + h_]; \
        _Pragma("unroll") for (int t = 0; t < 2; ++t) { _Pragma("unroll") for (int j = 0; j < 4; ++j) upre[t][j] = wu_[(16 * mt + 4 * fq + j) * 128 + 64 + 16 * (nt0 + t) + fr]; } \
        { const int r_ = tid >> 3, c0_ = (tid & 7) * 8, i_ = d_ ? 63 - r_ : r_; \
          qv = *(const u32x4*)(dq_ + (size_t)i_ * 768 + 64 * h_ + c0_); kv = *(const u32x4*)(dq_ + (size_t)i_ * 768 + 256 + 64 * h_ + c0_); \
          wv = *(const u32x4*)(wu_ + r_ * 128 + c0_); sv = *(const u32x4*)(st_ + r_ * 64 + c0_); } } while (0)
    int u = (p.bid + p.G - (192 % p.G)) % p.G;
    if (u < NUNIT) GDN2_LOAD(u);
    for (; u < NUNIT; u += p.G) { const int tb = u >> 3, h = (u >> 1) & 3, d = u & 1, s0 = 64 * tb;
        LAS unsigned char* lds = lds0 + par * 57344; par ^= 1;
        LAS unsigned char* qh = lds; LAS unsigned char* kh = lds + 64 * TS; LAS unsigned char* wt = lds + 2 * 64 * TS; LAS unsigned char* sT = lds + 3 * 64 * TS; LAS unsigned char* aq = lds + 4 * 64 * TS; LAS unsigned char* vnT = lds + 5 * 64 * TS;
        LAS float* GC = (LAS float*)(lds + 6 * 64 * TS);
        if (wave == 0) { float pre = gq;
#pragma unroll
            for (int o = 1; o < 64; o <<= 1) { const float t = shup_(pre, lane, o); if (lane >= o) pre += t; }
            GC[lane] = pre; }
        bf16_t ucur[2][4];
#pragma unroll
        for (int t = 0; t < 2; ++t)
#pragma unroll
            for (int j = 0; j < 4; ++j) ucur[t][j] = upre[t][j];
        { const int r = tid >> 3, c0 = (tid & 7) * 8;
          *(LAS u32x4*)(qh + r * TS + c0 * 2) = qv; *(LAS u32x4*)(kh + r * TS + c0 * 2) = kv; *(LAS u32x4*)(wt + r * TS + c0 * 2) = wv; { const int ci = c0 >> 3, sq = ci >> 1, tp = ci & 1;
            *(LAS u32x2*)(sT + r * TS + (32 * tp + 4 * sq) * 2) = (u32x2){sv[0], sv[1]}; *(LAS u32x2*)(sT + r * TS + (32 * tp + 16 + 4 * sq) * 2) = (u32x2){sv[2], sv[3]}; } }
        if (u + p.G < NUNIT) GDN2_LOAD(u + p.G);
        __syncthreads();
        { f32x4 acc[2] = {(f32x4){0.f, 0.f, 0.f, 0.f}, (f32x4){0.f, 0.f, 0.f, 0.f}};
          mm_rows<64, 2>(qh, TS, kh, TS, mt, nt0, fr, fq, acc);
          float gr[4], gj[2];
#pragma unroll
          for (int j = 0; j < 4; ++j) gr[j] = GC[16 * mt + 4 * fq + j];
#pragma unroll
          for (int t = 0; t < 2; ++t) gj[t] = GC[16 * (nt0 + t) + fr];
#pragma unroll
          for (int t = 0; t < 2; ++t)
#pragma unroll
              for (int j = 0; j < 4; ++j) { const int r = 16 * mt + 4 * fq + j, jj = 16 * (nt0 + t) + fr; *(LAS bf16_t*)(aq + r * TS + jj * 2) = (bf16_t)f2bf(jj <= r ? acc[t][j] * __expf(gr[j] - gj[t]) : 0.f); }
          f32x4 av[2] = {(f32x4){0.f, 0.f, 0.f, 0.f}, (f32x4){0.f, 0.f, 0.f, 0.f}};
          mm_rows<64, 2>(wt, TS, sT, TS, mt, nt0, fr, fq, av);
#pragma unroll
          for (int t = 0; t < 2; ++t) { const int dv = 16 * (nt0 + t) + fr; float vn[4];
#pragma unroll
              for (int j = 0; j < 4; ++j) vn[j] = bf2f(ucur[t][j]) - av[t][j];
              *(LAS u32x2*)(vnT + dv * TS + (16 * mt + 4 * fq) * 2) = (u32x2){pk2(vn[0], vn[1]), pk2(vn[2], vn[3])}; } }
        __syncthreads();
        { f32x4 acc[2] = {(f32x4){0.f, 0.f, 0.f, 0.f}, (f32x4){0.f, 0.f, 0.f, 0.f}};
          mm_rows<64, 2>(sT, TS, qh, TS, mt, nt0, fr, fq, acc);
#pragma unroll
          for (int t = 0; t < 2; ++t) { const float sc = __expf(GC[16 * (nt0 + t) + fr]); acc[t] *= sc; }
          mm_rows<64, 2>(vnT, TS, aq, TS, mt, nt0, fr, fq, acc);
          bf16_t* ob = WSP(bf16_t, d ? SC_OB : SC_OF);
#pragma unroll
          for (int t = 0; t < 2; ++t) { const int r = 16 * (nt0 + t) + fr, i = d ? 63 - r : r; *(u32x2*)(ob + (size_t)(s0 + i) * 1024 + 768 + 64 * h + 16 * mt + 4 * fq) = (u32x2){pk2(acc[t][0], acc[t][1]), pk2(acc[t][2], acc[t][3])}; } }
    }
}
#undef GDN2_LOAD
constexpr int LPS = 65;
#define RW_LP(LP, GS, lw8) do { const int lane_ = lane_id_asm(), c_ = lane_, tg_ = wave; float loc_[8]; float run_ = 0.f; \
        _Pragma("unroll") for (int ii = 0; ii < 8; ++ii) { run_ += (lw8)[ii]; loc_[ii] = run_; } \
        (GS)[tg_ * 64 + c_] = run_; __syncthreads(); float off_ = 0.f; \
        _Pragma("unroll") for (int g2 = 0; g2 < 8; ++g2) if (g2 < tg_) off_ += (GS)[g2 * 64 + c_]; \
        _Pragma("unroll") for (int ii = 0; ii < 8; ++ii) (LP)[(8 * tg_ + ii) * LPS + c_] = loc_[ii] + off_; __syncthreads(); } while (0)
struct RwRhs { const LAS unsigned char* zt; const LAS unsigned char* RU;
    __device__ __forceinline__ float operator()(int r, int col) const { return col < 64 ? bf2f(*(const LAS bf16_t*)(zt + r * TS + col * 2)) : bf2f(*(const LAS bf16_t*)(RU + (col - 64) * TS + r * 2)); } };
__device__ __forceinline__ void rw_p1(const Cx& p, LAS unsigned char* lds, int layer, int b) {
    const int wave = __builtin_amdgcn_readfirstlane(p.tid >> 6), mt = wave >> 1, nt0 = (wave & 1) * 2;
#define RW_LANES const int lane = lane_id_asm(), tid = wave * 64 + lane, fr = lane & 15, fq = lane >> 4; (void)tid; (void)fr; (void)fq
    LAS float* LP = (LAS float*)lds; LAS float* GS = (LAS float*)(lds + 16640);
    LAS unsigned char* zt = lds + 18688; LAS unsigned char* bt = lds + 27904; LAS unsigned char* kt = lds + 37120; LAS unsigned char* vT = lds + 46336; LAS unsigned char* Azk = lds + 55552;
    LAS float* Af = (LAS float*)(lds + 64768); LAS unsigned char* XT = lds + 82176; LAS unsigned char* Abf = lds + 100608; LAS unsigned char* RU = lds + 109824; LAS float* Dbuf = (LAS float*)(lds + 119040); LAS unsigned char* bhT = lds + 129280;
    const bf16_t* proj = WSP(bf16_t, WS_PROJ);
    float lw8[8]; f32x4 lwv[2], kkv[2], bv[2], kv[2]; bf16_t v8[8];
#define RW1_LOAD(uu) do { const int tb_ = (uu) >> 3, h_ = ((uu) >> 1) & 3, d_ = (uu) & 1, s0_ = 64 * tb_; const int lane_ = lane_id_asm(), tid_ = wave * 64 + lane_; \
        const float* lwp_ = WSP(float, SC_RLW) + (size_t)d_ * SB * 256 + (size_t)s0_ * 256 + 64 * h_; const size_t fo_ = (size_t)s0_ * 256 + 64 * h_; \
        _Pragma("unroll") for (int ii = 0; ii < 8; ++ii) { const int r_ = 8 * wave + ii; lw8[ii] = lwp_[(size_t)(d_ ? 63 - r_ : r_) * 256 + lane_]; } \
        { const int r_ = tid_ >> 3, c0_ = (tid_ & 7) * 8, i_ = d_ ? 63 - r_ : r_; \
          _Pragma("unroll") for (int q = 0; q < 2; ++q) { lwv[q] = *(const f32x4*)(lwp_ + (size_t)i_ * 256 + c0_ + 4 * q); kkv[q] = *(const f32x4*)(WSP(float, SC_RKK) + fo_ + (size_t)i_ * 256 + c0_ + 4 * q); \
              bv[q] = *(const f32x4*)(WSP(float, SC_RB) + fo_ + (size_t)i_ * 256 + c0_ + 4 * q); kv[q] = *(const f32x4*)(WSP(float, SC_RK) + fo_ + (size_t)i_ * 256 + c0_ + 4 * q); } } \
        { const bf16_t* pr0_ = proj + (size_t)tb_row0(b, tb_) * NPROJ; \
          _Pragma("unroll") for (int q = 0; q < 8; ++q) { const int e = tid_ + NTHR * q, r2 = e >> 6, cc = e & 63; v8[q] = pr0_[(size_t)(d_ ? 63 - r2 : r2) * NPROJ + PB_V + 64 * h_ + cc]; } } } while (0)
    int u = (p.bid + p.G - (96 % p.G)) % p.G; if (u >= NUNIT) return;
    RW1_LOAD(u);
    for (;;) { const int d = u & 1;
        RW_LP(LP, GS, lw8);
        { RW_LANES; const int r = tid >> 3, c0 = (tid & 7) * 8; unsigned wz[4], wb[4], wk[4];
#pragma unroll
          for (int q = 0; q < 8; q += 2) { float z2[2], b2[2], k2[2];
#pragma unroll
              for (int e = 0; e < 2; ++e) { const int cq = q + e, c = c0 + cq; const float lp = LP[r * LPS + c], lw = lwv[cq >> 2][cq & 3], em = __expf(-lp);
                  z2[e] = -kkv[cq >> 2][cq & 3] * __expf(lp - lw); b2[e] = bv[cq >> 2][cq & 3] * em; k2[e] = kv[cq >> 2][cq & 3] * em; }
              wz[q >> 1] = pk2(z2[0], z2[1]); wb[q >> 1] = pk2(b2[0], b2[1]); wk[q >> 1] = pk2(k2[0], k2[1]); }
          *(LAS u32x4*)(zt + r * TS + c0 * 2) = (u32x4){wz[0], wz[1], wz[2], wz[3]}; *(LAS u32x4*)(bt + r * TS + c0 * 2) = (u32x4){wb[0], wb[1], wb[2], wb[3]}; *(LAS u32x4*)(kt + r * TS + c0 * 2) = (u32x4){wk[0], wk[1], wk[2], wk[3]};
#pragma unroll
          for (int q = 0; q < 8; ++q) { const int e = tid + NTHR * q, r2 = e >> 6, cc = e & 63; *(LAS bf16_t*)(vT + cc * TS + r2 * 2) = v8[q]; } }
        __syncthreads();
        const int un = u + p.G; const bool more = un < NUNIT;
        if (more) RW1_LOAD(un);
        { RW_LANES; f32x4 a1[2] = {(f32x4){0.f, 0.f, 0.f, 0.f}, (f32x4){0.f, 0.f, 0.f, 0.f}}, a2[2] = {(f32x4){0.f, 0.f, 0.f, 0.f}, (f32x4){0.f, 0.f, 0.f, 0.f}};
          mm_rows<64, 2>(zt, TS, bt, TS, mt, nt0, fr, fq, a1);
          mm_rows<64, 2>(zt, TS, kt, TS, mt, nt0, fr, fq, a2);
#pragma unroll
          for (int t = 0; t < 2; ++t)
#pragma unroll
              for (int j = 0; j < 4; ++j) { const int r = 16 * mt + 4 * fq + j, jj = 16 * (nt0 + t) + fr; const float a = jj < r ? a1[t][j] : 0.f;
                  Af[jj * AFS + r] = a; *(LAS bf16_t*)(Abf + r * TS + jj * 2) = (bf16_t)f2bf(a); *(LAS bf16_t*)(Azk + r * TS + jj * 2) = (bf16_t)f2bf(jj < r ? a2[t][j] : 0.f); } }
        __syncthreads();
        { RW_LANES; f32x4 a[2] = {(f32x4){0.f, 0.f, 0.f, 0.f}, (f32x4){0.f, 0.f, 0.f, 0.f}};
          mm_rows<64, 2>(Azk, TS, vT, TS, mt, nt0, fr, fq, a);
#pragma unroll
          for (int t = 0; t < 2; ++t) *(LAS u32x2*)(RU + (16 * (nt0 + t) + fr) * TS + (16 * mt + 4 * fq) * 2) = (u32x2){pk2(a[t][0], a[t][1]), pk2(a[t][2], a[t][3])};
        }
        if (wave == 0) dr_tinv(Af, Dbuf, -1.0f);
        __syncthreads();
        { RW_LANES;
          const float el = __expf(LP[63 * LPS + (tid & 63)]); bf16_t braw[8], kraw[8];
#pragma unroll
          for (int q = 0; q < 8; ++q) { const int e = tid + NTHR * q, r2 = e >> 6, cc = e & 63; braw[q] = *(const LAS bf16_t*)(bt + r2 * TS + cc * 2); kraw[q] = *(const LAS bf16_t*)(kt + r2 * TS + cc * 2); }
#pragma unroll
          for (int q = 0; q < 8; ++q) { const int e = tid + NTHR * q, r2 = e >> 6, cc = e & 63;
              *(LAS bf16_t*)(bhT + cc * TS + r2 * 2) = (bf16_t)f2bf(bf2f(braw[q]) * el); *(LAS bf16_t*)(Azk + cc * TS + r2 * 2) = (bf16_t)f2bf(bf2f(kraw[q]) * el); } }
        __syncthreads();
        { const RwRhs rhs{zt, RU}; dr_solve(Abf, XT, Dbuf, -1.0f, wave, rhs, WSP(bf16_t, SC_RW_WU) + (size_t)u * 8192); }
        { RW_LANES; f32x4 am[2] = {(f32x4){0.f, 0.f, 0.f, 0.f}, (f32x4){0.f, 0.f, 0.f, 0.f}}, an[2] = {(f32x4){0.f, 0.f, 0.f, 0.f}, (f32x4){0.f, 0.f, 0.f, 0.f}};
          mm_rows<64, 2>(bhT, TS, XT, TS, mt, nt0, fr, fq, am);
          mm_rows<64, 2>(bhT, TS, XT + 64 * TS, TS, mt, nt0, fr, fq, an);
          mm_rows<64, 2>(Azk, TS, vT, TS, mt, nt0, fr, fq, an);
          bf16_t* Mg = WSP(bf16_t, SC_RW_M) + (size_t)cslot(u) * 4096; bf16_t* Ng = WSP(bf16_t, SC_RW_NS) + (size_t)cslot(u) * 4096;
#pragma unroll
          for (int t = 0; t < 2; ++t) {
#pragma unroll
              for (int j = 0; j < 4; ++j) { const int row = 16 * mt + 4 * fq + j, col = 16 * (nt0 + t) + fr; Mg[dr_mfrag_idx(row, col)] = (bf16_t)f2bf((row == col ? __expf(LP[63 * LPS + row]) : 0.f) + am[t][j]); }
              *(u32x2*)(Ng + (((nt0 + t) * 2 + (mt >> 1)) * 64 + lane) * 8 + (mt & 1) * 4) = (u32x2){pk2(an[t][0], an[t][1]), pk2(an[t][2], an[t][3])}; } }
        if (!more) break;
        u = un;
    }
#undef RW1_LOAD
}
__device__ __forceinline__ void rw_p2(const Cx& p, LAS unsigned char* lds, int layer, int b) {
    const int wave = __builtin_amdgcn_readfirstlane(p.tid >> 6), mt = wave >> 1, nt0 = (wave & 1) * 2;
    LAS float* LP = (LAS float*)lds; LAS float* GS = (LAS float*)(lds + 16640);
    LAS unsigned char* rt = lds + 18688; LAS unsigned char* bt = lds + 27904; LAS unsigned char* kt = lds + 37120; LAS unsigned char* vT = lds + 46336; LAS unsigned char* sT = lds + 55552; LAS unsigned char* wt = lds + 64768;
    LAS unsigned char* Arb = lds + 73984; LAS unsigned char* Ark = lds + 83200; LAS unsigned char* UT = lds + 92416;
    const bf16_t* proj = WSP(bf16_t, WS_PROJ);
    bf16_t upre[2][4]; float lw8[8]; u32x4 rv, wv, sv, vq; f32x4 bv[2], kv[2];
#define RW2_LOAD(uu) do { const int tb_ = (uu) >> 3, h_ = ((uu) >> 1) & 3, d_ = (uu) & 1, s0_ = 64 * tb_; const int lane_ = lane_id_asm(), tid_ = wave * 64 + lane_, fr_ = lane_ & 15, fq_ = lane_ >> 4; \
        const float* lwp_ = WSP(float, SC_RLW) + (size_t)d_ * SB * 256 + (size_t)s0_ * 256 + 64 * h_; const float* rk_ = WSP(float, SC_RK) + (size_t)s0_ * 256 + 64 * h_; const float* rb_ = WSP(float, SC_RB) + (size_t)s0_ * 256 + 64 * h_; \
        const bf16_t* pr_ = proj + (size_t)tb_row0(b, tb_) * NPROJ; const bf16_t* wu_ = WSP(bf16_t, SC_RW_WU) + (size_t)(uu) * 8192; const bf16_t* st_ = WSP(bf16_t, SC_RW_NS) + (size_t)cslot(uu) * 4096; \
        _Pragma("unroll") for (int t = 0; t < 2; ++t) { _Pragma("unroll") for (int j = 0; j < 4; ++j) upre[t][j] = wu_[(16 * mt + 4 * fq_ + j) * 128 + 64 + 16 * (nt0 + t) + fr_]; } \
        _Pragma("unroll") for (int ii = 0; ii < 8; ++ii) { const int r_ = 8 * wave + ii; lw8[ii] = lwp_[(size_t)(d_ ? 63 - r_ : r_) * 256 + lane_]; } \
        { const int r_ = tid_ >> 3, c0_ = (tid_ & 7) * 8, i_ = d_ ? 63 - r_ : r_; rv = *(const u32x4*)(pr_ + (size_t)i_ * NPROJ + PB_R + 64 * h_ + c0_); \
          _Pragma("unroll") for (int q = 0; q < 2; ++q) { bv[q] = *(const f32x4*)(rb_ + (size_t)i_ * 256 + c0_ + 4 * q); kv[q] = *(const f32x4*)(rk_ + (size_t)i_ * 256 + c0_ + 4 * q); } \
          wv = *(const u32x4*)(wu_ + r_ * 128 + c0_); sv = *(const u32x4*)(st_ + r_ * 64 + c0_); } \
        vq = *(const u32x4*)(pr_ + (size_t)(d_ ? 63 - lane_ : lane_) * NPROJ + PB_V + 64 * h_ + 8 * wave); } while (0)
    int u = (p.bid + p.G - (224 % p.G)) % p.G;
    if (u < NUNIT) RW2_LOAD(u);
    for (; u < NUNIT; u += p.G) { const int tb = u >> 3, h = (u >> 1) & 3, d = u & 1, s0 = 64 * tb;
        bf16_t ucur[2][4];
#pragma unroll
        for (int t = 0; t < 2; ++t)
#pragma unroll
            for (int j = 0; j < 4; ++j) ucur[t][j] = upre[t][j];
        RW_LP(LP, GS, lw8);
        { RW_LANES; const int r = tid >> 3, c0 = (tid & 7) * 8; unsigned wr[4], wb[4], wk[4];
#pragma unroll
          for (int q = 0; q < 8; q += 2) { float r2[2], b2[2], k2[2];
#pragma unroll
              for (int e = 0; e < 2; ++e) { const int cq = q + e, c = c0 + cq; const float lp = LP[r * LPS + c], em = __expf(-lp); const unsigned w = rv[q >> 1];
                  r2[e] = (e ? __uint_as_float(w & 0xffff0000u) : __uint_as_float(w << 16)) * __expf(lp); b2[e] = bv[cq >> 2][cq & 3] * em; k2[e] = kv[cq >> 2][cq & 3] * em; }
              wr[q >> 1] = pk2(r2[0], r2[1]); wb[q >> 1] = pk2(b2[0], b2[1]); wk[q >> 1] = pk2(k2[0], k2[1]); }
          *(LAS u32x4*)(rt + r * TS + c0 * 2) = (u32x4){wr[0], wr[1], wr[2], wr[3]}; *(LAS u32x4*)(bt + r * TS + c0 * 2) = (u32x4){wb[0], wb[1], wb[2], wb[3]}; *(LAS u32x4*)(kt + r * TS + c0 * 2) = (u32x4){wk[0], wk[1], wk[2], wk[3]};
          *(LAS u32x4*)(wt + r * TS + c0 * 2) = wv; { const int ci = c0 >> 3, sq = ci >> 1, tp = ci & 1;
            *(LAS u32x2*)(sT + r * TS + (32 * tp + 4 * sq) * 2) = (u32x2){sv[0], sv[1]}; *(LAS u32x2*)(sT + r * TS + (32 * tp + 16 + 4 * sq) * 2) = (u32x2){sv[2], sv[3]}; }
#pragma unroll
          for (int k = 0; k < 8; ++k) *(LAS bf16_t*)(vT + (8 * wave + k) * TS + lane * 2) = (bf16_t)(vq[k >> 1] >> (16 * (k & 1))); }
        if (u + p.G < NUNIT) RW2_LOAD(u + p.G);
        __syncthreads();
        { RW_LANES; f32x4 a1[2] = {(f32x4){0.f, 0.f, 0.f, 0.f}, (f32x4){0.f, 0.f, 0.f, 0.f}}, a2[2] = {(f32x4){0.f, 0.f, 0.f, 0.f}, (f32x4){0.f, 0.f, 0.f, 0.f}}, a3[2] = {(f32x4){0.f, 0.f, 0.f, 0.f}, (f32x4){0.f, 0.f, 0.f, 0.f}};
          mm_rows<64, 2>(rt, TS, bt, TS, mt, nt0, fr, fq, a1); mm_rows<64, 2>(rt, TS, kt, TS, mt, nt0, fr, fq, a2); mm_rows<64, 2>(wt, TS, sT, TS, mt, nt0, fr, fq, a3);
#pragma unroll
          for (int t = 0; t < 2; ++t) { const int dv = 16 * (nt0 + t) + fr; float uu[4];
#pragma unroll
              for (int j = 0; j < 4; ++j) { const int r = 16 * mt + 4 * fq + j, jj = dv; const bool keep = jj <= r;
                  *(LAS bf16_t*)(Arb + r * TS + jj * 2) = (bf16_t)f2bf(keep ? a1[t][j] : 0.f); *(LAS bf16_t*)(Ark + r * TS + jj * 2) = (bf16_t)f2bf(keep ? a2[t][j] : 0.f);
                  uu[j] = bf2f(ucur[t][j]) + a3[t][j]; }
              *(LAS u32x2*)(UT + dv * TS + (16 * mt + 4 * fq) * 2) = (u32x2){pk2(uu[0], uu[1]), pk2(uu[2], uu[3])}; } }
        __syncthreads();
        { RW_LANES; f32x4 acc[2] = {(f32x4){0.f, 0.f, 0.f, 0.f}, (f32x4){0.f, 0.f, 0.f, 0.f}};
          mm_rows<64, 2>(sT, TS, rt, TS, mt, nt0, fr, fq, acc); mm_rows<64, 2>(UT, TS, Arb, TS, mt, nt0, fr, fq, acc); mm_rows<64, 2>(vT, TS, Ark, TS, mt, nt0, fr, fq, acc);
          bf16_t* ob = WSP(bf16_t, d ? SC_OB : SC_OF);
#pragma unroll
          for (int t = 0; t < 2; ++t) { const int r = 16 * (nt0 + t) + fr, i = d ? 63 - r : r; *(u32x2*)(ob + (size_t)(s0 + i) * 1024 + 256 + 64 * h + 16 * mt + 4 * fq) = (u32x2){pk2(acc[t][0], acc[t][1]), pk2(acc[t][2], acc[t][3])}; } }
    }
#undef RW_LANES
#undef RW2_LOAD
}
__device__ __forceinline__ void phase_scan(const Cx& p, LAS unsigned char* lds, int layer, int b) {
    for (int w = p.bid; w < 160; w += p.G) {
        if (w < 64) ssd_chain(p, (w >> 4) & 3, (w >> 3) & 1, w & 7);
        else if (w < 96) gla_chain(p, ((w - 64) >> 3) & 3, ((w - 64) >> 2) & 1, (w - 64) & 3);
        else { const int i = w - 96, h = (i >> 3) & 3, d = (i >> 2) & 1, cb = i & 3;
            if (i < 32) dr_chain(p, SC_RW_M, SC_RW_NS, h, d, cb); else dr_chain(p, SC_DR_M, SC_DR_NS, h, d, cb); } }
}
#ifndef MK_ONE_LAUNCH
#define MK_ONE_LAUNCH 1
#endif
constexpr int PH_PER_LAYER = 2 + 5 * NB + 7;
constexpr int N_PHASES = 1 + NL * PH_PER_LAYER + 1;

__global__ void __launch_bounds__(NTHR, 2) mega_fwd(Params pp) {
    extern __shared__ __attribute__((aligned(16))) unsigned char lds_raw[];
    LAS unsigned char* lds = (LAS unsigned char*)lds_raw;
    const int swave = __builtin_amdgcn_readfirstlane(threadIdx.x >> 6);
    for (int i = threadIdx.x; i < (LDS_BYTES - LDS_CTL) / 4; i += NTHR) ((LAS unsigned*)(lds + LDS_CTL))[i] = 0u;
    __syncthreads();
    if (threadIdx.x < N_IN + 2) { const unsigned long long a = threadIdx.x < N_IN ? (unsigned long long)pp.in[threadIdx.x] : (threadIdx.x == N_IN ? (unsigned long long)pp.out : (unsigned long long)pp.ws); ((LAS unsigned*)(lds + LDS_PTRS))[2 * threadIdx.x] = (unsigned)a; ((LAS unsigned*)(lds + LDS_PTRS))[2 * threadIdx.x + 1] = (unsigned)(a >> 32); }
    __syncthreads();
    XcdBarrier bar = xcd_barrier_post((unsigned*)(pp.ws + WS_CTL) + CW_BAR + pp.li * XCD_BAR_WORDS, (volatile LAS unsigned*)(lds + LDS_CTL), threadIdx.x);
    LAS int* tb = (LAS int*)(lds + LDS_CTL + 64);
    int pc = 0; const int lo = pp.lo, hi = pp.hi;
#define PH_BEGIN if (pc >= lo && pc < hi) { Cx p; p.out = (unsigned long long)PIN(N_IN); p.ws = (unsigned long long)PIN(N_IN + 1); p.tid = swave * 64 + lane_id_asm(); p.bid = blockIdx.x; p.G = gridDim.x; p.pad = 0; asm volatile("" : "+s"(p.out), "+s"(p.ws), "+v"(p.tid), "+s"(p.bid), "+s"(p.G)); const int G = p.G, bid = p.bid; (void)G; (void)bid;
#define PH_END if (pc + 1 < hi) { XcdBarrier b2 = bar; asm volatile("" : "+s"(b2.bar), "+s"(b2.x)); xcd_barrier(b2, (unsigned)(swave * 64 + lane_id_asm())); } } ++pc;

    PH_BEGIN
        conv_run(p, (LAS float*)lds, CONV_A_UNITS, ConvDescA{0});
        __syncthreads();
        phase_mod(p, lds);
    PH_END

#pragma unroll
    for (int layer = 0; layer < NL; ++layer) {
        const int row_lo = layer == NL - 1 ? CROWS : 0;
        PH_BEGIN phase_norm1(p, layer); PH_END
        PH_BEGIN
            DenseSched S; S.init(ROWS, NPROJ, D, WSP(bf16_t, WS_WIN) + (size_t)layer * NPROJ * D, G, bid);
            EpiProj E{WSP(bf16_t, WS_PROJ), NPROJ};
            pg8::gemm_phase<D>(p.tid, lds, (const char*)WSP(bf16_t, WS_HBUF), S, E);
        PH_END
#pragma unroll 1
        for (int b = 0; b < NB; ++b) {
            PH_BEGIN phase_prep(p, lds, layer, b); PH_END
            PH_BEGIN gla_p1(p, lds, layer, b); __syncthreads(); ssd_p1(p, lds, layer, b); __syncthreads(); gdn_p1(p, lds, layer, b); __syncthreads(); rw_p1(p, lds, layer, b); PH_END
            PH_BEGIN phase_scan(p, lds, layer, b); PH_END
            PH_BEGIN gla_p2(p, lds, layer, b); __syncthreads(); ssd_p2(p, lds, layer, b); __syncthreads(); gdn_p2(p, lds, layer, b); __syncthreads(); rw_p2(p, lds, layer, b); PH_END
            PH_BEGIN phase_post(p, lds, layer, b); PH_END
        }
        PH_BEGIN
            DenseSched S; S.init(ROWS, D, D, WSP(bf16_t, WS_WOUT) + (size_t)layer * D * D, G, bid);
            EpiRes E{layer == 0 ? PIN(I_X) : (const float*)POUT, layer == 0 ? PIN(I_CTX) : (const float*)WSP(float, WS_CTXRES), POUT, WSP(float, WS_CTXRES), WSP(float, WS_MOD) + (size_t)layer * 5 * 6144 + 2048};
            pg8::gemm_phase<D>(p.tid, lds, (const char*)WSP(bf16_t, WS_HBUF), S, E);
        PH_END
        PH_BEGIN phase_norm2(p, lds, layer, row_lo);
            __syncthreads();
            conv_run(p, (LAS float*)lds, CONV_E_UNITS, ConvDescE{layer});
        PH_END
        PH_BEGIN
            moe_table(p, tb, layer, row_lo);
            MoeSched<true> S{tb + 128, tb, 2, G, bid, D, row_lo, WSP(int, WS_LTOK), (const char*)WSP(bf16_t, WS_EXPGU), (size_t)512 * D * 2};
            EpiGU E{WSP(bf16_t, WS_H)};
            pg8::gemm_phase<D>(p.tid, lds, (const char*)WSP(bf16_t, WS_HBUF), S, E);
        PH_END
#pragma unroll
        for (int half = 0; half < 2; ++half) {
            PH_BEGIN
                moe_table(p, tb, layer, row_lo);
                MoeSched<false> S{tb + 128, tb, 2, G, bid, EH, row_lo, WSP(int, WS_LTOK), (const char*)(WSP(bf16_t, WS_EXPD) + (size_t)half * 512 * EH), (size_t)D * EH * 2};
                EpiY E{WSP(bf16_t, WS_Y)};
                pg8::gemm_phase<EH>(p.tid, lds, (const char*)WSP(bf16_t, WS_H), S, E);
            PH_END
            PH_BEGIN
                moe_table(p, tb, layer, row_lo);
                phase_combine(p, tb, layer, row_lo, half);
            PH_END
        }
    }
    PH_BEGIN phase_final(p);
    PH_END
#undef PH_BEGIN
#undef PH_END
}

extern "C" void kernel_launch(void* const* d_in, const int* in_sizes, int n_in, void* d_out, int out_size, void* d_ws, size_t ws_size, hipStream_t stream) {
    static int grid = 0;
    if (grid == 0) {
        if (n_in != N_IN || in_sizes[0] != NB * SEQ * D || out_size != NB * SEQ * D || ws_size < WS_END) {
            fprintf(stderr, "kernel_launch: unexpected shapes (n_in %d, in0 %d, out %d, ws %zu); nothing launched\n", n_in, n_in > 0 ? in_sizes[0] : -1, out_size, ws_size); grid = -1; return; }
        int dev = 0, cus = 0, per_cu = 0;
        if (hipGetDevice(&dev) != hipSuccess || hipDeviceGetAttribute(&cus, hipDeviceAttributeMultiprocessorCount, dev) != hipSuccess) { grid = -1; return; }
        if (hipFuncSetAttribute((const void*)mega_fwd, hipFuncAttributeMaxDynamicSharedMemorySize, LDS_BYTES) != hipSuccess) { fprintf(stderr, "kernel_launch: hipFuncSetAttribute failed\n"); grid = -1; return; }
        if (hipOccupancyMaxActiveBlocksPerMultiprocessor(&per_cu, (const void*)mega_fwd, NTHR, LDS_BYTES) != hipSuccess || per_cu < 1) { fprintf(stderr, "kernel_launch: occupancy query says %d\n", per_cu); per_cu = 1; }
        (void)hipGetLastError();
        grid = cus * 1;
    }
    if (grid < 0) return;
    if (hipMemsetAsync((char*)d_ws + WS_CTL, 0, CTL_ZERO_BYTES, stream) != hipSuccess) return;
    Params p{};
    for (int i = 0; i < N_IN; ++i) p.in[i] = (const float*)d_in[i];
    p.out = (float*)d_out; p.ws = (unsigned char*)d_ws; p.pad = 0;
#if MK_ONE_LAUNCH
    p.lo = 0; p.hi = N_PHASES; p.li = 0;
    hipLaunchKernelGGL(mega_fwd, dim3(grid), dim3(NTHR), LDS_BYTES, stream, p);
#else
    for (int k = 0; k < N_PHASES; ++k) { p.lo = k; p.hi = k + 1; p.li = k;
        hipLaunchKernelGGL(mega_fwd, dim3(grid), dim3(NTHR), LDS_BYTES, stream, p); }
#endif
}
```

```cpp
#include <hip/hip_runtime.h>
#include <cstdio>
#include <cstdint>

typedef unsigned short bf16_t;
typedef short bf16x8 __attribute__((ext_vector_type(8)));
typedef float f32x4 __attribute__((ext_vector_type(4)));
typedef float f32x2 __attribute__((ext_vector_type(2)));
typedef unsigned u32x4 __attribute__((ext_vector_type(4)));
typedef unsigned u32x2 __attribute__((ext_vector_type(2)));

constexpr int NB = 4, SEQ = 8192, NCTX = 256, D = 1024, NL = 2;
constexpr int CROWS = NB * NCTX;
constexpr int ROWS = CROWS + NB * SEQ;
constexpr int SB = NCTX + SEQ;
constexpr int INW = 4056, NPROJ = 4096;
constexpr int NE = 64, NE1 = 65, TOPK = 8, EH = 256;
constexpr int GRIDW = 64, GRIDH = SEQ / GRIDW;
constexpr int PA_Q = 0, PA_K = 256, PA_V = 512, PA_G = 768, PA_GF = 1024, PA_GB = 1040;
constexpr int PB_R = 1056, PB_K = 1312, PB_V = 1568, PB_WF = 1824, PB_WB = 1856, PB_A = 1888, PB_G = 1920;
constexpr int PC_Z = 1984, PC_X = 2240, PC_DF = 3008, PC_DB = 3012;
constexpr int PD_Q = 3016, PD_Z = 3784, PD_BF = 4040, PD_BB = 4044, PD_AF = 4048, PD_AB = 4052;
enum { I_X = 0, I_C, I_CTX, I_CCTX, I_N1G, I_N2G, I_WMOD, I_BMOD, I_WIN, I_WOUT, I_GLA_W2, I_GLA_B, I_GLA_NG,
       I_RW_W2, I_RW_W0, I_RW_AW2, I_RW_A0, I_RW_GW2, I_RW_KK, I_RW_KA, I_RW_RK, I_RW_LNG, I_RW_LNB,
       I_SS_CW, I_SS_CB, I_SS_ALOG, I_SS_DTB, I_SS_D, I_SS_NG, I_DN_CW, I_DN_ALOG, I_DN_DTB, I_DN_NG,
       I_ROUT_W, I_ROUT_B, I_EXP_G, I_EXP_U, I_EXP_D, I_SH_G, I_SH_U, I_SH_D, I_FNG, N_IN };
static_assert(N_IN == 42, "input count");

constexpr size_t MiB = 1u << 20;
constexpr size_t WS_CTL = 0, CTL_ZERO_BYTES = 1 * MiB;
constexpr size_t WS_MOD = 1 * MiB;
constexpr size_t WS_RWGW = WS_MOD + 256 * 1024;
constexpr size_t WS_RWLR = WS_MOD + 384 * 1024;
constexpr size_t WS_WIN = 2 * MiB;
constexpr size_t WS_WOUT = 18 * MiB;
constexpr size_t WS_ROUT = 22 * MiB;
constexpr size_t WS_CTXRES = 23 * MiB;
constexpr size_t WS_EXPGU = 27 * MiB;
constexpr size_t WS_EXPD = 92 * MiB;
constexpr size_t WS_HBUF = 125 * MiB;
constexpr size_t WS_PROJ = 191 * MiB;
constexpr size_t WS_SCR = 455 * MiB;
constexpr size_t WS_END = 640455456;
constexpr int HROWS_MAX = ROWS * 9 + NE1 * 256;
constexpr size_t WS_Y = WS_HBUF;
constexpr size_t WS_H = 443 * MiB;
constexpr size_t WS_LTOK = 600 * MiB;
constexpr size_t WS_TOKT = WS_LTOK + (size_t)NE * ROWS * 4;
static_assert(WS_Y + (size_t)HROWS_MAX * 512 * 2 <= WS_H && WS_H + (size_t)HROWS_MAX * 256 * 2 <= WS_LTOK && WS_TOKT + (size_t)ROWS * 64 <= WS_END, "moe overlay");
constexpr size_t SC_OF = WS_SCR;
constexpr size_t SC_OB = SC_OF + (size_t)SB * 1024 * 2;
constexpr size_t SC_RK = SC_OB + (size_t)SB * 1024 * 2;
constexpr size_t SC_RKK = SC_RK + (size_t)SB * 256 * 4;
constexpr size_t SC_RB = SC_RKK + (size_t)SB * 256 * 4;
constexpr size_t SC_RLW = SC_RB + (size_t)SB * 256 * 4;
constexpr size_t SC_SX = SC_RLW + (size_t)2 * SB * 256 * 4;
constexpr size_t SC_DQ = SC_SX + (size_t)SB * 768 * 2;
constexpr size_t SC_SDT = SC_DQ + (size_t)SB * 768 * 2;
constexpr size_t SC_DG = SC_SDT + (size_t)SB * 8 * 4;
constexpr size_t SC_FEND = SC_DG + (size_t)SB * 16 * 4;
constexpr int NTB = SB / 64, NUNIT = NTB * 4 * 2;
constexpr size_t SC_RW_M = SC_FEND;
constexpr size_t SC_RW_NS = SC_RW_M + (size_t)(SB / 64 * 8) * 4096 * 2;
constexpr size_t SC_RW_WU = SC_RW_NS + (size_t)(SB / 64 * 8) * 4096 * 2;
constexpr size_t SC_END = SC_RW_WU + (size_t)(SB / 64 * 8) * 8192 * 2;
constexpr size_t SC2 = WS_EXPGU;
constexpr size_t SC_GLA_S = SC2;
constexpr size_t SC_GLA_DEC = SC_GLA_S + (size_t)NUNIT * 4096 * 4;
constexpr size_t SC_SSD_S = SC_GLA_DEC + (size_t)NUNIT * 64 * 4;
constexpr size_t SC_SSD_CD = SC_SSD_S + (size_t)NUNIT * 8192 * 4;
constexpr size_t SC_DR_M = SC_SSD_CD + (size_t)NUNIT * 4 + 4096;
constexpr size_t SC_DR_NS = SC_DR_M + (size_t)NUNIT * 4096 * 2;
constexpr size_t SC_DR_WU = SC_DR_NS + (size_t)NUNIT * 4096 * 2;
constexpr size_t SC2_END = SC_DR_WU + (size_t)NUNIT * 8192 * 2;
constexpr size_t SC_PX = (SC2_END + 255) / 256 * 256;
constexpr size_t SC_PK = SC_PX + (size_t)SB * 256 * 2;
static_assert(SC_PK + (size_t)SB * 256 * 2 <= WS_HBUF, "chunk slots and the post copies fit in the expert-weight region");
static_assert(SC_END <= WS_END, "scratch fits");
constexpr int CW_CNT = 1024;
constexpr int CW_BAR = 4096;

#define LAS __attribute__((address_space(3)))
constexpr int NTHR = 512;
constexpr int LDS_BYTES = 147456;
constexpr int LDS_CTL = 143360;
constexpr int LDS_PTRS = LDS_CTL + 2048;

__device__ __forceinline__ int lane_id_asm() { int l; asm volatile("v_mbcnt_lo_u32_b32 %0, -1, 0\n\tv_mbcnt_hi_u32_b32 %0, -1, %0" : "=v"(l)); return l; }
__device__ __forceinline__ float bf2f(bf16_t b) { return __uint_as_float(((unsigned)b) << 16); }
typedef float f32x2_t __attribute__((ext_vector_type(2))); typedef __bf16 bf16x2_t __attribute__((ext_vector_type(2)));
__device__ __forceinline__ unsigned pk2(float lo, float hi) { const f32x2_t v = {lo, hi}; return __builtin_bit_cast(unsigned, __builtin_convertvector(v, bf16x2_t)); }
__device__ __forceinline__ unsigned f2bf(float f) { return pk2(f, 0.f) & 0xffffu; }
__device__ __forceinline__ float rl(float x, int k) { return __uint_as_float(__builtin_amdgcn_readlane(__float_as_uint(x), k)); }
__device__ __forceinline__ float shx_(float v, int lane, int o) { return __uint_as_float(__builtin_amdgcn_ds_bpermute((lane ^ o) << 2, __float_as_uint(v))); }
__device__ __forceinline__ int shxi_(int v, int lane, int o) { return __builtin_amdgcn_ds_bpermute((lane ^ o) << 2, v); }
__device__ __forceinline__ float shup_(float v, int lane, int o) { return __uint_as_float(__builtin_amdgcn_ds_bpermute((lane - o) << 2, __float_as_uint(v))); }
#define DPPF(v, ctrl) __uint_as_float(__builtin_amdgcn_update_dpp(0, __float_as_uint(v), ctrl, 0xf, 0xf, false))
#define DPPI(v, ctrl) __builtin_amdgcn_update_dpp(0, (v), ctrl, 0xf, 0xf, false)
__device__ __forceinline__ float wsum(float v) {
    v += DPPF(v, 0xB1); v += DPPF(v, 0x4E); v += DPPF(v, 0x141); v += DPPF(v, 0x140);
    v += __uint_as_float(__builtin_amdgcn_ds_swizzle(__float_as_uint(v), 0x401F));
    return rl(v, 0) + rl(v, 32);
}
__device__ __forceinline__ float rcp_(float x) { return __builtin_amdgcn_rcpf(x); }
__device__ __forceinline__ float rsq_(float x) { return __builtin_amdgcn_rsqf(x); }
__device__ __forceinline__ float sigmoidf_(float x) { return rcp_(1.0f + __expf(-x)); }
__device__ __forceinline__ float siluf_(float x) { return x * rcp_(1.0f + __expf(-x)); }
__device__ __forceinline__ float log1pexp_(float t  ) { return t < 1e-4f ? t - 0.5f * t * t : __logf(1.0f + t); }
__device__ __forceinline__ float softplusf_(float x) { return x > 15.f ? x : log1pexp_(__expf(x)); }
__device__ __forceinline__ float logsigmoidf_(float x) { return fminf(x, 0.f) - log1pexp_(__expf(-fabsf(x))); }
__device__ __forceinline__ float tanhf_(float x) { const float e = __expf(2.0f * fminf(fmaxf(x, -15.f), 15.f)); return (e - 1.0f) * rcp_(e + 1.0f); }
__device__ __forceinline__ int seq_tok(int i, int d) { return d == 0 ? i : (i < NCTX ? NCTX - 1 - i : SB + NCTX - 1 - i); }
__device__ __forceinline__ int tok_row(int b, int s) { return s < NCTX ? b * NCTX + s : CROWS + b * SEQ + (s - NCTX); }

#define GAS __attribute__((address_space(1)))
struct Params { const float* in[N_IN]; float* out; unsigned char* ws; int lo, hi, li, pad; };
struct Cx { unsigned long long out, ws; int tid, bid, G, pad; };
__device__ __forceinline__ const float* PIN(int i) {
    extern __shared__ __attribute__((aligned(16))) unsigned char lds_raw_[];
    int off = __builtin_amdgcn_readfirstlane(LDS_PTRS + 8 * i); asm volatile("" : "+s"(off));
    const LAS unsigned* t = (const LAS unsigned*)((LAS unsigned char*)lds_raw_ + off);
    const unsigned lo = __builtin_amdgcn_readfirstlane(t[0]), hi = __builtin_amdgcn_readfirstlane(t[1]);
    return (const float*)(const GAS float*)(((unsigned long long)hi << 32) | lo);
}
#define XB_TMO      128
#define XB_XCNT(j)  (256  + 64 * (j))
#define XB_XSUB(j)  (1280 + 64 * (j))
#define XB_XGEN(j)  (2304 + 64 * (j))
#define XB_TOP      3328
#define XB_TOPGEN   3392
#define XCD_BAR_WORDS 3456
#define XB_SPIN_CAP (1u << 18)

__device__ __forceinline__ unsigned xb_ld(unsigned* p)              { return __hip_atomic_load(p, __ATOMIC_RELAXED, __HIP_MEMORY_SCOPE_AGENT); }
__device__ __forceinline__ unsigned xb_add(unsigned* p, unsigned v) { return __hip_atomic_fetch_add(p, v, __ATOMIC_RELAXED, __HIP_MEMORY_SCOPE_AGENT); }
__device__ __forceinline__ unsigned xb_xcc_id() { return (unsigned)__builtin_amdgcn_s_getreg((3 << 11) | 20) & 0xFu; }
#define XB_SPIN(cond, bar) do { unsigned _sp = 0; while (cond) { __builtin_amdgcn_s_sleep(1); \
    if ((++_sp & 255u) == 0u) { if (xb_ld(&(bar)[XB_TMO])) break; if (_sp > XB_SPIN_CAP) { atomicAdd(&(bar)[XB_TMO], 1u); break; } } } } while (0)

struct XcdBarrier {
    unsigned* bar; unsigned x;
    volatile LAS unsigned* st;
};

__device__ __forceinline__ XcdBarrier xcd_barrier_post(unsigned* bar, volatile LAS unsigned* st, const unsigned xb_tid) {
    XcdBarrier b; b.bar = bar; b.x = xb_xcc_id(); b.st = st;
    if (xb_tid == 0) (void)xb_add(&bar[XB_XCNT(b.x)], 1u);
    return b;
}
__device__ __forceinline__ void xcd_barrier_complete(unsigned* bar, unsigned x, unsigned& nloc, unsigned& nx) {
    const unsigned G = gridDim.x * gridDim.y * gridDim.z;
    unsigned sum, cnt, mine, sp = 0u;
    for (;;) {
        sum = 0u; cnt = 0u; mine = 0u;
#pragma unroll
        for (unsigned j = 0; j < 16; ++j) { const unsigned c = xb_ld(&bar[XB_XCNT(j)]); sum += c; cnt += (c > 0u) ? 1u : 0u; mine = (j == x) ? c : mine; }
        if (sum == G) break;
        __builtin_amdgcn_s_sleep(1);
        if ((++sp & 255u) == 0u) { if (xb_ld(&bar[XB_TMO])) break; if (sp > XB_SPIN_CAP) { atomicAdd(&bar[XB_TMO], 1u); break; } }
    }
    nloc = mine > 0u ? mine : 1u; nx = cnt > 0u ? cnt : 1u;
}

__device__ __forceinline__ void xcd_barrier(const XcdBarrier& b, const unsigned xb_tid) {
    asm volatile("s_waitcnt vmcnt(0)" ::: "memory");
    __syncthreads();
    if (xb_tid == 0) {
        unsigned* bar = b.bar;
        __builtin_amdgcn_s_waitcnt(0);
        unsigned nloc = b.st[0], nx = b.st[1];
        if (nloc == 0u) { xcd_barrier_complete(bar, b.x, nloc, nx); b.st[0] = nloc; b.st[1] = nx; }
        const unsigned old = xb_add(&bar[XB_XSUB(b.x)], 1u);
        const unsigned gen = old / nloc;
        if (old + 1u == (gen + 1u) * nloc) {
            __builtin_amdgcn_fence(__ATOMIC_RELEASE, "agent");
            asm volatile("s_waitcnt vmcnt(0)" ::: "memory");
            const unsigned og = xb_add(&bar[XB_TOP], 1u);
            const unsigned tg = og / nx;
            if (og + 1u == (tg + 1u) * nx) xb_add(&bar[XB_TOPGEN], 1u);
            else XB_SPIN(xb_ld(&bar[XB_TOPGEN]) == tg, bar);
            __builtin_amdgcn_fence(__ATOMIC_ACQUIRE, "agent");
            xb_add(&bar[XB_XGEN(b.x)], 1u);
            asm volatile("s_waitcnt vmcnt(0)" ::: "memory");
        } else {
            XB_SPIN(xb_ld(&bar[XB_XGEN(b.x)]) == gen, bar);
            __builtin_amdgcn_fence(__ATOMIC_ACQUIRE, "agent");
            asm volatile("s_waitcnt vmcnt(0)" ::: "memory");
        }
    }
    __syncthreads();
}

namespace pg8 {
constexpr int BM = 256, BK = 64, HALF = 128, HTB = HALF * BK * 2  , STAGE_BYTES = 8 * HTB, NXCD = 8, WGM = 8;
__host__ __device__ __forceinline__ int lds_byte(int r, int c) { const int st = (r >> 4) * 2 + (c >> 5), rr = r & 15, cc = c & 31, ob = rr * 64 + cc * 2; return st * 1024 + (ob ^ (((ob >> 9) & 1) << 5)); }
__host__ __device__ __forceinline__ void stage_rc(int b, int& R, int& C) { const int st = b / 1024, sb = b % 1024, swz = sb ^ (((sb >> 9) & 1) << 5); R = (st >> 1) * 16 + swz / 64; C = (st & 1) * 32 + (swz % 64) / 2; }
__host__ __device__ __forceinline__ int perm32(int rho) { const int n = rho >> 4, i = rho & 15; return 8 * (i >> 2) + 4 * n + (i & 3); }

struct Unit { int pm, pn, e, r0; };

__device__ __forceinline__ unsigned cvt_pk_bf16(float lo, float hi) { unsigned r; asm volatile("v_cvt_pk_bf16_f32 %0, %1, %2" : "=v"(r) : "v"(lo), "v"(hi)); return r; }

template <int K, class Epi, class Sched>
__device__ __forceinline__ void gemm_phase(const int tid, LAS unsigned char* lds, const char* Abase, const Sched& S, const Epi& E) {
    const int wid = __builtin_amdgcn_readfirstlane(tid >> 6), lane = tid & 63, wr = wid >> 2, wc = wid & 3, fr = lane & 15, fq = lane >> 4;
    const int nt = K / BK;
    constexpr bool DN = Sched::DENSE;
    int RA[2], CA[2]; unsigned voffB[2], voffA[2];
#pragma unroll
    for (int i = 0; i < 2; ++i) { int R, C; stage_rc(tid * 16 + i * 8192, R, C); const int Rb = Epi::PERM ? ((R & ~31) + perm32(R & 31)) : R;
        RA[i] = R; CA[i] = C; voffB[i] = (unsigned)(Rb * K + C) * 2u; voffA[i] = (unsigned)(R * K + C) * 2u; }
    const size_t kstep = (size_t)(BK * 2);
    const size_t hstep = (size_t)HALF * K * 2;
    const size_t tstep = 2 * hstep;
    const unsigned ldsw = (unsigned)wid * 1024u;
    const int aoff = lds_byte(wr * 64 + fr, fq * 8), boff = lds_byte(wc * 32 + fr, fq * 8);
#define PG8_SA(b, h) (((b) * 2 + (h)) * HTB)
#define PG8_SB(b, h) ((4 + (b) * 2 + (h)) * HTB)
#define PG8_STAGE(bufoff, gbase, voff) do { _Pragma("unroll") for (int _i = 0; _i < 2; ++_i) \
        __builtin_amdgcn_global_load_lds((const __attribute__((address_space(1))) unsigned*)((const __attribute__((address_space(1))) char*)(gbase) + (voff)[_i]), (LAS unsigned*)(lds + (bufoff) + ldsw + _i * 8192), 16, 0, 0); } while (0)
#define PG8_LDA(dst, b, h) do { _Pragma("unroll") for (int m = 0; m < 4; ++m) _Pragma("unroll") for (int k = 0; k < 2; ++k) dst[m][k] = *(const LAS bf16x8*)(lds + PG8_SA(b, h) + aoff + m * 2048 + k * 1024); } while (0)
#define PG8_LDB(dst, b, h) do { _Pragma("unroll") for (int n = 0; n < 2; ++n) _Pragma("unroll") for (int k = 0; k < 2; ++k) dst[n][k] = *(const LAS bf16x8*)(lds + PG8_SB(b, h) + boff + n * 2048 + k * 1024); } while (0)
#define PG8_MMA(ai, bj, At, Bt) do { __builtin_amdgcn_s_setprio(1); _Pragma("unroll") for (int m = 0; m < 4; ++m) _Pragma("unroll") for (int n = 0; n < 2; ++n) _Pragma("unroll") for (int k = 0; k < 2; ++k) \
        acc[ai][bj][m][n] = __builtin_amdgcn_mfma_f32_16x16x32_bf16(Bt[n][k], At[m][k], acc[ai][bj][m][n], 0, 0, 0); __builtin_amdgcn_s_setprio(0); } while (0)
#define PG8_WAIT_V(n) asm volatile("s_waitcnt vmcnt(" #n ")" ::: "memory")
#define PG8_WAIT_L(n) asm volatile("s_waitcnt lgkmcnt(" #n ")" ::: "memory")
#define PG8_BAR __builtin_amdgcn_s_barrier()
#define PG8_SCHED __builtin_amdgcn_sched_barrier(0)
#define PG8_AOFF(dst, u) do { _Pragma("unroll") for (int _h = 0; _h < 2; ++_h) _Pragma("unroll") for (int _i = 0; _i < 2; ++_i) \
        dst[_h][_i] = ((unsigned)S.a_row(u, _h * HALF + RA[_i]) * (unsigned)K + (unsigned)CA[_i]) * 2u; } while (0)
    Unit cur, nxt; int ui = 0;
    if (!S.next(0, cur)) return;
    f32x4 acc[2][2][4][2];
#pragma unroll
    for (int a = 0; a < 2; ++a)
#pragma unroll
        for (int b = 0; b < 2; ++b)
#pragma unroll
            for (int m = 0; m < 4; ++m)
#pragma unroll
                for (int n = 0; n < 2; ++n) acc[a][b][m][n] = (f32x4){0.f, 0.f, 0.f, 0.f};
    bf16x8 At[4][2], B0[2][2], B1[2][2];
    unsigned cO[2][2], nO[2][2];
    const char* cA = Abase; const char* nA = Abase;
    if constexpr (DN) cA = Abase + (size_t)S.a_row(cur, 0) * K * 2; else PG8_AOFF(cO, cur);
    const char* cB = S.b_ptr(cur);
#define PG8_STA(bufoff, h_, kb_, nx_) do { if constexpr (DN) PG8_STAGE(bufoff, ((nx_) ? nA : cA) + (h_) * hstep + (kb_), voffA); else PG8_STAGE(bufoff, Abase + (kb_), ((nx_) ? nO : cO)[h_]); } while (0)
    PG8_STAGE(PG8_SB(0, 0), cB, voffB); PG8_SCHED; PG8_STA(PG8_SA(0, 0), 0, 0, false); PG8_SCHED; PG8_STAGE(PG8_SB(0, 1), cB + hstep, voffB); PG8_SCHED; PG8_STA(PG8_SA(0, 1), 1, 0, false); PG8_SCHED;
    if (wr == 1) PG8_BAR;
    PG8_WAIT_V(4); PG8_BAR;
    PG8_STAGE(PG8_SB(1, 0), cB + kstep, voffB); PG8_SCHED; PG8_STA(PG8_SA(1, 0), 0, kstep, false); PG8_SCHED; PG8_STAGE(PG8_SB(1, 1), cB + hstep + kstep, voffB); PG8_SCHED;
    PG8_WAIT_V(6); PG8_BAR;
    for (;;) {
        const bool has_next = S.next(ui + 1, nxt);
        const char* nB = cB; nA = cA;
        if (has_next) { if constexpr (DN) nA = Abase + (size_t)S.a_row(nxt, 0) * K * 2; else PG8_AOFF(nO, nxt); nB = S.b_ptr(nxt); }
        else if constexpr (!DN) {
#pragma unroll
            for (int h = 0; h < 2; ++h)
#pragma unroll
                for (int i = 0; i < 2; ++i) nO[h][i] = cO[h][i]; }
        for (int t = 0; t < nt; t += 2) {
            const bool last = (t == nt - 2);
            const size_t k1 = (size_t)(t + 1) * kstep, k2 = last ? 0 : (size_t)(t + 2) * kstep, k3 = k2 + kstep;
            const char* b2 = last ? nB : cB + (size_t)(t + 2) * kstep; const char* b3 = b2 + kstep;
            PG8_LDB(B0, 0, 0); PG8_SCHED; PG8_LDA(At, 0, 0); PG8_STA(PG8_SA(1, 1), 1, k1, false);
            PG8_WAIT_L(8); PG8_BAR; PG8_WAIT_L(0); PG8_MMA(0, 0, At, B0); PG8_BAR; PG8_SCHED;
            PG8_LDB(B1, 0, 1); PG8_STAGE(PG8_SB(0, 0), b2, voffB);
            PG8_BAR; PG8_WAIT_L(0); PG8_MMA(0, 1, At, B1); PG8_BAR;
            PG8_LDA(At, 0, 1); PG8_STA(PG8_SA(0, 0), 0, k2, last);
            PG8_BAR; PG8_WAIT_L(0); PG8_MMA(1, 0, At, B0); PG8_BAR; PG8_SCHED;
            PG8_STAGE(PG8_SB(0, 1), b2 + hstep, voffB);
            PG8_WAIT_V(6); PG8_BAR; PG8_MMA(1, 1, At, B1); PG8_BAR;
            PG8_LDB(B0, 1, 0); PG8_SCHED; PG8_LDA(At, 1, 0); PG8_STA(PG8_SA(0, 1), 1, k2, last);
            PG8_WAIT_L(8); PG8_BAR; PG8_WAIT_L(0); PG8_MMA(0, 0, At, B0); PG8_BAR; PG8_SCHED;
            PG8_LDB(B1, 1, 1); PG8_STAGE(PG8_SB(1, 0), b3, voffB);
            PG8_BAR; PG8_WAIT_L(0); PG8_MMA(0, 1, At, B1); PG8_BAR;
            PG8_LDA(At, 1, 1); PG8_STA(PG8_SA(1, 0), 0, k3, last);
            PG8_BAR; PG8_WAIT_L(0); PG8_MMA(1, 0, At, B0); PG8_BAR; PG8_SCHED;
            PG8_STAGE(PG8_SB(1, 1), b3 + hstep, voffB);
            PG8_WAIT_V(6); PG8_BAR; PG8_MMA(1, 1, At, B1); PG8_BAR;
        }
        E(acc, cur, wid);
        if (!has_next) break;
#pragma unroll
        for (int a = 0; a < 2; ++a)
#pragma unroll
            for (int b = 0; b < 2; ++b)
#pragma unroll
                for (int m = 0; m < 4; ++m)
#pragma unroll
                    for (int n = 0; n < 2; ++n) acc[a][b][m][n] = (f32x4){0.f, 0.f, 0.f, 0.f};
        cur = nxt; cB = nB; cA = nA; ++ui;
        if constexpr (!DN) {
#pragma unroll
        for (int h = 0; h < 2; ++h)
#pragma unroll
            for (int i = 0; i < 2; ++i) cO[h][i] = nO[h][i]; }
    }
    PG8_WAIT_V(0);
    if (wr == 0) PG8_BAR;
    PG8_BAR;
#undef PG8_SA
#undef PG8_SB
#undef PG8_STAGE
#undef PG8_LDA
#undef PG8_LDB
#undef PG8_MMA
#undef PG8_WAIT_V
#undef PG8_WAIT_L
#undef PG8_BAR
#undef PG8_SCHED
#undef PG8_AOFF
#undef PG8_STA
}
}
struct DenseSched {
    static constexpr bool DENSE = true;
    int nM, nN, nwg, G, c, K, pm0, gap_at = 1 << 20, gap_len = 0; const char* Bt;
    __device__ __forceinline__ void init(int M, int N, int K_, const bf16_t* Bt_, int G_, int c_, int pm0_ = 0) { nM = M / 256; nN = N / 256; nwg = nM * nN; G = G_; c = c_; K = K_; pm0 = pm0_; Bt = (const char*)Bt_; }
    __device__ __forceinline__ bool next(int i, pg8::Unit& u) const {
        const long L = (long)i * G + c; if (L >= nwg) return false;
        int wgid = (int)L; { const int q = nwg / 8, r = nwg % 8, xcd = wgid % 8, off = wgid / 8; wgid = (xcd < r ? xcd * (q + 1) : r * (q + 1) + (xcd - r) * q) + off; }
        const int nig = 8 * nN, gid = wgid / nig, fm = gid * 8, gsz = (nM - fm) < 8 ? (nM - fm) : 8;
        u.pm = pm0 + fm + ((wgid % nig) % gsz); if (u.pm >= gap_at) u.pm += gap_len; u.pn = (wgid % nig) / gsz; u.e = 0; u.r0 = 0; return true;
    }
    __device__ __forceinline__ int a_row(const pg8::Unit& u, int r) const { return u.pm * 256 + r; }
    __device__ __forceinline__ const char* b_ptr(const pg8::Unit& u) const { return Bt + (size_t)u.pn * 256 * K * 2; }
};
struct HostSched {
    static constexpr bool DENSE = true;
    int n, c, K, nN, m0, cnt0, m1; const char* Bt;
    __device__ __forceinline__ bool next(int i, pg8::Unit& u) const {
        if (i > 0 || c < 0 || c >= n) return false;
        const int mi = c / nN; u.pm = mi < cnt0 ? m0 + mi : m1 + (mi - cnt0); u.pn = c % nN; u.e = 0; u.r0 = 0; return true;
    }
    __device__ __forceinline__ int a_row(const pg8::Unit& u, int r) const { return u.pm * 256 + r; }
    __device__ __forceinline__ const char* b_ptr(const pg8::Unit& u) const { return Bt + (size_t)u.pn * 256 * K * 2; }
};
template <bool GATHER> struct MoeSched {
    static constexpr bool DENSE = !GATHER;
    const LAS int* tstart; const LAS int* cnt; int nN, G, c, K, row_lo; const int* ltok; const char* Bt; size_t bstride;
    __device__ __forceinline__ bool next(int i, pg8::Unit& u) const {
        const long L = (long)i * G + c; const int ntile = __builtin_amdgcn_readfirstlane(tstart[NE1]); if (L >= (long)ntile * nN) return false;
        const int tile = (int)(L / nN); u.pn = (int)(L % nN);
        int e = 0;
#pragma unroll 1
        for (int step = 64; step >= 1; step >>= 1) { const int e2 = e + step; if (e2 <= NE && tstart[e2] <= tile) e = e2; }
        e = __builtin_amdgcn_readfirstlane(e); u.e = e; u.pm = __builtin_amdgcn_readfirstlane(tile); u.pn = __builtin_amdgcn_readfirstlane(u.pn); u.r0 = __builtin_amdgcn_readfirstlane((tile - tstart[e]) * 256); return true;
    }
    __device__ __forceinline__ int a_row(const pg8::Unit& u, int r) const {
        if (!GATHER) return u.pm * 256 + r;
        const int ri = u.r0 + r;
        if (u.e == NE) return ri < cnt[NE] ? row_lo + ri : row_lo;
        return ri < cnt[u.e] ? ltok[(size_t)u.e * ROWS + ri] : row_lo;
    }
    __device__ __forceinline__ const char* b_ptr(const pg8::Unit& u) const { return Bt + (size_t)u.e * bstride + (size_t)u.pn * 256 * K * 2; }
};

struct EpiProj {
    static constexpr bool PERM = true;
    bf16_t* O; int ldc;
    __device__ __forceinline__ void operator()(const f32x4 (&acc)[2][2][4][2], const pg8::Unit& u, const int wid) const {
        const int lane_ = lane_id_asm(), fr = lane_ & 15, fq = lane_ >> 4, wr = wid >> 2, wc = wid & 3;
        const int row0 = u.pm * 256 + wr * 64 + fr, col0 = u.pn * 256 + wc * 32 + 8 * fq;
#pragma unroll
        for (int ai = 0; ai < 2; ++ai)
#pragma unroll
            for (int m = 0; m < 4; ++m) { bf16_t* rowp = O + (size_t)(row0 + ai * 128 + m * 16) * ldc + col0;
#pragma unroll
                for (int bj = 0; bj < 2; ++bj) { const f32x4 v0 = acc[ai][bj][m][0], v1 = acc[ai][bj][m][1];
                    u32x4 w; w.x = pg8::cvt_pk_bf16(v0[0], v0[1]); w.y = pg8::cvt_pk_bf16(v0[2], v0[3]); w.z = pg8::cvt_pk_bf16(v1[0], v1[1]); w.w = pg8::cvt_pk_bf16(v1[2], v1[3]);
                    *(u32x4*)(rowp + bj * 128) = w; } }
    }
};
struct EpiRes {
    static constexpr bool PERM = false;
    const float* xsrc; const float* csrc; float* xdst; float* cdst; const float* gate;
    __device__ __forceinline__ void operator()(const f32x4 (&acc)[2][2][4][2], const pg8::Unit& u, const int wid) const {
        const int lane_ = lane_id_asm(), fr = lane_ & 15, fq = lane_ >> 4, wr = wid >> 2, wc = wid & 3;
        const int col0 = u.pn * 256 + wc * 32 + 4 * fq;
        const bool isc = u.pm < 4; const int sel = isc ? 4 : (u.pm - 4) >> 5;
        const float* src = isc ? csrc + (size_t)u.pm * 256 * D : xsrc + (size_t)(u.pm - 4) * 256 * D;
        float* dst = isc ? cdst + (size_t)u.pm * 256 * D : xdst + (size_t)(u.pm - 4) * 256 * D;
        f32x4 gv[2][2];
#pragma unroll
        for (int bj = 0; bj < 2; ++bj)
#pragma unroll
            for (int n = 0; n < 2; ++n) gv[bj][n] = *(const f32x4*)(gate + sel * 6144 + col0 + bj * 128 + n * 16);
#pragma unroll
        for (int ai = 0; ai < 2; ++ai)
#pragma unroll
            for (int m = 0; m < 4; ++m) { const size_t off = (size_t)(ai * 128 + wr * 64 + m * 16 + fr) * D + col0;
#pragma unroll
                for (int bj = 0; bj < 2; ++bj)
#pragma unroll
                    for (int n = 0; n < 2; ++n) { const f32x4 s = *(const f32x4*)(src + off + bj * 128 + n * 16); *(f32x4*)(dst + off + bj * 128 + n * 16) = s + gv[bj][n] * acc[ai][bj][m][n]; }
                asm volatile("" ::: "memory"); }
    }
};
struct EpiGU {
    static constexpr bool PERM = false;
    bf16_t* H;
    __device__ __forceinline__ void operator()(const f32x4 (&acc)[2][2][4][2], const pg8::Unit& u, const int wid) const {
        const int lane_ = lane_id_asm(), fr = lane_ & 15, fq = lane_ >> 4, wr = wid >> 2, wc = wid & 3;
        const int row0 = u.pm * 256 + wr * 64 + fr;
#pragma unroll
        for (int ai = 0; ai < 2; ++ai)
#pragma unroll
            for (int m = 0; m < 4; ++m) { bf16_t* rowp = H + (size_t)(row0 + ai * 128 + m * 16) * EH + 4 * fq;
#pragma unroll
                for (int bj = 0; bj < 2; ++bj) { const f32x4 g = acc[ai][bj][m][0], up = acc[ai][bj][m][1]; float h[4];
#pragma unroll
                    for (int j = 0; j < 4; ++j) h[j] = g[j] * rcp_(1.0f + __expf(-g[j])) * up[j];
                    u32x2 w; w.x = pg8::cvt_pk_bf16(h[0], h[1]); w.y = pg8::cvt_pk_bf16(h[2], h[3]);
                    *(u32x2*)(rowp + (u.pn * 256 + bj * 128 + wc * 32) / 2) = w; } }
    }
};
struct EpiY {
    static constexpr bool PERM = true;
    bf16_t* Y;
    __device__ __forceinline__ void operator()(const f32x4 (&acc)[2][2][4][2], const pg8::Unit& u, const int wid) const {
        const int lane_ = lane_id_asm(), fr = lane_ & 15, fq = lane_ >> 4, wr = wid >> 2, wc = wid & 3;
        const int row0 = u.pm * 256 + wr * 64 + fr, col0 = u.pn * 256 + wc * 32 + 8 * fq;
#pragma unroll
        for (int ai = 0; ai < 2; ++ai)
#pragma unroll
            for (int m = 0; m < 4; ++m) { bf16_t* rowp = Y + (size_t)(row0 + ai * 128 + m * 16) * 512 + col0;
#pragma unroll
                for (int bj = 0; bj < 2; ++bj) { const f32x4 v0 = acc[ai][bj][m][0], v1 = acc[ai][bj][m][1];
                    u32x4 w; w.x = pg8::cvt_pk_bf16(v0[0], v0[1]); w.y = pg8::cvt_pk_bf16(v0[2], v0[3]); w.z = pg8::cvt_pk_bf16(v1[0], v1[1]); w.w = pg8::cvt_pk_bf16(v1[2], v1[3]);
                    *(u32x4*)(rowp + bj * 128) = w; } }
    }
};
#define WSP(T, off) ((T*)(GAS T*)(p.ws + (unsigned long long)(off)))
#define POUT ((float*)(GAS float*)p.out)

constexpr int CONV_A_UNITS = 2048 + 512 + 64 + 8 + 12;
struct ConvDesc { const float* src; bf16_t* dst; int ldsrc, lddst, k0, n0, mode, nvalid; };
struct ConvDescA { int dummy;
    __device__ __forceinline__ ConvDesc operator()(const Cx& p, int u) const { ConvDesc c;
        if (u < 2048) { const int l = u >> 10, r = u & 1023; c.src = PIN(I_WIN) + (size_t)l * D * INW; c.ldsrc = INW; c.k0 = (r >> 6) * 64; c.n0 = (r & 63) * 64; c.nvalid = INW; c.dst = WSP(bf16_t, WS_WIN) + (size_t)l * NPROJ * D; c.lddst = D; c.mode = 0; }
        else if (u < 2560) { const int v = u - 2048, l = v >> 8, r = v & 255; c.src = PIN(I_WOUT) + (size_t)l * D * D; c.ldsrc = D; c.k0 = (r >> 4) * 64; c.n0 = (r & 15) * 64; c.nvalid = D; c.dst = WSP(bf16_t, WS_WOUT) + (size_t)l * D * D; c.lddst = D; c.mode = 0; }
        else if (u >= 2632) { const int v = u - 2632, m = v >> 2, r = v & 3;
            c.src = m < NL ? PIN(I_RW_W2) + (size_t)m * 64 * 256 : PIN(I_RW_AW2); c.ldsrc = 256; c.k0 = 0; c.n0 = r * 64; c.nvalid = 256; c.dst = WSP(bf16_t, WS_RWLR) + (size_t)m * 256 * 64; c.lddst = 64; c.mode = 0; }
        else if (u >= 2624) { const int v = u - 2624, l = v >> 2, r = v & 3;
            c.src = PIN(I_RW_GW2) + (size_t)l * 64 * 256; c.ldsrc = 256; c.k0 = 0; c.n0 = r * 64; c.nvalid = 256; c.dst = WSP(bf16_t, WS_RWGW) + (size_t)l * 256 * 64; c.lddst = 64; c.mode = 0; }
        else { const int v = u - 2560, l = v >> 5, lo = (v >> 4) & 1, r = v & 15;
            c.src = PIN(I_ROUT_W) + (size_t)l * D * NE; c.ldsrc = NE; c.k0 = r * 64; c.n0 = 0; c.nvalid = NE; c.dst = WSP(bf16_t, WS_ROUT) + (size_t)(l * 2 + lo) * NE * D; c.lddst = D; c.mode = lo ? 3 : 0; }
        return c; } };
constexpr int CONV_E_UNITS = NE1 * 192;
struct ConvDescE { int l;
    __device__ __forceinline__ ConvDesc operator()(const Cx& p, int u) const { ConvDesc c; const int e = u / 192, r = u % 192; c.nvalid = 1 << 30;
        if (r < 128) { const int up = r >> 6, q = r & 63;
            c.src = e < NE ? PIN(up ? I_EXP_U : I_EXP_G) + ((size_t)l * NE + e) * D * EH : PIN(up ? I_SH_U : I_SH_G) + (size_t)l * D * EH;
            c.ldsrc = EH; c.k0 = (q >> 2) * 64; c.n0 = (q & 3) * 64; c.dst = WSP(bf16_t, WS_EXPGU) + (size_t)e * 512 * D; c.lddst = D; c.mode = 1 + up; }
        else { const int q = r - 128;
            c.src = e < NE ? PIN(I_EXP_D) + ((size_t)l * NE + e) * EH * D : PIN(I_SH_D) + (size_t)l * EH * D;
            c.ldsrc = D; c.k0 = (q >> 4) * 64; c.n0 = (q & 15) * 64; c.dst = WSP(bf16_t, WS_EXPD) + (size_t)e * D * EH; c.lddst = EH; c.mode = 0; }
        return c; } };
template <class DescF> __device__ __forceinline__ void conv_run(const Cx& p, LAS float* tl, int total, const DescF& df) {
    const int t = p.tid; int u = p.bid; if (u >= total) return;
    float v[8]; ConvDesc c = df(p, u);
#define CONV_LD(cc) _Pragma("unroll") for (int j = 0; j < 8; ++j) { const int idx = t + NTHR * j, k = idx >> 6, n = idx & 63; v[j] = (cc).n0 + n < (cc).nvalid ? (cc).src[(size_t)((cc).k0 + k) * (cc).ldsrc + (cc).n0 + n] : 0.f; }
    CONV_LD(c)
    for (;;) {
#pragma unroll
        for (int j = 0; j < 8; ++j) { const int idx = t + NTHR * j; tl[(idx >> 6) * 65 + (idx & 63)] = v[j]; }
        __syncthreads();
        const int un = u + p.G; const bool more = un < total; const ConvDesc cn = df(p, more ? un : u);
        if (more) { CONV_LD(cn) }
#pragma unroll
        for (int j = 0; j < 4; ++j) { const int pi = t + NTHR * j, n = pi >> 5, k = (pi & 31) * 2; const int nn = c.n0 + n;
            const int row = (c.mode == 0 || c.mode == 3) ? nn : ((nn >> 4) * 32 + (nn & 15) + (c.mode == 2 ? 16 : 0));
            float v0 = tl[k * 65 + n], v1 = tl[(k + 1) * 65 + n];
            if (c.mode == 3) { v0 -= bf2f((bf16_t)f2bf(v0)); v1 -= bf2f((bf16_t)f2bf(v1)); }
            *(unsigned*)(c.dst + (size_t)row * c.lddst + c.k0 + k) = pk2(v0, v1); }
        __syncthreads();
        if (!more) break;
        c = cn; u = un;
    }
#undef CONV_LD
}
__device__ __forceinline__ void phase_mod(const Cx& p, LAS unsigned char* lds) {
    LAS float* sv = (LAS float*)lds; LAS float* red = sv + 5 * D;
    const int tid = p.tid;
    if (p.bid >= 192) return;
    for (int i = tid; i < 5 * D; i += NTHR) { const int j = i >> 10, k = i & 1023; const float c = j < 4 ? PIN(I_C)[j * D + k] : PIN(I_CCTX)[k]; sv[i] = siluf_(c); }
    __syncthreads();
    for (int u = p.bid; u < 192; u += p.G) {
        const int l = u / 96, cb = u % 96, kg = tid >> 6, cl = tid & 63;
        const float* w = PIN(I_WMOD) + (size_t)l * D * 6144 + cb * 64 + cl;
        float a0 = 0.f, a1 = 0.f, a2 = 0.f, a3 = 0.f, a4 = 0.f;
#pragma unroll 32
        for (int kk = 0; kk < 128; ++kk) { const int k = kg * 128 + kk; const float wv = w[(size_t)k * 6144];
            a0 += sv[k] * wv; a1 += sv[D + k] * wv; a2 += sv[2 * D + k] * wv; a3 += sv[3 * D + k] * wv; a4 += sv[4 * D + k] * wv; }
        red[(kg * 5 + 0) * 64 + cl] = a0; red[(kg * 5 + 1) * 64 + cl] = a1; red[(kg * 5 + 2) * 64 + cl] = a2; red[(kg * 5 + 3) * 64 + cl] = a3; red[(kg * 5 + 4) * 64 + cl] = a4;
        __syncthreads();
        if (tid < 320) { const int j = tid >> 6; float s = 0.f;
#pragma unroll
            for (int g = 0; g < 8; ++g) s += red[(g * 5 + j) * 64 + cl];
            WSP(float, WS_MOD)[((size_t)l * 5 + j) * 6144 + cb * 64 + cl] = s + PIN(I_BMOD)[l * 6144 + cb * 64 + cl]; }
        __syncthreads();
    }
}
__device__ __forceinline__ const float* res_row(const Cx& p, int layer_src0, int r) {
    if (r < CROWS) return (layer_src0 ? PIN(I_CTX) : (const float*)WSP(float, WS_CTXRES)) + (size_t)r * D;
    return (layer_src0 ? PIN(I_X) : (const float*)POUT) + (size_t)(r - CROWS) * D;
}
__device__ __forceinline__ int row_sel(int r) { return r < CROWS ? 4 : (r - CROWS) >> 13; }

__device__ __forceinline__ void norm_ld(const float* src, f32x4 (&v)[4], int lane) {
#pragma unroll
    for (int i = 0; i < 4; ++i) v[i] = *(const f32x4*)(src + 256 * i + 4 * lane);
}
__device__ __forceinline__ void norm_fin(const f32x4 (&v)[4], const float* g, const float* shift, const float* scale, bf16_t* dst, const bool tolds, LAS bf16_t* ldst, LAS bf16_t* ldlo, int lane) {
    float ss = 0.f;
#pragma unroll
    for (int i = 0; i < 4; ++i) ss += v[i][0] * v[i][0] + v[i][1] * v[i][1] + v[i][2] * v[i][2] + v[i][3] * v[i][3];
    ss = wsum(ss); const float rstd = rsq_(ss * (1.0f / D) + 1e-6f);
#pragma unroll
    for (int i = 0; i < 4; ++i) { const int col = 256 * i + 4 * lane; const f32x4 gv = *(const f32x4*)(g + col), sh = *(const f32x4*)(shift + col), sc = *(const f32x4*)(scale + col);
        const f32x4 y = v[i] * rstd * gv * (sc + 1.0f) + sh; u32x2 w; w.x = pk2(y[0], y[1]); w.y = pk2(y[2], y[3]);
        *(u32x2*)(dst + col) = w;
        if (tolds) { *(LAS u32x2*)(ldst + col) = w; u32x2 wl;
            wl.x = pk2(y[0] - __uint_as_float(w.x << 16), y[1] - __uint_as_float(w.x & 0xffff0000u)); wl.y = pk2(y[2] - __uint_as_float(w.y << 16), y[3] - __uint_as_float(w.y & 0xffff0000u));
            *(LAS u32x2*)(ldlo + col) = wl; } }
}
struct ModC { int s; f32x4 A[4], B[4];
    __device__ __forceinline__ void load(const float* g, const float* shift, const float* scale, int s_, int lane) { s = s_;
#pragma unroll
        for (int i = 0; i < 4; ++i) { const int col = 256 * i + 4 * lane; A[i] = *(const f32x4*)(g + col) * (*(const f32x4*)(scale + col) + 1.0f); B[i] = *(const f32x4*)(shift + col); } } };
__device__ __forceinline__ void norm_fin2(const f32x4 (&v)[4], const ModC& mc, bf16_t* dst, const bool tolds, LAS bf16_t* ldst, LAS bf16_t* ldlo, int lane) {
    float ss = 0.f;
#pragma unroll
    for (int i = 0; i < 4; ++i) ss += v[i][0] * v[i][0] + v[i][1] * v[i][1] + v[i][2] * v[i][2] + v[i][3] * v[i][3];
    ss = wsum(ss); const float rstd = rsq_(ss * (1.0f / D) + 1e-6f);
#pragma unroll
    for (int i = 0; i < 4; ++i) { const int col = 256 * i + 4 * lane;
        const f32x4 y = v[i] * rstd * mc.A[i] + mc.B[i]; u32x2 w; w.x = pk2(y[0], y[1]); w.y = pk2(y[2], y[3]);
        *(u32x2*)(dst + col) = w;
        if (tolds) { *(LAS u32x2*)(ldst + col) = w; u32x2 wl;
            wl.x = pk2(y[0] - __uint_as_float(w.x << 16), y[1] - __uint_as_float(w.x & 0xffff0000u)); wl.y = pk2(y[2] - __uint_as_float(w.y << 16), y[3] - __uint_as_float(w.y & 0xffff0000u));
            *(LAS u32x2*)(ldlo + col) = wl; } }
}
__device__ __forceinline__ void phase_norm1(const Cx& p, int layer) {
    const int lane = p.tid & 63, wave = p.tid >> 6;
    const float* mod = WSP(float, WS_MOD) + (size_t)layer * 5 * 6144; const float* g = PIN(I_N1G) + layer * D; bf16_t* hb = WSP(bf16_t, WS_HBUF);
    ModC mc; mc.s = -1; f32x4 n0[4], n1[4];
    int r = p.bid * 16 + wave * 2;
    if (r < ROWS) { norm_ld(res_row(p, layer == 0, r), n0, lane); norm_ld(res_row(p, layer == 0, r + 1), n1, lane); }
    for (; r < ROWS; r += p.G * 16) { f32x4 v0[4], v1[4];
#pragma unroll
        for (int i = 0; i < 4; ++i) { v0[i] = n0[i]; v1[i] = n1[i]; }
        const int rn = r + p.G * 16; if (rn < ROWS) { norm_ld(res_row(p, layer == 0, rn), n0, lane); norm_ld(res_row(p, layer == 0, rn + 1), n1, lane); }
        const int s = row_sel(r); if (s != mc.s) mc.load(g, mod + s * 6144 + 0, mod + s * 6144 + 1024, s, lane);
        norm_fin2(v0, mc, hb + (size_t)r * D, false, (LAS bf16_t*)0, (LAS bf16_t*)0, lane);
        norm_fin2(v1, mc, hb + (size_t)(r + 1) * D, false, (LAS bf16_t*)0, (LAS bf16_t*)0, lane); }
}
__device__ __forceinline__ float sum8_(float v) { v += DPPF(v, 0xB1); v += DPPF(v, 0x4E); v += DPPF(v, 0x141); return v; }
__device__ __forceinline__ float sum16_(float v) { v = sum8_(v); v += DPPF(v, 0x140); return v; }
__device__ __forceinline__ void bf8_to_f(const u32x4 w, float (&f)[8]) {
#pragma unroll
    for (int q = 0; q < 4; ++q) { f[2 * q] = __uint_as_float(w[q] << 16); f[2 * q + 1] = __uint_as_float(w[q] & 0xffff0000u); } }
__device__ __forceinline__ void phase_prep(const Cx& p, LAS unsigned char* lds, int layer, int b) {
    const int lane = p.tid & 63, wave = __builtin_amdgcn_readfirstlane(p.tid >> 6);
    const bf16_t* proj = WSP(bf16_t, WS_PROJ);
    const int e0 = p.bid * NTHR + p.tid, e1 = e0 + p.G * NTHR; bf16_t sq0 = 0, sq1 = 0;
#define SCAL_COL(q) ((q) < 8 ? PC_DF + (q) : (q) < 16 ? PD_BF + ((q) - 8) : PD_AF + ((q) - 16))
    if (e0 < SB * 24) sq0 = proj[(size_t)tok_row(b, e0 / 24) * NPROJ + SCAL_COL(e0 % 24)];
    if (e1 < SB * 24) sq1 = proj[(size_t)tok_row(b, e1 / 24) * NPROJ + SCAL_COL(e1 % 24)];
    if (p.bid < SB / 33) {
        constexpr int ATS = 208;
        LAS unsigned char* WWt = lds; LAS unsigned char* AWt = lds + 256 * 144; LAS unsigned char* At = lds + 2 * 256 * 144;
        { const bf16_t* w2c = WSP(bf16_t, WS_RWLR) + (size_t)layer * 256 * 64; const bf16_t* awc = WSP(bf16_t, WS_RWLR) + (size_t)NL * 256 * 64;
#pragma unroll
          for (int q = 0; q < 4; ++q) { const int e = p.tid + NTHR * q, n = e >> 3, ch = e & 7;
              *(LAS u32x4*)(WWt + n * 144 + ch * 16) = *(const u32x4*)(w2c + n * 64 + ch * 8); *(LAS u32x4*)(AWt + n * 144 + ch * 16) = *(const u32x4*)(awc + n * 64 + ch * 8); } }
        const int h = wave & 3, half = wave >> 2, fr = lane & 15, fq = lane >> 4;
        float a0c[4], w0fc[4], w0bc[4], kkc[4], kac[4];
#pragma unroll
        for (int nt = 0; nt < 4; ++nt) { const int c = 64 * h + 16 * nt + fr; a0c[nt] = PIN(I_RW_A0)[layer * 256 + c]; w0fc[nt] = PIN(I_RW_W0)[(layer * 2 + 0) * 256 + c]; w0bc[nt] = PIN(I_RW_W0)[(layer * 2 + 1) * 256 + c];
            kkc[nt] = PIN(I_RW_KK)[layer * 256 + c]; kac[nt] = PIN(I_RW_KA)[layer * 256 + c]; }
        for (int u = p.bid; u < SB / 33; u += p.G) {
            if (p.tid < 33 * 12) { const int tk = p.tid / 12, ch = p.tid % 12; u32x4 w = *(const u32x4*)(proj + (size_t)tok_row(b, u * 33 + tk) * NPROJ + PB_WF + 8 * ch);
                if (ch < 8) {
#pragma unroll
                    for (int q = 0; q < 4; ++q) w[q] = pk2(tanhf_(__uint_as_float(w[q] << 16)), tanhf_(__uint_as_float(w[q] & 0xffff0000u))); }
                *(LAS u32x4*)(At + tk * ATS + ch * 16) = w; }
            bf16_t kvA[4][4], kvB[4];
#pragma unroll
            for (int j = 0; j < 4; ++j) { const bf16_t* pr = proj + (size_t)tok_row(b, u * 33 + 16 * half + 4 * fq + j) * NPROJ + PB_K + 64 * h + fr;
#pragma unroll
                for (int nt = 0; nt < 4; ++nt) kvA[nt][j] = pr[16 * nt]; }
            { const bf16_t* pr = proj + (size_t)tok_row(b, u * 33 + 32) * NPROJ + PB_K + 64 * h + fr;
#pragma unroll
              for (int nt = 0; nt < 4; ++nt) kvB[nt] = pr[16 * nt]; }
            __syncthreads();
#pragma unroll
            for (int pass = 0; pass < 2; ++pass) { if (pass == 1 && half != 0) break;
                const int mt = pass ? 2 : half; f32x4 sa[4], sf[4], sb[4];
                const bf16x8 awf = *(const LAS bf16x8*)(At + (16 * mt + fr) * ATS + fq * 16), awb = *(const LAS bf16x8*)(At + (16 * mt + fr) * ATS + 64 + fq * 16), aa = *(const LAS bf16x8*)(At + (16 * mt + fr) * ATS + 128 + fq * 16);
#pragma unroll
                for (int nt = 0; nt < 4; ++nt) { const int n = 64 * h + 16 * nt + fr; const f32x4 z = (f32x4){0.f, 0.f, 0.f, 0.f};
                    sf[nt] = __builtin_amdgcn_mfma_f32_16x16x32_bf16(awf, *(const LAS bf16x8*)(WWt + n * 144 + fq * 16), z, 0, 0, 0);
                    sb[nt] = __builtin_amdgcn_mfma_f32_16x16x32_bf16(awb, *(const LAS bf16x8*)(WWt + n * 144 + 64 + fq * 16), z, 0, 0, 0);
                    sa[nt] = __builtin_amdgcn_mfma_f32_16x16x32_bf16(aa, *(const LAS bf16x8*)(AWt + n * 144 + layer * 64 + fq * 16), z, 0, 0, 0); }
#pragma unroll
                for (int j = 0; j < 4; ++j) { if (pass == 1 && j > 0) break;
                    const int tk = 16 * mt + 4 * fq + j; const bool valid = tk < 33; const int s = u * 33 + tk;
                    float kv[4], kr[4], ssq = 0.f;
#pragma unroll
                    for (int nt = 0; nt < 4; ++nt) { kv[nt] = bf2f(pass ? kvB[nt] : kvA[nt][j]); kr[nt] = kv[nt] * kkc[nt]; ssq += kr[nt] * kr[nt]; }
                    const float rs = rsq_(sum16_(ssq) + 1e-6f);
#pragma unroll
                    for (int nt = 0; nt < 4; ++nt) { const float a = sigmoidf_(sa[nt][j] + a0c[nt]);
                        const float lwf = -__expf(-softplusf_(-(sf[nt][j] + w0fc[nt])) - 0.5f), lwb = -__expf(-softplusf_(-(sb[nt][j] + w0bc[nt])) - 0.5f);
                        const float kk = kr[nt] * rs; const size_t o = (size_t)s * 256 + 64 * h + 16 * nt + fr;
                        if (valid) { WSP(float, SC_RK)[o] = kv[nt] * (1.0f + (a - 1.0f) * kac[nt]); WSP(float, SC_RKK)[o] = kk; WSP(float, SC_RB)[o] = kk * a;
                            WSP(float, SC_RLW)[o] = lwf; WSP(float, SC_RLW)[(size_t)SB * 256 + o] = lwb; } } } }
            __syncthreads();
        }
    }
    __syncthreads();
    { const int tid = p.tid; const float* dncw = PIN(I_DN_CW); const float* sscw = PIN(I_SS_CW); const float* sscb = PIN(I_SS_CB);
      constexpr int NCU = 2 * NTB * 6, TIMG = 3 * 66 * 128 * 2;
#define PC_LOAD(uu, v, vh) do { const int mixer_ = (uu) / (NTB * 6), r2_ = (uu) % (NTB * 6), rb_ = r2_ / 6, colbase_ = (mixer_ ? PD_Q : PC_X) + 128 * (r2_ % 6); \
          _Pragma("unroll") for (int q = 0; q < 6; ++q) { const int e = tid + NTHR * q, rr = e >> 10, tok = (e >> 4) & 63, ch = (e & 15) * 8; v[q] = (u32x4){0u, 0u, 0u, 0u}; \
              if (rb_ < 4) { if (rr == 1) v[q] = *(const u32x4*)(proj + (size_t)(b * NCTX + 64 * rb_ + tok) * NPROJ + colbase_ + ch); } \
              else { const int gr = rb_ - 4 + rr - 1; if (gr >= 0 && gr < GRIDH) v[q] = *(const u32x4*)(proj + (size_t)(CROWS + b * SEQ + gr * 64 + tok) * NPROJ + colbase_ + ch); } } \
          vh = (u32x4){0u, 0u, 0u, 0u}; if (tid < 96) { const int rr = tid >> 5, side = (tid >> 4) & 1, ch = (tid & 15) * 8;       \
              if (rb_ < 4 && rr == 1) { const int tk = side ? 64 * (rb_ + 1) : 64 * rb_ - 1; if (tk >= 0 && tk < NCTX) vh = *(const u32x4*)(proj + (size_t)(b * NCTX + tk) * NPROJ + colbase_ + ch); } } \
          { const int chn_ = 128 * (r2_ % 6) + 2 * (tid & 63); const float* cw_ = (mixer_ ? dncw : sscw) + (size_t)layer * 9 * 768 + chn_;        \
            _Pragma("unroll") for (int k = 0; k < 9; ++k) w[k] = *(const f32x2_t*)(cw_ + k * 768); bias = mixer_ ? (f32x2_t){0.f, 0.f} : *(const f32x2_t*)(sscb + layer * 768 + chn_); } } while (0)
      int u = p.bid, par = 0;
      if (u < NCU) { u32x4 v[6], vh; f32x2_t w[9], bias; PC_LOAD(u, v, vh);
        for (;;) { const int mixer = u / (NTB * 6), r2 = u % (NTB * 6), rb = r2 / 6, sixth = r2 % 6;
          LAS bf16_t* T = (LAS bf16_t*)(lds + par * TIMG); par ^= 1;
#pragma unroll
          for (int q = 0; q < 6; ++q) { const int e = tid + NTHR * q, rr = e >> 10, tok = (e >> 4) & 63, ch = (e & 15) * 8; *(LAS u32x4*)(T + (rr * 66 + tok + 1) * 128 + ch) = v[q]; }
          if (tid < 96) { const int rr = tid >> 5, side = (tid >> 4) & 1, ch = (tid & 15) * 8; *(LAS u32x4*)(T + (rr * 66 + (side ? 65 : 0)) * 128 + ch) = vh; }
          __syncthreads();
          const int un = u + p.G; const bool more = un < NCU;
          f32x2_t wc[9]; const f32x2_t bc = bias;
#pragma unroll
          for (int k = 0; k < 9; ++k) wc[k] = w[k];
          if (more) PC_LOAD(un, v, vh);
          { const int cp = tid & 63, tg8 = tid >> 6, chn = 128 * sixth + 2 * cp;
            bf16_t* dst = (mixer ? WSP(bf16_t, SC_DQ) : WSP(bf16_t, SC_SX)) + (size_t)(64 * rb) * 768 + chn;
            const int x = 8 * tg8; f32x2_t aa[4], ab[4];
#pragma unroll
            for (int q = 0; q < 4; ++q) { aa[q] = (f32x2_t){bc[0], bc[0]}; ab[q] = (f32x2_t){bc[1], bc[1]}; }
#pragma unroll
            for (int dy = 0; dy < 3; ++dy) { float ca[10], cb2[10];
#pragma unroll
                for (int dx = 0; dx < 10; ++dx) { const unsigned wv = *(const LAS unsigned*)(T + (dy * 66 + x + dx) * 128 + 2 * cp); ca[dx] = __uint_as_float(wv << 16); cb2[dx] = __uint_as_float(wv & 0xffff0000u); }
#pragma unroll
                for (int dx = 0; dx < 3; ++dx)
#pragma unroll
                    for (int q = 0; q < 4; ++q) { const f32x2_t va = {ca[2 * q + dx], ca[2 * q + dx + 1]}, vb = {cb2[2 * q + dx], cb2[2 * q + dx + 1]}; aa[q] += va * wc[dy * 3 + dx][0]; ab[q] += vb * wc[dy * 3 + dx][1]; } }
#pragma unroll
            for (int q = 0; q < 8; ++q) { float ya = siluf_(aa[q >> 1][q & 1]), yb = siluf_(ab[q >> 1][q & 1]);
                if (mixer && sixth < 4) { float ss = sum16_(ya * ya + yb * yb); ss += __uint_as_float(__builtin_amdgcn_ds_swizzle(__float_as_uint(ss), 0x401F));
                    const float rs = rsq_(ss + 1e-6f) * (sixth < 2 ? 0.125f : 1.0f); ya *= rs; yb *= rs; }
                *(unsigned*)(dst + (size_t)(x + q) * 768) = pk2(ya, yb); } }
          if (!more) break;
          u = un; } }
#undef PC_LOAD
#define SCAL_FIN(e_, raw_) do { const int s = (e_) / 24, q = (e_) % 24; const float xv = bf2f(raw_); \
          if (q < 8) { const int d = q >> 2, h = q & 3; WSP(float, SC_SDT)[(size_t)s * 8 + q] = softplusf_(xv + PIN(I_SS_DTB)[(layer * 2 + d) * 4 + h]); } \
          else if (q < 16) { WSP(float, SC_DG)[(size_t)s * 16 + (q - 8)] = sigmoidf_(xv); } \
          else { const int q2 = q - 16, d = q2 >> 2, h = q2 & 3; WSP(float, SC_DG)[(size_t)s * 16 + 8 + q2] = -__expf(PIN(I_DN_ALOG)[(layer * 2 + d) * 4 + h]) * softplusf_(xv + PIN(I_DN_DTB)[(layer * 2 + d) * 4 + h]); } } while (0)
      if (e0 < SB * 24) SCAL_FIN(e0, sq0);
      if (e1 < SB * 24) SCAL_FIN(e1, sq1);
      for (int e = e1 + p.G * NTHR; e < SB * 24; e += p.G * NTHR) { const bf16_t raw = proj[(size_t)tok_row(b, e / 24) * NPROJ + SCAL_COL(e % 24)]; SCAL_FIN(e, raw); }
#undef SCAL_FIN
#undef SCAL_COL
    }
}
__device__ __forceinline__ void phase_scan(const Cx& p, LAS unsigned char* lds, int layer, int b);
__device__ __forceinline__ void phase_post(const Cx& p, LAS unsigned char* lds, int layer, int b) {
    const int tid = p.tid, tsub = tid >> 7, c8 = (tid & 127) * 8, mixer = c8 >> 8, cm = c8 & 255, hh = cm >> 6;
    const bf16_t* proj = WSP(bf16_t, WS_PROJ); const bf16_t* of = WSP(bf16_t, SC_OF); const bf16_t* obk = WSP(bf16_t, SC_OB); bf16_t* yc = WSP(bf16_t, WS_HBUF);
    constexpr int PTS = 144, GTS = 260;
    LAS unsigned char* GWb = lds; LAS unsigned char* SGb = lds + 256 * PTS; LAS float* GT = (LAS float*)(lds + 256 * PTS + 48 * PTS);
    if ((int)p.bid < SB / 33) { const bf16_t* gsrc = WSP(bf16_t, WS_RWGW) + (size_t)layer * 256 * 64;
#pragma unroll
        for (int q = 0; q < 4; ++q) { const int e = tid + NTHR * q, n = e >> 3, ch = e & 7; *(LAS u32x4*)(GWb + n * PTS + ch * 16) = *(const u32x4*)(gsrc + n * 64 + ch * 8); } }
    float g0[8], g1[8], g2[8];
#pragma unroll
    for (int q = 0; q < 8; ++q) { const int c = cm + q; g0[q] = 0.f; g1[q] = 0.f; g2[q] = 0.f;
        if (mixer == 0) g0[q] = PIN(I_GLA_NG)[layer * 256 + c];
        else if (mixer == 1) { g0[q] = PIN(I_RW_LNG)[layer * 256 + c]; g1[q] = PIN(I_RW_LNB)[layer * 256 + c]; g2[q] = PIN(I_RW_RK)[layer * 256 + c]; }
        else if (mixer == 2) { g0[q] = PIN(I_SS_NG)[layer * 256 + c]; g1[q] = PIN(I_SS_D)[layer * 4 + hh]; }
        else g0[q] = PIN(I_DN_NG)[layer * 256 + c]; }
    const int col1 = (mixer == 0 ? PA_G : mixer == 1 ? PB_R : mixer == 2 ? PC_Z : PD_Z) + cm;
    for (int u = p.bid; u < SB / 33; u += p.G) {
        if (tid < 33 * 8) { const int tk = tid >> 3, ch = tid & 7; float gl[8]; bf8_to_f(*(const u32x4*)(proj + (size_t)tok_row(b, u * 33 + tk) * NPROJ + PB_G + 8 * ch), gl);
            *(LAS u32x4*)(SGb + tk * PTS + ch * 16) = (u32x4){pk2(sigmoidf_(gl[0]), sigmoidf_(gl[1])), pk2(sigmoidf_(gl[2]), sigmoidf_(gl[3])), pk2(sigmoidf_(gl[4]), sigmoidf_(gl[5])), pk2(sigmoidf_(gl[6]), sigmoidf_(gl[7]))}; }
        u32x4 rofA, robA, ra1A, ra2A = (u32x4){0u, 0u, 0u, 0u}, rkqA = (u32x4){0u, 0u, 0u, 0u}, rofB, robB, ra1B, ra2B = (u32x4){0u, 0u, 0u, 0u}, rkqB = (u32x4){0u, 0u, 0u, 0u};
#define POST_LOAD(S, t0_) do { const int tk_ = (t0_) + tsub; const int s_ = u * 33 + (tk_ < 33 ? tk_ : 32); const bf16_t* pr_ = proj + (size_t)tok_row(b, s_) * NPROJ; \
        rof##S = *(const u32x4*)(of + (size_t)s_ * 1024 + c8); rob##S = *(const u32x4*)(obk + (size_t)s_ * 1024 + c8); ra1##S = *(const u32x4*)(pr_ + col1); \
        { const bf16_t* p2_ = mixer == 1 ? pr_ + PB_V + cm : (mixer == 2 ? WSP(bf16_t, SC_PX) + (size_t)s_ * 256 + cm : pr_ + col1);        \
          const bf16_t* p3_ = mixer == 1 ? WSP(bf16_t, SC_PK) + (size_t)s_ * 256 + cm : pr_ + col1; \
          ra2##S = *(const u32x4*)p2_; rkq##S = *(const u32x4*)p3_; } } while (0)
        POST_LOAD(A, 0); POST_LOAD(B, 4);
        __syncthreads();
        { const int lane = tid & 63, wave = tid >> 6, fr = lane & 15, fq = lane >> 4; f32x4 acc[3][2];
#pragma unroll
          for (int mt = 0; mt < 3; ++mt) { acc[mt][0] = (f32x4){0.f, 0.f, 0.f, 0.f}; acc[mt][1] = (f32x4){0.f, 0.f, 0.f, 0.f}; }
#pragma unroll
          for (int ks = 0; ks < 2; ++ks) { bf16x8 bb[2];
#pragma unroll
              for (int nt = 0; nt < 2; ++nt) bb[nt] = *(const LAS bf16x8*)(GWb + (16 * (2 * wave + nt) + fr) * PTS + ks * 64 + fq * 16);
#pragma unroll
              for (int mt = 0; mt < 3; ++mt) { const bf16x8 a = *(const LAS bf16x8*)(SGb + (16 * mt + fr) * PTS + ks * 64 + fq * 16);
                  acc[mt][0] = __builtin_amdgcn_mfma_f32_16x16x32_bf16(a, bb[0], acc[mt][0], 0, 0, 0); acc[mt][1] = __builtin_amdgcn_mfma_f32_16x16x32_bf16(a, bb[1], acc[mt][1], 0, 0, 0); } }
#pragma unroll
          for (int mt = 0; mt < 3; ++mt)
#pragma unroll
              for (int nt = 0; nt < 2; ++nt)
#pragma unroll
                  for (int j = 0; j < 4; ++j) GT[(16 * mt + 4 * fq + j) * GTS + 16 * (2 * wave + nt) + fr] = acc[mt][nt][j]; }
        __syncthreads();
        auto pass = [&](const u32x4 cof, const u32x4 cob, const u32x4 ca1, const u32x4 ca2, const u32x4 ckq, const int t0) __attribute__((always_inline)) {
            const int tk = t0 + tsub; const bool live = tk < 33; const int tkc = live ? tk : 32, s = u * 33 + tkc, row = tok_row(b, s); (void)s;
            float o[8], a[8], y[8];
            { float t1[8], t2[8]; bf8_to_f(cof, t1); bf8_to_f(cob, t2);
#pragma unroll
              for (int q = 0; q < 8; ++q) o[q] = t1[q] + t2[q]; }
            bf8_to_f(ca1, a);
            if (mixer == 0 || mixer == 3) { float ss = 0.f;
#pragma unroll
                for (int q = 0; q < 8; ++q) ss += o[q] * o[q];
                const float rs = rsq_(sum8_(ss) * (1.0f / 64.0f) + 1e-6f);
#pragma unroll
                for (int q = 0; q < 8; ++q) y[q] = o[q] * rs * g0[q] * siluf_(a[q]);
            } else if (mixer == 2) { float xs[8]; bf8_to_f(ca2, xs); float ss = 0.f;
#pragma unroll
                for (int q = 0; q < 8; ++q) { y[q] = (o[q] + g1[q] * xs[q]) * siluf_(a[q]); ss += y[q] * y[q]; }
                const float rs = rsq_(sum16_(ss) * (1.0f / 128.0f) + 1e-6f);
#pragma unroll
                for (int q = 0; q < 8; ++q) y[q] *= rs * g0[q];
            } else { float vv[8], kk[8]; bf8_to_f(ca2, vv); bf8_to_f(ckq, kk);
                float su = 0.f, bo = 0.f;
#pragma unroll
                for (int q = 0; q < 8; ++q) { su += o[q]; bo += a[q] * kk[q] * g2[q]; }
                const float mu = sum8_(su) * (1.0f / 64.0f); bo = sum8_(bo); float va = 0.f;
#pragma unroll
                for (int q = 0; q < 8; ++q) { o[q] -= mu; va += o[q] * o[q]; }
                const float rs = rsq_(sum8_(va) * (1.0f / 64.0f) + 64e-5f);
                const f32x4 gt0 = *(const LAS f32x4*)(GT + tkc * GTS + cm), gt1 = *(const LAS f32x4*)(GT + tkc * GTS + cm + 4);
#pragma unroll
                for (int q = 0; q < 8; ++q) y[q] = (o[q] * rs * g0[q] + g1[q] + bo * vv[q]) * (q < 4 ? gt0[q & 3] : gt1[q & 3]); }
            if (live) *(u32x4*)(yc + (size_t)row * D + c8) = (u32x4){pk2(y[0], y[1]), pk2(y[2], y[3]), pk2(y[4], y[5]), pk2(y[6], y[7])};
        };
#pragma unroll 1
        for (int t0 = 0; t0 < 32; t0 += 8) {
            { const u32x4 cof = rofA, cob = robA, ca1 = ra1A, ca2 = ra2A, ckq = rkqA; POST_LOAD(A, t0 + 8); pass(cof, cob, ca1, ca2, ckq, t0); }
            { const u32x4 cof = rofB, cob = robB, ca1 = ra1B, ca2 = ra2B, ckq = rkqB; POST_LOAD(B, t0 + 12); pass(cof, cob, ca1, ca2, ckq, t0 + 4); } }
        pass(rofA, robA, ra1A, ra2A, rkqA, 32);
#undef POST_LOAD
    }
}
constexpr int N2_TILE = 32, N2_STRIDE = 2064;
__device__ __forceinline__ void phase_norm2(const Cx& p, LAS unsigned char* lds, int layer, int row_lo) {
    const int tid = p.tid, lane = tid & 63, wave = __builtin_amdgcn_readfirstlane(tid >> 6), fr = lane & 15, fq = lane >> 4;
    const float* mod = WSP(float, WS_MOD) + (size_t)layer * 5 * 6144; const float* g = PIN(I_N2G) + layer * D; bf16_t* hb = WSP(bf16_t, WS_HBUF);
    const bf16_t* rt = WSP(bf16_t, WS_ROUT) + (size_t)layer * 2 * NE * D;
    LAS float* lg = (LAS float*)(lds + 2 * N2_TILE * N2_STRIDE);
    unsigned* cnt = WSP(unsigned, WS_CTL) + CW_CNT + layer * 80 * 16; int* ltok = WSP(int, WS_LTOK); int* tokt = WSP(int, WS_TOKT);
    const float rbias = PIN(I_ROUT_B)[layer * NE + lane];
    const int nun = (ROWS - row_lo) / N2_TILE;
    ModC mc; mc.s = -1; f32x4 n0[4], n1[4], n2[4], n3[4];
    if ((int)p.bid < nun) { const int r = row_lo + p.bid * N2_TILE + 4 * wave; norm_ld(res_row(p, 0, r), n0, lane); norm_ld(res_row(p, 0, r + 1), n1, lane); norm_ld(res_row(p, 0, r + 2), n2, lane); norm_ld(res_row(p, 0, r + 3), n3, lane); }
    for (int u = p.bid; u < nun; u += p.G) { const int r0 = row_lo + u * N2_TILE;
        { const int tr = 4 * wave, r = r0 + tr;
          const int s = row_sel(r); if (s != mc.s) mc.load(g, mod + s * 6144 + 3072, mod + s * 6144 + 4096, s, lane);
          norm_fin2(n0, mc, hb + (size_t)r * D, true, (LAS bf16_t*)(lds + tr * N2_STRIDE), (LAS bf16_t*)(lds + N2_TILE * N2_STRIDE + tr * N2_STRIDE), lane);
          norm_fin2(n1, mc, hb + (size_t)(r + 1) * D, true, (LAS bf16_t*)(lds + (tr + 1) * N2_STRIDE), (LAS bf16_t*)(lds + N2_TILE * N2_STRIDE + (tr + 1) * N2_STRIDE), lane);
          norm_fin2(n2, mc, hb + (size_t)(r + 2) * D, true, (LAS bf16_t*)(lds + (tr + 2) * N2_STRIDE), (LAS bf16_t*)(lds + N2_TILE * N2_STRIDE + (tr + 2) * N2_STRIDE), lane);
          norm_fin2(n3, mc, hb + (size_t)(r + 3) * D, true, (LAS bf16_t*)(lds + (tr + 3) * N2_STRIDE), (LAS bf16_t*)(lds + N2_TILE * N2_STRIDE + (tr + 3) * N2_STRIDE), lane); }
        __syncthreads();
        { const int mt = wave >> 2, nt = wave & 3; f32x4 acc = (f32x4){0.f, 0.f, 0.f, 0.f};
          const LAS unsigned char* ap = lds + (16 * mt + fr) * N2_STRIDE + fq * 16; const bf16_t* bp = rt + (size_t)(16 * nt + fr) * D + fq * 8;
#pragma unroll 8
          for (int ks = 0; ks < 32; ++ks) { const bf16x8 a = *(const LAS bf16x8*)(ap + ks * 64), al = *(const LAS bf16x8*)(ap + N2_TILE * N2_STRIDE + ks * 64);
              const bf16x8 bb = *(const bf16x8*)(bp + ks * 32), bl = *(const bf16x8*)(bp + NE * D + ks * 32);
              acc = __builtin_amdgcn_mfma_f32_16x16x32_bf16(a, bb, acc, 0, 0, 0); acc = __builtin_amdgcn_mfma_f32_16x16x32_bf16(al, bb, acc, 0, 0, 0); acc = __builtin_amdgcn_mfma_f32_16x16x32_bf16(a, bl, acc, 0, 0, 0); }
#pragma unroll
          for (int j = 0; j < 4; ++j) lg[(16 * mt + 4 * fq + j) * 64 + 16 * nt + fr] = acc[j]; }
        __syncthreads();
        { const int un = u + p.G; if (un < nun) { const int rn = row_lo + un * N2_TILE + 4 * wave; norm_ld(res_row(p, 0, rn), n0, lane); norm_ld(res_row(p, 0, rn + 1), n1, lane); norm_ld(res_row(p, 0, rn + 2), n2, lane); norm_ld(res_row(p, 0, rn + 3), n3, lane); } }
#pragma unroll 1
        for (int i = 0; i < 4; ++i) { const int tr = 4 * wave + i, r = r0 + tr;
            const float sc = sigmoidf_(lg[tr * 64 + lane]); float sel = sc + rbias; float ssum = 0.f; int myE = 0; float myS = 0.f;
#pragma unroll 1
            for (int k = 0; k < TOPK; ++k) { float bv = sel; int bi = lane;
#define ARGSTEP(OV, OI) do { const float ov_ = (OV); const int oi_ = (OI); if (ov_ > bv || (ov_ == bv && oi_ < bi)) { bv = ov_; bi = oi_; } } while (0)
                ARGSTEP(DPPF(bv, 0xB1), DPPI(bi, 0xB1)); ARGSTEP(DPPF(bv, 0x4E), DPPI(bi, 0x4E)); ARGSTEP(DPPF(bv, 0x141), DPPI(bi, 0x141)); ARGSTEP(DPPF(bv, 0x140), DPPI(bi, 0x140));
                ARGSTEP(__uint_as_float(__builtin_amdgcn_ds_swizzle(__float_as_uint(bv), 0x401F)), __builtin_amdgcn_ds_swizzle(bi, 0x401F));
                { const float v0 = rl(bv, 0), v1 = rl(bv, 32); const int i0 = __builtin_amdgcn_readlane(bi, 0), i1 = __builtin_amdgcn_readlane(bi, 32); if (v1 > v0 || (v1 == v0 && i1 < i0)) { bv = v1; bi = i1; } else { bv = v0; bi = i0; } }
#undef ARGSTEP
                const int e = __builtin_amdgcn_readfirstlane(bi); const float se = rl(sc, e);
                ssum += se; if (lane == k) { myE = e; myS = se; } if (lane == e) sel = -1e30f; }
            if (lane < TOPK) { const unsigned pos = atomicAdd(cnt + myE * 16, 1u); ltok[(size_t)myE * ROWS + pos] = r; tokt[(size_t)r * 16 + lane] = (myE << 16) | (int)pos; ((float*)tokt)[(size_t)r * 16 + 8 + lane] = myS / ssum * 2.5f; } }
        __syncthreads();
    }
}
__device__ __forceinline__ void moe_table(const Cx& p, LAS int* tb, int layer, int row_lo) {
    const unsigned* cnt = WSP(unsigned, WS_CTL) + CW_CNT + layer * 80 * 16;
    if (p.tid < 64) { const int lane = p.tid;
        const int c = (int)__hip_atomic_load(cnt + lane * 16, __ATOMIC_RELAXED, __HIP_MEMORY_SCOPE_AGENT); const int t = (c + 255) >> 8; int incl = t;
#pragma unroll
        for (int o = 1; o < 64; o <<= 1) { const int v = __builtin_amdgcn_ds_bpermute((lane - o) << 2, incl); if (lane >= o) incl += v; }
        tb[lane] = c; tb[128 + lane] = incl - t;
        if (lane == 63) { const int cs = ROWS - row_lo; tb[NE] = cs; tb[128 + NE] = incl; tb[128 + NE1] = incl + ((cs + 255) >> 8); } }
    __syncthreads();
}
__device__ __forceinline__ void phase_combine(const Cx& p, const LAS int* tb, int layer, int row_lo, int half) {
    const int lane = p.tid & 63, wave = p.tid >> 6; const bool fin = layer == NL - 1 && half == 1; const float* fng = PIN(I_FNG); const bf16_t* Y = WSP(bf16_t, WS_Y); const int* tokt = WSP(int, WS_TOKT);
    const float* gate = WSP(float, WS_MOD) + (size_t)layer * 5 * 6144 + 5120; const int col = 512 * half + 8 * lane; const int shbase = tb[128 + NE] * 256;
#pragma unroll 2
    for (int r = row_lo + p.bid * 8 + wave; r < ROWS; r += p.G * 8) {
        const int sw = lane < 16 ? tokt[(size_t)r * 16 + lane] : 0;
        float a[8];
        { const u32x4 y = *(const u32x4*)(Y + (size_t)(shbase + (r - row_lo)) * 512 + 8 * lane);
#pragma unroll
          for (int q = 0; q < 4; ++q) { a[2 * q] = __uint_as_float(y[q] << 16); a[2 * q + 1] = __uint_as_float(y[q] & 0xffff0000u); } }
#pragma unroll
        for (int k = 0; k < 8; ++k) { const int sl = __builtin_amdgcn_readlane(sw, k); const float w = __uint_as_float(__builtin_amdgcn_readlane(sw, 8 + k));
            const int hrow = tb[128 + (sl >> 16)] * 256 + (sl & 0xffff); const u32x4 y = *(const u32x4*)(Y + (size_t)hrow * 512 + 8 * lane);
#pragma unroll
            for (int q = 0; q < 4; ++q) { a[2 * q] += w * __uint_as_float(y[q] << 16); a[2 * q + 1] += w * __uint_as_float(y[q] & 0xffff0000u); } }
        float* x = (float*)res_row(p, 0, r) + col; const float* gp = gate + row_sel(r) * 6144 + col;
        if (!fin) {
#pragma unroll
            for (int q = 0; q < 2; ++q) { const f32x4 gv = *(const f32x4*)(gp + 4 * q); f32x4 xv = *(const f32x4*)(x + 4 * q);
                xv[0] += gv[0] * a[4 * q]; xv[1] += gv[1] * a[4 * q + 1]; xv[2] += gv[2] * a[4 * q + 2]; xv[3] += gv[3] * a[4 * q + 3]; *(f32x4*)(x + 4 * q) = xv; }
        } else {
            f32x4 xv[2], xo[2]; float ss = 0.f;
#pragma unroll
            for (int q = 0; q < 2; ++q) { const f32x4 gv = *(const f32x4*)(gp + 4 * q); xv[q] = *(const f32x4*)(x + 4 * q); xo[q] = *(const f32x4*)(x - 512 + 4 * q);
                xv[q][0] += gv[0] * a[4 * q]; xv[q][1] += gv[1] * a[4 * q + 1]; xv[q][2] += gv[2] * a[4 * q + 2]; xv[q][3] += gv[3] * a[4 * q + 3];
                ss += xv[q][0] * xv[q][0] + xv[q][1] * xv[q][1] + xv[q][2] * xv[q][2] + xv[q][3] * xv[q][3] + xo[q][0] * xo[q][0] + xo[q][1] * xo[q][1] + xo[q][2] * xo[q][2] + xo[q][3] * xo[q][3]; }
            ss = wsum(ss); const float rstd = rsq_(ss * (1.0f / D) + 1e-6f);
#pragma unroll
            for (int q = 0; q < 2; ++q) { *(f32x4*)(x + 4 * q) = xv[q] * rstd * *(const f32x4*)(fng + col + 4 * q); *(f32x4*)(x - 512 + 4 * q) = xo[q] * rstd * *(const f32x4*)(fng + col - 512 + 4 * q); } }
    }
}
__device__ __forceinline__ int chain_tb(int n, int d) { return d == 0 ? n : (n < 4 ? 3 - n : 135 - n); }
__device__ __forceinline__ int cslot(int u) { return (u & 7) * NTB + (u >> 3); }
__device__ __forceinline__ int tb_row0(int b, int tb) { return tb < 4 ? b * NCTX + 64 * tb : CROWS + b * SEQ + 64 * (tb - 4); }
constexpr int TS = 144;
template <int K, int NT> __device__ __forceinline__ void mm_rows(const LAS unsigned char* A, int lda, const LAS unsigned char* Bt, int ldb, int mt, int nt0, int fr, int fq, f32x4 (&acc)[NT]) {
#pragma unroll
    for (int ks = 0; ks < K / 32; ++ks) { const bf16x8 a = *(const LAS bf16x8*)(A + (16 * mt + fr) * lda + ks * 64 + fq * 16);
#pragma unroll
        for (int nt = 0; nt < NT; ++nt) { const bf16x8 bb = *(const LAS bf16x8*)(Bt + (16 * (nt0 + nt) + fr) * ldb + ks * 64 + fq * 16);
            acc[nt] = __builtin_amdgcn_mfma_f32_16x16x32_bf16(a, bb, acc[nt], 0, 0, 0); } }
}
#define UNIT_LOOP(u, N, OFF) for (int u = (p.bid + p.G - ((OFF) % p.G)) % p.G; u < (N); u += p.G)
__device__ __forceinline__ void gla_p1(const Cx& p, LAS unsigned char* lds0, int layer, int b) {
    const int tid = p.tid, lane = tid & 63, wave = __builtin_amdgcn_readfirstlane(tid >> 6), fr = lane & 15, fq = lane >> 4;
    int par = 0;
    const bf16_t* proj = WSP(bf16_t, WS_PROJ); const int mt = wave >> 1, nt0 = (wave & 1) * 2; const int cl = lane, tg = wave;
    const float* w2p = PIN(I_GLA_W2); const float* gbp = PIN(I_GLA_B);
    float w2[16], gb; unsigned gw; bf16_t kq[8], vq[8];
#define GLA1_LOAD(uu) do { const int tb_ = (uu) >> 3, h_ = ((uu) >> 1) & 3, d_ = (uu) & 1, c_ = 64 * h_ + cl; const bf16_t* pr_ = proj + (size_t)tb_row0(b, tb_) * NPROJ; \
        _Pragma("unroll") for (int r = 0; r < 16; ++r) w2[r] = w2p[((size_t)(layer * 2 + d_) * 16 + r) * 256 + c_]; \
        gb = gbp[(layer * 2 + d_) * 256 + c_]; \
        { const int e = tid * 2, i = e >> 4, r = e & 15; gw = *(const unsigned*)(pr_ + (size_t)i * NPROJ + (d_ ? PA_GB : PA_GF) + r); } \
        _Pragma("unroll") for (int i8 = 0; i8 < 8; ++i8) { const bf16_t* pa = pr_ + (size_t)(8 * tg + i8) * NPROJ; kq[i8] = pa[PA_K + c_]; vq[i8] = pa[PA_V + c_]; } } while (0)
    int u = (p.bid + p.G) % p.G;
    if (u < NUNIT) GLA1_LOAD(u);
    for (; u < NUNIT; u += p.G) { const int d = u & 1;
        LAS unsigned char* lds = lds0 + par * 32768; par ^= 1;
        LAS unsigned char* ksT = lds; LAS unsigned char* vT = lds + 64 * TS; LAS float* gs = (LAS float*)(lds + 2 * 64 * TS); LAS float* glb = gs + 512;
        glb[tid * 2] = __uint_as_float(gw << 16); glb[tid * 2 + 1] = __uint_as_float(gw & 0xffff0000u);
        __syncthreads();
        float bl[8]; float run = 0.f;
#pragma unroll
        for (int ii = 0; ii < 8; ++ii) { const int i8 = d ? 7 - ii : ii; const LAS float* gl_ = glb + (8 * tg + i8) * 16; float z = gb;
#pragma unroll
            for (int r = 0; r < 16; ++r) z += gl_[r] * w2[r];
            run += logsigmoidf_(z) * (1.0f / 16.0f); if (d) bl[7 - ii] = run; else bl[ii] = run; }
        gs[tg * 64 + cl] = run;
        __syncthreads();
        float off = 0.f, total = 0.f;
#pragma unroll
        for (int g2 = 0; g2 < 8; ++g2) { const float t = gs[g2 * 64 + cl]; total += t; if (d ? g2 > tg : g2 < tg) off += t; }
#pragma unroll
        for (int i8 = 0; i8 < 8; i8 += 2) { const int i = 8 * tg + i8;
            const float ka = bf2f(kq[i8]) * __expf(total - (bl[i8] + off)), kb = bf2f(kq[i8 + 1]) * __expf(total - (bl[i8 + 1] + off));
            *(LAS unsigned*)(ksT + cl * TS + i * 2) = pk2(ka, kb); *(LAS unsigned*)(vT + cl * TS + i * 2) = (unsigned)vq[i8] | ((unsigned)vq[i8 + 1] << 16); }
        if (u + p.G < NUNIT) GLA1_LOAD(u + p.G);
        if (tg == 0) WSP(float, SC_GLA_DEC)[(size_t)cslot(u) * 64 + cl] = __expf(total);
        __syncthreads();
        { f32x4 acc[2] = {(f32x4){0.f, 0.f, 0.f, 0.f}, (f32x4){0.f, 0.f, 0.f, 0.f}}; float* kv = WSP(float, SC_GLA_S) + (size_t)cslot(u) * 4096;
          mm_rows<64, 2>(vT, TS, ksT, TS, mt, nt0, fr, fq, acc);
#pragma unroll
          for (int t = 0; t < 2; ++t) *(f32x4*)(kv + (16 * (nt0 + t) + fr) * 64 + 16 * mt + 4 * fq) = acc[t]; }
    }
#undef GLA1_LOAD
}
__device__ __forceinline__ void gla_chain(const Cx& p, int h, int d, int part) {
    if (p.tid >= 256) return;
    const int e0 = part * 1024 + p.tid * 4, dk = e0 >> 6;
    f32x4 s0 = (f32x4){0.f, 0.f, 0.f, 0.f};
    f32x4 n0[12]; float dc[12];
#define GC_LD(q, n_) do { const int u_ = cslot((chain_tb((n_), d) * 4 + h) * 2 + d); n0[q] = *(const f32x4*)(WSP(float, SC_GLA_S) + (size_t)u_ * 4096 + e0); dc[q] = WSP(float, SC_GLA_DEC)[(size_t)u_ * 64 + dk]; } while (0)
#define GC_ST(q, n_) do { const int u_ = cslot((chain_tb((n_), d) * 4 + h) * 2 + d); float* k_ = WSP(float, SC_GLA_S) + (size_t)u_ * 4096 + e0; \
        const f32x4 a0_ = n0[q]; const float de_ = dc[q]; GC_LD(q, (n_) + 12 < NTB ? (n_) + 12 : NTB - 1); *(f32x4*)k_ = s0; s0 = s0 * de_ + a0_; } while (0)
    GC_LD(0, 0); GC_LD(1, 1); GC_LD(2, 2); GC_LD(3, 3); GC_LD(4, 4); GC_LD(5, 5); GC_LD(6, 6); GC_LD(7, 7); GC_LD(8, 8); GC_LD(9, 9); GC_LD(10, 10); GC_LD(11, 11);
#pragma unroll 1
    for (int n = 0; n < NTB; n += 12) { GC_ST(0, n + 0); GC_ST(1, n + 1); GC_ST(2, n + 2); GC_ST(3, n + 3); GC_ST(4, n + 4); GC_ST(5, n + 5); GC_ST(6, n + 6); GC_ST(7, n + 7); GC_ST(8, n + 8); GC_ST(9, n + 9); GC_ST(10, n + 10); GC_ST(11, n + 11); }
#undef GC_LD
#undef GC_ST
}
__device__ __forceinline__ void gla_p2(const Cx& p, LAS unsigned char* lds0, int layer, int b) {
    const int tid = p.tid, lane = tid & 63, wave = __builtin_amdgcn_readfirstlane(tid >> 6), fr = lane & 15, fq = lane >> 4;
    int par = 0;
    const bf16_t* proj = WSP(bf16_t, WS_PROJ); const int cl = lane, tg = wave;
    const float* w2p = PIN(I_GLA_W2); const float* gbp = PIN(I_GLA_B);
    float w2[16], gb; unsigned gw; bf16_t qq[8], kq[8], vq[8]; float sq[8];
#define GLA2_LOAD(uu) do { const int tb_ = (uu) >> 3, h_ = ((uu) >> 1) & 3, d_ = (uu) & 1, c_ = 64 * h_ + cl; const bf16_t* pr_ = proj + (size_t)tb_row0(b, tb_) * NPROJ; \
        _Pragma("unroll") for (int r = 0; r < 16; ++r) w2[r] = w2p[((size_t)(layer * 2 + d_) * 16 + r) * 256 + c_]; \
        gb = gbp[(layer * 2 + d_) * 256 + c_]; \
        { const int e = tid * 2, i = e >> 4, r = e & 15; gw = *(const unsigned*)(pr_ + (size_t)i * NPROJ + (d_ ? PA_GB : PA_GF) + r); } \
        _Pragma("unroll") for (int i8 = 0; i8 < 8; ++i8) { const bf16_t* pa = pr_ + (size_t)(8 * tg + i8) * NPROJ; qq[i8] = pa[PA_Q + c_]; kq[i8] = pa[PA_K + c_]; vq[i8] = pa[PA_V + c_]; } \
        { const float* sp_ = WSP(float, SC_GLA_S) + (size_t)cslot(uu) * 4096; _Pragma("unroll") for (int q = 0; q < 8; ++q) sq[q] = sp_[tid + NTHR * q]; } } while (0)
    int u = (p.bid + p.G - (128 % p.G)) % p.G + (layer == NL - 1 ? 32 : 0);
    if (u < NUNIT) GLA2_LOAD(u);
    for (; u < NUNIT; u += p.G) { const int tb = u >> 3, h = (u >> 1) & 3, d = u & 1; const int s0 = 64 * tb;
        LAS unsigned char* lds = lds0 + par * 57344; par ^= 1;
        LAS unsigned char* qt = lds; LAS unsigned char* kt = lds + 64 * TS; LAS unsigned char* vT = lds + 2 * 64 * TS; LAS unsigned char* sT = lds + 3 * 64 * TS; LAS unsigned char* att = lds + 4 * 64 * TS;
        LAS float* gs = (LAS float*)(lds + 5 * 64 * TS); LAS float* glb = gs + 512;
        glb[tid * 2] = __uint_as_float(gw << 16); glb[tid * 2 + 1] = __uint_as_float(gw & 0xffff0000u);
#pragma unroll
        for (int q = 0; q < 8; ++q) { const int e = tid + NTHR * q, dk = e >> 6, dv = e & 63; *(LAS bf16_t*)(sT + dv * TS + dk * 2) = (bf16_t)f2bf(sq[q]); }
        __syncthreads();
        float bl[8]; float run = 0.f;
#pragma unroll
        for (int ii = 0; ii < 8; ++ii) { const int i8 = d ? 7 - ii : ii; const LAS float* gl_ = glb + (8 * tg + i8) * 16; float z = gb;
#pragma unroll
            for (int r = 0; r < 16; ++r) z += gl_[r] * w2[r];
            run += logsigmoidf_(z) * (1.0f / 16.0f); if (d) bl[7 - ii] = run; else bl[ii] = run; }
        gs[tg * 64 + cl] = run;
        __syncthreads();
        float off = 0.f;
#pragma unroll
        for (int g2 = 0; g2 < 8; ++g2) if (d ? g2 > tg : g2 < tg) off += gs[g2 * 64 + cl];
#pragma unroll
        for (int i8 = 0; i8 < 8; ++i8) { const int i = 8 * tg + i8; const float bi = bl[i8] + off;
            *(LAS bf16_t*)(qt + i * TS + cl * 2) = (bf16_t)f2bf(bf2f(qq[i8]) * 0.125f * __expf(bi));
            *(LAS bf16_t*)(kt + i * TS + cl * 2) = (bf16_t)f2bf(bf2f(kq[i8]) * __expf(-bi));
            *(LAS bf16_t*)(vT + cl * TS + i * 2) = vq[i8]; }
        if (u + p.G < NUNIT) GLA2_LOAD(u + p.G);
        __syncthreads();
        const int mt = wave >> 1, nt0 = (wave & 1) * 2;
        { f32x4 acc[2] = {(f32x4){0.f, 0.f, 0.f, 0.f}, (f32x4){0.f, 0.f, 0.f, 0.f}};
          mm_rows<64, 2>(kt, TS, qt, TS, mt, nt0, fr, fq, acc);
#pragma unroll
          for (int t = 0; t < 2; ++t) { const int i = 16 * (nt0 + t) + fr, j0 = 16 * mt + 4 * fq; float m4[4];
#pragma unroll
              for (int j = 0; j < 4; ++j) { const int jj = j0 + j; const bool keep = d ? jj >= i : jj <= i; m4[j] = keep ? acc[t][j] : 0.f; }
              *(LAS u32x2*)(att + i * TS + j0 * 2) = (u32x2){pk2(m4[0], m4[1]), pk2(m4[2], m4[3])}; } }
        __syncthreads();
        { f32x4 acc[2] = {(f32x4){0.f, 0.f, 0.f, 0.f}, (f32x4){0.f, 0.f, 0.f, 0.f}};
          mm_rows<64, 2>(vT, TS, att, TS, mt, nt0, fr, fq, acc);
          mm_rows<64, 2>(sT, TS, qt, TS, mt, nt0, fr, fq, acc);
          bf16_t* ob = WSP(bf16_t, d ? SC_OB : SC_OF);
#pragma unroll
          for (int t = 0; t < 2; ++t) *(u32x2*)(ob + (size_t)(s0 + 16 * (nt0 + t) + fr) * 1024 + 64 * h + 16 * mt + 4 * fq) = (u32x2){pk2(acc[t][0], acc[t][1]), pk2(acc[t][2], acc[t][3])}; }
    }
}
#undef GLA2_LOAD
constexpr int TS2 = 272;
__device__ __forceinline__ float ssd_acum(float a, int d, int lane, float& total) {
    float pre = a;
#pragma unroll
    for (int o = 1; o < 64; o <<= 1) { const float t = shup_(pre, lane, o); if (lane >= o) pre += t; }
    total = rl(pre, 63);
    return d ? total - pre + a : pre;
}
__device__ __forceinline__ void ssd_p1(const Cx& p, LAS unsigned char* lds0, int layer, int b) {
    const int tid = p.tid, lane = tid & 63, wave = __builtin_amdgcn_readfirstlane(tid >> 6), fr = lane & 15, fq = lane >> 4;
    int par = 0;
    const float* alogp = PIN(I_SS_ALOG);
    u32x4 bq[2], xq; float dtq;
#define SSD1_LOAD(uu) do { const int tb_ = (uu) >> 3, g_ = ((uu) >> 2) & 1, hd_ = (uu) & 3, h_ = 2 * g_ + (hd_ >> 1), d_ = hd_ & 1; \
        const bf16_t* sx_ = WSP(bf16_t, SC_SX) + (size_t)(64 * tb_ + lane) * 768; \
        bq[0] = *(const u32x4*)(sx_ + 256 + 128 * g_ + 16 * wave); bq[1] = *(const u32x4*)(sx_ + 256 + 128 * g_ + 16 * wave + 8); \
        xq = *(const u32x4*)(sx_ + 64 * h_ + 8 * wave); dtq = WSP(float, SC_SDT)[(size_t)(64 * tb_ + lane) * 8 + d_ * 4 + h_]; } while (0)
    int u3 = (p.bid + p.G - (32 % p.G)) % p.G;
    if (u3 < NTB * 8) SSD1_LOAD(u3);
    for (; u3 < NTB * 8; u3 += p.G) { const int tb = u3 >> 3, g = (u3 >> 2) & 1, hd = u3 & 3, h = 2 * g + (hd >> 1), d = hd & 1;
        LAS unsigned char* lds = lds0 + par * 32768; par ^= 1;
        LAS unsigned char* BT = lds; LAS unsigned char* xT = lds + 128 * TS; LAS float* AC = (LAS float*)(lds + 128 * TS + 64 * TS);
        if (wave == 0) { const float aneg = -__expf(alogp[(layer * 2 + d) * 4 + h]);
            float tot; const float ac = ssd_acum(aneg * dtq, d, lane, tot); AC[lane] = ac; if (lane == 0) { AC[64] = tot; WSP(float, SC_SSD_CD)[cslot((tb * 4 + h) * 2 + d)] = __expf(tot); } }
#pragma unroll
        for (int q = 0; q < 2; ++q)
#pragma unroll
            for (int k = 0; k < 8; ++k) *(LAS bf16_t*)(BT + (16 * wave + 8 * q + k) * TS + lane * 2) = (bf16_t)(bq[q][k >> 1] >> (16 * (k & 1)));
        __syncthreads();
        { const float f = dtq * __expf(AC[64] - AC[lane]);
#pragma unroll
          for (int k = 0; k < 8; ++k) *(LAS bf16_t*)(xT + (8 * wave + k) * TS + lane * 2) = (bf16_t)f2bf(bf2f((bf16_t)(xq[k >> 1] >> (16 * (k & 1)))) * f); }
        if (u3 + p.G < NTB * 8) SSD1_LOAD(u3 + p.G);
        __syncthreads();
        { float* cs = WSP(float, SC_SSD_S) + (size_t)cslot((tb * 4 + h) * 2 + d) * 8192; f32x4 acc[4];
#pragma unroll
          for (int t = 0; t < 4; ++t) acc[t] = (f32x4){0.f, 0.f, 0.f, 0.f};
          mm_rows<64, 4>(BT, TS, xT, TS, wave, 0, fr, fq, acc);
#pragma unroll
          for (int t = 0; t < 4; ++t) *(f32x4*)(cs + (16 * t + fr) * 128 + 16 * wave + 4 * fq) = acc[t]; }
    }
#undef SSD1_LOAD
}
__device__ __forceinline__ void ssd_chain(const Cx& p, int h, int d, int part) {
    if (p.tid >= 256) return;
    const int e0 = part * 1024 + p.tid * 4;
    f32x4 s = (f32x4){0.f, 0.f, 0.f, 0.f}; f32x4 nx[12]; float cd[12];
#define SC_LD(q, n_) do { const int u_ = cslot((chain_tb((n_), d) * 4 + h) * 2 + d); nx[q] = *(const f32x4*)(WSP(float, SC_SSD_S) + (size_t)u_ * 8192 + e0); cd[q] = WSP(float, SC_SSD_CD)[u_]; } while (0)
#define SC_ST(q, n_) do { const int u_ = cslot((chain_tb((n_), d) * 4 + h) * 2 + d); float* c_ = WSP(float, SC_SSD_S) + (size_t)u_ * 8192 + e0; const f32x4 a_ = nx[q]; const float de_ = cd[q]; \
        SC_LD(q, (n_) + 12 < NTB ? (n_) + 12 : NTB - 1); *(f32x4*)c_ = s; s = s * de_ + a_; } while (0)
    SC_LD(0, 0); SC_LD(1, 1); SC_LD(2, 2); SC_LD(3, 3); SC_LD(4, 4); SC_LD(5, 5); SC_LD(6, 6); SC_LD(7, 7); SC_LD(8, 8); SC_LD(9, 9); SC_LD(10, 10); SC_LD(11, 11);
#pragma unroll 1
    for (int n = 0; n < NTB; n += 12) { SC_ST(0, n + 0); SC_ST(1, n + 1); SC_ST(2, n + 2); SC_ST(3, n + 3); SC_ST(4, n + 4); SC_ST(5, n + 5); SC_ST(6, n + 6); SC_ST(7, n + 7); SC_ST(8, n + 8); SC_ST(9, n + 9); SC_ST(10, n + 10); SC_ST(11, n + 11); }
#undef SC_LD
#undef SC_ST
}
__device__ __forceinline__ void ssd_p2(const Cx& p, LAS unsigned char* lds, int layer, int b) {
    const int tid = p.tid, lane = tid & 63, wave = __builtin_amdgcn_readfirstlane(tid >> 6), fr = lane & 15, fq = lane >> 4;
    LAS unsigned char* Bt2 = lds; LAS float* cb = (LAS float*)(lds + 64 * TS2); LAS unsigned char* Mt = lds + 64 * TS2 + 64 * 65 * 4;
    int par = 0;
    const int mt = wave >> 1, nt0 = (wave & 1) * 2;
    const float* alogp = PIN(I_SS_ALOG);
    u32x4 cq[2], bq[2], xq; float dtq; f32x4 sq[4];
#define SSD2_LOAD(uu) do { const int tb_ = (uu) >> 3, g_ = ((uu) >> 2) & 1, hd_ = (uu) & 3, h_ = 2 * g_ + (hd_ >> 1), d_ = hd_ & 1; \
        const bf16_t* sx_ = WSP(bf16_t, SC_SX) + (size_t)(64 * tb_) * 768; \
        _Pragma("unroll") for (int q = 0; q < 2; ++q) { const int e = tid + NTHR * q, i = e >> 4, ch = e & 15; \
            cq[q] = *(const u32x4*)(sx_ + (size_t)i * 768 + 512 + 128 * g_ + ch * 8); bq[q] = *(const u32x4*)(sx_ + (size_t)i * 768 + 256 + 128 * g_ + ch * 8); } \
        xq = *(const u32x4*)(sx_ + (size_t)lane * 768 + 64 * h_ + 8 * wave); dtq = WSP(float, SC_SDT)[(size_t)(64 * tb_ + lane) * 8 + d_ * 4 + h_]; \
        const float* sp_ = WSP(float, SC_SSD_S) + (size_t)cslot((tb_ * 4 + h_) * 2 + d_) * 8192; \
        _Pragma("unroll") for (int q = 0; q < 4; ++q) sq[q] = *(const f32x4*)(sp_ + (tid + NTHR * q) * 4); } while (0)
    int u3 = (p.bid + p.G - (160 % p.G)) % p.G + (layer == NL - 1 ? 32 : 0);
    if (u3 < NTB * 8) SSD2_LOAD(u3);
    for (; u3 < NTB * 8; u3 += p.G) { const int tb = u3 >> 3, g = (u3 >> 2) & 1, hd = u3 & 3, h = 2 * g + (hd >> 1), d = hd & 1, s0 = 64 * tb; (void)g;
        LAS unsigned char* img = lds + 43520 + par * 44544; par ^= 1;
        LAS unsigned char* Ct = img; LAS unsigned char* Sb = img + 64 * TS2; LAS unsigned char* xT = img + 2 * 64 * TS2; LAS float* AC = (LAS float*)(img + 2 * 64 * TS2 + 64 * TS);
        if (wave == 0) { const float aneg = -__expf(alogp[(layer * 2 + d) * 4 + h]); float tot; AC[lane] = ssd_acum(aneg * dtq, d, lane, tot); }
#pragma unroll
        for (int q = 0; q < 2; ++q) { const int e = tid + NTHR * q, i = e >> 4, ch = e & 15;
            *(LAS u32x4*)(Ct + i * TS2 + ch * 16) = cq[q]; *(LAS u32x4*)(Bt2 + i * TS2 + ch * 16) = bq[q]; }
#pragma unroll
        for (int k = 0; k < 8; ++k) *(LAS bf16_t*)(xT + (8 * wave + k) * TS + lane * 2) = (bf16_t)f2bf(bf2f((bf16_t)(xq[k >> 1] >> (16 * (k & 1)))) * dtq);
        if (d == 0) *(u32x4*)(WSP(bf16_t, SC_PX) + (size_t)(s0 + lane) * 256 + 64 * h + 8 * wave) = xq;
#pragma unroll
        for (int q = 0; q < 4; ++q) { const int e = (tid + NTHR * q) * 4, pp = e >> 7, s = e & 127; const f32x4 v = sq[q];
            *(LAS u32x2*)(Sb + pp * TS2 + s * 2) = (u32x2){pk2(v[0], v[1]), pk2(v[2], v[3])}; }
        if (u3 + p.G < NTB * 8) SSD2_LOAD(u3 + p.G);
        __syncthreads();
        { f32x4 acc[2] = {(f32x4){0.f, 0.f, 0.f, 0.f}, (f32x4){0.f, 0.f, 0.f, 0.f}};
          mm_rows<128, 2>(Bt2, TS2, Ct, TS2, mt, nt0, fr, fq, acc);
#pragma unroll
          for (int t = 0; t < 2; ++t) { const int i = 16 * (nt0 + t) + fr, j0 = 16 * mt + 4 * fq; const float ai = AC[i]; float m4[4];
#pragma unroll
              for (int q = 0; q < 4; ++q) { const int j = j0 + q; const bool keep = d ? j >= i : j <= i; const float aj = AC[j]; m4[q] = keep ? acc[t][q] * __expf(ai - aj) : 0.f; }
              *(LAS u32x2*)(Mt + i * TS + j0 * 2) = (u32x2){pk2(m4[0], m4[1]), pk2(m4[2], m4[3])}; } }
        __syncthreads();
        { f32x4 acc[2] = {(f32x4){0.f, 0.f, 0.f, 0.f}, (f32x4){0.f, 0.f, 0.f, 0.f}};
          mm_rows<128, 2>(Sb, TS2, Ct, TS2, mt, nt0, fr, fq, acc);
#pragma unroll
          for (int t = 0; t < 2; ++t) { const float sc = __expf(AC[16 * (nt0 + t) + fr]); acc[t] *= sc; }
          mm_rows<64, 2>(xT, TS, Mt, TS, mt, nt0, fr, fq, acc);
          bf16_t* ob = WSP(bf16_t, d ? SC_OB : SC_OF);
#pragma unroll
          for (int t = 0; t < 2; ++t) *(u32x2*)(ob + (size_t)(s0 + 16 * (nt0 + t) + fr) * 1024 + 512 + 64 * h + 16 * mt + 4 * fq) = (u32x2){pk2(acc[t][0], acc[t][1]), pk2(acc[t][2], acc[t][3])}; }
    }
}
#undef SSD2_LOAD
constexpr int AFS = 68;
__device__ __forceinline__ int dr_mfrag_idx(int row, int col) { return (((row >> 4) * 2 + (col >> 5)) * 64 + ((col >> 2) & 3) * 16 + (row & 15)) * 8 + ((col >> 4) & 1) * 4 + (col & 3); }
__device__ __forceinline__ void dr_tinv(const LAS float* AfT, LAS float* Dbuf, const float sgn) {
    LAS unsigned char* TI = (LAS unsigned char*)Dbuf;
    { const int lane = lane_id_asm(), kb_ = lane >> 4, cc = lane & 15; float x[16];
#pragma unroll
        for (int i = 0; i < 16; ++i) x[i] = i == cc ? 1.f : 0.f;
        const LAS float* Ab = AfT + (16 * kb_) * AFS + 16 * kb_;
        f32x4 tri[36];
        { int q = 0;
#pragma unroll
          for (int j = 0; j < 15; ++j)
#pragma unroll
              for (int c4 = (j + 1) / 4; c4 < 4; ++c4) tri[q++] = *(const LAS f32x4*)(Ab + j * AFS + 4 * c4); }
        asm volatile("s_waitcnt lgkmcnt(0)" ::: "memory");
        { int q = 0;
#pragma unroll
          for (int j = 0; j < 15; ++j) { const float xj = sgn * x[j];
#pragma unroll
              for (int c4 = (j + 1) / 4; c4 < 4; ++c4) { const f32x4 t = tri[q++];
#pragma unroll
                  for (int e = 0; e < 4; ++e) if (4 * c4 + e > j) x[4 * c4 + e] -= t[e] * xj; } } }
        { u32x4 w0, w1;
#pragma unroll
          for (int i = 0; i < 16; ++i) *(LAS bf16_t*)(TI + ((kb_ * 16 + i) * 16 + cc) * 2) = (bf16_t)f2bf(x[i]); (void)w0; (void)w1; } }
}
template <class RhsF> __device__ __forceinline__ void dr_solve(const LAS unsigned char* Abf, LAS unsigned char* XT, const LAS float* Dbuf, const float sgn, const int wave, const RhsF& rhs, bf16_t* wu) {
    const LAS unsigned char* TI = (const LAS unsigned char*)Dbuf;
    { const int lane = lane_id_asm(), fr = lane & 15, fq = lane >> 4, col = 16 * wave + fr; u32x4 bx[2] = {(u32x4){0u, 0u, 0u, 0u}, (u32x4){0u, 0u, 0u, 0u}};
      float rv[4][4]; u32x2 af[6][2], tf[4];
#pragma unroll
      for (int k = 0; k < 4; ++k) {
#pragma unroll
          for (int j = 0; j < 4; ++j) rv[k][j] = rhs(16 * k + 4 * fq + j, col);
          tf[k] = *(const LAS u32x2*)(TI + ((k * 16 + fr) * 16 + 4 * fq) * 2); }
#pragma unroll
      for (int k = 1; k < 4; ++k)
#pragma unroll
          for (int ks = 0; ks < 2; ++ks) if (k > 2 * ks) { const int s = (k - 1) + (ks ? 2 : 0) + (k == 3 && ks == 0 ? 0 : 0);
              af[s][0] = *(const LAS u32x2*)(Abf + (16 * k + fr) * TS + (32 * ks + 4 * fq) * 2); af[s][1] = *(const LAS u32x2*)(Abf + (16 * k + fr) * TS + (32 * ks + 16 + 4 * fq) * 2); }
#pragma unroll
      for (int k = 0; k < 4; ++k) { f32x4 acc = (f32x4){0.f, 0.f, 0.f, 0.f};
#pragma unroll
          for (int ks = 0; ks < 2; ++ks) if (k > 2 * ks) { const int s = (k - 1) + (ks ? 2 : 0);
              acc = __builtin_amdgcn_mfma_f32_16x16x32_bf16(__builtin_bit_cast(bf16x8, (u32x4){af[s][0][0], af[s][0][1], af[s][1][0], af[s][1][1]}), __builtin_bit_cast(bf16x8, bx[ks]), acc, 0, 0, 0); }
          float dd[4];
#pragma unroll
          for (int j = 0; j < 4; ++j) dd[j] = rv[k][j] - sgn * acc[j];
          const f32x4 xk = __builtin_amdgcn_mfma_f32_16x16x32_bf16(__builtin_bit_cast(bf16x8, (u32x4){tf[k][0], tf[k][1], 0u, 0u}), __builtin_bit_cast(bf16x8, (u32x4){pk2(dd[0], dd[1]), pk2(dd[2], dd[3]), 0u, 0u}), (f32x4){0.f, 0.f, 0.f, 0.f}, 0, 0, 0);
          const unsigned p0 = pk2(xk[0], xk[1]), p1 = pk2(xk[2], xk[3]);
          bx[k >> 1][(k & 1) * 2] = p0; bx[k >> 1][(k & 1) * 2 + 1] = p1;
          *(LAS u32x2*)(XT + col * TS + (16 * k + 4 * fq) * 2) = (u32x2){p0, p1};
#pragma unroll
          for (int j = 0; j < 4; ++j) if (wave < 4) wu[(16 * k + 4 * fq + j) * 64 + col] = (bf16_t)f2bf(xk[j]);
          if (wave >= 4) *(u32x2*)(wu + 4096 + (((wave - 4) * 4 + k) * 64 + lane) * 4) = (u32x2){p0, p1}; } }
    __syncthreads();
}
template <class RhsF> __device__ __forceinline__ void dr_block_solve(const LAS unsigned char* Abf, const LAS float* AfT, LAS unsigned char* XT, LAS float* Dbuf, const float sgn, const int wave, const RhsF& rhs, bf16_t* wu) {
    if (wave == 0) dr_tinv(AfT, Dbuf, sgn);
    __syncthreads();
    dr_solve(Abf, XT, Dbuf, sgn, wave, rhs, wu);
}
struct GdnRhs { const LAS unsigned char* kb; const LAS unsigned char* vb; const LAS float* GC;
    __device__ __forceinline__ float operator()(int r, int col) const { return col < 64 ? bf2f(*(const LAS bf16_t*)(kb + r * TS + col * 2)) * __expf(GC[r]) : bf2f(*(const LAS bf16_t*)(vb + r * TS + (col - 64) * 2)); } };
__device__ __forceinline__ void gdn_p1(const Cx& p, LAS unsigned char* lds, int layer, int b) {
    const int wave = __builtin_amdgcn_readfirstlane(p.tid >> 6);
#define GDN_LANES const int lane = lane_id_asm(), tid = wave * 64 + lane, fr = lane & 15, fq = lane >> 4; (void)tid; (void)fr; (void)fq
    LAS unsigned char* kh = lds; LAS unsigned char* kb = lds + 64 * TS; LAS unsigned char* vb = lds + 2 * 64 * TS; LAS unsigned char* Abf = lds + 3 * 64 * TS; LAS unsigned char* kdT = lds + 4 * 64 * TS; LAS unsigned char* XT = lds + 5 * 64 * TS;
    LAS float* Af = (LAS float*)(lds + 7 * 64 * TS); LAS float* Dbuf = Af + 64 * AFS; LAS float* GC = Dbuf + 128 * 20;
    const int mt = wave >> 1, nt0 = (wave & 1) * 2;
    float gq, beta; u32x4 kv, vv;
#define GDN1_LOAD(uu) do { const int tb_ = (uu) >> 3, h_ = ((uu) >> 1) & 3, d_ = (uu) & 1; const int lane_ = lane_id_asm(), tid_ = wave * 64 + lane_; \
        const bf16_t* dq_ = WSP(bf16_t, SC_DQ) + (size_t)(64 * tb_) * 768; const float* dg_ = WSP(float, SC_DG) + (size_t)(64 * tb_) * 16; \
        gq = dg_[(d_ ? 63 - lane_ : lane_) * 16 + 8 + d_ * 4 + h_]; \
        { const int r_ = tid_ >> 3, c0_ = (tid_ & 7) * 8, i_ = d_ ? 63 - r_ : r_; beta = dg_[i_ * 16 + d_ * 4 + h_]; \
          kv = *(const u32x4*)(dq_ + (size_t)i_ * 768 + 256 + 64 * h_ + c0_); vv = *(const u32x4*)(dq_ + (size_t)i_ * 768 + 512 + 64 * h_ + c0_); } } while (0)
    int u = (p.bid + p.G - (64 % p.G)) % p.G;
    if (u < NUNIT) GDN1_LOAD(u);
    for (; u < NUNIT; u += p.G) {
        if (wave == 0) { GDN_LANES; float pre = gq;
#pragma unroll
            for (int o = 1; o < 64; o <<= 1) { const float t = shup_(pre, lane, o); if (lane >= o) pre += t; }
            GC[lane] = pre; }
        { GDN_LANES; const int r = tid >> 3, c0 = (tid & 7) * 8; u32x4 kw, vw;
#pragma unroll
          for (int q = 0; q < 4; ++q) { kw[q] = pk2(__uint_as_float(kv[q] << 16) * beta, __uint_as_float(kv[q] & 0xffff0000u) * beta); vw[q] = pk2(__uint_as_float(vv[q] << 16) * beta, __uint_as_float(vv[q] & 0xffff0000u) * beta); }
          *(LAS u32x4*)(kh + r * TS + c0 * 2) = kv; *(LAS u32x4*)(kb + r * TS + c0 * 2) = kw; *(LAS u32x4*)(vb + r * TS + c0 * 2) = vw;
 }
        if (u + p.G < NUNIT) GDN1_LOAD(u + p.G);
        __syncthreads();
        const float gtot = GC[63];
        { GDN_LANES; f32x4 acc[2] = {(f32x4){0.f, 0.f, 0.f, 0.f}, (f32x4){0.f, 0.f, 0.f, 0.f}};
          mm_rows<64, 2>(kh, TS, kb, TS, mt, nt0, fr, fq, acc);
          float gj[4], gr[2];
#pragma unroll
          for (int j = 0; j < 4; ++j) gj[j] = GC[16 * mt + 4 * fq + j];
#pragma unroll
          for (int t = 0; t < 2; ++t) gr[t] = GC[16 * (nt0 + t) + fr];
#pragma unroll
          for (int t = 0; t < 2; ++t) { const int r = 16 * (nt0 + t) + fr, j0 = 16 * mt + 4 * fq; float a4[4];
#pragma unroll
              for (int j = 0; j < 4; ++j) a4[j] = j0 + j < r ? acc[t][j] * __expf(gr[t] - gj[j]) : 0.f;
              *(LAS u32x2*)(Abf + r * TS + j0 * 2) = (u32x2){pk2(a4[0], a4[1]), pk2(a4[2], a4[3])};
              if (mt == nt0 + t) {
#pragma unroll
                  for (int j = 0; j < 4; ++j) Af[(j0 + j) * AFS + r] = a4[j]; } }
          { bf16_t kraw[8]; float gcr[8];
#pragma unroll
            for (int q = 0; q < 8; ++q) { const int e = tid + NTHR * q, r = e >> 6, cc = e & 63; kraw[q] = *(const LAS bf16_t*)(kh + r * TS + cc * 2); gcr[q] = GC[r]; }
#pragma unroll
            for (int q = 0; q < 8; ++q) { const int e = tid + NTHR * q, r = e >> 6, cc = e & 63; *(LAS bf16_t*)(kdT + cc * TS + r * 2) = (bf16_t)f2bf(bf2f(kraw[q]) * __expf(gtot - gcr[q])); } } }
        __syncthreads();
        { const GdnRhs rhs{kb, vb, GC}; dr_block_solve(Abf, Af, XT, Dbuf, 1.0f, wave, rhs, WSP(bf16_t, SC_DR_WU) + (size_t)u * 8192); }
        { GDN_LANES; f32x4 am[2] = {(f32x4){0.f, 0.f, 0.f, 0.f}, (f32x4){0.f, 0.f, 0.f, 0.f}}, an[2] = {(f32x4){0.f, 0.f, 0.f, 0.f}, (f32x4){0.f, 0.f, 0.f, 0.f}};
          mm_rows<64, 2>(XT, TS, kdT, TS, mt, nt0, fr, fq, am);
          mm_rows<64, 2>(kdT, TS, XT + 64 * TS, TS, mt, nt0, fr, fq, an);
          bf16_t* Mg = WSP(bf16_t, SC_DR_M) + (size_t)cslot(u) * 4096; bf16_t* Ng = WSP(bf16_t, SC_DR_NS) + (size_t)cslot(u) * 4096; const float eg = __expf(gtot);
#pragma unroll
          for (int t = 0; t < 2; ++t) {
              { const int row = 16 * (nt0 + t) + fr, col0 = 16 * mt + 4 * fq; float m4[4];
#pragma unroll
                for (int j = 0; j < 4; ++j) m4[j] = (row == col0 + j ? eg : 0.f) - am[t][j];
                *(u32x2*)(Mg + dr_mfrag_idx(row, col0)) = (u32x2){pk2(m4[0], m4[1]), pk2(m4[2], m4[3])}; }
              *(u32x2*)(Ng + (((nt0 + t) * 2 + (mt >> 1)) * 64 + lane) * 8 + (mt & 1) * 4) = (u32x2){pk2(an[t][0], an[t][1]), pk2(an[t][2], an[t][3])}; } }
    }
#undef GDN_LANES
#undef GDN1_LOAD
}
__device__ __forceinline__ void dr_chain(const Cx& p, size_t offM, size_t offNS, int h, int d, int cb) {
    const int lane = p.tid & 63, fr = lane & 15, fq = lane >> 4;
    if (p.tid >= 64) return;
    f32x4 acc[4];
#pragma unroll
    for (int t = 0; t < 4; ++t) acc[t] = (f32x4){0.f, 0.f, 0.f, 0.f};
    bf16x8 mR[4][4][2]; u32x4 nR[4][2];
#define DR_LD(m, nn, n_) do { const int u_ = cslot((chain_tb((n_), d) * 4 + h) * 2 + d); const bf16_t* M_ = WSP(bf16_t, offM) + (size_t)u_ * 4096; const bf16_t* N_ = WSP(bf16_t, offNS) + (size_t)u_ * 4096; \
        _Pragma("unroll") for (int t = 0; t < 4; ++t) { _Pragma("unroll") for (int ks = 0; ks < 2; ++ks) m[t][ks] = *(const bf16x8*)(M_ + ((t * 2 + ks) * 64 + lane) * 8); } \
        _Pragma("unroll") for (int pr = 0; pr < 2; ++pr) nn[pr] = *(const u32x4*)(N_ + ((cb * 2 + pr) * 64 + lane) * 8); } while (0)
#define DR_STEP(m, nn, n_) do { const int u_ = cslot((chain_tb((n_), d) * 4 + h) * 2 + d); bf16_t* ST_ = WSP(bf16_t, offNS) + (size_t)u_ * 4096 + (16 * cb + fr) * 64 + 16 * fq; \
        u32x2 sp_[4]; _Pragma("unroll") for (int t = 0; t < 4; ++t) sp_[t] = (u32x2){pk2(acc[t][0], acc[t][1]), pk2(acc[t][2], acc[t][3])}; \
        *(u32x4*)ST_ = (u32x4){sp_[0][0], sp_[0][1], sp_[1][0], sp_[1][1]}; *(u32x4*)(ST_ + 8) = (u32x4){sp_[2][0], sp_[2][1], sp_[3][0], sp_[3][1]};        \
        bf16x8 bf_[2]; _Pragma("unroll") for (int ks = 0; ks < 2; ++ks) { u32x4 w_ = (u32x4){sp_[2 * ks][0], sp_[2 * ks][1], sp_[2 * ks + 1][0], sp_[2 * ks + 1][1]}; bf_[ks] = __builtin_bit_cast(bf16x8, w_); } \
        _Pragma("unroll") for (int t = 0; t < 4; ++t) { const unsigned n0_ = nn[t >> 1][(t & 1) * 2], n1_ = nn[t >> 1][(t & 1) * 2 + 1]; f32x4 a_ = (f32x4){__uint_as_float(n0_ << 16), __uint_as_float(n0_ & 0xffff0000u), __uint_as_float(n1_ << 16), __uint_as_float(n1_ & 0xffff0000u)}; \
            a_ = __builtin_amdgcn_mfma_f32_16x16x32_bf16(m[t][0], bf_[0], a_, 0, 0, 0); acc[t] = __builtin_amdgcn_mfma_f32_16x16x32_bf16(m[t][1], bf_[1], a_, 0, 0, 0); } } while (0)
#define DR_GO(q, n_) do { DR_STEP(mR[q], nR[q], (n_)); DR_LD(mR[q], nR[q], (n_) + 4 < NTB ? (n_) + 4 : NTB - 1); } while (0)
    DR_LD(mR[0], nR[0], 0); DR_LD(mR[1], nR[1], 1); DR_LD(mR[2], nR[2], 2); DR_LD(mR[3], nR[3], 3);
#pragma unroll 1
    for (int n = 0; n < NTB; n += 4) { DR_GO(0, n); DR_GO(1, n + 1); DR_GO(2, n + 2); DR_GO(3, n + 3); }
#undef DR_GO
#undef DR_LD
#undef DR_STEP
}
__device__ __forceinline__ void gdn_p2(const Cx& p, LAS unsigned char* lds0, int layer, int b) {
    const int tid = p.tid, lane = tid & 63, wave = __builtin_amdgcn_readfirstlane(tid >> 6), fr = lane & 15, fq = lane >> 4;
    int par = 0;
    const int mt = wave >> 1, nt0 = (wave & 1) * 2;
    float gq; u32x2 upre[2]; u32x4 qv, kv, wv, sv;
#define GDN2_LOAD(uu) do { const int tb_ = (uu) >> 3, h_ = ((uu) >> 1) & 3, d_ = (uu) & 1; \
        const bf16_t* dq_ = WSP(bf16_t, SC_DQ) + (size_t)(64 * tb_) * 768; const float* dg_ = WSP(float, SC_DG) + (size_t)(64 * tb_) * 16; \
        const bf16_t* wu_ = WSP(bf16_t, SC_DR_WU) + (size_t)(uu) * 8192; const bf16_t* st_ = WSP(bf16_t, SC_DR_NS) + (size_t)cslot(uu) * 4096; \
        gq = dg_[(d_ ? 63 - lane : lane) * 16 + 8 + d_ * 4 + h_]; \
        _Pragma("unroll") for (int t = 0; t < 2; ++t) upre[t] = *(const u32x2*)(wu_ + 4096 + (((nt0 + t) * 4 + mt) * 64 + lane) * 4); \
        { const int r_ = tid >> 3, c0_ = (tid & 7) * 8, i_ = d_ ? 63 - r_ : r_; \
          qv = *(const u32x4*)(dq_ + (size_t)i_ * 768 + 64 * h_ + c0_); kv = *(const u32x4*)(dq_ + (size_t)i_ * 768 + 256 + 64 * h_ + c0_); \
          wv = *(const u32x4*)(wu_ + r_ * 64 + c0_); sv = *(const u32x4*)(st_ + r_ * 64 + c0_); } } while (0)
    int u = (p.bid + p.G - (192 % p.G)) % p.G + (layer == NL - 1 ? 32 : 0);
    if (u < NUNIT) GDN2_LOAD(u);
    for (; u < NUNIT; u += p.G) { const int tb = u >> 3, h = (u >> 1) & 3, d = u & 1, s0 = 64 * tb;
        LAS unsigned char* lds = lds0 + par * 57344; par ^= 1;
        LAS unsigned char* qh = lds; LAS unsigned char* kh = lds + 64 * TS; LAS unsigned char* wt = lds + 2 * 64 * TS; LAS unsigned char* sT = lds + 3 * 64 * TS; LAS unsigned char* aq = lds + 4 * 64 * TS; LAS unsigned char* vnT = lds + 5 * 64 * TS;
        LAS float* GC = (LAS float*)(lds + 6 * 64 * TS);
        if (wave == 0) { float pre = gq;
#pragma unroll
            for (int o = 1; o < 64; o <<= 1) { const float t = shup_(pre, lane, o); if (lane >= o) pre += t; }
            GC[lane] = pre; }
        float ucur[2][4];
#pragma unroll
        for (int t = 0; t < 2; ++t) { ucur[t][0] = __uint_as_float(upre[t][0] << 16); ucur[t][1] = __uint_as_float(upre[t][0] & 0xffff0000u); ucur[t][2] = __uint_as_float(upre[t][1] << 16); ucur[t][3] = __uint_as_float(upre[t][1] & 0xffff0000u); }
        { const int r = tid >> 3, c0 = (tid & 7) * 8;
          *(LAS u32x4*)(qh + r * TS + c0 * 2) = qv; *(LAS u32x4*)(kh + r * TS + c0 * 2) = kv; *(LAS u32x4*)(wt + r * TS + c0 * 2) = wv; { const int ci = c0 >> 3, sq = ci >> 1, tp = ci & 1;
            *(LAS u32x2*)(sT + r * TS + (32 * tp + 4 * sq) * 2) = (u32x2){sv[0], sv[1]}; *(LAS u32x2*)(sT + r * TS + (32 * tp + 16 + 4 * sq) * 2) = (u32x2){sv[2], sv[3]}; } }
        if (u + p.G < NUNIT) GDN2_LOAD(u + p.G);
        __syncthreads();
        { f32x4 acc[2] = {(f32x4){0.f, 0.f, 0.f, 0.f}, (f32x4){0.f, 0.f, 0.f, 0.f}};
          mm_rows<64, 2>(kh, TS, qh, TS, mt, nt0, fr, fq, acc);
          float gj[4], gr[2];
#pragma unroll
          for (int j = 0; j < 4; ++j) gj[j] = GC[16 * mt + 4 * fq + j];
#pragma unroll
          for (int t = 0; t < 2; ++t) gr[t] = GC[16 * (nt0 + t) + fr];
#pragma unroll
          for (int t = 0; t < 2; ++t) { const int r = 16 * (nt0 + t) + fr, j0 = 16 * mt + 4 * fq; float m4[4];
#pragma unroll
              for (int j = 0; j < 4; ++j) m4[j] = j0 + j <= r ? acc[t][j] * __expf(gr[t] - gj[j]) : 0.f;
              *(LAS u32x2*)(aq + r * TS + j0 * 2) = (u32x2){pk2(m4[0], m4[1]), pk2(m4[2], m4[3])}; }
          f32x4 av[2] = {(f32x4){0.f, 0.f, 0.f, 0.f}, (f32x4){0.f, 0.f, 0.f, 0.f}};
          mm_rows<64, 2>(wt, TS, sT, TS, mt, nt0, fr, fq, av);
#pragma unroll
          for (int t = 0; t < 2; ++t) { const int dv = 16 * (nt0 + t) + fr; float vn[4];
#pragma unroll
              for (int j = 0; j < 4; ++j) vn[j] = ucur[t][j] - av[t][j];
              *(LAS u32x2*)(vnT + dv * TS + (16 * mt + 4 * fq) * 2) = (u32x2){pk2(vn[0], vn[1]), pk2(vn[2], vn[3])}; } }
        __syncthreads();
        { f32x4 acc[2] = {(f32x4){0.f, 0.f, 0.f, 0.f}, (f32x4){0.f, 0.f, 0.f, 0.f}};
          mm_rows<64, 2>(sT, TS, qh, TS, mt, nt0, fr, fq, acc);
#pragma unroll
          for (int t = 0; t < 2; ++t) { const float sc = __expf(GC[16 * (nt0 + t) + fr]); acc[t] *= sc; }
          mm_rows<64, 2>(vnT, TS, aq, TS, mt, nt0, fr, fq, acc);
          bf16_t* ob = WSP(bf16_t, d ? SC_OB : SC_OF);
#pragma unroll
          for (int t = 0; t < 2; ++t) { const int r = 16 * (nt0 + t) + fr, i = d ? 63 - r : r; *(u32x2*)(ob + (size_t)(s0 + i) * 1024 + 768 + 64 * h + 16 * mt + 4 * fq) = (u32x2){pk2(acc[t][0], acc[t][1]), pk2(acc[t][2], acc[t][3])}; } }
    }
}
#undef GDN2_LOAD
constexpr int LPS = 65;
#define RW_LP(LP, GS, lw8) do { const int lane_ = lane_id_asm(), c_ = lane_, tg_ = wave; float loc_[8]; float run_ = 0.f; \
        _Pragma("unroll") for (int ii = 0; ii < 8; ++ii) { run_ += (lw8)[ii]; loc_[ii] = run_; } \
        (GS)[tg_ * 64 + c_] = run_; __syncthreads(); float off_ = 0.f; \
        _Pragma("unroll") for (int g2 = 0; g2 < 8; ++g2) if (g2 < tg_) off_ += (GS)[g2 * 64 + c_]; \
        _Pragma("unroll") for (int ii = 0; ii < 8; ++ii) (LP)[(8 * tg_ + ii) * LPS + c_] = loc_[ii] + off_; __syncthreads(); } while (0)
struct RwRhs { const LAS unsigned char* zt; const LAS unsigned char* RU;
    __device__ __forceinline__ float operator()(int r, int col) const { return col < 64 ? bf2f(*(const LAS bf16_t*)(zt + r * TS + col * 2)) : bf2f(*(const LAS bf16_t*)(RU + (col - 64) * TS + r * 2)); } };
__device__ __forceinline__ void rw_p1(const Cx& p, LAS unsigned char* lds, int layer, int b) {
    const int wave = __builtin_amdgcn_readfirstlane(p.tid >> 6), mt = wave >> 1, nt0 = (wave & 1) * 2;
#define RW_LANES const int lane = lane_id_asm(), tid = wave * 64 + lane, fr = lane & 15, fq = lane >> 4; (void)tid; (void)fr; (void)fq
    LAS float* LP = (LAS float*)lds; LAS float* GS = (LAS float*)(lds + 16640);
    LAS unsigned char* zt = lds + 18688; LAS unsigned char* bt = lds + 27904; LAS unsigned char* kt = lds + 37120; LAS unsigned char* vT = lds + 46336; LAS unsigned char* Azk = lds + 55552;
    LAS float* Af = (LAS float*)(lds + 64768); LAS unsigned char* XT = lds + 82176; LAS unsigned char* Abf = lds + 100608; LAS unsigned char* RU = lds + 109824; LAS float* Dbuf = (LAS float*)(lds + 119040); LAS unsigned char* bhT = lds + 129280;
    const bf16_t* proj = WSP(bf16_t, WS_PROJ);
    float lw8[8]; f32x4 lwv[2], kkv[2], bv[2], kv[2]; bf16_t v8[8];
#define RW1_LOAD(uu) do { const int tb_ = (uu) >> 3, h_ = ((uu) >> 1) & 3, d_ = (uu) & 1, s0_ = 64 * tb_; const int lane_ = lane_id_asm(), tid_ = wave * 64 + lane_; \
        const float* lwp_ = WSP(float, SC_RLW) + (size_t)d_ * SB * 256 + (size_t)s0_ * 256 + 64 * h_; const size_t fo_ = (size_t)s0_ * 256 + 64 * h_; \
        _Pragma("unroll") for (int ii = 0; ii < 8; ++ii) { const int r_ = 8 * wave + ii; lw8[ii] = lwp_[(size_t)(d_ ? 63 - r_ : r_) * 256 + lane_]; } \
        { const int r_ = tid_ >> 3, c0_ = (tid_ & 7) * 8, i_ = d_ ? 63 - r_ : r_; \
          _Pragma("unroll") for (int q = 0; q < 2; ++q) { lwv[q] = *(const f32x4*)(lwp_ + (size_t)i_ * 256 + c0_ + 4 * q); kkv[q] = *(const f32x4*)(WSP(float, SC_RKK) + fo_ + (size_t)i_ * 256 + c0_ + 4 * q); \
              bv[q] = *(const f32x4*)(WSP(float, SC_RB) + fo_ + (size_t)i_ * 256 + c0_ + 4 * q); kv[q] = *(const f32x4*)(WSP(float, SC_RK) + fo_ + (size_t)i_ * 256 + c0_ + 4 * q); } } \
        { const bf16_t* pr0_ = proj + (size_t)tb_row0(b, tb_) * NPROJ; \
          _Pragma("unroll") for (int q = 0; q < 8; ++q) { const int e = tid_ + NTHR * q, r2 = e >> 6, cc = e & 63; v8[q] = pr0_[(size_t)(d_ ? 63 - r2 : r2) * NPROJ + PB_V + 64 * h_ + cc]; } } } while (0)
    int u = (p.bid + p.G - (96 % p.G)) % p.G; if (u >= NUNIT) return;
    RW1_LOAD(u);
    for (;;) { const int d = u & 1;
        RW_LP(LP, GS, lw8);
        { RW_LANES; const int r = tid >> 3, c0 = (tid & 7) * 8; unsigned wz[4], wb[4], wk[4];
#pragma unroll
          for (int q = 0; q < 8; q += 2) { float z2[2], b2[2], k2[2];
#pragma unroll
              for (int e = 0; e < 2; ++e) { const int cq = q + e, c = c0 + cq; const float lp = LP[r * LPS + c], lw = lwv[cq >> 2][cq & 3], em = __expf(-lp);
                  z2[e] = -kkv[cq >> 2][cq & 3] * __expf(lp - lw); b2[e] = bv[cq >> 2][cq & 3] * em; k2[e] = kv[cq >> 2][cq & 3] * em; }
              wz[q >> 1] = pk2(z2[0], z2[1]); wb[q >> 1] = pk2(b2[0], b2[1]); wk[q >> 1] = pk2(k2[0], k2[1]); }
          *(LAS u32x4*)(zt + r * TS + c0 * 2) = (u32x4){wz[0], wz[1], wz[2], wz[3]}; *(LAS u32x4*)(bt + r * TS + c0 * 2) = (u32x4){wb[0], wb[1], wb[2], wb[3]}; *(LAS u32x4*)(kt + r * TS + c0 * 2) = (u32x4){wk[0], wk[1], wk[2], wk[3]};
#pragma unroll
          for (int q = 0; q < 8; ++q) { const int e = tid + NTHR * q, r2 = e >> 6, cc = e & 63; *(LAS bf16_t*)(vT + cc * TS + r2 * 2) = v8[q]; } }
        __syncthreads();
        const int un = u + p.G; const bool more = un < NUNIT;
        if (more) RW1_LOAD(un);
        { RW_LANES; f32x4 a1[2] = {(f32x4){0.f, 0.f, 0.f, 0.f}, (f32x4){0.f, 0.f, 0.f, 0.f}}, a2[2] = {(f32x4){0.f, 0.f, 0.f, 0.f}, (f32x4){0.f, 0.f, 0.f, 0.f}};
          mm_rows<64, 2>(bt, TS, zt, TS, mt, nt0, fr, fq, a1);
          mm_rows<64, 2>(kt, TS, zt, TS, mt, nt0, fr, fq, a2);
#pragma unroll
          for (int t = 0; t < 2; ++t) { const int r = 16 * (nt0 + t) + fr, j0 = 16 * mt + 4 * fq; float a4[4], k4[4];
#pragma unroll
              for (int j = 0; j < 4; ++j) { const bool keep = j0 + j < r; a4[j] = keep ? a1[t][j] : 0.f; k4[j] = keep ? a2[t][j] : 0.f; }
              *(LAS u32x2*)(Abf + r * TS + j0 * 2) = (u32x2){pk2(a4[0], a4[1]), pk2(a4[2], a4[3])}; *(LAS u32x2*)(Azk + r * TS + j0 * 2) = (u32x2){pk2(k4[0], k4[1]), pk2(k4[2], k4[3])};
              if (mt == nt0 + t) {
#pragma unroll
                  for (int j = 0; j < 4; ++j) Af[(j0 + j) * AFS + r] = a4[j]; } } }
        __syncthreads();
        { RW_LANES; f32x4 a[2] = {(f32x4){0.f, 0.f, 0.f, 0.f}, (f32x4){0.f, 0.f, 0.f, 0.f}};
          mm_rows<64, 2>(Azk, TS, vT, TS, mt, nt0, fr, fq, a);
#pragma unroll
          for (int t = 0; t < 2; ++t) *(LAS u32x2*)(RU + (16 * (nt0 + t) + fr) * TS + (16 * mt + 4 * fq) * 2) = (u32x2){pk2(a[t][0], a[t][1]), pk2(a[t][2], a[t][3])};
        }
        if (wave == 0) dr_tinv(Af, Dbuf, -1.0f);
        __syncthreads();
        { RW_LANES;
          const float el = __expf(LP[63 * LPS + (tid & 63)]); bf16_t braw[8], kraw[8];
#pragma unroll
          for (int q = 0; q < 8; ++q) { const int e = tid + NTHR * q, r2 = e >> 6, cc = e & 63; braw[q] = *(const LAS bf16_t*)(bt + r2 * TS + cc * 2); kraw[q] = *(const LAS bf16_t*)(kt + r2 * TS + cc * 2); }
#pragma unroll
          for (int q = 0; q < 8; ++q) { const int e = tid + NTHR * q, r2 = e >> 6, cc = e & 63;
              *(LAS bf16_t*)(bhT + cc * TS + r2 * 2) = (bf16_t)f2bf(bf2f(braw[q]) * el); *(LAS bf16_t*)(Azk + cc * TS + r2 * 2) = (bf16_t)f2bf(bf2f(kraw[q]) * el); } }
        __syncthreads();
        { const RwRhs rhs{zt, RU}; dr_solve(Abf, XT, Dbuf, -1.0f, wave, rhs, WSP(bf16_t, SC_RW_WU) + (size_t)u * 8192); }
        { RW_LANES; f32x4 am[2] = {(f32x4){0.f, 0.f, 0.f, 0.f}, (f32x4){0.f, 0.f, 0.f, 0.f}}, an[2] = {(f32x4){0.f, 0.f, 0.f, 0.f}, (f32x4){0.f, 0.f, 0.f, 0.f}};
          mm_rows<64, 2>(XT, TS, bhT, TS, mt, nt0, fr, fq, am);
          mm_rows<64, 2>(bhT, TS, XT + 64 * TS, TS, mt, nt0, fr, fq, an);
          mm_rows<64, 2>(Azk, TS, vT, TS, mt, nt0, fr, fq, an);
          bf16_t* Mg = WSP(bf16_t, SC_RW_M) + (size_t)cslot(u) * 4096; bf16_t* Ng = WSP(bf16_t, SC_RW_NS) + (size_t)cslot(u) * 4096;
#pragma unroll
          for (int t = 0; t < 2; ++t) {
              { const int row = 16 * (nt0 + t) + fr, col0 = 16 * mt + 4 * fq; const float el = __expf(LP[63 * LPS + row]); float m4[4];
#pragma unroll
                for (int j = 0; j < 4; ++j) m4[j] = (row == col0 + j ? el : 0.f) + am[t][j];
                *(u32x2*)(Mg + dr_mfrag_idx(row, col0)) = (u32x2){pk2(m4[0], m4[1]), pk2(m4[2], m4[3])}; }
              *(u32x2*)(Ng + (((nt0 + t) * 2 + (mt >> 1)) * 64 + lane) * 8 + (mt & 1) * 4) = (u32x2){pk2(an[t][0], an[t][1]), pk2(an[t][2], an[t][3])}; } }
        if (!more) break;
        u = un;
    }
#undef RW1_LOAD
}
__device__ __forceinline__ void rw_p2(const Cx& p, LAS unsigned char* lds, int layer, int b) {
    const int wave = __builtin_amdgcn_readfirstlane(p.tid >> 6), mt = wave >> 1, nt0 = (wave & 1) * 2;
    LAS float* LP = (LAS float*)lds; LAS float* GS = (LAS float*)(lds + 16640);
    LAS unsigned char* rt = lds + 18688; LAS unsigned char* bt = lds + 27904; LAS unsigned char* kt = lds + 37120; LAS unsigned char* vT = lds + 46336; LAS unsigned char* sT = lds + 55552; LAS unsigned char* wt = lds + 64768;
    LAS unsigned char* Arb = lds + 73984; LAS unsigned char* Ark = lds + 83200; LAS unsigned char* UT = lds + 92416;
    const bf16_t* proj = WSP(bf16_t, WS_PROJ);
    u32x2 upre[2]; float lw8[8]; u32x4 rv, wv, sv, vq; f32x4 bv[2], kv[2];
#define RW2_LOAD(uu) do { const int tb_ = (uu) >> 3, h_ = ((uu) >> 1) & 3, d_ = (uu) & 1, s0_ = 64 * tb_; const int lane_ = lane_id_asm(), tid_ = wave * 64 + lane_, fr_ = lane_ & 15, fq_ = lane_ >> 4; \
        const float* lwp_ = WSP(float, SC_RLW) + (size_t)d_ * SB * 256 + (size_t)s0_ * 256 + 64 * h_; const float* rk_ = WSP(float, SC_RK) + (size_t)s0_ * 256 + 64 * h_; const float* rb_ = WSP(float, SC_RB) + (size_t)s0_ * 256 + 64 * h_; \
        const bf16_t* pr_ = proj + (size_t)tb_row0(b, tb_) * NPROJ; const bf16_t* wu_ = WSP(bf16_t, SC_RW_WU) + (size_t)(uu) * 8192; const bf16_t* st_ = WSP(bf16_t, SC_RW_NS) + (size_t)cslot(uu) * 4096; \
        _Pragma("unroll") for (int t = 0; t < 2; ++t) upre[t] = *(const u32x2*)(wu_ + 4096 + (((nt0 + t) * 4 + mt) * 64 + lane_) * 4); \
        _Pragma("unroll") for (int ii = 0; ii < 8; ++ii) { const int r_ = 8 * wave + ii; lw8[ii] = lwp_[(size_t)(d_ ? 63 - r_ : r_) * 256 + lane_]; } \
        { const int r_ = tid_ >> 3, c0_ = (tid_ & 7) * 8, i_ = d_ ? 63 - r_ : r_; rv = *(const u32x4*)(pr_ + (size_t)i_ * NPROJ + PB_R + 64 * h_ + c0_); \
          _Pragma("unroll") for (int q = 0; q < 2; ++q) { bv[q] = *(const f32x4*)(rb_ + (size_t)i_ * 256 + c0_ + 4 * q); kv[q] = *(const f32x4*)(rk_ + (size_t)i_ * 256 + c0_ + 4 * q); } \
          wv = *(const u32x4*)(wu_ + r_ * 64 + c0_); sv = *(const u32x4*)(st_ + r_ * 64 + c0_); } \
        vq = *(const u32x4*)(pr_ + (size_t)(d_ ? 63 - lane_ : lane_) * NPROJ + PB_V + 64 * h_ + 8 * wave); } while (0)
    int u = (p.bid + p.G - (224 % p.G)) % p.G + (layer == NL - 1 ? 32 : 0);
    if (u < NUNIT) RW2_LOAD(u);
    for (; u < NUNIT; u += p.G) { const int tb = u >> 3, h = (u >> 1) & 3, d = u & 1, s0 = 64 * tb;
        float ucur[2][4];
#pragma unroll
        for (int t = 0; t < 2; ++t) { ucur[t][0] = __uint_as_float(upre[t][0] << 16); ucur[t][1] = __uint_as_float(upre[t][0] & 0xffff0000u); ucur[t][2] = __uint_as_float(upre[t][1] << 16); ucur[t][3] = __uint_as_float(upre[t][1] & 0xffff0000u); }
        RW_LP(LP, GS, lw8);
        { RW_LANES; const int r = tid >> 3, c0 = (tid & 7) * 8; unsigned wr[4], wb[4], wk[4];
#pragma unroll
          for (int q = 0; q < 8; q += 2) { float r2[2], b2[2], k2[2];
#pragma unroll
              for (int e = 0; e < 2; ++e) { const int cq = q + e, c = c0 + cq; const float lp = LP[r * LPS + c], em = __expf(-lp); const unsigned w = rv[q >> 1];
                  r2[e] = (e ? __uint_as_float(w & 0xffff0000u) : __uint_as_float(w << 16)) * __expf(lp); b2[e] = bv[cq >> 2][cq & 3] * em; k2[e] = kv[cq >> 2][cq & 3] * em; }
              wr[q >> 1] = pk2(r2[0], r2[1]); wb[q >> 1] = pk2(b2[0], b2[1]); wk[q >> 1] = pk2(k2[0], k2[1]); }
          if (d == 0) *(u32x4*)(WSP(bf16_t, SC_PK) + (size_t)(s0 + r) * 256 + 64 * h + c0) = (u32x4){pk2(kv[0][0], kv[0][1]), pk2(kv[0][2], kv[0][3]), pk2(kv[1][0], kv[1][1]), pk2(kv[1][2], kv[1][3])};
          *(LAS u32x4*)(rt + r * TS + c0 * 2) = (u32x4){wr[0], wr[1], wr[2], wr[3]}; *(LAS u32x4*)(bt + r * TS + c0 * 2) = (u32x4){wb[0], wb[1], wb[2], wb[3]}; *(LAS u32x4*)(kt + r * TS + c0 * 2) = (u32x4){wk[0], wk[1], wk[2], wk[3]};
          *(LAS u32x4*)(wt + r * TS + c0 * 2) = wv; { const int ci = c0 >> 3, sq = ci >> 1, tp = ci & 1;
            *(LAS u32x2*)(sT + r * TS + (32 * tp + 4 * sq) * 2) = (u32x2){sv[0], sv[1]}; *(LAS u32x2*)(sT + r * TS + (32 * tp + 16 + 4 * sq) * 2) = (u32x2){sv[2], sv[3]}; }
#pragma unroll
          for (int k = 0; k < 8; ++k) *(LAS bf16_t*)(vT + (8 * wave + k) * TS + lane * 2) = (bf16_t)(vq[k >> 1] >> (16 * (k & 1))); }
        if (u + p.G < NUNIT) RW2_LOAD(u + p.G);
        __syncthreads();
        { RW_LANES; f32x4 a1[2] = {(f32x4){0.f, 0.f, 0.f, 0.f}, (f32x4){0.f, 0.f, 0.f, 0.f}}, a2[2] = {(f32x4){0.f, 0.f, 0.f, 0.f}, (f32x4){0.f, 0.f, 0.f, 0.f}}, a3[2] = {(f32x4){0.f, 0.f, 0.f, 0.f}, (f32x4){0.f, 0.f, 0.f, 0.f}};
          mm_rows<64, 2>(bt, TS, rt, TS, mt, nt0, fr, fq, a1); mm_rows<64, 2>(kt, TS, rt, TS, mt, nt0, fr, fq, a2); mm_rows<64, 2>(wt, TS, sT, TS, mt, nt0, fr, fq, a3);
#pragma unroll
          for (int t = 0; t < 2; ++t) { const int r = 16 * (nt0 + t) + fr, j0 = 16 * mt + 4 * fq; float m1[4], m2[4];
#pragma unroll
              for (int j = 0; j < 4; ++j) { const bool keep = j0 + j <= r; m1[j] = keep ? a1[t][j] : 0.f; m2[j] = keep ? a2[t][j] : 0.f; }
              *(LAS u32x2*)(Arb + r * TS + j0 * 2) = (u32x2){pk2(m1[0], m1[1]), pk2(m1[2], m1[3])}; *(LAS u32x2*)(Ark + r * TS + j0 * 2) = (u32x2){pk2(m2[0], m2[1]), pk2(m2[2], m2[3])}; }
#pragma unroll
          for (int t = 0; t < 2; ++t) { const int dv = 16 * (nt0 + t) + fr; float uu[4];
#pragma unroll
              for (int j = 0; j < 4; ++j) uu[j] = ucur[t][j] + a3[t][j];
              *(LAS u32x2*)(UT + dv * TS + (16 * mt + 4 * fq) * 2) = (u32x2){pk2(uu[0], uu[1]), pk2(uu[2], uu[3])}; } }
        __syncthreads();
        { RW_LANES; f32x4 acc[2] = {(f32x4){0.f, 0.f, 0.f, 0.f}, (f32x4){0.f, 0.f, 0.f, 0.f}};
          mm_rows<64, 2>(sT, TS, rt, TS, mt, nt0, fr, fq, acc); mm_rows<64, 2>(UT, TS, Arb, TS, mt, nt0, fr, fq, acc); mm_rows<64, 2>(vT, TS, Ark, TS, mt, nt0, fr, fq, acc);
          bf16_t* ob = WSP(bf16_t, d ? SC_OB : SC_OF);
#pragma unroll
          for (int t = 0; t < 2; ++t) { const int r = 16 * (nt0 + t) + fr, i = d ? 63 - r : r; *(u32x2*)(ob + (size_t)(s0 + i) * 1024 + 256 + 64 * h + 16 * mt + 4 * fq) = (u32x2){pk2(acc[t][0], acc[t][1]), pk2(acc[t][2], acc[t][3])}; } }
    }
#undef RW_LANES
#undef RW2_LOAD
}
constexpr int PB_DEFER_M = 4;
__device__ __forceinline__ void phase_scan(const Cx& p, LAS unsigned char* lds, int layer, int b) {
    if (p.G >= 160 + PB_DEFER_M * 16 && b == 0 && (int)p.bid >= 160) {
        HostSched S{PB_DEFER_M * 16, (int)p.bid - 160, D, NPROJ / 256, ROWS / 256 - PB_DEFER_M, PB_DEFER_M, 0, (const char*)(WSP(bf16_t, WS_WIN) + (size_t)layer * NPROJ * D)};
        EpiProj E{WSP(bf16_t, WS_PROJ), NPROJ};
        pg8::gemm_phase<D>(p.tid, lds, (const char*)WSP(bf16_t, WS_HBUF), S, E);
        return;
    }
    if (p.G >= 256 && layer == 0 && b == 1 && (int)p.bid >= 160 && (int)p.bid < 176) {
        HostSched S{16, (int)p.bid - 160, D, D / 256, 4, 4, 0, (const char*)(WSP(bf16_t, WS_WOUT) + (size_t)layer * D * D)};
        EpiRes E{PIN(I_X), PIN(I_CTX), POUT, WSP(float, WS_CTXRES), WSP(float, WS_MOD) + (size_t)layer * 5 * 6144 + 2048};
        pg8::gemm_phase<D>(p.tid, lds, (const char*)WSP(bf16_t, WS_HBUF), S, E);
        return;
    }
    for (int w = p.bid; w < 160; w += p.G) {
        if (w < 64) ssd_chain(p, (w >> 4) & 3, (w >> 3) & 1, w & 7);
        else if (w < 96) gla_chain(p, ((w - 64) >> 3) & 3, ((w - 64) >> 2) & 1, (w - 64) & 3);
        else { const int i = w - 96, h = (i >> 3) & 3, d = (i >> 2) & 1, cb = i & 3;
            if (i < 32) dr_chain(p, SC_RW_M, SC_RW_NS, h, d, cb); else dr_chain(p, SC_DR_M, SC_DR_NS, h, d, cb); } }
}
#ifndef MK_ONE_LAUNCH
#define MK_ONE_LAUNCH 1
#endif
constexpr int PH_PER_LAYER = 2 + (1 + 4 * NB) + 7;
constexpr int N_PHASES = 1 + NL * PH_PER_LAYER;

__global__ void __launch_bounds__(NTHR, 2) mega_fwd(Params pp) {
    extern __shared__ __attribute__((aligned(16))) unsigned char lds_raw[];
    LAS unsigned char* lds = (LAS unsigned char*)lds_raw;
    const int swave = __builtin_amdgcn_readfirstlane(threadIdx.x >> 6);
    for (int i = threadIdx.x; i < (LDS_BYTES - LDS_CTL) / 4; i += NTHR) ((LAS unsigned*)(lds + LDS_CTL))[i] = 0u;
    __syncthreads();
    if (threadIdx.x < N_IN + 2) { const unsigned long long a = threadIdx.x < N_IN ? (unsigned long long)pp.in[threadIdx.x] : (threadIdx.x == N_IN ? (unsigned long long)pp.out : (unsigned long long)pp.ws); ((LAS unsigned*)(lds + LDS_PTRS))[2 * threadIdx.x] = (unsigned)a; ((LAS unsigned*)(lds + LDS_PTRS))[2 * threadIdx.x + 1] = (unsigned)(a >> 32); }
    __syncthreads();
    XcdBarrier bar = xcd_barrier_post((unsigned*)(pp.ws + WS_CTL) + CW_BAR + pp.li * XCD_BAR_WORDS, (volatile LAS unsigned*)(lds + LDS_CTL), threadIdx.x);
    LAS int* tb = (LAS int*)(lds + LDS_CTL + 64);
    int pc = 0; const int lo = pp.lo, hi = pp.hi;
#define PH_BEGIN if (pc >= lo && pc < hi) { Cx p; p.out = (unsigned long long)PIN(N_IN); p.ws = (unsigned long long)PIN(N_IN + 1); p.tid = swave * 64 + lane_id_asm(); p.bid = blockIdx.x; p.G = gridDim.x; p.pad = 0; asm volatile("" : "+s"(p.out), "+s"(p.ws), "+v"(p.tid), "+s"(p.bid), "+s"(p.G)); const int G = p.G, bid = p.bid; (void)G; (void)bid;
#define PH_END if (pc + 1 < hi) { XcdBarrier b2 = bar; asm volatile("" : "+s"(b2.bar), "+s"(b2.x)); xcd_barrier(b2, (unsigned)(swave * 64 + lane_id_asm())); } } ++pc;

    PH_BEGIN
        conv_run(p, (LAS float*)lds, CONV_A_UNITS, ConvDescA{0});
        __syncthreads();
        phase_mod(p, lds);
    PH_END

#pragma unroll
    for (int layer = 0; layer < NL; ++layer) {
        const int row_lo = layer == NL - 1 ? CROWS : 0;
        PH_BEGIN phase_norm1(p, layer); PH_END
        PH_BEGIN
            DenseSched S; S.init(G >= 160 + PB_DEFER_M * 16 ? ROWS - PB_DEFER_M * 256 : ROWS, NPROJ, D, WSP(bf16_t, WS_WIN) + (size_t)layer * NPROJ * D, G, bid);
            EpiProj E{WSP(bf16_t, WS_PROJ), NPROJ};
            pg8::gemm_phase<D>(p.tid, lds, (const char*)WSP(bf16_t, WS_HBUF), S, E);
        PH_END
#pragma unroll 1
        for (int b = 0; b < NB; ++b) {
            if (b == 0) { PH_BEGIN phase_prep(p, lds, layer, 0); PH_END }
            PH_BEGIN gla_p1(p, lds, layer, b); __syncthreads(); ssd_p1(p, lds, layer, b); __syncthreads(); gdn_p1(p, lds, layer, b); __syncthreads(); rw_p1(p, lds, layer, b); PH_END
            PH_BEGIN phase_scan(p, lds, layer, b); PH_END
            PH_BEGIN gla_p2(p, lds, layer, b); __syncthreads(); ssd_p2(p, lds, layer, b); __syncthreads(); gdn_p2(p, lds, layer, b); __syncthreads(); rw_p2(p, lds, layer, b); PH_END
            PH_BEGIN phase_post(p, lds, layer, b); if (b + 1 < NB) { __syncthreads(); phase_prep(p, lds, layer, b + 1); } PH_END
        }
        PH_BEGIN
            DenseSched S; S.init(ROWS - row_lo, D, D, WSP(bf16_t, WS_WOUT) + (size_t)layer * D * D, G, bid, row_lo / 256);
            if (layer == 0 && G >= 256) { S.init(ROWS - 1024, D, D, WSP(bf16_t, WS_WOUT) + (size_t)layer * D * D, G, bid, 0); S.gap_at = 4; S.gap_len = 4; }
            EpiRes E{layer == 0 ? PIN(I_X) : (const float*)POUT, layer == 0 ? PIN(I_CTX) : (const float*)WSP(float, WS_CTXRES), POUT, WSP(float, WS_CTXRES), WSP(float, WS_MOD) + (size_t)layer * 5 * 6144 + 2048};
            pg8::gemm_phase<D>(p.tid, lds, (const char*)WSP(bf16_t, WS_HBUF), S, E);
        PH_END
        PH_BEGIN phase_norm2(p, lds, layer, row_lo);
            __syncthreads();
            conv_run(p, (LAS float*)lds, CONV_E_UNITS, ConvDescE{layer});
        PH_END
        PH_BEGIN
            moe_table(p, tb, layer, row_lo);
            MoeSched<true> S{tb + 128, tb, 2, G, bid, D, row_lo, WSP(int, WS_LTOK), (const char*)WSP(bf16_t, WS_EXPGU), (size_t)512 * D * 2};
            EpiGU E{WSP(bf16_t, WS_H)};
            pg8::gemm_phase<D>(p.tid, lds, (const char*)WSP(bf16_t, WS_HBUF), S, E);
        PH_END
#pragma unroll
        for (int half = 0; half < 2; ++half) {
            PH_BEGIN
                moe_table(p, tb, layer, row_lo);
                MoeSched<false> S{tb + 128, tb, 2, G, bid, EH, row_lo, WSP(int, WS_LTOK), (const char*)(WSP(bf16_t, WS_EXPD) + (size_t)half * 512 * EH), (size_t)D * EH * 2};
                EpiY E{WSP(bf16_t, WS_Y)};
                pg8::gemm_phase<EH>(p.tid, lds, (const char*)WSP(bf16_t, WS_H), S, E);
            PH_END
            PH_BEGIN
                moe_table(p, tb, layer, row_lo);
                phase_combine(p, tb, layer, row_lo, half);
            PH_END
        }
    }
#undef PH_BEGIN
#undef PH_END
}

extern "C" void kernel_launch(void* const* d_in, const int* in_sizes, int n_in, void* d_out, int out_size, void* d_ws, size_t ws_size, hipStream_t stream) {
    static int grid = 0;
    if (grid == 0) {
        if (n_in != N_IN || in_sizes[0] != NB * SEQ * D || out_size != NB * SEQ * D || ws_size < WS_END) {
            fprintf(stderr, "kernel_launch: unexpected shapes (n_in %d, in0 %d, out %d, ws %zu); nothing launched\n", n_in, n_in > 0 ? in_sizes[0] : -1, out_size, ws_size); grid = -1; return; }
        int dev = 0, cus = 0, per_cu = 0;
        if (hipGetDevice(&dev) != hipSuccess || hipDeviceGetAttribute(&cus, hipDeviceAttributeMultiprocessorCount, dev) != hipSuccess) { grid = -1; return; }
        if (hipFuncSetAttribute((const void*)mega_fwd, hipFuncAttributeMaxDynamicSharedMemorySize, LDS_BYTES) != hipSuccess) { fprintf(stderr, "kernel_launch: hipFuncSetAttribute failed\n"); grid = -1; return; }
        if (hipOccupancyMaxActiveBlocksPerMultiprocessor(&per_cu, (const void*)mega_fwd, NTHR, LDS_BYTES) != hipSuccess || per_cu < 1) { fprintf(stderr, "kernel_launch: occupancy query says %d\n", per_cu); per_cu = 1; }
        (void)hipGetLastError();
        grid = cus * 1;
    }
    if (grid < 0) return;
    if (hipMemsetAsync((char*)d_ws + WS_CTL, 0, CTL_ZERO_BYTES, stream) != hipSuccess) return;
    Params p{};
    for (int i = 0; i < N_IN; ++i) p.in[i] = (const float*)d_in[i];
    p.out = (float*)d_out; p.ws = (unsigned char*)d_ws; p.pad = 0;
#if MK_ONE_LAUNCH
    p.lo = 0; p.hi = N_PHASES; p.li = 0;
    hipLaunchKernelGGL(mega_fwd, dim3(grid), dim3(NTHR), LDS_BYTES, stream, p);
#else
    for (int k = 0; k < N_PHASES; ++k) { p.lo = k; p.hi = k + 1; p.li = k;
        hipLaunchKernelGGL(mega_fwd, dim3(grid), dim3(NTHR), LDS_BYTES, stream, p); }
#endif
}
```
